# Optimizing an MI355X kernel written in HIP

```python
import math
import jax
import jax.numpy as jnp
from jax import lax
import numpy as np

D_MODEL = 1024
BATCH = 2
SEQ = 8192
DEPTH = 4
DEC_BATCH = 16
DEC_SEQ = 32
PAST_LEN = 1024

CHUNK = 64
N_META = 16
EPS = 1e-6
NEG_INF = -1e30
N_HEADS_A = 4
HEAD_DIM_A = 64
NUM_BUCKETS = 32
MAX_DISTANCE = 128
Q_BLOCK = 128
N_HEADS_B = 4
HEAD_DIM_B = 128
CONV_W = 4
S5_GROUP = 16
S5_GROUPS = 32
S5_STATE = 64
PEER_HEADS = 8
PEER_QDIM = 256
N_KEYS = 128
N_EXPERTS = N_KEYS * N_KEYS
PEER_TOPK = 16
PEER_BLOCK = 256

WIDTH_A = N_HEADS_A * 2 * HEAD_DIM_A
WIDTH_B = N_HEADS_B * HEAD_DIM_B
WIDTH_C = S5_GROUPS * S5_GROUP
OFF_QA = 0
OFF_KA = OFF_QA + WIDTH_A
OFF_VA = OFF_KA + WIDTH_A
OFF_QKVB = OFF_VA + WIDTH_A
OFF_GB = OFF_QKVB + 3 * WIDTH_B
OFF_BETA = OFF_GB + WIDTH_B
OFF_ALPHA = OFF_BETA + N_HEADS_B
OFF_UC = OFF_ALPHA + N_HEADS_B
OFF_GATE = OFF_UC + WIDTH_C
D_IN = OFF_GATE + 3 * D_MODEL

kernel_name = 'hybrid_stream_diffattn_gdn_s5_peer'


def rmsnorm(x, g):
    xf = x.astype(jnp.float32)
    y = xf * lax.rsqrt(jnp.mean(xf * xf, axis=-1, keepdims=True) + EPS)
    return (y * g.astype(jnp.float32)).astype(x.dtype)


def l2norm(x):
    xf = x.astype(jnp.float32)
    return xf * lax.rsqrt(jnp.sum(xf * xf, axis=-1, keepdims=True) + EPS)


def chunk_id(pos):
    return jnp.where(pos < N_META, 0, 1 + (pos - N_META) // CHUNK)


def t5_bias(q_pos, k_pos, table):
    rel = k_pos[None, :] - q_pos[:, None]
    half = NUM_BUCKETS // 2
    exact = half // 2
    n = jnp.abs(rel)
    nf = jnp.maximum(n, 1).astype(jnp.float32)
    far = exact + (jnp.log(nf / exact) / math.log(MAX_DISTANCE / exact) * (half - exact)).astype(jnp.int32)
    bucket = jnp.where(rel > 0, half, 0) + jnp.where(n < exact, n, jnp.minimum(far, half - 1))
    return jnp.moveaxis(table[bucket].astype(jnp.float32), -1, 0)


def diff_attn_core(q, k, v, q_pos, k_pos, lam, rel_table, mask):
    logits = jnp.einsum('bqhcd,bkhcd->bhcqk', q.astype(jnp.float32), k.astype(jnp.float32)) * (HEAD_DIM_A ** -0.5)
    logits = logits + t5_bias(q_pos, k_pos, rel_table)[None, :, None]
    if mask is not None:
        logits = jnp.where(mask, logits, NEG_INF)
    p = jax.nn.softmax(logits, axis=-1)
    w = p[:, :, 0] - lam * p[:, :, 1]
    return jnp.einsum('bhqk,bkhe->bqhe', w.astype(v.dtype), v)


def diff_attn_prompt(q, k, v, lam, rel_table):
    B, L = q.shape[0], q.shape[1]
    n_blk = -(-L // Q_BLOCK)
    qb = jnp.pad(q, ((0, 0), (0, n_blk * Q_BLOCK - L), (0, 0), (0, 0), (0, 0)))
    qb = jnp.moveaxis(qb.reshape(B, n_blk, Q_BLOCK, N_HEADS_A, 2, HEAD_DIM_A), 1, 0)
    starts = jnp.arange(n_blk, dtype=jnp.int32) * Q_BLOCK
    k_pos = jnp.arange(L, dtype=jnp.int32)
    k_chunk = chunk_id(k_pos)

    def block(args):
        q_i, s = args
        q_pos = s + jnp.arange(Q_BLOCK, dtype=jnp.int32)
        mask = k_chunk[None, :] <= chunk_id(q_pos)[:, None]
        return diff_attn_core(q_i, k, v, q_pos, k_pos, lam, rel_table, mask)

    o = lax.map(block, (qb, starts))
    o = jnp.moveaxis(o, 0, 1).reshape(B, n_blk * Q_BLOCK, N_HEADS_A, 2 * HEAD_DIM_A)
    return o[:, :L]


def causal_conv(hist, w):
    L = hist.shape[1] - (CONV_W - 1)
    out = hist[:, 0:L] * w[0]
    for i in range(1, CONV_W):
        out = out + hist[:, i:i + L] * w[i]
    return out


def gdn_chunk_scan(q, k, v, g, beta, S0, C):
    B, L, H = g.shape
    n = L // C

    def to_chunks(t):
        t = t.reshape((B, n, C) + t.shape[2:])
        return jnp.moveaxis(jnp.moveaxis(t, 1, 0), 3, 2)

    tri = jnp.tril(jnp.ones((C, C), dtype=bool))
    strict = jnp.tril(jnp.ones((C, C), dtype=bool), -1)
    eye = jnp.eye(C, dtype=jnp.float32)

    def step(S, inp):
        q_c, k_c, v_c, g_c, b_c = inp
        G = jnp.cumsum(g_c, axis=-1)
        decay = jnp.exp(jnp.where(tri, G[..., :, None] - G[..., None, :], -jnp.inf))
        kb = k_c * b_c[..., None]
        A = jnp.where(strict, jnp.einsum('bhid,bhjd->bhij', kb, k_c) * decay, 0.0)
        rhs = jnp.concatenate([v_c * b_c[..., None], kb * jnp.exp(G)[..., None]], axis=-1)
        sol = lax.linalg.triangular_solve(eye + A, rhs, left_side=True, lower=True, unit_diagonal=True)
        u, w = sol[..., :HEAD_DIM_B], sol[..., HEAD_DIM_B:]
        v_new = u - jnp.einsum('bhck,bhkv->bhcv', w, S)
        attn = jnp.einsum('bhid,bhjd->bhij', q_c, k_c) * decay
        o = jnp.einsum('bhck,bhkv->bhcv', q_c * jnp.exp(G)[..., None], S) + jnp.einsum('bhij,bhjv->bhiv', attn, v_new)
        G_last = G[..., -1:]
        S = S * jnp.exp(G_last)[..., None] + jnp.einsum('bhck,bhcv->bhkv', k_c * jnp.exp(G_last - G)[..., None], v_new)
        return S, o

    S, o = lax.scan(step, S0, (to_chunks(q), to_chunks(k), to_chunks(v), to_chunks(g), to_chunks(beta)))
    o = jnp.moveaxis(jnp.moveaxis(o, 2, 3), 0, 1).reshape(B, L, H, HEAD_DIM_B)
    return o, S


def gdn_segments(q, k, v, g, beta, S, segments):
    outs = []
    for (a, b, c) in segments:
        o, S = gdn_chunk_scan(q[:, a:b], k[:, a:b], v[:, a:b], g[:, a:b], beta[:, a:b], S, c)
        outs.append(o)
    return jnp.concatenate(outs, axis=1), S


def _ssm_combine(e1, e2):
    a1, b1 = e1
    a2, b2 = e2
    return a1 * a2, a2 * b1 + b2


def s5_scan(u, x0_re, x0_im, a_re, a_im, b_re, b_im, c_re, c_im, d, log_dt):
    f32 = jnp.float32
    uf = u.astype(f32)
    lam = lax.complex(a_re.astype(f32), a_im.astype(f32))
    lam_bar = jnp.exp(lam * jnp.exp(log_dt.astype(f32))[:, None])
    b_bar = ((lam_bar - 1.0) / lam)[..., None] * lax.complex(b_re.astype(f32), b_im.astype(f32))
    c = lax.complex(c_re.astype(f32), c_im.astype(f32))
    bu = jnp.einsum('blgi,gpi->blgp', uf.astype(jnp.complex64), b_bar)
    x0 = lax.complex(x0_re.astype(f32), x0_im.astype(f32))
    bu = bu.at[:, 0].add(lam_bar * x0)
    a = jnp.broadcast_to(lam_bar, bu.shape)
    _, xs = lax.associative_scan(_ssm_combine, (a, bu), axis=1)
    y = jnp.einsum('blgp,gip->blgi', xs, c).real + d.astype(f32) * uf
    return y, xs[:, -1]


def peer(h, wq, subkeys, pu, pv):
    T = h.shape[0]
    nb = -(-T // PEER_BLOCK)
    hb = jnp.pad(h, ((0, nb * PEER_BLOCK - T), (0, 0))).reshape(nb, PEER_BLOCK, D_MODEL)
    sk = subkeys.astype(jnp.float32)

    def block(hx):
        q = (hx @ wq).astype(jnp.float32).reshape(PEER_BLOCK, PEER_HEADS, 2, PEER_QDIM // 2)
        s = jnp.einsum('thcd,hcnd->thcn', q, sk)
        s1, i1 = lax.top_k(s[:, :, 0], PEER_TOPK)
        s2, i2 = lax.top_k(s[:, :, 1], PEER_TOPK)
        cand = (s1[..., :, None] + s2[..., None, :]).reshape(PEER_BLOCK, PEER_HEADS, PEER_TOPK * PEER_TOPK)
        best, ci = lax.top_k(cand, PEER_TOPK)
        e = (jnp.take_along_axis(i1, ci // PEER_TOPK, axis=-1) * N_KEYS
             + jnp.take_along_axis(i2, ci % PEER_TOPK, axis=-1))
        gw = jax.nn.softmax(best, axis=-1)
        act = jax.nn.gelu(jnp.einsum('td,thkd->thk', hx, pu[e]).astype(jnp.float32))
        return jnp.einsum('thk,thkd->td', (gw * act).astype(pv.dtype), pv[e])

    return lax.map(block, hb).reshape(nb * PEER_BLOCK, D_MODEL)[:T]


def trunk_layer(x, lp, layer_idx, rel_table, prompt, k_past, v_past, conv_hist, delta0, ssm0_re, ssm0_im):
    f32 = jnp.float32
    B, L = x.shape[0], x.shape[1]
    h = rmsnorm(x, lp['norm1'])
    z = h @ lp['w_in']

    qA = rmsnorm(z[..., OFF_QA:OFF_KA].reshape(B, L, N_HEADS_A, 2, HEAD_DIM_A), lp['q_norm'])
    kA = rmsnorm(z[..., OFF_KA:OFF_VA].reshape(B, L, N_HEADS_A, 2, HEAD_DIM_A), lp['k_norm'])
    vA = z[..., OFF_VA:OFF_QKVB].reshape(B, L, N_HEADS_A, 2 * HEAD_DIM_A)
    lam_init = 0.8 - 0.6 * math.exp(-0.3 * layer_idx)
    lqk = lp['lambda_qk'].astype(f32)
    lam = jnp.exp(jnp.sum(lqk[0] * lqk[1])) - jnp.exp(jnp.sum(lqk[2] * lqk[3])) + lam_init
    if prompt:
        oA = diff_attn_prompt(qA, kA, vA, lam, rel_table)
    else:
        P = k_past.shape[1]
        k_all = jnp.concatenate([k_past.reshape(B, P, N_HEADS_A, 2, HEAD_DIM_A), kA], axis=1)
        v_all = jnp.concatenate([v_past, vA], axis=1)
        oA = diff_attn_core(qA, k_all, v_all, P + jnp.arange(L, dtype=jnp.int32),
                            jnp.arange(P + L, dtype=jnp.int32), lam, rel_table, None)
    oA = (rmsnorm(oA, lp['subln']) * (1.0 - lam_init)).reshape(B, L, WIDTH_A)

    qkv_in = z[..., OFF_QKVB:OFF_GB]
    hist = jnp.concatenate([conv_hist.astype(qkv_in.dtype), qkv_in], axis=1)
    conv_state = hist[:, -(CONV_W - 1):]
    c = jax.nn.silu(causal_conv(hist, lp['conv_w']))
    qB = l2norm(c[..., :WIDTH_B].reshape(B, L, N_HEADS_B, HEAD_DIM_B)) * (HEAD_DIM_B ** -0.5)
    kB = l2norm(c[..., WIDTH_B:2 * WIDTH_B].reshape(B, L, N_HEADS_B, HEAD_DIM_B))
    vB = c[..., 2 * WIDTH_B:].reshape(B, L, N_HEADS_B, HEAD_DIM_B).astype(f32)
    beta = jax.nn.sigmoid(z[..., OFF_BETA:OFF_ALPHA].astype(f32))
    g = -jnp.exp(lp['a_log'].astype(f32)) * jax.nn.softplus(z[..., OFF_ALPHA:OFF_UC].astype(f32) + lp['dt_bias'].astype(f32))
    segments = ((0, N_META, N_META), (N_META, L, CHUNK)) if prompt else ((0, L, L),)
    oB, delta = gdn_segments(qB, kB, vB, g, beta, delta0.astype(f32), segments)
    gate_b = z[..., OFF_GB:OFF_BETA].reshape(B, L, N_HEADS_B, HEAD_DIM_B)
    oB = (rmsnorm(oB.astype(x.dtype), lp['gdn_norm']) * jax.nn.silu(gate_b)).reshape(B, L, WIDTH_B)

    u = z[..., OFF_UC:OFF_GATE].reshape(B, L, S5_GROUPS, S5_GROUP)
    yC, ssm = s5_scan(u, ssm0_re, ssm0_im, lp['s5_a_re'], lp['s5_a_im'], lp['s5_b_re'], lp['s5_b_im'],
                      lp['s5_c_re'], lp['s5_c_im'], lp['s5_d'], lp['s5_log_dt'])
    gl = jax.nn.gelu(yC.reshape(B, L, WIDTH_C).astype(x.dtype)) @ lp['w_glu']
    oC = gl[..., :WIDTH_C] * jax.nn.sigmoid(gl[..., WIDTH_C:])

    gates = jax.nn.sigmoid(z[..., OFF_GATE:].reshape(B, L, 3, D_MODEL))
    merged = (gates[:, :, 0] * (oA @ lp['wb_a']) + gates[:, :, 1] * (oB @ lp['wb_b'])
              + gates[:, :, 2] * (oC @ lp['wb_c']))
    x = x + merged @ lp['w_out']

    h2 = rmsnorm(x, lp['norm2'])
    x = x + peer(h2.reshape(B * L, D_MODEL), lp['peer_wq'], lp['peer_subkeys'], lp['peer_u'], lp['peer_v']).reshape(B, L, D_MODEL)
    return (x, kA.reshape(B, L, N_HEADS_A, 2 * HEAD_DIM_A), vA, conv_state, delta.astype(x.dtype),
            ssm.real.astype(x.dtype), ssm.imag.astype(x.dtype))


def setup_inputs(seed: int = 0) -> dict:
    key = jax.random.key(seed)
    ks = jax.random.split(key, 40)
    f32 = jnp.float32

    def nrm(k, shape, s):
        return jax.random.normal(k, shape, f32) * s

    dt = jnp.exp(jax.random.uniform(ks[14], (DEPTH, N_HEADS_B), f32, math.log(1e-3), math.log(1e-1)))
    return {
        'x_prompt': nrm(ks[0], (BATCH, SEQ, D_MODEL), 1.0),
        'x_sample': nrm(ks[1], (DEC_BATCH, DEC_SEQ, D_MODEL), 1.0),
        'cache_k': nrm(ks[2], (DEPTH, DEC_BATCH, PAST_LEN, N_HEADS_A, 2 * HEAD_DIM_A), 1.0),
        'cache_v': nrm(ks[3], (DEPTH, DEC_BATCH, PAST_LEN, N_HEADS_A, 2 * HEAD_DIM_A), 1.0),
        'state_conv': nrm(ks[4], (DEPTH, DEC_BATCH, CONV_W - 1, 3 * WIDTH_B), 1.0),
        'state_delta': nrm(ks[5], (DEPTH, DEC_BATCH, N_HEADS_B, HEAD_DIM_B, HEAD_DIM_B), 0.1),
        'state_ssm_re': nrm(ks[6], (DEPTH, DEC_BATCH, S5_GROUPS, S5_STATE), 0.1),
        'state_ssm_im': nrm(ks[7], (DEPTH, DEC_BATCH, S5_GROUPS, S5_STATE), 0.1),
        'meta_tokens': nrm(ks[8], (N_META, D_MODEL), 1.0),
        'rel_bias': nrm(ks[9], (NUM_BUCKETS, N_HEADS_A), 0.1),
        'norm1_g': 1.0 + nrm(ks[10], (DEPTH, D_MODEL), 0.01),
        'norm2_g': 1.0 + nrm(ks[11], (DEPTH, D_MODEL), 0.01),
        'final_norm_g': 1.0 + nrm(ks[12], (D_MODEL,), 0.01),
        'w_in': nrm(ks[13], (DEPTH, D_MODEL, D_IN), D_MODEL ** -0.5),
        'q_norm_g': 1.0 + nrm(ks[15], (DEPTH, HEAD_DIM_A), 0.01),
        'k_norm_g': 1.0 + nrm(ks[16], (DEPTH, HEAD_DIM_A), 0.01),
        'lambda_qk': nrm(ks[17], (DEPTH, 4, HEAD_DIM_A), 0.1),
        'subln_g': 1.0 + nrm(ks[18], (DEPTH, 2 * HEAD_DIM_A), 0.01),
        'conv_w': nrm(ks[19], (DEPTH, CONV_W, 3 * WIDTH_B), CONV_W ** -0.5),
        'gdn_a_log': jnp.log(jax.random.uniform(ks[20], (DEPTH, N_HEADS_B), f32, 1.0, 16.0)),
        'gdn_dt_bias': dt + jnp.log(-jnp.expm1(-dt)),
        'gdn_norm_g': 1.0 + nrm(ks[21], (DEPTH, HEAD_DIM_B), 0.01),
        's5_a_re': -0.5 + nrm(ks[22], (DEPTH, S5_GROUPS, S5_STATE), 0.01),
        's5_a_im': jnp.pi * jnp.arange(S5_STATE, dtype=f32) + nrm(ks[23], (DEPTH, S5_GROUPS, S5_STATE), 0.01),
        's5_b_re': nrm(ks[24], (DEPTH, S5_GROUPS, S5_STATE, S5_GROUP), (2 * S5_GROUP) ** -0.5),
        's5_b_im': nrm(ks[25], (DEPTH, S5_GROUPS, S5_STATE, S5_GROUP), (2 * S5_GROUP) ** -0.5),
        's5_c_re': nrm(ks[26], (DEPTH, S5_GROUPS, S5_GROUP, S5_STATE), (2 * S5_STATE) ** -0.5),
        's5_c_im': nrm(ks[27], (DEPTH, S5_GROUPS, S5_GROUP, S5_STATE), (2 * S5_STATE) ** -0.5),
        's5_d': nrm(ks[28], (DEPTH, S5_GROUPS, S5_GROUP), 1.0),
        's5_log_dt': jax.random.uniform(ks[29], (DEPTH, S5_GROUPS), f32, math.log(1e-3), math.log(1e-1)),
        'w_glu': nrm(ks[30], (DEPTH, WIDTH_C, 2 * WIDTH_C), WIDTH_C ** -0.5),
        'w_branch_a': nrm(ks[31], (DEPTH, WIDTH_A, D_MODEL), WIDTH_A ** -0.5),
        'w_branch_b': nrm(ks[32], (DEPTH, WIDTH_B, D_MODEL), WIDTH_B ** -0.5),
        'w_branch_c': nrm(ks[33], (DEPTH, WIDTH_C, D_MODEL), WIDTH_C ** -0.5),
        'w_out': nrm(ks[34], (DEPTH, D_MODEL, D_MODEL), D_MODEL ** -0.5),
        'peer_wq': nrm(ks[35], (DEPTH, D_MODEL, PEER_HEADS * PEER_QDIM), D_MODEL ** -0.5),
        'peer_subkeys': nrm(ks[36], (DEPTH, PEER_HEADS, 2, N_KEYS, PEER_QDIM // 2), (PEER_QDIM // 2) ** -0.5),
        'peer_u': nrm(ks[37], (DEPTH, N_EXPERTS, D_MODEL), D_MODEL ** -0.5),
        'peer_v': nrm(ks[38], (DEPTH, N_EXPERTS, D_MODEL), 0.1),
    }


def reference(x_prompt, x_sample, cache_k, cache_v, state_conv, state_delta, state_ssm_re, state_ssm_im,
              meta_tokens, rel_bias, norm1_g, norm2_g, final_norm_g, w_in, q_norm_g, k_norm_g, lambda_qk,
              subln_g, conv_w, gdn_a_log, gdn_dt_bias, gdn_norm_g, s5_a_re, s5_a_im, s5_b_re, s5_b_im,
              s5_c_re, s5_c_im, s5_d, s5_log_dt, w_glu, w_branch_a, w_branch_b, w_branch_c, w_out,
              peer_wq, peer_subkeys, peer_u, peer_v):
    params = [dict(norm1=norm1_g[l], norm2=norm2_g[l], w_in=w_in[l], q_norm=q_norm_g[l], k_norm=k_norm_g[l],
                   lambda_qk=lambda_qk[l], subln=subln_g[l], conv_w=conv_w[l], a_log=gdn_a_log[l],
                   dt_bias=gdn_dt_bias[l], gdn_norm=gdn_norm_g[l], s5_a_re=s5_a_re[l], s5_a_im=s5_a_im[l],
                   s5_b_re=s5_b_re[l], s5_b_im=s5_b_im[l], s5_c_re=s5_c_re[l], s5_c_im=s5_c_im[l],
                   s5_d=s5_d[l], s5_log_dt=s5_log_dt[l], w_glu=w_glu[l], wb_a=w_branch_a[l],
                   wb_b=w_branch_b[l], wb_c=w_branch_c[l], w_out=w_out[l], peer_wq=peer_wq[l],
                   peer_subkeys=peer_subkeys[l], peer_u=peer_u[l], peer_v=peer_v[l])
              for l in range(DEPTH)]
    f32 = jnp.float32

    B = x_prompt.shape[0]
    dt = x_prompt.dtype
    xp = jnp.concatenate([jnp.broadcast_to(meta_tokens.astype(dt)[None], (B, N_META, D_MODEL)), x_prompt], axis=1)
    kp, vp, cp, dp, srp, sip = [], [], [], [], [], []
    for l in range(DEPTH):
        xp, k_new, v_new, c_new, d_new, sr_new, si_new = trunk_layer(
            xp, params[l], l, rel_bias, True, None, None,
            jnp.zeros((B, CONV_W - 1, 3 * WIDTH_B), dt),
            jnp.zeros((B, N_HEADS_B, HEAD_DIM_B, HEAD_DIM_B), f32),
            jnp.zeros((B, S5_GROUPS, S5_STATE), f32), jnp.zeros((B, S5_GROUPS, S5_STATE), f32))
        kp.append(k_new); vp.append(v_new); cp.append(c_new); dp.append(d_new); srp.append(sr_new); sip.append(si_new)
    y_prompt = rmsnorm(xp, final_norm_g)[:, N_META:]

    xs = x_sample
    ks_, vs_, cs_, ds_, srs, sis = [], [], [], [], [], []
    for l in range(DEPTH):
        xs, k_new, v_new, c_new, d_new, sr_new, si_new = trunk_layer(
            xs, params[l], l, rel_bias, False, cache_k[l], cache_v[l], state_conv[l],
            state_delta[l], state_ssm_re[l], state_ssm_im[l])
        ks_.append(k_new); vs_.append(v_new); cs_.append(c_new); ds_.append(d_new); srs.append(sr_new); sis.append(si_new)
    y_sample = rmsnorm(xs, final_norm_g)

    k_prompt = jnp.stack(kp)
    v_prompt = jnp.stack(vp)
    k_sample = jnp.stack(ks_)
    v_sample = jnp.stack(vs_)
    conv_prompt = jnp.stack(cp)
    conv_sample = jnp.stack(cs_)
    delta_prompt = jnp.stack(dp)
    delta_sample = jnp.stack(ds_)
    ssm_re_prompt = jnp.stack(srp)
    ssm_im_prompt = jnp.stack(sip)
    ssm_re_sample = jnp.stack(srs)
    ssm_im_sample = jnp.stack(sis)
    return (y_prompt, y_sample, k_prompt, v_prompt, k_sample, v_sample, conv_prompt, conv_sample,
            delta_prompt, delta_sample, ssm_re_prompt, ssm_im_prompt, ssm_re_sample, ssm_im_sample)
```

```cpp
#include <hip/hip_runtime.h>
#include <cstdio>
#include <cstdint>
#define MK_ONE_LAUNCH 0
#ifndef D_MODEL
#define D_MODEL 1024
#define BATCH 2
#define SEQ 8192
#define DEPTH 4
#define DEC_BATCH 16
#define DEC_SEQ 32
#define PAST_LEN 1024
#define N_HEADS_A 4
#define HEAD_DIM_A 64
#define N_HEADS_B 4
#define HEAD_DIM_B 128
#define S5_GROUPS 32
#define S5_STATE 64
#define PEER_HEADS 8
#define PEER_QDIM 256
#define N_KEYS 128
#endif
#define CHUNK 64
#define N_META 16
#define EPSF 1e-6f
#define NUM_BUCKETS 32
#define CONV_W 4
#define S5_GROUP 16
#define PEER_TOPK 16
#define N_EXPERTS (N_KEYS * N_KEYS)
#define WIDTH_A (N_HEADS_A * 2 * HEAD_DIM_A)
#define WIDTH_B (N_HEADS_B * HEAD_DIM_B)
#define WIDTH_C (S5_GROUPS * S5_GROUP)
#define OFF_QA 0
#define OFF_KA (OFF_QA + WIDTH_A)
#define OFF_VA (OFF_KA + WIDTH_A)
#define OFF_QKVB (OFF_VA + WIDTH_A)
#define OFF_GB (OFF_QKVB + 3 * WIDTH_B)
#define OFF_BETA (OFF_GB + WIDTH_B)
#define OFF_ALPHA (OFF_BETA + N_HEADS_B)
#define OFF_UC (OFF_ALPHA + N_HEADS_B)
#define OFF_GATE (OFF_UC + WIDTH_C)
#define D_IN (OFF_GATE + 3 * D_MODEL)
#define LP (N_META + SEQ)
#define NP (BATCH * LP)
#define NS (DEC_BATCH * DEC_SEQ)
#define NT (NP + NS)
#define PQ (PEER_HEADS * PEER_QDIM)

enum { I_XP, I_XS, I_CK, I_CV, I_SCONV, I_SDELTA, I_SRE, I_SIM, I_META, I_REL, I_N1, I_N2, I_FN, I_WIN, I_QN, I_KN, I_LQK, I_SUBLN, I_CONVW, I_ALOG, I_DTB, I_GDNN,
       I_AR, I_AI, I_BR, I_BI, I_CR, I_CI, I_SD, I_LDT, I_WGLU, I_WBA, I_WBB, I_WBC, I_WOUT, I_PWQ, I_PSK, I_PU, I_PV, N_INPUTS };
#define O_YP 0
#define O_YS (O_YP + (size_t)BATCH * SEQ * D_MODEL)
#define O_KP (O_YS + (size_t)NS * D_MODEL)
#define O_VP (O_KP + (size_t)DEPTH * NP * WIDTH_A)
#define O_KS (O_VP + (size_t)DEPTH * NP * WIDTH_A)
#define O_VS (O_KS + (size_t)DEPTH * NS * WIDTH_A)
#define O_CP (O_VS + (size_t)DEPTH * NS * WIDTH_A)
#define O_CS (O_CP + (size_t)DEPTH * BATCH * (CONV_W - 1) * 3 * WIDTH_B)
#define O_DP (O_CS + (size_t)DEPTH * DEC_BATCH * (CONV_W - 1) * 3 * WIDTH_B)
#define O_DS (O_DP + (size_t)DEPTH * BATCH * N_HEADS_B * HEAD_DIM_B * HEAD_DIM_B)
#define O_SRP (O_DS + (size_t)DEPTH * DEC_BATCH * N_HEADS_B * HEAD_DIM_B * HEAD_DIM_B)
#define O_SIP (O_SRP + (size_t)DEPTH * BATCH * S5_GROUPS * S5_STATE)
#define O_SRS (O_SIP + (size_t)DEPTH * BATCH * S5_GROUPS * S5_STATE)
#define O_SIS (O_SRS + (size_t)DEPTH * DEC_BATCH * S5_GROUPS * S5_STATE)
#define O_END (O_SIS + (size_t)DEPTH * DEC_BATCH * S5_GROUPS * S5_STATE)

namespace pg8 {
#define PG8_LAS __attribute__((address_space(3)))
typedef unsigned short bf16_t;
typedef short bf16x8 __attribute__((ext_vector_type(8)));
typedef float f32x4 __attribute__((ext_vector_type(4)));
typedef unsigned u32x4 __attribute__((ext_vector_type(4)));
constexpr int BM = 256, BK = 64, HALF = 128, HTB = HALF * BK * 2  , STAGE_BYTES = 8 * HTB, NXCD = 8, WGM = 8;

__host__ __device__ __forceinline__ int lds_byte(int r, int c) { const int st = (r >> 4) * 2 + (c >> 5), rr = r & 15, cc = c & 31, ob = rr * 64 + cc * 2; return st * 1024 + (ob ^ (((ob >> 9) & 1) << 5)); }
__host__ __device__ __forceinline__ void stage_rc(int b, int& R, int& C) { const int st = b / 1024, sb = b % 1024, swz = sb ^ (((sb >> 9) & 1) << 5); R = (st >> 1) * 16 + swz / 64; C = (st & 1) * 32 + (swz % 64) / 2; }
__host__ __device__ __forceinline__ int perm32(int rho) { const int n = rho >> 4, i = rho & 15; return 8 * (i >> 2) + 4 * n + (i & 3); }

struct Unit { int pm, pn; };
struct Gemm { const bf16_t* A; const bf16_t* Bt; int M, N, K; };

struct StaticOrder {
    int nM, nN, nwg, G, c;
    __host__ __device__ void init(int M, int N, int G_, int c_) { nM = M / BM; nN = N / BM; nwg = nM * nN; G = G_; c = c_; }
    __host__ __device__ bool next(int i, Unit& u) const {
        const long L = (long)i * G + c; if (L >= nwg) return false;
        int wgid = (int)L; { const int q = nwg / NXCD, r = nwg % NXCD, xcd = wgid % NXCD, off = wgid / NXCD; wgid = (xcd < r ? xcd * (q + 1) : r * (q + 1) + (xcd - r) * q) + off; }
        const int nig = WGM * nN, gid = wgid / nig, fm = gid * WGM, gsz = (nM - fm) < WGM ? (nM - fm) : WGM;
        u.pm = fm + ((wgid % nig) % gsz); u.pn = (wgid % nig) / gsz; return true;
    }
    __device__ __forceinline__ void a_ready(const Unit&) const {}
    __device__ __forceinline__ void done(const Unit&) const {}
};

__device__ __forceinline__ unsigned cvt_pk_bf16(float lo, float hi) { unsigned r; asm volatile("v_cvt_pk_bf16_f32 %0, %1, %2" : "=v"(r) : "v"(lo), "v"(hi)); return r; }
typedef float f32x2 __attribute__((ext_vector_type(2)));
__device__ __forceinline__ f32x2 gelu_pk(f32x2 v) {
    const f32x2 av = __builtin_elementwise_abs(v), d = av * 0.2316418882f + 1.0f;
    f32x2 t; t.x = __builtin_amdgcn_rcpf(d.x); t.y = __builtin_amdgcn_rcpf(d.y);
    f32x2 q = t * 0.5307027145f + (-0.7265760135f); q = q * t + 0.7107068705f; q = q * t + (-0.142248368f); q = q * t + 0.127414796f; q = q * t;
    const f32x2 s = (v * v) * (-0.72134752044f);
    f32x2 e; e.x = __builtin_amdgcn_exp2f(s.x); e.y = __builtin_amdgcn_exp2f(s.y);
    const f32x2 m = v * (q * e), r = v - m;
    f32x2 o; o.x = v.x < 0.f ? m.x : r.x; o.y = v.y < 0.f ? m.y : r.y; return o;
}

template <int ACT  > struct EpiBf16 {
    static constexpr bool PERM = true, AFTER_DRAIN = false; static_assert(ACT == 0 || ACT == 1, "EpiBf16: ACT is 0 (none) or 1 (gelu_pk)");
    bf16_t* O; int ldc; const float* bias; int split_cols; size_t split_stride; float scale0;
    __device__ __forceinline__ void operator()(const f32x4 (&acc)[2][2][4][2], const Unit& u, int wr, int wc, int fr, int fq) const {
        const int row0 = u.pm * BM + wr * 64 + fr; int colt = u.pn * BM; bf16_t* base = O;
        float sc = 1.f; if (split_cols) { const int t = colt / split_cols; base += (size_t)t * split_stride; colt -= t * split_cols; if (t == 0) sc = scale0; }
        const int col0 = colt + wc * 32 + 8 * fq, bcol0 = u.pn * BM + wc * 32 + 8 * fq;
        f32x4 bv[2][2];
#pragma unroll
        for (int bj = 0; bj < 2; ++bj)
#pragma unroll
            for (int n = 0; n < 2; ++n) bv[bj][n] = bias ? *(const f32x4*)(bias + bcol0 + bj * HALF + 4 * n) : (f32x4){0.f, 0.f, 0.f, 0.f};
#pragma unroll
        for (int ai = 0; ai < 2; ++ai)
#pragma unroll
            for (int m = 0; m < 4; ++m) { bf16_t* rowp = base + (size_t)(row0 + ai * HALF + m * 16) * ldc + col0;
#pragma unroll
                for (int bj = 0; bj < 2; ++bj) { f32x4 v0 = acc[ai][bj][m][0] + bv[bj][0], v1 = acc[ai][bj][m][1] + bv[bj][1];
                    if (ACT == 1) { f32x2 a = gelu_pk((f32x2){v0[0], v0[1]}), b = gelu_pk((f32x2){v0[2], v0[3]}), c = gelu_pk((f32x2){v1[0], v1[1]}), d = gelu_pk((f32x2){v1[2], v1[3]});
                        v0 = (f32x4){a.x, a.y, b.x, b.y}; v1 = (f32x4){c.x, c.y, d.x, d.y}; }
                    v0 = v0 * sc; v1 = v1 * sc; u32x4 w; w.x = cvt_pk_bf16(v0[0], v0[1]); w.y = cvt_pk_bf16(v0[2], v0[3]); w.z = cvt_pk_bf16(v1[0], v1[1]); w.w = cvt_pk_bf16(v1[2], v1[3]);
                    *(u32x4*)(rowp + bj * HALF) = w; } }
    }
};

__device__ __forceinline__ float epi_sigm(float x) { return 1.f / (1.f + __expf(-x)); }
struct EpiGlu {
    static constexpr bool PERM = false, AFTER_DRAIN = false;
    bf16_t* O; int ldo;
    __device__ __forceinline__ void operator()(const f32x4 (&acc)[2][2][4][2], const Unit& u, int wr, int wc, int fr, int fq) const {
        const int row0 = u.pm * BM + wr * 64 + fr;
#pragma unroll
        for (int ai = 0; ai < 2; ++ai)
#pragma unroll
            for (int m = 0; m < 4; ++m) { bf16_t* rowp = O + (size_t)(row0 + ai * HALF + m * 16) * ldo + 4 * fq;
#pragma unroll
                for (int bj = 0; bj < 2; ++bj) { const int G = u.pn * 8 + bj * 4 + wc; const f32x4 av = acc[ai][bj][m][0], gv = acc[ai][bj][m][1];
                    typedef unsigned u32x2 __attribute__((ext_vector_type(2))); u32x2 w;
                    w.x = cvt_pk_bf16(av[0] * epi_sigm(gv[0]), av[1] * epi_sigm(gv[1])); w.y = cvt_pk_bf16(av[2] * epi_sigm(gv[2]), av[3] * epi_sigm(gv[3]));
                    *(u32x2*)(rowp + 16 * G) = w; } }
    }
};
template <int MODE> struct EpiMerge {
    static constexpr bool PERM = true, AFTER_DRAIN = false;
    float* M; bf16_t* Mb; const bf16_t* Zg; int ldz;
    __device__ __forceinline__ void operator()(const f32x4 (&acc)[2][2][4][2], const Unit& u, int wr, int wc, int fr, int fq) const {
        const int row0 = u.pm * BM + wr * 64 + fr, col0 = u.pn * BM + wc * 32 + 8 * fq;
#pragma unroll
        for (int ai = 0; ai < 2; ++ai)
#pragma unroll
            for (int m = 0; m < 4; ++m) { const size_t row = (size_t)(row0 + ai * HALF + m * 16);
#pragma unroll
                for (int bj = 0; bj < 2; ++bj) { const int col = col0 + bj * HALF;
                    const u32x4 gz = *(const u32x4*)(Zg + row * ldz + col);
                    float g[8]; g[0] = __builtin_bit_cast(float, gz.x << 16); g[1] = __builtin_bit_cast(float, gz.x & 0xffff0000u); g[2] = __builtin_bit_cast(float, gz.y << 16); g[3] = __builtin_bit_cast(float, gz.y & 0xffff0000u);
                    g[4] = __builtin_bit_cast(float, gz.z << 16); g[5] = __builtin_bit_cast(float, gz.z & 0xffff0000u); g[6] = __builtin_bit_cast(float, gz.w << 16); g[7] = __builtin_bit_cast(float, gz.w & 0xffff0000u);
                    f32x4 v0 = acc[ai][bj][m][0], v1 = acc[ai][bj][m][1];
#pragma unroll
                    for (int j = 0; j < 4; ++j) { v0[j] *= epi_sigm(g[j]); v1[j] *= epi_sigm(g[4 + j]); }
                    float* mp = M + row * 1024 + col;
                    if (MODE != 0) { v0 += *(const f32x4*)mp; v1 += *(const f32x4*)(mp + 4); }
                    if (MODE != 2) { *(f32x4*)mp = v0; *(f32x4*)(mp + 4) = v1; }
                    else { u32x4 w; w.x = cvt_pk_bf16(v0[0], v0[1]); w.y = cvt_pk_bf16(v0[2], v0[3]); w.z = cvt_pk_bf16(v1[0], v1[1]); w.w = cvt_pk_bf16(v1[2], v1[3]); *(u32x4*)(Mb + row * 1024 + col) = w; } } }
    }
};
struct EpiResid {
    static constexpr bool PERM = false, AFTER_DRAIN = false;
    float* X; int ldx;
    __device__ __forceinline__ void operator()(const f32x4 (&acc)[2][2][4][2], const Unit& u, int wr, int wc, int fr, int fq) const {
        const int row0 = u.pm * BM + wr * 64 + fr, col0 = u.pn * BM + wc * 32 + 4 * fq;
#pragma unroll
        for (int ai = 0; ai < 2; ++ai)
#pragma unroll
            for (int m = 0; m < 4; ++m) { const int row = row0 + ai * HALF + m * 16;
                bool ok = true; if (row < 16896) { const int p = row % 8448; ok = p >= 48 && p < 8256; }
                if (ok) { float* rowp = X + (size_t)row * ldx + col0;
#pragma unroll
                    for (int bj = 0; bj < 2; ++bj)
#pragma unroll
                        for (int n = 0; n < 2; ++n) { f32x4* p4 = (f32x4*)(rowp + bj * HALF + n * 16); *p4 = *p4 + acc[ai][bj][m][n]; } } }
    }
};
struct EpiF32 {
    static constexpr bool PERM = false, AFTER_DRAIN = false;
    float* C; int ldc;
    __device__ __forceinline__ void operator()(const f32x4 (&acc)[2][2][4][2], const Unit& u, int wr, int wc, int fr, int fq) const {
        const int row0 = u.pm * BM + wr * 64 + fr, col0 = u.pn * BM + wc * 32 + 4 * fq;
#pragma unroll
        for (int ai = 0; ai < 2; ++ai)
#pragma unroll
            for (int m = 0; m < 4; ++m) { float* rowp = C + (size_t)(row0 + ai * HALF + m * 16) * ldc + col0;
#pragma unroll
                for (int bj = 0; bj < 2; ++bj)
#pragma unroll
                    for (int n = 0; n < 2; ++n) *(f32x4*)(rowp + bj * HALF + n * 16) = acc[ai][bj][m][n]; }
    }
};

template <class Epi, class Sched, bool ALIGN_EPI = false, bool SP2 = false>
__device__ __forceinline__ void gemm_phase(PG8_LAS unsigned char* lds, const Gemm g, const Sched& S, const Epi& E) {
    int tid_ = threadIdx.x; asm volatile("" : "+v"(tid_));
    const int tid = tid_, wid = __builtin_amdgcn_readfirstlane(tid >> 6), lane = tid & 63, wr = wid >> 2, wc = wid & 3, fr = lane & 15, fq = lane >> 4;
    const int K = g.K, nt = K / BK;
    unsigned voffA[2], voffB[2];
#pragma unroll
    for (int i = 0; i < 2; ++i) { int R, C; stage_rc(tid * 16 + i * 8192, R, C); const int Rb = Epi::PERM ? ((R & ~31) + perm32(R & 31)) : R;
        voffA[i] = (unsigned)(R * K + C) * 2u; voffB[i] = (unsigned)(Rb * K + C) * 2u; }
    const size_t kstep = (size_t)(BK * 2);
    const size_t hstep = (size_t)HALF * K * 2;
    const size_t tstep = 2 * hstep;
    const unsigned ldsw = (unsigned)wid * 1024u;
    const int aoff = lds_byte(wr * 64 + fr, fq * 8), boff = lds_byte(wc * 32 + fr, fq * 8);
#define PG8_SA(b, h) (((b) * 2 + (h)) * HTB)
#define PG8_SB(b, h) ((4 + (b) * 2 + (h)) * HTB)
#define PG8_STAGE(bufoff, gbase, voff) do { _Pragma("unroll") for (int _i = 0; _i < 2; ++_i) \
        __builtin_amdgcn_global_load_lds((const unsigned*)((const char*)(gbase) + (voff)[_i]), (PG8_LAS unsigned*)(lds + (bufoff) + ldsw + _i * 8192), 16, 0, 0); } while (0)
#define PG8_LDA(dst, b, h) do { _Pragma("unroll") for (int m = 0; m < 4; ++m) _Pragma("unroll") for (int k = 0; k < 2; ++k) dst[m][k] = *(const PG8_LAS bf16x8*)(lds + PG8_SA(b, h) + aoff + m * 2048 + k * 1024); } while (0)
#define PG8_LDB(dst, b, h) do { _Pragma("unroll") for (int n = 0; n < 2; ++n) _Pragma("unroll") for (int k = 0; k < 2; ++k) dst[n][k] = *(const PG8_LAS bf16x8*)(lds + PG8_SB(b, h) + boff + n * 2048 + k * 1024); } while (0)
#define PG8_MMA(ai, bj, At, Bt) do { __builtin_amdgcn_s_setprio(1); _Pragma("unroll") for (int m = 0; m < 4; ++m) _Pragma("unroll") for (int n = 0; n < 2; ++n) _Pragma("unroll") for (int k = 0; k < 2; ++k) \
        acc[ai][bj][m][n] = __builtin_amdgcn_mfma_f32_16x16x32_bf16(Bt[n][k], At[m][k], acc[ai][bj][m][n], 0, 0, 0); __builtin_amdgcn_s_setprio(0); } while (0)
#define PG8_WAIT_V(n) asm volatile("s_waitcnt vmcnt(" #n ")" ::: "memory")
#define PG8_WAIT_L(n) asm volatile("s_waitcnt lgkmcnt(" #n ")" ::: "memory")
#define PG8_BAR __builtin_amdgcn_s_barrier()
#define PG8_SCHED __builtin_amdgcn_sched_barrier(0)
    Unit cur, nxt; int ui = 0;
    if (!S.next(0, cur)) return;
    f32x4 acc[2][2][4][2];
#pragma unroll
    for (int a = 0; a < 2; ++a)
#pragma unroll
        for (int b = 0; b < 2; ++b)
#pragma unroll
            for (int m = 0; m < 4; ++m)
#pragma unroll
                for (int n = 0; n < 2; ++n) acc[a][b][m][n] = (f32x4){0.f, 0.f, 0.f, 0.f};
    bf16x8 At[4][2], B0[2][2], B1[2][2];
    const char* cA = (const char*)g.A + (size_t)cur.pm * tstep; const char* cB = (const char*)g.Bt + (size_t)cur.pn * tstep;
    S.a_ready(cur);
    if constexpr (SP2) {
        PG8_STAGE(PG8_SB(0, 0), cB, voffB); PG8_STAGE(PG8_SB(0, 1), cB + hstep, voffB); PG8_STAGE(PG8_SA(0, 0), cA, voffA); PG8_STAGE(PG8_SA(0, 1), cA + hstep, voffA);
        if (wr == 1) PG8_BAR;
        PG8_WAIT_V(2); PG8_BAR;
        PG8_STAGE(PG8_SB(1, 0), cB + kstep, voffB); PG8_STAGE(PG8_SA(1, 0), cA + kstep, voffA); PG8_STAGE(PG8_SB(1, 1), cB + hstep + kstep, voffB);
        PG8_WAIT_V(6); PG8_BAR;
    } else {
        PG8_STAGE(PG8_SB(0, 0), cB, voffB); PG8_STAGE(PG8_SA(0, 0), cA, voffA); PG8_STAGE(PG8_SB(0, 1), cB + hstep, voffB); PG8_STAGE(PG8_SA(0, 1), cA + hstep, voffA);
        if (wr == 1) PG8_BAR;
        PG8_WAIT_V(4); PG8_BAR;
        PG8_STAGE(PG8_SB(1, 0), cB + kstep, voffB); PG8_STAGE(PG8_SA(1, 0), cA + kstep, voffA); PG8_STAGE(PG8_SB(1, 1), cB + hstep + kstep, voffB);
        PG8_WAIT_V(6); PG8_BAR;
    }
    for (;;) {
        const bool has_next = S.next(ui + 1, nxt);
        const char* nA = has_next ? (const char*)g.A + (size_t)nxt.pm * tstep : cA; const char* nB = has_next ? (const char*)g.Bt + (size_t)nxt.pn * tstep : cB;
        for (int t = 0; t < nt; t += 2) {
            const bool last = (t == nt - 2);
            const char* a1 = cA + (size_t)(t + 1) * kstep;
            const char* a2 = last ? nA : cA + (size_t)(t + 2) * kstep; const char* b2 = last ? nB : cB + (size_t)(t + 2) * kstep;
            const char* a3 = a2 + kstep; const char* b3 = b2 + kstep;
            if (last && has_next) S.a_ready(nxt);
            if constexpr (SP2) {
            PG8_LDB(B0, 0, 0); PG8_LDB(B1, 0, 1); PG8_SCHED; PG8_LDA(At, 0, 0); PG8_STAGE(PG8_SA(1, 1), a1 + hstep, voffA);
            PG8_WAIT_V(8); PG8_WAIT_L(0); PG8_BAR; PG8_MMA(0, 0, At, B0); PG8_MMA(0, 1, At, B1); PG8_BAR; PG8_SCHED;
            PG8_LDA(At, 0, 1); PG8_STAGE(PG8_SB(0, 0), b2, voffB); PG8_STAGE(PG8_SB(0, 1), b2 + hstep, voffB); PG8_STAGE(PG8_SA(0, 0), a2, voffA);
            PG8_WAIT_V(8); PG8_WAIT_L(0); PG8_BAR; PG8_MMA(1, 0, At, B0); PG8_MMA(1, 1, At, B1); PG8_BAR; PG8_SCHED;
            PG8_LDB(B0, 1, 0); PG8_LDB(B1, 1, 1); PG8_SCHED; PG8_LDA(At, 1, 0); PG8_STAGE(PG8_SA(0, 1), a2 + hstep, voffA);
            PG8_WAIT_V(8); PG8_WAIT_L(0); PG8_BAR; PG8_MMA(0, 0, At, B0); PG8_MMA(0, 1, At, B1); PG8_BAR; PG8_SCHED;
            PG8_LDA(At, 1, 1); PG8_STAGE(PG8_SB(1, 0), b3, voffB); PG8_STAGE(PG8_SB(1, 1), b3 + hstep, voffB); PG8_STAGE(PG8_SA(1, 0), a3, voffA);
            PG8_WAIT_V(8); PG8_WAIT_L(0); PG8_BAR; PG8_MMA(1, 0, At, B0); PG8_MMA(1, 1, At, B1); PG8_BAR; PG8_SCHED;
            } else {
            PG8_LDB(B0, 0, 0); PG8_SCHED; PG8_LDA(At, 0, 0); PG8_STAGE(PG8_SA(1, 1), a1 + hstep, voffA);
            PG8_WAIT_L(8); PG8_BAR; PG8_WAIT_L(0); PG8_MMA(0, 0, At, B0); PG8_BAR; PG8_SCHED;
            PG8_LDB(B1, 0, 1); PG8_STAGE(PG8_SB(0, 0), b2, voffB);
            PG8_BAR; PG8_WAIT_L(0); PG8_MMA(0, 1, At, B1); PG8_BAR;
            PG8_LDA(At, 0, 1); PG8_STAGE(PG8_SA(0, 0), a2, voffA);
            PG8_BAR; PG8_WAIT_L(0); PG8_MMA(1, 0, At, B0); PG8_BAR; PG8_SCHED;
            PG8_STAGE(PG8_SB(0, 1), b2 + hstep, voffB);
            PG8_WAIT_V(6); PG8_BAR; PG8_MMA(1, 1, At, B1); PG8_BAR;
            PG8_LDB(B0, 1, 0); PG8_SCHED; PG8_LDA(At, 1, 0); PG8_STAGE(PG8_SA(0, 1), a2 + hstep, voffA);
            PG8_WAIT_L(8); PG8_BAR; PG8_WAIT_L(0); PG8_MMA(0, 0, At, B0); PG8_BAR; PG8_SCHED;
            PG8_LDB(B1, 1, 1); PG8_STAGE(PG8_SB(1, 0), b3, voffB);
            PG8_BAR; PG8_WAIT_L(0); PG8_MMA(0, 1, At, B1); PG8_BAR;
            PG8_LDA(At, 1, 1); PG8_STAGE(PG8_SA(1, 0), a3, voffA);
            PG8_BAR; PG8_WAIT_L(0); PG8_MMA(1, 0, At, B0); PG8_BAR; PG8_SCHED;
            PG8_STAGE(PG8_SB(1, 1), b3 + hstep, voffB);
            PG8_WAIT_V(6); PG8_BAR; PG8_MMA(1, 1, At, B1); PG8_BAR;
            }
        }
        if constexpr (ALIGN_EPI) { if (wr == 0) PG8_BAR; }
        if constexpr (!Epi::AFTER_DRAIN) { E(acc, cur, wr, wc, fr, fq); S.done(cur); }
        if (!has_next) break;
#pragma unroll
        for (int a = 0; a < 2; ++a)
#pragma unroll
            for (int b = 0; b < 2; ++b)
#pragma unroll
                for (int m = 0; m < 4; ++m)
#pragma unroll
                    for (int n = 0; n < 2; ++n) acc[a][b][m][n] = (f32x4){0.f, 0.f, 0.f, 0.f};
        cur = nxt; cA = nA; cB = nB; ++ui;
        if constexpr (ALIGN_EPI) { if (wr == 1) PG8_BAR; }
    }
    PG8_WAIT_V(0);
    if constexpr (!ALIGN_EPI) { if (wr == 0) PG8_BAR; }
    PG8_BAR;
    if constexpr (Epi::AFTER_DRAIN) { E.fused(acc, cur, wr, wc, fr, fq, lds, wid, lane); S.done(cur); }
#undef PG8_SA
#undef PG8_SB
#undef PG8_STAGE
#undef PG8_LDA
#undef PG8_LDB
#undef PG8_MMA
#undef PG8_WAIT_V
#undef PG8_WAIT_L
#undef PG8_BAR
#undef PG8_SCHED
}
}
#include <hip/hip_bf16.h>
#include <cmath>
namespace attn_body {
using bf16=__hip_bfloat16;
using bf16x8=__attribute__((ext_vector_type(8)))short;
using s16x4=__attribute__((ext_vector_type(4)))short;
using f32x16=__attribute__((ext_vector_type(16)))float;
using u32x4=__attribute__((ext_vector_type(4)))unsigned;
constexpr int ASEQ=8448,D=64;
constexpr int QP=512,KP=512,VP=7424,OP=1024;
constexpr int NW=8,QBLK=32,QB=QBLK*NW,KVBLK=64,NQB=ASEQ/QB;
constexpr int ATTN_UNIT_ROWS=QB;
__device__ __forceinline__ int crow(int r,int hi){return (r&3)+8*(r>>2)+4*hi;}
#define SBAR() __builtin_amdgcn_sched_barrier(0)
constexpr int BT_OFF=383, BT_N=640;
__device__ __forceinline__ void bmask(f32x16&p0,f32x16&p1,int t,int q0,int wid,int r32,int hi,const __attribute__((address_space(3))) float*tab){
  const float NEG=-INFINITY; const int qw=q0+32*wid;
  if(t>(qw>>6)){
    #pragma unroll
    for(int r=0;r<16;++r){p0[r]=NEG;p1[r]=NEG;} return; }
  if(t>0 && 64*t+63+91<=qw) return;
  const int q=qw+r32, kb=64*t+4*hi;
  #pragma unroll
  for(int r=0;r<16;++r){ const int kv=kb+(r&3)+8*(r>>2); int i0=kv-q+BT_OFF, i1=i0+32; i0=i0<0?0:i0; i1=i1<0?0:i1;
    p0[r]+=tab[i0]; p1[r]+=tab[i1]; if(kv<48)p0[r]=NEG; if(kv+32<48)p1[r]=NEG; }
}

constexpr int NSLOT=3, SLOTB=8192;
constexpr int LDS_K=0, LDS_V=NSLOT*SLOTB, LDS_WS=2*NSLOT*SLOTB, LDS_OST=LDS_WS+NW*64*4, LDS_BT=LDS_OST+NW*4096, LDS_BYTES=LDS_BT+BT_N*4;
constexpr float C2=0.125f*1.4426950408889634f;
__device__ __forceinline__ void glds16(const void*gsrc,unsigned lds_dst){unsigned keep;
  asm volatile("s_mov_b32 %0, m0\n\ts_mov_b32 m0, %2\n\ts_nop 0\n\tglobal_load_lds_dwordx4 %1, off\n\ts_mov_b32 m0, %0":"=&s"(keep):"v"(gsrc),"s"(lds_dst):"memory");}
__device__ __forceinline__ float max3f(float a,float b,float c){float r;asm("v_max3_f32 %0, %1, %2, %3":"=v"(r):"v"(a),"v"(b),"v"(c));return r;}
__device__ __forceinline__ float max2f(float a,float b){float r;asm("v_max_f32_e32 %0, %1, %2":"=v"(r):"v"(a),"v"(b));return r;}
__device__ __forceinline__ float fadd_s(float a,float b){float r;asm("v_add_f32_e32 %0, %1, %2":"=v"(r):"v"(a),"v"(b));return r;}
__device__ __forceinline__ float fsub_s(float a,float b){float r;asm("v_sub_f32_e32 %0, %1, %2":"=v"(r):"v"(a),"v"(b));return r;}
typedef float f32x2_t __attribute__((ext_vector_type(2))); typedef __bf16 bf16x2_t __attribute__((ext_vector_type(2)));
__device__ __forceinline__ unsigned cvtpk_s(float lo,float hi){f32x2_t v={lo,hi};bf16x2_t b=__builtin_convertvector(v,bf16x2_t);return __builtin_bit_cast(unsigned,b);}
#define WAIT_BAR(N) asm volatile("s_waitcnt vmcnt(" #N ") lgkmcnt(0)\n\ts_barrier":::"memory")

__device__ __forceinline__ void qkt(f32x16&p0,f32x16&p1,const char*Kslot,const bf16x8*qr,const f32x16&negm,int r32,int hi){
  const char*kb=Kslot+hi*1024+r32*16;
  #pragma unroll
  for(int d0=0;d0<4;++d0){
    const bf16x8 b0=*reinterpret_cast<const bf16x8*>(kb+d0*2048);
    const bf16x8 b1=*reinterpret_cast<const bf16x8*>(kb+d0*2048+512);
    if(d0==0){p0=__builtin_amdgcn_mfma_f32_32x32x16_bf16(b0,qr[0],negm,0,0,0);p1=__builtin_amdgcn_mfma_f32_32x32x16_bf16(b1,qr[0],negm,0,0,0);}
    else{p0=__builtin_amdgcn_mfma_f32_32x32x16_bf16(b0,qr[d0],p0,0,0,0);p1=__builtin_amdgcn_mfma_f32_32x32x16_bf16(b1,qr[d0],p1,0,0,0);}}
}
typedef __attribute__((address_space(3))) const char* lds_cptr;
typedef __attribute__((address_space(3))) const float* lds_cfptr;
typedef short v4i16_t __attribute__((ext_vector_type(4)));
__device__ __forceinline__ void kload8(bf16x8*kf,lds_cptr kp){
  kf[0]=*(const __attribute__((address_space(3))) bf16x8*)(kp);      kf[1]=*(const __attribute__((address_space(3))) bf16x8*)(kp+512);
  kf[2]=*(const __attribute__((address_space(3))) bf16x8*)(kp+2048); kf[3]=*(const __attribute__((address_space(3))) bf16x8*)(kp+2560);
  kf[4]=*(const __attribute__((address_space(3))) bf16x8*)(kp+4096); kf[5]=*(const __attribute__((address_space(3))) bf16x8*)(kp+4608);
  kf[6]=*(const __attribute__((address_space(3))) bf16x8*)(kp+6144); kf[7]=*(const __attribute__((address_space(3))) bf16x8*)(kp+6656);
}
__device__ __forceinline__ void kload2(bf16x8*kf,lds_cptr kp,int j){ kf[2*j]=*(const __attribute__((address_space(3))) bf16x8*)(kp+j*2048); kf[2*j+1]=*(const __attribute__((address_space(3))) bf16x8*)(kp+j*2048+512); }
__device__ __forceinline__ s16x4 vtr(lds_cptr p){ return __builtin_bit_cast(s16x4,__builtin_amdgcn_ds_read_tr16_b64_v4i16((__attribute__((address_space(3))) v4i16_t*)p)); }
__device__ __forceinline__ float rowmax(const f32x16&p0,const f32x16&p1){
  float a=max3f(p0[0],p0[1],p1[0]),b=max3f(p0[2],p0[3],p1[1]);a=max3f(a,p1[2],p1[3]);
  #pragma unroll
  for(int r=4;r<16;r+=4){a=max3f(a,p0[r],p0[r+1]);b=max3f(b,p0[r+2],p0[r+3]);a=max3f(a,p1[r],p1[r+1]);b=max3f(b,p1[r+2],p1[r+3]);}
  const float m=max2f(a,b);
  auto rr=__builtin_amdgcn_permlane32_swap(__float_as_uint(m),__float_as_uint(m),false,false);
  return max2f(__uint_as_float(rr[0]),__uint_as_float(rr[1]));
}
__device__ __forceinline__ void pv(f32x16*o,int vb,bf16x8 pa0,bf16x8 pa1,bf16x8 pa2,bf16x8 pa3){
  #pragma unroll
  for(int d0=0;d0<2;++d0){s16x4 lo[4],hi[4];
    #pragma unroll
    for(int ks=0;ks<4;++ks){
      asm volatile("ds_read_b64_tr_b16 %0,%1 offset:%c2":"=&v"(lo[ks]):"v"(vb),"i"(d0*4096+ks*1024):"memory");
      asm volatile("ds_read_b64_tr_b16 %0,%1 offset:%c2":"=&v"(hi[ks]):"v"(vb),"i"(d0*4096+ks*1024+512):"memory");}
    asm volatile("s_waitcnt lgkmcnt(0)":::"memory");SBAR();
    #define PK(k) (bf16x8){lo[k][0],lo[k][1],lo[k][2],lo[k][3],hi[k][0],hi[k][1],hi[k][2],hi[k][3]}
    o[d0]=__builtin_amdgcn_mfma_f32_32x32x16_bf16(pa0,PK(0),o[d0],0,0,0);
    o[d0]=__builtin_amdgcn_mfma_f32_32x32x16_bf16(pa1,PK(1),o[d0],0,0,0);
    o[d0]=__builtin_amdgcn_mfma_f32_32x32x16_bf16(pa2,PK(2),o[d0],0,0,0);
    o[d0]=__builtin_amdgcn_mfma_f32_32x32x16_bf16(pa3,PK(3),o[d0],0,0,0);
    #undef PK
  }
}

#ifndef ATTN_STORE16
#define ATTN_STORE16(p,v) (*(u32x4*)(p)=(v))
#endif
template<int THRL> __device__ __forceinline__ void attn_unit(int b,int qoff,int voff,int ooff,int qb,const bf16*Q,const bf16*__restrict__ K,const bf16*__restrict__ V,bf16*O,char*shm){
  int tid_=threadIdx.x; asm volatile("":"+v"(tid_)); const int tid=tid_,lane=tid&63,r32=lane&31,hi=lane>>5; const int wid=__builtin_amdgcn_readfirstlane(tid>>6);
  const long rowbase=(long)b*ASEQ; const int q0=qb*QB;
  const bf16*Qw=Q+(rowbase+q0+wid*QBLK)*QP+qoff;
  const bf16*Kh=K+rowbase*KP+qoff,*Vh=V+rowbase*VP+voff;
  const unsigned lds0=(unsigned)(uintptr_t)shm;
  float*wsf=(float*)(shm+LDS_WS)+wid*64;
  const bf16*ksrc=Kh+(long)lane*KP+wid*8;
  const bf16*vsrc=Vh+(long)(16*(wid&3)+(lane>>2))*VP+(wid>>2)*32+(lane&3)*8;
  const unsigned kdst=lds0+LDS_K+wid*1024, vdst=lds0+LDS_V+wid*1024;
  #define DMA_K(t,slot) glds16(ksrc+(long)(t)*KVBLK*KP,(unsigned)__builtin_amdgcn_readfirstlane(kdst+(slot)))
  #define DMA_V(t,slot) glds16(vsrc+(long)(t)*KVBLK*VP,(unsigned)__builtin_amdgcn_readfirstlane(vdst+(slot)))
  const int vb0=(int)(lds0+LDS_V)+((lane>>4)&1)*32+(lane&3)*8+(4*hi+((lane&15)>>2))*64;
  const char*Kbase=shm+LDS_K; bf16x8 kf[8];
  const lds_cptr shm3=(lds_cptr)shm; const lds_cfptr btab=(lds_cfptr)(shm3+LDS_BT); const lds_cptr kp0=shm3+LDS_K+hi*1024+r32*16; const lds_cptr vp0=shm3+LDS_V+((lane>>4)&1)*32+(lane&3)*8+(4*hi+((lane&15)>>2))*64;
  const int NTL=(q0+QB)/KVBLK;
  DMA_K(0,0);DMA_V(0,0);DMA_K(1,SLOTB);
  bf16x8 qr[4];
  #pragma unroll
  for(int d0=0;d0<4;++d0)qr[d0]=*reinterpret_cast<const bf16x8*>(&Qw[(long)r32*QP+d0*16+hi*8]);
  float mhat=0.f,l_reg=0.f;f32x16 o[2];o[0]=f32x16{};o[1]=f32x16{};const f32x16 zt=f32x16{};
  const int qrel=wid*QBLK+r32;
  #define CMASK(P0,P1,t) bmask(P0,P1,(t),q0,wid,r32,hi,btab)
  bool resc=false;
  #define START(P0,P1) do{ const float rm=rowmax(P0,P1); resc=false; \
    { const float dl=rm; mhat=fadd_s(mhat,dl); \
      _Pragma("unroll") for(int r=0;r<16;++r){P0[r]=fsub_s(P0[r],dl);P1[r]=fsub_s(P1[r],dl);} \
      } \
    _Pragma("unroll") for(int r=0;r<16;++r)P0[r]=__builtin_amdgcn_exp2f(P0[r]); }while(0)
  #define RESC() do{ if(resc){ asm volatile("s_waitcnt lgkmcnt(0)":::"memory"); \
      _Pragma("unroll") for(int d_=0;d_<2;++d_) _Pragma("unroll") for(int r=0;r<16;++r)o[d_][r]*=wsf[crow(r,hi)]; } }while(0)
  f32x16 pA0,pA1,pB0,pB1;
  int sl_prev=0,sl_cur=0,sl_next=SLOTB;
  #define ROT() do{sl_prev=sl_cur;sl_cur=sl_next;sl_next=(sl_next==(NSLOT-1)*SLOTB)?0:sl_next+SLOTB;}while(0)
  DMA_K(2,2*SLOTB);
  WAIT_BAR(3);
  qkt(pA0,pA1,Kbase,qr,zt,r32,hi);asm volatile("s_nop 15\n\ts_nop 7":"+v"(pA0),"+v"(pA1));CMASK(pA0,pA1,0);
  START(pA0,pA1);
  _Pragma("unroll") for(int r=0;r<16;++r)pA1[r]=__builtin_amdgcn_exp2f(pA1[r]);
  WAIT_BAR(0);
  DMA_K(3,0);DMA_V(1,SLOTB);
  ROT();
  kload8(kf,kp0+sl_cur);
  WAIT_BAR(2);
  s16x4 vlo[8],vhi[8]; u32x4 pw0,pw1,pw2,pw3;
  #define PKW(P,B) cvtpk_s(P[B],P[B+1])
  #define PAF(k) __builtin_bit_cast(bf16x8,pw##k)
  #define VFR(i) (bf16x8){vlo[i][0],vlo[i][1],vlo[i][2],vlo[i][3],vhi[i][0],vhi[i][1],vhi[i][2],vhi[i][3]}
  #define PIN(x) asm volatile("":"+v"(x))
  #define MX3(a,b,c) __builtin_fmaxf(__builtin_fmaxf((a),(b)),(c))
  #define GAPA(MF,A0,A1,A2,A3,W0,W1,PW) do{ MF; sacc+=A0; sacc+=A1; sacc+=A2; sacc+=A3; PIN(sacc); W0; W1; PIN(PW); SBAR(); }while(0)
  #define EX(v) __builtin_amdgcn_exp2f(v)
  #define GAPB(MF,X,B) do{ MF; X[B]=EX(X[B]); X[B+1]=EX(X[B+1]); X[B+2]=EX(X[B+2]); X[B+3]=EX(X[B+3]); PIN(X); SBAR(); }while(0)
  #define VRD(i) do{ vlo[i]=vtr(vp_+(((i)>>2)*4096+((i)&3)*1024)); vhi[i]=vtr(vp_+(((i)>>2)*4096+((i)&3)*1024+512)); }while(0)
  #define KRD(G,j) do{ if(G){ kload2(kf,kp0+sl_next,j); SBAR(); } }while(0)
  #define STEP(C0,C1,P0,P1,t,GK,GV,GL) do{ SBAR(); \
    const lds_cptr vp_=vp0+sl_prev; \
    VRD(0); SBAR(); float sacc=(P0[0]+P0[1]); \
    GAPA(C0=__builtin_amdgcn_mfma_f32_32x32x16_bf16(kf[0],qr[0],zt,0,0,0), P0[2],P0[3],P0[4],P0[5],     pw0[0]=PKW(P0,0), pw0[1]=PKW(P0,2), pw0); \
    VRD(4); SBAR(); GAPA(C1=__builtin_amdgcn_mfma_f32_32x32x16_bf16(kf[1],qr[0],zt,0,0,0), P0[6],P0[7],P0[8],P0[9],     pw0[2]=PKW(P0,4), pw0[3]=PKW(P0,6), pw0); \
    VRD(1); SBAR(); GAPA(C0=__builtin_amdgcn_mfma_f32_32x32x16_bf16(kf[2],qr[1],C0,0,0,0),   P0[10],P0[11],P0[12],P0[13], pw1[0]=PKW(P0,8), pw1[1]=PKW(P0,10), pw1); \
    VRD(5); SBAR(); GAPA(C1=__builtin_amdgcn_mfma_f32_32x32x16_bf16(kf[3],qr[1],C1,0,0,0),   P0[14],P0[15],P1[0],P1[1],   pw1[2]=PKW(P0,12),pw1[3]=PKW(P0,14), pw1); \
    VRD(2); SBAR(); GAPA(C0=__builtin_amdgcn_mfma_f32_32x32x16_bf16(kf[4],qr[2],C0,0,0,0),   P1[2],P1[3],P1[4],P1[5],     pw2[0]=PKW(P1,0), pw2[1]=PKW(P1,2), pw2); \
    VRD(6); SBAR(); GAPA(C1=__builtin_amdgcn_mfma_f32_32x32x16_bf16(kf[5],qr[2],C1,0,0,0),   P1[6],P1[7],P1[8],P1[9],     pw2[2]=PKW(P1,4), pw2[3]=PKW(P1,6), pw2); \
    VRD(3); SBAR(); GAPA(C0=__builtin_amdgcn_mfma_f32_32x32x16_bf16(kf[6],qr[3],C0,0,0,0),   P1[10],P1[11],P1[12],P1[13], pw3[0]=PKW(P1,8), pw3[1]=PKW(P1,10), pw3); \
    VRD(7); SBAR(); GAPA(C1=__builtin_amdgcn_mfma_f32_32x32x16_bf16(kf[7],qr[3],C1,0,0,0),   P1[14],P1[15],0.f,0.f,       pw3[2]=PKW(P1,12),pw3[3]=PKW(P1,14), pw3); \
    l_reg+=sacc; \
    if(GK){DMA_K((t)+3,sl_cur);} if(GV){DMA_V((t)+1,sl_next);} \
    _Pragma("unroll") for(int r=0;r<16;++r){C0[r]-=mhat;C1[r]-=mhat;} \
    CMASK(C0,C1,t); \
    { float a=MX3(C0[0],C0[1],C1[0]),b=MX3(C0[2],C0[3],C1[1]); a=MX3(a,C1[2],C1[3]); \
      _Pragma("unroll") for(int r=4;r<16;r+=4){a=MX3(a,C0[r],C0[r+1]);b=MX3(b,C0[r+2],C0[r+3]);a=MX3(a,C1[r],C1[r+1]);b=MX3(b,C1[r+2],C1[r+3]);} \
      float rm=__builtin_fmaxf(a,b); { auto rr=__builtin_amdgcn_permlane32_swap(__float_as_uint(rm),__float_as_uint(rm),false,false); rm=__builtin_fmaxf(__uint_as_float(rr[0]),__uint_as_float(rr[1])); } \
      resc=false; \
      if(__builtin_expect(__any(rm>(float)THRL),0)){ const float dl=__builtin_fmaxf(rm,0.f); mhat+=dl; \
        _Pragma("unroll") for(int r=0;r<16;++r){C0[r]-=dl;C1[r]-=dl;} \
        const float f=__builtin_amdgcn_exp2f(-dl); l_reg*=f; if(hi==0)wsf[r32]=f; resc=true; } } \
    SBAR(); \
    GAPB(o[0]=__builtin_amdgcn_mfma_f32_32x32x16_bf16(PAF(0),VFR(0),o[0],0,0,0), C0,0); \
    GAPB(o[1]=__builtin_amdgcn_mfma_f32_32x32x16_bf16(PAF(0),VFR(4),o[1],0,0,0), C0,4); \
    KRD(GL,0); GAPB(o[0]=__builtin_amdgcn_mfma_f32_32x32x16_bf16(PAF(1),VFR(1),o[0],0,0,0), C0,8); \
    KRD(GL,1); GAPB(o[1]=__builtin_amdgcn_mfma_f32_32x32x16_bf16(PAF(1),VFR(5),o[1],0,0,0), C0,12); \
    KRD(GL,2); GAPB(o[0]=__builtin_amdgcn_mfma_f32_32x32x16_bf16(PAF(2),VFR(2),o[0],0,0,0), C1,0); \
    KRD(GL,3); GAPB(o[1]=__builtin_amdgcn_mfma_f32_32x32x16_bf16(PAF(2),VFR(6),o[1],0,0,0), C1,4); \
    GAPB(o[0]=__builtin_amdgcn_mfma_f32_32x32x16_bf16(PAF(3),VFR(3),o[0],0,0,0), C1,8); \
    GAPB(o[1]=__builtin_amdgcn_mfma_f32_32x32x16_bf16(PAF(3),VFR(7),o[1],0,0,0), C1,12); \
    }while(0)
  int t=1;
  #undef CMASK
  #define CMASK(P0,P1,t) do{}while(0)
  for(;t+7<NTL;t+=2){
    STEP(pB0,pB1,pA0,pA1,t,true,true,true);     WAIT_BAR(2); RESC(); ROT();
    STEP(pA0,pA1,pB0,pB1,t+1,true,true,true);   WAIT_BAR(2); RESC(); ROT();
  }
  #undef CMASK
  #define CMASK(P0,P1,t) bmask(P0,P1,(t),q0,wid,r32,hi,btab)
  #define ENDW(tt) do{ if((tt)+3<NTL){WAIT_BAR(2);} else if((tt)+2<NTL){WAIT_BAR(1);} else {WAIT_BAR(0);} }while(0)
  for(;t+1<NTL;t+=2){
    STEP(pB0,pB1,pA0,pA1,t,(t+3<NTL),(t+1<NTL),(t+1<NTL));       ENDW(t);   RESC(); ROT();
    STEP(pA0,pA1,pB0,pB1,t+1,(t+4<NTL),(t+2<NTL),(t+2<NTL));     ENDW(t+1); RESC(); ROT();
  }
  STEP(pB0,pB1,pA0,pA1,NTL-1,false,false,false); RESC();
  { float sacc=pB0[0]+pB0[1]; _Pragma("unroll") for(int r=2;r<16;++r)sacc+=pB0[r]; _Pragma("unroll") for(int r=0;r<16;++r)sacc+=pB1[r]; l_reg+=sacc;
    pw0=(u32x4){PKW(pB0,0),PKW(pB0,2),PKW(pB0,4),PKW(pB0,6)};pw1=(u32x4){PKW(pB0,8),PKW(pB0,10),PKW(pB0,12),PKW(pB0,14)};pw2=(u32x4){PKW(pB1,0),PKW(pB1,2),PKW(pB1,4),PKW(pB1,6)};pw3=(u32x4){PKW(pB1,8),PKW(pB1,10),PKW(pB1,12),PKW(pB1,14)};
    SBAR(); pv(o,vb0+sl_cur,PAF(0),PAF(1),PAF(2),PAF(3)); }
  #undef PKW
  #undef PAF
  #undef VFR
  #undef PIN
  #undef MX3
  #undef GAPA
  #undef GAPB
  #undef EX
  #undef VRD
  #undef KRD
  #undef STEP
  #undef ENDW
  {auto rr=__builtin_amdgcn_permlane32_swap(__float_as_uint(l_reg),__float_as_uint(l_reg),false,false);l_reg=__uint_as_float(rr[0])+__uint_as_float(rr[1]);}
  if(hi==0)wsf[32+r32]=l_reg;asm volatile("s_waitcnt lgkmcnt(0)":::"memory");
  float rli[16];
  #pragma unroll
  for(int r=0;r<16;++r)rli[r]=__builtin_amdgcn_rcpf(wsf[32+crow(r,hi)]);
  bf16*Ow=O+(rowbase+q0+wid*QBLK)*OP+ooff;
  { bf16*stg=(bf16*)(shm+LDS_OST)+wid*2048;
    #pragma unroll
    for(int r=0;r<16;++r){const int orow=crow(r,hi);
      #pragma unroll
      for(int d0=0;d0<2;++d0)stg[orow*64+d0*32+r32]=__float2bfloat16(o[d0][r]*rli[r]);}
    asm volatile("s_waitcnt lgkmcnt(0)":::"memory");
    #pragma unroll
    for(int i=0;i<4;++i){const int row=i*8+(lane>>3),ch=lane&7; const u32x4 v=*(const u32x4*)(stg+row*64+ch*8); ATTN_STORE16(Ow+(long)row*OP+ch*8,v);} }
  asm volatile("s_waitcnt lgkmcnt(0)\n\ts_barrier":::"memory");
  #undef DMA_K
  #undef DMA_V
  #undef CMASK
  #undef START
  #undef RESC
  #undef ROT
}
constexpr int ATTN_LDS_BYTES=LDS_BYTES;
#undef SBAR
#undef WAIT_BAR
#undef WAIT_BAR
}
namespace mk {
#define GAS __attribute__((address_space(1)))
#define LAS __attribute__((address_space(3)))
typedef unsigned short bf16;
typedef unsigned v4u __attribute__((ext_vector_type(4)));
typedef unsigned v2u __attribute__((ext_vector_type(2)));
typedef float f32x4 __attribute__((ext_vector_type(4)));
typedef float f32x16 __attribute__((ext_vector_type(16)));
typedef short bf16x8 __attribute__((ext_vector_type(8)));
typedef GAS unsigned gu32;
#define RLX_AGENT __ATOMIC_RELAXED, __HIP_MEMORY_SCOPE_AGENT
#define LDS_WAIT() asm volatile("s_waitcnt lgkmcnt(0)" ::: "memory")
#define VM_WAIT() asm volatile("s_waitcnt vmcnt(0)" ::: "memory")
__device__ __forceinline__ unsigned f2bf(float f) { unsigned u = __builtin_bit_cast(unsigned, f); return (u + 0x7fffu + ((u >> 16) & 1u)) >> 16; }
__device__ __forceinline__ unsigned pk2(float lo, float hi) { return f2bf(lo) | (f2bf(hi) << 16); }
__device__ __forceinline__ float bf2f(unsigned short b) { return __builtin_bit_cast(float, ((unsigned)b) << 16); }
__device__ __forceinline__ float bflo(unsigned w) { return __builtin_bit_cast(float, w << 16); }
__device__ __forceinline__ float bfhi(unsigned w) { return __builtin_bit_cast(float, w & 0xffff0000u); }

constexpr int NWAVES = 8, NTHR = NWAVES * 64;
constexpr int PADF = 48;
constexpr int LPP = 8448;
constexpr int PEND = PADF + LP;
constexpr int SROW0 = BATCH * LPP;
constexpr int RP = SROW0 + NS;
constexpr int ZN = 7424;
constexpr int ZC_QA = 0, ZC_KA = 512, ZC_VA = 1024, ZC_QKVB = 1536, ZC_GB = 3072, ZC_UC = 3584, ZC_GATE = 4096, ZC_BA = 7168;
static_assert(RP % 256 == 0 && ZN % 256 == 0 && D_MODEL == 1024 && WIDTH_A == 512 && WIDTH_B == 512 && WIDTH_C == 512, "shapes");
__host__ __device__ __forceinline__ int nat2prow(int row) { return row < NP ? (row / LP) * LPP + PADF + row % LP : SROW0 + (row - NP); }
__host__ __device__ __forceinline__ int zcol(int col) { return col < 3584 ? col : (col < 3592 ? ZC_BA + (col - 3584) : col - 8); }
__device__ __forceinline__ bool prow_valid(int prow) { if (prow >= SROW0) return true; const int p = prow % LPP; return p >= PADF && p < PEND; }
__device__ __forceinline__ int prow2nat(int prow) { if (prow >= SROW0) return NP + (prow - SROW0); return (prow / LPP) * LP + (prow % LPP) - PADF; }

constexpr int RING_OFF = 0, RING_BYTES = 131072;
constexpr int LDSCTL_OFF = RING_BYTES, MISC_OFF = LDSCTL_OFF + 320;
constexpr int LDS_BYTES = 147456;
static_assert(MISC_OFF + 128 <= LDS_BYTES, "LDS map");

constexpr size_t CTL_BYTES = 1u << 20;
constexpr int CW_TMO = 0, CW_CODE = 1;
constexpr int CW_BAR = 4096;
constexpr int CW_QUEUE = 16384;

#define XB_TMO      128
#define XB_XCNT(j)  (256  + 64 * (j))
#define XB_XSUB(j)  (1280 + 64 * (j))
#define XB_XGEN(j)  (2304 + 64 * (j))
#define XB_TOP      3328
#define XB_TOPGEN   3392
#define XCD_BAR_WORDS 3456
#define XB_SPIN_CAP (1u << 18)

__device__ __forceinline__ unsigned xb_ld(unsigned* p)              { return __hip_atomic_load(p, __ATOMIC_RELAXED, __HIP_MEMORY_SCOPE_AGENT); }
__device__ __forceinline__ unsigned xb_add(unsigned* p, unsigned v) { return __hip_atomic_fetch_add(p, v, __ATOMIC_RELAXED, __HIP_MEMORY_SCOPE_AGENT); }
__device__ __forceinline__ unsigned xb_xcc_id() { return (unsigned)__builtin_amdgcn_s_getreg((3 << 11) | 20) & 0xFu; }
#define XB_SPIN(cond, bar) do { unsigned _sp = 0; while (cond) { __builtin_amdgcn_s_sleep(1); \
    if ((++_sp & 255u) == 0u) { if (xb_ld(&(bar)[XB_TMO])) break; if (_sp > XB_SPIN_CAP) { atomicAdd(&(bar)[XB_TMO], 1u); break; } } } } while (0)

struct XcdBarrier {
    unsigned* bar; unsigned x;
    volatile LAS unsigned* st;
};

__device__ __forceinline__ XcdBarrier xcd_barrier_post(unsigned* bar, volatile LAS unsigned* st) {
    XcdBarrier b; b.bar = bar; b.x = xb_xcc_id(); b.st = st;
    if (threadIdx.x == 0) (void)xb_add(&bar[XB_XCNT(b.x)], 1u);
    return b;
}
__device__ __forceinline__ void xcd_barrier_complete(unsigned* bar, unsigned x, unsigned& nloc, unsigned& nx) {
    const unsigned G = gridDim.x * gridDim.y * gridDim.z;
    unsigned sum, cnt, mine, sp = 0u;
    for (;;) {
        sum = 0u; cnt = 0u; mine = 0u;
#pragma unroll
        for (unsigned j = 0; j < 16; ++j) { const unsigned c = xb_ld(&bar[XB_XCNT(j)]); sum += c; cnt += (c > 0u) ? 1u : 0u; mine = (j == x) ? c : mine; }
        if (sum == G) break;
        __builtin_amdgcn_s_sleep(1);
        if ((++sp & 255u) == 0u) { if (xb_ld(&bar[XB_TMO])) break; if (sp > XB_SPIN_CAP) { atomicAdd(&bar[XB_TMO], 1u); break; } }
    }
    nloc = mine > 0u ? mine : 1u; nx = cnt > 0u ? cnt : 1u;
}

__device__ __forceinline__ void xcd_barrier(const XcdBarrier& b) {
    asm volatile("s_waitcnt vmcnt(0)" ::: "memory");
    __syncthreads();
    if (threadIdx.x == 0) {
        unsigned* bar = b.bar;
        __builtin_amdgcn_s_waitcnt(0);
        unsigned nloc = b.st[0], nx = b.st[1];
        if (nloc == 0u) { xcd_barrier_complete(bar, b.x, nloc, nx); b.st[0] = nloc; b.st[1] = nx; }
        const unsigned old = xb_add(&bar[XB_XSUB(b.x)], 1u);
        const unsigned gen = old / nloc;
        if (old + 1u == (gen + 1u) * nloc) {
            __builtin_amdgcn_fence(__ATOMIC_RELEASE, "agent");
            asm volatile("s_waitcnt vmcnt(0)" ::: "memory");
            const unsigned og = xb_add(&bar[XB_TOP], 1u);
            const unsigned tg = og / nx;
            if (og + 1u == (tg + 1u) * nx) xb_add(&bar[XB_TOPGEN], 1u);
            else XB_SPIN(xb_ld(&bar[XB_TOPGEN]) == tg, bar);
            __builtin_amdgcn_fence(__ATOMIC_ACQUIRE, "agent");
            xb_add(&bar[XB_XGEN(b.x)], 1u);
            asm volatile("s_waitcnt vmcnt(0)" ::: "memory");
        } else {
            XB_SPIN(xb_ld(&bar[XB_XGEN(b.x)]) == gen, bar);
            __builtin_amdgcn_fence(__ATOMIC_ACQUIRE, "agent");
            asm volatile("s_waitcnt vmcnt(0)" ::: "memory");
        }
    }
    __syncthreads();
}


__device__ __forceinline__ float wave_sum(float v) {
#pragma unroll
    for (int o = 1; o < 64; o <<= 1) v += __shfl_xor(v, o);
    return v;
}
}
namespace mk {
enum Region { R_X, R_XN, R_WIN, R_Z, R_QN, R_KN, R_QKVB, R_BG, R_O, R_OA, R_OB, R_YC, R_OC, R_MRG, R_WGLU, R_WBR, R_WOUT, R_WQS, R_PU, R_PV, R_SC, R_GDN, R_S5T, R_MISC, R_S5E, R_S5X, R_MRGB, R_NREG };
constexpr int NPL = 16;
enum Phase { PH_PRO = 0, PL_NORM1 = 0, PL_GEMM_IN = 1, PL_ZPOST = 2, PL_LOCAL = 3, PL_MIX = 4, PL_MIXPOST = 5, PL_GEMM_GLU = 6, PL_GEMM_BRA = 7, PL_GEMM_BRB = 8, PL_GEMM_BRC = 9,
             PL_GEMM_OUT = 10, PL_NORM2 = 11, PL_GEMM_PEER = 12, PL_PEER = 13, PH_FINAL = 1 + DEPTH * NPL, PH_END = PH_FINAL + 1 };
enum ProMask { PM_X = 1, PM_WIN = 2, PM_WREST = 4, PM_PEERW = 8, PM_WQS = 16, PM_TABLES = 32 };
struct Args {
    const float* in[40];
    float* out;
    unsigned char* ws;
    unsigned long long off[32];
    int ph_lo, ph_hi, pro_mask, bar_region;
};
static_assert(sizeof(Args) == 40 * 8 + 8 + 8 + 32 * 8 + 16, "Args has no padding");

typedef const __attribute__((address_space(4))) Args* KArgs;
__device__ __forceinline__ KArgs kargs() { KArgs p = (KArgs)__builtin_amdgcn_kernarg_segment_ptr(); asm volatile("" : "+s"(p)); return p; }
#define WS_OPAQUE(a) unsigned char* wsb = (a).ws; asm volatile("" : "+s"(wsb))
__device__ __forceinline__ int otid() { int t = threadIdx.x; asm volatile("" : "+v"(t)); return t; }
struct Frame {
    LAS unsigned char* lds; volatile LAS unsigned* MISC; gu32* ctl;
    int vcu, G;
};

template <class CM> __device__ __forceinline__ void transpose_item(const float* W, int ld, int K, bf16* WT, int n0, int k0, const CM& cm, LAS float* scr, int lane) {
    const int sc = cm(n0 + (lane & 31));
#pragma unroll 8
    for (int i = 0; i < 32; ++i) { const int kk = 2 * i + (lane >> 5); scr[kk * 33 + (lane & 31)] = sc >= 0 ? W[(size_t)(k0 + kk) * ld + sc] : 0.f; }
    LDS_WAIT(); asm volatile("" ::: "memory");
    const int c = lane & 7;
#pragma unroll
    for (int j = 0; j < 4; ++j) { const int n = (lane >> 3) + 8 * j; const LAS float* s = scr + (8 * c) * 33 + n;
        v4u o; o.x = pk2(s[0 * 33], s[1 * 33]); o.y = pk2(s[2 * 33], s[3 * 33]); o.z = pk2(s[4 * 33], s[5 * 33]); o.w = pk2(s[6 * 33], s[7 * 33]);
        *(GAS v4u*)(WT + (size_t)(n0 + n) * K + k0 + 8 * c) = o; }
    LDS_WAIT(); asm volatile("" ::: "memory");
}
struct CmWin { __device__ __forceinline__ int operator()(int n) const { return n < 3584 ? n : (n < 7168 ? n + 8 : (n < 7176 ? 3584 + (n - 7168) : -1)); } };
struct CmId { __device__ __forceinline__ int operator()(int n) const { return n; } };
struct CmGlu { __device__ __forceinline__ int operator()(int n) const { const int G = n >> 5, i = n & 31; return i < 16 ? 16 * G + i : 512 + 16 * G + (i - 16); } };

__device__ __forceinline__ void rms_row_to_bf16(const float* xrow, const float* g, bf16* orow, int lane) {
    const GAS f32x4* xr = (const GAS f32x4*)xrow + lane;
    f32x4 v[4]; float s2 = 0.f;
#pragma unroll
    for (int j = 0; j < 4; ++j) { v[j] = xr[64 * j]; s2 += (v[j].x * v[j].x + v[j].y * v[j].y) + (v[j].z * v[j].z + v[j].w * v[j].w); }
    const float r = 1.f / sqrtf(wave_sum(s2) * (1.f / D_MODEL) + EPSF);
    const GAS f32x4* gr = (const GAS f32x4*)g + lane;
    GAS unsigned long long* o8 = (GAS unsigned long long*)orow + lane;
#pragma unroll
    for (int j = 0; j < 4; ++j) { const f32x4 gg = gr[64 * j];
        o8[64 * j] = (unsigned long long)pk2(v[j].x * r * gg.x, v[j].y * r * gg.y) | ((unsigned long long)pk2(v[j].z * r * gg.z, v[j].w * r * gg.w) << 32); }
}

__device__ __forceinline__ void p_norm(Frame& F, int l, int gi) {
    const KArgs ap = kargs(); const auto& a = *ap; WS_OPAQUE(a);
    const int tid = otid(), lane = tid & 63, wave = __builtin_amdgcn_readfirstlane(tid >> 6);
    const float* X = (const float*)(wsb + a.off[R_X]); bf16* XN = (bf16*)(wsb + a.off[R_XN]); const float* g = a.in[gi] + (size_t)l * D_MODEL;
    const int gw = F.vcu * NWAVES + wave, NGW = F.G * NWAVES;
    for (int m = gw; m < RP; m += NGW) rms_row_to_bf16(X + (size_t)m * D_MODEL, g, XN + (size_t)m * D_MODEL, lane);
}
__device__ __forceinline__ void unpack8(const v4u w, float (&f)[8]) { f[0] = bflo(w.x); f[1] = bfhi(w.x); f[2] = bflo(w.y); f[3] = bfhi(w.y); f[4] = bflo(w.z); f[5] = bfhi(w.z); f[6] = bflo(w.w); f[7] = bfhi(w.w); }
__device__ __forceinline__ v4u pack8(const float (&f)[8]) { v4u w; w.x = pk2(f[0], f[1]); w.y = pk2(f[2], f[3]); w.z = pk2(f[4], f[5]); w.w = pk2(f[6], f[7]); return w; }
__device__ __forceinline__ float sigm(float x) { return 1.f / (1.f + __expf(-x)); }
constexpr float ATT_C2 = 0.125f * 1.4426950408889634f;
__device__ __forceinline__ void p_zpost(Frame& F, int l) {
    const KArgs ap = kargs(); const auto& a = *ap; WS_OPAQUE(a);
    const bf16* Z = (const bf16*)(wsb + a.off[R_Z]);
    bf16* QN = (bf16*)(wsb + a.off[R_QN]); bf16* KN = (bf16*)(wsb + a.off[R_KN]); bf16* QKVB = (bf16*)(wsb + a.off[R_QKVB]); float* BG = (float*)(wsb + a.off[R_BG]);
    const int tid = otid(), lane = tid & 63, wave = __builtin_amdgcn_readfirstlane(tid >> 6);
    const int gw = F.vcu * NWAVES + wave, NGW = F.G * NWAVES;
    float gq[8], gk[8], cw[3][4][8];
#pragma unroll
    for (int j = 0; j < 8; ++j) { gq[j] = a.in[I_QN][l * HEAD_DIM_A + 8 * (lane & 7) + j] * ATT_C2; gk[j] = a.in[I_KN][l * HEAD_DIM_A + 8 * (lane & 7) + j]; }
#pragma unroll
    for (int w = 0; w < 3; ++w)
#pragma unroll
        for (int i = 0; i < 4; ++i)
#pragma unroll
            for (int j = 0; j < 8; ++j) cw[w][i][j] = a.in[I_CONVW][((size_t)l * CONV_W + i) * 3 * WIDTH_B + w * WIDTH_B + 8 * lane + j];
    float alog = 0.f, dtb = 0.f; if (lane < 4) { alog = a.in[I_ALOG][l * N_HEADS_B + lane]; dtb = a.in[I_DTB][l * N_HEADS_B + lane]; }
    for (int m = gw; m < RP; m += NGW) {
        const bool valid = prow_valid(m); const int nat = valid ? prow2nat(m) : 0;
        const bf16* zr = Z + (size_t)m * ZN;
        float f[8], o[8];
        unpack8(*(const GAS v4u*)(zr + ZC_QA + 8 * lane), f);
        { float ss = 0.f;
#pragma unroll
          for (int j = 0; j < 8; ++j) ss += f[j] * f[j];
          ss += __shfl_xor(ss, 1); ss += __shfl_xor(ss, 2); ss += __shfl_xor(ss, 4);
          const float r = 1.f / sqrtf(ss * (1.f / HEAD_DIM_A) + EPSF);
#pragma unroll
          for (int j = 0; j < 8; ++j) o[j] = f[j] * r * gq[j];
          *(GAS v4u*)(QN + (size_t)m * WIDTH_A + 8 * lane) = pack8(o); }
        unpack8(*(const GAS v4u*)(zr + ZC_KA + 8 * lane), f);
        { float ss = 0.f;
#pragma unroll
          for (int j = 0; j < 8; ++j) ss += f[j] * f[j];
          ss += __shfl_xor(ss, 1); ss += __shfl_xor(ss, 2); ss += __shfl_xor(ss, 4);
          const float r = 1.f / sqrtf(ss * (1.f / HEAD_DIM_A) + EPSF);
#pragma unroll
          for (int j = 0; j < 8; ++j) o[j] = f[j] * r * gk[j];
          *(GAS v4u*)(KN + (size_t)m * WIDTH_A + 8 * lane) = pack8(o);
          if (valid) { float* ko = nat < NP ? a.out + O_KP + ((size_t)l * NP + nat) * WIDTH_A : a.out + O_KS + ((size_t)l * NS + (nat - NP)) * WIDTH_A;
              *(GAS f32x4*)(ko + 8 * lane) = (f32x4){o[0], o[1], o[2], o[3]}; *(GAS f32x4*)(ko + 8 * lane + 4) = (f32x4){o[4], o[5], o[6], o[7]}; } }
        if (valid) { unpack8(*(const GAS v4u*)(zr + ZC_VA + 8 * lane), f);
            float* vo = nat < NP ? a.out + O_VP + ((size_t)l * NP + nat) * WIDTH_A : a.out + O_VS + ((size_t)l * NS + (nat - NP)) * WIDTH_A;
            *(GAS f32x4*)(vo + 8 * lane) = (f32x4){f[0], f[1], f[2], f[3]}; *(GAS f32x4*)(vo + 8 * lane + 4) = (f32x4){f[4], f[5], f[6], f[7]}; }
        const int ts = m >= SROW0 ? (m - SROW0) % DEC_SEQ : 1000; const int bs = m >= SROW0 ? (m - SROW0) / DEC_SEQ : 0;
        int cj = -1;
        if (m >= SROW0) { if (ts >= DEC_SEQ - 3) cj = ts - (DEC_SEQ - 3); } else { const int p = m % LPP; if (p >= PEND - 3 && p < PEND) cj = p - (PEND - 3); }
#pragma unroll
        for (int w = 0; w < 3; ++w) {
            float acc[8];
#pragma unroll
            for (int j = 0; j < 8; ++j) acc[j] = 0.f;
#pragma unroll
            for (int i = 0; i < 4; ++i) {
                const int dt = i - 3;
                if (ts + dt < 0) {
                    const float* sc = a.in[I_SCONV] + (((size_t)l * DEC_BATCH + bs) * (CONV_W - 1) + (CONV_W - 1 + ts + dt)) * 3 * WIDTH_B + w * WIDTH_B + 8 * lane;
                    const f32x4 s0 = *(const GAS f32x4*)sc, s1 = *(const GAS f32x4*)(sc + 4);
                    f[0] = s0.x; f[1] = s0.y; f[2] = s0.z; f[3] = s0.w; f[4] = s1.x; f[5] = s1.y; f[6] = s1.z; f[7] = s1.w;
                } else if (m + dt >= 0) unpack8(*(const GAS v4u*)(Z + (size_t)(m + dt) * ZN + ZC_QKVB + w * WIDTH_B + 8 * lane), f);
                else {
#pragma unroll
                    for (int j = 0; j < 8; ++j) f[j] = 0.f; }
#pragma unroll
                for (int j = 0; j < 8; ++j) acc[j] += f[j] * cw[w][i][j];
                if (i == 3 && cj >= 0) {
                    float* co = m >= SROW0 ? a.out + O_CS + (((size_t)l * DEC_BATCH + bs) * (CONV_W - 1) + cj) * 3 * WIDTH_B : a.out + O_CP + (((size_t)l * BATCH + m / LPP) * (CONV_W - 1) + cj) * 3 * WIDTH_B;
                    *(GAS f32x4*)(co + w * WIDTH_B + 8 * lane) = (f32x4){f[0], f[1], f[2], f[3]}; *(GAS f32x4*)(co + w * WIDTH_B + 8 * lane + 4) = (f32x4){f[4], f[5], f[6], f[7]}; }
            }
            float ss = 0.f;
#pragma unroll
            for (int j = 0; j < 8; ++j) { acc[j] = acc[j] * sigm(acc[j]); ss += acc[j] * acc[j]; }
            float sc = 1.f;
            if (w < 2) { ss += __shfl_xor(ss, 1); ss += __shfl_xor(ss, 2); ss += __shfl_xor(ss, 4); ss += __shfl_xor(ss, 8);
                sc = 1.f / sqrtf(ss + EPSF); if (w == 0) sc *= 0.08838834764831845f; }
#pragma unroll
            for (int j = 0; j < 8; ++j) o[j] = acc[j] * sc;
            *(GAS v4u*)(QKVB + (size_t)m * 3 * WIDTH_B + w * WIDTH_B + 8 * lane) = pack8(o);
        }
        if (lane < 4) { const float be = bf2f(zr[ZC_BA + lane]), al = bf2f(zr[ZC_BA + 4 + lane]) + dtb;
            const float sp = al > 20.f ? al : __logf(1.f + __expf(al));
            BG[(size_t)m * 8 + lane] = valid ? sigm(be) : 0.f; BG[(size_t)m * 8 + 4 + lane] = valid ? -__expf(alog) * sp : 0.f; }
    }
}
constexpr float LOG2E = 1.4426950408889634f;
__device__ __forceinline__ int t5_bucket_dev(int rel) {
    const int n = rel < 0 ? -rel : rel; int b;
    if (n < 8) b = n; else if (n < 12) b = 8; else if (n < 16) b = 9; else if (n < 23) b = 10; else if (n < 32) b = 11;
    else if (n < 46) b = 12; else if (n < 64) b = 13; else if (n < 91) b = 14; else b = 15;
    return b + (rel > 0 ? 16 : 0);
}
__device__ __forceinline__ void build_bias_table(LAS float* tab, const float* rel_bias, int h, int tid) {
    const float far = rel_bias[15 * N_HEADS_A + h];
    for (int i = tid; i < attn_body::BT_N; i += NTHR) tab[i] = (rel_bias[t5_bucket_dev(i - attn_body::BT_OFF) * N_HEADS_A + h] - far) * LOG2E;
}
__device__ __forceinline__ float lam_init_dev(int l) { return 0.8f - 0.6f * __expf(-0.3f * (float)l); }
__device__ __forceinline__ float lam_dev(const float* lqk_all, int l, int lane) {
    const float* q = lqk_all + (size_t)l * 4 * HEAD_DIM_A;
    const float s0 = wave_sum(q[lane] * q[HEAD_DIM_A + lane]), s1 = wave_sum(q[2 * HEAD_DIM_A + lane] * q[3 * HEAD_DIM_A + lane]);
    return __expf(s0) - __expf(s1) + lam_init_dev(l);
}
__device__ __forceinline__ int krow_dev(int s, int h, int j) { return 16 * s + 8 * (j >> 2) + 4 * h + (j & 3); }
__device__ __forceinline__ int crow_dev(int r, int h) { return (r & 3) + 8 * (r >> 2) + 4 * h; }
__device__ __forceinline__ bf16x8 pack_f8(const f32x4 a, const f32x4 b) { v4u w; w.x = pk2(a.x, a.y); w.y = pk2(a.z, a.w); w.z = pk2(b.x, b.y); w.w = pk2(b.z, b.w); return __builtin_bit_cast(bf16x8, w); }

__device__ __forceinline__ void sample_scores(f32x16& X, int kb, int c, const float* ck, const bf16* KN, int row0, int h, int hi, int r32, int qpos, const bf16x8 (&qf)[4], const LAS float* tab) {
    bf16x8 kf[4];
    if (kb < PAST_LEN / 32) { const float* kr = ck + (size_t)(kb * 32 + r32) * WIDTH_A + h * 128 + c * 64 + 8 * hi;
#pragma unroll
        for (int s = 0; s < 4; ++s) kf[s] = pack_f8(*(const GAS f32x4*)(kr + 16 * s), *(const GAS f32x4*)(kr + 16 * s + 4)); }
    else { const bf16* kr = KN + (size_t)(row0 + (kb * 32 - PAST_LEN) + r32) * WIDTH_A + h * 128 + c * 64 + 8 * hi;
#pragma unroll
        for (int s = 0; s < 4; ++s) kf[s] = *(const GAS bf16x8*)(kr + 16 * s); }
#pragma unroll
    for (int i = 0; i < 16; ++i) X[i] = 0.f;
#pragma unroll
    for (int s = 0; s < 4; ++s) X = __builtin_amdgcn_mfma_f32_32x32x16_bf16(kf[s], qf[s], X, 0, 0, 0);
#pragma unroll
    for (int i = 0; i < 16; ++i) { int idx = kb * 32 + crow_dev(i, hi) - qpos + attn_body::BT_OFF; idx = idx < 0 ? 0 : idx; X[i] += tab[idx]; }
}

__device__ __forceinline__ void attn_sample_unit(Frame& F, int l, int bs, int h) {
    const KArgs ap = kargs(); const auto& a = *ap; WS_OPAQUE(a);
    const int tid = otid(), lane = tid & 63, wid = __builtin_amdgcn_readfirstlane(tid >> 6), r32 = lane & 31, hi = lane >> 5;
    const bf16* QN = (const bf16*)(wsb + a.off[R_QN]); const bf16* KN = (const bf16*)(wsb + a.off[R_KN]); const bf16* Z = (const bf16*)(wsb + a.off[R_Z]); bf16* O = (bf16*)(wsb + a.off[R_O]);
    const float* ck = a.in[I_CK] + ((size_t)l * DEC_BATCH + bs) * PAST_LEN * WIDTH_A; const float* cv = a.in[I_CV] + ((size_t)l * DEC_BATCH + bs) * PAST_LEN * WIDTH_A;
    const int row0 = SROW0 + bs * DEC_SEQ;
    LAS float* tab = (LAS float*)(F.lds + RING_OFF + attn_body::LDS_BT);
    LAS float* st = (LAS float*)(F.lds + RING_OFF + 90112);
    LAS float* slot = (LAS float*)(F.lds + RING_OFF);
    const float lam = lam_dev(a.in[I_LQK], l, lane);
    build_bias_table(tab, a.in[I_REL], h, tid);
    bf16x8 qf[2][4];
#pragma unroll
    for (int c = 0; c < 2; ++c)
#pragma unroll
        for (int s = 0; s < 4; ++s) qf[c][s] = *(const GAS bf16x8*)(QN + (size_t)(row0 + r32) * WIDTH_A + h * 128 + c * 64 + 16 * s + 8 * hi);
    __syncthreads();
    float m[2] = {-1e30f, -1e30f}, lsum[2] = {0.f, 0.f};
    const int qpos = PAST_LEN + r32;
    for (int kb = wid; kb < (PAST_LEN + DEC_SEQ) / 32; kb += NWAVES) {
#pragma unroll
        for (int c = 0; c < 2; ++c) { f32x16 X; sample_scores(X, kb, c, ck, KN, row0, h, hi, r32, qpos, qf[c], tab);
            float mx = X[0];
#pragma unroll
            for (int i = 1; i < 16; ++i) mx = fmaxf(mx, X[i]);
            mx = fmaxf(mx, __shfl_xor(mx, 32)); const float mn = fmaxf(m[c], mx);
            float sum = 0.f;
#pragma unroll
            for (int i = 0; i < 16; ++i) sum += exp2f(X[i] - mn);
            lsum[c] = lsum[c] * exp2f(m[c] - mn) + sum; m[c] = mn; }
    }
#pragma unroll
    for (int c = 0; c < 2; ++c) { lsum[c] += __shfl_xor(lsum[c], 32); if (hi == 0) { st[((wid * 2 + c) * 2 + 0) * 32 + r32] = m[c]; st[((wid * 2 + c) * 2 + 1) * 32 + r32] = lsum[c]; } }
    __syncthreads();
    float gm[2], ginv[2];
#pragma unroll
    for (int c = 0; c < 2; ++c) { float mm = -1e30f;
#pragma unroll
        for (int w = 0; w < NWAVES; ++w) mm = fmaxf(mm, st[((w * 2 + c) * 2 + 0) * 32 + r32]);
        float ll = 0.f;
#pragma unroll
        for (int w = 0; w < NWAVES; ++w) ll += st[((w * 2 + c) * 2 + 1) * 32 + r32] * exp2f(st[((w * 2 + c) * 2 + 0) * 32 + r32] - mm);
        gm[c] = mm; ginv[c] = (c == 0 ? 1.f : lam) / ll; }
    f32x16 acc[4];
#pragma unroll
    for (int eb = 0; eb < 4; ++eb)
#pragma unroll
        for (int i = 0; i < 16; ++i) acc[eb][i] = 0.f;
    for (int kb = wid; kb < (PAST_LEN + DEC_SEQ) / 32; kb += NWAVES) {
        f32x16 X0, X1; sample_scores(X0, kb, 0, ck, KN, row0, h, hi, r32, qpos, qf[0], tab); sample_scores(X1, kb, 1, ck, KN, row0, h, hi, r32, qpos, qf[1], tab);
        float wv[16];
#pragma unroll
        for (int i = 0; i < 16; ++i) wv[i] = exp2f(X0[i] - gm[0]) * ginv[0] - exp2f(X1[i] - gm[1]) * ginv[1];
        bf16x8 xs[2];
#pragma unroll
        for (int s = 0; s < 2; ++s) { v4u w; w.x = pk2(wv[8 * s], wv[8 * s + 1]); w.y = pk2(wv[8 * s + 2], wv[8 * s + 3]); w.z = pk2(wv[8 * s + 4], wv[8 * s + 5]); w.w = pk2(wv[8 * s + 6], wv[8 * s + 7]); xs[s] = __builtin_bit_cast(bf16x8, w); }
#pragma unroll
        for (int eb = 0; eb < 4; ++eb)
#pragma unroll
            for (int s = 0; s < 2; ++s) {
                float vv[8];
                if (kb < PAST_LEN / 32) { const float* vb = cv + (size_t)(kb * 32 + 4 * hi) * WIDTH_A + h * 128 + eb * 32 + r32; asm volatile("" : "+v"(vb));
#pragma unroll
                    for (int j = 0; j < 8; ++j) vv[j] = vb[(size_t)(16 * s + 8 * (j >> 2) + (j & 3)) * WIDTH_A]; }
                else { const bf16* vb = Z + (size_t)(row0 + kb * 32 - PAST_LEN + 4 * hi) * ZN + ZC_VA + h * 128 + eb * 32 + r32; asm volatile("" : "+v"(vb));
#pragma unroll
                    for (int j = 0; j < 8; ++j) vv[j] = bf2f(vb[(size_t)(16 * s + 8 * (j >> 2) + (j & 3)) * ZN]); }
                v4u w; w.x = pk2(vv[0], vv[1]); w.y = pk2(vv[2], vv[3]); w.z = pk2(vv[4], vv[5]); w.w = pk2(vv[6], vv[7]);
                acc[eb] = __builtin_amdgcn_mfma_f32_32x32x16_bf16(xs[s], __builtin_bit_cast(bf16x8, w), acc[eb], 0, 0, 0);
            }
    }
    __syncthreads();
#pragma unroll
    for (int eb = 0; eb < 4; ++eb)
#pragma unroll
        for (int i = 0; i < 16; ++i) slot[(wid * 32 + crow_dev(i, hi)) * 128 + eb * 32 + r32] = acc[eb][i];
    __syncthreads();
    { const int q = tid >> 4, e0 = (tid & 15) * 8; float o[8];
#pragma unroll
      for (int j = 0; j < 8; ++j) o[j] = 0.f;
#pragma unroll
      for (int w = 0; w < NWAVES; ++w)
#pragma unroll
          for (int j = 0; j < 8; ++j) o[j] += slot[(w * 32 + q) * 128 + e0 + j];
      v4u pw; pw.x = pk2(o[0], o[1]); pw.y = pk2(o[2], o[3]); pw.z = pk2(o[4], o[5]); pw.w = pk2(o[6], o[7]);
      bf16* orow = O + (size_t)(row0 + q) * attn_body::OP + h * 256;
      unsigned zq = 0u; asm volatile("" : "+v"(zq));
      *(GAS v4u*)(orow + e0) = pw; *(GAS v4u*)(orow + 128 + e0) = (v4u){zq, zq, zq, zq}; }
    __syncthreads();
}

constexpr int ATT_NQB = LPP / 256;
constexpr int ATT_NPU = BATCH * 16 * ATT_NQB;
constexpr int ATT_NSU = DEC_BATCH * N_HEADS_A;
__device__ __forceinline__ void p_attention(Frame& F, int l, unsigned char* ldsg) {
    for (;;) {
        const KArgs ap = kargs(); const auto& a = *ap; WS_OPAQUE(a);
        const int tid = otid();
        gu32* head = (gu32*)wsb + CW_QUEUE + 64 * l;
        const attn_body::bf16* QN = (const attn_body::bf16*)(wsb + a.off[R_QN]); const attn_body::bf16* KN = (const attn_body::bf16*)(wsb + a.off[R_KN]);
        const attn_body::bf16* Z = (const attn_body::bf16*)(wsb + a.off[R_Z]); attn_body::bf16* O = (attn_body::bf16*)(wsb + a.off[R_O]);
        if (tid == 0) F.MISC[16] = __hip_atomic_fetch_add(head, 1u, RLX_AGENT);
        __syncthreads();
        const int u = (int)F.MISC[16];
        __syncthreads();
        if (u >= ATT_NPU + ATT_NSU) break;
        if (u < ATT_NPU) {
            const int qb = (ATT_NQB - 1) - u / 32, bvh = u % 32, b = bvh >> 4, vh = bvh & 15, h = vh >> 2, c = (vh >> 1) & 1, half = vh & 1;
            build_bias_table((LAS float*)(F.lds + RING_OFF + attn_body::LDS_BT), a.in[I_REL], h, tid);
            __syncthreads();
            attn_body::attn_unit<8>(b, h * 128 + c * 64, ZC_VA + h * 128 + half * 64, h * 256 + c * 128 + half * 64, qb, QN, KN, Z, O, (char*)ldsg + RING_OFF);
        } else { const int su = u - ATT_NPU; attn_sample_unit(F, l, su >> 2, su & 3); }
    }
}
__device__ __forceinline__ void p_mixpost_a(Frame& F, int l) {
    const KArgs ap = kargs(); const auto& a = *ap; WS_OPAQUE(a);
    const int tid = otid(), lane = tid & 63, wave = __builtin_amdgcn_readfirstlane(tid >> 6);
    const bf16* O = (const bf16*)(wsb + a.off[R_O]); bf16* OA = (bf16*)(wsb + a.off[R_OA]);
    const int gw = F.vcu * NWAVES + wave, NGW = F.G * NWAVES;
    const float lam = lam_dev(a.in[I_LQK], l, lane), post = 1.f - lam_init_dev(l);
    const int h = lane >> 4, e0 = 8 * (lane & 15);
    float sg[8];
#pragma unroll
    for (int j = 0; j < 8; ++j) sg[j] = a.in[I_SUBLN][l * 2 * HEAD_DIM_A + e0 + j] * post;
    for (int m = gw; m < RP; m += NGW) {
        float o0[8], o1[8], d[8];
        unpack8(*(const GAS v4u*)(O + (size_t)m * 1024 + h * 256 + e0), o0); unpack8(*(const GAS v4u*)(O + (size_t)m * 1024 + h * 256 + 128 + e0), o1);
        float ss = 0.f;
#pragma unroll
        for (int j = 0; j < 8; ++j) { d[j] = o0[j] - lam * o1[j]; ss += d[j] * d[j]; }
        ss += __shfl_xor(ss, 1); ss += __shfl_xor(ss, 2); ss += __shfl_xor(ss, 4); ss += __shfl_xor(ss, 8);
        const float r = 1.f / sqrtf(ss * (1.f / 128.f) + EPSF);
#pragma unroll
        for (int j = 0; j < 8; ++j) d[j] = d[j] * r * sg[j];
        *(GAS v4u*)(OA + (size_t)m * WIDTH_A + h * 128 + e0) = pack8(d);
    }
}
constexpr int GDN_NCH = PEND / 64;
constexpr int GDN_NPI = BATCH * N_HEADS_B * GDN_NCH;
constexpr int GDN_NSI = DEC_BATCH * N_HEADS_B;
constexpr int GDN_NI = GDN_NPI + GDN_NSI;
constexpr int GI_W = 0, GI_QG = 16384, GI_KG = 32768, GI_AT = 49152, GI_U = 57344, GI_SC = 90112, GI_STRIDE = 90368;
static_assert(GDN_NI % 2 == 0 && PEND % 64 == 0, "gdn items");
__device__ __forceinline__ int frag_off(int row, int kk, int nkb) {
    const int fid = ((row >> 5) * nkb + (kk >> 5)) * 2 + ((kk & 31) >> 4), ln = (row & 31) + 32 * (((kk & 15) >> 2) & 1), j = ((kk & 15) >> 3) * 4 + (kk & 3);
    return (fid * 64 + ln) * 8 + j;
}
__device__ __forceinline__ float rdlane(float v, int i) { return __builtin_bit_cast(float, __builtin_amdgcn_readlane(__builtin_bit_cast(int, v), i)); }
__device__ __forceinline__ int gdn_item_row(int item, int j) {
    if (item < GDN_NPI) { const int sh = item / GDN_NCH, n = item % GDN_NCH; return (sh / N_HEADS_B) * LPP + 64 * n + j; }
    const int s = item - GDN_NPI; return j < 32 ? -1 : SROW0 + (s >> 2) * DEC_SEQ + (j - 32);
}
__device__ __forceinline__ int gdn_item_head(int item) { return item < GDN_NPI ? (item / GDN_NCH) % N_HEADS_B : (item - GDN_NPI) & 3; }

__device__ __forceinline__ void p_gdn_chunk(Frame& F, int l) {
    const KArgs ap = kargs(); const auto& a = *ap; WS_OPAQUE(a);
    const int tid = otid(), wave = __builtin_amdgcn_readfirstlane(tid >> 6), grp = wave >> 2, gw = wave & 3;
    const bf16* QKVB = (const bf16*)(wsb + a.off[R_QKVB]); const float* BG = (const float*)(wsb + a.off[R_BG]); unsigned char* GD = wsb + a.off[R_GDN];
    LAS float* A_lds = (LAS float*)(F.lds + RING_OFF + grp * 20480);
    LAS float* Gs = A_lds + 4096; LAS float* Bs = Gs + 64; LAS float* Es = Bs + 64;
    for (int pr = F.vcu; 2 * pr < GDN_NI; pr += F.G) {
        int lane_ = tid & 63; asm volatile("" : "+v"(lane_));
        const int lane = lane_, r32 = lane & 31, hi = lane >> 5;
        const int item = 2 * pr + grp, h = gdn_item_head(item);
        unsigned char* ib = GD + (size_t)item * GI_STRIDE;
        const int rowt = gdn_item_row(item, lane);
        const float beta = rowt >= 0 ? BG[(size_t)rowt * 8 + h] : 0.f; float G = rowt >= 0 ? BG[(size_t)rowt * 8 + 4 + h] : 0.f;
#pragma unroll
        for (int o = 1; o < 64; o <<= 1) { const float v = __shfl_up(G, o); if (lane >= o) G += v; }
        const float Glast = rdlane(G, 63), eG = __expf(G);
        if (gw == 0) { Gs[lane] = G; Bs[lane] = beta; Es[lane] = eG; if (lane == 0) *(float*)(ib + GI_SC) = __expf(Glast); }
        __syncthreads();
        { const int i0 = 32 * (gw >> 1), j0 = 32 * (gw & 1);
          const int ra = gdn_item_row(item, i0 + r32), rb = gdn_item_row(item, j0 + r32);
          f32x16 akk, aqk;
#pragma unroll
          for (int r = 0; r < 16; ++r) { akk[r] = 0.f; aqk[r] = 0.f; }
          const bf16x8 zf = {0, 0, 0, 0, 0, 0, 0, 0};
#pragma unroll
          for (int s = 0; s < 8; ++s) {
              const bf16x8 qa = ra >= 0 ? *(const GAS bf16x8*)(QKVB + (size_t)ra * 1536 + h * 128 + 16 * s + 8 * hi) : zf;
              const bf16x8 ka = ra >= 0 ? *(const GAS bf16x8*)(QKVB + (size_t)ra * 1536 + 512 + h * 128 + 16 * s + 8 * hi) : zf;
              const bf16x8 kb = rb >= 0 ? *(const GAS bf16x8*)(QKVB + (size_t)rb * 1536 + 512 + h * 128 + 16 * s + 8 * hi) : zf;
              akk = __builtin_amdgcn_mfma_f32_32x32x16_bf16(ka, kb, akk, 0, 0, 0); aqk = __builtin_amdgcn_mfma_f32_32x32x16_bf16(qa, kb, aqk, 0, 0, 0);
          }
          const int j = j0 + r32; const float Gj = Gs[j]; bf16* AT = (bf16*)(ib + GI_AT);
#pragma unroll
          for (int r = 0; r < 16; ++r) { const int i = i0 + crow_dev(r, hi); const float dec = i >= j ? __expf(Gs[i] - Gj) : 0.f;
              A_lds[i * 64 + j] = i > j ? Bs[i] * akk[r] * dec : 0.f;
              AT[frag_off(i, j, 2)] = (bf16)f2bf(aqk[r] * dec); }
        }
        __syncthreads();
        { const int col = 64 * gw + lane; float x[64];
#pragma unroll
          for (int i = 0; i < 64; ++i) { const int ri = gdn_item_row(item, i);
              x[i] = ri >= 0 ? bf2f(QKVB[(size_t)ri * 1536 + (gw < 2 ? 1024 + h * 128 + col : 512 + h * 128 + (col - 128))]) : 0.f; }
#pragma unroll
          for (int i = 0; i < 64; ++i) x[i] *= gw < 2 ? rdlane(beta, i) : rdlane(beta, i) * rdlane(eG, i);
#pragma unroll
          for (int i = 1; i < 64; ++i) { const float arow = A_lds[i * 64 + lane];
#pragma unroll
              for (int j = 0; j < i; ++j) x[i] -= rdlane(arow, j) * x[j]; }
          if (gw < 2) { float* ub = (float*)(ib + GI_U) + col; asm volatile("" : "+v"(ub));
#pragma unroll
              for (int i = 0; i < 64; ++i) ub[i * 128] = x[i]; }
          else { const int k = col - 128; bf16* wb = (bf16*)(ib + GI_W) + frag_off(0, k, 4); asm volatile("" : "+v"(wb));
#pragma unroll
              for (int i = 0; i < 64; ++i) wb[(i >> 5) * 4096 + (i & 31) * 8] = (bf16)f2bf(x[i]); }
        }
        { bf16* QGF = (bf16*)(ib + GI_QG); bf16* KGF = (bf16*)(ib + GI_KG);
          for (int e = gw * 64 + lane; e < 64 * 128; e += 256) { const int c = e >> 7, k = e & 127, rc = gdn_item_row(item, c);
              const float qv = rc >= 0 ? bf2f(QKVB[(size_t)rc * 1536 + h * 128 + k]) : 0.f, kv = rc >= 0 ? bf2f(QKVB[(size_t)rc * 1536 + 512 + h * 128 + k]) : 0.f;
              QGF[frag_off(c, k, 4)] = (bf16)f2bf(qv * Es[c]); KGF[frag_off(k, c, 2)] = (bf16)f2bf(kv * __expf(Glast - Gs[c])); }
        }
        __syncthreads();
    }
}

__device__ __forceinline__ void gdn_chain(const unsigned char* GD, bf16* OB, const float* sdelta, float* dout, int item0, int nch, int h, int vb, int lane) {
    const int r32 = lane & 31, hi = lane >> 5;
    f32x16 S[4];
#pragma unroll
    for (int kb = 0; kb < 4; ++kb)
#pragma unroll
        for (int r = 0; r < 16; ++r) S[kb][r] = sdelta ? sdelta[(size_t)(kb * 32 + crow_dev(r, hi)) * HEAD_DIM_B + vb * 32 + r32] : 0.f;
    for (int n = 0; n < nch; ++n) {
        const int item = item0 + n; const unsigned char* ib = GD + (size_t)item * GI_STRIDE;
        const float eGl = *(const float*)(ib + GI_SC);
        const GAS bf16x8* WF = (const GAS bf16x8*)(ib + GI_W) + lane; const GAS bf16x8* QF = (const GAS bf16x8*)(ib + GI_QG) + lane;
        const GAS bf16x8* KF = (const GAS bf16x8*)(ib + GI_KG) + lane; const GAS bf16x8* AF = (const GAS bf16x8*)(ib + GI_AT) + lane; const float* U = (const float*)(ib + GI_U);
        bf16x8 Sp[4][2];
#pragma unroll
        for (int kb = 0; kb < 4; ++kb)
#pragma unroll
            for (int s = 0; s < 2; ++s) { v4u w; w.x = pk2(S[kb][8 * s], S[kb][8 * s + 1]); w.y = pk2(S[kb][8 * s + 2], S[kb][8 * s + 3]); w.z = pk2(S[kb][8 * s + 4], S[kb][8 * s + 5]); w.w = pk2(S[kb][8 * s + 6], S[kb][8 * s + 7]); Sp[kb][s] = __builtin_bit_cast(bf16x8, w); }
        f32x16 vn[2], ot[2];
#pragma unroll
        for (int cb = 0; cb < 2; ++cb) {
            f32x16 ws;
#pragma unroll
            for (int r = 0; r < 16; ++r) { ws[r] = 0.f; ot[cb][r] = 0.f; }
#pragma unroll
            for (int kb = 0; kb < 4; ++kb)
#pragma unroll
                for (int s = 0; s < 2; ++s) { ws = __builtin_amdgcn_mfma_f32_32x32x16_bf16(WF[((cb * 4 + kb) * 2 + s) * 64], Sp[kb][s], ws, 0, 0, 0);
                    ot[cb] = __builtin_amdgcn_mfma_f32_32x32x16_bf16(QF[((cb * 4 + kb) * 2 + s) * 64], Sp[kb][s], ot[cb], 0, 0, 0); }
#pragma unroll
            for (int r = 0; r < 16; ++r) vn[cb][r] = U[(cb * 32 + crow_dev(r, hi)) * 128 + vb * 32 + r32] - ws[r];
        }
        bf16x8 Vp[2][2];
#pragma unroll
        for (int cb = 0; cb < 2; ++cb)
#pragma unroll
            for (int s = 0; s < 2; ++s) { v4u w; w.x = pk2(vn[cb][8 * s], vn[cb][8 * s + 1]); w.y = pk2(vn[cb][8 * s + 2], vn[cb][8 * s + 3]); w.z = pk2(vn[cb][8 * s + 4], vn[cb][8 * s + 5]); w.w = pk2(vn[cb][8 * s + 6], vn[cb][8 * s + 7]); Vp[cb][s] = __builtin_bit_cast(bf16x8, w); }
#pragma unroll
        for (int cb = 0; cb < 2; ++cb)
#pragma unroll
            for (int c2 = 0; c2 <= cb; ++c2)
#pragma unroll
                for (int s = 0; s < 2; ++s) ot[cb] = __builtin_amdgcn_mfma_f32_32x32x16_bf16(AF[((cb * 2 + c2) * 2 + s) * 64], Vp[c2][s], ot[cb], 0, 0, 0);
#pragma unroll
        for (int cb = 0; cb < 2; ++cb)
#pragma unroll
            for (int r = 0; r < 16; ++r) { const int row = gdn_item_row(item, cb * 32 + crow_dev(r, hi)); if (row >= 0) OB[(size_t)row * WIDTH_B + h * 128 + vb * 32 + r32] = (bf16)f2bf(ot[cb][r]); }
#pragma unroll
        for (int kb = 0; kb < 4; ++kb) {
#pragma unroll
            for (int r = 0; r < 16; ++r) S[kb][r] *= eGl;
#pragma unroll
            for (int cb = 0; cb < 2; ++cb)
#pragma unroll
                for (int s = 0; s < 2; ++s) S[kb] = __builtin_amdgcn_mfma_f32_32x32x16_bf16(KF[((kb * 2 + cb) * 2 + s) * 64], Vp[cb][s], S[kb], 0, 0, 0);
        }
    }
#pragma unroll
    for (int kb = 0; kb < 4; ++kb)
#pragma unroll
        for (int r = 0; r < 16; ++r) dout[(size_t)(kb * 32 + crow_dev(r, hi)) * HEAD_DIM_B + vb * 32 + r32] = S[kb][r];
}
__device__ __forceinline__ void p_gdn_chain(Frame& F, int l) {
    const KArgs ap = kargs(); const auto& a = *ap; WS_OPAQUE(a);
    const int tid = otid(), lane = tid & 63, wave = __builtin_amdgcn_readfirstlane(tid >> 6);
    const unsigned char* GD = wsb + a.off[R_GDN]; bf16* OB = (bf16*)(wsb + a.off[R_OB]);
    if (wave == 0) { if (F.vcu < BATCH * N_HEADS_B * 4) { const int sh = F.vcu >> 2, vb = F.vcu & 3, sq = sh / N_HEADS_B, h = sh % N_HEADS_B;
            gdn_chain(GD, OB, nullptr, a.out + O_DP + (((size_t)l * BATCH + sq) * N_HEADS_B + h) * HEAD_DIM_B * HEAD_DIM_B, sh * GDN_NCH, GDN_NCH, h, vb, lane); } }
    else { const int t = F.vcu * (NWAVES - 1) + (wave - 1);
        if (t < GDN_NSI * 4) { const int s = t >> 2, vb = t & 3, bs = s >> 2, h = s & 3; const size_t so = (((size_t)l * DEC_BATCH + bs) * N_HEADS_B + h) * HEAD_DIM_B * HEAD_DIM_B;
            gdn_chain(GD, OB, a.in[I_SDELTA] + so, a.out + O_DS + so, GDN_NPI + s, 1, h, vb, lane); } }
}
__device__ __forceinline__ void p_mixpost_b(Frame& F, int l) {
    const KArgs ap = kargs(); const auto& a = *ap; WS_OPAQUE(a);
    const int tid = otid(), lane = tid & 63, wave = __builtin_amdgcn_readfirstlane(tid >> 6);
    bf16* OB = (bf16*)(wsb + a.off[R_OB]); const bf16* Z = (const bf16*)(wsb + a.off[R_Z]);
    const int gw = F.vcu * NWAVES + wave, NGW = F.G * NWAVES, e0 = 8 * (lane & 15);
    float gn[8];
#pragma unroll
    for (int j = 0; j < 8; ++j) gn[j] = a.in[I_GDNN][l * HEAD_DIM_B + e0 + j];
    for (int m = gw; m < RP; m += NGW) {
        float o[8], gt[8];
        unpack8(*(const GAS v4u*)(OB + (size_t)m * WIDTH_B + 8 * lane), o); unpack8(*(const GAS v4u*)(Z + (size_t)m * ZN + ZC_GB + 8 * lane), gt);
        float ss = 0.f;
#pragma unroll
        for (int j = 0; j < 8; ++j) ss += o[j] * o[j];
        ss += __shfl_xor(ss, 1); ss += __shfl_xor(ss, 2); ss += __shfl_xor(ss, 4); ss += __shfl_xor(ss, 8);
        const float r = 1.f / sqrtf(ss * (1.f / 128.f) + EPSF);
#pragma unroll
        for (int j = 0; j < 8; ++j) o[j] = o[j] * r * gn[j] * gt[j] * sigm(gt[j]);
        *(GAS v4u*)(OB + (size_t)m * WIDTH_B + 8 * lane) = pack8(o);
    }
}
constexpr int S5_M1 = 0, S5_M2 = 131072, S5_M3 = 196608, S5_L16 = 262144, S5_TSTRIDE = 262656;
constexpr int S5_NCHK = RP / 16;
constexpr int S5_NBLK = S5_NCHK / 32;
constexpr int S5_PCH = PEND / 16;
static_assert(S5_NCHK % 32 == 0 && LPP % 16 == 0 && PADF % 16 == 0 && S5_STATE == 64 && S5_GROUPS == 32, "s5 shapes");

__device__ __forceinline__ void s5_tables(Frame& F) {
    const KArgs ap = kargs(); const auto& a = *ap; WS_OPAQUE(a);
    const int tid = otid();
    LAS float* pw = (LAS float*)(F.lds + RING_OFF);
    LAS float* bb = pw + 17 * 128;
    LAS float* Kt = bb + 64 * 32;
    for (int it = F.vcu; it < DEPTH * S5_GROUPS; it += F.G) {
        const int l = it / S5_GROUPS, g = it % S5_GROUPS; const size_t gp = ((size_t)l * S5_GROUPS + g) * S5_STATE;
        unsigned char* tb = wsb + a.off[R_S5T] + (size_t)it * S5_TSTRIDE;
        const float dt = __expf(a.in[I_LDT][l * S5_GROUPS + g]);
        for (int e = tid; e < 17 * 64; e += NTHR) { const int k = e >> 6, p = e & 63; const float ar = a.in[I_AR][gp + p] * dt * (float)k, ai = a.in[I_AI][gp + p] * dt * (float)k;
            float sn, cs; sincosf(ai, &sn, &cs); const float er = expf(ar); pw[e * 2] = er * cs; pw[e * 2 + 1] = er * sn; }
        __syncthreads();
        for (int e = tid; e < 64 * 16; e += NTHR) { const int p = e >> 4; const float ar = a.in[I_AR][gp + p], ai = a.in[I_AI][gp + p];
            const float nr = pw[(64 + p) * 2] - 1.f, ni = pw[(64 + p) * 2 + 1], den = ar * ar + ai * ai, fr = (nr * ar + ni * ai) / den, fi = (ni * ar - nr * ai) / den;
            const float br = a.in[I_BR][gp * 16 + e], bi = a.in[I_BI][gp * 16 + e]; bb[e * 2] = fr * br - fi * bi; bb[e * 2 + 1] = fr * bi + fi * br; }
        if (tid < 128) { const int p = tid & 63; ((float*)(tb + S5_L16))[tid] = pw[(16 * 64 + p) * 2 + (tid >> 6)]; }
        __syncthreads();
        const float* cre = a.in[I_CR] + ((size_t)l * S5_GROUPS + g) * 16 * 64; const float* cim = a.in[I_CI] + ((size_t)l * S5_GROUPS + g) * 16 * 64;
        for (int e = tid; e < 4096; e += NTHR) { const int d = e >> 8, i = (e >> 4) & 15, j = e & 15; float acc = 0.f;
            for (int p = 0; p < 64; ++p) { const float cr = cre[i * 64 + p], ci = cim[i * 64 + p], pr = pw[(d * 64 + p) * 2], pi = pw[(d * 64 + p) * 2 + 1];
                const float tr = cr * pr - ci * pi, ti = cr * pi + ci * pr; acc += tr * bb[(p * 16 + j) * 2] - ti * bb[(p * 16 + j) * 2 + 1]; }
            Kt[e] = acc; }
        __syncthreads();
        bf16* M1 = (bf16*)(tb + S5_M1); bf16* M2 = (bf16*)(tb + S5_M2); bf16* M3 = (bf16*)(tb + S5_M3);
        for (int e = tid; e < 65536; e += NTHR) { const int n = e >> 8, k = e & 255, tau = n >> 4, i = n & 15, sg = k >> 4, j = k & 15;
            float v = 0.f; if (sg <= tau) { v = Kt[((tau - sg) * 16 + i) * 16 + j]; if (sg == tau && i == j) v += a.in[I_SD][(l * S5_GROUPS + g) * 16 + i]; }
            M1[e] = (bf16)f2bf(v); }
        for (int e = tid; e < 32768; e += NTHR) { const int n = e >> 8, k = e & 255, ri = n >> 6, p = n & 63, sg = k >> 4, j = k & 15;
            const float pr = pw[((15 - sg) * 64 + p) * 2], pi = pw[((15 - sg) * 64 + p) * 2 + 1], br = bb[(p * 16 + j) * 2], bi = bb[(p * 16 + j) * 2 + 1];
            M2[e] = (bf16)f2bf(ri == 0 ? pr * br - pi * bi : pr * bi + pi * br); }
        for (int e = tid; e < 32768; e += NTHR) { const int n = e >> 7, k = e & 127, tau = n >> 4, i = n & 15, ri = k >> 6, p = k & 63;
            const float cr = cre[i * 64 + p], ci = cim[i * 64 + p], pr = pw[((tau + 1) * 64 + p) * 2], pi = pw[((tau + 1) * 64 + p) * 2 + 1];
            M3[e] = (bf16)f2bf(ri == 0 ? cr * pr - ci * pi : -(cr * pi + ci * pr)); }
        __syncthreads();
    }
}
__device__ __forceinline__ void p_s5_e(Frame& F, int l) {
    const KArgs ap = kargs(); const auto& a = *ap; WS_OPAQUE(a);
    const int tid = otid(), lane = tid & 63, wave = __builtin_amdgcn_readfirstlane(tid >> 6), r32 = lane & 31, hi = lane >> 5;
    const bf16* Z = (const bf16*)(wsb + a.off[R_Z]); float* E = (float*)(wsb + a.off[R_S5E]);
    for (int u = F.vcu * NWAVES + wave; u < S5_NBLK * S5_GROUPS; u += F.G * NWAVES) {
        const int blk = u / S5_GROUPS, g = u % S5_GROUPS;
        const unsigned char* tb = wsb + a.off[R_S5T] + (size_t)(l * S5_GROUPS + g) * S5_TSTRIDE;
        const GAS bf16x8* M2 = (const GAS bf16x8*)(tb + S5_M2);
        const bf16* zr = Z + (size_t)((blk * 32 + r32) * 16) * ZN + ZC_UC + g * 16 + 8 * hi;
        f32x16 acc[4];
#pragma unroll
        for (int nb = 0; nb < 4; ++nb)
#pragma unroll
            for (int r = 0; r < 16; ++r) acc[nb][r] = 0.f;
#pragma unroll 4
        for (int sg = 0; sg < 16; ++sg) { const bf16x8 af = *(const GAS bf16x8*)(zr + (size_t)sg * ZN);
#pragma unroll
            for (int nb = 0; nb < 4; ++nb) acc[nb] = __builtin_amdgcn_mfma_f32_32x32x16_bf16(af, M2[((nb * 32 + r32) * 256 + sg * 16 + 8 * hi) >> 3], acc[nb], 0, 0, 0); }
#pragma unroll
        for (int nb = 0; nb < 4; ++nb)
#pragma unroll
            for (int r = 0; r < 16; ++r) E[((size_t)(blk * 32 + crow_dev(r, hi)) * S5_GROUPS + g) * 128 + nb * 32 + r32] = acc[nb][r];
    }
}
__device__ __forceinline__ void s5_scan_task(const float* E, bf16* XP, const float* l16, int g, int c0, int nch, float xr, float xi, float* ore, float* oim, int lane) {
    const float lr = l16[lane], li = l16[64 + lane];
    int c = 0;
    for (; c + 8 <= nch; c += 8) { float er[8], ei[8];
#pragma unroll
        for (int q = 0; q < 8; ++q) { const float* e = E + ((size_t)(c0 + c + q) * S5_GROUPS + g) * 128; er[q] = e[lane]; ei[q] = e[64 + lane]; }
#pragma unroll
        for (int q = 0; q < 8; ++q) { bf16* xp = XP + ((size_t)(c0 + c + q) * S5_GROUPS + g) * 128; xp[lane] = (bf16)f2bf(xr); xp[64 + lane] = (bf16)f2bf(xi);
            const float nr = lr * xr - li * xi + er[q], ni = lr * xi + li * xr + ei[q]; xr = nr; xi = ni; } }
    for (; c < nch; ++c) { const float* e = E + ((size_t)(c0 + c) * S5_GROUPS + g) * 128; bf16* xp = XP + ((size_t)(c0 + c) * S5_GROUPS + g) * 128; xp[lane] = (bf16)f2bf(xr); xp[64 + lane] = (bf16)f2bf(xi);
        const float nr = lr * xr - li * xi + e[lane], ni = lr * xi + li * xr + e[64 + lane]; xr = nr; xi = ni; }
    ore[lane] = xr; oim[lane] = xi;
}
constexpr int S5_NTASK = (BATCH + DEC_BATCH) * S5_GROUPS;
__device__ __forceinline__ void s5_scan_run(Frame& F, int l, int t, int lane) {
    const KArgs ap = kargs(); const auto& a = *ap; WS_OPAQUE(a);
    const int sq = t / S5_GROUPS, g = t % S5_GROUPS;
    const float* E = (const float*)(wsb + a.off[R_S5E]); bf16* XP = (bf16*)(wsb + a.off[R_S5X]);
    const float* l16 = (const float*)(wsb + a.off[R_S5T] + (size_t)(l * S5_GROUPS + g) * S5_TSTRIDE + S5_L16);
    if (sq < BATCH) { const size_t oo = (((size_t)l * BATCH + sq) * S5_GROUPS + g) * S5_STATE;
        s5_scan_task(E, XP, l16, g, sq * (LPP / 16), S5_PCH, 0.f, 0.f, a.out + O_SRP + oo, a.out + O_SIP + oo, lane); }
    else { const int bs = sq - BATCH; const size_t oo = (((size_t)l * DEC_BATCH + bs) * S5_GROUPS + g) * S5_STATE;
        s5_scan_task(E, XP, l16, g, SROW0 / 16 + bs * (DEC_SEQ / 16), DEC_SEQ / 16, a.in[I_SRE][oo + lane], a.in[I_SIM][oo + lane], a.out + O_SRS + oo, a.out + O_SIS + oo, lane); }
}
__device__ __forceinline__ float gelu_tanh(float x) { const float z = 0.7978845608028654f * (x + 0.044715f * x * x * x); const float t = 1.f - 2.f / (__expf(2.f * z) + 1.f); return 0.5f * x * (1.f + t); }
__device__ __forceinline__ void p_s5_out(Frame& F, int l) {
    const KArgs ap = kargs(); const auto& a = *ap; WS_OPAQUE(a);
    const int tid = otid(), lane = tid & 63, wave = __builtin_amdgcn_readfirstlane(tid >> 6), r32 = lane & 31, hi = lane >> 5;
    const bf16* Z = (const bf16*)(wsb + a.off[R_Z]); const bf16* XP = (const bf16*)(wsb + a.off[R_S5X]); bf16* YC = (bf16*)(wsb + a.off[R_YC]);
    for (int u = F.vcu * NWAVES + wave; u < S5_NBLK * S5_GROUPS; u += F.G * NWAVES) {
        const int blk = u / S5_GROUPS, g = u % S5_GROUPS;
        const unsigned char* tb = wsb + a.off[R_S5T] + (size_t)(l * S5_GROUPS + g) * S5_TSTRIDE;
        const GAS bf16x8* M1 = (const GAS bf16x8*)(tb + S5_M1); const GAS bf16x8* M3 = (const GAS bf16x8*)(tb + S5_M3);
        const bf16* zr = Z + (size_t)((blk * 32 + r32) * 16) * ZN + ZC_UC + g * 16 + 8 * hi;
        const bf16* xr = XP + ((size_t)(blk * 32 + r32) * S5_GROUPS + g) * 128 + 8 * hi;
        f32x16 acc[8];
#pragma unroll
        for (int nb = 0; nb < 8; ++nb)
#pragma unroll
            for (int r = 0; r < 16; ++r) acc[nb][r] = 0.f;
#pragma unroll 2
        for (int sg = 0; sg < 16; ++sg) { const bf16x8 af = *(const GAS bf16x8*)(zr + (size_t)sg * ZN);
#pragma unroll
            for (int nb = 0; nb < 8; ++nb) acc[nb] = __builtin_amdgcn_mfma_f32_32x32x16_bf16(af, M1[((nb * 32 + r32) * 256 + sg * 16 + 8 * hi) >> 3], acc[nb], 0, 0, 0); }
#pragma unroll 2
        for (int s = 0; s < 8; ++s) { const bf16x8 af = *(const GAS bf16x8*)(xr + 16 * s);
#pragma unroll
            for (int nb = 0; nb < 8; ++nb) acc[nb] = __builtin_amdgcn_mfma_f32_32x32x16_bf16(af, M3[((nb * 32 + r32) * 128 + s * 16 + 8 * hi) >> 3], acc[nb], 0, 0, 0); }
#pragma unroll
        for (int nb = 0; nb < 8; ++nb)
#pragma unroll
            for (int r = 0; r < 16; ++r) { const int row = (blk * 32 + crow_dev(r, hi)) * 16 + 2 * nb + (r32 >> 4);
                YC[(size_t)row * WIDTH_C + g * 16 + (r32 & 15)] = (bf16)f2bf(gelu_tanh(acc[nb][r])); }
    }
}
__device__ __forceinline__ float wave_max(float v) {
#pragma unroll
    for (int o = 1; o < 64; o <<= 1) v = fmaxf(v, __shfl_xor(v, o));
    return v;
}
__device__ __forceinline__ int rdlane_i(int v, int i) { return __builtin_amdgcn_readlane(v, i); }
constexpr float NEG_BIG = -3.0e38f;
__device__ __forceinline__ void pro_wqs(Frame& F) {
    const KArgs ap = kargs(); const auto& a = *ap; WS_OPAQUE(a);
    const int tid = otid(), lane = tid & 63, wave = __builtin_amdgcn_readfirstlane(tid >> 6);
    bf16* WQ = (bf16*)(wsb + a.off[R_WQS]);
    for (int t = F.vcu * NWAVES + wave; t < DEPTH * 16 * 16; t += F.G * NWAVES) {
        const int l = t >> 8, hc = (t >> 4) & 15, kb = t & 15, k = kb * 64 + lane;
        const float* wr = a.in[I_PWQ] + ((size_t)l * D_MODEL + k) * PQ + hc * 128;
        float w[128];
#pragma unroll
        for (int d = 0; d < 128; d += 4) { const f32x4 v = *(const GAS f32x4*)(wr + d); w[d] = v.x; w[d + 1] = v.y; w[d + 2] = v.z; w[d + 3] = v.w; }
        const float* sk = a.in[I_PSK] + ((size_t)l * 16 + hc) * 128 * 128;
        bf16* o = WQ + ((size_t)l * PQ + hc * 128) * D_MODEL + k;
#pragma clang loop vectorize(disable) unroll(disable)
        for (int n = 0; n < 128; ++n) { const float* sr = sk + n * 128; float acc = 0.f;
#pragma unroll
            for (int d = 0; d < 128; ++d) acc += w[d] * sr[d];
            o[(size_t)n * D_MODEL] = (bf16)f2bf(acc); }
    }
}
__device__ __forceinline__ void pro_wrest(Frame& F) {
    const KArgs ap = kargs(); const auto& a = *ap; WS_OPAQUE(a);
    const int tid = otid(), lane = tid & 63, wave = __builtin_amdgcn_readfirstlane(tid >> 6);
    LAS float* scr = (LAS float*)(F.lds + RING_OFF + wave * 16384);
    const int gw = F.vcu * NWAVES + wave, NGW = F.G * NWAVES;
    bf16* WG = (bf16*)(wsb + a.off[R_WGLU]); bf16* WB = (bf16*)(wsb + a.off[R_WBR]); bf16* WO = (bf16*)(wsb + a.off[R_WOUT]);
    constexpr int IG = (512 / 64) * (1024 / 32), IB = IG, IO = (1024 / 64) * (1024 / 32), IL = IG + 3 * IB + IO;
    for (int it = gw; it < DEPTH * IL; it += NGW) { const int l = it / IL; int r = it % IL;
        if (r < IG) { transpose_item(a.in[I_WGLU] + (size_t)l * 512 * 1024, 1024, 512, WG + (size_t)l * 1024 * 512, 32 * (r % 32), 64 * (r / 32), CmGlu(), scr, lane); continue; } r -= IG;
        if (r < 3 * IB) { const int w = r / IB, q = r % IB; transpose_item(a.in[I_WBA + w] + (size_t)l * 512 * 1024, 1024, 512, WB + ((size_t)l * 3 + w) * 1024 * 512, 32 * (q % 32), 64 * (q / 32), CmId(), scr, lane); continue; } r -= 3 * IB;
        transpose_item(a.in[I_WOUT] + (size_t)l * 1024 * 1024, 1024, 1024, WO + (size_t)l * 1024 * 1024, 32 * (r % 32), 64 * (r / 32), CmId(), scr, lane); }
}
__device__ __forceinline__ void pro_peerw(Frame& F) {
    const KArgs ap = kargs(); const auto& a = *ap; WS_OPAQUE(a);
    const int tid = otid();
    const size_t n8 = (size_t)DEPTH * N_EXPERTS * D_MODEL / 8, stride = (size_t)F.G * NTHR;
#pragma unroll
    for (int w = 0; w < 2; ++w) { const GAS f32x4* src = (const GAS f32x4*)a.in[I_PU + w]; GAS v4u* dst = (GAS v4u*)(wsb + a.off[R_PU + w]);
        for (size_t i = (size_t)F.vcu * NTHR + tid; i < n8; i += stride) { const f32x4 x = src[2 * i], y = src[2 * i + 1]; v4u o; o.x = pk2(x.x, x.y); o.y = pk2(x.z, x.w); o.z = pk2(y.x, y.y); o.w = pk2(y.z, y.w); dst[i] = o; } }
}
__device__ __forceinline__ void p_peer(Frame& F, int l) {
    const KArgs ap = kargs(); const auto& a = *ap; WS_OPAQUE(a);
    const int tid = otid(), lane = tid & 63, wave = __builtin_amdgcn_readfirstlane(tid >> 6);
    const float* SC = (const float*)(wsb + a.off[R_SC]); const bf16* XN = (const bf16*)(wsb + a.off[R_XN]); float* X = (float*)(wsb + a.off[R_X]);
    const bf16* PU = (const bf16*)(wsb + a.off[R_PU]) + (size_t)l * N_EXPERTS * D_MODEL; const bf16* PV = (const bf16*)(wsb + a.off[R_PV]) + (size_t)l * N_EXPERTS * D_MODEL;
    LAS float* stop = (LAS float*)(F.lds + RING_OFF + wave * 4096);
    LAS int* itop = (LAS int*)(stop + 256);
    LAS int* elist = itop + 256;
    LAS float* cf = (LAS float*)(elist + 128);
    for (int m = F.vcu * NWAVES + wave; m < RP; m += F.G * NWAVES) {
        if (!prow_valid(m)) continue;
        const float* sr = SC + (size_t)m * PQ;
        for (int hc = 0; hc < 16; ++hc) {
            float v0 = sr[hc * 128 + lane], v1 = sr[hc * 128 + 64 + lane], tv = 0.f; int ti = 0;
#pragma unroll
            for (int k = 0; k < 16; ++k) {
                const bool f = v0 >= v1; const float lb = f ? v0 : v1; const int li = f ? lane : lane + 64;
                const float wm = wave_max(lb);
                const unsigned long long mk = __ballot(lb == wm); const int src = __builtin_ctzll(mk);
                const int wi = rdlane_i(li, src);
                if (lane == k) { tv = wm; ti = wi; }
                if (lane == (wi & 63)) { if (wi < 64) v0 = NEG_BIG; else v1 = NEG_BIG; }
            }
            if (lane < 16) { stop[hc * 16 + lane] = tv; itop[hc * 16 + lane] = ti; }
        }
        LDS_WAIT();
        for (int h = 0; h < 8; ++h) {
            const float s1 = stop[(2 * h) * 16 + (lane >> 2)];
            float c[4];
#pragma unroll
            for (int j = 0; j < 4; ++j) c[j] = s1 + stop[(2 * h + 1) * 16 + (lane & 3) * 4 + j];
            float bv = 0.f; int bc = 0;
#pragma unroll
            for (int k = 0; k < 16; ++k) {
                float lb = c[0]; int lj = 0;
#pragma unroll
                for (int j = 1; j < 4; ++j) if (c[j] > lb) { lb = c[j]; lj = j; }
                const float wm = wave_max(lb);
                const unsigned long long mk = __ballot(lb == wm); const int src = __builtin_ctzll(mk);
                const int wc = rdlane_i(lane * 4 + lj, src);
                if (lane == k) { bv = wm; bc = wc; }
                if (lane == (wc >> 2)) {
#pragma unroll
                    for (int j = 0; j < 4; ++j) if ((wc & 3) == j) c[j] = NEG_BIG; }
            }
            const float b0 = rdlane(bv, 0); float e = lane < 16 ? __expf(bv - b0) : 0.f;
            float sum = e; sum += __shfl_xor(sum, 1); sum += __shfl_xor(sum, 2); sum += __shfl_xor(sum, 4); sum += __shfl_xor(sum, 8);
            if (lane < 16) { elist[h * 16 + lane] = itop[(2 * h) * 16 + (bc >> 4)] * N_KEYS + itop[(2 * h + 1) * 16 + (bc & 15)]; cf[h * 16 + lane] = e / sum; }
        }
        LDS_WAIT();
        float hx[16], out[16];
        { float t[8]; unpack8(*(const GAS v4u*)(XN + (size_t)m * D_MODEL + 8 * lane), t);
#pragma unroll
          for (int j = 0; j < 8; ++j) hx[j] = t[j];
          unpack8(*(const GAS v4u*)(XN + (size_t)m * D_MODEL + 512 + 8 * lane), t);
#pragma unroll
          for (int j = 0; j < 8; ++j) hx[8 + j] = t[j]; }
#pragma unroll
        for (int j = 0; j < 16; ++j) out[j] = 0.f;
        for (int q = 0; q < 128; q += 4) {
            v4u ua[4], ub[4], va[4], vb[4]; float cw[4];
#pragma unroll
            for (int i = 0; i < 4; ++i) { const size_t eo = (size_t)elist[q + i] * D_MODEL; cw[i] = cf[q + i];
                ua[i] = *(const GAS v4u*)(PU + eo + 8 * lane); ub[i] = *(const GAS v4u*)(PU + eo + 512 + 8 * lane);
                va[i] = *(const GAS v4u*)(PV + eo + 8 * lane); vb[i] = *(const GAS v4u*)(PV + eo + 512 + 8 * lane); }
#pragma unroll
            for (int i = 0; i < 4; ++i) { float t[8], d = 0.f;
                unpack8(ua[i], t);
#pragma unroll
                for (int j = 0; j < 8; ++j) d += hx[j] * t[j];
                unpack8(ub[i], t);
#pragma unroll
                for (int j = 0; j < 8; ++j) d += hx[8 + j] * t[j];
                d = wave_sum(d);
                const float cc = cw[i] * gelu_tanh(d);
                unpack8(va[i], t);
#pragma unroll
                for (int j = 0; j < 8; ++j) out[j] += cc * t[j];
                unpack8(vb[i], t);
#pragma unroll
                for (int j = 0; j < 8; ++j) out[8 + j] += cc * t[j]; }
        }
        { GAS f32x4* xr = (GAS f32x4*)(X + (size_t)m * D_MODEL + 8 * lane);
          xr[0] = xr[0] + (f32x4){out[0], out[1], out[2], out[3]}; xr[1] = xr[1] + (f32x4){out[4], out[5], out[6], out[7]};
          GAS f32x4* xs = (GAS f32x4*)(X + (size_t)m * D_MODEL + 512 + 8 * lane);
          xs[0] = xs[0] + (f32x4){out[8], out[9], out[10], out[11]}; xs[1] = xs[1] + (f32x4){out[12], out[13], out[14], out[15]}; }
    }
}
__device__ __forceinline__ void p_final(Frame& F) {
    const KArgs ap = kargs(); const auto& a = *ap; WS_OPAQUE(a);
    const int tid = otid(), lane = tid & 63, wave = __builtin_amdgcn_readfirstlane(tid >> 6);
    const float* X = (const float*)(wsb + a.off[R_X]); const float* g = a.in[I_FN];
    for (int m = F.vcu * NWAVES + wave; m < RP; m += F.G * NWAVES) {
        float* dst;
        if (m >= SROW0) dst = a.out + O_YS + (size_t)(m - SROW0) * D_MODEL;
        else { const int b = m / LPP, p = m % LPP; if (p < PADF + N_META || p >= PEND) continue; dst = a.out + O_YP + ((size_t)b * SEQ + (p - PADF - N_META)) * D_MODEL; }
        const GAS f32x4* xr = (const GAS f32x4*)(X + (size_t)m * D_MODEL) + lane;
        f32x4 v[4]; float s2 = 0.f;
#pragma unroll
        for (int j = 0; j < 4; ++j) { v[j] = xr[64 * j]; s2 += (v[j].x * v[j].x + v[j].y * v[j].y) + (v[j].z * v[j].z + v[j].w * v[j].w); }
        const float r = 1.f / sqrtf(wave_sum(s2) * (1.f / D_MODEL) + EPSF);
        const GAS f32x4* gr = (const GAS f32x4*)g + lane; GAS f32x4* o = (GAS f32x4*)dst + lane;
#pragma unroll
        for (int j = 0; j < 4; ++j) { const f32x4 gg = gr[64 * j]; o[64 * j] = (f32x4){v[j].x * r * gg.x, v[j].y * r * gg.y, v[j].z * r * gg.z, v[j].w * r * gg.w}; }
    }
}

__device__ __forceinline__ void p_prologue(Frame& F) {
    const KArgs ap = kargs(); const auto& a = *ap; WS_OPAQUE(a);
    const int tid = otid(), lane = tid & 63, wave = __builtin_amdgcn_readfirstlane(tid >> 6);
    LAS float* scr = (LAS float*)(F.lds + RING_OFF + wave * 16384);
    const int gw = F.vcu * NWAVES + wave, NGW = F.G * NWAVES;
    if (a.pro_mask & PM_X) {
        float* X = (float*)(wsb + a.off[R_X]);
        for (int m = gw; m < RP; m += NGW) {
            const float* src = nullptr;
            if (m >= SROW0) src = a.in[I_XS] + (size_t)(m - SROW0) * D_MODEL;
            else { const int b = m / LPP, p = m % LPP; if (p >= PADF && p < PEND) { const int pos = p - PADF; src = pos < N_META ? a.in[I_META] + (size_t)pos * D_MODEL : a.in[I_XP] + ((size_t)b * SEQ + pos - N_META) * D_MODEL; } }
            GAS f32x4* o = (GAS f32x4*)(X + (size_t)m * D_MODEL) + lane;
#pragma unroll
            for (int j = 0; j < 4; ++j) o[64 * j] = src ? ((const GAS f32x4*)src)[lane + 64 * j] : (f32x4){0.f, 0.f, 0.f, 0.f};
        }
    }
    if (a.pro_mask & PM_WIN) {
        bf16* WT = (bf16*)(wsb + a.off[R_WIN]);
        constexpr int IPL = (D_MODEL / 64) * (ZN / 32);
        for (int it = gw; it < DEPTH * IPL; it += NGW) { const int l = it / IPL, r = it % IPL, kb = r / (ZN / 32), nb = r % (ZN / 32);
            transpose_item(a.in[I_WIN] + (size_t)l * D_MODEL * D_IN, D_IN, D_MODEL, WT + (size_t)l * ZN * D_MODEL, 32 * nb, 64 * kb, CmWin(), scr, lane); }
    }
    __syncthreads();
    if (a.pro_mask & PM_TABLES) s5_tables(F);
    __syncthreads();
    if (a.pro_mask & PM_WREST) pro_wrest(F);
    if (a.pro_mask & PM_WQS) pro_wqs(F);
    if (a.pro_mask & PM_PEERW) pro_peerw(F);
}

__global__ void __launch_bounds__(NTHR, 2) mk_fwd(Args args) {
    extern __shared__ __attribute__((aligned(16))) unsigned char lds[];
    Frame F;
    F.lds = (LAS unsigned char*)lds; F.MISC = (volatile LAS unsigned*)(F.lds + MISC_OFF);
    F.G = gridDim.x; { const int bx = blockIdx.x; F.vcu = (F.G % 8 == 0) ? (bx % 8) * (F.G / 8) + bx / 8 : bx; }
    F.ctl = (gu32*)args.ws;
    for (int u = threadIdx.x; u < (LDS_BYTES - LDSCTL_OFF) / 4; u += NTHR) ((LAS unsigned*)(F.lds + LDSCTL_OFF))[u] = 0u;
    __syncthreads();
    const int lo = args.ph_lo, hi = args.ph_hi;
    unsigned* barw = (unsigned*)(F.ctl + CW_BAR) + (size_t)args.bar_region * XCD_BAR_WORDS;
    XcdBarrier bar; bar.bar = barw; bar.x = 0; bar.st = nullptr;
    if (hi - lo > 1) bar = xcd_barrier_post(barw, F.MISC + 8);
#define IN(k) (lo <= (k) && (k) < hi)
#define SEAM(k) do { if ((k) + 1 < hi) xcd_barrier(bar); } while (0)
    if (IN(PH_PRO)) { p_prologue(F); SEAM(PH_PRO); }
    for (int l = 0; l < DEPTH; ++l) {
        const int pb = 1 + l * NPL;
        if (IN(pb + PL_NORM1)) { p_norm(F, l, I_N1); SEAM(pb + PL_NORM1); }
        if (IN(pb + PL_GEMM_IN)) {
            const KArgs ap = kargs(); const auto& a = *ap; WS_OPAQUE(a);
            pg8::Gemm g{(const pg8::bf16_t*)(wsb + a.off[R_XN]), (const pg8::bf16_t*)(wsb + a.off[R_WIN]) + (size_t)l * ZN * D_MODEL, RP, ZN, D_MODEL};
            pg8::StaticOrder S; S.init(RP, ZN, F.G, (int)blockIdx.x);
            pg8::EpiBf16<0> E{(pg8::bf16_t*)(wsb + a.off[R_Z]), ZN, nullptr, 0, 0, 1.f};
            pg8::gemm_phase<pg8::EpiBf16<0>, pg8::StaticOrder, true, true>(F.lds + RING_OFF, g, S, E);
            SEAM(pb + PL_GEMM_IN);
        }
        if (IN(pb + PL_ZPOST)) { p_zpost(F, l); SEAM(pb + PL_ZPOST); }
        if (IN(pb + PL_LOCAL)) { p_gdn_chunk(F, l); p_s5_e(F, l); SEAM(pb + PL_LOCAL); }
        if (IN(pb + PL_MIX)) {
            p_gdn_chain(F, l);
            { const int tid = otid(), lane = tid & 63, wave = __builtin_amdgcn_readfirstlane(tid >> 6), NGW = F.G * NWAVES;
              for (int t = (F.vcu * NWAVES + wave + NGW - 256) % NGW; t < S5_NTASK; t += NGW) s5_scan_run(F, l, t, lane); }
            p_attention(F, l, lds); SEAM(pb + PL_MIX); }
        if (IN(pb + PL_MIXPOST)) { p_mixpost_a(F, l); p_mixpost_b(F, l); p_s5_out(F, l); SEAM(pb + PL_MIXPOST); }
        if (IN(pb + PL_GEMM_GLU)) {
            const KArgs ap = kargs(); const auto& a = *ap; WS_OPAQUE(a);
            { pg8::Gemm g{(const pg8::bf16_t*)(wsb + a.off[R_YC]), (const pg8::bf16_t*)(wsb + a.off[R_WGLU]) + (size_t)l * 1024 * 512, RP, 1024, 512};
              pg8::StaticOrder S; S.init(RP, 1024, F.G, (int)blockIdx.x); pg8::EpiGlu E{(pg8::bf16_t*)(wsb + a.off[R_OC]), WIDTH_C};
              pg8::gemm_phase<pg8::EpiGlu, pg8::StaticOrder, true, true>(F.lds + RING_OFF, g, S, E); }
            { pg8::Gemm g{(const pg8::bf16_t*)(wsb + a.off[R_OA]), (const pg8::bf16_t*)(wsb + a.off[R_WBR]) + ((size_t)l * 3 + 0) * 1024 * 512, RP, 1024, 512};
              pg8::StaticOrder S; S.init(RP, 1024, F.G, (int)blockIdx.x); pg8::EpiMerge<0> E{(float*)(wsb + a.off[R_MRG]), nullptr, (const pg8::bf16_t*)(wsb + a.off[R_Z]) + ZC_GATE, ZN};
              pg8::gemm_phase<pg8::EpiMerge<0>, pg8::StaticOrder, true, true>(F.lds + RING_OFF, g, S, E); }
            { pg8::Gemm g{(const pg8::bf16_t*)(wsb + a.off[R_OB]), (const pg8::bf16_t*)(wsb + a.off[R_WBR]) + ((size_t)l * 3 + 1) * 1024 * 512, RP, 1024, 512};
              pg8::StaticOrder S; S.init(RP, 1024, F.G, (int)blockIdx.x); pg8::EpiMerge<1> E{(float*)(wsb + a.off[R_MRG]), nullptr, (const pg8::bf16_t*)(wsb + a.off[R_Z]) + ZC_GATE + 1024, ZN};
              pg8::gemm_phase<pg8::EpiMerge<1>, pg8::StaticOrder, true, true>(F.lds + RING_OFF, g, S, E); }
            SEAM(pb + PL_GEMM_GLU); }
        if (IN(pb + PL_GEMM_BRC)) {
            const KArgs ap = kargs(); const auto& a = *ap; WS_OPAQUE(a);
            pg8::Gemm g{(const pg8::bf16_t*)(wsb + a.off[R_OC]), (const pg8::bf16_t*)(wsb + a.off[R_WBR]) + ((size_t)l * 3 + 2) * 1024 * 512, RP, 1024, 512};
            pg8::StaticOrder S; S.init(RP, 1024, F.G, (int)blockIdx.x); pg8::EpiMerge<2> E{(float*)(wsb + a.off[R_MRG]), (pg8::bf16_t*)(wsb + a.off[R_MRGB]), (const pg8::bf16_t*)(wsb + a.off[R_Z]) + ZC_GATE + 2048, ZN};
            pg8::gemm_phase<pg8::EpiMerge<2>, pg8::StaticOrder, true, true>(F.lds + RING_OFF, g, S, E);
            SEAM(pb + PL_GEMM_BRC); }
        if (IN(pb + PL_GEMM_OUT)) {
            const KArgs ap = kargs(); const auto& a = *ap; WS_OPAQUE(a);
            pg8::Gemm g{(const pg8::bf16_t*)(wsb + a.off[R_MRGB]), (const pg8::bf16_t*)(wsb + a.off[R_WOUT]) + (size_t)l * 1024 * 1024, RP, 1024, 1024};
            pg8::StaticOrder S; S.init(RP, 1024, F.G, (int)blockIdx.x); pg8::EpiResid E{(float*)(wsb + a.off[R_X]), D_MODEL};
            pg8::gemm_phase<pg8::EpiResid, pg8::StaticOrder, true, true>(F.lds + RING_OFF, g, S, E);
            SEAM(pb + PL_GEMM_OUT); }
        if (IN(pb + PL_NORM2)) { p_norm(F, l, I_N2); SEAM(pb + PL_NORM2); }
        if (IN(pb + PL_GEMM_PEER)) {
            const KArgs ap = kargs(); const auto& a = *ap; WS_OPAQUE(a);
            pg8::Gemm g{(const pg8::bf16_t*)(wsb + a.off[R_XN]), (const pg8::bf16_t*)(wsb + a.off[R_WQS]) + (size_t)l * PQ * D_MODEL, RP, PQ, D_MODEL};
            pg8::StaticOrder S; S.init(RP, PQ, F.G, (int)blockIdx.x); pg8::EpiF32 E{(float*)(wsb + a.off[R_SC]), PQ};
            pg8::gemm_phase<pg8::EpiF32, pg8::StaticOrder, true, true>(F.lds + RING_OFF, g, S, E);
            SEAM(pb + PL_GEMM_PEER); }
        if (IN(pb + PL_PEER)) { p_peer(F, l); SEAM(pb + PL_PEER); }
    }
    if (IN(PH_FINAL)) p_final(F);
#undef IN
#undef SEAM
}
}
#ifndef MK_ONE_LAUNCH
#define MK_ONE_LAUNCH 1
#endif
static int mk_grid = 0;
static bool mk_setup() {
    if (mk_grid) return mk_grid > 0;
    int dev = 0, cus = 0;
    if (hipGetDevice(&dev) != hipSuccess || hipDeviceGetAttribute(&cus, hipDeviceAttributeMultiprocessorCount, dev) != hipSuccess) { mk_grid = -1; return false; }
    if (hipFuncSetAttribute((const void*)mk::mk_fwd, hipFuncAttributeMaxDynamicSharedMemorySize, mk::LDS_BYTES) != hipSuccess) { fprintf(stderr, "kernel_launch: hipFuncSetAttribute failed\n"); mk_grid = -1; return false; }
    int per_cu = 0;
    if (hipOccupancyMaxActiveBlocksPerMultiprocessor(&per_cu, (const void*)mk::mk_fwd, mk::NTHR, mk::LDS_BYTES) != hipSuccess || per_cu < 1) { fprintf(stderr, "kernel_launch: occupancy query says %d workgroups per CU\n", per_cu); }
    (void)hipGetLastError();
    mk_grid = cus;
    return true;
}
static void mk_launch(mk::Args a, int lo, int hi, int region, hipStream_t stream) {
    a.ph_lo = lo; a.ph_hi = hi; a.bar_region = region;
    hipLaunchKernelGGL(mk::mk_fwd, dim3(mk_grid), dim3(mk::NTHR), mk::LDS_BYTES, stream, a);
    hipError_t e = hipPeekAtLastError(); if (e != hipSuccess) fprintf(stderr, "kernel_launch: launch failed: %s\n", hipGetErrorName(e));
}
extern "C" void kernel_launch(void* const* d_in, const int* in_sizes, int n_in, void* d_out, int out_size, void* d_ws, size_t ws_size, hipStream_t stream) {
    if (n_in != N_INPUTS || (size_t)out_size != (size_t)O_END) { fprintf(stderr, "kernel_launch: unexpected n_in %d / out_size %d\n", n_in, out_size); return; }
    if (!mk_setup()) return;
    const size_t MiB = 1u << 20;
    unsigned char* ws = (unsigned char*)d_ws;
    mk::Args a{};
    for (int i = 0; i < N_INPUTS; ++i) a.in[i] = (const float*)d_in[i];
    a.out = (float*)d_out; a.ws = ws;
    { using namespace mk; const struct { int r; size_t mib; } map[] = { {R_WIN, 1}, {R_WGLU, 59}, {R_WBR, 63}, {R_WOUT, 75}, {R_WQS, 83}, {R_S5T, 99}, {R_PU, 132}, {R_PV, 260}, {R_X, 388}, {R_XN, 456},
        {R_Z, 490}, {R_SC, 490}, {R_QN, 737}, {R_KN, 754}, {R_QKVB, 771}, {R_BG, 822}, {R_O, 823}, {R_MRGB, 823}, {R_OA, 857}, {R_OB, 874}, {R_GDN, 891}, {R_MRG, 891},
        {R_S5E, 986}, {R_YC, 986}, {R_S5X, 1003}, {R_OC, 1012} };
      for (auto& e : map) a.off[e.r] = e.mib * MiB; }
    if (1029 * MiB > ws_size) { fprintf(stderr, "kernel_launch: workspace too small (%zu)\n", ws_size); return; }
    if (hipMemsetAsync(ws, 0, mk::CTL_BYTES, stream) != hipSuccess) { fprintf(stderr, "kernel_launch: memset failed\n"); return; }
    a.pro_mask = mk::PM_X | mk::PM_WIN | mk::PM_TABLES | mk::PM_WREST | mk::PM_WQS | mk::PM_PEERW;
#if MK_ONE_LAUNCH
    mk_launch(a, 0, mk::PH_END, 0, stream);
#else
    int region = 0;
    mk_launch(a, mk::PH_PRO, mk::PH_PRO + 1, region++, stream);
    for (int l = 0; l < DEPTH; ++l) { const int pb = 1 + l * mk::NPL;
        for (int ph = mk::PL_NORM1; ph <= mk::PL_PEER; ++ph) { if (ph == mk::PL_GEMM_BRA || ph == mk::PL_GEMM_BRB) continue; mk_launch(a, pb + ph, pb + ph + 1, region++, stream); } }
    mk_launch(a, mk::PH_FINAL, mk::PH_END, region++, stream);
#endif
}
```

```cpp
#include <hip/hip_runtime.h>
#include <cstdio>
#include <cstdint>
#define MK_ONE_LAUNCH 1
#ifndef D_MODEL
#define D_MODEL 1024
#define BATCH 2
#define SEQ 8192
#define DEPTH 4
#define DEC_BATCH 16
#define DEC_SEQ 32
#define PAST_LEN 1024
#define N_HEADS_A 4
#define HEAD_DIM_A 64
#define N_HEADS_B 4
#define HEAD_DIM_B 128
#define S5_GROUPS 32
#define S5_STATE 64
#define PEER_HEADS 8
#define PEER_QDIM 256
#define N_KEYS 128
#endif
#define CHUNK 64
#define N_META 16
#define EPSF 1e-6f
#define NUM_BUCKETS 32
#define CONV_W 4
#define S5_GROUP 16
#define PEER_TOPK 16
#define N_EXPERTS (N_KEYS * N_KEYS)
#define WIDTH_A (N_HEADS_A * 2 * HEAD_DIM_A)
#define WIDTH_B (N_HEADS_B * HEAD_DIM_B)
#define WIDTH_C (S5_GROUPS * S5_GROUP)
#define OFF_QA 0
#define OFF_KA (OFF_QA + WIDTH_A)
#define OFF_VA (OFF_KA + WIDTH_A)
#define OFF_QKVB (OFF_VA + WIDTH_A)
#define OFF_GB (OFF_QKVB + 3 * WIDTH_B)
#define OFF_BETA (OFF_GB + WIDTH_B)
#define OFF_ALPHA (OFF_BETA + N_HEADS_B)
#define OFF_UC (OFF_ALPHA + N_HEADS_B)
#define OFF_GATE (OFF_UC + WIDTH_C)
#define D_IN (OFF_GATE + 3 * D_MODEL)
#define LP (N_META + SEQ)
#define NP (BATCH * LP)
#define NS (DEC_BATCH * DEC_SEQ)
#define NT (NP + NS)
#define PQ (PEER_HEADS * PEER_QDIM)

enum { I_XP, I_XS, I_CK, I_CV, I_SCONV, I_SDELTA, I_SRE, I_SIM, I_META, I_REL, I_N1, I_N2, I_FN, I_WIN, I_QN, I_KN, I_LQK, I_SUBLN, I_CONVW, I_ALOG, I_DTB, I_GDNN,
       I_AR, I_AI, I_BR, I_BI, I_CR, I_CI, I_SD, I_LDT, I_WGLU, I_WBA, I_WBB, I_WBC, I_WOUT, I_PWQ, I_PSK, I_PU, I_PV, N_INPUTS };
#define O_YP 0
#define O_YS (O_YP + (size_t)BATCH * SEQ * D_MODEL)
#define O_KP (O_YS + (size_t)NS * D_MODEL)
#define O_VP (O_KP + (size_t)DEPTH * NP * WIDTH_A)
#define O_KS (O_VP + (size_t)DEPTH * NP * WIDTH_A)
#define O_VS (O_KS + (size_t)DEPTH * NS * WIDTH_A)
#define O_CP (O_VS + (size_t)DEPTH * NS * WIDTH_A)
#define O_CS (O_CP + (size_t)DEPTH * BATCH * (CONV_W - 1) * 3 * WIDTH_B)
#define O_DP (O_CS + (size_t)DEPTH * DEC_BATCH * (CONV_W - 1) * 3 * WIDTH_B)
#define O_DS (O_DP + (size_t)DEPTH * BATCH * N_HEADS_B * HEAD_DIM_B * HEAD_DIM_B)
#define O_SRP (O_DS + (size_t)DEPTH * DEC_BATCH * N_HEADS_B * HEAD_DIM_B * HEAD_DIM_B)
#define O_SIP (O_SRP + (size_t)DEPTH * BATCH * S5_GROUPS * S5_STATE)
#define O_SRS (O_SIP + (size_t)DEPTH * BATCH * S5_GROUPS * S5_STATE)
#define O_SIS (O_SRS + (size_t)DEPTH * DEC_BATCH * S5_GROUPS * S5_STATE)
#define O_END (O_SIS + (size_t)DEPTH * DEC_BATCH * S5_GROUPS * S5_STATE)

namespace pg8 {
#define PG8_LAS __attribute__((address_space(3)))
typedef unsigned short bf16_t;
typedef short bf16x8 __attribute__((ext_vector_type(8)));
typedef float f32x4 __attribute__((ext_vector_type(4)));
typedef unsigned u32x4 __attribute__((ext_vector_type(4)));
constexpr int BM = 256, BK = 64, HALF = 128, HTB = HALF * BK * 2  , STAGE_BYTES = 8 * HTB, NXCD = 8, WGM = 8;

__host__ __device__ __forceinline__ int lds_byte(int r, int c) { const int st = (r >> 4) * 2 + (c >> 5), rr = r & 15, cc = c & 31, ob = rr * 64 + cc * 2; return st * 1024 + (ob ^ (((ob >> 9) & 1) << 5)); }
__host__ __device__ __forceinline__ void stage_rc(int b, int& R, int& C) { const int st = b / 1024, sb = b % 1024, swz = sb ^ (((sb >> 9) & 1) << 5); R = (st >> 1) * 16 + swz / 64; C = (st & 1) * 32 + (swz % 64) / 2; }
__host__ __device__ __forceinline__ int perm32(int rho) { const int n = rho >> 4, i = rho & 15; return 8 * (i >> 2) + 4 * n + (i & 3); }

struct Unit { int pm, pn; };
struct Gemm { const bf16_t* A; const bf16_t* Bt; int M, N, K; };

struct StaticOrder {
    int nM, nN, nwg, G, c;
    __host__ __device__ void init(int M, int N, int G_, int c_) { nM = M / BM; nN = N / BM; nwg = nM * nN; G = G_; c = c_; }
    __host__ __device__ bool next(int i, Unit& u) const {
        const long L = (long)i * G + c; if (L >= nwg) return false;
        int wgid = (int)L; { const int q = nwg / NXCD, r = nwg % NXCD, xcd = wgid % NXCD, off = wgid / NXCD; wgid = (xcd < r ? xcd * (q + 1) : r * (q + 1) + (xcd - r) * q) + off; }
        const int nig = WGM * nN, gid = wgid / nig, fm = gid * WGM, gsz = (nM - fm) < WGM ? (nM - fm) : WGM;
        u.pm = fm + ((wgid % nig) % gsz); u.pn = (wgid % nig) / gsz; return true;
    }
    __device__ __forceinline__ void a_ready(const Unit&) const {}
    __device__ __forceinline__ void done(const Unit&) const {}
};

__device__ __forceinline__ unsigned cvt_pk_bf16(float lo, float hi) { unsigned r; asm volatile("v_cvt_pk_bf16_f32 %0, %1, %2" : "=v"(r) : "v"(lo), "v"(hi)); return r; }
typedef float f32x2 __attribute__((ext_vector_type(2)));
__device__ __forceinline__ f32x2 gelu_pk(f32x2 v) {
    const f32x2 av = __builtin_elementwise_abs(v), d = av * 0.2316418882f + 1.0f;
    f32x2 t; t.x = __builtin_amdgcn_rcpf(d.x); t.y = __builtin_amdgcn_rcpf(d.y);
    f32x2 q = t * 0.5307027145f + (-0.7265760135f); q = q * t + 0.7107068705f; q = q * t + (-0.142248368f); q = q * t + 0.127414796f; q = q * t;
    const f32x2 s = (v * v) * (-0.72134752044f);
    f32x2 e; e.x = __builtin_amdgcn_exp2f(s.x); e.y = __builtin_amdgcn_exp2f(s.y);
    const f32x2 m = v * (q * e), r = v - m;
    f32x2 o; o.x = v.x < 0.f ? m.x : r.x; o.y = v.y < 0.f ? m.y : r.y; return o;
}

template <int ACT  > struct EpiBf16 {
    static constexpr bool PERM = true, AFTER_DRAIN = false; static_assert(ACT == 0 || ACT == 1, "EpiBf16: ACT is 0 (none) or 1 (gelu_pk)");
    bf16_t* O; int ldc; const float* bias; int split_cols; size_t split_stride; float scale0;
    __device__ __forceinline__ void operator()(const f32x4 (&acc)[2][2][4][2], const Unit& u, int wr, int wc, int fr, int fq) const {
        const int row0 = u.pm * BM + wr * 64 + fr; int colt = u.pn * BM; bf16_t* base = O;
        float sc = 1.f; if (split_cols) { const int t = colt / split_cols; base += (size_t)t * split_stride; colt -= t * split_cols; if (t == 0) sc = scale0; }
        const int col0 = colt + wc * 32 + 8 * fq, bcol0 = u.pn * BM + wc * 32 + 8 * fq;
        f32x4 bv[2][2];
#pragma unroll
        for (int bj = 0; bj < 2; ++bj)
#pragma unroll
            for (int n = 0; n < 2; ++n) bv[bj][n] = bias ? *(const f32x4*)(bias + bcol0 + bj * HALF + 4 * n) : (f32x4){0.f, 0.f, 0.f, 0.f};
#pragma unroll
        for (int ai = 0; ai < 2; ++ai)
#pragma unroll
            for (int m = 0; m < 4; ++m) { bf16_t* rowp = base + (size_t)(row0 + ai * HALF + m * 16) * ldc + col0;
#pragma unroll
                for (int bj = 0; bj < 2; ++bj) { f32x4 v0 = acc[ai][bj][m][0] + bv[bj][0], v1 = acc[ai][bj][m][1] + bv[bj][1];
                    if (ACT == 1) { f32x2 a = gelu_pk((f32x2){v0[0], v0[1]}), b = gelu_pk((f32x2){v0[2], v0[3]}), c = gelu_pk((f32x2){v1[0], v1[1]}), d = gelu_pk((f32x2){v1[2], v1[3]});
                        v0 = (f32x4){a.x, a.y, b.x, b.y}; v1 = (f32x4){c.x, c.y, d.x, d.y}; }
                    v0 = v0 * sc; v1 = v1 * sc; u32x4 w; w.x = cvt_pk_bf16(v0[0], v0[1]); w.y = cvt_pk_bf16(v0[2], v0[3]); w.z = cvt_pk_bf16(v1[0], v1[1]); w.w = cvt_pk_bf16(v1[2], v1[3]);
                    *(u32x4*)(rowp + bj * HALF) = w; } }
    }
};

__device__ __forceinline__ float epi_sigm(float x) { return 1.f / (1.f + __expf(-x)); }
struct EpiGlu {
    static constexpr bool PERM = false, AFTER_DRAIN = false;
    bf16_t* O; int ldo;
    __device__ __forceinline__ void operator()(const f32x4 (&acc)[2][2][4][2], const Unit& u, int wr, int wc, int fr, int fq) const {
        const int row0 = u.pm * BM + wr * 64 + fr;
#pragma unroll
        for (int ai = 0; ai < 2; ++ai)
#pragma unroll
            for (int m = 0; m < 4; ++m) { bf16_t* rowp = O + (size_t)(row0 + ai * HALF + m * 16) * ldo + 4 * fq;
#pragma unroll
                for (int bj = 0; bj < 2; ++bj) { const int G = u.pn * 8 + bj * 4 + wc; const f32x4 av = acc[ai][bj][m][0], gv = acc[ai][bj][m][1];
                    typedef unsigned u32x2 __attribute__((ext_vector_type(2))); u32x2 w;
                    w.x = cvt_pk_bf16(av[0] * epi_sigm(gv[0]), av[1] * epi_sigm(gv[1])); w.y = cvt_pk_bf16(av[2] * epi_sigm(gv[2]), av[3] * epi_sigm(gv[3]));
                    *(u32x2*)(rowp + 16 * G) = w; } }
    }
};
template <int MODE> struct EpiMerge {
    static constexpr bool PERM = true, AFTER_DRAIN = false;
    float* M; bf16_t* Mb; const bf16_t* Zg; int ldz;
    __device__ __forceinline__ void operator()(const f32x4 (&acc)[2][2][4][2], const Unit& u, int wr, int wc, int fr, int fq) const {
        const int row0 = u.pm * BM + wr * 64 + fr, col0 = u.pn * BM + wc * 32 + 8 * fq;
#pragma unroll
        for (int ai = 0; ai < 2; ++ai)
#pragma unroll
            for (int m = 0; m < 4; ++m) { const size_t row = (size_t)(row0 + ai * HALF + m * 16);
#pragma unroll
                for (int bj = 0; bj < 2; ++bj) { const int col = col0 + bj * HALF;
                    const u32x4 gz = *(const u32x4*)(Zg + row * ldz + col);
                    float g[8]; g[0] = __builtin_bit_cast(float, gz.x << 16); g[1] = __builtin_bit_cast(float, gz.x & 0xffff0000u); g[2] = __builtin_bit_cast(float, gz.y << 16); g[3] = __builtin_bit_cast(float, gz.y & 0xffff0000u);
                    g[4] = __builtin_bit_cast(float, gz.z << 16); g[5] = __builtin_bit_cast(float, gz.z & 0xffff0000u); g[6] = __builtin_bit_cast(float, gz.w << 16); g[7] = __builtin_bit_cast(float, gz.w & 0xffff0000u);
                    f32x4 v0 = acc[ai][bj][m][0], v1 = acc[ai][bj][m][1];
#pragma unroll
                    for (int j = 0; j < 4; ++j) { v0[j] *= epi_sigm(g[j]); v1[j] *= epi_sigm(g[4 + j]); }
                    float* mp = M + row * 1024 + col;
                    if (MODE != 0) { v0 += *(const f32x4*)mp; v1 += *(const f32x4*)(mp + 4); }
                    if (MODE != 2) { *(f32x4*)mp = v0; *(f32x4*)(mp + 4) = v1; }
                    else { u32x4 w; w.x = cvt_pk_bf16(v0[0], v0[1]); w.y = cvt_pk_bf16(v0[2], v0[3]); w.z = cvt_pk_bf16(v1[0], v1[1]); w.w = cvt_pk_bf16(v1[2], v1[3]); *(u32x4*)(Mb + row * 1024 + col) = w; } } }
    }
};
struct EpiResid {
    static constexpr bool PERM = false, AFTER_DRAIN = false;
    float* X; int ldx;
    __device__ __forceinline__ void operator()(const f32x4 (&acc)[2][2][4][2], const Unit& u, int wr, int wc, int fr, int fq) const {
        const int row0 = u.pm * BM + wr * 64 + fr, col0 = u.pn * BM + wc * 32 + 4 * fq;
#pragma unroll
        for (int ai = 0; ai < 2; ++ai)
#pragma unroll
            for (int m = 0; m < 4; ++m) { const int row = row0 + ai * HALF + m * 16;
                bool ok = true; if (row < 16896) { const int p = row % 8448; ok = p >= 48 && p < 8256; }
                if (ok) { float* rowp = X + (size_t)row * ldx + col0;
#pragma unroll
                    for (int bj = 0; bj < 2; ++bj)
#pragma unroll
                        for (int n = 0; n < 2; ++n) { f32x4* p4 = (f32x4*)(rowp + bj * HALF + n * 16); *p4 = *p4 + acc[ai][bj][m][n]; } } }
    }
};
struct EpiF32 {
    static constexpr bool PERM = false, AFTER_DRAIN = false;
    float* C; int ldc;
    __device__ __forceinline__ void operator()(const f32x4 (&acc)[2][2][4][2], const Unit& u, int wr, int wc, int fr, int fq) const {
        const int row0 = u.pm * BM + wr * 64 + fr, col0 = u.pn * BM + wc * 32 + 4 * fq;
#pragma unroll
        for (int ai = 0; ai < 2; ++ai)
#pragma unroll
            for (int m = 0; m < 4; ++m) { float* rowp = C + (size_t)(row0 + ai * HALF + m * 16) * ldc + col0;
#pragma unroll
                for (int bj = 0; bj < 2; ++bj)
#pragma unroll
                    for (int n = 0; n < 2; ++n) *(f32x4*)(rowp + bj * HALF + n * 16) = acc[ai][bj][m][n]; }
    }
};

template <class Epi, class Sched, bool ALIGN_EPI = false, bool SP2 = false>
__device__ __forceinline__ void gemm_phase(PG8_LAS unsigned char* lds, const Gemm g, const Sched& S, const Epi& E) {
    int tid_ = threadIdx.x; asm volatile("" : "+v"(tid_));
    const int tid = tid_, wid = __builtin_amdgcn_readfirstlane(tid >> 6), lane = tid & 63, wr = wid >> 2, wc = wid & 3, fr = lane & 15, fq = lane >> 4;
    const int K = g.K, nt = K / BK;
    unsigned voffA[2], voffB[2];
#pragma unroll
    for (int i = 0; i < 2; ++i) { int R, C; stage_rc(tid * 16 + i * 8192, R, C); const int Rb = Epi::PERM ? ((R & ~31) + perm32(R & 31)) : R;
        voffA[i] = (unsigned)(R * K + C) * 2u; voffB[i] = (unsigned)(Rb * K + C) * 2u; }
    const size_t kstep = (size_t)(BK * 2);
    const size_t hstep = (size_t)HALF * K * 2;
    const size_t tstep = 2 * hstep;
    const unsigned ldsw = (unsigned)wid * 1024u;
    const int aoff = lds_byte(wr * 64 + fr, fq * 8), boff = lds_byte(wc * 32 + fr, fq * 8);
#define PG8_SA(b, h) (((b) * 2 + (h)) * HTB)
#define PG8_SB(b, h) ((4 + (b) * 2 + (h)) * HTB)
#define PG8_STAGE(bufoff, gbase, voff) do { _Pragma("unroll") for (int _i = 0; _i < 2; ++_i) \
        __builtin_amdgcn_global_load_lds((const unsigned*)((const char*)(gbase) + (voff)[_i]), (PG8_LAS unsigned*)(lds + (bufoff) + ldsw + _i * 8192), 16, 0, 0); } while (0)
#define PG8_LDA(dst, b, h) do { _Pragma("unroll") for (int m = 0; m < 4; ++m) _Pragma("unroll") for (int k = 0; k < 2; ++k) dst[m][k] = *(const PG8_LAS bf16x8*)(lds + PG8_SA(b, h) + aoff + m * 2048 + k * 1024); } while (0)
#define PG8_LDB(dst, b, h) do { _Pragma("unroll") for (int n = 0; n < 2; ++n) _Pragma("unroll") for (int k = 0; k < 2; ++k) dst[n][k] = *(const PG8_LAS bf16x8*)(lds + PG8_SB(b, h) + boff + n * 2048 + k * 1024); } while (0)
#define PG8_MMA(ai, bj, At, Bt) do { __builtin_amdgcn_s_setprio(1); _Pragma("unroll") for (int m = 0; m < 4; ++m) _Pragma("unroll") for (int n = 0; n < 2; ++n) _Pragma("unroll") for (int k = 0; k < 2; ++k) \
        acc[ai][bj][m][n] = __builtin_amdgcn_mfma_f32_16x16x32_bf16(Bt[n][k], At[m][k], acc[ai][bj][m][n], 0, 0, 0); __builtin_amdgcn_s_setprio(0); } while (0)
#define PG8_WAIT_V(n) asm volatile("s_waitcnt vmcnt(" #n ")" ::: "memory")
#define PG8_WAIT_L(n) asm volatile("s_waitcnt lgkmcnt(" #n ")" ::: "memory")
#define PG8_BAR __builtin_amdgcn_s_barrier()
#define PG8_SCHED __builtin_amdgcn_sched_barrier(0)
    Unit cur, nxt; int ui = 0;
    if (!S.next(0, cur)) return;
    f32x4 acc[2][2][4][2];
#pragma unroll
    for (int a = 0; a < 2; ++a)
#pragma unroll
        for (int b = 0; b < 2; ++b)
#pragma unroll
            for (int m = 0; m < 4; ++m)
#pragma unroll
                for (int n = 0; n < 2; ++n) acc[a][b][m][n] = (f32x4){0.f, 0.f, 0.f, 0.f};
    bf16x8 At[4][2], B0[2][2], B1[2][2];
    const char* cA = (const char*)g.A + (size_t)cur.pm * tstep; const char* cB = (const char*)g.Bt + (size_t)cur.pn * tstep;
    S.a_ready(cur);
    if constexpr (SP2) {
        PG8_STAGE(PG8_SB(0, 0), cB, voffB); PG8_STAGE(PG8_SB(0, 1), cB + hstep, voffB); PG8_STAGE(PG8_SA(0, 0), cA, voffA); PG8_STAGE(PG8_SA(0, 1), cA + hstep, voffA);
        if (wr == 1) PG8_BAR;
        PG8_WAIT_V(2); PG8_BAR;
        PG8_STAGE(PG8_SB(1, 0), cB + kstep, voffB); PG8_STAGE(PG8_SA(1, 0), cA + kstep, voffA); PG8_STAGE(PG8_SB(1, 1), cB + hstep + kstep, voffB);
        PG8_WAIT_V(6); PG8_BAR;
    } else {
        PG8_STAGE(PG8_SB(0, 0), cB, voffB); PG8_STAGE(PG8_SA(0, 0), cA, voffA); PG8_STAGE(PG8_SB(0, 1), cB + hstep, voffB); PG8_STAGE(PG8_SA(0, 1), cA + hstep, voffA);
        if (wr == 1) PG8_BAR;
        PG8_WAIT_V(4); PG8_BAR;
        PG8_STAGE(PG8_SB(1, 0), cB + kstep, voffB); PG8_STAGE(PG8_SA(1, 0), cA + kstep, voffA); PG8_STAGE(PG8_SB(1, 1), cB + hstep + kstep, voffB);
        PG8_WAIT_V(6); PG8_BAR;
    }
    for (;;) {
        const bool has_next = S.next(ui + 1, nxt);
        const char* nA = has_next ? (const char*)g.A + (size_t)nxt.pm * tstep : cA; const char* nB = has_next ? (const char*)g.Bt + (size_t)nxt.pn * tstep : cB;
        for (int t = 0; t < nt; t += 2) {
            const bool last = (t == nt - 2);
            const char* a1 = cA + (size_t)(t + 1) * kstep;
            const char* a2 = last ? nA : cA + (size_t)(t + 2) * kstep; const char* b2 = last ? nB : cB + (size_t)(t + 2) * kstep;
            const char* a3 = a2 + kstep; const char* b3 = b2 + kstep;
            if (last && has_next) S.a_ready(nxt);
            if constexpr (SP2) {
            PG8_LDB(B0, 0, 0); PG8_LDB(B1, 0, 1); PG8_SCHED; PG8_LDA(At, 0, 0); PG8_STAGE(PG8_SA(1, 1), a1 + hstep, voffA);
            PG8_WAIT_V(8); PG8_WAIT_L(0); PG8_BAR; PG8_MMA(0, 0, At, B0); PG8_MMA(0, 1, At, B1); PG8_BAR; PG8_SCHED;
            PG8_LDA(At, 0, 1); PG8_STAGE(PG8_SB(0, 0), b2, voffB); PG8_STAGE(PG8_SB(0, 1), b2 + hstep, voffB); PG8_STAGE(PG8_SA(0, 0), a2, voffA);
            PG8_WAIT_V(8); PG8_WAIT_L(0); PG8_BAR; PG8_MMA(1, 0, At, B0); PG8_MMA(1, 1, At, B1); PG8_BAR; PG8_SCHED;
            PG8_LDB(B0, 1, 0); PG8_LDB(B1, 1, 1); PG8_SCHED; PG8_LDA(At, 1, 0); PG8_STAGE(PG8_SA(0, 1), a2 + hstep, voffA);
            PG8_WAIT_V(8); PG8_WAIT_L(0); PG8_BAR; PG8_MMA(0, 0, At, B0); PG8_MMA(0, 1, At, B1); PG8_BAR; PG8_SCHED;
            PG8_LDA(At, 1, 1); PG8_STAGE(PG8_SB(1, 0), b3, voffB); PG8_STAGE(PG8_SB(1, 1), b3 + hstep, voffB); PG8_STAGE(PG8_SA(1, 0), a3, voffA);
            PG8_WAIT_V(8); PG8_WAIT_L(0); PG8_BAR; PG8_MMA(1, 0, At, B0); PG8_MMA(1, 1, At, B1); PG8_BAR; PG8_SCHED;
            } else {
            PG8_LDB(B0, 0, 0); PG8_SCHED; PG8_LDA(At, 0, 0); PG8_STAGE(PG8_SA(1, 1), a1 + hstep, voffA);
            PG8_WAIT_L(8); PG8_BAR; PG8_WAIT_L(0); PG8_MMA(0, 0, At, B0); PG8_BAR; PG8_SCHED;
            PG8_LDB(B1, 0, 1); PG8_STAGE(PG8_SB(0, 0), b2, voffB);
            PG8_BAR; PG8_WAIT_L(0); PG8_MMA(0, 1, At, B1); PG8_BAR;
            PG8_LDA(At, 0, 1); PG8_STAGE(PG8_SA(0, 0), a2, voffA);
            PG8_BAR; PG8_WAIT_L(0); PG8_MMA(1, 0, At, B0); PG8_BAR; PG8_SCHED;
            PG8_STAGE(PG8_SB(0, 1), b2 + hstep, voffB);
            PG8_WAIT_V(6); PG8_BAR; PG8_MMA(1, 1, At, B1); PG8_BAR;
            PG8_LDB(B0, 1, 0); PG8_SCHED; PG8_LDA(At, 1, 0); PG8_STAGE(PG8_SA(0, 1), a2 + hstep, voffA);
            PG8_WAIT_L(8); PG8_BAR; PG8_WAIT_L(0); PG8_MMA(0, 0, At, B0); PG8_BAR; PG8_SCHED;
            PG8_LDB(B1, 1, 1); PG8_STAGE(PG8_SB(1, 0), b3, voffB);
            PG8_BAR; PG8_WAIT_L(0); PG8_MMA(0, 1, At, B1); PG8_BAR;
            PG8_LDA(At, 1, 1); PG8_STAGE(PG8_SA(1, 0), a3, voffA);
            PG8_BAR; PG8_WAIT_L(0); PG8_MMA(1, 0, At, B0); PG8_BAR; PG8_SCHED;
            PG8_STAGE(PG8_SB(1, 1), b3 + hstep, voffB);
            PG8_WAIT_V(6); PG8_BAR; PG8_MMA(1, 1, At, B1); PG8_BAR;
            }
        }
        if constexpr (ALIGN_EPI) { if (wr == 0) PG8_BAR; }
        if constexpr (!Epi::AFTER_DRAIN) { E(acc, cur, wr, wc, fr, fq); S.done(cur); }
        if (!has_next) break;
#pragma unroll
        for (int a = 0; a < 2; ++a)
#pragma unroll
            for (int b = 0; b < 2; ++b)
#pragma unroll
                for (int m = 0; m < 4; ++m)
#pragma unroll
                    for (int n = 0; n < 2; ++n) acc[a][b][m][n] = (f32x4){0.f, 0.f, 0.f, 0.f};
        cur = nxt; cA = nA; cB = nB; ++ui;
        if constexpr (ALIGN_EPI) { if (wr == 1) PG8_BAR; }
    }
    PG8_WAIT_V(0);
    if constexpr (!ALIGN_EPI) { if (wr == 0) PG8_BAR; }
    PG8_BAR;
    if constexpr (Epi::AFTER_DRAIN) { E.fused(acc, cur, wr, wc, fr, fq, lds, wid, lane); S.done(cur); }
#undef PG8_SA
#undef PG8_SB
#undef PG8_STAGE
#undef PG8_LDA
#undef PG8_LDB
#undef PG8_MMA
#undef PG8_WAIT_V
#undef PG8_WAIT_L
#undef PG8_BAR
#undef PG8_SCHED
}
}
#include <hip/hip_bf16.h>
#include <cmath>
namespace attn_body {
using bf16=__hip_bfloat16;
using bf16x8=__attribute__((ext_vector_type(8)))short;
using s16x4=__attribute__((ext_vector_type(4)))short;
using f32x16=__attribute__((ext_vector_type(16)))float;
using u32x4=__attribute__((ext_vector_type(4)))unsigned;
constexpr int ASEQ=8448,D=64;
constexpr int QP=512,KP=512,VP=7424,OP=1024;
constexpr int NW=8,QBLK=32,QB=QBLK*NW,KVBLK=64,NQB=ASEQ/QB;
constexpr int ATTN_UNIT_ROWS=QB;
__device__ __forceinline__ int crow(int r,int hi){return (r&3)+8*(r>>2)+4*hi;}
#define SBAR() __builtin_amdgcn_sched_barrier(0)
constexpr int BT_OFF=383, BT_N=640;
__device__ __forceinline__ void bmask(f32x16&p0,f32x16&p1,int t,int q0,int wid,int r32,int hi,const __attribute__((address_space(3))) float*tab){
  const float NEG=-INFINITY; const int qw=q0+32*wid;
  if(t>(qw>>6)){
    #pragma unroll
    for(int r=0;r<16;++r){p0[r]=NEG;p1[r]=NEG;} return; }
  if(t>0 && 64*t+63+91<=qw) return;
  const int q=qw+r32, kb=64*t+4*hi;
  #pragma unroll
  for(int r=0;r<16;++r){ const int kv=kb+(r&3)+8*(r>>2); int i0=kv-q+BT_OFF, i1=i0+32; i0=i0<0?0:i0; i1=i1<0?0:i1;
    p0[r]+=tab[i0]; p1[r]+=tab[i1]; if(kv<48)p0[r]=NEG; if(kv+32<48)p1[r]=NEG; }
}

constexpr int NSLOT=3, SLOTB=8192;
constexpr int LDS_K=0, LDS_V=NSLOT*SLOTB, LDS_WS=2*NSLOT*SLOTB, LDS_OST=LDS_WS+NW*64*4, LDS_BT=LDS_OST+NW*4096, LDS_BYTES=LDS_BT+BT_N*4;
constexpr float C2=0.125f*1.4426950408889634f;
__device__ __forceinline__ void glds16(const void*gsrc,unsigned lds_dst){unsigned keep;
  asm volatile("s_mov_b32 %0, m0\n\ts_mov_b32 m0, %2\n\ts_nop 0\n\tglobal_load_lds_dwordx4 %1, off\n\ts_mov_b32 m0, %0":"=&s"(keep):"v"(gsrc),"s"(lds_dst):"memory");}
__device__ __forceinline__ float max3f(float a,float b,float c){float r;asm("v_max3_f32 %0, %1, %2, %3":"=v"(r):"v"(a),"v"(b),"v"(c));return r;}
__device__ __forceinline__ float max2f(float a,float b){float r;asm("v_max_f32_e32 %0, %1, %2":"=v"(r):"v"(a),"v"(b));return r;}
__device__ __forceinline__ float fadd_s(float a,float b){float r;asm("v_add_f32_e32 %0, %1, %2":"=v"(r):"v"(a),"v"(b));return r;}
__device__ __forceinline__ float fsub_s(float a,float b){float r;asm("v_sub_f32_e32 %0, %1, %2":"=v"(r):"v"(a),"v"(b));return r;}
typedef float f32x2_t __attribute__((ext_vector_type(2))); typedef __bf16 bf16x2_t __attribute__((ext_vector_type(2)));
__device__ __forceinline__ unsigned cvtpk_s(float lo,float hi){f32x2_t v={lo,hi};bf16x2_t b=__builtin_convertvector(v,bf16x2_t);return __builtin_bit_cast(unsigned,b);}
#define WAIT_BAR(N) asm volatile("s_waitcnt vmcnt(" #N ") lgkmcnt(0)\n\ts_barrier":::"memory")

__device__ __forceinline__ void qkt(f32x16&p0,f32x16&p1,const char*Kslot,const bf16x8*qr,const f32x16&negm,int r32,int hi){
  const char*kb=Kslot+hi*1024+r32*16;
  #pragma unroll
  for(int d0=0;d0<4;++d0){
    const bf16x8 b0=*reinterpret_cast<const bf16x8*>(kb+d0*2048);
    const bf16x8 b1=*reinterpret_cast<const bf16x8*>(kb+d0*2048+512);
    if(d0==0){p0=__builtin_amdgcn_mfma_f32_32x32x16_bf16(b0,qr[0],negm,0,0,0);p1=__builtin_amdgcn_mfma_f32_32x32x16_bf16(b1,qr[0],negm,0,0,0);}
    else{p0=__builtin_amdgcn_mfma_f32_32x32x16_bf16(b0,qr[d0],p0,0,0,0);p1=__builtin_amdgcn_mfma_f32_32x32x16_bf16(b1,qr[d0],p1,0,0,0);}}
}
typedef __attribute__((address_space(3))) const char* lds_cptr;
typedef __attribute__((address_space(3))) const float* lds_cfptr;
typedef short v4i16_t __attribute__((ext_vector_type(4)));
__device__ __forceinline__ void kload8(bf16x8*kf,lds_cptr kp){
  kf[0]=*(const __attribute__((address_space(3))) bf16x8*)(kp);      kf[1]=*(const __attribute__((address_space(3))) bf16x8*)(kp+512);
  kf[2]=*(const __attribute__((address_space(3))) bf16x8*)(kp+2048); kf[3]=*(const __attribute__((address_space(3))) bf16x8*)(kp+2560);
  kf[4]=*(const __attribute__((address_space(3))) bf16x8*)(kp+4096); kf[5]=*(const __attribute__((address_space(3))) bf16x8*)(kp+4608);
  kf[6]=*(const __attribute__((address_space(3))) bf16x8*)(kp+6144); kf[7]=*(const __attribute__((address_space(3))) bf16x8*)(kp+6656);
}
__device__ __forceinline__ void kload2(bf16x8*kf,lds_cptr kp,int j){ kf[2*j]=*(const __attribute__((address_space(3))) bf16x8*)(kp+j*2048); kf[2*j+1]=*(const __attribute__((address_space(3))) bf16x8*)(kp+j*2048+512); }
__device__ __forceinline__ s16x4 vtr(lds_cptr p){ return __builtin_bit_cast(s16x4,__builtin_amdgcn_ds_read_tr16_b64_v4i16((__attribute__((address_space(3))) v4i16_t*)p)); }
__device__ __forceinline__ float rowmax(const f32x16&p0,const f32x16&p1){
  float a=max3f(p0[0],p0[1],p1[0]),b=max3f(p0[2],p0[3],p1[1]);a=max3f(a,p1[2],p1[3]);
  #pragma unroll
  for(int r=4;r<16;r+=4){a=max3f(a,p0[r],p0[r+1]);b=max3f(b,p0[r+2],p0[r+3]);a=max3f(a,p1[r],p1[r+1]);b=max3f(b,p1[r+2],p1[r+3]);}
  const float m=max2f(a,b);
  auto rr=__builtin_amdgcn_permlane32_swap(__float_as_uint(m),__float_as_uint(m),false,false);
  return max2f(__uint_as_float(rr[0]),__uint_as_float(rr[1]));
}
__device__ __forceinline__ void pv(f32x16*o,int vb,bf16x8 pa0,bf16x8 pa1,bf16x8 pa2,bf16x8 pa3){
  #pragma unroll
  for(int d0=0;d0<2;++d0){s16x4 lo[4],hi[4];
    #pragma unroll
    for(int ks=0;ks<4;++ks){
      asm volatile("ds_read_b64_tr_b16 %0,%1 offset:%c2":"=&v"(lo[ks]):"v"(vb),"i"(d0*4096+ks*1024):"memory");
      asm volatile("ds_read_b64_tr_b16 %0,%1 offset:%c2":"=&v"(hi[ks]):"v"(vb),"i"(d0*4096+ks*1024+512):"memory");}
    asm volatile("s_waitcnt lgkmcnt(0)":::"memory");SBAR();
    #define PK(k) (bf16x8){lo[k][0],lo[k][1],lo[k][2],lo[k][3],hi[k][0],hi[k][1],hi[k][2],hi[k][3]}
    o[d0]=__builtin_amdgcn_mfma_f32_32x32x16_bf16(pa0,PK(0),o[d0],0,0,0);
    o[d0]=__builtin_amdgcn_mfma_f32_32x32x16_bf16(pa1,PK(1),o[d0],0,0,0);
    o[d0]=__builtin_amdgcn_mfma_f32_32x32x16_bf16(pa2,PK(2),o[d0],0,0,0);
    o[d0]=__builtin_amdgcn_mfma_f32_32x32x16_bf16(pa3,PK(3),o[d0],0,0,0);
    #undef PK
  }
}

#ifndef ATTN_STORE16
#define ATTN_STORE16(p,v) (*(u32x4*)(p)=(v))
#endif
template<int THRL> __device__ __forceinline__ void attn_unit(int b,int qoff,int voff,int ooff,int qb,const bf16*Q,const bf16*__restrict__ K,const bf16*__restrict__ V,bf16*O,char*shm){
  int tid_=threadIdx.x; asm volatile("":"+v"(tid_)); const int tid=tid_,lane=tid&63,r32=lane&31,hi=lane>>5; const int wid=__builtin_amdgcn_readfirstlane(tid>>6);
  const long rowbase=(long)b*ASEQ; const int q0=qb*QB;
  const bf16*Qw=Q+(rowbase+q0+wid*QBLK)*QP+qoff;
  const bf16*Kh=K+rowbase*KP+qoff,*Vh=V+rowbase*VP+voff;
  const unsigned lds0=(unsigned)(uintptr_t)shm;
  float*wsf=(float*)(shm+LDS_WS)+wid*64;
  const bf16*ksrc=Kh+(long)lane*KP+wid*8;
  const bf16*vsrc=Vh+(long)(16*(wid&3)+(lane>>2))*VP+(wid>>2)*32+(lane&3)*8;
  const unsigned kdst=lds0+LDS_K+wid*1024, vdst=lds0+LDS_V+wid*1024;
  #define DMA_K(t,slot) glds16(ksrc+(long)(t)*KVBLK*KP,(unsigned)__builtin_amdgcn_readfirstlane(kdst+(slot)))
  #define DMA_V(t,slot) glds16(vsrc+(long)(t)*KVBLK*VP,(unsigned)__builtin_amdgcn_readfirstlane(vdst+(slot)))
  const int vb0=(int)(lds0+LDS_V)+((lane>>4)&1)*32+(lane&3)*8+(4*hi+((lane&15)>>2))*64;
  const char*Kbase=shm+LDS_K; bf16x8 kf[8];
  const lds_cptr shm3=(lds_cptr)shm; const lds_cfptr btab=(lds_cfptr)(shm3+LDS_BT); const lds_cptr kp0=shm3+LDS_K+hi*1024+r32*16; const lds_cptr vp0=shm3+LDS_V+((lane>>4)&1)*32+(lane&3)*8+(4*hi+((lane&15)>>2))*64;
  const int NTL=(q0+QB)/KVBLK;
  DMA_K(0,0);DMA_V(0,0);DMA_K(1,SLOTB);
  bf16x8 qr[4];
  #pragma unroll
  for(int d0=0;d0<4;++d0)qr[d0]=*reinterpret_cast<const bf16x8*>(&Qw[(long)r32*QP+d0*16+hi*8]);
  float mhat=0.f,l_reg=0.f;f32x16 o[2];o[0]=f32x16{};o[1]=f32x16{};const f32x16 zt=f32x16{};
  const int qrel=wid*QBLK+r32;
  #define CMASK(P0,P1,t) bmask(P0,P1,(t),q0,wid,r32,hi,btab)
  bool resc=false;
  #define START(P0,P1) do{ const float rm=rowmax(P0,P1); resc=false; \
    { const float dl=rm; mhat=fadd_s(mhat,dl); \
      _Pragma("unroll") for(int r=0;r<16;++r){P0[r]=fsub_s(P0[r],dl);P1[r]=fsub_s(P1[r],dl);} \
      } \
    _Pragma("unroll") for(int r=0;r<16;++r)P0[r]=__builtin_amdgcn_exp2f(P0[r]); }while(0)
  #define RESC() do{ if(resc){ asm volatile("s_waitcnt lgkmcnt(0)":::"memory"); \
      _Pragma("unroll") for(int d_=0;d_<2;++d_) _Pragma("unroll") for(int r=0;r<16;++r)o[d_][r]*=wsf[crow(r,hi)]; } }while(0)
  f32x16 pA0,pA1,pB0,pB1;
  int sl_prev=0,sl_cur=0,sl_next=SLOTB;
  #define ROT() do{sl_prev=sl_cur;sl_cur=sl_next;sl_next=(sl_next==(NSLOT-1)*SLOTB)?0:sl_next+SLOTB;}while(0)
  DMA_K(2,2*SLOTB);
  WAIT_BAR(3);
  qkt(pA0,pA1,Kbase,qr,zt,r32,hi);asm volatile("s_nop 15\n\ts_nop 7":"+v"(pA0),"+v"(pA1));CMASK(pA0,pA1,0);
  START(pA0,pA1);
  _Pragma("unroll") for(int r=0;r<16;++r)pA1[r]=__builtin_amdgcn_exp2f(pA1[r]);
  WAIT_BAR(0);
  DMA_K(3,0);DMA_V(1,SLOTB);
  ROT();
  kload8(kf,kp0+sl_cur);
  WAIT_BAR(2);
  s16x4 vlo[8],vhi[8]; u32x4 pw0,pw1,pw2,pw3;
  #define PKW(P,B) cvtpk_s(P[B],P[B+1])
  #define PAF(k) __builtin_bit_cast(bf16x8,pw##k)
  #define VFR(i) (bf16x8){vlo[i][0],vlo[i][1],vlo[i][2],vlo[i][3],vhi[i][0],vhi[i][1],vhi[i][2],vhi[i][3]}
  #define PIN(x) asm volatile("":"+v"(x))
  #define MX3(a,b,c) __builtin_fmaxf(__builtin_fmaxf((a),(b)),(c))
  #define GAPA(MF,A0,A1,A2,A3,W0,W1,PW) do{ MF; sacc+=A0; sacc+=A1; sacc+=A2; sacc+=A3; PIN(sacc); W0; W1; PIN(PW); SBAR(); }while(0)
  #define EX(v) __builtin_amdgcn_exp2f(v)
  #define GAPB(MF,X,B) do{ MF; X[B]=EX(X[B]); X[B+1]=EX(X[B+1]); X[B+2]=EX(X[B+2]); X[B+3]=EX(X[B+3]); PIN(X); SBAR(); }while(0)
  #define VRD(i) do{ vlo[i]=vtr(vp_+(((i)>>2)*4096+((i)&3)*1024)); vhi[i]=vtr(vp_+(((i)>>2)*4096+((i)&3)*1024+512)); }while(0)
  #define KRD(G,j) do{ if(G){ kload2(kf,kp0+sl_next,j); SBAR(); } }while(0)
  #define STEP(C0,C1,P0,P1,t,GK,GV,GL) do{ SBAR(); \
    const lds_cptr vp_=vp0+sl_prev; \
    VRD(0); SBAR(); float sacc=(P0[0]+P0[1]); \
    GAPA(C0=__builtin_amdgcn_mfma_f32_32x32x16_bf16(kf[0],qr[0],zt,0,0,0), P0[2],P0[3],P0[4],P0[5],     pw0[0]=PKW(P0,0), pw0[1]=PKW(P0,2), pw0); \
    VRD(4); SBAR(); GAPA(C1=__builtin_amdgcn_mfma_f32_32x32x16_bf16(kf[1],qr[0],zt,0,0,0), P0[6],P0[7],P0[8],P0[9],     pw0[2]=PKW(P0,4), pw0[3]=PKW(P0,6), pw0); \
    VRD(1); SBAR(); GAPA(C0=__builtin_amdgcn_mfma_f32_32x32x16_bf16(kf[2],qr[1],C0,0,0,0),   P0[10],P0[11],P0[12],P0[13], pw1[0]=PKW(P0,8), pw1[1]=PKW(P0,10), pw1); \
    VRD(5); SBAR(); GAPA(C1=__builtin_amdgcn_mfma_f32_32x32x16_bf16(kf[3],qr[1],C1,0,0,0),   P0[14],P0[15],P1[0],P1[1],   pw1[2]=PKW(P0,12),pw1[3]=PKW(P0,14), pw1); \
    VRD(2); SBAR(); GAPA(C0=__builtin_amdgcn_mfma_f32_32x32x16_bf16(kf[4],qr[2],C0,0,0,0),   P1[2],P1[3],P1[4],P1[5],     pw2[0]=PKW(P1,0), pw2[1]=PKW(P1,2), pw2); \
    VRD(6); SBAR(); GAPA(C1=__builtin_amdgcn_mfma_f32_32x32x16_bf16(kf[5],qr[2],C1,0,0,0),   P1[6],P1[7],P1[8],P1[9],     pw2[2]=PKW(P1,4), pw2[3]=PKW(P1,6), pw2); \
    VRD(3); SBAR(); GAPA(C0=__builtin_amdgcn_mfma_f32_32x32x16_bf16(kf[6],qr[3],C0,0,0,0),   P1[10],P1[11],P1[12],P1[13], pw3[0]=PKW(P1,8), pw3[1]=PKW(P1,10), pw3); \
    VRD(7); SBAR(); GAPA(C1=__builtin_amdgcn_mfma_f32_32x32x16_bf16(kf[7],qr[3],C1,0,0,0),   P1[14],P1[15],0.f,0.f,       pw3[2]=PKW(P1,12),pw3[3]=PKW(P1,14), pw3); \
    l_reg+=sacc; \
    if(GK){DMA_K((t)+3,sl_cur);} if(GV){DMA_V((t)+1,sl_next);} \
    _Pragma("unroll") for(int r=0;r<16;++r){C0[r]-=mhat;C1[r]-=mhat;} \
    CMASK(C0,C1,t); \
    { float a=MX3(C0[0],C0[1],C1[0]),b=MX3(C0[2],C0[3],C1[1]); a=MX3(a,C1[2],C1[3]); \
      _Pragma("unroll") for(int r=4;r<16;r+=4){a=MX3(a,C0[r],C0[r+1]);b=MX3(b,C0[r+2],C0[r+3]);a=MX3(a,C1[r],C1[r+1]);b=MX3(b,C1[r+2],C1[r+3]);} \
      float rm=__builtin_fmaxf(a,b); { auto rr=__builtin_amdgcn_permlane32_swap(__float_as_uint(rm),__float_as_uint(rm),false,false); rm=__builtin_fmaxf(__uint_as_float(rr[0]),__uint_as_float(rr[1])); } \
      resc=false; \
      if(__builtin_expect(__any(rm>(float)THRL),0)){ const float dl=__builtin_fmaxf(rm,0.f); mhat+=dl; \
        _Pragma("unroll") for(int r=0;r<16;++r){C0[r]-=dl;C1[r]-=dl;} \
        const float f=__builtin_amdgcn_exp2f(-dl); l_reg*=f; if(hi==0)wsf[r32]=f; resc=true; } } \
    SBAR(); \
    GAPB(o[0]=__builtin_amdgcn_mfma_f32_32x32x16_bf16(PAF(0),VFR(0),o[0],0,0,0), C0,0); \
    GAPB(o[1]=__builtin_amdgcn_mfma_f32_32x32x16_bf16(PAF(0),VFR(4),o[1],0,0,0), C0,4); \
    KRD(GL,0); GAPB(o[0]=__builtin_amdgcn_mfma_f32_32x32x16_bf16(PAF(1),VFR(1),o[0],0,0,0), C0,8); \
    KRD(GL,1); GAPB(o[1]=__builtin_amdgcn_mfma_f32_32x32x16_bf16(PAF(1),VFR(5),o[1],0,0,0), C0,12); \
    KRD(GL,2); GAPB(o[0]=__builtin_amdgcn_mfma_f32_32x32x16_bf16(PAF(2),VFR(2),o[0],0,0,0), C1,0); \
    KRD(GL,3); GAPB(o[1]=__builtin_amdgcn_mfma_f32_32x32x16_bf16(PAF(2),VFR(6),o[1],0,0,0), C1,4); \
    GAPB(o[0]=__builtin_amdgcn_mfma_f32_32x32x16_bf16(PAF(3),VFR(3),o[0],0,0,0), C1,8); \
    GAPB(o[1]=__builtin_amdgcn_mfma_f32_32x32x16_bf16(PAF(3),VFR(7),o[1],0,0,0), C1,12); \
    }while(0)
  int t=1;
  #undef CMASK
  #define CMASK(P0,P1,t) do{}while(0)
  for(;t+7<NTL;t+=2){
    STEP(pB0,pB1,pA0,pA1,t,true,true,true);     WAIT_BAR(2); RESC(); ROT();
    STEP(pA0,pA1,pB0,pB1,t+1,true,true,true);   WAIT_BAR(2); RESC(); ROT();
  }
  #undef CMASK
  #define CMASK(P0,P1,t) bmask(P0,P1,(t),q0,wid,r32,hi,btab)
  #define ENDW(tt) do{ if((tt)+3<NTL){WAIT_BAR(2);} else if((tt)+2<NTL){WAIT_BAR(1);} else {WAIT_BAR(0);} }while(0)
  for(;t+1<NTL;t+=2){
    STEP(pB0,pB1,pA0,pA1,t,(t+3<NTL),(t+1<NTL),(t+1<NTL));       ENDW(t);   RESC(); ROT();
    STEP(pA0,pA1,pB0,pB1,t+1,(t+4<NTL),(t+2<NTL),(t+2<NTL));     ENDW(t+1); RESC(); ROT();
  }
  STEP(pB0,pB1,pA0,pA1,NTL-1,false,false,false); RESC();
  { float sacc=pB0[0]+pB0[1]; _Pragma("unroll") for(int r=2;r<16;++r)sacc+=pB0[r]; _Pragma("unroll") for(int r=0;r<16;++r)sacc+=pB1[r]; l_reg+=sacc;
    pw0=(u32x4){PKW(pB0,0),PKW(pB0,2),PKW(pB0,4),PKW(pB0,6)};pw1=(u32x4){PKW(pB0,8),PKW(pB0,10),PKW(pB0,12),PKW(pB0,14)};pw2=(u32x4){PKW(pB1,0),PKW(pB1,2),PKW(pB1,4),PKW(pB1,6)};pw3=(u32x4){PKW(pB1,8),PKW(pB1,10),PKW(pB1,12),PKW(pB1,14)};
    SBAR(); pv(o,vb0+sl_cur,PAF(0),PAF(1),PAF(2),PAF(3)); }
  #undef PKW
  #undef PAF
  #undef VFR
  #undef PIN
  #undef MX3
  #undef GAPA
  #undef GAPB
  #undef EX
  #undef VRD
  #undef KRD
  #undef STEP
  #undef ENDW
  {auto rr=__builtin_amdgcn_permlane32_swap(__float_as_uint(l_reg),__float_as_uint(l_reg),false,false);l_reg=__uint_as_float(rr[0])+__uint_as_float(rr[1]);}
  if(hi==0)wsf[32+r32]=l_reg;asm volatile("s_waitcnt lgkmcnt(0)":::"memory");
  float rli[16];
  #pragma unroll
  for(int r=0;r<16;++r)rli[r]=__builtin_amdgcn_rcpf(wsf[32+crow(r,hi)]);
  bf16*Ow=O+(rowbase+q0+wid*QBLK)*OP+ooff;
  { bf16*stg=(bf16*)(shm+LDS_OST)+wid*2048;
    #pragma unroll
    for(int r=0;r<16;++r){const int orow=crow(r,hi);
      #pragma unroll
      for(int d0=0;d0<2;++d0)stg[orow*64+d0*32+r32]=__float2bfloat16(o[d0][r]*rli[r]);}
    asm volatile("s_waitcnt lgkmcnt(0)":::"memory");
    #pragma unroll
    for(int i=0;i<4;++i){const int row=i*8+(lane>>3),ch=lane&7; const u32x4 v=*(const u32x4*)(stg+row*64+ch*8); ATTN_STORE16(Ow+(long)row*OP+ch*8,v);} }
  asm volatile("s_waitcnt lgkmcnt(0)\n\ts_barrier":::"memory");
  #undef DMA_K
  #undef DMA_V
  #undef CMASK
  #undef START
  #undef RESC
  #undef ROT
}
constexpr int ATTN_LDS_BYTES=LDS_BYTES;
#undef SBAR
#undef WAIT_BAR
#undef WAIT_BAR
}
namespace mk {
#define GAS __attribute__((address_space(1)))
#define LAS __attribute__((address_space(3)))
typedef unsigned short bf16;
typedef unsigned v4u __attribute__((ext_vector_type(4)));
typedef unsigned v2u __attribute__((ext_vector_type(2)));
typedef float f32x4 __attribute__((ext_vector_type(4)));
typedef float f32x16 __attribute__((ext_vector_type(16)));
typedef short bf16x8 __attribute__((ext_vector_type(8)));
typedef GAS unsigned gu32;
#define RLX_AGENT __ATOMIC_RELAXED, __HIP_MEMORY_SCOPE_AGENT
#define LDS_WAIT() asm volatile("s_waitcnt lgkmcnt(0)" ::: "memory")
#define VM_WAIT() asm volatile("s_waitcnt vmcnt(0)" ::: "memory")
__device__ __forceinline__ unsigned f2bf(float f) { unsigned u = __builtin_bit_cast(unsigned, f); return (u + 0x7fffu + ((u >> 16) & 1u)) >> 16; }
__device__ __forceinline__ unsigned pk2(float lo, float hi) { return f2bf(lo) | (f2bf(hi) << 16); }
__device__ __forceinline__ float bf2f(unsigned short b) { return __builtin_bit_cast(float, ((unsigned)b) << 16); }
__device__ __forceinline__ float bflo(unsigned w) { return __builtin_bit_cast(float, w << 16); }
__device__ __forceinline__ float bfhi(unsigned w) { return __builtin_bit_cast(float, w & 0xffff0000u); }

constexpr int NWAVES = 8, NTHR = NWAVES * 64;
constexpr int PADF = 48;
constexpr int LPP = 8448;
constexpr int PEND = PADF + LP;
constexpr int SROW0 = BATCH * LPP;
constexpr int RP = SROW0 + NS;
constexpr int ZN = 7424;
constexpr int ZC_QA = 0, ZC_KA = 512, ZC_VA = 1024, ZC_QKVB = 1536, ZC_GB = 3072, ZC_UC = 3584, ZC_GATE = 4096, ZC_BA = 7168;
static_assert(RP % 256 == 0 && ZN % 256 == 0 && D_MODEL == 1024 && WIDTH_A == 512 && WIDTH_B == 512 && WIDTH_C == 512, "shapes");
__host__ __device__ __forceinline__ int nat2prow(int row) { return row < NP ? (row / LP) * LPP + PADF + row % LP : SROW0 + (row - NP); }
__host__ __device__ __forceinline__ int zcol(int col) { return col < 3584 ? col : (col < 3592 ? ZC_BA + (col - 3584) : col - 8); }
__device__ __forceinline__ bool prow_valid(int prow) { if (prow >= SROW0) return true; const int p = prow % LPP; return p >= PADF && p < PEND; }
__device__ __forceinline__ int prow2nat(int prow) { if (prow >= SROW0) return NP + (prow - SROW0); return (prow / LPP) * LP + (prow % LPP) - PADF; }

constexpr int RING_OFF = 0, RING_BYTES = 131072;
constexpr int LDSCTL_OFF = RING_BYTES, MISC_OFF = LDSCTL_OFF + 320;
constexpr int LDS_BYTES = 147456;
static_assert(MISC_OFF + 128 <= LDS_BYTES, "LDS map");

constexpr size_t CTL_BYTES = 1u << 20;
constexpr int CW_TMO = 0, CW_CODE = 1;
constexpr int CW_BAR = 4096;
constexpr int CW_QUEUE = 16384;

#define XB_TMO      128
#define XB_XCNT(j)  (256  + 64 * (j))
#define XB_XSUB(j)  (1280 + 64 * (j))
#define XB_XGEN(j)  (2304 + 64 * (j))
#define XB_TOP      3328
#define XB_TOPGEN   3392
#define XCD_BAR_WORDS 3456
#define XB_SPIN_CAP (1u << 18)

__device__ __forceinline__ unsigned xb_ld(unsigned* p)              { return __hip_atomic_load(p, __ATOMIC_RELAXED, __HIP_MEMORY_SCOPE_AGENT); }
__device__ __forceinline__ unsigned xb_add(unsigned* p, unsigned v) { return __hip_atomic_fetch_add(p, v, __ATOMIC_RELAXED, __HIP_MEMORY_SCOPE_AGENT); }
__device__ __forceinline__ unsigned xb_xcc_id() { return (unsigned)__builtin_amdgcn_s_getreg((3 << 11) | 20) & 0xFu; }
#define XB_SPIN(cond, bar) do { unsigned _sp = 0; while (cond) { __builtin_amdgcn_s_sleep(1); \
    if ((++_sp & 255u) == 0u) { if (xb_ld(&(bar)[XB_TMO])) break; if (_sp > XB_SPIN_CAP) { atomicAdd(&(bar)[XB_TMO], 1u); break; } } } } while (0)

struct XcdBarrier {
    unsigned* bar; unsigned x;
    volatile LAS unsigned* st;
};

__device__ __forceinline__ XcdBarrier xcd_barrier_post(unsigned* bar, volatile LAS unsigned* st) {
    XcdBarrier b; b.bar = bar; b.x = xb_xcc_id(); b.st = st;
    if (threadIdx.x == 0) (void)xb_add(&bar[XB_XCNT(b.x)], 1u);
    return b;
}
__device__ __forceinline__ void xcd_barrier_complete(unsigned* bar, unsigned x, unsigned& nloc, unsigned& nx) {
    const unsigned G = gridDim.x * gridDim.y * gridDim.z;
    unsigned sum, cnt, mine, sp = 0u;
    for (;;) {
        sum = 0u; cnt = 0u; mine = 0u;
#pragma unroll
        for (unsigned j = 0; j < 16; ++j) { const unsigned c = xb_ld(&bar[XB_XCNT(j)]); sum += c; cnt += (c > 0u) ? 1u : 0u; mine = (j == x) ? c : mine; }
        if (sum == G) break;
        __builtin_amdgcn_s_sleep(1);
        if ((++sp & 255u) == 0u) { if (xb_ld(&bar[XB_TMO])) break; if (sp > XB_SPIN_CAP) { atomicAdd(&bar[XB_TMO], 1u); break; } }
    }
    nloc = mine > 0u ? mine : 1u; nx = cnt > 0u ? cnt : 1u;
}

__device__ __forceinline__ void xcd_barrier(const XcdBarrier& b) {
    asm volatile("s_waitcnt vmcnt(0)" ::: "memory");
    __syncthreads();
    if (threadIdx.x == 0) {
        unsigned* bar = b.bar;
        __builtin_amdgcn_s_waitcnt(0);
        unsigned nloc = b.st[0], nx = b.st[1];
        if (nloc == 0u) { xcd_barrier_complete(bar, b.x, nloc, nx); b.st[0] = nloc; b.st[1] = nx; }
        const unsigned old = xb_add(&bar[XB_XSUB(b.x)], 1u);
        const unsigned gen = old / nloc;
        if (old + 1u == (gen + 1u) * nloc) {
            __builtin_amdgcn_fence(__ATOMIC_RELEASE, "agent");
            asm volatile("s_waitcnt vmcnt(0)" ::: "memory");
            const unsigned og = xb_add(&bar[XB_TOP], 1u);
            const unsigned tg = og / nx;
            if (og + 1u == (tg + 1u) * nx) xb_add(&bar[XB_TOPGEN], 1u);
            else XB_SPIN(xb_ld(&bar[XB_TOPGEN]) == tg, bar);
            __builtin_amdgcn_fence(__ATOMIC_ACQUIRE, "agent");
            xb_add(&bar[XB_XGEN(b.x)], 1u);
            asm volatile("s_waitcnt vmcnt(0)" ::: "memory");
        } else {
            XB_SPIN(xb_ld(&bar[XB_XGEN(b.x)]) == gen, bar);
            __builtin_amdgcn_fence(__ATOMIC_ACQUIRE, "agent");
            asm volatile("s_waitcnt vmcnt(0)" ::: "memory");
        }
    }
    __syncthreads();
}


__device__ __forceinline__ float wave_sum(float v) {
#pragma unroll
    for (int o = 1; o < 64; o <<= 1) v += __shfl_xor(v, o);
    return v;
}
}
namespace mk {
enum Region { R_X, R_XN, R_WIN, R_Z, R_QN, R_KN, R_QKVB, R_BG, R_O, R_OA, R_OB, R_YC, R_OC, R_MRG, R_WGLU, R_WBR, R_WOUT, R_WQS, R_PU, R_PV, R_SC, R_GDN, R_S5T, R_MISC, R_S5E, R_S5X, R_MRGB, R_NREG };
constexpr int NPL = 16;
enum Phase { PH_PRO = 0, PL_NORM1 = 0, PL_GEMM_IN = 1, PL_ZPOST = 2, PL_LOCAL = 3, PL_MIX = 4, PL_MIXPOST = 5, PL_GEMM_GLU = 6, PL_GEMM_BRA = 7, PL_GEMM_BRB = 8, PL_GEMM_BRC = 9,
             PL_GEMM_OUT = 10, PL_NORM2 = 11, PL_GEMM_PEER = 12, PL_PEER = 13, PH_FINAL = 1 + DEPTH * NPL, PH_END = PH_FINAL + 1 };
enum ProMask { PM_X = 1, PM_WIN = 2, PM_WREST = 4, PM_PEERW = 8, PM_WQS = 16, PM_TABLES = 32 };
struct Args {
    const float* in[40];
    float* out;
    unsigned char* ws;
    unsigned long long off[32];
    int ph_lo, ph_hi, pro_mask, bar_region;
};
static_assert(sizeof(Args) == 40 * 8 + 8 + 8 + 32 * 8 + 16, "Args has no padding");

typedef const __attribute__((address_space(4))) Args* KArgs;
__device__ __forceinline__ KArgs kargs() { KArgs p = (KArgs)__builtin_amdgcn_kernarg_segment_ptr(); asm volatile("" : "+s"(p)); return p; }
#define WS_OPAQUE(a) unsigned char* wsb = (a).ws; asm volatile("" : "+s"(wsb))
__device__ __forceinline__ int otid() { int t = threadIdx.x; asm volatile("" : "+v"(t)); return t; }
struct Frame {
    LAS unsigned char* lds; volatile LAS unsigned* MISC; gu32* ctl;
    int vcu, G;
};

template <class CM> __device__ __forceinline__ void transpose_item(const float* W, int ld, int K, bf16* WT, int n0, int k0, const CM& cm, LAS float* scr, int lane) {
    const int sc = cm(n0 + (lane & 31));
#pragma unroll 8
    for (int i = 0; i < 32; ++i) { const int kk = 2 * i + (lane >> 5); scr[kk * 33 + (lane & 31)] = sc >= 0 ? W[(size_t)(k0 + kk) * ld + sc] : 0.f; }
    LDS_WAIT(); asm volatile("" ::: "memory");
    const int c = lane & 7;
#pragma unroll
    for (int j = 0; j < 4; ++j) { const int n = (lane >> 3) + 8 * j; const LAS float* s = scr + (8 * c) * 33 + n;
        v4u o; o.x = pk2(s[0 * 33], s[1 * 33]); o.y = pk2(s[2 * 33], s[3 * 33]); o.z = pk2(s[4 * 33], s[5 * 33]); o.w = pk2(s[6 * 33], s[7 * 33]);
        *(GAS v4u*)(WT + (size_t)(n0 + n) * K + k0 + 8 * c) = o; }
    LDS_WAIT(); asm volatile("" ::: "memory");
}
struct CmWin { __device__ __forceinline__ int operator()(int n) const { return n < 3584 ? n : (n < 7168 ? n + 8 : (n < 7176 ? 3584 + (n - 7168) : -1)); } };
struct CmId { __device__ __forceinline__ int operator()(int n) const { return n; } };
struct CmGlu { __device__ __forceinline__ int operator()(int n) const { const int G = n >> 5, i = n & 31; return i < 16 ? 16 * G + i : 512 + 16 * G + (i - 16); } };

__device__ __forceinline__ void rms_row_to_bf16(const float* xrow, const float* g, bf16* orow, int lane) {
    const GAS f32x4* xr = (const GAS f32x4*)xrow + lane;
    f32x4 v[4]; float s2 = 0.f;
#pragma unroll
    for (int j = 0; j < 4; ++j) { v[j] = xr[64 * j]; s2 += (v[j].x * v[j].x + v[j].y * v[j].y) + (v[j].z * v[j].z + v[j].w * v[j].w); }
    const float r = 1.f / sqrtf(wave_sum(s2) * (1.f / D_MODEL) + EPSF);
    const GAS f32x4* gr = (const GAS f32x4*)g + lane;
    GAS unsigned long long* o8 = (GAS unsigned long long*)orow + lane;
#pragma unroll
    for (int j = 0; j < 4; ++j) { const f32x4 gg = gr[64 * j];
        o8[64 * j] = (unsigned long long)pk2(v[j].x * r * gg.x, v[j].y * r * gg.y) | ((unsigned long long)pk2(v[j].z * r * gg.z, v[j].w * r * gg.w) << 32); }
}

__device__ __forceinline__ void p_norm(Frame& F, int l, int gi) {
    const KArgs ap = kargs(); const auto& a = *ap; WS_OPAQUE(a);
    const int tid = otid(), lane = tid & 63, wave = __builtin_amdgcn_readfirstlane(tid >> 6);
    const float* X = (const float*)(wsb + a.off[R_X]); bf16* XN = (bf16*)(wsb + a.off[R_XN]); const float* g = a.in[gi] + (size_t)l * D_MODEL;
    const int gw = F.vcu * NWAVES + wave, NGW = F.G * NWAVES;
    for (int m = gw; m < RP; m += NGW) rms_row_to_bf16(X + (size_t)m * D_MODEL, g, XN + (size_t)m * D_MODEL, lane);
}
__device__ __forceinline__ void unpack8(const v4u w, float (&f)[8]) { f[0] = bflo(w.x); f[1] = bfhi(w.x); f[2] = bflo(w.y); f[3] = bfhi(w.y); f[4] = bflo(w.z); f[5] = bfhi(w.z); f[6] = bflo(w.w); f[7] = bfhi(w.w); }
__device__ __forceinline__ v4u pack8(const float (&f)[8]) { v4u w; w.x = pk2(f[0], f[1]); w.y = pk2(f[2], f[3]); w.z = pk2(f[4], f[5]); w.w = pk2(f[6], f[7]); return w; }
__device__ __forceinline__ float sigm(float x) { return 1.f / (1.f + __expf(-x)); }
constexpr float ATT_C2 = 0.125f * 1.4426950408889634f;
__device__ __forceinline__ void p_zpost(Frame& F, int l) {
    const KArgs ap = kargs(); const auto& a = *ap; WS_OPAQUE(a);
    const bf16* Z = (const bf16*)(wsb + a.off[R_Z]);
    bf16* QN = (bf16*)(wsb + a.off[R_QN]); bf16* KN = (bf16*)(wsb + a.off[R_KN]); bf16* QKVB = (bf16*)(wsb + a.off[R_QKVB]); float* BG = (float*)(wsb + a.off[R_BG]);
    const int tid = otid(), lane = tid & 63, wave = __builtin_amdgcn_readfirstlane(tid >> 6);
    const int gw = F.vcu * NWAVES + wave, NGW = F.G * NWAVES;
    float gq[8], gk[8], cw[3][4][8];
#pragma unroll
    for (int j = 0; j < 8; ++j) { gq[j] = a.in[I_QN][l * HEAD_DIM_A + 8 * (lane & 7) + j] * ATT_C2; gk[j] = a.in[I_KN][l * HEAD_DIM_A + 8 * (lane & 7) + j]; }
#pragma unroll
    for (int w = 0; w < 3; ++w)
#pragma unroll
        for (int i = 0; i < 4; ++i)
#pragma unroll
            for (int j = 0; j < 8; ++j) cw[w][i][j] = a.in[I_CONVW][((size_t)l * CONV_W + i) * 3 * WIDTH_B + w * WIDTH_B + 8 * lane + j];
    float alog = 0.f, dtb = 0.f; if (lane < 4) { alog = a.in[I_ALOG][l * N_HEADS_B + lane]; dtb = a.in[I_DTB][l * N_HEADS_B + lane]; }
    for (int m = gw; m < RP; m += NGW) {
        const bool valid = prow_valid(m); const int nat = valid ? prow2nat(m) : 0;
        const bf16* zr = Z + (size_t)m * ZN;
        float f[8], o[8];
        unpack8(*(const GAS v4u*)(zr + ZC_QA + 8 * lane), f);
        { float ss = 0.f;
#pragma unroll
          for (int j = 0; j < 8; ++j) ss += f[j] * f[j];
          ss += __shfl_xor(ss, 1); ss += __shfl_xor(ss, 2); ss += __shfl_xor(ss, 4);
          const float r = 1.f / sqrtf(ss * (1.f / HEAD_DIM_A) + EPSF);
#pragma unroll
          for (int j = 0; j < 8; ++j) o[j] = f[j] * r * gq[j];
          *(GAS v4u*)(QN + (size_t)m * WIDTH_A + 8 * lane) = pack8(o); }
        unpack8(*(const GAS v4u*)(zr + ZC_KA + 8 * lane), f);
        { float ss = 0.f;
#pragma unroll
          for (int j = 0; j < 8; ++j) ss += f[j] * f[j];
          ss += __shfl_xor(ss, 1); ss += __shfl_xor(ss, 2); ss += __shfl_xor(ss, 4);
          const float r = 1.f / sqrtf(ss * (1.f / HEAD_DIM_A) + EPSF);
#pragma unroll
          for (int j = 0; j < 8; ++j) o[j] = f[j] * r * gk[j];
          *(GAS v4u*)(KN + (size_t)m * WIDTH_A + 8 * lane) = pack8(o);
          if (valid) { float* ko = nat < NP ? a.out + O_KP + ((size_t)l * NP + nat) * WIDTH_A : a.out + O_KS + ((size_t)l * NS + (nat - NP)) * WIDTH_A;
              *(GAS f32x4*)(ko + 8 * lane) = (f32x4){o[0], o[1], o[2], o[3]}; *(GAS f32x4*)(ko + 8 * lane + 4) = (f32x4){o[4], o[5], o[6], o[7]}; } }
        if (valid) { unpack8(*(const GAS v4u*)(zr + ZC_VA + 8 * lane), f);
            float* vo = nat < NP ? a.out + O_VP + ((size_t)l * NP + nat) * WIDTH_A : a.out + O_VS + ((size_t)l * NS + (nat - NP)) * WIDTH_A;
            *(GAS f32x4*)(vo + 8 * lane) = (f32x4){f[0], f[1], f[2], f[3]}; *(GAS f32x4*)(vo + 8 * lane + 4) = (f32x4){f[4], f[5], f[6], f[7]}; }
        const int ts = m >= SROW0 ? (m - SROW0) % DEC_SEQ : 1000; const int bs = m >= SROW0 ? (m - SROW0) / DEC_SEQ : 0;
        int cj = -1;
        if (m >= SROW0) { if (ts >= DEC_SEQ - 3) cj = ts - (DEC_SEQ - 3); } else { const int p = m % LPP; if (p >= PEND - 3 && p < PEND) cj = p - (PEND - 3); }
#pragma unroll
        for (int w = 0; w < 3; ++w) {
            float acc[8];
#pragma unroll
            for (int j = 0; j < 8; ++j) acc[j] = 0.f;
#pragma unroll
            for (int i = 0; i < 4; ++i) {
                const int dt = i - 3;
                if (ts + dt < 0) {
                    const float* sc = a.in[I_SCONV] + (((size_t)l * DEC_BATCH + bs) * (CONV_W - 1) + (CONV_W - 1 + ts + dt)) * 3 * WIDTH_B + w * WIDTH_B + 8 * lane;
                    const f32x4 s0 = *(const GAS f32x4*)sc, s1 = *(const GAS f32x4*)(sc + 4);
                    f[0] = s0.x; f[1] = s0.y; f[2] = s0.z; f[3] = s0.w; f[4] = s1.x; f[5] = s1.y; f[6] = s1.z; f[7] = s1.w;
                } else if (m + dt >= 0) unpack8(*(const GAS v4u*)(Z + (size_t)(m + dt) * ZN + ZC_QKVB + w * WIDTH_B + 8 * lane), f);
                else {
#pragma unroll
                    for (int j = 0; j < 8; ++j) f[j] = 0.f; }
#pragma unroll
                for (int j = 0; j < 8; ++j) acc[j] += f[j] * cw[w][i][j];
                if (i == 3 && cj >= 0) {
                    float* co = m >= SROW0 ? a.out + O_CS + (((size_t)l * DEC_BATCH + bs) * (CONV_W - 1) + cj) * 3 * WIDTH_B : a.out + O_CP + (((size_t)l * BATCH + m / LPP) * (CONV_W - 1) + cj) * 3 * WIDTH_B;
                    *(GAS f32x4*)(co + w * WIDTH_B + 8 * lane) = (f32x4){f[0], f[1], f[2], f[3]}; *(GAS f32x4*)(co + w * WIDTH_B + 8 * lane + 4) = (f32x4){f[4], f[5], f[6], f[7]}; }
            }
            float ss = 0.f;
#pragma unroll
            for (int j = 0; j < 8; ++j) { acc[j] = acc[j] * sigm(acc[j]); ss += acc[j] * acc[j]; }
            float sc = 1.f;
            if (w < 2) { ss += __shfl_xor(ss, 1); ss += __shfl_xor(ss, 2); ss += __shfl_xor(ss, 4); ss += __shfl_xor(ss, 8);
                sc = 1.f / sqrtf(ss + EPSF); if (w == 0) sc *= 0.08838834764831845f; }
#pragma unroll
            for (int j = 0; j < 8; ++j) o[j] = acc[j] * sc;
            *(GAS v4u*)(QKVB + (size_t)m * 3 * WIDTH_B + w * WIDTH_B + 8 * lane) = pack8(o);
        }
        if (lane < 4) { const float be = bf2f(zr[ZC_BA + lane]), al = bf2f(zr[ZC_BA + 4 + lane]) + dtb;
            const float sp = al > 20.f ? al : __logf(1.f + __expf(al));
            BG[(size_t)m * 8 + lane] = valid ? sigm(be) : 0.f; BG[(size_t)m * 8 + 4 + lane] = valid ? -__expf(alog) * sp : 0.f; }
    }
}
constexpr float LOG2E = 1.4426950408889634f;
__device__ __forceinline__ int t5_bucket_dev(int rel) {
    const int n = rel < 0 ? -rel : rel; int b;
    if (n < 8) b = n; else if (n < 12) b = 8; else if (n < 16) b = 9; else if (n < 23) b = 10; else if (n < 32) b = 11;
    else if (n < 46) b = 12; else if (n < 64) b = 13; else if (n < 91) b = 14; else b = 15;
    return b + (rel > 0 ? 16 : 0);
}
__device__ __forceinline__ void build_bias_table(LAS float* tab, const float* rel_bias, int h, int tid) {
    const float far = rel_bias[15 * N_HEADS_A + h];
    for (int i = tid; i < attn_body::BT_N; i += NTHR) tab[i] = (rel_bias[t5_bucket_dev(i - attn_body::BT_OFF) * N_HEADS_A + h] - far) * LOG2E;
}
__device__ __forceinline__ float lam_init_dev(int l) { return 0.8f - 0.6f * __expf(-0.3f * (float)l); }
__device__ __forceinline__ float lam_dev(const float* lqk_all, int l, int lane) {
    const float* q = lqk_all + (size_t)l * 4 * HEAD_DIM_A;
    const float s0 = wave_sum(q[lane] * q[HEAD_DIM_A + lane]), s1 = wave_sum(q[2 * HEAD_DIM_A + lane] * q[3 * HEAD_DIM_A + lane]);
    return __expf(s0) - __expf(s1) + lam_init_dev(l);
}
__device__ __forceinline__ int krow_dev(int s, int h, int j) { return 16 * s + 8 * (j >> 2) + 4 * h + (j & 3); }
__device__ __forceinline__ int crow_dev(int r, int h) { return (r & 3) + 8 * (r >> 2) + 4 * h; }
__device__ __forceinline__ bf16x8 pack_f8(const f32x4 a, const f32x4 b) { v4u w; w.x = pk2(a.x, a.y); w.y = pk2(a.z, a.w); w.z = pk2(b.x, b.y); w.w = pk2(b.z, b.w); return __builtin_bit_cast(bf16x8, w); }

__device__ __forceinline__ void sample_scores(f32x16& X, int kb, int c, const float* ck, const bf16* KN, int row0, int h, int hi, int r32, int qpos, const bf16x8 (&qf)[4], const LAS float* tab) {
    bf16x8 kf[4];
    if (kb < PAST_LEN / 32) { const float* kr = ck + (size_t)(kb * 32 + r32) * WIDTH_A + h * 128 + c * 64 + 8 * hi;
#pragma unroll
        for (int s = 0; s < 4; ++s) kf[s] = pack_f8(*(const GAS f32x4*)(kr + 16 * s), *(const GAS f32x4*)(kr + 16 * s + 4)); }
    else { const bf16* kr = KN + (size_t)(row0 + (kb * 32 - PAST_LEN) + r32) * WIDTH_A + h * 128 + c * 64 + 8 * hi;
#pragma unroll
        for (int s = 0; s < 4; ++s) kf[s] = *(const GAS bf16x8*)(kr + 16 * s); }
#pragma unroll
    for (int i = 0; i < 16; ++i) X[i] = 0.f;
#pragma unroll
    for (int s = 0; s < 4; ++s) X = __builtin_amdgcn_mfma_f32_32x32x16_bf16(kf[s], qf[s], X, 0, 0, 0);
#pragma unroll
    for (int i = 0; i < 16; ++i) { int idx = kb * 32 + crow_dev(i, hi) - qpos + attn_body::BT_OFF; idx = idx < 0 ? 0 : idx; X[i] += tab[idx]; }
}

__device__ __forceinline__ void attn_sample_unit(Frame& F, int l, int bs, int h) {
    const KArgs ap = kargs(); const auto& a = *ap; WS_OPAQUE(a);
    const int tid = otid(), lane = tid & 63, wid = __builtin_amdgcn_readfirstlane(tid >> 6), r32 = lane & 31, hi = lane >> 5;
    const bf16* QN = (const bf16*)(wsb + a.off[R_QN]); const bf16* KN = (const bf16*)(wsb + a.off[R_KN]); const bf16* Z = (const bf16*)(wsb + a.off[R_Z]); bf16* O = (bf16*)(wsb + a.off[R_O]);
    const float* ck = a.in[I_CK] + ((size_t)l * DEC_BATCH + bs) * PAST_LEN * WIDTH_A; const float* cv = a.in[I_CV] + ((size_t)l * DEC_BATCH + bs) * PAST_LEN * WIDTH_A;
    const int row0 = SROW0 + bs * DEC_SEQ;
    LAS float* tab = (LAS float*)(F.lds + RING_OFF + attn_body::LDS_BT);
    LAS float* st = (LAS float*)(F.lds + RING_OFF + 90112);
    LAS float* slot = (LAS float*)(F.lds + RING_OFF);
    const float lam = lam_dev(a.in[I_LQK], l, lane);
    build_bias_table(tab, a.in[I_REL], h, tid);
    bf16x8 qf[2][4];
#pragma unroll
    for (int c = 0; c < 2; ++c)
#pragma unroll
        for (int s = 0; s < 4; ++s) qf[c][s] = *(const GAS bf16x8*)(QN + (size_t)(row0 + r32) * WIDTH_A + h * 128 + c * 64 + 16 * s + 8 * hi);
    __syncthreads();
    float m[2] = {-1e30f, -1e30f}, lsum[2] = {0.f, 0.f};
    const int qpos = PAST_LEN + r32;
    for (int kb = wid; kb < (PAST_LEN + DEC_SEQ) / 32; kb += NWAVES) {
#pragma unroll
        for (int c = 0; c < 2; ++c) { f32x16 X; sample_scores(X, kb, c, ck, KN, row0, h, hi, r32, qpos, qf[c], tab);
            float mx = X[0];
#pragma unroll
            for (int i = 1; i < 16; ++i) mx = fmaxf(mx, X[i]);
            mx = fmaxf(mx, __shfl_xor(mx, 32)); const float mn = fmaxf(m[c], mx);
            float sum = 0.f;
#pragma unroll
            for (int i = 0; i < 16; ++i) sum += exp2f(X[i] - mn);
            lsum[c] = lsum[c] * exp2f(m[c] - mn) + sum; m[c] = mn; }
    }
#pragma unroll
    for (int c = 0; c < 2; ++c) { lsum[c] += __shfl_xor(lsum[c], 32); if (hi == 0) { st[((wid * 2 + c) * 2 + 0) * 32 + r32] = m[c]; st[((wid * 2 + c) * 2 + 1) * 32 + r32] = lsum[c]; } }
    __syncthreads();
    float gm[2], ginv[2];
#pragma unroll
    for (int c = 0; c < 2; ++c) { float mm = -1e30f;
#pragma unroll
        for (int w = 0; w < NWAVES; ++w) mm = fmaxf(mm, st[((w * 2 + c) * 2 + 0) * 32 + r32]);
        float ll = 0.f;
#pragma unroll
        for (int w = 0; w < NWAVES; ++w) ll += st[((w * 2 + c) * 2 + 1) * 32 + r32] * exp2f(st[((w * 2 + c) * 2 + 0) * 32 + r32] - mm);
        gm[c] = mm; ginv[c] = (c == 0 ? 1.f : lam) / ll; }
    f32x16 acc[4];
#pragma unroll
    for (int eb = 0; eb < 4; ++eb)
#pragma unroll
        for (int i = 0; i < 16; ++i) acc[eb][i] = 0.f;
    for (int kb = wid; kb < (PAST_LEN + DEC_SEQ) / 32; kb += NWAVES) {
        f32x16 X0, X1; sample_scores(X0, kb, 0, ck, KN, row0, h, hi, r32, qpos, qf[0], tab); sample_scores(X1, kb, 1, ck, KN, row0, h, hi, r32, qpos, qf[1], tab);
        float wv[16];
#pragma unroll
        for (int i = 0; i < 16; ++i) wv[i] = exp2f(X0[i] - gm[0]) * ginv[0] - exp2f(X1[i] - gm[1]) * ginv[1];
        bf16x8 xs[2];
#pragma unroll
        for (int s = 0; s < 2; ++s) { v4u w; w.x = pk2(wv[8 * s], wv[8 * s + 1]); w.y = pk2(wv[8 * s + 2], wv[8 * s + 3]); w.z = pk2(wv[8 * s + 4], wv[8 * s + 5]); w.w = pk2(wv[8 * s + 6], wv[8 * s + 7]); xs[s] = __builtin_bit_cast(bf16x8, w); }
#pragma unroll
        for (int eb = 0; eb < 4; ++eb)
#pragma unroll
            for (int s = 0; s < 2; ++s) {
                float vv[8];
                if (kb < PAST_LEN / 32) { const float* vb = cv + (size_t)(kb * 32 + 4 * hi) * WIDTH_A + h * 128 + eb * 32 + r32; asm volatile("" : "+v"(vb));
#pragma unroll
                    for (int j = 0; j < 8; ++j) vv[j] = vb[(size_t)(16 * s + 8 * (j >> 2) + (j & 3)) * WIDTH_A]; }
                else { const bf16* vb = Z + (size_t)(row0 + kb * 32 - PAST_LEN + 4 * hi) * ZN + ZC_VA + h * 128 + eb * 32 + r32; asm volatile("" : "+v"(vb));
#pragma unroll
                    for (int j = 0; j < 8; ++j) vv[j] = bf2f(vb[(size_t)(16 * s + 8 * (j >> 2) + (j & 3)) * ZN]); }
                v4u w; w.x = pk2(vv[0], vv[1]); w.y = pk2(vv[2], vv[3]); w.z = pk2(vv[4], vv[5]); w.w = pk2(vv[6], vv[7]);
                acc[eb] = __builtin_amdgcn_mfma_f32_32x32x16_bf16(xs[s], __builtin_bit_cast(bf16x8, w), acc[eb], 0, 0, 0);
            }
    }
    __syncthreads();
#pragma unroll
    for (int eb = 0; eb < 4; ++eb)
#pragma unroll
        for (int i = 0; i < 16; ++i) slot[(wid * 32 + crow_dev(i, hi)) * 128 + eb * 32 + r32] = acc[eb][i];
    __syncthreads();
    { const int q = tid >> 4, e0 = (tid & 15) * 8; float o[8];
#pragma unroll
      for (int j = 0; j < 8; ++j) o[j] = 0.f;
#pragma unroll
      for (int w = 0; w < NWAVES; ++w)
#pragma unroll
          for (int j = 0; j < 8; ++j) o[j] += slot[(w * 32 + q) * 128 + e0 + j];
      v4u pw; pw.x = pk2(o[0], o[1]); pw.y = pk2(o[2], o[3]); pw.z = pk2(o[4], o[5]); pw.w = pk2(o[6], o[7]);
      bf16* orow = O + (size_t)(row0 + q) * attn_body::OP + h * 256;
      unsigned zq = 0u; asm volatile("" : "+v"(zq));
      *(GAS v4u*)(orow + e0) = pw; *(GAS v4u*)(orow + 128 + e0) = (v4u){zq, zq, zq, zq}; }
    __syncthreads();
}

constexpr int ATT_NQB = LPP / 256;
constexpr int ATT_NPU = BATCH * 16 * ATT_NQB;
constexpr int ATT_NSU = DEC_BATCH * N_HEADS_A;
__device__ __forceinline__ void p_attention(Frame& F, int l, unsigned char* ldsg) {
    for (;;) {
        const KArgs ap = kargs(); const auto& a = *ap; WS_OPAQUE(a);
        const int tid = otid();
        gu32* head = (gu32*)wsb + CW_QUEUE + 64 * l;
        const attn_body::bf16* QN = (const attn_body::bf16*)(wsb + a.off[R_QN]); const attn_body::bf16* KN = (const attn_body::bf16*)(wsb + a.off[R_KN]);
        const attn_body::bf16* Z = (const attn_body::bf16*)(wsb + a.off[R_Z]); attn_body::bf16* O = (attn_body::bf16*)(wsb + a.off[R_O]);
        if (tid == 0) F.MISC[16] = __hip_atomic_fetch_add(head, 1u, RLX_AGENT);
        __syncthreads();
        const int u = (int)F.MISC[16];
        __syncthreads();
        if (u >= ATT_NPU + ATT_NSU) break;
        if (u < ATT_NPU) {
            const int qb = (ATT_NQB - 1) - u / 32, bvh = u % 32, b = bvh >> 4, vh = bvh & 15, h = vh >> 2, c = (vh >> 1) & 1, half = vh & 1;
            build_bias_table((LAS float*)(F.lds + RING_OFF + attn_body::LDS_BT), a.in[I_REL], h, tid);
            __syncthreads();
            attn_body::attn_unit<8>(b, h * 128 + c * 64, ZC_VA + h * 128 + half * 64, h * 256 + c * 128 + half * 64, qb, QN, KN, Z, O, (char*)ldsg + RING_OFF);
        } else { const int su = u - ATT_NPU; attn_sample_unit(F, l, su >> 2, su & 3); }
    }
}
__device__ __forceinline__ void p_mixpost_a(Frame& F, int l) {
    const KArgs ap = kargs(); const auto& a = *ap; WS_OPAQUE(a);
    const int tid = otid(), lane = tid & 63, wave = __builtin_amdgcn_readfirstlane(tid >> 6);
    const bf16* O = (const bf16*)(wsb + a.off[R_O]); bf16* OA = (bf16*)(wsb + a.off[R_OA]);
    const int gw = F.vcu * NWAVES + wave, NGW = F.G * NWAVES;
    const float lam = lam_dev(a.in[I_LQK], l, lane), post = 1.f - lam_init_dev(l);
    const int h = lane >> 4, e0 = 8 * (lane & 15);
    float sg[8];
#pragma unroll
    for (int j = 0; j < 8; ++j) sg[j] = a.in[I_SUBLN][l * 2 * HEAD_DIM_A + e0 + j] * post;
    for (int m = gw; m < RP; m += NGW) {
        float o0[8], o1[8], d[8];
        unpack8(*(const GAS v4u*)(O + (size_t)m * 1024 + h * 256 + e0), o0); unpack8(*(const GAS v4u*)(O + (size_t)m * 1024 + h * 256 + 128 + e0), o1);
        float ss = 0.f;
#pragma unroll
        for (int j = 0; j < 8; ++j) { d[j] = o0[j] - lam * o1[j]; ss += d[j] * d[j]; }
        ss += __shfl_xor(ss, 1); ss += __shfl_xor(ss, 2); ss += __shfl_xor(ss, 4); ss += __shfl_xor(ss, 8);
        const float r = 1.f / sqrtf(ss * (1.f / 128.f) + EPSF);
#pragma unroll
        for (int j = 0; j < 8; ++j) d[j] = d[j] * r * sg[j];
        *(GAS v4u*)(OA + (size_t)m * WIDTH_A + h * 128 + e0) = pack8(d);
    }
}
constexpr int GDN_NCH = PEND / 64;
constexpr int GDN_NPI = BATCH * N_HEADS_B * GDN_NCH;
constexpr int GDN_NSI = DEC_BATCH * N_HEADS_B;
constexpr int GDN_NI = GDN_NPI + GDN_NSI;
constexpr int GI_W = 0, GI_QG = 16384, GI_KG = 32768, GI_AT = 49152, GI_U = 57344, GI_SC = 90112, GI_STRIDE = 90368;
static_assert(GDN_NI % 2 == 0 && PEND % 64 == 0, "gdn items");
__device__ __forceinline__ int frag_off(int row, int kk, int nkb) {
    const int fid = ((row >> 5) * nkb + (kk >> 5)) * 2 + ((kk & 31) >> 4), ln = (row & 31) + 32 * (((kk & 15) >> 2) & 1), j = ((kk & 15) >> 3) * 4 + (kk & 3);
    return (fid * 64 + ln) * 8 + j;
}
__device__ __forceinline__ float rdlane(float v, int i) { return __builtin_bit_cast(float, __builtin_amdgcn_readlane(__builtin_bit_cast(int, v), i)); }
__device__ __forceinline__ int gdn_item_row(int item, int j) {
    if (item < GDN_NPI) { const int sh = item / GDN_NCH, n = item % GDN_NCH; return (sh / N_HEADS_B) * LPP + 64 * n + j; }
    const int s = item - GDN_NPI; return j < 32 ? -1 : SROW0 + (s >> 2) * DEC_SEQ + (j - 32);
}
__device__ __forceinline__ int gdn_item_head(int item) { return item < GDN_NPI ? (item / GDN_NCH) % N_HEADS_B : (item - GDN_NPI) & 3; }

__device__ __forceinline__ void p_gdn_chunk(Frame& F, int l) {
    const KArgs ap = kargs(); const auto& a = *ap; WS_OPAQUE(a);
    const int tid = otid(), wave = __builtin_amdgcn_readfirstlane(tid >> 6), grp = wave >> 2, gw = wave & 3;
    const bf16* QKVB = (const bf16*)(wsb + a.off[R_QKVB]); const float* BG = (const float*)(wsb + a.off[R_BG]); unsigned char* GD = wsb + a.off[R_GDN];
    LAS float* A_lds = (LAS float*)(F.lds + RING_OFF + grp * 20480);
    LAS float* Gs = A_lds + 4096; LAS float* Bs = Gs + 64; LAS float* Es = Bs + 64;
    for (int pr = F.vcu; 2 * pr < GDN_NI; pr += F.G) {
        int lane_ = tid & 63; asm volatile("" : "+v"(lane_));
        const int lane = lane_, r32 = lane & 31, hi = lane >> 5;
        const int item = 2 * pr + grp, h = gdn_item_head(item);
        unsigned char* ib = GD + (size_t)item * GI_STRIDE;
        const int rowt = gdn_item_row(item, lane);
        const float beta = rowt >= 0 ? BG[(size_t)rowt * 8 + h] : 0.f; float G = rowt >= 0 ? BG[(size_t)rowt * 8 + 4 + h] : 0.f;
#pragma unroll
        for (int o = 1; o < 64; o <<= 1) { const float v = __shfl_up(G, o); if (lane >= o) G += v; }
        const float Glast = rdlane(G, 63), eG = __expf(G);
        if (gw == 0) { Gs[lane] = G; Bs[lane] = beta; Es[lane] = eG; if (lane == 0) *(float*)(ib + GI_SC) = __expf(Glast); }
        __syncthreads();
        { const int i0 = 32 * (gw >> 1), j0 = 32 * (gw & 1);
          const int ra = gdn_item_row(item, i0 + r32), rb = gdn_item_row(item, j0 + r32);
          f32x16 akk, aqk;
#pragma unroll
          for (int r = 0; r < 16; ++r) { akk[r] = 0.f; aqk[r] = 0.f; }
          const bf16x8 zf = {0, 0, 0, 0, 0, 0, 0, 0};
#pragma unroll
          for (int s = 0; s < 8; ++s) {
              const bf16x8 qa = ra >= 0 ? *(const GAS bf16x8*)(QKVB + (size_t)ra * 1536 + h * 128 + 16 * s + 8 * hi) : zf;
              const bf16x8 ka = ra >= 0 ? *(const GAS bf16x8*)(QKVB + (size_t)ra * 1536 + 512 + h * 128 + 16 * s + 8 * hi) : zf;
              const bf16x8 kb = rb >= 0 ? *(const GAS bf16x8*)(QKVB + (size_t)rb * 1536 + 512 + h * 128 + 16 * s + 8 * hi) : zf;
              akk = __builtin_amdgcn_mfma_f32_32x32x16_bf16(ka, kb, akk, 0, 0, 0); aqk = __builtin_amdgcn_mfma_f32_32x32x16_bf16(qa, kb, aqk, 0, 0, 0);
          }
          const int j = j0 + r32; const float Gj = Gs[j]; bf16* AT = (bf16*)(ib + GI_AT);
#pragma unroll
          for (int r = 0; r < 16; ++r) { const int i = i0 + crow_dev(r, hi); const float dec = i >= j ? __expf(Gs[i] - Gj) : 0.f;
              A_lds[i * 64 + j] = i > j ? Bs[i] * akk[r] * dec : 0.f;
              AT[frag_off(i, j, 2)] = (bf16)f2bf(aqk[r] * dec); }
        }
        __syncthreads();
        { const int col = 64 * gw + lane; float x[64];
#pragma unroll
          for (int i = 0; i < 64; ++i) { const int ri = gdn_item_row(item, i);
              x[i] = ri >= 0 ? bf2f(QKVB[(size_t)ri * 1536 + (gw < 2 ? 1024 + h * 128 + col : 512 + h * 128 + (col - 128))]) : 0.f; }
#pragma unroll
          for (int i = 0; i < 64; ++i) x[i] *= gw < 2 ? rdlane(beta, i) : rdlane(beta, i) * rdlane(eG, i);
#pragma unroll
          for (int i = 1; i < 64; ++i) { const float arow = A_lds[i * 64 + lane];
#pragma unroll
              for (int j = 0; j < i; ++j) x[i] -= rdlane(arow, j) * x[j]; }
          if (gw < 2) { float* ub = (float*)(ib + GI_U) + col; asm volatile("" : "+v"(ub));
#pragma unroll
              for (int i = 0; i < 64; ++i) ub[i * 128] = x[i]; }
          else { const int k = col - 128; bf16* wb = (bf16*)(ib + GI_W) + frag_off(0, k, 4); asm volatile("" : "+v"(wb));
#pragma unroll
              for (int i = 0; i < 64; ++i) wb[(i >> 5) * 4096 + (i & 31) * 8] = (bf16)f2bf(x[i]); }
        }
        { bf16* QGF = (bf16*)(ib + GI_QG); bf16* KGF = (bf16*)(ib + GI_KG);
          for (int e = gw * 64 + lane; e < 64 * 128; e += 256) { const int c = e >> 7, k = e & 127, rc = gdn_item_row(item, c);
              const float qv = rc >= 0 ? bf2f(QKVB[(size_t)rc * 1536 + h * 128 + k]) : 0.f, kv = rc >= 0 ? bf2f(QKVB[(size_t)rc * 1536 + 512 + h * 128 + k]) : 0.f;
              QGF[frag_off(c, k, 4)] = (bf16)f2bf(qv * Es[c]); KGF[frag_off(k, c, 2)] = (bf16)f2bf(kv * __expf(Glast - Gs[c])); }
        }
        __syncthreads();
    }
}

__device__ __forceinline__ void gdn_chain(const unsigned char* GD, bf16* OB, const float* sdelta, float* dout, int item0, int nch, int h, int vb, int lane) {
    const int r32 = lane & 31, hi = lane >> 5;
    f32x16 S[4];
#pragma unroll
    for (int kb = 0; kb < 4; ++kb)
#pragma unroll
        for (int r = 0; r < 16; ++r) S[kb][r] = sdelta ? sdelta[(size_t)(kb * 32 + crow_dev(r, hi)) * HEAD_DIM_B + vb * 32 + r32] : 0.f;
    for (int n = 0; n < nch; ++n) {
        const int item = item0 + n; const unsigned char* ib = GD + (size_t)item * GI_STRIDE;
        const float eGl = *(const float*)(ib + GI_SC);
        const GAS bf16x8* WF = (const GAS bf16x8*)(ib + GI_W) + lane; const GAS bf16x8* QF = (const GAS bf16x8*)(ib + GI_QG) + lane;
        const GAS bf16x8* KF = (const GAS bf16x8*)(ib + GI_KG) + lane; const GAS bf16x8* AF = (const GAS bf16x8*)(ib + GI_AT) + lane; const float* U = (const float*)(ib + GI_U);
        bf16x8 Sp[4][2];
#pragma unroll
        for (int kb = 0; kb < 4; ++kb)
#pragma unroll
            for (int s = 0; s < 2; ++s) { v4u w; w.x = pk2(S[kb][8 * s], S[kb][8 * s + 1]); w.y = pk2(S[kb][8 * s + 2], S[kb][8 * s + 3]); w.z = pk2(S[kb][8 * s + 4], S[kb][8 * s + 5]); w.w = pk2(S[kb][8 * s + 6], S[kb][8 * s + 7]); Sp[kb][s] = __builtin_bit_cast(bf16x8, w); }
        f32x16 vn[2], ot[2];
#pragma unroll
        for (int cb = 0; cb < 2; ++cb) {
            f32x16 ws;
#pragma unroll
            for (int r = 0; r < 16; ++r) { ws[r] = 0.f; ot[cb][r] = 0.f; }
#pragma unroll
            for (int kb = 0; kb < 4; ++kb)
#pragma unroll
                for (int s = 0; s < 2; ++s) { ws = __builtin_amdgcn_mfma_f32_32x32x16_bf16(WF[((cb * 4 + kb) * 2 + s) * 64], Sp[kb][s], ws, 0, 0, 0);
                    ot[cb] = __builtin_amdgcn_mfma_f32_32x32x16_bf16(QF[((cb * 4 + kb) * 2 + s) * 64], Sp[kb][s], ot[cb], 0, 0, 0); }
#pragma unroll
            for (int r = 0; r < 16; ++r) vn[cb][r] = U[(cb * 32 + crow_dev(r, hi)) * 128 + vb * 32 + r32] - ws[r];
        }
        bf16x8 Vp[2][2];
#pragma unroll
        for (int cb = 0; cb < 2; ++cb)
#pragma unroll
            for (int s = 0; s < 2; ++s) { v4u w; w.x = pk2(vn[cb][8 * s], vn[cb][8 * s + 1]); w.y = pk2(vn[cb][8 * s + 2], vn[cb][8 * s + 3]); w.z = pk2(vn[cb][8 * s + 4], vn[cb][8 * s + 5]); w.w = pk2(vn[cb][8 * s + 6], vn[cb][8 * s + 7]); Vp[cb][s] = __builtin_bit_cast(bf16x8, w); }
#pragma unroll
        for (int cb = 0; cb < 2; ++cb)
#pragma unroll
            for (int c2 = 0; c2 <= cb; ++c2)
#pragma unroll
                for (int s = 0; s < 2; ++s) ot[cb] = __builtin_amdgcn_mfma_f32_32x32x16_bf16(AF[((cb * 2 + c2) * 2 + s) * 64], Vp[c2][s], ot[cb], 0, 0, 0);
#pragma unroll
        for (int cb = 0; cb < 2; ++cb)
#pragma unroll
            for (int r = 0; r < 16; ++r) { const int row = gdn_item_row(item, cb * 32 + crow_dev(r, hi)); if (row >= 0) OB[(size_t)row * WIDTH_B + h * 128 + vb * 32 + r32] = (bf16)f2bf(ot[cb][r]); }
#pragma unroll
        for (int kb = 0; kb < 4; ++kb) {
#pragma unroll
            for (int r = 0; r < 16; ++r) S[kb][r] *= eGl;
#pragma unroll
            for (int cb = 0; cb < 2; ++cb)
#pragma unroll
                for (int s = 0; s < 2; ++s) S[kb] = __builtin_amdgcn_mfma_f32_32x32x16_bf16(KF[((kb * 2 + cb) * 2 + s) * 64], Vp[cb][s], S[kb], 0, 0, 0);
        }
    }
#pragma unroll
    for (int kb = 0; kb < 4; ++kb)
#pragma unroll
        for (int r = 0; r < 16; ++r) dout[(size_t)(kb * 32 + crow_dev(r, hi)) * HEAD_DIM_B + vb * 32 + r32] = S[kb][r];
}
__device__ __forceinline__ void p_gdn_chain(Frame& F, int l) {
    const KArgs ap = kargs(); const auto& a = *ap; WS_OPAQUE(a);
    const int tid = otid(), lane = tid & 63, wave = __builtin_amdgcn_readfirstlane(tid >> 6);
    const unsigned char* GD = wsb + a.off[R_GDN]; bf16* OB = (bf16*)(wsb + a.off[R_OB]);
    if (wave == 0) { if (F.vcu < BATCH * N_HEADS_B * 4) { const int sh = F.vcu >> 2, vb = F.vcu & 3, sq = sh / N_HEADS_B, h = sh % N_HEADS_B;
            gdn_chain(GD, OB, nullptr, a.out + O_DP + (((size_t)l * BATCH + sq) * N_HEADS_B + h) * HEAD_DIM_B * HEAD_DIM_B, sh * GDN_NCH, GDN_NCH, h, vb, lane); } }
    else { const int t = F.vcu * (NWAVES - 1) + (wave - 1);
        if (t < GDN_NSI * 4) { const int s = t >> 2, vb = t & 3, bs = s >> 2, h = s & 3; const size_t so = (((size_t)l * DEC_BATCH + bs) * N_HEADS_B + h) * HEAD_DIM_B * HEAD_DIM_B;
            gdn_chain(GD, OB, a.in[I_SDELTA] + so, a.out + O_DS + so, GDN_NPI + s, 1, h, vb, lane); } }
}
__device__ __forceinline__ void p_mixpost_b(Frame& F, int l) {
    const KArgs ap = kargs(); const auto& a = *ap; WS_OPAQUE(a);
    const int tid = otid(), lane = tid & 63, wave = __builtin_amdgcn_readfirstlane(tid >> 6);
    bf16* OB = (bf16*)(wsb + a.off[R_OB]); const bf16* Z = (const bf16*)(wsb + a.off[R_Z]);
    const int gw = F.vcu * NWAVES + wave, NGW = F.G * NWAVES, e0 = 8 * (lane & 15);
    float gn[8];
#pragma unroll
    for (int j = 0; j < 8; ++j) gn[j] = a.in[I_GDNN][l * HEAD_DIM_B + e0 + j];
    for (int m = gw; m < RP; m += NGW) {
        float o[8], gt[8];
        unpack8(*(const GAS v4u*)(OB + (size_t)m * WIDTH_B + 8 * lane), o); unpack8(*(const GAS v4u*)(Z + (size_t)m * ZN + ZC_GB + 8 * lane), gt);
        float ss = 0.f;
#pragma unroll
        for (int j = 0; j < 8; ++j) ss += o[j] * o[j];
        ss += __shfl_xor(ss, 1); ss += __shfl_xor(ss, 2); ss += __shfl_xor(ss, 4); ss += __shfl_xor(ss, 8);
        const float r = 1.f / sqrtf(ss * (1.f / 128.f) + EPSF);
#pragma unroll
        for (int j = 0; j < 8; ++j) o[j] = o[j] * r * gn[j] * gt[j] * sigm(gt[j]);
        *(GAS v4u*)(OB + (size_t)m * WIDTH_B + 8 * lane) = pack8(o);
    }
}
constexpr int S5_M1 = 0, S5_M2 = 131072, S5_M3 = 196608, S5_L16 = 262144, S5_TSTRIDE = 262656;
constexpr int S5_NCHK = RP / 16;
constexpr int S5_NBLK = S5_NCHK / 32;
constexpr int S5_PCH = PEND / 16;
static_assert(S5_NCHK % 32 == 0 && LPP % 16 == 0 && PADF % 16 == 0 && S5_STATE == 64 && S5_GROUPS == 32, "s5 shapes");

__device__ __forceinline__ void s5_tables(Frame& F) {
    const KArgs ap = kargs(); const auto& a = *ap; WS_OPAQUE(a);
    const int tid = otid();
    LAS float* pw = (LAS float*)(F.lds + RING_OFF);
    LAS float* bb = pw + 17 * 128;
    LAS float* Kt = bb + 64 * 32;
    for (int it = F.vcu; it < DEPTH * S5_GROUPS; it += F.G) {
        const int l = it / S5_GROUPS, g = it % S5_GROUPS; const size_t gp = ((size_t)l * S5_GROUPS + g) * S5_STATE;
        unsigned char* tb = wsb + a.off[R_S5T] + (size_t)it * S5_TSTRIDE;
        const float dt = __expf(a.in[I_LDT][l * S5_GROUPS + g]);
        for (int e = tid; e < 17 * 64; e += NTHR) { const int k = e >> 6, p = e & 63; const float ar = a.in[I_AR][gp + p] * dt * (float)k, ai = a.in[I_AI][gp + p] * dt * (float)k;
            float sn, cs; sincosf(ai, &sn, &cs); const float er = expf(ar); pw[e * 2] = er * cs; pw[e * 2 + 1] = er * sn; }
        __syncthreads();
        for (int e = tid; e < 64 * 16; e += NTHR) { const int p = e >> 4; const float ar = a.in[I_AR][gp + p], ai = a.in[I_AI][gp + p];
            const float nr = pw[(64 + p) * 2] - 1.f, ni = pw[(64 + p) * 2 + 1], den = ar * ar + ai * ai, fr = (nr * ar + ni * ai) / den, fi = (ni * ar - nr * ai) / den;
            const float br = a.in[I_BR][gp * 16 + e], bi = a.in[I_BI][gp * 16 + e]; bb[e * 2] = fr * br - fi * bi; bb[e * 2 + 1] = fr * bi + fi * br; }
        if (tid < 128) { const int p = tid & 63; ((float*)(tb + S5_L16))[tid] = pw[(16 * 64 + p) * 2 + (tid >> 6)]; }
        __syncthreads();
        const float* cre = a.in[I_CR] + ((size_t)l * S5_GROUPS + g) * 16 * 64; const float* cim = a.in[I_CI] + ((size_t)l * S5_GROUPS + g) * 16 * 64;
        for (int e = tid; e < 4096; e += NTHR) { const int d = e >> 8, i = (e >> 4) & 15, j = e & 15; float acc = 0.f;
            for (int p = 0; p < 64; ++p) { const float cr = cre[i * 64 + p], ci = cim[i * 64 + p], pr = pw[(d * 64 + p) * 2], pi = pw[(d * 64 + p) * 2 + 1];
                const float tr = cr * pr - ci * pi, ti = cr * pi + ci * pr; acc += tr * bb[(p * 16 + j) * 2] - ti * bb[(p * 16 + j) * 2 + 1]; }
            Kt[e] = acc; }
        __syncthreads();
        bf16* M1 = (bf16*)(tb + S5_M1); bf16* M2 = (bf16*)(tb + S5_M2); bf16* M3 = (bf16*)(tb + S5_M3);
        for (int e = tid; e < 65536; e += NTHR) { const int n = e >> 8, k = e & 255, tau = n >> 4, i = n & 15, sg = k >> 4, j = k & 15;
            float v = 0.f; if (sg <= tau) { v = Kt[((tau - sg) * 16 + i) * 16 + j]; if (sg == tau && i == j) v += a.in[I_SD][(l * S5_GROUPS + g) * 16 + i]; }
            M1[e] = (bf16)f2bf(v); }
        for (int e = tid; e < 32768; e += NTHR) { const int n = e >> 8, k = e & 255, ri = n >> 6, p = n & 63, sg = k >> 4, j = k & 15;
            const float pr = pw[((15 - sg) * 64 + p) * 2], pi = pw[((15 - sg) * 64 + p) * 2 + 1], br = bb[(p * 16 + j) * 2], bi = bb[(p * 16 + j) * 2 + 1];
            M2[e] = (bf16)f2bf(ri == 0 ? pr * br - pi * bi : pr * bi + pi * br); }
        for (int e = tid; e < 32768; e += NTHR) { const int n = e >> 7, k = e & 127, tau = n >> 4, i = n & 15, ri = k >> 6, p = k & 63;
            const float cr = cre[i * 64 + p], ci = cim[i * 64 + p], pr = pw[((tau + 1) * 64 + p) * 2], pi = pw[((tau + 1) * 64 + p) * 2 + 1];
            M3[e] = (bf16)f2bf(ri == 0 ? cr * pr - ci * pi : -(cr * pi + ci * pr)); }
        __syncthreads();
    }
}
__device__ __forceinline__ void p_s5_e(Frame& F, int l) {
    const KArgs ap = kargs(); const auto& a = *ap; WS_OPAQUE(a);
    const int tid = otid(), lane = tid & 63, wave = __builtin_amdgcn_readfirstlane(tid >> 6), r32 = lane & 31, hi = lane >> 5;
    const bf16* Z = (const bf16*)(wsb + a.off[R_Z]); float* E = (float*)(wsb + a.off[R_S5E]);
    for (int u = F.vcu * NWAVES + wave; u < S5_NBLK * S5_GROUPS; u += F.G * NWAVES) {
        const int blk = u / S5_GROUPS, g = u % S5_GROUPS;
        const unsigned char* tb = wsb + a.off[R_S5T] + (size_t)(l * S5_GROUPS + g) * S5_TSTRIDE;
        const GAS bf16x8* M2 = (const GAS bf16x8*)(tb + S5_M2);
        const bf16* zr = Z + (size_t)((blk * 32 + r32) * 16) * ZN + ZC_UC + g * 16 + 8 * hi;
        f32x16 acc[4];
#pragma unroll
        for (int nb = 0; nb < 4; ++nb)
#pragma unroll
            for (int r = 0; r < 16; ++r) acc[nb][r] = 0.f;
#pragma unroll 4
        for (int sg = 0; sg < 16; ++sg) { const bf16x8 af = *(const GAS bf16x8*)(zr + (size_t)sg * ZN);
#pragma unroll
            for (int nb = 0; nb < 4; ++nb) acc[nb] = __builtin_amdgcn_mfma_f32_32x32x16_bf16(af, M2[((nb * 32 + r32) * 256 + sg * 16 + 8 * hi) >> 3], acc[nb], 0, 0, 0); }
#pragma unroll
        for (int nb = 0; nb < 4; ++nb)
#pragma unroll
            for (int r = 0; r < 16; ++r) E[((size_t)(blk * 32 + crow_dev(r, hi)) * S5_GROUPS + g) * 128 + nb * 32 + r32] = acc[nb][r];
    }
}
__device__ __forceinline__ void s5_scan_task(const float* E, bf16* XP, const float* l16, int g, int c0, int nch, float xr, float xi, float* ore, float* oim, int lane) {
    const float lr = l16[lane], li = l16[64 + lane];
    int c = 0;
    for (; c + 8 <= nch; c += 8) { float er[8], ei[8];
#pragma unroll
        for (int q = 0; q < 8; ++q) { const float* e = E + ((size_t)(c0 + c + q) * S5_GROUPS + g) * 128; er[q] = e[lane]; ei[q] = e[64 + lane]; }
#pragma unroll
        for (int q = 0; q < 8; ++q) { bf16* xp = XP + ((size_t)(c0 + c + q) * S5_GROUPS + g) * 128; xp[lane] = (bf16)f2bf(xr); xp[64 + lane] = (bf16)f2bf(xi);
            const float nr = lr * xr - li * xi + er[q], ni = lr * xi + li * xr + ei[q]; xr = nr; xi = ni; } }
    for (; c < nch; ++c) { const float* e = E + ((size_t)(c0 + c) * S5_GROUPS + g) * 128; bf16* xp = XP + ((size_t)(c0 + c) * S5_GROUPS + g) * 128; xp[lane] = (bf16)f2bf(xr); xp[64 + lane] = (bf16)f2bf(xi);
        const float nr = lr * xr - li * xi + e[lane], ni = lr * xi + li * xr + e[64 + lane]; xr = nr; xi = ni; }
    ore[lane] = xr; oim[lane] = xi;
}
constexpr int S5_NTASK = (BATCH + DEC_BATCH) * S5_GROUPS;
__device__ __forceinline__ void s5_scan_run(Frame& F, int l, int t, int lane) {
    const KArgs ap = kargs(); const auto& a = *ap; WS_OPAQUE(a);
    const int sq = t / S5_GROUPS, g = t % S5_GROUPS;
    const float* E = (const float*)(wsb + a.off[R_S5E]); bf16* XP = (bf16*)(wsb + a.off[R_S5X]);
    const float* l16 = (const float*)(wsb + a.off[R_S5T] + (size_t)(l * S5_GROUPS + g) * S5_TSTRIDE + S5_L16);
    if (sq < BATCH) { const size_t oo = (((size_t)l * BATCH + sq) * S5_GROUPS + g) * S5_STATE;
        s5_scan_task(E, XP, l16, g, sq * (LPP / 16), S5_PCH, 0.f, 0.f, a.out + O_SRP + oo, a.out + O_SIP + oo, lane); }
    else { const int bs = sq - BATCH; const size_t oo = (((size_t)l * DEC_BATCH + bs) * S5_GROUPS + g) * S5_STATE;
        s5_scan_task(E, XP, l16, g, SROW0 / 16 + bs * (DEC_SEQ / 16), DEC_SEQ / 16, a.in[I_SRE][oo + lane], a.in[I_SIM][oo + lane], a.out + O_SRS + oo, a.out + O_SIS + oo, lane); }
}
__device__ __forceinline__ float gelu_tanh(float x) { const float z = 0.7978845608028654f * (x + 0.044715f * x * x * x); const float t = 1.f - 2.f / (__expf(2.f * z) + 1.f); return 0.5f * x * (1.f + t); }
__device__ __forceinline__ void p_s5_out(Frame& F, int l) {
    const KArgs ap = kargs(); const auto& a = *ap; WS_OPAQUE(a);
    const int tid = otid(), lane = tid & 63, wave = __builtin_amdgcn_readfirstlane(tid >> 6), r32 = lane & 31, hi = lane >> 5;
    const bf16* Z = (const bf16*)(wsb + a.off[R_Z]); const bf16* XP = (const bf16*)(wsb + a.off[R_S5X]); bf16* YC = (bf16*)(wsb + a.off[R_YC]);
    for (int u = F.vcu * NWAVES + wave; u < S5_NBLK * S5_GROUPS; u += F.G * NWAVES) {
        const int blk = u / S5_GROUPS, g = u % S5_GROUPS;
        const unsigned char* tb = wsb + a.off[R_S5T] + (size_t)(l * S5_GROUPS + g) * S5_TSTRIDE;
        const GAS bf16x8* M1 = (const GAS bf16x8*)(tb + S5_M1); const GAS bf16x8* M3 = (const GAS bf16x8*)(tb + S5_M3);
        const bf16* zr = Z + (size_t)((blk * 32 + r32) * 16) * ZN + ZC_UC + g * 16 + 8 * hi;
        const bf16* xr = XP + ((size_t)(blk * 32 + r32) * S5_GROUPS + g) * 128 + 8 * hi;
        f32x16 acc[8];
#pragma unroll
        for (int nb = 0; nb < 8; ++nb)
#pragma unroll
            for (int r = 0; r < 16; ++r) acc[nb][r] = 0.f;
#pragma unroll 2
        for (int sg = 0; sg < 16; ++sg) { const bf16x8 af = *(const GAS bf16x8*)(zr + (size_t)sg * ZN);
#pragma unroll
            for (int nb = 0; nb < 8; ++nb) acc[nb] = __builtin_amdgcn_mfma_f32_32x32x16_bf16(af, M1[((nb * 32 + r32) * 256 + sg * 16 + 8 * hi) >> 3], acc[nb], 0, 0, 0); }
#pragma unroll 2
        for (int s = 0; s < 8; ++s) { const bf16x8 af = *(const GAS bf16x8*)(xr + 16 * s);
#pragma unroll
            for (int nb = 0; nb < 8; ++nb) acc[nb] = __builtin_amdgcn_mfma_f32_32x32x16_bf16(af, M3[((nb * 32 + r32) * 128 + s * 16 + 8 * hi) >> 3], acc[nb], 0, 0, 0); }
#pragma unroll
        for (int nb = 0; nb < 8; ++nb)
#pragma unroll
            for (int r = 0; r < 16; ++r) { const int row = (blk * 32 + crow_dev(r, hi)) * 16 + 2 * nb + (r32 >> 4);
                YC[(size_t)row * WIDTH_C + g * 16 + (r32 & 15)] = (bf16)f2bf(gelu_tanh(acc[nb][r])); }
    }
}
__device__ __forceinline__ float wave_max(float v) {
#pragma unroll
    for (int o = 1; o < 64; o <<= 1) v = fmaxf(v, __shfl_xor(v, o));
    return v;
}
__device__ __forceinline__ int rdlane_i(int v, int i) { return __builtin_amdgcn_readlane(v, i); }
constexpr float NEG_BIG = -3.0e38f;
__device__ __forceinline__ void pro_wqs(Frame& F) {
    const KArgs ap = kargs(); const auto& a = *ap; WS_OPAQUE(a);
    const int tid = otid(), lane = tid & 63, wave = __builtin_amdgcn_readfirstlane(tid >> 6);
    bf16* WQ = (bf16*)(wsb + a.off[R_WQS]);
    for (int t = F.vcu * NWAVES + wave; t < DEPTH * 16 * 16; t += F.G * NWAVES) {
        const int l = t >> 8, hc = (t >> 4) & 15, kb = t & 15, k = kb * 64 + lane;
        const float* wr = a.in[I_PWQ] + ((size_t)l * D_MODEL + k) * PQ + hc * 128;
        float w[128];
#pragma unroll
        for (int d = 0; d < 128; d += 4) { const f32x4 v = *(const GAS f32x4*)(wr + d); w[d] = v.x; w[d + 1] = v.y; w[d + 2] = v.z; w[d + 3] = v.w; }
        const float* sk = a.in[I_PSK] + ((size_t)l * 16 + hc) * 128 * 128;
        bf16* o = WQ + ((size_t)l * PQ + hc * 128) * D_MODEL + k;
#pragma clang loop vectorize(disable) unroll(disable)
        for (int n = 0; n < 128; ++n) { const float* sr = sk + n * 128; float acc = 0.f;
#pragma unroll
            for (int d = 0; d < 128; ++d) acc += w[d] * sr[d];
            o[(size_t)n * D_MODEL] = (bf16)f2bf(acc); }
    }
}
__device__ __forceinline__ void pro_wrest(Frame& F) {
    const KArgs ap = kargs(); const auto& a = *ap; WS_OPAQUE(a);
    const int tid = otid(), lane = tid & 63, wave = __builtin_amdgcn_readfirstlane(tid >> 6);
    LAS float* scr = (LAS float*)(F.lds + RING_OFF + wave * 16384);
    const int gw = F.vcu * NWAVES + wave, NGW = F.G * NWAVES;
    bf16* WG = (bf16*)(wsb + a.off[R_WGLU]); bf16* WB = (bf16*)(wsb + a.off[R_WBR]); bf16* WO = (bf16*)(wsb + a.off[R_WOUT]);
    constexpr int IG = (512 / 64) * (1024 / 32), IB = IG, IO = (1024 / 64) * (1024 / 32), IL = IG + 3 * IB + IO;
    for (int it = gw; it < DEPTH * IL; it += NGW) { const int l = it / IL; int r = it % IL;
        if (r < IG) { transpose_item(a.in[I_WGLU] + (size_t)l * 512 * 1024, 1024, 512, WG + (size_t)l * 1024 * 512, 32 * (r % 32), 64 * (r / 32), CmGlu(), scr, lane); continue; } r -= IG;
        if (r < 3 * IB) { const int w = r / IB, q = r % IB; transpose_item(a.in[I_WBA + w] + (size_t)l * 512 * 1024, 1024, 512, WB + ((size_t)l * 3 + w) * 1024 * 512, 32 * (q % 32), 64 * (q / 32), CmId(), scr, lane); continue; } r -= 3 * IB;
        transpose_item(a.in[I_WOUT] + (size_t)l * 1024 * 1024, 1024, 1024, WO + (size_t)l * 1024 * 1024, 32 * (r % 32), 64 * (r / 32), CmId(), scr, lane); }
}
__device__ __forceinline__ void pro_peerw(Frame& F) {
    const KArgs ap = kargs(); const auto& a = *ap; WS_OPAQUE(a);
    const int tid = otid();
    const size_t n8 = (size_t)DEPTH * N_EXPERTS * D_MODEL / 8, stride = (size_t)F.G * NTHR;
#pragma unroll
    for (int w = 0; w < 2; ++w) { const GAS f32x4* src = (const GAS f32x4*)a.in[I_PU + w]; GAS v4u* dst = (GAS v4u*)(wsb + a.off[R_PU + w]);
        for (size_t i = (size_t)F.vcu * NTHR + tid; i < n8; i += stride) { const f32x4 x = src[2 * i], y = src[2 * i + 1]; v4u o; o.x = pk2(x.x, x.y); o.y = pk2(x.z, x.w); o.z = pk2(y.x, y.y); o.w = pk2(y.z, y.w); dst[i] = o; } }
}
__device__ __forceinline__ void p_peer(Frame& F, int l) {
    const KArgs ap = kargs(); const auto& a = *ap; WS_OPAQUE(a);
    const int tid = otid(), lane = tid & 63, wave = __builtin_amdgcn_readfirstlane(tid >> 6);
    const float* SC = (const float*)(wsb + a.off[R_SC]); const bf16* XN = (const bf16*)(wsb + a.off[R_XN]); float* X = (float*)(wsb + a.off[R_X]);
    const bf16* PU = (const bf16*)(wsb + a.off[R_PU]) + (size_t)l * N_EXPERTS * D_MODEL; const bf16* PV = (const bf16*)(wsb + a.off[R_PV]) + (size_t)l * N_EXPERTS * D_MODEL;
    LAS float* stop = (LAS float*)(F.lds + RING_OFF + wave * 4096);
    LAS int* itop = (LAS int*)(stop + 256);
    LAS int* elist = itop + 256;
    LAS float* cf = (LAS float*)(elist + 128);
    for (int m = F.vcu * NWAVES + wave; m < RP; m += F.G * NWAVES) {
        if (!prow_valid(m)) continue;
        const float* sr = SC + (size_t)m * PQ;
        for (int hc = 0; hc < 16; ++hc) {
            float v0 = sr[hc * 128 + lane], v1 = sr[hc * 128 + 64 + lane], tv = 0.f; int ti = 0;
#pragma unroll
            for (int k = 0; k < 16; ++k) {
                const bool f = v0 >= v1; const float lb = f ? v0 : v1; const int li = f ? lane : lane + 64;
                const float wm = wave_max(lb);
                const unsigned long long mk = __ballot(lb == wm); const int src = __builtin_ctzll(mk);
                const int wi = rdlane_i(li, src);
                if (lane == k) { tv = wm; ti = wi; }
                if (lane == (wi & 63)) { if (wi < 64) v0 = NEG_BIG; else v1 = NEG_BIG; }
            }
            if (lane < 16) { stop[hc * 16 + lane] = tv; itop[hc * 16 + lane] = ti; }
        }
        LDS_WAIT();
        for (int h = 0; h < 8; ++h) {
            const float s1 = stop[(2 * h) * 16 + (lane >> 2)];
            float c[4];
#pragma unroll
            for (int j = 0; j < 4; ++j) c[j] = s1 + stop[(2 * h + 1) * 16 + (lane & 3) * 4 + j];
            float bv = 0.f; int bc = 0;
#pragma unroll
            for (int k = 0; k < 16; ++k) {
                float lb = c[0]; int lj = 0;
#pragma unroll
                for (int j = 1; j < 4; ++j) if (c[j] > lb) { lb = c[j]; lj = j; }
                const float wm = wave_max(lb);
                const unsigned long long mk = __ballot(lb == wm); const int src = __builtin_ctzll(mk);
                const int wc = rdlane_i(lane * 4 + lj, src);
                if (lane == k) { bv = wm; bc = wc; }
                if (lane == (wc >> 2)) {
#pragma unroll
                    for (int j = 0; j < 4; ++j) if ((wc & 3) == j) c[j] = NEG_BIG; }
            }
            const float b0 = rdlane(bv, 0); float e = lane < 16 ? __expf(bv - b0) : 0.f;
            float sum = e; sum += __shfl_xor(sum, 1); sum += __shfl_xor(sum, 2); sum += __shfl_xor(sum, 4); sum += __shfl_xor(sum, 8);
            if (lane < 16) { elist[h * 16 + lane] = itop[(2 * h) * 16 + (bc >> 4)] * N_KEYS + itop[(2 * h + 1) * 16 + (bc & 15)]; cf[h * 16 + lane] = e / sum; }
        }
        LDS_WAIT();
        float hx[16], out[16];
        { float t[8]; unpack8(*(const GAS v4u*)(XN + (size_t)m * D_MODEL + 8 * lane), t);
#pragma unroll
          for (int j = 0; j < 8; ++j) hx[j] = t[j];
          unpack8(*(const GAS v4u*)(XN + (size_t)m * D_MODEL + 512 + 8 * lane), t);
#pragma unroll
          for (int j = 0; j < 8; ++j) hx[8 + j] = t[j]; }
#pragma unroll
        for (int j = 0; j < 16; ++j) out[j] = 0.f;
        for (int q = 0; q < 128; q += 4) {
            v4u ua[4], ub[4], va[4], vb[4]; float cw[4];
#pragma unroll
            for (int i = 0; i < 4; ++i) { const size_t eo = (size_t)elist[q + i] * D_MODEL; cw[i] = cf[q + i];
                ua[i] = *(const GAS v4u*)(PU + eo + 8 * lane); ub[i] = *(const GAS v4u*)(PU + eo + 512 + 8 * lane);
                va[i] = *(const GAS v4u*)(PV + eo + 8 * lane); vb[i] = *(const GAS v4u*)(PV + eo + 512 + 8 * lane); }
#pragma unroll
            for (int i = 0; i < 4; ++i) { float t[8], d = 0.f;
                unpack8(ua[i], t);
#pragma unroll
                for (int j = 0; j < 8; ++j) d += hx[j] * t[j];
                unpack8(ub[i], t);
#pragma unroll
                for (int j = 0; j < 8; ++j) d += hx[8 + j] * t[j];
                d = wave_sum(d);
                const float cc = cw[i] * gelu_tanh(d);
                unpack8(va[i], t);
#pragma unroll
                for (int j = 0; j < 8; ++j) out[j] += cc * t[j];
                unpack8(vb[i], t);
#pragma unroll
                for (int j = 0; j < 8; ++j) out[8 + j] += cc * t[j]; }
        }
        { GAS f32x4* xr = (GAS f32x4*)(X + (size_t)m * D_MODEL + 8 * lane);
          xr[0] = xr[0] + (f32x4){out[0], out[1], out[2], out[3]}; xr[1] = xr[1] + (f32x4){out[4], out[5], out[6], out[7]};
          GAS f32x4* xs = (GAS f32x4*)(X + (size_t)m * D_MODEL + 512 + 8 * lane);
          xs[0] = xs[0] + (f32x4){out[8], out[9], out[10], out[11]}; xs[1] = xs[1] + (f32x4){out[12], out[13], out[14], out[15]}; }
    }
}
__device__ __forceinline__ void p_final(Frame& F) {
    const KArgs ap = kargs(); const auto& a = *ap; WS_OPAQUE(a);
    const int tid = otid(), lane = tid & 63, wave = __builtin_amdgcn_readfirstlane(tid >> 6);
    const float* X = (const float*)(wsb + a.off[R_X]); const float* g = a.in[I_FN];
    for (int m = F.vcu * NWAVES + wave; m < RP; m += F.G * NWAVES) {
        float* dst;
        if (m >= SROW0) dst = a.out + O_YS + (size_t)(m - SROW0) * D_MODEL;
        else { const int b = m / LPP, p = m % LPP; if (p < PADF + N_META || p >= PEND) continue; dst = a.out + O_YP + ((size_t)b * SEQ + (p - PADF - N_META)) * D_MODEL; }
        const GAS f32x4* xr = (const GAS f32x4*)(X + (size_t)m * D_MODEL) + lane;
        f32x4 v[4]; float s2 = 0.f;
#pragma unroll
        for (int j = 0; j < 4; ++j) { v[j] = xr[64 * j]; s2 += (v[j].x * v[j].x + v[j].y * v[j].y) + (v[j].z * v[j].z + v[j].w * v[j].w); }
        const float r = 1.f / sqrtf(wave_sum(s2) * (1.f / D_MODEL) + EPSF);
        const GAS f32x4* gr = (const GAS f32x4*)g + lane; GAS f32x4* o = (GAS f32x4*)dst + lane;
#pragma unroll
        for (int j = 0; j < 4; ++j) { const f32x4 gg = gr[64 * j]; o[64 * j] = (f32x4){v[j].x * r * gg.x, v[j].y * r * gg.y, v[j].z * r * gg.z, v[j].w * r * gg.w}; }
    }
}

__device__ __forceinline__ void p_prologue(Frame& F) {
    const KArgs ap = kargs(); const auto& a = *ap; WS_OPAQUE(a);
    const int tid = otid(), lane = tid & 63, wave = __builtin_amdgcn_readfirstlane(tid >> 6);
    LAS float* scr = (LAS float*)(F.lds + RING_OFF + wave * 16384);
    const int gw = F.vcu * NWAVES + wave, NGW = F.G * NWAVES;
    if (a.pro_mask & PM_X) {
        float* X = (float*)(wsb + a.off[R_X]);
        for (int m = gw; m < RP; m += NGW) {
            const float* src = nullptr;
            if (m >= SROW0) src = a.in[I_XS] + (size_t)(m - SROW0) * D_MODEL;
            else { const int b = m / LPP, p = m % LPP; if (p >= PADF && p < PEND) { const int pos = p - PADF; src = pos < N_META ? a.in[I_META] + (size_t)pos * D_MODEL : a.in[I_XP] + ((size_t)b * SEQ + pos - N_META) * D_MODEL; } }
            GAS f32x4* o = (GAS f32x4*)(X + (size_t)m * D_MODEL) + lane;
#pragma unroll
            for (int j = 0; j < 4; ++j) o[64 * j] = src ? ((const GAS f32x4*)src)[lane + 64 * j] : (f32x4){0.f, 0.f, 0.f, 0.f};
        }
    }
    if (a.pro_mask & PM_WIN) {
        bf16* WT = (bf16*)(wsb + a.off[R_WIN]);
        constexpr int IPL = (D_MODEL / 64) * (ZN / 32);
        for (int it = gw; it < DEPTH * IPL; it += NGW) { const int l = it / IPL, r = it % IPL, kb = r / (ZN / 32), nb = r % (ZN / 32);
            transpose_item(a.in[I_WIN] + (size_t)l * D_MODEL * D_IN, D_IN, D_MODEL, WT + (size_t)l * ZN * D_MODEL, 32 * nb, 64 * kb, CmWin(), scr, lane); }
    }
    __syncthreads();
    if (a.pro_mask & PM_TABLES) s5_tables(F);
    __syncthreads();
    if (a.pro_mask & PM_WREST) pro_wrest(F);
    if (a.pro_mask & PM_WQS) pro_wqs(F);
    if (a.pro_mask & PM_PEERW) pro_peerw(F);
}

__global__ void __launch_bounds__(NTHR, 2) mk_fwd(Args args) {
    extern __shared__ __attribute__((aligned(16))) unsigned char lds[];
    Frame F;
    F.lds = (LAS unsigned char*)lds; F.MISC = (volatile LAS unsigned*)(F.lds + MISC_OFF);
    F.G = gridDim.x; { const int bx = blockIdx.x; F.vcu = (F.G % 8 == 0) ? (bx % 8) * (F.G / 8) + bx / 8 : bx; }
    F.ctl = (gu32*)args.ws;
    for (int u = threadIdx.x; u < (LDS_BYTES - LDSCTL_OFF) / 4; u += NTHR) ((LAS unsigned*)(F.lds + LDSCTL_OFF))[u] = 0u;
    __syncthreads();
    const int lo = args.ph_lo, hi = args.ph_hi;
    unsigned* barw = (unsigned*)(F.ctl + CW_BAR) + (size_t)args.bar_region * XCD_BAR_WORDS;
    XcdBarrier bar; bar.bar = barw; bar.x = 0; bar.st = nullptr;
    if (hi - lo > 1) bar = xcd_barrier_post(barw, F.MISC + 8);
#define IN(k) (lo <= (k) && (k) < hi)
#define SEAM(k) do { if ((k) + 1 < hi) xcd_barrier(bar); } while (0)
    if (IN(PH_PRO)) { p_prologue(F); SEAM(PH_PRO); }
    for (int l = 0; l < DEPTH; ++l) {
        const int pb = 1 + l * NPL;
        if (IN(pb + PL_NORM1)) { p_norm(F, l, I_N1); SEAM(pb + PL_NORM1); }
        if (IN(pb + PL_GEMM_IN)) {
            const KArgs ap = kargs(); const auto& a = *ap; WS_OPAQUE(a);
            pg8::Gemm g{(const pg8::bf16_t*)(wsb + a.off[R_XN]), (const pg8::bf16_t*)(wsb + a.off[R_WIN]) + (size_t)l * ZN * D_MODEL, RP, ZN, D_MODEL};
            pg8::StaticOrder S; S.init(RP, ZN, F.G, (int)blockIdx.x);
            pg8::EpiBf16<0> E{(pg8::bf16_t*)(wsb + a.off[R_Z]), ZN, nullptr, 0, 0, 1.f};
            pg8::gemm_phase<pg8::EpiBf16<0>, pg8::StaticOrder, true, true>(F.lds + RING_OFF, g, S, E);
            SEAM(pb + PL_GEMM_IN);
        }
        if (IN(pb + PL_ZPOST)) { p_zpost(F, l); SEAM(pb + PL_ZPOST); }
        if (IN(pb + PL_LOCAL)) { p_gdn_chunk(F, l); p_s5_e(F, l); SEAM(pb + PL_LOCAL); }
        if (IN(pb + PL_MIX)) {
            p_gdn_chain(F, l);
            { const int tid = otid(), lane = tid & 63, wave = __builtin_amdgcn_readfirstlane(tid >> 6), NGW = F.G * NWAVES;
              for (int t = (F.vcu * NWAVES + wave + NGW - 256) % NGW; t < S5_NTASK; t += NGW) s5_scan_run(F, l, t, lane); }
            p_attention(F, l, lds); SEAM(pb + PL_MIX); }
        if (IN(pb + PL_MIXPOST)) { p_mixpost_a(F, l); p_mixpost_b(F, l); p_s5_out(F, l); SEAM(pb + PL_MIXPOST); }
        if (IN(pb + PL_GEMM_GLU)) {
            const KArgs ap = kargs(); const auto& a = *ap; WS_OPAQUE(a);
            { pg8::Gemm g{(const pg8::bf16_t*)(wsb + a.off[R_YC]), (const pg8::bf16_t*)(wsb + a.off[R_WGLU]) + (size_t)l * 1024 * 512, RP, 1024, 512};
              pg8::StaticOrder S; S.init(RP, 1024, F.G, (int)blockIdx.x); pg8::EpiGlu E{(pg8::bf16_t*)(wsb + a.off[R_OC]), WIDTH_C};
              pg8::gemm_phase<pg8::EpiGlu, pg8::StaticOrder, true, true>(F.lds + RING_OFF, g, S, E); }
            { pg8::Gemm g{(const pg8::bf16_t*)(wsb + a.off[R_OA]), (const pg8::bf16_t*)(wsb + a.off[R_WBR]) + ((size_t)l * 3 + 0) * 1024 * 512, RP, 1024, 512};
              pg8::StaticOrder S; S.init(RP, 1024, F.G, (int)blockIdx.x); pg8::EpiMerge<0> E{(float*)(wsb + a.off[R_MRG]), nullptr, (const pg8::bf16_t*)(wsb + a.off[R_Z]) + ZC_GATE, ZN};
              pg8::gemm_phase<pg8::EpiMerge<0>, pg8::StaticOrder, true, true>(F.lds + RING_OFF, g, S, E); }
            { pg8::Gemm g{(const pg8::bf16_t*)(wsb + a.off[R_OB]), (const pg8::bf16_t*)(wsb + a.off[R_WBR]) + ((size_t)l * 3 + 1) * 1024 * 512, RP, 1024, 512};
              pg8::StaticOrder S; S.init(RP, 1024, F.G, (int)blockIdx.x); pg8::EpiMerge<1> E{(float*)(wsb + a.off[R_MRG]), nullptr, (const pg8::bf16_t*)(wsb + a.off[R_Z]) + ZC_GATE + 1024, ZN};
              pg8::gemm_phase<pg8::EpiMerge<1>, pg8::StaticOrder, true, true>(F.lds + RING_OFF, g, S, E); }
            SEAM(pb + PL_GEMM_GLU); }
        if (IN(pb + PL_GEMM_BRC)) {
            const KArgs ap = kargs(); const auto& a = *ap; WS_OPAQUE(a);
            pg8::Gemm g{(const pg8::bf16_t*)(wsb + a.off[R_OC]), (const pg8::bf16_t*)(wsb + a.off[R_WBR]) + ((size_t)l * 3 + 2) * 1024 * 512, RP, 1024, 512};
            pg8::StaticOrder S; S.init(RP, 1024, F.G, (int)blockIdx.x); pg8::EpiMerge<2> E{(float*)(wsb + a.off[R_MRG]), (pg8::bf16_t*)(wsb + a.off[R_MRGB]), (const pg8::bf16_t*)(wsb + a.off[R_Z]) + ZC_GATE + 2048, ZN};
            pg8::gemm_phase<pg8::EpiMerge<2>, pg8::StaticOrder, true, true>(F.lds + RING_OFF, g, S, E);
            SEAM(pb + PL_GEMM_BRC); }
        if (IN(pb + PL_GEMM_OUT)) {
            const KArgs ap = kargs(); const auto& a = *ap; WS_OPAQUE(a);
            pg8::Gemm g{(const pg8::bf16_t*)(wsb + a.off[R_MRGB]), (const pg8::bf16_t*)(wsb + a.off[R_WOUT]) + (size_t)l * 1024 * 1024, RP, 1024, 1024};
            pg8::StaticOrder S; S.init(RP, 1024, F.G, (int)blockIdx.x); pg8::EpiResid E{(float*)(wsb + a.off[R_X]), D_MODEL};
            pg8::gemm_phase<pg8::EpiResid, pg8::StaticOrder, true, true>(F.lds + RING_OFF, g, S, E);
            SEAM(pb + PL_GEMM_OUT); }
        if (IN(pb + PL_NORM2)) { p_norm(F, l, I_N2); SEAM(pb + PL_NORM2); }
        if (IN(pb + PL_GEMM_PEER)) {
            const KArgs ap = kargs(); const auto& a = *ap; WS_OPAQUE(a);
            pg8::Gemm g{(const pg8::bf16_t*)(wsb + a.off[R_XN]), (const pg8::bf16_t*)(wsb + a.off[R_WQS]) + (size_t)l * PQ * D_MODEL, RP, PQ, D_MODEL};
            pg8::StaticOrder S; S.init(RP, PQ, F.G, (int)blockIdx.x); pg8::EpiF32 E{(float*)(wsb + a.off[R_SC]), PQ};
            pg8::gemm_phase<pg8::EpiF32, pg8::StaticOrder, true, true>(F.lds + RING_OFF, g, S, E);
            SEAM(pb + PL_GEMM_PEER); }
        if (IN(pb + PL_PEER)) { p_peer(F, l); SEAM(pb + PL_PEER); }
    }
    if (IN(PH_FINAL)) p_final(F);
#undef IN
#undef SEAM
}
}
#ifndef MK_ONE_LAUNCH
#define MK_ONE_LAUNCH 1
#endif
static int mk_grid = 0;
static bool mk_setup() {
    if (mk_grid) return mk_grid > 0;
    int dev = 0, cus = 0;
    if (hipGetDevice(&dev) != hipSuccess || hipDeviceGetAttribute(&cus, hipDeviceAttributeMultiprocessorCount, dev) != hipSuccess) { mk_grid = -1; return false; }
    if (hipFuncSetAttribute((const void*)mk::mk_fwd, hipFuncAttributeMaxDynamicSharedMemorySize, mk::LDS_BYTES) != hipSuccess) { fprintf(stderr, "kernel_launch: hipFuncSetAttribute failed\n"); mk_grid = -1; return false; }
    int per_cu = 0;
    if (hipOccupancyMaxActiveBlocksPerMultiprocessor(&per_cu, (const void*)mk::mk_fwd, mk::NTHR, mk::LDS_BYTES) != hipSuccess || per_cu < 1) { fprintf(stderr, "kernel_launch: occupancy query says %d workgroups per CU\n", per_cu); }
    (void)hipGetLastError();
    mk_grid = cus;
    return true;
}
static void mk_launch(mk::Args a, int lo, int hi, int region, hipStream_t stream) {
    a.ph_lo = lo; a.ph_hi = hi; a.bar_region = region;
    hipLaunchKernelGGL(mk::mk_fwd, dim3(mk_grid), dim3(mk::NTHR), mk::LDS_BYTES, stream, a);
    hipError_t e = hipPeekAtLastError(); if (e != hipSuccess) fprintf(stderr, "kernel_launch: launch failed: %s\n", hipGetErrorName(e));
}
extern "C" void kernel_launch(void* const* d_in, const int* in_sizes, int n_in, void* d_out, int out_size, void* d_ws, size_t ws_size, hipStream_t stream) {
    if (n_in != N_INPUTS || (size_t)out_size != (size_t)O_END) { fprintf(stderr, "kernel_launch: unexpected n_in %d / out_size %d\n", n_in, out_size); return; }
    if (!mk_setup()) return;
    const size_t MiB = 1u << 20;
    unsigned char* ws = (unsigned char*)d_ws;
    mk::Args a{};
    for (int i = 0; i < N_INPUTS; ++i) a.in[i] = (const float*)d_in[i];
    a.out = (float*)d_out; a.ws = ws;
    { using namespace mk; const struct { int r; size_t mib; } map[] = { {R_WIN, 1}, {R_WGLU, 59}, {R_WBR, 63}, {R_WOUT, 75}, {R_WQS, 83}, {R_S5T, 99}, {R_PU, 132}, {R_PV, 260}, {R_X, 388}, {R_XN, 456},
        {R_Z, 490}, {R_SC, 490}, {R_QN, 737}, {R_KN, 754}, {R_QKVB, 771}, {R_BG, 822}, {R_O, 823}, {R_MRGB, 823}, {R_OA, 857}, {R_OB, 874}, {R_GDN, 891}, {R_MRG, 891},
        {R_S5E, 986}, {R_YC, 986}, {R_S5X, 1003}, {R_OC, 1012} };
      for (auto& e : map) a.off[e.r] = e.mib * MiB; }
    if (1029 * MiB > ws_size) { fprintf(stderr, "kernel_launch: workspace too small (%zu)\n", ws_size); return; }
    if (hipMemsetAsync(ws, 0, mk::CTL_BYTES, stream) != hipSuccess) { fprintf(stderr, "kernel_launch: memset failed\n"); return; }
    a.pro_mask = mk::PM_X | mk::PM_WIN | mk::PM_TABLES | mk::PM_WREST | mk::PM_WQS | mk::PM_PEERW;
#if MK_ONE_LAUNCH
    mk_launch(a, 0, mk::PH_END, 0, stream);
#else
    int region = 0;
    mk_launch(a, mk::PH_PRO, mk::PH_PRO + 1, region++, stream);
    for (int l = 0; l < DEPTH; ++l) { const int pb = 1 + l * mk::NPL;
        for (int ph = mk::PL_NORM1; ph <= mk::PL_PEER; ++ph) { if (ph == mk::PL_GEMM_BRA || ph == mk::PL_GEMM_BRB) continue; mk_launch(a, pb + ph, pb + ph + 1, region++, stream); } }
    mk_launch(a, mk::PH_FINAL, mk::PH_END, region++, stream);
#endif
}
```

```cpp
#include <hip/hip_runtime.h>
#include <cstdio>
#include <cstdint>
#define MK_ONE_LAUNCH 1
#ifndef D_MODEL
#define D_MODEL 1024
#define BATCH 2
#define SEQ 8192
#define DEPTH 4
#define DEC_BATCH 16
#define DEC_SEQ 32
#define PAST_LEN 1024
#define N_HEADS_A 4
#define HEAD_DIM_A 64
#define N_HEADS_B 4
#define HEAD_DIM_B 128
#define S5_GROUPS 32
#define S5_STATE 64
#define PEER_HEADS 8
#define PEER_QDIM 256
#define N_KEYS 128
#endif
#define CHUNK 64
#define N_META 16
#define EPSF 1e-6f
#define NUM_BUCKETS 32
#define CONV_W 4
#define S5_GROUP 16
#define PEER_TOPK 16
#define N_EXPERTS (N_KEYS * N_KEYS)
#define WIDTH_A (N_HEADS_A * 2 * HEAD_DIM_A)
#define WIDTH_B (N_HEADS_B * HEAD_DIM_B)
#define WIDTH_C (S5_GROUPS * S5_GROUP)
#define OFF_QA 0
#define OFF_KA (OFF_QA + WIDTH_A)
#define OFF_VA (OFF_KA + WIDTH_A)
#define OFF_QKVB (OFF_VA + WIDTH_A)
#define OFF_GB (OFF_QKVB + 3 * WIDTH_B)
#define OFF_BETA (OFF_GB + WIDTH_B)
#define OFF_ALPHA (OFF_BETA + N_HEADS_B)
#define OFF_UC (OFF_ALPHA + N_HEADS_B)
#define OFF_GATE (OFF_UC + WIDTH_C)
#define D_IN (OFF_GATE + 3 * D_MODEL)
#define LP (N_META + SEQ)
#define NP (BATCH * LP)
#define NS (DEC_BATCH * DEC_SEQ)
#define NT (NP + NS)
#define PQ (PEER_HEADS * PEER_QDIM)

enum { I_XP, I_XS, I_CK, I_CV, I_SCONV, I_SDELTA, I_SRE, I_SIM, I_META, I_REL, I_N1, I_N2, I_FN, I_WIN, I_QN, I_KN, I_LQK, I_SUBLN, I_CONVW, I_ALOG, I_DTB, I_GDNN,
       I_AR, I_AI, I_BR, I_BI, I_CR, I_CI, I_SD, I_LDT, I_WGLU, I_WBA, I_WBB, I_WBC, I_WOUT, I_PWQ, I_PSK, I_PU, I_PV, N_INPUTS };
#define O_YP 0
#define O_YS (O_YP + (size_t)BATCH * SEQ * D_MODEL)
#define O_KP (O_YS + (size_t)NS * D_MODEL)
#define O_VP (O_KP + (size_t)DEPTH * NP * WIDTH_A)
#define O_KS (O_VP + (size_t)DEPTH * NP * WIDTH_A)
#define O_VS (O_KS + (size_t)DEPTH * NS * WIDTH_A)
#define O_CP (O_VS + (size_t)DEPTH * NS * WIDTH_A)
#define O_CS (O_CP + (size_t)DEPTH * BATCH * (CONV_W - 1) * 3 * WIDTH_B)
#define O_DP (O_CS + (size_t)DEPTH * DEC_BATCH * (CONV_W - 1) * 3 * WIDTH_B)
#define O_DS (O_DP + (size_t)DEPTH * BATCH * N_HEADS_B * HEAD_DIM_B * HEAD_DIM_B)
#define O_SRP (O_DS + (size_t)DEPTH * DEC_BATCH * N_HEADS_B * HEAD_DIM_B * HEAD_DIM_B)
#define O_SIP (O_SRP + (size_t)DEPTH * BATCH * S5_GROUPS * S5_STATE)
#define O_SRS (O_SIP + (size_t)DEPTH * BATCH * S5_GROUPS * S5_STATE)
#define O_SIS (O_SRS + (size_t)DEPTH * DEC_BATCH * S5_GROUPS * S5_STATE)
#define O_END (O_SIS + (size_t)DEPTH * DEC_BATCH * S5_GROUPS * S5_STATE)

namespace pg8 {
#define PG8_LAS __attribute__((address_space(3)))
typedef unsigned short bf16_t;
typedef short bf16x8 __attribute__((ext_vector_type(8)));
typedef float f32x4 __attribute__((ext_vector_type(4)));
typedef unsigned u32x4 __attribute__((ext_vector_type(4)));
constexpr int BM = 256, BK = 64, HALF = 128, HTB = HALF * BK * 2  , STAGE_BYTES = 8 * HTB, NXCD = 8, WGM = 8;

__host__ __device__ __forceinline__ int lds_byte(int r, int c) { const int st = (r >> 4) * 2 + (c >> 5), rr = r & 15, cc = c & 31, ob = rr * 64 + cc * 2; return st * 1024 + (ob ^ (((ob >> 9) & 1) << 5)); }
__host__ __device__ __forceinline__ void stage_rc(int b, int& R, int& C) { const int st = b / 1024, sb = b % 1024, swz = sb ^ (((sb >> 9) & 1) << 5); R = (st >> 1) * 16 + swz / 64; C = (st & 1) * 32 + (swz % 64) / 2; }
__host__ __device__ __forceinline__ int perm32(int rho) { const int n = rho >> 4, i = rho & 15; return 8 * (i >> 2) + 4 * n + (i & 3); }

struct Unit { int pm, pn; };
struct Gemm { const bf16_t* A; const bf16_t* Bt; int M, N, K; };

struct StaticOrder {
    int nM, nN, nwg, G, c;
    __host__ __device__ void init(int M, int N, int G_, int c_) { nM = M / BM; nN = N / BM; nwg = nM * nN; G = G_; c = c_; }
    __host__ __device__ bool next(int i, Unit& u) const {
        const long L = (long)i * G + c; if (L >= nwg) return false;
        int wgid = (int)L; { const int q = nwg / NXCD, r = nwg % NXCD, xcd = wgid % NXCD, off = wgid / NXCD; wgid = (xcd < r ? xcd * (q + 1) : r * (q + 1) + (xcd - r) * q) + off; }
        const int nig = WGM * nN, gid = wgid / nig, fm = gid * WGM, gsz = (nM - fm) < WGM ? (nM - fm) : WGM;
        u.pm = fm + ((wgid % nig) % gsz); u.pn = (wgid % nig) / gsz; return true;
    }
    __device__ __forceinline__ void a_ready(const Unit&) const {}
    __device__ __forceinline__ void done(const Unit&) const {}
};

__device__ __forceinline__ unsigned cvt_pk_bf16(float lo, float hi) { unsigned r; asm volatile("v_cvt_pk_bf16_f32 %0, %1, %2" : "=v"(r) : "v"(lo), "v"(hi)); return r; }
typedef float f32x2 __attribute__((ext_vector_type(2)));
__device__ __forceinline__ f32x2 gelu_pk(f32x2 v) {
    const f32x2 av = __builtin_elementwise_abs(v), d = av * 0.2316418882f + 1.0f;
    f32x2 t; t.x = __builtin_amdgcn_rcpf(d.x); t.y = __builtin_amdgcn_rcpf(d.y);
    f32x2 q = t * 0.5307027145f + (-0.7265760135f); q = q * t + 0.7107068705f; q = q * t + (-0.142248368f); q = q * t + 0.127414796f; q = q * t;
    const f32x2 s = (v * v) * (-0.72134752044f);
    f32x2 e; e.x = __builtin_amdgcn_exp2f(s.x); e.y = __builtin_amdgcn_exp2f(s.y);
    const f32x2 m = v * (q * e), r = v - m;
    f32x2 o; o.x = v.x < 0.f ? m.x : r.x; o.y = v.y < 0.f ? m.y : r.y; return o;
}

template <int ACT  > struct EpiBf16 {
    static constexpr bool PERM = true, AFTER_DRAIN = false; static_assert(ACT == 0 || ACT == 1, "EpiBf16: ACT is 0 (none) or 1 (gelu_pk)");
    bf16_t* O; int ldc; const float* bias; int split_cols; size_t split_stride; float scale0;
    __device__ __forceinline__ void operator()(const f32x4 (&acc)[2][2][4][2], const Unit& u, int wr, int wc, int fr, int fq) const {
        const int row0 = u.pm * BM + wr * 64 + fr; int colt = u.pn * BM; bf16_t* base = O;
        float sc = 1.f; if (split_cols) { const int t = colt / split_cols; base += (size_t)t * split_stride; colt -= t * split_cols; if (t == 0) sc = scale0; }
        const int col0 = colt + wc * 32 + 8 * fq, bcol0 = u.pn * BM + wc * 32 + 8 * fq;
        f32x4 bv[2][2];
#pragma unroll
        for (int bj = 0; bj < 2; ++bj)
#pragma unroll
            for (int n = 0; n < 2; ++n) bv[bj][n] = bias ? *(const f32x4*)(bias + bcol0 + bj * HALF + 4 * n) : (f32x4){0.f, 0.f, 0.f, 0.f};
#pragma unroll
        for (int ai = 0; ai < 2; ++ai)
#pragma unroll
            for (int m = 0; m < 4; ++m) { bf16_t* rowp = base + (size_t)(row0 + ai * HALF + m * 16) * ldc + col0;
#pragma unroll
                for (int bj = 0; bj < 2; ++bj) { f32x4 v0 = acc[ai][bj][m][0] + bv[bj][0], v1 = acc[ai][bj][m][1] + bv[bj][1];
                    if (ACT == 1) { f32x2 a = gelu_pk((f32x2){v0[0], v0[1]}), b = gelu_pk((f32x2){v0[2], v0[3]}), c = gelu_pk((f32x2){v1[0], v1[1]}), d = gelu_pk((f32x2){v1[2], v1[3]});
                        v0 = (f32x4){a.x, a.y, b.x, b.y}; v1 = (f32x4){c.x, c.y, d.x, d.y}; }
                    v0 = v0 * sc; v1 = v1 * sc; u32x4 w; w.x = cvt_pk_bf16(v0[0], v0[1]); w.y = cvt_pk_bf16(v0[2], v0[3]); w.z = cvt_pk_bf16(v1[0], v1[1]); w.w = cvt_pk_bf16(v1[2], v1[3]);
                    *(u32x4*)(rowp + bj * HALF) = w; } }
    }
};

__device__ __forceinline__ float epi_sigm(float x) { return 1.f / (1.f + __expf(-x)); }
struct EpiGlu {
    static constexpr bool PERM = false, AFTER_DRAIN = false;
    bf16_t* O; int ldo;
    __device__ __forceinline__ void operator()(const f32x4 (&acc)[2][2][4][2], const Unit& u, int wr, int wc, int fr, int fq) const {
        const int row0 = u.pm * BM + wr * 64 + fr;
#pragma unroll
        for (int ai = 0; ai < 2; ++ai)
#pragma unroll
            for (int m = 0; m < 4; ++m) { bf16_t* rowp = O + (size_t)(row0 + ai * HALF + m * 16) * ldo + 4 * fq;
#pragma unroll
                for (int bj = 0; bj < 2; ++bj) { const int G = u.pn * 8 + bj * 4 + wc; const f32x4 av = acc[ai][bj][m][0], gv = acc[ai][bj][m][1];
                    typedef unsigned u32x2 __attribute__((ext_vector_type(2))); u32x2 w;
                    w.x = cvt_pk_bf16(av[0] * epi_sigm(gv[0]), av[1] * epi_sigm(gv[1])); w.y = cvt_pk_bf16(av[2] * epi_sigm(gv[2]), av[3] * epi_sigm(gv[3]));
                    *(u32x2*)(rowp + 16 * G) = w; } }
    }
};
template <int MODE> struct EpiMerge {
    static constexpr bool PERM = true, AFTER_DRAIN = false;
    float* M; bf16_t* Mb; const bf16_t* Zg; int ldz;
    __device__ __forceinline__ void operator()(const f32x4 (&acc)[2][2][4][2], const Unit& u, int wr, int wc, int fr, int fq) const {
        const int row0 = u.pm * BM + wr * 64 + fr, col0 = u.pn * BM + wc * 32 + 8 * fq;
#pragma unroll
        for (int ai = 0; ai < 2; ++ai)
#pragma unroll
            for (int m = 0; m < 4; ++m) { const size_t row = (size_t)(row0 + ai * HALF + m * 16);
#pragma unroll
                for (int bj = 0; bj < 2; ++bj) { const int col = col0 + bj * HALF;
                    const u32x4 gz = *(const u32x4*)(Zg + row * ldz + col);
                    float g[8]; g[0] = __builtin_bit_cast(float, gz.x << 16); g[1] = __builtin_bit_cast(float, gz.x & 0xffff0000u); g[2] = __builtin_bit_cast(float, gz.y << 16); g[3] = __builtin_bit_cast(float, gz.y & 0xffff0000u);
                    g[4] = __builtin_bit_cast(float, gz.z << 16); g[5] = __builtin_bit_cast(float, gz.z & 0xffff0000u); g[6] = __builtin_bit_cast(float, gz.w << 16); g[7] = __builtin_bit_cast(float, gz.w & 0xffff0000u);
                    f32x4 v0 = acc[ai][bj][m][0], v1 = acc[ai][bj][m][1];
#pragma unroll
                    for (int j = 0; j < 4; ++j) { v0[j] *= epi_sigm(g[j]); v1[j] *= epi_sigm(g[4 + j]); }
                    float* mp = M + row * 1024 + col;
                    if (MODE != 0) { v0 += *(const f32x4*)mp; v1 += *(const f32x4*)(mp + 4); }
                    if (MODE != 2) { *(f32x4*)mp = v0; *(f32x4*)(mp + 4) = v1; }
                    else { u32x4 w; w.x = cvt_pk_bf16(v0[0], v0[1]); w.y = cvt_pk_bf16(v0[2], v0[3]); w.z = cvt_pk_bf16(v1[0], v1[1]); w.w = cvt_pk_bf16(v1[2], v1[3]); *(u32x4*)(Mb + row * 1024 + col) = w; } } }
    }
};
struct EpiResid {
    static constexpr bool PERM = false, AFTER_DRAIN = false;
    float* X; int ldx;
    __device__ __forceinline__ void operator()(const f32x4 (&acc)[2][2][4][2], const Unit& u, int wr, int wc, int fr, int fq) const {
        const int row0 = u.pm * BM + wr * 64 + fr, col0 = u.pn * BM + wc * 32 + 4 * fq;
#pragma unroll
        for (int ai = 0; ai < 2; ++ai)
#pragma unroll
            for (int m = 0; m < 4; ++m) { const int row = row0 + ai * HALF + m * 16;
                bool ok = true; if (row < 16896) { const int p = row % 8448; ok = p >= 48 && p < 8256; }
                if (ok) { float* rowp = X + (size_t)row * ldx + col0;
#pragma unroll
                    for (int bj = 0; bj < 2; ++bj)
#pragma unroll
                        for (int n = 0; n < 2; ++n) { f32x4* p4 = (f32x4*)(rowp + bj * HALF + n * 16); *p4 = *p4 + acc[ai][bj][m][n]; } } }
    }
};
struct EpiF32 {
    static constexpr bool PERM = false, AFTER_DRAIN = false;
    float* C; int ldc;
    __device__ __forceinline__ void operator()(const f32x4 (&acc)[2][2][4][2], const Unit& u, int wr, int wc, int fr, int fq) const {
        const int row0 = u.pm * BM + wr * 64 + fr, col0 = u.pn * BM + wc * 32 + 4 * fq;
#pragma unroll
        for (int ai = 0; ai < 2; ++ai)
#pragma unroll
            for (int m = 0; m < 4; ++m) { float* rowp = C + (size_t)(row0 + ai * HALF + m * 16) * ldc + col0;
#pragma unroll
                for (int bj = 0; bj < 2; ++bj)
#pragma unroll
                    for (int n = 0; n < 2; ++n) *(f32x4*)(rowp + bj * HALF + n * 16) = acc[ai][bj][m][n]; }
    }
};

template <class Epi, class Sched, bool ALIGN_EPI = false, bool SP2 = false>
__device__ __forceinline__ void gemm_phase(PG8_LAS unsigned char* lds, const Gemm g, const Sched& S, const Epi& E) {
    int tid_ = threadIdx.x; asm volatile("" : "+v"(tid_));
    const int tid = tid_, wid = __builtin_amdgcn_readfirstlane(tid >> 6), lane = tid & 63, wr = wid >> 2, wc = wid & 3, fr = lane & 15, fq = lane >> 4;
    const int K = g.K, nt = K / BK;
    unsigned voffA[2], voffB[2];
#pragma unroll
    for (int i = 0; i < 2; ++i) { int R, C; stage_rc(tid * 16 + i * 8192, R, C); const int Rb = Epi::PERM ? ((R & ~31) + perm32(R & 31)) : R;
        voffA[i] = (unsigned)(R * K + C) * 2u; voffB[i] = (unsigned)(Rb * K + C) * 2u; }
    const size_t kstep = (size_t)(BK * 2);
    const size_t hstep = (size_t)HALF * K * 2;
    const size_t tstep = 2 * hstep;
    const unsigned ldsw = (unsigned)wid * 1024u;
    const int aoff = lds_byte(wr * 64 + fr, fq * 8), boff = lds_byte(wc * 32 + fr, fq * 8);
#define PG8_SA(b, h) (((b) * 2 + (h)) * HTB)
#define PG8_SB(b, h) ((4 + (b) * 2 + (h)) * HTB)
#define PG8_STAGE(bufoff, gbase, voff) do { _Pragma("unroll") for (int _i = 0; _i < 2; ++_i) \
        __builtin_amdgcn_global_load_lds((const unsigned*)((const char*)(gbase) + (voff)[_i]), (PG8_LAS unsigned*)(lds + (bufoff) + ldsw + _i * 8192), 16, 0, 0); } while (0)
#define PG8_LDA(dst, b, h) do { _Pragma("unroll") for (int m = 0; m < 4; ++m) _Pragma("unroll") for (int k = 0; k < 2; ++k) dst[m][k] = *(const PG8_LAS bf16x8*)(lds + PG8_SA(b, h) + aoff + m * 2048 + k * 1024); } while (0)
#define PG8_LDB(dst, b, h) do { _Pragma("unroll") for (int n = 0; n < 2; ++n) _Pragma("unroll") for (int k = 0; k < 2; ++k) dst[n][k] = *(const PG8_LAS bf16x8*)(lds + PG8_SB(b, h) + boff + n * 2048 + k * 1024); } while (0)
#define PG8_MMA(ai, bj, At, Bt) do { __builtin_amdgcn_s_setprio(1); _Pragma("unroll") for (int m = 0; m < 4; ++m) _Pragma("unroll") for (int n = 0; n < 2; ++n) _Pragma("unroll") for (int k = 0; k < 2; ++k) \
        acc[ai][bj][m][n] = __builtin_amdgcn_mfma_f32_16x16x32_bf16(Bt[n][k], At[m][k], acc[ai][bj][m][n], 0, 0, 0); __builtin_amdgcn_s_setprio(0); } while (0)
#define PG8_WAIT_V(n) asm volatile("s_waitcnt vmcnt(" #n ")" ::: "memory")
#define PG8_WAIT_L(n) asm volatile("s_waitcnt lgkmcnt(" #n ")" ::: "memory")
#define PG8_BAR __builtin_amdgcn_s_barrier()
#define PG8_SCHED __builtin_amdgcn_sched_barrier(0)
    Unit cur, nxt; int ui = 0;
    if (!S.next(0, cur)) return;
    f32x4 acc[2][2][4][2];
#pragma unroll
    for (int a = 0; a < 2; ++a)
#pragma unroll
        for (int b = 0; b < 2; ++b)
#pragma unroll
            for (int m = 0; m < 4; ++m)
#pragma unroll
                for (int n = 0; n < 2; ++n) acc[a][b][m][n] = (f32x4){0.f, 0.f, 0.f, 0.f};
    bf16x8 At[4][2], B0[2][2], B1[2][2];
    const char* cA = (const char*)g.A + (size_t)cur.pm * tstep; const char* cB = (const char*)g.Bt + (size_t)cur.pn * tstep;
    S.a_ready(cur);
    if constexpr (SP2) {
        PG8_STAGE(PG8_SB(0, 0), cB, voffB); PG8_STAGE(PG8_SB(0, 1), cB + hstep, voffB); PG8_STAGE(PG8_SA(0, 0), cA, voffA); PG8_STAGE(PG8_SA(0, 1), cA + hstep, voffA);
        if (wr == 1) PG8_BAR;
        PG8_WAIT_V(2); PG8_BAR;
        PG8_STAGE(PG8_SB(1, 0), cB + kstep, voffB); PG8_STAGE(PG8_SA(1, 0), cA + kstep, voffA); PG8_STAGE(PG8_SB(1, 1), cB + hstep + kstep, voffB);
        PG8_WAIT_V(6); PG8_BAR;
    } else {
        PG8_STAGE(PG8_SB(0, 0), cB, voffB); PG8_STAGE(PG8_SA(0, 0), cA, voffA); PG8_STAGE(PG8_SB(0, 1), cB + hstep, voffB); PG8_STAGE(PG8_SA(0, 1), cA + hstep, voffA);
        if (wr == 1) PG8_BAR;
        PG8_WAIT_V(4); PG8_BAR;
        PG8_STAGE(PG8_SB(1, 0), cB + kstep, voffB); PG8_STAGE(PG8_SA(1, 0), cA + kstep, voffA); PG8_STAGE(PG8_SB(1, 1), cB + hstep + kstep, voffB);
        PG8_WAIT_V(6); PG8_BAR;
    }
    for (;;) {
        const bool has_next = S.next(ui + 1, nxt);
        const char* nA = has_next ? (const char*)g.A + (size_t)nxt.pm * tstep : cA; const char* nB = has_next ? (const char*)g.Bt + (size_t)nxt.pn * tstep : cB;
        for (int t = 0; t < nt; t += 2) {
            const bool last = (t == nt - 2);
            const char* a1 = cA + (size_t)(t + 1) * kstep;
            const char* a2 = last ? nA : cA + (size_t)(t + 2) * kstep; const char* b2 = last ? nB : cB + (size_t)(t + 2) * kstep;
            const char* a3 = a2 + kstep; const char* b3 = b2 + kstep;
            if (last && has_next) S.a_ready(nxt);
            if constexpr (SP2) {
            PG8_LDB(B0, 0, 0); PG8_LDB(B1, 0, 1); PG8_SCHED; PG8_LDA(At, 0, 0); PG8_STAGE(PG8_SA(1, 1), a1 + hstep, voffA);
            PG8_WAIT_V(8); PG8_WAIT_L(0); PG8_BAR; PG8_MMA(0, 0, At, B0); PG8_MMA(0, 1, At, B1); PG8_BAR; PG8_SCHED;
            PG8_LDA(At, 0, 1); PG8_STAGE(PG8_SB(0, 0), b2, voffB); PG8_STAGE(PG8_SB(0, 1), b2 + hstep, voffB); PG8_STAGE(PG8_SA(0, 0), a2, voffA);
            PG8_WAIT_V(8); PG8_WAIT_L(0); PG8_BAR; PG8_MMA(1, 0, At, B0); PG8_MMA(1, 1, At, B1); PG8_BAR; PG8_SCHED;
            PG8_LDB(B0, 1, 0); PG8_LDB(B1, 1, 1); PG8_SCHED; PG8_LDA(At, 1, 0); PG8_STAGE(PG8_SA(0, 1), a2 + hstep, voffA);
            PG8_WAIT_V(8); PG8_WAIT_L(0); PG8_BAR; PG8_MMA(0, 0, At, B0); PG8_MMA(0, 1, At, B1); PG8_BAR; PG8_SCHED;
            PG8_LDA(At, 1, 1); PG8_STAGE(PG8_SB(1, 0), b3, voffB); PG8_STAGE(PG8_SB(1, 1), b3 + hstep, voffB); PG8_STAGE(PG8_SA(1, 0), a3, voffA);
            PG8_WAIT_V(8); PG8_WAIT_L(0); PG8_BAR; PG8_MMA(1, 0, At, B0); PG8_MMA(1, 1, At, B1); PG8_BAR; PG8_SCHED;
            } else {
            PG8_LDB(B0, 0, 0); PG8_SCHED; PG8_LDA(At, 0, 0); PG8_STAGE(PG8_SA(1, 1), a1 + hstep, voffA);
            PG8_WAIT_L(8); PG8_BAR; PG8_WAIT_L(0); PG8_MMA(0, 0, At, B0); PG8_BAR; PG8_SCHED;
            PG8_LDB(B1, 0, 1); PG8_STAGE(PG8_SB(0, 0), b2, voffB);
            PG8_BAR; PG8_WAIT_L(0); PG8_MMA(0, 1, At, B1); PG8_BAR;
            PG8_LDA(At, 0, 1); PG8_STAGE(PG8_SA(0, 0), a2, voffA);
            PG8_BAR; PG8_WAIT_L(0); PG8_MMA(1, 0, At, B0); PG8_BAR; PG8_SCHED;
            PG8_STAGE(PG8_SB(0, 1), b2 + hstep, voffB);
            PG8_WAIT_V(6); PG8_BAR; PG8_MMA(1, 1, At, B1); PG8_BAR;
            PG8_LDB(B0, 1, 0); PG8_SCHED; PG8_LDA(At, 1, 0); PG8_STAGE(PG8_SA(0, 1), a2 + hstep, voffA);
            PG8_WAIT_L(8); PG8_BAR; PG8_WAIT_L(0); PG8_MMA(0, 0, At, B0); PG8_BAR; PG8_SCHED;
            PG8_LDB(B1, 1, 1); PG8_STAGE(PG8_SB(1, 0), b3, voffB);
            PG8_BAR; PG8_WAIT_L(0); PG8_MMA(0, 1, At, B1); PG8_BAR;
            PG8_LDA(At, 1, 1); PG8_STAGE(PG8_SA(1, 0), a3, voffA);
            PG8_BAR; PG8_WAIT_L(0); PG8_MMA(1, 0, At, B0); PG8_BAR; PG8_SCHED;
            PG8_STAGE(PG8_SB(1, 1), b3 + hstep, voffB);
            PG8_WAIT_V(6); PG8_BAR; PG8_MMA(1, 1, At, B1); PG8_BAR;
            }
        }
        if constexpr (ALIGN_EPI) { if (wr == 0) PG8_BAR; }
        if constexpr (!Epi::AFTER_DRAIN) { E(acc, cur, wr, wc, fr, fq); S.done(cur); }
        if (!has_next) break;
#pragma unroll
        for (int a = 0; a < 2; ++a)
#pragma unroll
            for (int b = 0; b < 2; ++b)
#pragma unroll
                for (int m = 0; m < 4; ++m)
#pragma unroll
                    for (int n = 0; n < 2; ++n) acc[a][b][m][n] = (f32x4){0.f, 0.f, 0.f, 0.f};
        cur = nxt; cA = nA; cB = nB; ++ui;
        if constexpr (ALIGN_EPI) { if (wr == 1) PG8_BAR; }
    }
    PG8_WAIT_V(0);
    if constexpr (!ALIGN_EPI) { if (wr == 0) PG8_BAR; }
    PG8_BAR;
    if constexpr (Epi::AFTER_DRAIN) { E.fused(acc, cur, wr, wc, fr, fq, lds, wid, lane); S.done(cur); }
#undef PG8_SA
#undef PG8_SB
#undef PG8_STAGE
#undef PG8_LDA
#undef PG8_LDB
#undef PG8_MMA
#undef PG8_WAIT_V
#undef PG8_WAIT_L
#undef PG8_BAR
#undef PG8_SCHED
}
}
#include <hip/hip_bf16.h>
#include <cmath>
namespace attn_body {
using bf16=__hip_bfloat16;
using bf16x8=__attribute__((ext_vector_type(8)))short;
using s16x4=__attribute__((ext_vector_type(4)))short;
using f32x16=__attribute__((ext_vector_type(16)))float;
using u32x4=__attribute__((ext_vector_type(4)))unsigned;
constexpr int ASEQ=8448,D=64;
constexpr int QP=512,KP=512,VP=7424,OP=1024;
constexpr int NW=8,QBLK=32,QB=QBLK*NW,KVBLK=64,NQB=ASEQ/QB;
constexpr int ATTN_UNIT_ROWS=QB;
__device__ __forceinline__ int crow(int r,int hi){return (r&3)+8*(r>>2)+4*hi;}
#define SBAR() __builtin_amdgcn_sched_barrier(0)
constexpr int BT_OFF=383, BT_N=640;
__device__ __forceinline__ void bmask(f32x16&p0,f32x16&p1,int t,int q0,int wid,int r32,int hi,const __attribute__((address_space(3))) float*tab){
  const float NEG=-INFINITY; const int qw=q0+32*wid;
  if(t>(qw>>6)){
    #pragma unroll
    for(int r=0;r<16;++r){p0[r]=NEG;p1[r]=NEG;} return; }
  if(t>0 && 64*t+63+91<=qw) return;
  const int q=qw+r32, kb=64*t+4*hi;
  #pragma unroll
  for(int r=0;r<16;++r){ const int kv=kb+(r&3)+8*(r>>2); int i0=kv-q+BT_OFF, i1=i0+32; i0=i0<0?0:i0; i1=i1<0?0:i1;
    p0[r]+=tab[i0]; p1[r]+=tab[i1]; if(kv<48)p0[r]=NEG; if(kv+32<48)p1[r]=NEG; }
}

constexpr int NSLOT=3, SLOTB=8192;
constexpr int LDS_K=0, LDS_V=NSLOT*SLOTB, LDS_WS=2*NSLOT*SLOTB, LDS_OST=LDS_WS+NW*64*4, LDS_BT=LDS_OST+NW*4096, LDS_BYTES=LDS_BT+BT_N*4;
constexpr float C2=0.125f*1.4426950408889634f;
__device__ __forceinline__ void glds16(const void*gsrc,unsigned lds_dst){unsigned keep;
  asm volatile("s_mov_b32 %0, m0\n\ts_mov_b32 m0, %2\n\ts_nop 0\n\tglobal_load_lds_dwordx4 %1, off\n\ts_mov_b32 m0, %0":"=&s"(keep):"v"(gsrc),"s"(lds_dst):"memory");}
__device__ __forceinline__ float max3f(float a,float b,float c){float r;asm("v_max3_f32 %0, %1, %2, %3":"=v"(r):"v"(a),"v"(b),"v"(c));return r;}
__device__ __forceinline__ float max2f(float a,float b){float r;asm("v_max_f32_e32 %0, %1, %2":"=v"(r):"v"(a),"v"(b));return r;}
__device__ __forceinline__ float fadd_s(float a,float b){float r;asm("v_add_f32_e32 %0, %1, %2":"=v"(r):"v"(a),"v"(b));return r;}
__device__ __forceinline__ float fsub_s(float a,float b){float r;asm("v_sub_f32_e32 %0, %1, %2":"=v"(r):"v"(a),"v"(b));return r;}
typedef float f32x2_t __attribute__((ext_vector_type(2))); typedef __bf16 bf16x2_t __attribute__((ext_vector_type(2)));
__device__ __forceinline__ unsigned cvtpk_s(float lo,float hi){f32x2_t v={lo,hi};bf16x2_t b=__builtin_convertvector(v,bf16x2_t);return __builtin_bit_cast(unsigned,b);}
#define WAIT_BAR(N) asm volatile("s_waitcnt vmcnt(" #N ") lgkmcnt(0)\n\ts_barrier":::"memory")

__device__ __forceinline__ void qkt(f32x16&p0,f32x16&p1,const char*Kslot,const bf16x8*qr,const f32x16&negm,int r32,int hi){
  const char*kb=Kslot+hi*1024+r32*16;
  #pragma unroll
  for(int d0=0;d0<4;++d0){
    const bf16x8 b0=*reinterpret_cast<const bf16x8*>(kb+d0*2048);
    const bf16x8 b1=*reinterpret_cast<const bf16x8*>(kb+d0*2048+512);
    if(d0==0){p0=__builtin_amdgcn_mfma_f32_32x32x16_bf16(b0,qr[0],negm,0,0,0);p1=__builtin_amdgcn_mfma_f32_32x32x16_bf16(b1,qr[0],negm,0,0,0);}
    else{p0=__builtin_amdgcn_mfma_f32_32x32x16_bf16(b0,qr[d0],p0,0,0,0);p1=__builtin_amdgcn_mfma_f32_32x32x16_bf16(b1,qr[d0],p1,0,0,0);}}
}
typedef __attribute__((address_space(3))) const char* lds_cptr;
typedef __attribute__((address_space(3))) const float* lds_cfptr;
typedef short v4i16_t __attribute__((ext_vector_type(4)));
__device__ __forceinline__ void kload8(bf16x8*kf,lds_cptr kp){
  kf[0]=*(const __attribute__((address_space(3))) bf16x8*)(kp);      kf[1]=*(const __attribute__((address_space(3))) bf16x8*)(kp+512);
  kf[2]=*(const __attribute__((address_space(3))) bf16x8*)(kp+2048); kf[3]=*(const __attribute__((address_space(3))) bf16x8*)(kp+2560);
  kf[4]=*(const __attribute__((address_space(3))) bf16x8*)(kp+4096); kf[5]=*(const __attribute__((address_space(3))) bf16x8*)(kp+4608);
  kf[6]=*(const __attribute__((address_space(3))) bf16x8*)(kp+6144); kf[7]=*(const __attribute__((address_space(3))) bf16x8*)(kp+6656);
}
__device__ __forceinline__ void kload2(bf16x8*kf,lds_cptr kp,int j){ kf[2*j]=*(const __attribute__((address_space(3))) bf16x8*)(kp+j*2048); kf[2*j+1]=*(const __attribute__((address_space(3))) bf16x8*)(kp+j*2048+512); }
__device__ __forceinline__ s16x4 vtr(lds_cptr p){ return __builtin_bit_cast(s16x4,__builtin_amdgcn_ds_read_tr16_b64_v4i16((__attribute__((address_space(3))) v4i16_t*)p)); }
__device__ __forceinline__ float rowmax(const f32x16&p0,const f32x16&p1){
  float a=max3f(p0[0],p0[1],p1[0]),b=max3f(p0[2],p0[3],p1[1]);a=max3f(a,p1[2],p1[3]);
  #pragma unroll
  for(int r=4;r<16;r+=4){a=max3f(a,p0[r],p0[r+1]);b=max3f(b,p0[r+2],p0[r+3]);a=max3f(a,p1[r],p1[r+1]);b=max3f(b,p1[r+2],p1[r+3]);}
  const float m=max2f(a,b);
  auto rr=__builtin_amdgcn_permlane32_swap(__float_as_uint(m),__float_as_uint(m),false,false);
  return max2f(__uint_as_float(rr[0]),__uint_as_float(rr[1]));
}
__device__ __forceinline__ void pv(f32x16*o,int vb,bf16x8 pa0,bf16x8 pa1,bf16x8 pa2,bf16x8 pa3){
  #pragma unroll
  for(int d0=0;d0<2;++d0){s16x4 lo[4],hi[4];
    #pragma unroll
    for(int ks=0;ks<4;++ks){
      asm volatile("ds_read_b64_tr_b16 %0,%1 offset:%c2":"=&v"(lo[ks]):"v"(vb),"i"(d0*4096+ks*1024):"memory");
      asm volatile("ds_read_b64_tr_b16 %0,%1 offset:%c2":"=&v"(hi[ks]):"v"(vb),"i"(d0*4096+ks*1024+512):"memory");}
    asm volatile("s_waitcnt lgkmcnt(0)":::"memory");SBAR();
    #define PK(k) (bf16x8){lo[k][0],lo[k][1],lo[k][2],lo[k][3],hi[k][0],hi[k][1],hi[k][2],hi[k][3]}
    o[d0]=__builtin_amdgcn_mfma_f32_32x32x16_bf16(pa0,PK(0),o[d0],0,0,0);
    o[d0]=__builtin_amdgcn_mfma_f32_32x32x16_bf16(pa1,PK(1),o[d0],0,0,0);
    o[d0]=__builtin_amdgcn_mfma_f32_32x32x16_bf16(pa2,PK(2),o[d0],0,0,0);
    o[d0]=__builtin_amdgcn_mfma_f32_32x32x16_bf16(pa3,PK(3),o[d0],0,0,0);
    #undef PK
  }
}

#ifndef ATTN_STORE16
#define ATTN_STORE16(p,v) (*(u32x4*)(p)=(v))
#endif
template<int THRL> __device__ __forceinline__ void attn_unit(int b,int qoff,int voff,int ooff,int qb,const bf16*Q,const bf16*__restrict__ K,const bf16*__restrict__ V,bf16*O,char*shm){
  int tid_=threadIdx.x; asm volatile("":"+v"(tid_)); const int tid=tid_,lane=tid&63,r32=lane&31,hi=lane>>5; const int wid=__builtin_amdgcn_readfirstlane(tid>>6);
  const long rowbase=(long)b*ASEQ; const int q0=qb*QB;
  const bf16*Qw=Q+(rowbase+q0+wid*QBLK)*QP+qoff;
  const bf16*Kh=K+rowbase*KP+qoff,*Vh=V+rowbase*VP+voff;
  const unsigned lds0=(unsigned)(uintptr_t)shm;
  float*wsf=(float*)(shm+LDS_WS)+wid*64;
  const bf16*ksrc=Kh+(long)lane*KP+wid*8;
  const bf16*vsrc=Vh+(long)(16*(wid&3)+(lane>>2))*VP+(wid>>2)*32+(lane&3)*8;
  const unsigned kdst=lds0+LDS_K+wid*1024, vdst=lds0+LDS_V+wid*1024;
  #define DMA_K(t,slot) glds16(ksrc+(long)(t)*KVBLK*KP,(unsigned)__builtin_amdgcn_readfirstlane(kdst+(slot)))
  #define DMA_V(t,slot) glds16(vsrc+(long)(t)*KVBLK*VP,(unsigned)__builtin_amdgcn_readfirstlane(vdst+(slot)))
  const int vb0=(int)(lds0+LDS_V)+((lane>>4)&1)*32+(lane&3)*8+(4*hi+((lane&15)>>2))*64;
  const char*Kbase=shm+LDS_K; bf16x8 kf[8];
  const lds_cptr shm3=(lds_cptr)shm; const lds_cfptr btab=(lds_cfptr)(shm3+LDS_BT); const lds_cptr kp0=shm3+LDS_K+hi*1024+r32*16; const lds_cptr vp0=shm3+LDS_V+((lane>>4)&1)*32+(lane&3)*8+(4*hi+((lane&15)>>2))*64;
  const int NTL=(q0+QB)/KVBLK;
  DMA_K(0,0);DMA_V(0,0);DMA_K(1,SLOTB);
  bf16x8 qr[4];
  #pragma unroll
  for(int d0=0;d0<4;++d0)qr[d0]=*reinterpret_cast<const bf16x8*>(&Qw[(long)r32*QP+d0*16+hi*8]);
  float mhat=0.f,l_reg=0.f;f32x16 o[2];o[0]=f32x16{};o[1]=f32x16{};const f32x16 zt=f32x16{};
  const int qrel=wid*QBLK+r32;
  #define CMASK(P0,P1,t) bmask(P0,P1,(t),q0,wid,r32,hi,btab)
  bool resc=false;
  #define START(P0,P1) do{ const float rm=rowmax(P0,P1); resc=false; \
    { const float dl=rm; mhat=fadd_s(mhat,dl); \
      _Pragma("unroll") for(int r=0;r<16;++r){P0[r]=fsub_s(P0[r],dl);P1[r]=fsub_s(P1[r],dl);} \
      } \
    _Pragma("unroll") for(int r=0;r<16;++r)P0[r]=__builtin_amdgcn_exp2f(P0[r]); }while(0)
  #define RESC() do{ if(resc){ asm volatile("s_waitcnt lgkmcnt(0)":::"memory"); \
      _Pragma("unroll") for(int d_=0;d_<2;++d_) _Pragma("unroll") for(int r=0;r<16;++r)o[d_][r]*=wsf[crow(r,hi)]; } }while(0)
  f32x16 pA0,pA1,pB0,pB1;
  int sl_prev=0,sl_cur=0,sl_next=SLOTB;
  #define ROT() do{sl_prev=sl_cur;sl_cur=sl_next;sl_next=(sl_next==(NSLOT-1)*SLOTB)?0:sl_next+SLOTB;}while(0)
  DMA_K(2,2*SLOTB);
  WAIT_BAR(3);
  qkt(pA0,pA1,Kbase,qr,zt,r32,hi);asm volatile("s_nop 15\n\ts_nop 7":"+v"(pA0),"+v"(pA1));CMASK(pA0,pA1,0);
  START(pA0,pA1);
  _Pragma("unroll") for(int r=0;r<16;++r)pA1[r]=__builtin_amdgcn_exp2f(pA1[r]);
  WAIT_BAR(0);
  DMA_K(3,0);DMA_V(1,SLOTB);
  ROT();
  kload8(kf,kp0+sl_cur);
  WAIT_BAR(2);
  s16x4 vlo[8],vhi[8]; u32x4 pw0,pw1,pw2,pw3;
  #define PKW(P,B) cvtpk_s(P[B],P[B+1])
  #define PAF(k) __builtin_bit_cast(bf16x8,pw##k)
  #define VFR(i) (bf16x8){vlo[i][0],vlo[i][1],vlo[i][2],vlo[i][3],vhi[i][0],vhi[i][1],vhi[i][2],vhi[i][3]}
  #define PIN(x) asm volatile("":"+v"(x))
  #define MX3(a,b,c) __builtin_fmaxf(__builtin_fmaxf((a),(b)),(c))
  #define GAPA(MF,A0,A1,A2,A3,W0,W1,PW) do{ MF; sacc+=A0; sacc+=A1; sacc+=A2; sacc+=A3; PIN(sacc); W0; W1; PIN(PW); SBAR(); }while(0)
  #define EX(v) __builtin_amdgcn_exp2f(v)
  #define GAPB(MF,X,B) do{ MF; X[B]=EX(X[B]); X[B+1]=EX(X[B+1]); X[B+2]=EX(X[B+2]); X[B+3]=EX(X[B+3]); PIN(X); SBAR(); }while(0)
  #define VRD(i) do{ vlo[i]=vtr(vp_+(((i)>>2)*4096+((i)&3)*1024)); vhi[i]=vtr(vp_+(((i)>>2)*4096+((i)&3)*1024+512)); }while(0)
  #define KRD(G,j) do{ if(G){ kload2(kf,kp0+sl_next,j); SBAR(); } }while(0)
  #define STEP(C0,C1,P0,P1,t,GK,GV,GL) do{ SBAR(); \
    const lds_cptr vp_=vp0+sl_prev; \
    VRD(0); SBAR(); float sacc=(P0[0]+P0[1]); \
    GAPA(C0=__builtin_amdgcn_mfma_f32_32x32x16_bf16(kf[0],qr[0],zt,0,0,0), P0[2],P0[3],P0[4],P0[5],     pw0[0]=PKW(P0,0), pw0[1]=PKW(P0,2), pw0); \
    VRD(4); SBAR(); GAPA(C1=__builtin_amdgcn_mfma_f32_32x32x16_bf16(kf[1],qr[0],zt,0,0,0), P0[6],P0[7],P0[8],P0[9],     pw0[2]=PKW(P0,4), pw0[3]=PKW(P0,6), pw0); \
    VRD(1); SBAR(); GAPA(C0=__builtin_amdgcn_mfma_f32_32x32x16_bf16(kf[2],qr[1],C0,0,0,0),   P0[10],P0[11],P0[12],P0[13], pw1[0]=PKW(P0,8), pw1[1]=PKW(P0,10), pw1); \
    VRD(5); SBAR(); GAPA(C1=__builtin_amdgcn_mfma_f32_32x32x16_bf16(kf[3],qr[1],C1,0,0,0),   P0[14],P0[15],P1[0],P1[1],   pw1[2]=PKW(P0,12),pw1[3]=PKW(P0,14), pw1); \
    VRD(2); SBAR(); GAPA(C0=__builtin_amdgcn_mfma_f32_32x32x16_bf16(kf[4],qr[2],C0,0,0,0),   P1[2],P1[3],P1[4],P1[5],     pw2[0]=PKW(P1,0), pw2[1]=PKW(P1,2), pw2); \
    VRD(6); SBAR(); GAPA(C1=__builtin_amdgcn_mfma_f32_32x32x16_bf16(kf[5],qr[2],C1,0,0,0),   P1[6],P1[7],P1[8],P1[9],     pw2[2]=PKW(P1,4), pw2[3]=PKW(P1,6), pw2); \
    VRD(3); SBAR(); GAPA(C0=__builtin_amdgcn_mfma_f32_32x32x16_bf16(kf[6],qr[3],C0,0,0,0),   P1[10],P1[11],P1[12],P1[13], pw3[0]=PKW(P1,8), pw3[1]=PKW(P1,10), pw3); \
    VRD(7); SBAR(); GAPA(C1=__builtin_amdgcn_mfma_f32_32x32x16_bf16(kf[7],qr[3],C1,0,0,0),   P1[14],P1[15],0.f,0.f,       pw3[2]=PKW(P1,12),pw3[3]=PKW(P1,14), pw3); \
    l_reg+=sacc; \
    if(GK){DMA_K((t)+3,sl_cur);} if(GV){DMA_V((t)+1,sl_next);} \
    _Pragma("unroll") for(int r=0;r<16;++r){C0[r]-=mhat;C1[r]-=mhat;} \
    CMASK(C0,C1,t); \
    { float a=MX3(C0[0],C0[1],C1[0]),b=MX3(C0[2],C0[3],C1[1]); a=MX3(a,C1[2],C1[3]); \
      _Pragma("unroll") for(int r=4;r<16;r+=4){a=MX3(a,C0[r],C0[r+1]);b=MX3(b,C0[r+2],C0[r+3]);a=MX3(a,C1[r],C1[r+1]);b=MX3(b,C1[r+2],C1[r+3]);} \
      float rm=__builtin_fmaxf(a,b); { auto rr=__builtin_amdgcn_permlane32_swap(__float_as_uint(rm),__float_as_uint(rm),false,false); rm=__builtin_fmaxf(__uint_as_float(rr[0]),__uint_as_float(rr[1])); } \
      resc=false; \
      if(__builtin_expect(__any(rm>(float)THRL),0)){ const float dl=__builtin_fmaxf(rm,0.f); mhat+=dl; \
        _Pragma("unroll") for(int r=0;r<16;++r){C0[r]-=dl;C1[r]-=dl;} \
        const float f=__builtin_amdgcn_exp2f(-dl); l_reg*=f; if(hi==0)wsf[r32]=f; resc=true; } } \
    SBAR(); \
    GAPB(o[0]=__builtin_amdgcn_mfma_f32_32x32x16_bf16(PAF(0),VFR(0),o[0],0,0,0), C0,0); \
    GAPB(o[1]=__builtin_amdgcn_mfma_f32_32x32x16_bf16(PAF(0),VFR(4),o[1],0,0,0), C0,4); \
    KRD(GL,0); GAPB(o[0]=__builtin_amdgcn_mfma_f32_32x32x16_bf16(PAF(1),VFR(1),o[0],0,0,0), C0,8); \
    KRD(GL,1); GAPB(o[1]=__builtin_amdgcn_mfma_f32_32x32x16_bf16(PAF(1),VFR(5),o[1],0,0,0), C0,12); \
    KRD(GL,2); GAPB(o[0]=__builtin_amdgcn_mfma_f32_32x32x16_bf16(PAF(2),VFR(2),o[0],0,0,0), C1,0); \
    KRD(GL,3); GAPB(o[1]=__builtin_amdgcn_mfma_f32_32x32x16_bf16(PAF(2),VFR(6),o[1],0,0,0), C1,4); \
    GAPB(o[0]=__builtin_amdgcn_mfma_f32_32x32x16_bf16(PAF(3),VFR(3),o[0],0,0,0), C1,8); \
    GAPB(o[1]=__builtin_amdgcn_mfma_f32_32x32x16_bf16(PAF(3),VFR(7),o[1],0,0,0), C1,12); \
    }while(0)
  int t=1;
  #undef CMASK
  #define CMASK(P0,P1,t) do{}while(0)
  for(;t+7<NTL;t+=2){
    STEP(pB0,pB1,pA0,pA1,t,true,true,true);     WAIT_BAR(2); RESC(); ROT();
    STEP(pA0,pA1,pB0,pB1,t+1,true,true,true);   WAIT_BAR(2); RESC(); ROT();
  }
  #undef CMASK
  #define CMASK(P0,P1,t) bmask(P0,P1,(t),q0,wid,r32,hi,btab)
  #define ENDW(tt) do{ if((tt)+3<NTL){WAIT_BAR(2);} else if((tt)+2<NTL){WAIT_BAR(1);} else {WAIT_BAR(0);} }while(0)
  for(;t+1<NTL;t+=2){
    STEP(pB0,pB1,pA0,pA1,t,(t+3<NTL),(t+1<NTL),(t+1<NTL));       ENDW(t);   RESC(); ROT();
    STEP(pA0,pA1,pB0,pB1,t+1,(t+4<NTL),(t+2<NTL),(t+2<NTL));     ENDW(t+1); RESC(); ROT();
  }
  STEP(pB0,pB1,pA0,pA1,NTL-1,false,false,false); RESC();
  { float sacc=pB0[0]+pB0[1]; _Pragma("unroll") for(int r=2;r<16;++r)sacc+=pB0[r]; _Pragma("unroll") for(int r=0;r<16;++r)sacc+=pB1[r]; l_reg+=sacc;
    pw0=(u32x4){PKW(pB0,0),PKW(pB0,2),PKW(pB0,4),PKW(pB0,6)};pw1=(u32x4){PKW(pB0,8),PKW(pB0,10),PKW(pB0,12),PKW(pB0,14)};pw2=(u32x4){PKW(pB1,0),PKW(pB1,2),PKW(pB1,4),PKW(pB1,6)};pw3=(u32x4){PKW(pB1,8),PKW(pB1,10),PKW(pB1,12),PKW(pB1,14)};
    SBAR(); pv(o,vb0+sl_cur,PAF(0),PAF(1),PAF(2),PAF(3)); }
  #undef PKW
  #undef PAF
  #undef VFR
  #undef PIN
  #undef MX3
  #undef GAPA
  #undef GAPB
  #undef EX
  #undef VRD
  #undef KRD
  #undef STEP
  #undef ENDW
  {auto rr=__builtin_amdgcn_permlane32_swap(__float_as_uint(l_reg),__float_as_uint(l_reg),false,false);l_reg=__uint_as_float(rr[0])+__uint_as_float(rr[1]);}
  if(hi==0)wsf[32+r32]=l_reg;asm volatile("s_waitcnt lgkmcnt(0)":::"memory");
  float rli[16];
  #pragma unroll
  for(int r=0;r<16;++r)rli[r]=__builtin_amdgcn_rcpf(wsf[32+crow(r,hi)]);
  bf16*Ow=O+(rowbase+q0+wid*QBLK)*OP+ooff;
  { bf16*stg=(bf16*)(shm+LDS_OST)+wid*2048;
    #pragma unroll
    for(int r=0;r<16;++r){const int orow=crow(r,hi);
      #pragma unroll
      for(int d0=0;d0<2;++d0)stg[orow*64+d0*32+r32]=__float2bfloat16(o[d0][r]*rli[r]);}
    asm volatile("s_waitcnt lgkmcnt(0)":::"memory");
    #pragma unroll
    for(int i=0;i<4;++i){const int row=i*8+(lane>>3),ch=lane&7; const u32x4 v=*(const u32x4*)(stg+row*64+ch*8); ATTN_STORE16(Ow+(long)row*OP+ch*8,v);} }
  asm volatile("s_waitcnt lgkmcnt(0)\n\ts_barrier":::"memory");
  #undef DMA_K
  #undef DMA_V
  #undef CMASK
  #undef START
  #undef RESC
  #undef ROT
}
constexpr int ATTN_LDS_BYTES=LDS_BYTES;
#undef SBAR
#undef WAIT_BAR
#undef WAIT_BAR
}
namespace mk {
#define GAS __attribute__((address_space(1)))
#define LAS __attribute__((address_space(3)))
typedef unsigned short bf16;
typedef unsigned v4u __attribute__((ext_vector_type(4)));
typedef unsigned v2u __attribute__((ext_vector_type(2)));
typedef float f32x4 __attribute__((ext_vector_type(4)));
typedef float f32x16 __attribute__((ext_vector_type(16)));
typedef short bf16x8 __attribute__((ext_vector_type(8)));
typedef GAS unsigned gu32;
#define RLX_AGENT __ATOMIC_RELAXED, __HIP_MEMORY_SCOPE_AGENT
#define LDS_WAIT() asm volatile("s_waitcnt lgkmcnt(0)" ::: "memory")
#define VM_WAIT() asm volatile("s_waitcnt vmcnt(0)" ::: "memory")
__device__ __forceinline__ unsigned f2bf(float f) { unsigned u = __builtin_bit_cast(unsigned, f); return (u + 0x7fffu + ((u >> 16) & 1u)) >> 16; }
__device__ __forceinline__ unsigned pk2(float lo, float hi) { return f2bf(lo) | (f2bf(hi) << 16); }
__device__ __forceinline__ float bf2f(unsigned short b) { return __builtin_bit_cast(float, ((unsigned)b) << 16); }
__device__ __forceinline__ float bflo(unsigned w) { return __builtin_bit_cast(float, w << 16); }
__device__ __forceinline__ float bfhi(unsigned w) { return __builtin_bit_cast(float, w & 0xffff0000u); }

constexpr int NWAVES = 8, NTHR = NWAVES * 64;
constexpr int PADF = 48;
constexpr int LPP = 8448;
constexpr int PEND = PADF + LP;
constexpr int SROW0 = BATCH * LPP;
constexpr int RP = SROW0 + NS;
constexpr int ZN = 7424;
constexpr int ZC_QA = 0, ZC_KA = 512, ZC_VA = 1024, ZC_QKVB = 1536, ZC_GB = 3072, ZC_UC = 3584, ZC_GATE = 4096, ZC_BA = 7168;
static_assert(RP % 256 == 0 && ZN % 256 == 0 && D_MODEL == 1024 && WIDTH_A == 512 && WIDTH_B == 512 && WIDTH_C == 512, "shapes");
__host__ __device__ __forceinline__ int nat2prow(int row) { return row < NP ? (row / LP) * LPP + PADF + row % LP : SROW0 + (row - NP); }
__host__ __device__ __forceinline__ int zcol(int col) { return col < 3584 ? col : (col < 3592 ? ZC_BA + (col - 3584) : col - 8); }
__device__ __forceinline__ bool prow_valid(int prow) { if (prow >= SROW0) return true; const int p = prow % LPP; return p >= PADF && p < PEND; }
__device__ __forceinline__ int prow2nat(int prow) { if (prow >= SROW0) return NP + (prow - SROW0); return (prow / LPP) * LP + (prow % LPP) - PADF; }

constexpr int RING_OFF = 0, RING_BYTES = 131072;
constexpr int LDSCTL_OFF = RING_BYTES, MISC_OFF = LDSCTL_OFF + 320;
constexpr int LDS_BYTES = 147456;
static_assert(MISC_OFF + 128 <= LDS_BYTES, "LDS map");

constexpr size_t CTL_BYTES = 1u << 20;
constexpr int CW_TMO = 0, CW_CODE = 1;
constexpr int CW_BAR = 4096;
constexpr int CW_QUEUE = 16384;

#define XB_TMO      128
#define XB_XCNT(j)  (256  + 64 * (j))
#define XB_XSUB(j)  (1280 + 64 * (j))
#define XB_XGEN(j)  (2304 + 64 * (j))
#define XB_TOP      3328
#define XB_TOPGEN   3392
#define XCD_BAR_WORDS 3456
#define XB_SPIN_CAP (1u << 18)

__device__ __forceinline__ unsigned xb_ld(unsigned* p)              { return __hip_atomic_load(p, __ATOMIC_RELAXED, __HIP_MEMORY_SCOPE_AGENT); }
__device__ __forceinline__ unsigned xb_add(unsigned* p, unsigned v) { return __hip_atomic_fetch_add(p, v, __ATOMIC_RELAXED, __HIP_MEMORY_SCOPE_AGENT); }
__device__ __forceinline__ unsigned xb_xcc_id() { return (unsigned)__builtin_amdgcn_s_getreg((3 << 11) | 20) & 0xFu; }
#define XB_SPIN(cond, bar) do { unsigned _sp = 0; while (cond) { __builtin_amdgcn_s_sleep(1); \
    if ((++_sp & 255u) == 0u) { if (xb_ld(&(bar)[XB_TMO])) break; if (_sp > XB_SPIN_CAP) { atomicAdd(&(bar)[XB_TMO], 1u); break; } } } } while (0)

struct XcdBarrier {
    unsigned* bar; unsigned x;
    volatile LAS unsigned* st;
};

__device__ __forceinline__ XcdBarrier xcd_barrier_post(unsigned* bar, volatile LAS unsigned* st) {
    XcdBarrier b; b.bar = bar; b.x = xb_xcc_id(); b.st = st;
    if (threadIdx.x == 0) (void)xb_add(&bar[XB_XCNT(b.x)], 1u);
    return b;
}
__device__ __forceinline__ void xcd_barrier_complete(unsigned* bar, unsigned x, unsigned& nloc, unsigned& nx) {
    const unsigned G = gridDim.x * gridDim.y * gridDim.z;
    unsigned sum, cnt, mine, sp = 0u;
    for (;;) {
        sum = 0u; cnt = 0u; mine = 0u;
#pragma unroll
        for (unsigned j = 0; j < 16; ++j) { const unsigned c = xb_ld(&bar[XB_XCNT(j)]); sum += c; cnt += (c > 0u) ? 1u : 0u; mine = (j == x) ? c : mine; }
        if (sum == G) break;
        __builtin_amdgcn_s_sleep(1);
        if ((++sp & 255u) == 0u) { if (xb_ld(&bar[XB_TMO])) break; if (sp > XB_SPIN_CAP) { atomicAdd(&bar[XB_TMO], 1u); break; } }
    }
    nloc = mine > 0u ? mine : 1u; nx = cnt > 0u ? cnt : 1u;
}

__device__ __forceinline__ void xcd_barrier(const XcdBarrier& b) {
    asm volatile("s_waitcnt vmcnt(0)" ::: "memory");
    __syncthreads();
    if (threadIdx.x == 0) {
        unsigned* bar = b.bar;
        __builtin_amdgcn_s_waitcnt(0);
        unsigned nloc = b.st[0], nx = b.st[1];
        if (nloc == 0u) { xcd_barrier_complete(bar, b.x, nloc, nx); b.st[0] = nloc; b.st[1] = nx; }
        const unsigned old = xb_add(&bar[XB_XSUB(b.x)], 1u);
        const unsigned gen = old / nloc;
        if (old + 1u == (gen + 1u) * nloc) {
            __builtin_amdgcn_fence(__ATOMIC_RELEASE, "agent");
            asm volatile("s_waitcnt vmcnt(0)" ::: "memory");
            const unsigned og = xb_add(&bar[XB_TOP], 1u);
            const unsigned tg = og / nx;
            if (og + 1u == (tg + 1u) * nx) xb_add(&bar[XB_TOPGEN], 1u);
            else XB_SPIN(xb_ld(&bar[XB_TOPGEN]) == tg, bar);
            __builtin_amdgcn_fence(__ATOMIC_ACQUIRE, "agent");
            xb_add(&bar[XB_XGEN(b.x)], 1u);
            asm volatile("s_waitcnt vmcnt(0)" ::: "memory");
        } else {
            XB_SPIN(xb_ld(&bar[XB_XGEN(b.x)]) == gen, bar);
            __builtin_amdgcn_fence(__ATOMIC_ACQUIRE, "agent");
            asm volatile("s_waitcnt vmcnt(0)" ::: "memory");
        }
    }
    __syncthreads();
}


__device__ __forceinline__ float wave_sum(float v) {
#pragma unroll
    for (int o = 1; o < 64; o <<= 1) v += __shfl_xor(v, o);
    return v;
}
}
namespace mk {
enum Region { R_X, R_XN, R_WIN, R_Z, R_QN, R_KN, R_QKVB, R_BG, R_O, R_OA, R_OB, R_YC, R_OC, R_MRG, R_WGLU, R_WBR, R_WOUT, R_WQS, R_PU, R_PV, R_SC, R_GDN, R_S5T, R_MISC, R_S5E, R_S5X, R_MRGB, R_NREG };
constexpr int NPL = 16;
enum Phase { PH_PRO = 0, PL_NORM1 = 0, PL_GEMM_IN = 1, PL_ZPOST = 2, PL_LOCAL = 3, PL_MIX = 4, PL_MIXPOST = 5, PL_GEMM_GLU = 6, PL_GEMM_BRA = 7, PL_GEMM_BRB = 8, PL_GEMM_BRC = 9,
             PL_GEMM_OUT = 10, PL_NORM2 = 11, PL_GEMM_PEER = 12, PL_PEER = 13, PH_FINAL = 1 + DEPTH * NPL, PH_END = PH_FINAL + 1 };
enum ProMask { PM_X = 1, PM_WIN = 2, PM_WREST = 4, PM_PEERW = 8, PM_WQS = 16, PM_TABLES = 32 };
struct Args {
    const float* in[40];
    float* out;
    unsigned char* ws;
    unsigned long long off[32];
    int ph_lo, ph_hi, pro_mask, bar_region;
};
static_assert(sizeof(Args) == 40 * 8 + 8 + 8 + 32 * 8 + 16, "Args has no padding");

typedef const __attribute__((address_space(4))) Args* KArgs;
__device__ __forceinline__ KArgs kargs() { KArgs p = (KArgs)__builtin_amdgcn_kernarg_segment_ptr(); asm volatile("" : "+s"(p)); return p; }
#define WS_OPAQUE(a) unsigned char* wsb = (a).ws; asm volatile("" : "+s"(wsb))
__device__ __forceinline__ int otid() { int t = threadIdx.x; asm volatile("" : "+v"(t)); return t; }
struct Frame {
    LAS unsigned char* lds; volatile LAS unsigned* MISC; gu32* ctl;
    int vcu, G;
};

template <class CM> __device__ __forceinline__ void transpose_item(const float* W, int ld, int K, bf16* WT, int n0, int k0, const CM& cm, LAS float* scr, int lane) {
    const int sc = cm(n0 + (lane & 31));
#pragma unroll 8
    for (int i = 0; i < 32; ++i) { const int kk = 2 * i + (lane >> 5); scr[kk * 33 + (lane & 31)] = sc >= 0 ? W[(size_t)(k0 + kk) * ld + sc] : 0.f; }
    LDS_WAIT(); asm volatile("" ::: "memory");
    const int c = lane & 7;
#pragma unroll
    for (int j = 0; j < 4; ++j) { const int n = (lane >> 3) + 8 * j; const LAS float* s = scr + (8 * c) * 33 + n;
        v4u o; o.x = pk2(s[0 * 33], s[1 * 33]); o.y = pk2(s[2 * 33], s[3 * 33]); o.z = pk2(s[4 * 33], s[5 * 33]); o.w = pk2(s[6 * 33], s[7 * 33]);
        *(GAS v4u*)(WT + (size_t)(n0 + n) * K + k0 + 8 * c) = o; }
    LDS_WAIT(); asm volatile("" ::: "memory");
}
struct CmWin { __device__ __forceinline__ int operator()(int n) const { return n < 3584 ? n : (n < 7168 ? n + 8 : (n < 7176 ? 3584 + (n - 7168) : -1)); } };
struct CmId { __device__ __forceinline__ int operator()(int n) const { return n; } };
struct CmGlu { __device__ __forceinline__ int operator()(int n) const { const int G = n >> 5, i = n & 31; return i < 16 ? 16 * G + i : 512 + 16 * G + (i - 16); } };

__device__ __forceinline__ void rms_row_to_bf16(const float* xrow, const float* g, bf16* orow, int lane) {
    const GAS f32x4* xr = (const GAS f32x4*)xrow + lane;
    f32x4 v[4]; float s2 = 0.f;
#pragma unroll
    for (int j = 0; j < 4; ++j) { v[j] = xr[64 * j]; s2 += (v[j].x * v[j].x + v[j].y * v[j].y) + (v[j].z * v[j].z + v[j].w * v[j].w); }
    const float r = 1.f / sqrtf(wave_sum(s2) * (1.f / D_MODEL) + EPSF);
    const GAS f32x4* gr = (const GAS f32x4*)g + lane;
    GAS unsigned long long* o8 = (GAS unsigned long long*)orow + lane;
#pragma unroll
    for (int j = 0; j < 4; ++j) { const f32x4 gg = gr[64 * j];
        o8[64 * j] = (unsigned long long)pk2(v[j].x * r * gg.x, v[j].y * r * gg.y) | ((unsigned long long)pk2(v[j].z * r * gg.z, v[j].w * r * gg.w) << 32); }
}

__device__ __forceinline__ void p_norm(Frame& F, int l, int gi) {
    const KArgs ap = kargs(); const auto& a = *ap; WS_OPAQUE(a);
    const int tid = otid(), lane = tid & 63, wave = __builtin_amdgcn_readfirstlane(tid >> 6);
    const float* X = (const float*)(wsb + a.off[R_X]); bf16* XN = (bf16*)(wsb + a.off[R_XN]); const float* g = a.in[gi] + (size_t)l * D_MODEL;
    const int gw = F.vcu * NWAVES + wave, NGW = F.G * NWAVES;
    for (int m = gw; m < RP; m += NGW) rms_row_to_bf16(X + (size_t)m * D_MODEL, g, XN + (size_t)m * D_MODEL, lane);
}
__device__ __forceinline__ void unpack8(const v4u w, float (&f)[8]) { f[0] = bflo(w.x); f[1] = bfhi(w.x); f[2] = bflo(w.y); f[3] = bfhi(w.y); f[4] = bflo(w.z); f[5] = bfhi(w.z); f[6] = bflo(w.w); f[7] = bfhi(w.w); }
__device__ __forceinline__ v4u pack8(const float (&f)[8]) { v4u w; w.x = pk2(f[0], f[1]); w.y = pk2(f[2], f[3]); w.z = pk2(f[4], f[5]); w.w = pk2(f[6], f[7]); return w; }
__device__ __forceinline__ float sigm(float x) { return 1.f / (1.f + __expf(-x)); }
constexpr float ATT_C2 = 0.125f * 1.4426950408889634f;
__device__ __forceinline__ void p_zpost(Frame& F, int l) {
    const KArgs ap = kargs(); const auto& a = *ap; WS_OPAQUE(a);
    const bf16* Z = (const bf16*)(wsb + a.off[R_Z]);
    bf16* QN = (bf16*)(wsb + a.off[R_QN]); bf16* KN = (bf16*)(wsb + a.off[R_KN]); bf16* QKVB = (bf16*)(wsb + a.off[R_QKVB]); float* BG = (float*)(wsb + a.off[R_BG]);
    const int tid = otid(), lane = tid & 63, wave = __builtin_amdgcn_readfirstlane(tid >> 6);
    const int gw = F.vcu * NWAVES + wave, NGW = F.G * NWAVES;
    float gq[8], gk[8], cw[3][4][8];
#pragma unroll
    for (int j = 0; j < 8; ++j) { gq[j] = a.in[I_QN][l * HEAD_DIM_A + 8 * (lane & 7) + j] * ATT_C2; gk[j] = a.in[I_KN][l * HEAD_DIM_A + 8 * (lane & 7) + j]; }
#pragma unroll
    for (int w = 0; w < 3; ++w)
#pragma unroll
        for (int i = 0; i < 4; ++i)
#pragma unroll
            for (int j = 0; j < 8; ++j) cw[w][i][j] = a.in[I_CONVW][((size_t)l * CONV_W + i) * 3 * WIDTH_B + w * WIDTH_B + 8 * lane + j];
    float alog = 0.f, dtb = 0.f; if (lane < 4) { alog = a.in[I_ALOG][l * N_HEADS_B + lane]; dtb = a.in[I_DTB][l * N_HEADS_B + lane]; }
    for (int m = gw; m < RP; m += NGW) {
        const bool valid = prow_valid(m); const int nat = valid ? prow2nat(m) : 0;
        const bf16* zr = Z + (size_t)m * ZN;
        float f[8], o[8];
        unpack8(*(const GAS v4u*)(zr + ZC_QA + 8 * lane), f);
        { float ss = 0.f;
#pragma unroll
          for (int j = 0; j < 8; ++j) ss += f[j] * f[j];
          ss += __shfl_xor(ss, 1); ss += __shfl_xor(ss, 2); ss += __shfl_xor(ss, 4);
          const float r = 1.f / sqrtf(ss * (1.f / HEAD_DIM_A) + EPSF);
#pragma unroll
          for (int j = 0; j < 8; ++j) o[j] = f[j] * r * gq[j];
          *(GAS v4u*)(QN + (size_t)m * WIDTH_A + 8 * lane) = pack8(o); }
        unpack8(*(const GAS v4u*)(zr + ZC_KA + 8 * lane), f);
        { float ss = 0.f;
#pragma unroll
          for (int j = 0; j < 8; ++j) ss += f[j] * f[j];
          ss += __shfl_xor(ss, 1); ss += __shfl_xor(ss, 2); ss += __shfl_xor(ss, 4);
          const float r = 1.f / sqrtf(ss * (1.f / HEAD_DIM_A) + EPSF);
#pragma unroll
          for (int j = 0; j < 8; ++j) o[j] = f[j] * r * gk[j];
          *(GAS v4u*)(KN + (size_t)m * WIDTH_A + 8 * lane) = pack8(o);
          if (valid) { float* ko = nat < NP ? a.out + O_KP + ((size_t)l * NP + nat) * WIDTH_A : a.out + O_KS + ((size_t)l * NS + (nat - NP)) * WIDTH_A;
              *(GAS f32x4*)(ko + 8 * lane) = (f32x4){o[0], o[1], o[2], o[3]}; *(GAS f32x4*)(ko + 8 * lane + 4) = (f32x4){o[4], o[5], o[6], o[7]}; } }
        if (valid) { unpack8(*(const GAS v4u*)(zr + ZC_VA + 8 * lane), f);
            float* vo = nat < NP ? a.out + O_VP + ((size_t)l * NP + nat) * WIDTH_A : a.out + O_VS + ((size_t)l * NS + (nat - NP)) * WIDTH_A;
            *(GAS f32x4*)(vo + 8 * lane) = (f32x4){f[0], f[1], f[2], f[3]}; *(GAS f32x4*)(vo + 8 * lane + 4) = (f32x4){f[4], f[5], f[6], f[7]}; }
        const int ts = m >= SROW0 ? (m - SROW0) % DEC_SEQ : 1000; const int bs = m >= SROW0 ? (m - SROW0) / DEC_SEQ : 0;
        int cj = -1;
        if (m >= SROW0) { if (ts >= DEC_SEQ - 3) cj = ts - (DEC_SEQ - 3); } else { const int p = m % LPP; if (p >= PEND - 3 && p < PEND) cj = p - (PEND - 3); }
#pragma unroll
        for (int w = 0; w < 3; ++w) {
            float acc[8];
#pragma unroll
            for (int j = 0; j < 8; ++j) acc[j] = 0.f;
#pragma unroll
            for (int i = 0; i < 4; ++i) {
                const int dt = i - 3;
                if (ts + dt < 0) {
                    const float* sc = a.in[I_SCONV] + (((size_t)l * DEC_BATCH + bs) * (CONV_W - 1) + (CONV_W - 1 + ts + dt)) * 3 * WIDTH_B + w * WIDTH_B + 8 * lane;
                    const f32x4 s0 = *(const GAS f32x4*)sc, s1 = *(const GAS f32x4*)(sc + 4);
                    f[0] = s0.x; f[1] = s0.y; f[2] = s0.z; f[3] = s0.w; f[4] = s1.x; f[5] = s1.y; f[6] = s1.z; f[7] = s1.w;
                } else if (m + dt >= 0) unpack8(*(const GAS v4u*)(Z + (size_t)(m + dt) * ZN + ZC_QKVB + w * WIDTH_B + 8 * lane), f);
                else {
#pragma unroll
                    for (int j = 0; j < 8; ++j) f[j] = 0.f; }
#pragma unroll
                for (int j = 0; j < 8; ++j) acc[j] += f[j] * cw[w][i][j];
                if (i == 3 && cj >= 0) {
                    float* co = m >= SROW0 ? a.out + O_CS + (((size_t)l * DEC_BATCH + bs) * (CONV_W - 1) + cj) * 3 * WIDTH_B : a.out + O_CP + (((size_t)l * BATCH + m / LPP) * (CONV_W - 1) + cj) * 3 * WIDTH_B;
                    *(GAS f32x4*)(co + w * WIDTH_B + 8 * lane) = (f32x4){f[0], f[1], f[2], f[3]}; *(GAS f32x4*)(co + w * WIDTH_B + 8 * lane + 4) = (f32x4){f[4], f[5], f[6], f[7]}; }
            }
            float ss = 0.f;
#pragma unroll
            for (int j = 0; j < 8; ++j) { acc[j] = acc[j] * sigm(acc[j]); ss += acc[j] * acc[j]; }
            float sc = 1.f;
            if (w < 2) { ss += __shfl_xor(ss, 1); ss += __shfl_xor(ss, 2); ss += __shfl_xor(ss, 4); ss += __shfl_xor(ss, 8);
                sc = 1.f / sqrtf(ss + EPSF); if (w == 0) sc *= 0.08838834764831845f; }
#pragma unroll
            for (int j = 0; j < 8; ++j) o[j] = acc[j] * sc;
            *(GAS v4u*)(QKVB + (size_t)m * 3 * WIDTH_B + w * WIDTH_B + 8 * lane) = pack8(o);
        }
        if (lane < 4) { const float be = bf2f(zr[ZC_BA + lane]), al = bf2f(zr[ZC_BA + 4 + lane]) + dtb;
            const float sp = al > 20.f ? al : __logf(1.f + __expf(al));
            BG[(size_t)m * 8 + lane] = valid ? sigm(be) : 0.f; BG[(size_t)m * 8 + 4 + lane] = valid ? -__expf(alog) * sp : 0.f; }
    }
}
constexpr float LOG2E = 1.4426950408889634f;
__device__ __forceinline__ int t5_bucket_dev(int rel) {
    const int n = rel < 0 ? -rel : rel; int b;
    if (n < 8) b = n; else if (n < 12) b = 8; else if (n < 16) b = 9; else if (n < 23) b = 10; else if (n < 32) b = 11;
    else if (n < 46) b = 12; else if (n < 64) b = 13; else if (n < 91) b = 14; else b = 15;
    return b + (rel > 0 ? 16 : 0);
}
__device__ __forceinline__ void build_bias_table(LAS float* tab, const float* rel_bias, int h, int tid) {
    const float far = rel_bias[15 * N_HEADS_A + h];
    for (int i = tid; i < attn_body::BT_N; i += NTHR) tab[i] = (rel_bias[t5_bucket_dev(i - attn_body::BT_OFF) * N_HEADS_A + h] - far) * LOG2E;
}
__device__ __forceinline__ float lam_init_dev(int l) { return 0.8f - 0.6f * __expf(-0.3f * (float)l); }
__device__ __forceinline__ float lam_dev(const float* lqk_all, int l, int lane) {
    const float* q = lqk_all + (size_t)l * 4 * HEAD_DIM_A;
    const float s0 = wave_sum(q[lane] * q[HEAD_DIM_A + lane]), s1 = wave_sum(q[2 * HEAD_DIM_A + lane] * q[3 * HEAD_DIM_A + lane]);
    return __expf(s0) - __expf(s1) + lam_init_dev(l);
}
__device__ __forceinline__ int krow_dev(int s, int h, int j) { return 16 * s + 8 * (j >> 2) + 4 * h + (j & 3); }
__device__ __forceinline__ int crow_dev(int r, int h) { return (r & 3) + 8 * (r >> 2) + 4 * h; }
__device__ __forceinline__ bf16x8 pack_f8(const f32x4 a, const f32x4 b) { v4u w; w.x = pk2(a.x, a.y); w.y = pk2(a.z, a.w); w.z = pk2(b.x, b.y); w.w = pk2(b.z, b.w); return __builtin_bit_cast(bf16x8, w); }

__device__ __forceinline__ void sample_scores(f32x16& X, int kb, int c, const float* ck, const bf16* KN, int row0, int h, int hi, int r32, int qpos, const bf16x8 (&qf)[4], const LAS float* tab) {
    bf16x8 kf[4];
    if (kb < PAST_LEN / 32) { const float* kr = ck + (size_t)(kb * 32 + r32) * WIDTH_A + h * 128 + c * 64 + 8 * hi;
#pragma unroll
        for (int s = 0; s < 4; ++s) kf[s] = pack_f8(*(const GAS f32x4*)(kr + 16 * s), *(const GAS f32x4*)(kr + 16 * s + 4)); }
    else { const bf16* kr = KN + (size_t)(row0 + (kb * 32 - PAST_LEN) + r32) * WIDTH_A + h * 128 + c * 64 + 8 * hi;
#pragma unroll
        for (int s = 0; s < 4; ++s) kf[s] = *(const GAS bf16x8*)(kr + 16 * s); }
#pragma unroll
    for (int i = 0; i < 16; ++i) X[i] = 0.f;
#pragma unroll
    for (int s = 0; s < 4; ++s) X = __builtin_amdgcn_mfma_f32_32x32x16_bf16(kf[s], qf[s], X, 0, 0, 0);
#pragma unroll
    for (int i = 0; i < 16; ++i) { int idx = kb * 32 + crow_dev(i, hi) - qpos + attn_body::BT_OFF; idx = idx < 0 ? 0 : idx; X[i] += tab[idx]; }
}

__device__ __forceinline__ void attn_sample_unit(Frame& F, int l, int bs, int h) {
    const KArgs ap = kargs(); const auto& a = *ap; WS_OPAQUE(a);
    const int tid = otid(), lane = tid & 63, wid = __builtin_amdgcn_readfirstlane(tid >> 6), r32 = lane & 31, hi = lane >> 5;
    const bf16* QN = (const bf16*)(wsb + a.off[R_QN]); const bf16* KN = (const bf16*)(wsb + a.off[R_KN]); const bf16* Z = (const bf16*)(wsb + a.off[R_Z]); bf16* O = (bf16*)(wsb + a.off[R_O]);
    const float* ck = a.in[I_CK] + ((size_t)l * DEC_BATCH + bs) * PAST_LEN * WIDTH_A; const float* cv = a.in[I_CV] + ((size_t)l * DEC_BATCH + bs) * PAST_LEN * WIDTH_A;
    const int row0 = SROW0 + bs * DEC_SEQ;
    LAS float* tab = (LAS float*)(F.lds + RING_OFF + attn_body::LDS_BT);
    LAS float* st = (LAS float*)(F.lds + RING_OFF + 90112);
    LAS float* slot = (LAS float*)(F.lds + RING_OFF);
    const float lam = lam_dev(a.in[I_LQK], l, lane);
    build_bias_table(tab, a.in[I_REL], h, tid);
    bf16x8 qf[2][4];
#pragma unroll
    for (int c = 0; c < 2; ++c)
#pragma unroll
        for (int s = 0; s < 4; ++s) qf[c][s] = *(const GAS bf16x8*)(QN + (size_t)(row0 + r32) * WIDTH_A + h * 128 + c * 64 + 16 * s + 8 * hi);
    __syncthreads();
    float m[2] = {-1e30f, -1e30f}, lsum[2] = {0.f, 0.f};
    const int qpos = PAST_LEN + r32;
    for (int kb = wid; kb < (PAST_LEN + DEC_SEQ) / 32; kb += NWAVES) {
#pragma unroll
        for (int c = 0; c < 2; ++c) { f32x16 X; sample_scores(X, kb, c, ck, KN, row0, h, hi, r32, qpos, qf[c], tab);
            float mx = X[0];
#pragma unroll
            for (int i = 1; i < 16; ++i) mx = fmaxf(mx, X[i]);
            mx = fmaxf(mx, __shfl_xor(mx, 32)); const float mn = fmaxf(m[c], mx);
            float sum = 0.f;
#pragma unroll
            for (int i = 0; i < 16; ++i) sum += exp2f(X[i] - mn);
            lsum[c] = lsum[c] * exp2f(m[c] - mn) + sum; m[c] = mn; }
    }
#pragma unroll
    for (int c = 0; c < 2; ++c) { lsum[c] += __shfl_xor(lsum[c], 32); if (hi == 0) { st[((wid * 2 + c) * 2 + 0) * 32 + r32] = m[c]; st[((wid * 2 + c) * 2 + 1) * 32 + r32] = lsum[c]; } }
    __syncthreads();
    float gm[2], ginv[2];
#pragma unroll
    for (int c = 0; c < 2; ++c) { float mm = -1e30f;
#pragma unroll
        for (int w = 0; w < NWAVES; ++w) mm = fmaxf(mm, st[((w * 2 + c) * 2 + 0) * 32 + r32]);
        float ll = 0.f;
#pragma unroll
        for (int w = 0; w < NWAVES; ++w) ll += st[((w * 2 + c) * 2 + 1) * 32 + r32] * exp2f(st[((w * 2 + c) * 2 + 0) * 32 + r32] - mm);
        gm[c] = mm; ginv[c] = (c == 0 ? 1.f : lam) / ll; }
    f32x16 acc[4];
#pragma unroll
    for (int eb = 0; eb < 4; ++eb)
#pragma unroll
        for (int i = 0; i < 16; ++i) acc[eb][i] = 0.f;
    for (int kb = wid; kb < (PAST_LEN + DEC_SEQ) / 32; kb += NWAVES) {
        f32x16 X0, X1; sample_scores(X0, kb, 0, ck, KN, row0, h, hi, r32, qpos, qf[0], tab); sample_scores(X1, kb, 1, ck, KN, row0, h, hi, r32, qpos, qf[1], tab);
        float wv[16];
#pragma unroll
        for (int i = 0; i < 16; ++i) wv[i] = exp2f(X0[i] - gm[0]) * ginv[0] - exp2f(X1[i] - gm[1]) * ginv[1];
        bf16x8 xs[2];
#pragma unroll
        for (int s = 0; s < 2; ++s) { v4u w; w.x = pk2(wv[8 * s], wv[8 * s + 1]); w.y = pk2(wv[8 * s + 2], wv[8 * s + 3]); w.z = pk2(wv[8 * s + 4], wv[8 * s + 5]); w.w = pk2(wv[8 * s + 6], wv[8 * s + 7]); xs[s] = __builtin_bit_cast(bf16x8, w); }
#pragma unroll
        for (int eb = 0; eb < 4; ++eb)
#pragma unroll
            for (int s = 0; s < 2; ++s) {
                float vv[8];
                if (kb < PAST_LEN / 32) { const float* vb = cv + (size_t)(kb * 32 + 4 * hi) * WIDTH_A + h * 128 + eb * 32 + r32; asm volatile("" : "+v"(vb));
#pragma unroll
                    for (int j = 0; j < 8; ++j) vv[j] = vb[(size_t)(16 * s + 8 * (j >> 2) + (j & 3)) * WIDTH_A]; }
                else { const bf16* vb = Z + (size_t)(row0 + kb * 32 - PAST_LEN + 4 * hi) * ZN + ZC_VA + h * 128 + eb * 32 + r32; asm volatile("" : "+v"(vb));
#pragma unroll
                    for (int j = 0; j < 8; ++j) vv[j] = bf2f(vb[(size_t)(16 * s + 8 * (j >> 2) + (j & 3)) * ZN]); }
                v4u w; w.x = pk2(vv[0], vv[1]); w.y = pk2(vv[2], vv[3]); w.z = pk2(vv[4], vv[5]); w.w = pk2(vv[6], vv[7]);
                acc[eb] = __builtin_amdgcn_mfma_f32_32x32x16_bf16(xs[s], __builtin_bit_cast(bf16x8, w), acc[eb], 0, 0, 0);
            }
    }
    __syncthreads();
#pragma unroll
    for (int eb = 0; eb < 4; ++eb)
#pragma unroll
        for (int i = 0; i < 16; ++i) slot[(wid * 32 + crow_dev(i, hi)) * 128 + eb * 32 + r32] = acc[eb][i];
    __syncthreads();
    { const int q = tid >> 4, e0 = (tid & 15) * 8; float o[8];
#pragma unroll
      for (int j = 0; j < 8; ++j) o[j] = 0.f;
#pragma unroll
      for (int w = 0; w < NWAVES; ++w)
#pragma unroll
          for (int j = 0; j < 8; ++j) o[j] += slot[(w * 32 + q) * 128 + e0 + j];
      v4u pw; pw.x = pk2(o[0], o[1]); pw.y = pk2(o[2], o[3]); pw.z = pk2(o[4], o[5]); pw.w = pk2(o[6], o[7]);
      bf16* orow = O + (size_t)(row0 + q) * attn_body::OP + h * 256;
      unsigned zq = 0u; asm volatile("" : "+v"(zq));
      *(GAS v4u*)(orow + e0) = pw; *(GAS v4u*)(orow + 128 + e0) = (v4u){zq, zq, zq, zq}; }
    __syncthreads();
}

constexpr int ATT_NQB = LPP / 256;
constexpr int ATT_NPU = BATCH * 16 * ATT_NQB;
constexpr int ATT_NSU = DEC_BATCH * N_HEADS_A;
__device__ __forceinline__ void p_attention(Frame& F, int lq, unsigned char* ldsg) {
    const int l = lq % DEPTH;
    for (;;) {
        const KArgs ap = kargs(); const auto& a = *ap; WS_OPAQUE(a);
        const int tid = otid();
        gu32* head = (gu32*)wsb + CW_QUEUE + 64 * lq;
        const attn_body::bf16* QN = (const attn_body::bf16*)(wsb + a.off[R_QN]); const attn_body::bf16* KN = (const attn_body::bf16*)(wsb + a.off[R_KN]);
        const attn_body::bf16* Z = (const attn_body::bf16*)(wsb + a.off[R_Z]); attn_body::bf16* O = (attn_body::bf16*)(wsb + a.off[R_O]);
        if (tid == 0) F.MISC[16] = __hip_atomic_fetch_add(head, 1u, RLX_AGENT);
        __syncthreads();
        const int u = (int)F.MISC[16];
        __syncthreads();
        if (u >= ATT_NPU + ATT_NSU) break;
        if (u < ATT_NPU) {
            const int qb = (ATT_NQB - 1) - u / 32, bvh = u % 32, b = bvh >> 4, vh = bvh & 15, h = vh >> 2, c = (vh >> 1) & 1, half = vh & 1;
            build_bias_table((LAS float*)(F.lds + RING_OFF + attn_body::LDS_BT), a.in[I_REL], h, tid);
            __syncthreads();
            attn_body::attn_unit<8>(b, h * 128 + c * 64, ZC_VA + h * 128 + half * 64, h * 256 + c * 128 + half * 64, qb, QN, KN, Z, O, (char*)ldsg + RING_OFF);
        } else { const int su = u - ATT_NPU; attn_sample_unit(F, l, su >> 2, su & 3); }
    }
}
__device__ __forceinline__ void p_mixpost_a(Frame& F, int l) {
    const KArgs ap = kargs(); const auto& a = *ap; WS_OPAQUE(a);
    const int tid = otid(), lane = tid & 63, wave = __builtin_amdgcn_readfirstlane(tid >> 6);
    const bf16* O = (const bf16*)(wsb + a.off[R_O]); bf16* OA = (bf16*)(wsb + a.off[R_OA]);
    const int gw = F.vcu * NWAVES + wave, NGW = F.G * NWAVES;
    const float lam = lam_dev(a.in[I_LQK], l, lane), post = 1.f - lam_init_dev(l);
    const int h = lane >> 4, e0 = 8 * (lane & 15);
    float sg[8];
#pragma unroll
    for (int j = 0; j < 8; ++j) sg[j] = a.in[I_SUBLN][l * 2 * HEAD_DIM_A + e0 + j] * post;
    for (int m = gw; m < RP; m += NGW) {
        float o0[8], o1[8], d[8];
        unpack8(*(const GAS v4u*)(O + (size_t)m * 1024 + h * 256 + e0), o0); unpack8(*(const GAS v4u*)(O + (size_t)m * 1024 + h * 256 + 128 + e0), o1);
        float ss = 0.f;
#pragma unroll
        for (int j = 0; j < 8; ++j) { d[j] = o0[j] - lam * o1[j]; ss += d[j] * d[j]; }
        ss += __shfl_xor(ss, 1); ss += __shfl_xor(ss, 2); ss += __shfl_xor(ss, 4); ss += __shfl_xor(ss, 8);
        const float r = 1.f / sqrtf(ss * (1.f / 128.f) + EPSF);
#pragma unroll
        for (int j = 0; j < 8; ++j) d[j] = d[j] * r * sg[j];
        *(GAS v4u*)(OA + (size_t)m * WIDTH_A + h * 128 + e0) = pack8(d);
    }
}
constexpr int GDN_NCH = PEND / 64;
constexpr int GDN_NPI = BATCH * N_HEADS_B * GDN_NCH;
constexpr int GDN_NSI = DEC_BATCH * N_HEADS_B;
constexpr int GDN_NI = GDN_NPI + GDN_NSI;
constexpr int GI_W = 0, GI_QG = 16384, GI_KG = 32768, GI_AT = 49152, GI_U = 57344, GI_SC = 90112, GI_STRIDE = 90368;
static_assert(GDN_NI % 2 == 0 && PEND % 64 == 0, "gdn items");
__device__ __forceinline__ int frag_off(int row, int kk, int nkb) {
    const int fid = ((row >> 5) * nkb + (kk >> 5)) * 2 + ((kk & 31) >> 4), ln = (row & 31) + 32 * (((kk & 15) >> 2) & 1), j = ((kk & 15) >> 3) * 4 + (kk & 3);
    return (fid * 64 + ln) * 8 + j;
}
__device__ __forceinline__ float rdlane(float v, int i) { return __builtin_bit_cast(float, __builtin_amdgcn_readlane(__builtin_bit_cast(int, v), i)); }
__device__ __forceinline__ int gdn_item_row(int item, int j) {
    if (item < GDN_NPI) { const int sh = item / GDN_NCH, n = item % GDN_NCH; return (sh / N_HEADS_B) * LPP + 64 * n + j; }
    const int s = item - GDN_NPI; return j < 32 ? -1 : SROW0 + (s >> 2) * DEC_SEQ + (j - 32);
}
__device__ __forceinline__ int gdn_item_head(int item) { return item < GDN_NPI ? (item / GDN_NCH) % N_HEADS_B : (item - GDN_NPI) & 3; }

__device__ __forceinline__ void p_gdn_chunk(Frame& F, int l) {
    const KArgs ap = kargs(); const auto& a = *ap; WS_OPAQUE(a);
    const int tid = otid(), wave = __builtin_amdgcn_readfirstlane(tid >> 6), grp = wave >> 2, gw = wave & 3;
    const bf16* QKVB = (const bf16*)(wsb + a.off[R_QKVB]); const float* BG = (const float*)(wsb + a.off[R_BG]); unsigned char* GD = wsb + a.off[R_GDN];
    LAS float* A_lds = (LAS float*)(F.lds + RING_OFF + grp * 20480);
    LAS float* Gs = A_lds + 4096; LAS float* Bs = Gs + 64; LAS float* Es = Bs + 64;
    for (int pr = F.vcu; 2 * pr < GDN_NI; pr += F.G) {
        int lane_ = tid & 63; asm volatile("" : "+v"(lane_));
        const int lane = lane_, r32 = lane & 31, hi = lane >> 5;
        const int item = 2 * pr + grp, h = gdn_item_head(item);
        unsigned char* ib = GD + (size_t)item * GI_STRIDE;
        const int rowt = gdn_item_row(item, lane);
        const float beta = rowt >= 0 ? BG[(size_t)rowt * 8 + h] : 0.f; float G = rowt >= 0 ? BG[(size_t)rowt * 8 + 4 + h] : 0.f;
#pragma unroll
        for (int o = 1; o < 64; o <<= 1) { const float v = __shfl_up(G, o); if (lane >= o) G += v; }
        const float Glast = rdlane(G, 63), eG = __expf(G);
        if (gw == 0) { Gs[lane] = G; Bs[lane] = beta; Es[lane] = eG; if (lane == 0) *(float*)(ib + GI_SC) = __expf(Glast); }
        __syncthreads();
        { const int i0 = 32 * (gw >> 1), j0 = 32 * (gw & 1);
          const int ra = gdn_item_row(item, i0 + r32), rb = gdn_item_row(item, j0 + r32);
          f32x16 akk, aqk;
#pragma unroll
          for (int r = 0; r < 16; ++r) { akk[r] = 0.f; aqk[r] = 0.f; }
          const bf16x8 zf = {0, 0, 0, 0, 0, 0, 0, 0};
#pragma unroll
          for (int s = 0; s < 8; ++s) {
              const bf16x8 qa = ra >= 0 ? *(const GAS bf16x8*)(QKVB + (size_t)ra * 1536 + h * 128 + 16 * s + 8 * hi) : zf;
              const bf16x8 ka = ra >= 0 ? *(const GAS bf16x8*)(QKVB + (size_t)ra * 1536 + 512 + h * 128 + 16 * s + 8 * hi) : zf;
              const bf16x8 kb = rb >= 0 ? *(const GAS bf16x8*)(QKVB + (size_t)rb * 1536 + 512 + h * 128 + 16 * s + 8 * hi) : zf;
              akk = __builtin_amdgcn_mfma_f32_32x32x16_bf16(ka, kb, akk, 0, 0, 0); aqk = __builtin_amdgcn_mfma_f32_32x32x16_bf16(qa, kb, aqk, 0, 0, 0);
          }
          const int j = j0 + r32; const float Gj = Gs[j]; bf16* AT = (bf16*)(ib + GI_AT);
#pragma unroll
          for (int r = 0; r < 16; ++r) { const int i = i0 + crow_dev(r, hi); const float dec = i >= j ? __expf(Gs[i] - Gj) : 0.f;
              A_lds[i * 64 + j] = i > j ? Bs[i] * akk[r] * dec : 0.f;
              AT[frag_off(i, j, 2)] = (bf16)f2bf(aqk[r] * dec); }
        }
        __syncthreads();
        { const int col = 64 * gw + lane; float x[64];
#pragma unroll
          for (int i = 0; i < 64; ++i) { const int ri = gdn_item_row(item, i);
              x[i] = ri >= 0 ? bf2f(QKVB[(size_t)ri * 1536 + (gw < 2 ? 1024 + h * 128 + col : 512 + h * 128 + (col - 128))]) : 0.f; }
#pragma unroll
          for (int i = 0; i < 64; ++i) x[i] *= gw < 2 ? rdlane(beta, i) : rdlane(beta, i) * rdlane(eG, i);
#pragma unroll
          for (int i = 1; i < 64; ++i) { const float arow = A_lds[i * 64 + lane];
#pragma unroll
              for (int j = 0; j < i; ++j) x[i] -= rdlane(arow, j) * x[j]; }
          if (gw < 2) { float* ub = (float*)(ib + GI_U) + col; asm volatile("" : "+v"(ub));
#pragma unroll
              for (int i = 0; i < 64; ++i) ub[i * 128] = x[i]; }
          else { const int k = col - 128; bf16* wb = (bf16*)(ib + GI_W) + frag_off(0, k, 4); asm volatile("" : "+v"(wb));
#pragma unroll
              for (int i = 0; i < 64; ++i) wb[(i >> 5) * 4096 + (i & 31) * 8] = (bf16)f2bf(x[i]); }
        }
        { bf16* QGF = (bf16*)(ib + GI_QG); bf16* KGF = (bf16*)(ib + GI_KG);
          for (int e = gw * 64 + lane; e < 64 * 128; e += 256) { const int c = e >> 7, k = e & 127, rc = gdn_item_row(item, c);
              const float qv = rc >= 0 ? bf2f(QKVB[(size_t)rc * 1536 + h * 128 + k]) : 0.f, kv = rc >= 0 ? bf2f(QKVB[(size_t)rc * 1536 + 512 + h * 128 + k]) : 0.f;
              QGF[frag_off(c, k, 4)] = (bf16)f2bf(qv * Es[c]); KGF[frag_off(k, c, 2)] = (bf16)f2bf(kv * __expf(Glast - Gs[c])); }
        }
        __syncthreads();
    }
}

__device__ __forceinline__ void gdn_chain(const unsigned char* GD, bf16* OB, const float* sdelta, float* dout, int item0, int nch, int h, int vb, int lane) {
    const int r32 = lane & 31, hi = lane >> 5;
    f32x16 S[4];
#pragma unroll
    for (int kb = 0; kb < 4; ++kb)
#pragma unroll
        for (int r = 0; r < 16; ++r) S[kb][r] = sdelta ? sdelta[(size_t)(kb * 32 + crow_dev(r, hi)) * HEAD_DIM_B + vb * 32 + r32] : 0.f;
    for (int n = 0; n < nch; ++n) {
        const int item = item0 + n; const unsigned char* ib = GD + (size_t)item * GI_STRIDE;
        const float eGl = *(const float*)(ib + GI_SC);
        const GAS bf16x8* WF = (const GAS bf16x8*)(ib + GI_W) + lane; const GAS bf16x8* QF = (const GAS bf16x8*)(ib + GI_QG) + lane;
        const GAS bf16x8* KF = (const GAS bf16x8*)(ib + GI_KG) + lane; const GAS bf16x8* AF = (const GAS bf16x8*)(ib + GI_AT) + lane; const float* U = (const float*)(ib + GI_U);
        bf16x8 Sp[4][2];
#pragma unroll
        for (int kb = 0; kb < 4; ++kb)
#pragma unroll
            for (int s = 0; s < 2; ++s) { v4u w; w.x = pk2(S[kb][8 * s], S[kb][8 * s + 1]); w.y = pk2(S[kb][8 * s + 2], S[kb][8 * s + 3]); w.z = pk2(S[kb][8 * s + 4], S[kb][8 * s + 5]); w.w = pk2(S[kb][8 * s + 6], S[kb][8 * s + 7]); Sp[kb][s] = __builtin_bit_cast(bf16x8, w); }
        f32x16 vn[2], ot[2];
#pragma unroll
        for (int cb = 0; cb < 2; ++cb) {
            f32x16 ws;
#pragma unroll
            for (int r = 0; r < 16; ++r) { ws[r] = 0.f; ot[cb][r] = 0.f; }
#pragma unroll
            for (int kb = 0; kb < 4; ++kb)
#pragma unroll
                for (int s = 0; s < 2; ++s) { ws = __builtin_amdgcn_mfma_f32_32x32x16_bf16(WF[((cb * 4 + kb) * 2 + s) * 64], Sp[kb][s], ws, 0, 0, 0);
                    ot[cb] = __builtin_amdgcn_mfma_f32_32x32x16_bf16(QF[((cb * 4 + kb) * 2 + s) * 64], Sp[kb][s], ot[cb], 0, 0, 0); }
#pragma unroll
            for (int r = 0; r < 16; ++r) vn[cb][r] = U[(cb * 32 + crow_dev(r, hi)) * 128 + vb * 32 + r32] - ws[r];
        }
        bf16x8 Vp[2][2];
#pragma unroll
        for (int cb = 0; cb < 2; ++cb)
#pragma unroll
            for (int s = 0; s < 2; ++s) { v4u w; w.x = pk2(vn[cb][8 * s], vn[cb][8 * s + 1]); w.y = pk2(vn[cb][8 * s + 2], vn[cb][8 * s + 3]); w.z = pk2(vn[cb][8 * s + 4], vn[cb][8 * s + 5]); w.w = pk2(vn[cb][8 * s + 6], vn[cb][8 * s + 7]); Vp[cb][s] = __builtin_bit_cast(bf16x8, w); }
#pragma unroll
        for (int cb = 0; cb < 2; ++cb)
#pragma unroll
            for (int c2 = 0; c2 <= cb; ++c2)
#pragma unroll
                for (int s = 0; s < 2; ++s) ot[cb] = __builtin_amdgcn_mfma_f32_32x32x16_bf16(AF[((cb * 2 + c2) * 2 + s) * 64], Vp[c2][s], ot[cb], 0, 0, 0);
#pragma unroll
        for (int cb = 0; cb < 2; ++cb)
#pragma unroll
            for (int r = 0; r < 16; ++r) { const int row = gdn_item_row(item, cb * 32 + crow_dev(r, hi)); if (row >= 0) OB[(size_t)row * WIDTH_B + h * 128 + vb * 32 + r32] = (bf16)f2bf(ot[cb][r]); }
#pragma unroll
        for (int kb = 0; kb < 4; ++kb) {
#pragma unroll
            for (int r = 0; r < 16; ++r) S[kb][r] *= eGl;
#pragma unroll
            for (int cb = 0; cb < 2; ++cb)
#pragma unroll
                for (int s = 0; s < 2; ++s) S[kb] = __builtin_amdgcn_mfma_f32_32x32x16_bf16(KF[((kb * 2 + cb) * 2 + s) * 64], Vp[cb][s], S[kb], 0, 0, 0);
        }
    }
#pragma unroll
    for (int kb = 0; kb < 4; ++kb)
#pragma unroll
        for (int r = 0; r < 16; ++r) dout[(size_t)(kb * 32 + crow_dev(r, hi)) * HEAD_DIM_B + vb * 32 + r32] = S[kb][r];
}
constexpr int GCH_BUF = 57344;
__device__ __forceinline__ void gdn_chain_wg(Frame& F, const unsigned char* GD, bf16* OB, float* dout, int item0, int h) {
    const int tid = otid(), lane = tid & 63, wave = __builtin_amdgcn_readfirstlane(tid >> 6), r32 = lane & 31, hi = lane >> 5, vb = wave & 3;
    const bool comp = wave < 4;
    LAS unsigned char* lb = F.lds + RING_OFF;
    f32x16 S[4];
#pragma unroll
    for (int kb = 0; kb < 4; ++kb)
#pragma unroll
        for (int r = 0; r < 16; ++r) S[kb][r] = 0.f;
    float ucur[2][16], unext[2][16]; float egl_cur, egl_next = 0.f;
    { const unsigned char* ib = GD + (size_t)item0 * GI_STRIDE;
#pragma unroll
      for (int j = 0; j < 7; ++j) { const int pc = wave * 7 + j; __builtin_amdgcn_global_load_lds((const unsigned*)(ib + pc * 1024 + lane * 16), (LAS unsigned*)(lb + pc * 1024), 16, 0, 0); }
      const float* U = (const float*)(ib + GI_U);
#pragma unroll
      for (int cb = 0; cb < 2; ++cb)
#pragma unroll
          for (int r = 0; r < 16; ++r) ucur[cb][r] = comp ? U[(cb * 32 + crow_dev(r, hi)) * 128 + vb * 32 + r32] : 0.f;
      egl_cur = *(const float*)(ib + GI_SC); }
    VM_WAIT(); __syncthreads();
    for (int n = 0; n < GDN_NCH; ++n) {
        const int item = item0 + n; const LAS unsigned char* bufc = lb + (n & 1) * GCH_BUF;
        if (n + 1 < GDN_NCH) { const unsigned char* ib = GD + (size_t)(item + 1) * GI_STRIDE; LAS unsigned char* bufn = lb + ((n + 1) & 1) * GCH_BUF;
#pragma unroll
            for (int j = 0; j < 7; ++j) { const int pc = wave * 7 + j; __builtin_amdgcn_global_load_lds((const unsigned*)(ib + pc * 1024 + lane * 16), (LAS unsigned*)(bufn + pc * 1024), 16, 0, 0); }
            const float* U = (const float*)(ib + GI_U);
#pragma unroll
            for (int cb = 0; cb < 2; ++cb)
#pragma unroll
                for (int r = 0; r < 16; ++r) unext[cb][r] = comp ? U[(cb * 32 + crow_dev(r, hi)) * 128 + vb * 32 + r32] : 0.f;
            egl_next = *(const float*)(ib + GI_SC); }
        if (comp) {
            const LAS bf16x8* WF = (const LAS bf16x8*)(bufc + GI_W) + lane; const LAS bf16x8* QF = (const LAS bf16x8*)(bufc + GI_QG) + lane;
            const LAS bf16x8* KF = (const LAS bf16x8*)(bufc + GI_KG) + lane; const LAS bf16x8* AF = (const LAS bf16x8*)(bufc + GI_AT) + lane;
            bf16x8 Sp[4][2];
#pragma unroll
            for (int kb = 0; kb < 4; ++kb)
#pragma unroll
                for (int s = 0; s < 2; ++s) { v4u w; w.x = pk2(S[kb][8 * s], S[kb][8 * s + 1]); w.y = pk2(S[kb][8 * s + 2], S[kb][8 * s + 3]); w.z = pk2(S[kb][8 * s + 4], S[kb][8 * s + 5]); w.w = pk2(S[kb][8 * s + 6], S[kb][8 * s + 7]); Sp[kb][s] = __builtin_bit_cast(bf16x8, w); }
            f32x16 vn[2], ot[2];
#pragma unroll
            for (int cb = 0; cb < 2; ++cb) {
                f32x16 ws;
#pragma unroll
                for (int r = 0; r < 16; ++r) { ws[r] = 0.f; ot[cb][r] = 0.f; }
#pragma unroll
                for (int kb = 0; kb < 4; ++kb)
#pragma unroll
                    for (int s = 0; s < 2; ++s) { ws = __builtin_amdgcn_mfma_f32_32x32x16_bf16(WF[((cb * 4 + kb) * 2 + s) * 64], Sp[kb][s], ws, 0, 0, 0);
                        ot[cb] = __builtin_amdgcn_mfma_f32_32x32x16_bf16(QF[((cb * 4 + kb) * 2 + s) * 64], Sp[kb][s], ot[cb], 0, 0, 0); }
#pragma unroll
                for (int r = 0; r < 16; ++r) vn[cb][r] = ucur[cb][r] - ws[r];
            }
            bf16x8 Vp[2][2];
#pragma unroll
            for (int cb = 0; cb < 2; ++cb)
#pragma unroll
                for (int s = 0; s < 2; ++s) { v4u w; w.x = pk2(vn[cb][8 * s], vn[cb][8 * s + 1]); w.y = pk2(vn[cb][8 * s + 2], vn[cb][8 * s + 3]); w.z = pk2(vn[cb][8 * s + 4], vn[cb][8 * s + 5]); w.w = pk2(vn[cb][8 * s + 6], vn[cb][8 * s + 7]); Vp[cb][s] = __builtin_bit_cast(bf16x8, w); }
#pragma unroll
            for (int cb = 0; cb < 2; ++cb)
#pragma unroll
                for (int c2 = 0; c2 <= cb; ++c2)
#pragma unroll
                    for (int s = 0; s < 2; ++s) ot[cb] = __builtin_amdgcn_mfma_f32_32x32x16_bf16(AF[((cb * 2 + c2) * 2 + s) * 64], Vp[c2][s], ot[cb], 0, 0, 0);
            { const int row0 = gdn_item_row(item, 0);
#pragma unroll
              for (int cb = 0; cb < 2; ++cb)
#pragma unroll
                  for (int r = 0; r < 16; ++r) OB[(size_t)(row0 + cb * 32 + crow_dev(r, hi)) * WIDTH_B + h * 128 + vb * 32 + r32] = (bf16)f2bf(ot[cb][r]); }
#pragma unroll
            for (int kb = 0; kb < 4; ++kb) {
#pragma unroll
                for (int r = 0; r < 16; ++r) S[kb][r] *= egl_cur;
#pragma unroll
                for (int cb = 0; cb < 2; ++cb)
#pragma unroll
                    for (int s = 0; s < 2; ++s) S[kb] = __builtin_amdgcn_mfma_f32_32x32x16_bf16(KF[((kb * 2 + cb) * 2 + s) * 64], Vp[cb][s], S[kb], 0, 0, 0);
            }
        }
        VM_WAIT(); __syncthreads();
#pragma unroll
        for (int cb = 0; cb < 2; ++cb)
#pragma unroll
            for (int r = 0; r < 16; ++r) ucur[cb][r] = unext[cb][r];
        egl_cur = egl_next;
    }
    if (comp) {
#pragma unroll
        for (int kb = 0; kb < 4; ++kb)
#pragma unroll
            for (int r = 0; r < 16; ++r) dout[(size_t)(kb * 32 + crow_dev(r, hi)) * HEAD_DIM_B + vb * 32 + r32] = S[kb][r]; }
}
__device__ __forceinline__ void p_gdn_chain(Frame& F, int l) {
    const KArgs ap = kargs(); const auto& a = *ap; WS_OPAQUE(a);
    const unsigned char* GD = wsb + a.off[R_GDN]; bf16* OB = (bf16*)(wsb + a.off[R_OB]);
    if (F.vcu % 32 == 0 && F.vcu / 32 < BATCH * N_HEADS_B) { const int sh = F.vcu / 32, sq = sh / N_HEADS_B, h = sh % N_HEADS_B;
        gdn_chain_wg(F, GD, OB, a.out + O_DP + (((size_t)l * BATCH + sq) * N_HEADS_B + h) * HEAD_DIM_B * HEAD_DIM_B, sh * GDN_NCH, h); }
    else { const int tid = otid(), lane = tid & 63, wave = __builtin_amdgcn_readfirstlane(tid >> 6);
        const int t = (F.vcu - F.vcu / 32 - 1) * NWAVES + wave;
        if (t < GDN_NSI * 4) { const int s = t >> 2, vb = t & 3, bs = s >> 2, h = s & 3; const size_t so = (((size_t)l * DEC_BATCH + bs) * N_HEADS_B + h) * HEAD_DIM_B * HEAD_DIM_B;
            gdn_chain(GD, OB, a.in[I_SDELTA] + so, a.out + O_DS + so, GDN_NPI + s, 1, h, vb, lane); } }
}
__device__ __forceinline__ void p_mixpost_b(Frame& F, int l) {
    const KArgs ap = kargs(); const auto& a = *ap; WS_OPAQUE(a);
    const int tid = otid(), lane = tid & 63, wave = __builtin_amdgcn_readfirstlane(tid >> 6);
    bf16* OB = (bf16*)(wsb + a.off[R_OB]); const bf16* Z = (const bf16*)(wsb + a.off[R_Z]);
    const int gw = F.vcu * NWAVES + wave, NGW = F.G * NWAVES, e0 = 8 * (lane & 15);
    float gn[8];
#pragma unroll
    for (int j = 0; j < 8; ++j) gn[j] = a.in[I_GDNN][l * HEAD_DIM_B + e0 + j];
    for (int m = gw; m < RP; m += NGW) {
        float o[8], gt[8];
        unpack8(*(const GAS v4u*)(OB + (size_t)m * WIDTH_B + 8 * lane), o); unpack8(*(const GAS v4u*)(Z + (size_t)m * ZN + ZC_GB + 8 * lane), gt);
        float ss = 0.f;
#pragma unroll
        for (int j = 0; j < 8; ++j) ss += o[j] * o[j];
        ss += __shfl_xor(ss, 1); ss += __shfl_xor(ss, 2); ss += __shfl_xor(ss, 4); ss += __shfl_xor(ss, 8);
        const float r = 1.f / sqrtf(ss * (1.f / 128.f) + EPSF);
#pragma unroll
        for (int j = 0; j < 8; ++j) o[j] = o[j] * r * gn[j] * gt[j] * sigm(gt[j]);
        *(GAS v4u*)(OB + (size_t)m * WIDTH_B + 8 * lane) = pack8(o);
    }
}
constexpr int S5_M1 = 0, S5_M2 = 131072, S5_M3 = 196608, S5_L16 = 262144, S5_TSTRIDE = 262656;
constexpr int S5_NCHK = RP / 16;
constexpr int S5_NBLK = S5_NCHK / 32;
constexpr int S5_PCH = PEND / 16;
static_assert(S5_NCHK % 32 == 0 && LPP % 16 == 0 && PADF % 16 == 0 && S5_STATE == 64 && S5_GROUPS == 32, "s5 shapes");

__device__ __forceinline__ void s5_tables(Frame& F) {
    const KArgs ap = kargs(); const auto& a = *ap; WS_OPAQUE(a);
    const int tid = otid();
    LAS float* pw = (LAS float*)(F.lds + RING_OFF);
    LAS float* bb = pw + 17 * 128;
    LAS float* Kt = bb + 64 * 32;
    for (int it = F.vcu; it < DEPTH * S5_GROUPS; it += F.G) {
        const int l = it / S5_GROUPS, g = it % S5_GROUPS; const size_t gp = ((size_t)l * S5_GROUPS + g) * S5_STATE;
        unsigned char* tb = wsb + a.off[R_S5T] + (size_t)it * S5_TSTRIDE;
        const float dt = __expf(a.in[I_LDT][l * S5_GROUPS + g]);
        for (int e = tid; e < 17 * 64; e += NTHR) { const int k = e >> 6, p = e & 63; const float ar = a.in[I_AR][gp + p] * dt * (float)k, ai = a.in[I_AI][gp + p] * dt * (float)k;
            float sn, cs; sincosf(ai, &sn, &cs); const float er = expf(ar); pw[e * 2] = er * cs; pw[e * 2 + 1] = er * sn; }
        __syncthreads();
        for (int e = tid; e < 64 * 16; e += NTHR) { const int p = e >> 4; const float ar = a.in[I_AR][gp + p], ai = a.in[I_AI][gp + p];
            const float nr = pw[(64 + p) * 2] - 1.f, ni = pw[(64 + p) * 2 + 1], den = ar * ar + ai * ai, fr = (nr * ar + ni * ai) / den, fi = (ni * ar - nr * ai) / den;
            const float br = a.in[I_BR][gp * 16 + e], bi = a.in[I_BI][gp * 16 + e]; bb[e * 2] = fr * br - fi * bi; bb[e * 2 + 1] = fr * bi + fi * br; }
        if (tid < 128) { const int p = tid & 63; ((float*)(tb + S5_L16))[tid] = pw[(16 * 64 + p) * 2 + (tid >> 6)]; }
        __syncthreads();
        const float* cre = a.in[I_CR] + ((size_t)l * S5_GROUPS + g) * 16 * 64; const float* cim = a.in[I_CI] + ((size_t)l * S5_GROUPS + g) * 16 * 64;
        for (int e = tid; e < 4096; e += NTHR) { const int d = e >> 8, i = (e >> 4) & 15, j = e & 15; float acc = 0.f;
            for (int p = 0; p < 64; ++p) { const float cr = cre[i * 64 + p], ci = cim[i * 64 + p], pr = pw[(d * 64 + p) * 2], pi = pw[(d * 64 + p) * 2 + 1];
                const float tr = cr * pr - ci * pi, ti = cr * pi + ci * pr; acc += tr * bb[(p * 16 + j) * 2] - ti * bb[(p * 16 + j) * 2 + 1]; }
            Kt[e] = acc; }
        __syncthreads();
        bf16* M1 = (bf16*)(tb + S5_M1); bf16* M2 = (bf16*)(tb + S5_M2); bf16* M3 = (bf16*)(tb + S5_M3);
        for (int e = tid; e < 65536; e += NTHR) { const int n = e >> 8, k = e & 255, tau = n >> 4, i = n & 15, sg = k >> 4, j = k & 15;
            float v = 0.f; if (sg <= tau) { v = Kt[((tau - sg) * 16 + i) * 16 + j]; if (sg == tau && i == j) v += a.in[I_SD][(l * S5_GROUPS + g) * 16 + i]; }
            M1[e] = (bf16)f2bf(v); }
        for (int e = tid; e < 32768; e += NTHR) { const int n = e >> 8, k = e & 255, ri = n >> 6, p = n & 63, sg = k >> 4, j = k & 15;
            const float pr = pw[((15 - sg) * 64 + p) * 2], pi = pw[((15 - sg) * 64 + p) * 2 + 1], br = bb[(p * 16 + j) * 2], bi = bb[(p * 16 + j) * 2 + 1];
            M2[e] = (bf16)f2bf(ri == 0 ? pr * br - pi * bi : pr * bi + pi * br); }
        for (int e = tid; e < 32768; e += NTHR) { const int n = e >> 7, k = e & 127, tau = n >> 4, i = n & 15, ri = k >> 6, p = k & 63;
            const float cr = cre[i * 64 + p], ci = cim[i * 64 + p], pr = pw[((tau + 1) * 64 + p) * 2], pi = pw[((tau + 1) * 64 + p) * 2 + 1];
            M3[e] = (bf16)f2bf(ri == 0 ? cr * pr - ci * pi : -(cr * pi + ci * pr)); }
        __syncthreads();
    }
}
__device__ __forceinline__ void p_s5_e(Frame& F, int l) {
    const KArgs ap = kargs(); const auto& a = *ap; WS_OPAQUE(a);
    const int tid = otid(), lane = tid & 63, wave = __builtin_amdgcn_readfirstlane(tid >> 6), r32 = lane & 31, hi = lane >> 5;
    const bf16* Z = (const bf16*)(wsb + a.off[R_Z]); float* E = (float*)(wsb + a.off[R_S5E]);
    for (int u = F.vcu * NWAVES + wave; u < S5_NBLK * S5_GROUPS; u += F.G * NWAVES) {
        const int blk = u / S5_GROUPS, g = u % S5_GROUPS;
        const unsigned char* tb = wsb + a.off[R_S5T] + (size_t)(l * S5_GROUPS + g) * S5_TSTRIDE;
        const GAS bf16x8* M2 = (const GAS bf16x8*)(tb + S5_M2);
        const bf16* zr = Z + (size_t)((blk * 32 + r32) * 16) * ZN + ZC_UC + g * 16 + 8 * hi;
        f32x16 acc[4];
#pragma unroll
        for (int nb = 0; nb < 4; ++nb)
#pragma unroll
            for (int r = 0; r < 16; ++r) acc[nb][r] = 0.f;
#pragma unroll 4
        for (int sg = 0; sg < 16; ++sg) { const bf16x8 af = *(const GAS bf16x8*)(zr + (size_t)sg * ZN);
#pragma unroll
            for (int nb = 0; nb < 4; ++nb) acc[nb] = __builtin_amdgcn_mfma_f32_32x32x16_bf16(af, M2[((nb * 32 + r32) * 256 + sg * 16 + 8 * hi) >> 3], acc[nb], 0, 0, 0); }
#pragma unroll
        for (int nb = 0; nb < 4; ++nb)
#pragma unroll
            for (int r = 0; r < 16; ++r) E[((size_t)(blk * 32 + crow_dev(r, hi)) * S5_GROUPS + g) * 128 + nb * 32 + r32] = acc[nb][r];
    }
}
__device__ __forceinline__ void s5_scan_task(const float* E, bf16* XP, const float* l16, int g, int c0, int nch, float xr, float xi, float* ore, float* oim, int lane) {
    const float lr = l16[lane], li = l16[64 + lane];
    int c = 0;
    for (; c + 8 <= nch; c += 8) { float er[8], ei[8];
#pragma unroll
        for (int q = 0; q < 8; ++q) { const float* e = E + ((size_t)(c0 + c + q) * S5_GROUPS + g) * 128; er[q] = e[lane]; ei[q] = e[64 + lane]; }
#pragma unroll
        for (int q = 0; q < 8; ++q) { bf16* xp = XP + ((size_t)(c0 + c + q) * S5_GROUPS + g) * 128; xp[lane] = (bf16)f2bf(xr); xp[64 + lane] = (bf16)f2bf(xi);
            const float nr = lr * xr - li * xi + er[q], ni = lr * xi + li * xr + ei[q]; xr = nr; xi = ni; } }
    for (; c < nch; ++c) { const float* e = E + ((size_t)(c0 + c) * S5_GROUPS + g) * 128; bf16* xp = XP + ((size_t)(c0 + c) * S5_GROUPS + g) * 128; xp[lane] = (bf16)f2bf(xr); xp[64 + lane] = (bf16)f2bf(xi);
        const float nr = lr * xr - li * xi + e[lane], ni = lr * xi + li * xr + e[64 + lane]; xr = nr; xi = ni; }
    ore[lane] = xr; oim[lane] = xi;
}
constexpr int S5_NTASK = (BATCH + DEC_BATCH) * S5_GROUPS;
__device__ __forceinline__ void s5_scan_run(Frame& F, int l, int t, int lane) {
    const KArgs ap = kargs(); const auto& a = *ap; WS_OPAQUE(a);
    const int sq = t / S5_GROUPS, g = t % S5_GROUPS;
    const float* E = (const float*)(wsb + a.off[R_S5E]); bf16* XP = (bf16*)(wsb + a.off[R_S5X]);
    const float* l16 = (const float*)(wsb + a.off[R_S5T] + (size_t)(l * S5_GROUPS + g) * S5_TSTRIDE + S5_L16);
    if (sq < BATCH) { const size_t oo = (((size_t)l * BATCH + sq) * S5_GROUPS + g) * S5_STATE;
        s5_scan_task(E, XP, l16, g, sq * (LPP / 16), S5_PCH, 0.f, 0.f, a.out + O_SRP + oo, a.out + O_SIP + oo, lane); }
    else { const int bs = sq - BATCH; const size_t oo = (((size_t)l * DEC_BATCH + bs) * S5_GROUPS + g) * S5_STATE;
        s5_scan_task(E, XP, l16, g, SROW0 / 16 + bs * (DEC_SEQ / 16), DEC_SEQ / 16, a.in[I_SRE][oo + lane], a.in[I_SIM][oo + lane], a.out + O_SRS + oo, a.out + O_SIS + oo, lane); }
}
__device__ __forceinline__ float gelu_tanh(float x) { const float z = 0.7978845608028654f * (x + 0.044715f * x * x * x); const float t = 1.f - 2.f / (__expf(2.f * z) + 1.f); return 0.5f * x * (1.f + t); }
__device__ __forceinline__ void p_s5_out(Frame& F, int l) {
    const KArgs ap = kargs(); const auto& a = *ap; WS_OPAQUE(a);
    const int tid = otid(), lane = tid & 63, wave = __builtin_amdgcn_readfirstlane(tid >> 6), r32 = lane & 31, hi = lane >> 5;
    const bf16* Z = (const bf16*)(wsb + a.off[R_Z]); const bf16* XP = (const bf16*)(wsb + a.off[R_S5X]); bf16* YC = (bf16*)(wsb + a.off[R_YC]);
    for (int u = F.vcu * NWAVES + wave; u < S5_NBLK * S5_GROUPS; u += F.G * NWAVES) {
        const int blk = u / S5_GROUPS, g = u % S5_GROUPS;
        const unsigned char* tb = wsb + a.off[R_S5T] + (size_t)(l * S5_GROUPS + g) * S5_TSTRIDE;
        const GAS bf16x8* M1 = (const GAS bf16x8*)(tb + S5_M1); const GAS bf16x8* M3 = (const GAS bf16x8*)(tb + S5_M3);
        const bf16* zr = Z + (size_t)((blk * 32 + r32) * 16) * ZN + ZC_UC + g * 16 + 8 * hi;
        const bf16* xr = XP + ((size_t)(blk * 32 + r32) * S5_GROUPS + g) * 128 + 8 * hi;
        f32x16 acc[8];
#pragma unroll
        for (int nb = 0; nb < 8; ++nb)
#pragma unroll
            for (int r = 0; r < 16; ++r) acc[nb][r] = 0.f;
#pragma unroll 2
        for (int sg = 0; sg < 16; ++sg) { const bf16x8 af = *(const GAS bf16x8*)(zr + (size_t)sg * ZN);
#pragma unroll
            for (int nb = 0; nb < 8; ++nb) acc[nb] = __builtin_amdgcn_mfma_f32_32x32x16_bf16(af, M1[((nb * 32 + r32) * 256 + sg * 16 + 8 * hi) >> 3], acc[nb], 0, 0, 0); }
#pragma unroll 2
        for (int s = 0; s < 8; ++s) { const bf16x8 af = *(const GAS bf16x8*)(xr + 16 * s);
#pragma unroll
            for (int nb = 0; nb < 8; ++nb) acc[nb] = __builtin_amdgcn_mfma_f32_32x32x16_bf16(af, M3[((nb * 32 + r32) * 128 + s * 16 + 8 * hi) >> 3], acc[nb], 0, 0, 0); }
#pragma unroll
        for (int nb = 0; nb < 8; ++nb)
#pragma unroll
            for (int r = 0; r < 16; ++r) { const int row = (blk * 32 + crow_dev(r, hi)) * 16 + 2 * nb + (r32 >> 4);
                YC[(size_t)row * WIDTH_C + g * 16 + (r32 & 15)] = (bf16)f2bf(gelu_tanh(acc[nb][r])); }
    }
}
__device__ __forceinline__ float wave_max(float v) {
#pragma unroll
    for (int o = 1; o < 64; o <<= 1) v = fmaxf(v, __shfl_xor(v, o));
    return v;
}
__device__ __forceinline__ int rdlane_i(int v, int i) { return __builtin_amdgcn_readlane(v, i); }
constexpr float NEG_BIG = -3.0e38f;
__device__ __forceinline__ unsigned fkey(float v) { const unsigned u = __builtin_bit_cast(unsigned, v); return (u & 0x80000000u) ? ~u : (u | 0x80000000u); }
__device__ __forceinline__ int mbcnt64(unsigned long long m) { return __builtin_amdgcn_mbcnt_hi((unsigned)(m >> 32), __builtin_amdgcn_mbcnt_lo((unsigned)m, 0)); }
template <int CTRL> __device__ __forceinline__ float dpp_f(float v) { return __builtin_bit_cast(float, __builtin_amdgcn_update_dpp(0, __builtin_bit_cast(int, v), CTRL, 0xf, 0xf, true)); }
__device__ __forceinline__ float wave_sum_dpp(float v) {
    v += dpp_f<0xB1>(v); v += dpp_f<0x4E>(v); v += dpp_f<0x141>(v); v += dpp_f<0x140>(v);
    return rdlane(v, 0) + rdlane(v, 16) + rdlane(v, 32) + rdlane(v, 48);
}
__device__ __forceinline__ float wave_max_dpp(float v) {
    v = fmaxf(v, dpp_f<0xB1>(v)); v = fmaxf(v, dpp_f<0x4E>(v)); v = fmaxf(v, dpp_f<0x141>(v)); v = fmaxf(v, dpp_f<0x140>(v));
    return fmaxf(fmaxf(rdlane(v, 0), rdlane(v, 16)), fmaxf(rdlane(v, 32), rdlane(v, 48)));
}

__device__ __forceinline__ void pro_wqs(Frame& F) {
    const KArgs ap = kargs(); const auto& a = *ap; WS_OPAQUE(a);
    const int tid = otid(), lane = tid & 63, wave = __builtin_amdgcn_readfirstlane(tid >> 6);
    bf16* WQ = (bf16*)(wsb + a.off[R_WQS]);
    for (int t = F.vcu * NWAVES + wave; t < DEPTH * 16 * 16; t += F.G * NWAVES) {
        const int l = t >> 8, hc = (t >> 4) & 15, kb = t & 15, k = kb * 64 + lane;
        const float* wr = a.in[I_PWQ] + ((size_t)l * D_MODEL + k) * PQ + hc * 128;
        float w[128];
#pragma unroll
        for (int d = 0; d < 128; d += 4) { const f32x4 v = *(const GAS f32x4*)(wr + d); w[d] = v.x; w[d + 1] = v.y; w[d + 2] = v.z; w[d + 3] = v.w; }
        const float* sk = a.in[I_PSK] + ((size_t)l * 16 + hc) * 128 * 128;
        bf16* o = WQ + ((size_t)l * PQ + hc * 128) * D_MODEL + k;
#pragma clang loop vectorize(disable) unroll(disable)
        for (int n = 0; n < 128; ++n) { const float* sr = sk + n * 128; float acc = 0.f;
#pragma unroll
            for (int d = 0; d < 128; ++d) acc += w[d] * sr[d];
            o[(size_t)n * D_MODEL] = (bf16)f2bf(acc); }
    }
}
__device__ __forceinline__ void pro_wrest(Frame& F) {
    const KArgs ap = kargs(); const auto& a = *ap; WS_OPAQUE(a);
    const int tid = otid(), lane = tid & 63, wave = __builtin_amdgcn_readfirstlane(tid >> 6);
    LAS float* scr = (LAS float*)(F.lds + RING_OFF + wave * 16384);
    const int gw = F.vcu * NWAVES + wave, NGW = F.G * NWAVES;
    bf16* WG = (bf16*)(wsb + a.off[R_WGLU]); bf16* WB = (bf16*)(wsb + a.off[R_WBR]); bf16* WO = (bf16*)(wsb + a.off[R_WOUT]);
    constexpr int IG = (512 / 64) * (1024 / 32), IB = IG, IO = (1024 / 64) * (1024 / 32), IL = IG + 3 * IB + IO;
    for (int it = gw; it < DEPTH * IL; it += NGW) { const int l = it / IL; int r = it % IL;
        if (r < IG) { transpose_item(a.in[I_WGLU] + (size_t)l * 512 * 1024, 1024, 512, WG + (size_t)l * 1024 * 512, 32 * (r % 32), 64 * (r / 32), CmGlu(), scr, lane); continue; } r -= IG;
        if (r < 3 * IB) { const int w = r / IB, q = r % IB; transpose_item(a.in[I_WBA + w] + (size_t)l * 512 * 1024, 1024, 512, WB + ((size_t)l * 3 + w) * 1024 * 512, 32 * (q % 32), 64 * (q / 32), CmId(), scr, lane); continue; } r -= 3 * IB;
        transpose_item(a.in[I_WOUT] + (size_t)l * 1024 * 1024, 1024, 1024, WO + (size_t)l * 1024 * 1024, 32 * (r % 32), 64 * (r / 32), CmId(), scr, lane); }
}
typedef float f32x2v __attribute__((ext_vector_type(2)));
constexpr size_t PEER_ROWS = (size_t)DEPTH * N_EXPERTS;
__device__ __forceinline__ void pro_peerw(Frame& F) {
    const KArgs ap = kargs(); const auto& a = *ap; WS_OPAQUE(a);
    const int tid = otid(), lane = tid & 63, wave = __builtin_amdgcn_readfirstlane(tid >> 6);
    float* SCL = (float*)(wsb + a.off[R_MISC]);
    for (size_t rw = (size_t)F.vcu * NWAVES + wave; rw < 2 * PEER_ROWS; rw += (size_t)F.G * NWAVES) {
        const int w = rw >= PEER_ROWS; const size_t row = rw - (w ? PEER_ROWS : 0);
        const GAS f32x4* src = (const GAS f32x4*)(a.in[I_PU + w] + row * D_MODEL) + 4 * lane;
        const f32x4 x0 = src[0], x1 = src[1], x2 = src[2], x3 = src[3];
        float mx = fmaxf(fmaxf(fmaxf(fabsf(x0.x), fabsf(x0.y)), fmaxf(fabsf(x0.z), fabsf(x0.w))), fmaxf(fmaxf(fabsf(x1.x), fabsf(x1.y)), fmaxf(fabsf(x1.z), fabsf(x1.w))));
        mx = fmaxf(mx, fmaxf(fmaxf(fmaxf(fabsf(x2.x), fabsf(x2.y)), fmaxf(fabsf(x2.z), fabsf(x2.w))), fmaxf(fmaxf(fabsf(x3.x), fabsf(x3.y)), fmaxf(fabsf(x3.z), fabsf(x3.w)))));
        mx = wave_max(mx);
        const float inv = mx > 0.f ? 416.f / mx : 0.f;
        v4u o; int t;
        t = __builtin_amdgcn_cvt_pk_fp8_f32(x0.x * inv, x0.y * inv, 0, false); t = __builtin_amdgcn_cvt_pk_fp8_f32(x0.z * inv, x0.w * inv, t, true); o.x = (unsigned)t;
        t = __builtin_amdgcn_cvt_pk_fp8_f32(x1.x * inv, x1.y * inv, 0, false); t = __builtin_amdgcn_cvt_pk_fp8_f32(x1.z * inv, x1.w * inv, t, true); o.y = (unsigned)t;
        t = __builtin_amdgcn_cvt_pk_fp8_f32(x2.x * inv, x2.y * inv, 0, false); t = __builtin_amdgcn_cvt_pk_fp8_f32(x2.z * inv, x2.w * inv, t, true); o.z = (unsigned)t;
        t = __builtin_amdgcn_cvt_pk_fp8_f32(x3.x * inv, x3.y * inv, 0, false); t = __builtin_amdgcn_cvt_pk_fp8_f32(x3.z * inv, x3.w * inv, t, true); o.w = (unsigned)t;
        *((GAS v4u*)(wsb + a.off[R_PU + w] + row * D_MODEL) + lane) = o;
        if (lane == 0) SCL[rw] = mx * (1.f / 416.f);
    }
}
__device__ __forceinline__ void fp8x16_to_f32(const v4u q, float (&f)[16]) {
#pragma unroll
    for (int d = 0; d < 4; ++d) { const int w = (int)(d == 0 ? q.x : d == 1 ? q.y : d == 2 ? q.z : q.w);
        const f32x2v lo = __builtin_amdgcn_cvt_pk_f32_fp8(w, false), hi = __builtin_amdgcn_cvt_pk_f32_fp8(w, true); f[4 * d] = lo.x; f[4 * d + 1] = lo.y; f[4 * d + 2] = hi.x; f[4 * d + 3] = hi.y; }
}
__device__ __forceinline__ void p_peer(Frame& F, int l, bool dry) {
    const KArgs ap = kargs(); const auto& a = *ap; WS_OPAQUE(a);
    const int tid = otid(), lane = tid & 63, wave = __builtin_amdgcn_readfirstlane(tid >> 6);
    const float* SC = (const float*)(wsb + a.off[R_SC]); const bf16* XN = (const bf16*)(wsb + a.off[R_XN]); float* X = (float*)(wsb + a.off[R_X]);
    const unsigned char* PU = wsb + a.off[R_PU] + (size_t)l * N_EXPERTS * D_MODEL; const unsigned char* PV = wsb + a.off[R_PV] + (size_t)l * N_EXPERTS * D_MODEL;
    const float* SCU = (const float*)(wsb + a.off[R_MISC]) + (size_t)l * N_EXPERTS; const float* SCV = SCU + PEER_ROWS;
    LAS float* stop = (LAS float*)(F.lds + RING_OFF + wave * 4096);
    LAS int* itop = (LAS int*)(stop + 256);
    LAS int* elist = itop + 256;
    LAS float* cf = (LAS float*)(elist + 128);
    for (int m = F.vcu * NWAVES + wave; m < RP; m += F.G * NWAVES) {
        if (!prow_valid(m)) continue;
        const float* sr = SC + (size_t)m * PQ;
        for (int hc = 0; hc < 16; hc += 2) {
            const float va0 = sr[hc * 128 + lane], va1 = sr[hc * 128 + 64 + lane], vb0 = sr[hc * 128 + 128 + lane], vb1 = sr[hc * 128 + 192 + lane];
            const unsigned ka0 = fkey(va0), ka1 = fkey(va1), kb0 = fkey(vb0), kb1 = fkey(vb1);
            unsigned pa = 0u, pb = 0u;
#pragma unroll
            for (int bit = 31; bit >= 0; --bit) { const unsigned ta = pa | (1u << bit), tb = pb | (1u << bit);
                const int ca = __builtin_popcountll(__ballot(ka0 >= ta)) + __builtin_popcountll(__ballot(ka1 >= ta)), cb = __builtin_popcountll(__ballot(kb0 >= tb)) + __builtin_popcountll(__ballot(kb1 >= tb));
                pa = ca >= 16 ? ta : pa; pb = cb >= 16 ? tb : pb; }
            { const unsigned long long m0 = __ballot(ka0 >= pa), m1 = __ballot(ka1 >= pa); const int r0 = mbcnt64(m0), r1 = __builtin_popcountll(m0) + mbcnt64(m1);
              if (ka0 >= pa && r0 < 16) { stop[hc * 16 + r0] = va0; itop[hc * 16 + r0] = lane; }
              if (ka1 >= pa && r1 < 16) { stop[hc * 16 + r1] = va1; itop[hc * 16 + r1] = lane + 64; } }
            { const unsigned long long m0 = __ballot(kb0 >= pb), m1 = __ballot(kb1 >= pb); const int r0 = mbcnt64(m0), r1 = __builtin_popcountll(m0) + mbcnt64(m1);
              if (kb0 >= pb && r0 < 16) { stop[(hc + 1) * 16 + r0] = vb0; itop[(hc + 1) * 16 + r0] = lane; }
              if (kb1 >= pb && r1 < 16) { stop[(hc + 1) * 16 + r1] = vb1; itop[(hc + 1) * 16 + r1] = lane + 64; } }
        }
        LDS_WAIT();
        for (int h = 0; h < 8; ++h) {
            const float s1 = stop[(2 * h) * 16 + (lane >> 2)];
            float c[4]; unsigned kc[4];
#pragma unroll
            for (int j = 0; j < 4; ++j) { c[j] = s1 + stop[(2 * h + 1) * 16 + (lane & 3) * 4 + j]; kc[j] = fkey(c[j]); }
            unsigned pp = 0u;
#pragma unroll
            for (int bit = 31; bit >= 0; --bit) { const unsigned tt = pp | (1u << bit);
                const int cn = __builtin_popcountll(__ballot(kc[0] >= tt)) + __builtin_popcountll(__ballot(kc[1] >= tt)) + __builtin_popcountll(__ballot(kc[2] >= tt)) + __builtin_popcountll(__ballot(kc[3] >= tt));
                pp = cn >= 16 ? tt : pp; }
            const float cmax = wave_max_dpp(fmaxf(fmaxf(c[0], c[1]), fmaxf(c[2], c[3])));
            float esum = 0.f; int base = 0;
#pragma unroll
            for (int j = 0; j < 4; ++j) { const bool sel = kc[j] >= pp; const unsigned long long mk = __ballot(sel); const int rk = base + mbcnt64(mk); base += __builtin_popcountll(mk);
                const float ex = (sel && rk < 16) ? __expf(c[j] - cmax) : 0.f; esum += ex;
                if (sel && rk < 16) { const int ci = lane * 4 + j; elist[h * 16 + rk] = itop[(2 * h) * 16 + (ci >> 4)] * N_KEYS + itop[(2 * h + 1) * 16 + (ci & 15)]; cf[h * 16 + rk] = ex; } }
            esum = wave_sum_dpp(esum); const float inv = 1.f / esum;
            LDS_WAIT();
            if (lane < 16) cf[h * 16 + lane] *= inv;
        }
        LDS_WAIT();
        float hx[16], out[16];
        { float t[8]; unpack8(*(const GAS v4u*)(XN + (size_t)m * D_MODEL + 16 * lane), t);
#pragma unroll
          for (int j = 0; j < 8; ++j) hx[j] = t[j];
          unpack8(*(const GAS v4u*)(XN + (size_t)m * D_MODEL + 16 * lane + 8), t);
#pragma unroll
          for (int j = 0; j < 8; ++j) hx[8 + j] = t[j]; }
#pragma unroll
        for (int j = 0; j < 16; ++j) out[j] = 0.f;
        v4u uA[4], vA[4], uB[4], vB[4]; float suA[4], svA[4], cA[4], suB[4], svB[4], cB[4];
#define PEER_LOAD(U, V, SU, SV, CW, q0) do { _Pragma("unroll") for (int i = 0; i < 4; ++i) { const int e_ = elist[(q0) + i]; CW[i] = cf[(q0) + i]; \
            U[i] = *((const GAS v4u*)(PU + (size_t)e_ * D_MODEL) + lane); V[i] = *((const GAS v4u*)(PV + (size_t)e_ * D_MODEL) + lane); SU[i] = SCU[e_]; SV[i] = SCV[e_]; } } while (0)
#define PEER_COMP(U, V, SU, SV, CW) do { float d_[4]; _Pragma("unroll") for (int i = 0; i < 4; ++i) { float t[16]; d_[i] = 0.f; fp8x16_to_f32(U[i], t); \
            _Pragma("unroll") for (int j = 0; j < 16; ++j) d_[i] += hx[j] * t[j]; } \
            _Pragma("unroll") for (int i = 0; i < 4; ++i) d_[i] += dpp_f<0xB1>(d_[i]); _Pragma("unroll") for (int i = 0; i < 4; ++i) d_[i] += dpp_f<0x4E>(d_[i]); \
            _Pragma("unroll") for (int i = 0; i < 4; ++i) d_[i] += dpp_f<0x141>(d_[i]); _Pragma("unroll") for (int i = 0; i < 4; ++i) d_[i] += dpp_f<0x140>(d_[i]); \
            _Pragma("unroll") for (int i = 0; i < 4; ++i) { const float dd = (rdlane(d_[i], 0) + rdlane(d_[i], 16) + rdlane(d_[i], 32) + rdlane(d_[i], 48)) * SU[i]; const float cc = CW[i] * gelu_tanh(dd) * SV[i]; \
              float t[16]; fp8x16_to_f32(V[i], t); _Pragma("unroll") for (int j = 0; j < 16; ++j) out[j] += cc * t[j]; } } while (0)
        PEER_LOAD(uA, vA, suA, svA, cA, 0);
        for (int q = 0; q < 128; q += 8) {
            PEER_LOAD(uB, vB, suB, svB, cB, q + 4);
            PEER_COMP(uA, vA, suA, svA, cA);
            if (q + 8 < 128) PEER_LOAD(uA, vA, suA, svA, cA, q + 8);
            PEER_COMP(uB, vB, suB, svB, cB);
        }
#undef PEER_LOAD
#undef PEER_COMP
        if (!dry) { GAS f32x4* xr = (GAS f32x4*)(X + (size_t)m * D_MODEL + 16 * lane);
#pragma unroll
          for (int j = 0; j < 4; ++j) xr[j] = xr[j] + (f32x4){out[4 * j], out[4 * j + 1], out[4 * j + 2], out[4 * j + 3]}; }
    }
}
__device__ __forceinline__ void p_final(Frame& F) {
    const KArgs ap = kargs(); const auto& a = *ap; WS_OPAQUE(a);
    const int tid = otid(), lane = tid & 63, wave = __builtin_amdgcn_readfirstlane(tid >> 6);
    const float* X = (const float*)(wsb + a.off[R_X]); const float* g = a.in[I_FN];
    for (int m = F.vcu * NWAVES + wave; m < RP; m += F.G * NWAVES) {
        float* dst;
        if (m >= SROW0) dst = a.out + O_YS + (size_t)(m - SROW0) * D_MODEL;
        else { const int b = m / LPP, p = m % LPP; if (p < PADF + N_META || p >= PEND) continue; dst = a.out + O_YP + ((size_t)b * SEQ + (p - PADF - N_META)) * D_MODEL; }
        const GAS f32x4* xr = (const GAS f32x4*)(X + (size_t)m * D_MODEL) + lane;
        f32x4 v[4]; float s2 = 0.f;
#pragma unroll
        for (int j = 0; j < 4; ++j) { v[j] = xr[64 * j]; s2 += (v[j].x * v[j].x + v[j].y * v[j].y) + (v[j].z * v[j].z + v[j].w * v[j].w); }
        const float r = 1.f / sqrtf(wave_sum(s2) * (1.f / D_MODEL) + EPSF);
        const GAS f32x4* gr = (const GAS f32x4*)g + lane; GAS f32x4* o = (GAS f32x4*)dst + lane;
#pragma unroll
        for (int j = 0; j < 4; ++j) { const f32x4 gg = gr[64 * j]; o[64 * j] = (f32x4){v[j].x * r * gg.x, v[j].y * r * gg.y, v[j].z * r * gg.z, v[j].w * r * gg.w}; }
    }
}

__device__ __forceinline__ void p_prologue(Frame& F) {
    const KArgs ap = kargs(); const auto& a = *ap; WS_OPAQUE(a);
    const int tid = otid(), lane = tid & 63, wave = __builtin_amdgcn_readfirstlane(tid >> 6);
    LAS float* scr = (LAS float*)(F.lds + RING_OFF + wave * 16384);
    const int gw = F.vcu * NWAVES + wave, NGW = F.G * NWAVES;
    if (a.pro_mask & PM_X) {
        float* X = (float*)(wsb + a.off[R_X]);
        for (int m = gw; m < RP; m += NGW) {
            const float* src = nullptr;
            if (m >= SROW0) src = a.in[I_XS] + (size_t)(m - SROW0) * D_MODEL;
            else { const int b = m / LPP, p = m % LPP; if (p >= PADF && p < PEND) { const int pos = p - PADF; src = pos < N_META ? a.in[I_META] + (size_t)pos * D_MODEL : a.in[I_XP] + ((size_t)b * SEQ + pos - N_META) * D_MODEL; } }
            GAS f32x4* o = (GAS f32x4*)(X + (size_t)m * D_MODEL) + lane;
#pragma unroll
            for (int j = 0; j < 4; ++j) o[64 * j] = src ? ((const GAS f32x4*)src)[lane + 64 * j] : (f32x4){0.f, 0.f, 0.f, 0.f};
        }
    }
    if (a.pro_mask & PM_WIN) {
        bf16* WT = (bf16*)(wsb + a.off[R_WIN]);
        constexpr int IPL = (D_MODEL / 64) * (ZN / 32);
        for (int it = gw; it < DEPTH * IPL; it += NGW) { const int l = it / IPL, r = it % IPL, kb = r / (ZN / 32), nb = r % (ZN / 32);
            transpose_item(a.in[I_WIN] + (size_t)l * D_MODEL * D_IN, D_IN, D_MODEL, WT + (size_t)l * ZN * D_MODEL, 32 * nb, 64 * kb, CmWin(), scr, lane); }
    }
    __syncthreads();
    if (a.pro_mask & PM_TABLES) s5_tables(F);
    __syncthreads();
    if (a.pro_mask & PM_WREST) pro_wrest(F);
    if (a.pro_mask & PM_WQS) pro_wqs(F);
    if (a.pro_mask & PM_PEERW) pro_peerw(F);
}

__global__ void __launch_bounds__(NTHR, 2) mk_fwd(Args args) {
    extern __shared__ __attribute__((aligned(16))) unsigned char lds[];
    Frame F;
    F.lds = (LAS unsigned char*)lds; F.MISC = (volatile LAS unsigned*)(F.lds + MISC_OFF);
    F.G = gridDim.x; { const int bx = blockIdx.x; F.vcu = (F.G % 8 == 0) ? (bx % 8) * (F.G / 8) + bx / 8 : bx; }
    F.ctl = (gu32*)args.ws;
    for (int u = threadIdx.x; u < (LDS_BYTES - LDSCTL_OFF) / 4; u += NTHR) ((LAS unsigned*)(F.lds + LDSCTL_OFF))[u] = 0u;
    __syncthreads();
    const int lo = args.ph_lo, hi = args.ph_hi;
    unsigned* barw = (unsigned*)(F.ctl + CW_BAR) + (size_t)args.bar_region * XCD_BAR_WORDS;
    XcdBarrier bar; bar.bar = barw; bar.x = 0; bar.st = nullptr;
    if (hi - lo > 1) bar = xcd_barrier_post(barw, F.MISC + 8);
#define IN(k) (lo <= (k) && (k) < hi)
#define SEAM(k) do { if ((k) + 1 < hi) xcd_barrier(bar); } while (0)
#ifndef MK_REP
#define MK_REP -1
#endif
    if (IN(PH_PRO)) { for (int rep_ = 0; rep_ < ((MK_REP) == 200 ? 2 : 1); ++rep_) { p_prologue(F); __syncthreads(); } SEAM(PH_PRO); }
#ifndef MK_REP
#define MK_REP -1
#endif
#define REPEAT(ph) for (int rep_ = 0; rep_ < ((MK_REP) == (ph) ? 2 : 1); ++rep_)
    for (int l = 0; l < DEPTH; ++l) {
        const int pb = 1 + l * NPL;
        if (IN(pb + PL_NORM1)) { REPEAT(PL_NORM1) p_norm(F, l, I_N1); SEAM(pb + PL_NORM1); }
        if (IN(pb + PL_GEMM_IN)) {
            const KArgs ap = kargs(); const auto& a = *ap; WS_OPAQUE(a);
            pg8::Gemm g{(const pg8::bf16_t*)(wsb + a.off[R_XN]), (const pg8::bf16_t*)(wsb + a.off[R_WIN]) + (size_t)l * ZN * D_MODEL, RP, ZN, D_MODEL};
            pg8::StaticOrder S; S.init(RP, ZN, F.G, (int)blockIdx.x);
            pg8::EpiBf16<0> E{(pg8::bf16_t*)(wsb + a.off[R_Z]), ZN, nullptr, 0, 0, 1.f};
            REPEAT(PL_GEMM_IN) pg8::gemm_phase<pg8::EpiBf16<0>, pg8::StaticOrder, true, true>(F.lds + RING_OFF, g, S, E);
            SEAM(pb + PL_GEMM_IN);
        }
        if (IN(pb + PL_ZPOST)) { REPEAT(PL_ZPOST) p_zpost(F, l); SEAM(pb + PL_ZPOST); }
        if (IN(pb + PL_LOCAL)) { REPEAT(PL_LOCAL) { p_gdn_chunk(F, l); p_s5_e(F, l); } SEAM(pb + PL_LOCAL); }
        if (IN(pb + PL_MIX)) {
            REPEAT(100) p_gdn_chain(F, l);
            REPEAT(102) { const int tid = otid(), lane = tid & 63, wave = __builtin_amdgcn_readfirstlane(tid >> 6), NGW = F.G * NWAVES;
              for (int t = (F.vcu * NWAVES + wave + NGW - 256) % NGW; t < S5_NTASK; t += NGW) s5_scan_run(F, l, t, lane); }
            REPEAT(101) p_attention(F, l + DEPTH * rep_, lds);
            SEAM(pb + PL_MIX); }
        if (IN(pb + PL_MIXPOST)) { REPEAT(PL_MIXPOST) { p_mixpost_a(F, l); p_mixpost_b(F, l); p_s5_out(F, l); } SEAM(pb + PL_MIXPOST); }
        if (IN(pb + PL_GEMM_GLU)) REPEAT(PL_GEMM_GLU) {
            const KArgs ap = kargs(); const auto& a = *ap; WS_OPAQUE(a);
            { pg8::Gemm g{(const pg8::bf16_t*)(wsb + a.off[R_YC]), (const pg8::bf16_t*)(wsb + a.off[R_WGLU]) + (size_t)l * 1024 * 512, RP, 1024, 512};
              pg8::StaticOrder S; S.init(RP, 1024, F.G, (int)blockIdx.x); pg8::EpiGlu E{(pg8::bf16_t*)(wsb + a.off[R_OC]), WIDTH_C};
              pg8::gemm_phase<pg8::EpiGlu, pg8::StaticOrder, true, true>(F.lds + RING_OFF, g, S, E); }
            { pg8::Gemm g{(const pg8::bf16_t*)(wsb + a.off[R_OA]), (const pg8::bf16_t*)(wsb + a.off[R_WBR]) + ((size_t)l * 3 + 0) * 1024 * 512, RP, 1024, 512};
              pg8::StaticOrder S; S.init(RP, 1024, F.G, (int)blockIdx.x); pg8::EpiMerge<0> E{(float*)(wsb + a.off[R_MRG]), nullptr, (const pg8::bf16_t*)(wsb + a.off[R_Z]) + ZC_GATE, ZN};
              pg8::gemm_phase<pg8::EpiMerge<0>, pg8::StaticOrder, true, true>(F.lds + RING_OFF, g, S, E); }
            { pg8::Gemm g{(const pg8::bf16_t*)(wsb + a.off[R_OB]), (const pg8::bf16_t*)(wsb + a.off[R_WBR]) + ((size_t)l * 3 + 1) * 1024 * 512, RP, 1024, 512};
              pg8::StaticOrder S; S.init(RP, 1024, F.G, (int)blockIdx.x); pg8::EpiMerge<1> E{(float*)(wsb + a.off[R_MRG]), nullptr, (const pg8::bf16_t*)(wsb + a.off[R_Z]) + ZC_GATE + 1024, ZN};
              pg8::gemm_phase<pg8::EpiMerge<1>, pg8::StaticOrder, true, true>(F.lds + RING_OFF, g, S, E); }
            if (rep_ == ((MK_REP) == PL_GEMM_GLU ? 1 : 0)) SEAM(pb + PL_GEMM_GLU); }
        if (IN(pb + PL_GEMM_BRC)) {
            const KArgs ap = kargs(); const auto& a = *ap; WS_OPAQUE(a);
            pg8::Gemm g{(const pg8::bf16_t*)(wsb + a.off[R_OC]), (const pg8::bf16_t*)(wsb + a.off[R_WBR]) + ((size_t)l * 3 + 2) * 1024 * 512, RP, 1024, 512};
            pg8::StaticOrder S; S.init(RP, 1024, F.G, (int)blockIdx.x); pg8::EpiMerge<2> E{(float*)(wsb + a.off[R_MRG]), (pg8::bf16_t*)(wsb + a.off[R_MRGB]), (const pg8::bf16_t*)(wsb + a.off[R_Z]) + ZC_GATE + 2048, ZN};
            REPEAT(PL_GEMM_BRC) pg8::gemm_phase<pg8::EpiMerge<2>, pg8::StaticOrder, true, true>(F.lds + RING_OFF, g, S, E);
            SEAM(pb + PL_GEMM_BRC); }
        if (IN(pb + PL_GEMM_OUT)) {
            const KArgs ap = kargs(); const auto& a = *ap; WS_OPAQUE(a);
            pg8::Gemm g{(const pg8::bf16_t*)(wsb + a.off[R_MRGB]), (const pg8::bf16_t*)(wsb + a.off[R_WOUT]) + (size_t)l * 1024 * 1024, RP, 1024, 1024};
            pg8::StaticOrder S; S.init(RP, 1024, F.G, (int)blockIdx.x); pg8::EpiResid E{(float*)(wsb + a.off[R_X]), D_MODEL};
            pg8::gemm_phase<pg8::EpiResid, pg8::StaticOrder, true, true>(F.lds + RING_OFF, g, S, E);
            SEAM(pb + PL_GEMM_OUT); }
        if (IN(pb + PL_NORM2)) { REPEAT(PL_NORM2) p_norm(F, l, I_N2); SEAM(pb + PL_NORM2); }
        if (IN(pb + PL_GEMM_PEER)) {
            const KArgs ap = kargs(); const auto& a = *ap; WS_OPAQUE(a);
            pg8::Gemm g{(const pg8::bf16_t*)(wsb + a.off[R_XN]), (const pg8::bf16_t*)(wsb + a.off[R_WQS]) + (size_t)l * PQ * D_MODEL, RP, PQ, D_MODEL};
            pg8::StaticOrder S; S.init(RP, PQ, F.G, (int)blockIdx.x); pg8::EpiF32 E{(float*)(wsb + a.off[R_SC]), PQ};
            REPEAT(PL_GEMM_PEER) pg8::gemm_phase<pg8::EpiF32, pg8::StaticOrder, true, true>(F.lds + RING_OFF, g, S, E);
            SEAM(pb + PL_GEMM_PEER); }
        if (IN(pb + PL_PEER)) { REPEAT(PL_PEER) p_peer(F, l, (MK_REP) == PL_PEER && rep_ == 0); SEAM(pb + PL_PEER); }
    }
    if (IN(PH_FINAL)) p_final(F);
#undef IN
#undef SEAM
}
}
#ifndef MK_ONE_LAUNCH
#define MK_ONE_LAUNCH 1
#endif
static int mk_grid = 0;
static bool mk_setup() {
    if (mk_grid) return mk_grid > 0;
    int dev = 0, cus = 0;
    if (hipGetDevice(&dev) != hipSuccess || hipDeviceGetAttribute(&cus, hipDeviceAttributeMultiprocessorCount, dev) != hipSuccess) { mk_grid = -1; return false; }
    if (hipFuncSetAttribute((const void*)mk::mk_fwd, hipFuncAttributeMaxDynamicSharedMemorySize, mk::LDS_BYTES) != hipSuccess) { fprintf(stderr, "kernel_launch: hipFuncSetAttribute failed\n"); mk_grid = -1; return false; }
    int per_cu = 0;
    if (hipOccupancyMaxActiveBlocksPerMultiprocessor(&per_cu, (const void*)mk::mk_fwd, mk::NTHR, mk::LDS_BYTES) != hipSuccess || per_cu < 1) { fprintf(stderr, "kernel_launch: occupancy query says %d workgroups per CU\n", per_cu); }
    (void)hipGetLastError();
    mk_grid = cus;
    return true;
}
static void mk_launch(mk::Args a, int lo, int hi, int region, hipStream_t stream) {
    a.ph_lo = lo; a.ph_hi = hi; a.bar_region = region;
    hipLaunchKernelGGL(mk::mk_fwd, dim3(mk_grid), dim3(mk::NTHR), mk::LDS_BYTES, stream, a);
    hipError_t e = hipPeekAtLastError(); if (e != hipSuccess) fprintf(stderr, "kernel_launch: launch failed: %s\n", hipGetErrorName(e));
}
extern "C" void kernel_launch(void* const* d_in, const int* in_sizes, int n_in, void* d_out, int out_size, void* d_ws, size_t ws_size, hipStream_t stream) {
    if (n_in != N_INPUTS || (size_t)out_size != (size_t)O_END) { fprintf(stderr, "kernel_launch: unexpected n_in %d / out_size %d\n", n_in, out_size); return; }
    if (!mk_setup()) return;
    const size_t MiB = 1u << 20;
    unsigned char* ws = (unsigned char*)d_ws;
    mk::Args a{};
    for (int i = 0; i < N_INPUTS; ++i) a.in[i] = (const float*)d_in[i];
    a.out = (float*)d_out; a.ws = ws;
    { using namespace mk; const struct { int r; size_t mib; } map[] = { {R_WIN, 1}, {R_WGLU, 59}, {R_WBR, 63}, {R_WOUT, 75}, {R_WQS, 83}, {R_S5T, 99}, {R_PU, 132}, {R_PV, 196}, {R_MISC, 260}, {R_X, 388}, {R_XN, 456},
        {R_Z, 490}, {R_SC, 490}, {R_QN, 737}, {R_KN, 754}, {R_QKVB, 771}, {R_BG, 822}, {R_O, 823}, {R_MRGB, 823}, {R_OA, 857}, {R_OB, 874}, {R_GDN, 891}, {R_MRG, 891},
        {R_S5E, 986}, {R_YC, 986}, {R_S5X, 1003}, {R_OC, 1012} };
      for (auto& e : map) a.off[e.r] = e.mib * MiB; }
    if (1029 * MiB > ws_size) { fprintf(stderr, "kernel_launch: workspace too small (%zu)\n", ws_size); return; }
    if (hipMemsetAsync(ws, 0, mk::CTL_BYTES, stream) != hipSuccess) { fprintf(stderr, "kernel_launch: memset failed\n"); return; }
    a.pro_mask = mk::PM_X | mk::PM_WIN | mk::PM_TABLES | mk::PM_WREST | mk::PM_WQS | mk::PM_PEERW;
#if MK_ONE_LAUNCH
    mk_launch(a, 0, mk::PH_END, 0, stream);
#else
    int region = 0;
    mk_launch(a, mk::PH_PRO, mk::PH_PRO + 1, region++, stream);
    for (int l = 0; l < DEPTH; ++l) { const int pb = 1 + l * mk::NPL;
        for (int ph = mk::PL_NORM1; ph <= mk::PL_PEER; ++ph) { if (ph == mk::PL_GEMM_BRA || ph == mk::PL_GEMM_BRB) continue; mk_launch(a, pb + ph, pb + ph + 1, region++, stream); } }
    mk_launch(a, mk::PH_FINAL, mk::PH_END, region++, stream);
#endif
}
```

```cpp
#include <hip/hip_runtime.h>
#include <cstdio>
#include <cstdint>
#define MK_ONE_LAUNCH 1
#ifndef D_MODEL
#define D_MODEL 1024
#define BATCH 2
#define SEQ 8192
#define DEPTH 4
#define DEC_BATCH 16
#define DEC_SEQ 32
#define PAST_LEN 1024
#define N_HEADS_A 4
#define HEAD_DIM_A 64
#define N_HEADS_B 4
#define HEAD_DIM_B 128
#define S5_GROUPS 32
#define S5_STATE 64
#define PEER_HEADS 8
#define PEER_QDIM 256
#define N_KEYS 128
#endif
#define CHUNK 64
#define N_META 16
#define EPSF 1e-6f
#define NUM_BUCKETS 32
#define CONV_W 4
#define S5_GROUP 16
#define PEER_TOPK 16
#define N_EXPERTS (N_KEYS * N_KEYS)
#define WIDTH_A (N_HEADS_A * 2 * HEAD_DIM_A)
#define WIDTH_B (N_HEADS_B * HEAD_DIM_B)
#define WIDTH_C (S5_GROUPS * S5_GROUP)
#define OFF_QA 0
#define OFF_KA (OFF_QA + WIDTH_A)
#define OFF_VA (OFF_KA + WIDTH_A)
#define OFF_QKVB (OFF_VA + WIDTH_A)
#define OFF_GB (OFF_QKVB + 3 * WIDTH_B)
#define OFF_BETA (OFF_GB + WIDTH_B)
#define OFF_ALPHA (OFF_BETA + N_HEADS_B)
#define OFF_UC (OFF_ALPHA + N_HEADS_B)
#define OFF_GATE (OFF_UC + WIDTH_C)
#define D_IN (OFF_GATE + 3 * D_MODEL)
#define LP (N_META + SEQ)
#define NP (BATCH * LP)
#define NS (DEC_BATCH * DEC_SEQ)
#define NT (NP + NS)
#define PQ (PEER_HEADS * PEER_QDIM)

enum { I_XP, I_XS, I_CK, I_CV, I_SCONV, I_SDELTA, I_SRE, I_SIM, I_META, I_REL, I_N1, I_N2, I_FN, I_WIN, I_QN, I_KN, I_LQK, I_SUBLN, I_CONVW, I_ALOG, I_DTB, I_GDNN,
       I_AR, I_AI, I_BR, I_BI, I_CR, I_CI, I_SD, I_LDT, I_WGLU, I_WBA, I_WBB, I_WBC, I_WOUT, I_PWQ, I_PSK, I_PU, I_PV, N_INPUTS };
#define O_YP 0
#define O_YS (O_YP + (size_t)BATCH * SEQ * D_MODEL)
#define O_KP (O_YS + (size_t)NS * D_MODEL)
#define O_VP (O_KP + (size_t)DEPTH * NP * WIDTH_A)
#define O_KS (O_VP + (size_t)DEPTH * NP * WIDTH_A)
#define O_VS (O_KS + (size_t)DEPTH * NS * WIDTH_A)
#define O_CP (O_VS + (size_t)DEPTH * NS * WIDTH_A)
#define O_CS (O_CP + (size_t)DEPTH * BATCH * (CONV_W - 1) * 3 * WIDTH_B)
#define O_DP (O_CS + (size_t)DEPTH * DEC_BATCH * (CONV_W - 1) * 3 * WIDTH_B)
#define O_DS (O_DP + (size_t)DEPTH * BATCH * N_HEADS_B * HEAD_DIM_B * HEAD_DIM_B)
#define O_SRP (O_DS + (size_t)DEPTH * DEC_BATCH * N_HEADS_B * HEAD_DIM_B * HEAD_DIM_B)
#define O_SIP (O_SRP + (size_t)DEPTH * BATCH * S5_GROUPS * S5_STATE)
#define O_SRS (O_SIP + (size_t)DEPTH * BATCH * S5_GROUPS * S5_STATE)
#define O_SIS (O_SRS + (size_t)DEPTH * DEC_BATCH * S5_GROUPS * S5_STATE)
#define O_END (O_SIS + (size_t)DEPTH * DEC_BATCH * S5_GROUPS * S5_STATE)

namespace pg8 {
#define PG8_LAS __attribute__((address_space(3)))
typedef unsigned short bf16_t;
typedef short bf16x8 __attribute__((ext_vector_type(8)));
typedef float f32x4 __attribute__((ext_vector_type(4)));
typedef unsigned u32x4 __attribute__((ext_vector_type(4)));
constexpr int BM = 256, BK = 64, HALF = 128, HTB = HALF * BK * 2  , STAGE_BYTES = 8 * HTB, NXCD = 8, WGM = 8;

__host__ __device__ __forceinline__ int lds_byte(int r, int c) { const int st = (r >> 4) * 2 + (c >> 5), rr = r & 15, cc = c & 31, ob = rr * 64 + cc * 2; return st * 1024 + (ob ^ (((ob >> 9) & 1) << 5)); }
__host__ __device__ __forceinline__ void stage_rc(int b, int& R, int& C) { const int st = b / 1024, sb = b % 1024, swz = sb ^ (((sb >> 9) & 1) << 5); R = (st >> 1) * 16 + swz / 64; C = (st & 1) * 32 + (swz % 64) / 2; }
__host__ __device__ __forceinline__ int perm32(int rho) { const int n = rho >> 4, i = rho & 15; return 8 * (i >> 2) + 4 * n + (i & 3); }

struct Unit { int pm, pn; };
struct Gemm { const bf16_t* A; const bf16_t* Bt; int M, N, K; };

struct StaticOrder {
    int nM, nN, nwg, G, c;
    __host__ __device__ void init(int M, int N, int G_, int c_) { nM = M / BM; nN = N / BM; nwg = nM * nN; G = G_; c = c_; }
    __host__ __device__ bool next(int i, Unit& u) const {
        const long L = (long)i * G + c; if (L >= nwg) return false;
        int wgid = (int)L; { const int q = nwg / NXCD, r = nwg % NXCD, xcd = wgid % NXCD, off = wgid / NXCD; wgid = (xcd < r ? xcd * (q + 1) : r * (q + 1) + (xcd - r) * q) + off; }
        const int nig = WGM * nN, gid = wgid / nig, fm = gid * WGM, gsz = (nM - fm) < WGM ? (nM - fm) : WGM;
        u.pm = fm + ((wgid % nig) % gsz); u.pn = (wgid % nig) / gsz; return true;
    }
    __device__ __forceinline__ void a_ready(const Unit&) const {}
    __device__ __forceinline__ void done(const Unit&) const {}
};

__device__ __forceinline__ unsigned cvt_pk_bf16(float lo, float hi) { unsigned r; asm volatile("v_cvt_pk_bf16_f32 %0, %1, %2" : "=v"(r) : "v"(lo), "v"(hi)); return r; }
typedef float f32x2 __attribute__((ext_vector_type(2)));
__device__ __forceinline__ f32x2 gelu_pk(f32x2 v) {
    const f32x2 av = __builtin_elementwise_abs(v), d = av * 0.2316418882f + 1.0f;
    f32x2 t; t.x = __builtin_amdgcn_rcpf(d.x); t.y = __builtin_amdgcn_rcpf(d.y);
    f32x2 q = t * 0.5307027145f + (-0.7265760135f); q = q * t + 0.7107068705f; q = q * t + (-0.142248368f); q = q * t + 0.127414796f; q = q * t;
    const f32x2 s = (v * v) * (-0.72134752044f);
    f32x2 e; e.x = __builtin_amdgcn_exp2f(s.x); e.y = __builtin_amdgcn_exp2f(s.y);
    const f32x2 m = v * (q * e), r = v - m;
    f32x2 o; o.x = v.x < 0.f ? m.x : r.x; o.y = v.y < 0.f ? m.y : r.y; return o;
}

template <int ACT  > struct EpiBf16 {
    static constexpr bool PERM = true, AFTER_DRAIN = false; static_assert(ACT == 0 || ACT == 1, "EpiBf16: ACT is 0 (none) or 1 (gelu_pk)");
    bf16_t* O; int ldc; const float* bias; int split_cols; size_t split_stride; float scale0;
    __device__ __forceinline__ void operator()(const f32x4 (&acc)[2][2][4][2], const Unit& u, int wr, int wc, int fr, int fq) const {
        const int row0 = u.pm * BM + wr * 64 + fr; int colt = u.pn * BM; bf16_t* base = O;
        float sc = 1.f; if (split_cols) { const int t = colt / split_cols; base += (size_t)t * split_stride; colt -= t * split_cols; if (t == 0) sc = scale0; }
        const int col0 = colt + wc * 32 + 8 * fq, bcol0 = u.pn * BM + wc * 32 + 8 * fq;
        f32x4 bv[2][2];
#pragma unroll
        for (int bj = 0; bj < 2; ++bj)
#pragma unroll
            for (int n = 0; n < 2; ++n) bv[bj][n] = bias ? *(const f32x4*)(bias + bcol0 + bj * HALF + 4 * n) : (f32x4){0.f, 0.f, 0.f, 0.f};
#pragma unroll
        for (int ai = 0; ai < 2; ++ai)
#pragma unroll
            for (int m = 0; m < 4; ++m) { bf16_t* rowp = base + (size_t)(row0 + ai * HALF + m * 16) * ldc + col0;
#pragma unroll
                for (int bj = 0; bj < 2; ++bj) { f32x4 v0 = acc[ai][bj][m][0] + bv[bj][0], v1 = acc[ai][bj][m][1] + bv[bj][1];
                    if (ACT == 1) { f32x2 a = gelu_pk((f32x2){v0[0], v0[1]}), b = gelu_pk((f32x2){v0[2], v0[3]}), c = gelu_pk((f32x2){v1[0], v1[1]}), d = gelu_pk((f32x2){v1[2], v1[3]});
                        v0 = (f32x4){a.x, a.y, b.x, b.y}; v1 = (f32x4){c.x, c.y, d.x, d.y}; }
                    v0 = v0 * sc; v1 = v1 * sc; u32x4 w; w.x = cvt_pk_bf16(v0[0], v0[1]); w.y = cvt_pk_bf16(v0[2], v0[3]); w.z = cvt_pk_bf16(v1[0], v1[1]); w.w = cvt_pk_bf16(v1[2], v1[3]);
                    *(u32x4*)(rowp + bj * HALF) = w; } }
    }
};

__device__ __forceinline__ float epi_sigm(float x) { return __builtin_amdgcn_rcpf(1.f + __expf(-x)); }
struct EpiGlu {
    static constexpr bool PERM = false, AFTER_DRAIN = false;
    bf16_t* O; int ldo;
    __device__ __forceinline__ void operator()(const f32x4 (&acc)[2][2][4][2], const Unit& u, int wr, int wc, int fr, int fq) const {
        const int row0 = u.pm * BM + wr * 64 + fr;
#pragma unroll
        for (int ai = 0; ai < 2; ++ai)
#pragma unroll
            for (int m = 0; m < 4; ++m) { bf16_t* rowp = O + (size_t)(row0 + ai * HALF + m * 16) * ldo + 4 * fq;
#pragma unroll
                for (int bj = 0; bj < 2; ++bj) { const int G = u.pn * 8 + bj * 4 + wc; const f32x4 av = acc[ai][bj][m][0], gv = acc[ai][bj][m][1];
                    typedef unsigned u32x2 __attribute__((ext_vector_type(2))); u32x2 w;
                    w.x = cvt_pk_bf16(av[0] * epi_sigm(gv[0]), av[1] * epi_sigm(gv[1])); w.y = cvt_pk_bf16(av[2] * epi_sigm(gv[2]), av[3] * epi_sigm(gv[3]));
                    *(u32x2*)(rowp + 16 * G) = w; } }
    }
};
template <int MODE> struct EpiMerge {
    static constexpr bool PERM = true, AFTER_DRAIN = false;
    float* M; bf16_t* Mb; const bf16_t* Zg; int ldz;
    __device__ __forceinline__ void operator()(const f32x4 (&acc)[2][2][4][2], const Unit& u, int wr, int wc, int fr, int fq) const {
        const int row0 = u.pm * BM + wr * 64 + fr, col0 = u.pn * BM + wc * 32 + 8 * fq;
#pragma unroll
        for (int ai = 0; ai < 2; ++ai)
#pragma unroll
            for (int m = 0; m < 4; ++m) { const size_t row = (size_t)(row0 + ai * HALF + m * 16);
#pragma unroll
                for (int bj = 0; bj < 2; ++bj) { const int col = col0 + bj * HALF;
                    const u32x4 gz = *(const u32x4*)(Zg + row * ldz + col);
                    float g[8]; g[0] = __builtin_bit_cast(float, gz.x << 16); g[1] = __builtin_bit_cast(float, gz.x & 0xffff0000u); g[2] = __builtin_bit_cast(float, gz.y << 16); g[3] = __builtin_bit_cast(float, gz.y & 0xffff0000u);
                    g[4] = __builtin_bit_cast(float, gz.z << 16); g[5] = __builtin_bit_cast(float, gz.z & 0xffff0000u); g[6] = __builtin_bit_cast(float, gz.w << 16); g[7] = __builtin_bit_cast(float, gz.w & 0xffff0000u);
                    f32x4 v0 = acc[ai][bj][m][0], v1 = acc[ai][bj][m][1];
#pragma unroll
                    for (int j = 0; j < 4; ++j) { v0[j] *= epi_sigm(g[j]); v1[j] *= epi_sigm(g[4 + j]); }
                    float* mp = M + row * 1024 + col;
                    if (MODE != 0) { v0 += *(const f32x4*)mp; v1 += *(const f32x4*)(mp + 4); }
                    if (MODE != 2) { *(f32x4*)mp = v0; *(f32x4*)(mp + 4) = v1; }
                    else { u32x4 w; w.x = cvt_pk_bf16(v0[0], v0[1]); w.y = cvt_pk_bf16(v0[2], v0[3]); w.z = cvt_pk_bf16(v1[0], v1[1]); w.w = cvt_pk_bf16(v1[2], v1[3]); *(u32x4*)(Mb + row * 1024 + col) = w; } } }
    }
};
struct EpiResid {
    static constexpr bool PERM = false, AFTER_DRAIN = false;
    float* X; int ldx; bool dry;
    __device__ __forceinline__ void operator()(const f32x4 (&acc)[2][2][4][2], const Unit& u, int wr, int wc, int fr, int fq) const {
        const int row0 = u.pm * BM + wr * 64 + fr, col0 = u.pn * BM + wc * 32 + 4 * fq;
#pragma unroll
        for (int ai = 0; ai < 2; ++ai)
#pragma unroll
            for (int m = 0; m < 4; ++m) { const int row = row0 + ai * HALF + m * 16;
                bool ok = true; if (row < 16896) { const int p = row % 8448; ok = p >= 48 && p < 8256; }
                if (ok && !dry) { float* rowp = X + (size_t)row * ldx + col0;
#pragma unroll
                    for (int bj = 0; bj < 2; ++bj)
#pragma unroll
                        for (int n = 0; n < 2; ++n) { f32x4* p4 = (f32x4*)(rowp + bj * HALF + n * 16); *p4 = *p4 + acc[ai][bj][m][n]; } } }
    }
};
struct EpiF32 {
    static constexpr bool PERM = false, AFTER_DRAIN = false;
    float* C; int ldc;
    __device__ __forceinline__ void operator()(const f32x4 (&acc)[2][2][4][2], const Unit& u, int wr, int wc, int fr, int fq) const {
        const int row0 = u.pm * BM + wr * 64 + fr, col0 = u.pn * BM + wc * 32 + 4 * fq;
#pragma unroll
        for (int ai = 0; ai < 2; ++ai)
#pragma unroll
            for (int m = 0; m < 4; ++m) { float* rowp = C + (size_t)(row0 + ai * HALF + m * 16) * ldc + col0;
#pragma unroll
                for (int bj = 0; bj < 2; ++bj)
#pragma unroll
                    for (int n = 0; n < 2; ++n) *(f32x4*)(rowp + bj * HALF + n * 16) = acc[ai][bj][m][n]; }
    }
};

template <class Epi, class Sched, bool ALIGN_EPI = false, bool SP2 = false>
__device__ __forceinline__ void gemm_phase(PG8_LAS unsigned char* lds, const Gemm g, const Sched& S, const Epi& E) {
    int tid_ = threadIdx.x; asm volatile("" : "+v"(tid_));
    const int tid = tid_, wid = __builtin_amdgcn_readfirstlane(tid >> 6), lane = tid & 63, wr = wid >> 2, wc = wid & 3, fr = lane & 15, fq = lane >> 4;
    const int K = g.K, nt = K / BK;
    unsigned voffA[2], voffB[2];
#pragma unroll
    for (int i = 0; i < 2; ++i) { int R, C; stage_rc(tid * 16 + i * 8192, R, C); const int Rb = Epi::PERM ? ((R & ~31) + perm32(R & 31)) : R;
        voffA[i] = (unsigned)(R * K + C) * 2u; voffB[i] = (unsigned)(Rb * K + C) * 2u; }
    const size_t kstep = (size_t)(BK * 2);
    const size_t hstep = (size_t)HALF * K * 2;
    const size_t tstep = 2 * hstep;
    const unsigned ldsw = (unsigned)wid * 1024u;
    const int aoff = lds_byte(wr * 64 + fr, fq * 8), boff = lds_byte(wc * 32 + fr, fq * 8);
#define PG8_SA(b, h) (((b) * 2 + (h)) * HTB)
#define PG8_SB(b, h) ((4 + (b) * 2 + (h)) * HTB)
#define PG8_STAGE(bufoff, gbase, voff) do { _Pragma("unroll") for (int _i = 0; _i < 2; ++_i) \
        __builtin_amdgcn_global_load_lds((const unsigned*)((const char*)(gbase) + (voff)[_i]), (PG8_LAS unsigned*)(lds + (bufoff) + ldsw + _i * 8192), 16, 0, 0); } while (0)
#define PG8_LDA(dst, b, h) do { _Pragma("unroll") for (int m = 0; m < 4; ++m) _Pragma("unroll") for (int k = 0; k < 2; ++k) dst[m][k] = *(const PG8_LAS bf16x8*)(lds + PG8_SA(b, h) + aoff + m * 2048 + k * 1024); } while (0)
#define PG8_LDB(dst, b, h) do { _Pragma("unroll") for (int n = 0; n < 2; ++n) _Pragma("unroll") for (int k = 0; k < 2; ++k) dst[n][k] = *(const PG8_LAS bf16x8*)(lds + PG8_SB(b, h) + boff + n * 2048 + k * 1024); } while (0)
#define PG8_MMA(ai, bj, At, Bt) do { __builtin_amdgcn_s_setprio(1); _Pragma("unroll") for (int m = 0; m < 4; ++m) _Pragma("unroll") for (int n = 0; n < 2; ++n) _Pragma("unroll") for (int k = 0; k < 2; ++k) \
        acc[ai][bj][m][n] = __builtin_amdgcn_mfma_f32_16x16x32_bf16(Bt[n][k], At[m][k], acc[ai][bj][m][n], 0, 0, 0); __builtin_amdgcn_s_setprio(0); } while (0)
#define PG8_WAIT_V(n) asm volatile("s_waitcnt vmcnt(" #n ")" ::: "memory")
#define PG8_WAIT_L(n) asm volatile("s_waitcnt lgkmcnt(" #n ")" ::: "memory")
#define PG8_BAR __builtin_amdgcn_s_barrier()
#define PG8_SCHED __builtin_amdgcn_sched_barrier(0)
    Unit cur, nxt; int ui = 0;
    if (!S.next(0, cur)) return;
    f32x4 acc[2][2][4][2];
#pragma unroll
    for (int a = 0; a < 2; ++a)
#pragma unroll
        for (int b = 0; b < 2; ++b)
#pragma unroll
            for (int m = 0; m < 4; ++m)
#pragma unroll
                for (int n = 0; n < 2; ++n) acc[a][b][m][n] = (f32x4){0.f, 0.f, 0.f, 0.f};
    bf16x8 At[4][2], B0[2][2], B1[2][2];
    const char* cA = (const char*)g.A + (size_t)cur.pm * tstep; const char* cB = (const char*)g.Bt + (size_t)cur.pn * tstep;
    S.a_ready(cur);
    if constexpr (SP2) {
        PG8_STAGE(PG8_SB(0, 0), cB, voffB); PG8_STAGE(PG8_SB(0, 1), cB + hstep, voffB); PG8_STAGE(PG8_SA(0, 0), cA, voffA); PG8_STAGE(PG8_SA(0, 1), cA + hstep, voffA);
        if (wr == 1) PG8_BAR;
        PG8_WAIT_V(2); PG8_BAR;
        PG8_STAGE(PG8_SB(1, 0), cB + kstep, voffB); PG8_STAGE(PG8_SA(1, 0), cA + kstep, voffA); PG8_STAGE(PG8_SB(1, 1), cB + hstep + kstep, voffB);
        PG8_WAIT_V(6); PG8_BAR;
    } else {
        PG8_STAGE(PG8_SB(0, 0), cB, voffB); PG8_STAGE(PG8_SA(0, 0), cA, voffA); PG8_STAGE(PG8_SB(0, 1), cB + hstep, voffB); PG8_STAGE(PG8_SA(0, 1), cA + hstep, voffA);
        if (wr == 1) PG8_BAR;
        PG8_WAIT_V(4); PG8_BAR;
        PG8_STAGE(PG8_SB(1, 0), cB + kstep, voffB); PG8_STAGE(PG8_SA(1, 0), cA + kstep, voffA); PG8_STAGE(PG8_SB(1, 1), cB + hstep + kstep, voffB);
        PG8_WAIT_V(6); PG8_BAR;
    }
    for (;;) {
        const bool has_next = S.next(ui + 1, nxt);
        const char* nA = has_next ? (const char*)g.A + (size_t)nxt.pm * tstep : cA; const char* nB = has_next ? (const char*)g.Bt + (size_t)nxt.pn * tstep : cB;
        for (int t = 0; t < nt; t += 2) {
            const bool last = (t == nt - 2);
            const char* a1 = cA + (size_t)(t + 1) * kstep;
            const char* a2 = last ? nA : cA + (size_t)(t + 2) * kstep; const char* b2 = last ? nB : cB + (size_t)(t + 2) * kstep;
            const char* a3 = a2 + kstep; const char* b3 = b2 + kstep;
            if (last && has_next) S.a_ready(nxt);
            if constexpr (SP2) {
            PG8_LDB(B0, 0, 0); PG8_LDB(B1, 0, 1); PG8_SCHED; PG8_LDA(At, 0, 0); PG8_STAGE(PG8_SA(1, 1), a1 + hstep, voffA);
            PG8_WAIT_V(8); PG8_WAIT_L(0); PG8_BAR; PG8_MMA(0, 0, At, B0); PG8_MMA(0, 1, At, B1); PG8_BAR; PG8_SCHED;
            PG8_LDA(At, 0, 1); PG8_STAGE(PG8_SB(0, 0), b2, voffB); PG8_STAGE(PG8_SB(0, 1), b2 + hstep, voffB); PG8_STAGE(PG8_SA(0, 0), a2, voffA);
            PG8_WAIT_V(8); PG8_WAIT_L(0); PG8_BAR; PG8_MMA(1, 0, At, B0); PG8_MMA(1, 1, At, B1); PG8_BAR; PG8_SCHED;
            PG8_LDB(B0, 1, 0); PG8_LDB(B1, 1, 1); PG8_SCHED; PG8_LDA(At, 1, 0); PG8_STAGE(PG8_SA(0, 1), a2 + hstep, voffA);
            PG8_WAIT_V(8); PG8_WAIT_L(0); PG8_BAR; PG8_MMA(0, 0, At, B0); PG8_MMA(0, 1, At, B1); PG8_BAR; PG8_SCHED;
            PG8_LDA(At, 1, 1); PG8_STAGE(PG8_SB(1, 0), b3, voffB); PG8_STAGE(PG8_SB(1, 1), b3 + hstep, voffB); PG8_STAGE(PG8_SA(1, 0), a3, voffA);
            PG8_WAIT_V(8); PG8_WAIT_L(0); PG8_BAR; PG8_MMA(1, 0, At, B0); PG8_MMA(1, 1, At, B1); PG8_BAR; PG8_SCHED;
            } else {
            PG8_LDB(B0, 0, 0); PG8_SCHED; PG8_LDA(At, 0, 0); PG8_STAGE(PG8_SA(1, 1), a1 + hstep, voffA);
            PG8_WAIT_L(8); PG8_BAR; PG8_WAIT_L(0); PG8_MMA(0, 0, At, B0); PG8_BAR; PG8_SCHED;
            PG8_LDB(B1, 0, 1); PG8_STAGE(PG8_SB(0, 0), b2, voffB);
            PG8_BAR; PG8_WAIT_L(0); PG8_MMA(0, 1, At, B1); PG8_BAR;
            PG8_LDA(At, 0, 1); PG8_STAGE(PG8_SA(0, 0), a2, voffA);
            PG8_BAR; PG8_WAIT_L(0); PG8_MMA(1, 0, At, B0); PG8_BAR; PG8_SCHED;
            PG8_STAGE(PG8_SB(0, 1), b2 + hstep, voffB);
            PG8_WAIT_V(6); PG8_BAR; PG8_MMA(1, 1, At, B1); PG8_BAR;
            PG8_LDB(B0, 1, 0); PG8_SCHED; PG8_LDA(At, 1, 0); PG8_STAGE(PG8_SA(0, 1), a2 + hstep, voffA);
            PG8_WAIT_L(8); PG8_BAR; PG8_WAIT_L(0); PG8_MMA(0, 0, At, B0); PG8_BAR; PG8_SCHED;
            PG8_LDB(B1, 1, 1); PG8_STAGE(PG8_SB(1, 0), b3, voffB);
            PG8_BAR; PG8_WAIT_L(0); PG8_MMA(0, 1, At, B1); PG8_BAR;
            PG8_LDA(At, 1, 1); PG8_STAGE(PG8_SA(1, 0), a3, voffA);
            PG8_BAR; PG8_WAIT_L(0); PG8_MMA(1, 0, At, B0); PG8_BAR; PG8_SCHED;
            PG8_STAGE(PG8_SB(1, 1), b3 + hstep, voffB);
            PG8_WAIT_V(6); PG8_BAR; PG8_MMA(1, 1, At, B1); PG8_BAR;
            }
        }
        if constexpr (ALIGN_EPI) { if (wr == 0) PG8_BAR; }
        if constexpr (!Epi::AFTER_DRAIN) { E(acc, cur, wr, wc, fr, fq); S.done(cur); }
        if (!has_next) break;
#pragma unroll
        for (int a = 0; a < 2; ++a)
#pragma unroll
            for (int b = 0; b < 2; ++b)
#pragma unroll
                for (int m = 0; m < 4; ++m)
#pragma unroll
                    for (int n = 0; n < 2; ++n) acc[a][b][m][n] = (f32x4){0.f, 0.f, 0.f, 0.f};
        cur = nxt; cA = nA; cB = nB; ++ui;
        if constexpr (ALIGN_EPI) { if (wr == 1) PG8_BAR; }
    }
    PG8_WAIT_V(0);
    if constexpr (!ALIGN_EPI) { if (wr == 0) PG8_BAR; }
    PG8_BAR;
    if constexpr (Epi::AFTER_DRAIN) { E.fused(acc, cur, wr, wc, fr, fq, lds, wid, lane); S.done(cur); }
#undef PG8_SA
#undef PG8_SB
#undef PG8_STAGE
#undef PG8_LDA
#undef PG8_LDB
#undef PG8_MMA
#undef PG8_WAIT_V
#undef PG8_WAIT_L
#undef PG8_BAR
#undef PG8_SCHED
}
}
#include <hip/hip_bf16.h>
#include <cmath>
namespace attn_body {
using bf16=__hip_bfloat16;
using bf16x8=__attribute__((ext_vector_type(8)))short;
using s16x4=__attribute__((ext_vector_type(4)))short;
using f32x16=__attribute__((ext_vector_type(16)))float;
using u32x4=__attribute__((ext_vector_type(4)))unsigned;
constexpr int ASEQ=8448,D=64;
constexpr int QP=512,KP=512,VP=7424,OP=1024;
constexpr int NW=8,QBLK=32,QB=QBLK*NW,KVBLK=64,NQB=ASEQ/QB;
constexpr int ATTN_UNIT_ROWS=QB;
__device__ __forceinline__ int crow(int r,int hi){return (r&3)+8*(r>>2)+4*hi;}
#define SBAR() __builtin_amdgcn_sched_barrier(0)
constexpr int BT_OFF=383, BT_N=640;
__device__ __forceinline__ void bmask(f32x16&p0,f32x16&p1,int t,int q0,int wid,int r32,int hi,const __attribute__((address_space(3))) float*tab){
  const float NEG=-INFINITY; const int qw=q0+32*wid;
  if(t>(qw>>6)){
    #pragma unroll
    for(int r=0;r<16;++r){p0[r]=NEG;p1[r]=NEG;} return; }
  if(t>0 && 64*t+63+91<=qw) return;
  const int q=qw+r32, kb=64*t+4*hi;
  #pragma unroll
  for(int r=0;r<16;++r){ const int kv=kb+(r&3)+8*(r>>2); int i0=kv-q+BT_OFF, i1=i0+32; i0=i0<0?0:i0; i1=i1<0?0:i1;
    p0[r]+=tab[i0]; p1[r]+=tab[i1]; if(kv<48)p0[r]=NEG; if(kv+32<48)p1[r]=NEG; }
}

constexpr int NSLOT=3, SLOTB=8192;
constexpr int LDS_K=0, LDS_V=NSLOT*SLOTB, LDS_WS=2*NSLOT*SLOTB, LDS_OST=LDS_WS+NW*64*4, LDS_BT=LDS_OST+NW*4096, LDS_BYTES=LDS_BT+BT_N*4;
constexpr float C2=0.125f*1.4426950408889634f;
__device__ __forceinline__ void glds16(const void*gsrc,unsigned lds_dst){unsigned keep;
  asm volatile("s_mov_b32 %0, m0\n\ts_mov_b32 m0, %2\n\ts_nop 0\n\tglobal_load_lds_dwordx4 %1, off\n\ts_mov_b32 m0, %0":"=&s"(keep):"v"(gsrc),"s"(lds_dst):"memory");}
__device__ __forceinline__ float max3f(float a,float b,float c){float r;asm("v_max3_f32 %0, %1, %2, %3":"=v"(r):"v"(a),"v"(b),"v"(c));return r;}
__device__ __forceinline__ float max2f(float a,float b){float r;asm("v_max_f32_e32 %0, %1, %2":"=v"(r):"v"(a),"v"(b));return r;}
__device__ __forceinline__ float fadd_s(float a,float b){float r;asm("v_add_f32_e32 %0, %1, %2":"=v"(r):"v"(a),"v"(b));return r;}
__device__ __forceinline__ float fsub_s(float a,float b){float r;asm("v_sub_f32_e32 %0, %1, %2":"=v"(r):"v"(a),"v"(b));return r;}
typedef float f32x2_t __attribute__((ext_vector_type(2))); typedef __bf16 bf16x2_t __attribute__((ext_vector_type(2)));
__device__ __forceinline__ unsigned cvtpk_s(float lo,float hi){f32x2_t v={lo,hi};bf16x2_t b=__builtin_convertvector(v,bf16x2_t);return __builtin_bit_cast(unsigned,b);}
#define WAIT_BAR(N) asm volatile("s_waitcnt vmcnt(" #N ") lgkmcnt(0)\n\ts_barrier":::"memory")

__device__ __forceinline__ void qkt(f32x16&p0,f32x16&p1,const char*Kslot,const bf16x8*qr,const f32x16&negm,int r32,int hi){
  const char*kb=Kslot+hi*1024+r32*16;
  #pragma unroll
  for(int d0=0;d0<4;++d0){
    const bf16x8 b0=*reinterpret_cast<const bf16x8*>(kb+d0*2048);
    const bf16x8 b1=*reinterpret_cast<const bf16x8*>(kb+d0*2048+512);
    if(d0==0){p0=__builtin_amdgcn_mfma_f32_32x32x16_bf16(b0,qr[0],negm,0,0,0);p1=__builtin_amdgcn_mfma_f32_32x32x16_bf16(b1,qr[0],negm,0,0,0);}
    else{p0=__builtin_amdgcn_mfma_f32_32x32x16_bf16(b0,qr[d0],p0,0,0,0);p1=__builtin_amdgcn_mfma_f32_32x32x16_bf16(b1,qr[d0],p1,0,0,0);}}
}
typedef __attribute__((address_space(3))) const char* lds_cptr;
typedef __attribute__((address_space(3))) const float* lds_cfptr;
typedef short v4i16_t __attribute__((ext_vector_type(4)));
__device__ __forceinline__ void kload8(bf16x8*kf,lds_cptr kp){
  kf[0]=*(const __attribute__((address_space(3))) bf16x8*)(kp);      kf[1]=*(const __attribute__((address_space(3))) bf16x8*)(kp+512);
  kf[2]=*(const __attribute__((address_space(3))) bf16x8*)(kp+2048); kf[3]=*(const __attribute__((address_space(3))) bf16x8*)(kp+2560);
  kf[4]=*(const __attribute__((address_space(3))) bf16x8*)(kp+4096); kf[5]=*(const __attribute__((address_space(3))) bf16x8*)(kp+4608);
  kf[6]=*(const __attribute__((address_space(3))) bf16x8*)(kp+6144); kf[7]=*(const __attribute__((address_space(3))) bf16x8*)(kp+6656);
}
__device__ __forceinline__ void kload2(bf16x8*kf,lds_cptr kp,int j){ kf[2*j]=*(const __attribute__((address_space(3))) bf16x8*)(kp+j*2048); kf[2*j+1]=*(const __attribute__((address_space(3))) bf16x8*)(kp+j*2048+512); }
__device__ __forceinline__ s16x4 vtr(lds_cptr p){ return __builtin_bit_cast(s16x4,__builtin_amdgcn_ds_read_tr16_b64_v4i16((__attribute__((address_space(3))) v4i16_t*)p)); }
__device__ __forceinline__ float rowmax(const f32x16&p0,const f32x16&p1){
  float a=max3f(p0[0],p0[1],p1[0]),b=max3f(p0[2],p0[3],p1[1]);a=max3f(a,p1[2],p1[3]);
  #pragma unroll
  for(int r=4;r<16;r+=4){a=max3f(a,p0[r],p0[r+1]);b=max3f(b,p0[r+2],p0[r+3]);a=max3f(a,p1[r],p1[r+1]);b=max3f(b,p1[r+2],p1[r+3]);}
  const float m=max2f(a,b);
  auto rr=__builtin_amdgcn_permlane32_swap(__float_as_uint(m),__float_as_uint(m),false,false);
  return max2f(__uint_as_float(rr[0]),__uint_as_float(rr[1]));
}
__device__ __forceinline__ void pv(f32x16*o,int vb,bf16x8 pa0,bf16x8 pa1,bf16x8 pa2,bf16x8 pa3){
  #pragma unroll
  for(int d0=0;d0<2;++d0){s16x4 lo[4],hi[4];
    #pragma unroll
    for(int ks=0;ks<4;++ks){
      asm volatile("ds_read_b64_tr_b16 %0,%1 offset:%c2":"=&v"(lo[ks]):"v"(vb),"i"(d0*4096+ks*1024):"memory");
      asm volatile("ds_read_b64_tr_b16 %0,%1 offset:%c2":"=&v"(hi[ks]):"v"(vb),"i"(d0*4096+ks*1024+512):"memory");}
    asm volatile("s_waitcnt lgkmcnt(0)":::"memory");SBAR();
    #define PK(k) (bf16x8){lo[k][0],lo[k][1],lo[k][2],lo[k][3],hi[k][0],hi[k][1],hi[k][2],hi[k][3]}
    o[d0]=__builtin_amdgcn_mfma_f32_32x32x16_bf16(pa0,PK(0),o[d0],0,0,0);
    o[d0]=__builtin_amdgcn_mfma_f32_32x32x16_bf16(pa1,PK(1),o[d0],0,0,0);
    o[d0]=__builtin_amdgcn_mfma_f32_32x32x16_bf16(pa2,PK(2),o[d0],0,0,0);
    o[d0]=__builtin_amdgcn_mfma_f32_32x32x16_bf16(pa3,PK(3),o[d0],0,0,0);
    #undef PK
  }
}

#ifndef ATTN_STORE16
#define ATTN_STORE16(p,v) (*(u32x4*)(p)=(v))
#endif
template<int THRL> __device__ __forceinline__ void attn_unit(int b,int qoff,int voff,int ooff,int qb,const bf16*Q,const bf16*__restrict__ K,const bf16*__restrict__ V,bf16*O,char*shm){
  int tid_=threadIdx.x; asm volatile("":"+v"(tid_)); const int tid=tid_,lane=tid&63,r32=lane&31,hi=lane>>5; const int wid=__builtin_amdgcn_readfirstlane(tid>>6);
  const long rowbase=(long)b*ASEQ; const int q0=qb*QB;
  const bf16*Qw=Q+(rowbase+q0+wid*QBLK)*QP+qoff;
  const bf16*Kh=K+rowbase*KP+qoff,*Vh=V+rowbase*VP+voff;
  const unsigned lds0=(unsigned)(uintptr_t)shm;
  float*wsf=(float*)(shm+LDS_WS)+wid*64;
  const bf16*ksrc=Kh+(long)lane*KP+wid*8;
  const bf16*vsrc=Vh+(long)(16*(wid&3)+(lane>>2))*VP+(wid>>2)*32+(lane&3)*8;
  const unsigned kdst=lds0+LDS_K+wid*1024, vdst=lds0+LDS_V+wid*1024;
  #define DMA_K(t,slot) glds16(ksrc+(long)(t)*KVBLK*KP,(unsigned)__builtin_amdgcn_readfirstlane(kdst+(slot)))
  #define DMA_V(t,slot) glds16(vsrc+(long)(t)*KVBLK*VP,(unsigned)__builtin_amdgcn_readfirstlane(vdst+(slot)))
  const int vb0=(int)(lds0+LDS_V)+((lane>>4)&1)*32+(lane&3)*8+(4*hi+((lane&15)>>2))*64;
  const char*Kbase=shm+LDS_K; bf16x8 kf[8];
  const lds_cptr shm3=(lds_cptr)shm; const lds_cfptr btab=(lds_cfptr)(shm3+LDS_BT); const lds_cptr kp0=shm3+LDS_K+hi*1024+r32*16; const lds_cptr vp0=shm3+LDS_V+((lane>>4)&1)*32+(lane&3)*8+(4*hi+((lane&15)>>2))*64;
  const int NTL=(q0+QB)/KVBLK;
  DMA_K(0,0);DMA_V(0,0);DMA_K(1,SLOTB);
  bf16x8 qr[4];
  #pragma unroll
  for(int d0=0;d0<4;++d0)qr[d0]=*reinterpret_cast<const bf16x8*>(&Qw[(long)r32*QP+d0*16+hi*8]);
  float mhat=0.f,l_reg=0.f;f32x16 o[2];o[0]=f32x16{};o[1]=f32x16{};const f32x16 zt=f32x16{};
  const int qrel=wid*QBLK+r32;
  #define CMASK(P0,P1,t) bmask(P0,P1,(t),q0,wid,r32,hi,btab)
  bool resc=false;
  #define START(P0,P1) do{ const float rm=rowmax(P0,P1); resc=false; \
    { const float dl=rm; mhat=fadd_s(mhat,dl); \
      _Pragma("unroll") for(int r=0;r<16;++r){P0[r]=fsub_s(P0[r],dl);P1[r]=fsub_s(P1[r],dl);} \
      } \
    _Pragma("unroll") for(int r=0;r<16;++r)P0[r]=__builtin_amdgcn_exp2f(P0[r]); }while(0)
  #define RESC() do{ if(resc){ asm volatile("s_waitcnt lgkmcnt(0)":::"memory"); \
      _Pragma("unroll") for(int d_=0;d_<2;++d_) _Pragma("unroll") for(int r=0;r<16;++r)o[d_][r]*=wsf[crow(r,hi)]; } }while(0)
  f32x16 pA0,pA1,pB0,pB1;
  int sl_prev=0,sl_cur=0,sl_next=SLOTB;
  #define ROT() do{sl_prev=sl_cur;sl_cur=sl_next;sl_next=(sl_next==(NSLOT-1)*SLOTB)?0:sl_next+SLOTB;}while(0)
  DMA_K(2,2*SLOTB);
  WAIT_BAR(3);
  qkt(pA0,pA1,Kbase,qr,zt,r32,hi);asm volatile("s_nop 15\n\ts_nop 7":"+v"(pA0),"+v"(pA1));CMASK(pA0,pA1,0);
  START(pA0,pA1);
  _Pragma("unroll") for(int r=0;r<16;++r)pA1[r]=__builtin_amdgcn_exp2f(pA1[r]);
  WAIT_BAR(0);
  DMA_K(3,0);DMA_V(1,SLOTB);
  ROT();
  kload8(kf,kp0+sl_cur);
  WAIT_BAR(2);
  s16x4 vlo[8],vhi[8]; u32x4 pw0,pw1,pw2,pw3;
  #define PKW(P,B) cvtpk_s(P[B],P[B+1])
  #define PAF(k) __builtin_bit_cast(bf16x8,pw##k)
  #define VFR(i) (bf16x8){vlo[i][0],vlo[i][1],vlo[i][2],vlo[i][3],vhi[i][0],vhi[i][1],vhi[i][2],vhi[i][3]}
  #define PIN(x) asm volatile("":"+v"(x))
  #define MX3(a,b,c) __builtin_fmaxf(__builtin_fmaxf((a),(b)),(c))
  #define GAPA(MF,A0,A1,A2,A3,W0,W1,PW) do{ MF; sacc+=A0; sacc+=A1; sacc+=A2; sacc+=A3; PIN(sacc); W0; W1; PIN(PW); SBAR(); }while(0)
  #define EX(v) __builtin_amdgcn_exp2f(v)
  #define GAPB(MF,X,B) do{ MF; X[B]=EX(X[B]); X[B+1]=EX(X[B+1]); X[B+2]=EX(X[B+2]); X[B+3]=EX(X[B+3]); PIN(X); SBAR(); }while(0)
  #define VRD(i) do{ vlo[i]=vtr(vp_+(((i)>>2)*4096+((i)&3)*1024)); vhi[i]=vtr(vp_+(((i)>>2)*4096+((i)&3)*1024+512)); }while(0)
  #define KRD(G,j) do{ if(G){ kload2(kf,kp0+sl_next,j); SBAR(); } }while(0)
  #define STEP(C0,C1,P0,P1,t,GK,GV,GL) do{ SBAR(); \
    const lds_cptr vp_=vp0+sl_prev; \
    VRD(0); SBAR(); float sacc=(P0[0]+P0[1]); \
    GAPA(C0=__builtin_amdgcn_mfma_f32_32x32x16_bf16(kf[0],qr[0],zt,0,0,0), P0[2],P0[3],P0[4],P0[5],     pw0[0]=PKW(P0,0), pw0[1]=PKW(P0,2), pw0); \
    VRD(4); SBAR(); GAPA(C1=__builtin_amdgcn_mfma_f32_32x32x16_bf16(kf[1],qr[0],zt,0,0,0), P0[6],P0[7],P0[8],P0[9],     pw0[2]=PKW(P0,4), pw0[3]=PKW(P0,6), pw0); \
    VRD(1); SBAR(); GAPA(C0=__builtin_amdgcn_mfma_f32_32x32x16_bf16(kf[2],qr[1],C0,0,0,0),   P0[10],P0[11],P0[12],P0[13], pw1[0]=PKW(P0,8), pw1[1]=PKW(P0,10), pw1); \
    VRD(5); SBAR(); GAPA(C1=__builtin_amdgcn_mfma_f32_32x32x16_bf16(kf[3],qr[1],C1,0,0,0),   P0[14],P0[15],P1[0],P1[1],   pw1[2]=PKW(P0,12),pw1[3]=PKW(P0,14), pw1); \
    VRD(2); SBAR(); GAPA(C0=__builtin_amdgcn_mfma_f32_32x32x16_bf16(kf[4],qr[2],C0,0,0,0),   P1[2],P1[3],P1[4],P1[5],     pw2[0]=PKW(P1,0), pw2[1]=PKW(P1,2), pw2); \
    VRD(6); SBAR(); GAPA(C1=__builtin_amdgcn_mfma_f32_32x32x16_bf16(kf[5],qr[2],C1,0,0,0),   P1[6],P1[7],P1[8],P1[9],     pw2[2]=PKW(P1,4), pw2[3]=PKW(P1,6), pw2); \
    VRD(3); SBAR(); GAPA(C0=__builtin_amdgcn_mfma_f32_32x32x16_bf16(kf[6],qr[3],C0,0,0,0),   P1[10],P1[11],P1[12],P1[13], pw3[0]=PKW(P1,8), pw3[1]=PKW(P1,10), pw3); \
    VRD(7); SBAR(); GAPA(C1=__builtin_amdgcn_mfma_f32_32x32x16_bf16(kf[7],qr[3],C1,0,0,0),   P1[14],P1[15],0.f,0.f,       pw3[2]=PKW(P1,12),pw3[3]=PKW(P1,14), pw3); \
    l_reg+=sacc; \
    if(GK){DMA_K((t)+3,sl_cur);} if(GV){DMA_V((t)+1,sl_next);} \
    _Pragma("unroll") for(int r=0;r<16;++r){C0[r]-=mhat;C1[r]-=mhat;} \
    CMASK(C0,C1,t); \
    { float a=MX3(C0[0],C0[1],C1[0]),b=MX3(C0[2],C0[3],C1[1]); a=MX3(a,C1[2],C1[3]); \
      _Pragma("unroll") for(int r=4;r<16;r+=4){a=MX3(a,C0[r],C0[r+1]);b=MX3(b,C0[r+2],C0[r+3]);a=MX3(a,C1[r],C1[r+1]);b=MX3(b,C1[r+2],C1[r+3]);} \
      float rm=__builtin_fmaxf(a,b); { auto rr=__builtin_amdgcn_permlane32_swap(__float_as_uint(rm),__float_as_uint(rm),false,false); rm=__builtin_fmaxf(__uint_as_float(rr[0]),__uint_as_float(rr[1])); } \
      resc=false; \
      if(__builtin_expect(__any(rm>(float)THRL),0)){ const float dl=__builtin_fmaxf(rm,0.f); mhat+=dl; \
        _Pragma("unroll") for(int r=0;r<16;++r){C0[r]-=dl;C1[r]-=dl;} \
        const float f=__builtin_amdgcn_exp2f(-dl); l_reg*=f; if(hi==0)wsf[r32]=f; resc=true; } } \
    SBAR(); \
    GAPB(o[0]=__builtin_amdgcn_mfma_f32_32x32x16_bf16(PAF(0),VFR(0),o[0],0,0,0), C0,0); \
    GAPB(o[1]=__builtin_amdgcn_mfma_f32_32x32x16_bf16(PAF(0),VFR(4),o[1],0,0,0), C0,4); \
    KRD(GL,0); GAPB(o[0]=__builtin_amdgcn_mfma_f32_32x32x16_bf16(PAF(1),VFR(1),o[0],0,0,0), C0,8); \
    KRD(GL,1); GAPB(o[1]=__builtin_amdgcn_mfma_f32_32x32x16_bf16(PAF(1),VFR(5),o[1],0,0,0), C0,12); \
    KRD(GL,2); GAPB(o[0]=__builtin_amdgcn_mfma_f32_32x32x16_bf16(PAF(2),VFR(2),o[0],0,0,0), C1,0); \
    KRD(GL,3); GAPB(o[1]=__builtin_amdgcn_mfma_f32_32x32x16_bf16(PAF(2),VFR(6),o[1],0,0,0), C1,4); \
    GAPB(o[0]=__builtin_amdgcn_mfma_f32_32x32x16_bf16(PAF(3),VFR(3),o[0],0,0,0), C1,8); \
    GAPB(o[1]=__builtin_amdgcn_mfma_f32_32x32x16_bf16(PAF(3),VFR(7),o[1],0,0,0), C1,12); \
    }while(0)
  int t=1;
  #undef CMASK
  #define CMASK(P0,P1,t) do{}while(0)
  for(;t+7<NTL;t+=2){
    STEP(pB0,pB1,pA0,pA1,t,true,true,true);     WAIT_BAR(2); RESC(); ROT();
    STEP(pA0,pA1,pB0,pB1,t+1,true,true,true);   WAIT_BAR(2); RESC(); ROT();
  }
  #undef CMASK
  #define CMASK(P0,P1,t) bmask(P0,P1,(t),q0,wid,r32,hi,btab)
  #define ENDW(tt) do{ if((tt)+3<NTL){WAIT_BAR(2);} else if((tt)+2<NTL){WAIT_BAR(1);} else {WAIT_BAR(0);} }while(0)
  for(;t+1<NTL;t+=2){
    STEP(pB0,pB1,pA0,pA1,t,(t+3<NTL),(t+1<NTL),(t+1<NTL));       ENDW(t);   RESC(); ROT();
    STEP(pA0,pA1,pB0,pB1,t+1,(t+4<NTL),(t+2<NTL),(t+2<NTL));     ENDW(t+1); RESC(); ROT();
  }
  STEP(pB0,pB1,pA0,pA1,NTL-1,false,false,false); RESC();
  { float sacc=pB0[0]+pB0[1]; _Pragma("unroll") for(int r=2;r<16;++r)sacc+=pB0[r]; _Pragma("unroll") for(int r=0;r<16;++r)sacc+=pB1[r]; l_reg+=sacc;
    pw0=(u32x4){PKW(pB0,0),PKW(pB0,2),PKW(pB0,4),PKW(pB0,6)};pw1=(u32x4){PKW(pB0,8),PKW(pB0,10),PKW(pB0,12),PKW(pB0,14)};pw2=(u32x4){PKW(pB1,0),PKW(pB1,2),PKW(pB1,4),PKW(pB1,6)};pw3=(u32x4){PKW(pB1,8),PKW(pB1,10),PKW(pB1,12),PKW(pB1,14)};
    SBAR(); pv(o,vb0+sl_cur,PAF(0),PAF(1),PAF(2),PAF(3)); }
  #undef PKW
  #undef PAF
  #undef VFR
  #undef PIN
  #undef MX3
  #undef GAPA
  #undef GAPB
  #undef EX
  #undef VRD
  #undef KRD
  #undef STEP
  #undef ENDW
  {auto rr=__builtin_amdgcn_permlane32_swap(__float_as_uint(l_reg),__float_as_uint(l_reg),false,false);l_reg=__uint_as_float(rr[0])+__uint_as_float(rr[1]);}
  if(hi==0)wsf[32+r32]=l_reg;asm volatile("s_waitcnt lgkmcnt(0)":::"memory");
  float rli[16];
  #pragma unroll
  for(int r=0;r<16;++r)rli[r]=__builtin_amdgcn_rcpf(wsf[32+crow(r,hi)]);
  bf16*Ow=O+(rowbase+q0+wid*QBLK)*OP+ooff;
  { bf16*stg=(bf16*)(shm+LDS_OST)+wid*2048;
    #pragma unroll
    for(int r=0;r<16;++r){const int orow=crow(r,hi);
      #pragma unroll
      for(int d0=0;d0<2;++d0)stg[orow*64+d0*32+r32]=__float2bfloat16(o[d0][r]*rli[r]);}
    asm volatile("s_waitcnt lgkmcnt(0)":::"memory");
    #pragma unroll
    for(int i=0;i<4;++i){const int row=i*8+(lane>>3),ch=lane&7; const u32x4 v=*(const u32x4*)(stg+row*64+ch*8); ATTN_STORE16(Ow+(long)row*OP+ch*8,v);} }
  asm volatile("s_waitcnt lgkmcnt(0)\n\ts_barrier":::"memory");
  #undef DMA_K
  #undef DMA_V
  #undef CMASK
  #undef START
  #undef RESC
  #undef ROT
}
constexpr int ATTN_LDS_BYTES=LDS_BYTES;
#undef SBAR
#undef WAIT_BAR
#undef WAIT_BAR
}
namespace mk {
#define GAS __attribute__((address_space(1)))
#define LAS __attribute__((address_space(3)))
typedef unsigned short bf16;
typedef unsigned v4u __attribute__((ext_vector_type(4)));
typedef unsigned v2u __attribute__((ext_vector_type(2)));
typedef float f32x4 __attribute__((ext_vector_type(4)));
typedef float f32x16 __attribute__((ext_vector_type(16)));
typedef short bf16x8 __attribute__((ext_vector_type(8)));
typedef GAS unsigned gu32;
#define RLX_AGENT __ATOMIC_RELAXED, __HIP_MEMORY_SCOPE_AGENT
#define LDS_WAIT() asm volatile("s_waitcnt lgkmcnt(0)" ::: "memory")
#define VM_WAIT() asm volatile("s_waitcnt vmcnt(0)" ::: "memory")
__device__ __forceinline__ unsigned f2bf(float f) { unsigned u = __builtin_bit_cast(unsigned, f); return (u + 0x7fffu + ((u >> 16) & 1u)) >> 16; }
__device__ __forceinline__ unsigned pk2(float lo, float hi) { return f2bf(lo) | (f2bf(hi) << 16); }
__device__ __forceinline__ float bf2f(unsigned short b) { return __builtin_bit_cast(float, ((unsigned)b) << 16); }
__device__ __forceinline__ float bflo(unsigned w) { return __builtin_bit_cast(float, w << 16); }
__device__ __forceinline__ float bfhi(unsigned w) { return __builtin_bit_cast(float, w & 0xffff0000u); }

constexpr int NWAVES = 8, NTHR = NWAVES * 64;
constexpr int PADF = 48;
constexpr int LPP = 8448;
constexpr int PEND = PADF + LP;
constexpr int SROW0 = BATCH * LPP;
constexpr int RP = SROW0 + NS;
constexpr int ZN = 7424;
constexpr int ZC_QA = 0, ZC_KA = 512, ZC_VA = 1024, ZC_QKVB = 1536, ZC_GB = 3072, ZC_UC = 3584, ZC_GATE = 4096, ZC_BA = 7168;
static_assert(RP % 256 == 0 && ZN % 256 == 0 && D_MODEL == 1024 && WIDTH_A == 512 && WIDTH_B == 512 && WIDTH_C == 512, "shapes");
__host__ __device__ __forceinline__ int nat2prow(int row) { return row < NP ? (row / LP) * LPP + PADF + row % LP : SROW0 + (row - NP); }
__host__ __device__ __forceinline__ int zcol(int col) { return col < 3584 ? col : (col < 3592 ? ZC_BA + (col - 3584) : col - 8); }
__device__ __forceinline__ bool prow_valid(int prow) { if (prow >= SROW0) return true; const int p = prow % LPP; return p >= PADF && p < PEND; }
__device__ __forceinline__ int prow2nat(int prow) { if (prow >= SROW0) return NP + (prow - SROW0); return (prow / LPP) * LP + (prow % LPP) - PADF; }

constexpr int RING_OFF = 0, RING_BYTES = 147456;
constexpr int LDSCTL_OFF = RING_BYTES, MISC_OFF = LDSCTL_OFF + 320;
constexpr int LDS_BYTES = RING_BYTES + 1024;
static_assert(MISC_OFF + 128 <= LDS_BYTES, "LDS map");

constexpr size_t CTL_BYTES = 1u << 20;
constexpr int CW_TMO = 0, CW_CODE = 1;
constexpr int CW_BAR = 4096;
constexpr int CW_QUEUE = 16384;

#define XB_TMO      128
#define XB_XCNT(j)  (256  + 64 * (j))
#define XB_XSUB(j)  (1280 + 64 * (j))
#define XB_XGEN(j)  (2304 + 64 * (j))
#define XB_TOP      3328
#define XB_TOPGEN   3392
#define XCD_BAR_WORDS 3456
#define XB_SPIN_CAP (1u << 18)

__device__ __forceinline__ unsigned xb_ld(unsigned* p)              { return __hip_atomic_load(p, __ATOMIC_RELAXED, __HIP_MEMORY_SCOPE_AGENT); }
__device__ __forceinline__ unsigned xb_add(unsigned* p, unsigned v) { return __hip_atomic_fetch_add(p, v, __ATOMIC_RELAXED, __HIP_MEMORY_SCOPE_AGENT); }
__device__ __forceinline__ unsigned xb_xcc_id() { return (unsigned)__builtin_amdgcn_s_getreg((3 << 11) | 20) & 0xFu; }
#define XB_SPIN(cond, bar) do { unsigned _sp = 0; while (cond) { __builtin_amdgcn_s_sleep(1); \
    if ((++_sp & 255u) == 0u) { if (xb_ld(&(bar)[XB_TMO])) break; if (_sp > XB_SPIN_CAP) { atomicAdd(&(bar)[XB_TMO], 1u); break; } } } } while (0)

struct XcdBarrier {
    unsigned* bar; unsigned x;
    volatile LAS unsigned* st;
};

__device__ __forceinline__ XcdBarrier xcd_barrier_post(unsigned* bar, volatile LAS unsigned* st) {
    XcdBarrier b; b.bar = bar; b.x = xb_xcc_id(); b.st = st;
    if (threadIdx.x == 0) (void)xb_add(&bar[XB_XCNT(b.x)], 1u);
    return b;
}
__device__ __forceinline__ void xcd_barrier_complete(unsigned* bar, unsigned x, unsigned& nloc, unsigned& nx) {
    const unsigned G = gridDim.x * gridDim.y * gridDim.z;
    unsigned sum, cnt, mine, sp = 0u;
    for (;;) {
        sum = 0u; cnt = 0u; mine = 0u;
#pragma unroll
        for (unsigned j = 0; j < 16; ++j) { const unsigned c = xb_ld(&bar[XB_XCNT(j)]); sum += c; cnt += (c > 0u) ? 1u : 0u; mine = (j == x) ? c : mine; }
        if (sum == G) break;
        __builtin_amdgcn_s_sleep(1);
        if ((++sp & 255u) == 0u) { if (xb_ld(&bar[XB_TMO])) break; if (sp > XB_SPIN_CAP) { atomicAdd(&bar[XB_TMO], 1u); break; } }
    }
    nloc = mine > 0u ? mine : 1u; nx = cnt > 0u ? cnt : 1u;
}

__device__ __forceinline__ void xcd_barrier(const XcdBarrier& b) {
    asm volatile("s_waitcnt vmcnt(0)" ::: "memory");
    __syncthreads();
    if (threadIdx.x == 0) {
        unsigned* bar = b.bar;
        __builtin_amdgcn_s_waitcnt(0);
        unsigned nloc = b.st[0], nx = b.st[1];
        if (nloc == 0u) { xcd_barrier_complete(bar, b.x, nloc, nx); b.st[0] = nloc; b.st[1] = nx; }
        const unsigned old = xb_add(&bar[XB_XSUB(b.x)], 1u);
        const unsigned gen = old / nloc;
        if (old + 1u == (gen + 1u) * nloc) {
            __builtin_amdgcn_fence(__ATOMIC_RELEASE, "agent");
            asm volatile("s_waitcnt vmcnt(0)" ::: "memory");
            const unsigned og = xb_add(&bar[XB_TOP], 1u);
            const unsigned tg = og / nx;
            if (og + 1u == (tg + 1u) * nx) xb_add(&bar[XB_TOPGEN], 1u);
            else XB_SPIN(xb_ld(&bar[XB_TOPGEN]) == tg, bar);
            __builtin_amdgcn_fence(__ATOMIC_ACQUIRE, "agent");
            xb_add(&bar[XB_XGEN(b.x)], 1u);
            asm volatile("s_waitcnt vmcnt(0)" ::: "memory");
        } else {
            XB_SPIN(xb_ld(&bar[XB_XGEN(b.x)]) == gen, bar);
            __builtin_amdgcn_fence(__ATOMIC_ACQUIRE, "agent");
            asm volatile("s_waitcnt vmcnt(0)" ::: "memory");
        }
    }
    __syncthreads();
}


__device__ __forceinline__ float wave_sum(float v) {
#pragma unroll
    for (int o = 1; o < 64; o <<= 1) v += __shfl_xor(v, o);
    return v;
}
}
namespace mk {
enum Region { R_X, R_XN, R_WIN, R_Z, R_QN, R_KN, R_QKVB, R_BG, R_O, R_OA, R_OB, R_YC, R_OC, R_MRG, R_WGLU, R_WBR, R_WOUT, R_WQS, R_PU, R_PV, R_SC, R_GDN, R_S5T, R_MISC, R_S5E, R_S5X, R_MRGB, R_OBN, R_NREG };
constexpr int NPL = 16;
enum Phase { PH_PRO = 0, PL_NORM1 = 0, PL_GEMM_IN = 1, PL_ZPOST = 2, PL_LOCAL = 3, PL_MIX = 4, PL_MIXPOST = 5, PL_GEMM_GLU = 6, PL_GEMM_BRA = 7, PL_GEMM_BRB = 8, PL_GEMM_BRC = 9,
             PL_GEMM_OUT = 10, PL_NORM2 = 11, PL_GEMM_PEER = 12, PL_PEER = 13, PH_FINAL = 1 + DEPTH * NPL, PH_END = PH_FINAL + 1 };
enum ProMask { PM_X = 1, PM_WIN = 2, PM_WREST = 4, PM_PEERW = 8, PM_WQS = 16, PM_TABLES = 32 };
struct Args {
    const float* in[40];
    float* out;
    unsigned char* ws;
    unsigned long long off[32];
    int ph_lo, ph_hi, pro_mask, bar_region;
};
static_assert(sizeof(Args) == 40 * 8 + 8 + 8 + 32 * 8 + 16, "Args has no padding");

typedef const __attribute__((address_space(4))) Args* KArgs;
__device__ __forceinline__ KArgs kargs() { KArgs p = (KArgs)__builtin_amdgcn_kernarg_segment_ptr(); asm volatile("" : "+s"(p)); return p; }
#define WS_OPAQUE(a) unsigned char* wsb = (a).ws; asm volatile("" : "+s"(wsb))
__device__ __forceinline__ int otid() { int t = threadIdx.x; asm volatile("" : "+v"(t)); return t; }
struct Frame {
    LAS unsigned char* lds; volatile LAS unsigned* MISC; gu32* ctl;
    int vcu, G;
};

template <class CM> __device__ __forceinline__ void transpose_item(const float* W, int ld, int K, bf16* WT, int n0, int k0, const CM& cm, LAS float* scr, int lane) {
    const int sc = cm(n0 + (lane & 31));
#pragma unroll 8
    for (int i = 0; i < 32; ++i) { const int kk = 2 * i + (lane >> 5); scr[kk * 33 + (lane & 31)] = sc >= 0 ? W[(size_t)(k0 + kk) * ld + sc] : 0.f; }
    LDS_WAIT(); asm volatile("" ::: "memory");
    const int c = lane & 7;
#pragma unroll
    for (int j = 0; j < 4; ++j) { const int n = (lane >> 3) + 8 * j; const LAS float* s = scr + (8 * c) * 33 + n;
        v4u o; o.x = pk2(s[0 * 33], s[1 * 33]); o.y = pk2(s[2 * 33], s[3 * 33]); o.z = pk2(s[4 * 33], s[5 * 33]); o.w = pk2(s[6 * 33], s[7 * 33]);
        *(GAS v4u*)(WT + (size_t)(n0 + n) * K + k0 + 8 * c) = o; }
    LDS_WAIT(); asm volatile("" ::: "memory");
}
struct CmWin { __device__ __forceinline__ int operator()(int n) const { return n < 3584 ? n : (n < 7168 ? n + 8 : (n < 7176 ? 3584 + (n - 7168) : -1)); } };
struct CmId { __device__ __forceinline__ int operator()(int n) const { return n; } };
struct CmGlu { __device__ __forceinline__ int operator()(int n) const { const int G = n >> 5, i = n & 31; return i < 16 ? 16 * G + i : 512 + 16 * G + (i - 16); } };

__device__ __forceinline__ void rms_row_to_bf16(const float* xrow, const float* g, bf16* orow, int lane) {
    const GAS f32x4* xr = (const GAS f32x4*)xrow + lane;
    f32x4 v[4]; float s2 = 0.f;
#pragma unroll
    for (int j = 0; j < 4; ++j) { v[j] = xr[64 * j]; s2 += (v[j].x * v[j].x + v[j].y * v[j].y) + (v[j].z * v[j].z + v[j].w * v[j].w); }
    const float r = __builtin_amdgcn_rsqf(wave_sum(s2) * (1.f / D_MODEL) + EPSF);
    const GAS f32x4* gr = (const GAS f32x4*)g + lane;
    GAS unsigned long long* o8 = (GAS unsigned long long*)orow + lane;
#pragma unroll
    for (int j = 0; j < 4; ++j) { const f32x4 gg = gr[64 * j];
        o8[64 * j] = (unsigned long long)pk2(v[j].x * r * gg.x, v[j].y * r * gg.y) | ((unsigned long long)pk2(v[j].z * r * gg.z, v[j].w * r * gg.w) << 32); }
}

__device__ __forceinline__ void p_norm(Frame& F, int l, int gi) {
    const KArgs ap = kargs(); const auto& a = *ap; WS_OPAQUE(a);
    const int tid = otid(), lane = tid & 63, wave = __builtin_amdgcn_readfirstlane(tid >> 6);
    const float* X = (const float*)(wsb + a.off[R_X]); bf16* XN = (bf16*)(wsb + a.off[R_XN]); const float* g = a.in[gi] + (size_t)l * D_MODEL;
    const int gw = F.vcu * NWAVES + wave, NGW = F.G * NWAVES;
    for (int m = gw; m < RP; m += NGW) rms_row_to_bf16(X + (size_t)m * D_MODEL, g, XN + (size_t)m * D_MODEL, lane);
}
__device__ __forceinline__ void unpack8(const v4u w, float (&f)[8]) { f[0] = bflo(w.x); f[1] = bfhi(w.x); f[2] = bflo(w.y); f[3] = bfhi(w.y); f[4] = bflo(w.z); f[5] = bfhi(w.z); f[6] = bflo(w.w); f[7] = bfhi(w.w); }
__device__ __forceinline__ v4u pack8(const float (&f)[8]) { v4u w; w.x = pk2(f[0], f[1]); w.y = pk2(f[2], f[3]); w.z = pk2(f[4], f[5]); w.w = pk2(f[6], f[7]); return w; }
__device__ __forceinline__ float sigm(float x) { return __builtin_amdgcn_rcpf(1.f + __expf(-x)); }
constexpr float ATT_C2 = 0.125f * 1.4426950408889634f;
__device__ __forceinline__ void p_zpost(Frame& F, int l) {
    const KArgs ap = kargs(); const auto& a = *ap; WS_OPAQUE(a);
    const bf16* Z = (const bf16*)(wsb + a.off[R_Z]);
    bf16* QN = (bf16*)(wsb + a.off[R_QN]); bf16* KN = (bf16*)(wsb + a.off[R_KN]); bf16* QKVB = (bf16*)(wsb + a.off[R_QKVB]); float* BG = (float*)(wsb + a.off[R_BG]);
    const int tid = otid(), lane = tid & 63, wave = __builtin_amdgcn_readfirstlane(tid >> 6);
    const int gw = F.vcu * NWAVES + wave, NGW = F.G * NWAVES;
    float gq[8], gk[8], cw[3][4][8];
#pragma unroll
    for (int j = 0; j < 8; ++j) { gq[j] = a.in[I_QN][l * HEAD_DIM_A + 8 * (lane & 7) + j] * ATT_C2; gk[j] = a.in[I_KN][l * HEAD_DIM_A + 8 * (lane & 7) + j]; }
#pragma unroll
    for (int w = 0; w < 3; ++w)
#pragma unroll
        for (int i = 0; i < 4; ++i)
#pragma unroll
            for (int j = 0; j < 8; ++j) cw[w][i][j] = a.in[I_CONVW][((size_t)l * CONV_W + i) * 3 * WIDTH_B + w * WIDTH_B + 8 * lane + j];
    float alog = 0.f, dtb = 0.f; if (lane < 4) { alog = a.in[I_ALOG][l * N_HEADS_B + lane]; dtb = a.in[I_DTB][l * N_HEADS_B + lane]; }
    for (int m = gw; m < RP; m += NGW) {
        const bool valid = prow_valid(m); const int nat = valid ? prow2nat(m) : 0;
        const bf16* zr = Z + (size_t)m * ZN;
        float f[8], o[8];
        unpack8(*(const GAS v4u*)(zr + ZC_QA + 8 * lane), f);
        { float ss = 0.f;
#pragma unroll
          for (int j = 0; j < 8; ++j) ss += f[j] * f[j];
          ss += __shfl_xor(ss, 1); ss += __shfl_xor(ss, 2); ss += __shfl_xor(ss, 4);
          const float r = __builtin_amdgcn_rsqf(ss * (1.f / HEAD_DIM_A) + EPSF);
#pragma unroll
          for (int j = 0; j < 8; ++j) o[j] = f[j] * r * gq[j];
          *(GAS v4u*)(QN + (size_t)m * WIDTH_A + 8 * lane) = pack8(o); }
        unpack8(*(const GAS v4u*)(zr + ZC_KA + 8 * lane), f);
        { float ss = 0.f;
#pragma unroll
          for (int j = 0; j < 8; ++j) ss += f[j] * f[j];
          ss += __shfl_xor(ss, 1); ss += __shfl_xor(ss, 2); ss += __shfl_xor(ss, 4);
          const float r = __builtin_amdgcn_rsqf(ss * (1.f / HEAD_DIM_A) + EPSF);
#pragma unroll
          for (int j = 0; j < 8; ++j) o[j] = f[j] * r * gk[j];
          *(GAS v4u*)(KN + (size_t)m * WIDTH_A + 8 * lane) = pack8(o);
          if (valid) { float* ko = nat < NP ? a.out + O_KP + ((size_t)l * NP + nat) * WIDTH_A : a.out + O_KS + ((size_t)l * NS + (nat - NP)) * WIDTH_A;
              *(GAS f32x4*)(ko + 8 * lane) = (f32x4){o[0], o[1], o[2], o[3]}; *(GAS f32x4*)(ko + 8 * lane + 4) = (f32x4){o[4], o[5], o[6], o[7]}; } }
        if (valid) { unpack8(*(const GAS v4u*)(zr + ZC_VA + 8 * lane), f);
            float* vo = nat < NP ? a.out + O_VP + ((size_t)l * NP + nat) * WIDTH_A : a.out + O_VS + ((size_t)l * NS + (nat - NP)) * WIDTH_A;
            *(GAS f32x4*)(vo + 8 * lane) = (f32x4){f[0], f[1], f[2], f[3]}; *(GAS f32x4*)(vo + 8 * lane + 4) = (f32x4){f[4], f[5], f[6], f[7]}; }
        const int ts = m >= SROW0 ? (m - SROW0) % DEC_SEQ : 1000; const int bs = m >= SROW0 ? (m - SROW0) / DEC_SEQ : 0;
        int cj = -1;
        if (m >= SROW0) { if (ts >= DEC_SEQ - 3) cj = ts - (DEC_SEQ - 3); } else { const int p = m % LPP; if (p >= PEND - 3 && p < PEND) cj = p - (PEND - 3); }
#pragma unroll
        for (int w = 0; w < 3; ++w) {
            float acc[8];
#pragma unroll
            for (int j = 0; j < 8; ++j) acc[j] = 0.f;
#pragma unroll
            for (int i = 0; i < 4; ++i) {
                const int dt = i - 3;
                if (ts + dt < 0) {
                    const float* sc = a.in[I_SCONV] + (((size_t)l * DEC_BATCH + bs) * (CONV_W - 1) + (CONV_W - 1 + ts + dt)) * 3 * WIDTH_B + w * WIDTH_B + 8 * lane;
                    const f32x4 s0 = *(const GAS f32x4*)sc, s1 = *(const GAS f32x4*)(sc + 4);
                    f[0] = s0.x; f[1] = s0.y; f[2] = s0.z; f[3] = s0.w; f[4] = s1.x; f[5] = s1.y; f[6] = s1.z; f[7] = s1.w;
                } else if (m + dt >= 0) unpack8(*(const GAS v4u*)(Z + (size_t)(m + dt) * ZN + ZC_QKVB + w * WIDTH_B + 8 * lane), f);
                else {
#pragma unroll
                    for (int j = 0; j < 8; ++j) f[j] = 0.f; }
#pragma unroll
                for (int j = 0; j < 8; ++j) acc[j] += f[j] * cw[w][i][j];
                if (i == 3 && cj >= 0) {
                    float* co = m >= SROW0 ? a.out + O_CS + (((size_t)l * DEC_BATCH + bs) * (CONV_W - 1) + cj) * 3 * WIDTH_B : a.out + O_CP + (((size_t)l * BATCH + m / LPP) * (CONV_W - 1) + cj) * 3 * WIDTH_B;
                    *(GAS f32x4*)(co + w * WIDTH_B + 8 * lane) = (f32x4){f[0], f[1], f[2], f[3]}; *(GAS f32x4*)(co + w * WIDTH_B + 8 * lane + 4) = (f32x4){f[4], f[5], f[6], f[7]}; }
            }
            float ss = 0.f;
#pragma unroll
            for (int j = 0; j < 8; ++j) { acc[j] = acc[j] * sigm(acc[j]); ss += acc[j] * acc[j]; }
            float sc = 1.f;
            if (w < 2) { ss += __shfl_xor(ss, 1); ss += __shfl_xor(ss, 2); ss += __shfl_xor(ss, 4); ss += __shfl_xor(ss, 8);
                sc = __builtin_amdgcn_rsqf(ss + EPSF); if (w == 0) sc *= 0.08838834764831845f; }
#pragma unroll
            for (int j = 0; j < 8; ++j) o[j] = acc[j] * sc;
            *(GAS v4u*)(QKVB + (size_t)m * 3 * WIDTH_B + w * WIDTH_B + 8 * lane) = pack8(o);
        }
        if (lane < 4) { const float be = bf2f(zr[ZC_BA + lane]), al = bf2f(zr[ZC_BA + 4 + lane]) + dtb;
            const float sp = al > 20.f ? al : __logf(1.f + __expf(al));
            BG[(size_t)m * 8 + lane] = valid ? sigm(be) : 0.f; BG[(size_t)m * 8 + 4 + lane] = valid ? -__expf(alog) * sp : 0.f; }
    }
}
constexpr float LOG2E = 1.4426950408889634f;
__device__ __forceinline__ int t5_bucket_dev(int rel) {
    const int n = rel < 0 ? -rel : rel; int b;
    if (n < 8) b = n; else if (n < 12) b = 8; else if (n < 16) b = 9; else if (n < 23) b = 10; else if (n < 32) b = 11;
    else if (n < 46) b = 12; else if (n < 64) b = 13; else if (n < 91) b = 14; else b = 15;
    return b + (rel > 0 ? 16 : 0);
}
__device__ __forceinline__ void build_bias_table(LAS float* tab, const float* rel_bias, int h, int tid) {
    const float far = rel_bias[15 * N_HEADS_A + h];
    for (int i = tid; i < attn_body::BT_N; i += NTHR) tab[i] = (rel_bias[t5_bucket_dev(i - attn_body::BT_OFF) * N_HEADS_A + h] - far) * LOG2E;
}
__device__ __forceinline__ float lam_init_dev(int l) { return 0.8f - 0.6f * __expf(-0.3f * (float)l); }
__device__ __forceinline__ float lam_dev(const float* lqk_all, int l, int lane) {
    const float* q = lqk_all + (size_t)l * 4 * HEAD_DIM_A;
    const float s0 = wave_sum(q[lane] * q[HEAD_DIM_A + lane]), s1 = wave_sum(q[2 * HEAD_DIM_A + lane] * q[3 * HEAD_DIM_A + lane]);
    return __expf(s0) - __expf(s1) + lam_init_dev(l);
}
__device__ __forceinline__ int krow_dev(int s, int h, int j) { return 16 * s + 8 * (j >> 2) + 4 * h + (j & 3); }
__device__ __forceinline__ int crow_dev(int r, int h) { return (r & 3) + 8 * (r >> 2) + 4 * h; }
__device__ __forceinline__ bf16x8 pack_f8(const f32x4 a, const f32x4 b) { v4u w; w.x = pk2(a.x, a.y); w.y = pk2(a.z, a.w); w.z = pk2(b.x, b.y); w.w = pk2(b.z, b.w); return __builtin_bit_cast(bf16x8, w); }

__device__ __forceinline__ void sample_scores(f32x16& X, int kb, int c, const float* ck, const bf16* KN, int row0, int h, int hi, int r32, int qpos, const bf16x8 (&qf)[4], const LAS float* tab) {
    bf16x8 kf[4];
    if (kb < PAST_LEN / 32) { const float* kr = ck + (size_t)(kb * 32 + r32) * WIDTH_A + h * 128 + c * 64 + 8 * hi;
#pragma unroll
        for (int s = 0; s < 4; ++s) kf[s] = pack_f8(*(const GAS f32x4*)(kr + 16 * s), *(const GAS f32x4*)(kr + 16 * s + 4)); }
    else { const bf16* kr = KN + (size_t)(row0 + (kb * 32 - PAST_LEN) + r32) * WIDTH_A + h * 128 + c * 64 + 8 * hi;
#pragma unroll
        for (int s = 0; s < 4; ++s) kf[s] = *(const GAS bf16x8*)(kr + 16 * s); }
#pragma unroll
    for (int i = 0; i < 16; ++i) X[i] = 0.f;
#pragma unroll
    for (int s = 0; s < 4; ++s) X = __builtin_amdgcn_mfma_f32_32x32x16_bf16(kf[s], qf[s], X, 0, 0, 0);
#pragma unroll
    for (int i = 0; i < 16; ++i) { int idx = kb * 32 + crow_dev(i, hi) - qpos + attn_body::BT_OFF; idx = idx < 0 ? 0 : idx; X[i] += tab[idx]; }
}

__device__ __forceinline__ void attn_sample_unit(Frame& F, int l, int bs, int h) {
    const KArgs ap = kargs(); const auto& a = *ap; WS_OPAQUE(a);
    const int tid = otid(), lane = tid & 63, wid = __builtin_amdgcn_readfirstlane(tid >> 6), r32 = lane & 31, hi = lane >> 5;
    const bf16* QN = (const bf16*)(wsb + a.off[R_QN]); const bf16* KN = (const bf16*)(wsb + a.off[R_KN]); const bf16* Z = (const bf16*)(wsb + a.off[R_Z]); bf16* O = (bf16*)(wsb + a.off[R_O]);
    const float* ck = a.in[I_CK] + ((size_t)l * DEC_BATCH + bs) * PAST_LEN * WIDTH_A; const float* cv = a.in[I_CV] + ((size_t)l * DEC_BATCH + bs) * PAST_LEN * WIDTH_A;
    const int row0 = SROW0 + bs * DEC_SEQ;
    LAS float* tab = (LAS float*)(F.lds + RING_OFF + attn_body::LDS_BT);
    LAS float* st = (LAS float*)(F.lds + RING_OFF + 90112);
    LAS float* slot = (LAS float*)(F.lds + RING_OFF);
    const float lam = lam_dev(a.in[I_LQK], l, lane);
    build_bias_table(tab, a.in[I_REL], h, tid);
    bf16x8 qf[2][4];
#pragma unroll
    for (int c = 0; c < 2; ++c)
#pragma unroll
        for (int s = 0; s < 4; ++s) qf[c][s] = *(const GAS bf16x8*)(QN + (size_t)(row0 + r32) * WIDTH_A + h * 128 + c * 64 + 16 * s + 8 * hi);
    __syncthreads();
    float m[2] = {-1e30f, -1e30f}, lsum[2] = {0.f, 0.f};
    const int qpos = PAST_LEN + r32;
    for (int kb = wid; kb < (PAST_LEN + DEC_SEQ) / 32; kb += NWAVES) {
#pragma unroll
        for (int c = 0; c < 2; ++c) { f32x16 X; sample_scores(X, kb, c, ck, KN, row0, h, hi, r32, qpos, qf[c], tab);
            float mx = X[0];
#pragma unroll
            for (int i = 1; i < 16; ++i) mx = fmaxf(mx, X[i]);
            mx = fmaxf(mx, __shfl_xor(mx, 32)); const float mn = fmaxf(m[c], mx);
            float sum = 0.f;
#pragma unroll
            for (int i = 0; i < 16; ++i) sum += exp2f(X[i] - mn);
            lsum[c] = lsum[c] * exp2f(m[c] - mn) + sum; m[c] = mn; }
    }
#pragma unroll
    for (int c = 0; c < 2; ++c) { lsum[c] += __shfl_xor(lsum[c], 32); if (hi == 0) { st[((wid * 2 + c) * 2 + 0) * 32 + r32] = m[c]; st[((wid * 2 + c) * 2 + 1) * 32 + r32] = lsum[c]; } }
    __syncthreads();
    float gm[2], ginv[2];
#pragma unroll
    for (int c = 0; c < 2; ++c) { float mm = -1e30f;
#pragma unroll
        for (int w = 0; w < NWAVES; ++w) mm = fmaxf(mm, st[((w * 2 + c) * 2 + 0) * 32 + r32]);
        float ll = 0.f;
#pragma unroll
        for (int w = 0; w < NWAVES; ++w) ll += st[((w * 2 + c) * 2 + 1) * 32 + r32] * exp2f(st[((w * 2 + c) * 2 + 0) * 32 + r32] - mm);
        gm[c] = mm; ginv[c] = (c == 0 ? 1.f : lam) / ll; }
    f32x16 acc[4];
#pragma unroll
    for (int eb = 0; eb < 4; ++eb)
#pragma unroll
        for (int i = 0; i < 16; ++i) acc[eb][i] = 0.f;
    for (int kb = wid; kb < (PAST_LEN + DEC_SEQ) / 32; kb += NWAVES) {
        f32x16 X0, X1; sample_scores(X0, kb, 0, ck, KN, row0, h, hi, r32, qpos, qf[0], tab); sample_scores(X1, kb, 1, ck, KN, row0, h, hi, r32, qpos, qf[1], tab);
        float wv[16];
#pragma unroll
        for (int i = 0; i < 16; ++i) wv[i] = exp2f(X0[i] - gm[0]) * ginv[0] - exp2f(X1[i] - gm[1]) * ginv[1];
        bf16x8 xs[2];
#pragma unroll
        for (int s = 0; s < 2; ++s) { v4u w; w.x = pk2(wv[8 * s], wv[8 * s + 1]); w.y = pk2(wv[8 * s + 2], wv[8 * s + 3]); w.z = pk2(wv[8 * s + 4], wv[8 * s + 5]); w.w = pk2(wv[8 * s + 6], wv[8 * s + 7]); xs[s] = __builtin_bit_cast(bf16x8, w); }
#pragma unroll
        for (int eb = 0; eb < 4; ++eb)
#pragma unroll
            for (int s = 0; s < 2; ++s) {
                float vv[8];
                if (kb < PAST_LEN / 32) { const float* vb = cv + (size_t)(kb * 32 + 4 * hi) * WIDTH_A + h * 128 + eb * 32 + r32; asm volatile("" : "+v"(vb));
#pragma unroll
                    for (int j = 0; j < 8; ++j) vv[j] = vb[(size_t)(16 * s + 8 * (j >> 2) + (j & 3)) * WIDTH_A]; }
                else { const bf16* vb = Z + (size_t)(row0 + kb * 32 - PAST_LEN + 4 * hi) * ZN + ZC_VA + h * 128 + eb * 32 + r32; asm volatile("" : "+v"(vb));
#pragma unroll
                    for (int j = 0; j < 8; ++j) vv[j] = bf2f(vb[(size_t)(16 * s + 8 * (j >> 2) + (j & 3)) * ZN]); }
                v4u w; w.x = pk2(vv[0], vv[1]); w.y = pk2(vv[2], vv[3]); w.z = pk2(vv[4], vv[5]); w.w = pk2(vv[6], vv[7]);
                acc[eb] = __builtin_amdgcn_mfma_f32_32x32x16_bf16(xs[s], __builtin_bit_cast(bf16x8, w), acc[eb], 0, 0, 0);
            }
    }
    __syncthreads();
#pragma unroll
    for (int eb = 0; eb < 4; ++eb)
#pragma unroll
        for (int i = 0; i < 16; ++i) slot[(wid * 32 + crow_dev(i, hi)) * 128 + eb * 32 + r32] = acc[eb][i];
    __syncthreads();
    { const int q = tid >> 4, e0 = (tid & 15) * 8; float o[8];
#pragma unroll
      for (int j = 0; j < 8; ++j) o[j] = 0.f;
#pragma unroll
      for (int w = 0; w < NWAVES; ++w)
#pragma unroll
          for (int j = 0; j < 8; ++j) o[j] += slot[(w * 32 + q) * 128 + e0 + j];
      v4u pw; pw.x = pk2(o[0], o[1]); pw.y = pk2(o[2], o[3]); pw.z = pk2(o[4], o[5]); pw.w = pk2(o[6], o[7]);
      bf16* orow = O + (size_t)(row0 + q) * attn_body::OP + h * 256;
      unsigned zq = 0u; asm volatile("" : "+v"(zq));
      *(GAS v4u*)(orow + e0) = pw; *(GAS v4u*)(orow + 128 + e0) = (v4u){zq, zq, zq, zq}; }
    __syncthreads();
}

constexpr int ATT_NQB = LPP / 256;
constexpr int ATT_NPU = BATCH * 16 * ATT_NQB;
constexpr int ATT_NSU = DEC_BATCH * N_HEADS_A;
__device__ __forceinline__ void p_attention(Frame& F, int lq, unsigned char* ldsg) {
    const int l = lq % DEPTH;
    for (;;) {
        const KArgs ap = kargs(); const auto& a = *ap; WS_OPAQUE(a);
        const int tid = otid();
        gu32* head = (gu32*)wsb + CW_QUEUE + 64 * lq;
        const attn_body::bf16* QN = (const attn_body::bf16*)(wsb + a.off[R_QN]); const attn_body::bf16* KN = (const attn_body::bf16*)(wsb + a.off[R_KN]);
        const attn_body::bf16* Z = (const attn_body::bf16*)(wsb + a.off[R_Z]); attn_body::bf16* O = (attn_body::bf16*)(wsb + a.off[R_O]);
        if (tid == 0) F.MISC[16] = __hip_atomic_fetch_add(head, 1u, RLX_AGENT);
        __syncthreads();
        const int u = (int)F.MISC[16];
        __syncthreads();
        if (u >= ATT_NPU + ATT_NSU) break;
        if (u < ATT_NPU) {
            const int qb = (ATT_NQB - 1) - u / 32, bvh = u % 32, b = bvh >> 4, vh = bvh & 15, h = vh >> 2, c = (vh >> 1) & 1, half = vh & 1;
            build_bias_table((LAS float*)(F.lds + RING_OFF + attn_body::LDS_BT), a.in[I_REL], h, tid);
            __syncthreads();
            attn_body::attn_unit<8>(b, h * 128 + c * 64, ZC_VA + h * 128 + half * 64, h * 256 + c * 128 + half * 64, qb, QN, KN, Z, O, (char*)ldsg + RING_OFF);
        } else { const int su = u - ATT_NPU; attn_sample_unit(F, l, su >> 2, su & 3); }
    }
}
__device__ __forceinline__ void p_mixpost_a(Frame& F, int l) {
    const KArgs ap = kargs(); const auto& a = *ap; WS_OPAQUE(a);
    const int tid = otid(), lane = tid & 63, wave = __builtin_amdgcn_readfirstlane(tid >> 6);
    const bf16* O = (const bf16*)(wsb + a.off[R_O]); bf16* OA = (bf16*)(wsb + a.off[R_OA]);
    const int gw = F.vcu * NWAVES + wave, NGW = F.G * NWAVES;
    const float lam = lam_dev(a.in[I_LQK], l, lane), post = 1.f - lam_init_dev(l);
    const int h = lane >> 4, e0 = 8 * (lane & 15);
    float sg[8];
#pragma unroll
    for (int j = 0; j < 8; ++j) sg[j] = a.in[I_SUBLN][l * 2 * HEAD_DIM_A + e0 + j] * post;
    for (int m = gw; m < RP; m += NGW) {
        float o0[8], o1[8], d[8];
        unpack8(*(const GAS v4u*)(O + (size_t)m * 1024 + h * 256 + e0), o0); unpack8(*(const GAS v4u*)(O + (size_t)m * 1024 + h * 256 + 128 + e0), o1);
        float ss = 0.f;
#pragma unroll
        for (int j = 0; j < 8; ++j) { d[j] = o0[j] - lam * o1[j]; ss += d[j] * d[j]; }
        ss += __shfl_xor(ss, 1); ss += __shfl_xor(ss, 2); ss += __shfl_xor(ss, 4); ss += __shfl_xor(ss, 8);
        const float r = __builtin_amdgcn_rsqf(ss * (1.f / 128.f) + EPSF);
#pragma unroll
        for (int j = 0; j < 8; ++j) d[j] = d[j] * r * sg[j];
        *(GAS v4u*)(OA + (size_t)m * WIDTH_A + h * 128 + e0) = pack8(d);
    }
}
constexpr int GDN_NCH = PEND / 64;
constexpr int GDN_NPI = BATCH * N_HEADS_B * GDN_NCH;
constexpr int GDN_NSI = DEC_BATCH * N_HEADS_B;
constexpr int GDN_NI = GDN_NPI + GDN_NSI;
constexpr int GI_W = 0, GI_QG = 16384, GI_KG = 32768, GI_AT = 49152, GI_U = 57344, GI_SC = 73728, GI_STRIDE = 73984;
static_assert(GDN_NI % 2 == 0 && PEND % 64 == 0, "gdn items");
__device__ __forceinline__ int frag_off(int row, int kk, int nkb) {
    const int fid = ((row >> 5) * nkb + (kk >> 5)) * 2 + ((kk & 31) >> 4), ln = (row & 31) + 32 * (((kk & 15) >> 2) & 1), j = ((kk & 15) >> 3) * 4 + (kk & 3);
    return (fid * 64 + ln) * 8 + j;
}
__device__ __forceinline__ float rdlane(float v, int i) { return __builtin_bit_cast(float, __builtin_amdgcn_readlane(__builtin_bit_cast(int, v), i)); }
__device__ __forceinline__ int gdn_item_row(int item, int j) {
    if (item < GDN_NPI) { const int sh = item / GDN_NCH, n = item % GDN_NCH; return (sh / N_HEADS_B) * LPP + 64 * n + j; }
    const int s = item - GDN_NPI; return j < 32 ? -1 : SROW0 + (s >> 2) * DEC_SEQ + (j - 32);
}
__device__ __forceinline__ int gdn_item_head(int item) { return item < GDN_NPI ? (item / GDN_NCH) % N_HEADS_B : (item - GDN_NPI) & 3; }

__device__ __forceinline__ void gdn_flush(const LAS unsigned char* stg, unsigned char* dst, int nbytes, int gt) {
    for (int o = gt * 16; o < nbytes; o += 4096) *(GAS v4u*)(dst + o) = *(const LAS v4u*)(stg + o);
}
__device__ __forceinline__ void p_gdn_chunk(Frame& F, int l) {
    const KArgs ap = kargs(); const auto& a = *ap; WS_OPAQUE(a);
    const int tid = otid(), wave = __builtin_amdgcn_readfirstlane(tid >> 6), grp = wave >> 2, gw = wave & 3;
    const bf16* QKVB = (const bf16*)(wsb + a.off[R_QKVB]); const float* BG = (const float*)(wsb + a.off[R_BG]); unsigned char* GD = wsb + a.off[R_GDN];
    LAS float* A_lds = (LAS float*)(F.lds + RING_OFF + grp * 36864);
    LAS float* Gs = A_lds + 4096; LAS float* Bs = Gs + 64; LAS float* Es = Bs + 64;
    LAS unsigned char* stg = (LAS unsigned char*)(A_lds + 4096 + 256);
    LAS bf16* stgh = (LAS bf16*)stg;
    for (int pr = F.vcu; 2 * pr < GDN_NI; pr += F.G) {
        int lane_ = tid & 63; asm volatile("" : "+v"(lane_));
        const int lane = lane_, r32 = lane & 31, hi = lane >> 5, gt = gw * 64 + lane;
        const int item = 2 * pr + grp, h = gdn_item_head(item);
        unsigned char* ib = GD + (size_t)item * GI_STRIDE;
        const int rowt = gdn_item_row(item, lane);
        const float beta = rowt >= 0 ? BG[(size_t)rowt * 8 + h] : 0.f; float G = rowt >= 0 ? BG[(size_t)rowt * 8 + 4 + h] : 0.f;
#pragma unroll
        for (int o = 1; o < 64; o <<= 1) { const float v = __shfl_up(G, o); if (lane >= o) G += v; }
        const float Glast = rdlane(G, 63), eG = __expf(G);
        if (gw == 0) { Gs[lane] = G; Bs[lane] = beta; Es[lane] = eG; if (lane == 0) *(float*)(ib + GI_SC) = __expf(Glast); }
        __syncthreads();
        { const int i0 = 32 * (gw >> 1), j0 = 32 * (gw & 1);
          const int ra = gdn_item_row(item, i0 + r32), rb = gdn_item_row(item, j0 + r32);
          f32x16 akk, aqk;
#pragma unroll
          for (int r = 0; r < 16; ++r) { akk[r] = 0.f; aqk[r] = 0.f; }
          const bf16x8 zf = {0, 0, 0, 0, 0, 0, 0, 0};
#pragma unroll
          for (int s = 0; s < 8; ++s) {
              const bf16x8 qa = ra >= 0 ? *(const GAS bf16x8*)(QKVB + (size_t)ra * 1536 + h * 128 + 16 * s + 8 * hi) : zf;
              const bf16x8 ka = ra >= 0 ? *(const GAS bf16x8*)(QKVB + (size_t)ra * 1536 + 512 + h * 128 + 16 * s + 8 * hi) : zf;
              const bf16x8 kb = rb >= 0 ? *(const GAS bf16x8*)(QKVB + (size_t)rb * 1536 + 512 + h * 128 + 16 * s + 8 * hi) : zf;
              akk = __builtin_amdgcn_mfma_f32_32x32x16_bf16(ka, kb, akk, 0, 0, 0); aqk = __builtin_amdgcn_mfma_f32_32x32x16_bf16(qa, kb, aqk, 0, 0, 0);
          }
          const int j = j0 + r32; const float Gj = Gs[j];
#pragma unroll
          for (int r = 0; r < 16; ++r) { const int i = i0 + crow_dev(r, hi); const float dec = i >= j ? __expf(Gs[i] - Gj) : 0.f;
              A_lds[i * 64 + j] = i > j ? Bs[i] * akk[r] * dec : 0.f;
              stgh[frag_off(i, j, 2)] = (bf16)f2bf(aqk[r] * dec); }
        }
        __syncthreads();
        gdn_flush(stg, ib + GI_AT, 8192, gt);
        { const int col = 64 * gw + lane; float x[64];
#pragma unroll
          for (int i = 0; i < 64; ++i) { const int ri = gdn_item_row(item, i);
              x[i] = ri >= 0 ? bf2f(QKVB[(size_t)ri * 1536 + (gw < 2 ? 1024 + h * 128 + col : 512 + h * 128 + (col - 128))]) : 0.f; }
#pragma unroll
          for (int i = 0; i < 64; ++i) x[i] *= gw < 2 ? rdlane(beta, i) : rdlane(beta, i) * rdlane(eG, i);
#pragma unroll
          for (int i = 1; i < 64; ++i) { const float arow = A_lds[i * 64 + lane];
#pragma unroll
              for (int j = 0; j < i; ++j) x[i] -= rdlane(arow, j) * x[j]; }
          __syncthreads();
          if (gw < 2) { bf16* ub = (bf16*)(ib + GI_U) + col; asm volatile("" : "+v"(ub));
#pragma unroll
              for (int i = 0; i < 64; ++i) ub[i * 128] = (bf16)f2bf(x[i]); }
          else { const int k = col - 128; LAS bf16* wb = stgh + frag_off(0, k, 4);
#pragma unroll
              for (int i = 0; i < 64; ++i) wb[(i >> 5) * 4096 + (i & 31) * 8] = (bf16)f2bf(x[i]); }
        }
        __syncthreads();
        gdn_flush(stg, ib + GI_W, 16384, gt);
        __syncthreads();
        for (int e = gt; e < 64 * 128; e += 256) { const int c = e >> 7, k = e & 127, rc = gdn_item_row(item, c);
            const float qv = rc >= 0 ? bf2f(QKVB[(size_t)rc * 1536 + h * 128 + k]) : 0.f; stgh[frag_off(c, k, 4)] = (bf16)f2bf(qv * Es[c]); }
        __syncthreads();
        gdn_flush(stg, ib + GI_QG, 16384, gt);
        __syncthreads();
        for (int e = gt; e < 64 * 128; e += 256) { const int c = e >> 7, k = e & 127, rc = gdn_item_row(item, c);
            const float kv = rc >= 0 ? bf2f(QKVB[(size_t)rc * 1536 + 512 + h * 128 + k]) : 0.f; stgh[frag_off(k, c, 2)] = (bf16)f2bf(kv * __expf(Glast - Gs[c])); }
        __syncthreads();
        gdn_flush(stg, ib + GI_KG, 16384, gt);
        __syncthreads();
    }
}

__device__ __forceinline__ void gdn_chain(const unsigned char* GD, bf16* OB, const float* sdelta, float* dout, int item0, int nch, int h, int vb, int lane) {
    const int r32 = lane & 31, hi = lane >> 5;
    f32x16 S[4];
#pragma unroll
    for (int kb = 0; kb < 4; ++kb)
#pragma unroll
        for (int r = 0; r < 16; ++r) S[kb][r] = sdelta ? sdelta[(size_t)(kb * 32 + crow_dev(r, hi)) * HEAD_DIM_B + vb * 32 + r32] : 0.f;
    for (int n = 0; n < nch; ++n) {
        const int item = item0 + n; const unsigned char* ib = GD + (size_t)item * GI_STRIDE;
        const float eGl = *(const float*)(ib + GI_SC);
        const GAS bf16x8* WF = (const GAS bf16x8*)(ib + GI_W) + lane; const GAS bf16x8* QF = (const GAS bf16x8*)(ib + GI_QG) + lane;
        const GAS bf16x8* KF = (const GAS bf16x8*)(ib + GI_KG) + lane; const GAS bf16x8* AF = (const GAS bf16x8*)(ib + GI_AT) + lane; const bf16* U = (const bf16*)(ib + GI_U);
        bf16x8 Sp[4][2];
#pragma unroll
        for (int kb = 0; kb < 4; ++kb)
#pragma unroll
            for (int s = 0; s < 2; ++s) { v4u w; w.x = pk2(S[kb][8 * s], S[kb][8 * s + 1]); w.y = pk2(S[kb][8 * s + 2], S[kb][8 * s + 3]); w.z = pk2(S[kb][8 * s + 4], S[kb][8 * s + 5]); w.w = pk2(S[kb][8 * s + 6], S[kb][8 * s + 7]); Sp[kb][s] = __builtin_bit_cast(bf16x8, w); }
        f32x16 vn[2], ot[2];
#pragma unroll
        for (int cb = 0; cb < 2; ++cb) {
            f32x16 ws;
#pragma unroll
            for (int r = 0; r < 16; ++r) { ws[r] = 0.f; ot[cb][r] = 0.f; }
#pragma unroll
            for (int kb = 0; kb < 4; ++kb)
#pragma unroll
                for (int s = 0; s < 2; ++s) { ws = __builtin_amdgcn_mfma_f32_32x32x16_bf16(WF[((cb * 4 + kb) * 2 + s) * 64], Sp[kb][s], ws, 0, 0, 0);
                    ot[cb] = __builtin_amdgcn_mfma_f32_32x32x16_bf16(QF[((cb * 4 + kb) * 2 + s) * 64], Sp[kb][s], ot[cb], 0, 0, 0); }
#pragma unroll
            for (int r = 0; r < 16; ++r) vn[cb][r] = bf2f(U[(cb * 32 + crow_dev(r, hi)) * 128 + vb * 32 + r32]) - ws[r];
        }
        bf16x8 Vp[2][2];
#pragma unroll
        for (int cb = 0; cb < 2; ++cb)
#pragma unroll
            for (int s = 0; s < 2; ++s) { v4u w; w.x = pk2(vn[cb][8 * s], vn[cb][8 * s + 1]); w.y = pk2(vn[cb][8 * s + 2], vn[cb][8 * s + 3]); w.z = pk2(vn[cb][8 * s + 4], vn[cb][8 * s + 5]); w.w = pk2(vn[cb][8 * s + 6], vn[cb][8 * s + 7]); Vp[cb][s] = __builtin_bit_cast(bf16x8, w); }
#pragma unroll
        for (int cb = 0; cb < 2; ++cb)
#pragma unroll
            for (int c2 = 0; c2 <= cb; ++c2)
#pragma unroll
                for (int s = 0; s < 2; ++s) ot[cb] = __builtin_amdgcn_mfma_f32_32x32x16_bf16(AF[((cb * 2 + c2) * 2 + s) * 64], Vp[c2][s], ot[cb], 0, 0, 0);
#pragma unroll
        for (int cb = 0; cb < 2; ++cb)
#pragma unroll
            for (int r = 0; r < 16; ++r) { const int row = gdn_item_row(item, cb * 32 + crow_dev(r, hi)); if (row >= 0) OB[(size_t)row * WIDTH_B + h * 128 + vb * 32 + r32] = (bf16)f2bf(ot[cb][r]); }
#pragma unroll
        for (int kb = 0; kb < 4; ++kb) {
#pragma unroll
            for (int r = 0; r < 16; ++r) S[kb][r] *= eGl;
#pragma unroll
            for (int cb = 0; cb < 2; ++cb)
#pragma unroll
                for (int s = 0; s < 2; ++s) S[kb] = __builtin_amdgcn_mfma_f32_32x32x16_bf16(KF[((kb * 2 + cb) * 2 + s) * 64], Vp[cb][s], S[kb], 0, 0, 0);
        }
    }
#pragma unroll
    for (int kb = 0; kb < 4; ++kb)
#pragma unroll
        for (int r = 0; r < 16; ++r) dout[(size_t)(kb * 32 + crow_dev(r, hi)) * HEAD_DIM_B + vb * 32 + r32] = S[kb][r];
}
constexpr int GCH_BUF = 73728, GCH_PCS = 18;
#define GCH_BAR() do { asm volatile("s_waitcnt lgkmcnt(0)" ::: "memory"); __builtin_amdgcn_s_barrier(); asm volatile("" ::: "memory"); } while (0)
__device__ __forceinline__ void gdn_chain_wg(Frame& F, const unsigned char* GD, bf16* OB, float* dout, int item0, int h) {
    const int tid = otid(), lane = tid & 63, wave = __builtin_amdgcn_readfirstlane(tid >> 6), r32 = lane & 31, hi = lane >> 5, vb = wave & 3;
    LAS unsigned char* lb = F.lds + RING_OFF;
    if (wave >= 4) {
        const int p0 = (wave - 4) * GCH_PCS;
        v4u R0[GCH_PCS], R1[GCH_PCS];
#define GCH_LOAD(R, c) do { const unsigned char* s_ = GD + (size_t)(item0 + (c)) * GI_STRIDE + (size_t)p0 * 1024 + lane * 16; _Pragma("unroll") for (int j = 0; j < GCH_PCS; ++j) \
            asm volatile("global_load_dwordx4 %0, %1, off" : "=&v"(R[j]) : "v"(s_ + j * 1024) : "memory"); } while (0)
#define GCH_PUT(R, c) do { if ((c) + 1 < GDN_NCH) asm volatile("s_waitcnt vmcnt(18)" ::: "memory"); else asm volatile("s_waitcnt vmcnt(0)" ::: "memory"); \
            LAS v4u* d_ = (LAS v4u*)(lb + ((c) & 1) * GCH_BUF + p0 * 1024) + lane; _Pragma("unroll") for (int j = 0; j < GCH_PCS; ++j) d_[j * 64] = R[j]; } while (0)
        GCH_LOAD(R0, 0); GCH_LOAD(R1, 1);
        GCH_PUT(R0, 0); GCH_LOAD(R0, 2);
        GCH_BAR();
        for (int n = 0; n < GDN_NCH; n += 2) {
            if (n + 1 < GDN_NCH) GCH_PUT(R1, n + 1);
            if (n + 3 < GDN_NCH) GCH_LOAD(R1, n + 3);
            GCH_BAR();
            if (n + 1 < GDN_NCH) {
                if (n + 2 < GDN_NCH) GCH_PUT(R0, n + 2);
                if (n + 4 < GDN_NCH) GCH_LOAD(R0, n + 4);
                GCH_BAR(); }
        }
        asm volatile("s_waitcnt vmcnt(0)" ::: "memory");
#undef GCH_LOAD
#undef GCH_PUT
        return;
    }
    f32x16 S[4];
#pragma unroll
    for (int kb = 0; kb < 4; ++kb)
#pragma unroll
        for (int r = 0; r < 16; ++r) S[kb][r] = 0.f;
    float eg0 = *(const float*)(GD + (size_t)item0 * GI_STRIDE + GI_SC), eg1 = *(const float*)(GD + (size_t)(item0 + 1) * GI_STRIDE + GI_SC);
    GCH_BAR();
    for (int n = 0; n < GDN_NCH; ++n) {
        const int item = item0 + n; const LAS unsigned char* bufc = lb + (n & 1) * GCH_BUF;
        const float egl = eg0; eg0 = eg1; if (n + 2 < GDN_NCH) eg1 = *(const float*)(GD + (size_t)(item + 2) * GI_STRIDE + GI_SC);
        const LAS bf16x8* WF = (const LAS bf16x8*)(bufc + GI_W) + lane; const LAS bf16x8* QF = (const LAS bf16x8*)(bufc + GI_QG) + lane;
        const LAS bf16x8* KF = (const LAS bf16x8*)(bufc + GI_KG) + lane; const LAS bf16x8* AF = (const LAS bf16x8*)(bufc + GI_AT) + lane; const LAS bf16* U = (const LAS bf16*)(bufc + GI_U);
        bf16x8 Sp[4][2];
#pragma unroll
        for (int kb = 0; kb < 4; ++kb)
#pragma unroll
            for (int s = 0; s < 2; ++s) { v4u w; w.x = pk2(S[kb][8 * s], S[kb][8 * s + 1]); w.y = pk2(S[kb][8 * s + 2], S[kb][8 * s + 3]); w.z = pk2(S[kb][8 * s + 4], S[kb][8 * s + 5]); w.w = pk2(S[kb][8 * s + 6], S[kb][8 * s + 7]); Sp[kb][s] = __builtin_bit_cast(bf16x8, w); }
        f32x16 vn[2], ot[2];
#pragma unroll
        for (int cb = 0; cb < 2; ++cb) {
            f32x16 ws;
#pragma unroll
            for (int r = 0; r < 16; ++r) { ws[r] = 0.f; ot[cb][r] = 0.f; }
#pragma unroll
            for (int kb = 0; kb < 4; ++kb)
#pragma unroll
                for (int s = 0; s < 2; ++s) { ws = __builtin_amdgcn_mfma_f32_32x32x16_bf16(WF[((cb * 4 + kb) * 2 + s) * 64], Sp[kb][s], ws, 0, 0, 0);
                    ot[cb] = __builtin_amdgcn_mfma_f32_32x32x16_bf16(QF[((cb * 4 + kb) * 2 + s) * 64], Sp[kb][s], ot[cb], 0, 0, 0); }
#pragma unroll
            for (int r = 0; r < 16; ++r) vn[cb][r] = bf2f(U[(cb * 32 + crow_dev(r, hi)) * 128 + vb * 32 + r32]) - ws[r];
        }
        bf16x8 Vp[2][2];
#pragma unroll
        for (int cb = 0; cb < 2; ++cb)
#pragma unroll
            for (int s = 0; s < 2; ++s) { v4u w; w.x = pk2(vn[cb][8 * s], vn[cb][8 * s + 1]); w.y = pk2(vn[cb][8 * s + 2], vn[cb][8 * s + 3]); w.z = pk2(vn[cb][8 * s + 4], vn[cb][8 * s + 5]); w.w = pk2(vn[cb][8 * s + 6], vn[cb][8 * s + 7]); Vp[cb][s] = __builtin_bit_cast(bf16x8, w); }
#pragma unroll
        for (int cb = 0; cb < 2; ++cb)
#pragma unroll
            for (int c2 = 0; c2 <= cb; ++c2)
#pragma unroll
                for (int s = 0; s < 2; ++s) ot[cb] = __builtin_amdgcn_mfma_f32_32x32x16_bf16(AF[((cb * 2 + c2) * 2 + s) * 64], Vp[c2][s], ot[cb], 0, 0, 0);
        { const int row0 = gdn_item_row(item, 0);
#pragma unroll
          for (int cb = 0; cb < 2; ++cb)
#pragma unroll
              for (int r = 0; r < 16; ++r) OB[(size_t)(row0 + cb * 32 + crow_dev(r, hi)) * WIDTH_B + h * 128 + vb * 32 + r32] = (bf16)f2bf(ot[cb][r]); }
#pragma unroll
        for (int kb = 0; kb < 4; ++kb) {
#pragma unroll
            for (int r = 0; r < 16; ++r) S[kb][r] *= egl;
#pragma unroll
            for (int cb = 0; cb < 2; ++cb)
#pragma unroll
                for (int s = 0; s < 2; ++s) S[kb] = __builtin_amdgcn_mfma_f32_32x32x16_bf16(KF[((kb * 2 + cb) * 2 + s) * 64], Vp[cb][s], S[kb], 0, 0, 0);
        }
        GCH_BAR();
    }
#pragma unroll
    for (int kb = 0; kb < 4; ++kb)
#pragma unroll
        for (int r = 0; r < 16; ++r) dout[(size_t)(kb * 32 + crow_dev(r, hi)) * HEAD_DIM_B + vb * 32 + r32] = S[kb][r];
}
__device__ __forceinline__ void p_gdn_chain(Frame& F, int l) {
    const KArgs ap = kargs(); const auto& a = *ap; WS_OPAQUE(a);
    const unsigned char* GD = wsb + a.off[R_GDN]; bf16* OB = (bf16*)(wsb + a.off[R_OB]);
    if (F.vcu % 32 == 0 && F.vcu / 32 < BATCH * N_HEADS_B) { const int sh = F.vcu / 32, sq = sh / N_HEADS_B, h = sh % N_HEADS_B;
        gdn_chain_wg(F, GD, OB, a.out + O_DP + (((size_t)l * BATCH + sq) * N_HEADS_B + h) * HEAD_DIM_B * HEAD_DIM_B, sh * GDN_NCH, h); }
    else { const int tid = otid(), lane = tid & 63, wave = __builtin_amdgcn_readfirstlane(tid >> 6);
        const int t = (F.vcu - F.vcu / 32 - 1) * NWAVES + wave;
        if (t < GDN_NSI * 4) { const int s = t >> 2, vb = t & 3, bs = s >> 2, h = s & 3; const size_t so = (((size_t)l * DEC_BATCH + bs) * N_HEADS_B + h) * HEAD_DIM_B * HEAD_DIM_B;
            gdn_chain(GD, OB, a.in[I_SDELTA] + so, a.out + O_DS + so, GDN_NPI + s, 1, h, vb, lane); } }
}
__device__ __forceinline__ void p_mixpost_b(Frame& F, int l) {
    const KArgs ap = kargs(); const auto& a = *ap; WS_OPAQUE(a);
    const int tid = otid(), lane = tid & 63, wave = __builtin_amdgcn_readfirstlane(tid >> 6);
    const bf16* OB = (const bf16*)(wsb + a.off[R_OB]); bf16* OBN = (bf16*)(wsb + a.off[R_OBN]); const bf16* Z = (const bf16*)(wsb + a.off[R_Z]);
    const int gw = F.vcu * NWAVES + wave, NGW = F.G * NWAVES, e0 = 8 * (lane & 15);
    float gn[8];
#pragma unroll
    for (int j = 0; j < 8; ++j) gn[j] = a.in[I_GDNN][l * HEAD_DIM_B + e0 + j];
    for (int m = gw; m < RP; m += NGW) {
        float o[8], gt[8];
        unpack8(*(const GAS v4u*)(OB + (size_t)m * WIDTH_B + 8 * lane), o); unpack8(*(const GAS v4u*)(Z + (size_t)m * ZN + ZC_GB + 8 * lane), gt);
        float ss = 0.f;
#pragma unroll
        for (int j = 0; j < 8; ++j) ss += o[j] * o[j];
        ss += __shfl_xor(ss, 1); ss += __shfl_xor(ss, 2); ss += __shfl_xor(ss, 4); ss += __shfl_xor(ss, 8);
        const float r = __builtin_amdgcn_rsqf(ss * (1.f / 128.f) + EPSF);
#pragma unroll
        for (int j = 0; j < 8; ++j) o[j] = o[j] * r * gn[j] * gt[j] * sigm(gt[j]);
        *(GAS v4u*)(OBN + (size_t)m * WIDTH_B + 8 * lane) = pack8(o);
    }
}
constexpr int S5_M1 = 0, S5_M2 = 131072, S5_M3 = 196608, S5_L16 = 262144, S5_TSTRIDE = 262656;
constexpr int S5_NCHK = RP / 16;
constexpr int S5_NBLK = S5_NCHK / 32;
constexpr int S5_PCH = PEND / 16;
static_assert(S5_NCHK % 32 == 0 && LPP % 16 == 0 && PADF % 16 == 0 && S5_STATE == 64 && S5_GROUPS == 32, "s5 shapes");

__device__ __forceinline__ void s5_tables(Frame& F) {
    const KArgs ap = kargs(); const auto& a = *ap; WS_OPAQUE(a);
    const int tid = otid();
    LAS float* pw = (LAS float*)(F.lds + RING_OFF);
    LAS float* bb = pw + 17 * 128;
    LAS float* Kt = bb + 64 * 32;
    for (int it = F.vcu; it < DEPTH * S5_GROUPS; it += F.G) {
        const int l = it / S5_GROUPS, g = it % S5_GROUPS; const size_t gp = ((size_t)l * S5_GROUPS + g) * S5_STATE;
        unsigned char* tb = wsb + a.off[R_S5T] + (size_t)it * S5_TSTRIDE;
        const float dt = __expf(a.in[I_LDT][l * S5_GROUPS + g]);
        for (int e = tid; e < 17 * 64; e += NTHR) { const int k = e >> 6, p = e & 63; const float ar = a.in[I_AR][gp + p] * dt * (float)k, ai = a.in[I_AI][gp + p] * dt * (float)k;
            float sn, cs; sincosf(ai, &sn, &cs); const float er = expf(ar); pw[e * 2] = er * cs; pw[e * 2 + 1] = er * sn; }
        __syncthreads();
        for (int e = tid; e < 64 * 16; e += NTHR) { const int p = e >> 4; const float ar = a.in[I_AR][gp + p], ai = a.in[I_AI][gp + p];
            const float nr = pw[(64 + p) * 2] - 1.f, ni = pw[(64 + p) * 2 + 1], den = ar * ar + ai * ai, fr = (nr * ar + ni * ai) / den, fi = (ni * ar - nr * ai) / den;
            const float br = a.in[I_BR][gp * 16 + e], bi = a.in[I_BI][gp * 16 + e]; bb[e * 2] = fr * br - fi * bi; bb[e * 2 + 1] = fr * bi + fi * br; }
        if (tid < 128) { const int p = tid & 63; ((float*)(tb + S5_L16))[tid] = pw[(16 * 64 + p) * 2 + (tid >> 6)]; }
        __syncthreads();
        const float* cre = a.in[I_CR] + ((size_t)l * S5_GROUPS + g) * 16 * 64; const float* cim = a.in[I_CI] + ((size_t)l * S5_GROUPS + g) * 16 * 64;
        for (int e = tid; e < 4096; e += NTHR) { const int d = e >> 8, i = (e >> 4) & 15, j = e & 15; float acc = 0.f;
            for (int p = 0; p < 64; ++p) { const float cr = cre[i * 64 + p], ci = cim[i * 64 + p], pr = pw[(d * 64 + p) * 2], pi = pw[(d * 64 + p) * 2 + 1];
                const float tr = cr * pr - ci * pi, ti = cr * pi + ci * pr; acc += tr * bb[(p * 16 + j) * 2] - ti * bb[(p * 16 + j) * 2 + 1]; }
            Kt[e] = acc; }
        __syncthreads();
        bf16* M1 = (bf16*)(tb + S5_M1); bf16* M2 = (bf16*)(tb + S5_M2); bf16* M3 = (bf16*)(tb + S5_M3);
        for (int e = tid; e < 65536; e += NTHR) { const int n = e >> 8, k = e & 255, tau = n >> 4, i = n & 15, sg = k >> 4, j = k & 15;
            float v = 0.f; if (sg <= tau) { v = Kt[((tau - sg) * 16 + i) * 16 + j]; if (sg == tau && i == j) v += a.in[I_SD][(l * S5_GROUPS + g) * 16 + i]; }
            M1[e] = (bf16)f2bf(v); }
        for (int e = tid; e < 32768; e += NTHR) { const int n = e >> 8, k = e & 255, ri = n >> 6, p = n & 63, sg = k >> 4, j = k & 15;
            const float pr = pw[((15 - sg) * 64 + p) * 2], pi = pw[((15 - sg) * 64 + p) * 2 + 1], br = bb[(p * 16 + j) * 2], bi = bb[(p * 16 + j) * 2 + 1];
            M2[e] = (bf16)f2bf(ri == 0 ? pr * br - pi * bi : pr * bi + pi * br); }
        for (int e = tid; e < 32768; e += NTHR) { const int n = e >> 7, k = e & 127, tau = n >> 4, i = n & 15, ri = k >> 6, p = k & 63;
            const float cr = cre[i * 64 + p], ci = cim[i * 64 + p], pr = pw[((tau + 1) * 64 + p) * 2], pi = pw[((tau + 1) * 64 + p) * 2 + 1];
            M3[e] = (bf16)f2bf(ri == 0 ? cr * pr - ci * pi : -(cr * pi + ci * pr)); }
        __syncthreads();
    }
}
__device__ __forceinline__ void p_s5_e(Frame& F, int l) {
    const KArgs ap = kargs(); const auto& a = *ap; WS_OPAQUE(a);
    const int tid = otid(), lane = tid & 63, wave = __builtin_amdgcn_readfirstlane(tid >> 6), r32 = lane & 31, hi = lane >> 5;
    const bf16* Z = (const bf16*)(wsb + a.off[R_Z]); float* E = (float*)(wsb + a.off[R_S5E]);
    for (int u = F.vcu * NWAVES + wave; u < S5_NBLK * S5_GROUPS; u += F.G * NWAVES) {
        const int blk = u / S5_GROUPS, g = u % S5_GROUPS;
        const unsigned char* tb = wsb + a.off[R_S5T] + (size_t)(l * S5_GROUPS + g) * S5_TSTRIDE;
        const GAS bf16x8* M2 = (const GAS bf16x8*)(tb + S5_M2);
        const bf16* zr = Z + (size_t)((blk * 32 + r32) * 16) * ZN + ZC_UC + g * 16 + 8 * hi;
        f32x16 acc[4];
#pragma unroll
        for (int nb = 0; nb < 4; ++nb)
#pragma unroll
            for (int r = 0; r < 16; ++r) acc[nb][r] = 0.f;
#pragma unroll 4
        for (int sg = 0; sg < 16; ++sg) { const bf16x8 af = *(const GAS bf16x8*)(zr + (size_t)sg * ZN);
#pragma unroll
            for (int nb = 0; nb < 4; ++nb) acc[nb] = __builtin_amdgcn_mfma_f32_32x32x16_bf16(af, M2[((nb * 32 + r32) * 256 + sg * 16 + 8 * hi) >> 3], acc[nb], 0, 0, 0); }
#pragma unroll
        for (int nb = 0; nb < 4; ++nb)
#pragma unroll
            for (int r = 0; r < 16; ++r) E[((size_t)(blk * 32 + crow_dev(r, hi)) * S5_GROUPS + g) * 128 + nb * 32 + r32] = acc[nb][r];
    }
}
__device__ __forceinline__ void s5_scan_task(const float* E, bf16* XP, const float* l16, int g, int c0, int nch, float xr, float xi, float* ore, float* oim, int lane) {
    const float lr = l16[lane], li = l16[64 + lane];
    int c = 0;
    for (; c + 8 <= nch; c += 8) { float er[8], ei[8];
#pragma unroll
        for (int q = 0; q < 8; ++q) { const float* e = E + ((size_t)(c0 + c + q) * S5_GROUPS + g) * 128; er[q] = e[lane]; ei[q] = e[64 + lane]; }
#pragma unroll
        for (int q = 0; q < 8; ++q) { bf16* xp = XP + ((size_t)(c0 + c + q) * S5_GROUPS + g) * 128; xp[lane] = (bf16)f2bf(xr); xp[64 + lane] = (bf16)f2bf(xi);
            const float nr = lr * xr - li * xi + er[q], ni = lr * xi + li * xr + ei[q]; xr = nr; xi = ni; } }
    for (; c < nch; ++c) { const float* e = E + ((size_t)(c0 + c) * S5_GROUPS + g) * 128; bf16* xp = XP + ((size_t)(c0 + c) * S5_GROUPS + g) * 128; xp[lane] = (bf16)f2bf(xr); xp[64 + lane] = (bf16)f2bf(xi);
        const float nr = lr * xr - li * xi + e[lane], ni = lr * xi + li * xr + e[64 + lane]; xr = nr; xi = ni; }
    ore[lane] = xr; oim[lane] = xi;
}
constexpr int S5_NTASK = (BATCH + DEC_BATCH) * S5_GROUPS;
__device__ __forceinline__ void s5_scan_run(Frame& F, int l, int t, int lane) {
    const KArgs ap = kargs(); const auto& a = *ap; WS_OPAQUE(a);
    const int sq = t / S5_GROUPS, g = t % S5_GROUPS;
    const float* E = (const float*)(wsb + a.off[R_S5E]); bf16* XP = (bf16*)(wsb + a.off[R_S5X]);
    const float* l16 = (const float*)(wsb + a.off[R_S5T] + (size_t)(l * S5_GROUPS + g) * S5_TSTRIDE + S5_L16);
    if (sq < BATCH) { const size_t oo = (((size_t)l * BATCH + sq) * S5_GROUPS + g) * S5_STATE;
        s5_scan_task(E, XP, l16, g, sq * (LPP / 16), S5_PCH, 0.f, 0.f, a.out + O_SRP + oo, a.out + O_SIP + oo, lane); }
    else { const int bs = sq - BATCH; const size_t oo = (((size_t)l * DEC_BATCH + bs) * S5_GROUPS + g) * S5_STATE;
        s5_scan_task(E, XP, l16, g, SROW0 / 16 + bs * (DEC_SEQ / 16), DEC_SEQ / 16, a.in[I_SRE][oo + lane], a.in[I_SIM][oo + lane], a.out + O_SRS + oo, a.out + O_SIS + oo, lane); }
}
__device__ __forceinline__ float gelu_tanh(float x) { const float z = 0.7978845608028654f * (x + 0.044715f * x * x * x); const float t = 1.f - 2.f * __builtin_amdgcn_rcpf(__expf(2.f * z) + 1.f); return 0.5f * x * (1.f + t); }
__device__ __forceinline__ void p_s5_out(Frame& F, int l) {
    const KArgs ap = kargs(); const auto& a = *ap; WS_OPAQUE(a);
    const int tid = otid(), lane = tid & 63, wave = __builtin_amdgcn_readfirstlane(tid >> 6), r32 = lane & 31, hi = lane >> 5;
    const bf16* Z = (const bf16*)(wsb + a.off[R_Z]); const bf16* XP = (const bf16*)(wsb + a.off[R_S5X]); bf16* YC = (bf16*)(wsb + a.off[R_YC]);
    for (int u = F.vcu * NWAVES + wave; u < S5_NBLK * S5_GROUPS; u += F.G * NWAVES) {
        const int blk = u / S5_GROUPS, g = u % S5_GROUPS;
        const unsigned char* tb = wsb + a.off[R_S5T] + (size_t)(l * S5_GROUPS + g) * S5_TSTRIDE;
        const GAS bf16x8* M1 = (const GAS bf16x8*)(tb + S5_M1); const GAS bf16x8* M3 = (const GAS bf16x8*)(tb + S5_M3);
        const bf16* zr = Z + (size_t)((blk * 32 + r32) * 16) * ZN + ZC_UC + g * 16 + 8 * hi;
        const bf16* xr = XP + ((size_t)(blk * 32 + r32) * S5_GROUPS + g) * 128 + 8 * hi;
        f32x16 acc[8];
#pragma unroll
        for (int nb = 0; nb < 8; ++nb)
#pragma unroll
            for (int r = 0; r < 16; ++r) acc[nb][r] = 0.f;
#pragma unroll 2
        for (int sg = 0; sg < 16; ++sg) { const bf16x8 af = *(const GAS bf16x8*)(zr + (size_t)sg * ZN);
#pragma unroll
            for (int nb = 0; nb < 8; ++nb) acc[nb] = __builtin_amdgcn_mfma_f32_32x32x16_bf16(af, M1[((nb * 32 + r32) * 256 + sg * 16 + 8 * hi) >> 3], acc[nb], 0, 0, 0); }
#pragma unroll 2
        for (int s = 0; s < 8; ++s) { const bf16x8 af = *(const GAS bf16x8*)(xr + 16 * s);
#pragma unroll
            for (int nb = 0; nb < 8; ++nb) acc[nb] = __builtin_amdgcn_mfma_f32_32x32x16_bf16(af, M3[((nb * 32 + r32) * 128 + s * 16 + 8 * hi) >> 3], acc[nb], 0, 0, 0); }
#pragma unroll
        for (int nb = 0; nb < 8; ++nb)
#pragma unroll
            for (int r = 0; r < 16; ++r) { const int row = (blk * 32 + crow_dev(r, hi)) * 16 + 2 * nb + (r32 >> 4);
                YC[(size_t)row * WIDTH_C + g * 16 + (r32 & 15)] = (bf16)f2bf(gelu_tanh(acc[nb][r])); }
    }
}
__device__ __forceinline__ float wave_max(float v) {
#pragma unroll
    for (int o = 1; o < 64; o <<= 1) v = fmaxf(v, __shfl_xor(v, o));
    return v;
}
__device__ __forceinline__ int rdlane_i(int v, int i) { return __builtin_amdgcn_readlane(v, i); }
constexpr float NEG_BIG = -3.0e38f;
__device__ __forceinline__ unsigned fkey(float v) { const unsigned u = __builtin_bit_cast(unsigned, v); return (u & 0x80000000u) ? ~u : (u | 0x80000000u); }
__device__ __forceinline__ int mbcnt64(unsigned long long m) { return __builtin_amdgcn_mbcnt_hi((unsigned)(m >> 32), __builtin_amdgcn_mbcnt_lo((unsigned)m, 0)); }
template <int CTRL> __device__ __forceinline__ float dpp_f(float v) { return __builtin_bit_cast(float, __builtin_amdgcn_update_dpp(0, __builtin_bit_cast(int, v), CTRL, 0xf, 0xf, true)); }
__device__ __forceinline__ float wave_sum_dpp(float v) {
    v += dpp_f<0xB1>(v); v += dpp_f<0x4E>(v); v += dpp_f<0x141>(v); v += dpp_f<0x140>(v);
    return rdlane(v, 0) + rdlane(v, 16) + rdlane(v, 32) + rdlane(v, 48);
}
__device__ __forceinline__ float wave_max_dpp(float v) {
    v = fmaxf(v, dpp_f<0xB1>(v)); v = fmaxf(v, dpp_f<0x4E>(v)); v = fmaxf(v, dpp_f<0x141>(v)); v = fmaxf(v, dpp_f<0x140>(v));
    return fmaxf(fmaxf(rdlane(v, 0), rdlane(v, 16)), fmaxf(rdlane(v, 32), rdlane(v, 48)));
}

__device__ __forceinline__ void pro_wqs(Frame& F) {
    const KArgs ap = kargs(); const auto& a = *ap; WS_OPAQUE(a);
    const int tid = otid(), lane = tid & 63, wave = __builtin_amdgcn_readfirstlane(tid >> 6);
    bf16* WQ = (bf16*)(wsb + a.off[R_WQS]);
    for (int t = F.vcu * NWAVES + wave; t < DEPTH * 16 * 16; t += F.G * NWAVES) {
        const int l = t >> 8, hc = (t >> 4) & 15, kb = t & 15, k = kb * 64 + lane;
        const float* wr = a.in[I_PWQ] + ((size_t)l * D_MODEL + k) * PQ + hc * 128;
        float w[128];
#pragma unroll
        for (int d = 0; d < 128; d += 4) { const f32x4 v = *(const GAS f32x4*)(wr + d); w[d] = v.x; w[d + 1] = v.y; w[d + 2] = v.z; w[d + 3] = v.w; }
        const float* sk = a.in[I_PSK] + ((size_t)l * 16 + hc) * 128 * 128;
        bf16* o = WQ + ((size_t)l * PQ + hc * 128) * D_MODEL + k;
#pragma clang loop vectorize(disable) unroll(disable)
        for (int n = 0; n < 128; ++n) { const float* sr = sk + n * 128; float acc = 0.f;
#pragma unroll
            for (int d = 0; d < 128; ++d) acc += w[d] * sr[d];
            o[(size_t)n * D_MODEL] = (bf16)f2bf(acc); }
    }
}
__device__ __forceinline__ void pro_wrest(Frame& F) {
    const KArgs ap = kargs(); const auto& a = *ap; WS_OPAQUE(a);
    const int tid = otid(), lane = tid & 63, wave = __builtin_amdgcn_readfirstlane(tid >> 6);
    LAS float* scr = (LAS float*)(F.lds + RING_OFF + wave * 16384);
    const int gw = F.vcu * NWAVES + wave, NGW = F.G * NWAVES;
    bf16* WG = (bf16*)(wsb + a.off[R_WGLU]); bf16* WB = (bf16*)(wsb + a.off[R_WBR]); bf16* WO = (bf16*)(wsb + a.off[R_WOUT]);
    constexpr int IG = (512 / 64) * (1024 / 32), IB = IG, IO = (1024 / 64) * (1024 / 32), IL = IG + 3 * IB + IO;
    for (int it = gw; it < DEPTH * IL; it += NGW) { const int l = it / IL; int r = it % IL;
        if (r < IG) { transpose_item(a.in[I_WGLU] + (size_t)l * 512 * 1024, 1024, 512, WG + (size_t)l * 1024 * 512, 32 * (r % 32), 64 * (r / 32), CmGlu(), scr, lane); continue; } r -= IG;
        if (r < 3 * IB) { const int w = r / IB, q = r % IB; transpose_item(a.in[I_WBA + w] + (size_t)l * 512 * 1024, 1024, 512, WB + ((size_t)l * 3 + w) * 1024 * 512, 32 * (q % 32), 64 * (q / 32), CmId(), scr, lane); continue; } r -= 3 * IB;
        transpose_item(a.in[I_WOUT] + (size_t)l * 1024 * 1024, 1024, 1024, WO + (size_t)l * 1024 * 1024, 32 * (r % 32), 64 * (r / 32), CmId(), scr, lane); }
}
typedef float f32x2v __attribute__((ext_vector_type(2)));
constexpr size_t PEER_ROWS = (size_t)DEPTH * N_EXPERTS;
__device__ __forceinline__ void pro_peerw(Frame& F) {
    const KArgs ap = kargs(); const auto& a = *ap; WS_OPAQUE(a);
    const int tid = otid(), lane = tid & 63, wave = __builtin_amdgcn_readfirstlane(tid >> 6);
    float* SCL = (float*)(wsb + a.off[R_MISC]);
    for (size_t rw = (size_t)F.vcu * NWAVES + wave; rw < 2 * PEER_ROWS; rw += (size_t)F.G * NWAVES) {
        const int w = rw >= PEER_ROWS; const size_t row = rw - (w ? PEER_ROWS : 0);
        const GAS f32x4* src = (const GAS f32x4*)(a.in[I_PU + w] + row * D_MODEL) + 4 * lane;
        const f32x4 x0 = src[0], x1 = src[1], x2 = src[2], x3 = src[3];
        float mx = fmaxf(fmaxf(fmaxf(fabsf(x0.x), fabsf(x0.y)), fmaxf(fabsf(x0.z), fabsf(x0.w))), fmaxf(fmaxf(fabsf(x1.x), fabsf(x1.y)), fmaxf(fabsf(x1.z), fabsf(x1.w))));
        mx = fmaxf(mx, fmaxf(fmaxf(fmaxf(fabsf(x2.x), fabsf(x2.y)), fmaxf(fabsf(x2.z), fabsf(x2.w))), fmaxf(fmaxf(fabsf(x3.x), fabsf(x3.y)), fmaxf(fabsf(x3.z), fabsf(x3.w)))));
        mx = wave_max(mx);
        const float inv = mx > 0.f ? 416.f / mx : 0.f;
        v4u o; int t;
        t = __builtin_amdgcn_cvt_pk_fp8_f32(x0.x * inv, x0.y * inv, 0, false); t = __builtin_amdgcn_cvt_pk_fp8_f32(x0.z * inv, x0.w * inv, t, true); o.x = (unsigned)t;
        t = __builtin_amdgcn_cvt_pk_fp8_f32(x1.x * inv, x1.y * inv, 0, false); t = __builtin_amdgcn_cvt_pk_fp8_f32(x1.z * inv, x1.w * inv, t, true); o.y = (unsigned)t;
        t = __builtin_amdgcn_cvt_pk_fp8_f32(x2.x * inv, x2.y * inv, 0, false); t = __builtin_amdgcn_cvt_pk_fp8_f32(x2.z * inv, x2.w * inv, t, true); o.z = (unsigned)t;
        t = __builtin_amdgcn_cvt_pk_fp8_f32(x3.x * inv, x3.y * inv, 0, false); t = __builtin_amdgcn_cvt_pk_fp8_f32(x3.z * inv, x3.w * inv, t, true); o.w = (unsigned)t;
        *((GAS v4u*)(wsb + a.off[R_PU + w] + row * D_MODEL) + lane) = o;
        if (lane == 0) SCL[rw] = mx * (1.f / 416.f);
    }
}
__device__ __forceinline__ void fp8x16_to_f32(const v4u q, float (&f)[16]) {
#pragma unroll
    for (int d = 0; d < 4; ++d) { const int w = (int)(d == 0 ? q.x : d == 1 ? q.y : d == 2 ? q.z : q.w);
        const f32x2v lo = __builtin_amdgcn_cvt_pk_f32_fp8(w, false), hi = __builtin_amdgcn_cvt_pk_f32_fp8(w, true); f[4 * d] = lo.x; f[4 * d + 1] = lo.y; f[4 * d + 2] = hi.x; f[4 * d + 3] = hi.y; }
}
__device__ __forceinline__ void p_peer(Frame& F, int l, bool dry) {
    const KArgs ap = kargs(); const auto& a = *ap; WS_OPAQUE(a);
    const int tid = otid(), lane = tid & 63, wave = __builtin_amdgcn_readfirstlane(tid >> 6);
    const float* SC = (const float*)(wsb + a.off[R_SC]); const bf16* XN = (const bf16*)(wsb + a.off[R_XN]); float* X = (float*)(wsb + a.off[R_X]);
    const unsigned char* PU = wsb + a.off[R_PU] + (size_t)l * N_EXPERTS * D_MODEL; const unsigned char* PV = wsb + a.off[R_PV] + (size_t)l * N_EXPERTS * D_MODEL;
    const float* SCU = (const float*)(wsb + a.off[R_MISC]) + (size_t)l * N_EXPERTS; const float* SCV = SCU + PEER_ROWS;
    LAS float* stop = (LAS float*)(F.lds + RING_OFF + wave * 4096);
    LAS int* itop = (LAS int*)(stop + 256);
    LAS int* elist = itop + 256;
    LAS float* cf = (LAS float*)(elist + 128);
    for (int m = F.vcu * NWAVES + wave; m < RP; m += F.G * NWAVES) {
        if (!prow_valid(m)) continue;
        const float* sr = SC + (size_t)m * PQ;
        for (int hc = 0; hc < 16; hc += 2) {
            const float va0 = sr[hc * 128 + lane], va1 = sr[hc * 128 + 64 + lane], vb0 = sr[hc * 128 + 128 + lane], vb1 = sr[hc * 128 + 192 + lane];
            const unsigned ka0 = fkey(va0), ka1 = fkey(va1), kb0 = fkey(vb0), kb1 = fkey(vb1);
            unsigned pa = 0u, pb = 0u;
#pragma unroll
            for (int bit = 31; bit >= 0; --bit) { const unsigned ta = pa | (1u << bit), tb = pb | (1u << bit);
                const int ca = __builtin_popcountll(__ballot(ka0 >= ta)) + __builtin_popcountll(__ballot(ka1 >= ta)), cb = __builtin_popcountll(__ballot(kb0 >= tb)) + __builtin_popcountll(__ballot(kb1 >= tb));
                pa = ca >= 16 ? ta : pa; pb = cb >= 16 ? tb : pb; }
            { const unsigned long long m0 = __ballot(ka0 >= pa), m1 = __ballot(ka1 >= pa); const int r0 = mbcnt64(m0), r1 = __builtin_popcountll(m0) + mbcnt64(m1);
              if (ka0 >= pa && r0 < 16) { stop[hc * 16 + r0] = va0; itop[hc * 16 + r0] = lane; }
              if (ka1 >= pa && r1 < 16) { stop[hc * 16 + r1] = va1; itop[hc * 16 + r1] = lane + 64; } }
            { const unsigned long long m0 = __ballot(kb0 >= pb), m1 = __ballot(kb1 >= pb); const int r0 = mbcnt64(m0), r1 = __builtin_popcountll(m0) + mbcnt64(m1);
              if (kb0 >= pb && r0 < 16) { stop[(hc + 1) * 16 + r0] = vb0; itop[(hc + 1) * 16 + r0] = lane; }
              if (kb1 >= pb && r1 < 16) { stop[(hc + 1) * 16 + r1] = vb1; itop[(hc + 1) * 16 + r1] = lane + 64; } }
        }
        LDS_WAIT();
        for (int h = 0; h < 8; ++h) {
            const float s1 = stop[(2 * h) * 16 + (lane >> 2)];
            float c[4]; unsigned kc[4];
#pragma unroll
            for (int j = 0; j < 4; ++j) { c[j] = s1 + stop[(2 * h + 1) * 16 + (lane & 3) * 4 + j]; kc[j] = fkey(c[j]); }
            unsigned pp = 0u;
#pragma unroll
            for (int bit = 31; bit >= 0; --bit) { const unsigned tt = pp | (1u << bit);
                const int cn = __builtin_popcountll(__ballot(kc[0] >= tt)) + __builtin_popcountll(__ballot(kc[1] >= tt)) + __builtin_popcountll(__ballot(kc[2] >= tt)) + __builtin_popcountll(__ballot(kc[3] >= tt));
                pp = cn >= 16 ? tt : pp; }
            const float cmax = wave_max_dpp(fmaxf(fmaxf(c[0], c[1]), fmaxf(c[2], c[3])));
            float esum = 0.f; int base = 0;
#pragma unroll
            for (int j = 0; j < 4; ++j) { const bool sel = kc[j] >= pp; const unsigned long long mk = __ballot(sel); const int rk = base + mbcnt64(mk); base += __builtin_popcountll(mk);
                const float ex = (sel && rk < 16) ? __expf(c[j] - cmax) : 0.f; esum += ex;
                if (sel && rk < 16) { const int ci = lane * 4 + j; elist[h * 16 + rk] = itop[(2 * h) * 16 + (ci >> 4)] * N_KEYS + itop[(2 * h + 1) * 16 + (ci & 15)]; cf[h * 16 + rk] = ex; } }
            esum = wave_sum_dpp(esum); const float inv = __builtin_amdgcn_rcpf(esum);
            LDS_WAIT();
            if (lane < 16) cf[h * 16 + lane] *= inv;
        }
        LDS_WAIT();
        float hx[16], out[16];
        { float t[8]; unpack8(*(const GAS v4u*)(XN + (size_t)m * D_MODEL + 16 * lane), t);
#pragma unroll
          for (int j = 0; j < 8; ++j) hx[j] = t[j];
          unpack8(*(const GAS v4u*)(XN + (size_t)m * D_MODEL + 16 * lane + 8), t);
#pragma unroll
          for (int j = 0; j < 8; ++j) hx[8 + j] = t[j]; }
#pragma unroll
        for (int j = 0; j < 16; ++j) out[j] = 0.f;
        v4u uA[4], vA[4], uB[4], vB[4]; float suA[4], svA[4], cA[4], suB[4], svB[4], cB[4];
#define PEER_LOAD(U, V, SU, SV, CW, q0) do { _Pragma("unroll") for (int i = 0; i < 4; ++i) { const int e_ = elist[(q0) + i]; CW[i] = cf[(q0) + i]; \
            U[i] = *((const GAS v4u*)(PU + (size_t)e_ * D_MODEL) + lane); V[i] = *((const GAS v4u*)(PV + (size_t)e_ * D_MODEL) + lane); SU[i] = SCU[e_]; SV[i] = SCV[e_]; } } while (0)
#define PEER_COMP(U, V, SU, SV, CW) do { float d_[4]; _Pragma("unroll") for (int i = 0; i < 4; ++i) { float t[16]; d_[i] = 0.f; fp8x16_to_f32(U[i], t); \
            _Pragma("unroll") for (int j = 0; j < 16; ++j) d_[i] += hx[j] * t[j]; } \
            _Pragma("unroll") for (int i = 0; i < 4; ++i) d_[i] += dpp_f<0xB1>(d_[i]); _Pragma("unroll") for (int i = 0; i < 4; ++i) d_[i] += dpp_f<0x4E>(d_[i]); \
            _Pragma("unroll") for (int i = 0; i < 4; ++i) d_[i] += dpp_f<0x141>(d_[i]); _Pragma("unroll") for (int i = 0; i < 4; ++i) d_[i] += dpp_f<0x140>(d_[i]); \
            _Pragma("unroll") for (int i = 0; i < 4; ++i) { const float dd = (rdlane(d_[i], 0) + rdlane(d_[i], 16) + rdlane(d_[i], 32) + rdlane(d_[i], 48)) * SU[i]; const float cc = CW[i] * gelu_tanh(dd) * SV[i]; \
              float t[16]; fp8x16_to_f32(V[i], t); _Pragma("unroll") for (int j = 0; j < 16; ++j) out[j] += cc * t[j]; } } while (0)
        PEER_LOAD(uA, vA, suA, svA, cA, 0);
        for (int q = 0; q < 128; q += 8) {
            PEER_LOAD(uB, vB, suB, svB, cB, q + 4);
            PEER_COMP(uA, vA, suA, svA, cA);
            if (q + 8 < 128) PEER_LOAD(uA, vA, suA, svA, cA, q + 8);
            PEER_COMP(uB, vB, suB, svB, cB);
        }
#undef PEER_LOAD
#undef PEER_COMP
        if (!dry) { GAS f32x4* xr = (GAS f32x4*)(X + (size_t)m * D_MODEL + 16 * lane);
#pragma unroll
          for (int j = 0; j < 4; ++j) xr[j] = xr[j] + (f32x4){out[4 * j], out[4 * j + 1], out[4 * j + 2], out[4 * j + 3]}; }
    }
}
__device__ __forceinline__ void p_final(Frame& F) {
    const KArgs ap = kargs(); const auto& a = *ap; WS_OPAQUE(a);
    const int tid = otid(), lane = tid & 63, wave = __builtin_amdgcn_readfirstlane(tid >> 6);
    const float* X = (const float*)(wsb + a.off[R_X]); const float* g = a.in[I_FN];
    for (int m = F.vcu * NWAVES + wave; m < RP; m += F.G * NWAVES) {
        float* dst;
        if (m >= SROW0) dst = a.out + O_YS + (size_t)(m - SROW0) * D_MODEL;
        else { const int b = m / LPP, p = m % LPP; if (p < PADF + N_META || p >= PEND) continue; dst = a.out + O_YP + ((size_t)b * SEQ + (p - PADF - N_META)) * D_MODEL; }
        const GAS f32x4* xr = (const GAS f32x4*)(X + (size_t)m * D_MODEL) + lane;
        f32x4 v[4]; float s2 = 0.f;
#pragma unroll
        for (int j = 0; j < 4; ++j) { v[j] = xr[64 * j]; s2 += (v[j].x * v[j].x + v[j].y * v[j].y) + (v[j].z * v[j].z + v[j].w * v[j].w); }
        const float r = __builtin_amdgcn_rsqf(wave_sum(s2) * (1.f / D_MODEL) + EPSF);
        const GAS f32x4* gr = (const GAS f32x4*)g + lane; GAS f32x4* o = (GAS f32x4*)dst + lane;
#pragma unroll
        for (int j = 0; j < 4; ++j) { const f32x4 gg = gr[64 * j]; o[64 * j] = (f32x4){v[j].x * r * gg.x, v[j].y * r * gg.y, v[j].z * r * gg.z, v[j].w * r * gg.w}; }
    }
}

__device__ __forceinline__ void p_prologue(Frame& F) {
    const KArgs ap = kargs(); const auto& a = *ap; WS_OPAQUE(a);
    const int tid = otid(), lane = tid & 63, wave = __builtin_amdgcn_readfirstlane(tid >> 6);
    LAS float* scr = (LAS float*)(F.lds + RING_OFF + wave * 16384);
    const int gw = F.vcu * NWAVES + wave, NGW = F.G * NWAVES;
    if (a.pro_mask & PM_X) {
        float* X = (float*)(wsb + a.off[R_X]);
        for (int m = gw; m < RP; m += NGW) {
            const float* src = nullptr;
            if (m >= SROW0) src = a.in[I_XS] + (size_t)(m - SROW0) * D_MODEL;
            else { const int b = m / LPP, p = m % LPP; if (p >= PADF && p < PEND) { const int pos = p - PADF; src = pos < N_META ? a.in[I_META] + (size_t)pos * D_MODEL : a.in[I_XP] + ((size_t)b * SEQ + pos - N_META) * D_MODEL; } }
            GAS f32x4* o = (GAS f32x4*)(X + (size_t)m * D_MODEL) + lane;
#pragma unroll
            for (int j = 0; j < 4; ++j) o[64 * j] = src ? ((const GAS f32x4*)src)[lane + 64 * j] : (f32x4){0.f, 0.f, 0.f, 0.f};
        }
    }
    if (a.pro_mask & PM_WIN) {
        bf16* WT = (bf16*)(wsb + a.off[R_WIN]);
        constexpr int IPL = (D_MODEL / 64) * (ZN / 32);
        for (int it = gw; it < DEPTH * IPL; it += NGW) { const int l = it / IPL, r = it % IPL, kb = r / (ZN / 32), nb = r % (ZN / 32);
            transpose_item(a.in[I_WIN] + (size_t)l * D_MODEL * D_IN, D_IN, D_MODEL, WT + (size_t)l * ZN * D_MODEL, 32 * nb, 64 * kb, CmWin(), scr, lane); }
    }
    __syncthreads();
    if (a.pro_mask & PM_TABLES) s5_tables(F);
    __syncthreads();
    if (a.pro_mask & PM_WREST) pro_wrest(F);
    if (a.pro_mask & PM_WQS) pro_wqs(F);
    if (a.pro_mask & PM_PEERW) pro_peerw(F);
}

__global__ void __launch_bounds__(NTHR, 2) mk_fwd(Args args) {
    extern __shared__ __attribute__((aligned(16))) unsigned char lds[];
    Frame F;
    F.lds = (LAS unsigned char*)lds; F.MISC = (volatile LAS unsigned*)(F.lds + MISC_OFF);
    F.G = gridDim.x; { const int bx = blockIdx.x; F.vcu = (F.G % 8 == 0) ? (bx % 8) * (F.G / 8) + bx / 8 : bx; }
    F.ctl = (gu32*)args.ws;
    for (int u = threadIdx.x; u < (LDS_BYTES - LDSCTL_OFF) / 4; u += NTHR) ((LAS unsigned*)(F.lds + LDSCTL_OFF))[u] = 0u;
    __syncthreads();
    const int lo = args.ph_lo, hi = args.ph_hi;
    unsigned* barw = (unsigned*)(F.ctl + CW_BAR) + (size_t)args.bar_region * XCD_BAR_WORDS;
    XcdBarrier bar; bar.bar = barw; bar.x = 0; bar.st = nullptr;
    if (hi - lo > 1) bar = xcd_barrier_post(barw, F.MISC + 8);
#define IN(k) (lo <= (k) && (k) < hi)
#ifndef MK_REP
#define MK_REP -1
#endif
#define SEAM(k) do { if ((k) + 1 < hi) { xcd_barrier(bar); if ((MK_REP) == 300) xcd_barrier(bar); } } while (0)
#ifndef MK_REP
#define MK_REP -1
#endif
    if (IN(PH_PRO)) { for (int rep_ = 0; rep_ < ((MK_REP) == 200 ? 2 : 1); ++rep_) { p_prologue(F); __syncthreads(); } SEAM(PH_PRO); }
#ifndef MK_REP
#define MK_REP -1
#endif
#define REPEAT(ph) for (int rep_ = 0; rep_ < ((MK_REP) == (ph) ? 2 : 1); ++rep_)
    for (int l = 0; l < DEPTH; ++l) {
        const int pb = 1 + l * NPL;
        if (IN(pb + PL_NORM1)) { REPEAT(PL_NORM1) p_norm(F, l, I_N1); SEAM(pb + PL_NORM1); }
        if (IN(pb + PL_GEMM_IN)) {
            const KArgs ap = kargs(); const auto& a = *ap; WS_OPAQUE(a);
            pg8::Gemm g{(const pg8::bf16_t*)(wsb + a.off[R_XN]), (const pg8::bf16_t*)(wsb + a.off[R_WIN]) + (size_t)l * ZN * D_MODEL, RP, ZN, D_MODEL};
            pg8::StaticOrder S; S.init(RP, ZN, F.G, (int)blockIdx.x);
            pg8::EpiBf16<0> E{(pg8::bf16_t*)(wsb + a.off[R_Z]), ZN, nullptr, 0, 0, 1.f};
            REPEAT(PL_GEMM_IN) pg8::gemm_phase<pg8::EpiBf16<0>, pg8::StaticOrder, true, true>(F.lds + RING_OFF, g, S, E);
            SEAM(pb + PL_GEMM_IN);
        }
        if (IN(pb + PL_ZPOST)) { REPEAT(PL_ZPOST) p_zpost(F, l); SEAM(pb + PL_ZPOST); }
        if (IN(pb + PL_LOCAL)) { REPEAT(104) p_gdn_chunk(F, l); REPEAT(103) p_s5_e(F, l); SEAM(pb + PL_LOCAL); }
        if (IN(pb + PL_MIX)) {
            REPEAT(100) p_gdn_chain(F, l);
            REPEAT(102) { const int tid = otid(), lane = tid & 63, wave = __builtin_amdgcn_readfirstlane(tid >> 6), NGW = F.G * NWAVES;
              for (int t = (F.vcu * NWAVES + wave + NGW - 256) % NGW; t < S5_NTASK; t += NGW) s5_scan_run(F, l, t, lane); }
            REPEAT(101) p_attention(F, l + DEPTH * rep_, lds);
            SEAM(pb + PL_MIX); }
        if (IN(pb + PL_MIXPOST)) { REPEAT(PL_MIXPOST) { p_mixpost_a(F, l); p_mixpost_b(F, l); p_s5_out(F, l); } SEAM(pb + PL_MIXPOST); }
        if (IN(pb + PL_GEMM_GLU)) REPEAT(PL_GEMM_GLU) {
            const KArgs ap = kargs(); const auto& a = *ap; WS_OPAQUE(a);
            { pg8::Gemm g{(const pg8::bf16_t*)(wsb + a.off[R_YC]), (const pg8::bf16_t*)(wsb + a.off[R_WGLU]) + (size_t)l * 1024 * 512, RP, 1024, 512};
              pg8::StaticOrder S; S.init(RP, 1024, F.G, (int)blockIdx.x); pg8::EpiGlu E{(pg8::bf16_t*)(wsb + a.off[R_OC]), WIDTH_C};
              pg8::gemm_phase<pg8::EpiGlu, pg8::StaticOrder, true, true>(F.lds + RING_OFF, g, S, E); }
            { pg8::Gemm g{(const pg8::bf16_t*)(wsb + a.off[R_OA]), (const pg8::bf16_t*)(wsb + a.off[R_WBR]) + ((size_t)l * 3 + 0) * 1024 * 512, RP, 1024, 512};
              pg8::StaticOrder S; S.init(RP, 1024, F.G, (int)blockIdx.x); pg8::EpiMerge<0> E{(float*)(wsb + a.off[R_MRG]), nullptr, (const pg8::bf16_t*)(wsb + a.off[R_Z]) + ZC_GATE, ZN};
              pg8::gemm_phase<pg8::EpiMerge<0>, pg8::StaticOrder, true, true>(F.lds + RING_OFF, g, S, E); }
            { pg8::Gemm g{(const pg8::bf16_t*)(wsb + a.off[R_OBN]), (const pg8::bf16_t*)(wsb + a.off[R_WBR]) + ((size_t)l * 3 + 1) * 1024 * 512, RP, 1024, 512};
              pg8::StaticOrder S; S.init(RP, 1024, F.G, (int)blockIdx.x); pg8::EpiMerge<1> E{(float*)(wsb + a.off[R_MRG]), nullptr, (const pg8::bf16_t*)(wsb + a.off[R_Z]) + ZC_GATE + 1024, ZN};
              pg8::gemm_phase<pg8::EpiMerge<1>, pg8::StaticOrder, true, true>(F.lds + RING_OFF, g, S, E); }
            if (rep_ == ((MK_REP) == PL_GEMM_GLU ? 1 : 0)) SEAM(pb + PL_GEMM_GLU); }
        if (IN(pb + PL_GEMM_BRC)) {
            const KArgs ap = kargs(); const auto& a = *ap; WS_OPAQUE(a);
            pg8::Gemm g{(const pg8::bf16_t*)(wsb + a.off[R_OC]), (const pg8::bf16_t*)(wsb + a.off[R_WBR]) + ((size_t)l * 3 + 2) * 1024 * 512, RP, 1024, 512};
            pg8::StaticOrder S; S.init(RP, 1024, F.G, (int)blockIdx.x); pg8::EpiMerge<2> E{(float*)(wsb + a.off[R_MRG]), (pg8::bf16_t*)(wsb + a.off[R_MRGB]), (const pg8::bf16_t*)(wsb + a.off[R_Z]) + ZC_GATE + 2048, ZN};
            REPEAT(PL_GEMM_BRC) pg8::gemm_phase<pg8::EpiMerge<2>, pg8::StaticOrder, true, true>(F.lds + RING_OFF, g, S, E);
            SEAM(pb + PL_GEMM_BRC); }
        if (IN(pb + PL_GEMM_OUT)) {
            const KArgs ap = kargs(); const auto& a = *ap; WS_OPAQUE(a);
            pg8::Gemm g{(const pg8::bf16_t*)(wsb + a.off[R_MRGB]), (const pg8::bf16_t*)(wsb + a.off[R_WOUT]) + (size_t)l * 1024 * 1024, RP, 1024, 1024};
            pg8::StaticOrder S; S.init(RP, 1024, F.G, (int)blockIdx.x);
            REPEAT(PL_GEMM_OUT) { pg8::EpiResid E{(float*)(wsb + a.off[R_X]), D_MODEL, (MK_REP) == PL_GEMM_OUT && rep_ == 0};
            pg8::gemm_phase<pg8::EpiResid, pg8::StaticOrder, true, true>(F.lds + RING_OFF, g, S, E); }
            SEAM(pb + PL_GEMM_OUT); }
        if (IN(pb + PL_NORM2)) { REPEAT(PL_NORM2) p_norm(F, l, I_N2); SEAM(pb + PL_NORM2); }
        if (IN(pb + PL_GEMM_PEER)) {
            const KArgs ap = kargs(); const auto& a = *ap; WS_OPAQUE(a);
            pg8::Gemm g{(const pg8::bf16_t*)(wsb + a.off[R_XN]), (const pg8::bf16_t*)(wsb + a.off[R_WQS]) + (size_t)l * PQ * D_MODEL, RP, PQ, D_MODEL};
            pg8::StaticOrder S; S.init(RP, PQ, F.G, (int)blockIdx.x); pg8::EpiF32 E{(float*)(wsb + a.off[R_SC]), PQ};
            REPEAT(PL_GEMM_PEER) pg8::gemm_phase<pg8::EpiF32, pg8::StaticOrder, true, true>(F.lds + RING_OFF, g, S, E);
            SEAM(pb + PL_GEMM_PEER); }
        if (IN(pb + PL_PEER)) { REPEAT(PL_PEER) p_peer(F, l, (MK_REP) == PL_PEER && rep_ == 0); SEAM(pb + PL_PEER); }
    }
    if (IN(PH_FINAL)) p_final(F);
#undef IN
#undef SEAM
}
}
#ifndef MK_ONE_LAUNCH
#define MK_ONE_LAUNCH 1
#endif
static int mk_grid = 0;
static bool mk_setup() {
    if (mk_grid) return mk_grid > 0;
    int dev = 0, cus = 0;
    if (hipGetDevice(&dev) != hipSuccess || hipDeviceGetAttribute(&cus, hipDeviceAttributeMultiprocessorCount, dev) != hipSuccess) { mk_grid = -1; return false; }
    if (hipFuncSetAttribute((const void*)mk::mk_fwd, hipFuncAttributeMaxDynamicSharedMemorySize, mk::LDS_BYTES) != hipSuccess) { fprintf(stderr, "kernel_launch: hipFuncSetAttribute failed\n"); mk_grid = -1; return false; }
    int per_cu = 0;
    if (hipOccupancyMaxActiveBlocksPerMultiprocessor(&per_cu, (const void*)mk::mk_fwd, mk::NTHR, mk::LDS_BYTES) != hipSuccess || per_cu < 1) { fprintf(stderr, "kernel_launch: occupancy query says %d workgroups per CU\n", per_cu); }
    (void)hipGetLastError();
    mk_grid = cus;
    return true;
}
static void mk_launch(mk::Args a, int lo, int hi, int region, hipStream_t stream) {
    a.ph_lo = lo; a.ph_hi = hi; a.bar_region = region;
    hipLaunchKernelGGL(mk::mk_fwd, dim3(mk_grid), dim3(mk::NTHR), mk::LDS_BYTES, stream, a);
    hipError_t e = hipPeekAtLastError(); if (e != hipSuccess) fprintf(stderr, "kernel_launch: launch failed: %s\n", hipGetErrorName(e));
}
extern "C" void kernel_launch(void* const* d_in, const int* in_sizes, int n_in, void* d_out, int out_size, void* d_ws, size_t ws_size, hipStream_t stream) {
    if (n_in != N_INPUTS || (size_t)out_size != (size_t)O_END) { fprintf(stderr, "kernel_launch: unexpected n_in %d / out_size %d\n", n_in, out_size); return; }
    if (!mk_setup()) return;
    const size_t MiB = 1u << 20;
    unsigned char* ws = (unsigned char*)d_ws;
    mk::Args a{};
    for (int i = 0; i < N_INPUTS; ++i) a.in[i] = (const float*)d_in[i];
    a.out = (float*)d_out; a.ws = ws;
    { using namespace mk; const struct { int r; size_t mib; } map[] = { {R_WIN, 1}, {R_WGLU, 59}, {R_WBR, 63}, {R_WOUT, 75}, {R_WQS, 83}, {R_S5T, 99}, {R_PU, 132}, {R_PV, 196}, {R_MISC, 260}, {R_OBN, 262}, {R_X, 388}, {R_XN, 456},
        {R_Z, 490}, {R_SC, 490}, {R_QN, 737}, {R_KN, 754}, {R_QKVB, 771}, {R_BG, 822}, {R_O, 823}, {R_MRGB, 823}, {R_OA, 857}, {R_OB, 874}, {R_GDN, 891}, {R_MRG, 891},
        {R_S5E, 986}, {R_YC, 986}, {R_S5X, 1003}, {R_OC, 1012} };
      for (auto& e : map) a.off[e.r] = e.mib * MiB; }
    if (1029 * MiB > ws_size) { fprintf(stderr, "kernel_launch: workspace too small (%zu)\n", ws_size); return; }
    if (hipMemsetAsync(ws, 0, mk::CTL_BYTES, stream) != hipSuccess) { fprintf(stderr, "kernel_launch: memset failed\n"); return; }
    a.pro_mask = mk::PM_X | mk::PM_WIN | mk::PM_TABLES | mk::PM_WREST | mk::PM_WQS | mk::PM_PEERW;
#if MK_ONE_LAUNCH
    mk_launch(a, 0, mk::PH_END, 0, stream);
#else
    int region = 0;
    mk_launch(a, mk::PH_PRO, mk::PH_PRO + 1, region++, stream);
    for (int l = 0; l < DEPTH; ++l) { const int pb = 1 + l * mk::NPL;
        for (int ph = mk::PL_NORM1; ph <= mk::PL_PEER; ++ph) { if (ph == mk::PL_GEMM_BRA || ph == mk::PL_GEMM_BRB) continue; mk_launch(a, pb + ph, pb + ph + 1, region++, stream); } }
    mk_launch(a, mk::PH_FINAL, mk::PH_END, region++, stream);
#endif
}
```

```cpp
#include <hip/hip_runtime.h>
#include <cstdio>
#include <cstdint>
#include <utility>
#define MK_ONE_LAUNCH 1
#ifndef D_MODEL
#define D_MODEL 1024
#define BATCH 2
#define SEQ 8192
#define DEPTH 4
#define DEC_BATCH 16
#define DEC_SEQ 32
#define PAST_LEN 1024
#define N_HEADS_A 4
#define HEAD_DIM_A 64
#define N_HEADS_B 4
#define HEAD_DIM_B 128
#define S5_GROUPS 32
#define S5_STATE 64
#define PEER_HEADS 8
#define PEER_QDIM 256
#define N_KEYS 128
#endif
#define CHUNK 64
#define N_META 16
#define EPSF 1e-6f
#define NUM_BUCKETS 32
#define CONV_W 4
#define S5_GROUP 16
#define PEER_TOPK 16
#define N_EXPERTS (N_KEYS * N_KEYS)
#define WIDTH_A (N_HEADS_A * 2 * HEAD_DIM_A)
#define WIDTH_B (N_HEADS_B * HEAD_DIM_B)
#define WIDTH_C (S5_GROUPS * S5_GROUP)
#define OFF_QA 0
#define OFF_KA (OFF_QA + WIDTH_A)
#define OFF_VA (OFF_KA + WIDTH_A)
#define OFF_QKVB (OFF_VA + WIDTH_A)
#define OFF_GB (OFF_QKVB + 3 * WIDTH_B)
#define OFF_BETA (OFF_GB + WIDTH_B)
#define OFF_ALPHA (OFF_BETA + N_HEADS_B)
#define OFF_UC (OFF_ALPHA + N_HEADS_B)
#define OFF_GATE (OFF_UC + WIDTH_C)
#define D_IN (OFF_GATE + 3 * D_MODEL)
#define LP (N_META + SEQ)
#define NP (BATCH * LP)
#define NS (DEC_BATCH * DEC_SEQ)
#define NT (NP + NS)
#define PQ (PEER_HEADS * PEER_QDIM)

enum { I_XP, I_XS, I_CK, I_CV, I_SCONV, I_SDELTA, I_SRE, I_SIM, I_META, I_REL, I_N1, I_N2, I_FN, I_WIN, I_QN, I_KN, I_LQK, I_SUBLN, I_CONVW, I_ALOG, I_DTB, I_GDNN,
       I_AR, I_AI, I_BR, I_BI, I_CR, I_CI, I_SD, I_LDT, I_WGLU, I_WBA, I_WBB, I_WBC, I_WOUT, I_PWQ, I_PSK, I_PU, I_PV, N_INPUTS };
#define O_YP 0
#define O_YS (O_YP + (size_t)BATCH * SEQ * D_MODEL)
#define O_KP (O_YS + (size_t)NS * D_MODEL)
#define O_VP (O_KP + (size_t)DEPTH * NP * WIDTH_A)
#define O_KS (O_VP + (size_t)DEPTH * NP * WIDTH_A)
#define O_VS (O_KS + (size_t)DEPTH * NS * WIDTH_A)
#define O_CP (O_VS + (size_t)DEPTH * NS * WIDTH_A)
#define O_CS (O_CP + (size_t)DEPTH * BATCH * (CONV_W - 1) * 3 * WIDTH_B)
#define O_DP (O_CS + (size_t)DEPTH * DEC_BATCH * (CONV_W - 1) * 3 * WIDTH_B)
#define O_DS (O_DP + (size_t)DEPTH * BATCH * N_HEADS_B * HEAD_DIM_B * HEAD_DIM_B)
#define O_SRP (O_DS + (size_t)DEPTH * DEC_BATCH * N_HEADS_B * HEAD_DIM_B * HEAD_DIM_B)
#define O_SIP (O_SRP + (size_t)DEPTH * BATCH * S5_GROUPS * S5_STATE)
#define O_SRS (O_SIP + (size_t)DEPTH * BATCH * S5_GROUPS * S5_STATE)
#define O_SIS (O_SRS + (size_t)DEPTH * DEC_BATCH * S5_GROUPS * S5_STATE)
#define O_END (O_SIS + (size_t)DEPTH * DEC_BATCH * S5_GROUPS * S5_STATE)

namespace pg8 {
#define PG8_LAS __attribute__((address_space(3)))
typedef unsigned short bf16_t;
typedef short bf16x8 __attribute__((ext_vector_type(8)));
typedef float f32x4 __attribute__((ext_vector_type(4)));
typedef unsigned u32x4 __attribute__((ext_vector_type(4)));
constexpr int BM = 256, BK = 64, HALF = 128, HTB = HALF * BK * 2  , STAGE_BYTES = 8 * HTB, NXCD = 8, WGM = 8;

__host__ __device__ __forceinline__ int lds_byte(int r, int c) { const int st = (r >> 4) * 2 + (c >> 5), rr = r & 15, cc = c & 31, ob = rr * 64 + cc * 2; return st * 1024 + (ob ^ (((ob >> 9) & 1) << 5)); }
__host__ __device__ __forceinline__ void stage_rc(int b, int& R, int& C) { const int st = b / 1024, sb = b % 1024, swz = sb ^ (((sb >> 9) & 1) << 5); R = (st >> 1) * 16 + swz / 64; C = (st & 1) * 32 + (swz % 64) / 2; }
__host__ __device__ __forceinline__ int perm32(int rho) { const int n = rho >> 4, i = rho & 15; return 8 * (i >> 2) + 4 * n + (i & 3); }

struct Unit { int pm, pn; };
struct Gemm { const bf16_t* A; const bf16_t* Bt; int M, N, K; };

struct StaticOrder {
    int nM, nN, nwg, G, c;
    __host__ __device__ void init(int M, int N, int G_, int c_) { nM = M / BM; nN = N / BM; nwg = nM * nN; G = G_; c = c_; }
    __host__ __device__ bool next(int i, Unit& u) const {
        const long L = (long)i * G + c; if (L >= nwg) return false;
        int wgid = (int)L; { const int q = nwg / NXCD, r = nwg % NXCD, xcd = wgid % NXCD, off = wgid / NXCD; wgid = (xcd < r ? xcd * (q + 1) : r * (q + 1) + (xcd - r) * q) + off; }
        const int nig = WGM * nN, gid = wgid / nig, fm = gid * WGM, gsz = (nM - fm) < WGM ? (nM - fm) : WGM;
        u.pm = fm + ((wgid % nig) % gsz); u.pn = (wgid % nig) / gsz; return true;
    }
    __device__ __forceinline__ void a_ready(const Unit&) const {}
    __device__ __forceinline__ void done(const Unit&) const {}
};

__device__ __forceinline__ unsigned cvt_pk_bf16(float lo, float hi) { unsigned r; asm volatile("v_cvt_pk_bf16_f32 %0, %1, %2" : "=v"(r) : "v"(lo), "v"(hi)); return r; }
typedef float f32x2 __attribute__((ext_vector_type(2)));
__device__ __forceinline__ f32x2 gelu_pk(f32x2 v) {
    const f32x2 av = __builtin_elementwise_abs(v), d = av * 0.2316418882f + 1.0f;
    f32x2 t; t.x = __builtin_amdgcn_rcpf(d.x); t.y = __builtin_amdgcn_rcpf(d.y);
    f32x2 q = t * 0.5307027145f + (-0.7265760135f); q = q * t + 0.7107068705f; q = q * t + (-0.142248368f); q = q * t + 0.127414796f; q = q * t;
    const f32x2 s = (v * v) * (-0.72134752044f);
    f32x2 e; e.x = __builtin_amdgcn_exp2f(s.x); e.y = __builtin_amdgcn_exp2f(s.y);
    const f32x2 m = v * (q * e), r = v - m;
    f32x2 o; o.x = v.x < 0.f ? m.x : r.x; o.y = v.y < 0.f ? m.y : r.y; return o;
}

template <int ACT  > struct EpiBf16 {
    static constexpr bool PERM = true, AFTER_DRAIN = false; static_assert(ACT == 0 || ACT == 1, "EpiBf16: ACT is 0 (none) or 1 (gelu_pk)");
    bf16_t* O; int ldc; const float* bias; int split_cols; size_t split_stride; float scale0;
    __device__ __forceinline__ void operator()(const f32x4 (&acc)[2][2][4][2], const Unit& u, int wr, int wc, int fr, int fq) const {
        const int row0 = u.pm * BM + wr * 64 + fr; int colt = u.pn * BM; bf16_t* base = O;
        float sc = 1.f; if (split_cols) { const int t = colt / split_cols; base += (size_t)t * split_stride; colt -= t * split_cols; if (t == 0) sc = scale0; }
        const int col0 = colt + wc * 32 + 8 * fq, bcol0 = u.pn * BM + wc * 32 + 8 * fq;
        f32x4 bv[2][2];
#pragma unroll
        for (int bj = 0; bj < 2; ++bj)
#pragma unroll
            for (int n = 0; n < 2; ++n) bv[bj][n] = bias ? *(const f32x4*)(bias + bcol0 + bj * HALF + 4 * n) : (f32x4){0.f, 0.f, 0.f, 0.f};
#pragma unroll
        for (int ai = 0; ai < 2; ++ai)
#pragma unroll
            for (int m = 0; m < 4; ++m) { bf16_t* rowp = base + (size_t)(row0 + ai * HALF + m * 16) * ldc + col0;
#pragma unroll
                for (int bj = 0; bj < 2; ++bj) { f32x4 v0 = acc[ai][bj][m][0] + bv[bj][0], v1 = acc[ai][bj][m][1] + bv[bj][1];
                    if (ACT == 1) { f32x2 a = gelu_pk((f32x2){v0[0], v0[1]}), b = gelu_pk((f32x2){v0[2], v0[3]}), c = gelu_pk((f32x2){v1[0], v1[1]}), d = gelu_pk((f32x2){v1[2], v1[3]});
                        v0 = (f32x4){a.x, a.y, b.x, b.y}; v1 = (f32x4){c.x, c.y, d.x, d.y}; }
                    v0 = v0 * sc; v1 = v1 * sc; u32x4 w; w.x = cvt_pk_bf16(v0[0], v0[1]); w.y = cvt_pk_bf16(v0[2], v0[3]); w.z = cvt_pk_bf16(v1[0], v1[1]); w.w = cvt_pk_bf16(v1[2], v1[3]);
                    *(u32x4*)(rowp + bj * HALF) = w; } }
    }
};

__device__ __forceinline__ float epi_sigm(float x) { return __builtin_amdgcn_rcpf(1.f + __expf(-x)); }
struct EpiGlu {
    static constexpr bool PERM = false, AFTER_DRAIN = false;
    bf16_t* O; int ldo;
    __device__ __forceinline__ void operator()(const f32x4 (&acc)[2][2][4][2], const Unit& u, int wr, int wc, int fr, int fq) const {
        const int row0 = u.pm * BM + wr * 64 + fr;
#pragma unroll
        for (int ai = 0; ai < 2; ++ai)
#pragma unroll
            for (int m = 0; m < 4; ++m) { bf16_t* rowp = O + (size_t)(row0 + ai * HALF + m * 16) * ldo + 4 * fq;
#pragma unroll
                for (int bj = 0; bj < 2; ++bj) { const int G = u.pn * 8 + bj * 4 + wc; const f32x4 av = acc[ai][bj][m][0], gv = acc[ai][bj][m][1];
                    typedef unsigned u32x2 __attribute__((ext_vector_type(2))); u32x2 w;
                    w.x = cvt_pk_bf16(av[0] * epi_sigm(gv[0]), av[1] * epi_sigm(gv[1])); w.y = cvt_pk_bf16(av[2] * epi_sigm(gv[2]), av[3] * epi_sigm(gv[3]));
                    *(u32x2*)(rowp + 16 * G) = w; } }
    }
};
template <int MODE> struct EpiMerge {
    static constexpr bool PERM = true, AFTER_DRAIN = false;
    float* M; bf16_t* Mb; const bf16_t* Zg; int ldz;
    __device__ __forceinline__ void operator()(const f32x4 (&acc)[2][2][4][2], const Unit& u, int wr, int wc, int fr, int fq) const {
        const int row0 = u.pm * BM + wr * 64 + fr, col0 = u.pn * BM + wc * 32 + 8 * fq;
#pragma unroll
        for (int ai = 0; ai < 2; ++ai)
#pragma unroll
            for (int m = 0; m < 4; ++m) { const size_t row = (size_t)(row0 + ai * HALF + m * 16);
#pragma unroll
                for (int bj = 0; bj < 2; ++bj) { const int col = col0 + bj * HALF;
                    const u32x4 gz = *(const u32x4*)(Zg + row * ldz + col);
                    float g[8]; g[0] = __builtin_bit_cast(float, gz.x << 16); g[1] = __builtin_bit_cast(float, gz.x & 0xffff0000u); g[2] = __builtin_bit_cast(float, gz.y << 16); g[3] = __builtin_bit_cast(float, gz.y & 0xffff0000u);
                    g[4] = __builtin_bit_cast(float, gz.z << 16); g[5] = __builtin_bit_cast(float, gz.z & 0xffff0000u); g[6] = __builtin_bit_cast(float, gz.w << 16); g[7] = __builtin_bit_cast(float, gz.w & 0xffff0000u);
                    f32x4 v0 = acc[ai][bj][m][0], v1 = acc[ai][bj][m][1];
#pragma unroll
                    for (int j = 0; j < 4; ++j) { v0[j] *= epi_sigm(g[j]); v1[j] *= epi_sigm(g[4 + j]); }
                    float* mp = M + row * 1024 + col;
                    if (MODE != 0) { v0 += *(const f32x4*)mp; v1 += *(const f32x4*)(mp + 4); }
                    if (MODE != 2) { *(f32x4*)mp = v0; *(f32x4*)(mp + 4) = v1; }
                    else { u32x4 w; w.x = cvt_pk_bf16(v0[0], v0[1]); w.y = cvt_pk_bf16(v0[2], v0[3]); w.z = cvt_pk_bf16(v1[0], v1[1]); w.w = cvt_pk_bf16(v1[2], v1[3]); *(u32x4*)(Mb + row * 1024 + col) = w; } } }
    }
};
struct EpiResid {
    static constexpr bool PERM = false, AFTER_DRAIN = false;
    float* X; int ldx; bool dry;
    __device__ __forceinline__ void operator()(const f32x4 (&acc)[2][2][4][2], const Unit& u, int wr, int wc, int fr, int fq) const {
        const int row0 = u.pm * BM + wr * 64 + fr, col0 = u.pn * BM + wc * 32 + 4 * fq;
#pragma unroll
        for (int ai = 0; ai < 2; ++ai)
#pragma unroll
            for (int m = 0; m < 4; ++m) { const int row = row0 + ai * HALF + m * 16;
                bool ok = true; if (row < 16896) { const int p = row % 8448; ok = p >= 48 && p < 8256; }
                if (ok && !dry) { float* rowp = X + (size_t)row * ldx + col0;
#pragma unroll
                    for (int bj = 0; bj < 2; ++bj)
#pragma unroll
                        for (int n = 0; n < 2; ++n) { f32x4* p4 = (f32x4*)(rowp + bj * HALF + n * 16); *p4 = *p4 + acc[ai][bj][m][n]; } } }
    }
};
struct EpiF32 {
    static constexpr bool PERM = false, AFTER_DRAIN = false;
    float* C; int ldc;
    __device__ __forceinline__ void operator()(const f32x4 (&acc)[2][2][4][2], const Unit& u, int wr, int wc, int fr, int fq) const {
        const int row0 = u.pm * BM + wr * 64 + fr, col0 = u.pn * BM + wc * 32 + 4 * fq;
#pragma unroll
        for (int ai = 0; ai < 2; ++ai)
#pragma unroll
            for (int m = 0; m < 4; ++m) { float* rowp = C + (size_t)(row0 + ai * HALF + m * 16) * ldc + col0;
#pragma unroll
                for (int bj = 0; bj < 2; ++bj)
#pragma unroll
                    for (int n = 0; n < 2; ++n) *(f32x4*)(rowp + bj * HALF + n * 16) = acc[ai][bj][m][n]; }
    }
};

template <class Epi, class Sched, bool ALIGN_EPI = false, bool SP2 = false>
__device__ __forceinline__ void gemm_phase(PG8_LAS unsigned char* lds, const Gemm g, const Sched& S, const Epi& E, int wv) {
    unsigned om_ = ~0u; asm volatile("" : "+s"(om_), "+s"(wv)); int tid_ = wv * 64 + (int)__builtin_amdgcn_mbcnt_hi(om_, __builtin_amdgcn_mbcnt_lo(om_, 0u));
    const int tid = tid_, wid = __builtin_amdgcn_readfirstlane(tid >> 6), lane = tid & 63, wr = wid >> 2, wc = wid & 3, fr = lane & 15, fq = lane >> 4;
    const int K = g.K, nt = K / BK;
    unsigned voffA[2], voffB[2];
#pragma unroll
    for (int i = 0; i < 2; ++i) { int R, C; stage_rc(tid * 16 + i * 8192, R, C); const int Rb = Epi::PERM ? ((R & ~31) + perm32(R & 31)) : R;
        voffA[i] = (unsigned)(R * K + C) * 2u; voffB[i] = (unsigned)(Rb * K + C) * 2u; }
    const size_t kstep = (size_t)(BK * 2);
    const size_t hstep = (size_t)HALF * K * 2;
    const size_t tstep = 2 * hstep;
    const unsigned ldsw = (unsigned)wid * 1024u;
    const int aoff = lds_byte(wr * 64 + fr, fq * 8), boff = lds_byte(wc * 32 + fr, fq * 8);
#define PG8_SA(b, h) (((b) * 2 + (h)) * HTB)
#define PG8_SB(b, h) ((4 + (b) * 2 + (h)) * HTB)
#define PG8_STAGE(bufoff, gbase, voff) do { _Pragma("unroll") for (int _i = 0; _i < 2; ++_i) \
        __builtin_amdgcn_global_load_lds((const unsigned*)((const char*)(gbase) + (voff)[_i]), (PG8_LAS unsigned*)(lds + (bufoff) + ldsw + _i * 8192), 16, 0, 0); } while (0)
#define PG8_LDA(dst, b, h) do { _Pragma("unroll") for (int m = 0; m < 4; ++m) _Pragma("unroll") for (int k = 0; k < 2; ++k) dst[m][k] = *(const PG8_LAS bf16x8*)(lds + PG8_SA(b, h) + aoff + m * 2048 + k * 1024); } while (0)
#define PG8_LDB(dst, b, h) do { _Pragma("unroll") for (int n = 0; n < 2; ++n) _Pragma("unroll") for (int k = 0; k < 2; ++k) dst[n][k] = *(const PG8_LAS bf16x8*)(lds + PG8_SB(b, h) + boff + n * 2048 + k * 1024); } while (0)
#define PG8_MMA(ai, bj, At, Bt) do { __builtin_amdgcn_s_setprio(1); _Pragma("unroll") for (int m = 0; m < 4; ++m) _Pragma("unroll") for (int n = 0; n < 2; ++n) _Pragma("unroll") for (int k = 0; k < 2; ++k) \
        acc[ai][bj][m][n] = __builtin_amdgcn_mfma_f32_16x16x32_bf16(Bt[n][k], At[m][k], acc[ai][bj][m][n], 0, 0, 0); __builtin_amdgcn_s_setprio(0); } while (0)
#define PG8_WAIT_V(n) asm volatile("s_waitcnt vmcnt(" #n ")" ::: "memory")
#define PG8_WAIT_L(n) asm volatile("s_waitcnt lgkmcnt(" #n ")" ::: "memory")
#define PG8_BAR __builtin_amdgcn_s_barrier()
#define PG8_SCHED __builtin_amdgcn_sched_barrier(0)
    Unit cur, nxt; int ui = 0;
    if (!S.next(0, cur)) return;
    f32x4 acc[2][2][4][2];
#pragma unroll
    for (int a = 0; a < 2; ++a)
#pragma unroll
        for (int b = 0; b < 2; ++b)
#pragma unroll
            for (int m = 0; m < 4; ++m)
#pragma unroll
                for (int n = 0; n < 2; ++n) acc[a][b][m][n] = (f32x4){0.f, 0.f, 0.f, 0.f};
    bf16x8 At[4][2], B0[2][2], B1[2][2];
    const char* cA = (const char*)g.A + (size_t)cur.pm * tstep; const char* cB = (const char*)g.Bt + (size_t)cur.pn * tstep;
    S.a_ready(cur);
    if constexpr (SP2) {
        PG8_STAGE(PG8_SB(0, 0), cB, voffB); PG8_STAGE(PG8_SB(0, 1), cB + hstep, voffB); PG8_STAGE(PG8_SA(0, 0), cA, voffA); PG8_STAGE(PG8_SA(0, 1), cA + hstep, voffA);
        if (wr == 1) PG8_BAR;
        PG8_WAIT_V(2); PG8_BAR;
        PG8_STAGE(PG8_SB(1, 0), cB + kstep, voffB); PG8_STAGE(PG8_SA(1, 0), cA + kstep, voffA); PG8_STAGE(PG8_SB(1, 1), cB + hstep + kstep, voffB);
        PG8_WAIT_V(6); PG8_BAR;
    } else {
        PG8_STAGE(PG8_SB(0, 0), cB, voffB); PG8_STAGE(PG8_SA(0, 0), cA, voffA); PG8_STAGE(PG8_SB(0, 1), cB + hstep, voffB); PG8_STAGE(PG8_SA(0, 1), cA + hstep, voffA);
        if (wr == 1) PG8_BAR;
        PG8_WAIT_V(4); PG8_BAR;
        PG8_STAGE(PG8_SB(1, 0), cB + kstep, voffB); PG8_STAGE(PG8_SA(1, 0), cA + kstep, voffA); PG8_STAGE(PG8_SB(1, 1), cB + hstep + kstep, voffB);
        PG8_WAIT_V(6); PG8_BAR;
    }
    for (;;) {
        const bool has_next = S.next(ui + 1, nxt);
        const char* nA = has_next ? (const char*)g.A + (size_t)nxt.pm * tstep : cA; const char* nB = has_next ? (const char*)g.Bt + (size_t)nxt.pn * tstep : cB;
        for (int t = 0; t < nt; t += 2) {
            const bool last = (t == nt - 2);
            const char* a1 = cA + (size_t)(t + 1) * kstep;
            const char* a2 = last ? nA : cA + (size_t)(t + 2) * kstep; const char* b2 = last ? nB : cB + (size_t)(t + 2) * kstep;
            const char* a3 = a2 + kstep; const char* b3 = b2 + kstep;
            if (last && has_next) S.a_ready(nxt);
            if constexpr (SP2) {
            PG8_LDB(B0, 0, 0); PG8_LDB(B1, 0, 1); PG8_SCHED; PG8_LDA(At, 0, 0); PG8_STAGE(PG8_SA(1, 1), a1 + hstep, voffA);
            PG8_WAIT_V(8); PG8_WAIT_L(0); PG8_BAR; PG8_MMA(0, 0, At, B0); PG8_MMA(0, 1, At, B1); PG8_BAR; PG8_SCHED;
            PG8_LDA(At, 0, 1); PG8_STAGE(PG8_SB(0, 0), b2, voffB); PG8_STAGE(PG8_SB(0, 1), b2 + hstep, voffB); PG8_STAGE(PG8_SA(0, 0), a2, voffA);
            PG8_WAIT_V(8); PG8_WAIT_L(0); PG8_BAR; PG8_MMA(1, 0, At, B0); PG8_MMA(1, 1, At, B1); PG8_BAR; PG8_SCHED;
            PG8_LDB(B0, 1, 0); PG8_LDB(B1, 1, 1); PG8_SCHED; PG8_LDA(At, 1, 0); PG8_STAGE(PG8_SA(0, 1), a2 + hstep, voffA);
            PG8_WAIT_V(8); PG8_WAIT_L(0); PG8_BAR; PG8_MMA(0, 0, At, B0); PG8_MMA(0, 1, At, B1); PG8_BAR; PG8_SCHED;
            PG8_LDA(At, 1, 1); PG8_STAGE(PG8_SB(1, 0), b3, voffB); PG8_STAGE(PG8_SB(1, 1), b3 + hstep, voffB); PG8_STAGE(PG8_SA(1, 0), a3, voffA);
            PG8_WAIT_V(8); PG8_WAIT_L(0); PG8_BAR; PG8_MMA(1, 0, At, B0); PG8_MMA(1, 1, At, B1); PG8_BAR; PG8_SCHED;
            } else {
            PG8_LDB(B0, 0, 0); PG8_SCHED; PG8_LDA(At, 0, 0); PG8_STAGE(PG8_SA(1, 1), a1 + hstep, voffA);
            PG8_WAIT_L(8); PG8_BAR; PG8_WAIT_L(0); PG8_MMA(0, 0, At, B0); PG8_BAR; PG8_SCHED;
            PG8_LDB(B1, 0, 1); PG8_STAGE(PG8_SB(0, 0), b2, voffB);
            PG8_BAR; PG8_WAIT_L(0); PG8_MMA(0, 1, At, B1); PG8_BAR;
            PG8_LDA(At, 0, 1); PG8_STAGE(PG8_SA(0, 0), a2, voffA);
            PG8_BAR; PG8_WAIT_L(0); PG8_MMA(1, 0, At, B0); PG8_BAR; PG8_SCHED;
            PG8_STAGE(PG8_SB(0, 1), b2 + hstep, voffB);
            PG8_WAIT_V(6); PG8_BAR; PG8_MMA(1, 1, At, B1); PG8_BAR;
            PG8_LDB(B0, 1, 0); PG8_SCHED; PG8_LDA(At, 1, 0); PG8_STAGE(PG8_SA(0, 1), a2 + hstep, voffA);
            PG8_WAIT_L(8); PG8_BAR; PG8_WAIT_L(0); PG8_MMA(0, 0, At, B0); PG8_BAR; PG8_SCHED;
            PG8_LDB(B1, 1, 1); PG8_STAGE(PG8_SB(1, 0), b3, voffB);
            PG8_BAR; PG8_WAIT_L(0); PG8_MMA(0, 1, At, B1); PG8_BAR;
            PG8_LDA(At, 1, 1); PG8_STAGE(PG8_SA(1, 0), a3, voffA);
            PG8_BAR; PG8_WAIT_L(0); PG8_MMA(1, 0, At, B0); PG8_BAR; PG8_SCHED;
            PG8_STAGE(PG8_SB(1, 1), b3 + hstep, voffB);
            PG8_WAIT_V(6); PG8_BAR; PG8_MMA(1, 1, At, B1); PG8_BAR;
            }
        }
        if constexpr (ALIGN_EPI) { if (wr == 0) PG8_BAR; }
        if constexpr (!Epi::AFTER_DRAIN) { E(acc, cur, wr, wc, fr, fq); S.done(cur); }
        if (!has_next) break;
#pragma unroll
        for (int a = 0; a < 2; ++a)
#pragma unroll
            for (int b = 0; b < 2; ++b)
#pragma unroll
                for (int m = 0; m < 4; ++m)
#pragma unroll
                    for (int n = 0; n < 2; ++n) acc[a][b][m][n] = (f32x4){0.f, 0.f, 0.f, 0.f};
        cur = nxt; cA = nA; cB = nB; ++ui;
        if constexpr (ALIGN_EPI) { if (wr == 1) PG8_BAR; }
    }
    PG8_WAIT_V(0);
    if constexpr (!ALIGN_EPI) { if (wr == 0) PG8_BAR; }
    PG8_BAR;
    if constexpr (Epi::AFTER_DRAIN) { E.fused(acc, cur, wr, wc, fr, fq, lds, wid, lane); S.done(cur); }
#undef PG8_SA
#undef PG8_SB
#undef PG8_STAGE
#undef PG8_LDA
#undef PG8_LDB
#undef PG8_MMA
#undef PG8_WAIT_V
#undef PG8_WAIT_L
#undef PG8_BAR
#undef PG8_SCHED
}
}
#include <hip/hip_bf16.h>
#include <cmath>
namespace attn_body {
using bf16=__hip_bfloat16;
using bf16x8=__attribute__((ext_vector_type(8)))short;
using s16x4=__attribute__((ext_vector_type(4)))short;
using f32x16=__attribute__((ext_vector_type(16)))float;
using u32x4=__attribute__((ext_vector_type(4)))unsigned;
constexpr int ASEQ=8448,D=64;
constexpr int QP=512,KP=512,VP=7424,OP=1024;
constexpr int NW=8,QBLK=32,QB=QBLK*NW,KVBLK=64,NQB=ASEQ/QB;
constexpr int ATTN_UNIT_ROWS=QB;
__device__ __forceinline__ int crow(int r,int hi){return (r&3)+8*(r>>2)+4*hi;}
#define SBAR() __builtin_amdgcn_sched_barrier(0)
constexpr int BT_OFF=383, BT_N=640;
__device__ __forceinline__ void bmask(f32x16&p0,f32x16&p1,int t,int q0,int wid,int r32,int hi,const __attribute__((address_space(3))) float*tab){
  const float NEG=-INFINITY; const int qw=q0+32*wid;
  if(t>(qw>>6)){
    #pragma unroll
    for(int r=0;r<16;++r){p0[r]=NEG;p1[r]=NEG;} return; }
  if(t>0 && 64*t+63+91<=qw) return;
  const int q=qw+r32, kb=64*t+4*hi;
  #pragma unroll
  for(int r=0;r<16;++r){ const int kv=kb+(r&3)+8*(r>>2); int i0=kv-q+BT_OFF, i1=i0+32; i0=i0<0?0:i0; i1=i1<0?0:i1;
    p0[r]+=tab[i0]; p1[r]+=tab[i1]; if(kv<48)p0[r]=NEG; if(kv+32<48)p1[r]=NEG; }
}

constexpr int NSLOT=3, SLOTB=8192;
constexpr int LDS_K=0, LDS_V=NSLOT*SLOTB, LDS_WS=2*NSLOT*SLOTB, LDS_OST=LDS_WS+NW*64*4, LDS_BT=LDS_OST+NW*4096, LDS_BYTES=LDS_BT+BT_N*4;
constexpr float C2=0.125f*1.4426950408889634f;
__device__ __forceinline__ void glds16(const void*gsrc,unsigned lds_dst){unsigned keep;
  asm volatile("s_mov_b32 %0, m0\n\ts_mov_b32 m0, %2\n\ts_nop 0\n\tglobal_load_lds_dwordx4 %1, off\n\ts_mov_b32 m0, %0":"=&s"(keep):"v"(gsrc),"s"(lds_dst):"memory");}
__device__ __forceinline__ float max3f(float a,float b,float c){float r;asm("v_max3_f32 %0, %1, %2, %3":"=v"(r):"v"(a),"v"(b),"v"(c));return r;}
__device__ __forceinline__ float max2f(float a,float b){float r;asm("v_max_f32_e32 %0, %1, %2":"=v"(r):"v"(a),"v"(b));return r;}
__device__ __forceinline__ float fadd_s(float a,float b){float r;asm("v_add_f32_e32 %0, %1, %2":"=v"(r):"v"(a),"v"(b));return r;}
__device__ __forceinline__ float fsub_s(float a,float b){float r;asm("v_sub_f32_e32 %0, %1, %2":"=v"(r):"v"(a),"v"(b));return r;}
typedef float f32x2_t __attribute__((ext_vector_type(2))); typedef __bf16 bf16x2_t __attribute__((ext_vector_type(2)));
__device__ __forceinline__ unsigned cvtpk_s(float lo,float hi){f32x2_t v={lo,hi};bf16x2_t b=__builtin_convertvector(v,bf16x2_t);return __builtin_bit_cast(unsigned,b);}
#define WAIT_BAR(N) asm volatile("s_waitcnt vmcnt(" #N ") lgkmcnt(0)\n\ts_barrier":::"memory")

__device__ __forceinline__ void qkt(f32x16&p0,f32x16&p1,const char*Kslot,const bf16x8*qr,const f32x16&negm,int r32,int hi){
  const char*kb=Kslot+hi*1024+r32*16;
  #pragma unroll
  for(int d0=0;d0<4;++d0){
    const bf16x8 b0=*reinterpret_cast<const bf16x8*>(kb+d0*2048);
    const bf16x8 b1=*reinterpret_cast<const bf16x8*>(kb+d0*2048+512);
    if(d0==0){p0=__builtin_amdgcn_mfma_f32_32x32x16_bf16(b0,qr[0],negm,0,0,0);p1=__builtin_amdgcn_mfma_f32_32x32x16_bf16(b1,qr[0],negm,0,0,0);}
    else{p0=__builtin_amdgcn_mfma_f32_32x32x16_bf16(b0,qr[d0],p0,0,0,0);p1=__builtin_amdgcn_mfma_f32_32x32x16_bf16(b1,qr[d0],p1,0,0,0);}}
}
typedef __attribute__((address_space(3))) const char* lds_cptr;
typedef __attribute__((address_space(3))) const float* lds_cfptr;
typedef short v4i16_t __attribute__((ext_vector_type(4)));
__device__ __forceinline__ void kload8(bf16x8*kf,lds_cptr kp){
  kf[0]=*(const __attribute__((address_space(3))) bf16x8*)(kp);      kf[1]=*(const __attribute__((address_space(3))) bf16x8*)(kp+512);
  kf[2]=*(const __attribute__((address_space(3))) bf16x8*)(kp+2048); kf[3]=*(const __attribute__((address_space(3))) bf16x8*)(kp+2560);
  kf[4]=*(const __attribute__((address_space(3))) bf16x8*)(kp+4096); kf[5]=*(const __attribute__((address_space(3))) bf16x8*)(kp+4608);
  kf[6]=*(const __attribute__((address_space(3))) bf16x8*)(kp+6144); kf[7]=*(const __attribute__((address_space(3))) bf16x8*)(kp+6656);
}
__device__ __forceinline__ void kload2(bf16x8*kf,lds_cptr kp,int j){ kf[2*j]=*(const __attribute__((address_space(3))) bf16x8*)(kp+j*2048); kf[2*j+1]=*(const __attribute__((address_space(3))) bf16x8*)(kp+j*2048+512); }
__device__ __forceinline__ s16x4 vtr(lds_cptr p){ return __builtin_bit_cast(s16x4,__builtin_amdgcn_ds_read_tr16_b64_v4i16((__attribute__((address_space(3))) v4i16_t*)p)); }
__device__ __forceinline__ float rowmax(const f32x16&p0,const f32x16&p1){
  float a=max3f(p0[0],p0[1],p1[0]),b=max3f(p0[2],p0[3],p1[1]);a=max3f(a,p1[2],p1[3]);
  #pragma unroll
  for(int r=4;r<16;r+=4){a=max3f(a,p0[r],p0[r+1]);b=max3f(b,p0[r+2],p0[r+3]);a=max3f(a,p1[r],p1[r+1]);b=max3f(b,p1[r+2],p1[r+3]);}
  const float m=max2f(a,b);
  auto rr=__builtin_amdgcn_permlane32_swap(__float_as_uint(m),__float_as_uint(m),false,false);
  return max2f(__uint_as_float(rr[0]),__uint_as_float(rr[1]));
}
__device__ __forceinline__ void pv(f32x16*o,int vb,bf16x8 pa0,bf16x8 pa1,bf16x8 pa2,bf16x8 pa3){
  #pragma unroll
  for(int d0=0;d0<2;++d0){s16x4 lo[4],hi[4];
    #pragma unroll
    for(int ks=0;ks<4;++ks){
      asm volatile("ds_read_b64_tr_b16 %0,%1 offset:%c2":"=&v"(lo[ks]):"v"(vb),"i"(d0*4096+ks*1024):"memory");
      asm volatile("ds_read_b64_tr_b16 %0,%1 offset:%c2":"=&v"(hi[ks]):"v"(vb),"i"(d0*4096+ks*1024+512):"memory");}
    asm volatile("s_waitcnt lgkmcnt(0)":::"memory");SBAR();
    #define PK(k) (bf16x8){lo[k][0],lo[k][1],lo[k][2],lo[k][3],hi[k][0],hi[k][1],hi[k][2],hi[k][3]}
    o[d0]=__builtin_amdgcn_mfma_f32_32x32x16_bf16(pa0,PK(0),o[d0],0,0,0);
    o[d0]=__builtin_amdgcn_mfma_f32_32x32x16_bf16(pa1,PK(1),o[d0],0,0,0);
    o[d0]=__builtin_amdgcn_mfma_f32_32x32x16_bf16(pa2,PK(2),o[d0],0,0,0);
    o[d0]=__builtin_amdgcn_mfma_f32_32x32x16_bf16(pa3,PK(3),o[d0],0,0,0);
    #undef PK
  }
}

#ifndef ATTN_STORE16
#define ATTN_STORE16(p,v) (*(u32x4*)(p)=(v))
#endif
template<int THRL> __device__ __forceinline__ void attn_unit(int b,int qoff,int voff,int ooff,int qb,const bf16*Q,const bf16*__restrict__ K,const bf16*__restrict__ V,bf16*O,char*shm,int wv){
  unsigned om_ = ~0u; asm volatile("" : "+s"(om_), "+s"(wv)); int tid_ = wv * 64 + (int)__builtin_amdgcn_mbcnt_hi(om_, __builtin_amdgcn_mbcnt_lo(om_, 0u)); const int tid=tid_,lane=tid&63,r32=lane&31,hi=lane>>5; const int wid=__builtin_amdgcn_readfirstlane(tid>>6);
  const long rowbase=(long)b*ASEQ; const int q0=qb*QB;
  const bf16*Qw=Q+(rowbase+q0+wid*QBLK)*QP+qoff;
  const bf16*Kh=K+rowbase*KP+qoff,*Vh=V+rowbase*VP+voff;
  const unsigned lds0=(unsigned)(uintptr_t)shm;
  float*wsf=(float*)(shm+LDS_WS)+wid*64;
  const bf16*ksrc=Kh+(long)lane*KP+wid*8;
  const bf16*vsrc=Vh+(long)(16*(wid&3)+(lane>>2))*VP+(wid>>2)*32+(lane&3)*8;
  const unsigned kdst=lds0+LDS_K+wid*1024, vdst=lds0+LDS_V+wid*1024;
  #define DMA_K(t,slot) glds16(ksrc+(long)(t)*KVBLK*KP,(unsigned)__builtin_amdgcn_readfirstlane(kdst+(slot)))
  #define DMA_V(t,slot) glds16(vsrc+(long)(t)*KVBLK*VP,(unsigned)__builtin_amdgcn_readfirstlane(vdst+(slot)))
  const int vb0=(int)(lds0+LDS_V)+((lane>>4)&1)*32+(lane&3)*8+(4*hi+((lane&15)>>2))*64;
  const char*Kbase=shm+LDS_K; bf16x8 kf[8];
  const lds_cptr shm3=(lds_cptr)shm; const lds_cfptr btab=(lds_cfptr)(shm3+LDS_BT); const lds_cptr kp0=shm3+LDS_K+hi*1024+r32*16; const lds_cptr vp0=shm3+LDS_V+((lane>>4)&1)*32+(lane&3)*8+(4*hi+((lane&15)>>2))*64;
  const int NTL=(q0+QB)/KVBLK;
  DMA_K(0,0);DMA_V(0,0);DMA_K(1,SLOTB);
  bf16x8 qr[4];
  #pragma unroll
  for(int d0=0;d0<4;++d0)qr[d0]=*reinterpret_cast<const bf16x8*>(&Qw[(long)r32*QP+d0*16+hi*8]);
  float mhat=0.f,l_reg=0.f;f32x16 o[2];o[0]=f32x16{};o[1]=f32x16{};const f32x16 zt=f32x16{};
  const int qrel=wid*QBLK+r32;
  #define CMASK(P0,P1,t) bmask(P0,P1,(t),q0,wid,r32,hi,btab)
  bool resc=false;
  #define START(P0,P1) do{ const float rm=rowmax(P0,P1); resc=false; \
    { const float dl=rm; mhat=fadd_s(mhat,dl); \
      _Pragma("unroll") for(int r=0;r<16;++r){P0[r]=fsub_s(P0[r],dl);P1[r]=fsub_s(P1[r],dl);} \
      } \
    _Pragma("unroll") for(int r=0;r<16;++r)P0[r]=__builtin_amdgcn_exp2f(P0[r]); }while(0)
  #define RESC() do{ if(resc){ asm volatile("s_waitcnt lgkmcnt(0)":::"memory"); \
      _Pragma("unroll") for(int d_=0;d_<2;++d_) _Pragma("unroll") for(int r=0;r<16;++r)o[d_][r]*=wsf[crow(r,hi)]; } }while(0)
  f32x16 pA0,pA1,pB0,pB1;
  int sl_prev=0,sl_cur=0,sl_next=SLOTB;
  #define ROT() do{sl_prev=sl_cur;sl_cur=sl_next;sl_next=(sl_next==(NSLOT-1)*SLOTB)?0:sl_next+SLOTB;}while(0)
  DMA_K(2,2*SLOTB);
  WAIT_BAR(3);
  qkt(pA0,pA1,Kbase,qr,zt,r32,hi);asm volatile("s_nop 15\n\ts_nop 7":"+v"(pA0),"+v"(pA1));CMASK(pA0,pA1,0);
  START(pA0,pA1);
  _Pragma("unroll") for(int r=0;r<16;++r)pA1[r]=__builtin_amdgcn_exp2f(pA1[r]);
  WAIT_BAR(0);
  DMA_K(3,0);DMA_V(1,SLOTB);
  ROT();
  kload8(kf,kp0+sl_cur);
  WAIT_BAR(2);
  s16x4 vlo[8],vhi[8]; u32x4 pw0,pw1,pw2,pw3;
  #define PKW(P,B) cvtpk_s(P[B],P[B+1])
  #define PAF(k) __builtin_bit_cast(bf16x8,pw##k)
  #define VFR(i) (bf16x8){vlo[i][0],vlo[i][1],vlo[i][2],vlo[i][3],vhi[i][0],vhi[i][1],vhi[i][2],vhi[i][3]}
  #define PIN(x) asm volatile("":"+v"(x))
  #define MX3(a,b,c) __builtin_fmaxf(__builtin_fmaxf((a),(b)),(c))
  #define GAPA(MF,A0,A1,A2,A3,W0,W1,PW) do{ MF; sacc+=A0; sacc+=A1; sacc+=A2; sacc+=A3; PIN(sacc); W0; W1; PIN(PW); SBAR(); }while(0)
  #define EX(v) __builtin_amdgcn_exp2f(v)
  #define GAPB(MF,X,B) do{ MF; X[B]=EX(X[B]); X[B+1]=EX(X[B+1]); X[B+2]=EX(X[B+2]); X[B+3]=EX(X[B+3]); PIN(X); SBAR(); }while(0)
  #define VRD(i) do{ vlo[i]=vtr(vp_+(((i)>>2)*4096+((i)&3)*1024)); vhi[i]=vtr(vp_+(((i)>>2)*4096+((i)&3)*1024+512)); }while(0)
  #define KRD(G,j) do{ if(G){ kload2(kf,kp0+sl_next,j); SBAR(); } }while(0)
  #define STEP(C0,C1,P0,P1,t,GK,GV,GL) do{ SBAR(); \
    const lds_cptr vp_=vp0+sl_prev; \
    VRD(0); SBAR(); float sacc=(P0[0]+P0[1]); \
    GAPA(C0=__builtin_amdgcn_mfma_f32_32x32x16_bf16(kf[0],qr[0],zt,0,0,0), P0[2],P0[3],P0[4],P0[5],     pw0[0]=PKW(P0,0), pw0[1]=PKW(P0,2), pw0); \
    VRD(4); SBAR(); GAPA(C1=__builtin_amdgcn_mfma_f32_32x32x16_bf16(kf[1],qr[0],zt,0,0,0), P0[6],P0[7],P0[8],P0[9],     pw0[2]=PKW(P0,4), pw0[3]=PKW(P0,6), pw0); \
    VRD(1); SBAR(); GAPA(C0=__builtin_amdgcn_mfma_f32_32x32x16_bf16(kf[2],qr[1],C0,0,0,0),   P0[10],P0[11],P0[12],P0[13], pw1[0]=PKW(P0,8), pw1[1]=PKW(P0,10), pw1); \
    VRD(5); SBAR(); GAPA(C1=__builtin_amdgcn_mfma_f32_32x32x16_bf16(kf[3],qr[1],C1,0,0,0),   P0[14],P0[15],P1[0],P1[1],   pw1[2]=PKW(P0,12),pw1[3]=PKW(P0,14), pw1); \
    VRD(2); SBAR(); GAPA(C0=__builtin_amdgcn_mfma_f32_32x32x16_bf16(kf[4],qr[2],C0,0,0,0),   P1[2],P1[3],P1[4],P1[5],     pw2[0]=PKW(P1,0), pw2[1]=PKW(P1,2), pw2); \
    VRD(6); SBAR(); GAPA(C1=__builtin_amdgcn_mfma_f32_32x32x16_bf16(kf[5],qr[2],C1,0,0,0),   P1[6],P1[7],P1[8],P1[9],     pw2[2]=PKW(P1,4), pw2[3]=PKW(P1,6), pw2); \
    VRD(3); SBAR(); GAPA(C0=__builtin_amdgcn_mfma_f32_32x32x16_bf16(kf[6],qr[3],C0,0,0,0),   P1[10],P1[11],P1[12],P1[13], pw3[0]=PKW(P1,8), pw3[1]=PKW(P1,10), pw3); \
    VRD(7); SBAR(); GAPA(C1=__builtin_amdgcn_mfma_f32_32x32x16_bf16(kf[7],qr[3],C1,0,0,0),   P1[14],P1[15],0.f,0.f,       pw3[2]=PKW(P1,12),pw3[3]=PKW(P1,14), pw3); \
    l_reg+=sacc; \
    if(GK){DMA_K((t)+3,sl_cur);} if(GV){DMA_V((t)+1,sl_next);} \
    _Pragma("unroll") for(int r=0;r<16;++r){C0[r]-=mhat;C1[r]-=mhat;} \
    CMASK(C0,C1,t); \
    { float a=MX3(C0[0],C0[1],C1[0]),b=MX3(C0[2],C0[3],C1[1]); a=MX3(a,C1[2],C1[3]); \
      _Pragma("unroll") for(int r=4;r<16;r+=4){a=MX3(a,C0[r],C0[r+1]);b=MX3(b,C0[r+2],C0[r+3]);a=MX3(a,C1[r],C1[r+1]);b=MX3(b,C1[r+2],C1[r+3]);} \
      float rm=__builtin_fmaxf(a,b); { auto rr=__builtin_amdgcn_permlane32_swap(__float_as_uint(rm),__float_as_uint(rm),false,false); rm=__builtin_fmaxf(__uint_as_float(rr[0]),__uint_as_float(rr[1])); } \
      resc=false; \
      if(__builtin_expect(__any(rm>(float)THRL),0)){ const float dl=__builtin_fmaxf(rm,0.f); mhat+=dl; \
        _Pragma("unroll") for(int r=0;r<16;++r){C0[r]-=dl;C1[r]-=dl;} \
        const float f=__builtin_amdgcn_exp2f(-dl); l_reg*=f; if(hi==0)wsf[r32]=f; resc=true; } } \
    SBAR(); \
    GAPB(o[0]=__builtin_amdgcn_mfma_f32_32x32x16_bf16(PAF(0),VFR(0),o[0],0,0,0), C0,0); \
    GAPB(o[1]=__builtin_amdgcn_mfma_f32_32x32x16_bf16(PAF(0),VFR(4),o[1],0,0,0), C0,4); \
    KRD(GL,0); GAPB(o[0]=__builtin_amdgcn_mfma_f32_32x32x16_bf16(PAF(1),VFR(1),o[0],0,0,0), C0,8); \
    KRD(GL,1); GAPB(o[1]=__builtin_amdgcn_mfma_f32_32x32x16_bf16(PAF(1),VFR(5),o[1],0,0,0), C0,12); \
    KRD(GL,2); GAPB(o[0]=__builtin_amdgcn_mfma_f32_32x32x16_bf16(PAF(2),VFR(2),o[0],0,0,0), C1,0); \
    KRD(GL,3); GAPB(o[1]=__builtin_amdgcn_mfma_f32_32x32x16_bf16(PAF(2),VFR(6),o[1],0,0,0), C1,4); \
    GAPB(o[0]=__builtin_amdgcn_mfma_f32_32x32x16_bf16(PAF(3),VFR(3),o[0],0,0,0), C1,8); \
    GAPB(o[1]=__builtin_amdgcn_mfma_f32_32x32x16_bf16(PAF(3),VFR(7),o[1],0,0,0), C1,12); \
    }while(0)
  int t=1;
  #undef CMASK
  #define CMASK(P0,P1,t) do{}while(0)
  for(;t+7<NTL;t+=2){
    STEP(pB0,pB1,pA0,pA1,t,true,true,true);     WAIT_BAR(2); RESC(); ROT();
    STEP(pA0,pA1,pB0,pB1,t+1,true,true,true);   WAIT_BAR(2); RESC(); ROT();
  }
  #undef CMASK
  #define CMASK(P0,P1,t) bmask(P0,P1,(t),q0,wid,r32,hi,btab)
  #define ENDW(tt) do{ if((tt)+3<NTL){WAIT_BAR(2);} else if((tt)+2<NTL){WAIT_BAR(1);} else {WAIT_BAR(0);} }while(0)
  for(;t+1<NTL;t+=2){
    STEP(pB0,pB1,pA0,pA1,t,(t+3<NTL),(t+1<NTL),(t+1<NTL));       ENDW(t);   RESC(); ROT();
    STEP(pA0,pA1,pB0,pB1,t+1,(t+4<NTL),(t+2<NTL),(t+2<NTL));     ENDW(t+1); RESC(); ROT();
  }
  STEP(pB0,pB1,pA0,pA1,NTL-1,false,false,false); RESC();
  { float sacc=pB0[0]+pB0[1]; _Pragma("unroll") for(int r=2;r<16;++r)sacc+=pB0[r]; _Pragma("unroll") for(int r=0;r<16;++r)sacc+=pB1[r]; l_reg+=sacc;
    pw0=(u32x4){PKW(pB0,0),PKW(pB0,2),PKW(pB0,4),PKW(pB0,6)};pw1=(u32x4){PKW(pB0,8),PKW(pB0,10),PKW(pB0,12),PKW(pB0,14)};pw2=(u32x4){PKW(pB1,0),PKW(pB1,2),PKW(pB1,4),PKW(pB1,6)};pw3=(u32x4){PKW(pB1,8),PKW(pB1,10),PKW(pB1,12),PKW(pB1,14)};
    SBAR(); pv(o,vb0+sl_cur,PAF(0),PAF(1),PAF(2),PAF(3)); }
  #undef PKW
  #undef PAF
  #undef VFR
  #undef PIN
  #undef MX3
  #undef GAPA
  #undef GAPB
  #undef EX
  #undef VRD
  #undef KRD
  #undef STEP
  #undef ENDW
  {auto rr=__builtin_amdgcn_permlane32_swap(__float_as_uint(l_reg),__float_as_uint(l_reg),false,false);l_reg=__uint_as_float(rr[0])+__uint_as_float(rr[1]);}
  if(hi==0)wsf[32+r32]=l_reg;asm volatile("s_waitcnt lgkmcnt(0)":::"memory");
  float rli[16];
  #pragma unroll
  for(int r=0;r<16;++r)rli[r]=__builtin_amdgcn_rcpf(wsf[32+crow(r,hi)]);
  bf16*Ow=O+(rowbase+q0+wid*QBLK)*OP+ooff;
  { bf16*stg=(bf16*)(shm+LDS_OST)+wid*2048;
    #pragma unroll
    for(int r=0;r<16;++r){const int orow=crow(r,hi);
      #pragma unroll
      for(int d0=0;d0<2;++d0)stg[orow*64+d0*32+r32]=__float2bfloat16(o[d0][r]*rli[r]);}
    asm volatile("s_waitcnt lgkmcnt(0)":::"memory");
    #pragma unroll
    for(int i=0;i<4;++i){const int row=i*8+(lane>>3),ch=lane&7; const u32x4 v=*(const u32x4*)(stg+row*64+ch*8); ATTN_STORE16(Ow+(long)row*OP+ch*8,v);} }
  asm volatile("s_waitcnt lgkmcnt(0)\n\ts_barrier":::"memory");
  #undef DMA_K
  #undef DMA_V
  #undef CMASK
  #undef START
  #undef RESC
  #undef ROT
}
constexpr int ATTN_LDS_BYTES=LDS_BYTES;
#undef SBAR
#undef WAIT_BAR
#undef WAIT_BAR
}
namespace mk {
#define GAS __attribute__((address_space(1)))
#define LAS __attribute__((address_space(3)))
typedef unsigned short bf16;
typedef unsigned v4u __attribute__((ext_vector_type(4)));
typedef unsigned v2u __attribute__((ext_vector_type(2)));
typedef float f32x4 __attribute__((ext_vector_type(4)));
typedef float f32x16 __attribute__((ext_vector_type(16)));
typedef short bf16x8 __attribute__((ext_vector_type(8)));
typedef GAS unsigned gu32;
#define RLX_AGENT __ATOMIC_RELAXED, __HIP_MEMORY_SCOPE_AGENT
#define LDS_WAIT() asm volatile("s_waitcnt lgkmcnt(0)" ::: "memory")
#define VM_WAIT() asm volatile("s_waitcnt vmcnt(0)" ::: "memory")
__device__ __forceinline__ unsigned f2bf(float f) { unsigned u = __builtin_bit_cast(unsigned, f); return (u + 0x7fffu + ((u >> 16) & 1u)) >> 16; }
__device__ __forceinline__ unsigned pk2(float lo, float hi) { return f2bf(lo) | (f2bf(hi) << 16); }
__device__ __forceinline__ float bf2f(unsigned short b) { return __builtin_bit_cast(float, ((unsigned)b) << 16); }
__device__ __forceinline__ float bflo(unsigned w) { return __builtin_bit_cast(float, w << 16); }
__device__ __forceinline__ float bfhi(unsigned w) { return __builtin_bit_cast(float, w & 0xffff0000u); }

constexpr int NWAVES = 8, NTHR = NWAVES * 64;
constexpr int PADF = 48;
constexpr int LPP = 8448;
constexpr int PEND = PADF + LP;
constexpr int SROW0 = BATCH * LPP;
constexpr int RP = SROW0 + NS;
constexpr int ZN = 7424;
constexpr int ZC_QA = 0, ZC_KA = 512, ZC_VA = 1024, ZC_QKVB = 1536, ZC_GB = 3072, ZC_UC = 3584, ZC_GATE = 4096, ZC_BA = 7168;
static_assert(RP % 256 == 0 && ZN % 256 == 0 && D_MODEL == 1024 && WIDTH_A == 512 && WIDTH_B == 512 && WIDTH_C == 512, "shapes");
__host__ __device__ __forceinline__ int nat2prow(int row) { return row < NP ? (row / LP) * LPP + PADF + row % LP : SROW0 + (row - NP); }
__host__ __device__ __forceinline__ int zcol(int col) { return col < 3584 ? col : (col < 3592 ? ZC_BA + (col - 3584) : col - 8); }
__device__ __forceinline__ bool prow_valid(int prow) { if (prow >= SROW0) return true; const int p = prow % LPP; return p >= PADF && p < PEND; }
__device__ __forceinline__ int prow2nat(int prow) { if (prow >= SROW0) return NP + (prow - SROW0); return (prow / LPP) * LP + (prow % LPP) - PADF; }

constexpr int RING_OFF = 0, RING_BYTES = 147456;
constexpr int LDSCTL_OFF = RING_BYTES, MISC_OFF = LDSCTL_OFF + 320;
constexpr int LDS_BYTES = RING_BYTES + 1024;
static_assert(MISC_OFF + 128 <= LDS_BYTES, "LDS map");

constexpr size_t CTL_BYTES = 1u << 20;
constexpr int CW_TMO = 0, CW_CODE = 1;
constexpr int CW_BAR = 4096;
constexpr int CW_QUEUE = 16384;

__device__ __forceinline__ int lane_id() { return (int)__builtin_amdgcn_mbcnt_hi(~0u, __builtin_amdgcn_mbcnt_lo(~0u, 0u)); }
#define XB_TMO      128
#define XB_XCNT(j)  (256  + 64 * (j))
#define XB_XSUB(j)  (1280 + 64 * (j))
#define XB_XGEN(j)  (2304 + 64 * (j))
#define XB_TOP      3328
#define XB_TOPGEN   3392
#define XCD_BAR_WORDS 3456
#define XB_SPIN_CAP (1u << 18)

__device__ __forceinline__ unsigned xb_ld(unsigned* p)              { return __hip_atomic_load(p, __ATOMIC_RELAXED, __HIP_MEMORY_SCOPE_AGENT); }
__device__ __forceinline__ unsigned xb_add(unsigned* p, unsigned v) { return __hip_atomic_fetch_add(p, v, __ATOMIC_RELAXED, __HIP_MEMORY_SCOPE_AGENT); }
__device__ __forceinline__ unsigned xb_xcc_id() { return (unsigned)__builtin_amdgcn_s_getreg((3 << 11) | 20) & 0xFu; }
#define XB_SPIN(cond, bar) do { unsigned _sp = 0; while (cond) { __builtin_amdgcn_s_sleep(1); \
    if ((++_sp & 255u) == 0u) { if (xb_ld(&(bar)[XB_TMO])) break; if (_sp > XB_SPIN_CAP) { atomicAdd(&(bar)[XB_TMO], 1u); break; } } } } while (0)

struct XcdBarrier {
    unsigned* bar; unsigned x; int wv;
    volatile LAS unsigned* st;
};

__device__ __forceinline__ XcdBarrier xcd_barrier_post(unsigned* bar, volatile LAS unsigned* st, int wv) {
    XcdBarrier b; b.bar = bar; b.x = xb_xcc_id(); b.st = st; b.wv = wv;
    if (wv == 0 && lane_id() == 0) (void)xb_add(&bar[XB_XCNT(b.x)], 1u);
    return b;
}
__device__ __forceinline__ void xcd_barrier_complete(unsigned* bar, unsigned x, unsigned& nloc, unsigned& nx) {
    const unsigned G = gridDim.x * gridDim.y * gridDim.z;
    unsigned sum, cnt, mine, sp = 0u;
    for (;;) {
        sum = 0u; cnt = 0u; mine = 0u;
#pragma unroll
        for (unsigned j = 0; j < 16; ++j) { const unsigned c = xb_ld(&bar[XB_XCNT(j)]); sum += c; cnt += (c > 0u) ? 1u : 0u; mine = (j == x) ? c : mine; }
        if (sum == G) break;
        __builtin_amdgcn_s_sleep(1);
        if ((++sp & 255u) == 0u) { if (xb_ld(&bar[XB_TMO])) break; if (sp > XB_SPIN_CAP) { atomicAdd(&bar[XB_TMO], 1u); break; } }
    }
    nloc = mine > 0u ? mine : 1u; nx = cnt > 0u ? cnt : 1u;
}

__device__ __forceinline__ void xcd_barrier(const XcdBarrier& b) {
    asm volatile("s_waitcnt vmcnt(0)" ::: "memory");
    __syncthreads();
    if (b.wv == 0 && lane_id() == 0) {
        unsigned* bar = b.bar;
        __builtin_amdgcn_s_waitcnt(0);
        unsigned nloc = b.st[0], nx = b.st[1];
        if (nloc == 0u) { xcd_barrier_complete(bar, b.x, nloc, nx); b.st[0] = nloc; b.st[1] = nx; }
        const unsigned old = xb_add(&bar[XB_XSUB(b.x)], 1u);
        const unsigned gen = old / nloc;
        if (old + 1u == (gen + 1u) * nloc) {
            __builtin_amdgcn_fence(__ATOMIC_RELEASE, "agent");
            asm volatile("s_waitcnt vmcnt(0)" ::: "memory");
            const unsigned og = xb_add(&bar[XB_TOP], 1u);
            const unsigned tg = og / nx;
            if (og + 1u == (tg + 1u) * nx) xb_add(&bar[XB_TOPGEN], 1u);
            else XB_SPIN(xb_ld(&bar[XB_TOPGEN]) == tg, bar);
            __builtin_amdgcn_fence(__ATOMIC_ACQUIRE, "agent");
            xb_add(&bar[XB_XGEN(b.x)], 1u);
            asm volatile("s_waitcnt vmcnt(0)" ::: "memory");
        } else {
            XB_SPIN(xb_ld(&bar[XB_XGEN(b.x)]) == gen, bar);
            __builtin_amdgcn_fence(__ATOMIC_ACQUIRE, "agent");
            asm volatile("s_waitcnt vmcnt(0)" ::: "memory");
        }
    }
    __syncthreads();
}


template <int CTRL> __device__ __forceinline__ float dpp_f(float v) { return __builtin_bit_cast(float, __builtin_amdgcn_update_dpp(0, __builtin_bit_cast(int, v), CTRL, 0xf, 0xf, true)); }
template <int CTRL, int ROWMASK> __device__ __forceinline__ float dpp_fm(float v) { return __builtin_bit_cast(float, __builtin_amdgcn_update_dpp(0, __builtin_bit_cast(int, v), CTRL, ROWMASK, 0xf, false)); }
__device__ __forceinline__ float rdlane(float v, int i) { return __builtin_bit_cast(float, __builtin_amdgcn_readlane(__builtin_bit_cast(int, v), i)); }
__device__ __forceinline__ float sum8(float v) { v += dpp_f<0xB1>(v); v += dpp_f<0x4E>(v); v += dpp_f<0x141>(v); return v; }
__device__ __forceinline__ float sum16(float v) { v = sum8(v); v += dpp_f<0x140>(v); return v; }
__device__ __forceinline__ float wave_sum(float v) { v = sum16(v); return rdlane(v, 0) + rdlane(v, 16) + rdlane(v, 32) + rdlane(v, 48); }
__device__ __forceinline__ float wave_max(float v) {
    v = fmaxf(v, dpp_f<0xB1>(v)); v = fmaxf(v, dpp_f<0x4E>(v)); v = fmaxf(v, dpp_f<0x141>(v)); v = fmaxf(v, dpp_f<0x140>(v));
    return fmaxf(fmaxf(rdlane(v, 0), rdlane(v, 16)), fmaxf(rdlane(v, 32), rdlane(v, 48)));
}
__device__ __forceinline__ float scan64(float v) {
    v += dpp_f<0x111>(v); v += dpp_f<0x112>(v); v += dpp_f<0x114>(v); v += dpp_f<0x118>(v);
    v += dpp_fm<0x142, 0xA>(v); v += dpp_fm<0x143, 0xC>(v);
    return v;
}
__device__ __forceinline__ float swap32(float v) {
    const auto r = __builtin_amdgcn_permlane32_swap(__builtin_bit_cast(unsigned, v), __builtin_bit_cast(unsigned, v), false, false);
    return __builtin_bit_cast(float, (lane_id() & 32) ? r[0] : r[1]);
}
}
namespace mk {
enum Region { R_X, R_XN, R_WIN, R_Z, R_QN, R_KN, R_QKVB, R_BG, R_O, R_OA, R_OB, R_YC, R_OC, R_MRG, R_WGLU, R_WBR, R_WOUT, R_WQS, R_PU, R_PV, R_SC, R_GDN, R_S5T, R_MISC, R_S5E, R_S5X, R_MRGB, R_OBN, R_NREG };
constexpr int NPL = 16;
enum Phase { PH_PRO = 0, PL_NORM1 = 0, PL_GEMM_IN = 1, PL_ZPOST = 2, PL_LOCAL = 3, PL_MIX = 4, PL_MIXPOST = 5, PL_GEMM_GLU = 6, PL_GEMM_BRA = 7, PL_GEMM_BRB = 8, PL_GEMM_BRC = 9,
             PL_GEMM_OUT = 10, PL_NORM2 = 11, PL_GEMM_PEER = 12, PL_PEER = 13, PH_FINAL = 1 + DEPTH * NPL, PH_END = PH_FINAL + 1 };
enum ProMask { PM_X = 1, PM_WIN = 2, PM_WREST = 4, PM_PEERW = 8, PM_WQS = 16, PM_TABLES = 32 };
struct Args {
    const float* in[40];
    float* out;
    unsigned char* ws;
    unsigned long long off[32];
    int ph_lo, ph_hi, pro_mask, bar_region;
};
static_assert(sizeof(Args) == 40 * 8 + 8 + 8 + 32 * 8 + 16, "Args has no padding");

typedef const __attribute__((address_space(4))) Args* KArgs;
__device__ __forceinline__ KArgs kargs() { KArgs p = (KArgs)__builtin_amdgcn_kernarg_segment_ptr(); asm volatile("" : "+s"(p)); return p; }
#define WS_OPAQUE(a) unsigned char* wsb = (a).ws; asm volatile("" : "+s"(wsb))
#define otid() otid_(F.wv)
__device__ __forceinline__ int otid_(int wv) { unsigned m = ~0u; asm volatile("" : "+s"(m), "+s"(wv));
    return wv * 64 + (int)__builtin_amdgcn_mbcnt_hi(m, __builtin_amdgcn_mbcnt_lo(m, 0u)); }
struct Frame {
    LAS unsigned char* lds; volatile LAS unsigned* MISC; gu32* ctl;
    int vcu, G, wv;
};

template <class CM> __device__ __forceinline__ void transpose_item(const float* W, int ld, int K, bf16* WT, int n0, int k0, const CM& cm, LAS float* scr, int lane) {
    const int sc = cm(n0 + (lane & 31));
#pragma unroll 8
    for (int i = 0; i < 32; ++i) { const int kk = 2 * i + (lane >> 5); scr[kk * 33 + (lane & 31)] = sc >= 0 ? W[(size_t)(k0 + kk) * ld + sc] : 0.f; }
    LDS_WAIT(); asm volatile("" ::: "memory");
    const int c = lane & 7;
#pragma unroll
    for (int j = 0; j < 4; ++j) { const int n = (lane >> 3) + 8 * j; const LAS float* s = scr + (8 * c) * 33 + n;
        v4u o; o.x = pk2(s[0 * 33], s[1 * 33]); o.y = pk2(s[2 * 33], s[3 * 33]); o.z = pk2(s[4 * 33], s[5 * 33]); o.w = pk2(s[6 * 33], s[7 * 33]);
        *(GAS v4u*)(WT + (size_t)(n0 + n) * K + k0 + 8 * c) = o; }
    LDS_WAIT(); asm volatile("" ::: "memory");
}
struct CmWin { __device__ __forceinline__ int operator()(int n) const { return n < 3584 ? n : (n < 7168 ? n + 8 : (n < 7176 ? 3584 + (n - 7168) : -1)); } };
struct CmId { __device__ __forceinline__ int operator()(int n) const { return n; } };
struct CmGlu { __device__ __forceinline__ int operator()(int n) const { const int G = n >> 5, i = n & 31; return i < 16 ? 16 * G + i : 512 + 16 * G + (i - 16); } };

__device__ __forceinline__ void rms_row_to_bf16(const float* xrow, const float* g, bf16* orow, int lane) {
    const GAS f32x4* xr = (const GAS f32x4*)xrow + lane;
    f32x4 v[4]; float s2 = 0.f;
#pragma unroll
    for (int j = 0; j < 4; ++j) { v[j] = xr[64 * j]; s2 += (v[j].x * v[j].x + v[j].y * v[j].y) + (v[j].z * v[j].z + v[j].w * v[j].w); }
    const float r = __builtin_amdgcn_rsqf(wave_sum(s2) * (1.f / D_MODEL) + EPSF);
    const GAS f32x4* gr = (const GAS f32x4*)g + lane;
    GAS unsigned long long* o8 = (GAS unsigned long long*)orow + lane;
#pragma unroll
    for (int j = 0; j < 4; ++j) { const f32x4 gg = gr[64 * j];
        o8[64 * j] = (unsigned long long)pk2(v[j].x * r * gg.x, v[j].y * r * gg.y) | ((unsigned long long)pk2(v[j].z * r * gg.z, v[j].w * r * gg.w) << 32); }
}

__device__ __forceinline__ void p_norm(Frame& F, int l, int gi) {
    const KArgs ap = kargs(); const auto& a = *ap; WS_OPAQUE(a);
    const int tid = otid(), lane = tid & 63, wave = __builtin_amdgcn_readfirstlane(tid >> 6);
    const float* X = (const float*)(wsb + a.off[R_X]); bf16* XN = (bf16*)(wsb + a.off[R_XN]); const float* g = a.in[gi] + (size_t)l * D_MODEL;
    const int gw = F.vcu * NWAVES + wave, NGW = F.G * NWAVES;
    for (int m = gw; m < RP; m += NGW) rms_row_to_bf16(X + (size_t)m * D_MODEL, g, XN + (size_t)m * D_MODEL, lane);
}
__device__ __forceinline__ void unpack8(const v4u w, float (&f)[8]) { f[0] = bflo(w.x); f[1] = bfhi(w.x); f[2] = bflo(w.y); f[3] = bfhi(w.y); f[4] = bflo(w.z); f[5] = bfhi(w.z); f[6] = bflo(w.w); f[7] = bfhi(w.w); }
__device__ __forceinline__ v4u pack8(const float (&f)[8]) { v4u w; w.x = pk2(f[0], f[1]); w.y = pk2(f[2], f[3]); w.z = pk2(f[4], f[5]); w.w = pk2(f[6], f[7]); return w; }
__device__ __forceinline__ float sigm(float x) { return __builtin_amdgcn_rcpf(1.f + __expf(-x)); }
constexpr float ATT_C2 = 0.125f * 1.4426950408889634f;
__device__ __forceinline__ void p_zpost(Frame& F, int l) {
    const KArgs ap = kargs(); const auto& a = *ap; WS_OPAQUE(a);
    const bf16* Z = (const bf16*)(wsb + a.off[R_Z]);
    bf16* QN = (bf16*)(wsb + a.off[R_QN]); bf16* KN = (bf16*)(wsb + a.off[R_KN]); bf16* QKVB = (bf16*)(wsb + a.off[R_QKVB]); float* BG = (float*)(wsb + a.off[R_BG]);
    const int tid = otid(), lane = tid & 63, wave = __builtin_amdgcn_readfirstlane(tid >> 6);
    const int gw = F.vcu * NWAVES + wave, NGW = F.G * NWAVES;
    float gq[8], gk[8], cw[3][4][8];
#pragma unroll
    for (int j = 0; j < 8; ++j) { gq[j] = a.in[I_QN][l * HEAD_DIM_A + 8 * (lane & 7) + j] * ATT_C2; gk[j] = a.in[I_KN][l * HEAD_DIM_A + 8 * (lane & 7) + j]; }
#pragma unroll
    for (int w = 0; w < 3; ++w)
#pragma unroll
        for (int i = 0; i < 4; ++i)
#pragma unroll
            for (int j = 0; j < 8; ++j) cw[w][i][j] = a.in[I_CONVW][((size_t)l * CONV_W + i) * 3 * WIDTH_B + w * WIDTH_B + 8 * lane + j];
    float alog = 0.f, dtb = 0.f; if (lane < 4) { alog = a.in[I_ALOG][l * N_HEADS_B + lane]; dtb = a.in[I_DTB][l * N_HEADS_B + lane]; }
    for (int m = gw; m < RP; m += NGW) {
        const bool valid = prow_valid(m); const int nat = valid ? prow2nat(m) : 0;
        const bf16* zr = Z + (size_t)m * ZN;
        float f[8], o[8];
        unpack8(*(const GAS v4u*)(zr + ZC_QA + 8 * lane), f);
        { float ss = 0.f;
#pragma unroll
          for (int j = 0; j < 8; ++j) ss += f[j] * f[j];
          ss = sum8(ss);
          const float r = __builtin_amdgcn_rsqf(ss * (1.f / HEAD_DIM_A) + EPSF);
#pragma unroll
          for (int j = 0; j < 8; ++j) o[j] = f[j] * r * gq[j];
          *(GAS v4u*)(QN + (size_t)m * WIDTH_A + 8 * lane) = pack8(o); }
        unpack8(*(const GAS v4u*)(zr + ZC_KA + 8 * lane), f);
        { float ss = 0.f;
#pragma unroll
          for (int j = 0; j < 8; ++j) ss += f[j] * f[j];
          ss = sum8(ss);
          const float r = __builtin_amdgcn_rsqf(ss * (1.f / HEAD_DIM_A) + EPSF);
#pragma unroll
          for (int j = 0; j < 8; ++j) o[j] = f[j] * r * gk[j];
          *(GAS v4u*)(KN + (size_t)m * WIDTH_A + 8 * lane) = pack8(o);
          if (valid) { float* ko = nat < NP ? a.out + O_KP + ((size_t)l * NP + nat) * WIDTH_A : a.out + O_KS + ((size_t)l * NS + (nat - NP)) * WIDTH_A;
              *(GAS f32x4*)(ko + 8 * lane) = (f32x4){o[0], o[1], o[2], o[3]}; *(GAS f32x4*)(ko + 8 * lane + 4) = (f32x4){o[4], o[5], o[6], o[7]}; } }
        if (valid) { unpack8(*(const GAS v4u*)(zr + ZC_VA + 8 * lane), f);
            float* vo = nat < NP ? a.out + O_VP + ((size_t)l * NP + nat) * WIDTH_A : a.out + O_VS + ((size_t)l * NS + (nat - NP)) * WIDTH_A;
            *(GAS f32x4*)(vo + 8 * lane) = (f32x4){f[0], f[1], f[2], f[3]}; *(GAS f32x4*)(vo + 8 * lane + 4) = (f32x4){f[4], f[5], f[6], f[7]}; }
        const int ts = m >= SROW0 ? (m - SROW0) % DEC_SEQ : 1000; const int bs = m >= SROW0 ? (m - SROW0) / DEC_SEQ : 0;
        int cj = -1;
        if (m >= SROW0) { if (ts >= DEC_SEQ - 3) cj = ts - (DEC_SEQ - 3); } else { const int p = m % LPP; if (p >= PEND - 3 && p < PEND) cj = p - (PEND - 3); }
#pragma unroll
        for (int w = 0; w < 3; ++w) {
            float acc[8];
#pragma unroll
            for (int j = 0; j < 8; ++j) acc[j] = 0.f;
#pragma unroll
            for (int i = 0; i < 4; ++i) {
                const int dt = i - 3;
                if (ts + dt < 0) {
                    const float* sc = a.in[I_SCONV] + (((size_t)l * DEC_BATCH + bs) * (CONV_W - 1) + (CONV_W - 1 + ts + dt)) * 3 * WIDTH_B + w * WIDTH_B + 8 * lane;
                    const f32x4 s0 = *(const GAS f32x4*)sc, s1 = *(const GAS f32x4*)(sc + 4);
                    f[0] = s0.x; f[1] = s0.y; f[2] = s0.z; f[3] = s0.w; f[4] = s1.x; f[5] = s1.y; f[6] = s1.z; f[7] = s1.w;
                } else if (m + dt >= 0) unpack8(*(const GAS v4u*)(Z + (size_t)(m + dt) * ZN + ZC_QKVB + w * WIDTH_B + 8 * lane), f);
                else {
#pragma unroll
                    for (int j = 0; j < 8; ++j) f[j] = 0.f; }
#pragma unroll
                for (int j = 0; j < 8; ++j) acc[j] += f[j] * cw[w][i][j];
                if (i == 3 && cj >= 0) {
                    float* co = m >= SROW0 ? a.out + O_CS + (((size_t)l * DEC_BATCH + bs) * (CONV_W - 1) + cj) * 3 * WIDTH_B : a.out + O_CP + (((size_t)l * BATCH + m / LPP) * (CONV_W - 1) + cj) * 3 * WIDTH_B;
                    *(GAS f32x4*)(co + w * WIDTH_B + 8 * lane) = (f32x4){f[0], f[1], f[2], f[3]}; *(GAS f32x4*)(co + w * WIDTH_B + 8 * lane + 4) = (f32x4){f[4], f[5], f[6], f[7]}; }
            }
            float ss = 0.f;
#pragma unroll
            for (int j = 0; j < 8; ++j) { acc[j] = acc[j] * sigm(acc[j]); ss += acc[j] * acc[j]; }
            float sc = 1.f;
            if (w < 2) { ss = sum16(ss);
                sc = __builtin_amdgcn_rsqf(ss + EPSF); if (w == 0) sc *= 0.08838834764831845f; }
#pragma unroll
            for (int j = 0; j < 8; ++j) o[j] = acc[j] * sc;
            *(GAS v4u*)(QKVB + (size_t)m * 3 * WIDTH_B + w * WIDTH_B + 8 * lane) = pack8(o);
        }
        if (lane < 4) { const float be = bf2f(zr[ZC_BA + lane]), al = bf2f(zr[ZC_BA + 4 + lane]) + dtb;
            const float sp = al > 20.f ? al : __logf(1.f + __expf(al));
            BG[(size_t)m * 8 + lane] = valid ? sigm(be) : 0.f; BG[(size_t)m * 8 + 4 + lane] = valid ? -__expf(alog) * sp : 0.f; }
    }
}
constexpr float LOG2E = 1.4426950408889634f;
__device__ __forceinline__ int t5_bucket_dev(int rel) {
    const int n = rel < 0 ? -rel : rel; int b;
    if (n < 8) b = n; else if (n < 12) b = 8; else if (n < 16) b = 9; else if (n < 23) b = 10; else if (n < 32) b = 11;
    else if (n < 46) b = 12; else if (n < 64) b = 13; else if (n < 91) b = 14; else b = 15;
    return b + (rel > 0 ? 16 : 0);
}
__device__ __forceinline__ void build_bias_table(LAS float* tab, const float* rel_bias, int h, int tid) {
    const float far = rel_bias[15 * N_HEADS_A + h];
    for (int i = tid; i < attn_body::BT_N; i += NTHR) tab[i] = (rel_bias[t5_bucket_dev(i - attn_body::BT_OFF) * N_HEADS_A + h] - far) * LOG2E;
}
__device__ __forceinline__ float lam_init_dev(int l) { return 0.8f - 0.6f * __expf(-0.3f * (float)l); }
__device__ __forceinline__ float lam_dev(const float* lqk_all, int l, int lane) {
    const float* q = lqk_all + (size_t)l * 4 * HEAD_DIM_A;
    const float s0 = wave_sum(q[lane] * q[HEAD_DIM_A + lane]), s1 = wave_sum(q[2 * HEAD_DIM_A + lane] * q[3 * HEAD_DIM_A + lane]);
    return __expf(s0) - __expf(s1) + lam_init_dev(l);
}
__device__ __forceinline__ int krow_dev(int s, int h, int j) { return 16 * s + 8 * (j >> 2) + 4 * h + (j & 3); }
__device__ __forceinline__ int crow_dev(int r, int h) { return (r & 3) + 8 * (r >> 2) + 4 * h; }
__device__ __forceinline__ bf16x8 pack_f8(const f32x4 a, const f32x4 b) { v4u w; w.x = pk2(a.x, a.y); w.y = pk2(a.z, a.w); w.z = pk2(b.x, b.y); w.w = pk2(b.z, b.w); return __builtin_bit_cast(bf16x8, w); }

__device__ __forceinline__ void sample_scores(f32x16& X, int kb, int c, const float* ck, const bf16* KN, int row0, int h, int hi, int r32, int qpos, const bf16x8 (&qf)[4], const LAS float* tab) {
    bf16x8 kf[4];
    if (kb < PAST_LEN / 32) { const float* kr = ck + (size_t)(kb * 32 + r32) * WIDTH_A + h * 128 + c * 64 + 8 * hi;
#pragma unroll
        for (int s = 0; s < 4; ++s) kf[s] = pack_f8(*(const GAS f32x4*)(kr + 16 * s), *(const GAS f32x4*)(kr + 16 * s + 4)); }
    else { const bf16* kr = KN + (size_t)(row0 + (kb * 32 - PAST_LEN) + r32) * WIDTH_A + h * 128 + c * 64 + 8 * hi;
#pragma unroll
        for (int s = 0; s < 4; ++s) kf[s] = *(const GAS bf16x8*)(kr + 16 * s); }
#pragma unroll
    for (int i = 0; i < 16; ++i) X[i] = 0.f;
#pragma unroll
    for (int s = 0; s < 4; ++s) X = __builtin_amdgcn_mfma_f32_32x32x16_bf16(kf[s], qf[s], X, 0, 0, 0);
#pragma unroll
    for (int i = 0; i < 16; ++i) { int idx = kb * 32 + crow_dev(i, hi) - qpos + attn_body::BT_OFF; idx = idx < 0 ? 0 : idx; X[i] += tab[idx]; }
}

__device__ __forceinline__ void attn_sample_unit(Frame& F, int l, int bs, int h) {
    const KArgs ap = kargs(); const auto& a = *ap; WS_OPAQUE(a);
    const int tid = otid(), lane = tid & 63, wid = __builtin_amdgcn_readfirstlane(tid >> 6), r32 = lane & 31, hi = lane >> 5;
    const bf16* QN = (const bf16*)(wsb + a.off[R_QN]); const bf16* KN = (const bf16*)(wsb + a.off[R_KN]); const bf16* Z = (const bf16*)(wsb + a.off[R_Z]); bf16* O = (bf16*)(wsb + a.off[R_O]);
    const float* ck = a.in[I_CK] + ((size_t)l * DEC_BATCH + bs) * PAST_LEN * WIDTH_A; const float* cv = a.in[I_CV] + ((size_t)l * DEC_BATCH + bs) * PAST_LEN * WIDTH_A;
    const int row0 = SROW0 + bs * DEC_SEQ;
    LAS float* tab = (LAS float*)(F.lds + RING_OFF + attn_body::LDS_BT);
    LAS float* st = (LAS float*)(F.lds + RING_OFF + 90112);
    LAS float* slot = (LAS float*)(F.lds + RING_OFF);
    const float lam = lam_dev(a.in[I_LQK], l, lane);
    build_bias_table(tab, a.in[I_REL], h, tid);
    bf16x8 qf[2][4];
#pragma unroll
    for (int c = 0; c < 2; ++c)
#pragma unroll
        for (int s = 0; s < 4; ++s) qf[c][s] = *(const GAS bf16x8*)(QN + (size_t)(row0 + r32) * WIDTH_A + h * 128 + c * 64 + 16 * s + 8 * hi);
    __syncthreads();
    float m[2] = {-1e30f, -1e30f}, lsum[2] = {0.f, 0.f};
    const int qpos = PAST_LEN + r32;
    for (int kb = wid; kb < (PAST_LEN + DEC_SEQ) / 32; kb += NWAVES) {
#pragma unroll
        for (int c = 0; c < 2; ++c) { f32x16 X; sample_scores(X, kb, c, ck, KN, row0, h, hi, r32, qpos, qf[c], tab);
            float mx = X[0];
#pragma unroll
            for (int i = 1; i < 16; ++i) mx = fmaxf(mx, X[i]);
            mx = fmaxf(mx, swap32(mx)); const float mn = fmaxf(m[c], mx);
            float sum = 0.f;
#pragma unroll
            for (int i = 0; i < 16; ++i) sum += exp2f(X[i] - mn);
            lsum[c] = lsum[c] * exp2f(m[c] - mn) + sum; m[c] = mn; }
    }
#pragma unroll
    for (int c = 0; c < 2; ++c) { lsum[c] += swap32(lsum[c]); if (hi == 0) { st[((wid * 2 + c) * 2 + 0) * 32 + r32] = m[c]; st[((wid * 2 + c) * 2 + 1) * 32 + r32] = lsum[c]; } }
    __syncthreads();
    float gm[2], ginv[2];
#pragma unroll
    for (int c = 0; c < 2; ++c) { float mm = -1e30f;
#pragma unroll
        for (int w = 0; w < NWAVES; ++w) mm = fmaxf(mm, st[((w * 2 + c) * 2 + 0) * 32 + r32]);
        float ll = 0.f;
#pragma unroll
        for (int w = 0; w < NWAVES; ++w) ll += st[((w * 2 + c) * 2 + 1) * 32 + r32] * exp2f(st[((w * 2 + c) * 2 + 0) * 32 + r32] - mm);
        gm[c] = mm; ginv[c] = (c == 0 ? 1.f : lam) / ll; }
    f32x16 acc[4];
#pragma unroll
    for (int eb = 0; eb < 4; ++eb)
#pragma unroll
        for (int i = 0; i < 16; ++i) acc[eb][i] = 0.f;
    for (int kb = wid; kb < (PAST_LEN + DEC_SEQ) / 32; kb += NWAVES) {
        f32x16 X0, X1; sample_scores(X0, kb, 0, ck, KN, row0, h, hi, r32, qpos, qf[0], tab); sample_scores(X1, kb, 1, ck, KN, row0, h, hi, r32, qpos, qf[1], tab);
        float wv[16];
#pragma unroll
        for (int i = 0; i < 16; ++i) wv[i] = exp2f(X0[i] - gm[0]) * ginv[0] - exp2f(X1[i] - gm[1]) * ginv[1];
        bf16x8 xs[2];
#pragma unroll
        for (int s = 0; s < 2; ++s) { v4u w; w.x = pk2(wv[8 * s], wv[8 * s + 1]); w.y = pk2(wv[8 * s + 2], wv[8 * s + 3]); w.z = pk2(wv[8 * s + 4], wv[8 * s + 5]); w.w = pk2(wv[8 * s + 6], wv[8 * s + 7]); xs[s] = __builtin_bit_cast(bf16x8, w); }
#pragma unroll
        for (int eb = 0; eb < 4; ++eb)
#pragma unroll
            for (int s = 0; s < 2; ++s) {
                float vv[8];
                if (kb < PAST_LEN / 32) { const float* vb = cv + (size_t)(kb * 32 + 4 * hi) * WIDTH_A + h * 128 + eb * 32 + r32; asm volatile("" : "+v"(vb));
#pragma unroll
                    for (int j = 0; j < 8; ++j) vv[j] = vb[(size_t)(16 * s + 8 * (j >> 2) + (j & 3)) * WIDTH_A]; }
                else { const bf16* vb = Z + (size_t)(row0 + kb * 32 - PAST_LEN + 4 * hi) * ZN + ZC_VA + h * 128 + eb * 32 + r32; asm volatile("" : "+v"(vb));
#pragma unroll
                    for (int j = 0; j < 8; ++j) vv[j] = bf2f(vb[(size_t)(16 * s + 8 * (j >> 2) + (j & 3)) * ZN]); }
                v4u w; w.x = pk2(vv[0], vv[1]); w.y = pk2(vv[2], vv[3]); w.z = pk2(vv[4], vv[5]); w.w = pk2(vv[6], vv[7]);
                acc[eb] = __builtin_amdgcn_mfma_f32_32x32x16_bf16(xs[s], __builtin_bit_cast(bf16x8, w), acc[eb], 0, 0, 0);
            }
    }
    __syncthreads();
#pragma unroll
    for (int eb = 0; eb < 4; ++eb)
#pragma unroll
        for (int i = 0; i < 16; ++i) slot[(wid * 32 + crow_dev(i, hi)) * 128 + eb * 32 + r32] = acc[eb][i];
    __syncthreads();
    { const int q = tid >> 4, e0 = (tid & 15) * 8; float o[8];
#pragma unroll
      for (int j = 0; j < 8; ++j) o[j] = 0.f;
#pragma unroll
      for (int w = 0; w < NWAVES; ++w)
#pragma unroll
          for (int j = 0; j < 8; ++j) o[j] += slot[(w * 32 + q) * 128 + e0 + j];
      v4u pw; pw.x = pk2(o[0], o[1]); pw.y = pk2(o[2], o[3]); pw.z = pk2(o[4], o[5]); pw.w = pk2(o[6], o[7]);
      bf16* orow = O + (size_t)(row0 + q) * attn_body::OP + h * 256;
      unsigned zq = 0u; asm volatile("" : "+v"(zq));
      *(GAS v4u*)(orow + e0) = pw; *(GAS v4u*)(orow + 128 + e0) = (v4u){zq, zq, zq, zq}; }
    __syncthreads();
}

constexpr int ATT_NQB = LPP / 256;
constexpr int ATT_NPU = BATCH * 16 * ATT_NQB;
constexpr int ATT_NSU = DEC_BATCH * N_HEADS_A;
__device__ __forceinline__ void p_attention(Frame& F, int lq, unsigned char* ldsg) {
    const int l = lq % DEPTH;
    for (;;) {
        const KArgs ap = kargs(); const auto& a = *ap; WS_OPAQUE(a);
        const int tid = otid();
        gu32* head = (gu32*)wsb + CW_QUEUE + 64 * lq;
        const attn_body::bf16* QN = (const attn_body::bf16*)(wsb + a.off[R_QN]); const attn_body::bf16* KN = (const attn_body::bf16*)(wsb + a.off[R_KN]);
        const attn_body::bf16* Z = (const attn_body::bf16*)(wsb + a.off[R_Z]); attn_body::bf16* O = (attn_body::bf16*)(wsb + a.off[R_O]);
        if (tid == 0) F.MISC[16] = __hip_atomic_fetch_add(head, 1u, RLX_AGENT);
        __syncthreads();
        const int u = (int)F.MISC[16];
        __syncthreads();
        if (u >= ATT_NPU + ATT_NSU) break;
        if (u < ATT_NPU) {
            const int qb = (ATT_NQB - 1) - u / 32, bvh = u % 32, b = bvh >> 4, vh = bvh & 15, h = vh >> 2, c = (vh >> 1) & 1, half = vh & 1;
            build_bias_table((LAS float*)(F.lds + RING_OFF + attn_body::LDS_BT), a.in[I_REL], h, tid);
            __syncthreads();
            attn_body::attn_unit<8>(b, h * 128 + c * 64, ZC_VA + h * 128 + half * 64, h * 256 + c * 128 + half * 64, qb, QN, KN, Z, O, (char*)ldsg + RING_OFF, F.wv);
        } else { const int su = u - ATT_NPU; attn_sample_unit(F, l, su >> 2, su & 3); }
    }
}
__device__ __forceinline__ void p_mixpost_a(Frame& F, int l) {
    const KArgs ap = kargs(); const auto& a = *ap; WS_OPAQUE(a);
    const int tid = otid(), lane = tid & 63, wave = __builtin_amdgcn_readfirstlane(tid >> 6);
    const bf16* O = (const bf16*)(wsb + a.off[R_O]); bf16* OA = (bf16*)(wsb + a.off[R_OA]);
    const int gw = F.vcu * NWAVES + wave, NGW = F.G * NWAVES;
    const float lam = lam_dev(a.in[I_LQK], l, lane), post = 1.f - lam_init_dev(l);
    const int h = lane >> 4, e0 = 8 * (lane & 15);
    float sg[8];
#pragma unroll
    for (int j = 0; j < 8; ++j) sg[j] = a.in[I_SUBLN][l * 2 * HEAD_DIM_A + e0 + j] * post;
    for (int m = gw; m < RP; m += NGW) {
        float o0[8], o1[8], d[8];
        unpack8(*(const GAS v4u*)(O + (size_t)m * 1024 + h * 256 + e0), o0); unpack8(*(const GAS v4u*)(O + (size_t)m * 1024 + h * 256 + 128 + e0), o1);
        float ss = 0.f;
#pragma unroll
        for (int j = 0; j < 8; ++j) { d[j] = o0[j] - lam * o1[j]; ss += d[j] * d[j]; }
        ss = sum16(ss);
        const float r = __builtin_amdgcn_rsqf(ss * (1.f / 128.f) + EPSF);
#pragma unroll
        for (int j = 0; j < 8; ++j) d[j] = d[j] * r * sg[j];
        *(GAS v4u*)(OA + (size_t)m * WIDTH_A + h * 128 + e0) = pack8(d);
    }
}
constexpr int GDN_NCH = PEND / 64;
constexpr int GDN_NPI = BATCH * N_HEADS_B * GDN_NCH;
constexpr int GDN_NSI = DEC_BATCH * N_HEADS_B;
constexpr int GDN_NI = GDN_NPI + GDN_NSI;
constexpr int GI_W = 0, GI_QG = 16384, GI_KG = 32768, GI_AT = 49152, GI_U = 57344, GI_SC = 73728, GI_STRIDE = 73984;
static_assert(GDN_NI % 4 == 0 && PEND % 64 == 0, "gdn items");
__device__ __forceinline__ int frag_off(int row, int kk, int nkb) {
    const int fid = ((row >> 5) * nkb + (kk >> 5)) * 2 + ((kk & 31) >> 4), ln = (row & 31) + 32 * (((kk & 15) >> 2) & 1), j = ((kk & 15) >> 3) * 4 + (kk & 3);
    return (fid * 64 + ln) * 8 + j;
}
__device__ __forceinline__ int gdn_item_row(int item, int j) {
    if (item < GDN_NPI) { const int sh = item / GDN_NCH, n = item % GDN_NCH; return (sh / N_HEADS_B) * LPP + 64 * n + j; }
    const int s = item - GDN_NPI; return j < 32 ? -1 : SROW0 + (s >> 2) * DEC_SEQ + (j - 32);
}
__device__ __forceinline__ int gdn_item_head(int item) { return item < GDN_NPI ? (item / GDN_NCH) % N_HEADS_B : (item - GDN_NPI) & 3; }

__device__ __forceinline__ void gdn_flush(const LAS unsigned char* stg, unsigned char* dst, int nbytes, int gt) {
    for (int o = gt * 16; o < nbytes; o += 2048) *(GAS v4u*)(dst + o) = *(const LAS v4u*)(stg + o);
}
typedef float f32x2s __attribute__((ext_vector_type(2)));
#define GDN_RL8(a, arow, jb) asm volatile("v_readlane_b32 %0, %8, %9\n\tv_readlane_b32 %1, %8, %10\n\tv_readlane_b32 %2, %8, %11\n\tv_readlane_b32 %3, %8, %12\n\tv_readlane_b32 %4, %8, %13\n\tv_readlane_b32 %5, %8, %14\n\tv_readlane_b32 %6, %8, %15\n\tv_readlane_b32 %7, %8, %16" \
    : "=s"(a[0]), "=s"(a[1]), "=s"(a[2]), "=s"(a[3]), "=s"(a[4]), "=s"(a[5]), "=s"(a[6]), "=s"(a[7]) : "v"(arow), "i"(jb), "i"((jb) + 1), "i"((jb) + 2), "i"((jb) + 3), "i"((jb) + 4), "i"((jb) + 5), "i"((jb) + 6), "i"((jb) + 7))
template <int I, int JB> __device__ __forceinline__ void gdn_subst_blk(f32x2s (&x)[64], float arow) {
    if constexpr (JB < I) { float ar[8]; GDN_RL8(ar, arow, JB);
#pragma unroll
        for (int t = 0; t < 8; ++t) if (JB + t < I) x[I] -= ar[t] * x[JB + t];
        gdn_subst_blk<I, JB + 8>(x, arow); }
}
template <int... Is> __device__ __forceinline__ void gdn_subst_all(f32x2s (&x)[64], const LAS float* A, int lane, std::integer_sequence<int, Is...>) {
    (gdn_subst_blk<Is + 1, 0>(x, A[(Is + 1) * 64 + lane]), ...);
}
__device__ __forceinline__ void p_gdn_chunk(Frame& F, int l) {
    const KArgs ap = kargs(); const auto& a = *ap; WS_OPAQUE(a);
    const int tid = otid(), wave = __builtin_amdgcn_readfirstlane(tid >> 6), grp = wave >> 1, gw = wave & 1;
    const bf16* QKVB = (const bf16*)(wsb + a.off[R_QKVB]); const float* BG = (const float*)(wsb + a.off[R_BG]); unsigned char* GD = wsb + a.off[R_GDN];
    LAS float* A_lds = (LAS float*)(F.lds + RING_OFF + grp * 34816);
    LAS float* Gs = A_lds + 4096; LAS float* Bs = Gs + 64; LAS float* Es = Bs + 64;
    LAS unsigned char* stg = (LAS unsigned char*)(A_lds + 4096 + 256);
    LAS bf16* stgh = (LAS bf16*)stg;
    static_assert(4 * 34816 <= RING_BYTES && GDN_NI % 4 == 0, "gdn chunk LDS / items");
    for (int pr = F.vcu; 4 * pr < GDN_NI; pr += F.G) {
        int lane_ = otid() & 63;
        const int lane = lane_, r32 = lane & 31, hi = lane >> 5, gt = gw * 64 + lane;
        const int item = 4 * pr + grp, h = gdn_item_head(item);
        unsigned char* ib = GD + (size_t)item * GI_STRIDE;
        const int rowt = gdn_item_row(item, lane);
        const float beta = rowt >= 0 ? BG[(size_t)rowt * 8 + h] : 0.f; float G = rowt >= 0 ? BG[(size_t)rowt * 8 + 4 + h] : 0.f;
        G = scan64(G);
        const float Glast = rdlane(G, 63), eG = __expf(G);
        if (gw == 0) { Gs[lane] = G; Bs[lane] = beta; Es[lane] = eG; if (lane == 0) *(float*)(ib + GI_SC) = __expf(Glast); }
        __syncthreads();
#pragma unroll
        for (int bq = 0; bq < 2; ++bq) {
          const int i0 = 32 * gw, j0 = 32 * bq; const int j = j0 + r32;
          if (gw == 0 && bq == 1) {
#pragma unroll
              for (int r = 0; r < 16; ++r) { const int i = crow_dev(r, hi); A_lds[i * 64 + j] = 0.f; stgh[frag_off(i, j, 2)] = (bf16)0; }
          } else {
          const int ra = gdn_item_row(item, i0 + r32), rb = gdn_item_row(item, j0 + r32);
          f32x16 akk, aqk;
#pragma unroll
          for (int r = 0; r < 16; ++r) { akk[r] = 0.f; aqk[r] = 0.f; }
          const bf16x8 zf = {0, 0, 0, 0, 0, 0, 0, 0};
#pragma unroll
          for (int s = 0; s < 8; ++s) {
              const bf16x8 qa = ra >= 0 ? *(const GAS bf16x8*)(QKVB + (size_t)ra * 1536 + h * 128 + 16 * s + 8 * hi) : zf;
              const bf16x8 ka = ra >= 0 ? *(const GAS bf16x8*)(QKVB + (size_t)ra * 1536 + 512 + h * 128 + 16 * s + 8 * hi) : zf;
              const bf16x8 kb = rb >= 0 ? *(const GAS bf16x8*)(QKVB + (size_t)rb * 1536 + 512 + h * 128 + 16 * s + 8 * hi) : zf;
              akk = __builtin_amdgcn_mfma_f32_32x32x16_bf16(ka, kb, akk, 0, 0, 0); aqk = __builtin_amdgcn_mfma_f32_32x32x16_bf16(qa, kb, aqk, 0, 0, 0);
          }
          const float Gj = Gs[j];
#pragma unroll
          for (int r = 0; r < 16; ++r) { const int i = i0 + crow_dev(r, hi); const float dec = i >= j ? __expf(Gs[i] - Gj) : 0.f;
              A_lds[i * 64 + j] = i > j ? Bs[i] * akk[r] * dec : 0.f;
              stgh[frag_off(i, j, 2)] = (bf16)f2bf(aqk[r] * dec); }
          }
        }
        __syncthreads();
        gdn_flush(stg, ib + GI_AT, 8192, gt);
        { f32x2s x[64]; const int cbase = gw == 0 ? 1024 + h * 128 : 512 + h * 128;
#pragma unroll
          for (int i = 0; i < 64; ++i) { const int ri = __builtin_amdgcn_readfirstlane(gdn_item_row(item, i));
              const bf16* rowp = QKVB + (size_t)(ri < 0 ? 0 : ri) * 1536 + cbase;
              x[i] = ri >= 0 ? (f32x2s){bf2f(rowp[lane]), bf2f(rowp[lane + 64])} : (f32x2s){0.f, 0.f}; }
          const float rsc = gw == 0 ? beta : beta * eG;
#pragma unroll
          for (int i = 0; i < 64; ++i) x[i] *= rdlane(rsc, i);
          gdn_subst_all(x, A_lds, lane, std::make_integer_sequence<int, 63>{});
          __syncthreads();
          if (gw == 0) { bf16* ub = (bf16*)(ib + GI_U) + lane; asm volatile("" : "+v"(ub));
#pragma unroll
              for (int i = 0; i < 64; ++i) { ub[i * 128] = (bf16)f2bf(x[i].x); ub[i * 128 + 64] = (bf16)f2bf(x[i].y); } }
          else { LAS bf16* wb0 = stgh + frag_off(0, lane, 4); LAS bf16* wb1 = stgh + frag_off(0, lane + 64, 4);
#pragma unroll
              for (int i = 0; i < 64; ++i) { wb0[(i >> 5) * 4096 + (i & 31) * 8] = (bf16)f2bf(x[i].x); wb1[(i >> 5) * 4096 + (i & 31) * 8] = (bf16)f2bf(x[i].y); } }
        }
        __syncthreads();
        gdn_flush(stg, ib + GI_W, 16384, gt);
        __syncthreads();
        const float kgs = __expf(Glast - G);
#pragma unroll
        for (int hf = 0; hf < 2; ++hf) { float qv[32];
#pragma unroll
          for (int it = 0; it < 32; ++it) { const int c = it + 32 * hf, rc = __builtin_amdgcn_readfirstlane(gdn_item_row(item, c)); const bf16* rowp = QKVB + (size_t)(rc < 0 ? 0 : rc) * 1536 + h * 128; qv[it] = rc >= 0 ? bf2f(rowp[gt]) : 0.f; }
#pragma unroll
          for (int it = 0; it < 32; ++it) { const int c = it + 32 * hf; stgh[frag_off(c, gt, 4)] = (bf16)f2bf(qv[it] * rdlane(eG, c)); } }
        __syncthreads();
        gdn_flush(stg, ib + GI_QG, 16384, gt);
        __syncthreads();
#pragma unroll
        for (int hf = 0; hf < 2; ++hf) { float kv[32];
#pragma unroll
          for (int it = 0; it < 32; ++it) { const int c = it + 32 * hf, rc = __builtin_amdgcn_readfirstlane(gdn_item_row(item, c)); const bf16* rowp = QKVB + (size_t)(rc < 0 ? 0 : rc) * 1536 + 512 + h * 128; kv[it] = rc >= 0 ? bf2f(rowp[gt]) : 0.f; }
#pragma unroll
          for (int it = 0; it < 32; ++it) { const int c = it + 32 * hf; stgh[frag_off(gt, c, 2)] = (bf16)f2bf(kv[it] * rdlane(kgs, c)); } }
        __syncthreads();
        gdn_flush(stg, ib + GI_KG, 16384, gt);
        __syncthreads();
    }
}

__device__ __forceinline__ void gdn_chain(const unsigned char* GD, bf16* OB, const float* sdelta, float* dout, int item0, int nch, int h, int vb, int lane) {
    const int r32 = lane & 31, hi = lane >> 5;
    f32x16 S[4];
#pragma unroll
    for (int kb = 0; kb < 4; ++kb)
#pragma unroll
        for (int r = 0; r < 16; ++r) S[kb][r] = sdelta ? sdelta[(size_t)(kb * 32 + crow_dev(r, hi)) * HEAD_DIM_B + vb * 32 + r32] : 0.f;
    for (int n = 0; n < nch; ++n) {
        const int item = item0 + n; const unsigned char* ib = GD + (size_t)item * GI_STRIDE;
        const float eGl = *(const float*)(ib + GI_SC);
        const GAS bf16x8* WF = (const GAS bf16x8*)(ib + GI_W) + lane; const GAS bf16x8* QF = (const GAS bf16x8*)(ib + GI_QG) + lane;
        const GAS bf16x8* KF = (const GAS bf16x8*)(ib + GI_KG) + lane; const GAS bf16x8* AF = (const GAS bf16x8*)(ib + GI_AT) + lane; const bf16* U = (const bf16*)(ib + GI_U);
        bf16x8 Sp[4][2];
#pragma unroll
        for (int kb = 0; kb < 4; ++kb)
#pragma unroll
            for (int s = 0; s < 2; ++s) { v4u w; w.x = pk2(S[kb][8 * s], S[kb][8 * s + 1]); w.y = pk2(S[kb][8 * s + 2], S[kb][8 * s + 3]); w.z = pk2(S[kb][8 * s + 4], S[kb][8 * s + 5]); w.w = pk2(S[kb][8 * s + 6], S[kb][8 * s + 7]); Sp[kb][s] = __builtin_bit_cast(bf16x8, w); }
        f32x16 vn[2], ot[2];
#pragma unroll
        for (int cb = 0; cb < 2; ++cb) {
            f32x16 ws;
#pragma unroll
            for (int r = 0; r < 16; ++r) { ws[r] = 0.f; ot[cb][r] = 0.f; }
#pragma unroll
            for (int kb = 0; kb < 4; ++kb)
#pragma unroll
                for (int s = 0; s < 2; ++s) { ws = __builtin_amdgcn_mfma_f32_32x32x16_bf16(WF[((cb * 4 + kb) * 2 + s) * 64], Sp[kb][s], ws, 0, 0, 0);
                    ot[cb] = __builtin_amdgcn_mfma_f32_32x32x16_bf16(QF[((cb * 4 + kb) * 2 + s) * 64], Sp[kb][s], ot[cb], 0, 0, 0); }
#pragma unroll
            for (int r = 0; r < 16; ++r) vn[cb][r] = bf2f(U[(cb * 32 + crow_dev(r, hi)) * 128 + vb * 32 + r32]) - ws[r];
        }
        bf16x8 Vp[2][2];
#pragma unroll
        for (int cb = 0; cb < 2; ++cb)
#pragma unroll
            for (int s = 0; s < 2; ++s) { v4u w; w.x = pk2(vn[cb][8 * s], vn[cb][8 * s + 1]); w.y = pk2(vn[cb][8 * s + 2], vn[cb][8 * s + 3]); w.z = pk2(vn[cb][8 * s + 4], vn[cb][8 * s + 5]); w.w = pk2(vn[cb][8 * s + 6], vn[cb][8 * s + 7]); Vp[cb][s] = __builtin_bit_cast(bf16x8, w); }
#pragma unroll
        for (int cb = 0; cb < 2; ++cb)
#pragma unroll
            for (int c2 = 0; c2 <= cb; ++c2)
#pragma unroll
                for (int s = 0; s < 2; ++s) ot[cb] = __builtin_amdgcn_mfma_f32_32x32x16_bf16(AF[((cb * 2 + c2) * 2 + s) * 64], Vp[c2][s], ot[cb], 0, 0, 0);
#pragma unroll
        for (int cb = 0; cb < 2; ++cb)
#pragma unroll
            for (int r = 0; r < 16; ++r) { const int row = gdn_item_row(item, cb * 32 + crow_dev(r, hi)); if (row >= 0) OB[(size_t)row * WIDTH_B + h * 128 + vb * 32 + r32] = (bf16)f2bf(ot[cb][r]); }
#pragma unroll
        for (int kb = 0; kb < 4; ++kb) {
#pragma unroll
            for (int r = 0; r < 16; ++r) S[kb][r] *= eGl;
#pragma unroll
            for (int cb = 0; cb < 2; ++cb)
#pragma unroll
                for (int s = 0; s < 2; ++s) S[kb] = __builtin_amdgcn_mfma_f32_32x32x16_bf16(KF[((kb * 2 + cb) * 2 + s) * 64], Vp[cb][s], S[kb], 0, 0, 0);
        }
    }
#pragma unroll
    for (int kb = 0; kb < 4; ++kb)
#pragma unroll
        for (int r = 0; r < 16; ++r) dout[(size_t)(kb * 32 + crow_dev(r, hi)) * HEAD_DIM_B + vb * 32 + r32] = S[kb][r];
}
constexpr int GCH_BUF = 73728, GCH_PCS = 18;
#define GCH_BAR() do { asm volatile("s_waitcnt lgkmcnt(0)" ::: "memory"); __builtin_amdgcn_s_barrier(); asm volatile("" ::: "memory"); } while (0)
__device__ __forceinline__ void gdn_chain_wg(Frame& F, const unsigned char* GD, bf16* OB, float* dout, int item0, int h) {
    const int tid = otid(), lane = tid & 63, wave = __builtin_amdgcn_readfirstlane(tid >> 6), r32 = lane & 31, hi = lane >> 5, vb = wave & 3;
    LAS unsigned char* lb = F.lds + RING_OFF;
    if (wave >= 4) {
        const int p0 = (wave - 4) * GCH_PCS;
        v4u R0[GCH_PCS], R1[GCH_PCS];
#define GCH_LOAD(R, c) do { const unsigned char* s_ = GD + (size_t)(item0 + (c)) * GI_STRIDE + (size_t)p0 * 1024 + lane * 16; _Pragma("unroll") for (int j = 0; j < GCH_PCS; ++j) \
            asm volatile("global_load_dwordx4 %0, %1, off" : "=&v"(R[j]) : "v"(s_ + j * 1024) : "memory"); } while (0)
#define GCH_PUT(R, c) do { if ((c) + 1 < GDN_NCH) asm volatile("s_waitcnt vmcnt(18)" ::: "memory"); else asm volatile("s_waitcnt vmcnt(0)" ::: "memory"); \
            LAS v4u* d_ = (LAS v4u*)(lb + ((c) & 1) * GCH_BUF + p0 * 1024) + lane; _Pragma("unroll") for (int j = 0; j < GCH_PCS; ++j) d_[j * 64] = R[j]; } while (0)
        GCH_LOAD(R0, 0); GCH_LOAD(R1, 1);
        GCH_PUT(R0, 0); GCH_LOAD(R0, 2);
        GCH_BAR();
        for (int n = 0; n < GDN_NCH; n += 2) {
            if (n + 1 < GDN_NCH) GCH_PUT(R1, n + 1);
            if (n + 3 < GDN_NCH) GCH_LOAD(R1, n + 3);
            GCH_BAR();
            if (n + 1 < GDN_NCH) {
                if (n + 2 < GDN_NCH) GCH_PUT(R0, n + 2);
                if (n + 4 < GDN_NCH) GCH_LOAD(R0, n + 4);
                GCH_BAR(); }
        }
        asm volatile("s_waitcnt vmcnt(0)" ::: "memory");
#undef GCH_LOAD
#undef GCH_PUT
        return;
    }
    f32x16 S[4];
#pragma unroll
    for (int kb = 0; kb < 4; ++kb)
#pragma unroll
        for (int r = 0; r < 16; ++r) S[kb][r] = 0.f;
    float eg0 = *(const float*)(GD + (size_t)item0 * GI_STRIDE + GI_SC), eg1 = *(const float*)(GD + (size_t)(item0 + 1) * GI_STRIDE + GI_SC);
    GCH_BAR();
    for (int n = 0; n < GDN_NCH; ++n) {
        const int item = item0 + n; const LAS unsigned char* bufc = lb + (n & 1) * GCH_BUF;
        const float egl = eg0; eg0 = eg1; if (n + 2 < GDN_NCH) eg1 = *(const float*)(GD + (size_t)(item + 2) * GI_STRIDE + GI_SC);
        const LAS bf16x8* WF = (const LAS bf16x8*)(bufc + GI_W) + lane; const LAS bf16x8* QF = (const LAS bf16x8*)(bufc + GI_QG) + lane;
        const LAS bf16x8* KF = (const LAS bf16x8*)(bufc + GI_KG) + lane; const LAS bf16x8* AF = (const LAS bf16x8*)(bufc + GI_AT) + lane; const LAS bf16* U = (const LAS bf16*)(bufc + GI_U);
        bf16x8 Sp[4][2];
#pragma unroll
        for (int kb = 0; kb < 4; ++kb)
#pragma unroll
            for (int s = 0; s < 2; ++s) { v4u w; w.x = pk2(S[kb][8 * s], S[kb][8 * s + 1]); w.y = pk2(S[kb][8 * s + 2], S[kb][8 * s + 3]); w.z = pk2(S[kb][8 * s + 4], S[kb][8 * s + 5]); w.w = pk2(S[kb][8 * s + 6], S[kb][8 * s + 7]); Sp[kb][s] = __builtin_bit_cast(bf16x8, w); }
        f32x16 vn[2], ot[2];
#pragma unroll
        for (int cb = 0; cb < 2; ++cb) {
            f32x16 ws;
#pragma unroll
            for (int r = 0; r < 16; ++r) { ws[r] = 0.f; ot[cb][r] = 0.f; }
#pragma unroll
            for (int kb = 0; kb < 4; ++kb)
#pragma unroll
                for (int s = 0; s < 2; ++s) { ws = __builtin_amdgcn_mfma_f32_32x32x16_bf16(WF[((cb * 4 + kb) * 2 + s) * 64], Sp[kb][s], ws, 0, 0, 0);
                    ot[cb] = __builtin_amdgcn_mfma_f32_32x32x16_bf16(QF[((cb * 4 + kb) * 2 + s) * 64], Sp[kb][s], ot[cb], 0, 0, 0); }
#pragma unroll
            for (int r = 0; r < 16; ++r) vn[cb][r] = bf2f(U[(cb * 32 + crow_dev(r, hi)) * 128 + vb * 32 + r32]) - ws[r];
        }
        bf16x8 Vp[2][2];
#pragma unroll
        for (int cb = 0; cb < 2; ++cb)
#pragma unroll
            for (int s = 0; s < 2; ++s) { v4u w; w.x = pk2(vn[cb][8 * s], vn[cb][8 * s + 1]); w.y = pk2(vn[cb][8 * s + 2], vn[cb][8 * s + 3]); w.z = pk2(vn[cb][8 * s + 4], vn[cb][8 * s + 5]); w.w = pk2(vn[cb][8 * s + 6], vn[cb][8 * s + 7]); Vp[cb][s] = __builtin_bit_cast(bf16x8, w); }
#pragma unroll
        for (int cb = 0; cb < 2; ++cb)
#pragma unroll
            for (int c2 = 0; c2 <= cb; ++c2)
#pragma unroll
                for (int s = 0; s < 2; ++s) ot[cb] = __builtin_amdgcn_mfma_f32_32x32x16_bf16(AF[((cb * 2 + c2) * 2 + s) * 64], Vp[c2][s], ot[cb], 0, 0, 0);
        { const int row0 = gdn_item_row(item, 0);
#pragma unroll
          for (int cb = 0; cb < 2; ++cb)
#pragma unroll
              for (int r = 0; r < 16; ++r) OB[(size_t)(row0 + cb * 32 + crow_dev(r, hi)) * WIDTH_B + h * 128 + vb * 32 + r32] = (bf16)f2bf(ot[cb][r]); }
#pragma unroll
        for (int kb = 0; kb < 4; ++kb) {
#pragma unroll
            for (int r = 0; r < 16; ++r) S[kb][r] *= egl;
#pragma unroll
            for (int cb = 0; cb < 2; ++cb)
#pragma unroll
                for (int s = 0; s < 2; ++s) S[kb] = __builtin_amdgcn_mfma_f32_32x32x16_bf16(KF[((kb * 2 + cb) * 2 + s) * 64], Vp[cb][s], S[kb], 0, 0, 0);
        }
        GCH_BAR();
    }
#pragma unroll
    for (int kb = 0; kb < 4; ++kb)
#pragma unroll
        for (int r = 0; r < 16; ++r) dout[(size_t)(kb * 32 + crow_dev(r, hi)) * HEAD_DIM_B + vb * 32 + r32] = S[kb][r];
}
__device__ __forceinline__ void p_gdn_chain(Frame& F, int l) {
    const KArgs ap = kargs(); const auto& a = *ap; WS_OPAQUE(a);
    const unsigned char* GD = wsb + a.off[R_GDN]; bf16* OB = (bf16*)(wsb + a.off[R_OB]);
    if (F.vcu % 32 == 0 && F.vcu / 32 < BATCH * N_HEADS_B) { const int sh = F.vcu / 32, sq = sh / N_HEADS_B, h = sh % N_HEADS_B;
        gdn_chain_wg(F, GD, OB, a.out + O_DP + (((size_t)l * BATCH + sq) * N_HEADS_B + h) * HEAD_DIM_B * HEAD_DIM_B, sh * GDN_NCH, h); }
    else { const int tid = otid(), lane = tid & 63, wave = __builtin_amdgcn_readfirstlane(tid >> 6);
        const int t = (F.vcu - F.vcu / 32 - 1) * NWAVES + wave;
        if (t < GDN_NSI * 4) { const int s = t >> 2, vb = t & 3, bs = s >> 2, h = s & 3; const size_t so = (((size_t)l * DEC_BATCH + bs) * N_HEADS_B + h) * HEAD_DIM_B * HEAD_DIM_B;
            gdn_chain(GD, OB, a.in[I_SDELTA] + so, a.out + O_DS + so, GDN_NPI + s, 1, h, vb, lane); } }
}
__device__ __forceinline__ void p_mixpost_b(Frame& F, int l) {
    const KArgs ap = kargs(); const auto& a = *ap; WS_OPAQUE(a);
    const int tid = otid(), lane = tid & 63, wave = __builtin_amdgcn_readfirstlane(tid >> 6);
    const bf16* OB = (const bf16*)(wsb + a.off[R_OB]); bf16* OBN = (bf16*)(wsb + a.off[R_OBN]); const bf16* Z = (const bf16*)(wsb + a.off[R_Z]);
    const int gw = F.vcu * NWAVES + wave, NGW = F.G * NWAVES, e0 = 8 * (lane & 15);
    float gn[8];
#pragma unroll
    for (int j = 0; j < 8; ++j) gn[j] = a.in[I_GDNN][l * HEAD_DIM_B + e0 + j];
    for (int m = gw; m < RP; m += NGW) {
        float o[8], gt[8];
        unpack8(*(const GAS v4u*)(OB + (size_t)m * WIDTH_B + 8 * lane), o); unpack8(*(const GAS v4u*)(Z + (size_t)m * ZN + ZC_GB + 8 * lane), gt);
        float ss = 0.f;
#pragma unroll
        for (int j = 0; j < 8; ++j) ss += o[j] * o[j];
        ss = sum16(ss);
        const float r = __builtin_amdgcn_rsqf(ss * (1.f / 128.f) + EPSF);
#pragma unroll
        for (int j = 0; j < 8; ++j) o[j] = o[j] * r * gn[j] * gt[j] * sigm(gt[j]);
        *(GAS v4u*)(OBN + (size_t)m * WIDTH_B + 8 * lane) = pack8(o);
    }
}
constexpr int S5_M1 = 0, S5_M2 = 131072, S5_M3 = 196608, S5_L16 = 262144, S5_TSTRIDE = 262656;
constexpr int S5_NCHK = RP / 16;
constexpr int S5_NBLK = S5_NCHK / 32;
constexpr int S5_PCH = PEND / 16;
static_assert(S5_NCHK % 32 == 0 && LPP % 16 == 0 && PADF % 16 == 0 && S5_STATE == 64 && S5_GROUPS == 32, "s5 shapes");

__device__ __forceinline__ void s5_tables(Frame& F) {
    const KArgs ap = kargs(); const auto& a = *ap; WS_OPAQUE(a);
    const int tid = otid();
    LAS float* pw = (LAS float*)(F.lds + RING_OFF);
    LAS float* bb = pw + 17 * 128;
    LAS float* Kt = bb + 64 * 32;
    for (int it = F.vcu; it < DEPTH * S5_GROUPS; it += F.G) {
        const int l = it / S5_GROUPS, g = it % S5_GROUPS; const size_t gp = ((size_t)l * S5_GROUPS + g) * S5_STATE;
        unsigned char* tb = wsb + a.off[R_S5T] + (size_t)it * S5_TSTRIDE;
        const float dt = __expf(a.in[I_LDT][l * S5_GROUPS + g]);
        for (int e = tid; e < 17 * 64; e += NTHR) { const int k = e >> 6, p = e & 63; const float ar = a.in[I_AR][gp + p] * dt * (float)k, ai = a.in[I_AI][gp + p] * dt * (float)k;
            float sn, cs; sincosf(ai, &sn, &cs); const float er = expf(ar); pw[e * 2] = er * cs; pw[e * 2 + 1] = er * sn; }
        __syncthreads();
        for (int e = tid; e < 64 * 16; e += NTHR) { const int p = e >> 4; const float ar = a.in[I_AR][gp + p], ai = a.in[I_AI][gp + p];
            const float nr = pw[(64 + p) * 2] - 1.f, ni = pw[(64 + p) * 2 + 1], den = ar * ar + ai * ai, fr = (nr * ar + ni * ai) / den, fi = (ni * ar - nr * ai) / den;
            const float br = a.in[I_BR][gp * 16 + e], bi = a.in[I_BI][gp * 16 + e]; bb[e * 2] = fr * br - fi * bi; bb[e * 2 + 1] = fr * bi + fi * br; }
        if (tid < 128) { const int p = tid & 63; ((float*)(tb + S5_L16))[tid] = pw[(16 * 64 + p) * 2 + (tid >> 6)]; }
        __syncthreads();
        const float* cre = a.in[I_CR] + ((size_t)l * S5_GROUPS + g) * 16 * 64; const float* cim = a.in[I_CI] + ((size_t)l * S5_GROUPS + g) * 16 * 64;
        for (int e = tid; e < 4096; e += NTHR) { const int d = e >> 8, i = (e >> 4) & 15, j = e & 15; float acc = 0.f;
            for (int p = 0; p < 64; ++p) { const float cr = cre[i * 64 + p], ci = cim[i * 64 + p], pr = pw[(d * 64 + p) * 2], pi = pw[(d * 64 + p) * 2 + 1];
                const float tr = cr * pr - ci * pi, ti = cr * pi + ci * pr; acc += tr * bb[(p * 16 + j) * 2] - ti * bb[(p * 16 + j) * 2 + 1]; }
            Kt[e] = acc; }
        __syncthreads();
        bf16* M1 = (bf16*)(tb + S5_M1); bf16* M2 = (bf16*)(tb + S5_M2); bf16* M3 = (bf16*)(tb + S5_M3);
        for (int e = tid; e < 65536; e += NTHR) { const int n = e >> 8, k = e & 255, tau = n >> 4, i = n & 15, sg = k >> 4, j = k & 15;
            float v = 0.f; if (sg <= tau) { v = Kt[((tau - sg) * 16 + i) * 16 + j]; if (sg == tau && i == j) v += a.in[I_SD][(l * S5_GROUPS + g) * 16 + i]; }
            M1[e] = (bf16)f2bf(v); }
        for (int e = tid; e < 32768; e += NTHR) { const int n = e >> 8, k = e & 255, ri = n >> 6, p = n & 63, sg = k >> 4, j = k & 15;
            const float pr = pw[((15 - sg) * 64 + p) * 2], pi = pw[((15 - sg) * 64 + p) * 2 + 1], br = bb[(p * 16 + j) * 2], bi = bb[(p * 16 + j) * 2 + 1];
            M2[e] = (bf16)f2bf(ri == 0 ? pr * br - pi * bi : pr * bi + pi * br); }
        for (int e = tid; e < 32768; e += NTHR) { const int n = e >> 7, k = e & 127, tau = n >> 4, i = n & 15, ri = k >> 6, p = k & 63;
            const float cr = cre[i * 64 + p], ci = cim[i * 64 + p], pr = pw[((tau + 1) * 64 + p) * 2], pi = pw[((tau + 1) * 64 + p) * 2 + 1];
            M3[e] = (bf16)f2bf(ri == 0 ? cr * pr - ci * pi : -(cr * pi + ci * pr)); }
        __syncthreads();
    }
}
__device__ __forceinline__ void p_s5_e(Frame& F, int l) {
    const KArgs ap = kargs(); const auto& a = *ap; WS_OPAQUE(a);
    const int tid = otid(), lane = tid & 63, wave = __builtin_amdgcn_readfirstlane(tid >> 6), r32 = lane & 31, hi = lane >> 5;
    const bf16* Z = (const bf16*)(wsb + a.off[R_Z]); float* E = (float*)(wsb + a.off[R_S5E]);
    for (int u = F.vcu * NWAVES + wave; u < S5_NBLK * S5_GROUPS; u += F.G * NWAVES) {
        const int blk = u / S5_GROUPS, g = u % S5_GROUPS;
        const unsigned char* tb = wsb + a.off[R_S5T] + (size_t)(l * S5_GROUPS + g) * S5_TSTRIDE;
        const GAS bf16x8* M2 = (const GAS bf16x8*)(tb + S5_M2);
        const bf16* zr = Z + (size_t)((blk * 32 + r32) * 16) * ZN + ZC_UC + g * 16 + 8 * hi;
        f32x16 acc[4];
#pragma unroll
        for (int nb = 0; nb < 4; ++nb)
#pragma unroll
            for (int r = 0; r < 16; ++r) acc[nb][r] = 0.f;
#pragma unroll 4
        for (int sg = 0; sg < 16; ++sg) { const bf16x8 af = *(const GAS bf16x8*)(zr + (size_t)sg * ZN);
#pragma unroll
            for (int nb = 0; nb < 4; ++nb) acc[nb] = __builtin_amdgcn_mfma_f32_32x32x16_bf16(af, M2[((nb * 32 + r32) * 256 + sg * 16 + 8 * hi) >> 3], acc[nb], 0, 0, 0); }
#pragma unroll
        for (int nb = 0; nb < 4; ++nb)
#pragma unroll
            for (int r = 0; r < 16; ++r) E[((size_t)(blk * 32 + crow_dev(r, hi)) * S5_GROUPS + g) * 128 + nb * 32 + r32] = acc[nb][r];
    }
}
__device__ __forceinline__ void s5_scan_task(const float* E, bf16* XP, const float* l16, int g, int c0, int nch, float xr, float xi, float* ore, float* oim, int lane) {
    const float lr = l16[lane], li = l16[64 + lane];
    int c = 0;
    for (; c + 8 <= nch; c += 8) { float er[8], ei[8];
#pragma unroll
        for (int q = 0; q < 8; ++q) { const float* e = E + ((size_t)(c0 + c + q) * S5_GROUPS + g) * 128; er[q] = e[lane]; ei[q] = e[64 + lane]; }
#pragma unroll
        for (int q = 0; q < 8; ++q) { bf16* xp = XP + ((size_t)(c0 + c + q) * S5_GROUPS + g) * 128; xp[lane] = (bf16)f2bf(xr); xp[64 + lane] = (bf16)f2bf(xi);
            const float nr = lr * xr - li * xi + er[q], ni = lr * xi + li * xr + ei[q]; xr = nr; xi = ni; } }
    for (; c < nch; ++c) { const float* e = E + ((size_t)(c0 + c) * S5_GROUPS + g) * 128; bf16* xp = XP + ((size_t)(c0 + c) * S5_GROUPS + g) * 128; xp[lane] = (bf16)f2bf(xr); xp[64 + lane] = (bf16)f2bf(xi);
        const float nr = lr * xr - li * xi + e[lane], ni = lr * xi + li * xr + e[64 + lane]; xr = nr; xi = ni; }
    ore[lane] = xr; oim[lane] = xi;
}
constexpr int S5_NTASK = (BATCH + DEC_BATCH) * S5_GROUPS;
__device__ __forceinline__ void s5_scan_run(Frame& F, int l, int t, int lane) {
    const KArgs ap = kargs(); const auto& a = *ap; WS_OPAQUE(a);
    const int sq = t / S5_GROUPS, g = t % S5_GROUPS;
    const float* E = (const float*)(wsb + a.off[R_S5E]); bf16* XP = (bf16*)(wsb + a.off[R_S5X]);
    const float* l16 = (const float*)(wsb + a.off[R_S5T] + (size_t)(l * S5_GROUPS + g) * S5_TSTRIDE + S5_L16);
    if (sq < BATCH) { const size_t oo = (((size_t)l * BATCH + sq) * S5_GROUPS + g) * S5_STATE;
        s5_scan_task(E, XP, l16, g, sq * (LPP / 16), S5_PCH, 0.f, 0.f, a.out + O_SRP + oo, a.out + O_SIP + oo, lane); }
    else { const int bs = sq - BATCH; const size_t oo = (((size_t)l * DEC_BATCH + bs) * S5_GROUPS + g) * S5_STATE;
        s5_scan_task(E, XP, l16, g, SROW0 / 16 + bs * (DEC_SEQ / 16), DEC_SEQ / 16, a.in[I_SRE][oo + lane], a.in[I_SIM][oo + lane], a.out + O_SRS + oo, a.out + O_SIS + oo, lane); }
}
__device__ __forceinline__ float gelu_tanh(float x) { const float z = 0.7978845608028654f * (x + 0.044715f * x * x * x); const float t = 1.f - 2.f * __builtin_amdgcn_rcpf(__expf(2.f * z) + 1.f); return 0.5f * x * (1.f + t); }
__device__ __forceinline__ void p_s5_out(Frame& F, int l) {
    const KArgs ap = kargs(); const auto& a = *ap; WS_OPAQUE(a);
    const int tid = otid(), lane = tid & 63, wave = __builtin_amdgcn_readfirstlane(tid >> 6), r32 = lane & 31, hi = lane >> 5;
    const bf16* Z = (const bf16*)(wsb + a.off[R_Z]); const bf16* XP = (const bf16*)(wsb + a.off[R_S5X]); bf16* YC = (bf16*)(wsb + a.off[R_YC]);
    for (int u = F.vcu * NWAVES + wave; u < S5_NBLK * S5_GROUPS; u += F.G * NWAVES) {
        const int blk = u / S5_GROUPS, g = u % S5_GROUPS;
        const unsigned char* tb = wsb + a.off[R_S5T] + (size_t)(l * S5_GROUPS + g) * S5_TSTRIDE;
        const GAS bf16x8* M1 = (const GAS bf16x8*)(tb + S5_M1); const GAS bf16x8* M3 = (const GAS bf16x8*)(tb + S5_M3);
        const bf16* zr = Z + (size_t)((blk * 32 + r32) * 16) * ZN + ZC_UC + g * 16 + 8 * hi;
        const bf16* xr = XP + ((size_t)(blk * 32 + r32) * S5_GROUPS + g) * 128 + 8 * hi;
        f32x16 acc[8];
#pragma unroll
        for (int nb = 0; nb < 8; ++nb)
#pragma unroll
            for (int r = 0; r < 16; ++r) acc[nb][r] = 0.f;
#pragma unroll 2
        for (int sg = 0; sg < 16; ++sg) { const bf16x8 af = *(const GAS bf16x8*)(zr + (size_t)sg * ZN);
#pragma unroll
            for (int nb = 0; nb < 8; ++nb) acc[nb] = __builtin_amdgcn_mfma_f32_32x32x16_bf16(af, M1[((nb * 32 + r32) * 256 + sg * 16 + 8 * hi) >> 3], acc[nb], 0, 0, 0); }
#pragma unroll 2
        for (int s = 0; s < 8; ++s) { const bf16x8 af = *(const GAS bf16x8*)(xr + 16 * s);
#pragma unroll
            for (int nb = 0; nb < 8; ++nb) acc[nb] = __builtin_amdgcn_mfma_f32_32x32x16_bf16(af, M3[((nb * 32 + r32) * 128 + s * 16 + 8 * hi) >> 3], acc[nb], 0, 0, 0); }
#pragma unroll
        for (int nb = 0; nb < 8; ++nb)
#pragma unroll
            for (int r = 0; r < 16; ++r) { const int row = (blk * 32 + crow_dev(r, hi)) * 16 + 2 * nb + (r32 >> 4);
                YC[(size_t)row * WIDTH_C + g * 16 + (r32 & 15)] = (bf16)f2bf(gelu_tanh(acc[nb][r])); }
    }
}
__device__ __forceinline__ int rdlane_i(int v, int i) { return __builtin_amdgcn_readlane(v, i); }
constexpr float NEG_BIG = -3.0e38f;
__device__ __forceinline__ unsigned fkey(float v) { const unsigned u = __builtin_bit_cast(unsigned, v); return (u & 0x80000000u) ? ~u : (u | 0x80000000u); }
__device__ __forceinline__ int mbcnt64(unsigned long long m) { return __builtin_amdgcn_mbcnt_hi((unsigned)(m >> 32), __builtin_amdgcn_mbcnt_lo((unsigned)m, 0)); }
__device__ __forceinline__ void pro_wqs(Frame& F) {
    const KArgs ap = kargs(); const auto& a = *ap; WS_OPAQUE(a);
    const int tid = otid(), lane = tid & 63, wave = __builtin_amdgcn_readfirstlane(tid >> 6);
    bf16* WQ = (bf16*)(wsb + a.off[R_WQS]);
    for (int t = F.vcu * NWAVES + wave; t < DEPTH * 16 * 16; t += F.G * NWAVES) {
        const int l = t >> 8, hc = (t >> 4) & 15, kb = t & 15, k = kb * 64 + lane;
        const float* wr = a.in[I_PWQ] + ((size_t)l * D_MODEL + k) * PQ + hc * 128;
        float w[128];
#pragma unroll
        for (int d = 0; d < 128; d += 4) { const f32x4 v = *(const GAS f32x4*)(wr + d); w[d] = v.x; w[d + 1] = v.y; w[d + 2] = v.z; w[d + 3] = v.w; }
        const float* sk = a.in[I_PSK] + ((size_t)l * 16 + hc) * 128 * 128;
        bf16* o = WQ + ((size_t)l * PQ + hc * 128) * D_MODEL + k;
#pragma clang loop vectorize(disable) unroll(disable)
        for (int n = 0; n < 128; ++n) { const float* sr = sk + n * 128; float acc = 0.f;
#pragma unroll
            for (int d = 0; d < 128; ++d) acc += w[d] * sr[d];
            o[(size_t)n * D_MODEL] = (bf16)f2bf(acc); }
    }
}
__device__ __forceinline__ void pro_wrest(Frame& F) {
    const KArgs ap = kargs(); const auto& a = *ap; WS_OPAQUE(a);
    const int tid = otid(), lane = tid & 63, wave = __builtin_amdgcn_readfirstlane(tid >> 6);
    LAS float* scr = (LAS float*)(F.lds + RING_OFF + wave * 16384);
    const int gw = F.vcu * NWAVES + wave, NGW = F.G * NWAVES;
    bf16* WG = (bf16*)(wsb + a.off[R_WGLU]); bf16* WB = (bf16*)(wsb + a.off[R_WBR]); bf16* WO = (bf16*)(wsb + a.off[R_WOUT]);
    constexpr int IG = (512 / 64) * (1024 / 32), IB = IG, IO = (1024 / 64) * (1024 / 32), IL = IG + 3 * IB + IO;
    for (int it = gw; it < DEPTH * IL; it += NGW) { const int l = it / IL; int r = it % IL;
        if (r < IG) { transpose_item(a.in[I_WGLU] + (size_t)l * 512 * 1024, 1024, 512, WG + (size_t)l * 1024 * 512, 32 * (r % 32), 64 * (r / 32), CmGlu(), scr, lane); continue; } r -= IG;
        if (r < 3 * IB) { const int w = r / IB, q = r % IB; transpose_item(a.in[I_WBA + w] + (size_t)l * 512 * 1024, 1024, 512, WB + ((size_t)l * 3 + w) * 1024 * 512, 32 * (q % 32), 64 * (q / 32), CmId(), scr, lane); continue; } r -= 3 * IB;
        transpose_item(a.in[I_WOUT] + (size_t)l * 1024 * 1024, 1024, 1024, WO + (size_t)l * 1024 * 1024, 32 * (r % 32), 64 * (r / 32), CmId(), scr, lane); }
}
typedef float f32x2v __attribute__((ext_vector_type(2)));
constexpr size_t PEER_ROWS = (size_t)DEPTH * N_EXPERTS;
__device__ __forceinline__ void pro_peerw(Frame& F) {
    const KArgs ap = kargs(); const auto& a = *ap; WS_OPAQUE(a);
    const int tid = otid(), lane = tid & 63, wave = __builtin_amdgcn_readfirstlane(tid >> 6);
    float* SCL = (float*)(wsb + a.off[R_MISC]);
    for (size_t rw = (size_t)F.vcu * NWAVES + wave; rw < 2 * PEER_ROWS; rw += (size_t)F.G * NWAVES) {
        const int w = rw >= PEER_ROWS; const size_t row = rw - (w ? PEER_ROWS : 0);
        const GAS f32x4* src = (const GAS f32x4*)(a.in[I_PU + w] + row * D_MODEL) + 4 * lane;
        const f32x4 x0 = src[0], x1 = src[1], x2 = src[2], x3 = src[3];
        float mx = fmaxf(fmaxf(fmaxf(fabsf(x0.x), fabsf(x0.y)), fmaxf(fabsf(x0.z), fabsf(x0.w))), fmaxf(fmaxf(fabsf(x1.x), fabsf(x1.y)), fmaxf(fabsf(x1.z), fabsf(x1.w))));
        mx = fmaxf(mx, fmaxf(fmaxf(fmaxf(fabsf(x2.x), fabsf(x2.y)), fmaxf(fabsf(x2.z), fabsf(x2.w))), fmaxf(fmaxf(fabsf(x3.x), fabsf(x3.y)), fmaxf(fabsf(x3.z), fabsf(x3.w)))));
        mx = wave_max(mx);
        const float inv = mx > 0.f ? 416.f / mx : 0.f;
        v4u o; int t;
        t = __builtin_amdgcn_cvt_pk_fp8_f32(x0.x * inv, x0.y * inv, 0, false); t = __builtin_amdgcn_cvt_pk_fp8_f32(x0.z * inv, x0.w * inv, t, true); o.x = (unsigned)t;
        t = __builtin_amdgcn_cvt_pk_fp8_f32(x1.x * inv, x1.y * inv, 0, false); t = __builtin_amdgcn_cvt_pk_fp8_f32(x1.z * inv, x1.w * inv, t, true); o.y = (unsigned)t;
        t = __builtin_amdgcn_cvt_pk_fp8_f32(x2.x * inv, x2.y * inv, 0, false); t = __builtin_amdgcn_cvt_pk_fp8_f32(x2.z * inv, x2.w * inv, t, true); o.z = (unsigned)t;
        t = __builtin_amdgcn_cvt_pk_fp8_f32(x3.x * inv, x3.y * inv, 0, false); t = __builtin_amdgcn_cvt_pk_fp8_f32(x3.z * inv, x3.w * inv, t, true); o.w = (unsigned)t;
        *((GAS v4u*)(wsb + a.off[R_PU + w] + row * D_MODEL) + lane) = o;
        if (lane == 0) SCL[rw] = mx * (1.f / 416.f);
    }
}
__device__ __forceinline__ void fp8x16_to_f32(const v4u q, float (&f)[16]) {
#pragma unroll
    for (int d = 0; d < 4; ++d) { const int w = (int)(d == 0 ? q.x : d == 1 ? q.y : d == 2 ? q.z : q.w);
        const f32x2v lo = __builtin_amdgcn_cvt_pk_f32_fp8(w, false), hi = __builtin_amdgcn_cvt_pk_f32_fp8(w, true); f[4 * d] = lo.x; f[4 * d + 1] = lo.y; f[4 * d + 2] = hi.x; f[4 * d + 3] = hi.y; }
}
__device__ __forceinline__ void p_peer(Frame& F, int l, bool dry) {
    const KArgs ap = kargs(); const auto& a = *ap; WS_OPAQUE(a);
    const int tid = otid(), lane = tid & 63, wave = __builtin_amdgcn_readfirstlane(tid >> 6);
    const float* SC = (const float*)(wsb + a.off[R_SC]); const bf16* XN = (const bf16*)(wsb + a.off[R_XN]); float* X = (float*)(wsb + a.off[R_X]);
    const unsigned char* PU = wsb + a.off[R_PU] + (size_t)l * N_EXPERTS * D_MODEL; const unsigned char* PV = wsb + a.off[R_PV] + (size_t)l * N_EXPERTS * D_MODEL;
    const float* SCU = (const float*)(wsb + a.off[R_MISC]) + (size_t)l * N_EXPERTS; const float* SCV = SCU + PEER_ROWS;
    LAS float* stop = (LAS float*)(F.lds + RING_OFF + wave * 4096);
    LAS int* itop = (LAS int*)(stop + 256);
    LAS int* elist = itop + 256;
    LAS float* cf = (LAS float*)(elist + 128);
    for (int m = F.vcu * NWAVES + wave; m < RP; m += F.G * NWAVES) {
        if (!prow_valid(m)) continue;
        const float* sr = SC + (size_t)m * PQ;
#ifndef MK_REP
#define MK_REP -1
#endif
        for (int rp12 = 0; rp12 < ((MK_REP) == 105 ? 2 : 1); ++rp12) {
        float sv[32];
#pragma unroll
        for (int i = 0; i < 32; ++i) sv[i] = sr[i * 64 + lane];
#pragma unroll
        for (int hc = 0; hc < 16; hc += 2) {
            const float va0 = sv[2 * hc], va1 = sv[2 * hc + 1], vb0 = sv[2 * hc + 2], vb1 = sv[2 * hc + 3];
            const unsigned ka0 = fkey(va0), ka1 = fkey(va1), kb0 = fkey(vb0), kb1 = fkey(vb1);
            unsigned pa = 0u, pb = 0u; bool da = false, db = false;
            for (int bit = 31; bit >= 0 && !(da && db); --bit) { const unsigned ta = pa | (1u << bit), tb = pb | (1u << bit);
                const int ca = __builtin_popcountll(__ballot(ka0 >= ta)) + __builtin_popcountll(__ballot(ka1 >= ta)), cb = __builtin_popcountll(__ballot(kb0 >= tb)) + __builtin_popcountll(__ballot(kb1 >= tb));
                if (!da) { pa = ca >= 16 ? ta : pa; da = ca == 16; } if (!db) { pb = cb >= 16 ? tb : pb; db = cb == 16; } }
            { const unsigned long long m0 = __ballot(ka0 >= pa), m1 = __ballot(ka1 >= pa); const int r0 = mbcnt64(m0), r1 = __builtin_popcountll(m0) + mbcnt64(m1);
              if (ka0 >= pa && r0 < 16) { stop[hc * 16 + r0] = va0; itop[hc * 16 + r0] = lane; }
              if (ka1 >= pa && r1 < 16) { stop[hc * 16 + r1] = va1; itop[hc * 16 + r1] = lane + 64; } }
            { const unsigned long long m0 = __ballot(kb0 >= pb), m1 = __ballot(kb1 >= pb); const int r0 = mbcnt64(m0), r1 = __builtin_popcountll(m0) + mbcnt64(m1);
              if (kb0 >= pb && r0 < 16) { stop[(hc + 1) * 16 + r0] = vb0; itop[(hc + 1) * 16 + r0] = lane; }
              if (kb1 >= pb && r1 < 16) { stop[(hc + 1) * 16 + r1] = vb1; itop[(hc + 1) * 16 + r1] = lane + 64; } }
        }
        LDS_WAIT();
        for (int h = 0; h < 8; ++h) {
            const float s1 = stop[(2 * h) * 16 + (lane >> 2)];
            float c[4]; unsigned kc[4];
#pragma unroll
            for (int j = 0; j < 4; ++j) { c[j] = s1 + stop[(2 * h + 1) * 16 + (lane & 3) * 4 + j]; kc[j] = fkey(c[j]); }
            unsigned pp = 0u;
            for (int bit = 31; bit >= 0; --bit) { const unsigned tt = pp | (1u << bit);
                const int cn = __builtin_popcountll(__ballot(kc[0] >= tt)) + __builtin_popcountll(__ballot(kc[1] >= tt)) + __builtin_popcountll(__ballot(kc[2] >= tt)) + __builtin_popcountll(__ballot(kc[3] >= tt));
                pp = cn >= 16 ? tt : pp; if (cn == 16) break; }
            const float cmax = wave_max(fmaxf(fmaxf(c[0], c[1]), fmaxf(c[2], c[3])));
            float esum = 0.f; int base = 0;
#pragma unroll
            for (int j = 0; j < 4; ++j) { const bool sel = kc[j] >= pp; const unsigned long long mk = __ballot(sel); const int rk = base + mbcnt64(mk); base += __builtin_popcountll(mk);
                const float ex = (sel && rk < 16) ? __expf(c[j] - cmax) : 0.f; esum += ex;
                if (sel && rk < 16) { const int ci = lane * 4 + j; elist[h * 16 + rk] = itop[(2 * h) * 16 + (ci >> 4)] * N_KEYS + itop[(2 * h + 1) * 16 + (ci & 15)]; cf[h * 16 + rk] = ex; } }
            esum = wave_sum(esum); const float inv = __builtin_amdgcn_rcpf(esum);
            LDS_WAIT();
            if (lane < 16) cf[h * 16 + lane] *= inv;
        }
        LDS_WAIT();
        }
        for (int rp3 = 0; rp3 < ((MK_REP) == 106 ? 2 : 1); ++rp3) {
        float hx[16], out[16];
        { float t[8]; unpack8(*(const GAS v4u*)(XN + (size_t)m * D_MODEL + 16 * lane), t);
#pragma unroll
          for (int j = 0; j < 8; ++j) hx[j] = t[j];
          unpack8(*(const GAS v4u*)(XN + (size_t)m * D_MODEL + 16 * lane + 8), t);
#pragma unroll
          for (int j = 0; j < 8; ++j) hx[8 + j] = t[j]; }
#pragma unroll
        for (int j = 0; j < 16; ++j) out[j] = 0.f;
        v4u uA[4], vA[4], uB[4], vB[4]; float suA[4], svA[4], cA[4], suB[4], svB[4], cB[4];
#define PEER_LOAD(U, V, SU, SV, CW, q0) do { _Pragma("unroll") for (int i = 0; i < 4; ++i) { const int e_ = elist[(q0) + i]; CW[i] = cf[(q0) + i]; \
            U[i] = *((const GAS v4u*)(PU + (size_t)e_ * D_MODEL) + lane); V[i] = *((const GAS v4u*)(PV + (size_t)e_ * D_MODEL) + lane); SU[i] = SCU[e_]; SV[i] = SCV[e_]; } } while (0)
#define PEER_COMP(U, V, SU, SV, CW) do { float d_[4]; _Pragma("unroll") for (int i = 0; i < 4; ++i) { float t[16]; d_[i] = 0.f; fp8x16_to_f32(U[i], t); \
            _Pragma("unroll") for (int j = 0; j < 16; ++j) d_[i] += hx[j] * t[j]; } \
            _Pragma("unroll") for (int i = 0; i < 4; ++i) d_[i] += dpp_f<0xB1>(d_[i]); _Pragma("unroll") for (int i = 0; i < 4; ++i) d_[i] += dpp_f<0x4E>(d_[i]); \
            _Pragma("unroll") for (int i = 0; i < 4; ++i) d_[i] += dpp_f<0x141>(d_[i]); _Pragma("unroll") for (int i = 0; i < 4; ++i) d_[i] += dpp_f<0x140>(d_[i]); \
            _Pragma("unroll") for (int i = 0; i < 4; ++i) { const float dd = (rdlane(d_[i], 0) + rdlane(d_[i], 16) + rdlane(d_[i], 32) + rdlane(d_[i], 48)) * SU[i]; const float cc = CW[i] * gelu_tanh(dd) * SV[i]; \
              float t[16]; fp8x16_to_f32(V[i], t); _Pragma("unroll") for (int j = 0; j < 16; ++j) out[j] += cc * t[j]; } } while (0)
        PEER_LOAD(uA, vA, suA, svA, cA, 0);
        for (int q = 0; q < 128; q += 8) {
            PEER_LOAD(uB, vB, suB, svB, cB, q + 4);
            PEER_COMP(uA, vA, suA, svA, cA);
            if (q + 8 < 128) PEER_LOAD(uA, vA, suA, svA, cA, q + 8);
            PEER_COMP(uB, vB, suB, svB, cB);
        }
#undef PEER_LOAD
#undef PEER_COMP
        if (!dry && rp3 == ((MK_REP) == 106 ? 1 : 0)) { GAS f32x4* xr = (GAS f32x4*)(X + (size_t)m * D_MODEL + 16 * lane);
#pragma unroll
          for (int j = 0; j < 4; ++j) xr[j] = xr[j] + (f32x4){out[4 * j], out[4 * j + 1], out[4 * j + 2], out[4 * j + 3]}; }
        }
    }
}
__device__ __forceinline__ void p_final(Frame& F) {
    const KArgs ap = kargs(); const auto& a = *ap; WS_OPAQUE(a);
    const int tid = otid(), lane = tid & 63, wave = __builtin_amdgcn_readfirstlane(tid >> 6);
    const float* X = (const float*)(wsb + a.off[R_X]); const float* g = a.in[I_FN];
    for (int m = F.vcu * NWAVES + wave; m < RP; m += F.G * NWAVES) {
        float* dst;
        if (m >= SROW0) dst = a.out + O_YS + (size_t)(m - SROW0) * D_MODEL;
        else { const int b = m / LPP, p = m % LPP; if (p < PADF + N_META || p >= PEND) continue; dst = a.out + O_YP + ((size_t)b * SEQ + (p - PADF - N_META)) * D_MODEL; }
        const GAS f32x4* xr = (const GAS f32x4*)(X + (size_t)m * D_MODEL) + lane;
        f32x4 v[4]; float s2 = 0.f;
#pragma unroll
        for (int j = 0; j < 4; ++j) { v[j] = xr[64 * j]; s2 += (v[j].x * v[j].x + v[j].y * v[j].y) + (v[j].z * v[j].z + v[j].w * v[j].w); }
        const float r = __builtin_amdgcn_rsqf(wave_sum(s2) * (1.f / D_MODEL) + EPSF);
        const GAS f32x4* gr = (const GAS f32x4*)g + lane; GAS f32x4* o = (GAS f32x4*)dst + lane;
#pragma unroll
        for (int j = 0; j < 4; ++j) { const f32x4 gg = gr[64 * j]; o[64 * j] = (f32x4){v[j].x * r * gg.x, v[j].y * r * gg.y, v[j].z * r * gg.z, v[j].w * r * gg.w}; }
    }
}

__device__ __forceinline__ void p_prologue(Frame& F) {
    const KArgs ap = kargs(); const auto& a = *ap; WS_OPAQUE(a);
    const int tid = otid(), lane = tid & 63, wave = __builtin_amdgcn_readfirstlane(tid >> 6);
    LAS float* scr = (LAS float*)(F.lds + RING_OFF + wave * 16384);
    const int gw = F.vcu * NWAVES + wave, NGW = F.G * NWAVES;
    if (a.pro_mask & PM_X) {
        float* X = (float*)(wsb + a.off[R_X]);
        for (int m = gw; m < RP; m += NGW) {
            const float* src = nullptr;
            if (m >= SROW0) src = a.in[I_XS] + (size_t)(m - SROW0) * D_MODEL;
            else { const int b = m / LPP, p = m % LPP; if (p >= PADF && p < PEND) { const int pos = p - PADF; src = pos < N_META ? a.in[I_META] + (size_t)pos * D_MODEL : a.in[I_XP] + ((size_t)b * SEQ + pos - N_META) * D_MODEL; } }
            GAS f32x4* o = (GAS f32x4*)(X + (size_t)m * D_MODEL) + lane;
#pragma unroll
            for (int j = 0; j < 4; ++j) o[64 * j] = src ? ((const GAS f32x4*)src)[lane + 64 * j] : (f32x4){0.f, 0.f, 0.f, 0.f};
        }
    }
    if (a.pro_mask & PM_WIN) {
        bf16* WT = (bf16*)(wsb + a.off[R_WIN]);
        constexpr int IPL = (D_MODEL / 64) * (ZN / 32);
        for (int it = gw; it < DEPTH * IPL; it += NGW) { const int l = it / IPL, r = it % IPL, kb = r / (ZN / 32), nb = r % (ZN / 32);
            transpose_item(a.in[I_WIN] + (size_t)l * D_MODEL * D_IN, D_IN, D_MODEL, WT + (size_t)l * ZN * D_MODEL, 32 * nb, 64 * kb, CmWin(), scr, lane); }
    }
    __syncthreads();
    if (a.pro_mask & PM_TABLES) s5_tables(F);
    __syncthreads();
    if (a.pro_mask & PM_WREST) pro_wrest(F);
    if (a.pro_mask & PM_WQS) pro_wqs(F);
    if (a.pro_mask & PM_PEERW) pro_peerw(F);
}

__global__ void __launch_bounds__(NTHR, 2) mk_fwd(Args args) {
    extern __shared__ __attribute__((aligned(16))) unsigned char lds[];
    Frame F;
    F.lds = (LAS unsigned char*)lds; F.MISC = (volatile LAS unsigned*)(F.lds + MISC_OFF);
    F.wv = __builtin_amdgcn_readfirstlane((int)threadIdx.x >> 6);
    F.G = gridDim.x; { const int bx = blockIdx.x; F.vcu = (F.G % 8 == 0) ? (bx % 8) * (F.G / 8) + bx / 8 : bx; }
    F.ctl = (gu32*)args.ws;
    for (int u = F.wv * 64 + lane_id(); u < (LDS_BYTES - LDSCTL_OFF) / 4; u += NTHR) ((LAS unsigned*)(F.lds + LDSCTL_OFF))[u] = 0u;
    __syncthreads();
    const int lo = args.ph_lo, hi = args.ph_hi;
    unsigned* barw = (unsigned*)(F.ctl + CW_BAR) + (size_t)args.bar_region * XCD_BAR_WORDS;
    XcdBarrier bar; bar.bar = barw; bar.x = 0; bar.st = nullptr; bar.wv = F.wv;
    if (hi - lo > 1) bar = xcd_barrier_post(barw, F.MISC + 8, F.wv);
#define IN(k) (lo <= (k) && (k) < hi)
#ifndef MK_REP
#define MK_REP -1
#endif
#define SEAM(k) do { if ((k) + 1 < hi) { xcd_barrier(bar); if ((MK_REP) == 300) xcd_barrier(bar); } } while (0)
#ifndef MK_REP
#define MK_REP -1
#endif
    if (IN(PH_PRO)) { for (int rep_ = 0; rep_ < ((MK_REP) == 200 ? 2 : 1); ++rep_) { p_prologue(F); __syncthreads(); } SEAM(PH_PRO); }
#ifndef MK_REP
#define MK_REP -1
#endif
#define REPEAT(ph) for (int rep_ = 0; rep_ < ((MK_REP) == (ph) ? 2 : 1); ++rep_)
    for (int l = 0; l < DEPTH; ++l) {
        const int pb = 1 + l * NPL;
        if (IN(pb + PL_NORM1)) { REPEAT(PL_NORM1) p_norm(F, l, I_N1); SEAM(pb + PL_NORM1); }
        if (IN(pb + PL_GEMM_IN)) {
            const KArgs ap = kargs(); const auto& a = *ap; WS_OPAQUE(a);
            pg8::Gemm g{(const pg8::bf16_t*)(wsb + a.off[R_XN]), (const pg8::bf16_t*)(wsb + a.off[R_WIN]) + (size_t)l * ZN * D_MODEL, RP, ZN, D_MODEL};
            pg8::StaticOrder S; S.init(RP, ZN, F.G, (int)blockIdx.x);
            pg8::EpiBf16<0> E{(pg8::bf16_t*)(wsb + a.off[R_Z]), ZN, nullptr, 0, 0, 1.f};
            REPEAT(PL_GEMM_IN) pg8::gemm_phase<pg8::EpiBf16<0>, pg8::StaticOrder, true, true>(F.lds + RING_OFF, g, S, E, F.wv);
            SEAM(pb + PL_GEMM_IN);
        }
        if (IN(pb + PL_ZPOST)) { REPEAT(PL_ZPOST) p_zpost(F, l); SEAM(pb + PL_ZPOST); }
        if (IN(pb + PL_LOCAL)) { REPEAT(104) p_gdn_chunk(F, l); REPEAT(103) p_s5_e(F, l); SEAM(pb + PL_LOCAL); }
        if (IN(pb + PL_MIX)) {
            REPEAT(100) p_gdn_chain(F, l);
            REPEAT(102) { const int tid = otid(), lane = tid & 63, wave = __builtin_amdgcn_readfirstlane(tid >> 6), NGW = F.G * NWAVES;
              for (int t = (F.vcu * NWAVES + wave + NGW - 256) % NGW; t < S5_NTASK; t += NGW) s5_scan_run(F, l, t, lane); }
            REPEAT(101) p_attention(F, l + DEPTH * rep_, lds);
            SEAM(pb + PL_MIX); }
        if (IN(pb + PL_MIXPOST)) { REPEAT(PL_MIXPOST) { p_mixpost_a(F, l); p_mixpost_b(F, l); p_s5_out(F, l); } SEAM(pb + PL_MIXPOST); }
        if (IN(pb + PL_GEMM_GLU)) REPEAT(PL_GEMM_GLU) {
            const KArgs ap = kargs(); const auto& a = *ap; WS_OPAQUE(a);
            { pg8::Gemm g{(const pg8::bf16_t*)(wsb + a.off[R_YC]), (const pg8::bf16_t*)(wsb + a.off[R_WGLU]) + (size_t)l * 1024 * 512, RP, 1024, 512};
              pg8::StaticOrder S; S.init(RP, 1024, F.G, (int)blockIdx.x); pg8::EpiGlu E{(pg8::bf16_t*)(wsb + a.off[R_OC]), WIDTH_C};
              pg8::gemm_phase<pg8::EpiGlu, pg8::StaticOrder, true, true>(F.lds + RING_OFF, g, S, E, F.wv); }
            { pg8::Gemm g{(const pg8::bf16_t*)(wsb + a.off[R_OA]), (const pg8::bf16_t*)(wsb + a.off[R_WBR]) + ((size_t)l * 3 + 0) * 1024 * 512, RP, 1024, 512};
              pg8::StaticOrder S; S.init(RP, 1024, F.G, (int)blockIdx.x); pg8::EpiMerge<0> E{(float*)(wsb + a.off[R_MRG]), nullptr, (const pg8::bf16_t*)(wsb + a.off[R_Z]) + ZC_GATE, ZN};
              pg8::gemm_phase<pg8::EpiMerge<0>, pg8::StaticOrder, true, true>(F.lds + RING_OFF, g, S, E, F.wv); }
            { pg8::Gemm g{(const pg8::bf16_t*)(wsb + a.off[R_OBN]), (const pg8::bf16_t*)(wsb + a.off[R_WBR]) + ((size_t)l * 3 + 1) * 1024 * 512, RP, 1024, 512};
              pg8::StaticOrder S; S.init(RP, 1024, F.G, (int)blockIdx.x); pg8::EpiMerge<1> E{(float*)(wsb + a.off[R_MRG]), nullptr, (const pg8::bf16_t*)(wsb + a.off[R_Z]) + ZC_GATE + 1024, ZN};
              pg8::gemm_phase<pg8::EpiMerge<1>, pg8::StaticOrder, true, true>(F.lds + RING_OFF, g, S, E, F.wv); }
            if (rep_ == ((MK_REP) == PL_GEMM_GLU ? 1 : 0)) SEAM(pb + PL_GEMM_GLU); }
        if (IN(pb + PL_GEMM_BRC)) {
            const KArgs ap = kargs(); const auto& a = *ap; WS_OPAQUE(a);
            pg8::Gemm g{(const pg8::bf16_t*)(wsb + a.off[R_OC]), (const pg8::bf16_t*)(wsb + a.off[R_WBR]) + ((size_t)l * 3 + 2) * 1024 * 512, RP, 1024, 512};
            pg8::StaticOrder S; S.init(RP, 1024, F.G, (int)blockIdx.x); pg8::EpiMerge<2> E{(float*)(wsb + a.off[R_MRG]), (pg8::bf16_t*)(wsb + a.off[R_MRGB]), (const pg8::bf16_t*)(wsb + a.off[R_Z]) + ZC_GATE + 2048, ZN};
            REPEAT(PL_GEMM_BRC) pg8::gemm_phase<pg8::EpiMerge<2>, pg8::StaticOrder, true, true>(F.lds + RING_OFF, g, S, E, F.wv);
            SEAM(pb + PL_GEMM_BRC); }
        if (IN(pb + PL_GEMM_OUT)) {
            const KArgs ap = kargs(); const auto& a = *ap; WS_OPAQUE(a);
            pg8::Gemm g{(const pg8::bf16_t*)(wsb + a.off[R_MRGB]), (const pg8::bf16_t*)(wsb + a.off[R_WOUT]) + (size_t)l * 1024 * 1024, RP, 1024, 1024};
            pg8::StaticOrder S; S.init(RP, 1024, F.G, (int)blockIdx.x);
            REPEAT(PL_GEMM_OUT) { pg8::EpiResid E{(float*)(wsb + a.off[R_X]), D_MODEL, (MK_REP) == PL_GEMM_OUT && rep_ == 0};
            pg8::gemm_phase<pg8::EpiResid, pg8::StaticOrder, true, true>(F.lds + RING_OFF, g, S, E, F.wv); }
            SEAM(pb + PL_GEMM_OUT); }
        if (IN(pb + PL_NORM2)) { REPEAT(PL_NORM2) p_norm(F, l, I_N2); SEAM(pb + PL_NORM2); }
        if (IN(pb + PL_GEMM_PEER)) {
            const KArgs ap = kargs(); const auto& a = *ap; WS_OPAQUE(a);
            pg8::Gemm g{(const pg8::bf16_t*)(wsb + a.off[R_XN]), (const pg8::bf16_t*)(wsb + a.off[R_WQS]) + (size_t)l * PQ * D_MODEL, RP, PQ, D_MODEL};
            pg8::StaticOrder S; S.init(RP, PQ, F.G, (int)blockIdx.x); pg8::EpiF32 E{(float*)(wsb + a.off[R_SC]), PQ};
            REPEAT(PL_GEMM_PEER) pg8::gemm_phase<pg8::EpiF32, pg8::StaticOrder, true, true>(F.lds + RING_OFF, g, S, E, F.wv);
            SEAM(pb + PL_GEMM_PEER); }
        if (IN(pb + PL_PEER)) { REPEAT(PL_PEER) p_peer(F, l, (MK_REP) == PL_PEER && rep_ == 0); SEAM(pb + PL_PEER); }
    }
    if (IN(PH_FINAL)) p_final(F);
#undef IN
#undef SEAM
}
}
#ifndef MK_ONE_LAUNCH
#define MK_ONE_LAUNCH 1
#endif
static int mk_grid = 0;
static bool mk_setup() {
    if (mk_grid) return mk_grid > 0;
    int dev = 0, cus = 0;
    if (hipGetDevice(&dev) != hipSuccess || hipDeviceGetAttribute(&cus, hipDeviceAttributeMultiprocessorCount, dev) != hipSuccess) { mk_grid = -1; return false; }
    if (hipFuncSetAttribute((const void*)mk::mk_fwd, hipFuncAttributeMaxDynamicSharedMemorySize, mk::LDS_BYTES) != hipSuccess) { fprintf(stderr, "kernel_launch: hipFuncSetAttribute failed\n"); mk_grid = -1; return false; }
    int per_cu = 0;
    if (hipOccupancyMaxActiveBlocksPerMultiprocessor(&per_cu, (const void*)mk::mk_fwd, mk::NTHR, mk::LDS_BYTES) != hipSuccess || per_cu < 1) { fprintf(stderr, "kernel_launch: occupancy query says %d workgroups per CU\n", per_cu); }
    (void)hipGetLastError();
    mk_grid = cus;
    return true;
}
static void mk_launch(mk::Args a, int lo, int hi, int region, hipStream_t stream) {
    a.ph_lo = lo; a.ph_hi = hi; a.bar_region = region;
    hipLaunchKernelGGL(mk::mk_fwd, dim3(mk_grid), dim3(mk::NTHR), mk::LDS_BYTES, stream, a);
    hipError_t e = hipPeekAtLastError(); if (e != hipSuccess) fprintf(stderr, "kernel_launch: launch failed: %s\n", hipGetErrorName(e));
}
extern "C" void kernel_launch(void* const* d_in, const int* in_sizes, int n_in, void* d_out, int out_size, void* d_ws, size_t ws_size, hipStream_t stream) {
    if (n_in != N_INPUTS || (size_t)out_size != (size_t)O_END) { fprintf(stderr, "kernel_launch: unexpected n_in %d / out_size %d\n", n_in, out_size); return; }
    if (!mk_setup()) return;
    const size_t MiB = 1u << 20;
    unsigned char* ws = (unsigned char*)d_ws;
    mk::Args a{};
    for (int i = 0; i < N_INPUTS; ++i) a.in[i] = (const float*)d_in[i];
    a.out = (float*)d_out; a.ws = ws;
    { using namespace mk; const struct { int r; size_t mib; } map[] = { {R_WIN, 1}, {R_WGLU, 59}, {R_WBR, 63}, {R_WOUT, 75}, {R_WQS, 83}, {R_S5T, 99}, {R_PU, 132}, {R_PV, 196}, {R_MISC, 260}, {R_OBN, 262}, {R_X, 388}, {R_XN, 456},
        {R_Z, 490}, {R_SC, 490}, {R_QN, 737}, {R_KN, 754}, {R_QKVB, 771}, {R_BG, 822}, {R_O, 823}, {R_MRGB, 823}, {R_OA, 857}, {R_OB, 874}, {R_GDN, 891}, {R_MRG, 891},
        {R_S5E, 986}, {R_YC, 986}, {R_S5X, 1003}, {R_OC, 1012} };
      for (auto& e : map) a.off[e.r] = e.mib * MiB; }
    if (1029 * MiB > ws_size) { fprintf(stderr, "kernel_launch: workspace too small (%zu)\n", ws_size); return; }
    if (hipMemsetAsync(ws, 0, mk::CTL_BYTES, stream) != hipSuccess) { fprintf(stderr, "kernel_launch: memset failed\n"); return; }
    a.pro_mask = mk::PM_X | mk::PM_WIN | mk::PM_TABLES | mk::PM_WREST | mk::PM_WQS | mk::PM_PEERW;
#if MK_ONE_LAUNCH
    mk_launch(a, 0, mk::PH_END, 0, stream);
#else
    int region = 0;
    mk_launch(a, mk::PH_PRO, mk::PH_PRO + 1, region++, stream);
    for (int l = 0; l < DEPTH; ++l) { const int pb = 1 + l * mk::NPL;
        for (int ph = mk::PL_NORM1; ph <= mk::PL_PEER; ++ph) { if (ph == mk::PL_GEMM_BRA || ph == mk::PL_GEMM_BRB) continue; mk_launch(a, pb + ph, pb + ph + 1, region++, stream); } }
    mk_launch(a, mk::PH_FINAL, mk::PH_END, region++, stream);
#endif
}
```

```cpp
#include <hip/hip_runtime.h>
#include <cstdio>
#include <cstdint>
#include <utility>
#define MK_ONE_LAUNCH 1
#ifndef D_MODEL
#define D_MODEL 1024
#define BATCH 2
#define SEQ 8192
#define DEPTH 4
#define DEC_BATCH 16
#define DEC_SEQ 32
#define PAST_LEN 1024
#define N_HEADS_A 4
#define HEAD_DIM_A 64
#define N_HEADS_B 4
#define HEAD_DIM_B 128
#define S5_GROUPS 32
#define S5_STATE 64
#define PEER_HEADS 8
#define PEER_QDIM 256
#define N_KEYS 128
#endif
#define CHUNK 64
#define N_META 16
#define EPSF 1e-6f
#define NUM_BUCKETS 32
#define CONV_W 4
#define S5_GROUP 16
#define PEER_TOPK 16
#define N_EXPERTS (N_KEYS * N_KEYS)
#define WIDTH_A (N_HEADS_A * 2 * HEAD_DIM_A)
#define WIDTH_B (N_HEADS_B * HEAD_DIM_B)
#define WIDTH_C (S5_GROUPS * S5_GROUP)
#define OFF_QA 0
#define OFF_KA (OFF_QA + WIDTH_A)
#define OFF_VA (OFF_KA + WIDTH_A)
#define OFF_QKVB (OFF_VA + WIDTH_A)
#define OFF_GB (OFF_QKVB + 3 * WIDTH_B)
#define OFF_BETA (OFF_GB + WIDTH_B)
#define OFF_ALPHA (OFF_BETA + N_HEADS_B)
#define OFF_UC (OFF_ALPHA + N_HEADS_B)
#define OFF_GATE (OFF_UC + WIDTH_C)
#define D_IN (OFF_GATE + 3 * D_MODEL)
#define LP (N_META + SEQ)
#define NP (BATCH * LP)
#define NS (DEC_BATCH * DEC_SEQ)
#define NT (NP + NS)
#define PQ (PEER_HEADS * PEER_QDIM)

enum { I_XP, I_XS, I_CK, I_CV, I_SCONV, I_SDELTA, I_SRE, I_SIM, I_META, I_REL, I_N1, I_N2, I_FN, I_WIN, I_QN, I_KN, I_LQK, I_SUBLN, I_CONVW, I_ALOG, I_DTB, I_GDNN,
       I_AR, I_AI, I_BR, I_BI, I_CR, I_CI, I_SD, I_LDT, I_WGLU, I_WBA, I_WBB, I_WBC, I_WOUT, I_PWQ, I_PSK, I_PU, I_PV, N_INPUTS };
#define O_YP 0
#define O_YS (O_YP + (size_t)BATCH * SEQ * D_MODEL)
#define O_KP (O_YS + (size_t)NS * D_MODEL)
#define O_VP (O_KP + (size_t)DEPTH * NP * WIDTH_A)
#define O_KS (O_VP + (size_t)DEPTH * NP * WIDTH_A)
#define O_VS (O_KS + (size_t)DEPTH * NS * WIDTH_A)
#define O_CP (O_VS + (size_t)DEPTH * NS * WIDTH_A)
#define O_CS (O_CP + (size_t)DEPTH * BATCH * (CONV_W - 1) * 3 * WIDTH_B)
#define O_DP (O_CS + (size_t)DEPTH * DEC_BATCH * (CONV_W - 1) * 3 * WIDTH_B)
#define O_DS (O_DP + (size_t)DEPTH * BATCH * N_HEADS_B * HEAD_DIM_B * HEAD_DIM_B)
#define O_SRP (O_DS + (size_t)DEPTH * DEC_BATCH * N_HEADS_B * HEAD_DIM_B * HEAD_DIM_B)
#define O_SIP (O_SRP + (size_t)DEPTH * BATCH * S5_GROUPS * S5_STATE)
#define O_SRS (O_SIP + (size_t)DEPTH * BATCH * S5_GROUPS * S5_STATE)
#define O_SIS (O_SRS + (size_t)DEPTH * DEC_BATCH * S5_GROUPS * S5_STATE)
#define O_END (O_SIS + (size_t)DEPTH * DEC_BATCH * S5_GROUPS * S5_STATE)

namespace pg8 {
#define PG8_LAS __attribute__((address_space(3)))
typedef unsigned short bf16_t;
typedef short bf16x8 __attribute__((ext_vector_type(8)));
typedef float f32x4 __attribute__((ext_vector_type(4)));
typedef unsigned u32x4 __attribute__((ext_vector_type(4)));
constexpr int BM = 256, BK = 64, HALF = 128, HTB = HALF * BK * 2  , STAGE_BYTES = 8 * HTB, NXCD = 8, WGM = 8;

__host__ __device__ __forceinline__ int lds_byte(int r, int c) { const int st = (r >> 4) * 2 + (c >> 5), rr = r & 15, cc = c & 31, ob = rr * 64 + cc * 2; return st * 1024 + (ob ^ (((ob >> 9) & 1) << 5)); }
__host__ __device__ __forceinline__ void stage_rc(int b, int& R, int& C) { const int st = b / 1024, sb = b % 1024, swz = sb ^ (((sb >> 9) & 1) << 5); R = (st >> 1) * 16 + swz / 64; C = (st & 1) * 32 + (swz % 64) / 2; }
__host__ __device__ __forceinline__ int perm32(int rho) { const int n = rho >> 4, i = rho & 15; return 8 * (i >> 2) + 4 * n + (i & 3); }

struct Unit { int pm, pn; };
struct Gemm { const bf16_t* A; const bf16_t* Bt; int M, N, K; };

struct StaticOrder {
    int nM, nN, nwg, G, c;
    __host__ __device__ void init(int M, int N, int G_, int c_) { nM = M / BM; nN = N / BM; nwg = nM * nN; G = G_; c = c_; }
    __host__ __device__ bool next(int i, Unit& u) const {
        const long L = (long)i * G + c; if (L >= nwg) return false;
        int wgid = (int)L; { const int q = nwg / NXCD, r = nwg % NXCD, xcd = wgid % NXCD, off = wgid / NXCD; wgid = (xcd < r ? xcd * (q + 1) : r * (q + 1) + (xcd - r) * q) + off; }
        const int nig = WGM * nN, gid = wgid / nig, fm = gid * WGM, gsz = (nM - fm) < WGM ? (nM - fm) : WGM;
        u.pm = fm + ((wgid % nig) % gsz); u.pn = (wgid % nig) / gsz; return true;
    }
    __device__ __forceinline__ void a_ready(const Unit&) const {}
    __device__ __forceinline__ void done(const Unit&) const {}
};

__device__ __forceinline__ unsigned cvt_pk_bf16(float lo, float hi) { unsigned r; asm volatile("v_cvt_pk_bf16_f32 %0, %1, %2" : "=v"(r) : "v"(lo), "v"(hi)); return r; }
typedef float f32x2 __attribute__((ext_vector_type(2)));
__device__ __forceinline__ f32x2 gelu_pk(f32x2 v) {
    const f32x2 av = __builtin_elementwise_abs(v), d = av * 0.2316418882f + 1.0f;
    f32x2 t; t.x = __builtin_amdgcn_rcpf(d.x); t.y = __builtin_amdgcn_rcpf(d.y);
    f32x2 q = t * 0.5307027145f + (-0.7265760135f); q = q * t + 0.7107068705f; q = q * t + (-0.142248368f); q = q * t + 0.127414796f; q = q * t;
    const f32x2 s = (v * v) * (-0.72134752044f);
    f32x2 e; e.x = __builtin_amdgcn_exp2f(s.x); e.y = __builtin_amdgcn_exp2f(s.y);
    const f32x2 m = v * (q * e), r = v - m;
    f32x2 o; o.x = v.x < 0.f ? m.x : r.x; o.y = v.y < 0.f ? m.y : r.y; return o;
}

template <int ACT  > struct EpiBf16 {
    static constexpr bool PERM = true, AFTER_DRAIN = false; static_assert(ACT == 0 || ACT == 1, "EpiBf16: ACT is 0 (none) or 1 (gelu_pk)");
    bf16_t* O; int ldc; const float* bias; int split_cols; size_t split_stride; float scale0;
    __device__ __forceinline__ void operator()(const f32x4 (&acc)[2][2][4][2], const Unit& u, int wr, int wc, int fr, int fq) const {
        const int row0 = u.pm * BM + wr * 64 + fr; int colt = u.pn * BM; bf16_t* base = O;
        float sc = 1.f; if (split_cols) { const int t = colt / split_cols; base += (size_t)t * split_stride; colt -= t * split_cols; if (t == 0) sc = scale0; }
        const int col0 = colt + wc * 32 + 8 * fq, bcol0 = u.pn * BM + wc * 32 + 8 * fq;
        f32x4 bv[2][2];
#pragma unroll
        for (int bj = 0; bj < 2; ++bj)
#pragma unroll
            for (int n = 0; n < 2; ++n) bv[bj][n] = bias ? *(const f32x4*)(bias + bcol0 + bj * HALF + 4 * n) : (f32x4){0.f, 0.f, 0.f, 0.f};
#pragma unroll
        for (int ai = 0; ai < 2; ++ai)
#pragma unroll
            for (int m = 0; m < 4; ++m) { bf16_t* rowp = base + (size_t)(row0 + ai * HALF + m * 16) * ldc + col0;
#pragma unroll
                for (int bj = 0; bj < 2; ++bj) { f32x4 v0 = acc[ai][bj][m][0] + bv[bj][0], v1 = acc[ai][bj][m][1] + bv[bj][1];
                    if (ACT == 1) { f32x2 a = gelu_pk((f32x2){v0[0], v0[1]}), b = gelu_pk((f32x2){v0[2], v0[3]}), c = gelu_pk((f32x2){v1[0], v1[1]}), d = gelu_pk((f32x2){v1[2], v1[3]});
                        v0 = (f32x4){a.x, a.y, b.x, b.y}; v1 = (f32x4){c.x, c.y, d.x, d.y}; }
                    v0 = v0 * sc; v1 = v1 * sc; u32x4 w; w.x = cvt_pk_bf16(v0[0], v0[1]); w.y = cvt_pk_bf16(v0[2], v0[3]); w.z = cvt_pk_bf16(v1[0], v1[1]); w.w = cvt_pk_bf16(v1[2], v1[3]);
                    *(u32x4*)(rowp + bj * HALF) = w; } }
    }
};

__device__ __forceinline__ float epi_sigm(float x) { return __builtin_amdgcn_rcpf(1.f + __expf(-x)); }
struct EpiGlu {
    static constexpr bool PERM = false, AFTER_DRAIN = false;
    bf16_t* O; int ldo;
    __device__ __forceinline__ void operator()(const f32x4 (&acc)[2][2][4][2], const Unit& u, int wr, int wc, int fr, int fq) const {
        const int row0 = u.pm * BM + wr * 64 + fr;
#pragma unroll
        for (int ai = 0; ai < 2; ++ai)
#pragma unroll
            for (int m = 0; m < 4; ++m) { bf16_t* rowp = O + (size_t)(row0 + ai * HALF + m * 16) * ldo + 4 * fq;
#pragma unroll
                for (int bj = 0; bj < 2; ++bj) { const int G = u.pn * 8 + bj * 4 + wc; const f32x4 av = acc[ai][bj][m][0], gv = acc[ai][bj][m][1];
                    typedef unsigned u32x2 __attribute__((ext_vector_type(2))); u32x2 w;
                    w.x = cvt_pk_bf16(av[0] * epi_sigm(gv[0]), av[1] * epi_sigm(gv[1])); w.y = cvt_pk_bf16(av[2] * epi_sigm(gv[2]), av[3] * epi_sigm(gv[3]));
                    *(u32x2*)(rowp + 16 * G) = w; } }
    }
};
template <int MODE> struct EpiMerge {
    static constexpr bool PERM = true, AFTER_DRAIN = false;
    float* M; const float* M2; bf16_t* Mb; const bf16_t* Zg; int ldz;
    __device__ __forceinline__ void operator()(const f32x4 (&acc)[2][2][4][2], const Unit& u, int wr, int wc, int fr, int fq) const {
        const int row0 = u.pm * BM + wr * 64 + fr, col0 = u.pn * BM + wc * 32 + 8 * fq;
#pragma unroll
        for (int ai = 0; ai < 2; ++ai)
#pragma unroll
            for (int m = 0; m < 4; ++m) { const size_t row = (size_t)(row0 + ai * HALF + m * 16);
#pragma unroll
                for (int bj = 0; bj < 2; ++bj) { const int col = col0 + bj * HALF;
                    const u32x4 gz = *(const u32x4*)(Zg + row * ldz + col);
                    float g[8]; g[0] = __builtin_bit_cast(float, gz.x << 16); g[1] = __builtin_bit_cast(float, gz.x & 0xffff0000u); g[2] = __builtin_bit_cast(float, gz.y << 16); g[3] = __builtin_bit_cast(float, gz.y & 0xffff0000u);
                    g[4] = __builtin_bit_cast(float, gz.z << 16); g[5] = __builtin_bit_cast(float, gz.z & 0xffff0000u); g[6] = __builtin_bit_cast(float, gz.w << 16); g[7] = __builtin_bit_cast(float, gz.w & 0xffff0000u);
                    f32x4 v0 = acc[ai][bj][m][0], v1 = acc[ai][bj][m][1];
#pragma unroll
                    for (int j = 0; j < 4; ++j) { v0[j] *= epi_sigm(g[j]); v1[j] *= epi_sigm(g[4 + j]); }
                    if (MODE == 0) { float* mp = M + row * 1024 + col; *(f32x4*)mp = v0; *(f32x4*)(mp + 4) = v1; }
                    else { const float* mp = M + row * 1024 + col; const float* mq = M2 + row * 1024 + col;
                        v0 += *(const f32x4*)mp + *(const f32x4*)mq; v1 += *(const f32x4*)(mp + 4) + *(const f32x4*)(mq + 4);
                        u32x4 w; w.x = cvt_pk_bf16(v0[0], v0[1]); w.y = cvt_pk_bf16(v0[2], v0[3]); w.z = cvt_pk_bf16(v1[0], v1[1]); w.w = cvt_pk_bf16(v1[2], v1[3]); *(u32x4*)(Mb + row * 1024 + col) = w; } } }
    }
};
struct EpiResid {
    static constexpr bool PERM = false, AFTER_DRAIN = false;
    float* X; int ldx; bool dry;
    __device__ __forceinline__ void operator()(const f32x4 (&acc)[2][2][4][2], const Unit& u, int wr, int wc, int fr, int fq) const {
        const int row0 = u.pm * BM + wr * 64 + fr, col0 = u.pn * BM + wc * 32 + 4 * fq;
#pragma unroll
        for (int ai = 0; ai < 2; ++ai)
#pragma unroll
            for (int m = 0; m < 4; ++m) { const int row = row0 + ai * HALF + m * 16;
                bool ok = true; if (row < 16896) { const int p = row % 8448; ok = p >= 48 && p < 8256; }
                if (ok && !dry) { float* rowp = X + (size_t)row * ldx + col0;
#pragma unroll
                    for (int bj = 0; bj < 2; ++bj)
#pragma unroll
                        for (int n = 0; n < 2; ++n) { f32x4* p4 = (f32x4*)(rowp + bj * HALF + n * 16); *p4 = *p4 + acc[ai][bj][m][n]; } } }
    }
};
struct EpiF32 {
    static constexpr bool PERM = false, AFTER_DRAIN = false;
    float* C; int ldc;
    __device__ __forceinline__ void operator()(const f32x4 (&acc)[2][2][4][2], const Unit& u, int wr, int wc, int fr, int fq) const {
        const int row0 = u.pm * BM + wr * 64 + fr, col0 = u.pn * BM + wc * 32 + 4 * fq;
#pragma unroll
        for (int ai = 0; ai < 2; ++ai)
#pragma unroll
            for (int m = 0; m < 4; ++m) { float* rowp = C + (size_t)(row0 + ai * HALF + m * 16) * ldc + col0;
#pragma unroll
                for (int bj = 0; bj < 2; ++bj)
#pragma unroll
                    for (int n = 0; n < 2; ++n) *(f32x4*)(rowp + bj * HALF + n * 16) = acc[ai][bj][m][n]; }
    }
};

template <class Epi, class Sched, bool ALIGN_EPI = false, bool SP2 = false>
__device__ __forceinline__ void gemm_phase(PG8_LAS unsigned char* lds, const Gemm g, const Sched& S, const Epi& E, int wv) {
    unsigned om_ = ~0u; asm volatile("" : "+s"(om_), "+s"(wv)); int tid_ = wv * 64 + (int)__builtin_amdgcn_mbcnt_hi(om_, __builtin_amdgcn_mbcnt_lo(om_, 0u));
    const int tid = tid_, wid = __builtin_amdgcn_readfirstlane(tid >> 6), lane = tid & 63, wr = wid >> 2, wc = wid & 3, fr = lane & 15, fq = lane >> 4;
    const int K = g.K, nt = K / BK;
    unsigned voffA[2], voffB[2];
#pragma unroll
    for (int i = 0; i < 2; ++i) { int R, C; stage_rc(tid * 16 + i * 8192, R, C); const int Rb = Epi::PERM ? ((R & ~31) + perm32(R & 31)) : R;
        voffA[i] = (unsigned)(R * K + C) * 2u; voffB[i] = (unsigned)(Rb * K + C) * 2u; }
    const size_t kstep = (size_t)(BK * 2);
    const size_t hstep = (size_t)HALF * K * 2;
    const size_t tstep = 2 * hstep;
    const unsigned ldsw = (unsigned)wid * 1024u;
    const int aoff = lds_byte(wr * 64 + fr, fq * 8), boff = lds_byte(wc * 32 + fr, fq * 8);
#define PG8_SA(b, h) (((b) * 2 + (h)) * HTB)
#define PG8_SB(b, h) ((4 + (b) * 2 + (h)) * HTB)
#define PG8_STAGE(bufoff, gbase, voff) do { _Pragma("unroll") for (int _i = 0; _i < 2; ++_i) \
        __builtin_amdgcn_global_load_lds((const unsigned*)((const char*)(gbase) + (voff)[_i]), (PG8_LAS unsigned*)(lds + (bufoff) + ldsw + _i * 8192), 16, 0, 0); } while (0)
#define PG8_LDA(dst, b, h) do { _Pragma("unroll") for (int m = 0; m < 4; ++m) _Pragma("unroll") for (int k = 0; k < 2; ++k) dst[m][k] = *(const PG8_LAS bf16x8*)(lds + PG8_SA(b, h) + aoff + m * 2048 + k * 1024); } while (0)
#define PG8_LDB(dst, b, h) do { _Pragma("unroll") for (int n = 0; n < 2; ++n) _Pragma("unroll") for (int k = 0; k < 2; ++k) dst[n][k] = *(const PG8_LAS bf16x8*)(lds + PG8_SB(b, h) + boff + n * 2048 + k * 1024); } while (0)
#define PG8_MMA(ai, bj, At, Bt) do { __builtin_amdgcn_s_setprio(1); _Pragma("unroll") for (int m = 0; m < 4; ++m) _Pragma("unroll") for (int n = 0; n < 2; ++n) _Pragma("unroll") for (int k = 0; k < 2; ++k) \
        acc[ai][bj][m][n] = __builtin_amdgcn_mfma_f32_16x16x32_bf16(Bt[n][k], At[m][k], acc[ai][bj][m][n], 0, 0, 0); __builtin_amdgcn_s_setprio(0); } while (0)
#define PG8_WAIT_V(n) asm volatile("s_waitcnt vmcnt(" #n ")" ::: "memory")
#define PG8_WAIT_L(n) asm volatile("s_waitcnt lgkmcnt(" #n ")" ::: "memory")
#define PG8_BAR __builtin_amdgcn_s_barrier()
#define PG8_SCHED __builtin_amdgcn_sched_barrier(0)
    Unit cur, nxt; int ui = 0;
    if (!S.next(0, cur)) return;
    f32x4 acc[2][2][4][2];
#pragma unroll
    for (int a = 0; a < 2; ++a)
#pragma unroll
        for (int b = 0; b < 2; ++b)
#pragma unroll
            for (int m = 0; m < 4; ++m)
#pragma unroll
                for (int n = 0; n < 2; ++n) acc[a][b][m][n] = (f32x4){0.f, 0.f, 0.f, 0.f};
    bf16x8 At[4][2], B0[2][2], B1[2][2];
    const char* cA = (const char*)g.A + (size_t)cur.pm * tstep; const char* cB = (const char*)g.Bt + (size_t)cur.pn * tstep;
    S.a_ready(cur);
    if constexpr (SP2) {
        PG8_STAGE(PG8_SB(0, 0), cB, voffB); PG8_STAGE(PG8_SB(0, 1), cB + hstep, voffB); PG8_STAGE(PG8_SA(0, 0), cA, voffA); PG8_STAGE(PG8_SA(0, 1), cA + hstep, voffA);
        if (wr == 1) PG8_BAR;
        PG8_WAIT_V(2); PG8_BAR;
        PG8_STAGE(PG8_SB(1, 0), cB + kstep, voffB); PG8_STAGE(PG8_SA(1, 0), cA + kstep, voffA); PG8_STAGE(PG8_SB(1, 1), cB + hstep + kstep, voffB);
        PG8_WAIT_V(6); PG8_BAR;
    } else {
        PG8_STAGE(PG8_SB(0, 0), cB, voffB); PG8_STAGE(PG8_SA(0, 0), cA, voffA); PG8_STAGE(PG8_SB(0, 1), cB + hstep, voffB); PG8_STAGE(PG8_SA(0, 1), cA + hstep, voffA);
        if (wr == 1) PG8_BAR;
        PG8_WAIT_V(4); PG8_BAR;
        PG8_STAGE(PG8_SB(1, 0), cB + kstep, voffB); PG8_STAGE(PG8_SA(1, 0), cA + kstep, voffA); PG8_STAGE(PG8_SB(1, 1), cB + hstep + kstep, voffB);
        PG8_WAIT_V(6); PG8_BAR;
    }
    for (;;) {
        const bool has_next = S.next(ui + 1, nxt);
        const char* nA = has_next ? (const char*)g.A + (size_t)nxt.pm * tstep : cA; const char* nB = has_next ? (const char*)g.Bt + (size_t)nxt.pn * tstep : cB;
        for (int t = 0; t < nt; t += 2) {
            const bool last = (t == nt - 2);
            const char* a1 = cA + (size_t)(t + 1) * kstep;
            const char* a2 = last ? nA : cA + (size_t)(t + 2) * kstep; const char* b2 = last ? nB : cB + (size_t)(t + 2) * kstep;
            const char* a3 = a2 + kstep; const char* b3 = b2 + kstep;
            if (last && has_next) S.a_ready(nxt);
            if constexpr (SP2) {
            PG8_LDB(B0, 0, 0); PG8_LDB(B1, 0, 1); PG8_SCHED; PG8_LDA(At, 0, 0); PG8_STAGE(PG8_SA(1, 1), a1 + hstep, voffA);
            PG8_WAIT_V(8); PG8_WAIT_L(0); PG8_BAR; PG8_MMA(0, 0, At, B0); PG8_MMA(0, 1, At, B1); PG8_BAR; PG8_SCHED;
            PG8_LDA(At, 0, 1); PG8_STAGE(PG8_SB(0, 0), b2, voffB); PG8_STAGE(PG8_SB(0, 1), b2 + hstep, voffB); PG8_STAGE(PG8_SA(0, 0), a2, voffA);
            PG8_WAIT_V(8); PG8_WAIT_L(0); PG8_BAR; PG8_MMA(1, 0, At, B0); PG8_MMA(1, 1, At, B1); PG8_BAR; PG8_SCHED;
            PG8_LDB(B0, 1, 0); PG8_LDB(B1, 1, 1); PG8_SCHED; PG8_LDA(At, 1, 0); PG8_STAGE(PG8_SA(0, 1), a2 + hstep, voffA);
            PG8_WAIT_V(8); PG8_WAIT_L(0); PG8_BAR; PG8_MMA(0, 0, At, B0); PG8_MMA(0, 1, At, B1); PG8_BAR; PG8_SCHED;
            PG8_LDA(At, 1, 1); PG8_STAGE(PG8_SB(1, 0), b3, voffB); PG8_STAGE(PG8_SB(1, 1), b3 + hstep, voffB); PG8_STAGE(PG8_SA(1, 0), a3, voffA);
            PG8_WAIT_V(8); PG8_WAIT_L(0); PG8_BAR; PG8_MMA(1, 0, At, B0); PG8_MMA(1, 1, At, B1); PG8_BAR; PG8_SCHED;
            } else {
            PG8_LDB(B0, 0, 0); PG8_SCHED; PG8_LDA(At, 0, 0); PG8_STAGE(PG8_SA(1, 1), a1 + hstep, voffA);
            PG8_WAIT_L(8); PG8_BAR; PG8_WAIT_L(0); PG8_MMA(0, 0, At, B0); PG8_BAR; PG8_SCHED;
            PG8_LDB(B1, 0, 1); PG8_STAGE(PG8_SB(0, 0), b2, voffB);
            PG8_BAR; PG8_WAIT_L(0); PG8_MMA(0, 1, At, B1); PG8_BAR;
            PG8_LDA(At, 0, 1); PG8_STAGE(PG8_SA(0, 0), a2, voffA);
            PG8_BAR; PG8_WAIT_L(0); PG8_MMA(1, 0, At, B0); PG8_BAR; PG8_SCHED;
            PG8_STAGE(PG8_SB(0, 1), b2 + hstep, voffB);
            PG8_WAIT_V(6); PG8_BAR; PG8_MMA(1, 1, At, B1); PG8_BAR;
            PG8_LDB(B0, 1, 0); PG8_SCHED; PG8_LDA(At, 1, 0); PG8_STAGE(PG8_SA(0, 1), a2 + hstep, voffA);
            PG8_WAIT_L(8); PG8_BAR; PG8_WAIT_L(0); PG8_MMA(0, 0, At, B0); PG8_BAR; PG8_SCHED;
            PG8_LDB(B1, 1, 1); PG8_STAGE(PG8_SB(1, 0), b3, voffB);
            PG8_BAR; PG8_WAIT_L(0); PG8_MMA(0, 1, At, B1); PG8_BAR;
            PG8_LDA(At, 1, 1); PG8_STAGE(PG8_SA(1, 0), a3, voffA);
            PG8_BAR; PG8_WAIT_L(0); PG8_MMA(1, 0, At, B0); PG8_BAR; PG8_SCHED;
            PG8_STAGE(PG8_SB(1, 1), b3 + hstep, voffB);
            PG8_WAIT_V(6); PG8_BAR; PG8_MMA(1, 1, At, B1); PG8_BAR;
            }
        }
        if constexpr (ALIGN_EPI) { if (wr == 0) PG8_BAR; }
        if constexpr (!Epi::AFTER_DRAIN) { E(acc, cur, wr, wc, fr, fq); S.done(cur); }
        if (!has_next) break;
#pragma unroll
        for (int a = 0; a < 2; ++a)
#pragma unroll
            for (int b = 0; b < 2; ++b)
#pragma unroll
                for (int m = 0; m < 4; ++m)
#pragma unroll
                    for (int n = 0; n < 2; ++n) acc[a][b][m][n] = (f32x4){0.f, 0.f, 0.f, 0.f};
        cur = nxt; cA = nA; cB = nB; ++ui;
        if constexpr (ALIGN_EPI) { if (wr == 1) PG8_BAR; }
    }
    PG8_WAIT_V(0);
    if constexpr (!ALIGN_EPI) { if (wr == 0) PG8_BAR; }
    PG8_BAR;
    if constexpr (Epi::AFTER_DRAIN) { E.fused(acc, cur, wr, wc, fr, fq, lds, wid, lane); S.done(cur); }
#undef PG8_SA
#undef PG8_SB
#undef PG8_STAGE
#undef PG8_LDA
#undef PG8_LDB
#undef PG8_MMA
#undef PG8_WAIT_V
#undef PG8_WAIT_L
#undef PG8_BAR
#undef PG8_SCHED
}
}
#include <hip/hip_bf16.h>
#include <cmath>
namespace attn_body {
using bf16=__hip_bfloat16;
using bf16x8=__attribute__((ext_vector_type(8)))short;
using s16x4=__attribute__((ext_vector_type(4)))short;
using f32x16=__attribute__((ext_vector_type(16)))float;
using u32x4=__attribute__((ext_vector_type(4)))unsigned;
constexpr int ASEQ=8448,D=64;
constexpr int QP=512,KP=512,VP=7424,OP=1024;
constexpr int NW=8,QBLK=32,QB=QBLK*NW,KVBLK=64,NQB=ASEQ/QB;
constexpr int ATTN_UNIT_ROWS=QB;
__device__ __forceinline__ int crow(int r,int hi){return (r&3)+8*(r>>2)+4*hi;}
#define SBAR() __builtin_amdgcn_sched_barrier(0)
constexpr int BT_OFF=383, BT_N=640;
__device__ __forceinline__ void bmask(f32x16&p0,f32x16&p1,int t,int q0,int wid,int r32,int hi,const __attribute__((address_space(3))) float*tab){
  const float NEG=-INFINITY; const int qw=q0+32*wid;
  if(t>(qw>>6)){
    #pragma unroll
    for(int r=0;r<16;++r){p0[r]=NEG;p1[r]=NEG;} return; }
  if(t>0 && 64*t+63+91<=qw) return;
  const int q=qw+r32, kb=64*t+4*hi;
  #pragma unroll
  for(int r=0;r<16;++r){ const int kv=kb+(r&3)+8*(r>>2); int i0=kv-q+BT_OFF, i1=i0+32; i0=i0<0?0:i0; i1=i1<0?0:i1;
    p0[r]+=tab[i0]; p1[r]+=tab[i1]; if(kv<48)p0[r]=NEG; if(kv+32<48)p1[r]=NEG; }
}

constexpr int NSLOT=3, SLOTB=8192;
constexpr int LDS_K=0, LDS_V=NSLOT*SLOTB, LDS_WS=2*NSLOT*SLOTB, LDS_OST=LDS_WS+NW*64*4, LDS_BT=LDS_OST+NW*4096, LDS_BYTES=LDS_BT+BT_N*4;
constexpr float C2=0.125f*1.4426950408889634f;
__device__ __forceinline__ void glds16(const void*gsrc,unsigned lds_dst){unsigned keep;
  asm volatile("s_mov_b32 %0, m0\n\ts_mov_b32 m0, %2\n\ts_nop 0\n\tglobal_load_lds_dwordx4 %1, off\n\ts_mov_b32 m0, %0":"=&s"(keep):"v"(gsrc),"s"(lds_dst):"memory");}
__device__ __forceinline__ float max3f(float a,float b,float c){float r;asm("v_max3_f32 %0, %1, %2, %3":"=v"(r):"v"(a),"v"(b),"v"(c));return r;}
__device__ __forceinline__ float max2f(float a,float b){float r;asm("v_max_f32_e32 %0, %1, %2":"=v"(r):"v"(a),"v"(b));return r;}
__device__ __forceinline__ float fadd_s(float a,float b){float r;asm("v_add_f32_e32 %0, %1, %2":"=v"(r):"v"(a),"v"(b));return r;}
__device__ __forceinline__ float fsub_s(float a,float b){float r;asm("v_sub_f32_e32 %0, %1, %2":"=v"(r):"v"(a),"v"(b));return r;}
typedef float f32x2_t __attribute__((ext_vector_type(2))); typedef __bf16 bf16x2_t __attribute__((ext_vector_type(2)));
__device__ __forceinline__ unsigned cvtpk_s(float lo,float hi){f32x2_t v={lo,hi};bf16x2_t b=__builtin_convertvector(v,bf16x2_t);return __builtin_bit_cast(unsigned,b);}
#define WAIT_BAR(N) asm volatile("s_waitcnt vmcnt(" #N ") lgkmcnt(0)\n\ts_barrier":::"memory")

__device__ __forceinline__ void qkt(f32x16&p0,f32x16&p1,const char*Kslot,const bf16x8*qr,const f32x16&negm,int r32,int hi){
  const char*kb=Kslot+hi*1024+r32*16;
  #pragma unroll
  for(int d0=0;d0<4;++d0){
    const bf16x8 b0=*reinterpret_cast<const bf16x8*>(kb+d0*2048);
    const bf16x8 b1=*reinterpret_cast<const bf16x8*>(kb+d0*2048+512);
    if(d0==0){p0=__builtin_amdgcn_mfma_f32_32x32x16_bf16(b0,qr[0],negm,0,0,0);p1=__builtin_amdgcn_mfma_f32_32x32x16_bf16(b1,qr[0],negm,0,0,0);}
    else{p0=__builtin_amdgcn_mfma_f32_32x32x16_bf16(b0,qr[d0],p0,0,0,0);p1=__builtin_amdgcn_mfma_f32_32x32x16_bf16(b1,qr[d0],p1,0,0,0);}}
}
typedef __attribute__((address_space(3))) const char* lds_cptr;
typedef __attribute__((address_space(3))) const float* lds_cfptr;
typedef short v4i16_t __attribute__((ext_vector_type(4)));
__device__ __forceinline__ void kload8(bf16x8*kf,lds_cptr kp){
  kf[0]=*(const __attribute__((address_space(3))) bf16x8*)(kp);      kf[1]=*(const __attribute__((address_space(3))) bf16x8*)(kp+512);
  kf[2]=*(const __attribute__((address_space(3))) bf16x8*)(kp+2048); kf[3]=*(const __attribute__((address_space(3))) bf16x8*)(kp+2560);
  kf[4]=*(const __attribute__((address_space(3))) bf16x8*)(kp+4096); kf[5]=*(const __attribute__((address_space(3))) bf16x8*)(kp+4608);
  kf[6]=*(const __attribute__((address_space(3))) bf16x8*)(kp+6144); kf[7]=*(const __attribute__((address_space(3))) bf16x8*)(kp+6656);
}
__device__ __forceinline__ void kload2(bf16x8*kf,lds_cptr kp,int j){ kf[2*j]=*(const __attribute__((address_space(3))) bf16x8*)(kp+j*2048); kf[2*j+1]=*(const __attribute__((address_space(3))) bf16x8*)(kp+j*2048+512); }
__device__ __forceinline__ s16x4 vtr(lds_cptr p){ return __builtin_bit_cast(s16x4,__builtin_amdgcn_ds_read_tr16_b64_v4i16((__attribute__((address_space(3))) v4i16_t*)p)); }
__device__ __forceinline__ float rowmax(const f32x16&p0,const f32x16&p1){
  float a=max3f(p0[0],p0[1],p1[0]),b=max3f(p0[2],p0[3],p1[1]);a=max3f(a,p1[2],p1[3]);
  #pragma unroll
  for(int r=4;r<16;r+=4){a=max3f(a,p0[r],p0[r+1]);b=max3f(b,p0[r+2],p0[r+3]);a=max3f(a,p1[r],p1[r+1]);b=max3f(b,p1[r+2],p1[r+3]);}
  const float m=max2f(a,b);
  auto rr=__builtin_amdgcn_permlane32_swap(__float_as_uint(m),__float_as_uint(m),false,false);
  return max2f(__uint_as_float(rr[0]),__uint_as_float(rr[1]));
}
__device__ __forceinline__ void pv(f32x16*o,int vb,bf16x8 pa0,bf16x8 pa1,bf16x8 pa2,bf16x8 pa3){
  #pragma unroll
  for(int d0=0;d0<2;++d0){s16x4 lo[4],hi[4];
    #pragma unroll
    for(int ks=0;ks<4;++ks){
      asm volatile("ds_read_b64_tr_b16 %0,%1 offset:%c2":"=&v"(lo[ks]):"v"(vb),"i"(d0*4096+ks*1024):"memory");
      asm volatile("ds_read_b64_tr_b16 %0,%1 offset:%c2":"=&v"(hi[ks]):"v"(vb),"i"(d0*4096+ks*1024+512):"memory");}
    asm volatile("s_waitcnt lgkmcnt(0)":::"memory");SBAR();
    #define PK(k) (bf16x8){lo[k][0],lo[k][1],lo[k][2],lo[k][3],hi[k][0],hi[k][1],hi[k][2],hi[k][3]}
    o[d0]=__builtin_amdgcn_mfma_f32_32x32x16_bf16(pa0,PK(0),o[d0],0,0,0);
    o[d0]=__builtin_amdgcn_mfma_f32_32x32x16_bf16(pa1,PK(1),o[d0],0,0,0);
    o[d0]=__builtin_amdgcn_mfma_f32_32x32x16_bf16(pa2,PK(2),o[d0],0,0,0);
    o[d0]=__builtin_amdgcn_mfma_f32_32x32x16_bf16(pa3,PK(3),o[d0],0,0,0);
    #undef PK
  }
}

#ifndef ATTN_STORE16
#define ATTN_STORE16(p,v) (*(u32x4*)(p)=(v))
#endif
template<int THRL> __device__ __forceinline__ void attn_unit(int b,int qoff,int voff,int ooff,int qb,const bf16*Q,const bf16*__restrict__ K,const bf16*__restrict__ V,bf16*O,char*shm,int wv){
  unsigned om_ = ~0u; asm volatile("" : "+s"(om_), "+s"(wv)); int tid_ = wv * 64 + (int)__builtin_amdgcn_mbcnt_hi(om_, __builtin_amdgcn_mbcnt_lo(om_, 0u)); const int tid=tid_,lane=tid&63,r32=lane&31,hi=lane>>5; const int wid=__builtin_amdgcn_readfirstlane(tid>>6);
  const long rowbase=(long)b*ASEQ; const int q0=qb*QB;
  const bf16*Qw=Q+(rowbase+q0+wid*QBLK)*QP+qoff;
  const bf16*Kh=K+rowbase*KP+qoff,*Vh=V+rowbase*VP+voff;
  const unsigned lds0=(unsigned)(uintptr_t)shm;
  float*wsf=(float*)(shm+LDS_WS)+wid*64;
  const bf16*ksrc=Kh+(long)lane*KP+wid*8;
  const bf16*vsrc=Vh+(long)(16*(wid&3)+(lane>>2))*VP+(wid>>2)*32+(lane&3)*8;
  const unsigned kdst=lds0+LDS_K+wid*1024, vdst=lds0+LDS_V+wid*1024;
  #define DMA_K(t,slot) glds16(ksrc+(long)(t)*KVBLK*KP,(unsigned)__builtin_amdgcn_readfirstlane(kdst+(slot)))
  #define DMA_V(t,slot) glds16(vsrc+(long)(t)*KVBLK*VP,(unsigned)__builtin_amdgcn_readfirstlane(vdst+(slot)))
  const int vb0=(int)(lds0+LDS_V)+((lane>>4)&1)*32+(lane&3)*8+(4*hi+((lane&15)>>2))*64;
  const char*Kbase=shm+LDS_K; bf16x8 kf[8];
  const lds_cptr shm3=(lds_cptr)shm; const lds_cfptr btab=(lds_cfptr)(shm3+LDS_BT); const lds_cptr kp0=shm3+LDS_K+hi*1024+r32*16; const lds_cptr vp0=shm3+LDS_V+((lane>>4)&1)*32+(lane&3)*8+(4*hi+((lane&15)>>2))*64;
  const int NTL=(q0+QB)/KVBLK;
  DMA_K(0,0);DMA_V(0,0);DMA_K(1,SLOTB);
  bf16x8 qr[4];
  #pragma unroll
  for(int d0=0;d0<4;++d0)qr[d0]=*reinterpret_cast<const bf16x8*>(&Qw[(long)r32*QP+d0*16+hi*8]);
  float mhat=0.f,l_reg=0.f;f32x16 o[2];o[0]=f32x16{};o[1]=f32x16{};const f32x16 zt=f32x16{};
  const int qrel=wid*QBLK+r32;
  #define CMASK(P0,P1,t) bmask(P0,P1,(t),q0,wid,r32,hi,btab)
  bool resc=false;
  #define START(P0,P1) do{ const float rm=rowmax(P0,P1); resc=false; \
    { const float dl=rm; mhat=fadd_s(mhat,dl); \
      _Pragma("unroll") for(int r=0;r<16;++r){P0[r]=fsub_s(P0[r],dl);P1[r]=fsub_s(P1[r],dl);} \
      } \
    _Pragma("unroll") for(int r=0;r<16;++r)P0[r]=__builtin_amdgcn_exp2f(P0[r]); }while(0)
  #define RESC() do{ if(resc){ asm volatile("s_waitcnt lgkmcnt(0)":::"memory"); \
      _Pragma("unroll") for(int d_=0;d_<2;++d_) _Pragma("unroll") for(int r=0;r<16;++r)o[d_][r]*=wsf[crow(r,hi)]; } }while(0)
  f32x16 pA0,pA1,pB0,pB1;
  int sl_prev=0,sl_cur=0,sl_next=SLOTB;
  #define ROT() do{sl_prev=sl_cur;sl_cur=sl_next;sl_next=(sl_next==(NSLOT-1)*SLOTB)?0:sl_next+SLOTB;}while(0)
  DMA_K(2,2*SLOTB);
  WAIT_BAR(3);
  qkt(pA0,pA1,Kbase,qr,zt,r32,hi);asm volatile("s_nop 15\n\ts_nop 7":"+v"(pA0),"+v"(pA1));CMASK(pA0,pA1,0);
  START(pA0,pA1);
  _Pragma("unroll") for(int r=0;r<16;++r)pA1[r]=__builtin_amdgcn_exp2f(pA1[r]);
  WAIT_BAR(0);
  DMA_K(3,0);DMA_V(1,SLOTB);
  ROT();
  kload8(kf,kp0+sl_cur);
  WAIT_BAR(2);
  s16x4 vlo[8],vhi[8]; u32x4 pw0,pw1,pw2,pw3;
  #define PKW(P,B) cvtpk_s(P[B],P[B+1])
  #define PAF(k) __builtin_bit_cast(bf16x8,pw##k)
  #define VFR(i) (bf16x8){vlo[i][0],vlo[i][1],vlo[i][2],vlo[i][3],vhi[i][0],vhi[i][1],vhi[i][2],vhi[i][3]}
  #define PIN(x) asm volatile("":"+v"(x))
  #define MX3(a,b,c) __builtin_fmaxf(__builtin_fmaxf((a),(b)),(c))
  #define GAPA(MF,A0,A1,A2,A3,W0,W1,PW) do{ MF; sacc+=A0; sacc+=A1; sacc+=A2; sacc+=A3; PIN(sacc); W0; W1; PIN(PW); SBAR(); }while(0)
  #define EX(v) __builtin_amdgcn_exp2f(v)
  #define GAPB(MF,X,B) do{ MF; X[B]=EX(X[B]); X[B+1]=EX(X[B+1]); X[B+2]=EX(X[B+2]); X[B+3]=EX(X[B+3]); PIN(X); SBAR(); }while(0)
  #define VRD(i) do{ vlo[i]=vtr(vp_+(((i)>>2)*4096+((i)&3)*1024)); vhi[i]=vtr(vp_+(((i)>>2)*4096+((i)&3)*1024+512)); }while(0)
  #define KRD(G,j) do{ if(G){ kload2(kf,kp0+sl_next,j); SBAR(); } }while(0)
  #define STEP(C0,C1,P0,P1,t,GK,GV,GL) do{ SBAR(); \
    const lds_cptr vp_=vp0+sl_prev; \
    VRD(0); SBAR(); float sacc=(P0[0]+P0[1]); \
    GAPA(C0=__builtin_amdgcn_mfma_f32_32x32x16_bf16(kf[0],qr[0],zt,0,0,0), P0[2],P0[3],P0[4],P0[5],     pw0[0]=PKW(P0,0), pw0[1]=PKW(P0,2), pw0); \
    VRD(4); SBAR(); GAPA(C1=__builtin_amdgcn_mfma_f32_32x32x16_bf16(kf[1],qr[0],zt,0,0,0), P0[6],P0[7],P0[8],P0[9],     pw0[2]=PKW(P0,4), pw0[3]=PKW(P0,6), pw0); \
    VRD(1); SBAR(); GAPA(C0=__builtin_amdgcn_mfma_f32_32x32x16_bf16(kf[2],qr[1],C0,0,0,0),   P0[10],P0[11],P0[12],P0[13], pw1[0]=PKW(P0,8), pw1[1]=PKW(P0,10), pw1); \
    VRD(5); SBAR(); GAPA(C1=__builtin_amdgcn_mfma_f32_32x32x16_bf16(kf[3],qr[1],C1,0,0,0),   P0[14],P0[15],P1[0],P1[1],   pw1[2]=PKW(P0,12),pw1[3]=PKW(P0,14), pw1); \
    VRD(2); SBAR(); GAPA(C0=__builtin_amdgcn_mfma_f32_32x32x16_bf16(kf[4],qr[2],C0,0,0,0),   P1[2],P1[3],P1[4],P1[5],     pw2[0]=PKW(P1,0), pw2[1]=PKW(P1,2), pw2); \
    VRD(6); SBAR(); GAPA(C1=__builtin_amdgcn_mfma_f32_32x32x16_bf16(kf[5],qr[2],C1,0,0,0),   P1[6],P1[7],P1[8],P1[9],     pw2[2]=PKW(P1,4), pw2[3]=PKW(P1,6), pw2); \
    VRD(3); SBAR(); GAPA(C0=__builtin_amdgcn_mfma_f32_32x32x16_bf16(kf[6],qr[3],C0,0,0,0),   P1[10],P1[11],P1[12],P1[13], pw3[0]=PKW(P1,8), pw3[1]=PKW(P1,10), pw3); \
    VRD(7); SBAR(); GAPA(C1=__builtin_amdgcn_mfma_f32_32x32x16_bf16(kf[7],qr[3],C1,0,0,0),   P1[14],P1[15],0.f,0.f,       pw3[2]=PKW(P1,12),pw3[3]=PKW(P1,14), pw3); \
    l_reg+=sacc; \
    if(GK){DMA_K((t)+3,sl_cur);} if(GV){DMA_V((t)+1,sl_next);} \
    _Pragma("unroll") for(int r=0;r<16;++r){C0[r]-=mhat;C1[r]-=mhat;} \
    CMASK(C0,C1,t); \
    { float a=MX3(C0[0],C0[1],C1[0]),b=MX3(C0[2],C0[3],C1[1]); a=MX3(a,C1[2],C1[3]); \
      _Pragma("unroll") for(int r=4;r<16;r+=4){a=MX3(a,C0[r],C0[r+1]);b=MX3(b,C0[r+2],C0[r+3]);a=MX3(a,C1[r],C1[r+1]);b=MX3(b,C1[r+2],C1[r+3]);} \
      float rm=__builtin_fmaxf(a,b); { auto rr=__builtin_amdgcn_permlane32_swap(__float_as_uint(rm),__float_as_uint(rm),false,false); rm=__builtin_fmaxf(__uint_as_float(rr[0]),__uint_as_float(rr[1])); } \
      resc=false; \
      if(__builtin_expect(__any(rm>(float)THRL),0)){ const float dl=__builtin_fmaxf(rm,0.f); mhat+=dl; \
        _Pragma("unroll") for(int r=0;r<16;++r){C0[r]-=dl;C1[r]-=dl;} \
        const float f=__builtin_amdgcn_exp2f(-dl); l_reg*=f; if(hi==0)wsf[r32]=f; resc=true; } } \
    SBAR(); \
    GAPB(o[0]=__builtin_amdgcn_mfma_f32_32x32x16_bf16(PAF(0),VFR(0),o[0],0,0,0), C0,0); \
    GAPB(o[1]=__builtin_amdgcn_mfma_f32_32x32x16_bf16(PAF(0),VFR(4),o[1],0,0,0), C0,4); \
    KRD(GL,0); GAPB(o[0]=__builtin_amdgcn_mfma_f32_32x32x16_bf16(PAF(1),VFR(1),o[0],0,0,0), C0,8); \
    KRD(GL,1); GAPB(o[1]=__builtin_amdgcn_mfma_f32_32x32x16_bf16(PAF(1),VFR(5),o[1],0,0,0), C0,12); \
    KRD(GL,2); GAPB(o[0]=__builtin_amdgcn_mfma_f32_32x32x16_bf16(PAF(2),VFR(2),o[0],0,0,0), C1,0); \
    KRD(GL,3); GAPB(o[1]=__builtin_amdgcn_mfma_f32_32x32x16_bf16(PAF(2),VFR(6),o[1],0,0,0), C1,4); \
    GAPB(o[0]=__builtin_amdgcn_mfma_f32_32x32x16_bf16(PAF(3),VFR(3),o[0],0,0,0), C1,8); \
    GAPB(o[1]=__builtin_amdgcn_mfma_f32_32x32x16_bf16(PAF(3),VFR(7),o[1],0,0,0), C1,12); \
    }while(0)
  int t=1;
  #undef CMASK
  #define CMASK(P0,P1,t) do{}while(0)
  for(;t+7<NTL;t+=2){
    STEP(pB0,pB1,pA0,pA1,t,true,true,true);     WAIT_BAR(2); RESC(); ROT();
    STEP(pA0,pA1,pB0,pB1,t+1,true,true,true);   WAIT_BAR(2); RESC(); ROT();
  }
  #undef CMASK
  #define CMASK(P0,P1,t) bmask(P0,P1,(t),q0,wid,r32,hi,btab)
  #define ENDW(tt) do{ if((tt)+3<NTL){WAIT_BAR(2);} else if((tt)+2<NTL){WAIT_BAR(1);} else {WAIT_BAR(0);} }while(0)
  for(;t+1<NTL;t+=2){
    STEP(pB0,pB1,pA0,pA1,t,(t+3<NTL),(t+1<NTL),(t+1<NTL));       ENDW(t);   RESC(); ROT();
    STEP(pA0,pA1,pB0,pB1,t+1,(t+4<NTL),(t+2<NTL),(t+2<NTL));     ENDW(t+1); RESC(); ROT();
  }
  STEP(pB0,pB1,pA0,pA1,NTL-1,false,false,false); RESC();
  { float sacc=pB0[0]+pB0[1]; _Pragma("unroll") for(int r=2;r<16;++r)sacc+=pB0[r]; _Pragma("unroll") for(int r=0;r<16;++r)sacc+=pB1[r]; l_reg+=sacc;
    pw0=(u32x4){PKW(pB0,0),PKW(pB0,2),PKW(pB0,4),PKW(pB0,6)};pw1=(u32x4){PKW(pB0,8),PKW(pB0,10),PKW(pB0,12),PKW(pB0,14)};pw2=(u32x4){PKW(pB1,0),PKW(pB1,2),PKW(pB1,4),PKW(pB1,6)};pw3=(u32x4){PKW(pB1,8),PKW(pB1,10),PKW(pB1,12),PKW(pB1,14)};
    SBAR(); pv(o,vb0+sl_cur,PAF(0),PAF(1),PAF(2),PAF(3)); }
  #undef PKW
  #undef PAF
  #undef VFR
  #undef PIN
  #undef MX3
  #undef GAPA
  #undef GAPB
  #undef EX
  #undef VRD
  #undef KRD
  #undef STEP
  #undef ENDW
  {auto rr=__builtin_amdgcn_permlane32_swap(__float_as_uint(l_reg),__float_as_uint(l_reg),false,false);l_reg=__uint_as_float(rr[0])+__uint_as_float(rr[1]);}
  if(hi==0)wsf[32+r32]=l_reg;asm volatile("s_waitcnt lgkmcnt(0)":::"memory");
  float rli[16];
  #pragma unroll
  for(int r=0;r<16;++r)rli[r]=__builtin_amdgcn_rcpf(wsf[32+crow(r,hi)]);
  bf16*Ow=O+(rowbase+q0+wid*QBLK)*OP+ooff;
  { bf16*stg=(bf16*)(shm+LDS_OST)+wid*2048;
    #pragma unroll
    for(int r=0;r<16;++r){const int orow=crow(r,hi);
      #pragma unroll
      for(int d0=0;d0<2;++d0)stg[orow*64+d0*32+r32]=__float2bfloat16(o[d0][r]*rli[r]);}
    asm volatile("s_waitcnt lgkmcnt(0)":::"memory");
    #pragma unroll
    for(int i=0;i<4;++i){const int row=i*8+(lane>>3),ch=lane&7; const u32x4 v=*(const u32x4*)(stg+row*64+ch*8); ATTN_STORE16(Ow+(long)row*OP+ch*8,v);} }
  asm volatile("s_waitcnt lgkmcnt(0)\n\ts_barrier":::"memory");
  #undef DMA_K
  #undef DMA_V
  #undef CMASK
  #undef START
  #undef RESC
  #undef ROT
}
constexpr int ATTN_LDS_BYTES=LDS_BYTES;
#undef SBAR
#undef WAIT_BAR
#undef WAIT_BAR
}
namespace mk {
#define GAS __attribute__((address_space(1)))
#define LAS __attribute__((address_space(3)))
typedef unsigned short bf16;
typedef unsigned v4u __attribute__((ext_vector_type(4)));
typedef unsigned v2u __attribute__((ext_vector_type(2)));
typedef float f32x4 __attribute__((ext_vector_type(4)));
typedef float f32x16 __attribute__((ext_vector_type(16)));
typedef short bf16x8 __attribute__((ext_vector_type(8)));
typedef GAS unsigned gu32;
#define RLX_AGENT __ATOMIC_RELAXED, __HIP_MEMORY_SCOPE_AGENT
#define LDS_WAIT() asm volatile("s_waitcnt lgkmcnt(0)" ::: "memory")
#define VM_WAIT() asm volatile("s_waitcnt vmcnt(0)" ::: "memory")
__device__ __forceinline__ unsigned f2bf(float f) { unsigned u = __builtin_bit_cast(unsigned, f); return (u + 0x7fffu + ((u >> 16) & 1u)) >> 16; }
__device__ __forceinline__ unsigned pk2(float lo, float hi) { return f2bf(lo) | (f2bf(hi) << 16); }
__device__ __forceinline__ float bf2f(unsigned short b) { return __builtin_bit_cast(float, ((unsigned)b) << 16); }
__device__ __forceinline__ float bflo(unsigned w) { return __builtin_bit_cast(float, w << 16); }
__device__ __forceinline__ float bfhi(unsigned w) { return __builtin_bit_cast(float, w & 0xffff0000u); }

constexpr int NWAVES = 8, NTHR = NWAVES * 64;
constexpr int PADF = 48;
constexpr int LPP = 8448;
constexpr int PEND = PADF + LP;
constexpr int SROW0 = BATCH * LPP;
constexpr int RP = SROW0 + NS;
constexpr int ZN = 7424;
constexpr int ZC_QA = 0, ZC_KA = 512, ZC_VA = 1024, ZC_QKVB = 1536, ZC_GB = 3072, ZC_UC = 3584, ZC_GATE = 4096, ZC_BA = 7168;
static_assert(RP % 256 == 0 && ZN % 256 == 0 && D_MODEL == 1024 && WIDTH_A == 512 && WIDTH_B == 512 && WIDTH_C == 512, "shapes");
__host__ __device__ __forceinline__ int nat2prow(int row) { return row < NP ? (row / LP) * LPP + PADF + row % LP : SROW0 + (row - NP); }
__host__ __device__ __forceinline__ int zcol(int col) { return col < 3584 ? col : (col < 3592 ? ZC_BA + (col - 3584) : col - 8); }
__device__ __forceinline__ bool prow_valid(int prow) { if (prow >= SROW0) return true; const int p = prow % LPP; return p >= PADF && p < PEND; }
__device__ __forceinline__ int prow2nat(int prow) { if (prow >= SROW0) return NP + (prow - SROW0); return (prow / LPP) * LP + (prow % LPP) - PADF; }

constexpr int RING_OFF = 0, RING_BYTES = 147456;
constexpr int LDSCTL_OFF = RING_BYTES, MISC_OFF = LDSCTL_OFF + 320;
constexpr int LDS_BYTES = RING_BYTES + 1024;
static_assert(MISC_OFF + 128 <= LDS_BYTES, "LDS map");

constexpr size_t CTL_BYTES = 1u << 20;
constexpr int CW_TMO = 0, CW_CODE = 1;
constexpr int CW_BAR = 4096;
constexpr int CW_QUEUE = 16384;

__device__ __forceinline__ int lane_id() { return (int)__builtin_amdgcn_mbcnt_hi(~0u, __builtin_amdgcn_mbcnt_lo(~0u, 0u)); }
#define XB_TMO      128
#define XB_XCNT(j)  (256  + 64 * (j))
#define XB_XSUB(j)  (1280 + 64 * (j))
#define XB_XGEN(j)  (2304 + 64 * (j))
#define XB_TOP      3328
#define XB_TOPGEN   3392
#define XCD_BAR_WORDS 3456
#define XB_SPIN_CAP (1u << 18)

__device__ __forceinline__ unsigned xb_ld(unsigned* p)              { return __hip_atomic_load(p, __ATOMIC_RELAXED, __HIP_MEMORY_SCOPE_AGENT); }
__device__ __forceinline__ unsigned xb_add(unsigned* p, unsigned v) { return __hip_atomic_fetch_add(p, v, __ATOMIC_RELAXED, __HIP_MEMORY_SCOPE_AGENT); }
__device__ __forceinline__ unsigned xb_xcc_id() { return (unsigned)__builtin_amdgcn_s_getreg((3 << 11) | 20) & 0xFu; }
#define XB_SPIN(cond, bar) do { unsigned _sp = 0; while (cond) { __builtin_amdgcn_s_sleep(1); \
    if ((++_sp & 255u) == 0u) { if (xb_ld(&(bar)[XB_TMO])) break; if (_sp > XB_SPIN_CAP) { atomicAdd(&(bar)[XB_TMO], 1u); break; } } } } while (0)

struct XcdBarrier {
    unsigned* bar; unsigned x; int wv;
    volatile LAS unsigned* st;
};

__device__ __forceinline__ XcdBarrier xcd_barrier_post(unsigned* bar, volatile LAS unsigned* st, int wv) {
    XcdBarrier b; b.bar = bar; b.x = xb_xcc_id(); b.st = st; b.wv = wv;
    if (wv == 0 && lane_id() == 0) (void)xb_add(&bar[XB_XCNT(b.x)], 1u);
    return b;
}
__device__ __forceinline__ void xcd_barrier_complete(unsigned* bar, unsigned x, unsigned& nloc, unsigned& nx) {
    const unsigned G = gridDim.x * gridDim.y * gridDim.z;
    unsigned sum, cnt, mine, sp = 0u;
    for (;;) {
        sum = 0u; cnt = 0u; mine = 0u;
#pragma unroll
        for (unsigned j = 0; j < 16; ++j) { const unsigned c = xb_ld(&bar[XB_XCNT(j)]); sum += c; cnt += (c > 0u) ? 1u : 0u; mine = (j == x) ? c : mine; }
        if (sum == G) break;
        __builtin_amdgcn_s_sleep(1);
        if ((++sp & 255u) == 0u) { if (xb_ld(&bar[XB_TMO])) break; if (sp > XB_SPIN_CAP) { atomicAdd(&bar[XB_TMO], 1u); break; } }
    }
    nloc = mine > 0u ? mine : 1u; nx = cnt > 0u ? cnt : 1u;
}

__device__ __forceinline__ void xcd_barrier(const XcdBarrier& b) {
    asm volatile("s_waitcnt vmcnt(0)" ::: "memory");
    __syncthreads();
    if (b.wv == 0 && lane_id() == 0) {
        unsigned* bar = b.bar;
        __builtin_amdgcn_s_waitcnt(0);
        unsigned nloc = b.st[0], nx = b.st[1];
        if (nloc == 0u) { xcd_barrier_complete(bar, b.x, nloc, nx); b.st[0] = nloc; b.st[1] = nx; }
        const unsigned old = xb_add(&bar[XB_XSUB(b.x)], 1u);
        const unsigned gen = old / nloc;
        if (old + 1u == (gen + 1u) * nloc) {
            __builtin_amdgcn_fence(__ATOMIC_RELEASE, "agent");
            asm volatile("s_waitcnt vmcnt(0)" ::: "memory");
            const unsigned og = xb_add(&bar[XB_TOP], 1u);
            const unsigned tg = og / nx;
            if (og + 1u == (tg + 1u) * nx) xb_add(&bar[XB_TOPGEN], 1u);
            else XB_SPIN(xb_ld(&bar[XB_TOPGEN]) == tg, bar);
            __builtin_amdgcn_fence(__ATOMIC_ACQUIRE, "agent");
            xb_add(&bar[XB_XGEN(b.x)], 1u);
            asm volatile("s_waitcnt vmcnt(0)" ::: "memory");
        } else {
            XB_SPIN(xb_ld(&bar[XB_XGEN(b.x)]) == gen, bar);
            __builtin_amdgcn_fence(__ATOMIC_ACQUIRE, "agent");
            asm volatile("s_waitcnt vmcnt(0)" ::: "memory");
        }
    }
    __syncthreads();
}


template <int CTRL> __device__ __forceinline__ float dpp_f(float v) { return __builtin_bit_cast(float, __builtin_amdgcn_update_dpp(0, __builtin_bit_cast(int, v), CTRL, 0xf, 0xf, true)); }
template <int CTRL, int ROWMASK> __device__ __forceinline__ float dpp_fm(float v) { return __builtin_bit_cast(float, __builtin_amdgcn_update_dpp(0, __builtin_bit_cast(int, v), CTRL, ROWMASK, 0xf, false)); }
__device__ __forceinline__ float rdlane(float v, int i) { return __builtin_bit_cast(float, __builtin_amdgcn_readlane(__builtin_bit_cast(int, v), i)); }
__device__ __forceinline__ float sum8(float v) { v += dpp_f<0xB1>(v); v += dpp_f<0x4E>(v); v += dpp_f<0x141>(v); return v; }
__device__ __forceinline__ float sum16(float v) { v = sum8(v); v += dpp_f<0x140>(v); return v; }
__device__ __forceinline__ float wave_sum(float v) { v = sum16(v); return rdlane(v, 0) + rdlane(v, 16) + rdlane(v, 32) + rdlane(v, 48); }
__device__ __forceinline__ float wave_max(float v) {
    v = fmaxf(v, dpp_f<0xB1>(v)); v = fmaxf(v, dpp_f<0x4E>(v)); v = fmaxf(v, dpp_f<0x141>(v)); v = fmaxf(v, dpp_f<0x140>(v));
    return fmaxf(fmaxf(rdlane(v, 0), rdlane(v, 16)), fmaxf(rdlane(v, 32), rdlane(v, 48)));
}
__device__ __forceinline__ float scan64(float v) {
    v += dpp_f<0x111>(v); v += dpp_f<0x112>(v); v += dpp_f<0x114>(v); v += dpp_f<0x118>(v);
    v += dpp_fm<0x142, 0xA>(v); v += dpp_fm<0x143, 0xC>(v);
    return v;
}
__device__ __forceinline__ float swap32(float v) {
    const auto r = __builtin_amdgcn_permlane32_swap(__builtin_bit_cast(unsigned, v), __builtin_bit_cast(unsigned, v), false, false);
    return __builtin_bit_cast(float, (lane_id() & 32) ? r[0] : r[1]);
}
}
namespace mk {
enum Region { R_X, R_XN, R_WIN, R_Z, R_QN, R_KN, R_QKVB, R_BG, R_O, R_OA, R_OB, R_YC, R_OC, R_MRG, R_WGLU, R_WBR, R_WOUT, R_WQS, R_PU, R_PV, R_SC, R_GDN, R_S5T, R_MISC, R_S5E, R_S5X, R_MRGB, R_OBN, R_MRG2, R_NREG };
constexpr int NPL = 16;
enum Phase { PH_PRO = 0, PL_NORM1 = 0, PL_GEMM_IN = 1, PL_ZPOST = 2, PL_LOCAL = 3, PL_MIX = 4, PL_MIXPOST = 5, PL_GEMM_GLU = 6, PL_GEMM_BRA = 7, PL_GEMM_BRB = 8, PL_GEMM_BRC = 9,
             PL_GEMM_OUT = 10, PL_NORM2 = 11, PL_GEMM_PEER = 12, PL_PEER = 13, PH_FINAL = 1 + DEPTH * NPL, PH_END = PH_FINAL + 1 };
enum ProMask { PM_X = 1, PM_WIN = 2, PM_WREST = 4, PM_PEERW = 8, PM_WQS = 16, PM_TABLES = 32 };
struct Args {
    const float* in[40];
    float* out;
    unsigned char* ws;
    unsigned long long off[32];
    int ph_lo, ph_hi, pro_mask, bar_region;
};
static_assert(sizeof(Args) == 40 * 8 + 8 + 8 + 32 * 8 + 16, "Args has no padding");

typedef const __attribute__((address_space(4))) Args* KArgs;
__device__ __forceinline__ KArgs kargs() { KArgs p = (KArgs)__builtin_amdgcn_kernarg_segment_ptr(); asm volatile("" : "+s"(p)); return p; }
#define WS_OPAQUE(a) unsigned char* wsb = (a).ws; asm volatile("" : "+s"(wsb))
#define otid() otid_(F.wv)
__device__ __forceinline__ int otid_(int wv) { unsigned m = ~0u; asm volatile("" : "+s"(m), "+s"(wv));
    return wv * 64 + (int)__builtin_amdgcn_mbcnt_hi(m, __builtin_amdgcn_mbcnt_lo(m, 0u)); }
struct Frame {
    LAS unsigned char* lds; volatile LAS unsigned* MISC; gu32* ctl;
    int vcu, G, wv;
};

template <class CM> __device__ __forceinline__ void transpose_item(const float* W, int ld, int K, bf16* WT, int n0, int k0, const CM& cm, LAS float* scr, int lane) {
    const int sc = cm(n0 + (lane & 31));
#pragma unroll 8
    for (int i = 0; i < 32; ++i) { const int kk = 2 * i + (lane >> 5); scr[kk * 33 + (lane & 31)] = sc >= 0 ? W[(size_t)(k0 + kk) * ld + sc] : 0.f; }
    LDS_WAIT(); asm volatile("" ::: "memory");
    const int c = lane & 7;
#pragma unroll
    for (int j = 0; j < 4; ++j) { const int n = (lane >> 3) + 8 * j; const LAS float* s = scr + (8 * c) * 33 + n;
        v4u o; o.x = pk2(s[0 * 33], s[1 * 33]); o.y = pk2(s[2 * 33], s[3 * 33]); o.z = pk2(s[4 * 33], s[5 * 33]); o.w = pk2(s[6 * 33], s[7 * 33]);
        *(GAS v4u*)(WT + (size_t)(n0 + n) * K + k0 + 8 * c) = o; }
    LDS_WAIT(); asm volatile("" ::: "memory");
}
struct CmWin { __device__ __forceinline__ int operator()(int n) const { return n < 3584 ? n : (n < 7168 ? n + 8 : (n < 7176 ? 3584 + (n - 7168) : -1)); } };
struct CmId { __device__ __forceinline__ int operator()(int n) const { return n; } };
struct CmGlu { __device__ __forceinline__ int operator()(int n) const { const int G = n >> 5, i = n & 31; return i < 16 ? 16 * G + i : 512 + 16 * G + (i - 16); } };

__device__ __forceinline__ void rms_row_to_bf16(const float* xrow, const float* g, bf16* orow, int lane) {
    const GAS f32x4* xr = (const GAS f32x4*)xrow + lane;
    f32x4 v[4]; float s2 = 0.f;
#pragma unroll
    for (int j = 0; j < 4; ++j) { v[j] = xr[64 * j]; s2 += (v[j].x * v[j].x + v[j].y * v[j].y) + (v[j].z * v[j].z + v[j].w * v[j].w); }
    const float r = __builtin_amdgcn_rsqf(wave_sum(s2) * (1.f / D_MODEL) + EPSF);
    const GAS f32x4* gr = (const GAS f32x4*)g + lane;
    GAS unsigned long long* o8 = (GAS unsigned long long*)orow + lane;
#pragma unroll
    for (int j = 0; j < 4; ++j) { const f32x4 gg = gr[64 * j];
        o8[64 * j] = (unsigned long long)pk2(v[j].x * r * gg.x, v[j].y * r * gg.y) | ((unsigned long long)pk2(v[j].z * r * gg.z, v[j].w * r * gg.w) << 32); }
}

__device__ __forceinline__ void p_norm(Frame& F, int l, int gi) {
    const KArgs ap = kargs(); const auto& a = *ap; WS_OPAQUE(a);
    const int tid = otid(), lane = tid & 63, wave = __builtin_amdgcn_readfirstlane(tid >> 6);
    const float* X = (const float*)(wsb + a.off[R_X]); bf16* XN = (bf16*)(wsb + a.off[R_XN]); const float* g = a.in[gi] + (size_t)l * D_MODEL;
    const int gw = F.vcu * NWAVES + wave, NGW = F.G * NWAVES;
    for (int m = gw; m < RP; m += NGW) rms_row_to_bf16(X + (size_t)m * D_MODEL, g, XN + (size_t)m * D_MODEL, lane);
}
__device__ __forceinline__ void unpack8(const v4u w, float (&f)[8]) { f[0] = bflo(w.x); f[1] = bfhi(w.x); f[2] = bflo(w.y); f[3] = bfhi(w.y); f[4] = bflo(w.z); f[5] = bfhi(w.z); f[6] = bflo(w.w); f[7] = bfhi(w.w); }
__device__ __forceinline__ v4u pack8(const float (&f)[8]) { v4u w; w.x = pk2(f[0], f[1]); w.y = pk2(f[2], f[3]); w.z = pk2(f[4], f[5]); w.w = pk2(f[6], f[7]); return w; }
__device__ __forceinline__ float sigm(float x) { return __builtin_amdgcn_rcpf(1.f + __expf(-x)); }
constexpr float ATT_C2 = 0.125f * 1.4426950408889634f;
__device__ __forceinline__ void p_zpost(Frame& F, int l) {
    const KArgs ap = kargs(); const auto& a = *ap; WS_OPAQUE(a);
    const bf16* Z = (const bf16*)(wsb + a.off[R_Z]);
    bf16* QN = (bf16*)(wsb + a.off[R_QN]); bf16* KN = (bf16*)(wsb + a.off[R_KN]); bf16* QKVB = (bf16*)(wsb + a.off[R_QKVB]); float* BG = (float*)(wsb + a.off[R_BG]);
    const int tid = otid(), lane = tid & 63, wave = __builtin_amdgcn_readfirstlane(tid >> 6);
    const int gw = F.vcu * NWAVES + wave, NGW = F.G * NWAVES;
    float gq[8], gk[8], cw[3][4][8];
#pragma unroll
    for (int j = 0; j < 8; ++j) { gq[j] = a.in[I_QN][l * HEAD_DIM_A + 8 * (lane & 7) + j] * ATT_C2; gk[j] = a.in[I_KN][l * HEAD_DIM_A + 8 * (lane & 7) + j]; }
#pragma unroll
    for (int w = 0; w < 3; ++w)
#pragma unroll
        for (int i = 0; i < 4; ++i)
#pragma unroll
            for (int j = 0; j < 8; ++j) cw[w][i][j] = a.in[I_CONVW][((size_t)l * CONV_W + i) * 3 * WIDTH_B + w * WIDTH_B + 8 * lane + j];
    float alog = 0.f, dtb = 0.f; if (lane < 4) { alog = a.in[I_ALOG][l * N_HEADS_B + lane]; dtb = a.in[I_DTB][l * N_HEADS_B + lane]; }
    for (int m = gw; m < RP; m += NGW) {
        const bool valid = prow_valid(m); const int nat = valid ? prow2nat(m) : 0;
        const bf16* zr = Z + (size_t)m * ZN;
        float f[8], o[8];
        unpack8(*(const GAS v4u*)(zr + ZC_QA + 8 * lane), f);
        { float ss = 0.f;
#pragma unroll
          for (int j = 0; j < 8; ++j) ss += f[j] * f[j];
          ss = sum8(ss);
          const float r = __builtin_amdgcn_rsqf(ss * (1.f / HEAD_DIM_A) + EPSF);
#pragma unroll
          for (int j = 0; j < 8; ++j) o[j] = f[j] * r * gq[j];
          *(GAS v4u*)(QN + (size_t)m * WIDTH_A + 8 * lane) = pack8(o); }
        unpack8(*(const GAS v4u*)(zr + ZC_KA + 8 * lane), f);
        { float ss = 0.f;
#pragma unroll
          for (int j = 0; j < 8; ++j) ss += f[j] * f[j];
          ss = sum8(ss);
          const float r = __builtin_amdgcn_rsqf(ss * (1.f / HEAD_DIM_A) + EPSF);
#pragma unroll
          for (int j = 0; j < 8; ++j) o[j] = f[j] * r * gk[j];
          *(GAS v4u*)(KN + (size_t)m * WIDTH_A + 8 * lane) = pack8(o);
          if (valid) { float* ko = nat < NP ? a.out + O_KP + ((size_t)l * NP + nat) * WIDTH_A : a.out + O_KS + ((size_t)l * NS + (nat - NP)) * WIDTH_A;
              *(GAS f32x4*)(ko + 8 * lane) = (f32x4){o[0], o[1], o[2], o[3]}; *(GAS f32x4*)(ko + 8 * lane + 4) = (f32x4){o[4], o[5], o[6], o[7]}; } }
        if (valid) { unpack8(*(const GAS v4u*)(zr + ZC_VA + 8 * lane), f);
            float* vo = nat < NP ? a.out + O_VP + ((size_t)l * NP + nat) * WIDTH_A : a.out + O_VS + ((size_t)l * NS + (nat - NP)) * WIDTH_A;
            *(GAS f32x4*)(vo + 8 * lane) = (f32x4){f[0], f[1], f[2], f[3]}; *(GAS f32x4*)(vo + 8 * lane + 4) = (f32x4){f[4], f[5], f[6], f[7]}; }
        const int ts = m >= SROW0 ? (m - SROW0) % DEC_SEQ : 1000; const int bs = m >= SROW0 ? (m - SROW0) / DEC_SEQ : 0;
        int cj = -1;
        if (m >= SROW0) { if (ts >= DEC_SEQ - 3) cj = ts - (DEC_SEQ - 3); } else { const int p = m % LPP; if (p >= PEND - 3 && p < PEND) cj = p - (PEND - 3); }
#pragma unroll
        for (int w = 0; w < 3; ++w) {
            float acc[8];
#pragma unroll
            for (int j = 0; j < 8; ++j) acc[j] = 0.f;
#pragma unroll
            for (int i = 0; i < 4; ++i) {
                const int dt = i - 3;
                if (ts + dt < 0) {
                    const float* sc = a.in[I_SCONV] + (((size_t)l * DEC_BATCH + bs) * (CONV_W - 1) + (CONV_W - 1 + ts + dt)) * 3 * WIDTH_B + w * WIDTH_B + 8 * lane;
                    const f32x4 s0 = *(const GAS f32x4*)sc, s1 = *(const GAS f32x4*)(sc + 4);
                    f[0] = s0.x; f[1] = s0.y; f[2] = s0.z; f[3] = s0.w; f[4] = s1.x; f[5] = s1.y; f[6] = s1.z; f[7] = s1.w;
                } else if (m + dt >= 0) unpack8(*(const GAS v4u*)(Z + (size_t)(m + dt) * ZN + ZC_QKVB + w * WIDTH_B + 8 * lane), f);
                else {
#pragma unroll
                    for (int j = 0; j < 8; ++j) f[j] = 0.f; }
#pragma unroll
                for (int j = 0; j < 8; ++j) acc[j] += f[j] * cw[w][i][j];
                if (i == 3 && cj >= 0) {
                    float* co = m >= SROW0 ? a.out + O_CS + (((size_t)l * DEC_BATCH + bs) * (CONV_W - 1) + cj) * 3 * WIDTH_B : a.out + O_CP + (((size_t)l * BATCH + m / LPP) * (CONV_W - 1) + cj) * 3 * WIDTH_B;
                    *(GAS f32x4*)(co + w * WIDTH_B + 8 * lane) = (f32x4){f[0], f[1], f[2], f[3]}; *(GAS f32x4*)(co + w * WIDTH_B + 8 * lane + 4) = (f32x4){f[4], f[5], f[6], f[7]}; }
            }
            float ss = 0.f;
#pragma unroll
            for (int j = 0; j < 8; ++j) { acc[j] = acc[j] * sigm(acc[j]); ss += acc[j] * acc[j]; }
            float sc = 1.f;
            if (w < 2) { ss = sum16(ss);
                sc = __builtin_amdgcn_rsqf(ss + EPSF); if (w == 0) sc *= 0.08838834764831845f; }
#pragma unroll
            for (int j = 0; j < 8; ++j) o[j] = acc[j] * sc;
            *(GAS v4u*)(QKVB + (size_t)m * 3 * WIDTH_B + w * WIDTH_B + 8 * lane) = pack8(o);
        }
        if (lane < 4) { const float be = bf2f(zr[ZC_BA + lane]), al = bf2f(zr[ZC_BA + 4 + lane]) + dtb;
            const float sp = al > 20.f ? al : __logf(1.f + __expf(al));
            BG[(size_t)m * 8 + lane] = valid ? sigm(be) : 0.f; BG[(size_t)m * 8 + 4 + lane] = valid ? -__expf(alog) * sp : 0.f; }
    }
}
constexpr float LOG2E = 1.4426950408889634f;
__device__ __forceinline__ int t5_bucket_dev(int rel) {
    const int n = rel < 0 ? -rel : rel; int b;
    if (n < 8) b = n; else if (n < 12) b = 8; else if (n < 16) b = 9; else if (n < 23) b = 10; else if (n < 32) b = 11;
    else if (n < 46) b = 12; else if (n < 64) b = 13; else if (n < 91) b = 14; else b = 15;
    return b + (rel > 0 ? 16 : 0);
}
__device__ __forceinline__ void build_bias_table(LAS float* tab, const float* rel_bias, int h, int tid) {
    const float far = rel_bias[15 * N_HEADS_A + h];
    for (int i = tid; i < attn_body::BT_N; i += NTHR) tab[i] = (rel_bias[t5_bucket_dev(i - attn_body::BT_OFF) * N_HEADS_A + h] - far) * LOG2E;
}
__device__ __forceinline__ float lam_init_dev(int l) { return 0.8f - 0.6f * __expf(-0.3f * (float)l); }
__device__ __forceinline__ float lam_dev(const float* lqk_all, int l, int lane) {
    const float* q = lqk_all + (size_t)l * 4 * HEAD_DIM_A;
    const float s0 = wave_sum(q[lane] * q[HEAD_DIM_A + lane]), s1 = wave_sum(q[2 * HEAD_DIM_A + lane] * q[3 * HEAD_DIM_A + lane]);
    return __expf(s0) - __expf(s1) + lam_init_dev(l);
}
__device__ __forceinline__ int krow_dev(int s, int h, int j) { return 16 * s + 8 * (j >> 2) + 4 * h + (j & 3); }
__device__ __forceinline__ int crow_dev(int r, int h) { return (r & 3) + 8 * (r >> 2) + 4 * h; }
__device__ __forceinline__ bf16x8 pack_f8(const f32x4 a, const f32x4 b) { v4u w; w.x = pk2(a.x, a.y); w.y = pk2(a.z, a.w); w.z = pk2(b.x, b.y); w.w = pk2(b.z, b.w); return __builtin_bit_cast(bf16x8, w); }

__device__ __forceinline__ void sample_scores(f32x16& X, int kb, int c, const float* ck, const bf16* KN, int row0, int h, int hi, int r32, int qpos, const bf16x8 (&qf)[4], const LAS float* tab) {
    bf16x8 kf[4];
    if (kb < PAST_LEN / 32) { const float* kr = ck + (size_t)(kb * 32 + r32) * WIDTH_A + h * 128 + c * 64 + 8 * hi;
#pragma unroll
        for (int s = 0; s < 4; ++s) kf[s] = pack_f8(*(const GAS f32x4*)(kr + 16 * s), *(const GAS f32x4*)(kr + 16 * s + 4)); }
    else { const bf16* kr = KN + (size_t)(row0 + (kb * 32 - PAST_LEN) + r32) * WIDTH_A + h * 128 + c * 64 + 8 * hi;
#pragma unroll
        for (int s = 0; s < 4; ++s) kf[s] = *(const GAS bf16x8*)(kr + 16 * s); }
#pragma unroll
    for (int i = 0; i < 16; ++i) X[i] = 0.f;
#pragma unroll
    for (int s = 0; s < 4; ++s) X = __builtin_amdgcn_mfma_f32_32x32x16_bf16(kf[s], qf[s], X, 0, 0, 0);
#pragma unroll
    for (int i = 0; i < 16; ++i) { int idx = kb * 32 + crow_dev(i, hi) - qpos + attn_body::BT_OFF; idx = idx < 0 ? 0 : idx; X[i] += tab[idx]; }
}

__device__ __forceinline__ void attn_sample_unit(Frame& F, int l, int bs, int h) {
    const KArgs ap = kargs(); const auto& a = *ap; WS_OPAQUE(a);
    const int tid = otid(), lane = tid & 63, wid = __builtin_amdgcn_readfirstlane(tid >> 6), r32 = lane & 31, hi = lane >> 5;
    const bf16* QN = (const bf16*)(wsb + a.off[R_QN]); const bf16* KN = (const bf16*)(wsb + a.off[R_KN]); const bf16* Z = (const bf16*)(wsb + a.off[R_Z]); bf16* O = (bf16*)(wsb + a.off[R_O]);
    const float* ck = a.in[I_CK] + ((size_t)l * DEC_BATCH + bs) * PAST_LEN * WIDTH_A; const float* cv = a.in[I_CV] + ((size_t)l * DEC_BATCH + bs) * PAST_LEN * WIDTH_A;
    const int row0 = SROW0 + bs * DEC_SEQ;
    LAS float* tab = (LAS float*)(F.lds + RING_OFF + attn_body::LDS_BT);
    LAS float* st = (LAS float*)(F.lds + RING_OFF + 90112);
    LAS float* slot = (LAS float*)(F.lds + RING_OFF);
    const float lam = lam_dev(a.in[I_LQK], l, lane);
    build_bias_table(tab, a.in[I_REL], h, tid);
    bf16x8 qf[2][4];
#pragma unroll
    for (int c = 0; c < 2; ++c)
#pragma unroll
        for (int s = 0; s < 4; ++s) qf[c][s] = *(const GAS bf16x8*)(QN + (size_t)(row0 + r32) * WIDTH_A + h * 128 + c * 64 + 16 * s + 8 * hi);
    __syncthreads();
    float m[2] = {-1e30f, -1e30f}, lsum[2] = {0.f, 0.f};
    const int qpos = PAST_LEN + r32;
    for (int kb = wid; kb < (PAST_LEN + DEC_SEQ) / 32; kb += NWAVES) {
#pragma unroll
        for (int c = 0; c < 2; ++c) { f32x16 X; sample_scores(X, kb, c, ck, KN, row0, h, hi, r32, qpos, qf[c], tab);
            float mx = X[0];
#pragma unroll
            for (int i = 1; i < 16; ++i) mx = fmaxf(mx, X[i]);
            mx = fmaxf(mx, swap32(mx)); const float mn = fmaxf(m[c], mx);
            float sum = 0.f;
#pragma unroll
            for (int i = 0; i < 16; ++i) sum += exp2f(X[i] - mn);
            lsum[c] = lsum[c] * exp2f(m[c] - mn) + sum; m[c] = mn; }
    }
#pragma unroll
    for (int c = 0; c < 2; ++c) { lsum[c] += swap32(lsum[c]); if (hi == 0) { st[((wid * 2 + c) * 2 + 0) * 32 + r32] = m[c]; st[((wid * 2 + c) * 2 + 1) * 32 + r32] = lsum[c]; } }
    __syncthreads();
    float gm[2], ginv[2];
#pragma unroll
    for (int c = 0; c < 2; ++c) { float mm = -1e30f;
#pragma unroll
        for (int w = 0; w < NWAVES; ++w) mm = fmaxf(mm, st[((w * 2 + c) * 2 + 0) * 32 + r32]);
        float ll = 0.f;
#pragma unroll
        for (int w = 0; w < NWAVES; ++w) ll += st[((w * 2 + c) * 2 + 1) * 32 + r32] * exp2f(st[((w * 2 + c) * 2 + 0) * 32 + r32] - mm);
        gm[c] = mm; ginv[c] = (c == 0 ? 1.f : lam) / ll; }
    f32x16 acc[4];
#pragma unroll
    for (int eb = 0; eb < 4; ++eb)
#pragma unroll
        for (int i = 0; i < 16; ++i) acc[eb][i] = 0.f;
    for (int kb = wid; kb < (PAST_LEN + DEC_SEQ) / 32; kb += NWAVES) {
        f32x16 X0, X1; sample_scores(X0, kb, 0, ck, KN, row0, h, hi, r32, qpos, qf[0], tab); sample_scores(X1, kb, 1, ck, KN, row0, h, hi, r32, qpos, qf[1], tab);
        float wv[16];
#pragma unroll
        for (int i = 0; i < 16; ++i) wv[i] = exp2f(X0[i] - gm[0]) * ginv[0] - exp2f(X1[i] - gm[1]) * ginv[1];
        bf16x8 xs[2];
#pragma unroll
        for (int s = 0; s < 2; ++s) { v4u w; w.x = pk2(wv[8 * s], wv[8 * s + 1]); w.y = pk2(wv[8 * s + 2], wv[8 * s + 3]); w.z = pk2(wv[8 * s + 4], wv[8 * s + 5]); w.w = pk2(wv[8 * s + 6], wv[8 * s + 7]); xs[s] = __builtin_bit_cast(bf16x8, w); }
#pragma unroll
        for (int eb = 0; eb < 4; ++eb)
#pragma unroll
            for (int s = 0; s < 2; ++s) {
                float vv[8];
                if (kb < PAST_LEN / 32) { const float* vb = cv + (size_t)(kb * 32 + 4 * hi) * WIDTH_A + h * 128 + eb * 32 + r32; asm volatile("" : "+v"(vb));
#pragma unroll
                    for (int j = 0; j < 8; ++j) vv[j] = vb[(size_t)(16 * s + 8 * (j >> 2) + (j & 3)) * WIDTH_A]; }
                else { const bf16* vb = Z + (size_t)(row0 + kb * 32 - PAST_LEN + 4 * hi) * ZN + ZC_VA + h * 128 + eb * 32 + r32; asm volatile("" : "+v"(vb));
#pragma unroll
                    for (int j = 0; j < 8; ++j) vv[j] = bf2f(vb[(size_t)(16 * s + 8 * (j >> 2) + (j & 3)) * ZN]); }
                v4u w; w.x = pk2(vv[0], vv[1]); w.y = pk2(vv[2], vv[3]); w.z = pk2(vv[4], vv[5]); w.w = pk2(vv[6], vv[7]);
                acc[eb] = __builtin_amdgcn_mfma_f32_32x32x16_bf16(xs[s], __builtin_bit_cast(bf16x8, w), acc[eb], 0, 0, 0);
            }
    }
    __syncthreads();
#pragma unroll
    for (int eb = 0; eb < 4; ++eb)
#pragma unroll
        for (int i = 0; i < 16; ++i) slot[(wid * 32 + crow_dev(i, hi)) * 128 + eb * 32 + r32] = acc[eb][i];
    __syncthreads();
    { const int q = tid >> 4, e0 = (tid & 15) * 8; float o[8];
#pragma unroll
      for (int j = 0; j < 8; ++j) o[j] = 0.f;
#pragma unroll
      for (int w = 0; w < NWAVES; ++w)
#pragma unroll
          for (int j = 0; j < 8; ++j) o[j] += slot[(w * 32 + q) * 128 + e0 + j];
      v4u pw; pw.x = pk2(o[0], o[1]); pw.y = pk2(o[2], o[3]); pw.z = pk2(o[4], o[5]); pw.w = pk2(o[6], o[7]);
      bf16* orow = O + (size_t)(row0 + q) * attn_body::OP + h * 256;
      unsigned zq = 0u; asm volatile("" : "+v"(zq));
      *(GAS v4u*)(orow + e0) = pw; *(GAS v4u*)(orow + 128 + e0) = (v4u){zq, zq, zq, zq}; }
    __syncthreads();
}

constexpr int ATT_NQB = LPP / 256;
constexpr int ATT_NPU = BATCH * 16 * ATT_NQB;
constexpr int ATT_NSU = DEC_BATCH * N_HEADS_A;
__device__ __forceinline__ void p_attention(Frame& F, int lq, unsigned char* ldsg) {
    const int l = lq % DEPTH;
    for (;;) {
        const KArgs ap = kargs(); const auto& a = *ap; WS_OPAQUE(a);
        const int tid = otid();
        gu32* head = (gu32*)wsb + CW_QUEUE + 64 * lq;
        const attn_body::bf16* QN = (const attn_body::bf16*)(wsb + a.off[R_QN]); const attn_body::bf16* KN = (const attn_body::bf16*)(wsb + a.off[R_KN]);
        const attn_body::bf16* Z = (const attn_body::bf16*)(wsb + a.off[R_Z]); attn_body::bf16* O = (attn_body::bf16*)(wsb + a.off[R_O]);
        if (tid == 0) F.MISC[16] = __hip_atomic_fetch_add(head, 1u, RLX_AGENT);
        __syncthreads();
        const int u = (int)F.MISC[16];
        __syncthreads();
        if (u >= ATT_NPU + ATT_NSU) break;
        if (u < ATT_NPU) {
            const int qb = (ATT_NQB - 1) - u / 32, bvh = u % 32, b = bvh >> 4, vh = bvh & 15, h = vh >> 2, c = (vh >> 1) & 1, half = vh & 1;
            build_bias_table((LAS float*)(F.lds + RING_OFF + attn_body::LDS_BT), a.in[I_REL], h, tid);
            __syncthreads();
            attn_body::attn_unit<8>(b, h * 128 + c * 64, ZC_VA + h * 128 + half * 64, h * 256 + c * 128 + half * 64, qb, QN, KN, Z, O, (char*)ldsg + RING_OFF, F.wv);
        } else { const int su = u - ATT_NPU; attn_sample_unit(F, l, su >> 2, su & 3); }
    }
}
__device__ __forceinline__ void p_mixpost_a(Frame& F, int l) {
    const KArgs ap = kargs(); const auto& a = *ap; WS_OPAQUE(a);
    const int tid = otid(), lane = tid & 63, wave = __builtin_amdgcn_readfirstlane(tid >> 6);
    const bf16* O = (const bf16*)(wsb + a.off[R_O]); bf16* OA = (bf16*)(wsb + a.off[R_OA]);
    const int gw = F.vcu * NWAVES + wave, NGW = F.G * NWAVES;
    const float lam = lam_dev(a.in[I_LQK], l, lane), post = 1.f - lam_init_dev(l);
    const int h = lane >> 4, e0 = 8 * (lane & 15);
    float sg[8];
#pragma unroll
    for (int j = 0; j < 8; ++j) sg[j] = a.in[I_SUBLN][l * 2 * HEAD_DIM_A + e0 + j] * post;
    for (int m = gw; m < RP; m += NGW) {
        float o0[8], o1[8], d[8];
        unpack8(*(const GAS v4u*)(O + (size_t)m * 1024 + h * 256 + e0), o0); unpack8(*(const GAS v4u*)(O + (size_t)m * 1024 + h * 256 + 128 + e0), o1);
        float ss = 0.f;
#pragma unroll
        for (int j = 0; j < 8; ++j) { d[j] = o0[j] - lam * o1[j]; ss += d[j] * d[j]; }
        ss = sum16(ss);
        const float r = __builtin_amdgcn_rsqf(ss * (1.f / 128.f) + EPSF);
#pragma unroll
        for (int j = 0; j < 8; ++j) d[j] = d[j] * r * sg[j];
        *(GAS v4u*)(OA + (size_t)m * WIDTH_A + h * 128 + e0) = pack8(d);
    }
}
constexpr int GDN_NCH = PEND / 64;
constexpr int GDN_NPI = BATCH * N_HEADS_B * GDN_NCH;
constexpr int GDN_NSI = DEC_BATCH * N_HEADS_B;
constexpr int GDN_NI = GDN_NPI + GDN_NSI;
constexpr int GI_W = 0, GI_QG = 16384, GI_KG = 32768, GI_AT = 49152, GI_U = 57344, GI_SC = 73728, GI_STRIDE = 73984;
static_assert(GDN_NI % 4 == 0 && PEND % 64 == 0, "gdn items");
__device__ __forceinline__ int frag_off(int row, int kk, int nkb) {
    const int fid = ((row >> 5) * nkb + (kk >> 5)) * 2 + ((kk & 31) >> 4), ln = (row & 31) + 32 * (((kk & 15) >> 2) & 1), j = ((kk & 15) >> 3) * 4 + (kk & 3);
    return (fid * 64 + ln) * 8 + j;
}
__device__ __forceinline__ int gdn_item_row(int item, int j) {
    if (item < GDN_NPI) { const int sh = item / GDN_NCH, n = item % GDN_NCH; return (sh / N_HEADS_B) * LPP + 64 * n + j; }
    const int s = item - GDN_NPI; return j < 32 ? -1 : SROW0 + (s >> 2) * DEC_SEQ + (j - 32);
}
__device__ __forceinline__ int gdn_item_head(int item) { return item < GDN_NPI ? (item / GDN_NCH) % N_HEADS_B : (item - GDN_NPI) & 3; }

__device__ __forceinline__ void gdn_flush(const LAS unsigned char* stg, unsigned char* dst, int nbytes, int gt) {
    for (int o = gt * 16; o < nbytes; o += 2048) *(GAS v4u*)(dst + o) = *(const LAS v4u*)(stg + o);
}
typedef float f32x2s __attribute__((ext_vector_type(2)));
#define GDN_RL8(a, arow, jb) asm volatile("v_readlane_b32 %0, %8, %9\n\tv_readlane_b32 %1, %8, %10\n\tv_readlane_b32 %2, %8, %11\n\tv_readlane_b32 %3, %8, %12\n\tv_readlane_b32 %4, %8, %13\n\tv_readlane_b32 %5, %8, %14\n\tv_readlane_b32 %6, %8, %15\n\tv_readlane_b32 %7, %8, %16" \
    : "=s"(a[0]), "=s"(a[1]), "=s"(a[2]), "=s"(a[3]), "=s"(a[4]), "=s"(a[5]), "=s"(a[6]), "=s"(a[7]) : "v"(arow), "i"(jb), "i"((jb) + 1), "i"((jb) + 2), "i"((jb) + 3), "i"((jb) + 4), "i"((jb) + 5), "i"((jb) + 6), "i"((jb) + 7))
template <int I, int JB> __device__ __forceinline__ void gdn_subst_blk(f32x2s (&x)[64], float arow) {
    if constexpr (JB < I) { float ar[8]; GDN_RL8(ar, arow, JB);
#pragma unroll
        for (int t = 0; t < 8; ++t) if (JB + t < I) x[I] -= ar[t] * x[JB + t];
        gdn_subst_blk<I, JB + 8>(x, arow); }
}
template <int... Is> __device__ __forceinline__ void gdn_subst_all(f32x2s (&x)[64], const LAS float* A, int lane, std::integer_sequence<int, Is...>) {
    (gdn_subst_blk<Is + 1, 0>(x, A[(Is + 1) * 64 + lane]), ...);
}
__device__ __forceinline__ void p_gdn_chunk(Frame& F, int l) {
    const KArgs ap = kargs(); const auto& a = *ap; WS_OPAQUE(a);
    const int tid = otid(), wave = __builtin_amdgcn_readfirstlane(tid >> 6), grp = wave >> 1, gw = wave & 1;
    const bf16* QKVB = (const bf16*)(wsb + a.off[R_QKVB]); const float* BG = (const float*)(wsb + a.off[R_BG]); unsigned char* GD = wsb + a.off[R_GDN];
    LAS float* A_lds = (LAS float*)(F.lds + RING_OFF + grp * 34816);
    LAS float* Gs = A_lds + 4096; LAS float* Bs = Gs + 64; LAS float* Es = Bs + 64;
    LAS unsigned char* stg = (LAS unsigned char*)(A_lds + 4096 + 256);
    LAS bf16* stgh = (LAS bf16*)stg;
    static_assert(4 * 34816 <= RING_BYTES && GDN_NI % 4 == 0, "gdn chunk LDS / items");
    for (int pr = F.vcu; 4 * pr < GDN_NI; pr += F.G) {
        int lane_ = otid() & 63;
        const int lane = lane_, r32 = lane & 31, hi = lane >> 5, gt = gw * 64 + lane;
        const int item = 4 * pr + grp, h = gdn_item_head(item);
        unsigned char* ib = GD + (size_t)item * GI_STRIDE;
        const int rowt = gdn_item_row(item, lane);
        const float beta = rowt >= 0 ? BG[(size_t)rowt * 8 + h] : 0.f; float G = rowt >= 0 ? BG[(size_t)rowt * 8 + 4 + h] : 0.f;
        G = scan64(G);
        const float Glast = rdlane(G, 63), eG = __expf(G);
        if (gw == 0) { Gs[lane] = G; Bs[lane] = beta; Es[lane] = eG; if (lane == 0) *(float*)(ib + GI_SC) = __expf(Glast); }
        __syncthreads();
#pragma unroll
        for (int bq = 0; bq < 2; ++bq) {
          const int i0 = 32 * gw, j0 = 32 * bq; const int j = j0 + r32;
          if (gw == 0 && bq == 1) {
#pragma unroll
              for (int r = 0; r < 16; ++r) { const int i = crow_dev(r, hi); A_lds[i * 64 + j] = 0.f; stgh[frag_off(i, j, 2)] = (bf16)0; }
          } else {
          const int ra = gdn_item_row(item, i0 + r32), rb = gdn_item_row(item, j0 + r32);
          f32x16 akk, aqk;
#pragma unroll
          for (int r = 0; r < 16; ++r) { akk[r] = 0.f; aqk[r] = 0.f; }
          const bf16x8 zf = {0, 0, 0, 0, 0, 0, 0, 0};
#pragma unroll
          for (int s = 0; s < 8; ++s) {
              const bf16x8 qa = ra >= 0 ? *(const GAS bf16x8*)(QKVB + (size_t)ra * 1536 + h * 128 + 16 * s + 8 * hi) : zf;
              const bf16x8 ka = ra >= 0 ? *(const GAS bf16x8*)(QKVB + (size_t)ra * 1536 + 512 + h * 128 + 16 * s + 8 * hi) : zf;
              const bf16x8 kb = rb >= 0 ? *(const GAS bf16x8*)(QKVB + (size_t)rb * 1536 + 512 + h * 128 + 16 * s + 8 * hi) : zf;
              akk = __builtin_amdgcn_mfma_f32_32x32x16_bf16(ka, kb, akk, 0, 0, 0); aqk = __builtin_amdgcn_mfma_f32_32x32x16_bf16(qa, kb, aqk, 0, 0, 0);
          }
          const float Gj = Gs[j];
#pragma unroll
          for (int r = 0; r < 16; ++r) { const int i = i0 + crow_dev(r, hi); const float dec = i >= j ? __expf(Gs[i] - Gj) : 0.f;
              A_lds[i * 64 + j] = i > j ? Bs[i] * akk[r] * dec : 0.f;
              stgh[frag_off(i, j, 2)] = (bf16)f2bf(aqk[r] * dec); }
          }
        }
        __syncthreads();
        gdn_flush(stg, ib + GI_AT, 8192, gt);
        { f32x2s x[64]; const int cbase = gw == 0 ? 1024 + h * 128 : 512 + h * 128;
#pragma unroll
          for (int i = 0; i < 64; ++i) { const int ri = __builtin_amdgcn_readfirstlane(gdn_item_row(item, i));
              const bf16* rowp = QKVB + (size_t)(ri < 0 ? 0 : ri) * 1536 + cbase;
              x[i] = ri >= 0 ? (f32x2s){bf2f(rowp[lane]), bf2f(rowp[lane + 64])} : (f32x2s){0.f, 0.f}; }
          const float rsc = gw == 0 ? beta : beta * eG;
#pragma unroll
          for (int i = 0; i < 64; ++i) x[i] *= rdlane(rsc, i);
          gdn_subst_all(x, A_lds, lane, std::make_integer_sequence<int, 63>{});
          __syncthreads();
          if (gw == 0) { bf16* ub = (bf16*)(ib + GI_U) + lane; asm volatile("" : "+v"(ub));
#pragma unroll
              for (int i = 0; i < 64; ++i) { ub[i * 128] = (bf16)f2bf(x[i].x); ub[i * 128 + 64] = (bf16)f2bf(x[i].y); } }
          else { LAS bf16* wb0 = stgh + frag_off(0, lane, 4); LAS bf16* wb1 = stgh + frag_off(0, lane + 64, 4);
#pragma unroll
              for (int i = 0; i < 64; ++i) { wb0[(i >> 5) * 4096 + (i & 31) * 8] = (bf16)f2bf(x[i].x); wb1[(i >> 5) * 4096 + (i & 31) * 8] = (bf16)f2bf(x[i].y); } }
        }
        __syncthreads();
        gdn_flush(stg, ib + GI_W, 16384, gt);
        __syncthreads();
        const float kgs = __expf(Glast - G);
#pragma unroll
        for (int hf = 0; hf < 2; ++hf) { float qv[32];
#pragma unroll
          for (int it = 0; it < 32; ++it) { const int c = it + 32 * hf, rc = __builtin_amdgcn_readfirstlane(gdn_item_row(item, c)); const bf16* rowp = QKVB + (size_t)(rc < 0 ? 0 : rc) * 1536 + h * 128; qv[it] = rc >= 0 ? bf2f(rowp[gt]) : 0.f; }
#pragma unroll
          for (int it = 0; it < 32; ++it) { const int c = it + 32 * hf; stgh[frag_off(c, gt, 4)] = (bf16)f2bf(qv[it] * rdlane(eG, c)); } }
        __syncthreads();
        gdn_flush(stg, ib + GI_QG, 16384, gt);
        __syncthreads();
#pragma unroll
        for (int hf = 0; hf < 2; ++hf) { float kv[32];
#pragma unroll
          for (int it = 0; it < 32; ++it) { const int c = it + 32 * hf, rc = __builtin_amdgcn_readfirstlane(gdn_item_row(item, c)); const bf16* rowp = QKVB + (size_t)(rc < 0 ? 0 : rc) * 1536 + 512 + h * 128; kv[it] = rc >= 0 ? bf2f(rowp[gt]) : 0.f; }
#pragma unroll
          for (int it = 0; it < 32; ++it) { const int c = it + 32 * hf; stgh[frag_off(gt, c, 2)] = (bf16)f2bf(kv[it] * rdlane(kgs, c)); } }
        __syncthreads();
        gdn_flush(stg, ib + GI_KG, 16384, gt);
        __syncthreads();
    }
}

__device__ __forceinline__ void gdn_chain(const unsigned char* GD, bf16* OB, const float* sdelta, float* dout, int item0, int nch, int h, int vb, int lane) {
    const int r32 = lane & 31, hi = lane >> 5;
    f32x16 S[4];
#pragma unroll
    for (int kb = 0; kb < 4; ++kb)
#pragma unroll
        for (int r = 0; r < 16; ++r) S[kb][r] = sdelta ? sdelta[(size_t)(kb * 32 + crow_dev(r, hi)) * HEAD_DIM_B + vb * 32 + r32] : 0.f;
    for (int n = 0; n < nch; ++n) {
        const int item = item0 + n; const unsigned char* ib = GD + (size_t)item * GI_STRIDE;
        const float eGl = *(const float*)(ib + GI_SC);
        const GAS bf16x8* WF = (const GAS bf16x8*)(ib + GI_W) + lane; const GAS bf16x8* QF = (const GAS bf16x8*)(ib + GI_QG) + lane;
        const GAS bf16x8* KF = (const GAS bf16x8*)(ib + GI_KG) + lane; const GAS bf16x8* AF = (const GAS bf16x8*)(ib + GI_AT) + lane; const bf16* U = (const bf16*)(ib + GI_U);
        bf16x8 Sp[4][2];
#pragma unroll
        for (int kb = 0; kb < 4; ++kb)
#pragma unroll
            for (int s = 0; s < 2; ++s) { v4u w; w.x = pk2(S[kb][8 * s], S[kb][8 * s + 1]); w.y = pk2(S[kb][8 * s + 2], S[kb][8 * s + 3]); w.z = pk2(S[kb][8 * s + 4], S[kb][8 * s + 5]); w.w = pk2(S[kb][8 * s + 6], S[kb][8 * s + 7]); Sp[kb][s] = __builtin_bit_cast(bf16x8, w); }
        f32x16 vn[2], ot[2];
#pragma unroll
        for (int cb = 0; cb < 2; ++cb) {
            f32x16 ws;
#pragma unroll
            for (int r = 0; r < 16; ++r) { ws[r] = 0.f; ot[cb][r] = 0.f; }
#pragma unroll
            for (int kb = 0; kb < 4; ++kb)
#pragma unroll
                for (int s = 0; s < 2; ++s) { ws = __builtin_amdgcn_mfma_f32_32x32x16_bf16(WF[((cb * 4 + kb) * 2 + s) * 64], Sp[kb][s], ws, 0, 0, 0);
                    ot[cb] = __builtin_amdgcn_mfma_f32_32x32x16_bf16(QF[((cb * 4 + kb) * 2 + s) * 64], Sp[kb][s], ot[cb], 0, 0, 0); }
#pragma unroll
            for (int r = 0; r < 16; ++r) vn[cb][r] = bf2f(U[(cb * 32 + crow_dev(r, hi)) * 128 + vb * 32 + r32]) - ws[r];
        }
        bf16x8 Vp[2][2];
#pragma unroll
        for (int cb = 0; cb < 2; ++cb)
#pragma unroll
            for (int s = 0; s < 2; ++s) { v4u w; w.x = pk2(vn[cb][8 * s], vn[cb][8 * s + 1]); w.y = pk2(vn[cb][8 * s + 2], vn[cb][8 * s + 3]); w.z = pk2(vn[cb][8 * s + 4], vn[cb][8 * s + 5]); w.w = pk2(vn[cb][8 * s + 6], vn[cb][8 * s + 7]); Vp[cb][s] = __builtin_bit_cast(bf16x8, w); }
#pragma unroll
        for (int cb = 0; cb < 2; ++cb)
#pragma unroll
            for (int c2 = 0; c2 <= cb; ++c2)
#pragma unroll
                for (int s = 0; s < 2; ++s) ot[cb] = __builtin_amdgcn_mfma_f32_32x32x16_bf16(AF[((cb * 2 + c2) * 2 + s) * 64], Vp[c2][s], ot[cb], 0, 0, 0);
#pragma unroll
        for (int cb = 0; cb < 2; ++cb)
#pragma unroll
            for (int r = 0; r < 16; ++r) { const int row = gdn_item_row(item, cb * 32 + crow_dev(r, hi)); if (row >= 0) OB[(size_t)row * WIDTH_B + h * 128 + vb * 32 + r32] = (bf16)f2bf(ot[cb][r]); }
#pragma unroll
        for (int kb = 0; kb < 4; ++kb) {
#pragma unroll
            for (int r = 0; r < 16; ++r) S[kb][r] *= eGl;
#pragma unroll
            for (int cb = 0; cb < 2; ++cb)
#pragma unroll
                for (int s = 0; s < 2; ++s) S[kb] = __builtin_amdgcn_mfma_f32_32x32x16_bf16(KF[((kb * 2 + cb) * 2 + s) * 64], Vp[cb][s], S[kb], 0, 0, 0);
        }
    }
#pragma unroll
    for (int kb = 0; kb < 4; ++kb)
#pragma unroll
        for (int r = 0; r < 16; ++r) dout[(size_t)(kb * 32 + crow_dev(r, hi)) * HEAD_DIM_B + vb * 32 + r32] = S[kb][r];
}
constexpr int GCH_BUF = 73728, GCH_PCS = 18;
#define GCH_BAR() do { asm volatile("s_waitcnt lgkmcnt(0)" ::: "memory"); __builtin_amdgcn_s_barrier(); asm volatile("" ::: "memory"); } while (0)
__device__ __forceinline__ void gdn_chain_wg(Frame& F, const unsigned char* GD, bf16* OB, float* dout, int item0, int h) {
    const int tid = otid(), lane = tid & 63, wave = __builtin_amdgcn_readfirstlane(tid >> 6), r32 = lane & 31, hi = lane >> 5, vb = wave & 3;
    LAS unsigned char* lb = F.lds + RING_OFF;
    if (wave >= 4) {
        const int p0 = (wave - 4) * GCH_PCS;
        v4u R0[GCH_PCS], R1[GCH_PCS];
#define GCH_LOAD(R, c) do { const unsigned char* s_ = GD + (size_t)(item0 + (c)) * GI_STRIDE + (size_t)p0 * 1024 + lane * 16; _Pragma("unroll") for (int j = 0; j < GCH_PCS; ++j) \
            asm volatile("global_load_dwordx4 %0, %1, off" : "=&v"(R[j]) : "v"(s_ + j * 1024) : "memory"); } while (0)
#define GCH_PUT(R, c) do { if ((c) + 1 < GDN_NCH) asm volatile("s_waitcnt vmcnt(18)" ::: "memory"); else asm volatile("s_waitcnt vmcnt(0)" ::: "memory"); \
            LAS v4u* d_ = (LAS v4u*)(lb + ((c) & 1) * GCH_BUF + p0 * 1024) + lane; _Pragma("unroll") for (int j = 0; j < GCH_PCS; ++j) d_[j * 64] = R[j]; } while (0)
        GCH_LOAD(R0, 0); GCH_LOAD(R1, 1);
        GCH_PUT(R0, 0); GCH_LOAD(R0, 2);
        GCH_BAR();
        for (int n = 0; n < GDN_NCH; n += 2) {
            if (n + 1 < GDN_NCH) GCH_PUT(R1, n + 1);
            if (n + 3 < GDN_NCH) GCH_LOAD(R1, n + 3);
            GCH_BAR();
            if (n + 1 < GDN_NCH) {
                if (n + 2 < GDN_NCH) GCH_PUT(R0, n + 2);
                if (n + 4 < GDN_NCH) GCH_LOAD(R0, n + 4);
                GCH_BAR(); }
        }
        asm volatile("s_waitcnt vmcnt(0)" ::: "memory");
#undef GCH_LOAD
#undef GCH_PUT
        return;
    }
    f32x16 S[4];
#pragma unroll
    for (int kb = 0; kb < 4; ++kb)
#pragma unroll
        for (int r = 0; r < 16; ++r) S[kb][r] = 0.f;
    float eg0 = *(const float*)(GD + (size_t)item0 * GI_STRIDE + GI_SC), eg1 = *(const float*)(GD + (size_t)(item0 + 1) * GI_STRIDE + GI_SC);
    GCH_BAR();
    for (int n = 0; n < GDN_NCH; ++n) {
        const int item = item0 + n; const LAS unsigned char* bufc = lb + (n & 1) * GCH_BUF;
        const float egl = eg0; eg0 = eg1; if (n + 2 < GDN_NCH) eg1 = *(const float*)(GD + (size_t)(item + 2) * GI_STRIDE + GI_SC);
        const LAS bf16x8* WF = (const LAS bf16x8*)(bufc + GI_W) + lane; const LAS bf16x8* QF = (const LAS bf16x8*)(bufc + GI_QG) + lane;
        const LAS bf16x8* KF = (const LAS bf16x8*)(bufc + GI_KG) + lane; const LAS bf16x8* AF = (const LAS bf16x8*)(bufc + GI_AT) + lane; const LAS bf16* U = (const LAS bf16*)(bufc + GI_U);
        bf16x8 Sp[4][2];
#pragma unroll
        for (int kb = 0; kb < 4; ++kb)
#pragma unroll
            for (int s = 0; s < 2; ++s) { v4u w; w.x = pk2(S[kb][8 * s], S[kb][8 * s + 1]); w.y = pk2(S[kb][8 * s + 2], S[kb][8 * s + 3]); w.z = pk2(S[kb][8 * s + 4], S[kb][8 * s + 5]); w.w = pk2(S[kb][8 * s + 6], S[kb][8 * s + 7]); Sp[kb][s] = __builtin_bit_cast(bf16x8, w); }
        f32x16 vn[2], ot[2];
#pragma unroll
        for (int cb = 0; cb < 2; ++cb) {
            f32x16 ws;
#pragma unroll
            for (int r = 0; r < 16; ++r) { ws[r] = 0.f; ot[cb][r] = 0.f; }
#pragma unroll
            for (int kb = 0; kb < 4; ++kb)
#pragma unroll
                for (int s = 0; s < 2; ++s) { ws = __builtin_amdgcn_mfma_f32_32x32x16_bf16(WF[((cb * 4 + kb) * 2 + s) * 64], Sp[kb][s], ws, 0, 0, 0);
                    ot[cb] = __builtin_amdgcn_mfma_f32_32x32x16_bf16(QF[((cb * 4 + kb) * 2 + s) * 64], Sp[kb][s], ot[cb], 0, 0, 0); }
#pragma unroll
            for (int r = 0; r < 16; ++r) vn[cb][r] = bf2f(U[(cb * 32 + crow_dev(r, hi)) * 128 + vb * 32 + r32]) - ws[r];
        }
        bf16x8 Vp[2][2];
#pragma unroll
        for (int cb = 0; cb < 2; ++cb)
#pragma unroll
            for (int s = 0; s < 2; ++s) { v4u w; w.x = pk2(vn[cb][8 * s], vn[cb][8 * s + 1]); w.y = pk2(vn[cb][8 * s + 2], vn[cb][8 * s + 3]); w.z = pk2(vn[cb][8 * s + 4], vn[cb][8 * s + 5]); w.w = pk2(vn[cb][8 * s + 6], vn[cb][8 * s + 7]); Vp[cb][s] = __builtin_bit_cast(bf16x8, w); }
#pragma unroll
        for (int cb = 0; cb < 2; ++cb)
#pragma unroll
            for (int c2 = 0; c2 <= cb; ++c2)
#pragma unroll
                for (int s = 0; s < 2; ++s) ot[cb] = __builtin_amdgcn_mfma_f32_32x32x16_bf16(AF[((cb * 2 + c2) * 2 + s) * 64], Vp[c2][s], ot[cb], 0, 0, 0);
        { const int row0 = gdn_item_row(item, 0);
#pragma unroll
          for (int cb = 0; cb < 2; ++cb)
#pragma unroll
              for (int r = 0; r < 16; ++r) OB[(size_t)(row0 + cb * 32 + crow_dev(r, hi)) * WIDTH_B + h * 128 + vb * 32 + r32] = (bf16)f2bf(ot[cb][r]); }
#pragma unroll
        for (int kb = 0; kb < 4; ++kb) {
#pragma unroll
            for (int r = 0; r < 16; ++r) S[kb][r] *= egl;
#pragma unroll
            for (int cb = 0; cb < 2; ++cb)
#pragma unroll
                for (int s = 0; s < 2; ++s) S[kb] = __builtin_amdgcn_mfma_f32_32x32x16_bf16(KF[((kb * 2 + cb) * 2 + s) * 64], Vp[cb][s], S[kb], 0, 0, 0);
        }
        GCH_BAR();
    }
#pragma unroll
    for (int kb = 0; kb < 4; ++kb)
#pragma unroll
        for (int r = 0; r < 16; ++r) dout[(size_t)(kb * 32 + crow_dev(r, hi)) * HEAD_DIM_B + vb * 32 + r32] = S[kb][r];
}
__device__ __forceinline__ void p_gdn_chain(Frame& F, int l) {
    const KArgs ap = kargs(); const auto& a = *ap; WS_OPAQUE(a);
    const unsigned char* GD = wsb + a.off[R_GDN]; bf16* OB = (bf16*)(wsb + a.off[R_OB]);
    if (F.vcu % 32 == 0 && F.vcu / 32 < BATCH * N_HEADS_B) { const int sh = F.vcu / 32, sq = sh / N_HEADS_B, h = sh % N_HEADS_B;
        gdn_chain_wg(F, GD, OB, a.out + O_DP + (((size_t)l * BATCH + sq) * N_HEADS_B + h) * HEAD_DIM_B * HEAD_DIM_B, sh * GDN_NCH, h); }
    else { const int tid = otid(), lane = tid & 63, wave = __builtin_amdgcn_readfirstlane(tid >> 6);
        const int t = (F.vcu - F.vcu / 32 - 1) * NWAVES + wave;
        if (t < GDN_NSI * 4) { const int s = t >> 2, vb = t & 3, bs = s >> 2, h = s & 3; const size_t so = (((size_t)l * DEC_BATCH + bs) * N_HEADS_B + h) * HEAD_DIM_B * HEAD_DIM_B;
            gdn_chain(GD, OB, a.in[I_SDELTA] + so, a.out + O_DS + so, GDN_NPI + s, 1, h, vb, lane); } }
}
__device__ __forceinline__ void p_mixpost_b(Frame& F, int l) {
    const KArgs ap = kargs(); const auto& a = *ap; WS_OPAQUE(a);
    const int tid = otid(), lane = tid & 63, wave = __builtin_amdgcn_readfirstlane(tid >> 6);
    const bf16* OB = (const bf16*)(wsb + a.off[R_OB]); bf16* OBN = (bf16*)(wsb + a.off[R_OBN]); const bf16* Z = (const bf16*)(wsb + a.off[R_Z]);
    const int gw = F.vcu * NWAVES + wave, NGW = F.G * NWAVES, e0 = 8 * (lane & 15);
    float gn[8];
#pragma unroll
    for (int j = 0; j < 8; ++j) gn[j] = a.in[I_GDNN][l * HEAD_DIM_B + e0 + j];
    for (int m = gw; m < RP; m += NGW) {
        float o[8], gt[8];
        unpack8(*(const GAS v4u*)(OB + (size_t)m * WIDTH_B + 8 * lane), o); unpack8(*(const GAS v4u*)(Z + (size_t)m * ZN + ZC_GB + 8 * lane), gt);
        float ss = 0.f;
#pragma unroll
        for (int j = 0; j < 8; ++j) ss += o[j] * o[j];
        ss = sum16(ss);
        const float r = __builtin_amdgcn_rsqf(ss * (1.f / 128.f) + EPSF);
#pragma unroll
        for (int j = 0; j < 8; ++j) o[j] = o[j] * r * gn[j] * gt[j] * sigm(gt[j]);
        *(GAS v4u*)(OBN + (size_t)m * WIDTH_B + 8 * lane) = pack8(o);
    }
}
constexpr int S5_M1 = 0, S5_M2 = 131072, S5_M3 = 196608, S5_L16 = 262144, S5_TSTRIDE = 262656;
constexpr int S5_NCHK = RP / 16;
constexpr int S5_NBLK = S5_NCHK / 32;
constexpr int S5_PCH = PEND / 16;
static_assert(S5_NCHK % 32 == 0 && LPP % 16 == 0 && PADF % 16 == 0 && S5_STATE == 64 && S5_GROUPS == 32, "s5 shapes");

__device__ __forceinline__ void s5_tables(Frame& F) {
    const KArgs ap = kargs(); const auto& a = *ap; WS_OPAQUE(a);
    const int tid = otid();
    LAS float* pw = (LAS float*)(F.lds + RING_OFF);
    LAS float* bb = pw + 17 * 128;
    LAS float* Kt = bb + 64 * 32;
    for (int it = F.vcu; it < DEPTH * S5_GROUPS; it += F.G) {
        const int l = it / S5_GROUPS, g = it % S5_GROUPS; const size_t gp = ((size_t)l * S5_GROUPS + g) * S5_STATE;
        unsigned char* tb = wsb + a.off[R_S5T] + (size_t)it * S5_TSTRIDE;
        const float dt = __expf(a.in[I_LDT][l * S5_GROUPS + g]);
        for (int e = tid; e < 17 * 64; e += NTHR) { const int k = e >> 6, p = e & 63; const float ar = a.in[I_AR][gp + p] * dt * (float)k, ai = a.in[I_AI][gp + p] * dt * (float)k;
            float sn, cs; sincosf(ai, &sn, &cs); const float er = expf(ar); pw[e * 2] = er * cs; pw[e * 2 + 1] = er * sn; }
        __syncthreads();
        for (int e = tid; e < 64 * 16; e += NTHR) { const int p = e >> 4; const float ar = a.in[I_AR][gp + p], ai = a.in[I_AI][gp + p];
            const float nr = pw[(64 + p) * 2] - 1.f, ni = pw[(64 + p) * 2 + 1], den = ar * ar + ai * ai, fr = (nr * ar + ni * ai) / den, fi = (ni * ar - nr * ai) / den;
            const float br = a.in[I_BR][gp * 16 + e], bi = a.in[I_BI][gp * 16 + e]; bb[e * 2] = fr * br - fi * bi; bb[e * 2 + 1] = fr * bi + fi * br; }
        if (tid < 128) { const int p = tid & 63; ((float*)(tb + S5_L16))[tid] = pw[(16 * 64 + p) * 2 + (tid >> 6)]; }
        __syncthreads();
        const float* cre = a.in[I_CR] + ((size_t)l * S5_GROUPS + g) * 16 * 64; const float* cim = a.in[I_CI] + ((size_t)l * S5_GROUPS + g) * 16 * 64;
        for (int e = tid; e < 4096; e += NTHR) { const int d = e >> 8, i = (e >> 4) & 15, j = e & 15; float acc = 0.f;
            for (int p = 0; p < 64; ++p) { const float cr = cre[i * 64 + p], ci = cim[i * 64 + p], pr = pw[(d * 64 + p) * 2], pi = pw[(d * 64 + p) * 2 + 1];
                const float tr = cr * pr - ci * pi, ti = cr * pi + ci * pr; acc += tr * bb[(p * 16 + j) * 2] - ti * bb[(p * 16 + j) * 2 + 1]; }
            Kt[e] = acc; }
        __syncthreads();
        bf16* M1 = (bf16*)(tb + S5_M1); bf16* M2 = (bf16*)(tb + S5_M2); bf16* M3 = (bf16*)(tb + S5_M3);
        for (int e = tid; e < 65536; e += NTHR) { const int n = e >> 8, k = e & 255, tau = n >> 4, i = n & 15, sg = k >> 4, j = k & 15;
            float v = 0.f; if (sg <= tau) { v = Kt[((tau - sg) * 16 + i) * 16 + j]; if (sg == tau && i == j) v += a.in[I_SD][(l * S5_GROUPS + g) * 16 + i]; }
            M1[e] = (bf16)f2bf(v); }
        for (int e = tid; e < 32768; e += NTHR) { const int n = e >> 8, k = e & 255, ri = n >> 6, p = n & 63, sg = k >> 4, j = k & 15;
            const float pr = pw[((15 - sg) * 64 + p) * 2], pi = pw[((15 - sg) * 64 + p) * 2 + 1], br = bb[(p * 16 + j) * 2], bi = bb[(p * 16 + j) * 2 + 1];
            M2[e] = (bf16)f2bf(ri == 0 ? pr * br - pi * bi : pr * bi + pi * br); }
        for (int e = tid; e < 32768; e += NTHR) { const int n = e >> 7, k = e & 127, tau = n >> 4, i = n & 15, ri = k >> 6, p = k & 63;
            const float cr = cre[i * 64 + p], ci = cim[i * 64 + p], pr = pw[((tau + 1) * 64 + p) * 2], pi = pw[((tau + 1) * 64 + p) * 2 + 1];
            M3[e] = (bf16)f2bf(ri == 0 ? cr * pr - ci * pi : -(cr * pi + ci * pr)); }
        __syncthreads();
    }
}
__device__ __forceinline__ void p_s5_e(Frame& F, int l) {
    const KArgs ap = kargs(); const auto& a = *ap; WS_OPAQUE(a);
    const int tid = otid(), lane = tid & 63, wave = __builtin_amdgcn_readfirstlane(tid >> 6), r32 = lane & 31, hi = lane >> 5;
    const bf16* Z = (const bf16*)(wsb + a.off[R_Z]); float* E = (float*)(wsb + a.off[R_S5E]);
    for (int u = F.vcu * NWAVES + wave; u < S5_NBLK * S5_GROUPS; u += F.G * NWAVES) {
        const int blk = u / S5_GROUPS, g = u % S5_GROUPS;
        const unsigned char* tb = wsb + a.off[R_S5T] + (size_t)(l * S5_GROUPS + g) * S5_TSTRIDE;
        const GAS bf16x8* M2 = (const GAS bf16x8*)(tb + S5_M2);
        const bf16* zr = Z + (size_t)((blk * 32 + r32) * 16) * ZN + ZC_UC + g * 16 + 8 * hi;
        f32x16 acc[4];
#pragma unroll
        for (int nb = 0; nb < 4; ++nb)
#pragma unroll
            for (int r = 0; r < 16; ++r) acc[nb][r] = 0.f;
#pragma unroll 4
        for (int sg = 0; sg < 16; ++sg) { const bf16x8 af = *(const GAS bf16x8*)(zr + (size_t)sg * ZN);
#pragma unroll
            for (int nb = 0; nb < 4; ++nb) acc[nb] = __builtin_amdgcn_mfma_f32_32x32x16_bf16(af, M2[((nb * 32 + r32) * 256 + sg * 16 + 8 * hi) >> 3], acc[nb], 0, 0, 0); }
#pragma unroll
        for (int nb = 0; nb < 4; ++nb)
#pragma unroll
            for (int r = 0; r < 16; ++r) E[((size_t)(blk * 32 + crow_dev(r, hi)) * S5_GROUPS + g) * 128 + nb * 32 + r32] = acc[nb][r];
    }
}
__device__ __forceinline__ void s5_scan_task(const float* E, bf16* XP, const float* l16, int g, int c0, int nch, float xr, float xi, float* ore, float* oim, int lane) {
    const float lr = l16[lane], li = l16[64 + lane];
    int c = 0;
    for (; c + 8 <= nch; c += 8) { float er[8], ei[8];
#pragma unroll
        for (int q = 0; q < 8; ++q) { const float* e = E + ((size_t)(c0 + c + q) * S5_GROUPS + g) * 128; er[q] = e[lane]; ei[q] = e[64 + lane]; }
#pragma unroll
        for (int q = 0; q < 8; ++q) { bf16* xp = XP + ((size_t)(c0 + c + q) * S5_GROUPS + g) * 128; xp[lane] = (bf16)f2bf(xr); xp[64 + lane] = (bf16)f2bf(xi);
            const float nr = lr * xr - li * xi + er[q], ni = lr * xi + li * xr + ei[q]; xr = nr; xi = ni; } }
    for (; c < nch; ++c) { const float* e = E + ((size_t)(c0 + c) * S5_GROUPS + g) * 128; bf16* xp = XP + ((size_t)(c0 + c) * S5_GROUPS + g) * 128; xp[lane] = (bf16)f2bf(xr); xp[64 + lane] = (bf16)f2bf(xi);
        const float nr = lr * xr - li * xi + e[lane], ni = lr * xi + li * xr + e[64 + lane]; xr = nr; xi = ni; }
    ore[lane] = xr; oim[lane] = xi;
}
constexpr int S5_NTASK = (BATCH + DEC_BATCH) * S5_GROUPS;
__device__ __forceinline__ void s5_scan_run(Frame& F, int l, int t, int lane) {
    const KArgs ap = kargs(); const auto& a = *ap; WS_OPAQUE(a);
    const int sq = t / S5_GROUPS, g = t % S5_GROUPS;
    const float* E = (const float*)(wsb + a.off[R_S5E]); bf16* XP = (bf16*)(wsb + a.off[R_S5X]);
    const float* l16 = (const float*)(wsb + a.off[R_S5T] + (size_t)(l * S5_GROUPS + g) * S5_TSTRIDE + S5_L16);
    if (sq < BATCH) { const size_t oo = (((size_t)l * BATCH + sq) * S5_GROUPS + g) * S5_STATE;
        s5_scan_task(E, XP, l16, g, sq * (LPP / 16), S5_PCH, 0.f, 0.f, a.out + O_SRP + oo, a.out + O_SIP + oo, lane); }
    else { const int bs = sq - BATCH; const size_t oo = (((size_t)l * DEC_BATCH + bs) * S5_GROUPS + g) * S5_STATE;
        s5_scan_task(E, XP, l16, g, SROW0 / 16 + bs * (DEC_SEQ / 16), DEC_SEQ / 16, a.in[I_SRE][oo + lane], a.in[I_SIM][oo + lane], a.out + O_SRS + oo, a.out + O_SIS + oo, lane); }
}
__device__ __forceinline__ float gelu_tanh(float x) { const float z = 0.7978845608028654f * (x + 0.044715f * x * x * x); const float t = 1.f - 2.f * __builtin_amdgcn_rcpf(__expf(2.f * z) + 1.f); return 0.5f * x * (1.f + t); }
__device__ __forceinline__ void p_s5_out(Frame& F, int l) {
    const KArgs ap = kargs(); const auto& a = *ap; WS_OPAQUE(a);
    const int tid = otid(), lane = tid & 63, wave = __builtin_amdgcn_readfirstlane(tid >> 6), r32 = lane & 31, hi = lane >> 5;
    const bf16* Z = (const bf16*)(wsb + a.off[R_Z]); const bf16* XP = (const bf16*)(wsb + a.off[R_S5X]); bf16* YC = (bf16*)(wsb + a.off[R_YC]);
    for (int u = F.vcu * NWAVES + wave; u < S5_NBLK * S5_GROUPS; u += F.G * NWAVES) {
        const int blk = u / S5_GROUPS, g = u % S5_GROUPS;
        const unsigned char* tb = wsb + a.off[R_S5T] + (size_t)(l * S5_GROUPS + g) * S5_TSTRIDE;
        const GAS bf16x8* M1 = (const GAS bf16x8*)(tb + S5_M1); const GAS bf16x8* M3 = (const GAS bf16x8*)(tb + S5_M3);
        const bf16* zr = Z + (size_t)((blk * 32 + r32) * 16) * ZN + ZC_UC + g * 16 + 8 * hi;
        const bf16* xr = XP + ((size_t)(blk * 32 + r32) * S5_GROUPS + g) * 128 + 8 * hi;
        f32x16 acc[8];
#pragma unroll
        for (int nb = 0; nb < 8; ++nb)
#pragma unroll
            for (int r = 0; r < 16; ++r) acc[nb][r] = 0.f;
#pragma unroll 2
        for (int sg = 0; sg < 16; ++sg) { const bf16x8 af = *(const GAS bf16x8*)(zr + (size_t)sg * ZN);
#pragma unroll
            for (int nb = 0; nb < 8; ++nb) acc[nb] = __builtin_amdgcn_mfma_f32_32x32x16_bf16(af, M1[((nb * 32 + r32) * 256 + sg * 16 + 8 * hi) >> 3], acc[nb], 0, 0, 0); }
#pragma unroll 2
        for (int s = 0; s < 8; ++s) { const bf16x8 af = *(const GAS bf16x8*)(xr + 16 * s);
#pragma unroll
            for (int nb = 0; nb < 8; ++nb) acc[nb] = __builtin_amdgcn_mfma_f32_32x32x16_bf16(af, M3[((nb * 32 + r32) * 128 + s * 16 + 8 * hi) >> 3], acc[nb], 0, 0, 0); }
#pragma unroll
        for (int nb = 0; nb < 8; ++nb)
#pragma unroll
            for (int r = 0; r < 16; ++r) { const int row = (blk * 32 + crow_dev(r, hi)) * 16 + 2 * nb + (r32 >> 4);
                YC[(size_t)row * WIDTH_C + g * 16 + (r32 & 15)] = (bf16)f2bf(gelu_tanh(acc[nb][r])); }
    }
}
__device__ __forceinline__ int rdlane_i(int v, int i) { return __builtin_amdgcn_readlane(v, i); }
constexpr float NEG_BIG = -3.0e38f;
__device__ __forceinline__ unsigned fkey(float v) { const unsigned u = __builtin_bit_cast(unsigned, v); return (u & 0x80000000u) ? ~u : (u | 0x80000000u); }
__device__ __forceinline__ int mbcnt64(unsigned long long m) { return __builtin_amdgcn_mbcnt_hi((unsigned)(m >> 32), __builtin_amdgcn_mbcnt_lo((unsigned)m, 0)); }
__device__ __forceinline__ void pro_wqs(Frame& F) {
    const KArgs ap = kargs(); const auto& a = *ap; WS_OPAQUE(a);
    const int tid = otid(), lane = tid & 63, wave = __builtin_amdgcn_readfirstlane(tid >> 6);
    bf16* WQ = (bf16*)(wsb + a.off[R_WQS]);
    for (int t = F.vcu * NWAVES + wave; t < DEPTH * 16 * 16; t += F.G * NWAVES) {
        const int l = t >> 8, hc = (t >> 4) & 15, kb = t & 15, k = kb * 64 + lane;
        const float* wr = a.in[I_PWQ] + ((size_t)l * D_MODEL + k) * PQ + hc * 128;
        float w[128];
#pragma unroll
        for (int d = 0; d < 128; d += 4) { const f32x4 v = *(const GAS f32x4*)(wr + d); w[d] = v.x; w[d + 1] = v.y; w[d + 2] = v.z; w[d + 3] = v.w; }
        const float* sk = a.in[I_PSK] + ((size_t)l * 16 + hc) * 128 * 128;
        bf16* o = WQ + ((size_t)l * PQ + hc * 128) * D_MODEL + k;
#pragma clang loop vectorize(disable) unroll(disable)
        for (int n = 0; n < 128; ++n) { const float* sr = sk + n * 128; float acc = 0.f;
#pragma unroll
            for (int d = 0; d < 128; ++d) acc += w[d] * sr[d];
            o[(size_t)n * D_MODEL] = (bf16)f2bf(acc); }
    }
}
__device__ __forceinline__ void pro_wrest(Frame& F) {
    const KArgs ap = kargs(); const auto& a = *ap; WS_OPAQUE(a);
    const int tid = otid(), lane = tid & 63, wave = __builtin_amdgcn_readfirstlane(tid >> 6);
    LAS float* scr = (LAS float*)(F.lds + RING_OFF + wave * 16384);
    const int gw = F.vcu * NWAVES + wave, NGW = F.G * NWAVES;
    bf16* WG = (bf16*)(wsb + a.off[R_WGLU]); bf16* WB = (bf16*)(wsb + a.off[R_WBR]); bf16* WO = (bf16*)(wsb + a.off[R_WOUT]);
    constexpr int IG = (512 / 64) * (1024 / 32), IB = IG, IO = (1024 / 64) * (1024 / 32), IL = IG + 3 * IB + IO;
    for (int it = gw; it < DEPTH * IL; it += NGW) { const int l = it / IL; int r = it % IL;
        if (r < IG) { transpose_item(a.in[I_WGLU] + (size_t)l * 512 * 1024, 1024, 512, WG + (size_t)l * 1024 * 512, 32 * (r % 32), 64 * (r / 32), CmGlu(), scr, lane); continue; } r -= IG;
        if (r < 3 * IB) { const int w = r / IB, q = r % IB; transpose_item(a.in[I_WBA + w] + (size_t)l * 512 * 1024, 1024, 512, WB + ((size_t)l * 3 + w) * 1024 * 512, 32 * (q % 32), 64 * (q / 32), CmId(), scr, lane); continue; } r -= 3 * IB;
        transpose_item(a.in[I_WOUT] + (size_t)l * 1024 * 1024, 1024, 1024, WO + (size_t)l * 1024 * 1024, 32 * (r % 32), 64 * (r / 32), CmId(), scr, lane); }
}
typedef float f32x2v __attribute__((ext_vector_type(2)));
__device__ __forceinline__ unsigned pk_i8(const f32x4 x, float inv) {
    const int a = (int)rintf(x.x * inv), b = (int)rintf(x.y * inv), c = (int)rintf(x.z * inv), d = (int)rintf(x.w * inv);
    return (unsigned)(a & 0xff) | ((unsigned)(b & 0xff) << 8) | ((unsigned)(c & 0xff) << 16) | ((unsigned)(d & 0xff) << 24); }
constexpr size_t PEER_ROWS = (size_t)DEPTH * N_EXPERTS;
__device__ __forceinline__ void pro_peerw(Frame& F) {
    const KArgs ap = kargs(); const auto& a = *ap; WS_OPAQUE(a);
    const int tid = otid(), lane = tid & 63, wave = __builtin_amdgcn_readfirstlane(tid >> 6);
    float* SCL = (float*)(wsb + a.off[R_MISC]);
    for (size_t rw = (size_t)F.vcu * NWAVES + wave; rw < 2 * PEER_ROWS; rw += (size_t)F.G * NWAVES) {
        const int w = rw >= PEER_ROWS; const size_t row = rw - (w ? PEER_ROWS : 0);
        const GAS f32x4* src = (const GAS f32x4*)(a.in[I_PU + w] + row * D_MODEL) + 4 * lane;
        const f32x4 x0 = src[0], x1 = src[1], x2 = src[2], x3 = src[3];
        float mx = fmaxf(fmaxf(fmaxf(fabsf(x0.x), fabsf(x0.y)), fmaxf(fabsf(x0.z), fabsf(x0.w))), fmaxf(fmaxf(fabsf(x1.x), fabsf(x1.y)), fmaxf(fabsf(x1.z), fabsf(x1.w))));
        mx = fmaxf(mx, fmaxf(fmaxf(fmaxf(fabsf(x2.x), fabsf(x2.y)), fmaxf(fabsf(x2.z), fabsf(x2.w))), fmaxf(fmaxf(fabsf(x3.x), fabsf(x3.y)), fmaxf(fabsf(x3.z), fabsf(x3.w)))));
        mx = wave_max(mx);
        if (w == 0) {
            const float inv = mx > 0.f ? 127.f / mx : 0.f;
            v4u o; o.x = pk_i8(x0, inv); o.y = pk_i8(x1, inv); o.z = pk_i8(x2, inv); o.w = pk_i8(x3, inv);
            *((GAS v4u*)(wsb + a.off[R_PU] + row * D_MODEL) + lane) = o;
            if (lane == 0) SCL[rw] = mx * (1.f / 127.f);
            continue; }
        const float inv = mx > 0.f ? 416.f / mx : 0.f;
        v4u o; int t;
        t = __builtin_amdgcn_cvt_pk_fp8_f32(x0.x * inv, x0.y * inv, 0, false); t = __builtin_amdgcn_cvt_pk_fp8_f32(x0.z * inv, x0.w * inv, t, true); o.x = (unsigned)t;
        t = __builtin_amdgcn_cvt_pk_fp8_f32(x1.x * inv, x1.y * inv, 0, false); t = __builtin_amdgcn_cvt_pk_fp8_f32(x1.z * inv, x1.w * inv, t, true); o.y = (unsigned)t;
        t = __builtin_amdgcn_cvt_pk_fp8_f32(x2.x * inv, x2.y * inv, 0, false); t = __builtin_amdgcn_cvt_pk_fp8_f32(x2.z * inv, x2.w * inv, t, true); o.z = (unsigned)t;
        t = __builtin_amdgcn_cvt_pk_fp8_f32(x3.x * inv, x3.y * inv, 0, false); t = __builtin_amdgcn_cvt_pk_fp8_f32(x3.z * inv, x3.w * inv, t, true); o.w = (unsigned)t;
        *((GAS v4u*)(wsb + a.off[R_PU + w] + row * D_MODEL) + lane) = o;
        if (lane == 0) SCL[rw] = mx * (1.f / 416.f);
    }
}
__device__ __forceinline__ void fp8x16_to_f32(const v4u q, float (&f)[16]) {
#pragma unroll
    for (int d = 0; d < 4; ++d) { const int w = (int)(d == 0 ? q.x : d == 1 ? q.y : d == 2 ? q.z : q.w);
        const f32x2v lo = __builtin_amdgcn_cvt_pk_f32_fp8(w, false), hi = __builtin_amdgcn_cvt_pk_f32_fp8(w, true); f[4 * d] = lo.x; f[4 * d + 1] = lo.y; f[4 * d + 2] = hi.x; f[4 * d + 3] = hi.y; }
}
__device__ __forceinline__ void p_peer(Frame& F, int l, bool dry) {
    const KArgs ap = kargs(); const auto& a = *ap; WS_OPAQUE(a);
    const int tid = otid(), lane = tid & 63, wave = __builtin_amdgcn_readfirstlane(tid >> 6);
    const float* SC = (const float*)(wsb + a.off[R_SC]); const bf16* XN = (const bf16*)(wsb + a.off[R_XN]); float* X = (float*)(wsb + a.off[R_X]);
    const unsigned char* PU = wsb + a.off[R_PU] + (size_t)l * N_EXPERTS * D_MODEL; const unsigned char* PV = wsb + a.off[R_PV] + (size_t)l * N_EXPERTS * D_MODEL;
    const float* SCU = (const float*)(wsb + a.off[R_MISC]) + (size_t)l * N_EXPERTS; const float* SCV = SCU + PEER_ROWS;
    LAS float* stop = (LAS float*)(F.lds + RING_OFF + wave * 4096);
    LAS int* itop = (LAS int*)(stop + 256);
    LAS int* elist = itop + 256;
    LAS float* cf = (LAS float*)(elist + 128);
    for (int m = F.vcu * NWAVES + wave; m < RP; m += F.G * NWAVES) {
        if (!prow_valid(m)) continue;
        const float* sr = SC + (size_t)m * PQ;
#ifndef MK_REP
#define MK_REP -1
#endif
        for (int rp12 = 0; rp12 < ((MK_REP) == 105 ? 2 : 1); ++rp12) {
        float sv[32];
#pragma unroll
        for (int i = 0; i < 32; ++i) sv[i] = sr[i * 64 + lane];
#pragma unroll
        for (int hc = 0; hc < 16; hc += 2) {
            const float va0 = sv[2 * hc], va1 = sv[2 * hc + 1], vb0 = sv[2 * hc + 2], vb1 = sv[2 * hc + 3];
            const unsigned ka0 = fkey(va0), ka1 = fkey(va1), kb0 = fkey(vb0), kb1 = fkey(vb1);
            unsigned pa = 0u, pb = 0u; bool da = false, db = false;
            for (int bit = 31; bit >= 0 && !(da && db); --bit) { const unsigned ta = pa | (1u << bit), tb = pb | (1u << bit);
                const int ca = __builtin_popcountll(__ballot(ka0 >= ta)) + __builtin_popcountll(__ballot(ka1 >= ta)), cb = __builtin_popcountll(__ballot(kb0 >= tb)) + __builtin_popcountll(__ballot(kb1 >= tb));
                if (!da) { pa = ca >= 16 ? ta : pa; da = ca == 16; } if (!db) { pb = cb >= 16 ? tb : pb; db = cb == 16; } }
            { const unsigned long long m0 = __ballot(ka0 >= pa), m1 = __ballot(ka1 >= pa); const int r0 = mbcnt64(m0), r1 = __builtin_popcountll(m0) + mbcnt64(m1);
              if (ka0 >= pa && r0 < 16) { stop[hc * 16 + r0] = va0; itop[hc * 16 + r0] = lane; }
              if (ka1 >= pa && r1 < 16) { stop[hc * 16 + r1] = va1; itop[hc * 16 + r1] = lane + 64; } }
            { const unsigned long long m0 = __ballot(kb0 >= pb), m1 = __ballot(kb1 >= pb); const int r0 = mbcnt64(m0), r1 = __builtin_popcountll(m0) + mbcnt64(m1);
              if (kb0 >= pb && r0 < 16) { stop[(hc + 1) * 16 + r0] = vb0; itop[(hc + 1) * 16 + r0] = lane; }
              if (kb1 >= pb && r1 < 16) { stop[(hc + 1) * 16 + r1] = vb1; itop[(hc + 1) * 16 + r1] = lane + 64; } }
        }
        LDS_WAIT();
        for (int h = 0; h < 8; ++h) {
            const float s1 = stop[(2 * h) * 16 + (lane >> 2)];
            float c[4]; unsigned kc[4];
#pragma unroll
            for (int j = 0; j < 4; ++j) { c[j] = s1 + stop[(2 * h + 1) * 16 + (lane & 3) * 4 + j]; kc[j] = fkey(c[j]); }
            unsigned pp = 0u;
            for (int bit = 31; bit >= 0; --bit) { const unsigned tt = pp | (1u << bit);
                const int cn = __builtin_popcountll(__ballot(kc[0] >= tt)) + __builtin_popcountll(__ballot(kc[1] >= tt)) + __builtin_popcountll(__ballot(kc[2] >= tt)) + __builtin_popcountll(__ballot(kc[3] >= tt));
                pp = cn >= 16 ? tt : pp; if (cn == 16) break; }
            const float cmax = wave_max(fmaxf(fmaxf(c[0], c[1]), fmaxf(c[2], c[3])));
            float esum = 0.f; int base = 0;
#pragma unroll
            for (int j = 0; j < 4; ++j) { const bool sel = kc[j] >= pp; const unsigned long long mk = __ballot(sel); const int rk = base + mbcnt64(mk); base += __builtin_popcountll(mk);
                const float ex = (sel && rk < 16) ? __expf(c[j] - cmax) : 0.f; esum += ex;
                if (sel && rk < 16) { const int ci = lane * 4 + j; elist[h * 16 + rk] = itop[(2 * h) * 16 + (ci >> 4)] * N_KEYS + itop[(2 * h + 1) * 16 + (ci & 15)]; cf[h * 16 + rk] = ex; } }
            esum = wave_sum(esum); const float inv = __builtin_amdgcn_rcpf(esum);
            LDS_WAIT();
            if (lane < 16) cf[h * 16 + lane] *= inv;
        }
        LDS_WAIT();
        }
        for (int rp3 = 0; rp3 < ((MK_REP) == 106 ? 2 : 1); ++rp3) {
        float hx[16], out[16];
        { float t[8]; unpack8(*(const GAS v4u*)(XN + (size_t)m * D_MODEL + 16 * lane), t);
#pragma unroll
          for (int j = 0; j < 8; ++j) hx[j] = t[j];
          unpack8(*(const GAS v4u*)(XN + (size_t)m * D_MODEL + 16 * lane + 8), t);
#pragma unroll
          for (int j = 0; j < 8; ++j) hx[8 + j] = t[j]; }
#pragma unroll
        for (int j = 0; j < 16; ++j) out[j] = 0.f;
        float hmx = 0.f;
#pragma unroll
        for (int j = 0; j < 16; ++j) hmx = fmaxf(hmx, fabsf(hx[j]));
        hmx = wave_max(hmx); const float hinv = hmx > 0.f ? 127.f / hmx : 0.f, hsc = hmx * (1.f / 127.f);
        v4u hq; hq.x = pk_i8((f32x4){hx[0], hx[1], hx[2], hx[3]}, hinv); hq.y = pk_i8((f32x4){hx[4], hx[5], hx[6], hx[7]}, hinv); hq.z = pk_i8((f32x4){hx[8], hx[9], hx[10], hx[11]}, hinv); hq.w = pk_i8((f32x4){hx[12], hx[13], hx[14], hx[15]}, hinv);
        v4u uA[4], vA[4], uB[4], vB[4]; float suA[4], svA[4], cA[4], suB[4], svB[4], cB[4];
#define PEER_LOAD(U, V, SU, SV, CW, q0) do { _Pragma("unroll") for (int i = 0; i < 4; ++i) { const int e_ = elist[(q0) + i]; CW[i] = cf[(q0) + i]; \
            U[i] = *((const GAS v4u*)(PU + (size_t)e_ * D_MODEL) + lane); V[i] = *((const GAS v4u*)(PV + (size_t)e_ * D_MODEL) + lane); SU[i] = SCU[e_]; SV[i] = SCV[e_]; } } while (0)
#define PEER_COMP(U, V, SU, SV, CW) do { float d_[4]; _Pragma("unroll") for (int i = 0; i < 4; ++i) { int di_ = __builtin_amdgcn_sdot4((int)U[i].x, (int)hq.x, 0, false); di_ = __builtin_amdgcn_sdot4((int)U[i].y, (int)hq.y, di_, false); \
            di_ = __builtin_amdgcn_sdot4((int)U[i].z, (int)hq.z, di_, false); di_ = __builtin_amdgcn_sdot4((int)U[i].w, (int)hq.w, di_, false); d_[i] = (float)di_ * hsc; } \
            _Pragma("unroll") for (int i = 0; i < 4; ++i) d_[i] += dpp_f<0xB1>(d_[i]); _Pragma("unroll") for (int i = 0; i < 4; ++i) d_[i] += dpp_f<0x4E>(d_[i]); \
            _Pragma("unroll") for (int i = 0; i < 4; ++i) d_[i] += dpp_f<0x141>(d_[i]); _Pragma("unroll") for (int i = 0; i < 4; ++i) d_[i] += dpp_f<0x140>(d_[i]); \
            _Pragma("unroll") for (int i = 0; i < 4; ++i) { const float dd = (rdlane(d_[i], 0) + rdlane(d_[i], 16) + rdlane(d_[i], 32) + rdlane(d_[i], 48)) * SU[i]; const float cc = CW[i] * gelu_tanh(dd) * SV[i]; \
              float t[16]; fp8x16_to_f32(V[i], t); _Pragma("unroll") for (int j = 0; j < 16; ++j) out[j] += cc * t[j]; } } while (0)
        PEER_LOAD(uA, vA, suA, svA, cA, 0);
        for (int q = 0; q < 128; q += 8) {
            PEER_LOAD(uB, vB, suB, svB, cB, q + 4);
            PEER_COMP(uA, vA, suA, svA, cA);
            if (q + 8 < 128) PEER_LOAD(uA, vA, suA, svA, cA, q + 8);
            PEER_COMP(uB, vB, suB, svB, cB);
        }
#undef PEER_LOAD
#undef PEER_COMP
        if (!dry && rp3 == ((MK_REP) == 106 ? 1 : 0)) { GAS f32x4* xr = (GAS f32x4*)(X + (size_t)m * D_MODEL + 16 * lane);
          f32x4 xv[4]; float s2 = 0.f;
#pragma unroll
          for (int j = 0; j < 4; ++j) { xv[j] = xr[j] + (f32x4){out[4 * j], out[4 * j + 1], out[4 * j + 2], out[4 * j + 3]}; s2 += (xv[j].x * xv[j].x + xv[j].y * xv[j].y) + (xv[j].z * xv[j].z + xv[j].w * xv[j].w); }
          const float rn = __builtin_amdgcn_rsqf(wave_sum(s2) * (1.f / D_MODEL) + EPSF);
          if (l + 1 < DEPTH) {
#pragma unroll
              for (int j = 0; j < 4; ++j) xr[j] = xv[j];
              const GAS f32x4* gr = (const GAS f32x4*)(a.in[I_N1] + (size_t)(l + 1) * D_MODEL + 16 * lane); float o16[16];
#pragma unroll
              for (int j = 0; j < 4; ++j) { const f32x4 gg = gr[j]; o16[4 * j] = xv[j].x * rn * gg.x; o16[4 * j + 1] = xv[j].y * rn * gg.y; o16[4 * j + 2] = xv[j].z * rn * gg.z; o16[4 * j + 3] = xv[j].w * rn * gg.w; }
              v4u w0, w1; w0.x = pk2(o16[0], o16[1]); w0.y = pk2(o16[2], o16[3]); w0.z = pk2(o16[4], o16[5]); w0.w = pk2(o16[6], o16[7]); w1.x = pk2(o16[8], o16[9]); w1.y = pk2(o16[10], o16[11]); w1.z = pk2(o16[12], o16[13]); w1.w = pk2(o16[14], o16[15]);
              GAS v4u* xo = (GAS v4u*)((bf16*)(wsb + a.off[R_XN]) + (size_t)m * D_MODEL + 16 * lane); xo[0] = w0; xo[1] = w1;
          } else {
              float* dst = nullptr;
              if (m >= SROW0) dst = a.out + O_YS + (size_t)(m - SROW0) * D_MODEL; else { const int b_ = m / LPP, p_ = m % LPP; if (p_ >= PADF + N_META) dst = a.out + O_YP + ((size_t)b_ * SEQ + (p_ - PADF - N_META)) * D_MODEL; }
              if (dst) { const GAS f32x4* gr = (const GAS f32x4*)(a.in[I_FN] + 16 * lane); GAS f32x4* o = (GAS f32x4*)(dst + 16 * lane);
#pragma unroll
                  for (int j = 0; j < 4; ++j) { const f32x4 gg = gr[j]; o[j] = (f32x4){xv[j].x * rn * gg.x, xv[j].y * rn * gg.y, xv[j].z * rn * gg.z, xv[j].w * rn * gg.w}; } }
          } }
        }
    }
}
__device__ __forceinline__ void p_final(Frame& F) {
    const KArgs ap = kargs(); const auto& a = *ap; WS_OPAQUE(a);
    const int tid = otid(), lane = tid & 63, wave = __builtin_amdgcn_readfirstlane(tid >> 6);
    const float* X = (const float*)(wsb + a.off[R_X]); const float* g = a.in[I_FN];
    for (int m = F.vcu * NWAVES + wave; m < RP; m += F.G * NWAVES) {
        float* dst;
        if (m >= SROW0) dst = a.out + O_YS + (size_t)(m - SROW0) * D_MODEL;
        else { const int b = m / LPP, p = m % LPP; if (p < PADF + N_META || p >= PEND) continue; dst = a.out + O_YP + ((size_t)b * SEQ + (p - PADF - N_META)) * D_MODEL; }
        const GAS f32x4* xr = (const GAS f32x4*)(X + (size_t)m * D_MODEL) + lane;
        f32x4 v[4]; float s2 = 0.f;
#pragma unroll
        for (int j = 0; j < 4; ++j) { v[j] = xr[64 * j]; s2 += (v[j].x * v[j].x + v[j].y * v[j].y) + (v[j].z * v[j].z + v[j].w * v[j].w); }
        const float r = __builtin_amdgcn_rsqf(wave_sum(s2) * (1.f / D_MODEL) + EPSF);
        const GAS f32x4* gr = (const GAS f32x4*)g + lane; GAS f32x4* o = (GAS f32x4*)dst + lane;
#pragma unroll
        for (int j = 0; j < 4; ++j) { const f32x4 gg = gr[64 * j]; o[64 * j] = (f32x4){v[j].x * r * gg.x, v[j].y * r * gg.y, v[j].z * r * gg.z, v[j].w * r * gg.w}; }
    }
}

__device__ __forceinline__ void p_prologue(Frame& F) {
    const KArgs ap = kargs(); const auto& a = *ap; WS_OPAQUE(a);
    const int tid = otid(), lane = tid & 63, wave = __builtin_amdgcn_readfirstlane(tid >> 6);
    LAS float* scr = (LAS float*)(F.lds + RING_OFF + wave * 16384);
    const int gw = F.vcu * NWAVES + wave, NGW = F.G * NWAVES;
    if (a.pro_mask & PM_X) {
        float* X = (float*)(wsb + a.off[R_X]);
        for (int m = gw; m < RP; m += NGW) {
            const float* src = nullptr;
            if (m >= SROW0) src = a.in[I_XS] + (size_t)(m - SROW0) * D_MODEL;
            else { const int b = m / LPP, p = m % LPP; if (p >= PADF && p < PEND) { const int pos = p - PADF; src = pos < N_META ? a.in[I_META] + (size_t)pos * D_MODEL : a.in[I_XP] + ((size_t)b * SEQ + pos - N_META) * D_MODEL; } }
            GAS f32x4* o = (GAS f32x4*)(X + (size_t)m * D_MODEL) + lane;
#pragma unroll
            for (int j = 0; j < 4; ++j) o[64 * j] = src ? ((const GAS f32x4*)src)[lane + 64 * j] : (f32x4){0.f, 0.f, 0.f, 0.f};
        }
    }
    if (a.pro_mask & PM_WIN) {
        bf16* WT = (bf16*)(wsb + a.off[R_WIN]);
        constexpr int IPL = (D_MODEL / 64) * (ZN / 32);
        for (int it = gw; it < DEPTH * IPL; it += NGW) { const int l = it / IPL, r = it % IPL, kb = r / (ZN / 32), nb = r % (ZN / 32);
            transpose_item(a.in[I_WIN] + (size_t)l * D_MODEL * D_IN, D_IN, D_MODEL, WT + (size_t)l * ZN * D_MODEL, 32 * nb, 64 * kb, CmWin(), scr, lane); }
    }
    __syncthreads();
    if (a.pro_mask & PM_TABLES) s5_tables(F);
    __syncthreads();
    if (a.pro_mask & PM_WREST) pro_wrest(F);
    if (a.pro_mask & PM_WQS) pro_wqs(F);
    if (a.pro_mask & PM_PEERW) pro_peerw(F);
}

__global__ void __launch_bounds__(NTHR, 2) mk_fwd(Args args) {
    extern __shared__ __attribute__((aligned(16))) unsigned char lds[];
    Frame F;
    F.lds = (LAS unsigned char*)lds; F.MISC = (volatile LAS unsigned*)(F.lds + MISC_OFF);
    F.wv = __builtin_amdgcn_readfirstlane((int)threadIdx.x >> 6);
    F.G = gridDim.x; { const int bx = blockIdx.x; F.vcu = (F.G % 8 == 0) ? (bx % 8) * (F.G / 8) + bx / 8 : bx; }
    F.ctl = (gu32*)args.ws;
    for (int u = F.wv * 64 + lane_id(); u < (LDS_BYTES - LDSCTL_OFF) / 4; u += NTHR) ((LAS unsigned*)(F.lds + LDSCTL_OFF))[u] = 0u;
    __syncthreads();
    const int lo = args.ph_lo, hi = args.ph_hi;
    unsigned* barw = (unsigned*)(F.ctl + CW_BAR) + (size_t)args.bar_region * XCD_BAR_WORDS;
    XcdBarrier bar; bar.bar = barw; bar.x = 0; bar.st = nullptr; bar.wv = F.wv;
    if (hi - lo > 1) bar = xcd_barrier_post(barw, F.MISC + 8, F.wv);
#define IN(k) (lo <= (k) && (k) < hi)
#ifndef MK_REP
#define MK_REP -1
#endif
#define SEAM(k) do { if ((k) + 1 < hi) { xcd_barrier(bar); if ((MK_REP) == 300) xcd_barrier(bar); } } while (0)
#ifndef MK_REP
#define MK_REP -1
#endif
    if (IN(PH_PRO)) { for (int rep_ = 0; rep_ < ((MK_REP) == 200 ? 2 : 1); ++rep_) { p_prologue(F); __syncthreads(); } SEAM(PH_PRO); }
#ifndef MK_REP
#define MK_REP -1
#endif
#define REPEAT(ph) for (int rep_ = 0; rep_ < ((MK_REP) == (ph) ? 2 : 1); ++rep_)
    for (int l = 0; l < DEPTH; ++l) {
        const int pb = 1 + l * NPL;
        if (l == 0 && IN(pb + PL_NORM1)) { REPEAT(PL_NORM1) p_norm(F, l, I_N1); SEAM(pb + PL_NORM1); }
        if (IN(pb + PL_GEMM_IN)) {
            const KArgs ap = kargs(); const auto& a = *ap; WS_OPAQUE(a);
            pg8::Gemm g{(const pg8::bf16_t*)(wsb + a.off[R_XN]), (const pg8::bf16_t*)(wsb + a.off[R_WIN]) + (size_t)l * ZN * D_MODEL, RP, ZN, D_MODEL};
            pg8::StaticOrder S; S.init(RP, ZN, F.G, (int)blockIdx.x);
            pg8::EpiBf16<0> E{(pg8::bf16_t*)(wsb + a.off[R_Z]), ZN, nullptr, 0, 0, 1.f};
            REPEAT(PL_GEMM_IN) pg8::gemm_phase<pg8::EpiBf16<0>, pg8::StaticOrder, true, true>(F.lds + RING_OFF, g, S, E, F.wv);
            SEAM(pb + PL_GEMM_IN);
        }
        if (IN(pb + PL_ZPOST)) { REPEAT(PL_ZPOST) p_zpost(F, l); SEAM(pb + PL_ZPOST); }
        if (IN(pb + PL_LOCAL)) { REPEAT(104) p_gdn_chunk(F, l); REPEAT(103) p_s5_e(F, l); SEAM(pb + PL_LOCAL); }
        if (IN(pb + PL_MIX)) {
            REPEAT(100) p_gdn_chain(F, l);
            REPEAT(102) { const int tid = otid(), lane = tid & 63, wave = __builtin_amdgcn_readfirstlane(tid >> 6), NGW = F.G * NWAVES;
              for (int t = (F.vcu * NWAVES + wave + NGW - 256) % NGW; t < S5_NTASK; t += NGW) s5_scan_run(F, l, t, lane); }
            REPEAT(101) p_attention(F, l + DEPTH * rep_, lds);
            SEAM(pb + PL_MIX); }
        if (IN(pb + PL_MIXPOST)) { REPEAT(PL_MIXPOST) { p_mixpost_a(F, l); p_mixpost_b(F, l); p_s5_out(F, l); } SEAM(pb + PL_MIXPOST); }
        if (IN(pb + PL_GEMM_GLU)) REPEAT(PL_GEMM_GLU) {
            const KArgs ap = kargs(); const auto& a = *ap; WS_OPAQUE(a);
            { pg8::Gemm g{(const pg8::bf16_t*)(wsb + a.off[R_YC]), (const pg8::bf16_t*)(wsb + a.off[R_WGLU]) + (size_t)l * 1024 * 512, RP, 1024, 512};
              pg8::StaticOrder S; S.init(RP, 1024, F.G, (int)blockIdx.x); pg8::EpiGlu E{(pg8::bf16_t*)(wsb + a.off[R_OC]), WIDTH_C};
              pg8::gemm_phase<pg8::EpiGlu, pg8::StaticOrder, true, true>(F.lds + RING_OFF, g, S, E, F.wv); }
            { pg8::Gemm g{(const pg8::bf16_t*)(wsb + a.off[R_OA]), (const pg8::bf16_t*)(wsb + a.off[R_WBR]) + ((size_t)l * 3 + 0) * 1024 * 512, RP, 1024, 512};
              pg8::StaticOrder S; S.init(RP, 1024, F.G, (int)((blockIdx.x + 16) % F.G)); pg8::EpiMerge<0> E{(float*)(wsb + a.off[R_MRG]), nullptr, nullptr, (const pg8::bf16_t*)(wsb + a.off[R_Z]) + ZC_GATE, ZN};
              pg8::gemm_phase<pg8::EpiMerge<0>, pg8::StaticOrder, true, true>(F.lds + RING_OFF, g, S, E, F.wv); }
            { pg8::Gemm g{(const pg8::bf16_t*)(wsb + a.off[R_OBN]), (const pg8::bf16_t*)(wsb + a.off[R_WBR]) + ((size_t)l * 3 + 1) * 1024 * 512, RP, 1024, 512};
              pg8::StaticOrder S; S.init(RP, 1024, F.G, (int)((blockIdx.x + 32) % F.G)); pg8::EpiMerge<0> E{(float*)(wsb + a.off[R_MRG2]), nullptr, nullptr, (const pg8::bf16_t*)(wsb + a.off[R_Z]) + ZC_GATE + 1024, ZN};
              pg8::gemm_phase<pg8::EpiMerge<0>, pg8::StaticOrder, true, true>(F.lds + RING_OFF, g, S, E, F.wv); }
            if (rep_ == ((MK_REP) == PL_GEMM_GLU ? 1 : 0)) SEAM(pb + PL_GEMM_GLU); }
        if (IN(pb + PL_GEMM_BRC)) {
            const KArgs ap = kargs(); const auto& a = *ap; WS_OPAQUE(a);
            pg8::Gemm g{(const pg8::bf16_t*)(wsb + a.off[R_OC]), (const pg8::bf16_t*)(wsb + a.off[R_WBR]) + ((size_t)l * 3 + 2) * 1024 * 512, RP, 1024, 512};
            pg8::StaticOrder S; S.init(RP, 1024, F.G, (int)blockIdx.x); pg8::EpiMerge<2> E{(float*)(wsb + a.off[R_MRG]), (const float*)(wsb + a.off[R_MRG2]), (pg8::bf16_t*)(wsb + a.off[R_MRGB]), (const pg8::bf16_t*)(wsb + a.off[R_Z]) + ZC_GATE + 2048, ZN};
            REPEAT(PL_GEMM_BRC) pg8::gemm_phase<pg8::EpiMerge<2>, pg8::StaticOrder, true, true>(F.lds + RING_OFF, g, S, E, F.wv);
            SEAM(pb + PL_GEMM_BRC); }
        if (IN(pb + PL_GEMM_OUT)) {
            const KArgs ap = kargs(); const auto& a = *ap; WS_OPAQUE(a);
            pg8::Gemm g{(const pg8::bf16_t*)(wsb + a.off[R_MRGB]), (const pg8::bf16_t*)(wsb + a.off[R_WOUT]) + (size_t)l * 1024 * 1024, RP, 1024, 1024};
            pg8::StaticOrder S; S.init(RP, 1024, F.G, (int)blockIdx.x);
            REPEAT(PL_GEMM_OUT) { pg8::EpiResid E{(float*)(wsb + a.off[R_X]), D_MODEL, (MK_REP) == PL_GEMM_OUT && rep_ == 0};
            pg8::gemm_phase<pg8::EpiResid, pg8::StaticOrder, true, true>(F.lds + RING_OFF, g, S, E, F.wv); }
            SEAM(pb + PL_GEMM_OUT); }
        if (IN(pb + PL_NORM2)) { REPEAT(PL_NORM2) p_norm(F, l, I_N2); SEAM(pb + PL_NORM2); }
        if (IN(pb + PL_GEMM_PEER)) {
            const KArgs ap = kargs(); const auto& a = *ap; WS_OPAQUE(a);
            pg8::Gemm g{(const pg8::bf16_t*)(wsb + a.off[R_XN]), (const pg8::bf16_t*)(wsb + a.off[R_WQS]) + (size_t)l * PQ * D_MODEL, RP, PQ, D_MODEL};
            pg8::StaticOrder S; S.init(RP, PQ, F.G, (int)blockIdx.x); pg8::EpiF32 E{(float*)(wsb + a.off[R_SC]), PQ};
            REPEAT(PL_GEMM_PEER) pg8::gemm_phase<pg8::EpiF32, pg8::StaticOrder, true, true>(F.lds + RING_OFF, g, S, E, F.wv);
            SEAM(pb + PL_GEMM_PEER); }
        if (IN(pb + PL_PEER)) { REPEAT(PL_PEER) p_peer(F, l, (MK_REP) == PL_PEER && rep_ == 0); SEAM(pb + PL_PEER); }
    }
#undef IN
#undef SEAM
}
}
#ifndef MK_ONE_LAUNCH
#define MK_ONE_LAUNCH 1
#endif
static int mk_grid = 0;
static bool mk_setup() {
    if (mk_grid) return mk_grid > 0;
    int dev = 0, cus = 0;
    if (hipGetDevice(&dev) != hipSuccess || hipDeviceGetAttribute(&cus, hipDeviceAttributeMultiprocessorCount, dev) != hipSuccess) { mk_grid = -1; return false; }
    if (hipFuncSetAttribute((const void*)mk::mk_fwd, hipFuncAttributeMaxDynamicSharedMemorySize, mk::LDS_BYTES) != hipSuccess) { fprintf(stderr, "kernel_launch: hipFuncSetAttribute failed\n"); mk_grid = -1; return false; }
    int per_cu = 0;
    if (hipOccupancyMaxActiveBlocksPerMultiprocessor(&per_cu, (const void*)mk::mk_fwd, mk::NTHR, mk::LDS_BYTES) != hipSuccess || per_cu < 1) { fprintf(stderr, "kernel_launch: occupancy query says %d workgroups per CU\n", per_cu); }
    (void)hipGetLastError();
    mk_grid = cus;
    return true;
}
static void mk_launch(mk::Args a, int lo, int hi, int region, hipStream_t stream) {
    a.ph_lo = lo; a.ph_hi = hi; a.bar_region = region;
    hipLaunchKernelGGL(mk::mk_fwd, dim3(mk_grid), dim3(mk::NTHR), mk::LDS_BYTES, stream, a);
    hipError_t e = hipPeekAtLastError(); if (e != hipSuccess) fprintf(stderr, "kernel_launch: launch failed: %s\n", hipGetErrorName(e));
}
extern "C" void kernel_launch(void* const* d_in, const int* in_sizes, int n_in, void* d_out, int out_size, void* d_ws, size_t ws_size, hipStream_t stream) {
    if (n_in != N_INPUTS || (size_t)out_size != (size_t)O_END) { fprintf(stderr, "kernel_launch: unexpected n_in %d / out_size %d\n", n_in, out_size); return; }
    if (!mk_setup()) return;
    const size_t MiB = 1u << 20;
    unsigned char* ws = (unsigned char*)d_ws;
    mk::Args a{};
    for (int i = 0; i < N_INPUTS; ++i) a.in[i] = (const float*)d_in[i];
    a.out = (float*)d_out; a.ws = ws;
    { using namespace mk; const struct { int r; size_t mib; } map[] = { {R_WIN, 1}, {R_WGLU, 59}, {R_WBR, 63}, {R_WOUT, 75}, {R_WQS, 83}, {R_S5T, 99}, {R_PU, 132}, {R_PV, 196}, {R_MISC, 260}, {R_OBN, 262}, {R_MRG2, 280}, {R_X, 388}, {R_XN, 456},
        {R_Z, 490}, {R_SC, 490}, {R_QN, 737}, {R_KN, 754}, {R_QKVB, 771}, {R_BG, 822}, {R_O, 823}, {R_MRGB, 823}, {R_OA, 857}, {R_OB, 874}, {R_GDN, 891}, {R_MRG, 891},
        {R_S5E, 986}, {R_YC, 986}, {R_S5X, 1003}, {R_OC, 1012} };
      for (auto& e : map) a.off[e.r] = e.mib * MiB; }
    if (1029 * MiB > ws_size) { fprintf(stderr, "kernel_launch: workspace too small (%zu)\n", ws_size); return; }
    if (hipMemsetAsync(ws, 0, mk::CTL_BYTES, stream) != hipSuccess) { fprintf(stderr, "kernel_launch: memset failed\n"); return; }
    a.pro_mask = mk::PM_X | mk::PM_WIN | mk::PM_TABLES | mk::PM_WREST | mk::PM_WQS | mk::PM_PEERW;
#if MK_ONE_LAUNCH
    mk_launch(a, 0, mk::PH_END, 0, stream);
#else
    int region = 0;
    mk_launch(a, mk::PH_PRO, mk::PH_PRO + 1, region++, stream);
    for (int l = 0; l < DEPTH; ++l) { const int pb = 1 + l * mk::NPL;
        for (int ph = mk::PL_NORM1; ph <= mk::PL_PEER; ++ph) { if (ph == mk::PL_GEMM_BRA || ph == mk::PL_GEMM_BRB) continue; mk_launch(a, pb + ph, pb + ph + 1, region++, stream); } }
    mk_launch(a, mk::PH_FINAL, mk::PH_END, region++, stream);
#endif
}
```

```cpp
#include <hip/hip_runtime.h>
#include <cstdio>
#include <cstdint>
#include <utility>
#define MK_ONE_LAUNCH 1
#ifndef D_MODEL
#define D_MODEL 1024
#define BATCH 2
#define SEQ 8192
#define DEPTH 4
#define DEC_BATCH 16
#define DEC_SEQ 32
#define PAST_LEN 1024
#define N_HEADS_A 4
#define HEAD_DIM_A 64
#define N_HEADS_B 4
#define HEAD_DIM_B 128
#define S5_GROUPS 32
#define S5_STATE 64
#define PEER_HEADS 8
#define PEER_QDIM 256
#define N_KEYS 128
#endif
#define CHUNK 64
#define N_META 16
#define EPSF 1e-6f
#define NUM_BUCKETS 32
#define CONV_W 4
#define S5_GROUP 16
#define PEER_TOPK 16
#define N_EXPERTS (N_KEYS * N_KEYS)
#define WIDTH_A (N_HEADS_A * 2 * HEAD_DIM_A)
#define WIDTH_B (N_HEADS_B * HEAD_DIM_B)
#define WIDTH_C (S5_GROUPS * S5_GROUP)
#define OFF_QA 0
#define OFF_KA (OFF_QA + WIDTH_A)
#define OFF_VA (OFF_KA + WIDTH_A)
#define OFF_QKVB (OFF_VA + WIDTH_A)
#define OFF_GB (OFF_QKVB + 3 * WIDTH_B)
#define OFF_BETA (OFF_GB + WIDTH_B)
#define OFF_ALPHA (OFF_BETA + N_HEADS_B)
#define OFF_UC (OFF_ALPHA + N_HEADS_B)
#define OFF_GATE (OFF_UC + WIDTH_C)
#define D_IN (OFF_GATE + 3 * D_MODEL)
#define LP (N_META + SEQ)
#define NP (BATCH * LP)
#define NS (DEC_BATCH * DEC_SEQ)
#define NT (NP + NS)
#define PQ (PEER_HEADS * PEER_QDIM)

enum { I_XP, I_XS, I_CK, I_CV, I_SCONV, I_SDELTA, I_SRE, I_SIM, I_META, I_REL, I_N1, I_N2, I_FN, I_WIN, I_QN, I_KN, I_LQK, I_SUBLN, I_CONVW, I_ALOG, I_DTB, I_GDNN,
       I_AR, I_AI, I_BR, I_BI, I_CR, I_CI, I_SD, I_LDT, I_WGLU, I_WBA, I_WBB, I_WBC, I_WOUT, I_PWQ, I_PSK, I_PU, I_PV, N_INPUTS };
#define O_YP 0
#define O_YS (O_YP + (size_t)BATCH * SEQ * D_MODEL)
#define O_KP (O_YS + (size_t)NS * D_MODEL)
#define O_VP (O_KP + (size_t)DEPTH * NP * WIDTH_A)
#define O_KS (O_VP + (size_t)DEPTH * NP * WIDTH_A)
#define O_VS (O_KS + (size_t)DEPTH * NS * WIDTH_A)
#define O_CP (O_VS + (size_t)DEPTH * NS * WIDTH_A)
#define O_CS (O_CP + (size_t)DEPTH * BATCH * (CONV_W - 1) * 3 * WIDTH_B)
#define O_DP (O_CS + (size_t)DEPTH * DEC_BATCH * (CONV_W - 1) * 3 * WIDTH_B)
#define O_DS (O_DP + (size_t)DEPTH * BATCH * N_HEADS_B * HEAD_DIM_B * HEAD_DIM_B)
#define O_SRP (O_DS + (size_t)DEPTH * DEC_BATCH * N_HEADS_B * HEAD_DIM_B * HEAD_DIM_B)
#define O_SIP (O_SRP + (size_t)DEPTH * BATCH * S5_GROUPS * S5_STATE)
#define O_SRS (O_SIP + (size_t)DEPTH * BATCH * S5_GROUPS * S5_STATE)
#define O_SIS (O_SRS + (size_t)DEPTH * DEC_BATCH * S5_GROUPS * S5_STATE)
#define O_END (O_SIS + (size_t)DEPTH * DEC_BATCH * S5_GROUPS * S5_STATE)

namespace pg8 {
#define PG8_LAS __attribute__((address_space(3)))
typedef unsigned short bf16_t;
typedef short bf16x8 __attribute__((ext_vector_type(8)));
typedef float f32x4 __attribute__((ext_vector_type(4)));
typedef unsigned u32x4 __attribute__((ext_vector_type(4)));
constexpr int BM = 256, BK = 64, HALF = 128, HTB = HALF * BK * 2  , STAGE_BYTES = 8 * HTB, NXCD = 8, WGM = 8;

__host__ __device__ __forceinline__ int lds_byte(int r, int c) { const int st = (r >> 4) * 2 + (c >> 5), rr = r & 15, cc = c & 31, ob = rr * 64 + cc * 2; return st * 1024 + (ob ^ (((ob >> 9) & 1) << 5)); }
__host__ __device__ __forceinline__ void stage_rc(int b, int& R, int& C) { const int st = b / 1024, sb = b % 1024, swz = sb ^ (((sb >> 9) & 1) << 5); R = (st >> 1) * 16 + swz / 64; C = (st & 1) * 32 + (swz % 64) / 2; }
__host__ __device__ __forceinline__ int perm32(int rho) { const int n = rho >> 4, i = rho & 15; return 8 * (i >> 2) + 4 * n + (i & 3); }

struct Unit { int pm, pn; };
struct Gemm { const bf16_t* A; const bf16_t* Bt; int M, N, K; };

struct StaticOrder {
    int nM, nN, nwg, G, c;
    __host__ __device__ void init(int M, int N, int G_, int c_) { nM = M / BM; nN = N / BM; nwg = nM * nN; G = G_; c = c_; }
    __host__ __device__ bool next(int i, Unit& u) const {
        const long L = (long)i * G + c; if (L >= nwg) return false;
        int wgid = (int)L; { const int q = nwg / NXCD, r = nwg % NXCD, xcd = wgid % NXCD, off = wgid / NXCD; wgid = (xcd < r ? xcd * (q + 1) : r * (q + 1) + (xcd - r) * q) + off; }
        const int nig = WGM * nN, gid = wgid / nig, fm = gid * WGM, gsz = (nM - fm) < WGM ? (nM - fm) : WGM;
        u.pm = fm + ((wgid % nig) % gsz); u.pn = (wgid % nig) / gsz; return true;
    }
    __device__ __forceinline__ void a_ready(const Unit&) const {}
    __device__ __forceinline__ void done(const Unit&) const {}
};

__device__ __forceinline__ unsigned cvt_pk_bf16(float lo, float hi) { unsigned r; asm volatile("v_cvt_pk_bf16_f32 %0, %1, %2" : "=v"(r) : "v"(lo), "v"(hi)); return r; }
typedef float f32x2 __attribute__((ext_vector_type(2)));
__device__ __forceinline__ f32x2 gelu_pk(f32x2 v) {
    const f32x2 av = __builtin_elementwise_abs(v), d = av * 0.2316418882f + 1.0f;
    f32x2 t; t.x = __builtin_amdgcn_rcpf(d.x); t.y = __builtin_amdgcn_rcpf(d.y);
    f32x2 q = t * 0.5307027145f + (-0.7265760135f); q = q * t + 0.7107068705f; q = q * t + (-0.142248368f); q = q * t + 0.127414796f; q = q * t;
    const f32x2 s = (v * v) * (-0.72134752044f);
    f32x2 e; e.x = __builtin_amdgcn_exp2f(s.x); e.y = __builtin_amdgcn_exp2f(s.y);
    const f32x2 m = v * (q * e), r = v - m;
    f32x2 o; o.x = v.x < 0.f ? m.x : r.x; o.y = v.y < 0.f ? m.y : r.y; return o;
}

template <int ACT  > struct EpiBf16 {
    static constexpr bool PERM = true, AFTER_DRAIN = false; static_assert(ACT == 0 || ACT == 1, "EpiBf16: ACT is 0 (none) or 1 (gelu_pk)");
    bf16_t* O; int ldc; const float* bias; int split_cols; size_t split_stride; float scale0;
    __device__ __forceinline__ void operator()(const f32x4 (&acc)[2][2][4][2], const Unit& u, int wr, int wc, int fr, int fq) const {
        const int row0 = u.pm * BM + wr * 64 + fr; int colt = u.pn * BM; bf16_t* base = O;
        float sc = 1.f; if (split_cols) { const int t = colt / split_cols; base += (size_t)t * split_stride; colt -= t * split_cols; if (t == 0) sc = scale0; }
        const int col0 = colt + wc * 32 + 8 * fq, bcol0 = u.pn * BM + wc * 32 + 8 * fq;
        f32x4 bv[2][2];
#pragma unroll
        for (int bj = 0; bj < 2; ++bj)
#pragma unroll
            for (int n = 0; n < 2; ++n) bv[bj][n] = bias ? *(const f32x4*)(bias + bcol0 + bj * HALF + 4 * n) : (f32x4){0.f, 0.f, 0.f, 0.f};
#pragma unroll
        for (int ai = 0; ai < 2; ++ai)
#pragma unroll
            for (int m = 0; m < 4; ++m) { bf16_t* rowp = base + (size_t)(row0 + ai * HALF + m * 16) * ldc + col0;
#pragma unroll
                for (int bj = 0; bj < 2; ++bj) { f32x4 v0 = acc[ai][bj][m][0] + bv[bj][0], v1 = acc[ai][bj][m][1] + bv[bj][1];
                    if (ACT == 1) { f32x2 a = gelu_pk((f32x2){v0[0], v0[1]}), b = gelu_pk((f32x2){v0[2], v0[3]}), c = gelu_pk((f32x2){v1[0], v1[1]}), d = gelu_pk((f32x2){v1[2], v1[3]});
                        v0 = (f32x4){a.x, a.y, b.x, b.y}; v1 = (f32x4){c.x, c.y, d.x, d.y}; }
                    v0 = v0 * sc; v1 = v1 * sc; u32x4 w; w.x = cvt_pk_bf16(v0[0], v0[1]); w.y = cvt_pk_bf16(v0[2], v0[3]); w.z = cvt_pk_bf16(v1[0], v1[1]); w.w = cvt_pk_bf16(v1[2], v1[3]);
                    *(u32x4*)(rowp + bj * HALF) = w; } }
    }
};

__device__ __forceinline__ float epi_sigm(float x) { return __builtin_amdgcn_rcpf(1.f + __expf(-x)); }
struct EpiGlu {
    static constexpr bool PERM = false, AFTER_DRAIN = false;
    bf16_t* O; int ldo;
    __device__ __forceinline__ void operator()(const f32x4 (&acc)[2][2][4][2], const Unit& u, int wr, int wc, int fr, int fq) const {
        const int row0 = u.pm * BM + wr * 64 + fr;
#pragma unroll
        for (int ai = 0; ai < 2; ++ai)
#pragma unroll
            for (int m = 0; m < 4; ++m) { bf16_t* rowp = O + (size_t)(row0 + ai * HALF + m * 16) * ldo + 4 * fq;
#pragma unroll
                for (int bj = 0; bj < 2; ++bj) { const int G = u.pn * 8 + bj * 4 + wc; const f32x4 av = acc[ai][bj][m][0], gv = acc[ai][bj][m][1];
                    typedef unsigned u32x2 __attribute__((ext_vector_type(2))); u32x2 w;
                    w.x = cvt_pk_bf16(av[0] * epi_sigm(gv[0]), av[1] * epi_sigm(gv[1])); w.y = cvt_pk_bf16(av[2] * epi_sigm(gv[2]), av[3] * epi_sigm(gv[3]));
                    *(u32x2*)(rowp + 16 * G) = w; } }
    }
};
template <int MODE> struct EpiMerge {
    static constexpr bool PERM = true, AFTER_DRAIN = false;
    float* M; const float* M2; bf16_t* Mb; const bf16_t* Zg; int ldz;
    __device__ __forceinline__ void operator()(const f32x4 (&acc)[2][2][4][2], const Unit& u, int wr, int wc, int fr, int fq) const {
        const int row0 = u.pm * BM + wr * 64 + fr, col0 = u.pn * BM + wc * 32 + 8 * fq;
#pragma unroll
        for (int ai = 0; ai < 2; ++ai)
#pragma unroll
            for (int m = 0; m < 4; ++m) { const size_t row = (size_t)(row0 + ai * HALF + m * 16);
#pragma unroll
                for (int bj = 0; bj < 2; ++bj) { const int col = col0 + bj * HALF;
                    const u32x4 gz = *(const u32x4*)(Zg + row * ldz + col);
                    float g[8]; g[0] = __builtin_bit_cast(float, gz.x << 16); g[1] = __builtin_bit_cast(float, gz.x & 0xffff0000u); g[2] = __builtin_bit_cast(float, gz.y << 16); g[3] = __builtin_bit_cast(float, gz.y & 0xffff0000u);
                    g[4] = __builtin_bit_cast(float, gz.z << 16); g[5] = __builtin_bit_cast(float, gz.z & 0xffff0000u); g[6] = __builtin_bit_cast(float, gz.w << 16); g[7] = __builtin_bit_cast(float, gz.w & 0xffff0000u);
                    f32x4 v0 = acc[ai][bj][m][0], v1 = acc[ai][bj][m][1];
#pragma unroll
                    for (int j = 0; j < 4; ++j) { v0[j] *= epi_sigm(g[j]); v1[j] *= epi_sigm(g[4 + j]); }
                    if (MODE == 0) { float* mp = M + row * 1024 + col; *(f32x4*)mp = v0; *(f32x4*)(mp + 4) = v1; }
                    else { const float* mp = M + row * 1024 + col; const float* mq = M2 + row * 1024 + col;
                        v0 += *(const f32x4*)mp + *(const f32x4*)mq; v1 += *(const f32x4*)(mp + 4) + *(const f32x4*)(mq + 4);
                        u32x4 w; w.x = cvt_pk_bf16(v0[0], v0[1]); w.y = cvt_pk_bf16(v0[2], v0[3]); w.z = cvt_pk_bf16(v1[0], v1[1]); w.w = cvt_pk_bf16(v1[2], v1[3]); *(u32x4*)(Mb + row * 1024 + col) = w; } } }
    }
};
struct EpiResid {
    static constexpr bool PERM = false, AFTER_DRAIN = false;
    float* X; int ldx; bool dry; bf16_t* Xb;
    __device__ __forceinline__ void operator()(const f32x4 (&acc)[2][2][4][2], const Unit& u, int wr, int wc, int fr, int fq) const {
        const int row0 = u.pm * BM + wr * 64 + fr, col0 = u.pn * BM + wc * 32 + 4 * fq;
#pragma unroll
        for (int ai = 0; ai < 2; ++ai)
#pragma unroll
            for (int m = 0; m < 4; ++m) { const int row = row0 + ai * HALF + m * 16;
                bool ok = true; if (row < 16896) { const int p = row % 8448; ok = p >= 48 && p < 8256; }
                if (ok && !dry) { float* rowp = X + (size_t)row * ldx + col0;
#pragma unroll
                    for (int bj = 0; bj < 2; ++bj)
#pragma unroll
                        for (int n = 0; n < 2; ++n) { f32x4* p4 = (f32x4*)(rowp + bj * HALF + n * 16); const f32x4 v = *p4 + acc[ai][bj][m][n]; *p4 = v;
                            typedef unsigned u32x2 __attribute__((ext_vector_type(2))); u32x2 w; w.x = cvt_pk_bf16(v[0], v[1]); w.y = cvt_pk_bf16(v[2], v[3]);
                            *(u32x2*)(Xb + (size_t)row * ldx + col0 + bj * HALF + n * 16) = w; } } }
    }
};
struct EpiF32 {
    static constexpr bool PERM = false, AFTER_DRAIN = false;
    float* C; int ldc;
    __device__ __forceinline__ void operator()(const f32x4 (&acc)[2][2][4][2], const Unit& u, int wr, int wc, int fr, int fq) const {
        const int row0 = u.pm * BM + wr * 64 + fr, col0 = u.pn * BM + wc * 32 + 4 * fq;
#pragma unroll
        for (int ai = 0; ai < 2; ++ai)
#pragma unroll
            for (int m = 0; m < 4; ++m) { float* rowp = C + (size_t)(row0 + ai * HALF + m * 16) * ldc + col0;
#pragma unroll
                for (int bj = 0; bj < 2; ++bj)
#pragma unroll
                    for (int n = 0; n < 2; ++n) *(f32x4*)(rowp + bj * HALF + n * 16) = acc[ai][bj][m][n]; }
    }
};

template <class Epi, class Sched, bool ALIGN_EPI = false, bool SP2 = false>
__device__ __forceinline__ void gemm_phase(PG8_LAS unsigned char* lds, const Gemm g, const Sched& S, const Epi& E, int wv) {
    unsigned om_ = ~0u; asm volatile("" : "+s"(om_), "+s"(wv)); int tid_ = wv * 64 + (int)__builtin_amdgcn_mbcnt_hi(om_, __builtin_amdgcn_mbcnt_lo(om_, 0u));
    const int tid = tid_, wid = __builtin_amdgcn_readfirstlane(tid >> 6), lane = tid & 63, wr = wid >> 2, wc = wid & 3, fr = lane & 15, fq = lane >> 4;
    const int K = g.K, nt = K / BK;
    unsigned voffA[2], voffB[2];
#pragma unroll
    for (int i = 0; i < 2; ++i) { int R, C; stage_rc(tid * 16 + i * 8192, R, C); const int Rb = Epi::PERM ? ((R & ~31) + perm32(R & 31)) : R;
        voffA[i] = (unsigned)(R * K + C) * 2u; voffB[i] = (unsigned)(Rb * K + C) * 2u; }
    const size_t kstep = (size_t)(BK * 2);
    const size_t hstep = (size_t)HALF * K * 2;
    const size_t tstep = 2 * hstep;
    const unsigned ldsw = (unsigned)wid * 1024u;
    const int aoff = lds_byte(wr * 64 + fr, fq * 8), boff = lds_byte(wc * 32 + fr, fq * 8);
#define PG8_SA(b, h) (((b) * 2 + (h)) * HTB)
#define PG8_SB(b, h) ((4 + (b) * 2 + (h)) * HTB)
#define PG8_STAGE(bufoff, gbase, voff) do { _Pragma("unroll") for (int _i = 0; _i < 2; ++_i) \
        __builtin_amdgcn_global_load_lds((const unsigned*)((const char*)(gbase) + (voff)[_i]), (PG8_LAS unsigned*)(lds + (bufoff) + ldsw + _i * 8192), 16, 0, 0); } while (0)
#define PG8_LDA(dst, b, h) do { _Pragma("unroll") for (int m = 0; m < 4; ++m) _Pragma("unroll") for (int k = 0; k < 2; ++k) dst[m][k] = *(const PG8_LAS bf16x8*)(lds + PG8_SA(b, h) + aoff + m * 2048 + k * 1024); } while (0)
#define PG8_LDB(dst, b, h) do { _Pragma("unroll") for (int n = 0; n < 2; ++n) _Pragma("unroll") for (int k = 0; k < 2; ++k) dst[n][k] = *(const PG8_LAS bf16x8*)(lds + PG8_SB(b, h) + boff + n * 2048 + k * 1024); } while (0)
#define PG8_MMA(ai, bj, At, Bt) do { __builtin_amdgcn_s_setprio(1); _Pragma("unroll") for (int m = 0; m < 4; ++m) _Pragma("unroll") for (int n = 0; n < 2; ++n) _Pragma("unroll") for (int k = 0; k < 2; ++k) \
        acc[ai][bj][m][n] = __builtin_amdgcn_mfma_f32_16x16x32_bf16(Bt[n][k], At[m][k], acc[ai][bj][m][n], 0, 0, 0); __builtin_amdgcn_s_setprio(0); } while (0)
#define PG8_WAIT_V(n) asm volatile("s_waitcnt vmcnt(" #n ")" ::: "memory")
#define PG8_WAIT_L(n) asm volatile("s_waitcnt lgkmcnt(" #n ")" ::: "memory")
#define PG8_BAR __builtin_amdgcn_s_barrier()
#define PG8_SCHED __builtin_amdgcn_sched_barrier(0)
    Unit cur, nxt; int ui = 0;
    if (!S.next(0, cur)) return;
    f32x4 acc[2][2][4][2];
#pragma unroll
    for (int a = 0; a < 2; ++a)
#pragma unroll
        for (int b = 0; b < 2; ++b)
#pragma unroll
            for (int m = 0; m < 4; ++m)
#pragma unroll
                for (int n = 0; n < 2; ++n) acc[a][b][m][n] = (f32x4){0.f, 0.f, 0.f, 0.f};
    bf16x8 At[4][2], B0[2][2], B1[2][2];
    const char* cA = (const char*)g.A + (size_t)cur.pm * tstep; const char* cB = (const char*)g.Bt + (size_t)cur.pn * tstep;
    S.a_ready(cur);
    if constexpr (SP2) {
        PG8_STAGE(PG8_SB(0, 0), cB, voffB); PG8_STAGE(PG8_SB(0, 1), cB + hstep, voffB); PG8_STAGE(PG8_SA(0, 0), cA, voffA); PG8_STAGE(PG8_SA(0, 1), cA + hstep, voffA);
        if (wr == 1) PG8_BAR;
        PG8_WAIT_V(2); PG8_BAR;
        PG8_STAGE(PG8_SB(1, 0), cB + kstep, voffB); PG8_STAGE(PG8_SA(1, 0), cA + kstep, voffA); PG8_STAGE(PG8_SB(1, 1), cB + hstep + kstep, voffB);
        PG8_WAIT_V(6); PG8_BAR;
    } else {
        PG8_STAGE(PG8_SB(0, 0), cB, voffB); PG8_STAGE(PG8_SA(0, 0), cA, voffA); PG8_STAGE(PG8_SB(0, 1), cB + hstep, voffB); PG8_STAGE(PG8_SA(0, 1), cA + hstep, voffA);
        if (wr == 1) PG8_BAR;
        PG8_WAIT_V(4); PG8_BAR;
        PG8_STAGE(PG8_SB(1, 0), cB + kstep, voffB); PG8_STAGE(PG8_SA(1, 0), cA + kstep, voffA); PG8_STAGE(PG8_SB(1, 1), cB + hstep + kstep, voffB);
        PG8_WAIT_V(6); PG8_BAR;
    }
    for (;;) {
        const bool has_next = S.next(ui + 1, nxt);
        const char* nA = has_next ? (const char*)g.A + (size_t)nxt.pm * tstep : cA; const char* nB = has_next ? (const char*)g.Bt + (size_t)nxt.pn * tstep : cB;
        for (int t = 0; t < nt; t += 2) {
            const bool last = (t == nt - 2);
            const char* a1 = cA + (size_t)(t + 1) * kstep;
            const char* a2 = last ? nA : cA + (size_t)(t + 2) * kstep; const char* b2 = last ? nB : cB + (size_t)(t + 2) * kstep;
            const char* a3 = a2 + kstep; const char* b3 = b2 + kstep;
            if (last && has_next) S.a_ready(nxt);
            if constexpr (SP2) {
            PG8_LDB(B0, 0, 0); PG8_LDB(B1, 0, 1); PG8_SCHED; PG8_LDA(At, 0, 0); PG8_STAGE(PG8_SA(1, 1), a1 + hstep, voffA);
            PG8_WAIT_V(8); PG8_WAIT_L(0); PG8_BAR; PG8_MMA(0, 0, At, B0); PG8_MMA(0, 1, At, B1); PG8_BAR; PG8_SCHED;
            PG8_LDA(At, 0, 1); PG8_STAGE(PG8_SB(0, 0), b2, voffB); PG8_STAGE(PG8_SB(0, 1), b2 + hstep, voffB); PG8_STAGE(PG8_SA(0, 0), a2, voffA);
            PG8_WAIT_V(8); PG8_WAIT_L(0); PG8_BAR; PG8_MMA(1, 0, At, B0); PG8_MMA(1, 1, At, B1); PG8_BAR; PG8_SCHED;
            PG8_LDB(B0, 1, 0); PG8_LDB(B1, 1, 1); PG8_SCHED; PG8_LDA(At, 1, 0); PG8_STAGE(PG8_SA(0, 1), a2 + hstep, voffA);
            PG8_WAIT_V(8); PG8_WAIT_L(0); PG8_BAR; PG8_MMA(0, 0, At, B0); PG8_MMA(0, 1, At, B1); PG8_BAR; PG8_SCHED;
            PG8_LDA(At, 1, 1); PG8_STAGE(PG8_SB(1, 0), b3, voffB); PG8_STAGE(PG8_SB(1, 1), b3 + hstep, voffB); PG8_STAGE(PG8_SA(1, 0), a3, voffA);
            PG8_WAIT_V(8); PG8_WAIT_L(0); PG8_BAR; PG8_MMA(1, 0, At, B0); PG8_MMA(1, 1, At, B1); PG8_BAR; PG8_SCHED;
            } else {
            PG8_LDB(B0, 0, 0); PG8_SCHED; PG8_LDA(At, 0, 0); PG8_STAGE(PG8_SA(1, 1), a1 + hstep, voffA);
            PG8_WAIT_L(8); PG8_BAR; PG8_WAIT_L(0); PG8_MMA(0, 0, At, B0); PG8_BAR; PG8_SCHED;
            PG8_LDB(B1, 0, 1); PG8_STAGE(PG8_SB(0, 0), b2, voffB);
            PG8_BAR; PG8_WAIT_L(0); PG8_MMA(0, 1, At, B1); PG8_BAR;
            PG8_LDA(At, 0, 1); PG8_STAGE(PG8_SA(0, 0), a2, voffA);
            PG8_BAR; PG8_WAIT_L(0); PG8_MMA(1, 0, At, B0); PG8_BAR; PG8_SCHED;
            PG8_STAGE(PG8_SB(0, 1), b2 + hstep, voffB);
            PG8_WAIT_V(6); PG8_BAR; PG8_MMA(1, 1, At, B1); PG8_BAR;
            PG8_LDB(B0, 1, 0); PG8_SCHED; PG8_LDA(At, 1, 0); PG8_STAGE(PG8_SA(0, 1), a2 + hstep, voffA);
            PG8_WAIT_L(8); PG8_BAR; PG8_WAIT_L(0); PG8_MMA(0, 0, At, B0); PG8_BAR; PG8_SCHED;
            PG8_LDB(B1, 1, 1); PG8_STAGE(PG8_SB(1, 0), b3, voffB);
            PG8_BAR; PG8_WAIT_L(0); PG8_MMA(0, 1, At, B1); PG8_BAR;
            PG8_LDA(At, 1, 1); PG8_STAGE(PG8_SA(1, 0), a3, voffA);
            PG8_BAR; PG8_WAIT_L(0); PG8_MMA(1, 0, At, B0); PG8_BAR; PG8_SCHED;
            PG8_STAGE(PG8_SB(1, 1), b3 + hstep, voffB);
            PG8_WAIT_V(6); PG8_BAR; PG8_MMA(1, 1, At, B1); PG8_BAR;
            }
        }
        if constexpr (ALIGN_EPI) { if (wr == 0) PG8_BAR; }
        if constexpr (!Epi::AFTER_DRAIN) { E(acc, cur, wr, wc, fr, fq); S.done(cur); }
        if (!has_next) break;
#pragma unroll
        for (int a = 0; a < 2; ++a)
#pragma unroll
            for (int b = 0; b < 2; ++b)
#pragma unroll
                for (int m = 0; m < 4; ++m)
#pragma unroll
                    for (int n = 0; n < 2; ++n) acc[a][b][m][n] = (f32x4){0.f, 0.f, 0.f, 0.f};
        cur = nxt; cA = nA; cB = nB; ++ui;
        if constexpr (ALIGN_EPI) { if (wr == 1) PG8_BAR; }
    }
    PG8_WAIT_V(0);
    if constexpr (!ALIGN_EPI) { if (wr == 0) PG8_BAR; }
    PG8_BAR;
    if constexpr (Epi::AFTER_DRAIN) { E.fused(acc, cur, wr, wc, fr, fq, lds, wid, lane); S.done(cur); }
#undef PG8_SA
#undef PG8_SB
#undef PG8_STAGE
#undef PG8_LDA
#undef PG8_LDB
#undef PG8_MMA
#undef PG8_WAIT_V
#undef PG8_WAIT_L
#undef PG8_BAR
#undef PG8_SCHED
}
}
#include <hip/hip_bf16.h>
#include <cmath>
namespace attn_body {
using bf16=__hip_bfloat16;
using bf16x8=__attribute__((ext_vector_type(8)))short;
using s16x4=__attribute__((ext_vector_type(4)))short;
using f32x16=__attribute__((ext_vector_type(16)))float;
using u32x4=__attribute__((ext_vector_type(4)))unsigned;
constexpr int ASEQ=8448,D=64;
constexpr int QP=512,KP=512,VP=7424,OP=1024;
constexpr int NW=8,QBLK=32,QB=QBLK*NW,KVBLK=64,NQB=ASEQ/QB;
constexpr int ATTN_UNIT_ROWS=QB;
__device__ __forceinline__ int crow(int r,int hi){return (r&3)+8*(r>>2)+4*hi;}
#define SBAR() __builtin_amdgcn_sched_barrier(0)
constexpr int BT_OFF=383, BT_N=640;
__device__ __forceinline__ void bmask(f32x16&p0,f32x16&p1,int t,int q0,int wid,int r32,int hi,const __attribute__((address_space(3))) float*tab){
  const float NEG=-INFINITY; const int qw=q0+32*wid;
  if(t>(qw>>6)){
    #pragma unroll
    for(int r=0;r<16;++r){p0[r]=NEG;p1[r]=NEG;} return; }
  if(t>0 && 64*t+63+91<=qw) return;
  const int q=qw+r32, kb=64*t+4*hi;
  #pragma unroll
  for(int r=0;r<16;++r){ const int kv=kb+(r&3)+8*(r>>2); int i0=kv-q+BT_OFF, i1=i0+32; i0=i0<0?0:i0; i1=i1<0?0:i1;
    p0[r]+=tab[i0]; p1[r]+=tab[i1]; if(kv<48)p0[r]=NEG; if(kv+32<48)p1[r]=NEG; }
}

constexpr int NSLOT=3, SLOTB=8192;
constexpr int LDS_K=0, LDS_V=NSLOT*SLOTB, LDS_WS=2*NSLOT*SLOTB, LDS_OST=LDS_WS+NW*64*4, LDS_BT=LDS_OST+NW*4096, LDS_BYTES=LDS_BT+BT_N*4;
constexpr float C2=0.125f*1.4426950408889634f;
__device__ __forceinline__ void glds16(const void*gsrc,unsigned lds_dst){unsigned keep;
  asm volatile("s_mov_b32 %0, m0\n\ts_mov_b32 m0, %2\n\ts_nop 0\n\tglobal_load_lds_dwordx4 %1, off\n\ts_mov_b32 m0, %0":"=&s"(keep):"v"(gsrc),"s"(lds_dst):"memory");}
__device__ __forceinline__ float max3f(float a,float b,float c){float r;asm("v_max3_f32 %0, %1, %2, %3":"=v"(r):"v"(a),"v"(b),"v"(c));return r;}
__device__ __forceinline__ float max2f(float a,float b){float r;asm("v_max_f32_e32 %0, %1, %2":"=v"(r):"v"(a),"v"(b));return r;}
__device__ __forceinline__ float fadd_s(float a,float b){float r;asm("v_add_f32_e32 %0, %1, %2":"=v"(r):"v"(a),"v"(b));return r;}
__device__ __forceinline__ float fsub_s(float a,float b){float r;asm("v_sub_f32_e32 %0, %1, %2":"=v"(r):"v"(a),"v"(b));return r;}
typedef float f32x2_t __attribute__((ext_vector_type(2))); typedef __bf16 bf16x2_t __attribute__((ext_vector_type(2)));
__device__ __forceinline__ unsigned cvtpk_s(float lo,float hi){f32x2_t v={lo,hi};bf16x2_t b=__builtin_convertvector(v,bf16x2_t);return __builtin_bit_cast(unsigned,b);}
#define WAIT_BAR(N) asm volatile("s_waitcnt vmcnt(" #N ") lgkmcnt(0)\n\ts_barrier":::"memory")

__device__ __forceinline__ void qkt(f32x16&p0,f32x16&p1,const char*Kslot,const bf16x8*qr,const f32x16&negm,int r32,int hi){
  const char*kb=Kslot+hi*1024+r32*16;
  #pragma unroll
  for(int d0=0;d0<4;++d0){
    const bf16x8 b0=*reinterpret_cast<const bf16x8*>(kb+d0*2048);
    const bf16x8 b1=*reinterpret_cast<const bf16x8*>(kb+d0*2048+512);
    if(d0==0){p0=__builtin_amdgcn_mfma_f32_32x32x16_bf16(b0,qr[0],negm,0,0,0);p1=__builtin_amdgcn_mfma_f32_32x32x16_bf16(b1,qr[0],negm,0,0,0);}
    else{p0=__builtin_amdgcn_mfma_f32_32x32x16_bf16(b0,qr[d0],p0,0,0,0);p1=__builtin_amdgcn_mfma_f32_32x32x16_bf16(b1,qr[d0],p1,0,0,0);}}
}
typedef __attribute__((address_space(3))) const char* lds_cptr;
typedef __attribute__((address_space(3))) const float* lds_cfptr;
typedef short v4i16_t __attribute__((ext_vector_type(4)));
__device__ __forceinline__ void kload8(bf16x8*kf,lds_cptr kp){
  kf[0]=*(const __attribute__((address_space(3))) bf16x8*)(kp);      kf[1]=*(const __attribute__((address_space(3))) bf16x8*)(kp+512);
  kf[2]=*(const __attribute__((address_space(3))) bf16x8*)(kp+2048); kf[3]=*(const __attribute__((address_space(3))) bf16x8*)(kp+2560);
  kf[4]=*(const __attribute__((address_space(3))) bf16x8*)(kp+4096); kf[5]=*(const __attribute__((address_space(3))) bf16x8*)(kp+4608);
  kf[6]=*(const __attribute__((address_space(3))) bf16x8*)(kp+6144); kf[7]=*(const __attribute__((address_space(3))) bf16x8*)(kp+6656);
}
__device__ __forceinline__ void kload2(bf16x8*kf,lds_cptr kp,int j){ kf[2*j]=*(const __attribute__((address_space(3))) bf16x8*)(kp+j*2048); kf[2*j+1]=*(const __attribute__((address_space(3))) bf16x8*)(kp+j*2048+512); }
__device__ __forceinline__ s16x4 vtr(lds_cptr p){ return __builtin_bit_cast(s16x4,__builtin_amdgcn_ds_read_tr16_b64_v4i16((__attribute__((address_space(3))) v4i16_t*)p)); }
__device__ __forceinline__ float rowmax(const f32x16&p0,const f32x16&p1){
  float a=max3f(p0[0],p0[1],p1[0]),b=max3f(p0[2],p0[3],p1[1]);a=max3f(a,p1[2],p1[3]);
  #pragma unroll
  for(int r=4;r<16;r+=4){a=max3f(a,p0[r],p0[r+1]);b=max3f(b,p0[r+2],p0[r+3]);a=max3f(a,p1[r],p1[r+1]);b=max3f(b,p1[r+2],p1[r+3]);}
  const float m=max2f(a,b);
  auto rr=__builtin_amdgcn_permlane32_swap(__float_as_uint(m),__float_as_uint(m),false,false);
  return max2f(__uint_as_float(rr[0]),__uint_as_float(rr[1]));
}
__device__ __forceinline__ void pv(f32x16*o,int vb,bf16x8 pa0,bf16x8 pa1,bf16x8 pa2,bf16x8 pa3){
  #pragma unroll
  for(int d0=0;d0<2;++d0){s16x4 lo[4],hi[4];
    #pragma unroll
    for(int ks=0;ks<4;++ks){
      asm volatile("ds_read_b64_tr_b16 %0,%1 offset:%c2":"=&v"(lo[ks]):"v"(vb),"i"(d0*4096+ks*1024):"memory");
      asm volatile("ds_read_b64_tr_b16 %0,%1 offset:%c2":"=&v"(hi[ks]):"v"(vb),"i"(d0*4096+ks*1024+512):"memory");}
    asm volatile("s_waitcnt lgkmcnt(0)":::"memory");SBAR();
    #define PK(k) (bf16x8){lo[k][0],lo[k][1],lo[k][2],lo[k][3],hi[k][0],hi[k][1],hi[k][2],hi[k][3]}
    o[d0]=__builtin_amdgcn_mfma_f32_32x32x16_bf16(pa0,PK(0),o[d0],0,0,0);
    o[d0]=__builtin_amdgcn_mfma_f32_32x32x16_bf16(pa1,PK(1),o[d0],0,0,0);
    o[d0]=__builtin_amdgcn_mfma_f32_32x32x16_bf16(pa2,PK(2),o[d0],0,0,0);
    o[d0]=__builtin_amdgcn_mfma_f32_32x32x16_bf16(pa3,PK(3),o[d0],0,0,0);
    #undef PK
  }
}

#ifndef ATTN_STORE16
#define ATTN_STORE16(p,v) (*(u32x4*)(p)=(v))
#endif
template<int THRL> __device__ __forceinline__ void attn_unit(int b,int qoff,int voff,int ooff,int qb,const bf16*Q,const bf16*__restrict__ K,const bf16*__restrict__ V,bf16*O,char*shm,int wv){
  unsigned om_ = ~0u; asm volatile("" : "+s"(om_), "+s"(wv)); int tid_ = wv * 64 + (int)__builtin_amdgcn_mbcnt_hi(om_, __builtin_amdgcn_mbcnt_lo(om_, 0u)); const int tid=tid_,lane=tid&63,r32=lane&31,hi=lane>>5; const int wid=__builtin_amdgcn_readfirstlane(tid>>6);
  const long rowbase=(long)b*ASEQ; const int q0=qb*QB;
  const bf16*Qw=Q+(rowbase+q0+wid*QBLK)*QP+qoff;
  const bf16*Kh=K+rowbase*KP+qoff,*Vh=V+rowbase*VP+voff;
  const unsigned lds0=(unsigned)(uintptr_t)shm;
  float*wsf=(float*)(shm+LDS_WS)+wid*64;
  const bf16*ksrc=Kh+(long)lane*KP+wid*8;
  const bf16*vsrc=Vh+(long)(16*(wid&3)+(lane>>2))*VP+(wid>>2)*32+(lane&3)*8;
  const unsigned kdst=lds0+LDS_K+wid*1024, vdst=lds0+LDS_V+wid*1024;
  #define DMA_K(t,slot) glds16(ksrc+(long)(t)*KVBLK*KP,(unsigned)__builtin_amdgcn_readfirstlane(kdst+(slot)))
  #define DMA_V(t,slot) glds16(vsrc+(long)(t)*KVBLK*VP,(unsigned)__builtin_amdgcn_readfirstlane(vdst+(slot)))
  const int vb0=(int)(lds0+LDS_V)+((lane>>4)&1)*32+(lane&3)*8+(4*hi+((lane&15)>>2))*64;
  const char*Kbase=shm+LDS_K; bf16x8 kf[8];
  const lds_cptr shm3=(lds_cptr)shm; const lds_cfptr btab=(lds_cfptr)(shm3+LDS_BT); const lds_cptr kp0=shm3+LDS_K+hi*1024+r32*16; const lds_cptr vp0=shm3+LDS_V+((lane>>4)&1)*32+(lane&3)*8+(4*hi+((lane&15)>>2))*64;
  const int NTL=(q0+QB)/KVBLK;
  DMA_K(0,0);DMA_V(0,0);DMA_K(1,SLOTB);
  bf16x8 qr[4];
  #pragma unroll
  for(int d0=0;d0<4;++d0)qr[d0]=*reinterpret_cast<const bf16x8*>(&Qw[(long)r32*QP+d0*16+hi*8]);
  float mhat=0.f,l_reg=0.f;f32x16 o[2];o[0]=f32x16{};o[1]=f32x16{};const f32x16 zt=f32x16{};
  const int qrel=wid*QBLK+r32;
  #define CMASK(P0,P1,t) bmask(P0,P1,(t),q0,wid,r32,hi,btab)
  bool resc=false;
  #define START(P0,P1) do{ const float rm=rowmax(P0,P1); resc=false; \
    { const float dl=rm; mhat=fadd_s(mhat,dl); \
      _Pragma("unroll") for(int r=0;r<16;++r){P0[r]=fsub_s(P0[r],dl);P1[r]=fsub_s(P1[r],dl);} \
      } \
    _Pragma("unroll") for(int r=0;r<16;++r)P0[r]=__builtin_amdgcn_exp2f(P0[r]); }while(0)
  #define RESC() do{ if(resc){ asm volatile("s_waitcnt lgkmcnt(0)":::"memory"); \
      _Pragma("unroll") for(int d_=0;d_<2;++d_) _Pragma("unroll") for(int r=0;r<16;++r)o[d_][r]*=wsf[crow(r,hi)]; } }while(0)
  f32x16 pA0,pA1,pB0,pB1;
  int sl_prev=0,sl_cur=0,sl_next=SLOTB;
  #define ROT() do{sl_prev=sl_cur;sl_cur=sl_next;sl_next=(sl_next==(NSLOT-1)*SLOTB)?0:sl_next+SLOTB;}while(0)
  DMA_K(2,2*SLOTB);
  WAIT_BAR(3);
  qkt(pA0,pA1,Kbase,qr,zt,r32,hi);asm volatile("s_nop 15\n\ts_nop 7":"+v"(pA0),"+v"(pA1));CMASK(pA0,pA1,0);
  START(pA0,pA1);
  _Pragma("unroll") for(int r=0;r<16;++r)pA1[r]=__builtin_amdgcn_exp2f(pA1[r]);
  WAIT_BAR(0);
  DMA_K(3,0);DMA_V(1,SLOTB);
  ROT();
  kload8(kf,kp0+sl_cur);
  WAIT_BAR(2);
  s16x4 vlo[8],vhi[8]; u32x4 pw0,pw1,pw2,pw3;
  #define PKW(P,B) cvtpk_s(P[B],P[B+1])
  #define PAF(k) __builtin_bit_cast(bf16x8,pw##k)
  #define VFR(i) (bf16x8){vlo[i][0],vlo[i][1],vlo[i][2],vlo[i][3],vhi[i][0],vhi[i][1],vhi[i][2],vhi[i][3]}
  #define PIN(x) asm volatile("":"+v"(x))
  #define MX3(a,b,c) __builtin_fmaxf(__builtin_fmaxf((a),(b)),(c))
  #define GAPA(MF,A0,A1,A2,A3,W0,W1,PW) do{ MF; sacc+=A0; sacc+=A1; sacc+=A2; sacc+=A3; PIN(sacc); W0; W1; PIN(PW); SBAR(); }while(0)
  #define EX(v) __builtin_amdgcn_exp2f(v)
  #define GAPB(MF,X,B) do{ MF; X[B]=EX(X[B]); X[B+1]=EX(X[B+1]); X[B+2]=EX(X[B+2]); X[B+3]=EX(X[B+3]); PIN(X); SBAR(); }while(0)
  #define VRD(i) do{ vlo[i]=vtr(vp_+(((i)>>2)*4096+((i)&3)*1024)); vhi[i]=vtr(vp_+(((i)>>2)*4096+((i)&3)*1024+512)); }while(0)
  #define KRD(G,j) do{ if(G){ kload2(kf,kp0+sl_next,j); SBAR(); } }while(0)
  #define STEP(C0,C1,P0,P1,t,GK,GV,GL) do{ SBAR(); \
    const lds_cptr vp_=vp0+sl_prev; \
    VRD(0); SBAR(); float sacc=(P0[0]+P0[1]); \
    GAPA(C0=__builtin_amdgcn_mfma_f32_32x32x16_bf16(kf[0],qr[0],zt,0,0,0), P0[2],P0[3],P0[4],P0[5],     pw0[0]=PKW(P0,0), pw0[1]=PKW(P0,2), pw0); \
    VRD(4); SBAR(); GAPA(C1=__builtin_amdgcn_mfma_f32_32x32x16_bf16(kf[1],qr[0],zt,0,0,0), P0[6],P0[7],P0[8],P0[9],     pw0[2]=PKW(P0,4), pw0[3]=PKW(P0,6), pw0); \
    VRD(1); SBAR(); GAPA(C0=__builtin_amdgcn_mfma_f32_32x32x16_bf16(kf[2],qr[1],C0,0,0,0),   P0[10],P0[11],P0[12],P0[13], pw1[0]=PKW(P0,8), pw1[1]=PKW(P0,10), pw1); \
    VRD(5); SBAR(); GAPA(C1=__builtin_amdgcn_mfma_f32_32x32x16_bf16(kf[3],qr[1],C1,0,0,0),   P0[14],P0[15],P1[0],P1[1],   pw1[2]=PKW(P0,12),pw1[3]=PKW(P0,14), pw1); \
    VRD(2); SBAR(); GAPA(C0=__builtin_amdgcn_mfma_f32_32x32x16_bf16(kf[4],qr[2],C0,0,0,0),   P1[2],P1[3],P1[4],P1[5],     pw2[0]=PKW(P1,0), pw2[1]=PKW(P1,2), pw2); \
    VRD(6); SBAR(); GAPA(C1=__builtin_amdgcn_mfma_f32_32x32x16_bf16(kf[5],qr[2],C1,0,0,0),   P1[6],P1[7],P1[8],P1[9],     pw2[2]=PKW(P1,4), pw2[3]=PKW(P1,6), pw2); \
    VRD(3); SBAR(); GAPA(C0=__builtin_amdgcn_mfma_f32_32x32x16_bf16(kf[6],qr[3],C0,0,0,0),   P1[10],P1[11],P1[12],P1[13], pw3[0]=PKW(P1,8), pw3[1]=PKW(P1,10), pw3); \
    VRD(7); SBAR(); GAPA(C1=__builtin_amdgcn_mfma_f32_32x32x16_bf16(kf[7],qr[3],C1,0,0,0),   P1[14],P1[15],0.f,0.f,       pw3[2]=PKW(P1,12),pw3[3]=PKW(P1,14), pw3); \
    l_reg+=sacc; \
    if(GK){DMA_K((t)+3,sl_cur);} if(GV){DMA_V((t)+1,sl_next);} \
    _Pragma("unroll") for(int r=0;r<16;++r){C0[r]-=mhat;C1[r]-=mhat;} \
    CMASK(C0,C1,t); \
    { float a=MX3(C0[0],C0[1],C1[0]),b=MX3(C0[2],C0[3],C1[1]); a=MX3(a,C1[2],C1[3]); \
      _Pragma("unroll") for(int r=4;r<16;r+=4){a=MX3(a,C0[r],C0[r+1]);b=MX3(b,C0[r+2],C0[r+3]);a=MX3(a,C1[r],C1[r+1]);b=MX3(b,C1[r+2],C1[r+3]);} \
      float rm=__builtin_fmaxf(a,b); { auto rr=__builtin_amdgcn_permlane32_swap(__float_as_uint(rm),__float_as_uint(rm),false,false); rm=__builtin_fmaxf(__uint_as_float(rr[0]),__uint_as_float(rr[1])); } \
      resc=false; \
      if(__builtin_expect(__any(rm>(float)THRL),0)){ const float dl=__builtin_fmaxf(rm,0.f); mhat+=dl; \
        _Pragma("unroll") for(int r=0;r<16;++r){C0[r]-=dl;C1[r]-=dl;} \
        const float f=__builtin_amdgcn_exp2f(-dl); l_reg*=f; if(hi==0)wsf[r32]=f; resc=true; } } \
    SBAR(); \
    GAPB(o[0]=__builtin_amdgcn_mfma_f32_32x32x16_bf16(PAF(0),VFR(0),o[0],0,0,0), C0,0); \
    GAPB(o[1]=__builtin_amdgcn_mfma_f32_32x32x16_bf16(PAF(0),VFR(4),o[1],0,0,0), C0,4); \
    KRD(GL,0); GAPB(o[0]=__builtin_amdgcn_mfma_f32_32x32x16_bf16(PAF(1),VFR(1),o[0],0,0,0), C0,8); \
    KRD(GL,1); GAPB(o[1]=__builtin_amdgcn_mfma_f32_32x32x16_bf16(PAF(1),VFR(5),o[1],0,0,0), C0,12); \
    KRD(GL,2); GAPB(o[0]=__builtin_amdgcn_mfma_f32_32x32x16_bf16(PAF(2),VFR(2),o[0],0,0,0), C1,0); \
    KRD(GL,3); GAPB(o[1]=__builtin_amdgcn_mfma_f32_32x32x16_bf16(PAF(2),VFR(6),o[1],0,0,0), C1,4); \
    GAPB(o[0]=__builtin_amdgcn_mfma_f32_32x32x16_bf16(PAF(3),VFR(3),o[0],0,0,0), C1,8); \
    GAPB(o[1]=__builtin_amdgcn_mfma_f32_32x32x16_bf16(PAF(3),VFR(7),o[1],0,0,0), C1,12); \
    }while(0)
  int t=1;
  #undef CMASK
  #define CMASK(P0,P1,t) do{}while(0)
  for(;t+7<NTL;t+=2){
    STEP(pB0,pB1,pA0,pA1,t,true,true,true);     WAIT_BAR(2); RESC(); ROT();
    STEP(pA0,pA1,pB0,pB1,t+1,true,true,true);   WAIT_BAR(2); RESC(); ROT();
  }
  #undef CMASK
  #define CMASK(P0,P1,t) bmask(P0,P1,(t),q0,wid,r32,hi,btab)
  #define ENDW(tt) do{ if((tt)+3<NTL){WAIT_BAR(2);} else if((tt)+2<NTL){WAIT_BAR(1);} else {WAIT_BAR(0);} }while(0)
  for(;t+1<NTL;t+=2){
    STEP(pB0,pB1,pA0,pA1,t,(t+3<NTL),(t+1<NTL),(t+1<NTL));       ENDW(t);   RESC(); ROT();
    STEP(pA0,pA1,pB0,pB1,t+1,(t+4<NTL),(t+2<NTL),(t+2<NTL));     ENDW(t+1); RESC(); ROT();
  }
  STEP(pB0,pB1,pA0,pA1,NTL-1,false,false,false); RESC();
  { float sacc=pB0[0]+pB0[1]; _Pragma("unroll") for(int r=2;r<16;++r)sacc+=pB0[r]; _Pragma("unroll") for(int r=0;r<16;++r)sacc+=pB1[r]; l_reg+=sacc;
    pw0=(u32x4){PKW(pB0,0),PKW(pB0,2),PKW(pB0,4),PKW(pB0,6)};pw1=(u32x4){PKW(pB0,8),PKW(pB0,10),PKW(pB0,12),PKW(pB0,14)};pw2=(u32x4){PKW(pB1,0),PKW(pB1,2),PKW(pB1,4),PKW(pB1,6)};pw3=(u32x4){PKW(pB1,8),PKW(pB1,10),PKW(pB1,12),PKW(pB1,14)};
    SBAR(); pv(o,vb0+sl_cur,PAF(0),PAF(1),PAF(2),PAF(3)); }
  #undef PKW
  #undef PAF
  #undef VFR
  #undef PIN
  #undef MX3
  #undef GAPA
  #undef GAPB
  #undef EX
  #undef VRD
  #undef KRD
  #undef STEP
  #undef ENDW
  {auto rr=__builtin_amdgcn_permlane32_swap(__float_as_uint(l_reg),__float_as_uint(l_reg),false,false);l_reg=__uint_as_float(rr[0])+__uint_as_float(rr[1]);}
  if(hi==0)wsf[32+r32]=l_reg;asm volatile("s_waitcnt lgkmcnt(0)":::"memory");
  float rli[16];
  #pragma unroll
  for(int r=0;r<16;++r)rli[r]=__builtin_amdgcn_rcpf(wsf[32+crow(r,hi)]);
  bf16*Ow=O+(rowbase+q0+wid*QBLK)*OP+ooff;
  { bf16*stg=(bf16*)(shm+LDS_OST)+wid*2048;
    #pragma unroll
    for(int r=0;r<16;++r){const int orow=crow(r,hi);
      #pragma unroll
      for(int d0=0;d0<2;++d0)stg[orow*64+d0*32+r32]=__float2bfloat16(o[d0][r]*rli[r]);}
    asm volatile("s_waitcnt lgkmcnt(0)":::"memory");
    #pragma unroll
    for(int i=0;i<4;++i){const int row=i*8+(lane>>3),ch=lane&7; const u32x4 v=*(const u32x4*)(stg+row*64+ch*8); ATTN_STORE16(Ow+(long)row*OP+ch*8,v);} }
  asm volatile("s_waitcnt lgkmcnt(0)\n\ts_barrier":::"memory");
  #undef DMA_K
  #undef DMA_V
  #undef CMASK
  #undef START
  #undef RESC
  #undef ROT
}
constexpr int ATTN_LDS_BYTES=LDS_BYTES;
#undef SBAR
#undef WAIT_BAR
#undef WAIT_BAR
}
namespace mk {
#define GAS __attribute__((address_space(1)))
#define LAS __attribute__((address_space(3)))
typedef unsigned short bf16;
typedef unsigned v4u __attribute__((ext_vector_type(4)));
typedef unsigned v2u __attribute__((ext_vector_type(2)));
typedef float f32x4 __attribute__((ext_vector_type(4)));
typedef float f32x16 __attribute__((ext_vector_type(16)));
typedef short bf16x8 __attribute__((ext_vector_type(8)));
typedef GAS unsigned gu32;
#define RLX_AGENT __ATOMIC_RELAXED, __HIP_MEMORY_SCOPE_AGENT
#define LDS_WAIT() asm volatile("s_waitcnt lgkmcnt(0)" ::: "memory")
#define VM_WAIT() asm volatile("s_waitcnt vmcnt(0)" ::: "memory")
typedef float f32x2_cv __attribute__((ext_vector_type(2))); typedef __bf16 bf16x2_cv __attribute__((ext_vector_type(2)));
__device__ __forceinline__ unsigned pk2(float lo, float hi) { const f32x2_cv v = {lo, hi}; return __builtin_bit_cast(unsigned, __builtin_convertvector(v, bf16x2_cv)); }
__device__ __forceinline__ unsigned f2bf(float f) { return pk2(f, 0.f) & 0xffffu; }
__device__ __forceinline__ float bf2f(unsigned short b) { return __builtin_bit_cast(float, ((unsigned)b) << 16); }
__device__ __forceinline__ float bflo(unsigned w) { return __builtin_bit_cast(float, w << 16); }
__device__ __forceinline__ float bfhi(unsigned w) { return __builtin_bit_cast(float, w & 0xffff0000u); }

constexpr int NWAVES = 8, NTHR = NWAVES * 64;
constexpr int PADF = 48;
constexpr int LPP = 8448;
constexpr int PEND = PADF + LP;
constexpr int SROW0 = BATCH * LPP;
constexpr int RP = SROW0 + NS;
constexpr int ZN = 7424;
constexpr int ZC_QA = 0, ZC_KA = 512, ZC_VA = 1024, ZC_QKVB = 1536, ZC_GB = 3072, ZC_UC = 3584, ZC_GATE = 4096, ZC_BA = 7168;
static_assert(RP % 256 == 0 && ZN % 256 == 0 && D_MODEL == 1024 && WIDTH_A == 512 && WIDTH_B == 512 && WIDTH_C == 512, "shapes");
__host__ __device__ __forceinline__ int nat2prow(int row) { return row < NP ? (row / LP) * LPP + PADF + row % LP : SROW0 + (row - NP); }
__host__ __device__ __forceinline__ int zcol(int col) { return col < 3584 ? col : (col < 3592 ? ZC_BA + (col - 3584) : col - 8); }
__device__ __forceinline__ bool prow_valid(int prow) { if (prow >= SROW0) return true; const int p = prow % LPP; return p >= PADF && p < PEND; }
__device__ __forceinline__ int prow2nat(int prow) { if (prow >= SROW0) return NP + (prow - SROW0); return (prow / LPP) * LP + (prow % LPP) - PADF; }

constexpr int RING_OFF = 0, RING_BYTES = 147456;
constexpr int LDSCTL_OFF = RING_BYTES, MISC_OFF = LDSCTL_OFF + 320;
constexpr int LDS_BYTES = RING_BYTES + 1024;
static_assert(MISC_OFF + 128 <= LDS_BYTES, "LDS map");

constexpr size_t CTL_BYTES = 1u << 20;
constexpr int CW_TMO = 0, CW_CODE = 1;
constexpr int CW_BAR = 4096;
constexpr int CW_QUEUE = 16384;

__device__ __forceinline__ int lane_id() { return (int)__builtin_amdgcn_mbcnt_hi(~0u, __builtin_amdgcn_mbcnt_lo(~0u, 0u)); }
#define XB_TMO      128
#define XB_XCNT(j)  (256  + 64 * (j))
#define XB_XSUB(j)  (1280 + 64 * (j))
#define XB_XGEN(j)  (2304 + 64 * (j))
#define XB_TOP      3328
#define XB_TOPGEN   3392
#define XCD_BAR_WORDS 3456
#define XB_SPIN_CAP (1u << 18)

__device__ __forceinline__ unsigned xb_ld(unsigned* p)              { return __hip_atomic_load(p, __ATOMIC_RELAXED, __HIP_MEMORY_SCOPE_AGENT); }
__device__ __forceinline__ unsigned xb_add(unsigned* p, unsigned v) { return __hip_atomic_fetch_add(p, v, __ATOMIC_RELAXED, __HIP_MEMORY_SCOPE_AGENT); }
__device__ __forceinline__ unsigned xb_xcc_id() { return (unsigned)__builtin_amdgcn_s_getreg((3 << 11) | 20) & 0xFu; }
#define XB_SPIN(cond, bar) do { unsigned _sp = 0; while (cond) { __builtin_amdgcn_s_sleep(1); \
    if ((++_sp & 255u) == 0u) { if (xb_ld(&(bar)[XB_TMO])) break; if (_sp > XB_SPIN_CAP) { atomicAdd(&(bar)[XB_TMO], 1u); break; } } } } while (0)

struct XcdBarrier {
    unsigned* bar; unsigned x; int wv;
    volatile LAS unsigned* st;
};

__device__ __forceinline__ XcdBarrier xcd_barrier_post(unsigned* bar, volatile LAS unsigned* st, int wv) {
    XcdBarrier b; b.bar = bar; b.x = xb_xcc_id(); b.st = st; b.wv = wv;
    if (wv == 0 && lane_id() == 0) (void)xb_add(&bar[XB_XCNT(b.x)], 1u);
    return b;
}
__device__ __forceinline__ void xcd_barrier_complete(unsigned* bar, unsigned x, unsigned& nloc, unsigned& nx) {
    const unsigned G = gridDim.x * gridDim.y * gridDim.z;
    unsigned sum, cnt, mine, sp = 0u;
    for (;;) {
        sum = 0u; cnt = 0u; mine = 0u;
#pragma unroll
        for (unsigned j = 0; j < 16; ++j) { const unsigned c = xb_ld(&bar[XB_XCNT(j)]); sum += c; cnt += (c > 0u) ? 1u : 0u; mine = (j == x) ? c : mine; }
        if (sum == G) break;
        __builtin_amdgcn_s_sleep(1);
        if ((++sp & 255u) == 0u) { if (xb_ld(&bar[XB_TMO])) break; if (sp > XB_SPIN_CAP) { atomicAdd(&bar[XB_TMO], 1u); break; } }
    }
    nloc = mine > 0u ? mine : 1u; nx = cnt > 0u ? cnt : 1u;
}

__device__ __forceinline__ void xcd_barrier(const XcdBarrier& b) {
    asm volatile("s_waitcnt vmcnt(0)" ::: "memory");
    __syncthreads();
    if (b.wv == 0 && lane_id() == 0) {
        unsigned* bar = b.bar;
        __builtin_amdgcn_s_waitcnt(0);
        unsigned nloc = b.st[0], nx = b.st[1];
        if (nloc == 0u) { xcd_barrier_complete(bar, b.x, nloc, nx); b.st[0] = nloc; b.st[1] = nx; }
        const unsigned old = xb_add(&bar[XB_XSUB(b.x)], 1u);
        const unsigned gen = old / nloc;
        if (old + 1u == (gen + 1u) * nloc) {
            __builtin_amdgcn_fence(__ATOMIC_RELEASE, "agent");
            asm volatile("s_waitcnt vmcnt(0)" ::: "memory");
            const unsigned og = xb_add(&bar[XB_TOP], 1u);
            const unsigned tg = og / nx;
            if (og + 1u == (tg + 1u) * nx) xb_add(&bar[XB_TOPGEN], 1u);
            else XB_SPIN(xb_ld(&bar[XB_TOPGEN]) == tg, bar);
            __builtin_amdgcn_fence(__ATOMIC_ACQUIRE, "agent");
            xb_add(&bar[XB_XGEN(b.x)], 1u);
            asm volatile("s_waitcnt vmcnt(0)" ::: "memory");
        } else {
            XB_SPIN(xb_ld(&bar[XB_XGEN(b.x)]) == gen, bar);
            __builtin_amdgcn_fence(__ATOMIC_ACQUIRE, "agent");
            asm volatile("s_waitcnt vmcnt(0)" ::: "memory");
        }
    }
    __syncthreads();
}


template <int CTRL> __device__ __forceinline__ float dpp_f(float v) { return __builtin_bit_cast(float, __builtin_amdgcn_update_dpp(0, __builtin_bit_cast(int, v), CTRL, 0xf, 0xf, true)); }
template <int CTRL> __device__ __forceinline__ int dpp_i(int v) { return __builtin_amdgcn_update_dpp(0, v, CTRL, 0xf, 0xf, true); }
template <int CTRL, int ROWMASK> __device__ __forceinline__ float dpp_fm(float v) { return __builtin_bit_cast(float, __builtin_amdgcn_update_dpp(0, __builtin_bit_cast(int, v), CTRL, ROWMASK, 0xf, false)); }
__device__ __forceinline__ float rdlane(float v, int i) { return __builtin_bit_cast(float, __builtin_amdgcn_readlane(__builtin_bit_cast(int, v), i)); }
__device__ __forceinline__ float sum8(float v) { v += dpp_f<0xB1>(v); v += dpp_f<0x4E>(v); v += dpp_f<0x141>(v); return v; }
__device__ __forceinline__ float sum16(float v) { v = sum8(v); v += dpp_f<0x140>(v); return v; }
__device__ __forceinline__ float wave_sum(float v) { v = sum16(v); return rdlane(v, 0) + rdlane(v, 16) + rdlane(v, 32) + rdlane(v, 48); }
__device__ __forceinline__ float wave_max(float v) {
    v = fmaxf(v, dpp_f<0xB1>(v)); v = fmaxf(v, dpp_f<0x4E>(v)); v = fmaxf(v, dpp_f<0x141>(v)); v = fmaxf(v, dpp_f<0x140>(v));
    return fmaxf(fmaxf(rdlane(v, 0), rdlane(v, 16)), fmaxf(rdlane(v, 32), rdlane(v, 48)));
}
__device__ __forceinline__ float scan64(float v) {
    v += dpp_f<0x111>(v); v += dpp_f<0x112>(v); v += dpp_f<0x114>(v); v += dpp_f<0x118>(v);
    v += dpp_fm<0x142, 0xA>(v); v += dpp_fm<0x143, 0xC>(v);
    return v;
}
__device__ __forceinline__ float swap32(float v) {
    const auto r = __builtin_amdgcn_permlane32_swap(__builtin_bit_cast(unsigned, v), __builtin_bit_cast(unsigned, v), false, false);
    return __builtin_bit_cast(float, (lane_id() & 32) ? r[0] : r[1]);
}
}
namespace mk {
enum Region { R_X, R_XN, R_WIN, R_Z, R_QN, R_KN, R_QKVB, R_BG, R_O, R_OA, R_OB, R_YC, R_OC, R_MRG, R_WGLU, R_WBR, R_WOUT, R_WQS, R_PU, R_PV, R_SC, R_GDN, R_S5T, R_MISC, R_S5E, R_S5X, R_MRGB, R_OBN, R_MRG2, R_NREG };
constexpr int NPL = 16;
enum Phase { PH_PRO = 0, PL_NORM1 = 0, PL_GEMM_IN = 1, PL_ZPOST = 2, PL_LOCAL = 3, PL_MIX = 4, PL_MIXPOST = 5, PL_GEMM_GLU = 6, PL_GEMM_BRA = 7, PL_GEMM_BRB = 8, PL_GEMM_BRC = 9,
             PL_GEMM_OUT = 10, PL_NORM2 = 11, PL_GEMM_PEER = 12, PL_PEER = 13, PH_FINAL = 1 + DEPTH * NPL, PH_END = PH_FINAL + 1 };
enum ProMask { PM_X = 1, PM_WIN = 2, PM_WREST = 4, PM_PEERW = 8, PM_WQS = 16, PM_TABLES = 32 };
struct Args {
    const float* in[40];
    float* out;
    unsigned char* ws;
    unsigned long long off[32];
    int ph_lo, ph_hi, pro_mask, bar_region;
};
static_assert(sizeof(Args) == 40 * 8 + 8 + 8 + 32 * 8 + 16, "Args has no padding");

typedef const __attribute__((address_space(4))) Args* KArgs;
__device__ __forceinline__ KArgs kargs() { KArgs p = (KArgs)__builtin_amdgcn_kernarg_segment_ptr(); asm volatile("" : "+s"(p)); return p; }
#define WS_OPAQUE(a) unsigned char* wsb = (a).ws; asm volatile("" : "+s"(wsb))
#define otid() otid_(F.wv)
__device__ __forceinline__ int otid_(int wv) { unsigned m = ~0u; asm volatile("" : "+s"(m), "+s"(wv));
    return wv * 64 + (int)__builtin_amdgcn_mbcnt_hi(m, __builtin_amdgcn_mbcnt_lo(m, 0u)); }
struct Frame {
    LAS unsigned char* lds; volatile LAS unsigned* MISC; gu32* ctl;
    int vcu, G, wv;
};

template <class CM> __device__ __forceinline__ void transpose_item(const float* W, int ld, int K, bf16* WT, int n0, int k0, const CM& cm, LAS float* scr, int lane) {
    const int sc = cm(n0 + (lane & 31));
#pragma unroll 8
    for (int i = 0; i < 32; ++i) { const int kk = 2 * i + (lane >> 5); scr[kk * 33 + (lane & 31)] = sc >= 0 ? W[(size_t)(k0 + kk) * ld + sc] : 0.f; }
    LDS_WAIT(); asm volatile("" ::: "memory");
    const int c = lane & 7;
#pragma unroll
    for (int j = 0; j < 4; ++j) { const int n = (lane >> 3) + 8 * j; const LAS float* s = scr + (8 * c) * 33 + n;
        v4u o; o.x = pk2(s[0 * 33], s[1 * 33]); o.y = pk2(s[2 * 33], s[3 * 33]); o.z = pk2(s[4 * 33], s[5 * 33]); o.w = pk2(s[6 * 33], s[7 * 33]);
        *(GAS v4u*)(WT + (size_t)(n0 + n) * K + k0 + 8 * c) = o; }
    LDS_WAIT(); asm volatile("" ::: "memory");
}
struct CmWin { __device__ __forceinline__ int operator()(int n) const { return n < 3584 ? n : (n < 7168 ? n + 8 : (n < 7176 ? 3584 + (n - 7168) : -1)); } };
struct CmId { __device__ __forceinline__ int operator()(int n) const { return n; } };
struct CmGlu { __device__ __forceinline__ int operator()(int n) const { const int G = n >> 5, i = n & 31; return i < 16 ? 16 * G + i : 512 + 16 * G + (i - 16); } };

__device__ __forceinline__ void rms_row_to_bf16(const float* xrow, const float* g, bf16* orow, int lane) {
    const GAS f32x4* xr = (const GAS f32x4*)xrow + lane;
    f32x4 v[4]; float s2 = 0.f;
#pragma unroll
    for (int j = 0; j < 4; ++j) { v[j] = xr[64 * j]; s2 += (v[j].x * v[j].x + v[j].y * v[j].y) + (v[j].z * v[j].z + v[j].w * v[j].w); }
    const float r = __builtin_amdgcn_rsqf(wave_sum(s2) * (1.f / D_MODEL) + EPSF);
    const GAS f32x4* gr = (const GAS f32x4*)g + lane;
    GAS unsigned long long* o8 = (GAS unsigned long long*)orow + lane;
#pragma unroll
    for (int j = 0; j < 4; ++j) { const f32x4 gg = gr[64 * j];
        o8[64 * j] = (unsigned long long)pk2(v[j].x * r * gg.x, v[j].y * r * gg.y) | ((unsigned long long)pk2(v[j].z * r * gg.z, v[j].w * r * gg.w) << 32); }
}

__device__ __forceinline__ void p_norm(Frame& F, int l, int gi) {
    const KArgs ap = kargs(); const auto& a = *ap; WS_OPAQUE(a);
    const int tid = otid(), lane = tid & 63, wave = __builtin_amdgcn_readfirstlane(tid >> 6);
    const float* X = (const float*)(wsb + a.off[R_X]); bf16* XN = (bf16*)(wsb + a.off[R_XN]); const float* g = a.in[gi] + (size_t)l * D_MODEL;
    const int gw = F.vcu * NWAVES + wave, NGW = F.G * NWAVES;
    for (int m = gw; m < RP; m += NGW) rms_row_to_bf16(X + (size_t)m * D_MODEL, g, XN + (size_t)m * D_MODEL, lane);
}
__device__ __forceinline__ void unpack8(const v4u w, float (&f)[8]) { f[0] = bflo(w.x); f[1] = bfhi(w.x); f[2] = bflo(w.y); f[3] = bfhi(w.y); f[4] = bflo(w.z); f[5] = bfhi(w.z); f[6] = bflo(w.w); f[7] = bfhi(w.w); }
__device__ __forceinline__ v4u pack8(const float (&f)[8]) { v4u w; w.x = pk2(f[0], f[1]); w.y = pk2(f[2], f[3]); w.z = pk2(f[4], f[5]); w.w = pk2(f[6], f[7]); return w; }
__device__ __forceinline__ float sigm(float x) { return __builtin_amdgcn_rcpf(1.f + __expf(-x)); }
constexpr float ATT_C2 = 0.125f * 1.4426950408889634f;
__device__ __forceinline__ void p_zpost(Frame& F, int l) {
    const KArgs ap = kargs(); const auto& a = *ap; WS_OPAQUE(a);
    const bf16* Z = (const bf16*)(wsb + a.off[R_Z]);
    bf16* QN = (bf16*)(wsb + a.off[R_QN]); bf16* KN = (bf16*)(wsb + a.off[R_KN]); bf16* QKVB = (bf16*)(wsb + a.off[R_QKVB]); float* BG = (float*)(wsb + a.off[R_BG]);
    const int tid = otid(), lane = tid & 63, wave = __builtin_amdgcn_readfirstlane(tid >> 6);
    const int gw = F.vcu * NWAVES + wave, NGW = F.G * NWAVES;
    float gq[8], gk[8], cw[3][4][8];
#pragma unroll
    for (int j = 0; j < 8; ++j) { gq[j] = a.in[I_QN][l * HEAD_DIM_A + 8 * (lane & 7) + j] * ATT_C2; gk[j] = a.in[I_KN][l * HEAD_DIM_A + 8 * (lane & 7) + j]; }
#pragma unroll
    for (int w = 0; w < 3; ++w)
#pragma unroll
        for (int i = 0; i < 4; ++i)
#pragma unroll
            for (int j = 0; j < 8; ++j) cw[w][i][j] = a.in[I_CONVW][((size_t)l * CONV_W + i) * 3 * WIDTH_B + w * WIDTH_B + 8 * lane + j];
    float alog = 0.f, dtb = 0.f; if (lane < 4) { alog = a.in[I_ALOG][l * N_HEADS_B + lane]; dtb = a.in[I_DTB][l * N_HEADS_B + lane]; }
    for (int m = gw; m < RP; m += NGW) {
        const bool valid = prow_valid(m); const int nat = valid ? prow2nat(m) : 0;
        const bf16* zr = Z + (size_t)m * ZN;
        float f[8], o[8];
        unpack8(*(const GAS v4u*)(zr + ZC_QA + 8 * lane), f);
        { float ss = 0.f;
#pragma unroll
          for (int j = 0; j < 8; ++j) ss += f[j] * f[j];
          ss = sum8(ss);
          const float r = __builtin_amdgcn_rsqf(ss * (1.f / HEAD_DIM_A) + EPSF);
#pragma unroll
          for (int j = 0; j < 8; ++j) o[j] = f[j] * r * gq[j];
          *(GAS v4u*)(QN + (size_t)m * WIDTH_A + 8 * lane) = pack8(o); }
        unpack8(*(const GAS v4u*)(zr + ZC_KA + 8 * lane), f);
        { float ss = 0.f;
#pragma unroll
          for (int j = 0; j < 8; ++j) ss += f[j] * f[j];
          ss = sum8(ss);
          const float r = __builtin_amdgcn_rsqf(ss * (1.f / HEAD_DIM_A) + EPSF);
#pragma unroll
          for (int j = 0; j < 8; ++j) o[j] = f[j] * r * gk[j];
          *(GAS v4u*)(KN + (size_t)m * WIDTH_A + 8 * lane) = pack8(o);
          if (valid) { float* ko = nat < NP ? a.out + O_KP + ((size_t)l * NP + nat) * WIDTH_A : a.out + O_KS + ((size_t)l * NS + (nat - NP)) * WIDTH_A;
              *(GAS f32x4*)(ko + 8 * lane) = (f32x4){o[0], o[1], o[2], o[3]}; *(GAS f32x4*)(ko + 8 * lane + 4) = (f32x4){o[4], o[5], o[6], o[7]}; } }
        if (valid) { unpack8(*(const GAS v4u*)(zr + ZC_VA + 8 * lane), f);
            float* vo = nat < NP ? a.out + O_VP + ((size_t)l * NP + nat) * WIDTH_A : a.out + O_VS + ((size_t)l * NS + (nat - NP)) * WIDTH_A;
            *(GAS f32x4*)(vo + 8 * lane) = (f32x4){f[0], f[1], f[2], f[3]}; *(GAS f32x4*)(vo + 8 * lane + 4) = (f32x4){f[4], f[5], f[6], f[7]}; }
        const int ts = m >= SROW0 ? (m - SROW0) % DEC_SEQ : 1000; const int bs = m >= SROW0 ? (m - SROW0) / DEC_SEQ : 0;
        int cj = -1;
        if (m >= SROW0) { if (ts >= DEC_SEQ - 3) cj = ts - (DEC_SEQ - 3); } else { const int p = m % LPP; if (p >= PEND - 3 && p < PEND) cj = p - (PEND - 3); }
#pragma unroll
        for (int w = 0; w < 3; ++w) {
            float acc[8];
#pragma unroll
            for (int j = 0; j < 8; ++j) acc[j] = 0.f;
#pragma unroll
            for (int i = 0; i < 4; ++i) {
                const int dt = i - 3;
                if (ts + dt < 0) {
                    const float* sc = a.in[I_SCONV] + (((size_t)l * DEC_BATCH + bs) * (CONV_W - 1) + (CONV_W - 1 + ts + dt)) * 3 * WIDTH_B + w * WIDTH_B + 8 * lane;
                    const f32x4 s0 = *(const GAS f32x4*)sc, s1 = *(const GAS f32x4*)(sc + 4);
                    f[0] = s0.x; f[1] = s0.y; f[2] = s0.z; f[3] = s0.w; f[4] = s1.x; f[5] = s1.y; f[6] = s1.z; f[7] = s1.w;
                } else if (m + dt >= 0) unpack8(*(const GAS v4u*)(Z + (size_t)(m + dt) * ZN + ZC_QKVB + w * WIDTH_B + 8 * lane), f);
                else {
#pragma unroll
                    for (int j = 0; j < 8; ++j) f[j] = 0.f; }
#pragma unroll
                for (int j = 0; j < 8; ++j) acc[j] += f[j] * cw[w][i][j];
                if (i == 3 && cj >= 0) {
                    float* co = m >= SROW0 ? a.out + O_CS + (((size_t)l * DEC_BATCH + bs) * (CONV_W - 1) + cj) * 3 * WIDTH_B : a.out + O_CP + (((size_t)l * BATCH + m / LPP) * (CONV_W - 1) + cj) * 3 * WIDTH_B;
                    *(GAS f32x4*)(co + w * WIDTH_B + 8 * lane) = (f32x4){f[0], f[1], f[2], f[3]}; *(GAS f32x4*)(co + w * WIDTH_B + 8 * lane + 4) = (f32x4){f[4], f[5], f[6], f[7]}; }
            }
            float ss = 0.f;
#pragma unroll
            for (int j = 0; j < 8; ++j) { acc[j] = acc[j] * sigm(acc[j]); ss += acc[j] * acc[j]; }
            float sc = 1.f;
            if (w < 2) { ss = sum16(ss);
                sc = __builtin_amdgcn_rsqf(ss + EPSF); if (w == 0) sc *= 0.08838834764831845f; }
#pragma unroll
            for (int j = 0; j < 8; ++j) o[j] = acc[j] * sc;
            *(GAS v4u*)(QKVB + (size_t)m * 3 * WIDTH_B + w * WIDTH_B + 8 * lane) = pack8(o);
        }
        if (lane < 4) { const float be = bf2f(zr[ZC_BA + lane]), al = bf2f(zr[ZC_BA + 4 + lane]) + dtb;
            const float sp = al > 20.f ? al : __logf(1.f + __expf(al));
            BG[(size_t)m * 8 + lane] = valid ? sigm(be) : 0.f; BG[(size_t)m * 8 + 4 + lane] = valid ? -__expf(alog) * sp : 0.f; }
    }
}
constexpr float LOG2E = 1.4426950408889634f;
__device__ __forceinline__ int t5_bucket_dev(int rel) {
    const int n = rel < 0 ? -rel : rel; int b;
    if (n < 8) b = n; else if (n < 12) b = 8; else if (n < 16) b = 9; else if (n < 23) b = 10; else if (n < 32) b = 11;
    else if (n < 46) b = 12; else if (n < 64) b = 13; else if (n < 91) b = 14; else b = 15;
    return b + (rel > 0 ? 16 : 0);
}
__device__ __forceinline__ void build_bias_table(LAS float* tab, const float* rel_bias, int h, int tid) {
    const float far = rel_bias[15 * N_HEADS_A + h];
    for (int i = tid; i < attn_body::BT_N; i += NTHR) tab[i] = (rel_bias[t5_bucket_dev(i - attn_body::BT_OFF) * N_HEADS_A + h] - far) * LOG2E;
}
__device__ __forceinline__ float lam_init_dev(int l) { return 0.8f - 0.6f * __expf(-0.3f * (float)l); }
__device__ __forceinline__ float lam_dev(const float* lqk_all, int l, int lane) {
    const float* q = lqk_all + (size_t)l * 4 * HEAD_DIM_A;
    const float s0 = wave_sum(q[lane] * q[HEAD_DIM_A + lane]), s1 = wave_sum(q[2 * HEAD_DIM_A + lane] * q[3 * HEAD_DIM_A + lane]);
    return __expf(s0) - __expf(s1) + lam_init_dev(l);
}
__device__ __forceinline__ int krow_dev(int s, int h, int j) { return 16 * s + 8 * (j >> 2) + 4 * h + (j & 3); }
__device__ __forceinline__ int crow_dev(int r, int h) { return (r & 3) + 8 * (r >> 2) + 4 * h; }
__device__ __forceinline__ bf16x8 pack_f8(const f32x4 a, const f32x4 b) { v4u w; w.x = pk2(a.x, a.y); w.y = pk2(a.z, a.w); w.z = pk2(b.x, b.y); w.w = pk2(b.z, b.w); return __builtin_bit_cast(bf16x8, w); }

__device__ __forceinline__ void sample_scores(f32x16& X, int kb, int c, const float* ck, const bf16* KN, int row0, int h, int hi, int r32, int qpos, const bf16x8 (&qf)[4], const LAS float* tab) {
    bf16x8 kf[4];
    if (kb < PAST_LEN / 32) { const float* kr = ck + (size_t)(kb * 32 + r32) * WIDTH_A + h * 128 + c * 64 + 8 * hi;
#pragma unroll
        for (int s = 0; s < 4; ++s) kf[s] = pack_f8(*(const GAS f32x4*)(kr + 16 * s), *(const GAS f32x4*)(kr + 16 * s + 4)); }
    else { const bf16* kr = KN + (size_t)(row0 + (kb * 32 - PAST_LEN) + r32) * WIDTH_A + h * 128 + c * 64 + 8 * hi;
#pragma unroll
        for (int s = 0; s < 4; ++s) kf[s] = *(const GAS bf16x8*)(kr + 16 * s); }
#pragma unroll
    for (int i = 0; i < 16; ++i) X[i] = 0.f;
#pragma unroll
    for (int s = 0; s < 4; ++s) X = __builtin_amdgcn_mfma_f32_32x32x16_bf16(kf[s], qf[s], X, 0, 0, 0);
#pragma unroll
    for (int i = 0; i < 16; ++i) { int idx = kb * 32 + crow_dev(i, hi) - qpos + attn_body::BT_OFF; idx = idx < 0 ? 0 : idx; X[i] += tab[idx]; }
}

__device__ __forceinline__ void attn_sample_unit(Frame& F, int l, int bs, int h) {
    const KArgs ap = kargs(); const auto& a = *ap; WS_OPAQUE(a);
    const int tid = otid(), lane = tid & 63, wid = __builtin_amdgcn_readfirstlane(tid >> 6), r32 = lane & 31, hi = lane >> 5;
    const bf16* QN = (const bf16*)(wsb + a.off[R_QN]); const bf16* KN = (const bf16*)(wsb + a.off[R_KN]); const bf16* Z = (const bf16*)(wsb + a.off[R_Z]); bf16* O = (bf16*)(wsb + a.off[R_O]);
    const float* ck = a.in[I_CK] + ((size_t)l * DEC_BATCH + bs) * PAST_LEN * WIDTH_A; const float* cv = a.in[I_CV] + ((size_t)l * DEC_BATCH + bs) * PAST_LEN * WIDTH_A;
    const int row0 = SROW0 + bs * DEC_SEQ;
    LAS float* tab = (LAS float*)(F.lds + RING_OFF + attn_body::LDS_BT);
    LAS float* st = (LAS float*)(F.lds + RING_OFF + 90112);
    LAS float* slot = (LAS float*)(F.lds + RING_OFF);
    const float lam = lam_dev(a.in[I_LQK], l, lane);
    build_bias_table(tab, a.in[I_REL], h, tid);
    bf16x8 qf[2][4];
#pragma unroll
    for (int c = 0; c < 2; ++c)
#pragma unroll
        for (int s = 0; s < 4; ++s) qf[c][s] = *(const GAS bf16x8*)(QN + (size_t)(row0 + r32) * WIDTH_A + h * 128 + c * 64 + 16 * s + 8 * hi);
    __syncthreads();
    float m[2] = {-1e30f, -1e30f}, lsum[2] = {0.f, 0.f};
    const int qpos = PAST_LEN + r32;
    for (int kb = wid; kb < (PAST_LEN + DEC_SEQ) / 32; kb += NWAVES) {
#pragma unroll
        for (int c = 0; c < 2; ++c) { f32x16 X; sample_scores(X, kb, c, ck, KN, row0, h, hi, r32, qpos, qf[c], tab);
            float mx = X[0];
#pragma unroll
            for (int i = 1; i < 16; ++i) mx = fmaxf(mx, X[i]);
            mx = fmaxf(mx, swap32(mx)); const float mn = fmaxf(m[c], mx);
            float sum = 0.f;
#pragma unroll
            for (int i = 0; i < 16; ++i) sum += exp2f(X[i] - mn);
            lsum[c] = lsum[c] * exp2f(m[c] - mn) + sum; m[c] = mn; }
    }
#pragma unroll
    for (int c = 0; c < 2; ++c) { lsum[c] += swap32(lsum[c]); if (hi == 0) { st[((wid * 2 + c) * 2 + 0) * 32 + r32] = m[c]; st[((wid * 2 + c) * 2 + 1) * 32 + r32] = lsum[c]; } }
    __syncthreads();
    float gm[2], ginv[2];
#pragma unroll
    for (int c = 0; c < 2; ++c) { float mm = -1e30f;
#pragma unroll
        for (int w = 0; w < NWAVES; ++w) mm = fmaxf(mm, st[((w * 2 + c) * 2 + 0) * 32 + r32]);
        float ll = 0.f;
#pragma unroll
        for (int w = 0; w < NWAVES; ++w) ll += st[((w * 2 + c) * 2 + 1) * 32 + r32] * exp2f(st[((w * 2 + c) * 2 + 0) * 32 + r32] - mm);
        gm[c] = mm; ginv[c] = (c == 0 ? 1.f : lam) / ll; }
    f32x16 acc[4];
#pragma unroll
    for (int eb = 0; eb < 4; ++eb)
#pragma unroll
        for (int i = 0; i < 16; ++i) acc[eb][i] = 0.f;
    for (int kb = wid; kb < (PAST_LEN + DEC_SEQ) / 32; kb += NWAVES) {
        f32x16 X0, X1; sample_scores(X0, kb, 0, ck, KN, row0, h, hi, r32, qpos, qf[0], tab); sample_scores(X1, kb, 1, ck, KN, row0, h, hi, r32, qpos, qf[1], tab);
        float wv[16];
#pragma unroll
        for (int i = 0; i < 16; ++i) wv[i] = exp2f(X0[i] - gm[0]) * ginv[0] - exp2f(X1[i] - gm[1]) * ginv[1];
        bf16x8 xs[2];
#pragma unroll
        for (int s = 0; s < 2; ++s) { v4u w; w.x = pk2(wv[8 * s], wv[8 * s + 1]); w.y = pk2(wv[8 * s + 2], wv[8 * s + 3]); w.z = pk2(wv[8 * s + 4], wv[8 * s + 5]); w.w = pk2(wv[8 * s + 6], wv[8 * s + 7]); xs[s] = __builtin_bit_cast(bf16x8, w); }
#pragma unroll
        for (int eb = 0; eb < 4; ++eb)
#pragma unroll
            for (int s = 0; s < 2; ++s) {
                float vv[8];
                if (kb < PAST_LEN / 32) { const float* vb = cv + (size_t)(kb * 32 + 4 * hi) * WIDTH_A + h * 128 + eb * 32 + r32; asm volatile("" : "+v"(vb));
#pragma unroll
                    for (int j = 0; j < 8; ++j) vv[j] = vb[(size_t)(16 * s + 8 * (j >> 2) + (j & 3)) * WIDTH_A]; }
                else { const bf16* vb = Z + (size_t)(row0 + kb * 32 - PAST_LEN + 4 * hi) * ZN + ZC_VA + h * 128 + eb * 32 + r32; asm volatile("" : "+v"(vb));
#pragma unroll
                    for (int j = 0; j < 8; ++j) vv[j] = bf2f(vb[(size_t)(16 * s + 8 * (j >> 2) + (j & 3)) * ZN]); }
                v4u w; w.x = pk2(vv[0], vv[1]); w.y = pk2(vv[2], vv[3]); w.z = pk2(vv[4], vv[5]); w.w = pk2(vv[6], vv[7]);
                acc[eb] = __builtin_amdgcn_mfma_f32_32x32x16_bf16(xs[s], __builtin_bit_cast(bf16x8, w), acc[eb], 0, 0, 0);
            }
    }
    __syncthreads();
#pragma unroll
    for (int eb = 0; eb < 4; ++eb)
#pragma unroll
        for (int i = 0; i < 16; ++i) slot[(wid * 32 + crow_dev(i, hi)) * 128 + eb * 32 + r32] = acc[eb][i];
    __syncthreads();
    { const int q = tid >> 4, e0 = (tid & 15) * 8; float o[8];
#pragma unroll
      for (int j = 0; j < 8; ++j) o[j] = 0.f;
#pragma unroll
      for (int w = 0; w < NWAVES; ++w)
#pragma unroll
          for (int j = 0; j < 8; ++j) o[j] += slot[(w * 32 + q) * 128 + e0 + j];
      v4u pw; pw.x = pk2(o[0], o[1]); pw.y = pk2(o[2], o[3]); pw.z = pk2(o[4], o[5]); pw.w = pk2(o[6], o[7]);
      bf16* orow = O + (size_t)(row0 + q) * attn_body::OP + h * 256;
      unsigned zq = 0u; asm volatile("" : "+v"(zq));
      *(GAS v4u*)(orow + e0) = pw; *(GAS v4u*)(orow + 128 + e0) = (v4u){zq, zq, zq, zq}; }
    __syncthreads();
}

constexpr int ATT_NQB = LPP / 256;
constexpr int ATT_NPU = BATCH * 16 * ATT_NQB;
constexpr int ATT_NSU = DEC_BATCH * N_HEADS_A;
__device__ __forceinline__ void p_attention(Frame& F, int lq, unsigned char* ldsg) {
    const int l = lq % DEPTH;
    for (;;) {
        const KArgs ap = kargs(); const auto& a = *ap; WS_OPAQUE(a);
        const int tid = otid();
        gu32* head = (gu32*)wsb + CW_QUEUE + 64 * lq;
        const attn_body::bf16* QN = (const attn_body::bf16*)(wsb + a.off[R_QN]); const attn_body::bf16* KN = (const attn_body::bf16*)(wsb + a.off[R_KN]);
        const attn_body::bf16* Z = (const attn_body::bf16*)(wsb + a.off[R_Z]); attn_body::bf16* O = (attn_body::bf16*)(wsb + a.off[R_O]);
        if (tid == 0) F.MISC[16] = __hip_atomic_fetch_add(head, 1u, RLX_AGENT);
        __syncthreads();
        const int u = (int)F.MISC[16];
        __syncthreads();
        if (u >= ATT_NPU + ATT_NSU) break;
        if (u < ATT_NPU) {
            const int qb = (ATT_NQB - 1) - u / 32, bvh = u % 32, b = bvh >> 4, vh = bvh & 15, h = vh >> 2, c = (vh >> 1) & 1, half = vh & 1;
            build_bias_table((LAS float*)(F.lds + RING_OFF + attn_body::LDS_BT), a.in[I_REL], h, tid);
            __syncthreads();
            attn_body::attn_unit<8>(b, h * 128 + c * 64, ZC_VA + h * 128 + half * 64, h * 256 + c * 128 + half * 64, qb, QN, KN, Z, O, (char*)ldsg + RING_OFF, F.wv);
        } else { const int su = u - ATT_NPU; attn_sample_unit(F, l, su >> 2, su & 3); }
    }
}
__device__ __forceinline__ void p_mixpost_a(Frame& F, int l) {
    const KArgs ap = kargs(); const auto& a = *ap; WS_OPAQUE(a);
    const int tid = otid(), lane = tid & 63, wave = __builtin_amdgcn_readfirstlane(tid >> 6);
    const bf16* O = (const bf16*)(wsb + a.off[R_O]); bf16* OA = (bf16*)(wsb + a.off[R_OA]);
    const int gw = F.vcu * NWAVES + wave, NGW = F.G * NWAVES;
    const float lam = lam_dev(a.in[I_LQK], l, lane), post = 1.f - lam_init_dev(l);
    const int h = lane >> 4, e0 = 8 * (lane & 15);
    float sg[8];
#pragma unroll
    for (int j = 0; j < 8; ++j) sg[j] = a.in[I_SUBLN][l * 2 * HEAD_DIM_A + e0 + j] * post;
    for (int m = gw; m < RP; m += NGW) {
        float o0[8], o1[8], d[8];
        unpack8(*(const GAS v4u*)(O + (size_t)m * 1024 + h * 256 + e0), o0); unpack8(*(const GAS v4u*)(O + (size_t)m * 1024 + h * 256 + 128 + e0), o1);
        float ss = 0.f;
#pragma unroll
        for (int j = 0; j < 8; ++j) { d[j] = o0[j] - lam * o1[j]; ss += d[j] * d[j]; }
        ss = sum16(ss);
        const float r = __builtin_amdgcn_rsqf(ss * (1.f / 128.f) + EPSF);
#pragma unroll
        for (int j = 0; j < 8; ++j) d[j] = d[j] * r * sg[j];
        *(GAS v4u*)(OA + (size_t)m * WIDTH_A + h * 128 + e0) = pack8(d);
    }
}
constexpr int GDN_NCH = PEND / 64;
constexpr int GDN_NPI = BATCH * N_HEADS_B * GDN_NCH;
constexpr int GDN_NSI = DEC_BATCH * N_HEADS_B;
constexpr int GDN_NI = GDN_NPI + GDN_NSI;
constexpr int GI_W = 0, GI_QG = 16384, GI_KG = 32768, GI_AT = 49152, GI_U = 57344, GI_SC = 73728, GI_STRIDE = 73984;
static_assert(GDN_NI % 4 == 0 && PEND % 64 == 0, "gdn items");
__device__ __forceinline__ int frag_off(int row, int kk, int nkb) {
    const int fid = ((row >> 5) * nkb + (kk >> 5)) * 2 + ((kk & 31) >> 4), ln = (row & 31) + 32 * (((kk & 15) >> 2) & 1), j = ((kk & 15) >> 3) * 4 + (kk & 3);
    return (fid * 64 + ln) * 8 + j;
}
__device__ __forceinline__ int gdn_item_row(int item, int j) {
    if (item < GDN_NPI) { const int sh = item / GDN_NCH, n = item % GDN_NCH; return (sh / N_HEADS_B) * LPP + 64 * n + j; }
    const int s = item - GDN_NPI; return j < 32 ? -1 : SROW0 + (s >> 2) * DEC_SEQ + (j - 32);
}
__device__ __forceinline__ int gdn_item_head(int item) { return item < GDN_NPI ? (item / GDN_NCH) % N_HEADS_B : (item - GDN_NPI) & 3; }

__device__ __forceinline__ void gdn_flush(const LAS unsigned char* stg, unsigned char* dst, int nbytes, int gt) {
    for (int o = gt * 16; o < nbytes; o += 2048) *(GAS v4u*)(dst + o) = *(const LAS v4u*)(stg + o);
}
typedef float f32x2s __attribute__((ext_vector_type(2)));
#define GDN_RL8(a, arow, jb) asm volatile("v_readlane_b32 %0, %8, %9\n\tv_readlane_b32 %1, %8, %10\n\tv_readlane_b32 %2, %8, %11\n\tv_readlane_b32 %3, %8, %12\n\tv_readlane_b32 %4, %8, %13\n\tv_readlane_b32 %5, %8, %14\n\tv_readlane_b32 %6, %8, %15\n\tv_readlane_b32 %7, %8, %16" \
    : "=s"(a[0]), "=s"(a[1]), "=s"(a[2]), "=s"(a[3]), "=s"(a[4]), "=s"(a[5]), "=s"(a[6]), "=s"(a[7]) : "v"(arow), "i"(jb), "i"((jb) + 1), "i"((jb) + 2), "i"((jb) + 3), "i"((jb) + 4), "i"((jb) + 5), "i"((jb) + 6), "i"((jb) + 7))
template <int I, int JB> __device__ __forceinline__ void gdn_subst_blk(f32x2s (&x)[64], float arow) {
    if constexpr (JB < I) { float ar[8]; GDN_RL8(ar, arow, JB);
#pragma unroll
        for (int t = 0; t < 8; ++t) if (JB + t < I) x[I] -= ar[t] * x[JB + t];
        gdn_subst_blk<I, JB + 8>(x, arow); }
}
template <int... Is> __device__ __forceinline__ void gdn_subst_all(f32x2s (&x)[64], const LAS float* A, int lane, std::integer_sequence<int, Is...>) {
    (gdn_subst_blk<Is + 1, 0>(x, A[(Is + 1) * 64 + lane]), ...);
}
__device__ __forceinline__ void p_gdn_chunk(Frame& F, int l) {
    const KArgs ap = kargs(); const auto& a = *ap; WS_OPAQUE(a);
    const int tid = otid(), wave = __builtin_amdgcn_readfirstlane(tid >> 6), grp = wave >> 1, gw = wave & 1;
    const bf16* QKVB = (const bf16*)(wsb + a.off[R_QKVB]); const float* BG = (const float*)(wsb + a.off[R_BG]); unsigned char* GD = wsb + a.off[R_GDN];
    LAS float* A_lds = (LAS float*)(F.lds + RING_OFF + grp * 34816);
    LAS float* Gs = A_lds + 4096; LAS float* Bs = Gs + 64; LAS float* Es = Bs + 64;
    LAS unsigned char* stg = (LAS unsigned char*)(A_lds + 4096 + 256);
    LAS bf16* stgh = (LAS bf16*)stg;
    static_assert(4 * 34816 <= RING_BYTES && GDN_NI % 4 == 0, "gdn chunk LDS / items");
    for (int pr = F.vcu; 4 * pr < GDN_NI; pr += F.G) {
        int lane_ = otid() & 63;
        const int lane = lane_, r32 = lane & 31, hi = lane >> 5, gt = gw * 64 + lane;
        const int item = 4 * pr + grp, h = gdn_item_head(item);
        unsigned char* ib = GD + (size_t)item * GI_STRIDE;
        const int rowt = gdn_item_row(item, lane);
        const float beta = rowt >= 0 ? BG[(size_t)rowt * 8 + h] : 0.f; float G = rowt >= 0 ? BG[(size_t)rowt * 8 + 4 + h] : 0.f;
        G = scan64(G);
        const float Glast = rdlane(G, 63), eG = __expf(G);
        if (gw == 0) { Gs[lane] = G; Bs[lane] = beta; Es[lane] = eG; if (lane == 0) *(float*)(ib + GI_SC) = __expf(Glast); }
        __syncthreads();
#pragma unroll
        for (int bq = 0; bq < 2; ++bq) {
          const int i0 = 32 * gw, j0 = 32 * bq; const int j = j0 + r32;
          if (gw == 0 && bq == 1) {
#pragma unroll
              for (int r = 0; r < 16; ++r) { const int i = crow_dev(r, hi); A_lds[i * 64 + j] = 0.f; stgh[frag_off(i, j, 2)] = (bf16)0; }
          } else {
          const int ra = gdn_item_row(item, i0 + r32), rb = gdn_item_row(item, j0 + r32);
          f32x16 akk, aqk;
#pragma unroll
          for (int r = 0; r < 16; ++r) { akk[r] = 0.f; aqk[r] = 0.f; }
          const bf16x8 zf = {0, 0, 0, 0, 0, 0, 0, 0};
#pragma unroll
          for (int s = 0; s < 8; ++s) {
              const bf16x8 qa = ra >= 0 ? *(const GAS bf16x8*)(QKVB + (size_t)ra * 1536 + h * 128 + 16 * s + 8 * hi) : zf;
              const bf16x8 ka = ra >= 0 ? *(const GAS bf16x8*)(QKVB + (size_t)ra * 1536 + 512 + h * 128 + 16 * s + 8 * hi) : zf;
              const bf16x8 kb = rb >= 0 ? *(const GAS bf16x8*)(QKVB + (size_t)rb * 1536 + 512 + h * 128 + 16 * s + 8 * hi) : zf;
              akk = __builtin_amdgcn_mfma_f32_32x32x16_bf16(ka, kb, akk, 0, 0, 0); aqk = __builtin_amdgcn_mfma_f32_32x32x16_bf16(qa, kb, aqk, 0, 0, 0);
          }
          const float Gj = Gs[j];
#pragma unroll
          for (int r = 0; r < 16; ++r) { const int i = i0 + crow_dev(r, hi); const float dec = i >= j ? __expf(Gs[i] - Gj) : 0.f;
              A_lds[i * 64 + j] = i > j ? Bs[i] * akk[r] * dec : 0.f;
              stgh[frag_off(i, j, 2)] = (bf16)f2bf(aqk[r] * dec); }
          }
        }
        __syncthreads();
        gdn_flush(stg, ib + GI_AT, 8192, gt);
        { f32x2s x[64]; const int cbase = gw == 0 ? 1024 + h * 128 : 512 + h * 128;
#pragma unroll
          for (int i = 0; i < 64; ++i) { const int ri = __builtin_amdgcn_readfirstlane(gdn_item_row(item, i));
              const bf16* rowp = QKVB + (size_t)(ri < 0 ? 0 : ri) * 1536 + cbase;
              x[i] = ri >= 0 ? (f32x2s){bf2f(rowp[lane]), bf2f(rowp[lane + 64])} : (f32x2s){0.f, 0.f}; }
          const float rsc = gw == 0 ? beta : beta * eG;
#pragma unroll
          for (int i = 0; i < 64; ++i) x[i] *= rdlane(rsc, i);
          gdn_subst_all(x, A_lds, lane, std::make_integer_sequence<int, 63>{});
          __syncthreads();
          if (gw == 0) { bf16* ub = (bf16*)(ib + GI_U) + lane; asm volatile("" : "+v"(ub));
#pragma unroll
              for (int i = 0; i < 64; ++i) { ub[i * 128] = (bf16)f2bf(x[i].x); ub[i * 128 + 64] = (bf16)f2bf(x[i].y); } }
          else { LAS bf16* wb0 = stgh + frag_off(0, lane, 4); LAS bf16* wb1 = stgh + frag_off(0, lane + 64, 4);
#pragma unroll
              for (int i = 0; i < 64; ++i) { wb0[(i >> 5) * 4096 + (i & 31) * 8] = (bf16)f2bf(x[i].x); wb1[(i >> 5) * 4096 + (i & 31) * 8] = (bf16)f2bf(x[i].y); } }
        }
        __syncthreads();
        gdn_flush(stg, ib + GI_W, 16384, gt);
        __syncthreads();
        const float kgs = __expf(Glast - G);
#pragma unroll
        for (int hf = 0; hf < 2; ++hf) { float qv[32];
#pragma unroll
          for (int it = 0; it < 32; ++it) { const int c = it + 32 * hf, rc = __builtin_amdgcn_readfirstlane(gdn_item_row(item, c)); const bf16* rowp = QKVB + (size_t)(rc < 0 ? 0 : rc) * 1536 + h * 128; qv[it] = rc >= 0 ? bf2f(rowp[gt]) : 0.f; }
#pragma unroll
          for (int it = 0; it < 32; ++it) { const int c = it + 32 * hf; stgh[frag_off(c, gt, 4)] = (bf16)f2bf(qv[it] * rdlane(eG, c)); } }
        __syncthreads();
        gdn_flush(stg, ib + GI_QG, 16384, gt);
        __syncthreads();
#pragma unroll
        for (int hf = 0; hf < 2; ++hf) { float kv[32];
#pragma unroll
          for (int it = 0; it < 32; ++it) { const int c = it + 32 * hf, rc = __builtin_amdgcn_readfirstlane(gdn_item_row(item, c)); const bf16* rowp = QKVB + (size_t)(rc < 0 ? 0 : rc) * 1536 + 512 + h * 128; kv[it] = rc >= 0 ? bf2f(rowp[gt]) : 0.f; }
#pragma unroll
          for (int it = 0; it < 32; ++it) { const int c = it + 32 * hf; stgh[frag_off(gt, c, 2)] = (bf16)f2bf(kv[it] * rdlane(kgs, c)); } }
        __syncthreads();
        gdn_flush(stg, ib + GI_KG, 16384, gt);
        __syncthreads();
    }
}

__device__ __forceinline__ void gdn_chain(const unsigned char* GD, bf16* OB, const float* sdelta, float* dout, int item0, int nch, int h, int vb, int lane) {
    const int r32 = lane & 31, hi = lane >> 5;
    f32x16 S[4];
#pragma unroll
    for (int kb = 0; kb < 4; ++kb)
#pragma unroll
        for (int r = 0; r < 16; ++r) S[kb][r] = sdelta ? sdelta[(size_t)(kb * 32 + crow_dev(r, hi)) * HEAD_DIM_B + vb * 32 + r32] : 0.f;
    for (int n = 0; n < nch; ++n) {
        const int item = item0 + n; const unsigned char* ib = GD + (size_t)item * GI_STRIDE;
        const float eGl = *(const float*)(ib + GI_SC);
        const GAS bf16x8* WF = (const GAS bf16x8*)(ib + GI_W) + lane; const GAS bf16x8* QF = (const GAS bf16x8*)(ib + GI_QG) + lane;
        const GAS bf16x8* KF = (const GAS bf16x8*)(ib + GI_KG) + lane; const GAS bf16x8* AF = (const GAS bf16x8*)(ib + GI_AT) + lane; const bf16* U = (const bf16*)(ib + GI_U);
        bf16x8 Sp[4][2];
#pragma unroll
        for (int kb = 0; kb < 4; ++kb)
#pragma unroll
            for (int s = 0; s < 2; ++s) { v4u w; w.x = pk2(S[kb][8 * s], S[kb][8 * s + 1]); w.y = pk2(S[kb][8 * s + 2], S[kb][8 * s + 3]); w.z = pk2(S[kb][8 * s + 4], S[kb][8 * s + 5]); w.w = pk2(S[kb][8 * s + 6], S[kb][8 * s + 7]); Sp[kb][s] = __builtin_bit_cast(bf16x8, w); }
        f32x16 vn[2], ot[2];
#pragma unroll
        for (int cb = 0; cb < 2; ++cb) {
            f32x16 ws;
#pragma unroll
            for (int r = 0; r < 16; ++r) { ws[r] = 0.f; ot[cb][r] = 0.f; }
#pragma unroll
            for (int kb = 0; kb < 4; ++kb)
#pragma unroll
                for (int s = 0; s < 2; ++s) { ws = __builtin_amdgcn_mfma_f32_32x32x16_bf16(WF[((cb * 4 + kb) * 2 + s) * 64], Sp[kb][s], ws, 0, 0, 0);
                    ot[cb] = __builtin_amdgcn_mfma_f32_32x32x16_bf16(QF[((cb * 4 + kb) * 2 + s) * 64], Sp[kb][s], ot[cb], 0, 0, 0); }
#pragma unroll
            for (int r = 0; r < 16; ++r) vn[cb][r] = bf2f(U[(cb * 32 + crow_dev(r, hi)) * 128 + vb * 32 + r32]) - ws[r];
        }
        bf16x8 Vp[2][2];
#pragma unroll
        for (int cb = 0; cb < 2; ++cb)
#pragma unroll
            for (int s = 0; s < 2; ++s) { v4u w; w.x = pk2(vn[cb][8 * s], vn[cb][8 * s + 1]); w.y = pk2(vn[cb][8 * s + 2], vn[cb][8 * s + 3]); w.z = pk2(vn[cb][8 * s + 4], vn[cb][8 * s + 5]); w.w = pk2(vn[cb][8 * s + 6], vn[cb][8 * s + 7]); Vp[cb][s] = __builtin_bit_cast(bf16x8, w); }
#pragma unroll
        for (int cb = 0; cb < 2; ++cb)
#pragma unroll
            for (int c2 = 0; c2 <= cb; ++c2)
#pragma unroll
                for (int s = 0; s < 2; ++s) ot[cb] = __builtin_amdgcn_mfma_f32_32x32x16_bf16(AF[((cb * 2 + c2) * 2 + s) * 64], Vp[c2][s], ot[cb], 0, 0, 0);
#pragma unroll
        for (int cb = 0; cb < 2; ++cb)
#pragma unroll
            for (int r = 0; r < 16; ++r) { const int row = gdn_item_row(item, cb * 32 + crow_dev(r, hi)); if (row >= 0) OB[(size_t)row * WIDTH_B + h * 128 + vb * 32 + r32] = (bf16)f2bf(ot[cb][r]); }
#pragma unroll
        for (int kb = 0; kb < 4; ++kb) {
#pragma unroll
            for (int r = 0; r < 16; ++r) S[kb][r] *= eGl;
#pragma unroll
            for (int cb = 0; cb < 2; ++cb)
#pragma unroll
                for (int s = 0; s < 2; ++s) S[kb] = __builtin_amdgcn_mfma_f32_32x32x16_bf16(KF[((kb * 2 + cb) * 2 + s) * 64], Vp[cb][s], S[kb], 0, 0, 0);
        }
    }
#pragma unroll
    for (int kb = 0; kb < 4; ++kb)
#pragma unroll
        for (int r = 0; r < 16; ++r) dout[(size_t)(kb * 32 + crow_dev(r, hi)) * HEAD_DIM_B + vb * 32 + r32] = S[kb][r];
}
constexpr int GCH_BUF = 73728, GCH_PCS = 18;
#define GCH_BAR() do { asm volatile("s_waitcnt lgkmcnt(0)" ::: "memory"); __builtin_amdgcn_s_barrier(); asm volatile("" ::: "memory"); } while (0)
__device__ __forceinline__ void gdn_chain_wg(Frame& F, const unsigned char* GD, bf16* OB, float* dout, int item0, int h) {
    const int tid = otid(), lane = tid & 63, wave = __builtin_amdgcn_readfirstlane(tid >> 6), r32 = lane & 31, hi = lane >> 5, vb = wave & 3;
    LAS unsigned char* lb = F.lds + RING_OFF;
    if (wave >= 4) {
        const int p0 = (wave - 4) * GCH_PCS;
        v4u R0[GCH_PCS], R1[GCH_PCS];
#define GCH_LOAD(R, c) do { const unsigned char* s_ = GD + (size_t)(item0 + (c)) * GI_STRIDE + (size_t)p0 * 1024 + lane * 16; _Pragma("unroll") for (int j = 0; j < GCH_PCS; ++j) \
            asm volatile("global_load_dwordx4 %0, %1, off" : "=&v"(R[j]) : "v"(s_ + j * 1024) : "memory"); } while (0)
#define GCH_PUT(R, c) do { if ((c) + 1 < GDN_NCH) asm volatile("s_waitcnt vmcnt(18)" ::: "memory"); else asm volatile("s_waitcnt vmcnt(0)" ::: "memory"); \
            LAS v4u* d_ = (LAS v4u*)(lb + ((c) & 1) * GCH_BUF + p0 * 1024) + lane; _Pragma("unroll") for (int j = 0; j < GCH_PCS; ++j) d_[j * 64] = R[j]; } while (0)
        GCH_LOAD(R0, 0); GCH_LOAD(R1, 1);
        GCH_PUT(R0, 0); GCH_LOAD(R0, 2);
        GCH_BAR();
        for (int n = 0; n < GDN_NCH; n += 2) {
            if (n + 1 < GDN_NCH) GCH_PUT(R1, n + 1);
            if (n + 3 < GDN_NCH) GCH_LOAD(R1, n + 3);
            GCH_BAR();
            if (n + 1 < GDN_NCH) {
                if (n + 2 < GDN_NCH) GCH_PUT(R0, n + 2);
                if (n + 4 < GDN_NCH) GCH_LOAD(R0, n + 4);
                GCH_BAR(); }
        }
        asm volatile("s_waitcnt vmcnt(0)" ::: "memory");
#undef GCH_LOAD
#undef GCH_PUT
        return;
    }
    f32x16 S[4];
#pragma unroll
    for (int kb = 0; kb < 4; ++kb)
#pragma unroll
        for (int r = 0; r < 16; ++r) S[kb][r] = 0.f;
    float eg0 = *(const float*)(GD + (size_t)item0 * GI_STRIDE + GI_SC), eg1 = *(const float*)(GD + (size_t)(item0 + 1) * GI_STRIDE + GI_SC);
    GCH_BAR();
    for (int n = 0; n < GDN_NCH; ++n) {
        const int item = item0 + n; const LAS unsigned char* bufc = lb + (n & 1) * GCH_BUF;
        const float egl = eg0; eg0 = eg1; if (n + 2 < GDN_NCH) eg1 = *(const float*)(GD + (size_t)(item + 2) * GI_STRIDE + GI_SC);
        const LAS bf16x8* WF = (const LAS bf16x8*)(bufc + GI_W) + lane; const LAS bf16x8* QF = (const LAS bf16x8*)(bufc + GI_QG) + lane;
        const LAS bf16x8* KF = (const LAS bf16x8*)(bufc + GI_KG) + lane; const LAS bf16x8* AF = (const LAS bf16x8*)(bufc + GI_AT) + lane; const LAS bf16* U = (const LAS bf16*)(bufc + GI_U);
        bf16x8 Sp[4][2];
#pragma unroll
        for (int kb = 0; kb < 4; ++kb)
#pragma unroll
            for (int s = 0; s < 2; ++s) { v4u w; w.x = pk2(S[kb][8 * s], S[kb][8 * s + 1]); w.y = pk2(S[kb][8 * s + 2], S[kb][8 * s + 3]); w.z = pk2(S[kb][8 * s + 4], S[kb][8 * s + 5]); w.w = pk2(S[kb][8 * s + 6], S[kb][8 * s + 7]); Sp[kb][s] = __builtin_bit_cast(bf16x8, w); }
        f32x16 vn[2], ot[2];
#pragma unroll
        for (int cb = 0; cb < 2; ++cb) {
            f32x16 ws;
#pragma unroll
            for (int r = 0; r < 16; ++r) { ws[r] = 0.f; ot[cb][r] = 0.f; }
#pragma unroll
            for (int kb = 0; kb < 4; ++kb)
#pragma unroll
                for (int s = 0; s < 2; ++s) { ws = __builtin_amdgcn_mfma_f32_32x32x16_bf16(WF[((cb * 4 + kb) * 2 + s) * 64], Sp[kb][s], ws, 0, 0, 0);
                    ot[cb] = __builtin_amdgcn_mfma_f32_32x32x16_bf16(QF[((cb * 4 + kb) * 2 + s) * 64], Sp[kb][s], ot[cb], 0, 0, 0); }
#pragma unroll
            for (int r = 0; r < 16; ++r) vn[cb][r] = bf2f(U[(cb * 32 + crow_dev(r, hi)) * 128 + vb * 32 + r32]) - ws[r];
        }
        bf16x8 Vp[2][2];
#pragma unroll
        for (int cb = 0; cb < 2; ++cb)
#pragma unroll
            for (int s = 0; s < 2; ++s) { v4u w; w.x = pk2(vn[cb][8 * s], vn[cb][8 * s + 1]); w.y = pk2(vn[cb][8 * s + 2], vn[cb][8 * s + 3]); w.z = pk2(vn[cb][8 * s + 4], vn[cb][8 * s + 5]); w.w = pk2(vn[cb][8 * s + 6], vn[cb][8 * s + 7]); Vp[cb][s] = __builtin_bit_cast(bf16x8, w); }
#pragma unroll
        for (int cb = 0; cb < 2; ++cb)
#pragma unroll
            for (int c2 = 0; c2 <= cb; ++c2)
#pragma unroll
                for (int s = 0; s < 2; ++s) ot[cb] = __builtin_amdgcn_mfma_f32_32x32x16_bf16(AF[((cb * 2 + c2) * 2 + s) * 64], Vp[c2][s], ot[cb], 0, 0, 0);
        { const int row0 = gdn_item_row(item, 0);
#pragma unroll
          for (int cb = 0; cb < 2; ++cb)
#pragma unroll
              for (int r = 0; r < 16; ++r) OB[(size_t)(row0 + cb * 32 + crow_dev(r, hi)) * WIDTH_B + h * 128 + vb * 32 + r32] = (bf16)f2bf(ot[cb][r]); }
#pragma unroll
        for (int kb = 0; kb < 4; ++kb) {
#pragma unroll
            for (int r = 0; r < 16; ++r) S[kb][r] *= egl;
#pragma unroll
            for (int cb = 0; cb < 2; ++cb)
#pragma unroll
                for (int s = 0; s < 2; ++s) S[kb] = __builtin_amdgcn_mfma_f32_32x32x16_bf16(KF[((kb * 2 + cb) * 2 + s) * 64], Vp[cb][s], S[kb], 0, 0, 0);
        }
        GCH_BAR();
    }
#pragma unroll
    for (int kb = 0; kb < 4; ++kb)
#pragma unroll
        for (int r = 0; r < 16; ++r) dout[(size_t)(kb * 32 + crow_dev(r, hi)) * HEAD_DIM_B + vb * 32 + r32] = S[kb][r];
}
__device__ __forceinline__ void p_gdn_chain(Frame& F, int l) {
    const KArgs ap = kargs(); const auto& a = *ap; WS_OPAQUE(a);
    const unsigned char* GD = wsb + a.off[R_GDN]; bf16* OB = (bf16*)(wsb + a.off[R_OB]);
    if (F.vcu % 32 == 0 && F.vcu / 32 < BATCH * N_HEADS_B) { const int sh = F.vcu / 32, sq = sh / N_HEADS_B, h = sh % N_HEADS_B;
        gdn_chain_wg(F, GD, OB, a.out + O_DP + (((size_t)l * BATCH + sq) * N_HEADS_B + h) * HEAD_DIM_B * HEAD_DIM_B, sh * GDN_NCH, h); }
    else { const int tid = otid(), lane = tid & 63, wave = __builtin_amdgcn_readfirstlane(tid >> 6);
        const int t = (F.vcu - F.vcu / 32 - 1) * NWAVES + wave;
        if (t < GDN_NSI * 4) { const int s = t >> 2, vb = t & 3, bs = s >> 2, h = s & 3; const size_t so = (((size_t)l * DEC_BATCH + bs) * N_HEADS_B + h) * HEAD_DIM_B * HEAD_DIM_B;
            gdn_chain(GD, OB, a.in[I_SDELTA] + so, a.out + O_DS + so, GDN_NPI + s, 1, h, vb, lane); } }
}
__device__ __forceinline__ void p_mixpost_b(Frame& F, int l) {
    const KArgs ap = kargs(); const auto& a = *ap; WS_OPAQUE(a);
    const int tid = otid(), lane = tid & 63, wave = __builtin_amdgcn_readfirstlane(tid >> 6);
    const bf16* OB = (const bf16*)(wsb + a.off[R_OB]); bf16* OBN = (bf16*)(wsb + a.off[R_OBN]); const bf16* Z = (const bf16*)(wsb + a.off[R_Z]);
    const int gw = F.vcu * NWAVES + wave, NGW = F.G * NWAVES, e0 = 8 * (lane & 15);
    float gn[8];
#pragma unroll
    for (int j = 0; j < 8; ++j) gn[j] = a.in[I_GDNN][l * HEAD_DIM_B + e0 + j];
    for (int m = gw; m < RP; m += NGW) {
        float o[8], gt[8];
        unpack8(*(const GAS v4u*)(OB + (size_t)m * WIDTH_B + 8 * lane), o); unpack8(*(const GAS v4u*)(Z + (size_t)m * ZN + ZC_GB + 8 * lane), gt);
        float ss = 0.f;
#pragma unroll
        for (int j = 0; j < 8; ++j) ss += o[j] * o[j];
        ss = sum16(ss);
        const float r = __builtin_amdgcn_rsqf(ss * (1.f / 128.f) + EPSF);
#pragma unroll
        for (int j = 0; j < 8; ++j) o[j] = o[j] * r * gn[j] * gt[j] * sigm(gt[j]);
        *(GAS v4u*)(OBN + (size_t)m * WIDTH_B + 8 * lane) = pack8(o);
    }
}
constexpr int S5_M1 = 0, S5_M2 = 131072, S5_M3 = 196608, S5_L16 = 262144, S5_TSTRIDE = 262656;
constexpr int S5_NCHK = RP / 16;
constexpr int S5_NBLK = S5_NCHK / 32;
constexpr int S5_PCH = PEND / 16;
static_assert(S5_NCHK % 32 == 0 && LPP % 16 == 0 && PADF % 16 == 0 && S5_STATE == 64 && S5_GROUPS == 32, "s5 shapes");

__device__ __forceinline__ void s5_tables(Frame& F) {
    const KArgs ap = kargs(); const auto& a = *ap; WS_OPAQUE(a);
    const int tid = otid();
    LAS float* pw = (LAS float*)(F.lds + RING_OFF);
    LAS float* bb = pw + 17 * 128;
    LAS float* Kt = bb + 64 * 32;
    for (int it = F.vcu; it < DEPTH * S5_GROUPS; it += F.G) {
        const int l = it / S5_GROUPS, g = it % S5_GROUPS; const size_t gp = ((size_t)l * S5_GROUPS + g) * S5_STATE;
        unsigned char* tb = wsb + a.off[R_S5T] + (size_t)it * S5_TSTRIDE;
        const float dt = __expf(a.in[I_LDT][l * S5_GROUPS + g]);
        for (int e = tid; e < 17 * 64; e += NTHR) { const int k = e >> 6, p = e & 63; const float ar = a.in[I_AR][gp + p] * dt * (float)k, ai = a.in[I_AI][gp + p] * dt * (float)k;
            float sn, cs; sincosf(ai, &sn, &cs); const float er = expf(ar); pw[e * 2] = er * cs; pw[e * 2 + 1] = er * sn; }
        __syncthreads();
        for (int e = tid; e < 64 * 16; e += NTHR) { const int p = e >> 4; const float ar = a.in[I_AR][gp + p], ai = a.in[I_AI][gp + p];
            const float nr = pw[(64 + p) * 2] - 1.f, ni = pw[(64 + p) * 2 + 1], den = ar * ar + ai * ai, fr = (nr * ar + ni * ai) / den, fi = (ni * ar - nr * ai) / den;
            const float br = a.in[I_BR][gp * 16 + e], bi = a.in[I_BI][gp * 16 + e]; bb[e * 2] = fr * br - fi * bi; bb[e * 2 + 1] = fr * bi + fi * br; }
        if (tid < 128) { const int p = tid & 63; ((float*)(tb + S5_L16))[tid] = pw[(16 * 64 + p) * 2 + (tid >> 6)]; }
        __syncthreads();
        const float* cre = a.in[I_CR] + ((size_t)l * S5_GROUPS + g) * 16 * 64; const float* cim = a.in[I_CI] + ((size_t)l * S5_GROUPS + g) * 16 * 64;
        for (int e = tid; e < 4096; e += NTHR) { const int d = e >> 8, i = (e >> 4) & 15, j = e & 15; float acc = 0.f;
            for (int p = 0; p < 64; ++p) { const float cr = cre[i * 64 + p], ci = cim[i * 64 + p], pr = pw[(d * 64 + p) * 2], pi = pw[(d * 64 + p) * 2 + 1];
                const float tr = cr * pr - ci * pi, ti = cr * pi + ci * pr; acc += tr * bb[(p * 16 + j) * 2] - ti * bb[(p * 16 + j) * 2 + 1]; }
            Kt[e] = acc; }
        __syncthreads();
        bf16* M1 = (bf16*)(tb + S5_M1); bf16* M2 = (bf16*)(tb + S5_M2); bf16* M3 = (bf16*)(tb + S5_M3);
        for (int e = tid; e < 65536; e += NTHR) { const int n = e >> 8, k = e & 255, tau = n >> 4, i = n & 15, sg = k >> 4, j = k & 15;
            float v = 0.f; if (sg <= tau) { v = Kt[((tau - sg) * 16 + i) * 16 + j]; if (sg == tau && i == j) v += a.in[I_SD][(l * S5_GROUPS + g) * 16 + i]; }
            M1[e] = (bf16)f2bf(v); }
        for (int e = tid; e < 32768; e += NTHR) { const int n = e >> 8, k = e & 255, ri = n >> 6, p = n & 63, sg = k >> 4, j = k & 15;
            const float pr = pw[((15 - sg) * 64 + p) * 2], pi = pw[((15 - sg) * 64 + p) * 2 + 1], br = bb[(p * 16 + j) * 2], bi = bb[(p * 16 + j) * 2 + 1];
            M2[e] = (bf16)f2bf(ri == 0 ? pr * br - pi * bi : pr * bi + pi * br); }
        for (int e = tid; e < 32768; e += NTHR) { const int n = e >> 7, k = e & 127, tau = n >> 4, i = n & 15, ri = k >> 6, p = k & 63;
            const float cr = cre[i * 64 + p], ci = cim[i * 64 + p], pr = pw[((tau + 1) * 64 + p) * 2], pi = pw[((tau + 1) * 64 + p) * 2 + 1];
            M3[e] = (bf16)f2bf(ri == 0 ? cr * pr - ci * pi : -(cr * pi + ci * pr)); }
        __syncthreads();
    }
}
__device__ __forceinline__ void p_s5_e(Frame& F, int l) {
    const KArgs ap = kargs(); const auto& a = *ap; WS_OPAQUE(a);
    const int tid = otid(), lane = tid & 63, wave = __builtin_amdgcn_readfirstlane(tid >> 6), r32 = lane & 31, hi = lane >> 5;
    const bf16* Z = (const bf16*)(wsb + a.off[R_Z]); float* E = (float*)(wsb + a.off[R_S5E]);
    for (int u = F.vcu * NWAVES + wave; u < S5_NBLK * S5_GROUPS; u += F.G * NWAVES) {
        const int blk = u / S5_GROUPS, g = u % S5_GROUPS;
        const unsigned char* tb = wsb + a.off[R_S5T] + (size_t)(l * S5_GROUPS + g) * S5_TSTRIDE;
        const GAS bf16x8* M2 = (const GAS bf16x8*)(tb + S5_M2);
        const bf16* zr = Z + (size_t)((blk * 32 + r32) * 16) * ZN + ZC_UC + g * 16 + 8 * hi;
        f32x16 acc[4];
#pragma unroll
        for (int nb = 0; nb < 4; ++nb)
#pragma unroll
            for (int r = 0; r < 16; ++r) acc[nb][r] = 0.f;
#pragma unroll 4
        for (int sg = 0; sg < 16; ++sg) { const bf16x8 af = *(const GAS bf16x8*)(zr + (size_t)sg * ZN);
#pragma unroll
            for (int nb = 0; nb < 4; ++nb) acc[nb] = __builtin_amdgcn_mfma_f32_32x32x16_bf16(af, M2[((nb * 32 + r32) * 256 + sg * 16 + 8 * hi) >> 3], acc[nb], 0, 0, 0); }
#pragma unroll
        for (int nb = 0; nb < 4; ++nb)
#pragma unroll
            for (int r = 0; r < 16; ++r) E[((size_t)(blk * 32 + crow_dev(r, hi)) * S5_GROUPS + g) * 128 + nb * 32 + r32] = acc[nb][r];
    }
}
__device__ __forceinline__ void s5_scan_task(const float* E, bf16* XP, const float* l16, int g, int c0, int nch, float xr, float xi, float* ore, float* oim, int lane) {
    const float lr = l16[lane], li = l16[64 + lane];
    int c = 0;
    for (; c + 8 <= nch; c += 8) { float er[8], ei[8];
#pragma unroll
        for (int q = 0; q < 8; ++q) { const float* e = E + ((size_t)(c0 + c + q) * S5_GROUPS + g) * 128; er[q] = e[lane]; ei[q] = e[64 + lane]; }
#pragma unroll
        for (int q = 0; q < 8; ++q) { bf16* xp = XP + ((size_t)(c0 + c + q) * S5_GROUPS + g) * 128; xp[lane] = (bf16)f2bf(xr); xp[64 + lane] = (bf16)f2bf(xi);
            const float nr = lr * xr - li * xi + er[q], ni = lr * xi + li * xr + ei[q]; xr = nr; xi = ni; } }
    for (; c < nch; ++c) { const float* e = E + ((size_t)(c0 + c) * S5_GROUPS + g) * 128; bf16* xp = XP + ((size_t)(c0 + c) * S5_GROUPS + g) * 128; xp[lane] = (bf16)f2bf(xr); xp[64 + lane] = (bf16)f2bf(xi);
        const float nr = lr * xr - li * xi + e[lane], ni = lr * xi + li * xr + e[64 + lane]; xr = nr; xi = ni; }
    ore[lane] = xr; oim[lane] = xi;
}
constexpr int S5_NTASK = (BATCH + DEC_BATCH) * S5_GROUPS;
__device__ __forceinline__ void s5_scan_run(Frame& F, int l, int t, int lane) {
    const KArgs ap = kargs(); const auto& a = *ap; WS_OPAQUE(a);
    const int sq = t / S5_GROUPS, g = t % S5_GROUPS;
    const float* E = (const float*)(wsb + a.off[R_S5E]); bf16* XP = (bf16*)(wsb + a.off[R_S5X]);
    const float* l16 = (const float*)(wsb + a.off[R_S5T] + (size_t)(l * S5_GROUPS + g) * S5_TSTRIDE + S5_L16);
    if (sq < BATCH) { const size_t oo = (((size_t)l * BATCH + sq) * S5_GROUPS + g) * S5_STATE;
        s5_scan_task(E, XP, l16, g, sq * (LPP / 16), S5_PCH, 0.f, 0.f, a.out + O_SRP + oo, a.out + O_SIP + oo, lane); }
    else { const int bs = sq - BATCH; const size_t oo = (((size_t)l * DEC_BATCH + bs) * S5_GROUPS + g) * S5_STATE;
        s5_scan_task(E, XP, l16, g, SROW0 / 16 + bs * (DEC_SEQ / 16), DEC_SEQ / 16, a.in[I_SRE][oo + lane], a.in[I_SIM][oo + lane], a.out + O_SRS + oo, a.out + O_SIS + oo, lane); }
}
__device__ __forceinline__ float gelu_tanh(float x) { const float z = 0.7978845608028654f * (x + 0.044715f * x * x * x); const float t = 1.f - 2.f * __builtin_amdgcn_rcpf(__expf(2.f * z) + 1.f); return 0.5f * x * (1.f + t); }
__device__ __forceinline__ void p_s5_out(Frame& F, int l) {
    const KArgs ap = kargs(); const auto& a = *ap; WS_OPAQUE(a);
    const int tid = otid(), lane = tid & 63, wave = __builtin_amdgcn_readfirstlane(tid >> 6), r32 = lane & 31, hi = lane >> 5;
    const bf16* Z = (const bf16*)(wsb + a.off[R_Z]); const bf16* XP = (const bf16*)(wsb + a.off[R_S5X]); bf16* YC = (bf16*)(wsb + a.off[R_YC]);
    for (int u = F.vcu * NWAVES + wave; u < S5_NBLK * S5_GROUPS; u += F.G * NWAVES) {
        const int blk = u / S5_GROUPS, g = u % S5_GROUPS;
        const unsigned char* tb = wsb + a.off[R_S5T] + (size_t)(l * S5_GROUPS + g) * S5_TSTRIDE;
        const GAS bf16x8* M1 = (const GAS bf16x8*)(tb + S5_M1); const GAS bf16x8* M3 = (const GAS bf16x8*)(tb + S5_M3);
        const bf16* zr = Z + (size_t)((blk * 32 + r32) * 16) * ZN + ZC_UC + g * 16 + 8 * hi;
        const bf16* xr = XP + ((size_t)(blk * 32 + r32) * S5_GROUPS + g) * 128 + 8 * hi;
        f32x16 acc[8];
#pragma unroll
        for (int nb = 0; nb < 8; ++nb)
#pragma unroll
            for (int r = 0; r < 16; ++r) acc[nb][r] = 0.f;
#pragma unroll 2
        for (int sg = 0; sg < 16; ++sg) { const bf16x8 af = *(const GAS bf16x8*)(zr + (size_t)sg * ZN);
#pragma unroll
            for (int nb = 0; nb < 8; ++nb) acc[nb] = __builtin_amdgcn_mfma_f32_32x32x16_bf16(af, M1[((nb * 32 + r32) * 256 + sg * 16 + 8 * hi) >> 3], acc[nb], 0, 0, 0); }
#pragma unroll 2
        for (int s = 0; s < 8; ++s) { const bf16x8 af = *(const GAS bf16x8*)(xr + 16 * s);
#pragma unroll
            for (int nb = 0; nb < 8; ++nb) acc[nb] = __builtin_amdgcn_mfma_f32_32x32x16_bf16(af, M3[((nb * 32 + r32) * 128 + s * 16 + 8 * hi) >> 3], acc[nb], 0, 0, 0); }
#pragma unroll
        for (int nb = 0; nb < 8; ++nb)
#pragma unroll
            for (int r = 0; r < 16; ++r) { const int row = (blk * 32 + crow_dev(r, hi)) * 16 + 2 * nb + (r32 >> 4);
                YC[(size_t)row * WIDTH_C + g * 16 + (r32 & 15)] = (bf16)f2bf(gelu_tanh(acc[nb][r])); }
    }
}
__device__ __forceinline__ int rdlane_i(int v, int i) { return __builtin_amdgcn_readlane(v, i); }
constexpr float NEG_BIG = -3.0e38f;
__device__ __forceinline__ unsigned fkey(float v) { const unsigned u = __builtin_bit_cast(unsigned, v); return (u & 0x80000000u) ? ~u : (u | 0x80000000u); }
__device__ __forceinline__ int mbcnt64(unsigned long long m) { return __builtin_amdgcn_mbcnt_hi((unsigned)(m >> 32), __builtin_amdgcn_mbcnt_lo((unsigned)m, 0)); }
__device__ __forceinline__ void pro_wqs(Frame& F) {
    const KArgs ap = kargs(); const auto& a = *ap; WS_OPAQUE(a);
    const int tid = otid(), lane = tid & 63, wave = __builtin_amdgcn_readfirstlane(tid >> 6);
    bf16* WQ = (bf16*)(wsb + a.off[R_WQS]);
    for (int t = F.vcu * NWAVES + wave; t < DEPTH * 16 * 16; t += F.G * NWAVES) {
        const int l = t >> 8, hc = (t >> 4) & 15, kb = t & 15, k = kb * 64 + lane;
        const float* wr = a.in[I_PWQ] + ((size_t)l * D_MODEL + k) * PQ + hc * 128;
        float w[128];
#pragma unroll
        for (int d = 0; d < 128; d += 4) { const f32x4 v = *(const GAS f32x4*)(wr + d); w[d] = v.x; w[d + 1] = v.y; w[d + 2] = v.z; w[d + 3] = v.w; }
        const float* sk = a.in[I_PSK] + ((size_t)l * 16 + hc) * 128 * 128; const float g2k = a.in[I_N2][(size_t)l * D_MODEL + k];
        bf16* o = WQ + ((size_t)l * PQ + hc * 128) * D_MODEL + k;
#pragma clang loop vectorize(disable) unroll(disable)
        for (int n = 0; n < 128; ++n) { const float* sr = sk + n * 128; float acc = 0.f;
#pragma unroll
            for (int d = 0; d < 128; ++d) acc += w[d] * sr[d];
            o[(size_t)n * D_MODEL] = (bf16)f2bf(acc * g2k); }
    }
}
__device__ __forceinline__ void pro_wrest(Frame& F) {
    const KArgs ap = kargs(); const auto& a = *ap; WS_OPAQUE(a);
    const int tid = otid(), lane = tid & 63, wave = __builtin_amdgcn_readfirstlane(tid >> 6);
    LAS float* scr = (LAS float*)(F.lds + RING_OFF + wave * 16384);
    const int gw = F.vcu * NWAVES + wave, NGW = F.G * NWAVES;
    bf16* WG = (bf16*)(wsb + a.off[R_WGLU]); bf16* WB = (bf16*)(wsb + a.off[R_WBR]); bf16* WO = (bf16*)(wsb + a.off[R_WOUT]);
    constexpr int IG = (512 / 64) * (1024 / 32), IB = IG, IO = (1024 / 64) * (1024 / 32), IL = IG + 3 * IB + IO;
    for (int it = gw; it < DEPTH * IL; it += NGW) { const int l = it / IL; int r = it % IL;
        if (r < IG) { transpose_item(a.in[I_WGLU] + (size_t)l * 512 * 1024, 1024, 512, WG + (size_t)l * 1024 * 512, 32 * (r % 32), 64 * (r / 32), CmGlu(), scr, lane); continue; } r -= IG;
        if (r < 3 * IB) { const int w = r / IB, q = r % IB; transpose_item(a.in[I_WBA + w] + (size_t)l * 512 * 1024, 1024, 512, WB + ((size_t)l * 3 + w) * 1024 * 512, 32 * (q % 32), 64 * (q / 32), CmId(), scr, lane); continue; } r -= 3 * IB;
        transpose_item(a.in[I_WOUT] + (size_t)l * 1024 * 1024, 1024, 1024, WO + (size_t)l * 1024 * 1024, 32 * (r % 32), 64 * (r / 32), CmId(), scr, lane); }
}
typedef float f32x2v __attribute__((ext_vector_type(2)));
__device__ __forceinline__ unsigned pk_i8(const f32x4 x, float inv) {
    const int a = (int)rintf(x.x * inv), b = (int)rintf(x.y * inv), c = (int)rintf(x.z * inv), d = (int)rintf(x.w * inv);
    return (unsigned)(a & 0xff) | ((unsigned)(b & 0xff) << 8) | ((unsigned)(c & 0xff) << 16) | ((unsigned)(d & 0xff) << 24); }
constexpr size_t PEER_ROWS = (size_t)DEPTH * N_EXPERTS;
__device__ __forceinline__ void pro_peerw(Frame& F) {
    const KArgs ap = kargs(); const auto& a = *ap; WS_OPAQUE(a);
    const int tid = otid(), lane = tid & 63, wave = __builtin_amdgcn_readfirstlane(tid >> 6);
    float* SCL = (float*)(wsb + a.off[R_MISC]);
    for (size_t rw = (size_t)F.vcu * NWAVES + wave; rw < 2 * PEER_ROWS; rw += (size_t)F.G * NWAVES) {
        const int w = rw >= PEER_ROWS; const size_t row = rw - (w ? PEER_ROWS : 0);
        const GAS f32x4* src = (const GAS f32x4*)(a.in[I_PU + w] + row * D_MODEL) + 4 * lane;
        const f32x4 x0 = src[0], x1 = src[1], x2 = src[2], x3 = src[3];
        float mx = fmaxf(fmaxf(fmaxf(fabsf(x0.x), fabsf(x0.y)), fmaxf(fabsf(x0.z), fabsf(x0.w))), fmaxf(fmaxf(fabsf(x1.x), fabsf(x1.y)), fmaxf(fabsf(x1.z), fabsf(x1.w))));
        mx = fmaxf(mx, fmaxf(fmaxf(fmaxf(fabsf(x2.x), fabsf(x2.y)), fmaxf(fabsf(x2.z), fabsf(x2.w))), fmaxf(fmaxf(fabsf(x3.x), fabsf(x3.y)), fmaxf(fabsf(x3.z), fabsf(x3.w)))));
        mx = wave_max(mx);
        if (w == 0) {
            const float inv = mx > 0.f ? 127.f / mx : 0.f;
            v4u o; o.x = pk_i8(x0, inv); o.y = pk_i8(x1, inv); o.z = pk_i8(x2, inv); o.w = pk_i8(x3, inv);
            *((GAS v4u*)(wsb + a.off[R_PU] + row * D_MODEL) + lane) = o;
            if (lane == 0) SCL[rw] = mx * (1.f / 127.f);
            continue; }
        const float inv = mx > 0.f ? 416.f / mx : 0.f;
        v4u o; int t;
        t = __builtin_amdgcn_cvt_pk_fp8_f32(x0.x * inv, x0.y * inv, 0, false); t = __builtin_amdgcn_cvt_pk_fp8_f32(x0.z * inv, x0.w * inv, t, true); o.x = (unsigned)t;
        t = __builtin_amdgcn_cvt_pk_fp8_f32(x1.x * inv, x1.y * inv, 0, false); t = __builtin_amdgcn_cvt_pk_fp8_f32(x1.z * inv, x1.w * inv, t, true); o.y = (unsigned)t;
        t = __builtin_amdgcn_cvt_pk_fp8_f32(x2.x * inv, x2.y * inv, 0, false); t = __builtin_amdgcn_cvt_pk_fp8_f32(x2.z * inv, x2.w * inv, t, true); o.z = (unsigned)t;
        t = __builtin_amdgcn_cvt_pk_fp8_f32(x3.x * inv, x3.y * inv, 0, false); t = __builtin_amdgcn_cvt_pk_fp8_f32(x3.z * inv, x3.w * inv, t, true); o.w = (unsigned)t;
        *((GAS v4u*)(wsb + a.off[R_PU + w] + row * D_MODEL) + lane) = o;
        if (lane == 0) SCL[rw] = mx * (1.f / 416.f);
    }
}
__device__ __forceinline__ void fp8x16_to_f32(const v4u q, float (&f)[16]) {
#pragma unroll
    for (int d = 0; d < 4; ++d) { const int w = (int)(d == 0 ? q.x : d == 1 ? q.y : d == 2 ? q.z : q.w);
        const f32x2v lo = __builtin_amdgcn_cvt_pk_f32_fp8(w, false), hi = __builtin_amdgcn_cvt_pk_f32_fp8(w, true); f[4 * d] = lo.x; f[4 * d + 1] = lo.y; f[4 * d + 2] = hi.x; f[4 * d + 3] = hi.y; }
}
__device__ __forceinline__ void p_peer(Frame& F, int l, bool dry) {
    const KArgs ap = kargs(); const auto& a = *ap; WS_OPAQUE(a);
    const int tid = otid(), lane = tid & 63, wave = __builtin_amdgcn_readfirstlane(tid >> 6);
    const float* SC = (const float*)(wsb + a.off[R_SC]); const bf16* XN = (const bf16*)(wsb + a.off[R_XN]); float* X = (float*)(wsb + a.off[R_X]);
    const unsigned char* PU = wsb + a.off[R_PU] + (size_t)l * N_EXPERTS * D_MODEL; const unsigned char* PV = wsb + a.off[R_PV] + (size_t)l * N_EXPERTS * D_MODEL;
    const float* SCU = (const float*)(wsb + a.off[R_MISC]) + (size_t)l * N_EXPERTS; const float* SCV = SCU + PEER_ROWS;
    LAS float* stop = (LAS float*)(F.lds + RING_OFF + wave * 4096);
    LAS int* itop = (LAS int*)(stop + 256);
    LAS int* elist = itop + 256;
    LAS float* cf = (LAS float*)(elist + 128);
    for (int m = F.vcu * NWAVES + wave; m < RP; m += F.G * NWAVES) {
        if (!prow_valid(m)) continue;
        const float* sr = SC + (size_t)m * PQ;
        float hx[16], rs;
        { const GAS f32x4* xr0 = (const GAS f32x4*)(X + (size_t)m * D_MODEL + 16 * lane); const GAS f32x4* g4 = (const GAS f32x4*)(a.in[I_N2] + (size_t)l * D_MODEL + 16 * lane); float s2 = 0.f;
#pragma unroll
          for (int j = 0; j < 4; ++j) { const f32x4 xv = xr0[j], gv = g4[j]; s2 += (xv.x * xv.x + xv.y * xv.y) + (xv.z * xv.z + xv.w * xv.w); hx[4 * j] = xv.x * gv.x; hx[4 * j + 1] = xv.y * gv.y; hx[4 * j + 2] = xv.z * gv.z; hx[4 * j + 3] = xv.w * gv.w; }
          rs = __builtin_amdgcn_rsqf(wave_sum(s2) * (1.f / D_MODEL) + EPSF);
#pragma unroll
          for (int j = 0; j < 16; ++j) hx[j] *= rs; }
#ifndef MK_REP
#define MK_REP -1
#endif
        for (int rp12 = 0; rp12 < ((MK_REP) == 105 ? 2 : 1); ++rp12) {
        { unsigned k[32];
          { const GAS f32x4* p4 = (const GAS f32x4*)(sr + (lane >> 2) * 128 + (lane & 3) * 32);
#pragma unroll
            for (int j = 0; j < 8; ++j) { const f32x4 v = p4[j]; k[4 * j] = fkey(v.x); k[4 * j + 1] = fkey(v.y); k[4 * j + 2] = fkey(v.z); k[4 * j + 3] = fkey(v.w); } }
          unsigned p = 0u;
#pragma unroll
          for (int bit = 31; bit >= 0; --bit) { const unsigned t = p | (1u << bit); int c = 0;
#pragma unroll
              for (int j = 0; j < 32; ++j) c += k[j] >= t ? 1 : 0;
              c += dpp_i<0xB1>(c); c += dpp_i<0x4E>(c);
              p = c >= 16 ? t : p; }
          int cl = 0;
#pragma unroll
          for (int j = 0; j < 32; ++j) cl += k[j] >= p ? 1 : 0;
          const int q = lane & 3, c0 = dpp_i<0x00>(cl), c1 = dpp_i<0x55>(cl), c2 = dpp_i<0xAA>(cl);
          int pos = (q > 0 ? c0 : 0) + (q > 1 ? c1 : 0) + (q > 2 ? c2 : 0);
          const int sb = (lane >> 2) * 16;
#pragma unroll
          for (int j = 0; j < 32; ++j) { const bool sel = k[j] >= p;
              if (sel && pos < 16) { const unsigned u = (k[j] & 0x80000000u) ? (k[j] ^ 0x80000000u) : ~k[j]; stop[sb + pos] = __builtin_bit_cast(float, u); itop[sb + pos] = q * 32 + j; }
              pos += sel ? 1 : 0; }
        }
        LDS_WAIT();
        for (int h = 0; h < 8; ++h) {
            const float s1 = stop[(2 * h) * 16 + (lane >> 2)];
            float c[4]; unsigned kc[4];
#pragma unroll
            for (int j = 0; j < 4; ++j) { c[j] = s1 + stop[(2 * h + 1) * 16 + (lane & 3) * 4 + j]; kc[j] = fkey(c[j]); }
            unsigned pp = 0u;
            for (int bit = 31; bit >= 0; --bit) { const unsigned tt = pp | (1u << bit);
                const int cn = __builtin_popcountll(__ballot(kc[0] >= tt)) + __builtin_popcountll(__ballot(kc[1] >= tt)) + __builtin_popcountll(__ballot(kc[2] >= tt)) + __builtin_popcountll(__ballot(kc[3] >= tt));
                pp = cn >= 16 ? tt : pp; if (cn == 16) break; }
            const float cmax = wave_max(fmaxf(fmaxf(c[0], c[1]), fmaxf(c[2], c[3])));
            float esum = 0.f; int base = 0;
#pragma unroll
            for (int j = 0; j < 4; ++j) { const bool sel = kc[j] >= pp; const unsigned long long mk = __ballot(sel); const int rk = base + mbcnt64(mk); base += __builtin_popcountll(mk);
                const float ex = (sel && rk < 16) ? __expf(rs * (c[j] - cmax)) : 0.f; esum += ex;
                if (sel && rk < 16) { const int ci = lane * 4 + j; elist[h * 16 + rk] = itop[(2 * h) * 16 + (ci >> 4)] * N_KEYS + itop[(2 * h + 1) * 16 + (ci & 15)]; cf[h * 16 + rk] = ex; } }
            esum = wave_sum(esum); const float inv = __builtin_amdgcn_rcpf(esum);
            LDS_WAIT();
            if (lane < 16) cf[h * 16 + lane] *= inv;
        }
        LDS_WAIT();
        }
        for (int rp3 = 0; rp3 < ((MK_REP) == 106 ? 2 : 1); ++rp3) {
        float out[16];
#pragma unroll
        for (int j = 0; j < 16; ++j) out[j] = 0.f;
        float hmx = 0.f;
#pragma unroll
        for (int j = 0; j < 16; ++j) hmx = fmaxf(hmx, fabsf(hx[j]));
        hmx = wave_max(hmx); const float hinv = hmx > 0.f ? 127.f / hmx : 0.f, hsc = hmx * (1.f / 127.f);
        v4u hq; hq.x = pk_i8((f32x4){hx[0], hx[1], hx[2], hx[3]}, hinv); hq.y = pk_i8((f32x4){hx[4], hx[5], hx[6], hx[7]}, hinv); hq.z = pk_i8((f32x4){hx[8], hx[9], hx[10], hx[11]}, hinv); hq.w = pk_i8((f32x4){hx[12], hx[13], hx[14], hx[15]}, hinv);
        v4u uA[4], vA[4], uB[4], vB[4]; float suA, svA, cA, suB, svB, cB;
        const bool l60 = lane == 60, l61 = lane == 61, l62 = lane == 62;
#define PEER_LOAD(U, V, SU, SV, CW, q0) do { { const int em_ = elist[(q0) + (lane & 3)]; CW = cf[(q0) + (lane & 3)]; SU = SCU[em_]; SV = SCV[em_]; } _Pragma("unroll") for (int i = 0; i < 4; ++i) { const int e_ = elist[(q0) + i]; \
            U[i] = *((const GAS v4u*)(PU + (size_t)e_ * D_MODEL) + lane); V[i] = *((const GAS v4u*)(PV + (size_t)e_ * D_MODEL) + lane); } } while (0)
#define PEER_COMP(U, V, SU, SV, CW) do { float d_[4]; _Pragma("unroll") for (int i = 0; i < 4; ++i) { int di_ = __builtin_amdgcn_sdot4((int)U[i].x, (int)hq.x, 0, false); di_ = __builtin_amdgcn_sdot4((int)U[i].y, (int)hq.y, di_, false); \
            di_ = __builtin_amdgcn_sdot4((int)U[i].z, (int)hq.z, di_, false); di_ = __builtin_amdgcn_sdot4((int)U[i].w, (int)hq.w, di_, false); d_[i] = (float)di_; } \
            _Pragma("unroll") for (int i = 0; i < 4; ++i) d_[i] += dpp_f<0xB1>(d_[i]); _Pragma("unroll") for (int i = 0; i < 4; ++i) d_[i] += dpp_f<0x4E>(d_[i]); \
            _Pragma("unroll") for (int i = 0; i < 4; ++i) d_[i] += dpp_f<0x141>(d_[i]); _Pragma("unroll") for (int i = 0; i < 4; ++i) d_[i] += dpp_f<0x140>(d_[i]); \
            _Pragma("unroll") for (int i = 0; i < 4; ++i) d_[i] += dpp_fm<0x142, 0xA>(d_[i]); _Pragma("unroll") for (int i = 0; i < 4; ++i) d_[i] += dpp_fm<0x143, 0xC>(d_[i]);     \
            const float dsel_ = l60 ? d_[0] : l61 ? d_[1] : l62 ? d_[2] : d_[3];                                    \
            const float ccv_ = CW * gelu_tanh(dsel_ * hsc * SU) * SV; \
            _Pragma("unroll") for (int i = 0; i < 4; ++i) { const float cc = rdlane(ccv_, 60 + i); float t[16]; fp8x16_to_f32(V[i], t); _Pragma("unroll") for (int j = 0; j < 16; ++j) out[j] += cc * t[j]; } } while (0)
        PEER_LOAD(uA, vA, suA, svA, cA, 0);
        for (int q = 0; q < 128; q += 8) {
            PEER_LOAD(uB, vB, suB, svB, cB, q + 4);
            PEER_COMP(uA, vA, suA, svA, cA);
            if (q + 8 < 128) PEER_LOAD(uA, vA, suA, svA, cA, q + 8);
            PEER_COMP(uB, vB, suB, svB, cB);
        }
#undef PEER_LOAD
#undef PEER_COMP
        if (!dry && rp3 == ((MK_REP) == 106 ? 1 : 0)) { GAS f32x4* xr = (GAS f32x4*)(X + (size_t)m * D_MODEL + 16 * lane);
          f32x4 xv[4]; float s2 = 0.f;
#pragma unroll
          for (int j = 0; j < 4; ++j) { xv[j] = xr[j] + (f32x4){out[4 * j], out[4 * j + 1], out[4 * j + 2], out[4 * j + 3]}; s2 += (xv[j].x * xv[j].x + xv[j].y * xv[j].y) + (xv[j].z * xv[j].z + xv[j].w * xv[j].w); }
          const float rn = __builtin_amdgcn_rsqf(wave_sum(s2) * (1.f / D_MODEL) + EPSF);
          if (l + 1 < DEPTH) {
#pragma unroll
              for (int j = 0; j < 4; ++j) xr[j] = xv[j];
              const GAS f32x4* gr = (const GAS f32x4*)(a.in[I_N1] + (size_t)(l + 1) * D_MODEL + 16 * lane); float o16[16];
#pragma unroll
              for (int j = 0; j < 4; ++j) { const f32x4 gg = gr[j]; o16[4 * j] = xv[j].x * rn * gg.x; o16[4 * j + 1] = xv[j].y * rn * gg.y; o16[4 * j + 2] = xv[j].z * rn * gg.z; o16[4 * j + 3] = xv[j].w * rn * gg.w; }
              v4u w0, w1; w0.x = pk2(o16[0], o16[1]); w0.y = pk2(o16[2], o16[3]); w0.z = pk2(o16[4], o16[5]); w0.w = pk2(o16[6], o16[7]); w1.x = pk2(o16[8], o16[9]); w1.y = pk2(o16[10], o16[11]); w1.z = pk2(o16[12], o16[13]); w1.w = pk2(o16[14], o16[15]);
              GAS v4u* xo = (GAS v4u*)((bf16*)(wsb + a.off[R_XN]) + (size_t)m * D_MODEL + 16 * lane); xo[0] = w0; xo[1] = w1;
          } else {
              float* dst = nullptr;
              if (m >= SROW0) dst = a.out + O_YS + (size_t)(m - SROW0) * D_MODEL; else { const int b_ = m / LPP, p_ = m % LPP; if (p_ >= PADF + N_META) dst = a.out + O_YP + ((size_t)b_ * SEQ + (p_ - PADF - N_META)) * D_MODEL; }
              if (dst) { const GAS f32x4* gr = (const GAS f32x4*)(a.in[I_FN] + 16 * lane); GAS f32x4* o = (GAS f32x4*)(dst + 16 * lane);
#pragma unroll
                  for (int j = 0; j < 4; ++j) { const f32x4 gg = gr[j]; o[j] = (f32x4){xv[j].x * rn * gg.x, xv[j].y * rn * gg.y, xv[j].z * rn * gg.z, xv[j].w * rn * gg.w}; } }
          } }
        }
    }
}
__device__ __forceinline__ void p_final(Frame& F) {
    const KArgs ap = kargs(); const auto& a = *ap; WS_OPAQUE(a);
    const int tid = otid(), lane = tid & 63, wave = __builtin_amdgcn_readfirstlane(tid >> 6);
    const float* X = (const float*)(wsb + a.off[R_X]); const float* g = a.in[I_FN];
    for (int m = F.vcu * NWAVES + wave; m < RP; m += F.G * NWAVES) {
        float* dst;
        if (m >= SROW0) dst = a.out + O_YS + (size_t)(m - SROW0) * D_MODEL;
        else { const int b = m / LPP, p = m % LPP; if (p < PADF + N_META || p >= PEND) continue; dst = a.out + O_YP + ((size_t)b * SEQ + (p - PADF - N_META)) * D_MODEL; }
        const GAS f32x4* xr = (const GAS f32x4*)(X + (size_t)m * D_MODEL) + lane;
        f32x4 v[4]; float s2 = 0.f;
#pragma unroll
        for (int j = 0; j < 4; ++j) { v[j] = xr[64 * j]; s2 += (v[j].x * v[j].x + v[j].y * v[j].y) + (v[j].z * v[j].z + v[j].w * v[j].w); }
        const float r = __builtin_amdgcn_rsqf(wave_sum(s2) * (1.f / D_MODEL) + EPSF);
        const GAS f32x4* gr = (const GAS f32x4*)g + lane; GAS f32x4* o = (GAS f32x4*)dst + lane;
#pragma unroll
        for (int j = 0; j < 4; ++j) { const f32x4 gg = gr[64 * j]; o[64 * j] = (f32x4){v[j].x * r * gg.x, v[j].y * r * gg.y, v[j].z * r * gg.z, v[j].w * r * gg.w}; }
    }
}

__device__ __forceinline__ void p_prologue(Frame& F) {
    const KArgs ap = kargs(); const auto& a = *ap; WS_OPAQUE(a);
    const int tid = otid(), lane = tid & 63, wave = __builtin_amdgcn_readfirstlane(tid >> 6);
    LAS float* scr = (LAS float*)(F.lds + RING_OFF + wave * 16384);
    const int gw = F.vcu * NWAVES + wave, NGW = F.G * NWAVES;
    if (a.pro_mask & PM_X) {
        float* X = (float*)(wsb + a.off[R_X]);
        for (int m = gw; m < RP; m += NGW) {
            const float* src = nullptr;
            if (m >= SROW0) src = a.in[I_XS] + (size_t)(m - SROW0) * D_MODEL;
            else { const int b = m / LPP, p = m % LPP; if (p >= PADF && p < PEND) { const int pos = p - PADF; src = pos < N_META ? a.in[I_META] + (size_t)pos * D_MODEL : a.in[I_XP] + ((size_t)b * SEQ + pos - N_META) * D_MODEL; } }
            GAS f32x4* o = (GAS f32x4*)(X + (size_t)m * D_MODEL) + lane;
#pragma unroll
            for (int j = 0; j < 4; ++j) o[64 * j] = src ? ((const GAS f32x4*)src)[lane + 64 * j] : (f32x4){0.f, 0.f, 0.f, 0.f};
        }
    }
    if (a.pro_mask & PM_WIN) {
        bf16* WT = (bf16*)(wsb + a.off[R_WIN]);
        constexpr int IPL = (D_MODEL / 64) * (ZN / 32);
        for (int it = gw; it < DEPTH * IPL; it += NGW) { const int l = it / IPL, r = it % IPL, kb = r / (ZN / 32), nb = r % (ZN / 32);
            transpose_item(a.in[I_WIN] + (size_t)l * D_MODEL * D_IN, D_IN, D_MODEL, WT + (size_t)l * ZN * D_MODEL, 32 * nb, 64 * kb, CmWin(), scr, lane); }
    }
    __syncthreads();
    if (a.pro_mask & PM_TABLES) s5_tables(F);
    __syncthreads();
    if (a.pro_mask & PM_WREST) pro_wrest(F);
    if (a.pro_mask & PM_WQS) pro_wqs(F);
    if (a.pro_mask & PM_PEERW) pro_peerw(F);
}

__global__ void __launch_bounds__(NTHR, 2) mk_fwd(Args args) {
    extern __shared__ __attribute__((aligned(16))) unsigned char lds[];
    Frame F;
    F.lds = (LAS unsigned char*)lds; F.MISC = (volatile LAS unsigned*)(F.lds + MISC_OFF);
    F.wv = __builtin_amdgcn_readfirstlane((int)threadIdx.x >> 6);
    F.G = gridDim.x; { const int bx = blockIdx.x; F.vcu = (F.G % 8 == 0) ? (bx % 8) * (F.G / 8) + bx / 8 : bx; }
    F.ctl = (gu32*)args.ws;
    for (int u = F.wv * 64 + lane_id(); u < (LDS_BYTES - LDSCTL_OFF) / 4; u += NTHR) ((LAS unsigned*)(F.lds + LDSCTL_OFF))[u] = 0u;
    __syncthreads();
    const int lo = args.ph_lo, hi = args.ph_hi;
    unsigned* barw = (unsigned*)(F.ctl + CW_BAR) + (size_t)args.bar_region * XCD_BAR_WORDS;
    XcdBarrier bar; bar.bar = barw; bar.x = 0; bar.st = nullptr; bar.wv = F.wv;
    if (hi - lo > 1) bar = xcd_barrier_post(barw, F.MISC + 8, F.wv);
#define IN(k) (lo <= (k) && (k) < hi)
#ifndef MK_REP
#define MK_REP -1
#endif
#define SEAM(k) do { if ((k) + 1 < hi) { xcd_barrier(bar); if ((MK_REP) == 300) xcd_barrier(bar); } } while (0)
#ifndef MK_REP
#define MK_REP -1
#endif
    if (IN(PH_PRO)) { for (int rep_ = 0; rep_ < ((MK_REP) == 200 ? 2 : 1); ++rep_) { p_prologue(F); __syncthreads(); } SEAM(PH_PRO); }
#ifndef MK_REP
#define MK_REP -1
#endif
#define REPEAT(ph) for (int rep_ = 0; rep_ < ((MK_REP) == (ph) ? 2 : 1); ++rep_)
    for (int l = 0; l < DEPTH; ++l) {
        const int pb = 1 + l * NPL;
        if (l == 0 && IN(pb + PL_NORM1)) { REPEAT(PL_NORM1) p_norm(F, l, I_N1); SEAM(pb + PL_NORM1); }
        if (IN(pb + PL_GEMM_IN)) {
            const KArgs ap = kargs(); const auto& a = *ap; WS_OPAQUE(a);
            pg8::Gemm g{(const pg8::bf16_t*)(wsb + a.off[R_XN]), (const pg8::bf16_t*)(wsb + a.off[R_WIN]) + (size_t)l * ZN * D_MODEL, RP, ZN, D_MODEL};
            pg8::StaticOrder S; S.init(RP, ZN, F.G, (int)blockIdx.x);
            pg8::EpiBf16<0> E{(pg8::bf16_t*)(wsb + a.off[R_Z]), ZN, nullptr, 0, 0, 1.f};
            REPEAT(PL_GEMM_IN) pg8::gemm_phase<pg8::EpiBf16<0>, pg8::StaticOrder, true, true>(F.lds + RING_OFF, g, S, E, F.wv);
            SEAM(pb + PL_GEMM_IN);
        }
        if (IN(pb + PL_ZPOST)) { REPEAT(103) p_s5_e(F, l); REPEAT(PL_ZPOST) p_zpost(F, l);     SEAM(pb + PL_ZPOST); }
        if (IN(pb + PL_LOCAL)) { REPEAT(104) p_gdn_chunk(F, l); SEAM(pb + PL_LOCAL); }
        if (IN(pb + PL_MIX)) {
            REPEAT(100) p_gdn_chain(F, l);
            REPEAT(102) { const int tid = otid(), lane = tid & 63, wave = __builtin_amdgcn_readfirstlane(tid >> 6), NGW = F.G * NWAVES;
              for (int t = (F.vcu * NWAVES + wave + NGW - 256) % NGW; t < S5_NTASK; t += NGW) s5_scan_run(F, l, t, lane); }
            REPEAT(101) p_attention(F, l + DEPTH * rep_, lds);
            SEAM(pb + PL_MIX); }
        if (IN(pb + PL_MIXPOST)) { REPEAT(PL_MIXPOST) { p_mixpost_a(F, l); p_mixpost_b(F, l); p_s5_out(F, l); } SEAM(pb + PL_MIXPOST); }
        if (IN(pb + PL_GEMM_GLU)) REPEAT(PL_GEMM_GLU) {
            const KArgs ap = kargs(); const auto& a = *ap; WS_OPAQUE(a);
            { pg8::Gemm g{(const pg8::bf16_t*)(wsb + a.off[R_YC]), (const pg8::bf16_t*)(wsb + a.off[R_WGLU]) + (size_t)l * 1024 * 512, RP, 1024, 512};
              pg8::StaticOrder S; S.init(RP, 1024, F.G, (int)blockIdx.x); pg8::EpiGlu E{(pg8::bf16_t*)(wsb + a.off[R_OC]), WIDTH_C};
              pg8::gemm_phase<pg8::EpiGlu, pg8::StaticOrder, true, true>(F.lds + RING_OFF, g, S, E, F.wv); }
            { pg8::Gemm g{(const pg8::bf16_t*)(wsb + a.off[R_OA]), (const pg8::bf16_t*)(wsb + a.off[R_WBR]) + ((size_t)l * 3 + 0) * 1024 * 512, RP, 1024, 512};
              pg8::StaticOrder S; S.init(RP, 1024, F.G, (int)((blockIdx.x + 16) % F.G)); pg8::EpiMerge<0> E{(float*)(wsb + a.off[R_MRG]), nullptr, nullptr, (const pg8::bf16_t*)(wsb + a.off[R_Z]) + ZC_GATE, ZN};
              pg8::gemm_phase<pg8::EpiMerge<0>, pg8::StaticOrder, true, true>(F.lds + RING_OFF, g, S, E, F.wv); }
            { pg8::Gemm g{(const pg8::bf16_t*)(wsb + a.off[R_OBN]), (const pg8::bf16_t*)(wsb + a.off[R_WBR]) + ((size_t)l * 3 + 1) * 1024 * 512, RP, 1024, 512};
              pg8::StaticOrder S; S.init(RP, 1024, F.G, (int)((blockIdx.x + 32) % F.G)); pg8::EpiMerge<0> E{(float*)(wsb + a.off[R_MRG2]), nullptr, nullptr, (const pg8::bf16_t*)(wsb + a.off[R_Z]) + ZC_GATE + 1024, ZN};
              pg8::gemm_phase<pg8::EpiMerge<0>, pg8::StaticOrder, true, true>(F.lds + RING_OFF, g, S, E, F.wv); }
            if (rep_ == ((MK_REP) == PL_GEMM_GLU ? 1 : 0)) SEAM(pb + PL_GEMM_GLU); }
        if (IN(pb + PL_GEMM_BRC)) {
            const KArgs ap = kargs(); const auto& a = *ap; WS_OPAQUE(a);
            pg8::Gemm g{(const pg8::bf16_t*)(wsb + a.off[R_OC]), (const pg8::bf16_t*)(wsb + a.off[R_WBR]) + ((size_t)l * 3 + 2) * 1024 * 512, RP, 1024, 512};
            pg8::StaticOrder S; S.init(RP, 1024, F.G, (int)blockIdx.x); pg8::EpiMerge<2> E{(float*)(wsb + a.off[R_MRG]), (const float*)(wsb + a.off[R_MRG2]), (pg8::bf16_t*)(wsb + a.off[R_MRGB]), (const pg8::bf16_t*)(wsb + a.off[R_Z]) + ZC_GATE + 2048, ZN};
            REPEAT(PL_GEMM_BRC) pg8::gemm_phase<pg8::EpiMerge<2>, pg8::StaticOrder, true, true>(F.lds + RING_OFF, g, S, E, F.wv);
            SEAM(pb + PL_GEMM_BRC); }
        if (IN(pb + PL_GEMM_OUT)) {
            const KArgs ap = kargs(); const auto& a = *ap; WS_OPAQUE(a);
            pg8::Gemm g{(const pg8::bf16_t*)(wsb + a.off[R_MRGB]), (const pg8::bf16_t*)(wsb + a.off[R_WOUT]) + (size_t)l * 1024 * 1024, RP, 1024, 1024};
            pg8::StaticOrder S; S.init(RP, 1024, F.G, (int)blockIdx.x);
            REPEAT(PL_GEMM_OUT) { pg8::EpiResid E{(float*)(wsb + a.off[R_X]), D_MODEL, (MK_REP) == PL_GEMM_OUT && rep_ == 0, (pg8::bf16_t*)(wsb + a.off[R_XN])};
            pg8::gemm_phase<pg8::EpiResid, pg8::StaticOrder, true, true>(F.lds + RING_OFF, g, S, E, F.wv); }
            SEAM(pb + PL_GEMM_OUT); }
        if (IN(pb + PL_GEMM_PEER)) {
            const KArgs ap = kargs(); const auto& a = *ap; WS_OPAQUE(a);
            pg8::Gemm g{(const pg8::bf16_t*)(wsb + a.off[R_XN]), (const pg8::bf16_t*)(wsb + a.off[R_WQS]) + (size_t)l * PQ * D_MODEL, RP, PQ, D_MODEL};
            pg8::StaticOrder S; S.init(RP, PQ, F.G, (int)blockIdx.x); pg8::EpiF32 E{(float*)(wsb + a.off[R_SC]), PQ};
            REPEAT(PL_GEMM_PEER) pg8::gemm_phase<pg8::EpiF32, pg8::StaticOrder, true, true>(F.lds + RING_OFF, g, S, E, F.wv);
            SEAM(pb + PL_GEMM_PEER); }
        if (IN(pb + PL_PEER)) { REPEAT(PL_PEER) p_peer(F, l, (MK_REP) == PL_PEER && rep_ == 0); SEAM(pb + PL_PEER); }
    }
#undef IN
#undef SEAM
}
}
#ifndef MK_ONE_LAUNCH
#define MK_ONE_LAUNCH 1
#endif
static int mk_grid = 0;
static bool mk_setup() {
    if (mk_grid) return mk_grid > 0;
    int dev = 0, cus = 0;
    if (hipGetDevice(&dev) != hipSuccess || hipDeviceGetAttribute(&cus, hipDeviceAttributeMultiprocessorCount, dev) != hipSuccess) { mk_grid = -1; return false; }
    if (hipFuncSetAttribute((const void*)mk::mk_fwd, hipFuncAttributeMaxDynamicSharedMemorySize, mk::LDS_BYTES) != hipSuccess) { fprintf(stderr, "kernel_launch: hipFuncSetAttribute failed\n"); mk_grid = -1; return false; }
    int per_cu = 0;
    if (hipOccupancyMaxActiveBlocksPerMultiprocessor(&per_cu, (const void*)mk::mk_fwd, mk::NTHR, mk::LDS_BYTES) != hipSuccess || per_cu < 1) { fprintf(stderr, "kernel_launch: occupancy query says %d workgroups per CU\n", per_cu); }
    (void)hipGetLastError();
    mk_grid = cus;
    return true;
}
static void mk_launch(mk::Args a, int lo, int hi, int region, hipStream_t stream) {
    a.ph_lo = lo; a.ph_hi = hi; a.bar_region = region;
    hipLaunchKernelGGL(mk::mk_fwd, dim3(mk_grid), dim3(mk::NTHR), mk::LDS_BYTES, stream, a);
    hipError_t e = hipPeekAtLastError(); if (e != hipSuccess) fprintf(stderr, "kernel_launch: launch failed: %s\n", hipGetErrorName(e));
}
extern "C" void kernel_launch(void* const* d_in, const int* in_sizes, int n_in, void* d_out, int out_size, void* d_ws, size_t ws_size, hipStream_t stream) {
    if (n_in != N_INPUTS || (size_t)out_size != (size_t)O_END) { fprintf(stderr, "kernel_launch: unexpected n_in %d / out_size %d\n", n_in, out_size); return; }
    if (!mk_setup()) return;
    const size_t MiB = 1u << 20;
    unsigned char* ws = (unsigned char*)d_ws;
    mk::Args a{};
    for (int i = 0; i < N_INPUTS; ++i) a.in[i] = (const float*)d_in[i];
    a.out = (float*)d_out; a.ws = ws;
    { using namespace mk; const struct { int r; size_t mib; } map[] = { {R_WIN, 1}, {R_WGLU, 59}, {R_WBR, 63}, {R_WOUT, 75}, {R_WQS, 83}, {R_S5T, 99}, {R_PU, 132}, {R_PV, 196}, {R_MISC, 260}, {R_OBN, 262}, {R_MRG2, 280}, {R_X, 388}, {R_XN, 456},
        {R_Z, 490}, {R_SC, 490}, {R_QN, 737}, {R_KN, 754}, {R_QKVB, 771}, {R_BG, 822}, {R_O, 823}, {R_MRGB, 823}, {R_OA, 857}, {R_OB, 874}, {R_GDN, 891}, {R_MRG, 891},
        {R_S5E, 986}, {R_YC, 986}, {R_S5X, 1003}, {R_OC, 1012} };
      for (auto& e : map) a.off[e.r] = e.mib * MiB; }
    if (1029 * MiB > ws_size) { fprintf(stderr, "kernel_launch: workspace too small (%zu)\n", ws_size); return; }
    if (hipMemsetAsync(ws, 0, mk::CTL_BYTES, stream) != hipSuccess) { fprintf(stderr, "kernel_launch: memset failed\n"); return; }
    a.pro_mask = mk::PM_X | mk::PM_WIN | mk::PM_TABLES | mk::PM_WREST | mk::PM_WQS | mk::PM_PEERW;
#if MK_ONE_LAUNCH
    mk_launch(a, 0, mk::PH_END, 0, stream);
#else
    int region = 0;
    mk_launch(a, mk::PH_PRO, mk::PH_PRO + 1, region++, stream);
    for (int l = 0; l < DEPTH; ++l) { const int pb = 1 + l * mk::NPL;
        for (int ph = mk::PL_NORM1; ph <= mk::PL_PEER; ++ph) { if (ph == mk::PL_GEMM_BRA || ph == mk::PL_GEMM_BRB) continue; mk_launch(a, pb + ph, pb + ph + 1, region++, stream); } }
    mk_launch(a, mk::PH_FINAL, mk::PH_END, region++, stream);
#endif
}
```

```cpp
#include <hip/hip_runtime.h>
#include <cstdio>
#include <cstdint>
#include <utility>
#define MK_ONE_LAUNCH 1
#ifndef D_MODEL
#define D_MODEL 1024
#define BATCH 2
#define SEQ 8192
#define DEPTH 4
#define DEC_BATCH 16
#define DEC_SEQ 32
#define PAST_LEN 1024
#define N_HEADS_A 4
#define HEAD_DIM_A 64
#define N_HEADS_B 4
#define HEAD_DIM_B 128
#define S5_GROUPS 32
#define S5_STATE 64
#define PEER_HEADS 8
#define PEER_QDIM 256
#define N_KEYS 128
#endif
#define CHUNK 64
#define N_META 16
#define EPSF 1e-6f
#define NUM_BUCKETS 32
#define CONV_W 4
#define S5_GROUP 16
#define PEER_TOPK 16
#define N_EXPERTS (N_KEYS * N_KEYS)
#define WIDTH_A (N_HEADS_A * 2 * HEAD_DIM_A)
#define WIDTH_B (N_HEADS_B * HEAD_DIM_B)
#define WIDTH_C (S5_GROUPS * S5_GROUP)
#define OFF_QA 0
#define OFF_KA (OFF_QA + WIDTH_A)
#define OFF_VA (OFF_KA + WIDTH_A)
#define OFF_QKVB (OFF_VA + WIDTH_A)
#define OFF_GB (OFF_QKVB + 3 * WIDTH_B)
#define OFF_BETA (OFF_GB + WIDTH_B)
#define OFF_ALPHA (OFF_BETA + N_HEADS_B)
#define OFF_UC (OFF_ALPHA + N_HEADS_B)
#define OFF_GATE (OFF_UC + WIDTH_C)
#define D_IN (OFF_GATE + 3 * D_MODEL)
#define LP (N_META + SEQ)
#define NP (BATCH * LP)
#define NS (DEC_BATCH * DEC_SEQ)
#define NT (NP + NS)
#define PQ (PEER_HEADS * PEER_QDIM)

enum { I_XP, I_XS, I_CK, I_CV, I_SCONV, I_SDELTA, I_SRE, I_SIM, I_META, I_REL, I_N1, I_N2, I_FN, I_WIN, I_QN, I_KN, I_LQK, I_SUBLN, I_CONVW, I_ALOG, I_DTB, I_GDNN,
       I_AR, I_AI, I_BR, I_BI, I_CR, I_CI, I_SD, I_LDT, I_WGLU, I_WBA, I_WBB, I_WBC, I_WOUT, I_PWQ, I_PSK, I_PU, I_PV, N_INPUTS };
#define O_YP 0
#define O_YS (O_YP + (size_t)BATCH * SEQ * D_MODEL)
#define O_KP (O_YS + (size_t)NS * D_MODEL)
#define O_VP (O_KP + (size_t)DEPTH * NP * WIDTH_A)
#define O_KS (O_VP + (size_t)DEPTH * NP * WIDTH_A)
#define O_VS (O_KS + (size_t)DEPTH * NS * WIDTH_A)
#define O_CP (O_VS + (size_t)DEPTH * NS * WIDTH_A)
#define O_CS (O_CP + (size_t)DEPTH * BATCH * (CONV_W - 1) * 3 * WIDTH_B)
#define O_DP (O_CS + (size_t)DEPTH * DEC_BATCH * (CONV_W - 1) * 3 * WIDTH_B)
#define O_DS (O_DP + (size_t)DEPTH * BATCH * N_HEADS_B * HEAD_DIM_B * HEAD_DIM_B)
#define O_SRP (O_DS + (size_t)DEPTH * DEC_BATCH * N_HEADS_B * HEAD_DIM_B * HEAD_DIM_B)
#define O_SIP (O_SRP + (size_t)DEPTH * BATCH * S5_GROUPS * S5_STATE)
#define O_SRS (O_SIP + (size_t)DEPTH * BATCH * S5_GROUPS * S5_STATE)
#define O_SIS (O_SRS + (size_t)DEPTH * DEC_BATCH * S5_GROUPS * S5_STATE)
#define O_END (O_SIS + (size_t)DEPTH * DEC_BATCH * S5_GROUPS * S5_STATE)

namespace pg8 {
#define PG8_LAS __attribute__((address_space(3)))
typedef unsigned short bf16_t;
typedef short bf16x8 __attribute__((ext_vector_type(8)));
typedef float f32x4 __attribute__((ext_vector_type(4)));
typedef unsigned u32x4 __attribute__((ext_vector_type(4)));
constexpr int BM = 256, BK = 64, HALF = 128, HTB = HALF * BK * 2  , STAGE_BYTES = 8 * HTB, NXCD = 8, WGM = 8;

__host__ __device__ __forceinline__ int lds_byte(int r, int c) { const int st = (r >> 4) * 2 + (c >> 5), rr = r & 15, cc = c & 31, ob = rr * 64 + cc * 2; return st * 1024 + (ob ^ (((ob >> 9) & 1) << 5)); }
__host__ __device__ __forceinline__ void stage_rc(int b, int& R, int& C) { const int st = b / 1024, sb = b % 1024, swz = sb ^ (((sb >> 9) & 1) << 5); R = (st >> 1) * 16 + swz / 64; C = (st & 1) * 32 + (swz % 64) / 2; }
__host__ __device__ __forceinline__ int perm32(int rho) { const int n = rho >> 4, i = rho & 15; return 8 * (i >> 2) + 4 * n + (i & 3); }

struct Unit { int pm, pn; };
struct Gemm { const bf16_t* A; const bf16_t* Bt; int M, N, K; };

struct StaticOrder {
    int nM, nN, nwg, G, c;
    __host__ __device__ void init(int M, int N, int G_, int c_) { nM = M / BM; nN = N / BM; nwg = nM * nN; G = G_; c = c_; }
    __host__ __device__ bool next(int i, Unit& u) const {
        const long L = (long)i * G + c; if (L >= nwg) return false;
        int wgid = (int)L; { const int q = nwg / NXCD, r = nwg % NXCD, xcd = wgid % NXCD, off = wgid / NXCD; wgid = (xcd < r ? xcd * (q + 1) : r * (q + 1) + (xcd - r) * q) + off; }
        const int nig = WGM * nN, gid = wgid / nig, fm = gid * WGM, gsz = (nM - fm) < WGM ? (nM - fm) : WGM;
        u.pm = fm + ((wgid % nig) % gsz); u.pn = (wgid % nig) / gsz; return true;
    }
    __device__ __forceinline__ void a_ready(const Unit&) const {}
    __device__ __forceinline__ void done(const Unit&) const {}
};

__device__ __forceinline__ unsigned cvt_pk_bf16(float lo, float hi) { unsigned r; asm volatile("v_cvt_pk_bf16_f32 %0, %1, %2" : "=v"(r) : "v"(lo), "v"(hi)); return r; }
typedef float f32x2 __attribute__((ext_vector_type(2)));
__device__ __forceinline__ f32x2 gelu_pk(f32x2 v) {
    const f32x2 av = __builtin_elementwise_abs(v), d = av * 0.2316418882f + 1.0f;
    f32x2 t; t.x = __builtin_amdgcn_rcpf(d.x); t.y = __builtin_amdgcn_rcpf(d.y);
    f32x2 q = t * 0.5307027145f + (-0.7265760135f); q = q * t + 0.7107068705f; q = q * t + (-0.142248368f); q = q * t + 0.127414796f; q = q * t;
    const f32x2 s = (v * v) * (-0.72134752044f);
    f32x2 e; e.x = __builtin_amdgcn_exp2f(s.x); e.y = __builtin_amdgcn_exp2f(s.y);
    const f32x2 m = v * (q * e), r = v - m;
    f32x2 o; o.x = v.x < 0.f ? m.x : r.x; o.y = v.y < 0.f ? m.y : r.y; return o;
}

template <int ACT  > struct EpiBf16 {
    static constexpr bool PERM = true, AFTER_DRAIN = false; static_assert(ACT == 0 || ACT == 1, "EpiBf16: ACT is 0 (none) or 1 (gelu_pk)");
    bf16_t* O; int ldc; const float* bias; int split_cols; size_t split_stride; float scale0;
    __device__ __forceinline__ void operator()(const f32x4 (&acc)[2][2][4][2], const Unit& u, int wr, int wc, int fr, int fq) const {
        const int row0 = u.pm * BM + wr * 64 + fr; int colt = u.pn * BM; bf16_t* base = O;
        float sc = 1.f; if (split_cols) { const int t = colt / split_cols; base += (size_t)t * split_stride; colt -= t * split_cols; if (t == 0) sc = scale0; }
        const int col0 = colt + wc * 32 + 8 * fq, bcol0 = u.pn * BM + wc * 32 + 8 * fq;
        f32x4 bv[2][2];
#pragma unroll
        for (int bj = 0; bj < 2; ++bj)
#pragma unroll
            for (int n = 0; n < 2; ++n) bv[bj][n] = bias ? *(const f32x4*)(bias + bcol0 + bj * HALF + 4 * n) : (f32x4){0.f, 0.f, 0.f, 0.f};
#pragma unroll
        for (int ai = 0; ai < 2; ++ai)
#pragma unroll
            for (int m = 0; m < 4; ++m) { bf16_t* rowp = base + (size_t)(row0 + ai * HALF + m * 16) * ldc + col0;
#pragma unroll
                for (int bj = 0; bj < 2; ++bj) { f32x4 v0 = acc[ai][bj][m][0] + bv[bj][0], v1 = acc[ai][bj][m][1] + bv[bj][1];
                    if (ACT == 1) { f32x2 a = gelu_pk((f32x2){v0[0], v0[1]}), b = gelu_pk((f32x2){v0[2], v0[3]}), c = gelu_pk((f32x2){v1[0], v1[1]}), d = gelu_pk((f32x2){v1[2], v1[3]});
                        v0 = (f32x4){a.x, a.y, b.x, b.y}; v1 = (f32x4){c.x, c.y, d.x, d.y}; }
                    v0 = v0 * sc; v1 = v1 * sc; u32x4 w; w.x = cvt_pk_bf16(v0[0], v0[1]); w.y = cvt_pk_bf16(v0[2], v0[3]); w.z = cvt_pk_bf16(v1[0], v1[1]); w.w = cvt_pk_bf16(v1[2], v1[3]);
                    *(u32x4*)(rowp + bj * HALF) = w; } }
    }
};

__device__ __forceinline__ float epi_sigm(float x) { return __builtin_amdgcn_rcpf(1.f + __expf(-x)); }
struct EpiGlu {
    static constexpr bool PERM = false, AFTER_DRAIN = false;
    bf16_t* O; int ldo;
    __device__ __forceinline__ void operator()(const f32x4 (&acc)[2][2][4][2], const Unit& u, int wr, int wc, int fr, int fq) const {
        const int row0 = u.pm * BM + wr * 64 + fr;
#pragma unroll
        for (int ai = 0; ai < 2; ++ai)
#pragma unroll
            for (int m = 0; m < 4; ++m) { bf16_t* rowp = O + (size_t)(row0 + ai * HALF + m * 16) * ldo + 4 * fq;
#pragma unroll
                for (int bj = 0; bj < 2; ++bj) { const int G = u.pn * 8 + bj * 4 + wc; const f32x4 av = acc[ai][bj][m][0], gv = acc[ai][bj][m][1];
                    typedef unsigned u32x2 __attribute__((ext_vector_type(2))); u32x2 w;
                    w.x = cvt_pk_bf16(av[0] * epi_sigm(gv[0]), av[1] * epi_sigm(gv[1])); w.y = cvt_pk_bf16(av[2] * epi_sigm(gv[2]), av[3] * epi_sigm(gv[3]));
                    *(u32x2*)(rowp + 16 * G) = w; } }
    }
};
template <int MODE> struct EpiMerge {
    static constexpr bool PERM = true, AFTER_DRAIN = false;
    float* M; const float* M2; bf16_t* Mb; const bf16_t* Zg; int ldz;
    __device__ __forceinline__ void operator()(const f32x4 (&acc)[2][2][4][2], const Unit& u, int wr, int wc, int fr, int fq) const {
        const int row0 = u.pm * BM + wr * 64 + fr, col0 = u.pn * BM + wc * 32 + 8 * fq;
#pragma unroll
        for (int ai = 0; ai < 2; ++ai)
#pragma unroll
            for (int m = 0; m < 4; ++m) { const size_t row = (size_t)(row0 + ai * HALF + m * 16);
#pragma unroll
                for (int bj = 0; bj < 2; ++bj) { const int col = col0 + bj * HALF;
                    const u32x4 gz = *(const u32x4*)(Zg + row * ldz + col);
                    float g[8]; g[0] = __builtin_bit_cast(float, gz.x << 16); g[1] = __builtin_bit_cast(float, gz.x & 0xffff0000u); g[2] = __builtin_bit_cast(float, gz.y << 16); g[3] = __builtin_bit_cast(float, gz.y & 0xffff0000u);
                    g[4] = __builtin_bit_cast(float, gz.z << 16); g[5] = __builtin_bit_cast(float, gz.z & 0xffff0000u); g[6] = __builtin_bit_cast(float, gz.w << 16); g[7] = __builtin_bit_cast(float, gz.w & 0xffff0000u);
                    f32x4 v0 = acc[ai][bj][m][0], v1 = acc[ai][bj][m][1];
#pragma unroll
                    for (int j = 0; j < 4; ++j) { v0[j] *= epi_sigm(g[j]); v1[j] *= epi_sigm(g[4 + j]); }
                    if (MODE == 0) { float* mp = M + row * 1024 + col; *(f32x4*)mp = v0; *(f32x4*)(mp + 4) = v1; }
                    else { const float* mp = M + row * 1024 + col; const float* mq = M2 + row * 1024 + col;
                        v0 += *(const f32x4*)mp + *(const f32x4*)mq; v1 += *(const f32x4*)(mp + 4) + *(const f32x4*)(mq + 4);
                        u32x4 w; w.x = cvt_pk_bf16(v0[0], v0[1]); w.y = cvt_pk_bf16(v0[2], v0[3]); w.z = cvt_pk_bf16(v1[0], v1[1]); w.w = cvt_pk_bf16(v1[2], v1[3]); *(u32x4*)(Mb + row * 1024 + col) = w; } } }
    }
};
struct EpiResid {
    static constexpr bool PERM = false, AFTER_DRAIN = false;
    float* X; int ldx; bool dry; bf16_t* Xb;
    __device__ __forceinline__ void operator()(const f32x4 (&acc)[2][2][4][2], const Unit& u, int wr, int wc, int fr, int fq) const {
        const int row0 = u.pm * BM + wr * 64 + fr, col0 = u.pn * BM + wc * 32 + 4 * fq;
#pragma unroll
        for (int ai = 0; ai < 2; ++ai)
#pragma unroll
            for (int m = 0; m < 4; ++m) { const int row = row0 + ai * HALF + m * 16;
                bool ok = true; if (row < 16896) { const int p = row % 8448; ok = p >= 48 && p < 8256; }
                if (ok && !dry) { float* rowp = X + (size_t)row * ldx + col0;
#pragma unroll
                    for (int bj = 0; bj < 2; ++bj)
#pragma unroll
                        for (int n = 0; n < 2; ++n) { f32x4* p4 = (f32x4*)(rowp + bj * HALF + n * 16); const f32x4 v = *p4 + acc[ai][bj][m][n]; *p4 = v;
                            typedef unsigned u32x2 __attribute__((ext_vector_type(2))); u32x2 w; w.x = cvt_pk_bf16(v[0], v[1]); w.y = cvt_pk_bf16(v[2], v[3]);
                            *(u32x2*)(Xb + (size_t)row * ldx + col0 + bj * HALF + n * 16) = w; } } }
    }
};
struct EpiF32 {
    static constexpr bool PERM = false, AFTER_DRAIN = false;
    float* C; int ldc;
    __device__ __forceinline__ void operator()(const f32x4 (&acc)[2][2][4][2], const Unit& u, int wr, int wc, int fr, int fq) const {
        const int row0 = u.pm * BM + wr * 64 + fr, col0 = u.pn * BM + wc * 32 + 4 * fq;
#pragma unroll
        for (int ai = 0; ai < 2; ++ai)
#pragma unroll
            for (int m = 0; m < 4; ++m) { float* rowp = C + (size_t)(row0 + ai * HALF + m * 16) * ldc + col0;
#pragma unroll
                for (int bj = 0; bj < 2; ++bj)
#pragma unroll
                    for (int n = 0; n < 2; ++n) *(f32x4*)(rowp + bj * HALF + n * 16) = acc[ai][bj][m][n]; }
    }
};

template <class Epi, class Sched, bool ALIGN_EPI = false, bool SP2 = false>
__device__ __forceinline__ void gemm_phase(PG8_LAS unsigned char* lds, const Gemm g, const Sched& S, const Epi& E, int wv) {
    unsigned om_ = ~0u; asm volatile("" : "+s"(om_), "+s"(wv)); int tid_ = wv * 64 + (int)__builtin_amdgcn_mbcnt_hi(om_, __builtin_amdgcn_mbcnt_lo(om_, 0u));
    const int tid = tid_, wid = __builtin_amdgcn_readfirstlane(tid >> 6), lane = tid & 63, wr = wid >> 2, wc = wid & 3, fr = lane & 15, fq = lane >> 4;
    const int K = g.K, nt = K / BK;
    unsigned voffA[2], voffB[2];
#pragma unroll
    for (int i = 0; i < 2; ++i) { int R, C; stage_rc(tid * 16 + i * 8192, R, C); const int Rb = Epi::PERM ? ((R & ~31) + perm32(R & 31)) : R;
        voffA[i] = (unsigned)(R * K + C) * 2u; voffB[i] = (unsigned)(Rb * K + C) * 2u; }
    const size_t kstep = (size_t)(BK * 2);
    const size_t hstep = (size_t)HALF * K * 2;
    const size_t tstep = 2 * hstep;
    const unsigned ldsw = (unsigned)wid * 1024u;
    const int aoff = lds_byte(wr * 64 + fr, fq * 8), boff = lds_byte(wc * 32 + fr, fq * 8);
#define PG8_SA(b, h) (((b) * 2 + (h)) * HTB)
#define PG8_SB(b, h) ((4 + (b) * 2 + (h)) * HTB)
#define PG8_STAGE(bufoff, gbase, voff) do { _Pragma("unroll") for (int _i = 0; _i < 2; ++_i) \
        __builtin_amdgcn_global_load_lds((const unsigned*)((const char*)(gbase) + (voff)[_i]), (PG8_LAS unsigned*)(lds + (bufoff) + ldsw + _i * 8192), 16, 0, 0); } while (0)
#define PG8_LDA(dst, b, h) do { _Pragma("unroll") for (int m = 0; m < 4; ++m) _Pragma("unroll") for (int k = 0; k < 2; ++k) dst[m][k] = *(const PG8_LAS bf16x8*)(lds + PG8_SA(b, h) + aoff + m * 2048 + k * 1024); } while (0)
#define PG8_LDB(dst, b, h) do { _Pragma("unroll") for (int n = 0; n < 2; ++n) _Pragma("unroll") for (int k = 0; k < 2; ++k) dst[n][k] = *(const PG8_LAS bf16x8*)(lds + PG8_SB(b, h) + boff + n * 2048 + k * 1024); } while (0)
#define PG8_MMA(ai, bj, At, Bt) do { __builtin_amdgcn_s_setprio(1); _Pragma("unroll") for (int m = 0; m < 4; ++m) _Pragma("unroll") for (int n = 0; n < 2; ++n) _Pragma("unroll") for (int k = 0; k < 2; ++k) \
        acc[ai][bj][m][n] = __builtin_amdgcn_mfma_f32_16x16x32_bf16(Bt[n][k], At[m][k], acc[ai][bj][m][n], 0, 0, 0); __builtin_amdgcn_s_setprio(0); } while (0)
#define PG8_WAIT_V(n) asm volatile("s_waitcnt vmcnt(" #n ")" ::: "memory")
#define PG8_WAIT_L(n) asm volatile("s_waitcnt lgkmcnt(" #n ")" ::: "memory")
#define PG8_BAR __builtin_amdgcn_s_barrier()
#define PG8_SCHED __builtin_amdgcn_sched_barrier(0)
    Unit cur, nxt; int ui = 0;
    if (!S.next(0, cur)) return;
    f32x4 acc[2][2][4][2];
#pragma unroll
    for (int a = 0; a < 2; ++a)
#pragma unroll
        for (int b = 0; b < 2; ++b)
#pragma unroll
            for (int m = 0; m < 4; ++m)
#pragma unroll
                for (int n = 0; n < 2; ++n) acc[a][b][m][n] = (f32x4){0.f, 0.f, 0.f, 0.f};
    bf16x8 At[4][2], B0[2][2], B1[2][2];
    const char* cA = (const char*)g.A + (size_t)cur.pm * tstep; const char* cB = (const char*)g.Bt + (size_t)cur.pn * tstep;
    S.a_ready(cur);
    if constexpr (SP2) {
        PG8_STAGE(PG8_SB(0, 0), cB, voffB); PG8_STAGE(PG8_SB(0, 1), cB + hstep, voffB); PG8_STAGE(PG8_SA(0, 0), cA, voffA); PG8_STAGE(PG8_SA(0, 1), cA + hstep, voffA);
        if (wr == 1) PG8_BAR;
        PG8_WAIT_V(2); PG8_BAR;
        PG8_STAGE(PG8_SB(1, 0), cB + kstep, voffB); PG8_STAGE(PG8_SA(1, 0), cA + kstep, voffA); PG8_STAGE(PG8_SB(1, 1), cB + hstep + kstep, voffB);
        PG8_WAIT_V(6); PG8_BAR;
    } else {
        PG8_STAGE(PG8_SB(0, 0), cB, voffB); PG8_STAGE(PG8_SA(0, 0), cA, voffA); PG8_STAGE(PG8_SB(0, 1), cB + hstep, voffB); PG8_STAGE(PG8_SA(0, 1), cA + hstep, voffA);
        if (wr == 1) PG8_BAR;
        PG8_WAIT_V(4); PG8_BAR;
        PG8_STAGE(PG8_SB(1, 0), cB + kstep, voffB); PG8_STAGE(PG8_SA(1, 0), cA + kstep, voffA); PG8_STAGE(PG8_SB(1, 1), cB + hstep + kstep, voffB);
        PG8_WAIT_V(6); PG8_BAR;
    }
    for (;;) {
        const bool has_next = S.next(ui + 1, nxt);
        const char* nA = has_next ? (const char*)g.A + (size_t)nxt.pm * tstep : cA; const char* nB = has_next ? (const char*)g.Bt + (size_t)nxt.pn * tstep : cB;
        for (int t = 0; t < nt; t += 2) {
            const bool last = (t == nt - 2);
            const char* a1 = cA + (size_t)(t + 1) * kstep;
            const char* a2 = last ? nA : cA + (size_t)(t + 2) * kstep; const char* b2 = last ? nB : cB + (size_t)(t + 2) * kstep;
            const char* a3 = a2 + kstep; const char* b3 = b2 + kstep;
            if (last && has_next) S.a_ready(nxt);
            if constexpr (SP2) {
            PG8_LDB(B0, 0, 0); PG8_LDB(B1, 0, 1); PG8_SCHED; PG8_LDA(At, 0, 0); PG8_STAGE(PG8_SA(1, 1), a1 + hstep, voffA);
            PG8_WAIT_V(8); PG8_WAIT_L(0); PG8_BAR; PG8_MMA(0, 0, At, B0); PG8_MMA(0, 1, At, B1); PG8_BAR; PG8_SCHED;
            PG8_LDA(At, 0, 1); PG8_STAGE(PG8_SB(0, 0), b2, voffB); PG8_STAGE(PG8_SB(0, 1), b2 + hstep, voffB); PG8_STAGE(PG8_SA(0, 0), a2, voffA);
            PG8_WAIT_V(8); PG8_WAIT_L(0); PG8_BAR; PG8_MMA(1, 0, At, B0); PG8_MMA(1, 1, At, B1); PG8_BAR; PG8_SCHED;
            PG8_LDB(B0, 1, 0); PG8_LDB(B1, 1, 1); PG8_SCHED; PG8_LDA(At, 1, 0); PG8_STAGE(PG8_SA(0, 1), a2 + hstep, voffA);
            PG8_WAIT_V(8); PG8_WAIT_L(0); PG8_BAR; PG8_MMA(0, 0, At, B0); PG8_MMA(0, 1, At, B1); PG8_BAR; PG8_SCHED;
            PG8_LDA(At, 1, 1); PG8_STAGE(PG8_SB(1, 0), b3, voffB); PG8_STAGE(PG8_SB(1, 1), b3 + hstep, voffB); PG8_STAGE(PG8_SA(1, 0), a3, voffA);
            PG8_WAIT_V(8); PG8_WAIT_L(0); PG8_BAR; PG8_MMA(1, 0, At, B0); PG8_MMA(1, 1, At, B1); PG8_BAR; PG8_SCHED;
            } else {
            PG8_LDB(B0, 0, 0); PG8_SCHED; PG8_LDA(At, 0, 0); PG8_STAGE(PG8_SA(1, 1), a1 + hstep, voffA);
            PG8_WAIT_L(8); PG8_BAR; PG8_WAIT_L(0); PG8_MMA(0, 0, At, B0); PG8_BAR; PG8_SCHED;
            PG8_LDB(B1, 0, 1); PG8_STAGE(PG8_SB(0, 0), b2, voffB);
            PG8_BAR; PG8_WAIT_L(0); PG8_MMA(0, 1, At, B1); PG8_BAR;
            PG8_LDA(At, 0, 1); PG8_STAGE(PG8_SA(0, 0), a2, voffA);
            PG8_BAR; PG8_WAIT_L(0); PG8_MMA(1, 0, At, B0); PG8_BAR; PG8_SCHED;
            PG8_STAGE(PG8_SB(0, 1), b2 + hstep, voffB);
            PG8_WAIT_V(6); PG8_BAR; PG8_MMA(1, 1, At, B1); PG8_BAR;
            PG8_LDB(B0, 1, 0); PG8_SCHED; PG8_LDA(At, 1, 0); PG8_STAGE(PG8_SA(0, 1), a2 + hstep, voffA);
            PG8_WAIT_L(8); PG8_BAR; PG8_WAIT_L(0); PG8_MMA(0, 0, At, B0); PG8_BAR; PG8_SCHED;
            PG8_LDB(B1, 1, 1); PG8_STAGE(PG8_SB(1, 0), b3, voffB);
            PG8_BAR; PG8_WAIT_L(0); PG8_MMA(0, 1, At, B1); PG8_BAR;
            PG8_LDA(At, 1, 1); PG8_STAGE(PG8_SA(1, 0), a3, voffA);
            PG8_BAR; PG8_WAIT_L(0); PG8_MMA(1, 0, At, B0); PG8_BAR; PG8_SCHED;
            PG8_STAGE(PG8_SB(1, 1), b3 + hstep, voffB);
            PG8_WAIT_V(6); PG8_BAR; PG8_MMA(1, 1, At, B1); PG8_BAR;
            }
        }
        if constexpr (ALIGN_EPI) { if (wr == 0) PG8_BAR; }
        if constexpr (!Epi::AFTER_DRAIN) { E(acc, cur, wr, wc, fr, fq); S.done(cur); }
        if (!has_next) break;
#pragma unroll
        for (int a = 0; a < 2; ++a)
#pragma unroll
            for (int b = 0; b < 2; ++b)
#pragma unroll
                for (int m = 0; m < 4; ++m)
#pragma unroll
                    for (int n = 0; n < 2; ++n) acc[a][b][m][n] = (f32x4){0.f, 0.f, 0.f, 0.f};
        cur = nxt; cA = nA; cB = nB; ++ui;
        if constexpr (ALIGN_EPI) { if (wr == 1) PG8_BAR; }
    }
    PG8_WAIT_V(0);
    if constexpr (!ALIGN_EPI) { if (wr == 0) PG8_BAR; }
    PG8_BAR;
    if constexpr (Epi::AFTER_DRAIN) { E.fused(acc, cur, wr, wc, fr, fq, lds, wid, lane); S.done(cur); }
#undef PG8_SA
#undef PG8_SB
#undef PG8_STAGE
#undef PG8_LDA
#undef PG8_LDB
#undef PG8_MMA
#undef PG8_WAIT_V
#undef PG8_WAIT_L
#undef PG8_BAR
#undef PG8_SCHED
}
}
#include <hip/hip_bf16.h>
#include <cmath>
namespace attn_body {
using bf16=__hip_bfloat16;
using bf16x8=__attribute__((ext_vector_type(8)))short;
using s16x4=__attribute__((ext_vector_type(4)))short;
using f32x16=__attribute__((ext_vector_type(16)))float;
using u32x4=__attribute__((ext_vector_type(4)))unsigned;
constexpr int ASEQ=8448,D=64;
constexpr int QP=512,KP=512,VP=7424,OP=1024;
constexpr int NW=8,QBLK=32,QB=QBLK*NW,KVBLK=64,NQB=ASEQ/QB;
constexpr int ATTN_UNIT_ROWS=QB;
__device__ __forceinline__ int crow(int r,int hi){return (r&3)+8*(r>>2)+4*hi;}
#define SBAR() __builtin_amdgcn_sched_barrier(0)
constexpr int BT_OFF=383, BT_N=640;
__device__ __forceinline__ void bmask(f32x16&p0,f32x16&p1,int t,int q0,int wid,int r32,int hi,const __attribute__((address_space(3))) float*tab){
  const float NEG=-INFINITY; const int qw=q0+32*wid;
  if(t>(qw>>6)){
    #pragma unroll
    for(int r=0;r<16;++r){p0[r]=NEG;p1[r]=NEG;} return; }
  if(t>0 && 64*t+63+91<=qw) return;
  const int q=qw+r32, kb=64*t+4*hi;
  #pragma unroll
  for(int r=0;r<16;++r){ const int kv=kb+(r&3)+8*(r>>2); int i0=kv-q+BT_OFF, i1=i0+32; i0=i0<0?0:i0; i1=i1<0?0:i1;
    p0[r]+=tab[i0]; p1[r]+=tab[i1]; if(kv<48)p0[r]=NEG; if(kv+32<48)p1[r]=NEG; }
}

constexpr int NSLOT=3, SLOTB=8192;
constexpr int LDS_K=0, LDS_V=NSLOT*SLOTB, LDS_WS=2*NSLOT*SLOTB, LDS_OST=LDS_WS+NW*64*4, LDS_BT=LDS_OST+NW*4096, LDS_BYTES=LDS_BT+BT_N*4;
constexpr float C2=0.125f*1.4426950408889634f;
__device__ __forceinline__ void glds16(const void*gsrc,unsigned lds_dst){unsigned keep;
  asm volatile("s_mov_b32 %0, m0\n\ts_mov_b32 m0, %2\n\ts_nop 0\n\tglobal_load_lds_dwordx4 %1, off\n\ts_mov_b32 m0, %0":"=&s"(keep):"v"(gsrc),"s"(lds_dst):"memory");}
__device__ __forceinline__ float max3f(float a,float b,float c){float r;asm("v_max3_f32 %0, %1, %2, %3":"=v"(r):"v"(a),"v"(b),"v"(c));return r;}
__device__ __forceinline__ float max2f(float a,float b){float r;asm("v_max_f32_e32 %0, %1, %2":"=v"(r):"v"(a),"v"(b));return r;}
__device__ __forceinline__ float fadd_s(float a,float b){float r;asm("v_add_f32_e32 %0, %1, %2":"=v"(r):"v"(a),"v"(b));return r;}
__device__ __forceinline__ float fsub_s(float a,float b){float r;asm("v_sub_f32_e32 %0, %1, %2":"=v"(r):"v"(a),"v"(b));return r;}
typedef float f32x2_t __attribute__((ext_vector_type(2))); typedef __bf16 bf16x2_t __attribute__((ext_vector_type(2)));
__device__ __forceinline__ unsigned cvtpk_s(float lo,float hi){f32x2_t v={lo,hi};bf16x2_t b=__builtin_convertvector(v,bf16x2_t);return __builtin_bit_cast(unsigned,b);}
#define WAIT_BAR(N) asm volatile("s_waitcnt vmcnt(" #N ") lgkmcnt(0)\n\ts_barrier":::"memory")

__device__ __forceinline__ void qkt(f32x16&p0,f32x16&p1,const char*Kslot,const bf16x8*qr,const f32x16&negm,int r32,int hi){
  const char*kb=Kslot+hi*1024+r32*16;
  #pragma unroll
  for(int d0=0;d0<4;++d0){
    const bf16x8 b0=*reinterpret_cast<const bf16x8*>(kb+d0*2048);
    const bf16x8 b1=*reinterpret_cast<const bf16x8*>(kb+d0*2048+512);
    if(d0==0){p0=__builtin_amdgcn_mfma_f32_32x32x16_bf16(b0,qr[0],negm,0,0,0);p1=__builtin_amdgcn_mfma_f32_32x32x16_bf16(b1,qr[0],negm,0,0,0);}
    else{p0=__builtin_amdgcn_mfma_f32_32x32x16_bf16(b0,qr[d0],p0,0,0,0);p1=__builtin_amdgcn_mfma_f32_32x32x16_bf16(b1,qr[d0],p1,0,0,0);}}
}
typedef __attribute__((address_space(3))) const char* lds_cptr;
typedef __attribute__((address_space(3))) const float* lds_cfptr;
typedef short v4i16_t __attribute__((ext_vector_type(4)));
__device__ __forceinline__ void kload8(bf16x8*kf,lds_cptr kp){
  kf[0]=*(const __attribute__((address_space(3))) bf16x8*)(kp);      kf[1]=*(const __attribute__((address_space(3))) bf16x8*)(kp+512);
  kf[2]=*(const __attribute__((address_space(3))) bf16x8*)(kp+2048); kf[3]=*(const __attribute__((address_space(3))) bf16x8*)(kp+2560);
  kf[4]=*(const __attribute__((address_space(3))) bf16x8*)(kp+4096); kf[5]=*(const __attribute__((address_space(3))) bf16x8*)(kp+4608);
  kf[6]=*(const __attribute__((address_space(3))) bf16x8*)(kp+6144); kf[7]=*(const __attribute__((address_space(3))) bf16x8*)(kp+6656);
}
__device__ __forceinline__ void kload2(bf16x8*kf,lds_cptr kp,int j){ kf[2*j]=*(const __attribute__((address_space(3))) bf16x8*)(kp+j*2048); kf[2*j+1]=*(const __attribute__((address_space(3))) bf16x8*)(kp+j*2048+512); }
__device__ __forceinline__ s16x4 vtr(lds_cptr p){ return __builtin_bit_cast(s16x4,__builtin_amdgcn_ds_read_tr16_b64_v4i16((__attribute__((address_space(3))) v4i16_t*)p)); }
__device__ __forceinline__ float rowmax(const f32x16&p0,const f32x16&p1){
  float a=max3f(p0[0],p0[1],p1[0]),b=max3f(p0[2],p0[3],p1[1]);a=max3f(a,p1[2],p1[3]);
  #pragma unroll
  for(int r=4;r<16;r+=4){a=max3f(a,p0[r],p0[r+1]);b=max3f(b,p0[r+2],p0[r+3]);a=max3f(a,p1[r],p1[r+1]);b=max3f(b,p1[r+2],p1[r+3]);}
  const float m=max2f(a,b);
  auto rr=__builtin_amdgcn_permlane32_swap(__float_as_uint(m),__float_as_uint(m),false,false);
  return max2f(__uint_as_float(rr[0]),__uint_as_float(rr[1]));
}
__device__ __forceinline__ void pv(f32x16*o,int vb,bf16x8 pa0,bf16x8 pa1,bf16x8 pa2,bf16x8 pa3){
  #pragma unroll
  for(int d0=0;d0<2;++d0){s16x4 lo[4],hi[4];
    #pragma unroll
    for(int ks=0;ks<4;++ks){
      asm volatile("ds_read_b64_tr_b16 %0,%1 offset:%c2":"=&v"(lo[ks]):"v"(vb),"i"(d0*4096+ks*1024):"memory");
      asm volatile("ds_read_b64_tr_b16 %0,%1 offset:%c2":"=&v"(hi[ks]):"v"(vb),"i"(d0*4096+ks*1024+512):"memory");}
    asm volatile("s_waitcnt lgkmcnt(0)":::"memory");SBAR();
    #define PK(k) (bf16x8){lo[k][0],lo[k][1],lo[k][2],lo[k][3],hi[k][0],hi[k][1],hi[k][2],hi[k][3]}
    o[d0]=__builtin_amdgcn_mfma_f32_32x32x16_bf16(pa0,PK(0),o[d0],0,0,0);
    o[d0]=__builtin_amdgcn_mfma_f32_32x32x16_bf16(pa1,PK(1),o[d0],0,0,0);
    o[d0]=__builtin_amdgcn_mfma_f32_32x32x16_bf16(pa2,PK(2),o[d0],0,0,0);
    o[d0]=__builtin_amdgcn_mfma_f32_32x32x16_bf16(pa3,PK(3),o[d0],0,0,0);
    #undef PK
  }
}

#ifndef ATTN_STORE16
#define ATTN_STORE16(p,v) (*(u32x4*)(p)=(v))
#endif
template<int THRL> __device__ __forceinline__ void attn_unit(int b,int qoff,int voff,int ooff,int qb,const bf16*Q,const bf16*__restrict__ K,const bf16*__restrict__ V,bf16*O,char*shm,int wv){
  unsigned om_ = ~0u; asm volatile("" : "+s"(om_), "+s"(wv)); int tid_ = wv * 64 + (int)__builtin_amdgcn_mbcnt_hi(om_, __builtin_amdgcn_mbcnt_lo(om_, 0u)); const int tid=tid_,lane=tid&63,r32=lane&31,hi=lane>>5; const int wid=__builtin_amdgcn_readfirstlane(tid>>6);
  const long rowbase=(long)b*ASEQ; const int q0=qb*QB;
  const bf16*Qw=Q+(rowbase+q0+wid*QBLK)*QP+qoff;
  const bf16*Kh=K+rowbase*KP+qoff,*Vh=V+rowbase*VP+voff;
  const unsigned lds0=(unsigned)(uintptr_t)shm;
  float*wsf=(float*)(shm+LDS_WS)+wid*64;
  const bf16*ksrc=Kh+(long)lane*KP+wid*8;
  const bf16*vsrc=Vh+(long)(16*(wid&3)+(lane>>2))*VP+(wid>>2)*32+(lane&3)*8;
  const unsigned kdst=lds0+LDS_K+wid*1024, vdst=lds0+LDS_V+wid*1024;
  #define DMA_K(t,slot) glds16(ksrc+(long)(t)*KVBLK*KP,(unsigned)__builtin_amdgcn_readfirstlane(kdst+(slot)))
  #define DMA_V(t,slot) glds16(vsrc+(long)(t)*KVBLK*VP,(unsigned)__builtin_amdgcn_readfirstlane(vdst+(slot)))
  const int vb0=(int)(lds0+LDS_V)+((lane>>4)&1)*32+(lane&3)*8+(4*hi+((lane&15)>>2))*64;
  const char*Kbase=shm+LDS_K; bf16x8 kf[8];
  const lds_cptr shm3=(lds_cptr)shm; const lds_cfptr btab=(lds_cfptr)(shm3+LDS_BT); const lds_cptr kp0=shm3+LDS_K+hi*1024+r32*16; const lds_cptr vp0=shm3+LDS_V+((lane>>4)&1)*32+(lane&3)*8+(4*hi+((lane&15)>>2))*64;
  const int NTL=(q0+QB)/KVBLK;
  DMA_K(0,0);DMA_V(0,0);DMA_K(1,SLOTB);
  bf16x8 qr[4];
  #pragma unroll
  for(int d0=0;d0<4;++d0)qr[d0]=*reinterpret_cast<const bf16x8*>(&Qw[(long)r32*QP+d0*16+hi*8]);
  float mhat=0.f,l_reg=0.f;f32x16 o[2];o[0]=f32x16{};o[1]=f32x16{};const f32x16 zt=f32x16{};
  const int qrel=wid*QBLK+r32;
  #define CMASK(P0,P1,t) bmask(P0,P1,(t),q0,wid,r32,hi,btab)
  bool resc=false;
  #define START(P0,P1) do{ const float rm=rowmax(P0,P1); resc=false; \
    { const float dl=rm; mhat=fadd_s(mhat,dl); \
      _Pragma("unroll") for(int r=0;r<16;++r){P0[r]=fsub_s(P0[r],dl);P1[r]=fsub_s(P1[r],dl);} \
      } \
    _Pragma("unroll") for(int r=0;r<16;++r)P0[r]=__builtin_amdgcn_exp2f(P0[r]); }while(0)
  #define RESC() do{ if(resc){ asm volatile("s_waitcnt lgkmcnt(0)":::"memory"); \
      _Pragma("unroll") for(int d_=0;d_<2;++d_) _Pragma("unroll") for(int r=0;r<16;++r)o[d_][r]*=wsf[crow(r,hi)]; } }while(0)
  f32x16 pA0,pA1,pB0,pB1;
  int sl_prev=0,sl_cur=0,sl_next=SLOTB;
  #define ROT() do{sl_prev=sl_cur;sl_cur=sl_next;sl_next=(sl_next==(NSLOT-1)*SLOTB)?0:sl_next+SLOTB;}while(0)
  DMA_K(2,2*SLOTB);
  WAIT_BAR(3);
  qkt(pA0,pA1,Kbase,qr,zt,r32,hi);asm volatile("s_nop 15\n\ts_nop 7":"+v"(pA0),"+v"(pA1));CMASK(pA0,pA1,0);
  START(pA0,pA1);
  _Pragma("unroll") for(int r=0;r<16;++r)pA1[r]=__builtin_amdgcn_exp2f(pA1[r]);
  WAIT_BAR(0);
  DMA_K(3,0);DMA_V(1,SLOTB);
  ROT();
  kload8(kf,kp0+sl_cur);
  WAIT_BAR(2);
  s16x4 vlo[8],vhi[8]; u32x4 pw0,pw1,pw2,pw3;
  #define PKW(P,B) cvtpk_s(P[B],P[B+1])
  #define PAF(k) __builtin_bit_cast(bf16x8,pw##k)
  #define VFR(i) (bf16x8){vlo[i][0],vlo[i][1],vlo[i][2],vlo[i][3],vhi[i][0],vhi[i][1],vhi[i][2],vhi[i][3]}
  #define PIN(x) asm volatile("":"+v"(x))
  #define MX3(a,b,c) __builtin_fmaxf(__builtin_fmaxf((a),(b)),(c))
  #define GAPA(MF,A0,A1,A2,A3,W0,W1,PW) do{ MF; sacc+=A0; sacc+=A1; sacc+=A2; sacc+=A3; PIN(sacc); W0; W1; PIN(PW); SBAR(); }while(0)
  #define EX(v) __builtin_amdgcn_exp2f(v)
  #define GAPB(MF,X,B) do{ MF; X[B]=EX(X[B]); X[B+1]=EX(X[B+1]); X[B+2]=EX(X[B+2]); X[B+3]=EX(X[B+3]); PIN(X); SBAR(); }while(0)
  #define VRD(i) do{ vlo[i]=vtr(vp_+(((i)>>2)*4096+((i)&3)*1024)); vhi[i]=vtr(vp_+(((i)>>2)*4096+((i)&3)*1024+512)); }while(0)
  #define KRD(G,j) do{ if(G){ kload2(kf,kp0+sl_next,j); SBAR(); } }while(0)
  #define STEP(C0,C1,P0,P1,t,GK,GV,GL) do{ SBAR(); \
    const lds_cptr vp_=vp0+sl_prev; \
    VRD(0); SBAR(); float sacc=(P0[0]+P0[1]); \
    GAPA(C0=__builtin_amdgcn_mfma_f32_32x32x16_bf16(kf[0],qr[0],zt,0,0,0), P0[2],P0[3],P0[4],P0[5],     pw0[0]=PKW(P0,0), pw0[1]=PKW(P0,2), pw0); \
    VRD(4); SBAR(); GAPA(C1=__builtin_amdgcn_mfma_f32_32x32x16_bf16(kf[1],qr[0],zt,0,0,0), P0[6],P0[7],P0[8],P0[9],     pw0[2]=PKW(P0,4), pw0[3]=PKW(P0,6), pw0); \
    VRD(1); SBAR(); GAPA(C0=__builtin_amdgcn_mfma_f32_32x32x16_bf16(kf[2],qr[1],C0,0,0,0),   P0[10],P0[11],P0[12],P0[13], pw1[0]=PKW(P0,8), pw1[1]=PKW(P0,10), pw1); \
    VRD(5); SBAR(); GAPA(C1=__builtin_amdgcn_mfma_f32_32x32x16_bf16(kf[3],qr[1],C1,0,0,0),   P0[14],P0[15],P1[0],P1[1],   pw1[2]=PKW(P0,12),pw1[3]=PKW(P0,14), pw1); \
    VRD(2); SBAR(); GAPA(C0=__builtin_amdgcn_mfma_f32_32x32x16_bf16(kf[4],qr[2],C0,0,0,0),   P1[2],P1[3],P1[4],P1[5],     pw2[0]=PKW(P1,0), pw2[1]=PKW(P1,2), pw2); \
    VRD(6); SBAR(); GAPA(C1=__builtin_amdgcn_mfma_f32_32x32x16_bf16(kf[5],qr[2],C1,0,0,0),   P1[6],P1[7],P1[8],P1[9],     pw2[2]=PKW(P1,4), pw2[3]=PKW(P1,6), pw2); \
    VRD(3); SBAR(); GAPA(C0=__builtin_amdgcn_mfma_f32_32x32x16_bf16(kf[6],qr[3],C0,0,0,0),   P1[10],P1[11],P1[12],P1[13], pw3[0]=PKW(P1,8), pw3[1]=PKW(P1,10), pw3); \
    VRD(7); SBAR(); GAPA(C1=__builtin_amdgcn_mfma_f32_32x32x16_bf16(kf[7],qr[3],C1,0,0,0),   P1[14],P1[15],0.f,0.f,       pw3[2]=PKW(P1,12),pw3[3]=PKW(P1,14), pw3); \
    l_reg+=sacc; \
    if(GK){DMA_K((t)+3,sl_cur);} if(GV){DMA_V((t)+1,sl_next);} \
    _Pragma("unroll") for(int r=0;r<16;++r){C0[r]-=mhat;C1[r]-=mhat;} \
    CMASK(C0,C1,t); \
    { float a=MX3(C0[0],C0[1],C1[0]),b=MX3(C0[2],C0[3],C1[1]); a=MX3(a,C1[2],C1[3]); \
      _Pragma("unroll") for(int r=4;r<16;r+=4){a=MX3(a,C0[r],C0[r+1]);b=MX3(b,C0[r+2],C0[r+3]);a=MX3(a,C1[r],C1[r+1]);b=MX3(b,C1[r+2],C1[r+3]);} \
      float rm=__builtin_fmaxf(a,b); { auto rr=__builtin_amdgcn_permlane32_swap(__float_as_uint(rm),__float_as_uint(rm),false,false); rm=__builtin_fmaxf(__uint_as_float(rr[0]),__uint_as_float(rr[1])); } \
      resc=false; \
      if(__builtin_expect(__any(rm>(float)THRL),0)){ const float dl=__builtin_fmaxf(rm,0.f); mhat+=dl; \
        _Pragma("unroll") for(int r=0;r<16;++r){C0[r]-=dl;C1[r]-=dl;} \
        const float f=__builtin_amdgcn_exp2f(-dl); l_reg*=f; if(hi==0)wsf[r32]=f; resc=true; } } \
    SBAR(); \
    GAPB(o[0]=__builtin_amdgcn_mfma_f32_32x32x16_bf16(PAF(0),VFR(0),o[0],0,0,0), C0,0); \
    GAPB(o[1]=__builtin_amdgcn_mfma_f32_32x32x16_bf16(PAF(0),VFR(4),o[1],0,0,0), C0,4); \
    KRD(GL,0); GAPB(o[0]=__builtin_amdgcn_mfma_f32_32x32x16_bf16(PAF(1),VFR(1),o[0],0,0,0), C0,8); \
    KRD(GL,1); GAPB(o[1]=__builtin_amdgcn_mfma_f32_32x32x16_bf16(PAF(1),VFR(5),o[1],0,0,0), C0,12); \
    KRD(GL,2); GAPB(o[0]=__builtin_amdgcn_mfma_f32_32x32x16_bf16(PAF(2),VFR(2),o[0],0,0,0), C1,0); \
    KRD(GL,3); GAPB(o[1]=__builtin_amdgcn_mfma_f32_32x32x16_bf16(PAF(2),VFR(6),o[1],0,0,0), C1,4); \
    GAPB(o[0]=__builtin_amdgcn_mfma_f32_32x32x16_bf16(PAF(3),VFR(3),o[0],0,0,0), C1,8); \
    GAPB(o[1]=__builtin_amdgcn_mfma_f32_32x32x16_bf16(PAF(3),VFR(7),o[1],0,0,0), C1,12); \
    }while(0)
  int t=1;
  #undef CMASK
  #define CMASK(P0,P1,t) do{}while(0)
  for(;t+7<NTL;t+=2){
    STEP(pB0,pB1,pA0,pA1,t,true,true,true);     WAIT_BAR(2); RESC(); ROT();
    STEP(pA0,pA1,pB0,pB1,t+1,true,true,true);   WAIT_BAR(2); RESC(); ROT();
  }
  #undef CMASK
  #define CMASK(P0,P1,t) bmask(P0,P1,(t),q0,wid,r32,hi,btab)
  #define ENDW(tt) do{ if((tt)+3<NTL){WAIT_BAR(2);} else if((tt)+2<NTL){WAIT_BAR(1);} else {WAIT_BAR(0);} }while(0)
  for(;t+1<NTL;t+=2){
    STEP(pB0,pB1,pA0,pA1,t,(t+3<NTL),(t+1<NTL),(t+1<NTL));       ENDW(t);   RESC(); ROT();
    STEP(pA0,pA1,pB0,pB1,t+1,(t+4<NTL),(t+2<NTL),(t+2<NTL));     ENDW(t+1); RESC(); ROT();
  }
  STEP(pB0,pB1,pA0,pA1,NTL-1,false,false,false); RESC();
  { float sacc=pB0[0]+pB0[1]; _Pragma("unroll") for(int r=2;r<16;++r)sacc+=pB0[r]; _Pragma("unroll") for(int r=0;r<16;++r)sacc+=pB1[r]; l_reg+=sacc;
    pw0=(u32x4){PKW(pB0,0),PKW(pB0,2),PKW(pB0,4),PKW(pB0,6)};pw1=(u32x4){PKW(pB0,8),PKW(pB0,10),PKW(pB0,12),PKW(pB0,14)};pw2=(u32x4){PKW(pB1,0),PKW(pB1,2),PKW(pB1,4),PKW(pB1,6)};pw3=(u32x4){PKW(pB1,8),PKW(pB1,10),PKW(pB1,12),PKW(pB1,14)};
    SBAR(); pv(o,vb0+sl_cur,PAF(0),PAF(1),PAF(2),PAF(3)); }
  #undef PKW
  #undef PAF
  #undef VFR
  #undef PIN
  #undef MX3
  #undef GAPA
  #undef GAPB
  #undef EX
  #undef VRD
  #undef KRD
  #undef STEP
  #undef ENDW
  {auto rr=__builtin_amdgcn_permlane32_swap(__float_as_uint(l_reg),__float_as_uint(l_reg),false,false);l_reg=__uint_as_float(rr[0])+__uint_as_float(rr[1]);}
  if(hi==0)wsf[32+r32]=l_reg;asm volatile("s_waitcnt lgkmcnt(0)":::"memory");
  float rli[16];
  #pragma unroll
  for(int r=0;r<16;++r)rli[r]=__builtin_amdgcn_rcpf(wsf[32+crow(r,hi)]);
  bf16*Ow=O+(rowbase+q0+wid*QBLK)*OP+ooff;
  { bf16*stg=(bf16*)(shm+LDS_OST)+wid*2048;
    #pragma unroll
    for(int r=0;r<16;++r){const int orow=crow(r,hi);
      #pragma unroll
      for(int d0=0;d0<2;++d0)stg[orow*64+d0*32+r32]=__float2bfloat16(o[d0][r]*rli[r]);}
    asm volatile("s_waitcnt lgkmcnt(0)":::"memory");
    #pragma unroll
    for(int i=0;i<4;++i){const int row=i*8+(lane>>3),ch=lane&7; const u32x4 v=*(const u32x4*)(stg+row*64+ch*8); ATTN_STORE16(Ow+(long)row*OP+ch*8,v);} }
  asm volatile("s_waitcnt lgkmcnt(0)\n\ts_barrier":::"memory");
  #undef DMA_K
  #undef DMA_V
  #undef CMASK
  #undef START
  #undef RESC
  #undef ROT
}
constexpr int ATTN_LDS_BYTES=LDS_BYTES;
#undef SBAR
#undef WAIT_BAR
#undef WAIT_BAR
}
namespace mk {
#define GAS __attribute__((address_space(1)))
#define LAS __attribute__((address_space(3)))
typedef unsigned short bf16;
typedef unsigned v4u __attribute__((ext_vector_type(4)));
typedef unsigned v2u __attribute__((ext_vector_type(2)));
typedef float f32x4 __attribute__((ext_vector_type(4)));
typedef float f32x16 __attribute__((ext_vector_type(16)));
typedef short bf16x8 __attribute__((ext_vector_type(8)));
typedef GAS unsigned gu32;
#define RLX_AGENT __ATOMIC_RELAXED, __HIP_MEMORY_SCOPE_AGENT
#define LDS_WAIT() asm volatile("s_waitcnt lgkmcnt(0)" ::: "memory")
#define VM_WAIT() asm volatile("s_waitcnt vmcnt(0)" ::: "memory")
typedef float f32x2_cv __attribute__((ext_vector_type(2))); typedef __bf16 bf16x2_cv __attribute__((ext_vector_type(2)));
__device__ __forceinline__ unsigned pk2(float lo, float hi) { const f32x2_cv v = {lo, hi}; return __builtin_bit_cast(unsigned, __builtin_convertvector(v, bf16x2_cv)); }
__device__ __forceinline__ unsigned f2bf(float f) { return pk2(f, 0.f) & 0xffffu; }
__device__ __forceinline__ float bf2f(unsigned short b) { return __builtin_bit_cast(float, ((unsigned)b) << 16); }
__device__ __forceinline__ float bflo(unsigned w) { return __builtin_bit_cast(float, w << 16); }
__device__ __forceinline__ float bfhi(unsigned w) { return __builtin_bit_cast(float, w & 0xffff0000u); }

constexpr int NWAVES = 8, NTHR = NWAVES * 64;
constexpr int PADF = 48;
constexpr int LPP = 8448;
constexpr int PEND = PADF + LP;
constexpr int SROW0 = BATCH * LPP;
constexpr int RP = SROW0 + NS;
constexpr int ZN = 7424;
constexpr int ZC_QA = 0, ZC_KA = 512, ZC_VA = 1024, ZC_QKVB = 1536, ZC_GB = 3072, ZC_UC = 3584, ZC_GATE = 4096, ZC_BA = 7168;
static_assert(RP % 256 == 0 && ZN % 256 == 0 && D_MODEL == 1024 && WIDTH_A == 512 && WIDTH_B == 512 && WIDTH_C == 512, "shapes");
__host__ __device__ __forceinline__ int nat2prow(int row) { return row < NP ? (row / LP) * LPP + PADF + row % LP : SROW0 + (row - NP); }
__host__ __device__ __forceinline__ int zcol(int col) { return col < 3584 ? col : (col < 3592 ? ZC_BA + (col - 3584) : col - 8); }
__device__ __forceinline__ bool prow_valid(int prow) { if (prow >= SROW0) return true; const int p = prow % LPP; return p >= PADF && p < PEND; }
__device__ __forceinline__ int prow2nat(int prow) { if (prow >= SROW0) return NP + (prow - SROW0); return (prow / LPP) * LP + (prow % LPP) - PADF; }

constexpr int RING_OFF = 0, RING_BYTES = 147456;
constexpr int LDSCTL_OFF = RING_BYTES, MISC_OFF = LDSCTL_OFF + 320;
constexpr int LDS_BYTES = RING_BYTES + 1024;
static_assert(MISC_OFF + 128 <= LDS_BYTES, "LDS map");

constexpr size_t CTL_BYTES = 1u << 20;
constexpr int CW_TMO = 0, CW_CODE = 1;
constexpr int CW_BAR = 4096;
constexpr int CW_QUEUE = 16384;

__device__ __forceinline__ int lane_id() { return (int)__builtin_amdgcn_mbcnt_hi(~0u, __builtin_amdgcn_mbcnt_lo(~0u, 0u)); }
#define XB_TMO      128
#define XB_XCNT(j)  (256  + 64 * (j))
#define XB_XSUB(j)  (1280 + 64 * (j))
#define XB_XGEN(j)  (2304 + 64 * (j))
#define XB_TOP      3328
#define XB_TOPGEN   3392
#define XCD_BAR_WORDS 3456
#define XB_SPIN_CAP (1u << 18)

__device__ __forceinline__ unsigned xb_ld(unsigned* p)              { return __hip_atomic_load(p, __ATOMIC_RELAXED, __HIP_MEMORY_SCOPE_AGENT); }
__device__ __forceinline__ unsigned xb_add(unsigned* p, unsigned v) { return __hip_atomic_fetch_add(p, v, __ATOMIC_RELAXED, __HIP_MEMORY_SCOPE_AGENT); }
__device__ __forceinline__ unsigned xb_xcc_id() { return (unsigned)__builtin_amdgcn_s_getreg((3 << 11) | 20) & 0xFu; }
#define XB_SPIN(cond, bar) do { unsigned _sp = 0; while (cond) { __builtin_amdgcn_s_sleep(1); \
    if ((++_sp & 255u) == 0u) { if (xb_ld(&(bar)[XB_TMO])) break; if (_sp > XB_SPIN_CAP) { atomicAdd(&(bar)[XB_TMO], 1u); break; } } } } while (0)

struct XcdBarrier {
    unsigned* bar; unsigned x; int wv;
    volatile LAS unsigned* st;
};

__device__ __forceinline__ XcdBarrier xcd_barrier_post(unsigned* bar, volatile LAS unsigned* st, int wv) {
    XcdBarrier b; b.bar = bar; b.x = xb_xcc_id(); b.st = st; b.wv = wv;
    if (wv == 0 && lane_id() == 0) (void)xb_add(&bar[XB_XCNT(b.x)], 1u);
    return b;
}
__device__ __forceinline__ void xcd_barrier_complete(unsigned* bar, unsigned x, unsigned& nloc, unsigned& nx) {
    const unsigned G = gridDim.x * gridDim.y * gridDim.z;
    unsigned sum, cnt, mine, sp = 0u;
    for (;;) {
        sum = 0u; cnt = 0u; mine = 0u;
#pragma unroll
        for (unsigned j = 0; j < 16; ++j) { const unsigned c = xb_ld(&bar[XB_XCNT(j)]); sum += c; cnt += (c > 0u) ? 1u : 0u; mine = (j == x) ? c : mine; }
        if (sum == G) break;
        __builtin_amdgcn_s_sleep(1);
        if ((++sp & 255u) == 0u) { if (xb_ld(&bar[XB_TMO])) break; if (sp > XB_SPIN_CAP) { atomicAdd(&bar[XB_TMO], 1u); break; } }
    }
    nloc = mine > 0u ? mine : 1u; nx = cnt > 0u ? cnt : 1u;
}

__device__ __forceinline__ void xcd_barrier(const XcdBarrier& b) {
    asm volatile("s_waitcnt vmcnt(0)" ::: "memory");
    __syncthreads();
    if (b.wv == 0 && lane_id() == 0) {
        unsigned* bar = b.bar;
        __builtin_amdgcn_s_waitcnt(0);
        unsigned nloc = b.st[0], nx = b.st[1];
        if (nloc == 0u) { xcd_barrier_complete(bar, b.x, nloc, nx); b.st[0] = nloc; b.st[1] = nx; }
        const unsigned old = xb_add(&bar[XB_XSUB(b.x)], 1u);
        const unsigned gen = old / nloc;
        if (old + 1u == (gen + 1u) * nloc) {
            __builtin_amdgcn_fence(__ATOMIC_RELEASE, "agent");
            asm volatile("s_waitcnt vmcnt(0)" ::: "memory");
            const unsigned og = xb_add(&bar[XB_TOP], 1u);
            const unsigned tg = og / nx;
            if (og + 1u == (tg + 1u) * nx) xb_add(&bar[XB_TOPGEN], 1u);
            else XB_SPIN(xb_ld(&bar[XB_TOPGEN]) == tg, bar);
            __builtin_amdgcn_fence(__ATOMIC_ACQUIRE, "agent");
            xb_add(&bar[XB_XGEN(b.x)], 1u);
            asm volatile("s_waitcnt vmcnt(0)" ::: "memory");
        } else {
            XB_SPIN(xb_ld(&bar[XB_XGEN(b.x)]) == gen, bar);
            __builtin_amdgcn_fence(__ATOMIC_ACQUIRE, "agent");
            asm volatile("s_waitcnt vmcnt(0)" ::: "memory");
        }
    }
    __syncthreads();
}


template <int CTRL> __device__ __forceinline__ float dpp_f(float v) { return __builtin_bit_cast(float, __builtin_amdgcn_update_dpp(0, __builtin_bit_cast(int, v), CTRL, 0xf, 0xf, true)); }
template <int CTRL> __device__ __forceinline__ int dpp_i(int v) { return __builtin_amdgcn_update_dpp(0, v, CTRL, 0xf, 0xf, true); }
template <int CTRL, int ROWMASK> __device__ __forceinline__ float dpp_fm(float v) { return __builtin_bit_cast(float, __builtin_amdgcn_update_dpp(0, __builtin_bit_cast(int, v), CTRL, ROWMASK, 0xf, false)); }
__device__ __forceinline__ float rdlane(float v, int i) { return __builtin_bit_cast(float, __builtin_amdgcn_readlane(__builtin_bit_cast(int, v), i)); }
__device__ __forceinline__ float sum8(float v) { v += dpp_f<0xB1>(v); v += dpp_f<0x4E>(v); v += dpp_f<0x141>(v); return v; }
__device__ __forceinline__ float sum16(float v) { v = sum8(v); v += dpp_f<0x140>(v); return v; }
__device__ __forceinline__ float wave_sum(float v) { v = sum16(v); return rdlane(v, 0) + rdlane(v, 16) + rdlane(v, 32) + rdlane(v, 48); }
__device__ __forceinline__ float wave_max(float v) {
    v = fmaxf(v, dpp_f<0xB1>(v)); v = fmaxf(v, dpp_f<0x4E>(v)); v = fmaxf(v, dpp_f<0x141>(v)); v = fmaxf(v, dpp_f<0x140>(v));
    return fmaxf(fmaxf(rdlane(v, 0), rdlane(v, 16)), fmaxf(rdlane(v, 32), rdlane(v, 48)));
}
__device__ __forceinline__ float scan64(float v) {
    v += dpp_f<0x111>(v); v += dpp_f<0x112>(v); v += dpp_f<0x114>(v); v += dpp_f<0x118>(v);
    v += dpp_fm<0x142, 0xA>(v); v += dpp_fm<0x143, 0xC>(v);
    return v;
}
__device__ __forceinline__ float swap32(float v) {
    const auto r = __builtin_amdgcn_permlane32_swap(__builtin_bit_cast(unsigned, v), __builtin_bit_cast(unsigned, v), false, false);
    return __builtin_bit_cast(float, (lane_id() & 32) ? r[0] : r[1]);
}
}
namespace mk {
enum Region { R_X, R_XN, R_WIN, R_Z, R_QN, R_KN, R_QKVB, R_BG, R_O, R_OA, R_OB, R_YC, R_OC, R_MRG, R_WGLU, R_WBR, R_WOUT, R_WQS, R_PU, R_PV, R_SC, R_GDN, R_S5T, R_MISC, R_S5E, R_S5X, R_MRGB, R_OBN, R_MRG2, R_NREG };
constexpr int NPL = 16;
enum Phase { PH_PRO = 0, PL_NORM1 = 0, PL_GEMM_IN = 1, PL_ZPOST = 2, PL_LOCAL = 3, PL_MIX = 4, PL_MIXPOST = 5, PL_GEMM_GLU = 6, PL_GEMM_BRA = 7, PL_GEMM_BRB = 8, PL_GEMM_BRC = 9,
             PL_GEMM_OUT = 10, PL_NORM2 = 11, PL_GEMM_PEER = 12, PL_PEER = 13, PH_FINAL = 1 + DEPTH * NPL, PH_END = PH_FINAL + 1 };
enum ProMask { PM_X = 1, PM_WIN = 2, PM_WREST = 4, PM_PEERW = 8, PM_WQS = 16, PM_TABLES = 32 };
struct Args {
    const float* in[40];
    float* out;
    unsigned char* ws;
    unsigned long long off[32];
    int ph_lo, ph_hi, pro_mask, bar_region;
};
static_assert(sizeof(Args) == 40 * 8 + 8 + 8 + 32 * 8 + 16, "Args has no padding");

typedef const __attribute__((address_space(4))) Args* KArgs;
__device__ __forceinline__ KArgs kargs() { KArgs p = (KArgs)__builtin_amdgcn_kernarg_segment_ptr(); asm volatile("" : "+s"(p)); return p; }
__device__ __forceinline__ void assume_global(const void* p) {
#if defined(__HIP_DEVICE_COMPILE__)
    __builtin_assume(!__builtin_amdgcn_is_shared(p) && !__builtin_amdgcn_is_private(p));
#endif
}
#define GIN(a, i) ((const float*)(const GAS float*)(a).in[i])
#define GOUT(a) ((float*)(GAS float*)(a).out)
#define WS_OPAQUE(a) GAS unsigned char* wsg_ = (GAS unsigned char*)(a).ws; asm volatile("" : "+s"(wsg_)); unsigned char* wsb = (unsigned char*)wsg_
#define otid() otid_(F.wv)
__device__ __forceinline__ int otid_(int wv) { unsigned m = ~0u; asm volatile("" : "+s"(m), "+s"(wv));
    return wv * 64 + (int)__builtin_amdgcn_mbcnt_hi(m, __builtin_amdgcn_mbcnt_lo(m, 0u)); }
struct Frame {
    LAS unsigned char* lds; volatile LAS unsigned* MISC; gu32* ctl;
    int vcu, G, wv;
};

template <class CM> __device__ __forceinline__ void transpose_item(const float* W, int ld, int K, bf16* WT, int n0, int k0, const CM& cm, LAS float* scr, int lane) {
    const int sc = cm(n0 + (lane & 31));
#pragma unroll 8
    for (int i = 0; i < 32; ++i) { const int kk = 2 * i + (lane >> 5); scr[kk * 33 + (lane & 31)] = sc >= 0 ? W[(size_t)(k0 + kk) * ld + sc] : 0.f; }
    LDS_WAIT(); asm volatile("" ::: "memory");
    const int c = lane & 7;
#pragma unroll
    for (int j = 0; j < 4; ++j) { const int n = (lane >> 3) + 8 * j; const LAS float* s = scr + (8 * c) * 33 + n;
        v4u o; o.x = pk2(s[0 * 33], s[1 * 33]); o.y = pk2(s[2 * 33], s[3 * 33]); o.z = pk2(s[4 * 33], s[5 * 33]); o.w = pk2(s[6 * 33], s[7 * 33]);
        *(GAS v4u*)(WT + (size_t)(n0 + n) * K + k0 + 8 * c) = o; }
    LDS_WAIT(); asm volatile("" ::: "memory");
}
struct CmWin { __device__ __forceinline__ int operator()(int n) const { return n < 3584 ? n : (n < 7168 ? n + 8 : (n < 7176 ? 3584 + (n - 7168) : -1)); } };
struct CmId { __device__ __forceinline__ int operator()(int n) const { return n; } };
struct CmGlu { __device__ __forceinline__ int operator()(int n) const { const int G = n >> 5, i = n & 31; return i < 16 ? 16 * G + i : 512 + 16 * G + (i - 16); } };

__device__ __forceinline__ void rms_row_to_bf16(const float* xrow, const float* g, bf16* orow, int lane) {
    const GAS f32x4* xr = (const GAS f32x4*)xrow + lane;
    f32x4 v[4]; float s2 = 0.f;
#pragma unroll
    for (int j = 0; j < 4; ++j) { v[j] = xr[64 * j]; s2 += (v[j].x * v[j].x + v[j].y * v[j].y) + (v[j].z * v[j].z + v[j].w * v[j].w); }
    const float r = __builtin_amdgcn_rsqf(wave_sum(s2) * (1.f / D_MODEL) + EPSF);
    const GAS f32x4* gr = (const GAS f32x4*)g + lane;
    GAS unsigned long long* o8 = (GAS unsigned long long*)orow + lane;
#pragma unroll
    for (int j = 0; j < 4; ++j) { const f32x4 gg = gr[64 * j];
        o8[64 * j] = (unsigned long long)pk2(v[j].x * r * gg.x, v[j].y * r * gg.y) | ((unsigned long long)pk2(v[j].z * r * gg.z, v[j].w * r * gg.w) << 32); }
}

__device__ __forceinline__ void p_norm(Frame& F, int l, int gi) {
    const KArgs ap = kargs(); const auto& a = *ap; WS_OPAQUE(a);
    const int tid = otid(), lane = tid & 63, wave = __builtin_amdgcn_readfirstlane(tid >> 6);
    const float* X = (const float*)(wsb + a.off[R_X]); bf16* XN = (bf16*)(wsb + a.off[R_XN]); const float* g = GIN(a, gi) + (size_t)l * D_MODEL;
    const int gw = F.vcu * NWAVES + wave, NGW = F.G * NWAVES;
    for (int m = gw; m < RP; m += NGW) rms_row_to_bf16(X + (size_t)m * D_MODEL, g, XN + (size_t)m * D_MODEL, lane);
}
__device__ __forceinline__ void unpack8(const v4u w, float (&f)[8]) { f[0] = bflo(w.x); f[1] = bfhi(w.x); f[2] = bflo(w.y); f[3] = bfhi(w.y); f[4] = bflo(w.z); f[5] = bfhi(w.z); f[6] = bflo(w.w); f[7] = bfhi(w.w); }
__device__ __forceinline__ v4u pack8(const float (&f)[8]) { v4u w; w.x = pk2(f[0], f[1]); w.y = pk2(f[2], f[3]); w.z = pk2(f[4], f[5]); w.w = pk2(f[6], f[7]); return w; }
__device__ __forceinline__ float sigm(float x) { return __builtin_amdgcn_rcpf(1.f + __expf(-x)); }
constexpr float ATT_C2 = 0.125f * 1.4426950408889634f;
__device__ __forceinline__ void p_zpost(Frame& F, int l) {
    const KArgs ap = kargs(); const auto& a = *ap; WS_OPAQUE(a);
    const bf16* Z = (const bf16*)(wsb + a.off[R_Z]);
    bf16* QN = (bf16*)(wsb + a.off[R_QN]); bf16* KN = (bf16*)(wsb + a.off[R_KN]); bf16* QKVB = (bf16*)(wsb + a.off[R_QKVB]); float* BG = (float*)(wsb + a.off[R_BG]);
    const int tid = otid(), lane = tid & 63, wave = __builtin_amdgcn_readfirstlane(tid >> 6);
    const int gw = F.vcu * NWAVES + wave, NGW = F.G * NWAVES;
    float gq[8], gk[8], cw[3][4][8];
#pragma unroll
    for (int j = 0; j < 8; ++j) { gq[j] = GIN(a, I_QN)[l * HEAD_DIM_A + 8 * (lane & 7) + j] * ATT_C2; gk[j] = GIN(a, I_KN)[l * HEAD_DIM_A + 8 * (lane & 7) + j]; }
#pragma unroll
    for (int w = 0; w < 3; ++w)
#pragma unroll
        for (int i = 0; i < 4; ++i)
#pragma unroll
            for (int j = 0; j < 8; ++j) cw[w][i][j] = GIN(a, I_CONVW)[((size_t)l * CONV_W + i) * 3 * WIDTH_B + w * WIDTH_B + 8 * lane + j];
    float alog = 0.f, dtb = 0.f; if (lane < 4) { alog = GIN(a, I_ALOG)[l * N_HEADS_B + lane]; dtb = GIN(a, I_DTB)[l * N_HEADS_B + lane]; }
    for (int m = gw; m < RP; m += NGW) {
        const bool valid = prow_valid(m); const int nat = valid ? prow2nat(m) : 0;
        const bf16* zr = Z + (size_t)m * ZN;
        float f[8], o[8];
        unpack8(*(const GAS v4u*)(zr + ZC_QA + 8 * lane), f);
        { float ss = 0.f;
#pragma unroll
          for (int j = 0; j < 8; ++j) ss += f[j] * f[j];
          ss = sum8(ss);
          const float r = __builtin_amdgcn_rsqf(ss * (1.f / HEAD_DIM_A) + EPSF);
#pragma unroll
          for (int j = 0; j < 8; ++j) o[j] = f[j] * r * gq[j];
          *(GAS v4u*)(QN + (size_t)m * WIDTH_A + 8 * lane) = pack8(o); }
        unpack8(*(const GAS v4u*)(zr + ZC_KA + 8 * lane), f);
        { float ss = 0.f;
#pragma unroll
          for (int j = 0; j < 8; ++j) ss += f[j] * f[j];
          ss = sum8(ss);
          const float r = __builtin_amdgcn_rsqf(ss * (1.f / HEAD_DIM_A) + EPSF);
#pragma unroll
          for (int j = 0; j < 8; ++j) o[j] = f[j] * r * gk[j];
          *(GAS v4u*)(KN + (size_t)m * WIDTH_A + 8 * lane) = pack8(o);
          if (valid) { float* ko = nat < NP ? GOUT(a) + O_KP + ((size_t)l * NP + nat) * WIDTH_A : GOUT(a) + O_KS + ((size_t)l * NS + (nat - NP)) * WIDTH_A;
              *(GAS f32x4*)(ko + 8 * lane) = (f32x4){o[0], o[1], o[2], o[3]}; *(GAS f32x4*)(ko + 8 * lane + 4) = (f32x4){o[4], o[5], o[6], o[7]}; } }
        if (valid) { unpack8(*(const GAS v4u*)(zr + ZC_VA + 8 * lane), f);
            float* vo = nat < NP ? GOUT(a) + O_VP + ((size_t)l * NP + nat) * WIDTH_A : GOUT(a) + O_VS + ((size_t)l * NS + (nat - NP)) * WIDTH_A;
            *(GAS f32x4*)(vo + 8 * lane) = (f32x4){f[0], f[1], f[2], f[3]}; *(GAS f32x4*)(vo + 8 * lane + 4) = (f32x4){f[4], f[5], f[6], f[7]}; }
        const int ts = m >= SROW0 ? (m - SROW0) % DEC_SEQ : 1000; const int bs = m >= SROW0 ? (m - SROW0) / DEC_SEQ : 0;
        int cj = -1;
        if (m >= SROW0) { if (ts >= DEC_SEQ - 3) cj = ts - (DEC_SEQ - 3); } else { const int p = m % LPP; if (p >= PEND - 3 && p < PEND) cj = p - (PEND - 3); }
#pragma unroll
        for (int w = 0; w < 3; ++w) {
            float acc[8];
#pragma unroll
            for (int j = 0; j < 8; ++j) acc[j] = 0.f;
#pragma unroll
            for (int i = 0; i < 4; ++i) {
                const int dt = i - 3;
                if (ts + dt < 0) {
                    const float* sc = GIN(a, I_SCONV) + (((size_t)l * DEC_BATCH + bs) * (CONV_W - 1) + (CONV_W - 1 + ts + dt)) * 3 * WIDTH_B + w * WIDTH_B + 8 * lane;
                    const f32x4 s0 = *(const GAS f32x4*)sc, s1 = *(const GAS f32x4*)(sc + 4);
                    f[0] = s0.x; f[1] = s0.y; f[2] = s0.z; f[3] = s0.w; f[4] = s1.x; f[5] = s1.y; f[6] = s1.z; f[7] = s1.w;
                } else if (m + dt >= 0) unpack8(*(const GAS v4u*)(Z + (size_t)(m + dt) * ZN + ZC_QKVB + w * WIDTH_B + 8 * lane), f);
                else {
#pragma unroll
                    for (int j = 0; j < 8; ++j) f[j] = 0.f; }
#pragma unroll
                for (int j = 0; j < 8; ++j) acc[j] += f[j] * cw[w][i][j];
                if (i == 3 && cj >= 0) {
                    float* co = m >= SROW0 ? GOUT(a) + O_CS + (((size_t)l * DEC_BATCH + bs) * (CONV_W - 1) + cj) * 3 * WIDTH_B : GOUT(a) + O_CP + (((size_t)l * BATCH + m / LPP) * (CONV_W - 1) + cj) * 3 * WIDTH_B;
                    *(GAS f32x4*)(co + w * WIDTH_B + 8 * lane) = (f32x4){f[0], f[1], f[2], f[3]}; *(GAS f32x4*)(co + w * WIDTH_B + 8 * lane + 4) = (f32x4){f[4], f[5], f[6], f[7]}; }
            }
            float ss = 0.f;
#pragma unroll
            for (int j = 0; j < 8; ++j) { acc[j] = acc[j] * sigm(acc[j]); ss += acc[j] * acc[j]; }
            float sc = 1.f;
            if (w < 2) { ss = sum16(ss);
                sc = __builtin_amdgcn_rsqf(ss + EPSF); if (w == 0) sc *= 0.08838834764831845f; }
#pragma unroll
            for (int j = 0; j < 8; ++j) o[j] = acc[j] * sc;
            *(GAS v4u*)(QKVB + (size_t)m * 3 * WIDTH_B + w * WIDTH_B + 8 * lane) = pack8(o);
        }
        if (lane < 4) { const float be = bf2f(zr[ZC_BA + lane]), al = bf2f(zr[ZC_BA + 4 + lane]) + dtb;
            const float sp = al > 20.f ? al : __logf(1.f + __expf(al));
            BG[(size_t)m * 8 + lane] = valid ? sigm(be) : 0.f; BG[(size_t)m * 8 + 4 + lane] = valid ? -__expf(alog) * sp : 0.f; }
    }
}
constexpr float LOG2E = 1.4426950408889634f;
__device__ __forceinline__ int t5_bucket_dev(int rel) {
    const int n = rel < 0 ? -rel : rel; int b;
    if (n < 8) b = n; else if (n < 12) b = 8; else if (n < 16) b = 9; else if (n < 23) b = 10; else if (n < 32) b = 11;
    else if (n < 46) b = 12; else if (n < 64) b = 13; else if (n < 91) b = 14; else b = 15;
    return b + (rel > 0 ? 16 : 0);
}
__device__ __forceinline__ void build_bias_table(LAS float* tab, const float* rel_bias, int h, int tid) {
    const float far = rel_bias[15 * N_HEADS_A + h];
    for (int i = tid; i < attn_body::BT_N; i += NTHR) tab[i] = (rel_bias[t5_bucket_dev(i - attn_body::BT_OFF) * N_HEADS_A + h] - far) * LOG2E;
}
__device__ __forceinline__ float lam_init_dev(int l) { return 0.8f - 0.6f * __expf(-0.3f * (float)l); }
__device__ __forceinline__ float lam_dev(const float* lqk_all, int l, int lane) {
    const float* q = lqk_all + (size_t)l * 4 * HEAD_DIM_A;
    const float s0 = wave_sum(q[lane] * q[HEAD_DIM_A + lane]), s1 = wave_sum(q[2 * HEAD_DIM_A + lane] * q[3 * HEAD_DIM_A + lane]);
    return __expf(s0) - __expf(s1) + lam_init_dev(l);
}
__device__ __forceinline__ int krow_dev(int s, int h, int j) { return 16 * s + 8 * (j >> 2) + 4 * h + (j & 3); }
__device__ __forceinline__ int crow_dev(int r, int h) { return (r & 3) + 8 * (r >> 2) + 4 * h; }
__device__ __forceinline__ bf16x8 pack_f8(const f32x4 a, const f32x4 b) { v4u w; w.x = pk2(a.x, a.y); w.y = pk2(a.z, a.w); w.z = pk2(b.x, b.y); w.w = pk2(b.z, b.w); return __builtin_bit_cast(bf16x8, w); }

__device__ __forceinline__ void sample_scores(f32x16& X, int kb, int c, const float* ck, const bf16* KN, int row0, int h, int hi, int r32, int qpos, const bf16x8 (&qf)[4], const LAS float* tab) {
    bf16x8 kf[4];
    if (kb < PAST_LEN / 32) { const float* kr = ck + (size_t)(kb * 32 + r32) * WIDTH_A + h * 128 + c * 64 + 8 * hi;
#pragma unroll
        for (int s = 0; s < 4; ++s) kf[s] = pack_f8(*(const GAS f32x4*)(kr + 16 * s), *(const GAS f32x4*)(kr + 16 * s + 4)); }
    else { const bf16* kr = KN + (size_t)(row0 + (kb * 32 - PAST_LEN) + r32) * WIDTH_A + h * 128 + c * 64 + 8 * hi;
#pragma unroll
        for (int s = 0; s < 4; ++s) kf[s] = *(const GAS bf16x8*)(kr + 16 * s); }
#pragma unroll
    for (int i = 0; i < 16; ++i) X[i] = 0.f;
#pragma unroll
    for (int s = 0; s < 4; ++s) X = __builtin_amdgcn_mfma_f32_32x32x16_bf16(kf[s], qf[s], X, 0, 0, 0);
#pragma unroll
    for (int i = 0; i < 16; ++i) { int idx = kb * 32 + crow_dev(i, hi) - qpos + attn_body::BT_OFF; idx = idx < 0 ? 0 : idx; X[i] += tab[idx]; }
}

__device__ __forceinline__ void attn_sample_unit(Frame& F, int l, int bs, int h) {
    const KArgs ap = kargs(); const auto& a = *ap; WS_OPAQUE(a);
    const int tid = otid(), lane = tid & 63, wid = __builtin_amdgcn_readfirstlane(tid >> 6), r32 = lane & 31, hi = lane >> 5;
    const bf16* QN = (const bf16*)(wsb + a.off[R_QN]); const bf16* KN = (const bf16*)(wsb + a.off[R_KN]); const bf16* Z = (const bf16*)(wsb + a.off[R_Z]); bf16* O = (bf16*)(wsb + a.off[R_O]);
    const float* ck = GIN(a, I_CK) + ((size_t)l * DEC_BATCH + bs) * PAST_LEN * WIDTH_A; const float* cv = GIN(a, I_CV) + ((size_t)l * DEC_BATCH + bs) * PAST_LEN * WIDTH_A;
    const int row0 = SROW0 + bs * DEC_SEQ;
    LAS float* tab = (LAS float*)(F.lds + RING_OFF + attn_body::LDS_BT);
    LAS float* st = (LAS float*)(F.lds + RING_OFF + 90112);
    LAS float* slot = (LAS float*)(F.lds + RING_OFF);
    const float lam = lam_dev(GIN(a, I_LQK), l, lane);
    build_bias_table(tab, GIN(a, I_REL), h, tid);
    bf16x8 qf[2][4];
#pragma unroll
    for (int c = 0; c < 2; ++c)
#pragma unroll
        for (int s = 0; s < 4; ++s) qf[c][s] = *(const GAS bf16x8*)(QN + (size_t)(row0 + r32) * WIDTH_A + h * 128 + c * 64 + 16 * s + 8 * hi);
    __syncthreads();
    float m[2] = {-1e30f, -1e30f}, lsum[2] = {0.f, 0.f};
    const int qpos = PAST_LEN + r32;
    for (int kb = wid; kb < (PAST_LEN + DEC_SEQ) / 32; kb += NWAVES) {
#pragma unroll
        for (int c = 0; c < 2; ++c) { f32x16 X; sample_scores(X, kb, c, ck, KN, row0, h, hi, r32, qpos, qf[c], tab);
            float mx = X[0];
#pragma unroll
            for (int i = 1; i < 16; ++i) mx = fmaxf(mx, X[i]);
            mx = fmaxf(mx, swap32(mx)); const float mn = fmaxf(m[c], mx);
            float sum = 0.f;
#pragma unroll
            for (int i = 0; i < 16; ++i) sum += exp2f(X[i] - mn);
            lsum[c] = lsum[c] * exp2f(m[c] - mn) + sum; m[c] = mn; }
    }
#pragma unroll
    for (int c = 0; c < 2; ++c) { lsum[c] += swap32(lsum[c]); if (hi == 0) { st[((wid * 2 + c) * 2 + 0) * 32 + r32] = m[c]; st[((wid * 2 + c) * 2 + 1) * 32 + r32] = lsum[c]; } }
    __syncthreads();
    float gm[2], ginv[2];
#pragma unroll
    for (int c = 0; c < 2; ++c) { float mm = -1e30f;
#pragma unroll
        for (int w = 0; w < NWAVES; ++w) mm = fmaxf(mm, st[((w * 2 + c) * 2 + 0) * 32 + r32]);
        float ll = 0.f;
#pragma unroll
        for (int w = 0; w < NWAVES; ++w) ll += st[((w * 2 + c) * 2 + 1) * 32 + r32] * exp2f(st[((w * 2 + c) * 2 + 0) * 32 + r32] - mm);
        gm[c] = mm; ginv[c] = (c == 0 ? 1.f : lam) / ll; }
    f32x16 acc[4];
#pragma unroll
    for (int eb = 0; eb < 4; ++eb)
#pragma unroll
        for (int i = 0; i < 16; ++i) acc[eb][i] = 0.f;
    for (int kb = wid; kb < (PAST_LEN + DEC_SEQ) / 32; kb += NWAVES) {
        f32x16 X0, X1; sample_scores(X0, kb, 0, ck, KN, row0, h, hi, r32, qpos, qf[0], tab); sample_scores(X1, kb, 1, ck, KN, row0, h, hi, r32, qpos, qf[1], tab);
        float wv[16];
#pragma unroll
        for (int i = 0; i < 16; ++i) wv[i] = exp2f(X0[i] - gm[0]) * ginv[0] - exp2f(X1[i] - gm[1]) * ginv[1];
        bf16x8 xs[2];
#pragma unroll
        for (int s = 0; s < 2; ++s) { v4u w; w.x = pk2(wv[8 * s], wv[8 * s + 1]); w.y = pk2(wv[8 * s + 2], wv[8 * s + 3]); w.z = pk2(wv[8 * s + 4], wv[8 * s + 5]); w.w = pk2(wv[8 * s + 6], wv[8 * s + 7]); xs[s] = __builtin_bit_cast(bf16x8, w); }
#pragma unroll
        for (int eb = 0; eb < 4; ++eb)
#pragma unroll
            for (int s = 0; s < 2; ++s) {
                float vv[8];
                if (kb < PAST_LEN / 32) { const GAS float* vb = (const GAS float*)(cv + (size_t)(kb * 32 + 4 * hi) * WIDTH_A + h * 128 + eb * 32 + r32); asm volatile("" : "+v"(vb));
#pragma unroll
                    for (int j = 0; j < 8; ++j) vv[j] = vb[(size_t)(16 * s + 8 * (j >> 2) + (j & 3)) * WIDTH_A]; }
                else { const GAS bf16* vb = (const GAS bf16*)(Z + (size_t)(row0 + kb * 32 - PAST_LEN + 4 * hi) * ZN + ZC_VA + h * 128 + eb * 32 + r32); asm volatile("" : "+v"(vb));
#pragma unroll
                    for (int j = 0; j < 8; ++j) vv[j] = bf2f(vb[(size_t)(16 * s + 8 * (j >> 2) + (j & 3)) * ZN]); }
                v4u w; w.x = pk2(vv[0], vv[1]); w.y = pk2(vv[2], vv[3]); w.z = pk2(vv[4], vv[5]); w.w = pk2(vv[6], vv[7]);
                acc[eb] = __builtin_amdgcn_mfma_f32_32x32x16_bf16(xs[s], __builtin_bit_cast(bf16x8, w), acc[eb], 0, 0, 0);
            }
    }
    __syncthreads();
#pragma unroll
    for (int eb = 0; eb < 4; ++eb)
#pragma unroll
        for (int i = 0; i < 16; ++i) slot[(wid * 32 + crow_dev(i, hi)) * 128 + eb * 32 + r32] = acc[eb][i];
    __syncthreads();
    { const int q = tid >> 4, e0 = (tid & 15) * 8; float o[8];
#pragma unroll
      for (int j = 0; j < 8; ++j) o[j] = 0.f;
#pragma unroll
      for (int w = 0; w < NWAVES; ++w)
#pragma unroll
          for (int j = 0; j < 8; ++j) o[j] += slot[(w * 32 + q) * 128 + e0 + j];
      v4u pw; pw.x = pk2(o[0], o[1]); pw.y = pk2(o[2], o[3]); pw.z = pk2(o[4], o[5]); pw.w = pk2(o[6], o[7]);
      bf16* orow = O + (size_t)(row0 + q) * attn_body::OP + h * 256;
      unsigned zq = 0u; asm volatile("" : "+v"(zq));
      *(GAS v4u*)(orow + e0) = pw; *(GAS v4u*)(orow + 128 + e0) = (v4u){zq, zq, zq, zq}; }
    __syncthreads();
}

constexpr int ATT_NQB = LPP / 256;
constexpr int ATT_NPU = BATCH * 16 * ATT_NQB;
constexpr int ATT_NSU = DEC_BATCH * N_HEADS_A;
__device__ __forceinline__ void p_attention(Frame& F, int lq, unsigned char* ldsg) {
    const int l = lq % DEPTH;
    for (;;) {
        const KArgs ap = kargs(); const auto& a = *ap; WS_OPAQUE(a);
        const int tid = otid();
        gu32* head = (gu32*)wsb + CW_QUEUE + 64 * lq;
        const attn_body::bf16* QN = (const attn_body::bf16*)(wsb + a.off[R_QN]); const attn_body::bf16* KN = (const attn_body::bf16*)(wsb + a.off[R_KN]);
        const attn_body::bf16* Z = (const attn_body::bf16*)(wsb + a.off[R_Z]); attn_body::bf16* O = (attn_body::bf16*)(wsb + a.off[R_O]);
        if (tid == 0) F.MISC[16] = __hip_atomic_fetch_add(head, 1u, RLX_AGENT);
        __syncthreads();
        const int u = (int)F.MISC[16];
        __syncthreads();
        if (u >= ATT_NPU + ATT_NSU) break;
        if (u < ATT_NPU) {
            const int qb = (ATT_NQB - 1) - u / 32, bvh = u % 32, b = bvh >> 4, vh = bvh & 15, h = vh >> 2, c = (vh >> 1) & 1, half = vh & 1;
            build_bias_table((LAS float*)(F.lds + RING_OFF + attn_body::LDS_BT), GIN(a, I_REL), h, tid);
            __syncthreads();
            attn_body::attn_unit<8>(b, h * 128 + c * 64, ZC_VA + h * 128 + half * 64, h * 256 + c * 128 + half * 64, qb, QN, KN, Z, O, (char*)ldsg + RING_OFF, F.wv);
        } else { const int su = u - ATT_NPU; attn_sample_unit(F, l, su >> 2, su & 3); }
    }
}
__device__ __forceinline__ void p_mixpost_a(Frame& F, int l) {
    const KArgs ap = kargs(); const auto& a = *ap; WS_OPAQUE(a);
    const int tid = otid(), lane = tid & 63, wave = __builtin_amdgcn_readfirstlane(tid >> 6);
    const bf16* O = (const bf16*)(wsb + a.off[R_O]); bf16* OA = (bf16*)(wsb + a.off[R_OA]);
    const int gw = F.vcu * NWAVES + wave, NGW = F.G * NWAVES;
    const float lam = lam_dev(GIN(a, I_LQK), l, lane), post = 1.f - lam_init_dev(l);
    const int h = lane >> 4, e0 = 8 * (lane & 15);
    float sg[8];
#pragma unroll
    for (int j = 0; j < 8; ++j) sg[j] = GIN(a, I_SUBLN)[l * 2 * HEAD_DIM_A + e0 + j] * post;
    for (int m = gw; m < RP; m += NGW) {
        float o0[8], o1[8], d[8];
        unpack8(*(const GAS v4u*)(O + (size_t)m * 1024 + h * 256 + e0), o0); unpack8(*(const GAS v4u*)(O + (size_t)m * 1024 + h * 256 + 128 + e0), o1);
        float ss = 0.f;
#pragma unroll
        for (int j = 0; j < 8; ++j) { d[j] = o0[j] - lam * o1[j]; ss += d[j] * d[j]; }
        ss = sum16(ss);
        const float r = __builtin_amdgcn_rsqf(ss * (1.f / 128.f) + EPSF);
#pragma unroll
        for (int j = 0; j < 8; ++j) d[j] = d[j] * r * sg[j];
        *(GAS v4u*)(OA + (size_t)m * WIDTH_A + h * 128 + e0) = pack8(d);
    }
}
constexpr int GDN_NCH = PEND / 64;
constexpr int GDN_NPI = BATCH * N_HEADS_B * GDN_NCH;
constexpr int GDN_NSI = DEC_BATCH * N_HEADS_B;
constexpr int GDN_NI = GDN_NPI + GDN_NSI;
constexpr int GI_W = 0, GI_QG = 16384, GI_KG = 32768, GI_AT = 49152, GI_U = 57344, GI_SC = 73728, GI_STRIDE = 73984;
static_assert(GDN_NI % 4 == 0 && PEND % 64 == 0, "gdn items");
__device__ __forceinline__ int frag_off(int row, int kk, int nkb) {
    const int fid = ((row >> 5) * nkb + (kk >> 5)) * 2 + ((kk & 31) >> 4), ln = (row & 31) + 32 * (((kk & 15) >> 2) & 1), j = ((kk & 15) >> 3) * 4 + (kk & 3);
    return (fid * 64 + ln) * 8 + j;
}
__device__ __forceinline__ int gdn_item_row(int item, int j) {
    if (item < GDN_NPI) { const int sh = item / GDN_NCH, n = item % GDN_NCH; return (sh / N_HEADS_B) * LPP + 64 * n + j; }
    const int s = item - GDN_NPI; return j < 32 ? -1 : SROW0 + (s >> 2) * DEC_SEQ + (j - 32);
}
__device__ __forceinline__ int gdn_item_head(int item) { return item < GDN_NPI ? (item / GDN_NCH) % N_HEADS_B : (item - GDN_NPI) & 3; }

__device__ __forceinline__ void gdn_flush(const LAS unsigned char* stg, unsigned char* dst, int nbytes, int gt) {
    for (int o = gt * 16; o < nbytes; o += 2048) *(GAS v4u*)(dst + o) = *(const LAS v4u*)(stg + o);
}
typedef float f32x2s __attribute__((ext_vector_type(2)));
#define GDN_RL8(a, arow, jb) asm volatile("v_readlane_b32 %0, %8, %9\n\tv_readlane_b32 %1, %8, %10\n\tv_readlane_b32 %2, %8, %11\n\tv_readlane_b32 %3, %8, %12\n\tv_readlane_b32 %4, %8, %13\n\tv_readlane_b32 %5, %8, %14\n\tv_readlane_b32 %6, %8, %15\n\tv_readlane_b32 %7, %8, %16" \
    : "=s"(a[0]), "=s"(a[1]), "=s"(a[2]), "=s"(a[3]), "=s"(a[4]), "=s"(a[5]), "=s"(a[6]), "=s"(a[7]) : "v"(arow), "i"(jb), "i"((jb) + 1), "i"((jb) + 2), "i"((jb) + 3), "i"((jb) + 4), "i"((jb) + 5), "i"((jb) + 6), "i"((jb) + 7))
template <int I, int JB> __device__ __forceinline__ void gdn_subst_blk(f32x2s (&x)[64], float arow) {
    if constexpr (JB < I) { float ar[8]; GDN_RL8(ar, arow, JB);
#pragma unroll
        for (int t = 0; t < 8; ++t) if (JB + t < I) x[I] -= ar[t] * x[JB + t];
        gdn_subst_blk<I, JB + 8>(x, arow); }
}
template <int... Is> __device__ __forceinline__ void gdn_subst_all(f32x2s (&x)[64], const LAS float* A, int lane, std::integer_sequence<int, Is...>) {
    (gdn_subst_blk<Is + 1, 0>(x, A[(Is + 1) * 64 + lane]), ...);
}
__device__ __forceinline__ void p_gdn_chunk(Frame& F, int l) {
    const KArgs ap = kargs(); const auto& a = *ap; WS_OPAQUE(a);
    const int tid = otid(), wave = __builtin_amdgcn_readfirstlane(tid >> 6), grp = wave >> 1, gw = wave & 1;
    const bf16* QKVB = (const bf16*)(wsb + a.off[R_QKVB]); const float* BG = (const float*)(wsb + a.off[R_BG]); unsigned char* GD = wsb + a.off[R_GDN];
    LAS float* A_lds = (LAS float*)(F.lds + RING_OFF + grp * 34816);
    LAS float* Gs = A_lds + 4096; LAS float* Bs = Gs + 64; LAS float* Es = Bs + 64;
    LAS unsigned char* stg = (LAS unsigned char*)(A_lds + 4096 + 256);
    LAS bf16* stgh = (LAS bf16*)stg;
    static_assert(4 * 34816 <= RING_BYTES && GDN_NI % 4 == 0, "gdn chunk LDS / items");
    for (int pr = F.vcu; 4 * pr < GDN_NI; pr += F.G) {
        int lane_ = otid() & 63;
        const int lane = lane_, r32 = lane & 31, hi = lane >> 5, gt = gw * 64 + lane;
        const int item = 4 * pr + grp, h = gdn_item_head(item);
        unsigned char* ib = GD + (size_t)item * GI_STRIDE;
        const int rowt = gdn_item_row(item, lane);
        const float beta = rowt >= 0 ? BG[(size_t)rowt * 8 + h] : 0.f; float G = rowt >= 0 ? BG[(size_t)rowt * 8 + 4 + h] : 0.f;
        G = scan64(G);
        const float Glast = rdlane(G, 63), eG = __expf(G);
        if (gw == 0) { Gs[lane] = G; Bs[lane] = beta; Es[lane] = eG; if (lane == 0) *(float*)(ib + GI_SC) = __expf(Glast); }
        __syncthreads();
#pragma unroll
        for (int bq = 0; bq < 2; ++bq) {
          const int i0 = 32 * gw, j0 = 32 * bq; const int j = j0 + r32;
          if (gw == 0 && bq == 1) {
#pragma unroll
              for (int r = 0; r < 16; ++r) { const int i = crow_dev(r, hi); A_lds[i * 64 + j] = 0.f; stgh[frag_off(i, j, 2)] = (bf16)0; }
          } else {
          const int ra = gdn_item_row(item, i0 + r32), rb = gdn_item_row(item, j0 + r32);
          f32x16 akk, aqk;
#pragma unroll
          for (int r = 0; r < 16; ++r) { akk[r] = 0.f; aqk[r] = 0.f; }
          const bf16x8 zf = {0, 0, 0, 0, 0, 0, 0, 0};
#pragma unroll
          for (int s = 0; s < 8; ++s) {
              const bf16x8 qa = ra >= 0 ? *(const GAS bf16x8*)(QKVB + (size_t)ra * 1536 + h * 128 + 16 * s + 8 * hi) : zf;
              const bf16x8 ka = ra >= 0 ? *(const GAS bf16x8*)(QKVB + (size_t)ra * 1536 + 512 + h * 128 + 16 * s + 8 * hi) : zf;
              const bf16x8 kb = rb >= 0 ? *(const GAS bf16x8*)(QKVB + (size_t)rb * 1536 + 512 + h * 128 + 16 * s + 8 * hi) : zf;
              akk = __builtin_amdgcn_mfma_f32_32x32x16_bf16(ka, kb, akk, 0, 0, 0); aqk = __builtin_amdgcn_mfma_f32_32x32x16_bf16(qa, kb, aqk, 0, 0, 0);
          }
          const float Gj = Gs[j];
#pragma unroll
          for (int r = 0; r < 16; ++r) { const int i = i0 + crow_dev(r, hi); const float dec = i >= j ? __expf(Gs[i] - Gj) : 0.f;
              A_lds[i * 64 + j] = i > j ? Bs[i] * akk[r] * dec : 0.f;
              stgh[frag_off(i, j, 2)] = (bf16)f2bf(aqk[r] * dec); }
          }
        }
        __syncthreads();
        gdn_flush(stg, ib + GI_AT, 8192, gt);
        { f32x2s x[64]; const int cbase = gw == 0 ? 1024 + h * 128 : 512 + h * 128;
#pragma unroll
          for (int i = 0; i < 64; ++i) { const int ri = __builtin_amdgcn_readfirstlane(gdn_item_row(item, i));
              const bf16* rowp = QKVB + (size_t)(ri < 0 ? 0 : ri) * 1536 + cbase;
              x[i] = ri >= 0 ? (f32x2s){bf2f(rowp[lane]), bf2f(rowp[lane + 64])} : (f32x2s){0.f, 0.f}; }
          const float rsc = gw == 0 ? beta : beta * eG;
#pragma unroll
          for (int i = 0; i < 64; ++i) x[i] *= rdlane(rsc, i);
          gdn_subst_all(x, A_lds, lane, std::make_integer_sequence<int, 63>{});
          __syncthreads();
          if (gw == 0) { GAS bf16* ub = (GAS bf16*)(ib + GI_U) + lane; asm volatile("" : "+v"(ub));
#pragma unroll
              for (int i = 0; i < 64; ++i) { ub[i * 128] = (bf16)f2bf(x[i].x); ub[i * 128 + 64] = (bf16)f2bf(x[i].y); } }
          else { LAS bf16* wb0 = stgh + frag_off(0, lane, 4); LAS bf16* wb1 = stgh + frag_off(0, lane + 64, 4);
#pragma unroll
              for (int i = 0; i < 64; ++i) { wb0[(i >> 5) * 4096 + (i & 31) * 8] = (bf16)f2bf(x[i].x); wb1[(i >> 5) * 4096 + (i & 31) * 8] = (bf16)f2bf(x[i].y); } }
        }
        __syncthreads();
        gdn_flush(stg, ib + GI_W, 16384, gt);
        __syncthreads();
        const float kgs = __expf(Glast - G);
#pragma unroll
        for (int hf = 0; hf < 2; ++hf) { float qv[32];
#pragma unroll
          for (int it = 0; it < 32; ++it) { const int c = it + 32 * hf, rc = __builtin_amdgcn_readfirstlane(gdn_item_row(item, c)); const bf16* rowp = QKVB + (size_t)(rc < 0 ? 0 : rc) * 1536 + h * 128; qv[it] = rc >= 0 ? bf2f(rowp[gt]) : 0.f; }
#pragma unroll
          for (int it = 0; it < 32; ++it) { const int c = it + 32 * hf; stgh[frag_off(c, gt, 4)] = (bf16)f2bf(qv[it] * rdlane(eG, c)); } }
        __syncthreads();
        gdn_flush(stg, ib + GI_QG, 16384, gt);
        __syncthreads();
#pragma unroll
        for (int hf = 0; hf < 2; ++hf) { float kv[32];
#pragma unroll
          for (int it = 0; it < 32; ++it) { const int c = it + 32 * hf, rc = __builtin_amdgcn_readfirstlane(gdn_item_row(item, c)); const bf16* rowp = QKVB + (size_t)(rc < 0 ? 0 : rc) * 1536 + 512 + h * 128; kv[it] = rc >= 0 ? bf2f(rowp[gt]) : 0.f; }
#pragma unroll
          for (int it = 0; it < 32; ++it) { const int c = it + 32 * hf; stgh[frag_off(gt, c, 2)] = (bf16)f2bf(kv[it] * rdlane(kgs, c)); } }
        __syncthreads();
        gdn_flush(stg, ib + GI_KG, 16384, gt);
        __syncthreads();
    }
}

__device__ __forceinline__ void gdn_chain(const unsigned char* GD, bf16* OB, const float* sdelta, float* dout, int item0, int nch, int h, int vb, int lane) {
    const int r32 = lane & 31, hi = lane >> 5;
    f32x16 S[4];
#pragma unroll
    for (int kb = 0; kb < 4; ++kb)
#pragma unroll
        for (int r = 0; r < 16; ++r) S[kb][r] = sdelta ? sdelta[(size_t)(kb * 32 + crow_dev(r, hi)) * HEAD_DIM_B + vb * 32 + r32] : 0.f;
    for (int n = 0; n < nch; ++n) {
        const int item = item0 + n; const unsigned char* ib = GD + (size_t)item * GI_STRIDE;
        const float eGl = *(const float*)(ib + GI_SC);
        const GAS bf16x8* WF = (const GAS bf16x8*)(ib + GI_W) + lane; const GAS bf16x8* QF = (const GAS bf16x8*)(ib + GI_QG) + lane;
        const GAS bf16x8* KF = (const GAS bf16x8*)(ib + GI_KG) + lane; const GAS bf16x8* AF = (const GAS bf16x8*)(ib + GI_AT) + lane; const bf16* U = (const bf16*)(ib + GI_U);
        bf16x8 Sp[4][2];
#pragma unroll
        for (int kb = 0; kb < 4; ++kb)
#pragma unroll
            for (int s = 0; s < 2; ++s) { v4u w; w.x = pk2(S[kb][8 * s], S[kb][8 * s + 1]); w.y = pk2(S[kb][8 * s + 2], S[kb][8 * s + 3]); w.z = pk2(S[kb][8 * s + 4], S[kb][8 * s + 5]); w.w = pk2(S[kb][8 * s + 6], S[kb][8 * s + 7]); Sp[kb][s] = __builtin_bit_cast(bf16x8, w); }
        f32x16 vn[2], ot[2];
#pragma unroll
        for (int cb = 0; cb < 2; ++cb) {
            f32x16 ws;
#pragma unroll
            for (int r = 0; r < 16; ++r) { ws[r] = 0.f; ot[cb][r] = 0.f; }
#pragma unroll
            for (int kb = 0; kb < 4; ++kb)
#pragma unroll
                for (int s = 0; s < 2; ++s) { ws = __builtin_amdgcn_mfma_f32_32x32x16_bf16(WF[((cb * 4 + kb) * 2 + s) * 64], Sp[kb][s], ws, 0, 0, 0);
                    ot[cb] = __builtin_amdgcn_mfma_f32_32x32x16_bf16(QF[((cb * 4 + kb) * 2 + s) * 64], Sp[kb][s], ot[cb], 0, 0, 0); }
#pragma unroll
            for (int r = 0; r < 16; ++r) vn[cb][r] = bf2f(U[(cb * 32 + crow_dev(r, hi)) * 128 + vb * 32 + r32]) - ws[r];
        }
        bf16x8 Vp[2][2];
#pragma unroll
        for (int cb = 0; cb < 2; ++cb)
#pragma unroll
            for (int s = 0; s < 2; ++s) { v4u w; w.x = pk2(vn[cb][8 * s], vn[cb][8 * s + 1]); w.y = pk2(vn[cb][8 * s + 2], vn[cb][8 * s + 3]); w.z = pk2(vn[cb][8 * s + 4], vn[cb][8 * s + 5]); w.w = pk2(vn[cb][8 * s + 6], vn[cb][8 * s + 7]); Vp[cb][s] = __builtin_bit_cast(bf16x8, w); }
#pragma unroll
        for (int cb = 0; cb < 2; ++cb)
#pragma unroll
            for (int c2 = 0; c2 <= cb; ++c2)
#pragma unroll
                for (int s = 0; s < 2; ++s) ot[cb] = __builtin_amdgcn_mfma_f32_32x32x16_bf16(AF[((cb * 2 + c2) * 2 + s) * 64], Vp[c2][s], ot[cb], 0, 0, 0);
#pragma unroll
        for (int cb = 0; cb < 2; ++cb)
#pragma unroll
            for (int r = 0; r < 16; ++r) { const int row = gdn_item_row(item, cb * 32 + crow_dev(r, hi)); if (row >= 0) OB[(size_t)row * WIDTH_B + h * 128 + vb * 32 + r32] = (bf16)f2bf(ot[cb][r]); }
#pragma unroll
        for (int kb = 0; kb < 4; ++kb) {
#pragma unroll
            for (int r = 0; r < 16; ++r) S[kb][r] *= eGl;
#pragma unroll
            for (int cb = 0; cb < 2; ++cb)
#pragma unroll
                for (int s = 0; s < 2; ++s) S[kb] = __builtin_amdgcn_mfma_f32_32x32x16_bf16(KF[((kb * 2 + cb) * 2 + s) * 64], Vp[cb][s], S[kb], 0, 0, 0);
        }
    }
#pragma unroll
    for (int kb = 0; kb < 4; ++kb)
#pragma unroll
        for (int r = 0; r < 16; ++r) dout[(size_t)(kb * 32 + crow_dev(r, hi)) * HEAD_DIM_B + vb * 32 + r32] = S[kb][r];
}
constexpr int GCH_BUF = 73728, GCH_PCS = 18;
#define GCH_BAR() do { asm volatile("s_waitcnt lgkmcnt(0)" ::: "memory"); __builtin_amdgcn_s_barrier(); asm volatile("" ::: "memory"); } while (0)
__device__ __forceinline__ void gdn_chain_wg(Frame& F, const unsigned char* GD, bf16* OB, float* dout, int item0, int h) {
    const int tid = otid(), lane = tid & 63, wave = __builtin_amdgcn_readfirstlane(tid >> 6), r32 = lane & 31, hi = lane >> 5, vb = wave & 3;
    LAS unsigned char* lb = F.lds + RING_OFF;
    if (wave >= 4) {
        const int p0 = (wave - 4) * GCH_PCS;
        v4u R0[GCH_PCS], R1[GCH_PCS];
#define GCH_LOAD(R, c) do { const unsigned char* s_ = GD + (size_t)(item0 + (c)) * GI_STRIDE + (size_t)p0 * 1024 + lane * 16; _Pragma("unroll") for (int j = 0; j < GCH_PCS; ++j) \
            asm volatile("global_load_dwordx4 %0, %1, off" : "=&v"(R[j]) : "v"(s_ + j * 1024) : "memory"); } while (0)
#define GCH_PUT(R, c) do { if ((c) + 1 < GDN_NCH) asm volatile("s_waitcnt vmcnt(18)" ::: "memory"); else asm volatile("s_waitcnt vmcnt(0)" ::: "memory"); \
            LAS v4u* d_ = (LAS v4u*)(lb + ((c) & 1) * GCH_BUF + p0 * 1024) + lane; _Pragma("unroll") for (int j = 0; j < GCH_PCS; ++j) d_[j * 64] = R[j]; } while (0)
        GCH_LOAD(R0, 0); GCH_LOAD(R1, 1);
        GCH_PUT(R0, 0); GCH_LOAD(R0, 2);
        GCH_BAR();
        for (int n = 0; n < GDN_NCH; n += 2) {
            if (n + 1 < GDN_NCH) GCH_PUT(R1, n + 1);
            if (n + 3 < GDN_NCH) GCH_LOAD(R1, n + 3);
            GCH_BAR();
            if (n + 1 < GDN_NCH) {
                if (n + 2 < GDN_NCH) GCH_PUT(R0, n + 2);
                if (n + 4 < GDN_NCH) GCH_LOAD(R0, n + 4);
                GCH_BAR(); }
        }
        asm volatile("s_waitcnt vmcnt(0)" ::: "memory");
#undef GCH_LOAD
#undef GCH_PUT
        return;
    }
    f32x16 S[4];
#pragma unroll
    for (int kb = 0; kb < 4; ++kb)
#pragma unroll
        for (int r = 0; r < 16; ++r) S[kb][r] = 0.f;
    float eg0 = *(const float*)(GD + (size_t)item0 * GI_STRIDE + GI_SC), eg1 = *(const float*)(GD + (size_t)(item0 + 1) * GI_STRIDE + GI_SC);
    GCH_BAR();
    for (int n = 0; n < GDN_NCH; ++n) {
        const int item = item0 + n; const LAS unsigned char* bufc = lb + (n & 1) * GCH_BUF;
        const float egl = eg0; eg0 = eg1; if (n + 2 < GDN_NCH) eg1 = *(const float*)(GD + (size_t)(item + 2) * GI_STRIDE + GI_SC);
        const LAS bf16x8* WF = (const LAS bf16x8*)(bufc + GI_W) + lane; const LAS bf16x8* QF = (const LAS bf16x8*)(bufc + GI_QG) + lane;
        const LAS bf16x8* KF = (const LAS bf16x8*)(bufc + GI_KG) + lane; const LAS bf16x8* AF = (const LAS bf16x8*)(bufc + GI_AT) + lane; const LAS bf16* U = (const LAS bf16*)(bufc + GI_U);
        bf16x8 Sp[4][2];
#pragma unroll
        for (int kb = 0; kb < 4; ++kb)
#pragma unroll
            for (int s = 0; s < 2; ++s) { v4u w; w.x = pk2(S[kb][8 * s], S[kb][8 * s + 1]); w.y = pk2(S[kb][8 * s + 2], S[kb][8 * s + 3]); w.z = pk2(S[kb][8 * s + 4], S[kb][8 * s + 5]); w.w = pk2(S[kb][8 * s + 6], S[kb][8 * s + 7]); Sp[kb][s] = __builtin_bit_cast(bf16x8, w); }
        f32x16 vn[2], ot[2];
#pragma unroll
        for (int cb = 0; cb < 2; ++cb) {
            f32x16 ws;
#pragma unroll
            for (int r = 0; r < 16; ++r) { ws[r] = 0.f; ot[cb][r] = 0.f; }
#pragma unroll
            for (int kb = 0; kb < 4; ++kb)
#pragma unroll
                for (int s = 0; s < 2; ++s) { ws = __builtin_amdgcn_mfma_f32_32x32x16_bf16(WF[((cb * 4 + kb) * 2 + s) * 64], Sp[kb][s], ws, 0, 0, 0);
                    ot[cb] = __builtin_amdgcn_mfma_f32_32x32x16_bf16(QF[((cb * 4 + kb) * 2 + s) * 64], Sp[kb][s], ot[cb], 0, 0, 0); }
#pragma unroll
            for (int r = 0; r < 16; ++r) vn[cb][r] = bf2f(U[(cb * 32 + crow_dev(r, hi)) * 128 + vb * 32 + r32]) - ws[r];
        }
        bf16x8 Vp[2][2];
#pragma unroll
        for (int cb = 0; cb < 2; ++cb)
#pragma unroll
            for (int s = 0; s < 2; ++s) { v4u w; w.x = pk2(vn[cb][8 * s], vn[cb][8 * s + 1]); w.y = pk2(vn[cb][8 * s + 2], vn[cb][8 * s + 3]); w.z = pk2(vn[cb][8 * s + 4], vn[cb][8 * s + 5]); w.w = pk2(vn[cb][8 * s + 6], vn[cb][8 * s + 7]); Vp[cb][s] = __builtin_bit_cast(bf16x8, w); }
#pragma unroll
        for (int cb = 0; cb < 2; ++cb)
#pragma unroll
            for (int c2 = 0; c2 <= cb; ++c2)
#pragma unroll
                for (int s = 0; s < 2; ++s) ot[cb] = __builtin_amdgcn_mfma_f32_32x32x16_bf16(AF[((cb * 2 + c2) * 2 + s) * 64], Vp[c2][s], ot[cb], 0, 0, 0);
        { const int row0 = gdn_item_row(item, 0);
#pragma unroll
          for (int cb = 0; cb < 2; ++cb)
#pragma unroll
              for (int r = 0; r < 16; ++r) OB[(size_t)(row0 + cb * 32 + crow_dev(r, hi)) * WIDTH_B + h * 128 + vb * 32 + r32] = (bf16)f2bf(ot[cb][r]); }
#pragma unroll
        for (int kb = 0; kb < 4; ++kb) {
#pragma unroll
            for (int r = 0; r < 16; ++r) S[kb][r] *= egl;
#pragma unroll
            for (int cb = 0; cb < 2; ++cb)
#pragma unroll
                for (int s = 0; s < 2; ++s) S[kb] = __builtin_amdgcn_mfma_f32_32x32x16_bf16(KF[((kb * 2 + cb) * 2 + s) * 64], Vp[cb][s], S[kb], 0, 0, 0);
        }
        GCH_BAR();
    }
#pragma unroll
    for (int kb = 0; kb < 4; ++kb)
#pragma unroll
        for (int r = 0; r < 16; ++r) dout[(size_t)(kb * 32 + crow_dev(r, hi)) * HEAD_DIM_B + vb * 32 + r32] = S[kb][r];
}
__device__ __forceinline__ void p_gdn_chain(Frame& F, int l) {
    const KArgs ap = kargs(); const auto& a = *ap; WS_OPAQUE(a);
    const unsigned char* GD = wsb + a.off[R_GDN]; bf16* OB = (bf16*)(wsb + a.off[R_OB]);
    if (F.vcu % 32 == 0 && F.vcu / 32 < BATCH * N_HEADS_B) { const int sh = F.vcu / 32, sq = sh / N_HEADS_B, h = sh % N_HEADS_B;
        gdn_chain_wg(F, GD, OB, GOUT(a) + O_DP + (((size_t)l * BATCH + sq) * N_HEADS_B + h) * HEAD_DIM_B * HEAD_DIM_B, sh * GDN_NCH, h); }
    else { const int tid = otid(), lane = tid & 63, wave = __builtin_amdgcn_readfirstlane(tid >> 6);
        const int t = (F.vcu - F.vcu / 32 - 1) * NWAVES + wave;
        if (t < GDN_NSI * 4) { const int s = t >> 2, vb = t & 3, bs = s >> 2, h = s & 3; const size_t so = (((size_t)l * DEC_BATCH + bs) * N_HEADS_B + h) * HEAD_DIM_B * HEAD_DIM_B;
            gdn_chain(GD, OB, GIN(a, I_SDELTA) + so, GOUT(a) + O_DS + so, GDN_NPI + s, 1, h, vb, lane); } }
}
__device__ __forceinline__ void p_mixpost_b(Frame& F, int l) {
    const KArgs ap = kargs(); const auto& a = *ap; WS_OPAQUE(a);
    const int tid = otid(), lane = tid & 63, wave = __builtin_amdgcn_readfirstlane(tid >> 6);
    const bf16* OB = (const bf16*)(wsb + a.off[R_OB]); bf16* OBN = (bf16*)(wsb + a.off[R_OBN]); const bf16* Z = (const bf16*)(wsb + a.off[R_Z]);
    const int gw = F.vcu * NWAVES + wave, NGW = F.G * NWAVES, e0 = 8 * (lane & 15);
    float gn[8];
#pragma unroll
    for (int j = 0; j < 8; ++j) gn[j] = GIN(a, I_GDNN)[l * HEAD_DIM_B + e0 + j];
    for (int m = gw; m < RP; m += NGW) {
        float o[8], gt[8];
        unpack8(*(const GAS v4u*)(OB + (size_t)m * WIDTH_B + 8 * lane), o); unpack8(*(const GAS v4u*)(Z + (size_t)m * ZN + ZC_GB + 8 * lane), gt);
        float ss = 0.f;
#pragma unroll
        for (int j = 0; j < 8; ++j) ss += o[j] * o[j];
        ss = sum16(ss);
        const float r = __builtin_amdgcn_rsqf(ss * (1.f / 128.f) + EPSF);
#pragma unroll
        for (int j = 0; j < 8; ++j) o[j] = o[j] * r * gn[j] * gt[j] * sigm(gt[j]);
        *(GAS v4u*)(OBN + (size_t)m * WIDTH_B + 8 * lane) = pack8(o);
    }
}
constexpr int S5_M1 = 0, S5_M2 = 131072, S5_M3 = 196608, S5_L16 = 262144, S5_TSTRIDE = 262656;
constexpr int S5_NCHK = RP / 16;
constexpr int S5_NBLK = S5_NCHK / 32;
constexpr int S5_PCH = PEND / 16;
static_assert(S5_NCHK % 32 == 0 && LPP % 16 == 0 && PADF % 16 == 0 && S5_STATE == 64 && S5_GROUPS == 32, "s5 shapes");

__device__ __forceinline__ void s5_tables(Frame& F) {
    const KArgs ap = kargs(); const auto& a = *ap; WS_OPAQUE(a);
    const int tid = otid();
    LAS float* pw = (LAS float*)(F.lds + RING_OFF);
    LAS float* bb = pw + 17 * 128;
    LAS float* Kt = bb + 64 * 32;
    for (int it = F.vcu; it < DEPTH * S5_GROUPS; it += F.G) {
        const int l = it / S5_GROUPS, g = it % S5_GROUPS; const size_t gp = ((size_t)l * S5_GROUPS + g) * S5_STATE;
        unsigned char* tb = wsb + a.off[R_S5T] + (size_t)it * S5_TSTRIDE;
        const float dt = __expf(GIN(a, I_LDT)[l * S5_GROUPS + g]);
        for (int e = tid; e < 17 * 64; e += NTHR) { const int k = e >> 6, p = e & 63; const float ar = GIN(a, I_AR)[gp + p] * dt * (float)k, ai = GIN(a, I_AI)[gp + p] * dt * (float)k;
            float sn, cs; sincosf(ai, &sn, &cs); const float er = expf(ar); pw[e * 2] = er * cs; pw[e * 2 + 1] = er * sn; }
        __syncthreads();
        for (int e = tid; e < 64 * 16; e += NTHR) { const int p = e >> 4; const float ar = GIN(a, I_AR)[gp + p], ai = GIN(a, I_AI)[gp + p];
            const float nr = pw[(64 + p) * 2] - 1.f, ni = pw[(64 + p) * 2 + 1], den = ar * ar + ai * ai, fr = (nr * ar + ni * ai) / den, fi = (ni * ar - nr * ai) / den;
            const float br = GIN(a, I_BR)[gp * 16 + e], bi = GIN(a, I_BI)[gp * 16 + e]; bb[e * 2] = fr * br - fi * bi; bb[e * 2 + 1] = fr * bi + fi * br; }
        if (tid < 128) { const int p = tid & 63; ((float*)(tb + S5_L16))[tid] = pw[(16 * 64 + p) * 2 + (tid >> 6)]; }
        __syncthreads();
        const float* cre = GIN(a, I_CR) + ((size_t)l * S5_GROUPS + g) * 16 * 64; const float* cim = GIN(a, I_CI) + ((size_t)l * S5_GROUPS + g) * 16 * 64;
        for (int e = tid; e < 4096; e += NTHR) { const int d = e >> 8, i = (e >> 4) & 15, j = e & 15; float acc = 0.f;
            for (int p = 0; p < 64; ++p) { const float cr = cre[i * 64 + p], ci = cim[i * 64 + p], pr = pw[(d * 64 + p) * 2], pi = pw[(d * 64 + p) * 2 + 1];
                const float tr = cr * pr - ci * pi, ti = cr * pi + ci * pr; acc += tr * bb[(p * 16 + j) * 2] - ti * bb[(p * 16 + j) * 2 + 1]; }
            Kt[e] = acc; }
        __syncthreads();
        bf16* M1 = (bf16*)(tb + S5_M1); bf16* M2 = (bf16*)(tb + S5_M2); bf16* M3 = (bf16*)(tb + S5_M3);
        for (int e = tid; e < 65536; e += NTHR) { const int n = e >> 8, k = e & 255, tau = n >> 4, i = n & 15, sg = k >> 4, j = k & 15;
            float v = 0.f; if (sg <= tau) { v = Kt[((tau - sg) * 16 + i) * 16 + j]; if (sg == tau && i == j) v += GIN(a, I_SD)[(l * S5_GROUPS + g) * 16 + i]; }
            M1[e] = (bf16)f2bf(v); }
        for (int e = tid; e < 32768; e += NTHR) { const int n = e >> 8, k = e & 255, ri = n >> 6, p = n & 63, sg = k >> 4, j = k & 15;
            const float pr = pw[((15 - sg) * 64 + p) * 2], pi = pw[((15 - sg) * 64 + p) * 2 + 1], br = bb[(p * 16 + j) * 2], bi = bb[(p * 16 + j) * 2 + 1];
            M2[e] = (bf16)f2bf(ri == 0 ? pr * br - pi * bi : pr * bi + pi * br); }
        for (int e = tid; e < 32768; e += NTHR) { const int n = e >> 7, k = e & 127, tau = n >> 4, i = n & 15, ri = k >> 6, p = k & 63;
            const float cr = cre[i * 64 + p], ci = cim[i * 64 + p], pr = pw[((tau + 1) * 64 + p) * 2], pi = pw[((tau + 1) * 64 + p) * 2 + 1];
            M3[e] = (bf16)f2bf(ri == 0 ? cr * pr - ci * pi : -(cr * pi + ci * pr)); }
        __syncthreads();
    }
}
__device__ __forceinline__ void p_s5_e(Frame& F, int l) {
    const KArgs ap = kargs(); const auto& a = *ap; WS_OPAQUE(a);
    const int tid = otid(), lane = tid & 63, wave = __builtin_amdgcn_readfirstlane(tid >> 6), r32 = lane & 31, hi = lane >> 5;
    const bf16* Z = (const bf16*)(wsb + a.off[R_Z]); float* E = (float*)(wsb + a.off[R_S5E]);
    for (int u = F.vcu * NWAVES + wave; u < S5_NBLK * S5_GROUPS; u += F.G * NWAVES) {
        const int blk = u / S5_GROUPS, g = u % S5_GROUPS;
        const unsigned char* tb = wsb + a.off[R_S5T] + (size_t)(l * S5_GROUPS + g) * S5_TSTRIDE;
        const GAS bf16x8* M2 = (const GAS bf16x8*)(tb + S5_M2);
        const bf16* zr = Z + (size_t)((blk * 32 + r32) * 16) * ZN + ZC_UC + g * 16 + 8 * hi;
        f32x16 acc[4];
#pragma unroll
        for (int nb = 0; nb < 4; ++nb)
#pragma unroll
            for (int r = 0; r < 16; ++r) acc[nb][r] = 0.f;
#pragma unroll 4
        for (int sg = 0; sg < 16; ++sg) { const bf16x8 af = *(const GAS bf16x8*)(zr + (size_t)sg * ZN);
#pragma unroll
            for (int nb = 0; nb < 4; ++nb) acc[nb] = __builtin_amdgcn_mfma_f32_32x32x16_bf16(af, M2[((nb * 32 + r32) * 256 + sg * 16 + 8 * hi) >> 3], acc[nb], 0, 0, 0); }
#pragma unroll
        for (int nb = 0; nb < 4; ++nb)
#pragma unroll
            for (int r = 0; r < 16; ++r) E[((size_t)(blk * 32 + crow_dev(r, hi)) * S5_GROUPS + g) * 128 + nb * 32 + r32] = acc[nb][r];
    }
}
__device__ __forceinline__ void s5_scan_task(const float* E, bf16* XP, const float* l16, int g, int c0, int nch, float xr, float xi, float* ore, float* oim, int lane) {
    const float lr = l16[lane], li = l16[64 + lane];
    int c = 0;
    for (; c + 8 <= nch; c += 8) { float er[8], ei[8];
#pragma unroll
        for (int q = 0; q < 8; ++q) { const float* e = E + ((size_t)(c0 + c + q) * S5_GROUPS + g) * 128; er[q] = e[lane]; ei[q] = e[64 + lane]; }
#pragma unroll
        for (int q = 0; q < 8; ++q) { bf16* xp = XP + ((size_t)(c0 + c + q) * S5_GROUPS + g) * 128; xp[lane] = (bf16)f2bf(xr); xp[64 + lane] = (bf16)f2bf(xi);
            const float nr = lr * xr - li * xi + er[q], ni = lr * xi + li * xr + ei[q]; xr = nr; xi = ni; } }
    for (; c < nch; ++c) { const float* e = E + ((size_t)(c0 + c) * S5_GROUPS + g) * 128; bf16* xp = XP + ((size_t)(c0 + c) * S5_GROUPS + g) * 128; xp[lane] = (bf16)f2bf(xr); xp[64 + lane] = (bf16)f2bf(xi);
        const float nr = lr * xr - li * xi + e[lane], ni = lr * xi + li * xr + e[64 + lane]; xr = nr; xi = ni; }
    ore[lane] = xr; oim[lane] = xi;
}
constexpr int S5_NTASK = (BATCH + DEC_BATCH) * S5_GROUPS;
__device__ __forceinline__ void s5_scan_run(Frame& F, int l, int t, int lane) {
    const KArgs ap = kargs(); const auto& a = *ap; WS_OPAQUE(a);
    const int sq = t / S5_GROUPS, g = t % S5_GROUPS;
    const float* E = (const float*)(wsb + a.off[R_S5E]); bf16* XP = (bf16*)(wsb + a.off[R_S5X]);
    const float* l16 = (const float*)(wsb + a.off[R_S5T] + (size_t)(l * S5_GROUPS + g) * S5_TSTRIDE + S5_L16);
    if (sq < BATCH) { const size_t oo = (((size_t)l * BATCH + sq) * S5_GROUPS + g) * S5_STATE;
        s5_scan_task(E, XP, l16, g, sq * (LPP / 16), S5_PCH, 0.f, 0.f, GOUT(a) + O_SRP + oo, GOUT(a) + O_SIP + oo, lane); }
    else { const int bs = sq - BATCH; const size_t oo = (((size_t)l * DEC_BATCH + bs) * S5_GROUPS + g) * S5_STATE;
        s5_scan_task(E, XP, l16, g, SROW0 / 16 + bs * (DEC_SEQ / 16), DEC_SEQ / 16, GIN(a, I_SRE)[oo + lane], GIN(a, I_SIM)[oo + lane], GOUT(a) + O_SRS + oo, GOUT(a) + O_SIS + oo, lane); }
}
__device__ __forceinline__ float gelu_tanh(float x) { const float z = 0.7978845608028654f * (x + 0.044715f * x * x * x); const float t = 1.f - 2.f * __builtin_amdgcn_rcpf(__expf(2.f * z) + 1.f); return 0.5f * x * (1.f + t); }
__device__ __forceinline__ void p_s5_out(Frame& F, int l) {
    const KArgs ap = kargs(); const auto& a = *ap; WS_OPAQUE(a);
    const int tid = otid(), lane = tid & 63, wave = __builtin_amdgcn_readfirstlane(tid >> 6), r32 = lane & 31, hi = lane >> 5;
    const bf16* Z = (const bf16*)(wsb + a.off[R_Z]); const bf16* XP = (const bf16*)(wsb + a.off[R_S5X]); bf16* YC = (bf16*)(wsb + a.off[R_YC]);
    for (int u = F.vcu * NWAVES + wave; u < S5_NBLK * S5_GROUPS; u += F.G * NWAVES) {
        const int blk = u / S5_GROUPS, g = u % S5_GROUPS;
        const unsigned char* tb = wsb + a.off[R_S5T] + (size_t)(l * S5_GROUPS + g) * S5_TSTRIDE;
        const GAS bf16x8* M1 = (const GAS bf16x8*)(tb + S5_M1); const GAS bf16x8* M3 = (const GAS bf16x8*)(tb + S5_M3);
        const bf16* zr = Z + (size_t)((blk * 32 + r32) * 16) * ZN + ZC_UC + g * 16 + 8 * hi;
        const bf16* xr = XP + ((size_t)(blk * 32 + r32) * S5_GROUPS + g) * 128 + 8 * hi;
        f32x16 acc[8];
#pragma unroll
        for (int nb = 0; nb < 8; ++nb)
#pragma unroll
            for (int r = 0; r < 16; ++r) acc[nb][r] = 0.f;
#pragma unroll 2
        for (int sg = 0; sg < 16; ++sg) { const bf16x8 af = *(const GAS bf16x8*)(zr + (size_t)sg * ZN);
#pragma unroll
            for (int nb = 0; nb < 8; ++nb) acc[nb] = __builtin_amdgcn_mfma_f32_32x32x16_bf16(af, M1[((nb * 32 + r32) * 256 + sg * 16 + 8 * hi) >> 3], acc[nb], 0, 0, 0); }
#pragma unroll 2
        for (int s = 0; s < 8; ++s) { const bf16x8 af = *(const GAS bf16x8*)(xr + 16 * s);
#pragma unroll
            for (int nb = 0; nb < 8; ++nb) acc[nb] = __builtin_amdgcn_mfma_f32_32x32x16_bf16(af, M3[((nb * 32 + r32) * 128 + s * 16 + 8 * hi) >> 3], acc[nb], 0, 0, 0); }
#pragma unroll
        for (int nb = 0; nb < 8; ++nb)
#pragma unroll
            for (int r = 0; r < 16; ++r) { const int row = (blk * 32 + crow_dev(r, hi)) * 16 + 2 * nb + (r32 >> 4);
                YC[(size_t)row * WIDTH_C + g * 16 + (r32 & 15)] = (bf16)f2bf(gelu_tanh(acc[nb][r])); }
    }
}
__device__ __forceinline__ int rdlane_i(int v, int i) { return __builtin_amdgcn_readlane(v, i); }
constexpr float NEG_BIG = -3.0e38f;
__device__ __forceinline__ unsigned fkey(float v) { const unsigned u = __builtin_bit_cast(unsigned, v); return (u & 0x80000000u) ? ~u : (u | 0x80000000u); }
__device__ __forceinline__ int mbcnt64(unsigned long long m) { return __builtin_amdgcn_mbcnt_hi((unsigned)(m >> 32), __builtin_amdgcn_mbcnt_lo((unsigned)m, 0)); }
__device__ __forceinline__ void pro_wqs(Frame& F) {
    const KArgs ap = kargs(); const auto& a = *ap; WS_OPAQUE(a);
    const int tid = otid(), lane = tid & 63, wave = __builtin_amdgcn_readfirstlane(tid >> 6);
    bf16* WQ = (bf16*)(wsb + a.off[R_WQS]);
    for (int t = F.vcu * NWAVES + wave; t < DEPTH * 16 * 16; t += F.G * NWAVES) {
        const int l = t >> 8, hc = (t >> 4) & 15, kb = t & 15, k = kb * 64 + lane;
        const float* wr = GIN(a, I_PWQ) + ((size_t)l * D_MODEL + k) * PQ + hc * 128;
        float w[128];
#pragma unroll
        for (int d = 0; d < 128; d += 4) { const f32x4 v = *(const GAS f32x4*)(wr + d); w[d] = v.x; w[d + 1] = v.y; w[d + 2] = v.z; w[d + 3] = v.w; }
        const float* sk = GIN(a, I_PSK) + ((size_t)l * 16 + hc) * 128 * 128; const float g2k = GIN(a, I_N2)[(size_t)l * D_MODEL + k];
        bf16* o = WQ + ((size_t)l * PQ + hc * 128) * D_MODEL + k;
#pragma clang loop vectorize(disable) unroll(disable)
        for (int n = 0; n < 128; ++n) { const float* sr = sk + n * 128; float acc = 0.f;
#pragma unroll
            for (int d = 0; d < 128; ++d) acc += w[d] * sr[d];
            o[(size_t)n * D_MODEL] = (bf16)f2bf(acc * g2k); }
    }
}
__device__ __forceinline__ void pro_wrest(Frame& F) {
    const KArgs ap = kargs(); const auto& a = *ap; WS_OPAQUE(a);
    const int tid = otid(), lane = tid & 63, wave = __builtin_amdgcn_readfirstlane(tid >> 6);
    LAS float* scr = (LAS float*)(F.lds + RING_OFF + wave * 16384);
    const int gw = F.vcu * NWAVES + wave, NGW = F.G * NWAVES;
    bf16* WG = (bf16*)(wsb + a.off[R_WGLU]); bf16* WB = (bf16*)(wsb + a.off[R_WBR]); bf16* WO = (bf16*)(wsb + a.off[R_WOUT]);
    constexpr int IG = (512 / 64) * (1024 / 32), IB = IG, IO = (1024 / 64) * (1024 / 32), IL = IG + 3 * IB + IO;
    for (int it = gw; it < DEPTH * IL; it += NGW) { const int l = it / IL; int r = it % IL;
        if (r < IG) { transpose_item(GIN(a, I_WGLU) + (size_t)l * 512 * 1024, 1024, 512, WG + (size_t)l * 1024 * 512, 32 * (r % 32), 64 * (r / 32), CmGlu(), scr, lane); continue; } r -= IG;
        if (r < 3 * IB) { const int w = r / IB, q = r % IB; transpose_item(GIN(a, I_WBA + w) + (size_t)l * 512 * 1024, 1024, 512, WB + ((size_t)l * 3 + w) * 1024 * 512, 32 * (q % 32), 64 * (q / 32), CmId(), scr, lane); continue; } r -= 3 * IB;
        transpose_item(GIN(a, I_WOUT) + (size_t)l * 1024 * 1024, 1024, 1024, WO + (size_t)l * 1024 * 1024, 32 * (r % 32), 64 * (r / 32), CmId(), scr, lane); }
}
typedef float f32x2v __attribute__((ext_vector_type(2)));
__device__ __forceinline__ unsigned pk_i8(const f32x4 x, float inv) {
    const int a = (int)rintf(x.x * inv), b = (int)rintf(x.y * inv), c = (int)rintf(x.z * inv), d = (int)rintf(x.w * inv);
    return (unsigned)(a & 0xff) | ((unsigned)(b & 0xff) << 8) | ((unsigned)(c & 0xff) << 16) | ((unsigned)(d & 0xff) << 24); }
constexpr size_t PEER_ROWS = (size_t)DEPTH * N_EXPERTS;
__device__ __forceinline__ void pro_peerw(Frame& F) {
    const KArgs ap = kargs(); const auto& a = *ap; WS_OPAQUE(a);
    const int tid = otid(), lane = tid & 63, wave = __builtin_amdgcn_readfirstlane(tid >> 6);
    float* SCL = (float*)(wsb + a.off[R_MISC]);
    for (size_t rw = (size_t)F.vcu * NWAVES + wave; rw < 2 * PEER_ROWS; rw += (size_t)F.G * NWAVES) {
        const int w = rw >= PEER_ROWS; const size_t row = rw - (w ? PEER_ROWS : 0);
        const GAS f32x4* src = (const GAS f32x4*)(GIN(a, I_PU + w) + row * D_MODEL) + 4 * lane;
        const f32x4 x0 = src[0], x1 = src[1], x2 = src[2], x3 = src[3];
        float mx = fmaxf(fmaxf(fmaxf(fabsf(x0.x), fabsf(x0.y)), fmaxf(fabsf(x0.z), fabsf(x0.w))), fmaxf(fmaxf(fabsf(x1.x), fabsf(x1.y)), fmaxf(fabsf(x1.z), fabsf(x1.w))));
        mx = fmaxf(mx, fmaxf(fmaxf(fmaxf(fabsf(x2.x), fabsf(x2.y)), fmaxf(fabsf(x2.z), fabsf(x2.w))), fmaxf(fmaxf(fabsf(x3.x), fabsf(x3.y)), fmaxf(fabsf(x3.z), fabsf(x3.w)))));
        mx = wave_max(mx);
        if (w == 0) {
            const float inv = mx > 0.f ? 127.f / mx : 0.f;
            v4u o; o.x = pk_i8(x0, inv); o.y = pk_i8(x1, inv); o.z = pk_i8(x2, inv); o.w = pk_i8(x3, inv);
            *((GAS v4u*)(wsb + a.off[R_PU] + row * D_MODEL) + lane) = o;
            if (lane == 0) SCL[rw] = mx * (1.f / 127.f);
            continue; }
        const float inv = mx > 0.f ? 416.f / mx : 0.f;
        v4u o; int t;
        t = __builtin_amdgcn_cvt_pk_fp8_f32(x0.x * inv, x0.y * inv, 0, false); t = __builtin_amdgcn_cvt_pk_fp8_f32(x0.z * inv, x0.w * inv, t, true); o.x = (unsigned)t;
        t = __builtin_amdgcn_cvt_pk_fp8_f32(x1.x * inv, x1.y * inv, 0, false); t = __builtin_amdgcn_cvt_pk_fp8_f32(x1.z * inv, x1.w * inv, t, true); o.y = (unsigned)t;
        t = __builtin_amdgcn_cvt_pk_fp8_f32(x2.x * inv, x2.y * inv, 0, false); t = __builtin_amdgcn_cvt_pk_fp8_f32(x2.z * inv, x2.w * inv, t, true); o.z = (unsigned)t;
        t = __builtin_amdgcn_cvt_pk_fp8_f32(x3.x * inv, x3.y * inv, 0, false); t = __builtin_amdgcn_cvt_pk_fp8_f32(x3.z * inv, x3.w * inv, t, true); o.w = (unsigned)t;
        *((GAS v4u*)(wsb + a.off[R_PU + w] + row * D_MODEL) + lane) = o;
        if (lane == 0) SCL[rw] = mx * (1.f / 416.f);
    }
}
__device__ __forceinline__ void fp8x16_to_f32(const v4u q, float (&f)[16]) {
#pragma unroll
    for (int d = 0; d < 4; ++d) { const int w = (int)(d == 0 ? q.x : d == 1 ? q.y : d == 2 ? q.z : q.w);
        const f32x2v lo = __builtin_amdgcn_cvt_pk_f32_fp8(w, false), hi = __builtin_amdgcn_cvt_pk_f32_fp8(w, true); f[4 * d] = lo.x; f[4 * d + 1] = lo.y; f[4 * d + 2] = hi.x; f[4 * d + 3] = hi.y; }
}
__device__ __forceinline__ void p_peer(Frame& F, int l, bool dry) {
    const KArgs ap = kargs(); const auto& a = *ap; WS_OPAQUE(a);
    const int tid = otid(), lane = tid & 63, wave = __builtin_amdgcn_readfirstlane(tid >> 6);
    const float* SC = (const float*)(wsb + a.off[R_SC]); const bf16* XN = (const bf16*)(wsb + a.off[R_XN]); float* X = (float*)(wsb + a.off[R_X]);
    const unsigned char* PU = wsb + a.off[R_PU] + (size_t)l * N_EXPERTS * D_MODEL; const unsigned char* PV = wsb + a.off[R_PV] + (size_t)l * N_EXPERTS * D_MODEL;
    const float* SCU = (const float*)(wsb + a.off[R_MISC]) + (size_t)l * N_EXPERTS; const float* SCV = SCU + PEER_ROWS;
    LAS float* stop = (LAS float*)(F.lds + RING_OFF + wave * 4096);
    LAS int* itop = (LAS int*)(stop + 256);
    LAS int* elist = itop + 256;
    LAS float* cf = (LAS float*)(elist + 128);
    for (int m = F.vcu * NWAVES + wave; m < RP; m += F.G * NWAVES) {
        if (!prow_valid(m)) continue;
        const float* sr = SC + (size_t)m * PQ;
        float hx[16], rs;
        { const GAS f32x4* xr0 = (const GAS f32x4*)(X + (size_t)m * D_MODEL + 16 * lane); const GAS f32x4* g4 = (const GAS f32x4*)(GIN(a, I_N2) + (size_t)l * D_MODEL + 16 * lane); float s2 = 0.f;
#pragma unroll
          for (int j = 0; j < 4; ++j) { const f32x4 xv = xr0[j], gv = g4[j]; s2 += (xv.x * xv.x + xv.y * xv.y) + (xv.z * xv.z + xv.w * xv.w); hx[4 * j] = xv.x * gv.x; hx[4 * j + 1] = xv.y * gv.y; hx[4 * j + 2] = xv.z * gv.z; hx[4 * j + 3] = xv.w * gv.w; }
          rs = __builtin_amdgcn_rsqf(wave_sum(s2) * (1.f / D_MODEL) + EPSF);
#pragma unroll
          for (int j = 0; j < 16; ++j) hx[j] *= rs; }
#ifndef MK_REP
#define MK_REP -1
#endif
        for (int rp12 = 0; rp12 < ((MK_REP) == 105 ? 2 : 1); ++rp12) {
        { unsigned k[32];
          { const GAS f32x4* p4 = (const GAS f32x4*)(sr + (lane >> 2) * 128 + (lane & 3) * 32);
#pragma unroll
            for (int j = 0; j < 8; ++j) { const f32x4 v = p4[j]; k[4 * j] = fkey(v.x); k[4 * j + 1] = fkey(v.y); k[4 * j + 2] = fkey(v.z); k[4 * j + 3] = fkey(v.w); } }
          unsigned p = 0u;
#pragma unroll
          for (int bit = 31; bit >= 0; --bit) { const unsigned t = p | (1u << bit); int c = 0;
#pragma unroll
              for (int j = 0; j < 32; ++j) c += k[j] >= t ? 1 : 0;
              c += dpp_i<0xB1>(c); c += dpp_i<0x4E>(c);
              p = c >= 16 ? t : p; }
          int cl = 0;
#pragma unroll
          for (int j = 0; j < 32; ++j) cl += k[j] >= p ? 1 : 0;
          const int q = lane & 3, c0 = dpp_i<0x00>(cl), c1 = dpp_i<0x55>(cl), c2 = dpp_i<0xAA>(cl);
          int pos = (q > 0 ? c0 : 0) + (q > 1 ? c1 : 0) + (q > 2 ? c2 : 0);
          const int sb = (lane >> 2) * 16;
#pragma unroll
          for (int j = 0; j < 32; ++j) { const bool sel = k[j] >= p;
              if (sel && pos < 16) { const unsigned u = (k[j] & 0x80000000u) ? (k[j] ^ 0x80000000u) : ~k[j]; stop[sb + pos] = __builtin_bit_cast(float, u); itop[sb + pos] = q * 32 + j; }
              pos += sel ? 1 : 0; }
        }
        LDS_WAIT();
        for (int h = 0; h < 8; ++h) {
            const float s1 = stop[(2 * h) * 16 + (lane >> 2)];
            float c[4]; unsigned kc[4];
#pragma unroll
            for (int j = 0; j < 4; ++j) { c[j] = s1 + stop[(2 * h + 1) * 16 + (lane & 3) * 4 + j]; kc[j] = fkey(c[j]); }
            unsigned pp = 0u;
            for (int bit = 31; bit >= 0; --bit) { const unsigned tt = pp | (1u << bit);
                const int cn = __builtin_popcountll(__ballot(kc[0] >= tt)) + __builtin_popcountll(__ballot(kc[1] >= tt)) + __builtin_popcountll(__ballot(kc[2] >= tt)) + __builtin_popcountll(__ballot(kc[3] >= tt));
                pp = cn >= 16 ? tt : pp; if (cn == 16) break; }
            const float cmax = wave_max(fmaxf(fmaxf(c[0], c[1]), fmaxf(c[2], c[3])));
            float esum = 0.f; int base = 0;
#pragma unroll
            for (int j = 0; j < 4; ++j) { const bool sel = kc[j] >= pp; const unsigned long long mk = __ballot(sel); const int rk = base + mbcnt64(mk); base += __builtin_popcountll(mk);
                const float ex = (sel && rk < 16) ? __expf(rs * (c[j] - cmax)) : 0.f; esum += ex;
                if (sel && rk < 16) { const int ci = lane * 4 + j; elist[h * 16 + rk] = itop[(2 * h) * 16 + (ci >> 4)] * N_KEYS + itop[(2 * h + 1) * 16 + (ci & 15)]; cf[h * 16 + rk] = ex; } }
            esum = wave_sum(esum); const float inv = __builtin_amdgcn_rcpf(esum);
            LDS_WAIT();
            if (lane < 16) cf[h * 16 + lane] *= inv;
        }
        LDS_WAIT();
        }
        for (int rp3 = 0; rp3 < ((MK_REP) == 106 ? 2 : 1); ++rp3) {
        float out[16];
#pragma unroll
        for (int j = 0; j < 16; ++j) out[j] = 0.f;
        float hmx = 0.f;
#pragma unroll
        for (int j = 0; j < 16; ++j) hmx = fmaxf(hmx, fabsf(hx[j]));
        hmx = wave_max(hmx); const float hinv = hmx > 0.f ? 127.f / hmx : 0.f, hsc = hmx * (1.f / 127.f);
        v4u hq; hq.x = pk_i8((f32x4){hx[0], hx[1], hx[2], hx[3]}, hinv); hq.y = pk_i8((f32x4){hx[4], hx[5], hx[6], hx[7]}, hinv); hq.z = pk_i8((f32x4){hx[8], hx[9], hx[10], hx[11]}, hinv); hq.w = pk_i8((f32x4){hx[12], hx[13], hx[14], hx[15]}, hinv);
        v4u uA[4], vA[4], uB[4], vB[4]; float suA, svA, cA, suB, svB, cB;
        const bool l60 = lane == 60, l61 = lane == 61, l62 = lane == 62;
#define PEER_LOAD(U, V, SU, SV, CW, q0) do { { const int em_ = elist[(q0) + (lane & 3)]; CW = cf[(q0) + (lane & 3)]; SU = SCU[em_]; SV = SCV[em_]; } _Pragma("unroll") for (int i = 0; i < 4; ++i) { const int e_ = elist[(q0) + i]; \
            U[i] = *((const GAS v4u*)(PU + (size_t)e_ * D_MODEL) + lane); V[i] = *((const GAS v4u*)(PV + (size_t)e_ * D_MODEL) + lane); } } while (0)
#define PEER_COMP(U, V, SU, SV, CW) do { float d_[4]; _Pragma("unroll") for (int i = 0; i < 4; ++i) { int di_ = __builtin_amdgcn_sdot4((int)U[i].x, (int)hq.x, 0, false); di_ = __builtin_amdgcn_sdot4((int)U[i].y, (int)hq.y, di_, false); \
            di_ = __builtin_amdgcn_sdot4((int)U[i].z, (int)hq.z, di_, false); di_ = __builtin_amdgcn_sdot4((int)U[i].w, (int)hq.w, di_, false); d_[i] = (float)di_; } \
            _Pragma("unroll") for (int i = 0; i < 4; ++i) d_[i] += dpp_f<0xB1>(d_[i]); _Pragma("unroll") for (int i = 0; i < 4; ++i) d_[i] += dpp_f<0x4E>(d_[i]); \
            _Pragma("unroll") for (int i = 0; i < 4; ++i) d_[i] += dpp_f<0x141>(d_[i]); _Pragma("unroll") for (int i = 0; i < 4; ++i) d_[i] += dpp_f<0x140>(d_[i]); \
            _Pragma("unroll") for (int i = 0; i < 4; ++i) d_[i] += dpp_fm<0x142, 0xA>(d_[i]); _Pragma("unroll") for (int i = 0; i < 4; ++i) d_[i] += dpp_fm<0x143, 0xC>(d_[i]);     \
            const float dsel_ = l60 ? d_[0] : l61 ? d_[1] : l62 ? d_[2] : d_[3];                                    \
            const float ccv_ = CW * gelu_tanh(dsel_ * hsc * SU) * SV; \
            _Pragma("unroll") for (int i = 0; i < 4; ++i) { const float cc = rdlane(ccv_, 60 + i); float t[16]; fp8x16_to_f32(V[i], t); _Pragma("unroll") for (int j = 0; j < 16; ++j) out[j] += cc * t[j]; } } while (0)
        PEER_LOAD(uA, vA, suA, svA, cA, 0);
        for (int q = 0; q < 128; q += 8) {
            PEER_LOAD(uB, vB, suB, svB, cB, q + 4);
            PEER_COMP(uA, vA, suA, svA, cA);
            if (q + 8 < 128) PEER_LOAD(uA, vA, suA, svA, cA, q + 8);
            PEER_COMP(uB, vB, suB, svB, cB);
        }
#undef PEER_LOAD
#undef PEER_COMP
        if (!dry && rp3 == ((MK_REP) == 106 ? 1 : 0)) { GAS f32x4* xr = (GAS f32x4*)(X + (size_t)m * D_MODEL + 16 * lane);
          f32x4 xv[4]; float s2 = 0.f;
#pragma unroll
          for (int j = 0; j < 4; ++j) { xv[j] = xr[j] + (f32x4){out[4 * j], out[4 * j + 1], out[4 * j + 2], out[4 * j + 3]}; s2 += (xv[j].x * xv[j].x + xv[j].y * xv[j].y) + (xv[j].z * xv[j].z + xv[j].w * xv[j].w); }
          const float rn = __builtin_amdgcn_rsqf(wave_sum(s2) * (1.f / D_MODEL) + EPSF);
          if (l + 1 < DEPTH) {
#pragma unroll
              for (int j = 0; j < 4; ++j) xr[j] = xv[j];
              const GAS f32x4* gr = (const GAS f32x4*)(GIN(a, I_N1) + (size_t)(l + 1) * D_MODEL + 16 * lane); float o16[16];
#pragma unroll
              for (int j = 0; j < 4; ++j) { const f32x4 gg = gr[j]; o16[4 * j] = xv[j].x * rn * gg.x; o16[4 * j + 1] = xv[j].y * rn * gg.y; o16[4 * j + 2] = xv[j].z * rn * gg.z; o16[4 * j + 3] = xv[j].w * rn * gg.w; }
              v4u w0, w1; w0.x = pk2(o16[0], o16[1]); w0.y = pk2(o16[2], o16[3]); w0.z = pk2(o16[4], o16[5]); w0.w = pk2(o16[6], o16[7]); w1.x = pk2(o16[8], o16[9]); w1.y = pk2(o16[10], o16[11]); w1.z = pk2(o16[12], o16[13]); w1.w = pk2(o16[14], o16[15]);
              GAS v4u* xo = (GAS v4u*)((bf16*)(wsb + a.off[R_XN]) + (size_t)m * D_MODEL + 16 * lane); xo[0] = w0; xo[1] = w1;
          } else {
              float* dst = nullptr;
              if (m >= SROW0) dst = GOUT(a) + O_YS + (size_t)(m - SROW0) * D_MODEL; else { const int b_ = m / LPP, p_ = m % LPP; if (p_ >= PADF + N_META) dst = GOUT(a) + O_YP + ((size_t)b_ * SEQ + (p_ - PADF - N_META)) * D_MODEL; }
              if (dst) { const GAS f32x4* gr = (const GAS f32x4*)(GIN(a, I_FN) + 16 * lane); GAS f32x4* o = (GAS f32x4*)(dst + 16 * lane);
#pragma unroll
                  for (int j = 0; j < 4; ++j) { const f32x4 gg = gr[j]; o[j] = (f32x4){xv[j].x * rn * gg.x, xv[j].y * rn * gg.y, xv[j].z * rn * gg.z, xv[j].w * rn * gg.w}; } }
          } }
        }
    }
}
__device__ __forceinline__ void p_final(Frame& F) {
    const KArgs ap = kargs(); const auto& a = *ap; WS_OPAQUE(a);
    const int tid = otid(), lane = tid & 63, wave = __builtin_amdgcn_readfirstlane(tid >> 6);
    const float* X = (const float*)(wsb + a.off[R_X]); const float* g = GIN(a, I_FN);
    for (int m = F.vcu * NWAVES + wave; m < RP; m += F.G * NWAVES) {
        float* dst;
        if (m >= SROW0) dst = GOUT(a) + O_YS + (size_t)(m - SROW0) * D_MODEL;
        else { const int b = m / LPP, p = m % LPP; if (p < PADF + N_META || p >= PEND) continue; dst = GOUT(a) + O_YP + ((size_t)b * SEQ + (p - PADF - N_META)) * D_MODEL; }
        const GAS f32x4* xr = (const GAS f32x4*)(X + (size_t)m * D_MODEL) + lane;
        f32x4 v[4]; float s2 = 0.f;
#pragma unroll
        for (int j = 0; j < 4; ++j) { v[j] = xr[64 * j]; s2 += (v[j].x * v[j].x + v[j].y * v[j].y) + (v[j].z * v[j].z + v[j].w * v[j].w); }
        const float r = __builtin_amdgcn_rsqf(wave_sum(s2) * (1.f / D_MODEL) + EPSF);
        const GAS f32x4* gr = (const GAS f32x4*)g + lane; GAS f32x4* o = (GAS f32x4*)dst + lane;
#pragma unroll
        for (int j = 0; j < 4; ++j) { const f32x4 gg = gr[64 * j]; o[64 * j] = (f32x4){v[j].x * r * gg.x, v[j].y * r * gg.y, v[j].z * r * gg.z, v[j].w * r * gg.w}; }
    }
}

__device__ __forceinline__ void p_prologue(Frame& F) {
    const KArgs ap = kargs(); const auto& a = *ap; WS_OPAQUE(a);
    const int tid = otid(), lane = tid & 63, wave = __builtin_amdgcn_readfirstlane(tid >> 6);
    LAS float* scr = (LAS float*)(F.lds + RING_OFF + wave * 16384);
    const int gw = F.vcu * NWAVES + wave, NGW = F.G * NWAVES;
    if (a.pro_mask & PM_X) {
        float* X = (float*)(wsb + a.off[R_X]);
        for (int m = gw; m < RP; m += NGW) {
            const float* src = nullptr;
            if (m >= SROW0) src = GIN(a, I_XS) + (size_t)(m - SROW0) * D_MODEL;
            else { const int b = m / LPP, p = m % LPP; if (p >= PADF && p < PEND) { const int pos = p - PADF; src = pos < N_META ? GIN(a, I_META) + (size_t)pos * D_MODEL : GIN(a, I_XP) + ((size_t)b * SEQ + pos - N_META) * D_MODEL; } }
            GAS f32x4* o = (GAS f32x4*)(X + (size_t)m * D_MODEL) + lane;
#pragma unroll
            for (int j = 0; j < 4; ++j) o[64 * j] = src ? ((const GAS f32x4*)src)[lane + 64 * j] : (f32x4){0.f, 0.f, 0.f, 0.f};
        }
    }
    if (a.pro_mask & PM_WIN) {
        bf16* WT = (bf16*)(wsb + a.off[R_WIN]);
        constexpr int IPL = (D_MODEL / 64) * (ZN / 32);
        for (int it = gw; it < DEPTH * IPL; it += NGW) { const int l = it / IPL, r = it % IPL, kb = r / (ZN / 32), nb = r % (ZN / 32);
            transpose_item(GIN(a, I_WIN) + (size_t)l * D_MODEL * D_IN, D_IN, D_MODEL, WT + (size_t)l * ZN * D_MODEL, 32 * nb, 64 * kb, CmWin(), scr, lane); }
    }
    __syncthreads();
    if (a.pro_mask & PM_TABLES) s5_tables(F);
    __syncthreads();
    if (a.pro_mask & PM_WREST) pro_wrest(F);
    if (a.pro_mask & PM_WQS) pro_wqs(F);
    if (a.pro_mask & PM_PEERW) pro_peerw(F);
}

__global__ void __launch_bounds__(NTHR, 2) mk_fwd(Args args) {
    extern __shared__ __attribute__((aligned(16))) unsigned char lds[];
    Frame F;
    F.lds = (LAS unsigned char*)lds; F.MISC = (volatile LAS unsigned*)(F.lds + MISC_OFF);
    F.wv = __builtin_amdgcn_readfirstlane((int)threadIdx.x >> 6);
    F.G = gridDim.x; { const int bx = blockIdx.x; F.vcu = (F.G % 8 == 0) ? (bx % 8) * (F.G / 8) + bx / 8 : bx; }
    F.ctl = (gu32*)args.ws;
    for (int u = F.wv * 64 + lane_id(); u < (LDS_BYTES - LDSCTL_OFF) / 4; u += NTHR) ((LAS unsigned*)(F.lds + LDSCTL_OFF))[u] = 0u;
    __syncthreads();
    const int lo = args.ph_lo, hi = args.ph_hi;
    unsigned* barw = (unsigned*)(F.ctl + CW_BAR) + (size_t)args.bar_region * XCD_BAR_WORDS;
    XcdBarrier bar; bar.bar = barw; bar.x = 0; bar.st = nullptr; bar.wv = F.wv;
    if (hi - lo > 1) bar = xcd_barrier_post(barw, F.MISC + 8, F.wv);
#define IN(k) (lo <= (k) && (k) < hi)
#ifndef MK_REP
#define MK_REP -1
#endif
#define SEAM(k) do { if ((k) + 1 < hi) { xcd_barrier(bar); if ((MK_REP) == 300) xcd_barrier(bar); } } while (0)
#ifndef MK_REP
#define MK_REP -1
#endif
    if (IN(PH_PRO)) { for (int rep_ = 0; rep_ < ((MK_REP) == 200 ? 2 : 1); ++rep_) { p_prologue(F); __syncthreads(); } SEAM(PH_PRO); }
#ifndef MK_REP
#define MK_REP -1
#endif
#define REPEAT(ph) for (int rep_ = 0; rep_ < ((MK_REP) == (ph) ? 2 : 1); ++rep_)
    for (int l = 0; l < DEPTH; ++l) {
        const int pb = 1 + l * NPL;
        if (l == 0 && IN(pb + PL_NORM1)) { REPEAT(PL_NORM1) p_norm(F, l, I_N1); SEAM(pb + PL_NORM1); }
        if (IN(pb + PL_GEMM_IN)) {
            const KArgs ap = kargs(); const auto& a = *ap; WS_OPAQUE(a);
            pg8::Gemm g{(const pg8::bf16_t*)(wsb + a.off[R_XN]), (const pg8::bf16_t*)(wsb + a.off[R_WIN]) + (size_t)l * ZN * D_MODEL, RP, ZN, D_MODEL};
            pg8::StaticOrder S; S.init(RP, ZN, F.G, (int)blockIdx.x);
            pg8::EpiBf16<0> E{(pg8::bf16_t*)(wsb + a.off[R_Z]), ZN, nullptr, 0, 0, 1.f};
            REPEAT(PL_GEMM_IN) pg8::gemm_phase<pg8::EpiBf16<0>, pg8::StaticOrder, true, true>(F.lds + RING_OFF, g, S, E, F.wv);
            SEAM(pb + PL_GEMM_IN);
        }
        if (IN(pb + PL_ZPOST)) { REPEAT(103) p_s5_e(F, l); REPEAT(PL_ZPOST) p_zpost(F, l);     SEAM(pb + PL_ZPOST); }
        if (IN(pb + PL_LOCAL)) { REPEAT(104) p_gdn_chunk(F, l); SEAM(pb + PL_LOCAL); }
        if (IN(pb + PL_MIX)) {
            REPEAT(100) p_gdn_chain(F, l);
            REPEAT(102) { const int tid = otid(), lane = tid & 63, wave = __builtin_amdgcn_readfirstlane(tid >> 6), NGW = F.G * NWAVES;
              for (int t = (F.vcu * NWAVES + wave + NGW - 256) % NGW; t < S5_NTASK; t += NGW) s5_scan_run(F, l, t, lane); }
            REPEAT(101) p_attention(F, l + DEPTH * rep_, lds);
            SEAM(pb + PL_MIX); }
        if (IN(pb + PL_MIXPOST)) { REPEAT(PL_MIXPOST) { p_mixpost_a(F, l); p_mixpost_b(F, l); p_s5_out(F, l); } SEAM(pb + PL_MIXPOST); }
        if (IN(pb + PL_GEMM_GLU)) REPEAT(PL_GEMM_GLU) {
            const KArgs ap = kargs(); const auto& a = *ap; WS_OPAQUE(a);
            { pg8::Gemm g{(const pg8::bf16_t*)(wsb + a.off[R_YC]), (const pg8::bf16_t*)(wsb + a.off[R_WGLU]) + (size_t)l * 1024 * 512, RP, 1024, 512};
              pg8::StaticOrder S; S.init(RP, 1024, F.G, (int)blockIdx.x); pg8::EpiGlu E{(pg8::bf16_t*)(wsb + a.off[R_OC]), WIDTH_C};
              pg8::gemm_phase<pg8::EpiGlu, pg8::StaticOrder, true, true>(F.lds + RING_OFF, g, S, E, F.wv); }
            { pg8::Gemm g{(const pg8::bf16_t*)(wsb + a.off[R_OA]), (const pg8::bf16_t*)(wsb + a.off[R_WBR]) + ((size_t)l * 3 + 0) * 1024 * 512, RP, 1024, 512};
              pg8::StaticOrder S; S.init(RP, 1024, F.G, (int)((blockIdx.x + 16) % F.G)); pg8::EpiMerge<0> E{(float*)(wsb + a.off[R_MRG]), nullptr, nullptr, (const pg8::bf16_t*)(wsb + a.off[R_Z]) + ZC_GATE, ZN};
              pg8::gemm_phase<pg8::EpiMerge<0>, pg8::StaticOrder, true, true>(F.lds + RING_OFF, g, S, E, F.wv); }
            { pg8::Gemm g{(const pg8::bf16_t*)(wsb + a.off[R_OBN]), (const pg8::bf16_t*)(wsb + a.off[R_WBR]) + ((size_t)l * 3 + 1) * 1024 * 512, RP, 1024, 512};
              pg8::StaticOrder S; S.init(RP, 1024, F.G, (int)((blockIdx.x + 32) % F.G)); pg8::EpiMerge<0> E{(float*)(wsb + a.off[R_MRG2]), nullptr, nullptr, (const pg8::bf16_t*)(wsb + a.off[R_Z]) + ZC_GATE + 1024, ZN};
              pg8::gemm_phase<pg8::EpiMerge<0>, pg8::StaticOrder, true, true>(F.lds + RING_OFF, g, S, E, F.wv); }
            if (rep_ == ((MK_REP) == PL_GEMM_GLU ? 1 : 0)) SEAM(pb + PL_GEMM_GLU); }
        if (IN(pb + PL_GEMM_BRC)) {
            const KArgs ap = kargs(); const auto& a = *ap; WS_OPAQUE(a);
            pg8::Gemm g{(const pg8::bf16_t*)(wsb + a.off[R_OC]), (const pg8::bf16_t*)(wsb + a.off[R_WBR]) + ((size_t)l * 3 + 2) * 1024 * 512, RP, 1024, 512};
            pg8::StaticOrder S; S.init(RP, 1024, F.G, (int)blockIdx.x); pg8::EpiMerge<2> E{(float*)(wsb + a.off[R_MRG]), (const float*)(wsb + a.off[R_MRG2]), (pg8::bf16_t*)(wsb + a.off[R_MRGB]), (const pg8::bf16_t*)(wsb + a.off[R_Z]) + ZC_GATE + 2048, ZN};
            REPEAT(PL_GEMM_BRC) pg8::gemm_phase<pg8::EpiMerge<2>, pg8::StaticOrder, true, true>(F.lds + RING_OFF, g, S, E, F.wv);
            SEAM(pb + PL_GEMM_BRC); }
        if (IN(pb + PL_GEMM_OUT)) {
            const KArgs ap = kargs(); const auto& a = *ap; WS_OPAQUE(a);
            pg8::Gemm g{(const pg8::bf16_t*)(wsb + a.off[R_MRGB]), (const pg8::bf16_t*)(wsb + a.off[R_WOUT]) + (size_t)l * 1024 * 1024, RP, 1024, 1024};
            pg8::StaticOrder S; S.init(RP, 1024, F.G, (int)blockIdx.x);
            REPEAT(PL_GEMM_OUT) { pg8::EpiResid E{(float*)(wsb + a.off[R_X]), D_MODEL, (MK_REP) == PL_GEMM_OUT && rep_ == 0, (pg8::bf16_t*)(wsb + a.off[R_XN])};
            pg8::gemm_phase<pg8::EpiResid, pg8::StaticOrder, true, true>(F.lds + RING_OFF, g, S, E, F.wv); }
            SEAM(pb + PL_GEMM_OUT); }
        if (IN(pb + PL_GEMM_PEER)) {
            const KArgs ap = kargs(); const auto& a = *ap; WS_OPAQUE(a);
            pg8::Gemm g{(const pg8::bf16_t*)(wsb + a.off[R_XN]), (const pg8::bf16_t*)(wsb + a.off[R_WQS]) + (size_t)l * PQ * D_MODEL, RP, PQ, D_MODEL};
            pg8::StaticOrder S; S.init(RP, PQ, F.G, (int)blockIdx.x); pg8::EpiF32 E{(float*)(wsb + a.off[R_SC]), PQ};
            REPEAT(PL_GEMM_PEER) pg8::gemm_phase<pg8::EpiF32, pg8::StaticOrder, true, true>(F.lds + RING_OFF, g, S, E, F.wv);
            SEAM(pb + PL_GEMM_PEER); }
        if (IN(pb + PL_PEER)) { REPEAT(PL_PEER) p_peer(F, l, (MK_REP) == PL_PEER && rep_ == 0); SEAM(pb + PL_PEER); }
    }
#undef IN
#undef SEAM
}
}
#ifndef MK_ONE_LAUNCH
#define MK_ONE_LAUNCH 1
#endif
static int mk_grid = 0;
static bool mk_setup() {
    if (mk_grid) return mk_grid > 0;
    int dev = 0, cus = 0;
    if (hipGetDevice(&dev) != hipSuccess || hipDeviceGetAttribute(&cus, hipDeviceAttributeMultiprocessorCount, dev) != hipSuccess) { mk_grid = -1; return false; }
    if (hipFuncSetAttribute((const void*)mk::mk_fwd, hipFuncAttributeMaxDynamicSharedMemorySize, mk::LDS_BYTES) != hipSuccess) { fprintf(stderr, "kernel_launch: hipFuncSetAttribute failed\n"); mk_grid = -1; return false; }
    int per_cu = 0;
    if (hipOccupancyMaxActiveBlocksPerMultiprocessor(&per_cu, (const void*)mk::mk_fwd, mk::NTHR, mk::LDS_BYTES) != hipSuccess || per_cu < 1) { fprintf(stderr, "kernel_launch: occupancy query says %d workgroups per CU\n", per_cu); }
    (void)hipGetLastError();
    mk_grid = cus;
    return true;
}
static void mk_launch(mk::Args a, int lo, int hi, int region, hipStream_t stream) {
    a.ph_lo = lo; a.ph_hi = hi; a.bar_region = region;
    hipLaunchKernelGGL(mk::mk_fwd, dim3(mk_grid), dim3(mk::NTHR), mk::LDS_BYTES, stream, a);
    hipError_t e = hipPeekAtLastError(); if (e != hipSuccess) fprintf(stderr, "kernel_launch: launch failed: %s\n", hipGetErrorName(e));
}
extern "C" void kernel_launch(void* const* d_in, const int* in_sizes, int n_in, void* d_out, int out_size, void* d_ws, size_t ws_size, hipStream_t stream) {
    if (n_in != N_INPUTS || (size_t)out_size != (size_t)O_END) { fprintf(stderr, "kernel_launch: unexpected n_in %d / out_size %d\n", n_in, out_size); return; }
    if (!mk_setup()) return;
    const size_t MiB = 1u << 20;
    unsigned char* ws = (unsigned char*)d_ws;
    mk::Args a{};
    for (int i = 0; i < N_INPUTS; ++i) a.in[i] = (const float*)d_in[i];
    a.out = (float*)d_out; a.ws = ws;
    { using namespace mk; const struct { int r; size_t mib; } map[] = { {R_WIN, 1}, {R_WGLU, 59}, {R_WBR, 63}, {R_WOUT, 75}, {R_WQS, 83}, {R_S5T, 99}, {R_PU, 132}, {R_PV, 196}, {R_MISC, 260}, {R_OBN, 262}, {R_MRG2, 280}, {R_X, 388}, {R_XN, 456},
        {R_Z, 490}, {R_SC, 490}, {R_QN, 737}, {R_KN, 754}, {R_QKVB, 771}, {R_BG, 822}, {R_O, 823}, {R_MRGB, 823}, {R_OA, 857}, {R_OB, 874}, {R_GDN, 891}, {R_MRG, 891},
        {R_S5E, 986}, {R_YC, 986}, {R_S5X, 1003}, {R_OC, 1012} };
      for (auto& e : map) a.off[e.r] = e.mib * MiB; }
    if (1029 * MiB > ws_size) { fprintf(stderr, "kernel_launch: workspace too small (%zu)\n", ws_size); return; }
    if (hipMemsetAsync(ws, 0, mk::CTL_BYTES, stream) != hipSuccess) { fprintf(stderr, "kernel_launch: memset failed\n"); return; }
    a.pro_mask = mk::PM_X | mk::PM_WIN | mk::PM_TABLES | mk::PM_WREST | mk::PM_WQS | mk::PM_PEERW;
#if MK_ONE_LAUNCH
    mk_launch(a, 0, mk::PH_END, 0, stream);
#else
    int region = 0;
    mk_launch(a, mk::PH_PRO, mk::PH_PRO + 1, region++, stream);
    for (int l = 0; l < DEPTH; ++l) { const int pb = 1 + l * mk::NPL;
        for (int ph = mk::PL_NORM1; ph <= mk::PL_PEER; ++ph) { if (ph == mk::PL_GEMM_BRA || ph == mk::PL_GEMM_BRB) continue; mk_launch(a, pb + ph, pb + ph + 1, region++, stream); } }
    mk_launch(a, mk::PH_FINAL, mk::PH_END, region++, stream);
#endif
}
```

```cpp
#include <hip/hip_runtime.h>
#include <cstdio>
#include <cstdint>
#include <utility>
#define MK_ONE_LAUNCH 1
#ifndef D_MODEL
#define D_MODEL 1024
#define BATCH 2
#define SEQ 8192
#define DEPTH 4
#define DEC_BATCH 16
#define DEC_SEQ 32
#define PAST_LEN 1024
#define N_HEADS_A 4
#define HEAD_DIM_A 64
#define N_HEADS_B 4
#define HEAD_DIM_B 128
#define S5_GROUPS 32
#define S5_STATE 64
#define PEER_HEADS 8
#define PEER_QDIM 256
#define N_KEYS 128
#endif
#define CHUNK 64
#define N_META 16
#define EPSF 1e-6f
#define NUM_BUCKETS 32
#define CONV_W 4
#define S5_GROUP 16
#define PEER_TOPK 16
#define N_EXPERTS (N_KEYS * N_KEYS)
#define WIDTH_A (N_HEADS_A * 2 * HEAD_DIM_A)
#define WIDTH_B (N_HEADS_B * HEAD_DIM_B)
#define WIDTH_C (S5_GROUPS * S5_GROUP)
#define OFF_QA 0
#define OFF_KA (OFF_QA + WIDTH_A)
#define OFF_VA (OFF_KA + WIDTH_A)
#define OFF_QKVB (OFF_VA + WIDTH_A)
#define OFF_GB (OFF_QKVB + 3 * WIDTH_B)
#define OFF_BETA (OFF_GB + WIDTH_B)
#define OFF_ALPHA (OFF_BETA + N_HEADS_B)
#define OFF_UC (OFF_ALPHA + N_HEADS_B)
#define OFF_GATE (OFF_UC + WIDTH_C)
#define D_IN (OFF_GATE + 3 * D_MODEL)
#define LP (N_META + SEQ)
#define NP (BATCH * LP)
#define NS (DEC_BATCH * DEC_SEQ)
#define NT (NP + NS)
#define PQ (PEER_HEADS * PEER_QDIM)

enum { I_XP, I_XS, I_CK, I_CV, I_SCONV, I_SDELTA, I_SRE, I_SIM, I_META, I_REL, I_N1, I_N2, I_FN, I_WIN, I_QN, I_KN, I_LQK, I_SUBLN, I_CONVW, I_ALOG, I_DTB, I_GDNN,
       I_AR, I_AI, I_BR, I_BI, I_CR, I_CI, I_SD, I_LDT, I_WGLU, I_WBA, I_WBB, I_WBC, I_WOUT, I_PWQ, I_PSK, I_PU, I_PV, N_INPUTS };
#define O_YP 0
#define O_YS (O_YP + (size_t)BATCH * SEQ * D_MODEL)
#define O_KP (O_YS + (size_t)NS * D_MODEL)
#define O_VP (O_KP + (size_t)DEPTH * NP * WIDTH_A)
#define O_KS (O_VP + (size_t)DEPTH * NP * WIDTH_A)
#define O_VS (O_KS + (size_t)DEPTH * NS * WIDTH_A)
#define O_CP (O_VS + (size_t)DEPTH * NS * WIDTH_A)
#define O_CS (O_CP + (size_t)DEPTH * BATCH * (CONV_W - 1) * 3 * WIDTH_B)
#define O_DP (O_CS + (size_t)DEPTH * DEC_BATCH * (CONV_W - 1) * 3 * WIDTH_B)
#define O_DS (O_DP + (size_t)DEPTH * BATCH * N_HEADS_B * HEAD_DIM_B * HEAD_DIM_B)
#define O_SRP (O_DS + (size_t)DEPTH * DEC_BATCH * N_HEADS_B * HEAD_DIM_B * HEAD_DIM_B)
#define O_SIP (O_SRP + (size_t)DEPTH * BATCH * S5_GROUPS * S5_STATE)
#define O_SRS (O_SIP + (size_t)DEPTH * BATCH * S5_GROUPS * S5_STATE)
#define O_SIS (O_SRS + (size_t)DEPTH * DEC_BATCH * S5_GROUPS * S5_STATE)
#define O_END (O_SIS + (size_t)DEPTH * DEC_BATCH * S5_GROUPS * S5_STATE)

namespace pg8 {
#define PG8_LAS __attribute__((address_space(3)))
typedef unsigned short bf16_t;
typedef short bf16x8 __attribute__((ext_vector_type(8)));
typedef float f32x4 __attribute__((ext_vector_type(4)));
typedef unsigned u32x4 __attribute__((ext_vector_type(4)));
constexpr int BM = 256, BK = 64, HALF = 128, HTB = HALF * BK * 2  , STAGE_BYTES = 8 * HTB, NXCD = 8, WGM = 8;

__host__ __device__ __forceinline__ int lds_byte(int r, int c) { const int st = (r >> 4) * 2 + (c >> 5), rr = r & 15, cc = c & 31, ob = rr * 64 + cc * 2; return st * 1024 + (ob ^ (((ob >> 9) & 1) << 5)); }
__host__ __device__ __forceinline__ void stage_rc(int b, int& R, int& C) { const int st = b / 1024, sb = b % 1024, swz = sb ^ (((sb >> 9) & 1) << 5); R = (st >> 1) * 16 + swz / 64; C = (st & 1) * 32 + (swz % 64) / 2; }
__host__ __device__ __forceinline__ int perm32(int rho) { const int n = rho >> 4, i = rho & 15; return 8 * (i >> 2) + 4 * n + (i & 3); }

struct Unit { int pm, pn; };
struct Gemm { const bf16_t* A; const bf16_t* Bt; int M, N, K; };

struct StaticOrder {
    int nM, nN, nwg, G, c;
    __host__ __device__ void init(int M, int N, int G_, int c_) { nM = M / BM; nN = N / BM; nwg = nM * nN; G = G_; c = c_; }
    __host__ __device__ bool next(int i, Unit& u) const {
        const long L = (long)i * G + c; if (L >= nwg) return false;
        int wgid = (int)L; { const int q = nwg / NXCD, r = nwg % NXCD, xcd = wgid % NXCD, off = wgid / NXCD; wgid = (xcd < r ? xcd * (q + 1) : r * (q + 1) + (xcd - r) * q) + off; }
        const int nig = WGM * nN, gid = wgid / nig, fm = gid * WGM, gsz = (nM - fm) < WGM ? (nM - fm) : WGM;
        u.pm = fm + ((wgid % nig) % gsz); u.pn = (wgid % nig) / gsz; return true;
    }
    __device__ __forceinline__ void a_ready(const Unit&) const {}
    __device__ __forceinline__ void done(const Unit&) const {}
};

__device__ __forceinline__ unsigned cvt_pk_bf16(float lo, float hi) { unsigned r; asm volatile("v_cvt_pk_bf16_f32 %0, %1, %2" : "=v"(r) : "v"(lo), "v"(hi)); return r; }
typedef float f32x2 __attribute__((ext_vector_type(2)));
__device__ __forceinline__ f32x2 gelu_pk(f32x2 v) {
    const f32x2 av = __builtin_elementwise_abs(v), d = av * 0.2316418882f + 1.0f;
    f32x2 t; t.x = __builtin_amdgcn_rcpf(d.x); t.y = __builtin_amdgcn_rcpf(d.y);
    f32x2 q = t * 0.5307027145f + (-0.7265760135f); q = q * t + 0.7107068705f; q = q * t + (-0.142248368f); q = q * t + 0.127414796f; q = q * t;
    const f32x2 s = (v * v) * (-0.72134752044f);
    f32x2 e; e.x = __builtin_amdgcn_exp2f(s.x); e.y = __builtin_amdgcn_exp2f(s.y);
    const f32x2 m = v * (q * e), r = v - m;
    f32x2 o; o.x = v.x < 0.f ? m.x : r.x; o.y = v.y < 0.f ? m.y : r.y; return o;
}

template <int ACT  > struct EpiBf16 {
    static constexpr bool PERM = true, AFTER_DRAIN = false; static_assert(ACT == 0 || ACT == 1, "EpiBf16: ACT is 0 (none) or 1 (gelu_pk)");
    bf16_t* O; int ldc; const float* bias; int split_cols; size_t split_stride; float scale0;
    __device__ __forceinline__ void operator()(const f32x4 (&acc)[2][2][4][2], const Unit& u, int wr, int wc, int fr, int fq) const {
        const int row0 = u.pm * BM + wr * 64 + fr; int colt = u.pn * BM; bf16_t* base = O;
        float sc = 1.f; if (split_cols) { const int t = colt / split_cols; base += (size_t)t * split_stride; colt -= t * split_cols; if (t == 0) sc = scale0; }
        const int col0 = colt + wc * 32 + 8 * fq, bcol0 = u.pn * BM + wc * 32 + 8 * fq;
        f32x4 bv[2][2];
#pragma unroll
        for (int bj = 0; bj < 2; ++bj)
#pragma unroll
            for (int n = 0; n < 2; ++n) bv[bj][n] = bias ? *(const f32x4*)(bias + bcol0 + bj * HALF + 4 * n) : (f32x4){0.f, 0.f, 0.f, 0.f};
#pragma unroll
        for (int ai = 0; ai < 2; ++ai)
#pragma unroll
            for (int m = 0; m < 4; ++m) { bf16_t* rowp = base + (size_t)(row0 + ai * HALF + m * 16) * ldc + col0;
#pragma unroll
                for (int bj = 0; bj < 2; ++bj) { f32x4 v0 = acc[ai][bj][m][0] + bv[bj][0], v1 = acc[ai][bj][m][1] + bv[bj][1];
                    if (ACT == 1) { f32x2 a = gelu_pk((f32x2){v0[0], v0[1]}), b = gelu_pk((f32x2){v0[2], v0[3]}), c = gelu_pk((f32x2){v1[0], v1[1]}), d = gelu_pk((f32x2){v1[2], v1[3]});
                        v0 = (f32x4){a.x, a.y, b.x, b.y}; v1 = (f32x4){c.x, c.y, d.x, d.y}; }
                    v0 = v0 * sc; v1 = v1 * sc; u32x4 w; w.x = cvt_pk_bf16(v0[0], v0[1]); w.y = cvt_pk_bf16(v0[2], v0[3]); w.z = cvt_pk_bf16(v1[0], v1[1]); w.w = cvt_pk_bf16(v1[2], v1[3]);
                    *(u32x4*)(rowp + bj * HALF) = w; } }
    }
};

__device__ __forceinline__ float epi_sigm(float x) { return __builtin_amdgcn_rcpf(1.f + __expf(-x)); }
struct EpiGlu {
    static constexpr bool PERM = false, AFTER_DRAIN = false;
    bf16_t* O; int ldo;
    __device__ __forceinline__ void operator()(const f32x4 (&acc)[2][2][4][2], const Unit& u, int wr, int wc, int fr, int fq) const {
        const int row0 = u.pm * BM + wr * 64 + fr;
#pragma unroll
        for (int ai = 0; ai < 2; ++ai)
#pragma unroll
            for (int m = 0; m < 4; ++m) { bf16_t* rowp = O + (size_t)(row0 + ai * HALF + m * 16) * ldo + 4 * fq;
#pragma unroll
                for (int bj = 0; bj < 2; ++bj) { const int G = u.pn * 8 + bj * 4 + wc; const f32x4 av = acc[ai][bj][m][0], gv = acc[ai][bj][m][1];
                    typedef unsigned u32x2 __attribute__((ext_vector_type(2))); u32x2 w;
                    w.x = cvt_pk_bf16(av[0] * epi_sigm(gv[0]), av[1] * epi_sigm(gv[1])); w.y = cvt_pk_bf16(av[2] * epi_sigm(gv[2]), av[3] * epi_sigm(gv[3]));
                    *(u32x2*)(rowp + 16 * G) = w; } }
    }
};
template <int MODE> struct EpiMerge {
    static constexpr bool PERM = true, AFTER_DRAIN = false;
    float* M; const float* M2; bf16_t* Mb; const bf16_t* Zg; int ldz;
    __device__ __forceinline__ void operator()(const f32x4 (&acc)[2][2][4][2], const Unit& u, int wr, int wc, int fr, int fq) const {
        const int row0 = u.pm * BM + wr * 64 + fr, col0 = u.pn * BM + wc * 32 + 8 * fq;
#pragma unroll
        for (int ai = 0; ai < 2; ++ai)
#pragma unroll
            for (int m = 0; m < 4; ++m) { const size_t row = (size_t)(row0 + ai * HALF + m * 16);
#pragma unroll
                for (int bj = 0; bj < 2; ++bj) { const int col = col0 + bj * HALF;
                    const u32x4 gz = *(const u32x4*)(Zg + row * ldz + col);
                    float g[8]; g[0] = __builtin_bit_cast(float, gz.x << 16); g[1] = __builtin_bit_cast(float, gz.x & 0xffff0000u); g[2] = __builtin_bit_cast(float, gz.y << 16); g[3] = __builtin_bit_cast(float, gz.y & 0xffff0000u);
                    g[4] = __builtin_bit_cast(float, gz.z << 16); g[5] = __builtin_bit_cast(float, gz.z & 0xffff0000u); g[6] = __builtin_bit_cast(float, gz.w << 16); g[7] = __builtin_bit_cast(float, gz.w & 0xffff0000u);
                    f32x4 v0 = acc[ai][bj][m][0], v1 = acc[ai][bj][m][1];
#pragma unroll
                    for (int j = 0; j < 4; ++j) { v0[j] *= epi_sigm(g[j]); v1[j] *= epi_sigm(g[4 + j]); }
                    if (MODE == 0) { float* mp = M + row * 1024 + col; *(f32x4*)mp = v0; *(f32x4*)(mp + 4) = v1; }
                    else { const float* mp = M + row * 1024 + col; const float* mq = M2 + row * 1024 + col;
                        v0 += *(const f32x4*)mp + *(const f32x4*)mq; v1 += *(const f32x4*)(mp + 4) + *(const f32x4*)(mq + 4);
                        u32x4 w; w.x = cvt_pk_bf16(v0[0], v0[1]); w.y = cvt_pk_bf16(v0[2], v0[3]); w.z = cvt_pk_bf16(v1[0], v1[1]); w.w = cvt_pk_bf16(v1[2], v1[3]); *(u32x4*)(Mb + row * 1024 + col) = w; } } }
    }
};
struct EpiResid {
    static constexpr bool PERM = false, AFTER_DRAIN = false;
    float* X; int ldx; bool dry; bf16_t* Xb;
    __device__ __forceinline__ void operator()(const f32x4 (&acc)[2][2][4][2], const Unit& u, int wr, int wc, int fr, int fq) const {
        const int row0 = u.pm * BM + wr * 64 + fr, col0 = u.pn * BM + wc * 32 + 4 * fq;
#pragma unroll
        for (int ai = 0; ai < 2; ++ai)
#pragma unroll
            for (int m = 0; m < 4; ++m) { const int row = row0 + ai * HALF + m * 16;
                bool ok = true; if (row < 16896) { const int p = row % 8448; ok = p >= 48 && p < 8256; }
                if (ok && !dry) { float* rowp = X + (size_t)row * ldx + col0;
#pragma unroll
                    for (int bj = 0; bj < 2; ++bj)
#pragma unroll
                        for (int n = 0; n < 2; ++n) { f32x4* p4 = (f32x4*)(rowp + bj * HALF + n * 16); const f32x4 v = *p4 + acc[ai][bj][m][n]; *p4 = v;
                            typedef unsigned u32x2 __attribute__((ext_vector_type(2))); u32x2 w; w.x = cvt_pk_bf16(v[0], v[1]); w.y = cvt_pk_bf16(v[2], v[3]);
                            *(u32x2*)(Xb + (size_t)row * ldx + col0 + bj * HALF + n * 16) = w; } } }
    }
};
struct EpiF32 {
    static constexpr bool PERM = false, AFTER_DRAIN = false;
    float* C; int ldc;
    __device__ __forceinline__ void operator()(const f32x4 (&acc)[2][2][4][2], const Unit& u, int wr, int wc, int fr, int fq) const {
        const int row0 = u.pm * BM + wr * 64 + fr, col0 = u.pn * BM + wc * 32 + 4 * fq;
#pragma unroll
        for (int ai = 0; ai < 2; ++ai)
#pragma unroll
            for (int m = 0; m < 4; ++m) { float* rowp = C + (size_t)(row0 + ai * HALF + m * 16) * ldc + col0;
#pragma unroll
                for (int bj = 0; bj < 2; ++bj)
#pragma unroll
                    for (int n = 0; n < 2; ++n) *(f32x4*)(rowp + bj * HALF + n * 16) = acc[ai][bj][m][n]; }
    }
};

template <class Epi, class Sched, bool ALIGN_EPI = false, bool SP2 = false>
__device__ __forceinline__ void gemm_phase(PG8_LAS unsigned char* lds, const Gemm g, const Sched& S, const Epi& E, int wv) {
    unsigned om_ = ~0u; asm volatile("" : "+s"(om_), "+s"(wv)); int tid_ = wv * 64 + (int)__builtin_amdgcn_mbcnt_hi(om_, __builtin_amdgcn_mbcnt_lo(om_, 0u));
    const int tid = tid_, wid = __builtin_amdgcn_readfirstlane(tid >> 6), lane = tid & 63, wr = wid >> 2, wc = wid & 3, fr = lane & 15, fq = lane >> 4;
    const int K = g.K, nt = K / BK;
    unsigned voffA[2], voffB[2];
#pragma unroll
    for (int i = 0; i < 2; ++i) { int R, C; stage_rc(tid * 16 + i * 8192, R, C); const int Rb = Epi::PERM ? ((R & ~31) + perm32(R & 31)) : R;
        voffA[i] = (unsigned)(R * K + C) * 2u; voffB[i] = (unsigned)(Rb * K + C) * 2u; }
    const size_t kstep = (size_t)(BK * 2);
    const size_t hstep = (size_t)HALF * K * 2;
    const size_t tstep = 2 * hstep;
    const unsigned ldsw = (unsigned)wid * 1024u;
    const int aoff = lds_byte(wr * 64 + fr, fq * 8), boff = lds_byte(wc * 32 + fr, fq * 8);
#define PG8_SA(b, h) (((b) * 2 + (h)) * HTB)
#define PG8_SB(b, h) ((4 + (b) * 2 + (h)) * HTB)
#define PG8_STAGE(bufoff, gbase, voff) do { _Pragma("unroll") for (int _i = 0; _i < 2; ++_i) \
        __builtin_amdgcn_global_load_lds((const unsigned*)((const char*)(gbase) + (voff)[_i]), (PG8_LAS unsigned*)(lds + (bufoff) + ldsw + _i * 8192), 16, 0, 0); } while (0)
#define PG8_LDA(dst, b, h) do { _Pragma("unroll") for (int m = 0; m < 4; ++m) _Pragma("unroll") for (int k = 0; k < 2; ++k) dst[m][k] = *(const PG8_LAS bf16x8*)(lds + PG8_SA(b, h) + aoff + m * 2048 + k * 1024); } while (0)
#define PG8_LDB(dst, b, h) do { _Pragma("unroll") for (int n = 0; n < 2; ++n) _Pragma("unroll") for (int k = 0; k < 2; ++k) dst[n][k] = *(const PG8_LAS bf16x8*)(lds + PG8_SB(b, h) + boff + n * 2048 + k * 1024); } while (0)
#define PG8_MMA(ai, bj, At, Bt) do { __builtin_amdgcn_s_setprio(1); _Pragma("unroll") for (int m = 0; m < 4; ++m) _Pragma("unroll") for (int n = 0; n < 2; ++n) _Pragma("unroll") for (int k = 0; k < 2; ++k) \
        acc[ai][bj][m][n] = __builtin_amdgcn_mfma_f32_16x16x32_bf16(Bt[n][k], At[m][k], acc[ai][bj][m][n], 0, 0, 0); __builtin_amdgcn_s_setprio(0); } while (0)
#define PG8_WAIT_V(n) asm volatile("s_waitcnt vmcnt(" #n ")" ::: "memory")
#define PG8_WAIT_L(n) asm volatile("s_waitcnt lgkmcnt(" #n ")" ::: "memory")
#define PG8_BAR __builtin_amdgcn_s_barrier()
#define PG8_SCHED __builtin_amdgcn_sched_barrier(0)
    Unit cur, nxt; int ui = 0;
    if (!S.next(0, cur)) return;
    f32x4 acc[2][2][4][2];
#pragma unroll
    for (int a = 0; a < 2; ++a)
#pragma unroll
        for (int b = 0; b < 2; ++b)
#pragma unroll
            for (int m = 0; m < 4; ++m)
#pragma unroll
                for (int n = 0; n < 2; ++n) acc[a][b][m][n] = (f32x4){0.f, 0.f, 0.f, 0.f};
    bf16x8 At[4][2], B0[2][2], B1[2][2];
    const char* cA = (const char*)g.A + (size_t)cur.pm * tstep; const char* cB = (const char*)g.Bt + (size_t)cur.pn * tstep;
    S.a_ready(cur);
    if constexpr (SP2) {
        PG8_STAGE(PG8_SB(0, 0), cB, voffB); PG8_STAGE(PG8_SB(0, 1), cB + hstep, voffB); PG8_STAGE(PG8_SA(0, 0), cA, voffA); PG8_STAGE(PG8_SA(0, 1), cA + hstep, voffA);
        if (wr == 1) PG8_BAR;
        PG8_WAIT_V(2); PG8_BAR;
        PG8_STAGE(PG8_SB(1, 0), cB + kstep, voffB); PG8_STAGE(PG8_SA(1, 0), cA + kstep, voffA); PG8_STAGE(PG8_SB(1, 1), cB + hstep + kstep, voffB);
        PG8_WAIT_V(6); PG8_BAR;
    } else {
        PG8_STAGE(PG8_SB(0, 0), cB, voffB); PG8_STAGE(PG8_SA(0, 0), cA, voffA); PG8_STAGE(PG8_SB(0, 1), cB + hstep, voffB); PG8_STAGE(PG8_SA(0, 1), cA + hstep, voffA);
        if (wr == 1) PG8_BAR;
        PG8_WAIT_V(4); PG8_BAR;
        PG8_STAGE(PG8_SB(1, 0), cB + kstep, voffB); PG8_STAGE(PG8_SA(1, 0), cA + kstep, voffA); PG8_STAGE(PG8_SB(1, 1), cB + hstep + kstep, voffB);
        PG8_WAIT_V(6); PG8_BAR;
    }
    for (;;) {
        const bool has_next = S.next(ui + 1, nxt);
        const char* nA = has_next ? (const char*)g.A + (size_t)nxt.pm * tstep : cA; const char* nB = has_next ? (const char*)g.Bt + (size_t)nxt.pn * tstep : cB;
        for (int t = 0; t < nt; t += 2) {
            const bool last = (t == nt - 2);
            const char* a1 = cA + (size_t)(t + 1) * kstep;
            const char* a2 = last ? nA : cA + (size_t)(t + 2) * kstep; const char* b2 = last ? nB : cB + (size_t)(t + 2) * kstep;
            const char* a3 = a2 + kstep; const char* b3 = b2 + kstep;
            if (last && has_next) S.a_ready(nxt);
            if constexpr (SP2) {
            PG8_LDB(B0, 0, 0); PG8_LDB(B1, 0, 1); PG8_SCHED; PG8_LDA(At, 0, 0); PG8_STAGE(PG8_SA(1, 1), a1 + hstep, voffA);
            PG8_WAIT_V(8); PG8_WAIT_L(0); PG8_BAR; PG8_MMA(0, 0, At, B0); PG8_MMA(0, 1, At, B1); PG8_BAR; PG8_SCHED;
            PG8_LDA(At, 0, 1); PG8_STAGE(PG8_SB(0, 0), b2, voffB); PG8_STAGE(PG8_SB(0, 1), b2 + hstep, voffB); PG8_STAGE(PG8_SA(0, 0), a2, voffA);
            PG8_WAIT_V(8); PG8_WAIT_L(0); PG8_BAR; PG8_MMA(1, 0, At, B0); PG8_MMA(1, 1, At, B1); PG8_BAR; PG8_SCHED;
            PG8_LDB(B0, 1, 0); PG8_LDB(B1, 1, 1); PG8_SCHED; PG8_LDA(At, 1, 0); PG8_STAGE(PG8_SA(0, 1), a2 + hstep, voffA);
            PG8_WAIT_V(8); PG8_WAIT_L(0); PG8_BAR; PG8_MMA(0, 0, At, B0); PG8_MMA(0, 1, At, B1); PG8_BAR; PG8_SCHED;
            PG8_LDA(At, 1, 1); PG8_STAGE(PG8_SB(1, 0), b3, voffB); PG8_STAGE(PG8_SB(1, 1), b3 + hstep, voffB); PG8_STAGE(PG8_SA(1, 0), a3, voffA);
            PG8_WAIT_V(8); PG8_WAIT_L(0); PG8_BAR; PG8_MMA(1, 0, At, B0); PG8_MMA(1, 1, At, B1); PG8_BAR; PG8_SCHED;
            } else {
            PG8_LDB(B0, 0, 0); PG8_SCHED; PG8_LDA(At, 0, 0); PG8_STAGE(PG8_SA(1, 1), a1 + hstep, voffA);
            PG8_WAIT_L(8); PG8_BAR; PG8_WAIT_L(0); PG8_MMA(0, 0, At, B0); PG8_BAR; PG8_SCHED;
            PG8_LDB(B1, 0, 1); PG8_STAGE(PG8_SB(0, 0), b2, voffB);
            PG8_BAR; PG8_WAIT_L(0); PG8_MMA(0, 1, At, B1); PG8_BAR;
            PG8_LDA(At, 0, 1); PG8_STAGE(PG8_SA(0, 0), a2, voffA);
            PG8_BAR; PG8_WAIT_L(0); PG8_MMA(1, 0, At, B0); PG8_BAR; PG8_SCHED;
            PG8_STAGE(PG8_SB(0, 1), b2 + hstep, voffB);
            PG8_WAIT_V(6); PG8_BAR; PG8_MMA(1, 1, At, B1); PG8_BAR;
            PG8_LDB(B0, 1, 0); PG8_SCHED; PG8_LDA(At, 1, 0); PG8_STAGE(PG8_SA(0, 1), a2 + hstep, voffA);
            PG8_WAIT_L(8); PG8_BAR; PG8_WAIT_L(0); PG8_MMA(0, 0, At, B0); PG8_BAR; PG8_SCHED;
            PG8_LDB(B1, 1, 1); PG8_STAGE(PG8_SB(1, 0), b3, voffB);
            PG8_BAR; PG8_WAIT_L(0); PG8_MMA(0, 1, At, B1); PG8_BAR;
            PG8_LDA(At, 1, 1); PG8_STAGE(PG8_SA(1, 0), a3, voffA);
            PG8_BAR; PG8_WAIT_L(0); PG8_MMA(1, 0, At, B0); PG8_BAR; PG8_SCHED;
            PG8_STAGE(PG8_SB(1, 1), b3 + hstep, voffB);
            PG8_WAIT_V(6); PG8_BAR; PG8_MMA(1, 1, At, B1); PG8_BAR;
            }
        }
        if constexpr (ALIGN_EPI) { if (wr == 0) PG8_BAR; }
        if constexpr (!Epi::AFTER_DRAIN) { E(acc, cur, wr, wc, fr, fq); S.done(cur); }
        if (!has_next) break;
#pragma unroll
        for (int a = 0; a < 2; ++a)
#pragma unroll
            for (int b = 0; b < 2; ++b)
#pragma unroll
                for (int m = 0; m < 4; ++m)
#pragma unroll
                    for (int n = 0; n < 2; ++n) acc[a][b][m][n] = (f32x4){0.f, 0.f, 0.f, 0.f};
        cur = nxt; cA = nA; cB = nB; ++ui;
        if constexpr (ALIGN_EPI) { if (wr == 1) PG8_BAR; }
    }
    PG8_WAIT_V(0);
    if constexpr (!ALIGN_EPI) { if (wr == 0) PG8_BAR; }
    PG8_BAR;
    if constexpr (Epi::AFTER_DRAIN) { E.fused(acc, cur, wr, wc, fr, fq, lds, wid, lane); S.done(cur); }
#undef PG8_SA
#undef PG8_SB
#undef PG8_STAGE
#undef PG8_LDA
#undef PG8_LDB
#undef PG8_MMA
#undef PG8_WAIT_V
#undef PG8_WAIT_L
#undef PG8_BAR
#undef PG8_SCHED
}
}
#include <hip/hip_bf16.h>
#include <cmath>
namespace attn_body {
using bf16=__hip_bfloat16;
using bf16x8=__attribute__((ext_vector_type(8)))short;
using s16x4=__attribute__((ext_vector_type(4)))short;
using f32x16=__attribute__((ext_vector_type(16)))float;
using u32x4=__attribute__((ext_vector_type(4)))unsigned;
constexpr int ASEQ=8448,D=64;
constexpr int QP=512,KP=512,VP=7424,OP=1024;
constexpr int NW=8,QBLK=32,QB=QBLK*NW,KVBLK=64,NQB=ASEQ/QB;
constexpr int ATTN_UNIT_ROWS=QB;
__device__ __forceinline__ int crow(int r,int hi){return (r&3)+8*(r>>2)+4*hi;}
#define SBAR() __builtin_amdgcn_sched_barrier(0)
constexpr int BT_OFF=383, BT_N=640;
__device__ __forceinline__ void bmask(f32x16&p0,f32x16&p1,int t,int q0,int wid,int r32,int hi,const __attribute__((address_space(3))) float*tab){
  const float NEG=-INFINITY; const int qw=q0+32*wid;
  if(t>(qw>>6)){
    #pragma unroll
    for(int r=0;r<16;++r){p0[r]=NEG;p1[r]=NEG;} return; }
  if(t>0 && 64*t+63+91<=qw) return;
  const int q=qw+r32, kb=64*t+4*hi;
  #pragma unroll
  for(int r=0;r<16;++r){ const int kv=kb+(r&3)+8*(r>>2); int i0=kv-q+BT_OFF, i1=i0+32; i0=i0<0?0:i0; i1=i1<0?0:i1;
    p0[r]+=tab[i0]; p1[r]+=tab[i1]; if(kv<48)p0[r]=NEG; if(kv+32<48)p1[r]=NEG; }
}

constexpr int NSLOT=3, SLOTB=8192;
constexpr int LDS_K=0, LDS_V=NSLOT*SLOTB, LDS_WS=2*NSLOT*SLOTB, LDS_OST=LDS_WS+NW*64*4, LDS_BT=LDS_OST+NW*4096, LDS_BYTES=LDS_BT+BT_N*4;
constexpr float C2=0.125f*1.4426950408889634f;
__device__ __forceinline__ void glds16(const void*gsrc,unsigned lds_dst){unsigned keep;
  asm volatile("s_mov_b32 %0, m0\n\ts_mov_b32 m0, %2\n\ts_nop 0\n\tglobal_load_lds_dwordx4 %1, off\n\ts_mov_b32 m0, %0":"=&s"(keep):"v"(gsrc),"s"(lds_dst):"memory");}
__device__ __forceinline__ float max3f(float a,float b,float c){float r;asm("v_max3_f32 %0, %1, %2, %3":"=v"(r):"v"(a),"v"(b),"v"(c));return r;}
__device__ __forceinline__ float max2f(float a,float b){float r;asm("v_max_f32_e32 %0, %1, %2":"=v"(r):"v"(a),"v"(b));return r;}
__device__ __forceinline__ float fadd_s(float a,float b){float r;asm("v_add_f32_e32 %0, %1, %2":"=v"(r):"v"(a),"v"(b));return r;}
__device__ __forceinline__ float fsub_s(float a,float b){float r;asm("v_sub_f32_e32 %0, %1, %2":"=v"(r):"v"(a),"v"(b));return r;}
typedef float f32x2_t __attribute__((ext_vector_type(2))); typedef __bf16 bf16x2_t __attribute__((ext_vector_type(2)));
__device__ __forceinline__ unsigned cvtpk_s(float lo,float hi){f32x2_t v={lo,hi};bf16x2_t b=__builtin_convertvector(v,bf16x2_t);return __builtin_bit_cast(unsigned,b);}
#define WAIT_BAR(N) asm volatile("s_waitcnt vmcnt(" #N ") lgkmcnt(0)\n\ts_barrier":::"memory")

__device__ __forceinline__ void qkt(f32x16&p0,f32x16&p1,const char*Kslot,const bf16x8*qr,const f32x16&negm,int r32,int hi){
  const char*kb=Kslot+hi*1024+r32*16;
  #pragma unroll
  for(int d0=0;d0<4;++d0){
    const bf16x8 b0=*reinterpret_cast<const bf16x8*>(kb+d0*2048);
    const bf16x8 b1=*reinterpret_cast<const bf16x8*>(kb+d0*2048+512);
    if(d0==0){p0=__builtin_amdgcn_mfma_f32_32x32x16_bf16(b0,qr[0],negm,0,0,0);p1=__builtin_amdgcn_mfma_f32_32x32x16_bf16(b1,qr[0],negm,0,0,0);}
    else{p0=__builtin_amdgcn_mfma_f32_32x32x16_bf16(b0,qr[d0],p0,0,0,0);p1=__builtin_amdgcn_mfma_f32_32x32x16_bf16(b1,qr[d0],p1,0,0,0);}}
}
typedef __attribute__((address_space(3))) const char* lds_cptr;
typedef __attribute__((address_space(3))) const float* lds_cfptr;
typedef short v4i16_t __attribute__((ext_vector_type(4)));
__device__ __forceinline__ void kload8(bf16x8*kf,lds_cptr kp){
  kf[0]=*(const __attribute__((address_space(3))) bf16x8*)(kp);      kf[1]=*(const __attribute__((address_space(3))) bf16x8*)(kp+512);
  kf[2]=*(const __attribute__((address_space(3))) bf16x8*)(kp+2048); kf[3]=*(const __attribute__((address_space(3))) bf16x8*)(kp+2560);
  kf[4]=*(const __attribute__((address_space(3))) bf16x8*)(kp+4096); kf[5]=*(const __attribute__((address_space(3))) bf16x8*)(kp+4608);
  kf[6]=*(const __attribute__((address_space(3))) bf16x8*)(kp+6144); kf[7]=*(const __attribute__((address_space(3))) bf16x8*)(kp+6656);
}
__device__ __forceinline__ void kload2(bf16x8*kf,lds_cptr kp,int j){ kf[2*j]=*(const __attribute__((address_space(3))) bf16x8*)(kp+j*2048); kf[2*j+1]=*(const __attribute__((address_space(3))) bf16x8*)(kp+j*2048+512); }
__device__ __forceinline__ s16x4 vtr(lds_cptr p){ return __builtin_bit_cast(s16x4,__builtin_amdgcn_ds_read_tr16_b64_v4i16((__attribute__((address_space(3))) v4i16_t*)p)); }
__device__ __forceinline__ float rowmax(const f32x16&p0,const f32x16&p1){
  float a=max3f(p0[0],p0[1],p1[0]),b=max3f(p0[2],p0[3],p1[1]);a=max3f(a,p1[2],p1[3]);
  #pragma unroll
  for(int r=4;r<16;r+=4){a=max3f(a,p0[r],p0[r+1]);b=max3f(b,p0[r+2],p0[r+3]);a=max3f(a,p1[r],p1[r+1]);b=max3f(b,p1[r+2],p1[r+3]);}
  const float m=max2f(a,b);
  auto rr=__builtin_amdgcn_permlane32_swap(__float_as_uint(m),__float_as_uint(m),false,false);
  return max2f(__uint_as_float(rr[0]),__uint_as_float(rr[1]));
}
__device__ __forceinline__ void pv(f32x16*o,int vb,bf16x8 pa0,bf16x8 pa1,bf16x8 pa2,bf16x8 pa3){
  #pragma unroll
  for(int d0=0;d0<2;++d0){s16x4 lo[4],hi[4];
    #pragma unroll
    for(int ks=0;ks<4;++ks){
      asm volatile("ds_read_b64_tr_b16 %0,%1 offset:%c2":"=&v"(lo[ks]):"v"(vb),"i"(d0*4096+ks*1024):"memory");
      asm volatile("ds_read_b64_tr_b16 %0,%1 offset:%c2":"=&v"(hi[ks]):"v"(vb),"i"(d0*4096+ks*1024+512):"memory");}
    asm volatile("s_waitcnt lgkmcnt(0)":::"memory");SBAR();
    #define PK(k) (bf16x8){lo[k][0],lo[k][1],lo[k][2],lo[k][3],hi[k][0],hi[k][1],hi[k][2],hi[k][3]}
    o[d0]=__builtin_amdgcn_mfma_f32_32x32x16_bf16(pa0,PK(0),o[d0],0,0,0);
    o[d0]=__builtin_amdgcn_mfma_f32_32x32x16_bf16(pa1,PK(1),o[d0],0,0,0);
    o[d0]=__builtin_amdgcn_mfma_f32_32x32x16_bf16(pa2,PK(2),o[d0],0,0,0);
    o[d0]=__builtin_amdgcn_mfma_f32_32x32x16_bf16(pa3,PK(3),o[d0],0,0,0);
    #undef PK
  }
}

#ifndef ATTN_STORE16
#define ATTN_STORE16(p,v) (*(u32x4*)(p)=(v))
#endif
template<int THRL> __device__ __forceinline__ void attn_unit(int b,int qoff,int voff,int ooff,int qb,const bf16*Q,const bf16*__restrict__ K,const bf16*__restrict__ V,bf16*O,char*shm,int wv){
  unsigned om_ = ~0u; asm volatile("" : "+s"(om_), "+s"(wv)); int tid_ = wv * 64 + (int)__builtin_amdgcn_mbcnt_hi(om_, __builtin_amdgcn_mbcnt_lo(om_, 0u)); const int tid=tid_,lane=tid&63,r32=lane&31,hi=lane>>5; const int wid=__builtin_amdgcn_readfirstlane(tid>>6);
  const long rowbase=(long)b*ASEQ; const int q0=qb*QB;
  const bf16*Qw=Q+(rowbase+q0+wid*QBLK)*QP+qoff;
  const bf16*Kh=K+rowbase*KP+qoff,*Vh=V+rowbase*VP+voff;
  const unsigned lds0=(unsigned)(uintptr_t)shm;
  float*wsf=(float*)(shm+LDS_WS)+wid*64;
  const bf16*ksrc=Kh+(long)lane*KP+wid*8;
  const bf16*vsrc=Vh+(long)(16*(wid&3)+(lane>>2))*VP+(wid>>2)*32+(lane&3)*8;
  const unsigned kdst=lds0+LDS_K+wid*1024, vdst=lds0+LDS_V+wid*1024;
  #define DMA_K(t,slot) glds16(ksrc+(long)(t)*KVBLK*KP,(unsigned)__builtin_amdgcn_readfirstlane(kdst+(slot)))
  #define DMA_V(t,slot) glds16(vsrc+(long)(t)*KVBLK*VP,(unsigned)__builtin_amdgcn_readfirstlane(vdst+(slot)))
  const int vb0=(int)(lds0+LDS_V)+((lane>>4)&1)*32+(lane&3)*8+(4*hi+((lane&15)>>2))*64;
  const char*Kbase=shm+LDS_K; bf16x8 kf[8];
  const lds_cptr shm3=(lds_cptr)shm; const lds_cfptr btab=(lds_cfptr)(shm3+LDS_BT); const lds_cptr kp0=shm3+LDS_K+hi*1024+r32*16; const lds_cptr vp0=shm3+LDS_V+((lane>>4)&1)*32+(lane&3)*8+(4*hi+((lane&15)>>2))*64;
  const int NTL=(q0+QB)/KVBLK;
  DMA_K(0,0);DMA_V(0,0);DMA_K(1,SLOTB);
  bf16x8 qr[4];
  #pragma unroll
  for(int d0=0;d0<4;++d0)qr[d0]=*reinterpret_cast<const bf16x8*>(&Qw[(long)r32*QP+d0*16+hi*8]);
  float mhat=0.f,l_reg=0.f;f32x16 o[2];o[0]=f32x16{};o[1]=f32x16{};const f32x16 zt=f32x16{};
  const int qrel=wid*QBLK+r32;
  #define CMASK(P0,P1,t) bmask(P0,P1,(t),q0,wid,r32,hi,btab)
  bool resc=false;
  #define START(P0,P1) do{ const float rm=rowmax(P0,P1); resc=false; \
    { const float dl=rm; mhat=fadd_s(mhat,dl); \
      _Pragma("unroll") for(int r=0;r<16;++r){P0[r]=fsub_s(P0[r],dl);P1[r]=fsub_s(P1[r],dl);} \
      } \
    _Pragma("unroll") for(int r=0;r<16;++r)P0[r]=__builtin_amdgcn_exp2f(P0[r]); }while(0)
  #define RESC() do{ if(resc){ asm volatile("s_waitcnt lgkmcnt(0)":::"memory"); \
      _Pragma("unroll") for(int d_=0;d_<2;++d_) _Pragma("unroll") for(int r=0;r<16;++r)o[d_][r]*=wsf[crow(r,hi)]; } }while(0)
  f32x16 pA0,pA1,pB0,pB1;
  int sl_prev=0,sl_cur=0,sl_next=SLOTB;
  #define ROT() do{sl_prev=sl_cur;sl_cur=sl_next;sl_next=(sl_next==(NSLOT-1)*SLOTB)?0:sl_next+SLOTB;}while(0)
  DMA_K(2,2*SLOTB);
  WAIT_BAR(3);
  qkt(pA0,pA1,Kbase,qr,zt,r32,hi);asm volatile("s_nop 15\n\ts_nop 7":"+v"(pA0),"+v"(pA1));CMASK(pA0,pA1,0);
  START(pA0,pA1);
  _Pragma("unroll") for(int r=0;r<16;++r)pA1[r]=__builtin_amdgcn_exp2f(pA1[r]);
  WAIT_BAR(0);
  DMA_K(3,0);DMA_V(1,SLOTB);
  ROT();
  kload8(kf,kp0+sl_cur);
  WAIT_BAR(2);
  s16x4 vlo[8],vhi[8]; u32x4 pw0,pw1,pw2,pw3;
  #define PKW(P,B) cvtpk_s(P[B],P[B+1])
  #define PAF(k) __builtin_bit_cast(bf16x8,pw##k)
  #define VFR(i) (bf16x8){vlo[i][0],vlo[i][1],vlo[i][2],vlo[i][3],vhi[i][0],vhi[i][1],vhi[i][2],vhi[i][3]}
  #define PIN(x) asm volatile("":"+v"(x))
  #define MX3(a,b,c) __builtin_fmaxf(__builtin_fmaxf((a),(b)),(c))
  #define GAPA(MF,A0,A1,A2,A3,W0,W1,PW) do{ MF; sacc+=A0; sacc+=A1; sacc+=A2; sacc+=A3; PIN(sacc); W0; W1; PIN(PW); SBAR(); }while(0)
  #define EX(v) __builtin_amdgcn_exp2f(v)
  #define GAPB(MF,X,B) do{ MF; X[B]=EX(X[B]); X[B+1]=EX(X[B+1]); X[B+2]=EX(X[B+2]); X[B+3]=EX(X[B+3]); PIN(X); SBAR(); }while(0)
  #define VRD(i) do{ vlo[i]=vtr(vp_+(((i)>>2)*4096+((i)&3)*1024)); vhi[i]=vtr(vp_+(((i)>>2)*4096+((i)&3)*1024+512)); }while(0)
  #define KRD(G,j) do{ if(G){ kload2(kf,kp0+sl_next,j); SBAR(); } }while(0)
  #define STEP(C0,C1,P0,P1,t,GK,GV,GL) do{ SBAR(); \
    const lds_cptr vp_=vp0+sl_prev; \
    VRD(0); SBAR(); float sacc=(P0[0]+P0[1]); \
    GAPA(C0=__builtin_amdgcn_mfma_f32_32x32x16_bf16(kf[0],qr[0],zt,0,0,0), P0[2],P0[3],P0[4],P0[5],     pw0[0]=PKW(P0,0), pw0[1]=PKW(P0,2), pw0); \
    VRD(4); SBAR(); GAPA(C1=__builtin_amdgcn_mfma_f32_32x32x16_bf16(kf[1],qr[0],zt,0,0,0), P0[6],P0[7],P0[8],P0[9],     pw0[2]=PKW(P0,4), pw0[3]=PKW(P0,6), pw0); \
    VRD(1); SBAR(); GAPA(C0=__builtin_amdgcn_mfma_f32_32x32x16_bf16(kf[2],qr[1],C0,0,0,0),   P0[10],P0[11],P0[12],P0[13], pw1[0]=PKW(P0,8), pw1[1]=PKW(P0,10), pw1); \
    VRD(5); SBAR(); GAPA(C1=__builtin_amdgcn_mfma_f32_32x32x16_bf16(kf[3],qr[1],C1,0,0,0),   P0[14],P0[15],P1[0],P1[1],   pw1[2]=PKW(P0,12),pw1[3]=PKW(P0,14), pw1); \
    VRD(2); SBAR(); GAPA(C0=__builtin_amdgcn_mfma_f32_32x32x16_bf16(kf[4],qr[2],C0,0,0,0),   P1[2],P1[3],P1[4],P1[5],     pw2[0]=PKW(P1,0), pw2[1]=PKW(P1,2), pw2); \
    VRD(6); SBAR(); GAPA(C1=__builtin_amdgcn_mfma_f32_32x32x16_bf16(kf[5],qr[2],C1,0,0,0),   P1[6],P1[7],P1[8],P1[9],     pw2[2]=PKW(P1,4), pw2[3]=PKW(P1,6), pw2); \
    VRD(3); SBAR(); GAPA(C0=__builtin_amdgcn_mfma_f32_32x32x16_bf16(kf[6],qr[3],C0,0,0,0),   P1[10],P1[11],P1[12],P1[13], pw3[0]=PKW(P1,8), pw3[1]=PKW(P1,10), pw3); \
    VRD(7); SBAR(); GAPA(C1=__builtin_amdgcn_mfma_f32_32x32x16_bf16(kf[7],qr[3],C1,0,0,0),   P1[14],P1[15],0.f,0.f,       pw3[2]=PKW(P1,12),pw3[3]=PKW(P1,14), pw3); \
    l_reg+=sacc; \
    if(GK){DMA_K((t)+3,sl_cur);} if(GV){DMA_V((t)+1,sl_next);} \
    _Pragma("unroll") for(int r=0;r<16;++r){C0[r]-=mhat;C1[r]-=mhat;} \
    CMASK(C0,C1,t); \
    { float a=MX3(C0[0],C0[1],C1[0]),b=MX3(C0[2],C0[3],C1[1]); a=MX3(a,C1[2],C1[3]); \
      _Pragma("unroll") for(int r=4;r<16;r+=4){a=MX3(a,C0[r],C0[r+1]);b=MX3(b,C0[r+2],C0[r+3]);a=MX3(a,C1[r],C1[r+1]);b=MX3(b,C1[r+2],C1[r+3]);} \
      float rm=__builtin_fmaxf(a,b); { auto rr=__builtin_amdgcn_permlane32_swap(__float_as_uint(rm),__float_as_uint(rm),false,false); rm=__builtin_fmaxf(__uint_as_float(rr[0]),__uint_as_float(rr[1])); } \
      resc=false; \
      if(__builtin_expect(__any(rm>(float)THRL),0)){ const float dl=__builtin_fmaxf(rm,0.f); mhat+=dl; \
        _Pragma("unroll") for(int r=0;r<16;++r){C0[r]-=dl;C1[r]-=dl;} \
        const float f=__builtin_amdgcn_exp2f(-dl); l_reg*=f; if(hi==0)wsf[r32]=f; resc=true; } } \
    SBAR(); \
    GAPB(o[0]=__builtin_amdgcn_mfma_f32_32x32x16_bf16(PAF(0),VFR(0),o[0],0,0,0), C0,0); \
    GAPB(o[1]=__builtin_amdgcn_mfma_f32_32x32x16_bf16(PAF(0),VFR(4),o[1],0,0,0), C0,4); \
    KRD(GL,0); GAPB(o[0]=__builtin_amdgcn_mfma_f32_32x32x16_bf16(PAF(1),VFR(1),o[0],0,0,0), C0,8); \
    KRD(GL,1); GAPB(o[1]=__builtin_amdgcn_mfma_f32_32x32x16_bf16(PAF(1),VFR(5),o[1],0,0,0), C0,12); \
    KRD(GL,2); GAPB(o[0]=__builtin_amdgcn_mfma_f32_32x32x16_bf16(PAF(2),VFR(2),o[0],0,0,0), C1,0); \
    KRD(GL,3); GAPB(o[1]=__builtin_amdgcn_mfma_f32_32x32x16_bf16(PAF(2),VFR(6),o[1],0,0,0), C1,4); \
    GAPB(o[0]=__builtin_amdgcn_mfma_f32_32x32x16_bf16(PAF(3),VFR(3),o[0],0,0,0), C1,8); \
    GAPB(o[1]=__builtin_amdgcn_mfma_f32_32x32x16_bf16(PAF(3),VFR(7),o[1],0,0,0), C1,12); \
    }while(0)
  int t=1;
  #undef CMASK
  #define CMASK(P0,P1,t) do{}while(0)
  for(;t+7<NTL;t+=2){
    STEP(pB0,pB1,pA0,pA1,t,true,true,true);     WAIT_BAR(2); RESC(); ROT();
    STEP(pA0,pA1,pB0,pB1,t+1,true,true,true);   WAIT_BAR(2); RESC(); ROT();
  }
  #undef CMASK
  #define CMASK(P0,P1,t) bmask(P0,P1,(t),q0,wid,r32,hi,btab)
  #define ENDW(tt) do{ if((tt)+3<NTL){WAIT_BAR(2);} else if((tt)+2<NTL){WAIT_BAR(1);} else {WAIT_BAR(0);} }while(0)
  for(;t+1<NTL;t+=2){
    STEP(pB0,pB1,pA0,pA1,t,(t+3<NTL),(t+1<NTL),(t+1<NTL));       ENDW(t);   RESC(); ROT();
    STEP(pA0,pA1,pB0,pB1,t+1,(t+4<NTL),(t+2<NTL),(t+2<NTL));     ENDW(t+1); RESC(); ROT();
  }
  STEP(pB0,pB1,pA0,pA1,NTL-1,false,false,false); RESC();
  { float sacc=pB0[0]+pB0[1]; _Pragma("unroll") for(int r=2;r<16;++r)sacc+=pB0[r]; _Pragma("unroll") for(int r=0;r<16;++r)sacc+=pB1[r]; l_reg+=sacc;
    pw0=(u32x4){PKW(pB0,0),PKW(pB0,2),PKW(pB0,4),PKW(pB0,6)};pw1=(u32x4){PKW(pB0,8),PKW(pB0,10),PKW(pB0,12),PKW(pB0,14)};pw2=(u32x4){PKW(pB1,0),PKW(pB1,2),PKW(pB1,4),PKW(pB1,6)};pw3=(u32x4){PKW(pB1,8),PKW(pB1,10),PKW(pB1,12),PKW(pB1,14)};
    SBAR(); pv(o,vb0+sl_cur,PAF(0),PAF(1),PAF(2),PAF(3)); }
  #undef PKW
  #undef PAF
  #undef VFR
  #undef PIN
  #undef MX3
  #undef GAPA
  #undef GAPB
  #undef EX
  #undef VRD
  #undef KRD
  #undef STEP
  #undef ENDW
  {auto rr=__builtin_amdgcn_permlane32_swap(__float_as_uint(l_reg),__float_as_uint(l_reg),false,false);l_reg=__uint_as_float(rr[0])+__uint_as_float(rr[1]);}
  if(hi==0)wsf[32+r32]=l_reg;asm volatile("s_waitcnt lgkmcnt(0)":::"memory");
  float rli[16];
  #pragma unroll
  for(int r=0;r<16;++r)rli[r]=__builtin_amdgcn_rcpf(wsf[32+crow(r,hi)]);
  bf16*Ow=O+(rowbase+q0+wid*QBLK)*OP+ooff;
  { bf16*stg=(bf16*)(shm+LDS_OST)+wid*2048;
    #pragma unroll
    for(int r=0;r<16;++r){const int orow=crow(r,hi);
      #pragma unroll
      for(int d0=0;d0<2;++d0)stg[orow*64+d0*32+r32]=__float2bfloat16(o[d0][r]*rli[r]);}
    asm volatile("s_waitcnt lgkmcnt(0)":::"memory");
    #pragma unroll
    for(int i=0;i<4;++i){const int row=i*8+(lane>>3),ch=lane&7; const u32x4 v=*(const u32x4*)(stg+row*64+ch*8); ATTN_STORE16(Ow+(long)row*OP+ch*8,v);} }
  asm volatile("s_waitcnt lgkmcnt(0)\n\ts_barrier":::"memory");
  #undef DMA_K
  #undef DMA_V
  #undef CMASK
  #undef START
  #undef RESC
  #undef ROT
}
constexpr int ATTN_LDS_BYTES=LDS_BYTES;
#undef SBAR
#undef WAIT_BAR
#undef WAIT_BAR
}
namespace mk {
#define GAS __attribute__((address_space(1)))
#define LAS __attribute__((address_space(3)))
typedef unsigned short bf16;
typedef unsigned v4u __attribute__((ext_vector_type(4)));
typedef unsigned v2u __attribute__((ext_vector_type(2)));
typedef float f32x4 __attribute__((ext_vector_type(4)));
typedef float f32x16 __attribute__((ext_vector_type(16)));
typedef short bf16x8 __attribute__((ext_vector_type(8)));
typedef GAS unsigned gu32;
#define RLX_AGENT __ATOMIC_RELAXED, __HIP_MEMORY_SCOPE_AGENT
#define LDS_WAIT() asm volatile("s_waitcnt lgkmcnt(0)" ::: "memory")
#define VM_WAIT() asm volatile("s_waitcnt vmcnt(0)" ::: "memory")
typedef float f32x2_cv __attribute__((ext_vector_type(2))); typedef __bf16 bf16x2_cv __attribute__((ext_vector_type(2)));
__device__ __forceinline__ unsigned pk2(float lo, float hi) { const f32x2_cv v = {lo, hi}; return __builtin_bit_cast(unsigned, __builtin_convertvector(v, bf16x2_cv)); }
__device__ __forceinline__ unsigned f2bf(float f) { return pk2(f, 0.f) & 0xffffu; }
__device__ __forceinline__ float bf2f(unsigned short b) { return __builtin_bit_cast(float, ((unsigned)b) << 16); }
__device__ __forceinline__ float bflo(unsigned w) { return __builtin_bit_cast(float, w << 16); }
__device__ __forceinline__ float bfhi(unsigned w) { return __builtin_bit_cast(float, w & 0xffff0000u); }

constexpr int NWAVES = 8, NTHR = NWAVES * 64;
constexpr int PADF = 48;
constexpr int LPP = 8448;
constexpr int PEND = PADF + LP;
constexpr int SROW0 = BATCH * LPP;
constexpr int RP = SROW0 + NS;
constexpr int ZN = 7424;
constexpr int ZC_QA = 0, ZC_KA = 512, ZC_VA = 1024, ZC_QKVB = 1536, ZC_GB = 3072, ZC_UC = 3584, ZC_GATE = 4096, ZC_BA = 7168;
static_assert(RP % 256 == 0 && ZN % 256 == 0 && D_MODEL == 1024 && WIDTH_A == 512 && WIDTH_B == 512 && WIDTH_C == 512, "shapes");
__host__ __device__ __forceinline__ int nat2prow(int row) { return row < NP ? (row / LP) * LPP + PADF + row % LP : SROW0 + (row - NP); }
__host__ __device__ __forceinline__ int zcol(int col) { return col < 3584 ? col : (col < 3592 ? ZC_BA + (col - 3584) : col - 8); }
__device__ __forceinline__ bool prow_valid(int prow) { if (prow >= SROW0) return true; const int p = prow % LPP; return p >= PADF && p < PEND; }
__device__ __forceinline__ int prow2nat(int prow) { if (prow >= SROW0) return NP + (prow - SROW0); return (prow / LPP) * LP + (prow % LPP) - PADF; }

constexpr int RING_OFF = 0, RING_BYTES = 147456;
constexpr int LDSCTL_OFF = RING_BYTES, MISC_OFF = LDSCTL_OFF + 320;
constexpr int LDS_BYTES = RING_BYTES + 1024;
static_assert(MISC_OFF + 128 <= LDS_BYTES, "LDS map");

constexpr size_t CTL_BYTES = 1u << 20;
constexpr int CW_TMO = 0, CW_CODE = 1;
constexpr int CW_BAR = 4096;
constexpr int CW_QUEUE = 16384;
constexpr int CW_GDNFLAG = 32768;

__device__ __forceinline__ int lane_id() { return (int)__builtin_amdgcn_mbcnt_hi(~0u, __builtin_amdgcn_mbcnt_lo(~0u, 0u)); }
#define XB_TMO      128
#define XB_XCNT(j)  (256  + 64 * (j))
#define XB_XSUB(j)  (1280 + 64 * (j))
#define XB_XGEN(j)  (2304 + 64 * (j))
#define XB_TOP      3328
#define XB_TOPGEN   3392
#define XCD_BAR_WORDS 3456
#define XB_SPIN_CAP (1u << 18)

__device__ __forceinline__ unsigned xb_ld(unsigned* p)              { return __hip_atomic_load(p, __ATOMIC_RELAXED, __HIP_MEMORY_SCOPE_AGENT); }
__device__ __forceinline__ unsigned xb_add(unsigned* p, unsigned v) { return __hip_atomic_fetch_add(p, v, __ATOMIC_RELAXED, __HIP_MEMORY_SCOPE_AGENT); }
__device__ __forceinline__ unsigned xb_xcc_id() { return (unsigned)__builtin_amdgcn_s_getreg((3 << 11) | 20) & 0xFu; }
#define XB_SPIN(cond, bar) do { unsigned _sp = 0; while (cond) { __builtin_amdgcn_s_sleep(1); \
    if ((++_sp & 255u) == 0u) { if (xb_ld(&(bar)[XB_TMO])) break; if (_sp > XB_SPIN_CAP) { atomicAdd(&(bar)[XB_TMO], 1u); break; } } } } while (0)

struct XcdBarrier {
    unsigned* bar; unsigned x; int wv;
    volatile LAS unsigned* st;
};

__device__ __forceinline__ XcdBarrier xcd_barrier_post(unsigned* bar, volatile LAS unsigned* st, int wv) {
    XcdBarrier b; b.bar = bar; b.x = xb_xcc_id(); b.st = st; b.wv = wv;
    if (wv == 0 && lane_id() == 0) (void)xb_add(&bar[XB_XCNT(b.x)], 1u);
    return b;
}
__device__ __forceinline__ void xcd_barrier_complete(unsigned* bar, unsigned x, unsigned& nloc, unsigned& nx) {
    const unsigned G = gridDim.x * gridDim.y * gridDim.z;
    unsigned sum, cnt, mine, sp = 0u;
    for (;;) {
        sum = 0u; cnt = 0u; mine = 0u;
#pragma unroll
        for (unsigned j = 0; j < 16; ++j) { const unsigned c = xb_ld(&bar[XB_XCNT(j)]); sum += c; cnt += (c > 0u) ? 1u : 0u; mine = (j == x) ? c : mine; }
        if (sum == G) break;
        __builtin_amdgcn_s_sleep(1);
        if ((++sp & 255u) == 0u) { if (xb_ld(&bar[XB_TMO])) break; if (sp > XB_SPIN_CAP) { atomicAdd(&bar[XB_TMO], 1u); break; } }
    }
    nloc = mine > 0u ? mine : 1u; nx = cnt > 0u ? cnt : 1u;
}

__device__ __forceinline__ void xcd_barrier(const XcdBarrier& b) {
    asm volatile("s_waitcnt vmcnt(0)" ::: "memory");
    __syncthreads();
    if (b.wv == 0 && lane_id() == 0) {
        unsigned* bar = b.bar;
        __builtin_amdgcn_s_waitcnt(0);
        unsigned nloc = b.st[0], nx = b.st[1];
        if (nloc == 0u) { xcd_barrier_complete(bar, b.x, nloc, nx); b.st[0] = nloc; b.st[1] = nx; }
        const unsigned old = xb_add(&bar[XB_XSUB(b.x)], 1u);
        const unsigned gen = old / nloc;
        if (old + 1u == (gen + 1u) * nloc) {
            __builtin_amdgcn_fence(__ATOMIC_RELEASE, "agent");
            asm volatile("s_waitcnt vmcnt(0)" ::: "memory");
            const unsigned og = xb_add(&bar[XB_TOP], 1u);
            const unsigned tg = og / nx;
            if (og + 1u == (tg + 1u) * nx) xb_add(&bar[XB_TOPGEN], 1u);
            else XB_SPIN(xb_ld(&bar[XB_TOPGEN]) == tg, bar);
            __builtin_amdgcn_fence(__ATOMIC_ACQUIRE, "agent");
            xb_add(&bar[XB_XGEN(b.x)], 1u);
            asm volatile("s_waitcnt vmcnt(0)" ::: "memory");
        } else {
            XB_SPIN(xb_ld(&bar[XB_XGEN(b.x)]) == gen, bar);
            __builtin_amdgcn_fence(__ATOMIC_ACQUIRE, "agent");
            asm volatile("s_waitcnt vmcnt(0)" ::: "memory");
        }
    }
    __syncthreads();
}


template <int CTRL> __device__ __forceinline__ float dpp_f(float v) { return __builtin_bit_cast(float, __builtin_amdgcn_update_dpp(0, __builtin_bit_cast(int, v), CTRL, 0xf, 0xf, true)); }
template <int CTRL> __device__ __forceinline__ int dpp_i(int v) { return __builtin_amdgcn_update_dpp(0, v, CTRL, 0xf, 0xf, true); }
template <int CTRL, int ROWMASK> __device__ __forceinline__ float dpp_fm(float v) { return __builtin_bit_cast(float, __builtin_amdgcn_update_dpp(0, __builtin_bit_cast(int, v), CTRL, ROWMASK, 0xf, false)); }
__device__ __forceinline__ float rdlane(float v, int i) { return __builtin_bit_cast(float, __builtin_amdgcn_readlane(__builtin_bit_cast(int, v), i)); }
__device__ __forceinline__ float sum8(float v) { v += dpp_f<0xB1>(v); v += dpp_f<0x4E>(v); v += dpp_f<0x141>(v); return v; }
__device__ __forceinline__ float sum16(float v) { v = sum8(v); v += dpp_f<0x140>(v); return v; }
__device__ __forceinline__ float wave_sum(float v) { v = sum16(v); return rdlane(v, 0) + rdlane(v, 16) + rdlane(v, 32) + rdlane(v, 48); }
__device__ __forceinline__ float wave_max(float v) {
    v = fmaxf(v, dpp_f<0xB1>(v)); v = fmaxf(v, dpp_f<0x4E>(v)); v = fmaxf(v, dpp_f<0x141>(v)); v = fmaxf(v, dpp_f<0x140>(v));
    return fmaxf(fmaxf(rdlane(v, 0), rdlane(v, 16)), fmaxf(rdlane(v, 32), rdlane(v, 48)));
}
__device__ __forceinline__ float scan64(float v) {
    v += dpp_f<0x111>(v); v += dpp_f<0x112>(v); v += dpp_f<0x114>(v); v += dpp_f<0x118>(v);
    v += dpp_fm<0x142, 0xA>(v); v += dpp_fm<0x143, 0xC>(v);
    return v;
}
__device__ __forceinline__ float swap32(float v) {
    const auto r = __builtin_amdgcn_permlane32_swap(__builtin_bit_cast(unsigned, v), __builtin_bit_cast(unsigned, v), false, false);
    return __builtin_bit_cast(float, (lane_id() & 32) ? r[0] : r[1]);
}
}
namespace mk {
enum Region { R_X, R_XN, R_WIN, R_Z, R_QN, R_KN, R_QKVB, R_BG, R_O, R_OA, R_OB, R_YC, R_OC, R_MRG, R_WGLU, R_WBR, R_WOUT, R_WQS, R_PU, R_PV, R_SC, R_GDN, R_S5T, R_MISC, R_S5E, R_S5X, R_MRGB, R_OBN, R_MRG2, R_NREG };
constexpr int NPL = 16;
enum Phase { PH_PRO = 0, PL_NORM1 = 0, PL_GEMM_IN = 1, PL_ZPOST = 2, PL_LOCAL = 3, PL_MIX = 4, PL_MIXPOST = 5, PL_GEMM_GLU = 6, PL_GEMM_BRA = 7, PL_GEMM_BRB = 8, PL_GEMM_BRC = 9,
             PL_GEMM_OUT = 10, PL_NORM2 = 11, PL_GEMM_PEER = 12, PL_PEER = 13, PH_FINAL = 1 + DEPTH * NPL, PH_END = PH_FINAL + 1 };
enum ProMask { PM_X = 1, PM_WIN = 2, PM_WREST = 4, PM_PEERW = 8, PM_WQS = 16, PM_TABLES = 32 };
struct Args {
    const float* in[40];
    float* out;
    unsigned char* ws;
    unsigned long long off[32];
    int ph_lo, ph_hi, pro_mask, bar_region;
};
static_assert(sizeof(Args) == 40 * 8 + 8 + 8 + 32 * 8 + 16, "Args has no padding");

typedef const __attribute__((address_space(4))) Args* KArgs;
__device__ __forceinline__ KArgs kargs() { KArgs p = (KArgs)__builtin_amdgcn_kernarg_segment_ptr(); asm volatile("" : "+s"(p)); return p; }
__device__ __forceinline__ void assume_global(const void* p) {
#if defined(__HIP_DEVICE_COMPILE__)
    __builtin_assume(!__builtin_amdgcn_is_shared(p) && !__builtin_amdgcn_is_private(p));
#endif
}
#define GIN(a, i) ((const float*)(const GAS float*)(a).in[i])
#define GOUT(a) ((float*)(GAS float*)(a).out)
#define WS_OPAQUE(a) GAS unsigned char* wsg_ = (GAS unsigned char*)(a).ws; asm volatile("" : "+s"(wsg_)); unsigned char* wsb = (unsigned char*)wsg_
#define otid() otid_(F.wv)
__device__ __forceinline__ int otid_(int wv) { unsigned m = ~0u; asm volatile("" : "+s"(m), "+s"(wv));
    return wv * 64 + (int)__builtin_amdgcn_mbcnt_hi(m, __builtin_amdgcn_mbcnt_lo(m, 0u)); }
struct Frame {
    LAS unsigned char* lds; volatile LAS unsigned* MISC; gu32* ctl;
    int vcu, G, wv;
};

template <class CM> __device__ __forceinline__ void transpose_item(const float* W, int ld, int K, bf16* WT, int n0, int k0, const CM& cm, LAS float* scr, int lane) {
    const int sc = cm(n0 + (lane & 31));
#pragma unroll 8
    for (int i = 0; i < 32; ++i) { const int kk = 2 * i + (lane >> 5); scr[kk * 33 + (lane & 31)] = sc >= 0 ? W[(size_t)(k0 + kk) * ld + sc] : 0.f; }
    LDS_WAIT(); asm volatile("" ::: "memory");
    const int c = lane & 7;
#pragma unroll
    for (int j = 0; j < 4; ++j) { const int n = (lane >> 3) + 8 * j; const LAS float* s = scr + (8 * c) * 33 + n;
        v4u o; o.x = pk2(s[0 * 33], s[1 * 33]); o.y = pk2(s[2 * 33], s[3 * 33]); o.z = pk2(s[4 * 33], s[5 * 33]); o.w = pk2(s[6 * 33], s[7 * 33]);
        *(GAS v4u*)(WT + (size_t)(n0 + n) * K + k0 + 8 * c) = o; }
    LDS_WAIT(); asm volatile("" ::: "memory");
}
struct CmWin { __device__ __forceinline__ int operator()(int n) const { return n < 3584 ? n : (n < 7168 ? n + 8 : (n < 7176 ? 3584 + (n - 7168) : -1)); } };
struct CmId { __device__ __forceinline__ int operator()(int n) const { return n; } };
struct CmGlu { __device__ __forceinline__ int operator()(int n) const { const int G = n >> 5, i = n & 31; return i < 16 ? 16 * G + i : 512 + 16 * G + (i - 16); } };

__device__ __forceinline__ void rms_row_to_bf16(const float* xrow, const float* g, bf16* orow, int lane) {
    const GAS f32x4* xr = (const GAS f32x4*)xrow + lane;
    f32x4 v[4]; float s2 = 0.f;
#pragma unroll
    for (int j = 0; j < 4; ++j) { v[j] = xr[64 * j]; s2 += (v[j].x * v[j].x + v[j].y * v[j].y) + (v[j].z * v[j].z + v[j].w * v[j].w); }
    const float r = __builtin_amdgcn_rsqf(wave_sum(s2) * (1.f / D_MODEL) + EPSF);
    const GAS f32x4* gr = (const GAS f32x4*)g + lane;
    GAS unsigned long long* o8 = (GAS unsigned long long*)orow + lane;
#pragma unroll
    for (int j = 0; j < 4; ++j) { const f32x4 gg = gr[64 * j];
        o8[64 * j] = (unsigned long long)pk2(v[j].x * r * gg.x, v[j].y * r * gg.y) | ((unsigned long long)pk2(v[j].z * r * gg.z, v[j].w * r * gg.w) << 32); }
}

__device__ __forceinline__ void p_norm(Frame& F, int l, int gi) {
    const KArgs ap = kargs(); const auto& a = *ap; WS_OPAQUE(a);
    const int tid = otid(), lane = tid & 63, wave = __builtin_amdgcn_readfirstlane(tid >> 6);
    const float* X = (const float*)(wsb + a.off[R_X]); bf16* XN = (bf16*)(wsb + a.off[R_XN]); const float* g = GIN(a, gi) + (size_t)l * D_MODEL;
    const int gw = F.vcu * NWAVES + wave, NGW = F.G * NWAVES;
    for (int m = gw; m < RP; m += NGW) rms_row_to_bf16(X + (size_t)m * D_MODEL, g, XN + (size_t)m * D_MODEL, lane);
}
__device__ __forceinline__ void unpack8(const v4u w, float (&f)[8]) { f[0] = bflo(w.x); f[1] = bfhi(w.x); f[2] = bflo(w.y); f[3] = bfhi(w.y); f[4] = bflo(w.z); f[5] = bfhi(w.z); f[6] = bflo(w.w); f[7] = bfhi(w.w); }
__device__ __forceinline__ v4u pack8(const float (&f)[8]) { v4u w; w.x = pk2(f[0], f[1]); w.y = pk2(f[2], f[3]); w.z = pk2(f[4], f[5]); w.w = pk2(f[6], f[7]); return w; }
__device__ __forceinline__ float sigm(float x) { return __builtin_amdgcn_rcpf(1.f + __expf(-x)); }
constexpr float ATT_C2 = 0.125f * 1.4426950408889634f;
__device__ __forceinline__ void p_zpost(Frame& F, int l) {
    const KArgs ap = kargs(); const auto& a = *ap; WS_OPAQUE(a);
    const bf16* Z = (const bf16*)(wsb + a.off[R_Z]);
    bf16* QN = (bf16*)(wsb + a.off[R_QN]); bf16* KN = (bf16*)(wsb + a.off[R_KN]); bf16* QKVB = (bf16*)(wsb + a.off[R_QKVB]); float* BG = (float*)(wsb + a.off[R_BG]);
    const int tid = otid(), lane = tid & 63, wave = __builtin_amdgcn_readfirstlane(tid >> 6);
    const int gw = F.vcu * NWAVES + wave, NGW = F.G * NWAVES;
    float gq[8], gk[8], cw[3][4][8];
#pragma unroll
    for (int j = 0; j < 8; ++j) { gq[j] = GIN(a, I_QN)[l * HEAD_DIM_A + 8 * (lane & 7) + j] * ATT_C2; gk[j] = GIN(a, I_KN)[l * HEAD_DIM_A + 8 * (lane & 7) + j]; }
#pragma unroll
    for (int w = 0; w < 3; ++w)
#pragma unroll
        for (int i = 0; i < 4; ++i)
#pragma unroll
            for (int j = 0; j < 8; ++j) cw[w][i][j] = GIN(a, I_CONVW)[((size_t)l * CONV_W + i) * 3 * WIDTH_B + w * WIDTH_B + 8 * lane + j];
    float alog = 0.f, dtb = 0.f; if (lane < 4) { alog = GIN(a, I_ALOG)[l * N_HEADS_B + lane]; dtb = GIN(a, I_DTB)[l * N_HEADS_B + lane]; }
    for (int m = gw; m < RP; m += NGW) {
        const bool valid = prow_valid(m); const int nat = valid ? prow2nat(m) : 0;
        const bf16* zr = Z + (size_t)m * ZN;
        float f[8], o[8];
        unpack8(*(const GAS v4u*)(zr + ZC_QA + 8 * lane), f);
        { float ss = 0.f;
#pragma unroll
          for (int j = 0; j < 8; ++j) ss += f[j] * f[j];
          ss = sum8(ss);
          const float r = __builtin_amdgcn_rsqf(ss * (1.f / HEAD_DIM_A) + EPSF);
#pragma unroll
          for (int j = 0; j < 8; ++j) o[j] = f[j] * r * gq[j];
          *(GAS v4u*)(QN + (size_t)m * WIDTH_A + 8 * lane) = pack8(o); }
        unpack8(*(const GAS v4u*)(zr + ZC_KA + 8 * lane), f);
        { float ss = 0.f;
#pragma unroll
          for (int j = 0; j < 8; ++j) ss += f[j] * f[j];
          ss = sum8(ss);
          const float r = __builtin_amdgcn_rsqf(ss * (1.f / HEAD_DIM_A) + EPSF);
#pragma unroll
          for (int j = 0; j < 8; ++j) o[j] = f[j] * r * gk[j];
          *(GAS v4u*)(KN + (size_t)m * WIDTH_A + 8 * lane) = pack8(o);
          if (valid) { float* ko = nat < NP ? GOUT(a) + O_KP + ((size_t)l * NP + nat) * WIDTH_A : GOUT(a) + O_KS + ((size_t)l * NS + (nat - NP)) * WIDTH_A;
              *(GAS f32x4*)(ko + 8 * lane) = (f32x4){o[0], o[1], o[2], o[3]}; *(GAS f32x4*)(ko + 8 * lane + 4) = (f32x4){o[4], o[5], o[6], o[7]}; } }
        if (valid) { unpack8(*(const GAS v4u*)(zr + ZC_VA + 8 * lane), f);
            float* vo = nat < NP ? GOUT(a) + O_VP + ((size_t)l * NP + nat) * WIDTH_A : GOUT(a) + O_VS + ((size_t)l * NS + (nat - NP)) * WIDTH_A;
            *(GAS f32x4*)(vo + 8 * lane) = (f32x4){f[0], f[1], f[2], f[3]}; *(GAS f32x4*)(vo + 8 * lane + 4) = (f32x4){f[4], f[5], f[6], f[7]}; }
        const int ts = m >= SROW0 ? (m - SROW0) % DEC_SEQ : 1000; const int bs = m >= SROW0 ? (m - SROW0) / DEC_SEQ : 0;
        int cj = -1;
        if (m >= SROW0) { if (ts >= DEC_SEQ - 3) cj = ts - (DEC_SEQ - 3); } else { const int p = m % LPP; if (p >= PEND - 3 && p < PEND) cj = p - (PEND - 3); }
#pragma unroll
        for (int w = 0; w < 3; ++w) {
            float acc[8];
#pragma unroll
            for (int j = 0; j < 8; ++j) acc[j] = 0.f;
#pragma unroll
            for (int i = 0; i < 4; ++i) {
                const int dt = i - 3;
                if (ts + dt < 0) {
                    const float* sc = GIN(a, I_SCONV) + (((size_t)l * DEC_BATCH + bs) * (CONV_W - 1) + (CONV_W - 1 + ts + dt)) * 3 * WIDTH_B + w * WIDTH_B + 8 * lane;
                    const f32x4 s0 = *(const GAS f32x4*)sc, s1 = *(const GAS f32x4*)(sc + 4);
                    f[0] = s0.x; f[1] = s0.y; f[2] = s0.z; f[3] = s0.w; f[4] = s1.x; f[5] = s1.y; f[6] = s1.z; f[7] = s1.w;
                } else if (m + dt >= 0) unpack8(*(const GAS v4u*)(Z + (size_t)(m + dt) * ZN + ZC_QKVB + w * WIDTH_B + 8 * lane), f);
                else {
#pragma unroll
                    for (int j = 0; j < 8; ++j) f[j] = 0.f; }
#pragma unroll
                for (int j = 0; j < 8; ++j) acc[j] += f[j] * cw[w][i][j];
                if (i == 3 && cj >= 0) {
                    float* co = m >= SROW0 ? GOUT(a) + O_CS + (((size_t)l * DEC_BATCH + bs) * (CONV_W - 1) + cj) * 3 * WIDTH_B : GOUT(a) + O_CP + (((size_t)l * BATCH + m / LPP) * (CONV_W - 1) + cj) * 3 * WIDTH_B;
                    *(GAS f32x4*)(co + w * WIDTH_B + 8 * lane) = (f32x4){f[0], f[1], f[2], f[3]}; *(GAS f32x4*)(co + w * WIDTH_B + 8 * lane + 4) = (f32x4){f[4], f[5], f[6], f[7]}; }
            }
            float ss = 0.f;
#pragma unroll
            for (int j = 0; j < 8; ++j) { acc[j] = acc[j] * sigm(acc[j]); ss += acc[j] * acc[j]; }
            float sc = 1.f;
            if (w < 2) { ss = sum16(ss);
                sc = __builtin_amdgcn_rsqf(ss + EPSF); if (w == 0) sc *= 0.08838834764831845f; }
#pragma unroll
            for (int j = 0; j < 8; ++j) o[j] = acc[j] * sc;
            *(GAS v4u*)(QKVB + (size_t)m * 3 * WIDTH_B + w * WIDTH_B + 8 * lane) = pack8(o);
        }
        if (lane < 4) { const float be = bf2f(zr[ZC_BA + lane]), al = bf2f(zr[ZC_BA + 4 + lane]) + dtb;
            const float sp = al > 20.f ? al : __logf(1.f + __expf(al));
            BG[(size_t)m * 8 + lane] = valid ? sigm(be) : 0.f; BG[(size_t)m * 8 + 4 + lane] = valid ? -__expf(alog) * sp : 0.f; }
    }
}
constexpr float LOG2E = 1.4426950408889634f;
__device__ __forceinline__ int t5_bucket_dev(int rel) {
    const int n = rel < 0 ? -rel : rel; int b;
    if (n < 8) b = n; else if (n < 12) b = 8; else if (n < 16) b = 9; else if (n < 23) b = 10; else if (n < 32) b = 11;
    else if (n < 46) b = 12; else if (n < 64) b = 13; else if (n < 91) b = 14; else b = 15;
    return b + (rel > 0 ? 16 : 0);
}
__device__ __forceinline__ void build_bias_table(LAS float* tab, const float* rel_bias, int h, int tid) {
    const float far = rel_bias[15 * N_HEADS_A + h];
    for (int i = tid; i < attn_body::BT_N; i += NTHR) tab[i] = (rel_bias[t5_bucket_dev(i - attn_body::BT_OFF) * N_HEADS_A + h] - far) * LOG2E;
}
__device__ __forceinline__ float lam_init_dev(int l) { return 0.8f - 0.6f * __expf(-0.3f * (float)l); }
__device__ __forceinline__ float lam_dev(const float* lqk_all, int l, int lane) {
    const float* q = lqk_all + (size_t)l * 4 * HEAD_DIM_A;
    const float s0 = wave_sum(q[lane] * q[HEAD_DIM_A + lane]), s1 = wave_sum(q[2 * HEAD_DIM_A + lane] * q[3 * HEAD_DIM_A + lane]);
    return __expf(s0) - __expf(s1) + lam_init_dev(l);
}
__device__ __forceinline__ int krow_dev(int s, int h, int j) { return 16 * s + 8 * (j >> 2) + 4 * h + (j & 3); }
__device__ __forceinline__ int crow_dev(int r, int h) { return (r & 3) + 8 * (r >> 2) + 4 * h; }
__device__ __forceinline__ bf16x8 pack_f8(const f32x4 a, const f32x4 b) { v4u w; w.x = pk2(a.x, a.y); w.y = pk2(a.z, a.w); w.z = pk2(b.x, b.y); w.w = pk2(b.z, b.w); return __builtin_bit_cast(bf16x8, w); }

__device__ __forceinline__ void sample_scores(f32x16& X, int kb, int c, const float* ck, const bf16* KN, int row0, int h, int hi, int r32, int qpos, const bf16x8 (&qf)[4], const LAS float* tab) {
    bf16x8 kf[4];
    if (kb < PAST_LEN / 32) { const float* kr = ck + (size_t)(kb * 32 + r32) * WIDTH_A + h * 128 + c * 64 + 8 * hi;
#pragma unroll
        for (int s = 0; s < 4; ++s) kf[s] = pack_f8(*(const GAS f32x4*)(kr + 16 * s), *(const GAS f32x4*)(kr + 16 * s + 4)); }
    else { const bf16* kr = KN + (size_t)(row0 + (kb * 32 - PAST_LEN) + r32) * WIDTH_A + h * 128 + c * 64 + 8 * hi;
#pragma unroll
        for (int s = 0; s < 4; ++s) kf[s] = *(const GAS bf16x8*)(kr + 16 * s); }
#pragma unroll
    for (int i = 0; i < 16; ++i) X[i] = 0.f;
#pragma unroll
    for (int s = 0; s < 4; ++s) X = __builtin_amdgcn_mfma_f32_32x32x16_bf16(kf[s], qf[s], X, 0, 0, 0);
#pragma unroll
    for (int i = 0; i < 16; ++i) { int idx = kb * 32 + crow_dev(i, hi) - qpos + attn_body::BT_OFF; idx = idx < 0 ? 0 : idx; X[i] += tab[idx]; }
}

__device__ __forceinline__ void attn_sample_unit(Frame& F, int l, int bs, int h) {
    const KArgs ap = kargs(); const auto& a = *ap; WS_OPAQUE(a);
    const int tid = otid(), lane = tid & 63, wid = __builtin_amdgcn_readfirstlane(tid >> 6), r32 = lane & 31, hi = lane >> 5;
    const bf16* QN = (const bf16*)(wsb + a.off[R_QN]); const bf16* KN = (const bf16*)(wsb + a.off[R_KN]); const bf16* Z = (const bf16*)(wsb + a.off[R_Z]); bf16* O = (bf16*)(wsb + a.off[R_O]);
    const float* ck = GIN(a, I_CK) + ((size_t)l * DEC_BATCH + bs) * PAST_LEN * WIDTH_A; const float* cv = GIN(a, I_CV) + ((size_t)l * DEC_BATCH + bs) * PAST_LEN * WIDTH_A;
    const int row0 = SROW0 + bs * DEC_SEQ;
    LAS float* tab = (LAS float*)(F.lds + RING_OFF + attn_body::LDS_BT);
    LAS float* st = (LAS float*)(F.lds + RING_OFF + 90112);
    LAS float* slot = (LAS float*)(F.lds + RING_OFF);
    const float lam = lam_dev(GIN(a, I_LQK), l, lane);
    build_bias_table(tab, GIN(a, I_REL), h, tid);
    bf16x8 qf[2][4];
#pragma unroll
    for (int c = 0; c < 2; ++c)
#pragma unroll
        for (int s = 0; s < 4; ++s) qf[c][s] = *(const GAS bf16x8*)(QN + (size_t)(row0 + r32) * WIDTH_A + h * 128 + c * 64 + 16 * s + 8 * hi);
    __syncthreads();
    float m[2] = {-1e30f, -1e30f}, lsum[2] = {0.f, 0.f};
    const int qpos = PAST_LEN + r32;
    for (int kb = wid; kb < (PAST_LEN + DEC_SEQ) / 32; kb += NWAVES) {
#pragma unroll
        for (int c = 0; c < 2; ++c) { f32x16 X; sample_scores(X, kb, c, ck, KN, row0, h, hi, r32, qpos, qf[c], tab);
            float mx = X[0];
#pragma unroll
            for (int i = 1; i < 16; ++i) mx = fmaxf(mx, X[i]);
            mx = fmaxf(mx, swap32(mx)); const float mn = fmaxf(m[c], mx);
            float sum = 0.f;
#pragma unroll
            for (int i = 0; i < 16; ++i) sum += exp2f(X[i] - mn);
            lsum[c] = lsum[c] * exp2f(m[c] - mn) + sum; m[c] = mn; }
    }
#pragma unroll
    for (int c = 0; c < 2; ++c) { lsum[c] += swap32(lsum[c]); if (hi == 0) { st[((wid * 2 + c) * 2 + 0) * 32 + r32] = m[c]; st[((wid * 2 + c) * 2 + 1) * 32 + r32] = lsum[c]; } }
    __syncthreads();
    float gm[2], ginv[2];
#pragma unroll
    for (int c = 0; c < 2; ++c) { float mm = -1e30f;
#pragma unroll
        for (int w = 0; w < NWAVES; ++w) mm = fmaxf(mm, st[((w * 2 + c) * 2 + 0) * 32 + r32]);
        float ll = 0.f;
#pragma unroll
        for (int w = 0; w < NWAVES; ++w) ll += st[((w * 2 + c) * 2 + 1) * 32 + r32] * exp2f(st[((w * 2 + c) * 2 + 0) * 32 + r32] - mm);
        gm[c] = mm; ginv[c] = (c == 0 ? 1.f : lam) / ll; }
    f32x16 acc[4];
#pragma unroll
    for (int eb = 0; eb < 4; ++eb)
#pragma unroll
        for (int i = 0; i < 16; ++i) acc[eb][i] = 0.f;
    for (int kb = wid; kb < (PAST_LEN + DEC_SEQ) / 32; kb += NWAVES) {
        f32x16 X0, X1; sample_scores(X0, kb, 0, ck, KN, row0, h, hi, r32, qpos, qf[0], tab); sample_scores(X1, kb, 1, ck, KN, row0, h, hi, r32, qpos, qf[1], tab);
        float wv[16];
#pragma unroll
        for (int i = 0; i < 16; ++i) wv[i] = exp2f(X0[i] - gm[0]) * ginv[0] - exp2f(X1[i] - gm[1]) * ginv[1];
        bf16x8 xs[2];
#pragma unroll
        for (int s = 0; s < 2; ++s) { v4u w; w.x = pk2(wv[8 * s], wv[8 * s + 1]); w.y = pk2(wv[8 * s + 2], wv[8 * s + 3]); w.z = pk2(wv[8 * s + 4], wv[8 * s + 5]); w.w = pk2(wv[8 * s + 6], wv[8 * s + 7]); xs[s] = __builtin_bit_cast(bf16x8, w); }
#pragma unroll
        for (int eb = 0; eb < 4; ++eb)
#pragma unroll
            for (int s = 0; s < 2; ++s) {
                float vv[8];
                if (kb < PAST_LEN / 32) { const GAS float* vb = (const GAS float*)(cv + (size_t)(kb * 32 + 4 * hi) * WIDTH_A + h * 128 + eb * 32 + r32); asm volatile("" : "+v"(vb));
#pragma unroll
                    for (int j = 0; j < 8; ++j) vv[j] = vb[(size_t)(16 * s + 8 * (j >> 2) + (j & 3)) * WIDTH_A]; }
                else { const GAS bf16* vb = (const GAS bf16*)(Z + (size_t)(row0 + kb * 32 - PAST_LEN + 4 * hi) * ZN + ZC_VA + h * 128 + eb * 32 + r32); asm volatile("" : "+v"(vb));
#pragma unroll
                    for (int j = 0; j < 8; ++j) vv[j] = bf2f(vb[(size_t)(16 * s + 8 * (j >> 2) + (j & 3)) * ZN]); }
                v4u w; w.x = pk2(vv[0], vv[1]); w.y = pk2(vv[2], vv[3]); w.z = pk2(vv[4], vv[5]); w.w = pk2(vv[6], vv[7]);
                acc[eb] = __builtin_amdgcn_mfma_f32_32x32x16_bf16(xs[s], __builtin_bit_cast(bf16x8, w), acc[eb], 0, 0, 0);
            }
    }
    __syncthreads();
#pragma unroll
    for (int eb = 0; eb < 4; ++eb)
#pragma unroll
        for (int i = 0; i < 16; ++i) slot[(wid * 32 + crow_dev(i, hi)) * 128 + eb * 32 + r32] = acc[eb][i];
    __syncthreads();
    { const int q = tid >> 4, e0 = (tid & 15) * 8; float o[8];
#pragma unroll
      for (int j = 0; j < 8; ++j) o[j] = 0.f;
#pragma unroll
      for (int w = 0; w < NWAVES; ++w)
#pragma unroll
          for (int j = 0; j < 8; ++j) o[j] += slot[(w * 32 + q) * 128 + e0 + j];
      v4u pw; pw.x = pk2(o[0], o[1]); pw.y = pk2(o[2], o[3]); pw.z = pk2(o[4], o[5]); pw.w = pk2(o[6], o[7]);
      bf16* orow = O + (size_t)(row0 + q) * attn_body::OP + h * 256;
      unsigned zq = 0u; asm volatile("" : "+v"(zq));
      *(GAS v4u*)(orow + e0) = pw; *(GAS v4u*)(orow + 128 + e0) = (v4u){zq, zq, zq, zq}; }
    __syncthreads();
}

constexpr int ATT_NQB = LPP / 256;
constexpr int ATT_NPU = BATCH * 16 * ATT_NQB;
constexpr int ATT_NSU = DEC_BATCH * N_HEADS_A;
__device__ __forceinline__ void p_attention(Frame& F, int lq, unsigned char* ldsg) {
    const int l = lq % DEPTH;
    for (;;) {
        const KArgs ap = kargs(); const auto& a = *ap; WS_OPAQUE(a);
        const int tid = otid();
        gu32* head = (gu32*)wsb + CW_QUEUE + 64 * lq;
        const attn_body::bf16* QN = (const attn_body::bf16*)(wsb + a.off[R_QN]); const attn_body::bf16* KN = (const attn_body::bf16*)(wsb + a.off[R_KN]);
        const attn_body::bf16* Z = (const attn_body::bf16*)(wsb + a.off[R_Z]); attn_body::bf16* O = (attn_body::bf16*)(wsb + a.off[R_O]);
        if (tid == 0) F.MISC[16] = __hip_atomic_fetch_add(head, 1u, RLX_AGENT);
        __syncthreads();
        const int u = (int)F.MISC[16];
        __syncthreads();
        if (u >= ATT_NPU + ATT_NSU) break;
        if (u < ATT_NPU) {
            const int qb = (ATT_NQB - 1) - u / 32, bvh = u % 32, b = bvh >> 4, vh = bvh & 15, h = vh >> 2, c = (vh >> 1) & 1, half = vh & 1;
            build_bias_table((LAS float*)(F.lds + RING_OFF + attn_body::LDS_BT), GIN(a, I_REL), h, tid);
            __syncthreads();
            attn_body::attn_unit<8>(b, h * 128 + c * 64, ZC_VA + h * 128 + half * 64, h * 256 + c * 128 + half * 64, qb, QN, KN, Z, O, (char*)ldsg + RING_OFF, F.wv);
        } else { const int su = u - ATT_NPU; attn_sample_unit(F, l, su >> 2, su & 3); }
    }
}
__device__ __forceinline__ void p_mixpost_a(Frame& F, int l) {
    const KArgs ap = kargs(); const auto& a = *ap; WS_OPAQUE(a);
    const int tid = otid(), lane = tid & 63, wave = __builtin_amdgcn_readfirstlane(tid >> 6);
    const bf16* O = (const bf16*)(wsb + a.off[R_O]); bf16* OA = (bf16*)(wsb + a.off[R_OA]);
    const int gw = F.vcu * NWAVES + wave, NGW = F.G * NWAVES;
    const float lam = lam_dev(GIN(a, I_LQK), l, lane), post = 1.f - lam_init_dev(l);
    const int h = lane >> 4, e0 = 8 * (lane & 15);
    float sg[8];
#pragma unroll
    for (int j = 0; j < 8; ++j) sg[j] = GIN(a, I_SUBLN)[l * 2 * HEAD_DIM_A + e0 + j] * post;
    for (int m = gw; m < RP; m += NGW) {
        float o0[8], o1[8], d[8];
        unpack8(*(const GAS v4u*)(O + (size_t)m * 1024 + h * 256 + e0), o0); unpack8(*(const GAS v4u*)(O + (size_t)m * 1024 + h * 256 + 128 + e0), o1);
        float ss = 0.f;
#pragma unroll
        for (int j = 0; j < 8; ++j) { d[j] = o0[j] - lam * o1[j]; ss += d[j] * d[j]; }
        ss = sum16(ss);
        const float r = __builtin_amdgcn_rsqf(ss * (1.f / 128.f) + EPSF);
#pragma unroll
        for (int j = 0; j < 8; ++j) d[j] = d[j] * r * sg[j];
        *(GAS v4u*)(OA + (size_t)m * WIDTH_A + h * 128 + e0) = pack8(d);
    }
}
constexpr int GDN_NCH = PEND / 64;
constexpr int GDN_NPI = BATCH * N_HEADS_B * GDN_NCH;
constexpr int GDN_NSI = DEC_BATCH * N_HEADS_B;
constexpr int GDN_NI = GDN_NPI + GDN_NSI;
constexpr int GI_W = 0, GI_QG = 16384, GI_KG = 32768, GI_AT = 49152, GI_U = 57344, GI_SC = 73728, GI_STRIDE = 73984, GI_EG = 2048  ;
static_assert(GDN_NI % 4 == 0 && PEND % 64 == 0, "gdn items");
__device__ __forceinline__ int frag_off(int row, int kk, int nkb) {
    const int fid = ((row >> 5) * nkb + (kk >> 5)) * 2 + ((kk & 31) >> 4), ln = (row & 31) + 32 * (((kk & 15) >> 2) & 1), j = ((kk & 15) >> 3) * 4 + (kk & 3);
    return (fid * 64 + ln) * 8 + j;
}
__device__ __forceinline__ int gdn_item_row(int item, int j) {
    if (item < GDN_NPI) { const int sh = item / GDN_NCH, n = item % GDN_NCH; return (sh / N_HEADS_B) * LPP + 64 * n + j; }
    const int s = item - GDN_NPI; return j < 32 ? -1 : SROW0 + (s >> 2) * DEC_SEQ + (j - 32);
}
__device__ __forceinline__ int gdn_item_head(int item) { return item < GDN_NPI ? (item / GDN_NCH) % N_HEADS_B : (item - GDN_NPI) & 3; }

__device__ __forceinline__ void gdn_flush(const LAS unsigned char* stg, unsigned char* dst, int nbytes, int gt) {
    for (int o = gt * 16; o < nbytes; o += 2048) *(GAS v4u*)(dst + o) = *(const LAS v4u*)(stg + o);
}
typedef float f32x2s __attribute__((ext_vector_type(2)));
#define GDN_RL8(a, arow, jb) asm volatile("v_readlane_b32 %0, %8, %9\n\tv_readlane_b32 %1, %8, %10\n\tv_readlane_b32 %2, %8, %11\n\tv_readlane_b32 %3, %8, %12\n\tv_readlane_b32 %4, %8, %13\n\tv_readlane_b32 %5, %8, %14\n\tv_readlane_b32 %6, %8, %15\n\tv_readlane_b32 %7, %8, %16" \
    : "=s"(a[0]), "=s"(a[1]), "=s"(a[2]), "=s"(a[3]), "=s"(a[4]), "=s"(a[5]), "=s"(a[6]), "=s"(a[7]) : "v"(arow), "i"(jb), "i"((jb) + 1), "i"((jb) + 2), "i"((jb) + 3), "i"((jb) + 4), "i"((jb) + 5), "i"((jb) + 6), "i"((jb) + 7))
template <int I, int JB> __device__ __forceinline__ void gdn_subst_blk(f32x2s (&x)[64], float arow) {
    if constexpr (JB < I) { float ar[8]; GDN_RL8(ar, arow, JB);
#pragma unroll
        for (int t = 0; t < 8; ++t) if (JB + t < I) x[I] -= ar[t] * x[JB + t];
        gdn_subst_blk<I, JB + 8>(x, arow); }
}
template <int... Is> __device__ __forceinline__ void gdn_subst_all(f32x2s (&x)[64], const LAS float* A, int lane, std::integer_sequence<int, Is...>) {
    (gdn_subst_blk<Is + 1, 0>(x, A[(Is + 1) * 64 + lane]), ...);
}
template <int MODE> __device__ __forceinline__ void p_gdn_chunk(Frame& F, int l, int q) {
    const KArgs ap = kargs(); const auto& a = *ap; WS_OPAQUE(a);
    const int tid = otid(), wave = __builtin_amdgcn_readfirstlane(tid >> 6), grp = wave >> 1, gw = wave & 1;
    const bf16* QKVB = (const bf16*)(wsb + a.off[R_QKVB]); const float* BG = (const float*)(wsb + a.off[R_BG]); unsigned char* GD = wsb + a.off[R_GDN];
    LAS float* A_lds = (LAS float*)(F.lds + RING_OFF + grp * 34816);
    LAS float* Gs = A_lds + 4096; LAS float* Bs = Gs + 64; LAS float* Es = Bs + 64;
    LAS unsigned char* stg = (LAS unsigned char*)(A_lds + 4096 + 256);
    LAS bf16* stgh = (LAS bf16*)stg;
    static_assert(4 * 34816 <= RING_BYTES && GDN_NI % 4 == 0, "gdn chunk LDS / items");
    for (int pr = MODE == 0 ? F.vcu : q; MODE == 0 ? pr < (GDN_NPI - BATCH * N_HEADS_B) / 4 : pr == q; pr += (MODE == 0 ? F.G : 1 << 20)) {
        int lane_ = otid() & 63;
        const int lane = lane_, r32 = lane & 31, hi = lane >> 5, gt = gw * 64 + lane;
        int item;
        if (MODE == 0) { const int j = 4 * pr + grp; item = (j >> 7) * GDN_NCH + (j & 127); }
        else item = q < 16 ? GDN_NPI + 4 * q + grp : (4 * (q - 16) + grp) * GDN_NCH + (GDN_NCH - 1);
        const int h = gdn_item_head(item);
        unsigned char* ib = GD + (size_t)item * GI_STRIDE;
        const int rowt = gdn_item_row(item, lane);
        const float beta = rowt >= 0 ? BG[(size_t)rowt * 8 + h] : 0.f; float G = rowt >= 0 ? BG[(size_t)rowt * 8 + 4 + h] : 0.f;
        G = scan64(G);
        const float Glast = rdlane(G, 63), eG = __expf(G);
        if (gw == 0) { Gs[lane] = G; Bs[lane] = beta; Es[lane] = eG; }
        __syncthreads();
#pragma unroll
        for (int bq = 0; bq < 2; ++bq) {
          const int i0 = 32 * gw, j0 = 32 * bq; const int j = j0 + r32;
          if (gw == 0 && bq == 1) {
#pragma unroll
              for (int r = 0; r < 16; ++r) { const int i = crow_dev(r, hi); A_lds[i * 64 + j] = 0.f; stgh[frag_off(i, j, 2)] = (bf16)0; }
              LDS_WAIT(); if (lane == 0) *(LAS float*)(stg + GI_EG) = __expf(Glast);
          } else {
          const int ra = gdn_item_row(item, i0 + r32), rb = gdn_item_row(item, j0 + r32);
          f32x16 akk, aqk;
#pragma unroll
          for (int r = 0; r < 16; ++r) { akk[r] = 0.f; aqk[r] = 0.f; }
          const bf16x8 zf = {0, 0, 0, 0, 0, 0, 0, 0};
#pragma unroll
          for (int s = 0; s < 8; ++s) {
              const bf16x8 qa = ra >= 0 ? *(const GAS bf16x8*)(QKVB + (size_t)ra * 1536 + h * 128 + 16 * s + 8 * hi) : zf;
              const bf16x8 ka = ra >= 0 ? *(const GAS bf16x8*)(QKVB + (size_t)ra * 1536 + 512 + h * 128 + 16 * s + 8 * hi) : zf;
              const bf16x8 kb = rb >= 0 ? *(const GAS bf16x8*)(QKVB + (size_t)rb * 1536 + 512 + h * 128 + 16 * s + 8 * hi) : zf;
              akk = __builtin_amdgcn_mfma_f32_32x32x16_bf16(ka, kb, akk, 0, 0, 0); aqk = __builtin_amdgcn_mfma_f32_32x32x16_bf16(qa, kb, aqk, 0, 0, 0);
          }
          const float Gj = Gs[j];
#pragma unroll
          for (int r = 0; r < 16; ++r) { const int i = i0 + crow_dev(r, hi); const float dec = i >= j ? __expf(Gs[i] - Gj) : 0.f;
              A_lds[i * 64 + j] = i > j ? Bs[i] * akk[r] * dec : 0.f;
              stgh[frag_off(i, j, 2)] = (bf16)f2bf(aqk[r] * dec); }
          }
        }
        __syncthreads();
        gdn_flush(stg, ib + GI_AT, 8192, gt);
        { f32x2s x[64]; const int cbase = gw == 0 ? 1024 + h * 128 : 512 + h * 128;
#pragma unroll
          for (int i = 0; i < 64; ++i) { const int ri = __builtin_amdgcn_readfirstlane(gdn_item_row(item, i));
              const bf16* rowp = QKVB + (size_t)(ri < 0 ? 0 : ri) * 1536 + cbase;
              x[i] = ri >= 0 ? (f32x2s){bf2f(rowp[lane]), bf2f(rowp[lane + 64])} : (f32x2s){0.f, 0.f}; }
          const float rsc = gw == 0 ? beta : beta * eG;
#pragma unroll
          for (int i = 0; i < 64; ++i) x[i] *= rdlane(rsc, i);
          gdn_subst_all(x, A_lds, lane, std::make_integer_sequence<int, 63>{});
          __syncthreads();
          if (gw == 0) { GAS bf16* ub = (GAS bf16*)(ib + GI_U) + lane; asm volatile("" : "+v"(ub));
#pragma unroll
              for (int i = 0; i < 64; ++i) { ub[i * 128] = (bf16)f2bf(x[i].x); ub[i * 128 + 64] = (bf16)f2bf(x[i].y); } }
          else { LAS bf16* wb0 = stgh + frag_off(0, lane, 4); LAS bf16* wb1 = stgh + frag_off(0, lane + 64, 4);
#pragma unroll
              for (int i = 0; i < 64; ++i) { wb0[(i >> 5) * 4096 + (i & 31) * 8] = (bf16)f2bf(x[i].x); wb1[(i >> 5) * 4096 + (i & 31) * 8] = (bf16)f2bf(x[i].y); } }
        }
        __syncthreads();
        gdn_flush(stg, ib + GI_W, 16384, gt);
        __syncthreads();
        const float kgs = __expf(Glast - G);
#pragma unroll
        for (int hf = 0; hf < 2; ++hf) { float qv[32];
#pragma unroll
          for (int it = 0; it < 32; ++it) { const int c = it + 32 * hf, rc = __builtin_amdgcn_readfirstlane(gdn_item_row(item, c)); const bf16* rowp = QKVB + (size_t)(rc < 0 ? 0 : rc) * 1536 + h * 128; qv[it] = rc >= 0 ? bf2f(rowp[gt]) : 0.f; }
#pragma unroll
          for (int it = 0; it < 32; ++it) { const int c = it + 32 * hf; stgh[frag_off(c, gt, 4)] = (bf16)f2bf(qv[it] * rdlane(eG, c)); } }
        __syncthreads();
        gdn_flush(stg, ib + GI_QG, 16384, gt);
        __syncthreads();
#pragma unroll
        for (int hf = 0; hf < 2; ++hf) { float kv[32];
#pragma unroll
          for (int it = 0; it < 32; ++it) { const int c = it + 32 * hf, rc = __builtin_amdgcn_readfirstlane(gdn_item_row(item, c)); const bf16* rowp = QKVB + (size_t)(rc < 0 ? 0 : rc) * 1536 + 512 + h * 128; kv[it] = rc >= 0 ? bf2f(rowp[gt]) : 0.f; }
#pragma unroll
          for (int it = 0; it < 32; ++it) { const int c = it + 32 * hf; stgh[frag_off(gt, c, 2)] = (bf16)f2bf(kv[it] * rdlane(kgs, c)); } }
        __syncthreads();
        gdn_flush(stg, ib + GI_KG, 16384, gt);
        VM_WAIT(); __syncthreads();
        if (MODE == 1 && q >= 16) {
            if (wave == 0 && (otid() & 63) == 0) { __builtin_amdgcn_fence(__ATOMIC_RELEASE, "agent"); asm volatile("s_waitcnt vmcnt(0)" ::: "memory");
                gu32* fl = (gu32*)wsb + CW_GDNFLAG;
#pragma unroll
                for (int c = 0; c < 4; ++c) __hip_atomic_store(fl + 64 * (4 * (q - 16) + c), (unsigned)(l + 1), RLX_AGENT); } }
    }
}

__device__ __forceinline__ void gdn_chain(const unsigned char* GD, bf16* OB, const float* sdelta, float* dout, int item0, int nch, int h, int vb, int lane) {
    const int r32 = lane & 31, hi = lane >> 5;
    f32x16 S[4];
#pragma unroll
    for (int kb = 0; kb < 4; ++kb)
#pragma unroll
        for (int r = 0; r < 16; ++r) S[kb][r] = sdelta ? sdelta[(size_t)(kb * 32 + crow_dev(r, hi)) * HEAD_DIM_B + vb * 32 + r32] : 0.f;
    for (int n = 0; n < nch; ++n) {
        const int item = item0 + n; const unsigned char* ib = GD + (size_t)item * GI_STRIDE;
        const float eGl = *(const float*)(ib + GI_AT + GI_EG);
        const GAS bf16x8* WF = (const GAS bf16x8*)(ib + GI_W) + lane; const GAS bf16x8* QF = (const GAS bf16x8*)(ib + GI_QG) + lane;
        const GAS bf16x8* KF = (const GAS bf16x8*)(ib + GI_KG) + lane; const GAS bf16x8* AF = (const GAS bf16x8*)(ib + GI_AT) + lane; const bf16* U = (const bf16*)(ib + GI_U);
        bf16x8 Sp[4][2];
#pragma unroll
        for (int kb = 0; kb < 4; ++kb)
#pragma unroll
            for (int s = 0; s < 2; ++s) { v4u w; w.x = pk2(S[kb][8 * s], S[kb][8 * s + 1]); w.y = pk2(S[kb][8 * s + 2], S[kb][8 * s + 3]); w.z = pk2(S[kb][8 * s + 4], S[kb][8 * s + 5]); w.w = pk2(S[kb][8 * s + 6], S[kb][8 * s + 7]); Sp[kb][s] = __builtin_bit_cast(bf16x8, w); }
        f32x16 vn[2], ot[2];
#pragma unroll
        for (int cb = 0; cb < 2; ++cb) {
            f32x16 ws;
#pragma unroll
            for (int r = 0; r < 16; ++r) { ws[r] = 0.f; ot[cb][r] = 0.f; }
#pragma unroll
            for (int kb = 0; kb < 4; ++kb)
#pragma unroll
                for (int s = 0; s < 2; ++s) { ws = __builtin_amdgcn_mfma_f32_32x32x16_bf16(WF[((cb * 4 + kb) * 2 + s) * 64], Sp[kb][s], ws, 0, 0, 0);
                    ot[cb] = __builtin_amdgcn_mfma_f32_32x32x16_bf16(QF[((cb * 4 + kb) * 2 + s) * 64], Sp[kb][s], ot[cb], 0, 0, 0); }
#pragma unroll
            for (int r = 0; r < 16; ++r) vn[cb][r] = bf2f(U[(cb * 32 + crow_dev(r, hi)) * 128 + vb * 32 + r32]) - ws[r];
        }
        bf16x8 Vp[2][2];
#pragma unroll
        for (int cb = 0; cb < 2; ++cb)
#pragma unroll
            for (int s = 0; s < 2; ++s) { v4u w; w.x = pk2(vn[cb][8 * s], vn[cb][8 * s + 1]); w.y = pk2(vn[cb][8 * s + 2], vn[cb][8 * s + 3]); w.z = pk2(vn[cb][8 * s + 4], vn[cb][8 * s + 5]); w.w = pk2(vn[cb][8 * s + 6], vn[cb][8 * s + 7]); Vp[cb][s] = __builtin_bit_cast(bf16x8, w); }
#pragma unroll
        for (int cb = 0; cb < 2; ++cb)
#pragma unroll
            for (int c2 = 0; c2 <= cb; ++c2)
#pragma unroll
                for (int s = 0; s < 2; ++s) ot[cb] = __builtin_amdgcn_mfma_f32_32x32x16_bf16(AF[((cb * 2 + c2) * 2 + s) * 64], Vp[c2][s], ot[cb], 0, 0, 0);
#pragma unroll
        for (int cb = 0; cb < 2; ++cb)
#pragma unroll
            for (int r = 0; r < 16; ++r) { const int row = gdn_item_row(item, cb * 32 + crow_dev(r, hi)); if (row >= 0) OB[(size_t)row * WIDTH_B + h * 128 + vb * 32 + r32] = (bf16)f2bf(ot[cb][r]); }
#pragma unroll
        for (int kb = 0; kb < 4; ++kb) {
#pragma unroll
            for (int r = 0; r < 16; ++r) S[kb][r] *= eGl;
#pragma unroll
            for (int cb = 0; cb < 2; ++cb)
#pragma unroll
                for (int s = 0; s < 2; ++s) S[kb] = __builtin_amdgcn_mfma_f32_32x32x16_bf16(KF[((kb * 2 + cb) * 2 + s) * 64], Vp[cb][s], S[kb], 0, 0, 0);
        }
    }
#pragma unroll
    for (int kb = 0; kb < 4; ++kb)
#pragma unroll
        for (int r = 0; r < 16; ++r) dout[(size_t)(kb * 32 + crow_dev(r, hi)) * HEAD_DIM_B + vb * 32 + r32] = S[kb][r];
}
constexpr int GCH_BUF = 73728, GCH_PCS = 18;
#define GCH_BAR() do { asm volatile("s_waitcnt lgkmcnt(0)" ::: "memory"); __builtin_amdgcn_s_barrier(); asm volatile("" ::: "memory"); } while (0)
__device__ __forceinline__ void gdn_chain_wg(Frame& F, const unsigned char* GD, bf16* OB, float* dout, int item0, int h, gu32* flag, unsigned epoch) {
    const int tid = otid(), lane = tid & 63, wave = __builtin_amdgcn_readfirstlane(tid >> 6), r32 = lane & 31, hi = lane >> 5, vb = wave & 3;
    LAS unsigned char* lb = F.lds + RING_OFF;
    if (wave >= 4) {
        const int p0 = (wave - 4) * GCH_PCS;
        v4u R0[GCH_PCS], R1[GCH_PCS];
#define GCH_LOAD(R, c) do { if ((c) == GDN_NCH - 1) { unsigned sp_ = 0; while (__hip_atomic_load(flag, RLX_AGENT) != epoch) { __builtin_amdgcn_s_sleep(2); if (++sp_ > (1u << 22)) break; } \
            __builtin_amdgcn_fence(__ATOMIC_ACQUIRE, "agent"); asm volatile("s_waitcnt vmcnt(0)" ::: "memory"); }     \
            const unsigned char* s_ = GD + (size_t)(item0 + (c)) * GI_STRIDE + (size_t)p0 * 1024 + lane * 16; _Pragma("unroll") for (int j = 0; j < GCH_PCS; ++j) \
            asm volatile("global_load_dwordx4 %0, %1, off" : "=&v"(R[j]) : "v"(s_ + j * 1024) : "memory"); } while (0)
#define GCH_PUT(R, c) do { if ((c) + 1 < GDN_NCH) asm volatile("s_waitcnt vmcnt(18)" ::: "memory"); else asm volatile("s_waitcnt vmcnt(0)" ::: "memory"); \
            LAS v4u* d_ = (LAS v4u*)(lb + ((c) & 1) * GCH_BUF + p0 * 1024) + lane; _Pragma("unroll") for (int j = 0; j < GCH_PCS; ++j) d_[j * 64] = R[j]; } while (0)
        GCH_LOAD(R0, 0); GCH_LOAD(R1, 1);
        GCH_PUT(R0, 0); GCH_LOAD(R0, 2);
        GCH_BAR();
        for (int n = 0; n < GDN_NCH; n += 2) {
            if (n + 1 < GDN_NCH) GCH_PUT(R1, n + 1);
            if (n + 3 < GDN_NCH) GCH_LOAD(R1, n + 3);
            GCH_BAR();
            if (n + 1 < GDN_NCH) {
                if (n + 2 < GDN_NCH) GCH_PUT(R0, n + 2);
                if (n + 4 < GDN_NCH) GCH_LOAD(R0, n + 4);
                GCH_BAR(); }
        }
        asm volatile("s_waitcnt vmcnt(0)" ::: "memory");
#undef GCH_LOAD
#undef GCH_PUT
        return;
    }
    f32x16 S[4];
#pragma unroll
    for (int kb = 0; kb < 4; ++kb)
#pragma unroll
        for (int r = 0; r < 16; ++r) S[kb][r] = 0.f;
    GCH_BAR();
    for (int n = 0; n < GDN_NCH; ++n) {
        const int item = item0 + n; const LAS unsigned char* bufc = lb + (n & 1) * GCH_BUF;
        const float egl = *(const LAS float*)(bufc + GI_AT + GI_EG);
        const LAS bf16x8* WF = (const LAS bf16x8*)(bufc + GI_W) + lane; const LAS bf16x8* QF = (const LAS bf16x8*)(bufc + GI_QG) + lane;
        const LAS bf16x8* KF = (const LAS bf16x8*)(bufc + GI_KG) + lane; const LAS bf16x8* AF = (const LAS bf16x8*)(bufc + GI_AT) + lane; const LAS bf16* U = (const LAS bf16*)(bufc + GI_U);
        bf16x8 Sp[4][2];
#pragma unroll
        for (int kb = 0; kb < 4; ++kb)
#pragma unroll
            for (int s = 0; s < 2; ++s) { v4u w; w.x = pk2(S[kb][8 * s], S[kb][8 * s + 1]); w.y = pk2(S[kb][8 * s + 2], S[kb][8 * s + 3]); w.z = pk2(S[kb][8 * s + 4], S[kb][8 * s + 5]); w.w = pk2(S[kb][8 * s + 6], S[kb][8 * s + 7]); Sp[kb][s] = __builtin_bit_cast(bf16x8, w); }
        f32x16 vn[2], ot[2];
#pragma unroll
        for (int cb = 0; cb < 2; ++cb) {
            f32x16 ws;
#pragma unroll
            for (int r = 0; r < 16; ++r) { ws[r] = 0.f; ot[cb][r] = 0.f; }
#pragma unroll
            for (int kb = 0; kb < 4; ++kb)
#pragma unroll
                for (int s = 0; s < 2; ++s) { ws = __builtin_amdgcn_mfma_f32_32x32x16_bf16(WF[((cb * 4 + kb) * 2 + s) * 64], Sp[kb][s], ws, 0, 0, 0);
                    ot[cb] = __builtin_amdgcn_mfma_f32_32x32x16_bf16(QF[((cb * 4 + kb) * 2 + s) * 64], Sp[kb][s], ot[cb], 0, 0, 0); }
#pragma unroll
            for (int r = 0; r < 16; ++r) vn[cb][r] = bf2f(U[(cb * 32 + crow_dev(r, hi)) * 128 + vb * 32 + r32]) - ws[r];
        }
        bf16x8 Vp[2][2];
#pragma unroll
        for (int cb = 0; cb < 2; ++cb)
#pragma unroll
            for (int s = 0; s < 2; ++s) { v4u w; w.x = pk2(vn[cb][8 * s], vn[cb][8 * s + 1]); w.y = pk2(vn[cb][8 * s + 2], vn[cb][8 * s + 3]); w.z = pk2(vn[cb][8 * s + 4], vn[cb][8 * s + 5]); w.w = pk2(vn[cb][8 * s + 6], vn[cb][8 * s + 7]); Vp[cb][s] = __builtin_bit_cast(bf16x8, w); }
#pragma unroll
        for (int cb = 0; cb < 2; ++cb)
#pragma unroll
            for (int c2 = 0; c2 <= cb; ++c2)
#pragma unroll
                for (int s = 0; s < 2; ++s) ot[cb] = __builtin_amdgcn_mfma_f32_32x32x16_bf16(AF[((cb * 2 + c2) * 2 + s) * 64], Vp[c2][s], ot[cb], 0, 0, 0);
        { const int row0 = gdn_item_row(item, 0);
#pragma unroll
          for (int cb = 0; cb < 2; ++cb)
#pragma unroll
              for (int r = 0; r < 16; ++r) OB[(size_t)(row0 + cb * 32 + crow_dev(r, hi)) * WIDTH_B + h * 128 + vb * 32 + r32] = (bf16)f2bf(ot[cb][r]); }
#pragma unroll
        for (int kb = 0; kb < 4; ++kb) {
#pragma unroll
            for (int r = 0; r < 16; ++r) S[kb][r] *= egl;
#pragma unroll
            for (int cb = 0; cb < 2; ++cb)
#pragma unroll
                for (int s = 0; s < 2; ++s) S[kb] = __builtin_amdgcn_mfma_f32_32x32x16_bf16(KF[((kb * 2 + cb) * 2 + s) * 64], Vp[cb][s], S[kb], 0, 0, 0);
        }
        GCH_BAR();
    }
#pragma unroll
    for (int kb = 0; kb < 4; ++kb)
#pragma unroll
        for (int r = 0; r < 16; ++r) dout[(size_t)(kb * 32 + crow_dev(r, hi)) * HEAD_DIM_B + vb * 32 + r32] = S[kb][r];
}
__device__ __forceinline__ void p_gdn_chain(Frame& F, int l) {
    const KArgs ap = kargs(); const auto& a = *ap; WS_OPAQUE(a);
    const unsigned char* GD = wsb + a.off[R_GDN]; bf16* OB = (bf16*)(wsb + a.off[R_OB]);
    if (F.vcu % 32 == 0 && F.vcu / 32 < BATCH * N_HEADS_B) { const int sh = F.vcu / 32, sq = sh / N_HEADS_B, h = sh % N_HEADS_B;
        gdn_chain_wg(F, GD, OB, GOUT(a) + O_DP + (((size_t)l * BATCH + sq) * N_HEADS_B + h) * HEAD_DIM_B * HEAD_DIM_B, sh * GDN_NCH, h, (gu32*)wsb + CW_GDNFLAG + 64 * sh, (unsigned)(l + 1)); }
    else { const int q = F.vcu - F.vcu / 32 - 1;
        if (q < 18) { p_gdn_chunk<1>(F, l, q);
            if (q < 16) { const int tid = otid(), lane = tid & 63, wave = __builtin_amdgcn_readfirstlane(tid >> 6);
#pragma unroll
                for (int tt = 0; tt < 2; ++tt) { const int t = wave + 8 * tt, s = 4 * q + (t >> 2), vb = t & 3, bs = s >> 2, h = s & 3; const size_t so = (((size_t)l * DEC_BATCH + bs) * N_HEADS_B + h) * HEAD_DIM_B * HEAD_DIM_B;
                    gdn_chain(GD, OB, GIN(a, I_SDELTA) + so, GOUT(a) + O_DS + so, GDN_NPI + s, 1, h, vb, lane); } } } }
}
__device__ __forceinline__ void p_mixpost_b(Frame& F, int l) {
    const KArgs ap = kargs(); const auto& a = *ap; WS_OPAQUE(a);
    const int tid = otid(), lane = tid & 63, wave = __builtin_amdgcn_readfirstlane(tid >> 6);
    const bf16* OB = (const bf16*)(wsb + a.off[R_OB]); bf16* OBN = (bf16*)(wsb + a.off[R_OBN]); const bf16* Z = (const bf16*)(wsb + a.off[R_Z]);
    const int gw = F.vcu * NWAVES + wave, NGW = F.G * NWAVES, e0 = 8 * (lane & 15);
    float gn[8];
#pragma unroll
    for (int j = 0; j < 8; ++j) gn[j] = GIN(a, I_GDNN)[l * HEAD_DIM_B + e0 + j];
    for (int m = gw; m < RP; m += NGW) {
        float o[8], gt[8];
        unpack8(*(const GAS v4u*)(OB + (size_t)m * WIDTH_B + 8 * lane), o); unpack8(*(const GAS v4u*)(Z + (size_t)m * ZN + ZC_GB + 8 * lane), gt);
        float ss = 0.f;
#pragma unroll
        for (int j = 0; j < 8; ++j) ss += o[j] * o[j];
        ss = sum16(ss);
        const float r = __builtin_amdgcn_rsqf(ss * (1.f / 128.f) + EPSF);
#pragma unroll
        for (int j = 0; j < 8; ++j) o[j] = o[j] * r * gn[j] * gt[j] * sigm(gt[j]);
        *(GAS v4u*)(OBN + (size_t)m * WIDTH_B + 8 * lane) = pack8(o);
    }
}
constexpr int S5_M1 = 0, S5_M2 = 131072, S5_M3 = 196608, S5_L16 = 262144, S5_TSTRIDE = 262656;
constexpr int S5_NCHK = RP / 16;
constexpr int S5_NBLK = S5_NCHK / 32;
constexpr int S5_PCH = PEND / 16;
static_assert(S5_NCHK % 32 == 0 && LPP % 16 == 0 && PADF % 16 == 0 && S5_STATE == 64 && S5_GROUPS == 32, "s5 shapes");

__device__ __forceinline__ void s5_tables(Frame& F) {
    const KArgs ap = kargs(); const auto& a = *ap; WS_OPAQUE(a);
    const int tid = otid();
    LAS float* pw = (LAS float*)(F.lds + RING_OFF);
    LAS float* bb = pw + 17 * 128;
    LAS float* Kt = bb + 64 * 32;
    for (int it = F.vcu; it < DEPTH * S5_GROUPS; it += F.G) {
        const int l = it / S5_GROUPS, g = it % S5_GROUPS; const size_t gp = ((size_t)l * S5_GROUPS + g) * S5_STATE;
        unsigned char* tb = wsb + a.off[R_S5T] + (size_t)it * S5_TSTRIDE;
        const float dt = __expf(GIN(a, I_LDT)[l * S5_GROUPS + g]);
        for (int e = tid; e < 17 * 64; e += NTHR) { const int k = e >> 6, p = e & 63; const float ar = GIN(a, I_AR)[gp + p] * dt * (float)k, ai = GIN(a, I_AI)[gp + p] * dt * (float)k;
            float sn, cs; sincosf(ai, &sn, &cs); const float er = expf(ar); pw[e * 2] = er * cs; pw[e * 2 + 1] = er * sn; }
        __syncthreads();
        for (int e = tid; e < 64 * 16; e += NTHR) { const int p = e >> 4; const float ar = GIN(a, I_AR)[gp + p], ai = GIN(a, I_AI)[gp + p];
            const float nr = pw[(64 + p) * 2] - 1.f, ni = pw[(64 + p) * 2 + 1], den = ar * ar + ai * ai, fr = (nr * ar + ni * ai) / den, fi = (ni * ar - nr * ai) / den;
            const float br = GIN(a, I_BR)[gp * 16 + e], bi = GIN(a, I_BI)[gp * 16 + e]; bb[e * 2] = fr * br - fi * bi; bb[e * 2 + 1] = fr * bi + fi * br; }
        if (tid < 128) { const int p = tid & 63; ((float*)(tb + S5_L16))[tid] = pw[(16 * 64 + p) * 2 + (tid >> 6)]; }
        __syncthreads();
        const float* cre = GIN(a, I_CR) + ((size_t)l * S5_GROUPS + g) * 16 * 64; const float* cim = GIN(a, I_CI) + ((size_t)l * S5_GROUPS + g) * 16 * 64;
        for (int e = tid; e < 4096; e += NTHR) { const int d = e >> 8, i = (e >> 4) & 15, j = e & 15; float acc = 0.f;
            for (int p = 0; p < 64; ++p) { const float cr = cre[i * 64 + p], ci = cim[i * 64 + p], pr = pw[(d * 64 + p) * 2], pi = pw[(d * 64 + p) * 2 + 1];
                const float tr = cr * pr - ci * pi, ti = cr * pi + ci * pr; acc += tr * bb[(p * 16 + j) * 2] - ti * bb[(p * 16 + j) * 2 + 1]; }
            Kt[e] = acc; }
        __syncthreads();
        bf16* M1 = (bf16*)(tb + S5_M1); bf16* M2 = (bf16*)(tb + S5_M2); bf16* M3 = (bf16*)(tb + S5_M3);
        for (int e = tid; e < 65536; e += NTHR) { const int n = e >> 8, k = e & 255, tau = n >> 4, i = n & 15, sg = k >> 4, j = k & 15;
            float v = 0.f; if (sg <= tau) { v = Kt[((tau - sg) * 16 + i) * 16 + j]; if (sg == tau && i == j) v += GIN(a, I_SD)[(l * S5_GROUPS + g) * 16 + i]; }
            M1[e] = (bf16)f2bf(v); }
        for (int e = tid; e < 32768; e += NTHR) { const int n = e >> 8, k = e & 255, ri = n >> 6, p = n & 63, sg = k >> 4, j = k & 15;
            const float pr = pw[((15 - sg) * 64 + p) * 2], pi = pw[((15 - sg) * 64 + p) * 2 + 1], br = bb[(p * 16 + j) * 2], bi = bb[(p * 16 + j) * 2 + 1];
            M2[e] = (bf16)f2bf(ri == 0 ? pr * br - pi * bi : pr * bi + pi * br); }
        for (int e = tid; e < 32768; e += NTHR) { const int n = e >> 7, k = e & 127, tau = n >> 4, i = n & 15, ri = k >> 6, p = k & 63;
            const float cr = cre[i * 64 + p], ci = cim[i * 64 + p], pr = pw[((tau + 1) * 64 + p) * 2], pi = pw[((tau + 1) * 64 + p) * 2 + 1];
            M3[e] = (bf16)f2bf(ri == 0 ? cr * pr - ci * pi : -(cr * pi + ci * pr)); }
        __syncthreads();
    }
}
__device__ __forceinline__ void p_s5_e(Frame& F, int l) {
    const KArgs ap = kargs(); const auto& a = *ap; WS_OPAQUE(a);
    const int tid = otid(), lane = tid & 63, wave = __builtin_amdgcn_readfirstlane(tid >> 6), r32 = lane & 31, hi = lane >> 5;
    const bf16* Z = (const bf16*)(wsb + a.off[R_Z]); float* E = (float*)(wsb + a.off[R_S5E]);
    for (int u = F.vcu * NWAVES + wave; u < S5_NBLK * S5_GROUPS; u += F.G * NWAVES) {
        const int blk = u / S5_GROUPS, g = u % S5_GROUPS;
        const unsigned char* tb = wsb + a.off[R_S5T] + (size_t)(l * S5_GROUPS + g) * S5_TSTRIDE;
        const GAS bf16x8* M2 = (const GAS bf16x8*)(tb + S5_M2);
        const bf16* zr = Z + (size_t)((blk * 32 + r32) * 16) * ZN + ZC_UC + g * 16 + 8 * hi;
        f32x16 acc[4];
#pragma unroll
        for (int nb = 0; nb < 4; ++nb)
#pragma unroll
            for (int r = 0; r < 16; ++r) acc[nb][r] = 0.f;
#pragma unroll 4
        for (int sg = 0; sg < 16; ++sg) { const bf16x8 af = *(const GAS bf16x8*)(zr + (size_t)sg * ZN);
#pragma unroll
            for (int nb = 0; nb < 4; ++nb) acc[nb] = __builtin_amdgcn_mfma_f32_32x32x16_bf16(af, M2[((nb * 32 + r32) * 256 + sg * 16 + 8 * hi) >> 3], acc[nb], 0, 0, 0); }
#pragma unroll
        for (int nb = 0; nb < 4; ++nb)
#pragma unroll
            for (int r = 0; r < 16; ++r) E[((size_t)(blk * 32 + crow_dev(r, hi)) * S5_GROUPS + g) * 128 + nb * 32 + r32] = acc[nb][r];
    }
}
__device__ __forceinline__ void s5_scan_task(const float* E, bf16* XP, const float* l16, int g, int c0, int nch, float xr, float xi, float* ore, float* oim, int lane) {
    const float lr = l16[lane], li = l16[64 + lane];
    int c = 0;
    for (; c + 8 <= nch; c += 8) { float er[8], ei[8];
#pragma unroll
        for (int q = 0; q < 8; ++q) { const float* e = E + ((size_t)(c0 + c + q) * S5_GROUPS + g) * 128; er[q] = e[lane]; ei[q] = e[64 + lane]; }
#pragma unroll
        for (int q = 0; q < 8; ++q) { bf16* xp = XP + ((size_t)(c0 + c + q) * S5_GROUPS + g) * 128; xp[lane] = (bf16)f2bf(xr); xp[64 + lane] = (bf16)f2bf(xi);
            const float nr = lr * xr - li * xi + er[q], ni = lr * xi + li * xr + ei[q]; xr = nr; xi = ni; } }
    for (; c < nch; ++c) { const float* e = E + ((size_t)(c0 + c) * S5_GROUPS + g) * 128; bf16* xp = XP + ((size_t)(c0 + c) * S5_GROUPS + g) * 128; xp[lane] = (bf16)f2bf(xr); xp[64 + lane] = (bf16)f2bf(xi);
        const float nr = lr * xr - li * xi + e[lane], ni = lr * xi + li * xr + e[64 + lane]; xr = nr; xi = ni; }
    ore[lane] = xr; oim[lane] = xi;
}
constexpr int S5_NTASK = (BATCH + DEC_BATCH) * S5_GROUPS;
__device__ __forceinline__ void s5_scan_run(Frame& F, int l, int t, int lane) {
    const KArgs ap = kargs(); const auto& a = *ap; WS_OPAQUE(a);
    const int sq = t / S5_GROUPS, g = t % S5_GROUPS;
    const float* E = (const float*)(wsb + a.off[R_S5E]); bf16* XP = (bf16*)(wsb + a.off[R_S5X]);
    const float* l16 = (const float*)(wsb + a.off[R_S5T] + (size_t)(l * S5_GROUPS + g) * S5_TSTRIDE + S5_L16);
    if (sq < BATCH) { const size_t oo = (((size_t)l * BATCH + sq) * S5_GROUPS + g) * S5_STATE;
        s5_scan_task(E, XP, l16, g, sq * (LPP / 16), S5_PCH, 0.f, 0.f, GOUT(a) + O_SRP + oo, GOUT(a) + O_SIP + oo, lane); }
    else { const int bs = sq - BATCH; const size_t oo = (((size_t)l * DEC_BATCH + bs) * S5_GROUPS + g) * S5_STATE;
        s5_scan_task(E, XP, l16, g, SROW0 / 16 + bs * (DEC_SEQ / 16), DEC_SEQ / 16, GIN(a, I_SRE)[oo + lane], GIN(a, I_SIM)[oo + lane], GOUT(a) + O_SRS + oo, GOUT(a) + O_SIS + oo, lane); }
}
__device__ __forceinline__ float gelu_tanh(float x) { const float z = 0.7978845608028654f * (x + 0.044715f * x * x * x); const float t = 1.f - 2.f * __builtin_amdgcn_rcpf(__expf(2.f * z) + 1.f); return 0.5f * x * (1.f + t); }
__device__ __forceinline__ void p_s5_out(Frame& F, int l) {
    const KArgs ap = kargs(); const auto& a = *ap; WS_OPAQUE(a);
    const int tid = otid(), lane = tid & 63, wave = __builtin_amdgcn_readfirstlane(tid >> 6), r32 = lane & 31, hi = lane >> 5;
    const bf16* Z = (const bf16*)(wsb + a.off[R_Z]); const bf16* XP = (const bf16*)(wsb + a.off[R_S5X]); bf16* YC = (bf16*)(wsb + a.off[R_YC]);
    for (int u = F.vcu * NWAVES + wave; u < S5_NBLK * S5_GROUPS; u += F.G * NWAVES) {
        const int blk = u / S5_GROUPS, g = u % S5_GROUPS;
        const unsigned char* tb = wsb + a.off[R_S5T] + (size_t)(l * S5_GROUPS + g) * S5_TSTRIDE;
        const GAS bf16x8* M1 = (const GAS bf16x8*)(tb + S5_M1); const GAS bf16x8* M3 = (const GAS bf16x8*)(tb + S5_M3);
        const bf16* zr = Z + (size_t)((blk * 32 + r32) * 16) * ZN + ZC_UC + g * 16 + 8 * hi;
        const bf16* xr = XP + ((size_t)(blk * 32 + r32) * S5_GROUPS + g) * 128 + 8 * hi;
        f32x16 acc[8];
#pragma unroll
        for (int nb = 0; nb < 8; ++nb)
#pragma unroll
            for (int r = 0; r < 16; ++r) acc[nb][r] = 0.f;
#pragma unroll 2
        for (int sg = 0; sg < 16; ++sg) { const bf16x8 af = *(const GAS bf16x8*)(zr + (size_t)sg * ZN);
#pragma unroll
            for (int nb = 0; nb < 8; ++nb) acc[nb] = __builtin_amdgcn_mfma_f32_32x32x16_bf16(af, M1[((nb * 32 + r32) * 256 + sg * 16 + 8 * hi) >> 3], acc[nb], 0, 0, 0); }
#pragma unroll 2
        for (int s = 0; s < 8; ++s) { const bf16x8 af = *(const GAS bf16x8*)(xr + 16 * s);
#pragma unroll
            for (int nb = 0; nb < 8; ++nb) acc[nb] = __builtin_amdgcn_mfma_f32_32x32x16_bf16(af, M3[((nb * 32 + r32) * 128 + s * 16 + 8 * hi) >> 3], acc[nb], 0, 0, 0); }
#pragma unroll
        for (int nb = 0; nb < 8; ++nb)
#pragma unroll
            for (int r = 0; r < 16; ++r) { const int row = (blk * 32 + crow_dev(r, hi)) * 16 + 2 * nb + (r32 >> 4);
                YC[(size_t)row * WIDTH_C + g * 16 + (r32 & 15)] = (bf16)f2bf(gelu_tanh(acc[nb][r])); }
    }
}
__device__ __forceinline__ int rdlane_i(int v, int i) { return __builtin_amdgcn_readlane(v, i); }
constexpr float NEG_BIG = -3.0e38f;
__device__ __forceinline__ unsigned fkey(float v) { const unsigned u = __builtin_bit_cast(unsigned, v); return (u & 0x80000000u) ? ~u : (u | 0x80000000u); }
__device__ __forceinline__ int mbcnt64(unsigned long long m) { return __builtin_amdgcn_mbcnt_hi((unsigned)(m >> 32), __builtin_amdgcn_mbcnt_lo((unsigned)m, 0)); }
__device__ __forceinline__ void pro_wqs(Frame& F) {
    const KArgs ap = kargs(); const auto& a = *ap; WS_OPAQUE(a);
    const int tid = otid(), lane = tid & 63, wave = __builtin_amdgcn_readfirstlane(tid >> 6);
    bf16* WQ = (bf16*)(wsb + a.off[R_WQS]);
    for (int t = F.vcu * NWAVES + wave; t < DEPTH * 16 * 16; t += F.G * NWAVES) {
        const int l = t >> 8, hc = (t >> 4) & 15, kb = t & 15, k = kb * 64 + lane;
        const float* wr = GIN(a, I_PWQ) + ((size_t)l * D_MODEL + k) * PQ + hc * 128;
        float w[128];
#pragma unroll
        for (int d = 0; d < 128; d += 4) { const f32x4 v = *(const GAS f32x4*)(wr + d); w[d] = v.x; w[d + 1] = v.y; w[d + 2] = v.z; w[d + 3] = v.w; }
        const float* sk = GIN(a, I_PSK) + ((size_t)l * 16 + hc) * 128 * 128; const float g2k = GIN(a, I_N2)[(size_t)l * D_MODEL + k];
        bf16* o = WQ + ((size_t)l * PQ + hc * 128) * D_MODEL + k;
#pragma clang loop vectorize(disable) unroll(disable)
        for (int n = 0; n < 128; ++n) { const float* sr = sk + n * 128; float acc = 0.f;
#pragma unroll
            for (int d = 0; d < 128; ++d) acc += w[d] * sr[d];
            o[(size_t)n * D_MODEL] = (bf16)f2bf(acc * g2k); }
    }
}
__device__ __forceinline__ void pro_wrest(Frame& F) {
    const KArgs ap = kargs(); const auto& a = *ap; WS_OPAQUE(a);
    const int tid = otid(), lane = tid & 63, wave = __builtin_amdgcn_readfirstlane(tid >> 6);
    LAS float* scr = (LAS float*)(F.lds + RING_OFF + wave * 16384);
    const int gw = F.vcu * NWAVES + wave, NGW = F.G * NWAVES;
    bf16* WG = (bf16*)(wsb + a.off[R_WGLU]); bf16* WB = (bf16*)(wsb + a.off[R_WBR]); bf16* WO = (bf16*)(wsb + a.off[R_WOUT]);
    constexpr int IG = (512 / 64) * (1024 / 32), IB = IG, IO = (1024 / 64) * (1024 / 32), IL = IG + 3 * IB + IO;
    for (int it = gw; it < DEPTH * IL; it += NGW) { const int l = it / IL; int r = it % IL;
        if (r < IG) { transpose_item(GIN(a, I_WGLU) + (size_t)l * 512 * 1024, 1024, 512, WG + (size_t)l * 1024 * 512, 32 * (r % 32), 64 * (r / 32), CmGlu(), scr, lane); continue; } r -= IG;
        if (r < 3 * IB) { const int w = r / IB, q = r % IB; transpose_item(GIN(a, I_WBA + w) + (size_t)l * 512 * 1024, 1024, 512, WB + ((size_t)l * 3 + w) * 1024 * 512, 32 * (q % 32), 64 * (q / 32), CmId(), scr, lane); continue; } r -= 3 * IB;
        transpose_item(GIN(a, I_WOUT) + (size_t)l * 1024 * 1024, 1024, 1024, WO + (size_t)l * 1024 * 1024, 32 * (r % 32), 64 * (r / 32), CmId(), scr, lane); }
}
typedef float f32x2v __attribute__((ext_vector_type(2)));
__device__ __forceinline__ unsigned pk_i8(const f32x4 x, float inv) {
    const int a = (int)rintf(x.x * inv), b = (int)rintf(x.y * inv), c = (int)rintf(x.z * inv), d = (int)rintf(x.w * inv);
    return (unsigned)(a & 0xff) | ((unsigned)(b & 0xff) << 8) | ((unsigned)(c & 0xff) << 16) | ((unsigned)(d & 0xff) << 24); }
constexpr size_t PEER_ROWS = (size_t)DEPTH * N_EXPERTS;
__device__ __forceinline__ void pro_peerw(Frame& F) {
    const KArgs ap = kargs(); const auto& a = *ap; WS_OPAQUE(a);
    const int tid = otid(), lane = tid & 63, wave = __builtin_amdgcn_readfirstlane(tid >> 6);
    float* SCL = (float*)(wsb + a.off[R_MISC]);
    for (size_t rw = (size_t)F.vcu * NWAVES + wave; rw < 2 * PEER_ROWS; rw += (size_t)F.G * NWAVES) {
        const int w = rw >= PEER_ROWS; const size_t row = rw - (w ? PEER_ROWS : 0);
        const GAS f32x4* src = (const GAS f32x4*)(GIN(a, I_PU + w) + row * D_MODEL) + 4 * lane;
        const f32x4 x0 = src[0], x1 = src[1], x2 = src[2], x3 = src[3];
        float mx = fmaxf(fmaxf(fmaxf(fabsf(x0.x), fabsf(x0.y)), fmaxf(fabsf(x0.z), fabsf(x0.w))), fmaxf(fmaxf(fabsf(x1.x), fabsf(x1.y)), fmaxf(fabsf(x1.z), fabsf(x1.w))));
        mx = fmaxf(mx, fmaxf(fmaxf(fmaxf(fabsf(x2.x), fabsf(x2.y)), fmaxf(fabsf(x2.z), fabsf(x2.w))), fmaxf(fmaxf(fabsf(x3.x), fabsf(x3.y)), fmaxf(fabsf(x3.z), fabsf(x3.w)))));
        mx = wave_max(mx);
        if (w == 0) {
            const float inv = mx > 0.f ? 127.f / mx : 0.f;
            v4u o; o.x = pk_i8(x0, inv); o.y = pk_i8(x1, inv); o.z = pk_i8(x2, inv); o.w = pk_i8(x3, inv);
            *((GAS v4u*)(wsb + a.off[R_PU] + row * D_MODEL) + lane) = o;
            if (lane == 0) SCL[rw] = mx * (1.f / 127.f);
            continue; }
        const float inv = mx > 0.f ? 416.f / mx : 0.f;
        v4u o; int t;
        t = __builtin_amdgcn_cvt_pk_fp8_f32(x0.x * inv, x0.y * inv, 0, false); t = __builtin_amdgcn_cvt_pk_fp8_f32(x0.z * inv, x0.w * inv, t, true); o.x = (unsigned)t;
        t = __builtin_amdgcn_cvt_pk_fp8_f32(x1.x * inv, x1.y * inv, 0, false); t = __builtin_amdgcn_cvt_pk_fp8_f32(x1.z * inv, x1.w * inv, t, true); o.y = (unsigned)t;
        t = __builtin_amdgcn_cvt_pk_fp8_f32(x2.x * inv, x2.y * inv, 0, false); t = __builtin_amdgcn_cvt_pk_fp8_f32(x2.z * inv, x2.w * inv, t, true); o.z = (unsigned)t;
        t = __builtin_amdgcn_cvt_pk_fp8_f32(x3.x * inv, x3.y * inv, 0, false); t = __builtin_amdgcn_cvt_pk_fp8_f32(x3.z * inv, x3.w * inv, t, true); o.w = (unsigned)t;
        *((GAS v4u*)(wsb + a.off[R_PU + w] + row * D_MODEL) + lane) = o;
        if (lane == 0) SCL[rw] = mx * (1.f / 416.f);
    }
}
__device__ __forceinline__ void fp8x16_to_f32(const v4u q, float (&f)[16]) {
#pragma unroll
    for (int d = 0; d < 4; ++d) { const int w = (int)(d == 0 ? q.x : d == 1 ? q.y : d == 2 ? q.z : q.w);
        const f32x2v lo = __builtin_amdgcn_cvt_pk_f32_fp8(w, false), hi = __builtin_amdgcn_cvt_pk_f32_fp8(w, true); f[4 * d] = lo.x; f[4 * d + 1] = lo.y; f[4 * d + 2] = hi.x; f[4 * d + 3] = hi.y; }
}
__device__ __forceinline__ void p_peer(Frame& F, int l, bool dry) {
    const KArgs ap = kargs(); const auto& a = *ap; WS_OPAQUE(a);
    const int tid = otid(), lane = tid & 63, wave = __builtin_amdgcn_readfirstlane(tid >> 6);
    const float* SC = (const float*)(wsb + a.off[R_SC]); const bf16* XN = (const bf16*)(wsb + a.off[R_XN]); float* X = (float*)(wsb + a.off[R_X]);
    const unsigned char* PU = wsb + a.off[R_PU] + (size_t)l * N_EXPERTS * D_MODEL; const unsigned char* PV = wsb + a.off[R_PV] + (size_t)l * N_EXPERTS * D_MODEL;
    const float* SCU = (const float*)(wsb + a.off[R_MISC]) + (size_t)l * N_EXPERTS; const float* SCV = SCU + PEER_ROWS;
    LAS float* stop = (LAS float*)(F.lds + RING_OFF + wave * 4096);
    LAS int* itop = (LAS int*)(stop + 256);
    LAS int* elist = itop + 256;
    LAS float* cf = (LAS float*)(elist + 128);
    for (int m = F.vcu * NWAVES + wave; m < RP; m += F.G * NWAVES) {
        if (!prow_valid(m)) continue;
        const float* sr = SC + (size_t)m * PQ;
        float hx[16], rs;
        { const GAS f32x4* xr0 = (const GAS f32x4*)(X + (size_t)m * D_MODEL + 16 * lane); const GAS f32x4* g4 = (const GAS f32x4*)(GIN(a, I_N2) + (size_t)l * D_MODEL + 16 * lane); float s2 = 0.f;
#pragma unroll
          for (int j = 0; j < 4; ++j) { const f32x4 xv = xr0[j], gv = g4[j]; s2 += (xv.x * xv.x + xv.y * xv.y) + (xv.z * xv.z + xv.w * xv.w); hx[4 * j] = xv.x * gv.x; hx[4 * j + 1] = xv.y * gv.y; hx[4 * j + 2] = xv.z * gv.z; hx[4 * j + 3] = xv.w * gv.w; }
          rs = __builtin_amdgcn_rsqf(wave_sum(s2) * (1.f / D_MODEL) + EPSF);
#pragma unroll
          for (int j = 0; j < 16; ++j) hx[j] *= rs; }
#ifndef MK_REP
#define MK_REP -1
#endif
        for (int rp12 = 0; rp12 < ((MK_REP) == 105 ? 2 : 1); ++rp12) {
        { unsigned k[32];
          { const GAS f32x4* p4 = (const GAS f32x4*)(sr + (lane >> 2) * 128 + (lane & 3) * 32);
#pragma unroll
            for (int j = 0; j < 8; ++j) { const f32x4 v = p4[j]; k[4 * j] = fkey(v.x); k[4 * j + 1] = fkey(v.y); k[4 * j + 2] = fkey(v.z); k[4 * j + 3] = fkey(v.w); } }
          unsigned p = 0u;
#pragma unroll
          for (int bit = 31; bit >= 0; --bit) { const unsigned t = p | (1u << bit); int c = 0;
#pragma unroll
              for (int j = 0; j < 32; ++j) c += k[j] >= t ? 1 : 0;
              c += dpp_i<0xB1>(c); c += dpp_i<0x4E>(c);
              p = c >= 16 ? t : p; }
          int cl = 0;
#pragma unroll
          for (int j = 0; j < 32; ++j) cl += k[j] >= p ? 1 : 0;
          const int q = lane & 3, c0 = dpp_i<0x00>(cl), c1 = dpp_i<0x55>(cl), c2 = dpp_i<0xAA>(cl);
          int pos = (q > 0 ? c0 : 0) + (q > 1 ? c1 : 0) + (q > 2 ? c2 : 0);
          const int sb = (lane >> 2) * 16;
#pragma unroll
          for (int j = 0; j < 32; ++j) { const bool sel = k[j] >= p;
              if (sel && pos < 16) { const unsigned u = (k[j] & 0x80000000u) ? (k[j] ^ 0x80000000u) : ~k[j]; stop[sb + pos] = __builtin_bit_cast(float, u); itop[sb + pos] = q * 32 + j; }
              pos += sel ? 1 : 0; }
        }
        LDS_WAIT();
        for (int h = 0; h < 8; ++h) {
            const float s1 = stop[(2 * h) * 16 + (lane >> 2)];
            float c[4]; unsigned kc[4];
#pragma unroll
            for (int j = 0; j < 4; ++j) { c[j] = s1 + stop[(2 * h + 1) * 16 + (lane & 3) * 4 + j]; kc[j] = fkey(c[j]); }
            unsigned pp = 0u;
            for (int bit = 31; bit >= 0; --bit) { const unsigned tt = pp | (1u << bit);
                const int cn = __builtin_popcountll(__ballot(kc[0] >= tt)) + __builtin_popcountll(__ballot(kc[1] >= tt)) + __builtin_popcountll(__ballot(kc[2] >= tt)) + __builtin_popcountll(__ballot(kc[3] >= tt));
                pp = cn >= 16 ? tt : pp; if (cn == 16) break; }
            const float cmax = wave_max(fmaxf(fmaxf(c[0], c[1]), fmaxf(c[2], c[3])));
            float esum = 0.f; int base = 0;
#pragma unroll
            for (int j = 0; j < 4; ++j) { const bool sel = kc[j] >= pp; const unsigned long long mk = __ballot(sel); const int rk = base + mbcnt64(mk); base += __builtin_popcountll(mk);
                const float ex = (sel && rk < 16) ? __expf(rs * (c[j] - cmax)) : 0.f; esum += ex;
                if (sel && rk < 16) { const int ci = lane * 4 + j; elist[h * 16 + rk] = itop[(2 * h) * 16 + (ci >> 4)] * N_KEYS + itop[(2 * h + 1) * 16 + (ci & 15)]; cf[h * 16 + rk] = ex; } }
            esum = wave_sum(esum); const float inv = __builtin_amdgcn_rcpf(esum);
            LDS_WAIT();
            if (lane < 16) cf[h * 16 + lane] *= inv;
        }
        LDS_WAIT();
        }
        for (int rp3 = 0; rp3 < ((MK_REP) == 106 ? 2 : 1); ++rp3) {
        float out[16];
#pragma unroll
        for (int j = 0; j < 16; ++j) out[j] = 0.f;
        float hmx = 0.f;
#pragma unroll
        for (int j = 0; j < 16; ++j) hmx = fmaxf(hmx, fabsf(hx[j]));
        hmx = wave_max(hmx); const float hinv = hmx > 0.f ? 127.f / hmx : 0.f, hsc = hmx * (1.f / 127.f);
        v4u hq; hq.x = pk_i8((f32x4){hx[0], hx[1], hx[2], hx[3]}, hinv); hq.y = pk_i8((f32x4){hx[4], hx[5], hx[6], hx[7]}, hinv); hq.z = pk_i8((f32x4){hx[8], hx[9], hx[10], hx[11]}, hinv); hq.w = pk_i8((f32x4){hx[12], hx[13], hx[14], hx[15]}, hinv);
        v4u uA[4], vA[4], uB[4], vB[4]; float suA, svA, cA, suB, svB, cB;
        const bool l60 = lane == 60, l61 = lane == 61, l62 = lane == 62;
#define PEER_LOAD(U, V, SU, SV, CW, q0) do { { const int em_ = elist[(q0) + (lane & 3)]; CW = cf[(q0) + (lane & 3)]; SU = SCU[em_]; SV = SCV[em_]; } _Pragma("unroll") for (int i = 0; i < 4; ++i) { const int e_ = elist[(q0) + i]; \
            U[i] = *((const GAS v4u*)(PU + (size_t)e_ * D_MODEL) + lane); V[i] = *((const GAS v4u*)(PV + (size_t)e_ * D_MODEL) + lane); } } while (0)
#define PEER_COMP(U, V, SU, SV, CW) do { float d_[4]; _Pragma("unroll") for (int i = 0; i < 4; ++i) { int di_ = __builtin_amdgcn_sdot4((int)U[i].x, (int)hq.x, 0, false); di_ = __builtin_amdgcn_sdot4((int)U[i].y, (int)hq.y, di_, false); \
            di_ = __builtin_amdgcn_sdot4((int)U[i].z, (int)hq.z, di_, false); di_ = __builtin_amdgcn_sdot4((int)U[i].w, (int)hq.w, di_, false); d_[i] = (float)di_; } \
            _Pragma("unroll") for (int i = 0; i < 4; ++i) d_[i] += dpp_f<0xB1>(d_[i]); _Pragma("unroll") for (int i = 0; i < 4; ++i) d_[i] += dpp_f<0x4E>(d_[i]); \
            _Pragma("unroll") for (int i = 0; i < 4; ++i) d_[i] += dpp_f<0x141>(d_[i]); _Pragma("unroll") for (int i = 0; i < 4; ++i) d_[i] += dpp_f<0x140>(d_[i]); \
            _Pragma("unroll") for (int i = 0; i < 4; ++i) d_[i] += dpp_fm<0x142, 0xA>(d_[i]); _Pragma("unroll") for (int i = 0; i < 4; ++i) d_[i] += dpp_fm<0x143, 0xC>(d_[i]);     \
            const float dsel_ = l60 ? d_[0] : l61 ? d_[1] : l62 ? d_[2] : d_[3];                                    \
            const float ccv_ = CW * gelu_tanh(dsel_ * hsc * SU) * SV; \
            _Pragma("unroll") for (int i = 0; i < 4; ++i) { const float cc = rdlane(ccv_, 60 + i); float t[16]; fp8x16_to_f32(V[i], t); _Pragma("unroll") for (int j = 0; j < 16; ++j) out[j] += cc * t[j]; } } while (0)
        PEER_LOAD(uA, vA, suA, svA, cA, 0);
        for (int q = 0; q < 128; q += 8) {
            PEER_LOAD(uB, vB, suB, svB, cB, q + 4);
            PEER_COMP(uA, vA, suA, svA, cA);
            if (q + 8 < 128) PEER_LOAD(uA, vA, suA, svA, cA, q + 8);
            PEER_COMP(uB, vB, suB, svB, cB);
        }
#undef PEER_LOAD
#undef PEER_COMP
        if (!dry && rp3 == ((MK_REP) == 106 ? 1 : 0)) { GAS f32x4* xr = (GAS f32x4*)(X + (size_t)m * D_MODEL + 16 * lane);
          f32x4 xv[4]; float s2 = 0.f;
#pragma unroll
          for (int j = 0; j < 4; ++j) { xv[j] = xr[j] + (f32x4){out[4 * j], out[4 * j + 1], out[4 * j + 2], out[4 * j + 3]}; s2 += (xv[j].x * xv[j].x + xv[j].y * xv[j].y) + (xv[j].z * xv[j].z + xv[j].w * xv[j].w); }
          const float rn = __builtin_amdgcn_rsqf(wave_sum(s2) * (1.f / D_MODEL) + EPSF);
          if (l + 1 < DEPTH) {
#pragma unroll
              for (int j = 0; j < 4; ++j) xr[j] = xv[j];
              const GAS f32x4* gr = (const GAS f32x4*)(GIN(a, I_N1) + (size_t)(l + 1) * D_MODEL + 16 * lane); float o16[16];
#pragma unroll
              for (int j = 0; j < 4; ++j) { const f32x4 gg = gr[j]; o16[4 * j] = xv[j].x * rn * gg.x; o16[4 * j + 1] = xv[j].y * rn * gg.y; o16[4 * j + 2] = xv[j].z * rn * gg.z; o16[4 * j + 3] = xv[j].w * rn * gg.w; }
              v4u w0, w1; w0.x = pk2(o16[0], o16[1]); w0.y = pk2(o16[2], o16[3]); w0.z = pk2(o16[4], o16[5]); w0.w = pk2(o16[6], o16[7]); w1.x = pk2(o16[8], o16[9]); w1.y = pk2(o16[10], o16[11]); w1.z = pk2(o16[12], o16[13]); w1.w = pk2(o16[14], o16[15]);
              GAS v4u* xo = (GAS v4u*)((bf16*)(wsb + a.off[R_XN]) + (size_t)m * D_MODEL + 16 * lane); xo[0] = w0; xo[1] = w1;
          } else {
              float* dst = nullptr;
              if (m >= SROW0) dst = GOUT(a) + O_YS + (size_t)(m - SROW0) * D_MODEL; else { const int b_ = m / LPP, p_ = m % LPP; if (p_ >= PADF + N_META) dst = GOUT(a) + O_YP + ((size_t)b_ * SEQ + (p_ - PADF - N_META)) * D_MODEL; }
              if (dst) { const GAS f32x4* gr = (const GAS f32x4*)(GIN(a, I_FN) + 16 * lane); GAS f32x4* o = (GAS f32x4*)(dst + 16 * lane);
#pragma unroll
                  for (int j = 0; j < 4; ++j) { const f32x4 gg = gr[j]; o[j] = (f32x4){xv[j].x * rn * gg.x, xv[j].y * rn * gg.y, xv[j].z * rn * gg.z, xv[j].w * rn * gg.w}; } }
          } }
        }
    }
}
__device__ __forceinline__ void p_final(Frame& F) {
    const KArgs ap = kargs(); const auto& a = *ap; WS_OPAQUE(a);
    const int tid = otid(), lane = tid & 63, wave = __builtin_amdgcn_readfirstlane(tid >> 6);
    const float* X = (const float*)(wsb + a.off[R_X]); const float* g = GIN(a, I_FN);
    for (int m = F.vcu * NWAVES + wave; m < RP; m += F.G * NWAVES) {
        float* dst;
        if (m >= SROW0) dst = GOUT(a) + O_YS + (size_t)(m - SROW0) * D_MODEL;
        else { const int b = m / LPP, p = m % LPP; if (p < PADF + N_META || p >= PEND) continue; dst = GOUT(a) + O_YP + ((size_t)b * SEQ + (p - PADF - N_META)) * D_MODEL; }
        const GAS f32x4* xr = (const GAS f32x4*)(X + (size_t)m * D_MODEL) + lane;
        f32x4 v[4]; float s2 = 0.f;
#pragma unroll
        for (int j = 0; j < 4; ++j) { v[j] = xr[64 * j]; s2 += (v[j].x * v[j].x + v[j].y * v[j].y) + (v[j].z * v[j].z + v[j].w * v[j].w); }
        const float r = __builtin_amdgcn_rsqf(wave_sum(s2) * (1.f / D_MODEL) + EPSF);
        const GAS f32x4* gr = (const GAS f32x4*)g + lane; GAS f32x4* o = (GAS f32x4*)dst + lane;
#pragma unroll
        for (int j = 0; j < 4; ++j) { const f32x4 gg = gr[64 * j]; o[64 * j] = (f32x4){v[j].x * r * gg.x, v[j].y * r * gg.y, v[j].z * r * gg.z, v[j].w * r * gg.w}; }
    }
}

__device__ __forceinline__ void p_prologue(Frame& F) {
    const KArgs ap = kargs(); const auto& a = *ap; WS_OPAQUE(a);
    const int tid = otid(), lane = tid & 63, wave = __builtin_amdgcn_readfirstlane(tid >> 6);
    LAS float* scr = (LAS float*)(F.lds + RING_OFF + wave * 16384);
    const int gw = F.vcu * NWAVES + wave, NGW = F.G * NWAVES;
    if (a.pro_mask & PM_X) {
        float* X = (float*)(wsb + a.off[R_X]);
        for (int m = gw; m < RP; m += NGW) {
            const float* src = nullptr;
            if (m >= SROW0) src = GIN(a, I_XS) + (size_t)(m - SROW0) * D_MODEL;
            else { const int b = m / LPP, p = m % LPP; if (p >= PADF && p < PEND) { const int pos = p - PADF; src = pos < N_META ? GIN(a, I_META) + (size_t)pos * D_MODEL : GIN(a, I_XP) + ((size_t)b * SEQ + pos - N_META) * D_MODEL; } }
            GAS f32x4* o = (GAS f32x4*)(X + (size_t)m * D_MODEL) + lane;
#pragma unroll
            for (int j = 0; j < 4; ++j) o[64 * j] = src ? ((const GAS f32x4*)src)[lane + 64 * j] : (f32x4){0.f, 0.f, 0.f, 0.f};
        }
    }
    if (a.pro_mask & PM_WIN) {
        bf16* WT = (bf16*)(wsb + a.off[R_WIN]);
        constexpr int IPL = (D_MODEL / 64) * (ZN / 32);
        for (int it = gw; it < DEPTH * IPL; it += NGW) { const int l = it / IPL, r = it % IPL, kb = r / (ZN / 32), nb = r % (ZN / 32);
            transpose_item(GIN(a, I_WIN) + (size_t)l * D_MODEL * D_IN, D_IN, D_MODEL, WT + (size_t)l * ZN * D_MODEL, 32 * nb, 64 * kb, CmWin(), scr, lane); }
    }
    __syncthreads();
    if (a.pro_mask & PM_TABLES) s5_tables(F);
    __syncthreads();
    if (a.pro_mask & PM_WREST) pro_wrest(F);
    if (a.pro_mask & PM_WQS) pro_wqs(F);
    if (a.pro_mask & PM_PEERW) pro_peerw(F);
}

__global__ void __launch_bounds__(NTHR, 2) mk_fwd(Args args) {
    extern __shared__ __attribute__((aligned(16))) unsigned char lds[];
    Frame F;
    F.lds = (LAS unsigned char*)lds; F.MISC = (volatile LAS unsigned*)(F.lds + MISC_OFF);
    F.wv = __builtin_amdgcn_readfirstlane((int)threadIdx.x >> 6);
    F.G = gridDim.x; { const int bx = blockIdx.x; F.vcu = (F.G % 8 == 0) ? (bx % 8) * (F.G / 8) + bx / 8 : bx; }
    F.ctl = (gu32*)args.ws;
    for (int u = F.wv * 64 + lane_id(); u < (LDS_BYTES - LDSCTL_OFF) / 4; u += NTHR) ((LAS unsigned*)(F.lds + LDSCTL_OFF))[u] = 0u;
    __syncthreads();
    const int lo = args.ph_lo, hi = args.ph_hi;
    unsigned* barw = (unsigned*)(F.ctl + CW_BAR) + (size_t)args.bar_region * XCD_BAR_WORDS;
    XcdBarrier bar; bar.bar = barw; bar.x = 0; bar.st = nullptr; bar.wv = F.wv;
    if (hi - lo > 1) bar = xcd_barrier_post(barw, F.MISC + 8, F.wv);
#define IN(k) (lo <= (k) && (k) < hi)
#ifndef MK_REP
#define MK_REP -1
#endif
#define SEAM(k) do { if ((k) + 1 < hi) { xcd_barrier(bar); if ((MK_REP) == 300) xcd_barrier(bar); } } while (0)
#ifndef MK_REP
#define MK_REP -1
#endif
    if (IN(PH_PRO)) { for (int rep_ = 0; rep_ < ((MK_REP) == 200 ? 2 : 1); ++rep_) { p_prologue(F); __syncthreads(); } SEAM(PH_PRO); }
#ifndef MK_REP
#define MK_REP -1
#endif
#define REPEAT(ph) for (int rep_ = 0; rep_ < ((MK_REP) == (ph) ? 2 : 1); ++rep_)
    for (int l = 0; l < DEPTH; ++l) {
        const int pb = 1 + l * NPL;
        if (l == 0 && IN(pb + PL_NORM1)) { REPEAT(PL_NORM1) p_norm(F, l, I_N1); SEAM(pb + PL_NORM1); }
        if (IN(pb + PL_GEMM_IN)) {
            const KArgs ap = kargs(); const auto& a = *ap; WS_OPAQUE(a);
            pg8::Gemm g{(const pg8::bf16_t*)(wsb + a.off[R_XN]), (const pg8::bf16_t*)(wsb + a.off[R_WIN]) + (size_t)l * ZN * D_MODEL, RP, ZN, D_MODEL};
            pg8::StaticOrder S; S.init(RP, ZN, F.G, (int)blockIdx.x);
            pg8::EpiBf16<0> E{(pg8::bf16_t*)(wsb + a.off[R_Z]), ZN, nullptr, 0, 0, 1.f};
            REPEAT(PL_GEMM_IN) pg8::gemm_phase<pg8::EpiBf16<0>, pg8::StaticOrder, true, true>(F.lds + RING_OFF, g, S, E, F.wv);
            SEAM(pb + PL_GEMM_IN);
        }
        if (IN(pb + PL_ZPOST)) { REPEAT(103) p_s5_e(F, l); REPEAT(PL_ZPOST) p_zpost(F, l);     SEAM(pb + PL_ZPOST); }
        if (IN(pb + PL_LOCAL)) { REPEAT(104) p_gdn_chunk<0>(F, l, 0); SEAM(pb + PL_LOCAL); }
        if (IN(pb + PL_MIX)) {
            REPEAT(100) p_gdn_chain(F, l);
            REPEAT(102) { const int tid = otid(), lane = tid & 63, wave = __builtin_amdgcn_readfirstlane(tid >> 6), NGW = F.G * NWAVES;
              for (int t = (F.vcu * NWAVES + wave + NGW - 256) % NGW; t < S5_NTASK; t += NGW) s5_scan_run(F, l, t, lane); }
            REPEAT(101) p_attention(F, l + DEPTH * rep_, lds);
            SEAM(pb + PL_MIX); }
        if (IN(pb + PL_MIXPOST)) { REPEAT(PL_MIXPOST) { p_mixpost_a(F, l); p_mixpost_b(F, l); p_s5_out(F, l); } SEAM(pb + PL_MIXPOST); }
        if (IN(pb + PL_GEMM_GLU)) REPEAT(PL_GEMM_GLU) {
            const KArgs ap = kargs(); const auto& a = *ap; WS_OPAQUE(a);
            { pg8::Gemm g{(const pg8::bf16_t*)(wsb + a.off[R_YC]), (const pg8::bf16_t*)(wsb + a.off[R_WGLU]) + (size_t)l * 1024 * 512, RP, 1024, 512};
              pg8::StaticOrder S; S.init(RP, 1024, F.G, (int)blockIdx.x); pg8::EpiGlu E{(pg8::bf16_t*)(wsb + a.off[R_OC]), WIDTH_C};
              pg8::gemm_phase<pg8::EpiGlu, pg8::StaticOrder, true, true>(F.lds + RING_OFF, g, S, E, F.wv); }
            { pg8::Gemm g{(const pg8::bf16_t*)(wsb + a.off[R_OA]), (const pg8::bf16_t*)(wsb + a.off[R_WBR]) + ((size_t)l * 3 + 0) * 1024 * 512, RP, 1024, 512};
              pg8::StaticOrder S; S.init(RP, 1024, F.G, (int)((blockIdx.x + 16) % F.G)); pg8::EpiMerge<0> E{(float*)(wsb + a.off[R_MRG]), nullptr, nullptr, (const pg8::bf16_t*)(wsb + a.off[R_Z]) + ZC_GATE, ZN};
              pg8::gemm_phase<pg8::EpiMerge<0>, pg8::StaticOrder, true, true>(F.lds + RING_OFF, g, S, E, F.wv); }
            { pg8::Gemm g{(const pg8::bf16_t*)(wsb + a.off[R_OBN]), (const pg8::bf16_t*)(wsb + a.off[R_WBR]) + ((size_t)l * 3 + 1) * 1024 * 512, RP, 1024, 512};
              pg8::StaticOrder S; S.init(RP, 1024, F.G, (int)((blockIdx.x + 32) % F.G)); pg8::EpiMerge<0> E{(float*)(wsb + a.off[R_MRG2]), nullptr, nullptr, (const pg8::bf16_t*)(wsb + a.off[R_Z]) + ZC_GATE + 1024, ZN};
              pg8::gemm_phase<pg8::EpiMerge<0>, pg8::StaticOrder, true, true>(F.lds + RING_OFF, g, S, E, F.wv); }
            if (rep_ == ((MK_REP) == PL_GEMM_GLU ? 1 : 0)) SEAM(pb + PL_GEMM_GLU); }
        if (IN(pb + PL_GEMM_BRC)) {
            const KArgs ap = kargs(); const auto& a = *ap; WS_OPAQUE(a);
            pg8::Gemm g{(const pg8::bf16_t*)(wsb + a.off[R_OC]), (const pg8::bf16_t*)(wsb + a.off[R_WBR]) + ((size_t)l * 3 + 2) * 1024 * 512, RP, 1024, 512};
            pg8::StaticOrder S; S.init(RP, 1024, F.G, (int)blockIdx.x); pg8::EpiMerge<2> E{(float*)(wsb + a.off[R_MRG]), (const float*)(wsb + a.off[R_MRG2]), (pg8::bf16_t*)(wsb + a.off[R_MRGB]), (const pg8::bf16_t*)(wsb + a.off[R_Z]) + ZC_GATE + 2048, ZN};
            REPEAT(PL_GEMM_BRC) pg8::gemm_phase<pg8::EpiMerge<2>, pg8::StaticOrder, true, true>(F.lds + RING_OFF, g, S, E, F.wv);
            SEAM(pb + PL_GEMM_BRC); }
        if (IN(pb + PL_GEMM_OUT)) {
            const KArgs ap = kargs(); const auto& a = *ap; WS_OPAQUE(a);
            pg8::Gemm g{(const pg8::bf16_t*)(wsb + a.off[R_MRGB]), (const pg8::bf16_t*)(wsb + a.off[R_WOUT]) + (size_t)l * 1024 * 1024, RP, 1024, 1024};
            pg8::StaticOrder S; S.init(RP, 1024, F.G, (int)blockIdx.x);
            REPEAT(PL_GEMM_OUT) { pg8::EpiResid E{(float*)(wsb + a.off[R_X]), D_MODEL, (MK_REP) == PL_GEMM_OUT && rep_ == 0, (pg8::bf16_t*)(wsb + a.off[R_XN])};
            pg8::gemm_phase<pg8::EpiResid, pg8::StaticOrder, true, true>(F.lds + RING_OFF, g, S, E, F.wv); }
            SEAM(pb + PL_GEMM_OUT); }
        if (IN(pb + PL_GEMM_PEER)) {
            const KArgs ap = kargs(); const auto& a = *ap; WS_OPAQUE(a);
            pg8::Gemm g{(const pg8::bf16_t*)(wsb + a.off[R_XN]), (const pg8::bf16_t*)(wsb + a.off[R_WQS]) + (size_t)l * PQ * D_MODEL, RP, PQ, D_MODEL};
            pg8::StaticOrder S; S.init(RP, PQ, F.G, (int)blockIdx.x); pg8::EpiF32 E{(float*)(wsb + a.off[R_SC]), PQ};
            REPEAT(PL_GEMM_PEER) pg8::gemm_phase<pg8::EpiF32, pg8::StaticOrder, true, true>(F.lds + RING_OFF, g, S, E, F.wv);
            SEAM(pb + PL_GEMM_PEER); }
        if (IN(pb + PL_PEER)) { REPEAT(PL_PEER) p_peer(F, l, (MK_REP) == PL_PEER && rep_ == 0); SEAM(pb + PL_PEER); }
    }
#undef IN
#undef SEAM
}
}
#ifndef MK_ONE_LAUNCH
#define MK_ONE_LAUNCH 1
#endif
static int mk_grid = 0;
static bool mk_setup() {
    if (mk_grid) return mk_grid > 0;
    int dev = 0, cus = 0;
    if (hipGetDevice(&dev) != hipSuccess || hipDeviceGetAttribute(&cus, hipDeviceAttributeMultiprocessorCount, dev) != hipSuccess) { mk_grid = -1; return false; }
    if (hipFuncSetAttribute((const void*)mk::mk_fwd, hipFuncAttributeMaxDynamicSharedMemorySize, mk::LDS_BYTES) != hipSuccess) { fprintf(stderr, "kernel_launch: hipFuncSetAttribute failed\n"); mk_grid = -1; return false; }
    int per_cu = 0;
    if (hipOccupancyMaxActiveBlocksPerMultiprocessor(&per_cu, (const void*)mk::mk_fwd, mk::NTHR, mk::LDS_BYTES) != hipSuccess || per_cu < 1) { fprintf(stderr, "kernel_launch: occupancy query says %d workgroups per CU\n", per_cu); }
    (void)hipGetLastError();
    mk_grid = cus;
    return true;
}
static void mk_launch(mk::Args a, int lo, int hi, int region, hipStream_t stream) {
    a.ph_lo = lo; a.ph_hi = hi; a.bar_region = region;
    hipLaunchKernelGGL(mk::mk_fwd, dim3(mk_grid), dim3(mk::NTHR), mk::LDS_BYTES, stream, a);
    hipError_t e = hipPeekAtLastError(); if (e != hipSuccess) fprintf(stderr, "kernel_launch: launch failed: %s\n", hipGetErrorName(e));
}
extern "C" void kernel_launch(void* const* d_in, const int* in_sizes, int n_in, void* d_out, int out_size, void* d_ws, size_t ws_size, hipStream_t stream) {
    if (n_in != N_INPUTS || (size_t)out_size != (size_t)O_END) { fprintf(stderr, "kernel_launch: unexpected n_in %d / out_size %d\n", n_in, out_size); return; }
    if (!mk_setup()) return;
    const size_t MiB = 1u << 20;
    unsigned char* ws = (unsigned char*)d_ws;
    mk::Args a{};
    for (int i = 0; i < N_INPUTS; ++i) a.in[i] = (const float*)d_in[i];
    a.out = (float*)d_out; a.ws = ws;
    { using namespace mk; const struct { int r; size_t mib; } map[] = { {R_WIN, 1}, {R_WGLU, 59}, {R_WBR, 63}, {R_WOUT, 75}, {R_WQS, 83}, {R_S5T, 99}, {R_PU, 132}, {R_PV, 196}, {R_MISC, 260}, {R_OBN, 262}, {R_MRG2, 280}, {R_X, 388}, {R_XN, 456},
        {R_Z, 490}, {R_SC, 490}, {R_QN, 737}, {R_KN, 754}, {R_QKVB, 771}, {R_BG, 822}, {R_O, 823}, {R_MRGB, 823}, {R_OA, 857}, {R_OB, 874}, {R_GDN, 891}, {R_MRG, 891},
        {R_S5E, 986}, {R_YC, 986}, {R_S5X, 1003}, {R_OC, 1012} };
      for (auto& e : map) a.off[e.r] = e.mib * MiB; }
    if (1029 * MiB > ws_size) { fprintf(stderr, "kernel_launch: workspace too small (%zu)\n", ws_size); return; }
    if (hipMemsetAsync(ws, 0, mk::CTL_BYTES, stream) != hipSuccess) { fprintf(stderr, "kernel_launch: memset failed\n"); return; }
    a.pro_mask = mk::PM_X | mk::PM_WIN | mk::PM_TABLES | mk::PM_WREST | mk::PM_WQS | mk::PM_PEERW;
#if MK_ONE_LAUNCH
    mk_launch(a, 0, mk::PH_END, 0, stream);
#else
    int region = 0;
    mk_launch(a, mk::PH_PRO, mk::PH_PRO + 1, region++, stream);
    for (int l = 0; l < DEPTH; ++l) { const int pb = 1 + l * mk::NPL;
        for (int ph = mk::PL_NORM1; ph <= mk::PL_PEER; ++ph) { if (ph == mk::PL_GEMM_BRA || ph == mk::PL_GEMM_BRB) continue; mk_launch(a, pb + ph, pb + ph + 1, region++, stream); } }
    mk_launch(a, mk::PH_FINAL, mk::PH_END, region++, stream);
#endif
}
```

```cpp
#include <hip/hip_runtime.h>
#include <cstdio>
#include <cstdint>
#include <utility>
#define MK_ONE_LAUNCH 1
#ifndef D_MODEL
#define D_MODEL 1024
#define BATCH 2
#define SEQ 8192
#define DEPTH 4
#define DEC_BATCH 16
#define DEC_SEQ 32
#define PAST_LEN 1024
#define N_HEADS_A 4
#define HEAD_DIM_A 64
#define N_HEADS_B 4
#define HEAD_DIM_B 128
#define S5_GROUPS 32
#define S5_STATE 64
#define PEER_HEADS 8
#define PEER_QDIM 256
#define N_KEYS 128
#endif
#define CHUNK 64
#define N_META 16
#define EPSF 1e-6f
#define NUM_BUCKETS 32
#define CONV_W 4
#define S5_GROUP 16
#define PEER_TOPK 16
#define N_EXPERTS (N_KEYS * N_KEYS)
#define WIDTH_A (N_HEADS_A * 2 * HEAD_DIM_A)
#define WIDTH_B (N_HEADS_B * HEAD_DIM_B)
#define WIDTH_C (S5_GROUPS * S5_GROUP)
#define OFF_QA 0
#define OFF_KA (OFF_QA + WIDTH_A)
#define OFF_VA (OFF_KA + WIDTH_A)
#define OFF_QKVB (OFF_VA + WIDTH_A)
#define OFF_GB (OFF_QKVB + 3 * WIDTH_B)
#define OFF_BETA (OFF_GB + WIDTH_B)
#define OFF_ALPHA (OFF_BETA + N_HEADS_B)
#define OFF_UC (OFF_ALPHA + N_HEADS_B)
#define OFF_GATE (OFF_UC + WIDTH_C)
#define D_IN (OFF_GATE + 3 * D_MODEL)
#define LP (N_META + SEQ)
#define NP (BATCH * LP)
#define NS (DEC_BATCH * DEC_SEQ)
#define NT (NP + NS)
#define PQ (PEER_HEADS * PEER_QDIM)

enum { I_XP, I_XS, I_CK, I_CV, I_SCONV, I_SDELTA, I_SRE, I_SIM, I_META, I_REL, I_N1, I_N2, I_FN, I_WIN, I_QN, I_KN, I_LQK, I_SUBLN, I_CONVW, I_ALOG, I_DTB, I_GDNN,
       I_AR, I_AI, I_BR, I_BI, I_CR, I_CI, I_SD, I_LDT, I_WGLU, I_WBA, I_WBB, I_WBC, I_WOUT, I_PWQ, I_PSK, I_PU, I_PV, N_INPUTS };
#define O_YP 0
#define O_YS (O_YP + (size_t)BATCH * SEQ * D_MODEL)
#define O_KP (O_YS + (size_t)NS * D_MODEL)
#define O_VP (O_KP + (size_t)DEPTH * NP * WIDTH_A)
#define O_KS (O_VP + (size_t)DEPTH * NP * WIDTH_A)
#define O_VS (O_KS + (size_t)DEPTH * NS * WIDTH_A)
#define O_CP (O_VS + (size_t)DEPTH * NS * WIDTH_A)
#define O_CS (O_CP + (size_t)DEPTH * BATCH * (CONV_W - 1) * 3 * WIDTH_B)
#define O_DP (O_CS + (size_t)DEPTH * DEC_BATCH * (CONV_W - 1) * 3 * WIDTH_B)
#define O_DS (O_DP + (size_t)DEPTH * BATCH * N_HEADS_B * HEAD_DIM_B * HEAD_DIM_B)
#define O_SRP (O_DS + (size_t)DEPTH * DEC_BATCH * N_HEADS_B * HEAD_DIM_B * HEAD_DIM_B)
#define O_SIP (O_SRP + (size_t)DEPTH * BATCH * S5_GROUPS * S5_STATE)
#define O_SRS (O_SIP + (size_t)DEPTH * BATCH * S5_GROUPS * S5_STATE)
#define O_SIS (O_SRS + (size_t)DEPTH * DEC_BATCH * S5_GROUPS * S5_STATE)
#define O_END (O_SIS + (size_t)DEPTH * DEC_BATCH * S5_GROUPS * S5_STATE)

namespace pg8 {
#define PG8_LAS __attribute__((address_space(3)))
typedef unsigned short bf16_t;
typedef short bf16x8 __attribute__((ext_vector_type(8)));
typedef float f32x4 __attribute__((ext_vector_type(4)));
typedef unsigned u32x4 __attribute__((ext_vector_type(4)));
constexpr int BM = 256, BK = 64, HALF = 128, HTB = HALF * BK * 2  , STAGE_BYTES = 8 * HTB, NXCD = 8, WGM = 8;

__host__ __device__ __forceinline__ int lds_byte(int r, int c) { const int st = (r >> 4) * 2 + (c >> 5), rr = r & 15, cc = c & 31, ob = rr * 64 + cc * 2; return st * 1024 + (ob ^ (((ob >> 9) & 1) << 5)); }
__host__ __device__ __forceinline__ void stage_rc(int b, int& R, int& C) { const int st = b / 1024, sb = b % 1024, swz = sb ^ (((sb >> 9) & 1) << 5); R = (st >> 1) * 16 + swz / 64; C = (st & 1) * 32 + (swz % 64) / 2; }
__host__ __device__ __forceinline__ int perm32(int rho) { const int n = rho >> 4, i = rho & 15; return 8 * (i >> 2) + 4 * n + (i & 3); }

struct Unit { int pm, pn; };
struct Gemm { const bf16_t* A; const bf16_t* Bt; int M, N, K; };

struct StaticOrder {
    int nM, nN, nwg, G, c;
    __host__ __device__ void init(int M, int N, int G_, int c_) { nM = M / BM; nN = N / BM; nwg = nM * nN; G = G_; c = c_; }
    __host__ __device__ bool next(int i, Unit& u) const {
        const long L = (long)i * G + c; if (L >= nwg) return false;
        int wgid = (int)L; { const int q = nwg / NXCD, r = nwg % NXCD, xcd = wgid % NXCD, off = wgid / NXCD; wgid = (xcd < r ? xcd * (q + 1) : r * (q + 1) + (xcd - r) * q) + off; }
        const int nig = WGM * nN, gid = wgid / nig, fm = gid * WGM, gsz = (nM - fm) < WGM ? (nM - fm) : WGM;
        u.pm = fm + ((wgid % nig) % gsz); u.pn = (wgid % nig) / gsz; return true;
    }
    __device__ __forceinline__ void a_ready(const Unit&) const {}
    __device__ __forceinline__ void done(const Unit&) const {}
};

__device__ __forceinline__ unsigned cvt_pk_bf16(float lo, float hi) { unsigned r; asm volatile("v_cvt_pk_bf16_f32 %0, %1, %2" : "=v"(r) : "v"(lo), "v"(hi)); return r; }
typedef float f32x2 __attribute__((ext_vector_type(2)));
__device__ __forceinline__ f32x2 gelu_pk(f32x2 v) {
    const f32x2 av = __builtin_elementwise_abs(v), d = av * 0.2316418882f + 1.0f;
    f32x2 t; t.x = __builtin_amdgcn_rcpf(d.x); t.y = __builtin_amdgcn_rcpf(d.y);
    f32x2 q = t * 0.5307027145f + (-0.7265760135f); q = q * t + 0.7107068705f; q = q * t + (-0.142248368f); q = q * t + 0.127414796f; q = q * t;
    const f32x2 s = (v * v) * (-0.72134752044f);
    f32x2 e; e.x = __builtin_amdgcn_exp2f(s.x); e.y = __builtin_amdgcn_exp2f(s.y);
    const f32x2 m = v * (q * e), r = v - m;
    f32x2 o; o.x = v.x < 0.f ? m.x : r.x; o.y = v.y < 0.f ? m.y : r.y; return o;
}

template <int ACT  > struct EpiBf16 {
    static constexpr bool PERM = true, AFTER_DRAIN = false; static_assert(ACT == 0 || ACT == 1, "EpiBf16: ACT is 0 (none) or 1 (gelu_pk)");
    bf16_t* O; int ldc; const float* bias; int split_cols; size_t split_stride; float scale0;
    __device__ __forceinline__ void operator()(const f32x4 (&acc)[2][2][4][2], const Unit& u, int wr, int wc, int fr, int fq) const {
        const int row0 = u.pm * BM + wr * 64 + fr; int colt = u.pn * BM; bf16_t* base = O;
        float sc = 1.f; if (split_cols) { const int t = colt / split_cols; base += (size_t)t * split_stride; colt -= t * split_cols; if (t == 0) sc = scale0; }
        const int col0 = colt + wc * 32 + 8 * fq, bcol0 = u.pn * BM + wc * 32 + 8 * fq;
        f32x4 bv[2][2];
#pragma unroll
        for (int bj = 0; bj < 2; ++bj)
#pragma unroll
            for (int n = 0; n < 2; ++n) bv[bj][n] = bias ? *(const f32x4*)(bias + bcol0 + bj * HALF + 4 * n) : (f32x4){0.f, 0.f, 0.f, 0.f};
#pragma unroll
        for (int ai = 0; ai < 2; ++ai)
#pragma unroll
            for (int m = 0; m < 4; ++m) { bf16_t* rowp = base + (size_t)(row0 + ai * HALF + m * 16) * ldc + col0;
#pragma unroll
                for (int bj = 0; bj < 2; ++bj) { f32x4 v0 = acc[ai][bj][m][0] + bv[bj][0], v1 = acc[ai][bj][m][1] + bv[bj][1];
                    if (ACT == 1) { f32x2 a = gelu_pk((f32x2){v0[0], v0[1]}), b = gelu_pk((f32x2){v0[2], v0[3]}), c = gelu_pk((f32x2){v1[0], v1[1]}), d = gelu_pk((f32x2){v1[2], v1[3]});
                        v0 = (f32x4){a.x, a.y, b.x, b.y}; v1 = (f32x4){c.x, c.y, d.x, d.y}; }
                    v0 = v0 * sc; v1 = v1 * sc; u32x4 w; w.x = cvt_pk_bf16(v0[0], v0[1]); w.y = cvt_pk_bf16(v0[2], v0[3]); w.z = cvt_pk_bf16(v1[0], v1[1]); w.w = cvt_pk_bf16(v1[2], v1[3]);
                    *(u32x4*)(rowp + bj * HALF) = w; } }
    }
};

__device__ __forceinline__ float epi_sigm(float x) { return __builtin_amdgcn_rcpf(1.f + __expf(-x)); }
struct EpiGlu {
    static constexpr bool PERM = false, AFTER_DRAIN = false;
    bf16_t* O; int ldo;
    __device__ __forceinline__ void operator()(const f32x4 (&acc)[2][2][4][2], const Unit& u, int wr, int wc, int fr, int fq) const {
        const int row0 = u.pm * BM + wr * 64 + fr;
#pragma unroll
        for (int ai = 0; ai < 2; ++ai)
#pragma unroll
            for (int m = 0; m < 4; ++m) { bf16_t* rowp = O + (size_t)(row0 + ai * HALF + m * 16) * ldo + 4 * fq;
#pragma unroll
                for (int bj = 0; bj < 2; ++bj) { const int G = u.pn * 8 + bj * 4 + wc; const f32x4 av = acc[ai][bj][m][0], gv = acc[ai][bj][m][1];
                    typedef unsigned u32x2 __attribute__((ext_vector_type(2))); u32x2 w;
                    w.x = cvt_pk_bf16(av[0] * epi_sigm(gv[0]), av[1] * epi_sigm(gv[1])); w.y = cvt_pk_bf16(av[2] * epi_sigm(gv[2]), av[3] * epi_sigm(gv[3]));
                    *(u32x2*)(rowp + 16 * G) = w; } }
    }
};
template <int MODE> struct EpiMerge {
    static constexpr bool PERM = true, AFTER_DRAIN = false;
    bf16_t* M; const bf16_t* M2; bf16_t* Mb; const bf16_t* Zg; int ldz;
    __device__ __forceinline__ void operator()(const f32x4 (&acc)[2][2][4][2], const Unit& u, int wr, int wc, int fr, int fq) const {
        const int row0 = u.pm * BM + wr * 64 + fr, col0 = u.pn * BM + wc * 32 + 8 * fq;
#pragma unroll
        for (int ai = 0; ai < 2; ++ai)
#pragma unroll
            for (int m = 0; m < 4; ++m) { const size_t row = (size_t)(row0 + ai * HALF + m * 16);
#pragma unroll
                for (int bj = 0; bj < 2; ++bj) { const int col = col0 + bj * HALF;
                    const u32x4 gz = *(const u32x4*)(Zg + row * ldz + col);
                    float g[8]; g[0] = __builtin_bit_cast(float, gz.x << 16); g[1] = __builtin_bit_cast(float, gz.x & 0xffff0000u); g[2] = __builtin_bit_cast(float, gz.y << 16); g[3] = __builtin_bit_cast(float, gz.y & 0xffff0000u);
                    g[4] = __builtin_bit_cast(float, gz.z << 16); g[5] = __builtin_bit_cast(float, gz.z & 0xffff0000u); g[6] = __builtin_bit_cast(float, gz.w << 16); g[7] = __builtin_bit_cast(float, gz.w & 0xffff0000u);
                    f32x4 v0 = acc[ai][bj][m][0], v1 = acc[ai][bj][m][1];
#pragma unroll
                    for (int j = 0; j < 4; ++j) { v0[j] *= epi_sigm(g[j]); v1[j] *= epi_sigm(g[4 + j]); }
                    if (MODE == 0) { u32x4 w; w.x = cvt_pk_bf16(v0[0], v0[1]); w.y = cvt_pk_bf16(v0[2], v0[3]); w.z = cvt_pk_bf16(v1[0], v1[1]); w.w = cvt_pk_bf16(v1[2], v1[3]); *(u32x4*)(M + row * 1024 + col) = w; }
                    else { const u32x4 pa = *(const u32x4*)(M + row * 1024 + col), pb = *(const u32x4*)(M2 + row * 1024 + col);
#define EPI_LO(w) __builtin_bit_cast(float, (w) << 16)
#define EPI_HI(w) __builtin_bit_cast(float, (w) & 0xffff0000u)
                        v0[0] += EPI_LO(pa.x) + EPI_LO(pb.x); v0[1] += EPI_HI(pa.x) + EPI_HI(pb.x); v0[2] += EPI_LO(pa.y) + EPI_LO(pb.y); v0[3] += EPI_HI(pa.y) + EPI_HI(pb.y);
                        v1[0] += EPI_LO(pa.z) + EPI_LO(pb.z); v1[1] += EPI_HI(pa.z) + EPI_HI(pb.z); v1[2] += EPI_LO(pa.w) + EPI_LO(pb.w); v1[3] += EPI_HI(pa.w) + EPI_HI(pb.w);
#undef EPI_LO
#undef EPI_HI
                        u32x4 w; w.x = cvt_pk_bf16(v0[0], v0[1]); w.y = cvt_pk_bf16(v0[2], v0[3]); w.z = cvt_pk_bf16(v1[0], v1[1]); w.w = cvt_pk_bf16(v1[2], v1[3]); *(u32x4*)(Mb + row * 1024 + col) = w; } } }
    }
};
struct EpiResid {
    static constexpr bool PERM = false, AFTER_DRAIN = false;
    float* X; int ldx; bool dry; bf16_t* Xb;
    __device__ __forceinline__ void operator()(const f32x4 (&acc)[2][2][4][2], const Unit& u, int wr, int wc, int fr, int fq) const {
        const int row0 = u.pm * BM + wr * 64 + fr, col0 = u.pn * BM + wc * 32 + 4 * fq;
#pragma unroll
        for (int ai = 0; ai < 2; ++ai)
#pragma unroll
            for (int m = 0; m < 4; ++m) { const int row = row0 + ai * HALF + m * 16;
                bool ok = true; if (row < 16896) { const int p = row % 8448; ok = p >= 48 && p < 8256; }
                if (ok && !dry) { float* rowp = X + (size_t)row * ldx + col0;
#pragma unroll
                    for (int bj = 0; bj < 2; ++bj)
#pragma unroll
                        for (int n = 0; n < 2; ++n) { f32x4* p4 = (f32x4*)(rowp + bj * HALF + n * 16); const f32x4 v = *p4 + acc[ai][bj][m][n]; *p4 = v;
                            typedef unsigned u32x2 __attribute__((ext_vector_type(2))); u32x2 w; w.x = cvt_pk_bf16(v[0], v[1]); w.y = cvt_pk_bf16(v[2], v[3]);
                            *(u32x2*)(Xb + (size_t)row * ldx + col0 + bj * HALF + n * 16) = w; } } }
    }
};
struct EpiF32 {
    static constexpr bool PERM = false, AFTER_DRAIN = false;
    float* C; int ldc;
    __device__ __forceinline__ void operator()(const f32x4 (&acc)[2][2][4][2], const Unit& u, int wr, int wc, int fr, int fq) const {
        const int row0 = u.pm * BM + wr * 64 + fr, col0 = u.pn * BM + wc * 32 + 4 * fq;
#pragma unroll
        for (int ai = 0; ai < 2; ++ai)
#pragma unroll
            for (int m = 0; m < 4; ++m) { float* rowp = C + (size_t)(row0 + ai * HALF + m * 16) * ldc + col0;
#pragma unroll
                for (int bj = 0; bj < 2; ++bj)
#pragma unroll
                    for (int n = 0; n < 2; ++n) *(f32x4*)(rowp + bj * HALF + n * 16) = acc[ai][bj][m][n]; }
    }
};

template <class Epi, class Sched, bool ALIGN_EPI = false, bool SP2 = false>
__device__ __forceinline__ void gemm_phase(PG8_LAS unsigned char* lds, const Gemm g, const Sched& S, const Epi& E, int wv) {
    unsigned om_ = ~0u; asm volatile("" : "+s"(om_), "+s"(wv)); int tid_ = wv * 64 + (int)__builtin_amdgcn_mbcnt_hi(om_, __builtin_amdgcn_mbcnt_lo(om_, 0u));
    const int tid = tid_, wid = __builtin_amdgcn_readfirstlane(tid >> 6), lane = tid & 63, wr = wid >> 2, wc = wid & 3, fr = lane & 15, fq = lane >> 4;
    const int K = g.K, nt = K / BK;
    unsigned voffA[2], voffB[2];
#pragma unroll
    for (int i = 0; i < 2; ++i) { int R, C; stage_rc(tid * 16 + i * 8192, R, C); const int Rb = Epi::PERM ? ((R & ~31) + perm32(R & 31)) : R;
        voffA[i] = (unsigned)(R * K + C) * 2u; voffB[i] = (unsigned)(Rb * K + C) * 2u; }
    const size_t kstep = (size_t)(BK * 2);
    const size_t hstep = (size_t)HALF * K * 2;
    const size_t tstep = 2 * hstep;
    const unsigned ldsw = (unsigned)wid * 1024u;
    const int aoff = lds_byte(wr * 64 + fr, fq * 8), boff = lds_byte(wc * 32 + fr, fq * 8);
#define PG8_SA(b, h) (((b) * 2 + (h)) * HTB)
#define PG8_SB(b, h) ((4 + (b) * 2 + (h)) * HTB)
#define PG8_STAGE(bufoff, gbase, voff) do { _Pragma("unroll") for (int _i = 0; _i < 2; ++_i) \
        __builtin_amdgcn_global_load_lds((const unsigned*)((const char*)(gbase) + (voff)[_i]), (PG8_LAS unsigned*)(lds + (bufoff) + ldsw + _i * 8192), 16, 0, 0); } while (0)
#define PG8_LDA(dst, b, h) do { _Pragma("unroll") for (int m = 0; m < 4; ++m) _Pragma("unroll") for (int k = 0; k < 2; ++k) dst[m][k] = *(const PG8_LAS bf16x8*)(lds + PG8_SA(b, h) + aoff + m * 2048 + k * 1024); } while (0)
#define PG8_LDB(dst, b, h) do { _Pragma("unroll") for (int n = 0; n < 2; ++n) _Pragma("unroll") for (int k = 0; k < 2; ++k) dst[n][k] = *(const PG8_LAS bf16x8*)(lds + PG8_SB(b, h) + boff + n * 2048 + k * 1024); } while (0)
#define PG8_MMA(ai, bj, At, Bt) do { __builtin_amdgcn_s_setprio(1); _Pragma("unroll") for (int m = 0; m < 4; ++m) _Pragma("unroll") for (int n = 0; n < 2; ++n) _Pragma("unroll") for (int k = 0; k < 2; ++k) \
        acc[ai][bj][m][n] = __builtin_amdgcn_mfma_f32_16x16x32_bf16(Bt[n][k], At[m][k], acc[ai][bj][m][n], 0, 0, 0); __builtin_amdgcn_s_setprio(0); } while (0)
#define PG8_WAIT_V(n) asm volatile("s_waitcnt vmcnt(" #n ")" ::: "memory")
#define PG8_WAIT_L(n) asm volatile("s_waitcnt lgkmcnt(" #n ")" ::: "memory")
#define PG8_BAR __builtin_amdgcn_s_barrier()
#define PG8_SCHED __builtin_amdgcn_sched_barrier(0)
    Unit cur, nxt; int ui = 0;
    if (!S.next(0, cur)) return;
    f32x4 acc[2][2][4][2];
#pragma unroll
    for (int a = 0; a < 2; ++a)
#pragma unroll
        for (int b = 0; b < 2; ++b)
#pragma unroll
            for (int m = 0; m < 4; ++m)
#pragma unroll
                for (int n = 0; n < 2; ++n) acc[a][b][m][n] = (f32x4){0.f, 0.f, 0.f, 0.f};
    bf16x8 At[4][2], B0[2][2], B1[2][2];
    const char* cA = (const char*)g.A + (size_t)cur.pm * tstep; const char* cB = (const char*)g.Bt + (size_t)cur.pn * tstep;
    S.a_ready(cur);
    if constexpr (SP2) {
        PG8_STAGE(PG8_SB(0, 0), cB, voffB); PG8_STAGE(PG8_SB(0, 1), cB + hstep, voffB); PG8_STAGE(PG8_SA(0, 0), cA, voffA); PG8_STAGE(PG8_SA(0, 1), cA + hstep, voffA);
        if (wr == 1) PG8_BAR;
        PG8_WAIT_V(2); PG8_BAR;
        PG8_STAGE(PG8_SB(1, 0), cB + kstep, voffB); PG8_STAGE(PG8_SA(1, 0), cA + kstep, voffA); PG8_STAGE(PG8_SB(1, 1), cB + hstep + kstep, voffB);
        PG8_WAIT_V(6); PG8_BAR;
    } else {
        PG8_STAGE(PG8_SB(0, 0), cB, voffB); PG8_STAGE(PG8_SA(0, 0), cA, voffA); PG8_STAGE(PG8_SB(0, 1), cB + hstep, voffB); PG8_STAGE(PG8_SA(0, 1), cA + hstep, voffA);
        if (wr == 1) PG8_BAR;
        PG8_WAIT_V(4); PG8_BAR;
        PG8_STAGE(PG8_SB(1, 0), cB + kstep, voffB); PG8_STAGE(PG8_SA(1, 0), cA + kstep, voffA); PG8_STAGE(PG8_SB(1, 1), cB + hstep + kstep, voffB);
        PG8_WAIT_V(6); PG8_BAR;
    }
    for (;;) {
        const bool has_next = S.next(ui + 1, nxt);
        const char* nA = has_next ? (const char*)g.A + (size_t)nxt.pm * tstep : cA; const char* nB = has_next ? (const char*)g.Bt + (size_t)nxt.pn * tstep : cB;
        for (int t = 0; t < nt; t += 2) {
            const bool last = (t == nt - 2);
            const char* a1 = cA + (size_t)(t + 1) * kstep;
            const char* a2 = last ? nA : cA + (size_t)(t + 2) * kstep; const char* b2 = last ? nB : cB + (size_t)(t + 2) * kstep;
            const char* a3 = a2 + kstep; const char* b3 = b2 + kstep;
            if (last && has_next) S.a_ready(nxt);
            if constexpr (SP2) {
            PG8_LDB(B0, 0, 0); PG8_LDB(B1, 0, 1); PG8_SCHED; PG8_LDA(At, 0, 0); PG8_STAGE(PG8_SA(1, 1), a1 + hstep, voffA);
            PG8_WAIT_V(8); PG8_WAIT_L(0); PG8_BAR; PG8_MMA(0, 0, At, B0); PG8_MMA(0, 1, At, B1); PG8_BAR; PG8_SCHED;
            PG8_LDA(At, 0, 1); PG8_STAGE(PG8_SB(0, 0), b2, voffB); PG8_STAGE(PG8_SB(0, 1), b2 + hstep, voffB); PG8_STAGE(PG8_SA(0, 0), a2, voffA);
            PG8_WAIT_V(8); PG8_WAIT_L(0); PG8_BAR; PG8_MMA(1, 0, At, B0); PG8_MMA(1, 1, At, B1); PG8_BAR; PG8_SCHED;
            PG8_LDB(B0, 1, 0); PG8_LDB(B1, 1, 1); PG8_SCHED; PG8_LDA(At, 1, 0); PG8_STAGE(PG8_SA(0, 1), a2 + hstep, voffA);
            PG8_WAIT_V(8); PG8_WAIT_L(0); PG8_BAR; PG8_MMA(0, 0, At, B0); PG8_MMA(0, 1, At, B1); PG8_BAR; PG8_SCHED;
            PG8_LDA(At, 1, 1); PG8_STAGE(PG8_SB(1, 0), b3, voffB); PG8_STAGE(PG8_SB(1, 1), b3 + hstep, voffB); PG8_STAGE(PG8_SA(1, 0), a3, voffA);
            PG8_WAIT_V(8); PG8_WAIT_L(0); PG8_BAR; PG8_MMA(1, 0, At, B0); PG8_MMA(1, 1, At, B1); PG8_BAR; PG8_SCHED;
            } else {
            PG8_LDB(B0, 0, 0); PG8_SCHED; PG8_LDA(At, 0, 0); PG8_STAGE(PG8_SA(1, 1), a1 + hstep, voffA);
            PG8_WAIT_L(8); PG8_BAR; PG8_WAIT_L(0); PG8_MMA(0, 0, At, B0); PG8_BAR; PG8_SCHED;
            PG8_LDB(B1, 0, 1); PG8_STAGE(PG8_SB(0, 0), b2, voffB);
            PG8_BAR; PG8_WAIT_L(0); PG8_MMA(0, 1, At, B1); PG8_BAR;
            PG8_LDA(At, 0, 1); PG8_STAGE(PG8_SA(0, 0), a2, voffA);
            PG8_BAR; PG8_WAIT_L(0); PG8_MMA(1, 0, At, B0); PG8_BAR; PG8_SCHED;
            PG8_STAGE(PG8_SB(0, 1), b2 + hstep, voffB);
            PG8_WAIT_V(6); PG8_BAR; PG8_MMA(1, 1, At, B1); PG8_BAR;
            PG8_LDB(B0, 1, 0); PG8_SCHED; PG8_LDA(At, 1, 0); PG8_STAGE(PG8_SA(0, 1), a2 + hstep, voffA);
            PG8_WAIT_L(8); PG8_BAR; PG8_WAIT_L(0); PG8_MMA(0, 0, At, B0); PG8_BAR; PG8_SCHED;
            PG8_LDB(B1, 1, 1); PG8_STAGE(PG8_SB(1, 0), b3, voffB);
            PG8_BAR; PG8_WAIT_L(0); PG8_MMA(0, 1, At, B1); PG8_BAR;
            PG8_LDA(At, 1, 1); PG8_STAGE(PG8_SA(1, 0), a3, voffA);
            PG8_BAR; PG8_WAIT_L(0); PG8_MMA(1, 0, At, B0); PG8_BAR; PG8_SCHED;
            PG8_STAGE(PG8_SB(1, 1), b3 + hstep, voffB);
            PG8_WAIT_V(6); PG8_BAR; PG8_MMA(1, 1, At, B1); PG8_BAR;
            }
        }
        if constexpr (ALIGN_EPI) { if (wr == 0) PG8_BAR; }
        if constexpr (!Epi::AFTER_DRAIN) { E(acc, cur, wr, wc, fr, fq); S.done(cur); }
        if (!has_next) break;
#pragma unroll
        for (int a = 0; a < 2; ++a)
#pragma unroll
            for (int b = 0; b < 2; ++b)
#pragma unroll
                for (int m = 0; m < 4; ++m)
#pragma unroll
                    for (int n = 0; n < 2; ++n) acc[a][b][m][n] = (f32x4){0.f, 0.f, 0.f, 0.f};
        cur = nxt; cA = nA; cB = nB; ++ui;
        if constexpr (ALIGN_EPI) { if (wr == 1) PG8_BAR; }
    }
    PG8_WAIT_V(0);
    if constexpr (!ALIGN_EPI) { if (wr == 0) PG8_BAR; }
    PG8_BAR;
    if constexpr (Epi::AFTER_DRAIN) { E.fused(acc, cur, wr, wc, fr, fq, lds, wid, lane); S.done(cur); }
#undef PG8_SA
#undef PG8_SB
#undef PG8_STAGE
#undef PG8_LDA
#undef PG8_LDB
#undef PG8_MMA
#undef PG8_WAIT_V
#undef PG8_WAIT_L
#undef PG8_BAR
#undef PG8_SCHED
}
}
#include <hip/hip_bf16.h>
#include <cmath>
namespace attn_body {
using bf16=__hip_bfloat16;
using bf16x8=__attribute__((ext_vector_type(8)))short;
using s16x4=__attribute__((ext_vector_type(4)))short;
using f32x16=__attribute__((ext_vector_type(16)))float;
using u32x4=__attribute__((ext_vector_type(4)))unsigned;
constexpr int ASEQ=8448,D=64;
constexpr int QP=512,KP=512,VP=7424,OP=1024;
constexpr int NW=8,QBLK=32,QB=QBLK*NW,KVBLK=64,NQB=ASEQ/QB;
constexpr int ATTN_UNIT_ROWS=QB;
__device__ __forceinline__ int crow(int r,int hi){return (r&3)+8*(r>>2)+4*hi;}
#define SBAR() __builtin_amdgcn_sched_barrier(0)
constexpr int BT_OFF=383, BT_N=640;
__device__ __forceinline__ void bmask(f32x16&p0,f32x16&p1,int t,int q0,int wid,int r32,int hi,const __attribute__((address_space(3))) float*tab){
  const float NEG=-INFINITY; const int qw=q0+32*wid;
  if(t>(qw>>6)){
    #pragma unroll
    for(int r=0;r<16;++r){p0[r]=NEG;p1[r]=NEG;} return; }
  if(t>0 && 64*t+63+91<=qw) return;
  const int q=qw+r32, kb=64*t+4*hi;
  #pragma unroll
  for(int r=0;r<16;++r){ const int kv=kb+(r&3)+8*(r>>2); int i0=kv-q+BT_OFF, i1=i0+32; i0=i0<0?0:i0; i1=i1<0?0:i1;
    p0[r]+=tab[i0]; p1[r]+=tab[i1]; if(kv<48)p0[r]=NEG; if(kv+32<48)p1[r]=NEG; }
}

constexpr int NSLOT=3, SLOTB=8192;
constexpr int LDS_K=0, LDS_V=NSLOT*SLOTB, LDS_WS=2*NSLOT*SLOTB, LDS_OST=LDS_WS+NW*64*4, LDS_BT=LDS_OST+NW*4096, LDS_BYTES=LDS_BT+BT_N*4;
constexpr float C2=0.125f*1.4426950408889634f;
__device__ __forceinline__ void glds16(const void*gsrc,unsigned lds_dst){unsigned keep;
  asm volatile("s_mov_b32 %0, m0\n\ts_mov_b32 m0, %2\n\ts_nop 0\n\tglobal_load_lds_dwordx4 %1, off\n\ts_mov_b32 m0, %0":"=&s"(keep):"v"(gsrc),"s"(lds_dst):"memory");}
__device__ __forceinline__ float max3f(float a,float b,float c){float r;asm("v_max3_f32 %0, %1, %2, %3":"=v"(r):"v"(a),"v"(b),"v"(c));return r;}
__device__ __forceinline__ float max2f(float a,float b){float r;asm("v_max_f32_e32 %0, %1, %2":"=v"(r):"v"(a),"v"(b));return r;}
__device__ __forceinline__ float fadd_s(float a,float b){float r;asm("v_add_f32_e32 %0, %1, %2":"=v"(r):"v"(a),"v"(b));return r;}
__device__ __forceinline__ float fsub_s(float a,float b){float r;asm("v_sub_f32_e32 %0, %1, %2":"=v"(r):"v"(a),"v"(b));return r;}
typedef float f32x2_t __attribute__((ext_vector_type(2))); typedef __bf16 bf16x2_t __attribute__((ext_vector_type(2)));
__device__ __forceinline__ unsigned cvtpk_s(float lo,float hi){f32x2_t v={lo,hi};bf16x2_t b=__builtin_convertvector(v,bf16x2_t);return __builtin_bit_cast(unsigned,b);}
#define WAIT_BAR(N) asm volatile("s_waitcnt vmcnt(" #N ") lgkmcnt(0)\n\ts_barrier":::"memory")

__device__ __forceinline__ void qkt(f32x16&p0,f32x16&p1,const char*Kslot,const bf16x8*qr,const f32x16&negm,int r32,int hi){
  const char*kb=Kslot+hi*1024+r32*16;
  #pragma unroll
  for(int d0=0;d0<4;++d0){
    const bf16x8 b0=*reinterpret_cast<const bf16x8*>(kb+d0*2048);
    const bf16x8 b1=*reinterpret_cast<const bf16x8*>(kb+d0*2048+512);
    if(d0==0){p0=__builtin_amdgcn_mfma_f32_32x32x16_bf16(b0,qr[0],negm,0,0,0);p1=__builtin_amdgcn_mfma_f32_32x32x16_bf16(b1,qr[0],negm,0,0,0);}
    else{p0=__builtin_amdgcn_mfma_f32_32x32x16_bf16(b0,qr[d0],p0,0,0,0);p1=__builtin_amdgcn_mfma_f32_32x32x16_bf16(b1,qr[d0],p1,0,0,0);}}
}
typedef __attribute__((address_space(3))) const char* lds_cptr;
typedef __attribute__((address_space(3))) const float* lds_cfptr;
typedef short v4i16_t __attribute__((ext_vector_type(4)));
__device__ __forceinline__ void kload8(bf16x8*kf,lds_cptr kp){
  kf[0]=*(const __attribute__((address_space(3))) bf16x8*)(kp);      kf[1]=*(const __attribute__((address_space(3))) bf16x8*)(kp+512);
  kf[2]=*(const __attribute__((address_space(3))) bf16x8*)(kp+2048); kf[3]=*(const __attribute__((address_space(3))) bf16x8*)(kp+2560);
  kf[4]=*(const __attribute__((address_space(3))) bf16x8*)(kp+4096); kf[5]=*(const __attribute__((address_space(3))) bf16x8*)(kp+4608);
  kf[6]=*(const __attribute__((address_space(3))) bf16x8*)(kp+6144); kf[7]=*(const __attribute__((address_space(3))) bf16x8*)(kp+6656);
}
__device__ __forceinline__ void kload2(bf16x8*kf,lds_cptr kp,int j){ kf[2*j]=*(const __attribute__((address_space(3))) bf16x8*)(kp+j*2048); kf[2*j+1]=*(const __attribute__((address_space(3))) bf16x8*)(kp+j*2048+512); }
__device__ __forceinline__ s16x4 vtr(lds_cptr p){ return __builtin_bit_cast(s16x4,__builtin_amdgcn_ds_read_tr16_b64_v4i16((__attribute__((address_space(3))) v4i16_t*)p)); }
__device__ __forceinline__ float rowmax(const f32x16&p0,const f32x16&p1){
  float a=max3f(p0[0],p0[1],p1[0]),b=max3f(p0[2],p0[3],p1[1]);a=max3f(a,p1[2],p1[3]);
  #pragma unroll
  for(int r=4;r<16;r+=4){a=max3f(a,p0[r],p0[r+1]);b=max3f(b,p0[r+2],p0[r+3]);a=max3f(a,p1[r],p1[r+1]);b=max3f(b,p1[r+2],p1[r+3]);}
  const float m=max2f(a,b);
  auto rr=__builtin_amdgcn_permlane32_swap(__float_as_uint(m),__float_as_uint(m),false,false);
  return max2f(__uint_as_float(rr[0]),__uint_as_float(rr[1]));
}
__device__ __forceinline__ void pv(f32x16*o,int vb,bf16x8 pa0,bf16x8 pa1,bf16x8 pa2,bf16x8 pa3){
  #pragma unroll
  for(int d0=0;d0<2;++d0){s16x4 lo[4],hi[4];
    #pragma unroll
    for(int ks=0;ks<4;++ks){
      asm volatile("ds_read_b64_tr_b16 %0,%1 offset:%c2":"=&v"(lo[ks]):"v"(vb),"i"(d0*4096+ks*1024):"memory");
      asm volatile("ds_read_b64_tr_b16 %0,%1 offset:%c2":"=&v"(hi[ks]):"v"(vb),"i"(d0*4096+ks*1024+512):"memory");}
    asm volatile("s_waitcnt lgkmcnt(0)":::"memory");SBAR();
    #define PK(k) (bf16x8){lo[k][0],lo[k][1],lo[k][2],lo[k][3],hi[k][0],hi[k][1],hi[k][2],hi[k][3]}
    o[d0]=__builtin_amdgcn_mfma_f32_32x32x16_bf16(pa0,PK(0),o[d0],0,0,0);
    o[d0]=__builtin_amdgcn_mfma_f32_32x32x16_bf16(pa1,PK(1),o[d0],0,0,0);
    o[d0]=__builtin_amdgcn_mfma_f32_32x32x16_bf16(pa2,PK(2),o[d0],0,0,0);
    o[d0]=__builtin_amdgcn_mfma_f32_32x32x16_bf16(pa3,PK(3),o[d0],0,0,0);
    #undef PK
  }
}

#ifndef ATTN_STORE16
#define ATTN_STORE16(p,v) (*(u32x4*)(p)=(v))
#endif
template<int THRL> __device__ __forceinline__ void attn_unit(int b,int qoff,int voff,int ooff,int qb,const bf16*Q,const bf16*__restrict__ K,const bf16*__restrict__ V,bf16*O,char*shm,int wv){
  unsigned om_ = ~0u; asm volatile("" : "+s"(om_), "+s"(wv)); int tid_ = wv * 64 + (int)__builtin_amdgcn_mbcnt_hi(om_, __builtin_amdgcn_mbcnt_lo(om_, 0u)); const int tid=tid_,lane=tid&63,r32=lane&31,hi=lane>>5; const int wid=__builtin_amdgcn_readfirstlane(tid>>6);
  const long rowbase=(long)b*ASEQ; const int q0=qb*QB;
  const bf16*Qw=Q+(rowbase+q0+wid*QBLK)*QP+qoff;
  const bf16*Kh=K+rowbase*KP+qoff,*Vh=V+rowbase*VP+voff;
  const unsigned lds0=(unsigned)(uintptr_t)shm;
  float*wsf=(float*)(shm+LDS_WS)+wid*64;
  const bf16*ksrc=Kh+(long)lane*KP+wid*8;
  const bf16*vsrc=Vh+(long)(16*(wid&3)+(lane>>2))*VP+(wid>>2)*32+(lane&3)*8;
  const unsigned kdst=lds0+LDS_K+wid*1024, vdst=lds0+LDS_V+wid*1024;
  #define DMA_K(t,slot) glds16(ksrc+(long)(t)*KVBLK*KP,(unsigned)__builtin_amdgcn_readfirstlane(kdst+(slot)))
  #define DMA_V(t,slot) glds16(vsrc+(long)(t)*KVBLK*VP,(unsigned)__builtin_amdgcn_readfirstlane(vdst+(slot)))
  const int vb0=(int)(lds0+LDS_V)+((lane>>4)&1)*32+(lane&3)*8+(4*hi+((lane&15)>>2))*64;
  const char*Kbase=shm+LDS_K; bf16x8 kf[8];
  const lds_cptr shm3=(lds_cptr)shm; const lds_cfptr btab=(lds_cfptr)(shm3+LDS_BT); const lds_cptr kp0=shm3+LDS_K+hi*1024+r32*16; const lds_cptr vp0=shm3+LDS_V+((lane>>4)&1)*32+(lane&3)*8+(4*hi+((lane&15)>>2))*64;
  const int NTL=(q0+QB)/KVBLK;
  DMA_K(0,0);DMA_V(0,0);DMA_K(1,SLOTB);
  bf16x8 qr[4];
  #pragma unroll
  for(int d0=0;d0<4;++d0)qr[d0]=*reinterpret_cast<const bf16x8*>(&Qw[(long)r32*QP+d0*16+hi*8]);
  float mhat=0.f,l_reg=0.f;f32x16 o[2];o[0]=f32x16{};o[1]=f32x16{};const f32x16 zt=f32x16{};
  const int qrel=wid*QBLK+r32;
  #define CMASK(P0,P1,t) bmask(P0,P1,(t),q0,wid,r32,hi,btab)
  bool resc=false;
  #define START(P0,P1) do{ const float rm=rowmax(P0,P1); resc=false; \
    { const float dl=rm; mhat=fadd_s(mhat,dl); \
      _Pragma("unroll") for(int r=0;r<16;++r){P0[r]=fsub_s(P0[r],dl);P1[r]=fsub_s(P1[r],dl);} \
      } \
    _Pragma("unroll") for(int r=0;r<16;++r)P0[r]=__builtin_amdgcn_exp2f(P0[r]); }while(0)
  #define RESC() do{ if(resc){ asm volatile("s_waitcnt lgkmcnt(0)":::"memory"); \
      _Pragma("unroll") for(int d_=0;d_<2;++d_) _Pragma("unroll") for(int r=0;r<16;++r)o[d_][r]*=wsf[crow(r,hi)]; } }while(0)
  f32x16 pA0,pA1,pB0,pB1;
  int sl_prev=0,sl_cur=0,sl_next=SLOTB;
  #define ROT() do{sl_prev=sl_cur;sl_cur=sl_next;sl_next=(sl_next==(NSLOT-1)*SLOTB)?0:sl_next+SLOTB;}while(0)
  DMA_K(2,2*SLOTB);
  WAIT_BAR(3);
  qkt(pA0,pA1,Kbase,qr,zt,r32,hi);asm volatile("s_nop 15\n\ts_nop 7":"+v"(pA0),"+v"(pA1));CMASK(pA0,pA1,0);
  START(pA0,pA1);
  _Pragma("unroll") for(int r=0;r<16;++r)pA1[r]=__builtin_amdgcn_exp2f(pA1[r]);
  WAIT_BAR(0);
  DMA_K(3,0);DMA_V(1,SLOTB);
  ROT();
  kload8(kf,kp0+sl_cur);
  WAIT_BAR(2);
  s16x4 vlo[8],vhi[8]; u32x4 pw0,pw1,pw2,pw3;
  #define PKW(P,B) cvtpk_s(P[B],P[B+1])
  #define PAF(k) __builtin_bit_cast(bf16x8,pw##k)
  #define VFR(i) (bf16x8){vlo[i][0],vlo[i][1],vlo[i][2],vlo[i][3],vhi[i][0],vhi[i][1],vhi[i][2],vhi[i][3]}
  #define PIN(x) asm volatile("":"+v"(x))
  #define MX3(a,b,c) __builtin_fmaxf(__builtin_fmaxf((a),(b)),(c))
  #define GAPA(MF,A0,A1,A2,A3,W0,W1,PW) do{ MF; sacc+=A0; sacc+=A1; sacc+=A2; sacc+=A3; PIN(sacc); W0; W1; PIN(PW); SBAR(); }while(0)
  #define EX(v) __builtin_amdgcn_exp2f(v)
  #define GAPB(MF,X,B) do{ MF; X[B]=EX(X[B]); X[B+1]=EX(X[B+1]); X[B+2]=EX(X[B+2]); X[B+3]=EX(X[B+3]); PIN(X); SBAR(); }while(0)
  #define VRD(i) do{ vlo[i]=vtr(vp_+(((i)>>2)*4096+((i)&3)*1024)); vhi[i]=vtr(vp_+(((i)>>2)*4096+((i)&3)*1024+512)); }while(0)
  #define KRD(G,j) do{ if(G){ kload2(kf,kp0+sl_next,j); SBAR(); } }while(0)
  #define STEP(C0,C1,P0,P1,t,GK,GV,GL) do{ SBAR(); \
    const lds_cptr vp_=vp0+sl_prev; \
    VRD(0); SBAR(); float sacc=(P0[0]+P0[1]); \
    GAPA(C0=__builtin_amdgcn_mfma_f32_32x32x16_bf16(kf[0],qr[0],zt,0,0,0), P0[2],P0[3],P0[4],P0[5],     pw0[0]=PKW(P0,0), pw0[1]=PKW(P0,2), pw0); \
    VRD(4); SBAR(); GAPA(C1=__builtin_amdgcn_mfma_f32_32x32x16_bf16(kf[1],qr[0],zt,0,0,0), P0[6],P0[7],P0[8],P0[9],     pw0[2]=PKW(P0,4), pw0[3]=PKW(P0,6), pw0); \
    VRD(1); SBAR(); GAPA(C0=__builtin_amdgcn_mfma_f32_32x32x16_bf16(kf[2],qr[1],C0,0,0,0),   P0[10],P0[11],P0[12],P0[13], pw1[0]=PKW(P0,8), pw1[1]=PKW(P0,10), pw1); \
    VRD(5); SBAR(); GAPA(C1=__builtin_amdgcn_mfma_f32_32x32x16_bf16(kf[3],qr[1],C1,0,0,0),   P0[14],P0[15],P1[0],P1[1],   pw1[2]=PKW(P0,12),pw1[3]=PKW(P0,14), pw1); \
    VRD(2); SBAR(); GAPA(C0=__builtin_amdgcn_mfma_f32_32x32x16_bf16(kf[4],qr[2],C0,0,0,0),   P1[2],P1[3],P1[4],P1[5],     pw2[0]=PKW(P1,0), pw2[1]=PKW(P1,2), pw2); \
    VRD(6); SBAR(); GAPA(C1=__builtin_amdgcn_mfma_f32_32x32x16_bf16(kf[5],qr[2],C1,0,0,0),   P1[6],P1[7],P1[8],P1[9],     pw2[2]=PKW(P1,4), pw2[3]=PKW(P1,6), pw2); \
    VRD(3); SBAR(); GAPA(C0=__builtin_amdgcn_mfma_f32_32x32x16_bf16(kf[6],qr[3],C0,0,0,0),   P1[10],P1[11],P1[12],P1[13], pw3[0]=PKW(P1,8), pw3[1]=PKW(P1,10), pw3); \
    VRD(7); SBAR(); GAPA(C1=__builtin_amdgcn_mfma_f32_32x32x16_bf16(kf[7],qr[3],C1,0,0,0),   P1[14],P1[15],0.f,0.f,       pw3[2]=PKW(P1,12),pw3[3]=PKW(P1,14), pw3); \
    l_reg+=sacc; \
    if(GK){DMA_K((t)+3,sl_cur);} if(GV){DMA_V((t)+1,sl_next);} \
    _Pragma("unroll") for(int r=0;r<16;++r){C0[r]-=mhat;C1[r]-=mhat;} \
    CMASK(C0,C1,t); \
    { float a=MX3(C0[0],C0[1],C1[0]),b=MX3(C0[2],C0[3],C1[1]); a=MX3(a,C1[2],C1[3]); \
      _Pragma("unroll") for(int r=4;r<16;r+=4){a=MX3(a,C0[r],C0[r+1]);b=MX3(b,C0[r+2],C0[r+3]);a=MX3(a,C1[r],C1[r+1]);b=MX3(b,C1[r+2],C1[r+3]);} \
      float rm=__builtin_fmaxf(a,b); { auto rr=__builtin_amdgcn_permlane32_swap(__float_as_uint(rm),__float_as_uint(rm),false,false); rm=__builtin_fmaxf(__uint_as_float(rr[0]),__uint_as_float(rr[1])); } \
      resc=false; \
      if(__builtin_expect(__any(rm>(float)THRL),0)){ const float dl=__builtin_fmaxf(rm,0.f); mhat+=dl; \
        _Pragma("unroll") for(int r=0;r<16;++r){C0[r]-=dl;C1[r]-=dl;} \
        const float f=__builtin_amdgcn_exp2f(-dl); l_reg*=f; if(hi==0)wsf[r32]=f; resc=true; } } \
    SBAR(); \
    GAPB(o[0]=__builtin_amdgcn_mfma_f32_32x32x16_bf16(PAF(0),VFR(0),o[0],0,0,0), C0,0); \
    GAPB(o[1]=__builtin_amdgcn_mfma_f32_32x32x16_bf16(PAF(0),VFR(4),o[1],0,0,0), C0,4); \
    KRD(GL,0); GAPB(o[0]=__builtin_amdgcn_mfma_f32_32x32x16_bf16(PAF(1),VFR(1),o[0],0,0,0), C0,8); \
    KRD(GL,1); GAPB(o[1]=__builtin_amdgcn_mfma_f32_32x32x16_bf16(PAF(1),VFR(5),o[1],0,0,0), C0,12); \
    KRD(GL,2); GAPB(o[0]=__builtin_amdgcn_mfma_f32_32x32x16_bf16(PAF(2),VFR(2),o[0],0,0,0), C1,0); \
    KRD(GL,3); GAPB(o[1]=__builtin_amdgcn_mfma_f32_32x32x16_bf16(PAF(2),VFR(6),o[1],0,0,0), C1,4); \
    GAPB(o[0]=__builtin_amdgcn_mfma_f32_32x32x16_bf16(PAF(3),VFR(3),o[0],0,0,0), C1,8); \
    GAPB(o[1]=__builtin_amdgcn_mfma_f32_32x32x16_bf16(PAF(3),VFR(7),o[1],0,0,0), C1,12); \
    }while(0)
  int t=1;
  #undef CMASK
  #define CMASK(P0,P1,t) do{}while(0)
  for(;t+7<NTL;t+=2){
    STEP(pB0,pB1,pA0,pA1,t,true,true,true);     WAIT_BAR(2); RESC(); ROT();
    STEP(pA0,pA1,pB0,pB1,t+1,true,true,true);   WAIT_BAR(2); RESC(); ROT();
  }
  #undef CMASK
  #define CMASK(P0,P1,t) bmask(P0,P1,(t),q0,wid,r32,hi,btab)
  #define ENDW(tt) do{ if((tt)+3<NTL){WAIT_BAR(2);} else if((tt)+2<NTL){WAIT_BAR(1);} else {WAIT_BAR(0);} }while(0)
  for(;t+1<NTL;t+=2){
    STEP(pB0,pB1,pA0,pA1,t,(t+3<NTL),(t+1<NTL),(t+1<NTL));       ENDW(t);   RESC(); ROT();
    STEP(pA0,pA1,pB0,pB1,t+1,(t+4<NTL),(t+2<NTL),(t+2<NTL));     ENDW(t+1); RESC(); ROT();
  }
  STEP(pB0,pB1,pA0,pA1,NTL-1,false,false,false); RESC();
  { float sacc=pB0[0]+pB0[1]; _Pragma("unroll") for(int r=2;r<16;++r)sacc+=pB0[r]; _Pragma("unroll") for(int r=0;r<16;++r)sacc+=pB1[r]; l_reg+=sacc;
    pw0=(u32x4){PKW(pB0,0),PKW(pB0,2),PKW(pB0,4),PKW(pB0,6)};pw1=(u32x4){PKW(pB0,8),PKW(pB0,10),PKW(pB0,12),PKW(pB0,14)};pw2=(u32x4){PKW(pB1,0),PKW(pB1,2),PKW(pB1,4),PKW(pB1,6)};pw3=(u32x4){PKW(pB1,8),PKW(pB1,10),PKW(pB1,12),PKW(pB1,14)};
    SBAR(); pv(o,vb0+sl_cur,PAF(0),PAF(1),PAF(2),PAF(3)); }
  #undef PKW
  #undef PAF
  #undef VFR
  #undef PIN
  #undef MX3
  #undef GAPA
  #undef GAPB
  #undef EX
  #undef VRD
  #undef KRD
  #undef STEP
  #undef ENDW
  {auto rr=__builtin_amdgcn_permlane32_swap(__float_as_uint(l_reg),__float_as_uint(l_reg),false,false);l_reg=__uint_as_float(rr[0])+__uint_as_float(rr[1]);}
  if(hi==0)wsf[32+r32]=l_reg;asm volatile("s_waitcnt lgkmcnt(0)":::"memory");
  float rli[16];
  #pragma unroll
  for(int r=0;r<16;++r)rli[r]=__builtin_amdgcn_rcpf(wsf[32+crow(r,hi)]);
  bf16*Ow=O+(rowbase+q0+wid*QBLK)*OP+ooff;
  { bf16*stg=(bf16*)(shm+LDS_OST)+wid*2048;
    #pragma unroll
    for(int r=0;r<16;++r){const int orow=crow(r,hi);
      #pragma unroll
      for(int d0=0;d0<2;++d0)stg[orow*64+d0*32+r32]=__float2bfloat16(o[d0][r]*rli[r]);}
    asm volatile("s_waitcnt lgkmcnt(0)":::"memory");
    #pragma unroll
    for(int i=0;i<4;++i){const int row=i*8+(lane>>3),ch=lane&7; const u32x4 v=*(const u32x4*)(stg+row*64+ch*8); ATTN_STORE16(Ow+(long)row*OP+ch*8,v);} }
  asm volatile("s_waitcnt lgkmcnt(0)\n\ts_barrier":::"memory");
  #undef DMA_K
  #undef DMA_V
  #undef CMASK
  #undef START
  #undef RESC
  #undef ROT
}
constexpr int ATTN_LDS_BYTES=LDS_BYTES;
#undef SBAR
#undef WAIT_BAR
#undef WAIT_BAR
}
namespace mk {
#define GAS __attribute__((address_space(1)))
#define LAS __attribute__((address_space(3)))
typedef unsigned short bf16;
typedef unsigned v4u __attribute__((ext_vector_type(4)));
typedef unsigned v2u __attribute__((ext_vector_type(2)));
typedef float f32x4 __attribute__((ext_vector_type(4)));
typedef float f32x16 __attribute__((ext_vector_type(16)));
typedef short bf16x8 __attribute__((ext_vector_type(8)));
typedef GAS unsigned gu32;
#define RLX_AGENT __ATOMIC_RELAXED, __HIP_MEMORY_SCOPE_AGENT
#define LDS_WAIT() asm volatile("s_waitcnt lgkmcnt(0)" ::: "memory")
#define VM_WAIT() asm volatile("s_waitcnt vmcnt(0)" ::: "memory")
typedef float f32x2_cv __attribute__((ext_vector_type(2))); typedef __bf16 bf16x2_cv __attribute__((ext_vector_type(2)));
__device__ __forceinline__ unsigned pk2(float lo, float hi) { const f32x2_cv v = {lo, hi}; return __builtin_bit_cast(unsigned, __builtin_convertvector(v, bf16x2_cv)); }
__device__ __forceinline__ unsigned f2bf(float f) { return pk2(f, 0.f) & 0xffffu; }
__device__ __forceinline__ float bf2f(unsigned short b) { return __builtin_bit_cast(float, ((unsigned)b) << 16); }
__device__ __forceinline__ float bflo(unsigned w) { return __builtin_bit_cast(float, w << 16); }
__device__ __forceinline__ float bfhi(unsigned w) { return __builtin_bit_cast(float, w & 0xffff0000u); }

constexpr int NWAVES = 8, NTHR = NWAVES * 64;
constexpr int PADF = 48;
constexpr int LPP = 8448;
constexpr int PEND = PADF + LP;
constexpr int SROW0 = BATCH * LPP;
constexpr int RP = SROW0 + NS;
constexpr int ZN = 7424;
constexpr int ZC_QA = 0, ZC_KA = 512, ZC_VA = 1024, ZC_QKVB = 1536, ZC_GB = 3072, ZC_UC = 3584, ZC_GATE = 4096, ZC_BA = 7168;
static_assert(RP % 256 == 0 && ZN % 256 == 0 && D_MODEL == 1024 && WIDTH_A == 512 && WIDTH_B == 512 && WIDTH_C == 512, "shapes");
__host__ __device__ __forceinline__ int nat2prow(int row) { return row < NP ? (row / LP) * LPP + PADF + row % LP : SROW0 + (row - NP); }
__host__ __device__ __forceinline__ int zcol(int col) { return col < 3584 ? col : (col < 3592 ? ZC_BA + (col - 3584) : col - 8); }
__device__ __forceinline__ bool prow_valid(int prow) { if (prow >= SROW0) return true; const int p = prow % LPP; return p >= PADF && p < PEND; }
__device__ __forceinline__ int prow2nat(int prow) { if (prow >= SROW0) return NP + (prow - SROW0); return (prow / LPP) * LP + (prow % LPP) - PADF; }

constexpr int RING_OFF = 0, RING_BYTES = 147456;
constexpr int LDSCTL_OFF = RING_BYTES, MISC_OFF = LDSCTL_OFF + 320;
constexpr int LDS_BYTES = RING_BYTES + 1024;
static_assert(MISC_OFF + 128 <= LDS_BYTES, "LDS map");

constexpr size_t CTL_BYTES = 1u << 20;
constexpr int CW_TMO = 0, CW_CODE = 1;
constexpr int CW_BAR = 4096;
constexpr int CW_QUEUE = 16384;
constexpr int CW_GDNFLAG = 32768;

__device__ __forceinline__ int lane_id() { return (int)__builtin_amdgcn_mbcnt_hi(~0u, __builtin_amdgcn_mbcnt_lo(~0u, 0u)); }
#define XB_TMO      128
#define XB_XCNT(j)  (256  + 64 * (j))
#define XB_XSUB(j)  (1280 + 64 * (j))
#define XB_XGEN(j)  (2304 + 64 * (j))
#define XB_TOP      3328
#define XB_TOPGEN   3392
#define XCD_BAR_WORDS 3456
#define XB_SPIN_CAP (1u << 18)

__device__ __forceinline__ unsigned xb_ld(unsigned* p)              { return __hip_atomic_load(p, __ATOMIC_RELAXED, __HIP_MEMORY_SCOPE_AGENT); }
__device__ __forceinline__ unsigned xb_add(unsigned* p, unsigned v) { return __hip_atomic_fetch_add(p, v, __ATOMIC_RELAXED, __HIP_MEMORY_SCOPE_AGENT); }
__device__ __forceinline__ unsigned xb_xcc_id() { return (unsigned)__builtin_amdgcn_s_getreg((3 << 11) | 20) & 0xFu; }
#define XB_SPIN(cond, bar) do { unsigned _sp = 0; while (cond) { __builtin_amdgcn_s_sleep(1); \
    if ((++_sp & 255u) == 0u) { if (xb_ld(&(bar)[XB_TMO])) break; if (_sp > XB_SPIN_CAP) { atomicAdd(&(bar)[XB_TMO], 1u); break; } } } } while (0)

struct XcdBarrier {
    unsigned* bar; unsigned x; int wv;
    volatile LAS unsigned* st;
};

__device__ __forceinline__ XcdBarrier xcd_barrier_post(unsigned* bar, volatile LAS unsigned* st, int wv) {
    XcdBarrier b; b.bar = bar; b.x = xb_xcc_id(); b.st = st; b.wv = wv;
    if (wv == 0 && lane_id() == 0) (void)xb_add(&bar[XB_XCNT(b.x)], 1u);
    return b;
}
__device__ __forceinline__ void xcd_barrier_complete(unsigned* bar, unsigned x, unsigned& nloc, unsigned& nx) {
    const unsigned G = gridDim.x * gridDim.y * gridDim.z;
    unsigned sum, cnt, mine, sp = 0u;
    for (;;) {
        sum = 0u; cnt = 0u; mine = 0u;
#pragma unroll
        for (unsigned j = 0; j < 16; ++j) { const unsigned c = xb_ld(&bar[XB_XCNT(j)]); sum += c; cnt += (c > 0u) ? 1u : 0u; mine = (j == x) ? c : mine; }
        if (sum == G) break;
        __builtin_amdgcn_s_sleep(1);
        if ((++sp & 255u) == 0u) { if (xb_ld(&bar[XB_TMO])) break; if (sp > XB_SPIN_CAP) { atomicAdd(&bar[XB_TMO], 1u); break; } }
    }
    nloc = mine > 0u ? mine : 1u; nx = cnt > 0u ? cnt : 1u;
}

__device__ __forceinline__ void xcd_barrier(const XcdBarrier& b) {
    asm volatile("s_waitcnt vmcnt(0)" ::: "memory");
    __syncthreads();
    if (b.wv == 0 && lane_id() == 0) {
        unsigned* bar = b.bar;
        __builtin_amdgcn_s_waitcnt(0);
        unsigned nloc = b.st[0], nx = b.st[1];
        if (nloc == 0u) { xcd_barrier_complete(bar, b.x, nloc, nx); b.st[0] = nloc; b.st[1] = nx; }
        const unsigned old = xb_add(&bar[XB_XSUB(b.x)], 1u);
        const unsigned gen = old / nloc;
        if (old + 1u == (gen + 1u) * nloc) {
            __builtin_amdgcn_fence(__ATOMIC_RELEASE, "agent");
            asm volatile("s_waitcnt vmcnt(0)" ::: "memory");
            const unsigned og = xb_add(&bar[XB_TOP], 1u);
            const unsigned tg = og / nx;
            if (og + 1u == (tg + 1u) * nx) xb_add(&bar[XB_TOPGEN], 1u);
            else XB_SPIN(xb_ld(&bar[XB_TOPGEN]) == tg, bar);
            __builtin_amdgcn_fence(__ATOMIC_ACQUIRE, "agent");
            xb_add(&bar[XB_XGEN(b.x)], 1u);
            asm volatile("s_waitcnt vmcnt(0)" ::: "memory");
        } else {
            XB_SPIN(xb_ld(&bar[XB_XGEN(b.x)]) == gen, bar);
            __builtin_amdgcn_fence(__ATOMIC_ACQUIRE, "agent");
            asm volatile("s_waitcnt vmcnt(0)" ::: "memory");
        }
    }
    __syncthreads();
}


template <int CTRL> __device__ __forceinline__ float dpp_f(float v) { return __builtin_bit_cast(float, __builtin_amdgcn_update_dpp(0, __builtin_bit_cast(int, v), CTRL, 0xf, 0xf, true)); }
template <int CTRL> __device__ __forceinline__ int dpp_i(int v) { return __builtin_amdgcn_update_dpp(0, v, CTRL, 0xf, 0xf, true); }
template <int CTRL, int ROWMASK> __device__ __forceinline__ float dpp_fm(float v) { return __builtin_bit_cast(float, __builtin_amdgcn_update_dpp(0, __builtin_bit_cast(int, v), CTRL, ROWMASK, 0xf, false)); }
__device__ __forceinline__ float rdlane(float v, int i) { return __builtin_bit_cast(float, __builtin_amdgcn_readlane(__builtin_bit_cast(int, v), i)); }
__device__ __forceinline__ float sum8(float v) { v += dpp_f<0xB1>(v); v += dpp_f<0x4E>(v); v += dpp_f<0x141>(v); return v; }
__device__ __forceinline__ float sum16(float v) { v = sum8(v); v += dpp_f<0x140>(v); return v; }
__device__ __forceinline__ float wave_sum(float v) { v = sum16(v); return rdlane(v, 0) + rdlane(v, 16) + rdlane(v, 32) + rdlane(v, 48); }
__device__ __forceinline__ float wave_max(float v) {
    v = fmaxf(v, dpp_f<0xB1>(v)); v = fmaxf(v, dpp_f<0x4E>(v)); v = fmaxf(v, dpp_f<0x141>(v)); v = fmaxf(v, dpp_f<0x140>(v));
    return fmaxf(fmaxf(rdlane(v, 0), rdlane(v, 16)), fmaxf(rdlane(v, 32), rdlane(v, 48)));
}
__device__ __forceinline__ float scan64(float v) {
    v += dpp_f<0x111>(v); v += dpp_f<0x112>(v); v += dpp_f<0x114>(v); v += dpp_f<0x118>(v);
    v += dpp_fm<0x142, 0xA>(v); v += dpp_fm<0x143, 0xC>(v);
    return v;
}
__device__ __forceinline__ float swap32(float v) {
    const auto r = __builtin_amdgcn_permlane32_swap(__builtin_bit_cast(unsigned, v), __builtin_bit_cast(unsigned, v), false, false);
    return __builtin_bit_cast(float, (lane_id() & 32) ? r[0] : r[1]);
}
}
namespace mk {
enum Region { R_X, R_XN, R_WIN, R_Z, R_QN, R_KN, R_QKVB, R_BG, R_O, R_OA, R_OB, R_YC, R_OC, R_MRG, R_WGLU, R_WBR, R_WOUT, R_WQS, R_PU, R_PV, R_SC, R_GDN, R_S5T, R_MISC, R_S5E, R_S5X, R_MRGB, R_OBN, R_MRG2, R_NREG };
constexpr int NPL = 16;
enum Phase { PH_PRO = 0, PL_NORM1 = 0, PL_GEMM_IN = 1, PL_ZPOST = 2, PL_LOCAL = 3, PL_MIX = 4, PL_MIXPOST = 5, PL_GEMM_GLU = 6, PL_GEMM_BRA = 7, PL_GEMM_BRB = 8, PL_GEMM_BRC = 9,
             PL_GEMM_OUT = 10, PL_NORM2 = 11, PL_GEMM_PEER = 12, PL_PEER = 13, PH_FINAL = 1 + DEPTH * NPL, PH_END = PH_FINAL + 1 };
enum ProMask { PM_X = 1, PM_WIN = 2, PM_WREST = 4, PM_PEERW = 8, PM_WQS = 16, PM_TABLES = 32 };
struct Args {
    const float* in[40];
    float* out;
    unsigned char* ws;
    unsigned long long off[32];
    int ph_lo, ph_hi, pro_mask, bar_region;
};
static_assert(sizeof(Args) == 40 * 8 + 8 + 8 + 32 * 8 + 16, "Args has no padding");

typedef const __attribute__((address_space(4))) Args* KArgs;
__device__ __forceinline__ KArgs kargs() { KArgs p = (KArgs)__builtin_amdgcn_kernarg_segment_ptr(); asm volatile("" : "+s"(p)); return p; }
__device__ __forceinline__ void assume_global(const void* p) {
#if defined(__HIP_DEVICE_COMPILE__)
    __builtin_assume(!__builtin_amdgcn_is_shared(p) && !__builtin_amdgcn_is_private(p));
#endif
}
#define GIN(a, i) ((const float*)(const GAS float*)(a).in[i])
#define GOUT(a) ((float*)(GAS float*)(a).out)
#define WS_OPAQUE(a) GAS unsigned char* wsg_ = (GAS unsigned char*)(a).ws; asm volatile("" : "+s"(wsg_)); unsigned char* wsb = (unsigned char*)wsg_
#define otid() otid_(F.wv)
__device__ __forceinline__ int otid_(int wv) { unsigned m = ~0u; asm volatile("" : "+s"(m), "+s"(wv));
    return wv * 64 + (int)__builtin_amdgcn_mbcnt_hi(m, __builtin_amdgcn_mbcnt_lo(m, 0u)); }
struct Frame {
    LAS unsigned char* lds; volatile LAS unsigned* MISC; gu32* ctl;
    int vcu, G, wv;
};

template <class CM> __device__ __forceinline__ void transpose_item(const float* W, int ld, int K, bf16* WT, int n0, int k0, const CM& cm, LAS float* scr, int lane) {
    const int sc = cm(n0 + (lane & 31));
#pragma unroll 8
    for (int i = 0; i < 32; ++i) { const int kk = 2 * i + (lane >> 5); scr[kk * 33 + (lane & 31)] = sc >= 0 ? W[(size_t)(k0 + kk) * ld + sc] : 0.f; }
    LDS_WAIT(); asm volatile("" ::: "memory");
    const int c = lane & 7;
#pragma unroll
    for (int j = 0; j < 4; ++j) { const int n = (lane >> 3) + 8 * j; const LAS float* s = scr + (8 * c) * 33 + n;
        v4u o; o.x = pk2(s[0 * 33], s[1 * 33]); o.y = pk2(s[2 * 33], s[3 * 33]); o.z = pk2(s[4 * 33], s[5 * 33]); o.w = pk2(s[6 * 33], s[7 * 33]);
        *(GAS v4u*)(WT + (size_t)(n0 + n) * K + k0 + 8 * c) = o; }
    LDS_WAIT(); asm volatile("" ::: "memory");
}
struct CmWin { __device__ __forceinline__ int operator()(int n) const { return n < 3584 ? n : (n < 7168 ? n + 8 : (n < 7176 ? 3584 + (n - 7168) : -1)); } };
struct CmId { __device__ __forceinline__ int operator()(int n) const { return n; } };
struct CmGlu { __device__ __forceinline__ int operator()(int n) const { const int G = n >> 5, i = n & 31; return i < 16 ? 16 * G + i : 512 + 16 * G + (i - 16); } };

__device__ __forceinline__ void rms_row_to_bf16(const float* xrow, const float* g, bf16* orow, int lane) {
    const GAS f32x4* xr = (const GAS f32x4*)xrow + lane;
    f32x4 v[4]; float s2 = 0.f;
#pragma unroll
    for (int j = 0; j < 4; ++j) { v[j] = xr[64 * j]; s2 += (v[j].x * v[j].x + v[j].y * v[j].y) + (v[j].z * v[j].z + v[j].w * v[j].w); }
    const float r = __builtin_amdgcn_rsqf(wave_sum(s2) * (1.f / D_MODEL) + EPSF);
    const GAS f32x4* gr = (const GAS f32x4*)g + lane;
    GAS unsigned long long* o8 = (GAS unsigned long long*)orow + lane;
#pragma unroll
    for (int j = 0; j < 4; ++j) { const f32x4 gg = gr[64 * j];
        o8[64 * j] = (unsigned long long)pk2(v[j].x * r * gg.x, v[j].y * r * gg.y) | ((unsigned long long)pk2(v[j].z * r * gg.z, v[j].w * r * gg.w) << 32); }
}

__device__ __forceinline__ void p_norm(Frame& F, int l, int gi) {
    const KArgs ap = kargs(); const auto& a = *ap; WS_OPAQUE(a);
    const int tid = otid(), lane = tid & 63, wave = __builtin_amdgcn_readfirstlane(tid >> 6);
    const float* X = (const float*)(wsb + a.off[R_X]); bf16* XN = (bf16*)(wsb + a.off[R_XN]); const float* g = GIN(a, gi) + (size_t)l * D_MODEL;
    const int gw = F.vcu * NWAVES + wave, NGW = F.G * NWAVES;
    for (int m = gw; m < RP; m += NGW) rms_row_to_bf16(X + (size_t)m * D_MODEL, g, XN + (size_t)m * D_MODEL, lane);
}
__device__ __forceinline__ void unpack8(const v4u w, float (&f)[8]) { f[0] = bflo(w.x); f[1] = bfhi(w.x); f[2] = bflo(w.y); f[3] = bfhi(w.y); f[4] = bflo(w.z); f[5] = bfhi(w.z); f[6] = bflo(w.w); f[7] = bfhi(w.w); }
__device__ __forceinline__ v4u pack8(const float (&f)[8]) { v4u w; w.x = pk2(f[0], f[1]); w.y = pk2(f[2], f[3]); w.z = pk2(f[4], f[5]); w.w = pk2(f[6], f[7]); return w; }
__device__ __forceinline__ float sigm(float x) { return __builtin_amdgcn_rcpf(1.f + __expf(-x)); }
constexpr float ATT_C2 = 0.125f * 1.4426950408889634f;
__device__ __forceinline__ void p_zpost(Frame& F, int l) {
    const KArgs ap = kargs(); const auto& a = *ap; WS_OPAQUE(a);
    const bf16* Z = (const bf16*)(wsb + a.off[R_Z]);
    bf16* QN = (bf16*)(wsb + a.off[R_QN]); bf16* KN = (bf16*)(wsb + a.off[R_KN]); bf16* QKVB = (bf16*)(wsb + a.off[R_QKVB]); float* BG = (float*)(wsb + a.off[R_BG]);
    const int tid = otid(), lane = tid & 63, wave = __builtin_amdgcn_readfirstlane(tid >> 6);
    const int gw = F.vcu * NWAVES + wave, NGW = F.G * NWAVES;
    float gq[8], gk[8], cw[3][4][8];
#pragma unroll
    for (int j = 0; j < 8; ++j) { gq[j] = GIN(a, I_QN)[l * HEAD_DIM_A + 8 * (lane & 7) + j] * ATT_C2; gk[j] = GIN(a, I_KN)[l * HEAD_DIM_A + 8 * (lane & 7) + j]; }
#pragma unroll
    for (int w = 0; w < 3; ++w)
#pragma unroll
        for (int i = 0; i < 4; ++i)
#pragma unroll
            for (int j = 0; j < 8; ++j) cw[w][i][j] = GIN(a, I_CONVW)[((size_t)l * CONV_W + i) * 3 * WIDTH_B + w * WIDTH_B + 8 * lane + j];
    float alog = 0.f, dtb = 0.f; if (lane < 4) { alog = GIN(a, I_ALOG)[l * N_HEADS_B + lane]; dtb = GIN(a, I_DTB)[l * N_HEADS_B + lane]; }
    for (int m = gw; m < RP; m += NGW) {
        const bool valid = prow_valid(m); const int nat = valid ? prow2nat(m) : 0;
        const bf16* zr = Z + (size_t)m * ZN;
        float f[8], o[8];
        unpack8(*(const GAS v4u*)(zr + ZC_QA + 8 * lane), f);
        { float ss = 0.f;
#pragma unroll
          for (int j = 0; j < 8; ++j) ss += f[j] * f[j];
          ss = sum8(ss);
          const float r = __builtin_amdgcn_rsqf(ss * (1.f / HEAD_DIM_A) + EPSF);
#pragma unroll
          for (int j = 0; j < 8; ++j) o[j] = f[j] * r * gq[j];
          *(GAS v4u*)(QN + (size_t)m * WIDTH_A + 8 * lane) = pack8(o); }
        unpack8(*(const GAS v4u*)(zr + ZC_KA + 8 * lane), f);
        { float ss = 0.f;
#pragma unroll
          for (int j = 0; j < 8; ++j) ss += f[j] * f[j];
          ss = sum8(ss);
          const float r = __builtin_amdgcn_rsqf(ss * (1.f / HEAD_DIM_A) + EPSF);
#pragma unroll
          for (int j = 0; j < 8; ++j) o[j] = f[j] * r * gk[j];
          *(GAS v4u*)(KN + (size_t)m * WIDTH_A + 8 * lane) = pack8(o);
          if (valid) { float* ko = nat < NP ? GOUT(a) + O_KP + ((size_t)l * NP + nat) * WIDTH_A : GOUT(a) + O_KS + ((size_t)l * NS + (nat - NP)) * WIDTH_A;
              *(GAS f32x4*)(ko + 8 * lane) = (f32x4){o[0], o[1], o[2], o[3]}; *(GAS f32x4*)(ko + 8 * lane + 4) = (f32x4){o[4], o[5], o[6], o[7]}; } }
        if (valid) { unpack8(*(const GAS v4u*)(zr + ZC_VA + 8 * lane), f);
            float* vo = nat < NP ? GOUT(a) + O_VP + ((size_t)l * NP + nat) * WIDTH_A : GOUT(a) + O_VS + ((size_t)l * NS + (nat - NP)) * WIDTH_A;
            *(GAS f32x4*)(vo + 8 * lane) = (f32x4){f[0], f[1], f[2], f[3]}; *(GAS f32x4*)(vo + 8 * lane + 4) = (f32x4){f[4], f[5], f[6], f[7]}; }
        const int ts = m >= SROW0 ? (m - SROW0) % DEC_SEQ : 1000; const int bs = m >= SROW0 ? (m - SROW0) / DEC_SEQ : 0;
        int cj = -1;
        if (m >= SROW0) { if (ts >= DEC_SEQ - 3) cj = ts - (DEC_SEQ - 3); } else { const int p = m % LPP; if (p >= PEND - 3 && p < PEND) cj = p - (PEND - 3); }
#pragma unroll
        for (int w = 0; w < 3; ++w) {
            float acc[8];
#pragma unroll
            for (int j = 0; j < 8; ++j) acc[j] = 0.f;
#pragma unroll
            for (int i = 0; i < 4; ++i) {
                const int dt = i - 3;
                if (ts + dt < 0) {
                    const float* sc = GIN(a, I_SCONV) + (((size_t)l * DEC_BATCH + bs) * (CONV_W - 1) + (CONV_W - 1 + ts + dt)) * 3 * WIDTH_B + w * WIDTH_B + 8 * lane;
                    const f32x4 s0 = *(const GAS f32x4*)sc, s1 = *(const GAS f32x4*)(sc + 4);
                    f[0] = s0.x; f[1] = s0.y; f[2] = s0.z; f[3] = s0.w; f[4] = s1.x; f[5] = s1.y; f[6] = s1.z; f[7] = s1.w;
                } else if (m + dt >= 0) unpack8(*(const GAS v4u*)(Z + (size_t)(m + dt) * ZN + ZC_QKVB + w * WIDTH_B + 8 * lane), f);
                else {
#pragma unroll
                    for (int j = 0; j < 8; ++j) f[j] = 0.f; }
#pragma unroll
                for (int j = 0; j < 8; ++j) acc[j] += f[j] * cw[w][i][j];
                if (i == 3 && cj >= 0) {
                    float* co = m >= SROW0 ? GOUT(a) + O_CS + (((size_t)l * DEC_BATCH + bs) * (CONV_W - 1) + cj) * 3 * WIDTH_B : GOUT(a) + O_CP + (((size_t)l * BATCH + m / LPP) * (CONV_W - 1) + cj) * 3 * WIDTH_B;
                    *(GAS f32x4*)(co + w * WIDTH_B + 8 * lane) = (f32x4){f[0], f[1], f[2], f[3]}; *(GAS f32x4*)(co + w * WIDTH_B + 8 * lane + 4) = (f32x4){f[4], f[5], f[6], f[7]}; }
            }
            float ss = 0.f;
#pragma unroll
            for (int j = 0; j < 8; ++j) { acc[j] = acc[j] * sigm(acc[j]); ss += acc[j] * acc[j]; }
            float sc = 1.f;
            if (w < 2) { ss = sum16(ss);
                sc = __builtin_amdgcn_rsqf(ss + EPSF); if (w == 0) sc *= 0.08838834764831845f; }
#pragma unroll
            for (int j = 0; j < 8; ++j) o[j] = acc[j] * sc;
            *(GAS v4u*)(QKVB + (size_t)m * 3 * WIDTH_B + w * WIDTH_B + 8 * lane) = pack8(o);
        }
        if (lane < 4) { const float be = bf2f(zr[ZC_BA + lane]), al = bf2f(zr[ZC_BA + 4 + lane]) + dtb;
            const float sp = al > 20.f ? al : __logf(1.f + __expf(al));
            BG[(size_t)m * 8 + lane] = valid ? sigm(be) : 0.f; BG[(size_t)m * 8 + 4 + lane] = valid ? -__expf(alog) * sp : 0.f; }
    }
}
constexpr float LOG2E = 1.4426950408889634f;
__device__ __forceinline__ int t5_bucket_dev(int rel) {
    const int n = rel < 0 ? -rel : rel; int b;
    if (n < 8) b = n; else if (n < 12) b = 8; else if (n < 16) b = 9; else if (n < 23) b = 10; else if (n < 32) b = 11;
    else if (n < 46) b = 12; else if (n < 64) b = 13; else if (n < 91) b = 14; else b = 15;
    return b + (rel > 0 ? 16 : 0);
}
__device__ __forceinline__ void build_bias_table(LAS float* tab, const float* rel_bias, int h, int tid) {
    const float far = rel_bias[15 * N_HEADS_A + h];
    for (int i = tid; i < attn_body::BT_N; i += NTHR) tab[i] = (rel_bias[t5_bucket_dev(i - attn_body::BT_OFF) * N_HEADS_A + h] - far) * LOG2E;
}
__device__ __forceinline__ float lam_init_dev(int l) { return 0.8f - 0.6f * __expf(-0.3f * (float)l); }
__device__ __forceinline__ float lam_dev(const float* lqk_all, int l, int lane) {
    const float* q = lqk_all + (size_t)l * 4 * HEAD_DIM_A;
    const float s0 = wave_sum(q[lane] * q[HEAD_DIM_A + lane]), s1 = wave_sum(q[2 * HEAD_DIM_A + lane] * q[3 * HEAD_DIM_A + lane]);
    return __expf(s0) - __expf(s1) + lam_init_dev(l);
}
__device__ __forceinline__ int krow_dev(int s, int h, int j) { return 16 * s + 8 * (j >> 2) + 4 * h + (j & 3); }
__device__ __forceinline__ int crow_dev(int r, int h) { return (r & 3) + 8 * (r >> 2) + 4 * h; }
__device__ __forceinline__ bf16x8 pack_f8(const f32x4 a, const f32x4 b) { v4u w; w.x = pk2(a.x, a.y); w.y = pk2(a.z, a.w); w.z = pk2(b.x, b.y); w.w = pk2(b.z, b.w); return __builtin_bit_cast(bf16x8, w); }

__device__ __forceinline__ void sample_scores(f32x16& X, int kb, int c, const float* ck, const bf16* KN, int row0, int h, int hi, int r32, int qpos, const bf16x8 (&qf)[4], const LAS float* tab) {
    bf16x8 kf[4];
    if (kb < PAST_LEN / 32) { const float* kr = ck + (size_t)(kb * 32 + r32) * WIDTH_A + h * 128 + c * 64 + 8 * hi;
#pragma unroll
        for (int s = 0; s < 4; ++s) kf[s] = pack_f8(*(const GAS f32x4*)(kr + 16 * s), *(const GAS f32x4*)(kr + 16 * s + 4)); }
    else { const bf16* kr = KN + (size_t)(row0 + (kb * 32 - PAST_LEN) + r32) * WIDTH_A + h * 128 + c * 64 + 8 * hi;
#pragma unroll
        for (int s = 0; s < 4; ++s) kf[s] = *(const GAS bf16x8*)(kr + 16 * s); }
#pragma unroll
    for (int i = 0; i < 16; ++i) X[i] = 0.f;
#pragma unroll
    for (int s = 0; s < 4; ++s) X = __builtin_amdgcn_mfma_f32_32x32x16_bf16(kf[s], qf[s], X, 0, 0, 0);
#pragma unroll
    for (int i = 0; i < 16; ++i) { int idx = kb * 32 + crow_dev(i, hi) - qpos + attn_body::BT_OFF; idx = idx < 0 ? 0 : idx; X[i] += tab[idx]; }
}

__device__ __forceinline__ void attn_sample_unit(Frame& F, int l, int bs, int h) {
    const KArgs ap = kargs(); const auto& a = *ap; WS_OPAQUE(a);
    const int tid = otid(), lane = tid & 63, wid = __builtin_amdgcn_readfirstlane(tid >> 6), r32 = lane & 31, hi = lane >> 5;
    const bf16* QN = (const bf16*)(wsb + a.off[R_QN]); const bf16* KN = (const bf16*)(wsb + a.off[R_KN]); const bf16* Z = (const bf16*)(wsb + a.off[R_Z]); bf16* O = (bf16*)(wsb + a.off[R_O]);
    const float* ck = GIN(a, I_CK) + ((size_t)l * DEC_BATCH + bs) * PAST_LEN * WIDTH_A; const float* cv = GIN(a, I_CV) + ((size_t)l * DEC_BATCH + bs) * PAST_LEN * WIDTH_A;
    const int row0 = SROW0 + bs * DEC_SEQ;
    LAS float* tab = (LAS float*)(F.lds + RING_OFF + attn_body::LDS_BT);
    LAS float* st = (LAS float*)(F.lds + RING_OFF + 90112);
    LAS float* slot = (LAS float*)(F.lds + RING_OFF);
    const float lam = lam_dev(GIN(a, I_LQK), l, lane);
    build_bias_table(tab, GIN(a, I_REL), h, tid);
    bf16x8 qf[2][4];
#pragma unroll
    for (int c = 0; c < 2; ++c)
#pragma unroll
        for (int s = 0; s < 4; ++s) qf[c][s] = *(const GAS bf16x8*)(QN + (size_t)(row0 + r32) * WIDTH_A + h * 128 + c * 64 + 16 * s + 8 * hi);
    __syncthreads();
    float m[2] = {-1e30f, -1e30f}, lsum[2] = {0.f, 0.f};
    const int qpos = PAST_LEN + r32;
    for (int kb = wid; kb < (PAST_LEN + DEC_SEQ) / 32; kb += NWAVES) {
#pragma unroll
        for (int c = 0; c < 2; ++c) { f32x16 X; sample_scores(X, kb, c, ck, KN, row0, h, hi, r32, qpos, qf[c], tab);
            float mx = X[0];
#pragma unroll
            for (int i = 1; i < 16; ++i) mx = fmaxf(mx, X[i]);
            mx = fmaxf(mx, swap32(mx)); const float mn = fmaxf(m[c], mx);
            float sum = 0.f;
#pragma unroll
            for (int i = 0; i < 16; ++i) sum += exp2f(X[i] - mn);
            lsum[c] = lsum[c] * exp2f(m[c] - mn) + sum; m[c] = mn; }
    }
#pragma unroll
    for (int c = 0; c < 2; ++c) { lsum[c] += swap32(lsum[c]); if (hi == 0) { st[((wid * 2 + c) * 2 + 0) * 32 + r32] = m[c]; st[((wid * 2 + c) * 2 + 1) * 32 + r32] = lsum[c]; } }
    __syncthreads();
    float gm[2], ginv[2];
#pragma unroll
    for (int c = 0; c < 2; ++c) { float mm = -1e30f;
#pragma unroll
        for (int w = 0; w < NWAVES; ++w) mm = fmaxf(mm, st[((w * 2 + c) * 2 + 0) * 32 + r32]);
        float ll = 0.f;
#pragma unroll
        for (int w = 0; w < NWAVES; ++w) ll += st[((w * 2 + c) * 2 + 1) * 32 + r32] * exp2f(st[((w * 2 + c) * 2 + 0) * 32 + r32] - mm);
        gm[c] = mm; ginv[c] = (c == 0 ? 1.f : lam) / ll; }
    f32x16 acc[4];
#pragma unroll
    for (int eb = 0; eb < 4; ++eb)
#pragma unroll
        for (int i = 0; i < 16; ++i) acc[eb][i] = 0.f;
    for (int kb = wid; kb < (PAST_LEN + DEC_SEQ) / 32; kb += NWAVES) {
        f32x16 X0, X1; sample_scores(X0, kb, 0, ck, KN, row0, h, hi, r32, qpos, qf[0], tab); sample_scores(X1, kb, 1, ck, KN, row0, h, hi, r32, qpos, qf[1], tab);
        float wv[16];
#pragma unroll
        for (int i = 0; i < 16; ++i) wv[i] = exp2f(X0[i] - gm[0]) * ginv[0] - exp2f(X1[i] - gm[1]) * ginv[1];
        bf16x8 xs[2];
#pragma unroll
        for (int s = 0; s < 2; ++s) { v4u w; w.x = pk2(wv[8 * s], wv[8 * s + 1]); w.y = pk2(wv[8 * s + 2], wv[8 * s + 3]); w.z = pk2(wv[8 * s + 4], wv[8 * s + 5]); w.w = pk2(wv[8 * s + 6], wv[8 * s + 7]); xs[s] = __builtin_bit_cast(bf16x8, w); }
#pragma unroll
        for (int eb = 0; eb < 4; ++eb)
#pragma unroll
            for (int s = 0; s < 2; ++s) {
                float vv[8];
                if (kb < PAST_LEN / 32) { const GAS float* vb = (const GAS float*)(cv + (size_t)(kb * 32 + 4 * hi) * WIDTH_A + h * 128 + eb * 32 + r32); asm volatile("" : "+v"(vb));
#pragma unroll
                    for (int j = 0; j < 8; ++j) vv[j] = vb[(size_t)(16 * s + 8 * (j >> 2) + (j & 3)) * WIDTH_A]; }
                else { const GAS bf16* vb = (const GAS bf16*)(Z + (size_t)(row0 + kb * 32 - PAST_LEN + 4 * hi) * ZN + ZC_VA + h * 128 + eb * 32 + r32); asm volatile("" : "+v"(vb));
#pragma unroll
                    for (int j = 0; j < 8; ++j) vv[j] = bf2f(vb[(size_t)(16 * s + 8 * (j >> 2) + (j & 3)) * ZN]); }
                v4u w; w.x = pk2(vv[0], vv[1]); w.y = pk2(vv[2], vv[3]); w.z = pk2(vv[4], vv[5]); w.w = pk2(vv[6], vv[7]);
                acc[eb] = __builtin_amdgcn_mfma_f32_32x32x16_bf16(xs[s], __builtin_bit_cast(bf16x8, w), acc[eb], 0, 0, 0);
            }
    }
    __syncthreads();
#pragma unroll
    for (int eb = 0; eb < 4; ++eb)
#pragma unroll
        for (int i = 0; i < 16; ++i) slot[(wid * 32 + crow_dev(i, hi)) * 128 + eb * 32 + r32] = acc[eb][i];
    __syncthreads();
    { const int q = tid >> 4, e0 = (tid & 15) * 8; float o[8];
#pragma unroll
      for (int j = 0; j < 8; ++j) o[j] = 0.f;
#pragma unroll
      for (int w = 0; w < NWAVES; ++w)
#pragma unroll
          for (int j = 0; j < 8; ++j) o[j] += slot[(w * 32 + q) * 128 + e0 + j];
      v4u pw; pw.x = pk2(o[0], o[1]); pw.y = pk2(o[2], o[3]); pw.z = pk2(o[4], o[5]); pw.w = pk2(o[6], o[7]);
      bf16* orow = O + (size_t)(row0 + q) * attn_body::OP + h * 256;
      unsigned zq = 0u; asm volatile("" : "+v"(zq));
      *(GAS v4u*)(orow + e0) = pw; *(GAS v4u*)(orow + 128 + e0) = (v4u){zq, zq, zq, zq}; }
    __syncthreads();
}

constexpr int ATT_NQB = LPP / 256;
constexpr int ATT_NPU = BATCH * 16 * ATT_NQB;
constexpr int ATT_NSU = DEC_BATCH * N_HEADS_A;
__device__ __forceinline__ void p_attention(Frame& F, int lq, unsigned char* ldsg) {
    const int l = lq % DEPTH;
    for (;;) {
        const KArgs ap = kargs(); const auto& a = *ap; WS_OPAQUE(a);
        const int tid = otid();
        gu32* head = (gu32*)wsb + CW_QUEUE + 64 * lq;
        const attn_body::bf16* QN = (const attn_body::bf16*)(wsb + a.off[R_QN]); const attn_body::bf16* KN = (const attn_body::bf16*)(wsb + a.off[R_KN]);
        const attn_body::bf16* Z = (const attn_body::bf16*)(wsb + a.off[R_Z]); attn_body::bf16* O = (attn_body::bf16*)(wsb + a.off[R_O]);
        if (tid == 0) F.MISC[16] = __hip_atomic_fetch_add(head, 1u, RLX_AGENT);
        __syncthreads();
        const int u = (int)F.MISC[16];
        __syncthreads();
        if (u >= ATT_NPU + ATT_NSU) break;
        if (u < ATT_NPU) {
            const int qb = (ATT_NQB - 1) - u / 32, bvh = u % 32, b = bvh >> 4, vh = bvh & 15, h = vh >> 2, c = (vh >> 1) & 1, half = vh & 1;
            build_bias_table((LAS float*)(F.lds + RING_OFF + attn_body::LDS_BT), GIN(a, I_REL), h, tid);
            __syncthreads();
            attn_body::attn_unit<8>(b, h * 128 + c * 64, ZC_VA + h * 128 + half * 64, h * 256 + c * 128 + half * 64, qb, QN, KN, Z, O, (char*)ldsg + RING_OFF, F.wv);
        } else { const int su = u - ATT_NPU; attn_sample_unit(F, l, su >> 2, su & 3); }
    }
}
__device__ __forceinline__ void p_mixpost_a(Frame& F, int l) {
    const KArgs ap = kargs(); const auto& a = *ap; WS_OPAQUE(a);
    const int tid = otid(), lane = tid & 63, wave = __builtin_amdgcn_readfirstlane(tid >> 6);
    const bf16* O = (const bf16*)(wsb + a.off[R_O]); bf16* OA = (bf16*)(wsb + a.off[R_OA]);
    const int gw = F.vcu * NWAVES + wave, NGW = F.G * NWAVES;
    const float lam = lam_dev(GIN(a, I_LQK), l, lane), post = 1.f - lam_init_dev(l);
    const int h = lane >> 4, e0 = 8 * (lane & 15);
    float sg[8];
#pragma unroll
    for (int j = 0; j < 8; ++j) sg[j] = GIN(a, I_SUBLN)[l * 2 * HEAD_DIM_A + e0 + j] * post;
    for (int m = gw; m < RP; m += NGW) {
        float o0[8], o1[8], d[8];
        unpack8(*(const GAS v4u*)(O + (size_t)m * 1024 + h * 256 + e0), o0); unpack8(*(const GAS v4u*)(O + (size_t)m * 1024 + h * 256 + 128 + e0), o1);
        float ss = 0.f;
#pragma unroll
        for (int j = 0; j < 8; ++j) { d[j] = o0[j] - lam * o1[j]; ss += d[j] * d[j]; }
        ss = sum16(ss);
        const float r = __builtin_amdgcn_rsqf(ss * (1.f / 128.f) + EPSF);
#pragma unroll
        for (int j = 0; j < 8; ++j) d[j] = d[j] * r * sg[j];
        *(GAS v4u*)(OA + (size_t)m * WIDTH_A + h * 128 + e0) = pack8(d);
    }
}
constexpr int GDN_NCH = PEND / 64;
constexpr int GDN_NPI = BATCH * N_HEADS_B * GDN_NCH;
constexpr int GDN_NSI = DEC_BATCH * N_HEADS_B;
constexpr int GDN_NI = GDN_NPI + GDN_NSI;
constexpr int GI_W = 0, GI_QG = 16384, GI_KG = 32768, GI_AT = 49152, GI_U = 57344, GI_SC = 73728, GI_STRIDE = 73984, GI_EG = 2048  ;
static_assert(GDN_NI % 4 == 0 && PEND % 64 == 0, "gdn items");
__device__ __forceinline__ int frag_off(int row, int kk, int nkb) {
    const int fid = ((row >> 5) * nkb + (kk >> 5)) * 2 + ((kk & 31) >> 4), ln = (row & 31) + 32 * (((kk & 15) >> 2) & 1), j = ((kk & 15) >> 3) * 4 + (kk & 3);
    return (fid * 64 + ln) * 8 + j;
}
__device__ __forceinline__ int gdn_item_row(int item, int j) {
    if (item < GDN_NPI) { const int sh = item / GDN_NCH, n = item % GDN_NCH; return (sh / N_HEADS_B) * LPP + 64 * n + j; }
    const int s = item - GDN_NPI; return j < 32 ? -1 : SROW0 + (s >> 2) * DEC_SEQ + (j - 32);
}
__device__ __forceinline__ int gdn_item_head(int item) { return item < GDN_NPI ? (item / GDN_NCH) % N_HEADS_B : (item - GDN_NPI) & 3; }

__device__ __forceinline__ void gdn_flush(const LAS unsigned char* stg, unsigned char* dst, int nbytes, int gt) {
    for (int o = gt * 16; o < nbytes; o += 2048) *(GAS v4u*)(dst + o) = *(const LAS v4u*)(stg + o);
}
typedef float f32x2s __attribute__((ext_vector_type(2)));
#define GDN_RL8(a, arow, jb) asm volatile("v_readlane_b32 %0, %8, %9\n\tv_readlane_b32 %1, %8, %10\n\tv_readlane_b32 %2, %8, %11\n\tv_readlane_b32 %3, %8, %12\n\tv_readlane_b32 %4, %8, %13\n\tv_readlane_b32 %5, %8, %14\n\tv_readlane_b32 %6, %8, %15\n\tv_readlane_b32 %7, %8, %16" \
    : "=s"(a[0]), "=s"(a[1]), "=s"(a[2]), "=s"(a[3]), "=s"(a[4]), "=s"(a[5]), "=s"(a[6]), "=s"(a[7]) : "v"(arow), "i"(jb), "i"((jb) + 1), "i"((jb) + 2), "i"((jb) + 3), "i"((jb) + 4), "i"((jb) + 5), "i"((jb) + 6), "i"((jb) + 7))
template <int I, int JB> __device__ __forceinline__ void gdn_subst_blk(f32x2s (&x)[64], float arow) {
    if constexpr (JB < I) { float ar[8]; GDN_RL8(ar, arow, JB);
#pragma unroll
        for (int t = 0; t < 8; ++t) if (JB + t < I) x[I] -= ar[t] * x[JB + t];
        gdn_subst_blk<I, JB + 8>(x, arow); }
}
template <int... Is> __device__ __forceinline__ void gdn_subst_all(f32x2s (&x)[64], const LAS float* A, int lane, std::integer_sequence<int, Is...>) {
    (gdn_subst_blk<Is + 1, 0>(x, A[(Is + 1) * 64 + lane]), ...);
}
template <int MODE> __device__ __forceinline__ void p_gdn_chunk(Frame& F, int l, int q) {
    const KArgs ap = kargs(); const auto& a = *ap; WS_OPAQUE(a);
    const int tid = otid(), wave = __builtin_amdgcn_readfirstlane(tid >> 6), grp = wave >> 1, gw = wave & 1;
    const bf16* QKVB = (const bf16*)(wsb + a.off[R_QKVB]); const float* BG = (const float*)(wsb + a.off[R_BG]); unsigned char* GD = wsb + a.off[R_GDN];
    LAS float* A_lds = (LAS float*)(F.lds + RING_OFF + grp * 34816);
    LAS float* Gs = A_lds + 4096; LAS float* Bs = Gs + 64; LAS float* Es = Bs + 64;
    LAS unsigned char* stg = (LAS unsigned char*)(A_lds + 4096 + 256);
    LAS bf16* stgh = (LAS bf16*)stg;
    static_assert(4 * 34816 <= RING_BYTES && GDN_NI % 4 == 0, "gdn chunk LDS / items");
    for (int pr = MODE == 0 ? F.vcu : q; MODE == 0 ? pr < (GDN_NPI - BATCH * N_HEADS_B) / 4 : pr == q; pr += (MODE == 0 ? F.G : 1 << 20)) {
        int lane_ = otid() & 63;
        const int lane = lane_, r32 = lane & 31, hi = lane >> 5, gt = gw * 64 + lane;
        int item;
        if (MODE == 0) { const int j = 4 * pr + grp; item = (j >> 7) * GDN_NCH + (j & 127); }
        else item = q < 16 ? GDN_NPI + 4 * q + grp : (4 * (q - 16) + grp) * GDN_NCH + (GDN_NCH - 1);
        const int h = gdn_item_head(item);
        unsigned char* ib = GD + (size_t)item * GI_STRIDE;
        const int rowt = gdn_item_row(item, lane);
        const float beta = rowt >= 0 ? BG[(size_t)rowt * 8 + h] : 0.f; float G = rowt >= 0 ? BG[(size_t)rowt * 8 + 4 + h] : 0.f;
        G = scan64(G);
        const float Glast = rdlane(G, 63), eG = __expf(G);
        if (gw == 0) { Gs[lane] = G; Bs[lane] = beta; Es[lane] = eG; }
        __syncthreads();
#pragma unroll
        for (int bq = 0; bq < 2; ++bq) {
          const int i0 = 32 * gw, j0 = 32 * bq; const int j = j0 + r32;
          if (gw == 0 && bq == 1) {
#pragma unroll
              for (int r = 0; r < 16; ++r) { const int i = crow_dev(r, hi); A_lds[i * 64 + j] = 0.f; stgh[frag_off(i, j, 2)] = (bf16)0; }
              LDS_WAIT(); if (lane == 0) *(LAS float*)(stg + GI_EG) = __expf(Glast);
          } else {
          const int ra = gdn_item_row(item, i0 + r32), rb = gdn_item_row(item, j0 + r32);
          f32x16 akk, aqk;
#pragma unroll
          for (int r = 0; r < 16; ++r) { akk[r] = 0.f; aqk[r] = 0.f; }
          const bf16x8 zf = {0, 0, 0, 0, 0, 0, 0, 0};
#pragma unroll
          for (int s = 0; s < 8; ++s) {
              const bf16x8 qa = ra >= 0 ? *(const GAS bf16x8*)(QKVB + (size_t)ra * 1536 + h * 128 + 16 * s + 8 * hi) : zf;
              const bf16x8 ka = ra >= 0 ? *(const GAS bf16x8*)(QKVB + (size_t)ra * 1536 + 512 + h * 128 + 16 * s + 8 * hi) : zf;
              const bf16x8 kb = rb >= 0 ? *(const GAS bf16x8*)(QKVB + (size_t)rb * 1536 + 512 + h * 128 + 16 * s + 8 * hi) : zf;
              akk = __builtin_amdgcn_mfma_f32_32x32x16_bf16(ka, kb, akk, 0, 0, 0); aqk = __builtin_amdgcn_mfma_f32_32x32x16_bf16(qa, kb, aqk, 0, 0, 0);
          }
          const float Gj = Gs[j];
#pragma unroll
          for (int r = 0; r < 16; ++r) { const int i = i0 + crow_dev(r, hi); const float dec = i >= j ? __expf(Gs[i] - Gj) : 0.f;
              A_lds[i * 64 + j] = i > j ? Bs[i] * akk[r] * dec : 0.f;
              stgh[frag_off(i, j, 2)] = (bf16)f2bf(aqk[r] * dec); }
          }
        }
        __syncthreads();
        gdn_flush(stg, ib + GI_AT, 8192, gt);
        { f32x2s x[64]; const int cbase = gw == 0 ? 1024 + h * 128 : 512 + h * 128;
#pragma unroll
          for (int i = 0; i < 64; ++i) { const int ri = __builtin_amdgcn_readfirstlane(gdn_item_row(item, i));
              const bf16* rowp = QKVB + (size_t)(ri < 0 ? 0 : ri) * 1536 + cbase;
              x[i] = ri >= 0 ? (f32x2s){bf2f(rowp[lane]), bf2f(rowp[lane + 64])} : (f32x2s){0.f, 0.f}; }
          const float rsc = gw == 0 ? beta : beta * eG;
#pragma unroll
          for (int i = 0; i < 64; ++i) x[i] *= rdlane(rsc, i);
          gdn_subst_all(x, A_lds, lane, std::make_integer_sequence<int, 63>{});
          __syncthreads();
          if (gw == 0) { GAS bf16* ub = (GAS bf16*)(ib + GI_U) + lane; asm volatile("" : "+v"(ub));
#pragma unroll
              for (int i = 0; i < 64; ++i) { ub[i * 128] = (bf16)f2bf(x[i].x); ub[i * 128 + 64] = (bf16)f2bf(x[i].y); } }
          else { LAS bf16* wb0 = stgh + frag_off(0, lane, 4); LAS bf16* wb1 = stgh + frag_off(0, lane + 64, 4);
#pragma unroll
              for (int i = 0; i < 64; ++i) { wb0[(i >> 5) * 4096 + (i & 31) * 8] = (bf16)f2bf(x[i].x); wb1[(i >> 5) * 4096 + (i & 31) * 8] = (bf16)f2bf(x[i].y); } }
        }
        __syncthreads();
        gdn_flush(stg, ib + GI_W, 16384, gt);
        __syncthreads();
        const float kgs = __expf(Glast - G);
#pragma unroll
        for (int hf = 0; hf < 2; ++hf) { float qv[32];
#pragma unroll
          for (int it = 0; it < 32; ++it) { const int c = it + 32 * hf, rc = __builtin_amdgcn_readfirstlane(gdn_item_row(item, c)); const bf16* rowp = QKVB + (size_t)(rc < 0 ? 0 : rc) * 1536 + h * 128; qv[it] = rc >= 0 ? bf2f(rowp[gt]) : 0.f; }
#pragma unroll
          for (int it = 0; it < 32; ++it) { const int c = it + 32 * hf; stgh[frag_off(c, gt, 4)] = (bf16)f2bf(qv[it] * rdlane(eG, c)); } }
        __syncthreads();
        gdn_flush(stg, ib + GI_QG, 16384, gt);
        __syncthreads();
#pragma unroll
        for (int hf = 0; hf < 2; ++hf) { float kv[32];
#pragma unroll
          for (int it = 0; it < 32; ++it) { const int c = it + 32 * hf, rc = __builtin_amdgcn_readfirstlane(gdn_item_row(item, c)); const bf16* rowp = QKVB + (size_t)(rc < 0 ? 0 : rc) * 1536 + 512 + h * 128; kv[it] = rc >= 0 ? bf2f(rowp[gt]) : 0.f; }
#pragma unroll
          for (int it = 0; it < 32; ++it) { const int c = it + 32 * hf; stgh[frag_off(gt, c, 2)] = (bf16)f2bf(kv[it] * rdlane(kgs, c)); } }
        __syncthreads();
        gdn_flush(stg, ib + GI_KG, 16384, gt);
        VM_WAIT(); __syncthreads();
        if (MODE == 1 && q >= 16) {
            if (wave == 0 && (otid() & 63) == 0) { __builtin_amdgcn_fence(__ATOMIC_RELEASE, "agent"); asm volatile("s_waitcnt vmcnt(0)" ::: "memory");
                gu32* fl = (gu32*)wsb + CW_GDNFLAG;
#pragma unroll
                for (int c = 0; c < 4; ++c) __hip_atomic_store(fl + 64 * (4 * (q - 16) + c), (unsigned)(l + 1), RLX_AGENT); } }
    }
}

__device__ __forceinline__ void gdn_chain(const unsigned char* GD, bf16* OB, const float* sdelta, float* dout, int item0, int nch, int h, int vb, int lane) {
    const int r32 = lane & 31, hi = lane >> 5;
    f32x16 S[4];
#pragma unroll
    for (int kb = 0; kb < 4; ++kb)
#pragma unroll
        for (int r = 0; r < 16; ++r) S[kb][r] = sdelta ? sdelta[(size_t)(kb * 32 + crow_dev(r, hi)) * HEAD_DIM_B + vb * 32 + r32] : 0.f;
    for (int n = 0; n < nch; ++n) {
        const int item = item0 + n; const unsigned char* ib = GD + (size_t)item * GI_STRIDE;
        const float eGl = *(const float*)(ib + GI_AT + GI_EG);
        const GAS bf16x8* WF = (const GAS bf16x8*)(ib + GI_W) + lane; const GAS bf16x8* QF = (const GAS bf16x8*)(ib + GI_QG) + lane;
        const GAS bf16x8* KF = (const GAS bf16x8*)(ib + GI_KG) + lane; const GAS bf16x8* AF = (const GAS bf16x8*)(ib + GI_AT) + lane; const bf16* U = (const bf16*)(ib + GI_U);
        bf16x8 Sp[4][2];
#pragma unroll
        for (int kb = 0; kb < 4; ++kb)
#pragma unroll
            for (int s = 0; s < 2; ++s) { v4u w; w.x = pk2(S[kb][8 * s], S[kb][8 * s + 1]); w.y = pk2(S[kb][8 * s + 2], S[kb][8 * s + 3]); w.z = pk2(S[kb][8 * s + 4], S[kb][8 * s + 5]); w.w = pk2(S[kb][8 * s + 6], S[kb][8 * s + 7]); Sp[kb][s] = __builtin_bit_cast(bf16x8, w); }
        f32x16 vn[2], ot[2];
#pragma unroll
        for (int cb = 0; cb < 2; ++cb) {
            f32x16 ws;
#pragma unroll
            for (int r = 0; r < 16; ++r) { ws[r] = 0.f; ot[cb][r] = 0.f; }
#pragma unroll
            for (int kb = 0; kb < 4; ++kb)
#pragma unroll
                for (int s = 0; s < 2; ++s) { ws = __builtin_amdgcn_mfma_f32_32x32x16_bf16(WF[((cb * 4 + kb) * 2 + s) * 64], Sp[kb][s], ws, 0, 0, 0);
                    ot[cb] = __builtin_amdgcn_mfma_f32_32x32x16_bf16(QF[((cb * 4 + kb) * 2 + s) * 64], Sp[kb][s], ot[cb], 0, 0, 0); }
#pragma unroll
            for (int r = 0; r < 16; ++r) vn[cb][r] = bf2f(U[(cb * 32 + crow_dev(r, hi)) * 128 + vb * 32 + r32]) - ws[r];
        }
        bf16x8 Vp[2][2];
#pragma unroll
        for (int cb = 0; cb < 2; ++cb)
#pragma unroll
            for (int s = 0; s < 2; ++s) { v4u w; w.x = pk2(vn[cb][8 * s], vn[cb][8 * s + 1]); w.y = pk2(vn[cb][8 * s + 2], vn[cb][8 * s + 3]); w.z = pk2(vn[cb][8 * s + 4], vn[cb][8 * s + 5]); w.w = pk2(vn[cb][8 * s + 6], vn[cb][8 * s + 7]); Vp[cb][s] = __builtin_bit_cast(bf16x8, w); }
#pragma unroll
        for (int cb = 0; cb < 2; ++cb)
#pragma unroll
            for (int c2 = 0; c2 <= cb; ++c2)
#pragma unroll
                for (int s = 0; s < 2; ++s) ot[cb] = __builtin_amdgcn_mfma_f32_32x32x16_bf16(AF[((cb * 2 + c2) * 2 + s) * 64], Vp[c2][s], ot[cb], 0, 0, 0);
#pragma unroll
        for (int cb = 0; cb < 2; ++cb)
#pragma unroll
            for (int r = 0; r < 16; ++r) { const int row = gdn_item_row(item, cb * 32 + crow_dev(r, hi)); if (row >= 0) OB[(size_t)row * WIDTH_B + h * 128 + vb * 32 + r32] = (bf16)f2bf(ot[cb][r]); }
#pragma unroll
        for (int kb = 0; kb < 4; ++kb) {
#pragma unroll
            for (int r = 0; r < 16; ++r) S[kb][r] *= eGl;
#pragma unroll
            for (int cb = 0; cb < 2; ++cb)
#pragma unroll
                for (int s = 0; s < 2; ++s) S[kb] = __builtin_amdgcn_mfma_f32_32x32x16_bf16(KF[((kb * 2 + cb) * 2 + s) * 64], Vp[cb][s], S[kb], 0, 0, 0);
        }
    }
#pragma unroll
    for (int kb = 0; kb < 4; ++kb)
#pragma unroll
        for (int r = 0; r < 16; ++r) dout[(size_t)(kb * 32 + crow_dev(r, hi)) * HEAD_DIM_B + vb * 32 + r32] = S[kb][r];
}
constexpr int GCH_BUF = 73728, GCH_PCS = 18;
#define GCH_BAR() do { asm volatile("s_waitcnt lgkmcnt(0)" ::: "memory"); __builtin_amdgcn_s_barrier(); asm volatile("" ::: "memory"); } while (0)
__device__ __forceinline__ void gdn_chain_wg(Frame& F, const unsigned char* GD, bf16* OB, float* dout, int item0, int h, gu32* flag, unsigned epoch) {
    const int tid = otid(), lane = tid & 63, wave = __builtin_amdgcn_readfirstlane(tid >> 6), r32 = lane & 31, hi = lane >> 5, vb = wave & 3;
    LAS unsigned char* lb = F.lds + RING_OFF;
    if (wave >= 4) {
        const int p0 = (wave - 4) * GCH_PCS;
        v4u R0[GCH_PCS], R1[GCH_PCS];
#define GCH_LOAD(R, c) do { if ((c) == GDN_NCH - 1) { unsigned sp_ = 0; while (__hip_atomic_load(flag, RLX_AGENT) != epoch) { __builtin_amdgcn_s_sleep(2); if (++sp_ > (1u << 22)) break; } \
            __builtin_amdgcn_fence(__ATOMIC_ACQUIRE, "agent"); asm volatile("s_waitcnt vmcnt(0)" ::: "memory"); }     \
            const unsigned char* s_ = GD + (size_t)(item0 + (c)) * GI_STRIDE + (size_t)p0 * 1024 + lane * 16; _Pragma("unroll") for (int j = 0; j < GCH_PCS; ++j) \
            asm volatile("global_load_dwordx4 %0, %1, off" : "=&v"(R[j]) : "v"(s_ + j * 1024) : "memory"); } while (0)
#define GCH_PUT(R, c) do { if ((c) + 1 < GDN_NCH) asm volatile("s_waitcnt vmcnt(18)" ::: "memory"); else asm volatile("s_waitcnt vmcnt(0)" ::: "memory"); \
            LAS v4u* d_ = (LAS v4u*)(lb + ((c) & 1) * GCH_BUF + p0 * 1024) + lane; _Pragma("unroll") for (int j = 0; j < GCH_PCS; ++j) d_[j * 64] = R[j]; } while (0)
        GCH_LOAD(R0, 0); GCH_LOAD(R1, 1);
        GCH_PUT(R0, 0); GCH_LOAD(R0, 2);
        GCH_BAR();
        for (int n = 0; n < GDN_NCH; n += 2) {
            if (n + 1 < GDN_NCH) GCH_PUT(R1, n + 1);
            if (n + 3 < GDN_NCH) GCH_LOAD(R1, n + 3);
            GCH_BAR();
            if (n + 1 < GDN_NCH) {
                if (n + 2 < GDN_NCH) GCH_PUT(R0, n + 2);
                if (n + 4 < GDN_NCH) GCH_LOAD(R0, n + 4);
                GCH_BAR(); }
        }
        asm volatile("s_waitcnt vmcnt(0)" ::: "memory");
#undef GCH_LOAD
#undef GCH_PUT
        return;
    }
    f32x16 S[4];
#pragma unroll
    for (int kb = 0; kb < 4; ++kb)
#pragma unroll
        for (int r = 0; r < 16; ++r) S[kb][r] = 0.f;
    GCH_BAR();
    for (int n = 0; n < GDN_NCH; ++n) {
        const int item = item0 + n; const LAS unsigned char* bufc = lb + (n & 1) * GCH_BUF;
        const float egl = *(const LAS float*)(bufc + GI_AT + GI_EG);
        const LAS bf16x8* WF = (const LAS bf16x8*)(bufc + GI_W) + lane; const LAS bf16x8* QF = (const LAS bf16x8*)(bufc + GI_QG) + lane;
        const LAS bf16x8* KF = (const LAS bf16x8*)(bufc + GI_KG) + lane; const LAS bf16x8* AF = (const LAS bf16x8*)(bufc + GI_AT) + lane; const LAS bf16* U = (const LAS bf16*)(bufc + GI_U);
        bf16x8 Sp[4][2];
#pragma unroll
        for (int kb = 0; kb < 4; ++kb)
#pragma unroll
            for (int s = 0; s < 2; ++s) { v4u w; w.x = pk2(S[kb][8 * s], S[kb][8 * s + 1]); w.y = pk2(S[kb][8 * s + 2], S[kb][8 * s + 3]); w.z = pk2(S[kb][8 * s + 4], S[kb][8 * s + 5]); w.w = pk2(S[kb][8 * s + 6], S[kb][8 * s + 7]); Sp[kb][s] = __builtin_bit_cast(bf16x8, w); }
        f32x16 vn[2], ot[2];
#pragma unroll
        for (int cb = 0; cb < 2; ++cb) {
            f32x16 ws;
#pragma unroll
            for (int r = 0; r < 16; ++r) { ws[r] = 0.f; ot[cb][r] = 0.f; }
#pragma unroll
            for (int kb = 0; kb < 4; ++kb)
#pragma unroll
                for (int s = 0; s < 2; ++s) { ws = __builtin_amdgcn_mfma_f32_32x32x16_bf16(WF[((cb * 4 + kb) * 2 + s) * 64], Sp[kb][s], ws, 0, 0, 0);
                    ot[cb] = __builtin_amdgcn_mfma_f32_32x32x16_bf16(QF[((cb * 4 + kb) * 2 + s) * 64], Sp[kb][s], ot[cb], 0, 0, 0); }
#pragma unroll
            for (int r = 0; r < 16; ++r) vn[cb][r] = bf2f(U[(cb * 32 + crow_dev(r, hi)) * 128 + vb * 32 + r32]) - ws[r];
        }
        bf16x8 Vp[2][2];
#pragma unroll
        for (int cb = 0; cb < 2; ++cb)
#pragma unroll
            for (int s = 0; s < 2; ++s) { v4u w; w.x = pk2(vn[cb][8 * s], vn[cb][8 * s + 1]); w.y = pk2(vn[cb][8 * s + 2], vn[cb][8 * s + 3]); w.z = pk2(vn[cb][8 * s + 4], vn[cb][8 * s + 5]); w.w = pk2(vn[cb][8 * s + 6], vn[cb][8 * s + 7]); Vp[cb][s] = __builtin_bit_cast(bf16x8, w); }
#pragma unroll
        for (int cb = 0; cb < 2; ++cb)
#pragma unroll
            for (int c2 = 0; c2 <= cb; ++c2)
#pragma unroll
                for (int s = 0; s < 2; ++s) ot[cb] = __builtin_amdgcn_mfma_f32_32x32x16_bf16(AF[((cb * 2 + c2) * 2 + s) * 64], Vp[c2][s], ot[cb], 0, 0, 0);
        { const int row0 = gdn_item_row(item, 0);
#pragma unroll
          for (int cb = 0; cb < 2; ++cb)
#pragma unroll
              for (int r = 0; r < 16; ++r) OB[(size_t)(row0 + cb * 32 + crow_dev(r, hi)) * WIDTH_B + h * 128 + vb * 32 + r32] = (bf16)f2bf(ot[cb][r]); }
#pragma unroll
        for (int kb = 0; kb < 4; ++kb) {
#pragma unroll
            for (int r = 0; r < 16; ++r) S[kb][r] *= egl;
#pragma unroll
            for (int cb = 0; cb < 2; ++cb)
#pragma unroll
                for (int s = 0; s < 2; ++s) S[kb] = __builtin_amdgcn_mfma_f32_32x32x16_bf16(KF[((kb * 2 + cb) * 2 + s) * 64], Vp[cb][s], S[kb], 0, 0, 0);
        }
        GCH_BAR();
    }
#pragma unroll
    for (int kb = 0; kb < 4; ++kb)
#pragma unroll
        for (int r = 0; r < 16; ++r) dout[(size_t)(kb * 32 + crow_dev(r, hi)) * HEAD_DIM_B + vb * 32 + r32] = S[kb][r];
}
__device__ __forceinline__ void p_gdn_chain(Frame& F, int l) {
    const KArgs ap = kargs(); const auto& a = *ap; WS_OPAQUE(a);
    const unsigned char* GD = wsb + a.off[R_GDN]; bf16* OB = (bf16*)(wsb + a.off[R_OB]);
    if (F.vcu % 32 == 0 && F.vcu / 32 < BATCH * N_HEADS_B) { const int sh = F.vcu / 32, sq = sh / N_HEADS_B, h = sh % N_HEADS_B;
        gdn_chain_wg(F, GD, OB, GOUT(a) + O_DP + (((size_t)l * BATCH + sq) * N_HEADS_B + h) * HEAD_DIM_B * HEAD_DIM_B, sh * GDN_NCH, h, (gu32*)wsb + CW_GDNFLAG + 64 * sh, (unsigned)(l + 1)); }
    else { const int q = F.vcu - F.vcu / 32 - 1;
        if (q < 18) { p_gdn_chunk<1>(F, l, q);
            if (q < 16) { const int tid = otid(), lane = tid & 63, wave = __builtin_amdgcn_readfirstlane(tid >> 6);
#pragma unroll
                for (int tt = 0; tt < 2; ++tt) { const int t = wave + 8 * tt, s = 4 * q + (t >> 2), vb = t & 3, bs = s >> 2, h = s & 3; const size_t so = (((size_t)l * DEC_BATCH + bs) * N_HEADS_B + h) * HEAD_DIM_B * HEAD_DIM_B;
                    gdn_chain(GD, OB, GIN(a, I_SDELTA) + so, GOUT(a) + O_DS + so, GDN_NPI + s, 1, h, vb, lane); } } } }
}
__device__ __forceinline__ void p_mixpost_b(Frame& F, int l) {
    const KArgs ap = kargs(); const auto& a = *ap; WS_OPAQUE(a);
    const int tid = otid(), lane = tid & 63, wave = __builtin_amdgcn_readfirstlane(tid >> 6);
    const bf16* OB = (const bf16*)(wsb + a.off[R_OB]); bf16* OBN = (bf16*)(wsb + a.off[R_OBN]); const bf16* Z = (const bf16*)(wsb + a.off[R_Z]);
    const int gw = F.vcu * NWAVES + wave, NGW = F.G * NWAVES, e0 = 8 * (lane & 15);
    float gn[8];
#pragma unroll
    for (int j = 0; j < 8; ++j) gn[j] = GIN(a, I_GDNN)[l * HEAD_DIM_B + e0 + j];
    for (int m = gw; m < RP; m += NGW) {
        float o[8], gt[8];
        unpack8(*(const GAS v4u*)(OB + (size_t)m * WIDTH_B + 8 * lane), o); unpack8(*(const GAS v4u*)(Z + (size_t)m * ZN + ZC_GB + 8 * lane), gt);
        float ss = 0.f;
#pragma unroll
        for (int j = 0; j < 8; ++j) ss += o[j] * o[j];
        ss = sum16(ss);
        const float r = __builtin_amdgcn_rsqf(ss * (1.f / 128.f) + EPSF);
#pragma unroll
        for (int j = 0; j < 8; ++j) o[j] = o[j] * r * gn[j] * gt[j] * sigm(gt[j]);
        *(GAS v4u*)(OBN + (size_t)m * WIDTH_B + 8 * lane) = pack8(o);
    }
}
constexpr int S5_M1 = 0, S5_M2 = 131072, S5_M3 = 196608, S5_L16 = 262144, S5_TSTRIDE = 262656;
constexpr int S5_NCHK = RP / 16;
constexpr int S5_NBLK = S5_NCHK / 32;
constexpr int S5_PCH = PEND / 16;
static_assert(S5_NCHK % 32 == 0 && LPP % 16 == 0 && PADF % 16 == 0 && S5_STATE == 64 && S5_GROUPS == 32, "s5 shapes");

__device__ __forceinline__ void s5_tables(Frame& F) {
    const KArgs ap = kargs(); const auto& a = *ap; WS_OPAQUE(a);
    const int tid = otid();
    LAS float* pw = (LAS float*)(F.lds + RING_OFF);
    LAS float* bb = pw + 17 * 128;
    LAS float* Kt = bb + 64 * 32;
    for (int it = F.vcu; it < DEPTH * S5_GROUPS; it += F.G) {
        const int l = it / S5_GROUPS, g = it % S5_GROUPS; const size_t gp = ((size_t)l * S5_GROUPS + g) * S5_STATE;
        unsigned char* tb = wsb + a.off[R_S5T] + (size_t)it * S5_TSTRIDE;
        const float dt = __expf(GIN(a, I_LDT)[l * S5_GROUPS + g]);
        for (int e = tid; e < 17 * 64; e += NTHR) { const int k = e >> 6, p = e & 63; const float ar = GIN(a, I_AR)[gp + p] * dt * (float)k, ai = GIN(a, I_AI)[gp + p] * dt * (float)k;
            float sn, cs; sincosf(ai, &sn, &cs); const float er = expf(ar); pw[e * 2] = er * cs; pw[e * 2 + 1] = er * sn; }
        __syncthreads();
        for (int e = tid; e < 64 * 16; e += NTHR) { const int p = e >> 4; const float ar = GIN(a, I_AR)[gp + p], ai = GIN(a, I_AI)[gp + p];
            const float nr = pw[(64 + p) * 2] - 1.f, ni = pw[(64 + p) * 2 + 1], den = ar * ar + ai * ai, fr = (nr * ar + ni * ai) / den, fi = (ni * ar - nr * ai) / den;
            const float br = GIN(a, I_BR)[gp * 16 + e], bi = GIN(a, I_BI)[gp * 16 + e]; bb[e * 2] = fr * br - fi * bi; bb[e * 2 + 1] = fr * bi + fi * br; }
        if (tid < 128) { const int p = tid & 63; ((float*)(tb + S5_L16))[tid] = pw[(16 * 64 + p) * 2 + (tid >> 6)]; }
        __syncthreads();
        const float* cre = GIN(a, I_CR) + ((size_t)l * S5_GROUPS + g) * 16 * 64; const float* cim = GIN(a, I_CI) + ((size_t)l * S5_GROUPS + g) * 16 * 64;
        for (int e = tid; e < 4096; e += NTHR) { const int d = e >> 8, i = (e >> 4) & 15, j = e & 15; float acc = 0.f;
            for (int p = 0; p < 64; ++p) { const float cr = cre[i * 64 + p], ci = cim[i * 64 + p], pr = pw[(d * 64 + p) * 2], pi = pw[(d * 64 + p) * 2 + 1];
                const float tr = cr * pr - ci * pi, ti = cr * pi + ci * pr; acc += tr * bb[(p * 16 + j) * 2] - ti * bb[(p * 16 + j) * 2 + 1]; }
            Kt[e] = acc; }
        __syncthreads();
        bf16* M1 = (bf16*)(tb + S5_M1); bf16* M2 = (bf16*)(tb + S5_M2); bf16* M3 = (bf16*)(tb + S5_M3);
        for (int e = tid; e < 65536; e += NTHR) { const int n = e >> 8, k = e & 255, tau = n >> 4, i = n & 15, sg = k >> 4, j = k & 15;
            float v = 0.f; if (sg <= tau) { v = Kt[((tau - sg) * 16 + i) * 16 + j]; if (sg == tau && i == j) v += GIN(a, I_SD)[(l * S5_GROUPS + g) * 16 + i]; }
            M1[e] = (bf16)f2bf(v); }
        for (int e = tid; e < 32768; e += NTHR) { const int n = e >> 8, k = e & 255, ri = n >> 6, p = n & 63, sg = k >> 4, j = k & 15;
            const float pr = pw[((15 - sg) * 64 + p) * 2], pi = pw[((15 - sg) * 64 + p) * 2 + 1], br = bb[(p * 16 + j) * 2], bi = bb[(p * 16 + j) * 2 + 1];
            M2[e] = (bf16)f2bf(ri == 0 ? pr * br - pi * bi : pr * bi + pi * br); }
        for (int e = tid; e < 32768; e += NTHR) { const int n = e >> 7, k = e & 127, tau = n >> 4, i = n & 15, ri = k >> 6, p = k & 63;
            const float cr = cre[i * 64 + p], ci = cim[i * 64 + p], pr = pw[((tau + 1) * 64 + p) * 2], pi = pw[((tau + 1) * 64 + p) * 2 + 1];
            M3[e] = (bf16)f2bf(ri == 0 ? cr * pr - ci * pi : -(cr * pi + ci * pr)); }
        __syncthreads();
    }
}
__device__ __forceinline__ void p_s5_e(Frame& F, int l) {
    const KArgs ap = kargs(); const auto& a = *ap; WS_OPAQUE(a);
    const int tid = otid(), lane = tid & 63, wave = __builtin_amdgcn_readfirstlane(tid >> 6), r32 = lane & 31, hi = lane >> 5;
    const bf16* Z = (const bf16*)(wsb + a.off[R_Z]); float* E = (float*)(wsb + a.off[R_S5E]);
    for (int u = F.vcu * NWAVES + wave; u < S5_NBLK * S5_GROUPS; u += F.G * NWAVES) {
        const int blk = u / S5_GROUPS, g = u % S5_GROUPS;
        const unsigned char* tb = wsb + a.off[R_S5T] + (size_t)(l * S5_GROUPS + g) * S5_TSTRIDE;
        const GAS bf16x8* M2 = (const GAS bf16x8*)(tb + S5_M2);
        const bf16* zr = Z + (size_t)((blk * 32 + r32) * 16) * ZN + ZC_UC + g * 16 + 8 * hi;
        f32x16 acc[4];
#pragma unroll
        for (int nb = 0; nb < 4; ++nb)
#pragma unroll
            for (int r = 0; r < 16; ++r) acc[nb][r] = 0.f;
#pragma unroll 4
        for (int sg = 0; sg < 16; ++sg) { const bf16x8 af = *(const GAS bf16x8*)(zr + (size_t)sg * ZN);
#pragma unroll
            for (int nb = 0; nb < 4; ++nb) acc[nb] = __builtin_amdgcn_mfma_f32_32x32x16_bf16(af, M2[((nb * 32 + r32) * 256 + sg * 16 + 8 * hi) >> 3], acc[nb], 0, 0, 0); }
#pragma unroll
        for (int nb = 0; nb < 4; ++nb)
#pragma unroll
            for (int r = 0; r < 16; ++r) E[((size_t)(blk * 32 + crow_dev(r, hi)) * S5_GROUPS + g) * 128 + nb * 32 + r32] = acc[nb][r];
    }
}
__device__ __forceinline__ void s5_scan_task(const float* E, bf16* XP, const float* l16, int g, int c0, int nch, float xr, float xi, float* ore, float* oim, int lane) {
    const float lr = l16[lane], li = l16[64 + lane];
    int c = 0;
    for (; c + 8 <= nch; c += 8) { float er[8], ei[8];
#pragma unroll
        for (int q = 0; q < 8; ++q) { const float* e = E + ((size_t)(c0 + c + q) * S5_GROUPS + g) * 128; er[q] = e[lane]; ei[q] = e[64 + lane]; }
#pragma unroll
        for (int q = 0; q < 8; ++q) { bf16* xp = XP + ((size_t)(c0 + c + q) * S5_GROUPS + g) * 128; xp[lane] = (bf16)f2bf(xr); xp[64 + lane] = (bf16)f2bf(xi);
            const float nr = lr * xr - li * xi + er[q], ni = lr * xi + li * xr + ei[q]; xr = nr; xi = ni; } }
    for (; c < nch; ++c) { const float* e = E + ((size_t)(c0 + c) * S5_GROUPS + g) * 128; bf16* xp = XP + ((size_t)(c0 + c) * S5_GROUPS + g) * 128; xp[lane] = (bf16)f2bf(xr); xp[64 + lane] = (bf16)f2bf(xi);
        const float nr = lr * xr - li * xi + e[lane], ni = lr * xi + li * xr + e[64 + lane]; xr = nr; xi = ni; }
    ore[lane] = xr; oim[lane] = xi;
}
constexpr int S5_NTASK = (BATCH + DEC_BATCH) * S5_GROUPS;
__device__ __forceinline__ void s5_scan_run(Frame& F, int l, int t, int lane) {
    const KArgs ap = kargs(); const auto& a = *ap; WS_OPAQUE(a);
    const int sq = t / S5_GROUPS, g = t % S5_GROUPS;
    const float* E = (const float*)(wsb + a.off[R_S5E]); bf16* XP = (bf16*)(wsb + a.off[R_S5X]);
    const float* l16 = (const float*)(wsb + a.off[R_S5T] + (size_t)(l * S5_GROUPS + g) * S5_TSTRIDE + S5_L16);
    if (sq < BATCH) { const size_t oo = (((size_t)l * BATCH + sq) * S5_GROUPS + g) * S5_STATE;
        s5_scan_task(E, XP, l16, g, sq * (LPP / 16), S5_PCH, 0.f, 0.f, GOUT(a) + O_SRP + oo, GOUT(a) + O_SIP + oo, lane); }
    else { const int bs = sq - BATCH; const size_t oo = (((size_t)l * DEC_BATCH + bs) * S5_GROUPS + g) * S5_STATE;
        s5_scan_task(E, XP, l16, g, SROW0 / 16 + bs * (DEC_SEQ / 16), DEC_SEQ / 16, GIN(a, I_SRE)[oo + lane], GIN(a, I_SIM)[oo + lane], GOUT(a) + O_SRS + oo, GOUT(a) + O_SIS + oo, lane); }
}
__device__ __forceinline__ float gelu_tanh(float x) { const float z = 0.7978845608028654f * (x + 0.044715f * x * x * x); const float t = 1.f - 2.f * __builtin_amdgcn_rcpf(__expf(2.f * z) + 1.f); return 0.5f * x * (1.f + t); }
__device__ __forceinline__ void p_s5_out(Frame& F, int l) {
    const KArgs ap = kargs(); const auto& a = *ap; WS_OPAQUE(a);
    const int tid = otid(), lane = tid & 63, wave = __builtin_amdgcn_readfirstlane(tid >> 6), r32 = lane & 31, hi = lane >> 5;
    const bf16* Z = (const bf16*)(wsb + a.off[R_Z]); const bf16* XP = (const bf16*)(wsb + a.off[R_S5X]); bf16* YC = (bf16*)(wsb + a.off[R_YC]);
    for (int u = F.vcu * NWAVES + wave; u < S5_NBLK * S5_GROUPS; u += F.G * NWAVES) {
        const int blk = u / S5_GROUPS, g = u % S5_GROUPS;
        const unsigned char* tb = wsb + a.off[R_S5T] + (size_t)(l * S5_GROUPS + g) * S5_TSTRIDE;
        const GAS bf16x8* M1 = (const GAS bf16x8*)(tb + S5_M1); const GAS bf16x8* M3 = (const GAS bf16x8*)(tb + S5_M3);
        const bf16* zr = Z + (size_t)((blk * 32 + r32) * 16) * ZN + ZC_UC + g * 16 + 8 * hi;
        const bf16* xr = XP + ((size_t)(blk * 32 + r32) * S5_GROUPS + g) * 128 + 8 * hi;
        f32x16 acc[8];
#pragma unroll
        for (int nb = 0; nb < 8; ++nb)
#pragma unroll
            for (int r = 0; r < 16; ++r) acc[nb][r] = 0.f;
#pragma unroll 2
        for (int sg = 0; sg < 16; ++sg) { const bf16x8 af = *(const GAS bf16x8*)(zr + (size_t)sg * ZN);
#pragma unroll
            for (int nb = 0; nb < 8; ++nb) acc[nb] = __builtin_amdgcn_mfma_f32_32x32x16_bf16(af, M1[((nb * 32 + r32) * 256 + sg * 16 + 8 * hi) >> 3], acc[nb], 0, 0, 0); }
#pragma unroll 2
        for (int s = 0; s < 8; ++s) { const bf16x8 af = *(const GAS bf16x8*)(xr + 16 * s);
#pragma unroll
            for (int nb = 0; nb < 8; ++nb) acc[nb] = __builtin_amdgcn_mfma_f32_32x32x16_bf16(af, M3[((nb * 32 + r32) * 128 + s * 16 + 8 * hi) >> 3], acc[nb], 0, 0, 0); }
#pragma unroll
        for (int nb = 0; nb < 8; ++nb)
#pragma unroll
            for (int r = 0; r < 16; ++r) { const int row = (blk * 32 + crow_dev(r, hi)) * 16 + 2 * nb + (r32 >> 4);
                YC[(size_t)row * WIDTH_C + g * 16 + (r32 & 15)] = (bf16)f2bf(gelu_tanh(acc[nb][r])); }
    }
}
__device__ __forceinline__ int rdlane_i(int v, int i) { return __builtin_amdgcn_readlane(v, i); }
constexpr float NEG_BIG = -3.0e38f;
__device__ __forceinline__ unsigned fkey(float v) { const unsigned u = __builtin_bit_cast(unsigned, v); return (u & 0x80000000u) ? ~u : (u | 0x80000000u); }
__device__ __forceinline__ int mbcnt64(unsigned long long m) { return __builtin_amdgcn_mbcnt_hi((unsigned)(m >> 32), __builtin_amdgcn_mbcnt_lo((unsigned)m, 0)); }
__device__ __forceinline__ void pro_wqs(Frame& F) {
    const KArgs ap = kargs(); const auto& a = *ap; WS_OPAQUE(a);
    const int tid = otid(), lane = tid & 63, wave = __builtin_amdgcn_readfirstlane(tid >> 6);
    bf16* WQ = (bf16*)(wsb + a.off[R_WQS]);
    for (int t = F.vcu * NWAVES + wave; t < DEPTH * 16 * 16; t += F.G * NWAVES) {
        const int l = t >> 8, hc = (t >> 4) & 15, kb = t & 15, k = kb * 64 + lane;
        const float* wr = GIN(a, I_PWQ) + ((size_t)l * D_MODEL + k) * PQ + hc * 128;
        float w[128];
#pragma unroll
        for (int d = 0; d < 128; d += 4) { const f32x4 v = *(const GAS f32x4*)(wr + d); w[d] = v.x; w[d + 1] = v.y; w[d + 2] = v.z; w[d + 3] = v.w; }
        const float* sk = GIN(a, I_PSK) + ((size_t)l * 16 + hc) * 128 * 128; const float g2k = GIN(a, I_N2)[(size_t)l * D_MODEL + k];
        bf16* o = WQ + ((size_t)l * PQ + hc * 128) * D_MODEL + k;
#pragma clang loop vectorize(disable) unroll(disable)
        for (int n = 0; n < 128; ++n) { const float* sr = sk + n * 128; float acc = 0.f;
#pragma unroll
            for (int d = 0; d < 128; ++d) acc += w[d] * sr[d];
            o[(size_t)n * D_MODEL] = (bf16)f2bf(acc * g2k); }
    }
}
__device__ __forceinline__ void pro_wrest(Frame& F) {
    const KArgs ap = kargs(); const auto& a = *ap; WS_OPAQUE(a);
    const int tid = otid(), lane = tid & 63, wave = __builtin_amdgcn_readfirstlane(tid >> 6);
    LAS float* scr = (LAS float*)(F.lds + RING_OFF + wave * 16384);
    const int gw = F.vcu * NWAVES + wave, NGW = F.G * NWAVES;
    bf16* WG = (bf16*)(wsb + a.off[R_WGLU]); bf16* WB = (bf16*)(wsb + a.off[R_WBR]); bf16* WO = (bf16*)(wsb + a.off[R_WOUT]);
    constexpr int IG = (512 / 64) * (1024 / 32), IB = IG, IO = (1024 / 64) * (1024 / 32), IL = IG + 3 * IB + IO;
    for (int it = gw; it < DEPTH * IL; it += NGW) { const int l = it / IL; int r = it % IL;
        if (r < IG) { transpose_item(GIN(a, I_WGLU) + (size_t)l * 512 * 1024, 1024, 512, WG + (size_t)l * 1024 * 512, 32 * (r % 32), 64 * (r / 32), CmGlu(), scr, lane); continue; } r -= IG;
        if (r < 3 * IB) { const int w = r / IB, q = r % IB; transpose_item(GIN(a, I_WBA + w) + (size_t)l * 512 * 1024, 1024, 512, WB + ((size_t)l * 3 + w) * 1024 * 512, 32 * (q % 32), 64 * (q / 32), CmId(), scr, lane); continue; } r -= 3 * IB;
        transpose_item(GIN(a, I_WOUT) + (size_t)l * 1024 * 1024, 1024, 1024, WO + (size_t)l * 1024 * 1024, 32 * (r % 32), 64 * (r / 32), CmId(), scr, lane); }
}
typedef float f32x2v __attribute__((ext_vector_type(2)));
__device__ __forceinline__ unsigned pk_i8(const f32x4 x, float inv) {
    const int a = (int)rintf(x.x * inv), b = (int)rintf(x.y * inv), c = (int)rintf(x.z * inv), d = (int)rintf(x.w * inv);
    return (unsigned)(a & 0xff) | ((unsigned)(b & 0xff) << 8) | ((unsigned)(c & 0xff) << 16) | ((unsigned)(d & 0xff) << 24); }
constexpr size_t PEER_ROWS = (size_t)DEPTH * N_EXPERTS;
__device__ __forceinline__ float absmax16(const f32x4 x0, const f32x4 x1, const f32x4 x2, const f32x4 x3) {
    float mx = fmaxf(fmaxf(fmaxf(fabsf(x0.x), fabsf(x0.y)), fmaxf(fabsf(x0.z), fabsf(x0.w))), fmaxf(fmaxf(fabsf(x1.x), fabsf(x1.y)), fmaxf(fabsf(x1.z), fabsf(x1.w))));
    return fmaxf(mx, fmaxf(fmaxf(fmaxf(fabsf(x2.x), fabsf(x2.y)), fmaxf(fabsf(x2.z), fabsf(x2.w))), fmaxf(fmaxf(fabsf(x3.x), fabsf(x3.y)), fmaxf(fabsf(x3.z), fabsf(x3.w)))));
}
__device__ __forceinline__ unsigned pk_fp8(const f32x4 x, float inv) { int t = __builtin_amdgcn_cvt_pk_fp8_f32(x.x * inv, x.y * inv, 0, false); t = __builtin_amdgcn_cvt_pk_fp8_f32(x.z * inv, x.w * inv, t, true); return (unsigned)t; }
__device__ __forceinline__ void pro_peerw(Frame& F) {
    const KArgs ap = kargs(); const auto& a = *ap; WS_OPAQUE(a);
    const int tid = otid(), lane = tid & 63, wave = __builtin_amdgcn_readfirstlane(tid >> 6);
    float* SCL = (float*)(wsb + a.off[R_MISC]);
    constexpr int RB = 4;
    static_assert(PEER_ROWS % RB == 0, "peer rows");
    for (size_t rw0 = ((size_t)F.vcu * NWAVES + wave) * RB; rw0 < 2 * PEER_ROWS; rw0 += (size_t)F.G * NWAVES * RB) {
        const int w = rw0 >= PEER_ROWS; const size_t row0 = rw0 - (w ? PEER_ROWS : 0);
        f32x4 x[RB][4];
#pragma unroll
        for (int r = 0; r < RB; ++r) { const GAS f32x4* src = (const GAS f32x4*)(GIN(a, I_PU + w) + (row0 + r) * D_MODEL) + 4 * lane;
#pragma unroll
            for (int j = 0; j < 4; ++j) x[r][j] = src[j]; }
#pragma unroll
        for (int r = 0; r < RB; ++r) { const float mx = wave_max(absmax16(x[r][0], x[r][1], x[r][2], x[r][3])); v4u o;
            if (w == 0) { const float inv = mx > 0.f ? 127.f / mx : 0.f; o.x = pk_i8(x[r][0], inv); o.y = pk_i8(x[r][1], inv); o.z = pk_i8(x[r][2], inv); o.w = pk_i8(x[r][3], inv);
                if (lane == 0) SCL[rw0 + r] = mx * (1.f / 127.f); }
            else { const float inv = mx > 0.f ? 416.f / mx : 0.f; o.x = pk_fp8(x[r][0], inv); o.y = pk_fp8(x[r][1], inv); o.z = pk_fp8(x[r][2], inv); o.w = pk_fp8(x[r][3], inv);
                if (lane == 0) SCL[rw0 + r] = mx * (1.f / 416.f); }
            *((GAS v4u*)(wsb + a.off[R_PU + w] + (row0 + r) * D_MODEL) + lane) = o; }
    }
}
__device__ __forceinline__ void fp8x16_to_f32(const v4u q, float (&f)[16]) {
#pragma unroll
    for (int d = 0; d < 4; ++d) { const int w = (int)(d == 0 ? q.x : d == 1 ? q.y : d == 2 ? q.z : q.w);
        const f32x2v lo = __builtin_amdgcn_cvt_pk_f32_fp8(w, false), hi = __builtin_amdgcn_cvt_pk_f32_fp8(w, true); f[4 * d] = lo.x; f[4 * d + 1] = lo.y; f[4 * d + 2] = hi.x; f[4 * d + 3] = hi.y; }
}
__device__ __forceinline__ void p_peer(Frame& F, int l, bool dry) {
    const KArgs ap = kargs(); const auto& a = *ap; WS_OPAQUE(a);
    const int tid = otid(), lane = tid & 63, wave = __builtin_amdgcn_readfirstlane(tid >> 6);
    const float* SC = (const float*)(wsb + a.off[R_SC]); const bf16* XN = (const bf16*)(wsb + a.off[R_XN]); float* X = (float*)(wsb + a.off[R_X]);
    const unsigned char* PU = wsb + a.off[R_PU] + (size_t)l * N_EXPERTS * D_MODEL; const unsigned char* PV = wsb + a.off[R_PV] + (size_t)l * N_EXPERTS * D_MODEL;
    const float* SCU = (const float*)(wsb + a.off[R_MISC]) + (size_t)l * N_EXPERTS; const float* SCV = SCU + PEER_ROWS;
    LAS float* stop = (LAS float*)(F.lds + RING_OFF + wave * 4096);
    LAS int* itop = (LAS int*)(stop + 256);
    LAS int* elist = itop + 256;
    LAS float* cf = (LAS float*)(elist + 128);
    for (int m = F.vcu * NWAVES + wave; m < RP; m += F.G * NWAVES) {
        if (!prow_valid(m)) continue;
        const float* sr = SC + (size_t)m * PQ;
        float hx[16], rs;
        { const GAS f32x4* xr0 = (const GAS f32x4*)(X + (size_t)m * D_MODEL + 16 * lane); const GAS f32x4* g4 = (const GAS f32x4*)(GIN(a, I_N2) + (size_t)l * D_MODEL + 16 * lane); float s2 = 0.f;
#pragma unroll
          for (int j = 0; j < 4; ++j) { const f32x4 xv = xr0[j], gv = g4[j]; s2 += (xv.x * xv.x + xv.y * xv.y) + (xv.z * xv.z + xv.w * xv.w); hx[4 * j] = xv.x * gv.x; hx[4 * j + 1] = xv.y * gv.y; hx[4 * j + 2] = xv.z * gv.z; hx[4 * j + 3] = xv.w * gv.w; }
          rs = __builtin_amdgcn_rsqf(wave_sum(s2) * (1.f / D_MODEL) + EPSF);
#pragma unroll
          for (int j = 0; j < 16; ++j) hx[j] *= rs; }
#ifndef MK_REP
#define MK_REP -1
#endif
        for (int rp12 = 0; rp12 < ((MK_REP) == 105 ? 2 : 1); ++rp12) {
        { unsigned k[32];
          { const GAS f32x4* p4 = (const GAS f32x4*)(sr + (lane >> 2) * 128 + (lane & 3) * 32);
#pragma unroll
            for (int j = 0; j < 8; ++j) { const f32x4 v = p4[j]; k[4 * j] = fkey(v.x); k[4 * j + 1] = fkey(v.y); k[4 * j + 2] = fkey(v.z); k[4 * j + 3] = fkey(v.w); } }
          unsigned p = 0u;
#pragma unroll
          for (int bit = 31; bit >= 0; --bit) { const unsigned t = p | (1u << bit); int c = 0;
#pragma unroll
              for (int j = 0; j < 32; ++j) c += k[j] >= t ? 1 : 0;
              c += dpp_i<0xB1>(c); c += dpp_i<0x4E>(c);
              p = c >= 16 ? t : p; }
          int cl = 0;
#pragma unroll
          for (int j = 0; j < 32; ++j) cl += k[j] >= p ? 1 : 0;
          const int q = lane & 3, c0 = dpp_i<0x00>(cl), c1 = dpp_i<0x55>(cl), c2 = dpp_i<0xAA>(cl);
          int pos = (q > 0 ? c0 : 0) + (q > 1 ? c1 : 0) + (q > 2 ? c2 : 0);
          const int sb = (lane >> 2) * 16;
#pragma unroll
          for (int j = 0; j < 32; ++j) { const bool sel = k[j] >= p;
              if (sel && pos < 16) { const unsigned u = (k[j] & 0x80000000u) ? (k[j] ^ 0x80000000u) : ~k[j]; stop[sb + pos] = __builtin_bit_cast(float, u); itop[sb + pos] = q * 32 + j; }
              pos += sel ? 1 : 0; }
        }
        LDS_WAIT();
        for (int h = 0; h < 8; ++h) {
            const float s1 = stop[(2 * h) * 16 + (lane >> 2)];
            float c[4]; unsigned kc[4];
#pragma unroll
            for (int j = 0; j < 4; ++j) { c[j] = s1 + stop[(2 * h + 1) * 16 + (lane & 3) * 4 + j]; kc[j] = fkey(c[j]); }
            unsigned pp = 0u;
            for (int bit = 31; bit >= 0; --bit) { const unsigned tt = pp | (1u << bit);
                const int cn = __builtin_popcountll(__ballot(kc[0] >= tt)) + __builtin_popcountll(__ballot(kc[1] >= tt)) + __builtin_popcountll(__ballot(kc[2] >= tt)) + __builtin_popcountll(__ballot(kc[3] >= tt));
                pp = cn >= 16 ? tt : pp; if (cn == 16) break; }
            const float cmax = wave_max(fmaxf(fmaxf(c[0], c[1]), fmaxf(c[2], c[3])));
            float esum = 0.f; int base = 0;
#pragma unroll
            for (int j = 0; j < 4; ++j) { const bool sel = kc[j] >= pp; const unsigned long long mk = __ballot(sel); const int rk = base + mbcnt64(mk); base += __builtin_popcountll(mk);
                const float ex = (sel && rk < 16) ? __expf(rs * (c[j] - cmax)) : 0.f; esum += ex;
                if (sel && rk < 16) { const int ci = lane * 4 + j; elist[h * 16 + rk] = itop[(2 * h) * 16 + (ci >> 4)] * N_KEYS + itop[(2 * h + 1) * 16 + (ci & 15)]; cf[h * 16 + rk] = ex; } }
            esum = wave_sum(esum); const float inv = __builtin_amdgcn_rcpf(esum);
            LDS_WAIT();
            if (lane < 16) cf[h * 16 + lane] *= inv;
        }
        LDS_WAIT();
        }
        for (int rp3 = 0; rp3 < ((MK_REP) == 106 ? 2 : 1); ++rp3) {
        float out[16];
#pragma unroll
        for (int j = 0; j < 16; ++j) out[j] = 0.f;
        float hmx = 0.f;
#pragma unroll
        for (int j = 0; j < 16; ++j) hmx = fmaxf(hmx, fabsf(hx[j]));
        hmx = wave_max(hmx); const float hinv = hmx > 0.f ? 127.f / hmx : 0.f, hsc = hmx * (1.f / 127.f);
        v4u hq; hq.x = pk_i8((f32x4){hx[0], hx[1], hx[2], hx[3]}, hinv); hq.y = pk_i8((f32x4){hx[4], hx[5], hx[6], hx[7]}, hinv); hq.z = pk_i8((f32x4){hx[8], hx[9], hx[10], hx[11]}, hinv); hq.w = pk_i8((f32x4){hx[12], hx[13], hx[14], hx[15]}, hinv);
        v4u uA[4], vA[4], uB[4], vB[4]; float suA, svA, cA, suB, svB, cB;
        const bool l60 = lane == 60, l61 = lane == 61, l62 = lane == 62;
#define PEER_LOAD(U, V, SU, SV, CW, q0) do { { const int em_ = elist[(q0) + (lane & 3)]; CW = cf[(q0) + (lane & 3)]; SU = SCU[em_]; SV = SCV[em_]; } _Pragma("unroll") for (int i = 0; i < 4; ++i) { const int e_ = elist[(q0) + i]; \
            U[i] = *((const GAS v4u*)(PU + (size_t)e_ * D_MODEL) + lane); V[i] = *((const GAS v4u*)(PV + (size_t)e_ * D_MODEL) + lane); } } while (0)
#define PEER_COMP(U, V, SU, SV, CW) do { float d_[4]; _Pragma("unroll") for (int i = 0; i < 4; ++i) { int di_ = __builtin_amdgcn_sdot4((int)U[i].x, (int)hq.x, 0, false); di_ = __builtin_amdgcn_sdot4((int)U[i].y, (int)hq.y, di_, false); \
            di_ = __builtin_amdgcn_sdot4((int)U[i].z, (int)hq.z, di_, false); di_ = __builtin_amdgcn_sdot4((int)U[i].w, (int)hq.w, di_, false); d_[i] = (float)di_; } \
            _Pragma("unroll") for (int i = 0; i < 4; ++i) d_[i] += dpp_f<0xB1>(d_[i]); _Pragma("unroll") for (int i = 0; i < 4; ++i) d_[i] += dpp_f<0x4E>(d_[i]); \
            _Pragma("unroll") for (int i = 0; i < 4; ++i) d_[i] += dpp_f<0x141>(d_[i]); _Pragma("unroll") for (int i = 0; i < 4; ++i) d_[i] += dpp_f<0x140>(d_[i]); \
            _Pragma("unroll") for (int i = 0; i < 4; ++i) d_[i] += dpp_fm<0x142, 0xA>(d_[i]); _Pragma("unroll") for (int i = 0; i < 4; ++i) d_[i] += dpp_fm<0x143, 0xC>(d_[i]);     \
            const float dsel_ = l60 ? d_[0] : l61 ? d_[1] : l62 ? d_[2] : d_[3];                                    \
            const float ccv_ = CW * gelu_tanh(dsel_ * hsc * SU) * SV; \
            _Pragma("unroll") for (int i = 0; i < 4; ++i) { const float cc = rdlane(ccv_, 60 + i); float t[16]; fp8x16_to_f32(V[i], t); _Pragma("unroll") for (int j = 0; j < 16; ++j) out[j] += cc * t[j]; } } while (0)
        PEER_LOAD(uA, vA, suA, svA, cA, 0);
        for (int q = 0; q < 128; q += 8) {
            PEER_LOAD(uB, vB, suB, svB, cB, q + 4);
            PEER_COMP(uA, vA, suA, svA, cA);
            if (q + 8 < 128) PEER_LOAD(uA, vA, suA, svA, cA, q + 8);
            PEER_COMP(uB, vB, suB, svB, cB);
        }
#undef PEER_LOAD
#undef PEER_COMP
        if (!dry && rp3 == ((MK_REP) == 106 ? 1 : 0)) { GAS f32x4* xr = (GAS f32x4*)(X + (size_t)m * D_MODEL + 16 * lane);
          f32x4 xv[4]; float s2 = 0.f;
#pragma unroll
          for (int j = 0; j < 4; ++j) { xv[j] = xr[j] + (f32x4){out[4 * j], out[4 * j + 1], out[4 * j + 2], out[4 * j + 3]}; s2 += (xv[j].x * xv[j].x + xv[j].y * xv[j].y) + (xv[j].z * xv[j].z + xv[j].w * xv[j].w); }
          const float rn = __builtin_amdgcn_rsqf(wave_sum(s2) * (1.f / D_MODEL) + EPSF);
          if (l + 1 < DEPTH) {
#pragma unroll
              for (int j = 0; j < 4; ++j) xr[j] = xv[j];
              const GAS f32x4* gr = (const GAS f32x4*)(GIN(a, I_N1) + (size_t)(l + 1) * D_MODEL + 16 * lane); float o16[16];
#pragma unroll
              for (int j = 0; j < 4; ++j) { const f32x4 gg = gr[j]; o16[4 * j] = xv[j].x * rn * gg.x; o16[4 * j + 1] = xv[j].y * rn * gg.y; o16[4 * j + 2] = xv[j].z * rn * gg.z; o16[4 * j + 3] = xv[j].w * rn * gg.w; }
              v4u w0, w1; w0.x = pk2(o16[0], o16[1]); w0.y = pk2(o16[2], o16[3]); w0.z = pk2(o16[4], o16[5]); w0.w = pk2(o16[6], o16[7]); w1.x = pk2(o16[8], o16[9]); w1.y = pk2(o16[10], o16[11]); w1.z = pk2(o16[12], o16[13]); w1.w = pk2(o16[14], o16[15]);
              GAS v4u* xo = (GAS v4u*)((bf16*)(wsb + a.off[R_XN]) + (size_t)m * D_MODEL + 16 * lane); xo[0] = w0; xo[1] = w1;
          } else {
              float* dst = nullptr;
              if (m >= SROW0) dst = GOUT(a) + O_YS + (size_t)(m - SROW0) * D_MODEL; else { const int b_ = m / LPP, p_ = m % LPP; if (p_ >= PADF + N_META) dst = GOUT(a) + O_YP + ((size_t)b_ * SEQ + (p_ - PADF - N_META)) * D_MODEL; }
              if (dst) { const GAS f32x4* gr = (const GAS f32x4*)(GIN(a, I_FN) + 16 * lane); GAS f32x4* o = (GAS f32x4*)(dst + 16 * lane);
#pragma unroll
                  for (int j = 0; j < 4; ++j) { const f32x4 gg = gr[j]; o[j] = (f32x4){xv[j].x * rn * gg.x, xv[j].y * rn * gg.y, xv[j].z * rn * gg.z, xv[j].w * rn * gg.w}; } }
          } }
        }
    }
}
__device__ __forceinline__ void p_final(Frame& F) {
    const KArgs ap = kargs(); const auto& a = *ap; WS_OPAQUE(a);
    const int tid = otid(), lane = tid & 63, wave = __builtin_amdgcn_readfirstlane(tid >> 6);
    const float* X = (const float*)(wsb + a.off[R_X]); const float* g = GIN(a, I_FN);
    for (int m = F.vcu * NWAVES + wave; m < RP; m += F.G * NWAVES) {
        float* dst;
        if (m >= SROW0) dst = GOUT(a) + O_YS + (size_t)(m - SROW0) * D_MODEL;
        else { const int b = m / LPP, p = m % LPP; if (p < PADF + N_META || p >= PEND) continue; dst = GOUT(a) + O_YP + ((size_t)b * SEQ + (p - PADF - N_META)) * D_MODEL; }
        const GAS f32x4* xr = (const GAS f32x4*)(X + (size_t)m * D_MODEL) + lane;
        f32x4 v[4]; float s2 = 0.f;
#pragma unroll
        for (int j = 0; j < 4; ++j) { v[j] = xr[64 * j]; s2 += (v[j].x * v[j].x + v[j].y * v[j].y) + (v[j].z * v[j].z + v[j].w * v[j].w); }
        const float r = __builtin_amdgcn_rsqf(wave_sum(s2) * (1.f / D_MODEL) + EPSF);
        const GAS f32x4* gr = (const GAS f32x4*)g + lane; GAS f32x4* o = (GAS f32x4*)dst + lane;
#pragma unroll
        for (int j = 0; j < 4; ++j) { const f32x4 gg = gr[64 * j]; o[64 * j] = (f32x4){v[j].x * r * gg.x, v[j].y * r * gg.y, v[j].z * r * gg.z, v[j].w * r * gg.w}; }
    }
}

__device__ __forceinline__ void p_prologue(Frame& F) {
    const KArgs ap = kargs(); const auto& a = *ap; WS_OPAQUE(a);
    const int tid = otid(), lane = tid & 63, wave = __builtin_amdgcn_readfirstlane(tid >> 6);
    LAS float* scr = (LAS float*)(F.lds + RING_OFF + wave * 16384);
    const int gw = F.vcu * NWAVES + wave, NGW = F.G * NWAVES;
    if (a.pro_mask & PM_X) {
        float* X = (float*)(wsb + a.off[R_X]);
        for (int m = gw; m < RP; m += NGW) {
            const float* src = nullptr;
            if (m >= SROW0) src = GIN(a, I_XS) + (size_t)(m - SROW0) * D_MODEL;
            else { const int b = m / LPP, p = m % LPP; if (p >= PADF && p < PEND) { const int pos = p - PADF; src = pos < N_META ? GIN(a, I_META) + (size_t)pos * D_MODEL : GIN(a, I_XP) + ((size_t)b * SEQ + pos - N_META) * D_MODEL; } }
            GAS f32x4* o = (GAS f32x4*)(X + (size_t)m * D_MODEL) + lane;
#pragma unroll
            for (int j = 0; j < 4; ++j) o[64 * j] = src ? ((const GAS f32x4*)src)[lane + 64 * j] : (f32x4){0.f, 0.f, 0.f, 0.f};
        }
    }
    if (a.pro_mask & PM_WIN) {
        bf16* WT = (bf16*)(wsb + a.off[R_WIN]);
        constexpr int IPL = (D_MODEL / 64) * (ZN / 32);
        for (int it = gw; it < DEPTH * IPL; it += NGW) { const int l = it / IPL, r = it % IPL, kb = r / (ZN / 32), nb = r % (ZN / 32);
            transpose_item(GIN(a, I_WIN) + (size_t)l * D_MODEL * D_IN, D_IN, D_MODEL, WT + (size_t)l * ZN * D_MODEL, 32 * nb, 64 * kb, CmWin(), scr, lane); }
    }
    __syncthreads();
    if (a.pro_mask & PM_TABLES) s5_tables(F);
    __syncthreads();
    if (a.pro_mask & PM_WREST) pro_wrest(F);
    if (a.pro_mask & PM_WQS) pro_wqs(F);
    if (a.pro_mask & PM_PEERW) pro_peerw(F);
}

__global__ void __launch_bounds__(NTHR, 2) mk_fwd(Args args) {
    extern __shared__ __attribute__((aligned(16))) unsigned char lds[];
    Frame F;
    F.lds = (LAS unsigned char*)lds; F.MISC = (volatile LAS unsigned*)(F.lds + MISC_OFF);
    F.wv = __builtin_amdgcn_readfirstlane((int)threadIdx.x >> 6);
    F.G = gridDim.x; { const int bx = blockIdx.x; F.vcu = (F.G % 8 == 0) ? (bx % 8) * (F.G / 8) + bx / 8 : bx; }
    F.ctl = (gu32*)args.ws;
    for (int u = F.wv * 64 + lane_id(); u < (LDS_BYTES - LDSCTL_OFF) / 4; u += NTHR) ((LAS unsigned*)(F.lds + LDSCTL_OFF))[u] = 0u;
    __syncthreads();
    const int lo = args.ph_lo, hi = args.ph_hi;
    unsigned* barw = (unsigned*)(F.ctl + CW_BAR) + (size_t)args.bar_region * XCD_BAR_WORDS;
    XcdBarrier bar; bar.bar = barw; bar.x = 0; bar.st = nullptr; bar.wv = F.wv;
    if (hi - lo > 1) bar = xcd_barrier_post(barw, F.MISC + 8, F.wv);
#define IN(k) (lo <= (k) && (k) < hi)
#ifndef MK_REP
#define MK_REP -1
#endif
#define SEAM(k) do { if ((k) + 1 < hi) { xcd_barrier(bar); if ((MK_REP) == 300) xcd_barrier(bar); } } while (0)
#ifndef MK_REP
#define MK_REP -1
#endif
    if (IN(PH_PRO)) { for (int rep_ = 0; rep_ < ((MK_REP) == 200 ? 2 : 1); ++rep_) { p_prologue(F); __syncthreads(); } SEAM(PH_PRO); }
#ifndef MK_REP
#define MK_REP -1
#endif
#define REPEAT(ph) for (int rep_ = 0; rep_ < ((MK_REP) == (ph) ? 2 : 1); ++rep_)
    for (int l = 0; l < DEPTH; ++l) {
        const int pb = 1 + l * NPL;
        if (l == 0 && IN(pb + PL_NORM1)) { REPEAT(PL_NORM1) p_norm(F, l, I_N1); SEAM(pb + PL_NORM1); }
        if (IN(pb + PL_GEMM_IN)) {
            const KArgs ap = kargs(); const auto& a = *ap; WS_OPAQUE(a);
            pg8::Gemm g{(const pg8::bf16_t*)(wsb + a.off[R_XN]), (const pg8::bf16_t*)(wsb + a.off[R_WIN]) + (size_t)l * ZN * D_MODEL, RP, ZN, D_MODEL};
            pg8::StaticOrder S; S.init(RP, ZN, F.G, (int)blockIdx.x);
            pg8::EpiBf16<0> E{(pg8::bf16_t*)(wsb + a.off[R_Z]), ZN, nullptr, 0, 0, 1.f};
            REPEAT(PL_GEMM_IN) pg8::gemm_phase<pg8::EpiBf16<0>, pg8::StaticOrder, true, true>(F.lds + RING_OFF, g, S, E, F.wv);
            SEAM(pb + PL_GEMM_IN);
        }
        if (IN(pb + PL_ZPOST)) { REPEAT(103) p_s5_e(F, l); REPEAT(PL_ZPOST) p_zpost(F, l);     SEAM(pb + PL_ZPOST); }
        if (IN(pb + PL_LOCAL)) { REPEAT(104) p_gdn_chunk<0>(F, l, 0); SEAM(pb + PL_LOCAL); }
        if (IN(pb + PL_MIX)) {
            REPEAT(100) p_gdn_chain(F, l);
            REPEAT(102) { const int tid = otid(), lane = tid & 63, wave = __builtin_amdgcn_readfirstlane(tid >> 6);
              const int q = F.vcu - F.vcu / 32 - 1;
              if (F.vcu % 32 != 0 && q >= 18) for (int t = (q - 18) * NWAVES + wave; t < S5_NTASK; t += (F.G - F.G / 32 - 18) * NWAVES) s5_scan_run(F, l, t, lane); }
            REPEAT(101) p_attention(F, l + DEPTH * rep_, lds);
            SEAM(pb + PL_MIX); }
        if (IN(pb + PL_MIXPOST)) { REPEAT(PL_MIXPOST) { p_mixpost_a(F, l); p_mixpost_b(F, l); p_s5_out(F, l); } SEAM(pb + PL_MIXPOST); }
        if (IN(pb + PL_GEMM_GLU)) REPEAT(PL_GEMM_GLU) {
            const KArgs ap = kargs(); const auto& a = *ap; WS_OPAQUE(a);
            { pg8::Gemm g{(const pg8::bf16_t*)(wsb + a.off[R_YC]), (const pg8::bf16_t*)(wsb + a.off[R_WGLU]) + (size_t)l * 1024 * 512, RP, 1024, 512};
              pg8::StaticOrder S; S.init(RP, 1024, F.G, (int)blockIdx.x); pg8::EpiGlu E{(pg8::bf16_t*)(wsb + a.off[R_OC]), WIDTH_C};
              pg8::gemm_phase<pg8::EpiGlu, pg8::StaticOrder, true, true>(F.lds + RING_OFF, g, S, E, F.wv); }
            { pg8::Gemm g{(const pg8::bf16_t*)(wsb + a.off[R_OA]), (const pg8::bf16_t*)(wsb + a.off[R_WBR]) + ((size_t)l * 3 + 0) * 1024 * 512, RP, 1024, 512};
              pg8::StaticOrder S; S.init(RP, 1024, F.G, (int)((blockIdx.x + 16) % F.G)); pg8::EpiMerge<0> E{(pg8::bf16_t*)(wsb + a.off[R_MRG]), nullptr, nullptr, (const pg8::bf16_t*)(wsb + a.off[R_Z]) + ZC_GATE, ZN};
              pg8::gemm_phase<pg8::EpiMerge<0>, pg8::StaticOrder, true, true>(F.lds + RING_OFF, g, S, E, F.wv); }
            { pg8::Gemm g{(const pg8::bf16_t*)(wsb + a.off[R_OBN]), (const pg8::bf16_t*)(wsb + a.off[R_WBR]) + ((size_t)l * 3 + 1) * 1024 * 512, RP, 1024, 512};
              pg8::StaticOrder S; S.init(RP, 1024, F.G, (int)((blockIdx.x + 32) % F.G)); pg8::EpiMerge<0> E{(pg8::bf16_t*)(wsb + a.off[R_MRG2]), nullptr, nullptr, (const pg8::bf16_t*)(wsb + a.off[R_Z]) + ZC_GATE + 1024, ZN};
              pg8::gemm_phase<pg8::EpiMerge<0>, pg8::StaticOrder, true, true>(F.lds + RING_OFF, g, S, E, F.wv); }
            if (rep_ == ((MK_REP) == PL_GEMM_GLU ? 1 : 0)) SEAM(pb + PL_GEMM_GLU); }
        if (IN(pb + PL_GEMM_BRC)) {
            const KArgs ap = kargs(); const auto& a = *ap; WS_OPAQUE(a);
            pg8::Gemm g{(const pg8::bf16_t*)(wsb + a.off[R_OC]), (const pg8::bf16_t*)(wsb + a.off[R_WBR]) + ((size_t)l * 3 + 2) * 1024 * 512, RP, 1024, 512};
            pg8::StaticOrder S; S.init(RP, 1024, F.G, (int)blockIdx.x); pg8::EpiMerge<2> E{(pg8::bf16_t*)(wsb + a.off[R_MRG]), (const pg8::bf16_t*)(wsb + a.off[R_MRG2]), (pg8::bf16_t*)(wsb + a.off[R_MRGB]), (const pg8::bf16_t*)(wsb + a.off[R_Z]) + ZC_GATE + 2048, ZN};
            REPEAT(PL_GEMM_BRC) pg8::gemm_phase<pg8::EpiMerge<2>, pg8::StaticOrder, true, true>(F.lds + RING_OFF, g, S, E, F.wv);
            SEAM(pb + PL_GEMM_BRC); }
        if (IN(pb + PL_GEMM_OUT)) {
            const KArgs ap = kargs(); const auto& a = *ap; WS_OPAQUE(a);
            pg8::Gemm g{(const pg8::bf16_t*)(wsb + a.off[R_MRGB]), (const pg8::bf16_t*)(wsb + a.off[R_WOUT]) + (size_t)l * 1024 * 1024, RP, 1024, 1024};
            pg8::StaticOrder S; S.init(RP, 1024, F.G, (int)blockIdx.x);
            REPEAT(PL_GEMM_OUT) { pg8::EpiResid E{(float*)(wsb + a.off[R_X]), D_MODEL, (MK_REP) == PL_GEMM_OUT && rep_ == 0, (pg8::bf16_t*)(wsb + a.off[R_XN])};
            pg8::gemm_phase<pg8::EpiResid, pg8::StaticOrder, true, true>(F.lds + RING_OFF, g, S, E, F.wv); }
            SEAM(pb + PL_GEMM_OUT); }
        if (IN(pb + PL_GEMM_PEER)) {
            const KArgs ap = kargs(); const auto& a = *ap; WS_OPAQUE(a);
            pg8::Gemm g{(const pg8::bf16_t*)(wsb + a.off[R_XN]), (const pg8::bf16_t*)(wsb + a.off[R_WQS]) + (size_t)l * PQ * D_MODEL, RP, PQ, D_MODEL};
            pg8::StaticOrder S; S.init(RP, PQ, F.G, (int)blockIdx.x); pg8::EpiF32 E{(float*)(wsb + a.off[R_SC]), PQ};
            REPEAT(PL_GEMM_PEER) pg8::gemm_phase<pg8::EpiF32, pg8::StaticOrder, true, true>(F.lds + RING_OFF, g, S, E, F.wv);
            SEAM(pb + PL_GEMM_PEER); }
        if (IN(pb + PL_PEER)) { REPEAT(PL_PEER) p_peer(F, l, (MK_REP) == PL_PEER && rep_ == 0); SEAM(pb + PL_PEER); }
    }
#undef IN
#undef SEAM
}
}
#ifndef MK_ONE_LAUNCH
#define MK_ONE_LAUNCH 1
#endif
static int mk_grid = 0;
static bool mk_setup() {
    if (mk_grid) return mk_grid > 0;
    int dev = 0, cus = 0;
    if (hipGetDevice(&dev) != hipSuccess || hipDeviceGetAttribute(&cus, hipDeviceAttributeMultiprocessorCount, dev) != hipSuccess) { mk_grid = -1; return false; }
    if (hipFuncSetAttribute((const void*)mk::mk_fwd, hipFuncAttributeMaxDynamicSharedMemorySize, mk::LDS_BYTES) != hipSuccess) { fprintf(stderr, "kernel_launch: hipFuncSetAttribute failed\n"); mk_grid = -1; return false; }
    int per_cu = 0;
    if (hipOccupancyMaxActiveBlocksPerMultiprocessor(&per_cu, (const void*)mk::mk_fwd, mk::NTHR, mk::LDS_BYTES) != hipSuccess || per_cu < 1) { fprintf(stderr, "kernel_launch: occupancy query says %d workgroups per CU\n", per_cu); }
    (void)hipGetLastError();
    mk_grid = cus;
    return true;
}
static void mk_launch(mk::Args a, int lo, int hi, int region, hipStream_t stream) {
    a.ph_lo = lo; a.ph_hi = hi; a.bar_region = region;
    hipLaunchKernelGGL(mk::mk_fwd, dim3(mk_grid), dim3(mk::NTHR), mk::LDS_BYTES, stream, a);
    hipError_t e = hipPeekAtLastError(); if (e != hipSuccess) fprintf(stderr, "kernel_launch: launch failed: %s\n", hipGetErrorName(e));
}
extern "C" void kernel_launch(void* const* d_in, const int* in_sizes, int n_in, void* d_out, int out_size, void* d_ws, size_t ws_size, hipStream_t stream) {
    if (n_in != N_INPUTS || (size_t)out_size != (size_t)O_END) { fprintf(stderr, "kernel_launch: unexpected n_in %d / out_size %d\n", n_in, out_size); return; }
    if (!mk_setup()) return;
    const size_t MiB = 1u << 20;
    unsigned char* ws = (unsigned char*)d_ws;
    mk::Args a{};
    for (int i = 0; i < N_INPUTS; ++i) a.in[i] = (const float*)d_in[i];
    a.out = (float*)d_out; a.ws = ws;
    { using namespace mk; const struct { int r; size_t mib; } map[] = { {R_WIN, 1}, {R_WGLU, 59}, {R_WBR, 63}, {R_WOUT, 75}, {R_WQS, 83}, {R_S5T, 99}, {R_PU, 132}, {R_PV, 196}, {R_MISC, 260}, {R_OBN, 262}, {R_MRG2, 280}, {R_X, 388}, {R_XN, 456},
        {R_Z, 490}, {R_SC, 490}, {R_QN, 737}, {R_KN, 754}, {R_QKVB, 771}, {R_BG, 822}, {R_O, 823}, {R_MRGB, 823}, {R_OA, 857}, {R_OB, 874}, {R_GDN, 891}, {R_MRG, 891},
        {R_S5E, 986}, {R_YC, 986}, {R_S5X, 1003}, {R_OC, 1012} };
      for (auto& e : map) a.off[e.r] = e.mib * MiB; }
    if (1029 * MiB > ws_size) { fprintf(stderr, "kernel_launch: workspace too small (%zu)\n", ws_size); return; }
    if (hipMemsetAsync(ws, 0, mk::CTL_BYTES, stream) != hipSuccess) { fprintf(stderr, "kernel_launch: memset failed\n"); return; }
    a.pro_mask = mk::PM_X | mk::PM_WIN | mk::PM_TABLES | mk::PM_WREST | mk::PM_WQS | mk::PM_PEERW;
#if MK_ONE_LAUNCH
    mk_launch(a, 0, mk::PH_END, 0, stream);
#else
    int region = 0;
    mk_launch(a, mk::PH_PRO, mk::PH_PRO + 1, region++, stream);
    for (int l = 0; l < DEPTH; ++l) { const int pb = 1 + l * mk::NPL;
        for (int ph = mk::PL_NORM1; ph <= mk::PL_PEER; ++ph) { if (ph == mk::PL_GEMM_BRA || ph == mk::PL_GEMM_BRB) continue; mk_launch(a, pb + ph, pb + ph + 1, region++, stream); } }
    mk_launch(a, mk::PH_FINAL, mk::PH_END, region++, stream);
#endif
}
```

```cpp
#include <hip/hip_runtime.h>
#include <cstdio>
#include <cstdint>
#include <utility>
#define MK_ONE_LAUNCH 1
#ifndef D_MODEL
#define D_MODEL 1024
#define BATCH 2
#define SEQ 8192
#define DEPTH 4
#define DEC_BATCH 16
#define DEC_SEQ 32
#define PAST_LEN 1024
#define N_HEADS_A 4
#define HEAD_DIM_A 64
#define N_HEADS_B 4
#define HEAD_DIM_B 128
#define S5_GROUPS 32
#define S5_STATE 64
#define PEER_HEADS 8
#define PEER_QDIM 256
#define N_KEYS 128
#endif
#define CHUNK 64
#define N_META 16
#define EPSF 1e-6f
#define NUM_BUCKETS 32
#define CONV_W 4
#define S5_GROUP 16
#define PEER_TOPK 16
#define N_EXPERTS (N_KEYS * N_KEYS)
#define WIDTH_A (N_HEADS_A * 2 * HEAD_DIM_A)
#define WIDTH_B (N_HEADS_B * HEAD_DIM_B)
#define WIDTH_C (S5_GROUPS * S5_GROUP)
#define OFF_QA 0
#define OFF_KA (OFF_QA + WIDTH_A)
#define OFF_VA (OFF_KA + WIDTH_A)
#define OFF_QKVB (OFF_VA + WIDTH_A)
#define OFF_GB (OFF_QKVB + 3 * WIDTH_B)
#define OFF_BETA (OFF_GB + WIDTH_B)
#define OFF_ALPHA (OFF_BETA + N_HEADS_B)
#define OFF_UC (OFF_ALPHA + N_HEADS_B)
#define OFF_GATE (OFF_UC + WIDTH_C)
#define D_IN (OFF_GATE + 3 * D_MODEL)
#define LP (N_META + SEQ)
#define NP (BATCH * LP)
#define NS (DEC_BATCH * DEC_SEQ)
#define NT (NP + NS)
#define PQ (PEER_HEADS * PEER_QDIM)

enum { I_XP, I_XS, I_CK, I_CV, I_SCONV, I_SDELTA, I_SRE, I_SIM, I_META, I_REL, I_N1, I_N2, I_FN, I_WIN, I_QN, I_KN, I_LQK, I_SUBLN, I_CONVW, I_ALOG, I_DTB, I_GDNN,
       I_AR, I_AI, I_BR, I_BI, I_CR, I_CI, I_SD, I_LDT, I_WGLU, I_WBA, I_WBB, I_WBC, I_WOUT, I_PWQ, I_PSK, I_PU, I_PV, N_INPUTS };
#define O_YP 0
#define O_YS (O_YP + (size_t)BATCH * SEQ * D_MODEL)
#define O_KP (O_YS + (size_t)NS * D_MODEL)
#define O_VP (O_KP + (size_t)DEPTH * NP * WIDTH_A)
#define O_KS (O_VP + (size_t)DEPTH * NP * WIDTH_A)
#define O_VS (O_KS + (size_t)DEPTH * NS * WIDTH_A)
#define O_CP (O_VS + (size_t)DEPTH * NS * WIDTH_A)
#define O_CS (O_CP + (size_t)DEPTH * BATCH * (CONV_W - 1) * 3 * WIDTH_B)
#define O_DP (O_CS + (size_t)DEPTH * DEC_BATCH * (CONV_W - 1) * 3 * WIDTH_B)
#define O_DS (O_DP + (size_t)DEPTH * BATCH * N_HEADS_B * HEAD_DIM_B * HEAD_DIM_B)
#define O_SRP (O_DS + (size_t)DEPTH * DEC_BATCH * N_HEADS_B * HEAD_DIM_B * HEAD_DIM_B)
#define O_SIP (O_SRP + (size_t)DEPTH * BATCH * S5_GROUPS * S5_STATE)
#define O_SRS (O_SIP + (size_t)DEPTH * BATCH * S5_GROUPS * S5_STATE)
#define O_SIS (O_SRS + (size_t)DEPTH * DEC_BATCH * S5_GROUPS * S5_STATE)
#define O_END (O_SIS + (size_t)DEPTH * DEC_BATCH * S5_GROUPS * S5_STATE)

namespace pg8 {
#define PG8_LAS __attribute__((address_space(3)))
typedef unsigned short bf16_t;
typedef short bf16x8 __attribute__((ext_vector_type(8)));
typedef float f32x4 __attribute__((ext_vector_type(4)));
typedef unsigned u32x4 __attribute__((ext_vector_type(4)));
constexpr int BM = 256, BK = 64, HALF = 128, HTB = HALF * BK * 2  , STAGE_BYTES = 8 * HTB, NXCD = 8, WGM = 8;

__host__ __device__ __forceinline__ int lds_byte(int r, int c) { const int st = (r >> 4) * 2 + (c >> 5), rr = r & 15, cc = c & 31, ob = rr * 64 + cc * 2; return st * 1024 + (ob ^ (((ob >> 9) & 1) << 5)); }
__host__ __device__ __forceinline__ void stage_rc(int b, int& R, int& C) { const int st = b / 1024, sb = b % 1024, swz = sb ^ (((sb >> 9) & 1) << 5); R = (st >> 1) * 16 + swz / 64; C = (st & 1) * 32 + (swz % 64) / 2; }
__host__ __device__ __forceinline__ int perm32(int rho) { const int n = rho >> 4, i = rho & 15; return 8 * (i >> 2) + 4 * n + (i & 3); }

struct Unit { int pm, pn; };
struct Gemm { const bf16_t* A; const bf16_t* Bt; int M, N, K; };

struct StaticOrder {
    int nM, nN, nwg, G, c;
    __host__ __device__ void init(int M, int N, int G_, int c_) { nM = M / BM; nN = N / BM; nwg = nM * nN; G = G_; c = c_; }
    __host__ __device__ bool next(int i, Unit& u) const {
        const long L = (long)i * G + c; if (L >= nwg) return false;
        int wgid = (int)L; { const int q = nwg / NXCD, r = nwg % NXCD, xcd = wgid % NXCD, off = wgid / NXCD; wgid = (xcd < r ? xcd * (q + 1) : r * (q + 1) + (xcd - r) * q) + off; }
        const int nig = WGM * nN, gid = wgid / nig, fm = gid * WGM, gsz = (nM - fm) < WGM ? (nM - fm) : WGM;
        u.pm = fm + ((wgid % nig) % gsz); u.pn = (wgid % nig) / gsz; return true;
    }
    __device__ __forceinline__ void a_ready(const Unit&) const {}
    __device__ __forceinline__ void done(const Unit&) const {}
};

__device__ __forceinline__ unsigned cvt_pk_bf16(float lo, float hi) { unsigned r; asm volatile("v_cvt_pk_bf16_f32 %0, %1, %2" : "=v"(r) : "v"(lo), "v"(hi)); return r; }
typedef float f32x2 __attribute__((ext_vector_type(2)));
__device__ __forceinline__ f32x2 gelu_pk(f32x2 v) {
    const f32x2 av = __builtin_elementwise_abs(v), d = av * 0.2316418882f + 1.0f;
    f32x2 t; t.x = __builtin_amdgcn_rcpf(d.x); t.y = __builtin_amdgcn_rcpf(d.y);
    f32x2 q = t * 0.5307027145f + (-0.7265760135f); q = q * t + 0.7107068705f; q = q * t + (-0.142248368f); q = q * t + 0.127414796f; q = q * t;
    const f32x2 s = (v * v) * (-0.72134752044f);
    f32x2 e; e.x = __builtin_amdgcn_exp2f(s.x); e.y = __builtin_amdgcn_exp2f(s.y);
    const f32x2 m = v * (q * e), r = v - m;
    f32x2 o; o.x = v.x < 0.f ? m.x : r.x; o.y = v.y < 0.f ? m.y : r.y; return o;
}

template <int ACT  > struct EpiBf16 {
    static constexpr bool PERM = true, AFTER_DRAIN = false; static_assert(ACT == 0 || ACT == 1, "EpiBf16: ACT is 0 (none) or 1 (gelu_pk)");
    bf16_t* O; int ldc; const float* bias; int split_cols; size_t split_stride; float scale0;
    __device__ __forceinline__ void operator()(const f32x4 (&acc)[2][2][4][2], const Unit& u, int wr, int wc, int fr, int fq) const {
        const int row0 = u.pm * BM + wr * 64 + fr; int colt = u.pn * BM; bf16_t* base = O;
        float sc = 1.f; if (split_cols) { const int t = colt / split_cols; base += (size_t)t * split_stride; colt -= t * split_cols; if (t == 0) sc = scale0; }
        const int col0 = colt + wc * 32 + 8 * fq, bcol0 = u.pn * BM + wc * 32 + 8 * fq;
        f32x4 bv[2][2];
#pragma unroll
        for (int bj = 0; bj < 2; ++bj)
#pragma unroll
            for (int n = 0; n < 2; ++n) bv[bj][n] = bias ? *(const f32x4*)(bias + bcol0 + bj * HALF + 4 * n) : (f32x4){0.f, 0.f, 0.f, 0.f};
#pragma unroll
        for (int ai = 0; ai < 2; ++ai)
#pragma unroll
            for (int m = 0; m < 4; ++m) { bf16_t* rowp = base + (size_t)(row0 + ai * HALF + m * 16) * ldc + col0;
#pragma unroll
                for (int bj = 0; bj < 2; ++bj) { f32x4 v0 = acc[ai][bj][m][0] + bv[bj][0], v1 = acc[ai][bj][m][1] + bv[bj][1];
                    if (ACT == 1) { f32x2 a = gelu_pk((f32x2){v0[0], v0[1]}), b = gelu_pk((f32x2){v0[2], v0[3]}), c = gelu_pk((f32x2){v1[0], v1[1]}), d = gelu_pk((f32x2){v1[2], v1[3]});
                        v0 = (f32x4){a.x, a.y, b.x, b.y}; v1 = (f32x4){c.x, c.y, d.x, d.y}; }
                    v0 = v0 * sc; v1 = v1 * sc; u32x4 w; w.x = cvt_pk_bf16(v0[0], v0[1]); w.y = cvt_pk_bf16(v0[2], v0[3]); w.z = cvt_pk_bf16(v1[0], v1[1]); w.w = cvt_pk_bf16(v1[2], v1[3]);
                    *(u32x4*)(rowp + bj * HALF) = w; } }
    }
};

__device__ __forceinline__ float epi_sigm(float x) { return __builtin_amdgcn_rcpf(1.f + __expf(-x)); }
struct EpiGlu {
    static constexpr bool PERM = false, AFTER_DRAIN = false;
    bf16_t* O; int ldo;
    __device__ __forceinline__ void operator()(const f32x4 (&acc)[2][2][4][2], const Unit& u, int wr, int wc, int fr, int fq) const {
        const int row0 = u.pm * BM + wr * 64 + fr;
#pragma unroll
        for (int ai = 0; ai < 2; ++ai)
#pragma unroll
            for (int m = 0; m < 4; ++m) { bf16_t* rowp = O + (size_t)(row0 + ai * HALF + m * 16) * ldo + 4 * fq;
#pragma unroll
                for (int bj = 0; bj < 2; ++bj) { const int G = u.pn * 8 + bj * 4 + wc; const f32x4 av = acc[ai][bj][m][0], gv = acc[ai][bj][m][1];
                    typedef unsigned u32x2 __attribute__((ext_vector_type(2))); u32x2 w;
                    w.x = cvt_pk_bf16(av[0] * epi_sigm(gv[0]), av[1] * epi_sigm(gv[1])); w.y = cvt_pk_bf16(av[2] * epi_sigm(gv[2]), av[3] * epi_sigm(gv[3]));
                    *(u32x2*)(rowp + 16 * G) = w; } }
    }
};
template <int MODE> struct EpiMerge {
    static constexpr bool PERM = true, AFTER_DRAIN = false;
    bf16_t* M; const bf16_t* M2; bf16_t* Mb; const bf16_t* Zg; int ldz;
    __device__ __forceinline__ void operator()(const f32x4 (&acc)[2][2][4][2], const Unit& u, int wr, int wc, int fr, int fq) const {
        const int row0 = u.pm * BM + wr * 64 + fr, col0 = u.pn * BM + wc * 32 + 8 * fq;
#define EPI_LO(w) __builtin_bit_cast(float, (w) << 16)
#define EPI_HI(w) __builtin_bit_cast(float, (w) & 0xffff0000u)
        constexpr int MG = MODE == 2 ? 2 : 4;
#pragma unroll
        for (int aim = 0; aim < 8; aim += MG) { const int ai = aim >> 2, m0 = aim & 3;
            u32x4 gz[MG][2], pa[MG][2], pb[MG][2];
#pragma unroll
            for (int m = 0; m < MG; ++m)
#pragma unroll
                for (int bj = 0; bj < 2; ++bj) { const size_t row = (size_t)(row0 + ai * HALF + (m0 + m) * 16); const int col = col0 + bj * HALF;
                    gz[m][bj] = *(const u32x4*)(Zg + row * ldz + col);
                    if (MODE == 2) { pa[m][bj] = *(const u32x4*)(M + row * 1024 + col); pb[m][bj] = *(const u32x4*)(M2 + row * 1024 + col); } }
#pragma unroll
            for (int m = 0; m < MG; ++m)
#pragma unroll
                for (int bj = 0; bj < 2; ++bj) { const size_t row = (size_t)(row0 + ai * HALF + (m0 + m) * 16); const int col = col0 + bj * HALF; const u32x4 g = gz[m][bj];
                    f32x4 v0 = acc[ai][bj][m0 + m][0], v1 = acc[ai][bj][m0 + m][1];
                    v0[0] *= epi_sigm(EPI_LO(g.x)); v0[1] *= epi_sigm(EPI_HI(g.x)); v0[2] *= epi_sigm(EPI_LO(g.y)); v0[3] *= epi_sigm(EPI_HI(g.y));
                    v1[0] *= epi_sigm(EPI_LO(g.z)); v1[1] *= epi_sigm(EPI_HI(g.z)); v1[2] *= epi_sigm(EPI_LO(g.w)); v1[3] *= epi_sigm(EPI_HI(g.w));
                    if (MODE == 2) { const u32x4 a_ = pa[m][bj], b_ = pb[m][bj];
                        v0[0] += EPI_LO(a_.x) + EPI_LO(b_.x); v0[1] += EPI_HI(a_.x) + EPI_HI(b_.x); v0[2] += EPI_LO(a_.y) + EPI_LO(b_.y); v0[3] += EPI_HI(a_.y) + EPI_HI(b_.y);
                        v1[0] += EPI_LO(a_.z) + EPI_LO(b_.z); v1[1] += EPI_HI(a_.z) + EPI_HI(b_.z); v1[2] += EPI_LO(a_.w) + EPI_LO(b_.w); v1[3] += EPI_HI(a_.w) + EPI_HI(b_.w); }
                    u32x4 w; w.x = cvt_pk_bf16(v0[0], v0[1]); w.y = cvt_pk_bf16(v0[2], v0[3]); w.z = cvt_pk_bf16(v1[0], v1[1]); w.w = cvt_pk_bf16(v1[2], v1[3]);
                    *(u32x4*)((MODE == 2 ? Mb : M) + row * 1024 + col) = w; }
        }
#undef EPI_LO
#undef EPI_HI
    }
};
struct EpiResid {
    static constexpr bool PERM = false, AFTER_DRAIN = false;
    float* X; int ldx; bool dry; bf16_t* Xb;
    __device__ __forceinline__ void operator()(const f32x4 (&acc)[2][2][4][2], const Unit& u, int wr, int wc, int fr, int fq) const {
        const int row0 = u.pm * BM + wr * 64 + fr, col0 = u.pn * BM + wc * 32 + 4 * fq;
        typedef unsigned u32x2 __attribute__((ext_vector_type(2)));
#pragma unroll
        for (int aim = 0; aim < 8; aim += 2) { const int ai = aim >> 2, m0 = aim & 3;
            f32x4 xo[2][2][2]; bool ok[2];
#pragma unroll
            for (int m = 0; m < 2; ++m) { const int row = row0 + ai * HALF + (m0 + m) * 16; ok[m] = true; if (row < 16896) { const int p = row % 8448; ok[m] = p >= 48 && p < 8256; } ok[m] = ok[m] && !dry;
                const float* rowp = X + (size_t)row * ldx + col0;
#pragma unroll
                for (int bj = 0; bj < 2; ++bj)
#pragma unroll
                    for (int n = 0; n < 2; ++n) xo[m][bj][n] = *(const f32x4*)(rowp + bj * HALF + n * 16); }
#pragma unroll
            for (int m = 0; m < 2; ++m) { const int row = row0 + ai * HALF + (m0 + m) * 16;
                if (ok[m]) { float* rowp = X + (size_t)row * ldx + col0;
#pragma unroll
                    for (int bj = 0; bj < 2; ++bj)
#pragma unroll
                        for (int n = 0; n < 2; ++n) { const f32x4 v = xo[m][bj][n] + acc[ai][bj][m0 + m][n]; *(f32x4*)(rowp + bj * HALF + n * 16) = v;
                            u32x2 w; w.x = cvt_pk_bf16(v[0], v[1]); w.y = cvt_pk_bf16(v[2], v[3]); *(u32x2*)(Xb + (size_t)row * ldx + col0 + bj * HALF + n * 16) = w; } } }
        }
    }
};
struct EpiF32 {
    static constexpr bool PERM = false, AFTER_DRAIN = false;
    float* C; int ldc;
    __device__ __forceinline__ void operator()(const f32x4 (&acc)[2][2][4][2], const Unit& u, int wr, int wc, int fr, int fq) const {
        const int row0 = u.pm * BM + wr * 64 + fr, col0 = u.pn * BM + wc * 32 + 4 * fq;
#pragma unroll
        for (int ai = 0; ai < 2; ++ai)
#pragma unroll
            for (int m = 0; m < 4; ++m) { float* rowp = C + (size_t)(row0 + ai * HALF + m * 16) * ldc + col0;
#pragma unroll
                for (int bj = 0; bj < 2; ++bj)
#pragma unroll
                    for (int n = 0; n < 2; ++n) *(f32x4*)(rowp + bj * HALF + n * 16) = acc[ai][bj][m][n]; }
    }
};

template <class Epi, class Sched, bool ALIGN_EPI = false, bool SP2 = false>
__device__ __forceinline__ void gemm_phase(PG8_LAS unsigned char* lds, const Gemm g, const Sched& S, const Epi& E, int wv) {
    unsigned om_ = ~0u; asm volatile("" : "+s"(om_), "+s"(wv)); int tid_ = wv * 64 + (int)__builtin_amdgcn_mbcnt_hi(om_, __builtin_amdgcn_mbcnt_lo(om_, 0u));
    const int tid = tid_, wid = __builtin_amdgcn_readfirstlane(tid >> 6), lane = tid & 63, wr = wid >> 2, wc = wid & 3, fr = lane & 15, fq = lane >> 4;
    const int K = g.K, nt = K / BK;
    unsigned voffA[2], voffB[2];
#pragma unroll
    for (int i = 0; i < 2; ++i) { int R, C; stage_rc(tid * 16 + i * 8192, R, C); const int Rb = Epi::PERM ? ((R & ~31) + perm32(R & 31)) : R;
        voffA[i] = (unsigned)(R * K + C) * 2u; voffB[i] = (unsigned)(Rb * K + C) * 2u; }
    const size_t kstep = (size_t)(BK * 2);
    const size_t hstep = (size_t)HALF * K * 2;
    const size_t tstep = 2 * hstep;
    const unsigned ldsw = (unsigned)wid * 1024u;
    const int aoff = lds_byte(wr * 64 + fr, fq * 8), boff = lds_byte(wc * 32 + fr, fq * 8);
#define PG8_SA(b, h) (((b) * 2 + (h)) * HTB)
#define PG8_SB(b, h) ((4 + (b) * 2 + (h)) * HTB)
#define PG8_STAGE(bufoff, gbase, voff) do { _Pragma("unroll") for (int _i = 0; _i < 2; ++_i) \
        __builtin_amdgcn_global_load_lds((const unsigned*)((const char*)(gbase) + (voff)[_i]), (PG8_LAS unsigned*)(lds + (bufoff) + ldsw + _i * 8192), 16, 0, 0); } while (0)
#define PG8_LDA(dst, b, h) do { _Pragma("unroll") for (int m = 0; m < 4; ++m) _Pragma("unroll") for (int k = 0; k < 2; ++k) dst[m][k] = *(const PG8_LAS bf16x8*)(lds + PG8_SA(b, h) + aoff + m * 2048 + k * 1024); } while (0)
#define PG8_LDB(dst, b, h) do { _Pragma("unroll") for (int n = 0; n < 2; ++n) _Pragma("unroll") for (int k = 0; k < 2; ++k) dst[n][k] = *(const PG8_LAS bf16x8*)(lds + PG8_SB(b, h) + boff + n * 2048 + k * 1024); } while (0)
#define PG8_MMA(ai, bj, At, Bt) do { __builtin_amdgcn_s_setprio(1); _Pragma("unroll") for (int m = 0; m < 4; ++m) _Pragma("unroll") for (int n = 0; n < 2; ++n) _Pragma("unroll") for (int k = 0; k < 2; ++k) \
        acc[ai][bj][m][n] = __builtin_amdgcn_mfma_f32_16x16x32_bf16(Bt[n][k], At[m][k], acc[ai][bj][m][n], 0, 0, 0); __builtin_amdgcn_s_setprio(0); } while (0)
#define PG8_WAIT_V(n) asm volatile("s_waitcnt vmcnt(" #n ")" ::: "memory")
#define PG8_WAIT_L(n) asm volatile("s_waitcnt lgkmcnt(" #n ")" ::: "memory")
#define PG8_BAR __builtin_amdgcn_s_barrier()
#define PG8_SCHED __builtin_amdgcn_sched_barrier(0)
    Unit cur, nxt; int ui = 0;
    if (!S.next(0, cur)) return;
    f32x4 acc[2][2][4][2];
#pragma unroll
    for (int a = 0; a < 2; ++a)
#pragma unroll
        for (int b = 0; b < 2; ++b)
#pragma unroll
            for (int m = 0; m < 4; ++m)
#pragma unroll
                for (int n = 0; n < 2; ++n) acc[a][b][m][n] = (f32x4){0.f, 0.f, 0.f, 0.f};
    bf16x8 At[4][2], B0[2][2], B1[2][2];
    const char* cA = (const char*)g.A + (size_t)cur.pm * tstep; const char* cB = (const char*)g.Bt + (size_t)cur.pn * tstep;
    S.a_ready(cur);
    if constexpr (SP2) {
        PG8_STAGE(PG8_SB(0, 0), cB, voffB); PG8_STAGE(PG8_SB(0, 1), cB + hstep, voffB); PG8_STAGE(PG8_SA(0, 0), cA, voffA); PG8_STAGE(PG8_SA(0, 1), cA + hstep, voffA);
        if (wr == 1) PG8_BAR;
        PG8_WAIT_V(2); PG8_BAR;
        PG8_STAGE(PG8_SB(1, 0), cB + kstep, voffB); PG8_STAGE(PG8_SA(1, 0), cA + kstep, voffA); PG8_STAGE(PG8_SB(1, 1), cB + hstep + kstep, voffB);
        PG8_WAIT_V(6); PG8_BAR;
    } else {
        PG8_STAGE(PG8_SB(0, 0), cB, voffB); PG8_STAGE(PG8_SA(0, 0), cA, voffA); PG8_STAGE(PG8_SB(0, 1), cB + hstep, voffB); PG8_STAGE(PG8_SA(0, 1), cA + hstep, voffA);
        if (wr == 1) PG8_BAR;
        PG8_WAIT_V(4); PG8_BAR;
        PG8_STAGE(PG8_SB(1, 0), cB + kstep, voffB); PG8_STAGE(PG8_SA(1, 0), cA + kstep, voffA); PG8_STAGE(PG8_SB(1, 1), cB + hstep + kstep, voffB);
        PG8_WAIT_V(6); PG8_BAR;
    }
    for (;;) {
        const bool has_next = S.next(ui + 1, nxt);
        const char* nA = has_next ? (const char*)g.A + (size_t)nxt.pm * tstep : cA; const char* nB = has_next ? (const char*)g.Bt + (size_t)nxt.pn * tstep : cB;
        for (int t = 0; t < nt; t += 2) {
            const bool last = (t == nt - 2);
            const char* a1 = cA + (size_t)(t + 1) * kstep;
            const char* a2 = last ? nA : cA + (size_t)(t + 2) * kstep; const char* b2 = last ? nB : cB + (size_t)(t + 2) * kstep;
            const char* a3 = a2 + kstep; const char* b3 = b2 + kstep;
            if (last && has_next) S.a_ready(nxt);
            if constexpr (SP2) {
            PG8_LDB(B0, 0, 0); PG8_LDB(B1, 0, 1); PG8_SCHED; PG8_LDA(At, 0, 0); PG8_STAGE(PG8_SA(1, 1), a1 + hstep, voffA);
            PG8_WAIT_V(8); PG8_WAIT_L(0); PG8_BAR; PG8_MMA(0, 0, At, B0); PG8_MMA(0, 1, At, B1); PG8_BAR; PG8_SCHED;
            PG8_LDA(At, 0, 1); PG8_STAGE(PG8_SB(0, 0), b2, voffB); PG8_STAGE(PG8_SB(0, 1), b2 + hstep, voffB); PG8_STAGE(PG8_SA(0, 0), a2, voffA);
            PG8_WAIT_V(8); PG8_WAIT_L(0); PG8_BAR; PG8_MMA(1, 0, At, B0); PG8_MMA(1, 1, At, B1); PG8_BAR; PG8_SCHED;
            PG8_LDB(B0, 1, 0); PG8_LDB(B1, 1, 1); PG8_SCHED; PG8_LDA(At, 1, 0); PG8_STAGE(PG8_SA(0, 1), a2 + hstep, voffA);
            PG8_WAIT_V(8); PG8_WAIT_L(0); PG8_BAR; PG8_MMA(0, 0, At, B0); PG8_MMA(0, 1, At, B1); PG8_BAR; PG8_SCHED;
            PG8_LDA(At, 1, 1); PG8_STAGE(PG8_SB(1, 0), b3, voffB); PG8_STAGE(PG8_SB(1, 1), b3 + hstep, voffB); PG8_STAGE(PG8_SA(1, 0), a3, voffA);
            PG8_WAIT_V(8); PG8_WAIT_L(0); PG8_BAR; PG8_MMA(1, 0, At, B0); PG8_MMA(1, 1, At, B1); PG8_BAR; PG8_SCHED;
            } else {
            PG8_LDB(B0, 0, 0); PG8_SCHED; PG8_LDA(At, 0, 0); PG8_STAGE(PG8_SA(1, 1), a1 + hstep, voffA);
            PG8_WAIT_L(8); PG8_BAR; PG8_WAIT_L(0); PG8_MMA(0, 0, At, B0); PG8_BAR; PG8_SCHED;
            PG8_LDB(B1, 0, 1); PG8_STAGE(PG8_SB(0, 0), b2, voffB);
            PG8_BAR; PG8_WAIT_L(0); PG8_MMA(0, 1, At, B1); PG8_BAR;
            PG8_LDA(At, 0, 1); PG8_STAGE(PG8_SA(0, 0), a2, voffA);
            PG8_BAR; PG8_WAIT_L(0); PG8_MMA(1, 0, At, B0); PG8_BAR; PG8_SCHED;
            PG8_STAGE(PG8_SB(0, 1), b2 + hstep, voffB);
            PG8_WAIT_V(6); PG8_BAR; PG8_MMA(1, 1, At, B1); PG8_BAR;
            PG8_LDB(B0, 1, 0); PG8_SCHED; PG8_LDA(At, 1, 0); PG8_STAGE(PG8_SA(0, 1), a2 + hstep, voffA);
            PG8_WAIT_L(8); PG8_BAR; PG8_WAIT_L(0); PG8_MMA(0, 0, At, B0); PG8_BAR; PG8_SCHED;
            PG8_LDB(B1, 1, 1); PG8_STAGE(PG8_SB(1, 0), b3, voffB);
            PG8_BAR; PG8_WAIT_L(0); PG8_MMA(0, 1, At, B1); PG8_BAR;
            PG8_LDA(At, 1, 1); PG8_STAGE(PG8_SA(1, 0), a3, voffA);
            PG8_BAR; PG8_WAIT_L(0); PG8_MMA(1, 0, At, B0); PG8_BAR; PG8_SCHED;
            PG8_STAGE(PG8_SB(1, 1), b3 + hstep, voffB);
            PG8_WAIT_V(6); PG8_BAR; PG8_MMA(1, 1, At, B1); PG8_BAR;
            }
        }
        if constexpr (ALIGN_EPI) { if (wr == 0) PG8_BAR; }
        if constexpr (!Epi::AFTER_DRAIN) { E(acc, cur, wr, wc, fr, fq); S.done(cur); }
        if (!has_next) break;
#pragma unroll
        for (int a = 0; a < 2; ++a)
#pragma unroll
            for (int b = 0; b < 2; ++b)
#pragma unroll
                for (int m = 0; m < 4; ++m)
#pragma unroll
                    for (int n = 0; n < 2; ++n) acc[a][b][m][n] = (f32x4){0.f, 0.f, 0.f, 0.f};
        cur = nxt; cA = nA; cB = nB; ++ui;
        if constexpr (ALIGN_EPI) { if (wr == 1) PG8_BAR; }
    }
    PG8_WAIT_V(0);
    if constexpr (!ALIGN_EPI) { if (wr == 0) PG8_BAR; }
    PG8_BAR;
    if constexpr (Epi::AFTER_DRAIN) { E.fused(acc, cur, wr, wc, fr, fq, lds, wid, lane); S.done(cur); }
#undef PG8_SA
#undef PG8_SB
#undef PG8_STAGE
#undef PG8_LDA
#undef PG8_LDB
#undef PG8_MMA
#undef PG8_WAIT_V
#undef PG8_WAIT_L
#undef PG8_BAR
#undef PG8_SCHED
}
}
#include <hip/hip_bf16.h>
#include <cmath>
namespace attn_body {
using bf16=__hip_bfloat16;
using bf16x8=__attribute__((ext_vector_type(8)))short;
using s16x4=__attribute__((ext_vector_type(4)))short;
using f32x16=__attribute__((ext_vector_type(16)))float;
using u32x4=__attribute__((ext_vector_type(4)))unsigned;
constexpr int ASEQ=8448,D=64;
constexpr int QP=512,KP=512,VP=7424,OP=1024;
constexpr int NW=8,QBLK=32,QB=QBLK*NW,KVBLK=64,NQB=ASEQ/QB;
constexpr int ATTN_UNIT_ROWS=QB;
__device__ __forceinline__ int crow(int r,int hi){return (r&3)+8*(r>>2)+4*hi;}
#define SBAR() __builtin_amdgcn_sched_barrier(0)
constexpr int BT_OFF=383, BT_N=640;
__device__ __forceinline__ void bmask(f32x16&p0,f32x16&p1,int t,int q0,int wid,int r32,int hi,const __attribute__((address_space(3))) float*tab){
  const float NEG=-INFINITY; const int qw=q0+32*wid;
  if(t>(qw>>6)){
    #pragma unroll
    for(int r=0;r<16;++r){p0[r]=NEG;p1[r]=NEG;} return; }
  if(t>0 && 64*t+63+91<=qw) return;
  const int q=qw+r32, kb=64*t+4*hi;
  #pragma unroll
  for(int r=0;r<16;++r){ const int kv=kb+(r&3)+8*(r>>2); int i0=kv-q+BT_OFF, i1=i0+32; i0=i0<0?0:i0; i1=i1<0?0:i1;
    p0[r]+=tab[i0]; p1[r]+=tab[i1]; if(kv<48)p0[r]=NEG; if(kv+32<48)p1[r]=NEG; }
}

constexpr int NSLOT=3, SLOTB=8192;
constexpr int LDS_K=0, LDS_V=NSLOT*SLOTB, LDS_WS=2*NSLOT*SLOTB, LDS_OST=LDS_WS+NW*64*4, LDS_BT=LDS_OST+NW*4096, LDS_BYTES=LDS_BT+BT_N*4;
constexpr float C2=0.125f*1.4426950408889634f;
__device__ __forceinline__ void glds16(const void*gsrc,unsigned lds_dst){unsigned keep;
  asm volatile("s_mov_b32 %0, m0\n\ts_mov_b32 m0, %2\n\ts_nop 0\n\tglobal_load_lds_dwordx4 %1, off\n\ts_mov_b32 m0, %0":"=&s"(keep):"v"(gsrc),"s"(lds_dst):"memory");}
__device__ __forceinline__ float max3f(float a,float b,float c){float r;asm("v_max3_f32 %0, %1, %2, %3":"=v"(r):"v"(a),"v"(b),"v"(c));return r;}
__device__ __forceinline__ float max2f(float a,float b){float r;asm("v_max_f32_e32 %0, %1, %2":"=v"(r):"v"(a),"v"(b));return r;}
__device__ __forceinline__ float fadd_s(float a,float b){float r;asm("v_add_f32_e32 %0, %1, %2":"=v"(r):"v"(a),"v"(b));return r;}
__device__ __forceinline__ float fsub_s(float a,float b){float r;asm("v_sub_f32_e32 %0, %1, %2":"=v"(r):"v"(a),"v"(b));return r;}
typedef float f32x2_t __attribute__((ext_vector_type(2))); typedef __bf16 bf16x2_t __attribute__((ext_vector_type(2)));
__device__ __forceinline__ unsigned cvtpk_s(float lo,float hi){f32x2_t v={lo,hi};bf16x2_t b=__builtin_convertvector(v,bf16x2_t);return __builtin_bit_cast(unsigned,b);}
#define WAIT_BAR(N) asm volatile("s_waitcnt vmcnt(" #N ") lgkmcnt(0)\n\ts_barrier":::"memory")

__device__ __forceinline__ void qkt(f32x16&p0,f32x16&p1,const char*Kslot,const bf16x8*qr,const f32x16&negm,int r32,int hi){
  const char*kb=Kslot+hi*1024+r32*16;
  #pragma unroll
  for(int d0=0;d0<4;++d0){
    const bf16x8 b0=*reinterpret_cast<const bf16x8*>(kb+d0*2048);
    const bf16x8 b1=*reinterpret_cast<const bf16x8*>(kb+d0*2048+512);
    if(d0==0){p0=__builtin_amdgcn_mfma_f32_32x32x16_bf16(b0,qr[0],negm,0,0,0);p1=__builtin_amdgcn_mfma_f32_32x32x16_bf16(b1,qr[0],negm,0,0,0);}
    else{p0=__builtin_amdgcn_mfma_f32_32x32x16_bf16(b0,qr[d0],p0,0,0,0);p1=__builtin_amdgcn_mfma_f32_32x32x16_bf16(b1,qr[d0],p1,0,0,0);}}
}
typedef __attribute__((address_space(3))) const char* lds_cptr;
typedef __attribute__((address_space(3))) const float* lds_cfptr;
typedef short v4i16_t __attribute__((ext_vector_type(4)));
__device__ __forceinline__ void kload8(bf16x8*kf,lds_cptr kp){
  kf[0]=*(const __attribute__((address_space(3))) bf16x8*)(kp);      kf[1]=*(const __attribute__((address_space(3))) bf16x8*)(kp+512);
  kf[2]=*(const __attribute__((address_space(3))) bf16x8*)(kp+2048); kf[3]=*(const __attribute__((address_space(3))) bf16x8*)(kp+2560);
  kf[4]=*(const __attribute__((address_space(3))) bf16x8*)(kp+4096); kf[5]=*(const __attribute__((address_space(3))) bf16x8*)(kp+4608);
  kf[6]=*(const __attribute__((address_space(3))) bf16x8*)(kp+6144); kf[7]=*(const __attribute__((address_space(3))) bf16x8*)(kp+6656);
}
__device__ __forceinline__ void kload2(bf16x8*kf,lds_cptr kp,int j){ kf[2*j]=*(const __attribute__((address_space(3))) bf16x8*)(kp+j*2048); kf[2*j+1]=*(const __attribute__((address_space(3))) bf16x8*)(kp+j*2048+512); }
__device__ __forceinline__ s16x4 vtr(lds_cptr p){ return __builtin_bit_cast(s16x4,__builtin_amdgcn_ds_read_tr16_b64_v4i16((__attribute__((address_space(3))) v4i16_t*)p)); }
__device__ __forceinline__ float rowmax(const f32x16&p0,const f32x16&p1){
  float a=max3f(p0[0],p0[1],p1[0]),b=max3f(p0[2],p0[3],p1[1]);a=max3f(a,p1[2],p1[3]);
  #pragma unroll
  for(int r=4;r<16;r+=4){a=max3f(a,p0[r],p0[r+1]);b=max3f(b,p0[r+2],p0[r+3]);a=max3f(a,p1[r],p1[r+1]);b=max3f(b,p1[r+2],p1[r+3]);}
  const float m=max2f(a,b);
  auto rr=__builtin_amdgcn_permlane32_swap(__float_as_uint(m),__float_as_uint(m),false,false);
  return max2f(__uint_as_float(rr[0]),__uint_as_float(rr[1]));
}
__device__ __forceinline__ void pv(f32x16*o,int vb,bf16x8 pa0,bf16x8 pa1,bf16x8 pa2,bf16x8 pa3){
  #pragma unroll
  for(int d0=0;d0<2;++d0){s16x4 lo[4],hi[4];
    #pragma unroll
    for(int ks=0;ks<4;++ks){
      asm volatile("ds_read_b64_tr_b16 %0,%1 offset:%c2":"=&v"(lo[ks]):"v"(vb),"i"(d0*4096+ks*1024):"memory");
      asm volatile("ds_read_b64_tr_b16 %0,%1 offset:%c2":"=&v"(hi[ks]):"v"(vb),"i"(d0*4096+ks*1024+512):"memory");}
    asm volatile("s_waitcnt lgkmcnt(0)":::"memory");SBAR();
    #define PK(k) (bf16x8){lo[k][0],lo[k][1],lo[k][2],lo[k][3],hi[k][0],hi[k][1],hi[k][2],hi[k][3]}
    o[d0]=__builtin_amdgcn_mfma_f32_32x32x16_bf16(pa0,PK(0),o[d0],0,0,0);
    o[d0]=__builtin_amdgcn_mfma_f32_32x32x16_bf16(pa1,PK(1),o[d0],0,0,0);
    o[d0]=__builtin_amdgcn_mfma_f32_32x32x16_bf16(pa2,PK(2),o[d0],0,0,0);
    o[d0]=__builtin_amdgcn_mfma_f32_32x32x16_bf16(pa3,PK(3),o[d0],0,0,0);
    #undef PK
  }
}

#ifndef ATTN_STORE16
#define ATTN_STORE16(p,v) (*(u32x4*)(p)=(v))
#endif
template<int THRL> __device__ __forceinline__ void attn_unit(int b,int qoff,int voff,int ooff,int qb,const bf16*Q,const bf16*__restrict__ K,const bf16*__restrict__ V,bf16*O,char*shm,int wv){
  unsigned om_ = ~0u; asm volatile("" : "+s"(om_), "+s"(wv)); int tid_ = wv * 64 + (int)__builtin_amdgcn_mbcnt_hi(om_, __builtin_amdgcn_mbcnt_lo(om_, 0u)); const int tid=tid_,lane=tid&63,r32=lane&31,hi=lane>>5; const int wid=__builtin_amdgcn_readfirstlane(tid>>6);
  const long rowbase=(long)b*ASEQ; const int q0=qb*QB;
  const bf16*Qw=Q+(rowbase+q0+wid*QBLK)*QP+qoff;
  const bf16*Kh=K+rowbase*KP+qoff,*Vh=V+rowbase*VP+voff;
  const unsigned lds0=(unsigned)(uintptr_t)shm;
  float*wsf=(float*)(shm+LDS_WS)+wid*64;
  const bf16*ksrc=Kh+(long)lane*KP+wid*8;
  const bf16*vsrc=Vh+(long)(16*(wid&3)+(lane>>2))*VP+(wid>>2)*32+(lane&3)*8;
  const unsigned kdst=lds0+LDS_K+wid*1024, vdst=lds0+LDS_V+wid*1024;
  #define DMA_K(t,slot) glds16(ksrc+(long)(t)*KVBLK*KP,(unsigned)__builtin_amdgcn_readfirstlane(kdst+(slot)))
  #define DMA_V(t,slot) glds16(vsrc+(long)(t)*KVBLK*VP,(unsigned)__builtin_amdgcn_readfirstlane(vdst+(slot)))
  const int vb0=(int)(lds0+LDS_V)+((lane>>4)&1)*32+(lane&3)*8+(4*hi+((lane&15)>>2))*64;
  const char*Kbase=shm+LDS_K; bf16x8 kf[8];
  const lds_cptr shm3=(lds_cptr)shm; const lds_cfptr btab=(lds_cfptr)(shm3+LDS_BT); const lds_cptr kp0=shm3+LDS_K+hi*1024+r32*16; const lds_cptr vp0=shm3+LDS_V+((lane>>4)&1)*32+(lane&3)*8+(4*hi+((lane&15)>>2))*64;
  const int NTL=(q0+QB)/KVBLK;
  DMA_K(0,0);DMA_V(0,0);DMA_K(1,SLOTB);
  bf16x8 qr[4];
  #pragma unroll
  for(int d0=0;d0<4;++d0)qr[d0]=*reinterpret_cast<const bf16x8*>(&Qw[(long)r32*QP+d0*16+hi*8]);
  float mhat=0.f,l_reg=0.f;f32x16 o[2];o[0]=f32x16{};o[1]=f32x16{};const f32x16 zt=f32x16{};
  const int qrel=wid*QBLK+r32;
  #define CMASK(P0,P1,t) bmask(P0,P1,(t),q0,wid,r32,hi,btab)
  bool resc=false;
  #define START(P0,P1) do{ const float rm=rowmax(P0,P1); resc=false; \
    { const float dl=rm; mhat=fadd_s(mhat,dl); \
      _Pragma("unroll") for(int r=0;r<16;++r){P0[r]=fsub_s(P0[r],dl);P1[r]=fsub_s(P1[r],dl);} \
      } \
    _Pragma("unroll") for(int r=0;r<16;++r)P0[r]=__builtin_amdgcn_exp2f(P0[r]); }while(0)
  #define RESC() do{ if(resc){ asm volatile("s_waitcnt lgkmcnt(0)":::"memory"); \
      _Pragma("unroll") for(int d_=0;d_<2;++d_) _Pragma("unroll") for(int r=0;r<16;++r)o[d_][r]*=wsf[crow(r,hi)]; } }while(0)
  f32x16 pA0,pA1,pB0,pB1;
  int sl_prev=0,sl_cur=0,sl_next=SLOTB;
  #define ROT() do{sl_prev=sl_cur;sl_cur=sl_next;sl_next=(sl_next==(NSLOT-1)*SLOTB)?0:sl_next+SLOTB;}while(0)
  DMA_K(2,2*SLOTB);
  WAIT_BAR(3);
  qkt(pA0,pA1,Kbase,qr,zt,r32,hi);asm volatile("s_nop 15\n\ts_nop 7":"+v"(pA0),"+v"(pA1));CMASK(pA0,pA1,0);
  START(pA0,pA1);
  _Pragma("unroll") for(int r=0;r<16;++r)pA1[r]=__builtin_amdgcn_exp2f(pA1[r]);
  WAIT_BAR(0);
  DMA_K(3,0);DMA_V(1,SLOTB);
  ROT();
  kload8(kf,kp0+sl_cur);
  WAIT_BAR(2);
  s16x4 vlo[8],vhi[8]; u32x4 pw0,pw1,pw2,pw3;
  #define PKW(P,B) cvtpk_s(P[B],P[B+1])
  #define PAF(k) __builtin_bit_cast(bf16x8,pw##k)
  #define VFR(i) (bf16x8){vlo[i][0],vlo[i][1],vlo[i][2],vlo[i][3],vhi[i][0],vhi[i][1],vhi[i][2],vhi[i][3]}
  #define PIN(x) asm volatile("":"+v"(x))
  #define MX3(a,b,c) __builtin_fmaxf(__builtin_fmaxf((a),(b)),(c))
  #define GAPA(MF,A0,A1,A2,A3,W0,W1,PW) do{ MF; sacc+=A0; sacc+=A1; sacc+=A2; sacc+=A3; PIN(sacc); W0; W1; PIN(PW); SBAR(); }while(0)
  #define EX(v) __builtin_amdgcn_exp2f(v)
  #define GAPB(MF,X,B) do{ MF; X[B]=EX(X[B]); X[B+1]=EX(X[B+1]); X[B+2]=EX(X[B+2]); X[B+3]=EX(X[B+3]); PIN(X); SBAR(); }while(0)
  #define VRD(i) do{ vlo[i]=vtr(vp_+(((i)>>2)*4096+((i)&3)*1024)); vhi[i]=vtr(vp_+(((i)>>2)*4096+((i)&3)*1024+512)); }while(0)
  #define KRD(G,j) do{ if(G){ kload2(kf,kp0+sl_next,j); SBAR(); } }while(0)
  #define STEP(C0,C1,P0,P1,t,GK,GV,GL) do{ SBAR(); \
    const lds_cptr vp_=vp0+sl_prev; \
    VRD(0); SBAR(); float sacc=(P0[0]+P0[1]); \
    GAPA(C0=__builtin_amdgcn_mfma_f32_32x32x16_bf16(kf[0],qr[0],zt,0,0,0), P0[2],P0[3],P0[4],P0[5],     pw0[0]=PKW(P0,0), pw0[1]=PKW(P0,2), pw0); \
    VRD(4); SBAR(); GAPA(C1=__builtin_amdgcn_mfma_f32_32x32x16_bf16(kf[1],qr[0],zt,0,0,0), P0[6],P0[7],P0[8],P0[9],     pw0[2]=PKW(P0,4), pw0[3]=PKW(P0,6), pw0); \
    VRD(1); SBAR(); GAPA(C0=__builtin_amdgcn_mfma_f32_32x32x16_bf16(kf[2],qr[1],C0,0,0,0),   P0[10],P0[11],P0[12],P0[13], pw1[0]=PKW(P0,8), pw1[1]=PKW(P0,10), pw1); \
    VRD(5); SBAR(); GAPA(C1=__builtin_amdgcn_mfma_f32_32x32x16_bf16(kf[3],qr[1],C1,0,0,0),   P0[14],P0[15],P1[0],P1[1],   pw1[2]=PKW(P0,12),pw1[3]=PKW(P0,14), pw1); \
    VRD(2); SBAR(); GAPA(C0=__builtin_amdgcn_mfma_f32_32x32x16_bf16(kf[4],qr[2],C0,0,0,0),   P1[2],P1[3],P1[4],P1[5],     pw2[0]=PKW(P1,0), pw2[1]=PKW(P1,2), pw2); \
    VRD(6); SBAR(); GAPA(C1=__builtin_amdgcn_mfma_f32_32x32x16_bf16(kf[5],qr[2],C1,0,0,0),   P1[6],P1[7],P1[8],P1[9],     pw2[2]=PKW(P1,4), pw2[3]=PKW(P1,6), pw2); \
    VRD(3); SBAR(); GAPA(C0=__builtin_amdgcn_mfma_f32_32x32x16_bf16(kf[6],qr[3],C0,0,0,0),   P1[10],P1[11],P1[12],P1[13], pw3[0]=PKW(P1,8), pw3[1]=PKW(P1,10), pw3); \
    VRD(7); SBAR(); GAPA(C1=__builtin_amdgcn_mfma_f32_32x32x16_bf16(kf[7],qr[3],C1,0,0,0),   P1[14],P1[15],0.f,0.f,       pw3[2]=PKW(P1,12),pw3[3]=PKW(P1,14), pw3); \
    l_reg+=sacc; \
    if(GK){DMA_K((t)+3,sl_cur);} if(GV){DMA_V((t)+1,sl_next);} \
    _Pragma("unroll") for(int r=0;r<16;++r){C0[r]-=mhat;C1[r]-=mhat;} \
    CMASK(C0,C1,t); \
    { float a=MX3(C0[0],C0[1],C1[0]),b=MX3(C0[2],C0[3],C1[1]); a=MX3(a,C1[2],C1[3]); \
      _Pragma("unroll") for(int r=4;r<16;r+=4){a=MX3(a,C0[r],C0[r+1]);b=MX3(b,C0[r+2],C0[r+3]);a=MX3(a,C1[r],C1[r+1]);b=MX3(b,C1[r+2],C1[r+3]);} \
      float rm=__builtin_fmaxf(a,b); { auto rr=__builtin_amdgcn_permlane32_swap(__float_as_uint(rm),__float_as_uint(rm),false,false); rm=__builtin_fmaxf(__uint_as_float(rr[0]),__uint_as_float(rr[1])); } \
      resc=false; \
      if(__builtin_expect(__any(rm>(float)THRL),0)){ const float dl=__builtin_fmaxf(rm,0.f); mhat+=dl; \
        _Pragma("unroll") for(int r=0;r<16;++r){C0[r]-=dl;C1[r]-=dl;} \
        const float f=__builtin_amdgcn_exp2f(-dl); l_reg*=f; if(hi==0)wsf[r32]=f; resc=true; } } \
    SBAR(); \
    GAPB(o[0]=__builtin_amdgcn_mfma_f32_32x32x16_bf16(PAF(0),VFR(0),o[0],0,0,0), C0,0); \
    GAPB(o[1]=__builtin_amdgcn_mfma_f32_32x32x16_bf16(PAF(0),VFR(4),o[1],0,0,0), C0,4); \
    KRD(GL,0); GAPB(o[0]=__builtin_amdgcn_mfma_f32_32x32x16_bf16(PAF(1),VFR(1),o[0],0,0,0), C0,8); \
    KRD(GL,1); GAPB(o[1]=__builtin_amdgcn_mfma_f32_32x32x16_bf16(PAF(1),VFR(5),o[1],0,0,0), C0,12); \
    KRD(GL,2); GAPB(o[0]=__builtin_amdgcn_mfma_f32_32x32x16_bf16(PAF(2),VFR(2),o[0],0,0,0), C1,0); \
    KRD(GL,3); GAPB(o[1]=__builtin_amdgcn_mfma_f32_32x32x16_bf16(PAF(2),VFR(6),o[1],0,0,0), C1,4); \
    GAPB(o[0]=__builtin_amdgcn_mfma_f32_32x32x16_bf16(PAF(3),VFR(3),o[0],0,0,0), C1,8); \
    GAPB(o[1]=__builtin_amdgcn_mfma_f32_32x32x16_bf16(PAF(3),VFR(7),o[1],0,0,0), C1,12); \
    }while(0)
  int t=1;
  #undef CMASK
  #define CMASK(P0,P1,t) do{}while(0)
  for(;t+7<NTL;t+=2){
    STEP(pB0,pB1,pA0,pA1,t,true,true,true);     WAIT_BAR(2); RESC(); ROT();
    STEP(pA0,pA1,pB0,pB1,t+1,true,true,true);   WAIT_BAR(2); RESC(); ROT();
  }
  #undef CMASK
  #define CMASK(P0,P1,t) bmask(P0,P1,(t),q0,wid,r32,hi,btab)
  #define ENDW(tt) do{ if((tt)+3<NTL){WAIT_BAR(2);} else if((tt)+2<NTL){WAIT_BAR(1);} else {WAIT_BAR(0);} }while(0)
  for(;t+1<NTL;t+=2){
    STEP(pB0,pB1,pA0,pA1,t,(t+3<NTL),(t+1<NTL),(t+1<NTL));       ENDW(t);   RESC(); ROT();
    STEP(pA0,pA1,pB0,pB1,t+1,(t+4<NTL),(t+2<NTL),(t+2<NTL));     ENDW(t+1); RESC(); ROT();
  }
  STEP(pB0,pB1,pA0,pA1,NTL-1,false,false,false); RESC();
  { float sacc=pB0[0]+pB0[1]; _Pragma("unroll") for(int r=2;r<16;++r)sacc+=pB0[r]; _Pragma("unroll") for(int r=0;r<16;++r)sacc+=pB1[r]; l_reg+=sacc;
    pw0=(u32x4){PKW(pB0,0),PKW(pB0,2),PKW(pB0,4),PKW(pB0,6)};pw1=(u32x4){PKW(pB0,8),PKW(pB0,10),PKW(pB0,12),PKW(pB0,14)};pw2=(u32x4){PKW(pB1,0),PKW(pB1,2),PKW(pB1,4),PKW(pB1,6)};pw3=(u32x4){PKW(pB1,8),PKW(pB1,10),PKW(pB1,12),PKW(pB1,14)};
    SBAR(); pv(o,vb0+sl_cur,PAF(0),PAF(1),PAF(2),PAF(3)); }
  #undef PKW
  #undef PAF
  #undef VFR
  #undef PIN
  #undef MX3
  #undef GAPA
  #undef GAPB
  #undef EX
  #undef VRD
  #undef KRD
  #undef STEP
  #undef ENDW
  {auto rr=__builtin_amdgcn_permlane32_swap(__float_as_uint(l_reg),__float_as_uint(l_reg),false,false);l_reg=__uint_as_float(rr[0])+__uint_as_float(rr[1]);}
  if(hi==0)wsf[32+r32]=l_reg;asm volatile("s_waitcnt lgkmcnt(0)":::"memory");
  float rli[16];
  #pragma unroll
  for(int r=0;r<16;++r)rli[r]=__builtin_amdgcn_rcpf(wsf[32+crow(r,hi)]);
  bf16*Ow=O+(rowbase+q0+wid*QBLK)*OP+ooff;
  { bf16*stg=(bf16*)(shm+LDS_OST)+wid*2048;
    #pragma unroll
    for(int r=0;r<16;++r){const int orow=crow(r,hi);
      #pragma unroll
      for(int d0=0;d0<2;++d0)stg[orow*64+d0*32+r32]=__float2bfloat16(o[d0][r]*rli[r]);}
    asm volatile("s_waitcnt lgkmcnt(0)":::"memory");
    #pragma unroll
    for(int i=0;i<4;++i){const int row=i*8+(lane>>3),ch=lane&7; const u32x4 v=*(const u32x4*)(stg+row*64+ch*8); ATTN_STORE16(Ow+(long)row*OP+ch*8,v);} }
  asm volatile("s_waitcnt lgkmcnt(0)\n\ts_barrier":::"memory");
  #undef DMA_K
  #undef DMA_V
  #undef CMASK
  #undef START
  #undef RESC
  #undef ROT
}
constexpr int ATTN_LDS_BYTES=LDS_BYTES;
#undef SBAR
#undef WAIT_BAR
#undef WAIT_BAR
}
namespace mk {
#define GAS __attribute__((address_space(1)))
#define LAS __attribute__((address_space(3)))
typedef unsigned short bf16;
typedef unsigned v4u __attribute__((ext_vector_type(4)));
typedef unsigned v2u __attribute__((ext_vector_type(2)));
typedef float f32x4 __attribute__((ext_vector_type(4)));
typedef float f32x16 __attribute__((ext_vector_type(16)));
typedef short bf16x8 __attribute__((ext_vector_type(8)));
typedef GAS unsigned gu32;
#define RLX_AGENT __ATOMIC_RELAXED, __HIP_MEMORY_SCOPE_AGENT
#define LDS_WAIT() asm volatile("s_waitcnt lgkmcnt(0)" ::: "memory")
#define VM_WAIT() asm volatile("s_waitcnt vmcnt(0)" ::: "memory")
typedef float f32x2_cv __attribute__((ext_vector_type(2))); typedef __bf16 bf16x2_cv __attribute__((ext_vector_type(2)));
__device__ __forceinline__ unsigned pk2(float lo, float hi) { const f32x2_cv v = {lo, hi}; return __builtin_bit_cast(unsigned, __builtin_convertvector(v, bf16x2_cv)); }
__device__ __forceinline__ unsigned f2bf(float f) { return pk2(f, 0.f) & 0xffffu; }
__device__ __forceinline__ float bf2f(unsigned short b) { return __builtin_bit_cast(float, ((unsigned)b) << 16); }
__device__ __forceinline__ float bflo(unsigned w) { return __builtin_bit_cast(float, w << 16); }
__device__ __forceinline__ float bfhi(unsigned w) { return __builtin_bit_cast(float, w & 0xffff0000u); }

constexpr int NWAVES = 8, NTHR = NWAVES * 64;
constexpr int PADF = 48;
constexpr int LPP = 8448;
constexpr int PEND = PADF + LP;
constexpr int SROW0 = BATCH * LPP;
constexpr int RP = SROW0 + NS;
constexpr int ZN = 7424;
constexpr int ZC_QA = 0, ZC_KA = 512, ZC_VA = 1024, ZC_QKVB = 1536, ZC_GB = 3072, ZC_UC = 3584, ZC_GATE = 4096, ZC_BA = 7168;
static_assert(RP % 256 == 0 && ZN % 256 == 0 && D_MODEL == 1024 && WIDTH_A == 512 && WIDTH_B == 512 && WIDTH_C == 512, "shapes");
__host__ __device__ __forceinline__ int nat2prow(int row) { return row < NP ? (row / LP) * LPP + PADF + row % LP : SROW0 + (row - NP); }
__host__ __device__ __forceinline__ int zcol(int col) { return col < 3584 ? col : (col < 3592 ? ZC_BA + (col - 3584) : col - 8); }
__device__ __forceinline__ bool prow_valid(int prow) { if (prow >= SROW0) return true; const int p = prow % LPP; return p >= PADF && p < PEND; }
__device__ __forceinline__ int prow2nat(int prow) { if (prow >= SROW0) return NP + (prow - SROW0); return (prow / LPP) * LP + (prow % LPP) - PADF; }

constexpr int RING_OFF = 0, RING_BYTES = 147456;
constexpr int LDSCTL_OFF = RING_BYTES, MISC_OFF = LDSCTL_OFF + 320;
constexpr int LDS_BYTES = RING_BYTES + 1024;
static_assert(MISC_OFF + 128 <= LDS_BYTES, "LDS map");

constexpr size_t CTL_BYTES = 1u << 20;
constexpr int CW_TMO = 0, CW_CODE = 1;
constexpr int CW_BAR = 4096;
constexpr int CW_QUEUE = 16384;
constexpr int CW_GDNFLAG = 32768;

__device__ __forceinline__ int lane_id() { return (int)__builtin_amdgcn_mbcnt_hi(~0u, __builtin_amdgcn_mbcnt_lo(~0u, 0u)); }
#define XB_TMO      128
#define XB_XCNT(j)  (256  + 64 * (j))
#define XB_XSUB(j)  (1280 + 64 * (j))
#define XB_XGEN(j)  (2304 + 64 * (j))
#define XB_TOP      3328
#define XB_TOPGEN   3392
#define XCD_BAR_WORDS 3456
#define XB_SPIN_CAP (1u << 18)

__device__ __forceinline__ unsigned xb_ld(unsigned* p)              { return __hip_atomic_load(p, __ATOMIC_RELAXED, __HIP_MEMORY_SCOPE_AGENT); }
__device__ __forceinline__ unsigned xb_add(unsigned* p, unsigned v) { return __hip_atomic_fetch_add(p, v, __ATOMIC_RELAXED, __HIP_MEMORY_SCOPE_AGENT); }
__device__ __forceinline__ unsigned xb_xcc_id() { return (unsigned)__builtin_amdgcn_s_getreg((3 << 11) | 20) & 0xFu; }
#define XB_SPIN(cond, bar) do { unsigned _sp = 0; while (cond) { __builtin_amdgcn_s_sleep(1); \
    if ((++_sp & 255u) == 0u) { if (xb_ld(&(bar)[XB_TMO])) break; if (_sp > XB_SPIN_CAP) { atomicAdd(&(bar)[XB_TMO], 1u); break; } } } } while (0)

struct XcdBarrier {
    unsigned* bar; unsigned x; int wv;
    volatile LAS unsigned* st;
};

__device__ __forceinline__ XcdBarrier xcd_barrier_post(unsigned* bar, volatile LAS unsigned* st, int wv) {
    XcdBarrier b; b.bar = bar; b.x = xb_xcc_id(); b.st = st; b.wv = wv;
    if (wv == 0 && lane_id() == 0) (void)xb_add(&bar[XB_XCNT(b.x)], 1u);
    return b;
}
__device__ __forceinline__ void xcd_barrier_complete(unsigned* bar, unsigned x, unsigned& nloc, unsigned& nx) {
    const unsigned G = gridDim.x * gridDim.y * gridDim.z;
    unsigned sum, cnt, mine, sp = 0u;
    for (;;) {
        sum = 0u; cnt = 0u; mine = 0u;
#pragma unroll
        for (unsigned j = 0; j < 16; ++j) { const unsigned c = xb_ld(&bar[XB_XCNT(j)]); sum += c; cnt += (c > 0u) ? 1u : 0u; mine = (j == x) ? c : mine; }
        if (sum == G) break;
        __builtin_amdgcn_s_sleep(1);
        if ((++sp & 255u) == 0u) { if (xb_ld(&bar[XB_TMO])) break; if (sp > XB_SPIN_CAP) { atomicAdd(&bar[XB_TMO], 1u); break; } }
    }
    nloc = mine > 0u ? mine : 1u; nx = cnt > 0u ? cnt : 1u;
}

__device__ __forceinline__ void xcd_barrier(const XcdBarrier& b) {
    asm volatile("s_waitcnt vmcnt(0)" ::: "memory");
    __syncthreads();
    if (b.wv == 0 && lane_id() == 0) {
        unsigned* bar = b.bar;
        __builtin_amdgcn_s_waitcnt(0);
        unsigned nloc = b.st[0], nx = b.st[1];
        if (nloc == 0u) { xcd_barrier_complete(bar, b.x, nloc, nx); b.st[0] = nloc; b.st[1] = nx; }
        const unsigned old = xb_add(&bar[XB_XSUB(b.x)], 1u);
        const unsigned gen = old / nloc;
        if (old + 1u == (gen + 1u) * nloc) {
            __builtin_amdgcn_fence(__ATOMIC_RELEASE, "agent");
            asm volatile("s_waitcnt vmcnt(0)" ::: "memory");
            const unsigned og = xb_add(&bar[XB_TOP], 1u);
            const unsigned tg = og / nx;
            if (og + 1u == (tg + 1u) * nx) xb_add(&bar[XB_TOPGEN], 1u);
            else XB_SPIN(xb_ld(&bar[XB_TOPGEN]) == tg, bar);
            __builtin_amdgcn_fence(__ATOMIC_ACQUIRE, "agent");
            xb_add(&bar[XB_XGEN(b.x)], 1u);
            asm volatile("s_waitcnt vmcnt(0)" ::: "memory");
        } else {
            XB_SPIN(xb_ld(&bar[XB_XGEN(b.x)]) == gen, bar);
            __builtin_amdgcn_fence(__ATOMIC_ACQUIRE, "agent");
            asm volatile("s_waitcnt vmcnt(0)" ::: "memory");
        }
    }
    __syncthreads();
}


template <int CTRL> __device__ __forceinline__ float dpp_f(float v) { return __builtin_bit_cast(float, __builtin_amdgcn_update_dpp(0, __builtin_bit_cast(int, v), CTRL, 0xf, 0xf, true)); }
template <int CTRL> __device__ __forceinline__ int dpp_i(int v) { return __builtin_amdgcn_update_dpp(0, v, CTRL, 0xf, 0xf, true); }
template <int CTRL, int ROWMASK> __device__ __forceinline__ float dpp_fm(float v) { return __builtin_bit_cast(float, __builtin_amdgcn_update_dpp(0, __builtin_bit_cast(int, v), CTRL, ROWMASK, 0xf, false)); }
__device__ __forceinline__ float rdlane(float v, int i) { return __builtin_bit_cast(float, __builtin_amdgcn_readlane(__builtin_bit_cast(int, v), i)); }
__device__ __forceinline__ float sum8(float v) { v += dpp_f<0xB1>(v); v += dpp_f<0x4E>(v); v += dpp_f<0x141>(v); return v; }
__device__ __forceinline__ float sum16(float v) { v = sum8(v); v += dpp_f<0x140>(v); return v; }
__device__ __forceinline__ float wave_sum(float v) { v = sum16(v); return rdlane(v, 0) + rdlane(v, 16) + rdlane(v, 32) + rdlane(v, 48); }
__device__ __forceinline__ float wave_max(float v) {
    v = fmaxf(v, dpp_f<0xB1>(v)); v = fmaxf(v, dpp_f<0x4E>(v)); v = fmaxf(v, dpp_f<0x141>(v)); v = fmaxf(v, dpp_f<0x140>(v));
    return fmaxf(fmaxf(rdlane(v, 0), rdlane(v, 16)), fmaxf(rdlane(v, 32), rdlane(v, 48)));
}
__device__ __forceinline__ float scan64(float v) {
    v += dpp_f<0x111>(v); v += dpp_f<0x112>(v); v += dpp_f<0x114>(v); v += dpp_f<0x118>(v);
    v += dpp_fm<0x142, 0xA>(v); v += dpp_fm<0x143, 0xC>(v);
    return v;
}
__device__ __forceinline__ float swap32(float v) {
    const auto r = __builtin_amdgcn_permlane32_swap(__builtin_bit_cast(unsigned, v), __builtin_bit_cast(unsigned, v), false, false);
    return __builtin_bit_cast(float, (lane_id() & 32) ? r[0] : r[1]);
}
__device__ __forceinline__ float swap16(float v) {
    const auto r = __builtin_amdgcn_permlane16_swap(__builtin_bit_cast(unsigned, v), __builtin_bit_cast(unsigned, v), false, false);
    return __builtin_bit_cast(float, (lane_id() & 16) ? r[0] : r[1]);
}
}
namespace mk {
enum Region { R_X, R_XN, R_WIN, R_Z, R_QN, R_KN, R_QKVB, R_BG, R_O, R_OA, R_OB, R_YC, R_OC, R_MRG, R_WGLU, R_WBR, R_WOUT, R_WQS, R_PU, R_PV, R_SC, R_GDN, R_S5T, R_MISC, R_S5E, R_S5X, R_MRGB, R_OBN, R_MRG2, R_NREG };
constexpr int NPL = 16;
enum Phase { PH_PRO = 0, PL_NORM1 = 0, PL_GEMM_IN = 1, PL_ZPOST = 2, PL_LOCAL = 3, PL_MIX = 4, PL_MIXPOST = 5, PL_GEMM_GLU = 6, PL_GEMM_BRA = 7, PL_GEMM_BRB = 8, PL_GEMM_BRC = 9,
             PL_GEMM_OUT = 10, PL_NORM2 = 11, PL_GEMM_PEER = 12, PL_PEER = 13, PH_FINAL = 1 + DEPTH * NPL, PH_END = PH_FINAL + 1 };
enum ProMask { PM_NORM0 = 64, PM_X = 1, PM_WIN = 2, PM_WREST = 4, PM_PEERW = 8, PM_WQS = 16, PM_TABLES = 32 };
struct Args {
    const float* in[40];
    float* out;
    unsigned char* ws;
    unsigned long long off[32];
    int ph_lo, ph_hi, pro_mask, bar_region;
};
static_assert(sizeof(Args) == 40 * 8 + 8 + 8 + 32 * 8 + 16, "Args has no padding");

typedef const __attribute__((address_space(4))) Args* KArgs;
__device__ __forceinline__ KArgs kargs() { KArgs p = (KArgs)__builtin_amdgcn_kernarg_segment_ptr(); asm volatile("" : "+s"(p)); return p; }
__device__ __forceinline__ void assume_global(const void* p) {
#if defined(__HIP_DEVICE_COMPILE__)
    __builtin_assume(!__builtin_amdgcn_is_shared(p) && !__builtin_amdgcn_is_private(p));
#endif
}
#define GIN(a, i) ((const float*)(const GAS float*)(a).in[i])
#define GOUT(a) ((float*)(GAS float*)(a).out)
#define WS_OPAQUE(a) GAS unsigned char* wsg_ = (GAS unsigned char*)(a).ws; asm volatile("" : "+s"(wsg_)); unsigned char* wsb = (unsigned char*)wsg_
#define otid() otid_(F.wv)
__device__ __forceinline__ int otid_(int wv) { unsigned m = ~0u; asm volatile("" : "+s"(m), "+s"(wv));
    return wv * 64 + (int)__builtin_amdgcn_mbcnt_hi(m, __builtin_amdgcn_mbcnt_lo(m, 0u)); }
struct Frame {
    LAS unsigned char* lds; volatile LAS unsigned* MISC; gu32* ctl;
    int vcu, G, wv;
};

struct TrItem { f32x4 v[8]; };
template <class CM> __device__ __forceinline__ void tr_load(TrItem& t, const float* W, int ld, int n0, int k0, const CM& cm, int lane) {
    const int sc = cm(n0 + 4 * (lane & 7)), kr = lane >> 3;
    const GAS float* Wg = (const GAS float*)W;
#pragma unroll
    for (int i = 0; i < 8; ++i) t.v[i] = sc >= 0 ? *(const GAS f32x4*)(Wg + (size_t)(k0 + 8 * i + kr) * ld + sc) : (f32x4){0.f, 0.f, 0.f, 0.f};
}
__device__ __forceinline__ void tr_store(const TrItem& t, int K, bf16* WT, int n0, int k0, LAS float* scr, int lane) {
    { const int q = lane & 7, kr = lane >> 3;
#pragma unroll
      for (int i = 0; i < 8; ++i) { LAS float* d = scr + (8 * i + kr) * 33 + 4 * q; d[0] = t.v[i].x; d[1] = t.v[i].y; d[2] = t.v[i].z; d[3] = t.v[i].w; } }
    LDS_WAIT(); asm volatile("" ::: "memory");
    const int c = lane & 7;
#pragma unroll
    for (int j = 0; j < 4; ++j) { const int n = (lane >> 3) + 8 * j; const LAS float* s = scr + (8 * c) * 33 + n;
        v4u o; o.x = pk2(s[0 * 33], s[1 * 33]); o.y = pk2(s[2 * 33], s[3 * 33]); o.z = pk2(s[4 * 33], s[5 * 33]); o.w = pk2(s[6 * 33], s[7 * 33]);
        *(GAS v4u*)(WT + (size_t)(n0 + n) * K + k0 + 8 * c) = o; }
    LDS_WAIT(); asm volatile("" ::: "memory");
}
struct CmWin { __device__ __forceinline__ int operator()(int n) const { return n < 3584 ? n : (n < 7168 ? n + 8 : (n < 7176 ? 3584 + (n - 7168) : -1)); } };
struct CmId { __device__ __forceinline__ int operator()(int n) const { return n; } };
struct CmGlu { __device__ __forceinline__ int operator()(int n) const { const int G = n >> 5, i = n & 31; return i < 16 ? 16 * G + i : 512 + 16 * G + (i - 16); } };

__device__ __forceinline__ void rms_row_to_bf16(const float* xrow, const float* g, bf16* orow, int lane) {
    const GAS f32x4* xr = (const GAS f32x4*)xrow + lane;
    f32x4 v[4]; float s2 = 0.f;
#pragma unroll
    for (int j = 0; j < 4; ++j) { v[j] = xr[64 * j]; s2 += (v[j].x * v[j].x + v[j].y * v[j].y) + (v[j].z * v[j].z + v[j].w * v[j].w); }
    const float r = __builtin_amdgcn_rsqf(wave_sum(s2) * (1.f / D_MODEL) + EPSF);
    const GAS f32x4* gr = (const GAS f32x4*)g + lane;
    GAS unsigned long long* o8 = (GAS unsigned long long*)orow + lane;
#pragma unroll
    for (int j = 0; j < 4; ++j) { const f32x4 gg = gr[64 * j];
        o8[64 * j] = (unsigned long long)pk2(v[j].x * r * gg.x, v[j].y * r * gg.y) | ((unsigned long long)pk2(v[j].z * r * gg.z, v[j].w * r * gg.w) << 32); }
}

__device__ __forceinline__ void p_norm(Frame& F, int l, int gi) {
    const KArgs ap = kargs(); const auto& a = *ap; WS_OPAQUE(a);
    const int tid = otid(), lane = tid & 63, wave = __builtin_amdgcn_readfirstlane(tid >> 6);
    const float* X = (const float*)(wsb + a.off[R_X]); bf16* XN = (bf16*)(wsb + a.off[R_XN]); const float* g = GIN(a, gi) + (size_t)l * D_MODEL;
    const int gw = F.vcu * NWAVES + wave, NGW = F.G * NWAVES;
    for (int m = gw; m < RP; m += NGW) rms_row_to_bf16(X + (size_t)m * D_MODEL, g, XN + (size_t)m * D_MODEL, lane);
}
__device__ __forceinline__ void p_norm0(Frame& F) {
    const KArgs ap = kargs(); const auto& a = *ap; WS_OPAQUE(a);
    const int tid = otid(), lane = tid & 63, wave = __builtin_amdgcn_readfirstlane(tid >> 6);
    float* X = (float*)(wsb + a.off[R_X]); bf16* XN = (bf16*)(wsb + a.off[R_XN]);
    const int gw = F.vcu * NWAVES + wave, NGW = F.G * NWAVES;
    f32x4 gg[4];
#pragma unroll
    for (int j = 0; j < 4; ++j) gg[j] = ((const GAS f32x4*)GIN(a, I_N1))[lane + 64 * j];
#define N0_SRC(m_, s_) do { s_ = nullptr; if ((m_) < RP) { if ((m_) >= SROW0) s_ = GIN(a, I_XS) + (size_t)((m_) - SROW0) * D_MODEL; \
        else { const int b_ = (m_) / LPP, p_ = (m_) % LPP; if (p_ >= PADF && p_ < PEND) { const int pos_ = p_ - PADF; s_ = pos_ < N_META ? GIN(a, I_META) + (size_t)pos_ * D_MODEL : GIN(a, I_XP) + ((size_t)b_ * SEQ + pos_ - N_META) * D_MODEL; } } } } while (0)
#define N0_OUT(m_, v_) do { if ((m_) < RP) { float s2_ = 0.f; _Pragma("unroll") for (int j = 0; j < 4; ++j) s2_ += (v_[j].x * v_[j].x + v_[j].y * v_[j].y) + (v_[j].z * v_[j].z + v_[j].w * v_[j].w); \
        const float r_ = __builtin_amdgcn_rsqf(wave_sum(s2_) * (1.f / D_MODEL) + EPSF); \
        GAS f32x4* o_ = (GAS f32x4*)(X + (size_t)(m_) * D_MODEL) + lane; GAS unsigned long long* o8_ = (GAS unsigned long long*)(XN + (size_t)(m_) * D_MODEL) + lane; \
        _Pragma("unroll") for (int j = 0; j < 4; ++j) { o_[64 * j] = v_[j]; \
            o8_[64 * j] = (unsigned long long)pk2(v_[j].x * r_ * gg[j].x, v_[j].y * r_ * gg[j].y) | ((unsigned long long)pk2(v_[j].z * r_ * gg[j].z, v_[j].w * r_ * gg[j].w) << 32); } } } while (0)
    for (int m = gw; m < RP; m += 2 * NGW) {
        const int m2 = m + NGW; const float* sa; const float* sb; N0_SRC(m, sa); N0_SRC(m2, sb);
        f32x4 va[4], vb[4];
#pragma unroll
        for (int j = 0; j < 4; ++j) va[j] = sa ? ((const GAS f32x4*)sa)[lane + 64 * j] : (f32x4){0.f, 0.f, 0.f, 0.f};
#pragma unroll
        for (int j = 0; j < 4; ++j) vb[j] = sb ? ((const GAS f32x4*)sb)[lane + 64 * j] : (f32x4){0.f, 0.f, 0.f, 0.f};
        N0_OUT(m, va); N0_OUT(m2, vb);
    }
#undef N0_SRC
#undef N0_OUT
}
__device__ __forceinline__ void unpack8(const v4u w, float (&f)[8]) { f[0] = bflo(w.x); f[1] = bfhi(w.x); f[2] = bflo(w.y); f[3] = bfhi(w.y); f[4] = bflo(w.z); f[5] = bfhi(w.z); f[6] = bflo(w.w); f[7] = bfhi(w.w); }
__device__ __forceinline__ v4u pack8(const float (&f)[8]) { v4u w; w.x = pk2(f[0], f[1]); w.y = pk2(f[2], f[3]); w.z = pk2(f[4], f[5]); w.w = pk2(f[6], f[7]); return w; }
__device__ __forceinline__ float sigm(float x) { return __builtin_amdgcn_rcpf(1.f + __expf(-x)); }
constexpr float ATT_C2 = 0.125f * 1.4426950408889634f;
__device__ __forceinline__ void p_zpost(Frame& F, int l) {
    const KArgs ap = kargs(); const auto& a = *ap; WS_OPAQUE(a);
    const bf16* Z = (const bf16*)(wsb + a.off[R_Z]);
    bf16* QN = (bf16*)(wsb + a.off[R_QN]); bf16* KN = (bf16*)(wsb + a.off[R_KN]); bf16* QKVB = (bf16*)(wsb + a.off[R_QKVB]); float* BG = (float*)(wsb + a.off[R_BG]);
    const int tid = otid(), lane = tid & 63, wave = __builtin_amdgcn_readfirstlane(tid >> 6);
    const int gw = F.vcu * NWAVES + wave, NGW = F.G * NWAVES;
    float gq[8], gk[8], cw[3][4][8];
#pragma unroll
    for (int j = 0; j < 8; ++j) { gq[j] = GIN(a, I_QN)[l * HEAD_DIM_A + 8 * (lane & 7) + j] * ATT_C2; gk[j] = GIN(a, I_KN)[l * HEAD_DIM_A + 8 * (lane & 7) + j]; }
#pragma unroll
    for (int w = 0; w < 3; ++w)
#pragma unroll
        for (int i = 0; i < 4; ++i)
#pragma unroll
            for (int j = 0; j < 8; ++j) cw[w][i][j] = GIN(a, I_CONVW)[((size_t)l * CONV_W + i) * 3 * WIDTH_B + w * WIDTH_B + 8 * lane + j];
    float alog = 0.f, dtb = 0.f; if (lane < 4) { alog = GIN(a, I_ALOG)[l * N_HEADS_B + lane]; dtb = GIN(a, I_DTB)[l * N_HEADS_B + lane]; }
    for (int m = gw; m < RP; m += NGW) {
        const bool valid = prow_valid(m); const int nat = valid ? prow2nat(m) : 0;
        const bf16* zr = Z + (size_t)m * ZN;
        float f[8], o[8];
        const v4u Lq = *(const GAS v4u*)(zr + ZC_QA + 8 * lane), Lk = *(const GAS v4u*)(zr + ZC_KA + 8 * lane), Lv = *(const GAS v4u*)(zr + ZC_VA + 8 * lane);
        v4u Lc[3][4];
#pragma unroll
        for (int w = 0; w < 3; ++w)
#pragma unroll
            for (int i = 0; i < 4; ++i) { const int mm = m + i - 3 < 0 ? 0 : m + i - 3; Lc[w][i] = *(const GAS v4u*)(Z + (size_t)mm * ZN + ZC_QKVB + w * WIDTH_B + 8 * lane); }
        const unsigned short Lbe = zr[ZC_BA + (lane & 3)], Lal = zr[ZC_BA + 4 + (lane & 3)];
        unpack8(Lq, f);
        { float ss = 0.f;
#pragma unroll
          for (int j = 0; j < 8; ++j) ss += f[j] * f[j];
          ss = sum8(ss);
          const float r = __builtin_amdgcn_rsqf(ss * (1.f / HEAD_DIM_A) + EPSF);
#pragma unroll
          for (int j = 0; j < 8; ++j) o[j] = f[j] * r * gq[j];
          *(GAS v4u*)(QN + (size_t)m * WIDTH_A + 8 * lane) = pack8(o); }
        unpack8(Lk, f);
        { float ss = 0.f;
#pragma unroll
          for (int j = 0; j < 8; ++j) ss += f[j] * f[j];
          ss = sum8(ss);
          const float r = __builtin_amdgcn_rsqf(ss * (1.f / HEAD_DIM_A) + EPSF);
#pragma unroll
          for (int j = 0; j < 8; ++j) o[j] = f[j] * r * gk[j];
          *(GAS v4u*)(KN + (size_t)m * WIDTH_A + 8 * lane) = pack8(o);
          if (valid) { float* ko = nat < NP ? GOUT(a) + O_KP + ((size_t)l * NP + nat) * WIDTH_A : GOUT(a) + O_KS + ((size_t)l * NS + (nat - NP)) * WIDTH_A;
              *(GAS f32x4*)(ko + 8 * lane) = (f32x4){o[0], o[1], o[2], o[3]}; *(GAS f32x4*)(ko + 8 * lane + 4) = (f32x4){o[4], o[5], o[6], o[7]}; } }
        if (valid) { unpack8(Lv, f);
            float* vo = nat < NP ? GOUT(a) + O_VP + ((size_t)l * NP + nat) * WIDTH_A : GOUT(a) + O_VS + ((size_t)l * NS + (nat - NP)) * WIDTH_A;
            *(GAS f32x4*)(vo + 8 * lane) = (f32x4){f[0], f[1], f[2], f[3]}; *(GAS f32x4*)(vo + 8 * lane + 4) = (f32x4){f[4], f[5], f[6], f[7]}; }
        const int ts = m >= SROW0 ? (m - SROW0) % DEC_SEQ : 1000; const int bs = m >= SROW0 ? (m - SROW0) / DEC_SEQ : 0;
        int cj = -1;
        if (m >= SROW0) { if (ts >= DEC_SEQ - 3) cj = ts - (DEC_SEQ - 3); } else { const int p = m % LPP; if (p >= PEND - 3 && p < PEND) cj = p - (PEND - 3); }
#pragma unroll
        for (int w = 0; w < 3; ++w) {
            float acc[8];
#pragma unroll
            for (int j = 0; j < 8; ++j) acc[j] = 0.f;
#pragma unroll
            for (int i = 0; i < 4; ++i) {
                const int dt = i - 3;
                if (ts + dt < 0) {
                    const float* sc = GIN(a, I_SCONV) + (((size_t)l * DEC_BATCH + bs) * (CONV_W - 1) + (CONV_W - 1 + ts + dt)) * 3 * WIDTH_B + w * WIDTH_B + 8 * lane;
                    const f32x4 s0 = *(const GAS f32x4*)sc, s1 = *(const GAS f32x4*)(sc + 4);
                    f[0] = s0.x; f[1] = s0.y; f[2] = s0.z; f[3] = s0.w; f[4] = s1.x; f[5] = s1.y; f[6] = s1.z; f[7] = s1.w;
                } else unpack8(Lc[w][i], f);
#pragma unroll
                for (int j = 0; j < 8; ++j) acc[j] += f[j] * cw[w][i][j];
                if (i == 3 && cj >= 0) {
                    float* co = m >= SROW0 ? GOUT(a) + O_CS + (((size_t)l * DEC_BATCH + bs) * (CONV_W - 1) + cj) * 3 * WIDTH_B : GOUT(a) + O_CP + (((size_t)l * BATCH + m / LPP) * (CONV_W - 1) + cj) * 3 * WIDTH_B;
                    *(GAS f32x4*)(co + w * WIDTH_B + 8 * lane) = (f32x4){f[0], f[1], f[2], f[3]}; *(GAS f32x4*)(co + w * WIDTH_B + 8 * lane + 4) = (f32x4){f[4], f[5], f[6], f[7]}; }
            }
            float ss = 0.f;
#pragma unroll
            for (int j = 0; j < 8; ++j) { acc[j] = acc[j] * sigm(acc[j]); ss += acc[j] * acc[j]; }
            float sc = 1.f;
            if (w < 2) { ss = sum16(ss);
                sc = __builtin_amdgcn_rsqf(ss + EPSF); if (w == 0) sc *= 0.08838834764831845f; }
#pragma unroll
            for (int j = 0; j < 8; ++j) o[j] = acc[j] * sc;
            *(GAS v4u*)(QKVB + (size_t)m * 3 * WIDTH_B + w * WIDTH_B + 8 * lane) = pack8(o);
        }
        if (lane < 4) { const float be = bf2f(Lbe), al = bf2f(Lal) + dtb;
            const float sp = al > 20.f ? al : __logf(1.f + __expf(al));
            BG[(size_t)m * 8 + lane] = valid ? sigm(be) : 0.f; BG[(size_t)m * 8 + 4 + lane] = valid ? -__expf(alog) * sp : 0.f; }
    }
}
constexpr float LOG2E = 1.4426950408889634f;
__device__ __forceinline__ int t5_bucket_dev(int rel) {
    const int n = rel < 0 ? -rel : rel; int b;
    if (n < 8) b = n; else if (n < 12) b = 8; else if (n < 16) b = 9; else if (n < 23) b = 10; else if (n < 32) b = 11;
    else if (n < 46) b = 12; else if (n < 64) b = 13; else if (n < 91) b = 14; else b = 15;
    return b + (rel > 0 ? 16 : 0);
}
__device__ __forceinline__ void build_bias_table(LAS float* tab, const float* rel_bias, int h, int tid) {
    const float far = rel_bias[15 * N_HEADS_A + h];
    for (int i = tid; i < attn_body::BT_N; i += NTHR) tab[i] = (rel_bias[t5_bucket_dev(i - attn_body::BT_OFF) * N_HEADS_A + h] - far) * LOG2E;
}
__device__ __forceinline__ float lam_init_dev(int l) { return 0.8f - 0.6f * __expf(-0.3f * (float)l); }
__device__ __forceinline__ float lam_dev(const float* lqk_all, int l, int lane) {
    const float* q = lqk_all + (size_t)l * 4 * HEAD_DIM_A;
    const float s0 = wave_sum(q[lane] * q[HEAD_DIM_A + lane]), s1 = wave_sum(q[2 * HEAD_DIM_A + lane] * q[3 * HEAD_DIM_A + lane]);
    return __expf(s0) - __expf(s1) + lam_init_dev(l);
}
__device__ __forceinline__ int krow_dev(int s, int h, int j) { return 16 * s + 8 * (j >> 2) + 4 * h + (j & 3); }
__device__ __forceinline__ int crow_dev(int r, int h) { return (r & 3) + 8 * (r >> 2) + 4 * h; }
__device__ __forceinline__ bf16x8 pack_f8(const f32x4 a, const f32x4 b) { v4u w; w.x = pk2(a.x, a.y); w.y = pk2(a.z, a.w); w.z = pk2(b.x, b.y); w.w = pk2(b.z, b.w); return __builtin_bit_cast(bf16x8, w); }

__device__ __forceinline__ void sample_scores(f32x16& X, int kb, int c, const float* ck, const bf16* KN, int row0, int h, int hi, int r32, int qpos, const bf16x8 (&qf)[4], const LAS float* tab) {
    bf16x8 kf[4];
    if (kb < PAST_LEN / 32) { const float* kr = ck + (size_t)(kb * 32 + r32) * WIDTH_A + h * 128 + c * 64 + 8 * hi;
#pragma unroll
        for (int s = 0; s < 4; ++s) kf[s] = pack_f8(*(const GAS f32x4*)(kr + 16 * s), *(const GAS f32x4*)(kr + 16 * s + 4)); }
    else { const bf16* kr = KN + (size_t)(row0 + (kb * 32 - PAST_LEN) + r32) * WIDTH_A + h * 128 + c * 64 + 8 * hi;
#pragma unroll
        for (int s = 0; s < 4; ++s) kf[s] = *(const GAS bf16x8*)(kr + 16 * s); }
#pragma unroll
    for (int i = 0; i < 16; ++i) X[i] = 0.f;
#pragma unroll
    for (int s = 0; s < 4; ++s) X = __builtin_amdgcn_mfma_f32_32x32x16_bf16(kf[s], qf[s], X, 0, 0, 0);
#pragma unroll
    for (int i = 0; i < 16; ++i) { int idx = kb * 32 + crow_dev(i, hi) - qpos + attn_body::BT_OFF; idx = idx < 0 ? 0 : idx; X[i] += tab[idx]; }
}

__device__ __forceinline__ void attn_sample_unit(Frame& F, int l, int bs, int h) {
    const KArgs ap = kargs(); const auto& a = *ap; WS_OPAQUE(a);
    const int tid = otid(), lane = tid & 63, wid = __builtin_amdgcn_readfirstlane(tid >> 6), r32 = lane & 31, hi = lane >> 5;
    const bf16* QN = (const bf16*)(wsb + a.off[R_QN]); const bf16* KN = (const bf16*)(wsb + a.off[R_KN]); const bf16* Z = (const bf16*)(wsb + a.off[R_Z]); bf16* O = (bf16*)(wsb + a.off[R_O]);
    const float* ck = GIN(a, I_CK) + ((size_t)l * DEC_BATCH + bs) * PAST_LEN * WIDTH_A; const float* cv = GIN(a, I_CV) + ((size_t)l * DEC_BATCH + bs) * PAST_LEN * WIDTH_A;
    const int row0 = SROW0 + bs * DEC_SEQ;
    LAS float* tab = (LAS float*)(F.lds + RING_OFF + attn_body::LDS_BT);
    LAS float* st = (LAS float*)(F.lds + RING_OFF + 90112);
    LAS float* slot = (LAS float*)(F.lds + RING_OFF);
    const float lam = lam_dev(GIN(a, I_LQK), l, lane);
    build_bias_table(tab, GIN(a, I_REL), h, tid);
    bf16x8 qf[2][4];
#pragma unroll
    for (int c = 0; c < 2; ++c)
#pragma unroll
        for (int s = 0; s < 4; ++s) qf[c][s] = *(const GAS bf16x8*)(QN + (size_t)(row0 + r32) * WIDTH_A + h * 128 + c * 64 + 16 * s + 8 * hi);
    __syncthreads();
    float m[2] = {-1e30f, -1e30f}, lsum[2] = {0.f, 0.f};
    const int qpos = PAST_LEN + r32;
    for (int kb = wid; kb < (PAST_LEN + DEC_SEQ) / 32; kb += NWAVES) {
#pragma unroll
        for (int c = 0; c < 2; ++c) { f32x16 X; sample_scores(X, kb, c, ck, KN, row0, h, hi, r32, qpos, qf[c], tab);
            float mx = X[0];
#pragma unroll
            for (int i = 1; i < 16; ++i) mx = fmaxf(mx, X[i]);
            mx = fmaxf(mx, swap32(mx)); const float mn = fmaxf(m[c], mx);
            float sum = 0.f;
#pragma unroll
            for (int i = 0; i < 16; ++i) sum += exp2f(X[i] - mn);
            lsum[c] = lsum[c] * exp2f(m[c] - mn) + sum; m[c] = mn; }
    }
#pragma unroll
    for (int c = 0; c < 2; ++c) { lsum[c] += swap32(lsum[c]); if (hi == 0) { st[((wid * 2 + c) * 2 + 0) * 32 + r32] = m[c]; st[((wid * 2 + c) * 2 + 1) * 32 + r32] = lsum[c]; } }
    __syncthreads();
    float gm[2], ginv[2];
#pragma unroll
    for (int c = 0; c < 2; ++c) { float mm = -1e30f;
#pragma unroll
        for (int w = 0; w < NWAVES; ++w) mm = fmaxf(mm, st[((w * 2 + c) * 2 + 0) * 32 + r32]);
        float ll = 0.f;
#pragma unroll
        for (int w = 0; w < NWAVES; ++w) ll += st[((w * 2 + c) * 2 + 1) * 32 + r32] * exp2f(st[((w * 2 + c) * 2 + 0) * 32 + r32] - mm);
        gm[c] = mm; ginv[c] = (c == 0 ? 1.f : lam) / ll; }
    f32x16 acc[4];
#pragma unroll
    for (int eb = 0; eb < 4; ++eb)
#pragma unroll
        for (int i = 0; i < 16; ++i) acc[eb][i] = 0.f;
    for (int kb = wid; kb < (PAST_LEN + DEC_SEQ) / 32; kb += NWAVES) {
        f32x16 X0, X1; sample_scores(X0, kb, 0, ck, KN, row0, h, hi, r32, qpos, qf[0], tab); sample_scores(X1, kb, 1, ck, KN, row0, h, hi, r32, qpos, qf[1], tab);
        float wv[16];
#pragma unroll
        for (int i = 0; i < 16; ++i) wv[i] = exp2f(X0[i] - gm[0]) * ginv[0] - exp2f(X1[i] - gm[1]) * ginv[1];
        bf16x8 xs[2];
#pragma unroll
        for (int s = 0; s < 2; ++s) { v4u w; w.x = pk2(wv[8 * s], wv[8 * s + 1]); w.y = pk2(wv[8 * s + 2], wv[8 * s + 3]); w.z = pk2(wv[8 * s + 4], wv[8 * s + 5]); w.w = pk2(wv[8 * s + 6], wv[8 * s + 7]); xs[s] = __builtin_bit_cast(bf16x8, w); }
#pragma unroll
        for (int eb = 0; eb < 4; ++eb)
#pragma unroll
            for (int s = 0; s < 2; ++s) {
                float vv[8];
                if (kb < PAST_LEN / 32) { const GAS float* vb = (const GAS float*)(cv + (size_t)(kb * 32 + 4 * hi) * WIDTH_A + h * 128 + eb * 32 + r32); asm volatile("" : "+v"(vb));
#pragma unroll
                    for (int j = 0; j < 8; ++j) vv[j] = vb[(size_t)(16 * s + 8 * (j >> 2) + (j & 3)) * WIDTH_A]; }
                else { const GAS bf16* vb = (const GAS bf16*)(Z + (size_t)(row0 + kb * 32 - PAST_LEN + 4 * hi) * ZN + ZC_VA + h * 128 + eb * 32 + r32); asm volatile("" : "+v"(vb));
#pragma unroll
                    for (int j = 0; j < 8; ++j) vv[j] = bf2f(vb[(size_t)(16 * s + 8 * (j >> 2) + (j & 3)) * ZN]); }
                v4u w; w.x = pk2(vv[0], vv[1]); w.y = pk2(vv[2], vv[3]); w.z = pk2(vv[4], vv[5]); w.w = pk2(vv[6], vv[7]);
                acc[eb] = __builtin_amdgcn_mfma_f32_32x32x16_bf16(xs[s], __builtin_bit_cast(bf16x8, w), acc[eb], 0, 0, 0);
            }
    }
    __syncthreads();
#pragma unroll
    for (int eb = 0; eb < 4; ++eb)
#pragma unroll
        for (int i = 0; i < 16; ++i) slot[(wid * 32 + crow_dev(i, hi)) * 128 + eb * 32 + r32] = acc[eb][i];
    __syncthreads();
    { const int q = tid >> 4, e0 = (tid & 15) * 8; float o[8];
#pragma unroll
      for (int j = 0; j < 8; ++j) o[j] = 0.f;
#pragma unroll
      for (int w = 0; w < NWAVES; ++w)
#pragma unroll
          for (int j = 0; j < 8; ++j) o[j] += slot[(w * 32 + q) * 128 + e0 + j];
      v4u pw; pw.x = pk2(o[0], o[1]); pw.y = pk2(o[2], o[3]); pw.z = pk2(o[4], o[5]); pw.w = pk2(o[6], o[7]);
      bf16* orow = O + (size_t)(row0 + q) * attn_body::OP + h * 256;
      unsigned zq = 0u; asm volatile("" : "+v"(zq));
      *(GAS v4u*)(orow + e0) = pw; *(GAS v4u*)(orow + 128 + e0) = (v4u){zq, zq, zq, zq}; }
    __syncthreads();
}

constexpr int ATT_NQB = LPP / 256;
constexpr int ATT_NPU = BATCH * 16 * ATT_NQB;
constexpr int ATT_NSU = DEC_BATCH * N_HEADS_A;
__device__ __forceinline__ void p_attention(Frame& F, int lq, unsigned char* ldsg) {
    const int l = lq % DEPTH;
    for (;;) {
        const KArgs ap = kargs(); const auto& a = *ap; WS_OPAQUE(a);
        const int tid = otid();
        gu32* head = (gu32*)wsb + CW_QUEUE + 64 * lq;
        const attn_body::bf16* QN = (const attn_body::bf16*)(wsb + a.off[R_QN]); const attn_body::bf16* KN = (const attn_body::bf16*)(wsb + a.off[R_KN]);
        const attn_body::bf16* Z = (const attn_body::bf16*)(wsb + a.off[R_Z]); attn_body::bf16* O = (attn_body::bf16*)(wsb + a.off[R_O]);
        if (tid == 0) F.MISC[16] = __hip_atomic_fetch_add(head, 1u, RLX_AGENT);
        __syncthreads();
        const int u = (int)F.MISC[16];
        __syncthreads();
        if (u >= ATT_NPU + ATT_NSU) break;
        if (u < ATT_NPU) {
            const int qb = (ATT_NQB - 1) - u / 32, bvh = u % 32, b = bvh >> 4, vh = bvh & 15, h = vh >> 2, c = (vh >> 1) & 1, half = vh & 1;
            build_bias_table((LAS float*)(F.lds + RING_OFF + attn_body::LDS_BT), GIN(a, I_REL), h, tid);
            __syncthreads();
            attn_body::attn_unit<8>(b, h * 128 + c * 64, ZC_VA + h * 128 + half * 64, h * 256 + c * 128 + half * 64, qb, QN, KN, Z, O, (char*)ldsg + RING_OFF, F.wv);
        } else { const int su = u - ATT_NPU; attn_sample_unit(F, l, su >> 2, su & 3); }
    }
}
__device__ __forceinline__ void p_mixpost_a(Frame& F, int l) {
    const KArgs ap = kargs(); const auto& a = *ap; WS_OPAQUE(a);
    const int tid = otid(), lane = tid & 63, wave = __builtin_amdgcn_readfirstlane(tid >> 6);
    const bf16* O = (const bf16*)(wsb + a.off[R_O]); bf16* OA = (bf16*)(wsb + a.off[R_OA]);
    const int gw = F.vcu * NWAVES + wave, NGW = F.G * NWAVES;
    const float lam = lam_dev(GIN(a, I_LQK), l, lane), post = 1.f - lam_init_dev(l);
    const int h = lane >> 4, e0 = 8 * (lane & 15);
    float sg[8];
#pragma unroll
    for (int j = 0; j < 8; ++j) sg[j] = GIN(a, I_SUBLN)[l * 2 * HEAD_DIM_A + e0 + j] * post;
    v4u n0 = *(const GAS v4u*)(O + (size_t)gw * 1024 + h * 256 + e0), n1 = *(const GAS v4u*)(O + (size_t)gw * 1024 + h * 256 + 128 + e0);
    for (int m = gw; m < RP; m += NGW) {
        float o0[8], o1[8], d[8];
        unpack8(n0, o0); unpack8(n1, o1);
        { const int mn = m + NGW < RP ? m + NGW : gw; n0 = *(const GAS v4u*)(O + (size_t)mn * 1024 + h * 256 + e0); n1 = *(const GAS v4u*)(O + (size_t)mn * 1024 + h * 256 + 128 + e0); }
        float ss = 0.f;
#pragma unroll
        for (int j = 0; j < 8; ++j) { d[j] = o0[j] - lam * o1[j]; ss += d[j] * d[j]; }
        ss = sum16(ss);
        const float r = __builtin_amdgcn_rsqf(ss * (1.f / 128.f) + EPSF);
#pragma unroll
        for (int j = 0; j < 8; ++j) d[j] = d[j] * r * sg[j];
        *(GAS v4u*)(OA + (size_t)m * WIDTH_A + h * 128 + e0) = pack8(d);
    }
}
constexpr int GDN_NCH = PEND / 64;
constexpr int GDN_NPI = BATCH * N_HEADS_B * GDN_NCH;
constexpr int GDN_NSI = DEC_BATCH * N_HEADS_B;
constexpr int GDN_NI = GDN_NPI + GDN_NSI;
constexpr int GI_W = 0, GI_QG = 16384, GI_KG = 32768, GI_AT = 49152, GI_U = 57344, GI_SC = 73728, GI_STRIDE = 73984, GI_EG = 2048  ;
static_assert(GDN_NI % 4 == 0 && PEND % 64 == 0, "gdn items");
__device__ __forceinline__ int frag_off(int row, int kk, int nkb) {
    const int fid = ((row >> 5) * nkb + (kk >> 5)) * 2 + ((kk & 31) >> 4), ln = (row & 31) + 32 * (((kk & 15) >> 2) & 1), j = ((kk & 15) >> 3) * 4 + (kk & 3);
    return (fid * 64 + ln) * 8 + j;
}
__device__ __forceinline__ int gdn_item_row(int item, int j) {
    if (item < GDN_NPI) { const int sh = item / GDN_NCH, n = item % GDN_NCH; return (sh / N_HEADS_B) * LPP + 64 * n + j; }
    const int s = item - GDN_NPI; return j < 32 ? -1 : SROW0 + (s >> 2) * DEC_SEQ + (j - 32);
}
__device__ __forceinline__ int gdn_item_head(int item) { return item < GDN_NPI ? (item / GDN_NCH) % N_HEADS_B : (item - GDN_NPI) & 3; }

__device__ __forceinline__ void gdn_flush(const LAS unsigned char* stg, unsigned char* dst, int nbytes, int gt) {
    for (int o = gt * 16; o < nbytes; o += 2048) *(GAS v4u*)(dst + o) = *(const LAS v4u*)(stg + o);
}
typedef float f32x2s __attribute__((ext_vector_type(2)));
#define GDN_RL8(a, arow, jb) asm volatile("v_readlane_b32 %0, %8, %9\n\tv_readlane_b32 %1, %8, %10\n\tv_readlane_b32 %2, %8, %11\n\tv_readlane_b32 %3, %8, %12\n\tv_readlane_b32 %4, %8, %13\n\tv_readlane_b32 %5, %8, %14\n\tv_readlane_b32 %6, %8, %15\n\tv_readlane_b32 %7, %8, %16" \
    : "=s"(a[0]), "=s"(a[1]), "=s"(a[2]), "=s"(a[3]), "=s"(a[4]), "=s"(a[5]), "=s"(a[6]), "=s"(a[7]) : "v"(arow), "i"(jb), "i"((jb) + 1), "i"((jb) + 2), "i"((jb) + 3), "i"((jb) + 4), "i"((jb) + 5), "i"((jb) + 6), "i"((jb) + 7))
template <int I, int JB> __device__ __forceinline__ void gdn_subst_blk(f32x2s (&x)[64], float arow) {
    if constexpr (JB < I) { float ar[8]; GDN_RL8(ar, arow, JB);
#pragma unroll
        for (int t = 0; t < 8; ++t) if (JB + t < I) x[I] -= ar[t] * x[JB + t];
        gdn_subst_blk<I, JB + 8>(x, arow); }
}
template <int... Is> __device__ __forceinline__ void gdn_subst_all(f32x2s (&x)[64], const LAS float* A, int lane, std::integer_sequence<int, Is...>) {
    (gdn_subst_blk<Is + 1, 0>(x, A[(Is + 1) * 64 + lane]), ...);
}
template <int MODE> __device__ __forceinline__ void p_gdn_chunk(Frame& F, int l, int q) {
    const KArgs ap = kargs(); const auto& a = *ap; WS_OPAQUE(a);
    const int tid = otid(), wave = __builtin_amdgcn_readfirstlane(tid >> 6), grp = wave >> 1, gw = wave & 1;
    const bf16* QKVB = (const bf16*)(wsb + a.off[R_QKVB]); const float* BG = (const float*)(wsb + a.off[R_BG]); unsigned char* GD = wsb + a.off[R_GDN];
    LAS float* A_lds = (LAS float*)(F.lds + RING_OFF + grp * 34816);
    LAS float* Gs = A_lds + 4096; LAS float* Bs = Gs + 64; LAS float* Es = Bs + 64;
    LAS unsigned char* stg = (LAS unsigned char*)(A_lds + 4096 + 256);
    LAS bf16* stgh = (LAS bf16*)stg;
    static_assert(4 * 34816 <= RING_BYTES && GDN_NI % 4 == 0, "gdn chunk LDS / items");
    for (int pr = MODE == 0 ? F.vcu : q; MODE == 0 ? pr < (GDN_NPI - BATCH * N_HEADS_B) / 4 : pr == q; pr += (MODE == 0 ? F.G : 1 << 20)) {
        int lane_ = otid() & 63;
        const int lane = lane_, r32 = lane & 31, hi = lane >> 5, gt = gw * 64 + lane;
        int item;
        if (MODE == 0) { const int j = 4 * pr + grp; item = (j >> 7) * GDN_NCH + (j & 127); }
        else item = q < 16 ? GDN_NPI + 4 * q + grp : (4 * (q - 16) + grp) * GDN_NCH + (GDN_NCH - 1);
        const int h = gdn_item_head(item);
        unsigned char* ib = GD + (size_t)item * GI_STRIDE;
        const int rowt = gdn_item_row(item, lane);
        const float beta = rowt >= 0 ? BG[(size_t)rowt * 8 + h] : 0.f; float G = rowt >= 0 ? BG[(size_t)rowt * 8 + 4 + h] : 0.f;
        G = scan64(G);
        const float Glast = rdlane(G, 63), eG = __expf(G);
        if (gw == 0) { Gs[lane] = G; Bs[lane] = beta; Es[lane] = eG; }
        __syncthreads();
#pragma unroll
        for (int bq = 0; bq < 2; ++bq) {
          const int i0 = 32 * gw, j0 = 32 * bq; const int j = j0 + r32;
          if (gw == 0 && bq == 1) {
#pragma unroll
              for (int r = 0; r < 16; ++r) { const int i = crow_dev(r, hi); A_lds[i * 64 + j] = 0.f; stgh[frag_off(i, j, 2)] = (bf16)0; }
              LDS_WAIT(); if (lane == 0) *(LAS float*)(stg + GI_EG) = __expf(Glast);
          } else {
          const int ra = gdn_item_row(item, i0 + r32), rb = gdn_item_row(item, j0 + r32);
          f32x16 akk, aqk;
#pragma unroll
          for (int r = 0; r < 16; ++r) { akk[r] = 0.f; aqk[r] = 0.f; }
          const bf16x8 zf = {0, 0, 0, 0, 0, 0, 0, 0};
          bf16x8 qa[8], ka[8], kb[8];
          { const bf16* pa = QKVB + (size_t)(ra < 0 ? 0 : ra) * 1536 + h * 128 + 8 * hi; const bf16* pb = QKVB + (size_t)(rb < 0 ? 0 : rb) * 1536 + 512 + h * 128 + 8 * hi;
#pragma unroll
            for (int s = 0; s < 8; ++s) { qa[s] = *(const GAS bf16x8*)(pa + 16 * s); ka[s] = *(const GAS bf16x8*)(pa + 512 + 16 * s); kb[s] = *(const GAS bf16x8*)(pb + 16 * s); } }
#pragma unroll
          for (int s = 0; s < 8; ++s) { if (ra < 0) { qa[s] = zf; ka[s] = zf; } if (rb < 0) kb[s] = zf;
              akk = __builtin_amdgcn_mfma_f32_32x32x16_bf16(ka[s], kb[s], akk, 0, 0, 0); aqk = __builtin_amdgcn_mfma_f32_32x32x16_bf16(qa[s], kb[s], aqk, 0, 0, 0); }
          const float Gj = Gs[j];
#pragma unroll
          for (int r = 0; r < 16; ++r) { const int i = i0 + crow_dev(r, hi); const float dec = i >= j ? __expf(Gs[i] - Gj) : 0.f;
              A_lds[i * 64 + j] = i > j ? Bs[i] * akk[r] * dec : 0.f;
              stgh[frag_off(i, j, 2)] = (bf16)f2bf(aqk[r] * dec); }
          }
        }
        __syncthreads();
        gdn_flush(stg, ib + GI_AT, 8192, gt);
        { f32x2s x[64]; const int cbase = gw == 0 ? 1024 + h * 128 : 512 + h * 128;
#pragma unroll
          for (int i = 0; i < 64; ++i) { const int ri = __builtin_amdgcn_readfirstlane(gdn_item_row(item, i));
              const bf16* rowp = QKVB + (size_t)(ri < 0 ? 0 : ri) * 1536 + cbase;
              x[i] = ri >= 0 ? (f32x2s){bf2f(rowp[lane]), bf2f(rowp[lane + 64])} : (f32x2s){0.f, 0.f}; }
          const float rsc = gw == 0 ? beta : beta * eG;
#pragma unroll
          for (int i = 0; i < 64; ++i) x[i] *= rdlane(rsc, i);
          gdn_subst_all(x, A_lds, lane, std::make_integer_sequence<int, 63>{});
          __syncthreads();
          if (gw == 0) { GAS bf16* ub = (GAS bf16*)(ib + GI_U) + lane; asm volatile("" : "+v"(ub));
#pragma unroll
              for (int i = 0; i < 64; ++i) { ub[i * 128] = (bf16)f2bf(x[i].x); ub[i * 128 + 64] = (bf16)f2bf(x[i].y); } }
          else { LAS bf16* wb0 = stgh + frag_off(0, lane, 4); LAS bf16* wb1 = stgh + frag_off(0, lane + 64, 4);
#pragma unroll
              for (int i = 0; i < 64; ++i) { wb0[(i >> 5) * 4096 + (i & 31) * 8] = (bf16)f2bf(x[i].x); wb1[(i >> 5) * 4096 + (i & 31) * 8] = (bf16)f2bf(x[i].y); } }
        }
        __syncthreads();
        gdn_flush(stg, ib + GI_W, 16384, gt);
        __syncthreads();
        const float kgs = __expf(Glast - G);
#pragma unroll
        for (int hf = 0; hf < 2; ++hf) { float qv[32];
#pragma unroll
          for (int it = 0; it < 32; ++it) { const int c = it + 32 * hf, rc = __builtin_amdgcn_readfirstlane(gdn_item_row(item, c)); const bf16* rowp = QKVB + (size_t)(rc < 0 ? 0 : rc) * 1536 + h * 128; qv[it] = rc >= 0 ? bf2f(rowp[gt]) : 0.f; }
#pragma unroll
          for (int it = 0; it < 32; ++it) { const int c = it + 32 * hf; stgh[frag_off(c, gt, 4)] = (bf16)f2bf(qv[it] * rdlane(eG, c)); } }
        __syncthreads();
        gdn_flush(stg, ib + GI_QG, 16384, gt);
        __syncthreads();
#pragma unroll
        for (int hf = 0; hf < 2; ++hf) { float kv[32];
#pragma unroll
          for (int it = 0; it < 32; ++it) { const int c = it + 32 * hf, rc = __builtin_amdgcn_readfirstlane(gdn_item_row(item, c)); const bf16* rowp = QKVB + (size_t)(rc < 0 ? 0 : rc) * 1536 + 512 + h * 128; kv[it] = rc >= 0 ? bf2f(rowp[gt]) : 0.f; }
#pragma unroll
          for (int it = 0; it < 32; ++it) { const int c = it + 32 * hf; stgh[frag_off(gt, c, 2)] = (bf16)f2bf(kv[it] * rdlane(kgs, c)); } }
        __syncthreads();
        gdn_flush(stg, ib + GI_KG, 16384, gt);
        VM_WAIT(); __syncthreads();
        if (MODE == 1 && q >= 16) {
            if (wave == 0 && (otid() & 63) == 0) { __builtin_amdgcn_fence(__ATOMIC_RELEASE, "agent"); asm volatile("s_waitcnt vmcnt(0)" ::: "memory");
                gu32* fl = (gu32*)wsb + CW_GDNFLAG;
#pragma unroll
                for (int c = 0; c < 4; ++c) __hip_atomic_store(fl + 64 * (4 * (q - 16) + c), (unsigned)(l + 1), RLX_AGENT); } }
    }
}

__device__ __forceinline__ void gdn_chain(const unsigned char* GD, bf16* OB, const float* sdelta, float* dout, int item0, int nch, int h, int vb, int lane) {
    const int r32 = lane & 31, hi = lane >> 5;
    f32x16 S[4];
#pragma unroll
    for (int kb = 0; kb < 4; ++kb)
#pragma unroll
        for (int r = 0; r < 16; ++r) S[kb][r] = sdelta ? sdelta[(size_t)(kb * 32 + crow_dev(r, hi)) * HEAD_DIM_B + vb * 32 + r32] : 0.f;
    for (int n = 0; n < nch; ++n) {
        const int item = item0 + n; const unsigned char* ib = GD + (size_t)item * GI_STRIDE;
        const float eGl = *(const float*)(ib + GI_AT + GI_EG);
        const GAS bf16x8* WF = (const GAS bf16x8*)(ib + GI_W) + lane; const GAS bf16x8* QF = (const GAS bf16x8*)(ib + GI_QG) + lane;
        const GAS bf16x8* KF = (const GAS bf16x8*)(ib + GI_KG) + lane; const GAS bf16x8* AF = (const GAS bf16x8*)(ib + GI_AT) + lane; const bf16* U = (const bf16*)(ib + GI_U);
        bf16x8 Sp[4][2];
#pragma unroll
        for (int kb = 0; kb < 4; ++kb)
#pragma unroll
            for (int s = 0; s < 2; ++s) { v4u w; w.x = pk2(S[kb][8 * s], S[kb][8 * s + 1]); w.y = pk2(S[kb][8 * s + 2], S[kb][8 * s + 3]); w.z = pk2(S[kb][8 * s + 4], S[kb][8 * s + 5]); w.w = pk2(S[kb][8 * s + 6], S[kb][8 * s + 7]); Sp[kb][s] = __builtin_bit_cast(bf16x8, w); }
        f32x16 vn[2], ot[2];
#pragma unroll
        for (int cb = 0; cb < 2; ++cb) {
            f32x16 ws;
#pragma unroll
            for (int r = 0; r < 16; ++r) { ws[r] = 0.f; ot[cb][r] = 0.f; }
#pragma unroll
            for (int kb = 0; kb < 4; ++kb)
#pragma unroll
                for (int s = 0; s < 2; ++s) { ws = __builtin_amdgcn_mfma_f32_32x32x16_bf16(WF[((cb * 4 + kb) * 2 + s) * 64], Sp[kb][s], ws, 0, 0, 0);
                    ot[cb] = __builtin_amdgcn_mfma_f32_32x32x16_bf16(QF[((cb * 4 + kb) * 2 + s) * 64], Sp[kb][s], ot[cb], 0, 0, 0); }
#pragma unroll
            for (int r = 0; r < 16; ++r) vn[cb][r] = bf2f(U[(cb * 32 + crow_dev(r, hi)) * 128 + vb * 32 + r32]) - ws[r];
        }
        bf16x8 Vp[2][2];
#pragma unroll
        for (int cb = 0; cb < 2; ++cb)
#pragma unroll
            for (int s = 0; s < 2; ++s) { v4u w; w.x = pk2(vn[cb][8 * s], vn[cb][8 * s + 1]); w.y = pk2(vn[cb][8 * s + 2], vn[cb][8 * s + 3]); w.z = pk2(vn[cb][8 * s + 4], vn[cb][8 * s + 5]); w.w = pk2(vn[cb][8 * s + 6], vn[cb][8 * s + 7]); Vp[cb][s] = __builtin_bit_cast(bf16x8, w); }
#pragma unroll
        for (int cb = 0; cb < 2; ++cb)
#pragma unroll
            for (int c2 = 0; c2 <= cb; ++c2)
#pragma unroll
                for (int s = 0; s < 2; ++s) ot[cb] = __builtin_amdgcn_mfma_f32_32x32x16_bf16(AF[((cb * 2 + c2) * 2 + s) * 64], Vp[c2][s], ot[cb], 0, 0, 0);
#pragma unroll
        for (int cb = 0; cb < 2; ++cb)
#pragma unroll
            for (int r = 0; r < 16; ++r) { const int row = gdn_item_row(item, cb * 32 + crow_dev(r, hi)); if (row >= 0) OB[(size_t)row * WIDTH_B + h * 128 + vb * 32 + r32] = (bf16)f2bf(ot[cb][r]); }
#pragma unroll
        for (int kb = 0; kb < 4; ++kb) {
#pragma unroll
            for (int r = 0; r < 16; ++r) S[kb][r] *= eGl;
#pragma unroll
            for (int cb = 0; cb < 2; ++cb)
#pragma unroll
                for (int s = 0; s < 2; ++s) S[kb] = __builtin_amdgcn_mfma_f32_32x32x16_bf16(KF[((kb * 2 + cb) * 2 + s) * 64], Vp[cb][s], S[kb], 0, 0, 0);
        }
    }
#pragma unroll
    for (int kb = 0; kb < 4; ++kb)
#pragma unroll
        for (int r = 0; r < 16; ++r) dout[(size_t)(kb * 32 + crow_dev(r, hi)) * HEAD_DIM_B + vb * 32 + r32] = S[kb][r];
}
constexpr int GCH_BUF = 73728, GCH_PCS = 18;
#define GCH_BAR() do { asm volatile("s_waitcnt lgkmcnt(0)" ::: "memory"); __builtin_amdgcn_s_barrier(); asm volatile("" ::: "memory"); } while (0)
__device__ __forceinline__ void gdn_chain_wg(Frame& F, const unsigned char* GD, bf16* OB, float* dout, int item0, int h, gu32* flag, unsigned epoch) {
    const int tid = otid(), lane = tid & 63, wave = __builtin_amdgcn_readfirstlane(tid >> 6), r32 = lane & 31, hi = lane >> 5, vb = wave & 3;
    LAS unsigned char* lb = F.lds + RING_OFF;
    if (wave >= 4) {
        const int p0 = (wave - 4) * GCH_PCS;
        v4u R0[GCH_PCS], R1[GCH_PCS];
#define GCH_LOAD(R, c) do { if ((c) == GDN_NCH - 1) { unsigned sp_ = 0; while (__hip_atomic_load(flag, RLX_AGENT) != epoch) { __builtin_amdgcn_s_sleep(2); if (++sp_ > (1u << 22)) break; } \
            __builtin_amdgcn_fence(__ATOMIC_ACQUIRE, "agent"); asm volatile("s_waitcnt vmcnt(0)" ::: "memory"); }     \
            const unsigned char* s_ = GD + (size_t)(item0 + (c)) * GI_STRIDE + (size_t)p0 * 1024 + lane * 16; _Pragma("unroll") for (int j = 0; j < GCH_PCS; ++j) \
            asm volatile("global_load_dwordx4 %0, %1, off" : "=&v"(R[j]) : "v"(s_ + j * 1024) : "memory"); } while (0)
#define GCH_PUT(R, c) do { if ((c) + 1 < GDN_NCH) asm volatile("s_waitcnt vmcnt(18)" ::: "memory"); else asm volatile("s_waitcnt vmcnt(0)" ::: "memory"); \
            LAS v4u* d_ = (LAS v4u*)(lb + ((c) & 1) * GCH_BUF + p0 * 1024) + lane; _Pragma("unroll") for (int j = 0; j < GCH_PCS; ++j) d_[j * 64] = R[j]; } while (0)
        GCH_LOAD(R0, 0); GCH_LOAD(R1, 1);
        GCH_PUT(R0, 0); GCH_LOAD(R0, 2);
        GCH_BAR();
        for (int n = 0; n < GDN_NCH; n += 2) {
            if (n + 1 < GDN_NCH) GCH_PUT(R1, n + 1);
            if (n + 3 < GDN_NCH) GCH_LOAD(R1, n + 3);
            GCH_BAR();
            if (n + 1 < GDN_NCH) {
                if (n + 2 < GDN_NCH) GCH_PUT(R0, n + 2);
                if (n + 4 < GDN_NCH) GCH_LOAD(R0, n + 4);
                GCH_BAR(); }
        }
        asm volatile("s_waitcnt vmcnt(0)" ::: "memory");
#undef GCH_LOAD
#undef GCH_PUT
        return;
    }
    f32x16 S[4];
#pragma unroll
    for (int kb = 0; kb < 4; ++kb)
#pragma unroll
        for (int r = 0; r < 16; ++r) S[kb][r] = 0.f;
    GCH_BAR();
    for (int n = 0; n < GDN_NCH; ++n) {
        const int item = item0 + n; const LAS unsigned char* bufc = lb + (n & 1) * GCH_BUF;
        const float egl = *(const LAS float*)(bufc + GI_AT + GI_EG);
        const LAS bf16x8* WF = (const LAS bf16x8*)(bufc + GI_W) + lane; const LAS bf16x8* QF = (const LAS bf16x8*)(bufc + GI_QG) + lane;
        const LAS bf16x8* KF = (const LAS bf16x8*)(bufc + GI_KG) + lane; const LAS bf16x8* AF = (const LAS bf16x8*)(bufc + GI_AT) + lane; const LAS bf16* U = (const LAS bf16*)(bufc + GI_U);
        bf16x8 Sp[4][2];
#pragma unroll
        for (int kb = 0; kb < 4; ++kb)
#pragma unroll
            for (int s = 0; s < 2; ++s) { v4u w; w.x = pk2(S[kb][8 * s], S[kb][8 * s + 1]); w.y = pk2(S[kb][8 * s + 2], S[kb][8 * s + 3]); w.z = pk2(S[kb][8 * s + 4], S[kb][8 * s + 5]); w.w = pk2(S[kb][8 * s + 6], S[kb][8 * s + 7]); Sp[kb][s] = __builtin_bit_cast(bf16x8, w); }
        f32x16 vn[2], ot[2];
#pragma unroll
        for (int cb = 0; cb < 2; ++cb) {
            f32x16 ws;
#pragma unroll
            for (int r = 0; r < 16; ++r) { ws[r] = 0.f; ot[cb][r] = 0.f; }
#pragma unroll
            for (int kb = 0; kb < 4; ++kb)
#pragma unroll
                for (int s = 0; s < 2; ++s) { ws = __builtin_amdgcn_mfma_f32_32x32x16_bf16(WF[((cb * 4 + kb) * 2 + s) * 64], Sp[kb][s], ws, 0, 0, 0);
                    ot[cb] = __builtin_amdgcn_mfma_f32_32x32x16_bf16(QF[((cb * 4 + kb) * 2 + s) * 64], Sp[kb][s], ot[cb], 0, 0, 0); }
#pragma unroll
            for (int r = 0; r < 16; ++r) vn[cb][r] = bf2f(U[(cb * 32 + crow_dev(r, hi)) * 128 + vb * 32 + r32]) - ws[r];
        }
        bf16x8 Vp[2][2];
#pragma unroll
        for (int cb = 0; cb < 2; ++cb)
#pragma unroll
            for (int s = 0; s < 2; ++s) { v4u w; w.x = pk2(vn[cb][8 * s], vn[cb][8 * s + 1]); w.y = pk2(vn[cb][8 * s + 2], vn[cb][8 * s + 3]); w.z = pk2(vn[cb][8 * s + 4], vn[cb][8 * s + 5]); w.w = pk2(vn[cb][8 * s + 6], vn[cb][8 * s + 7]); Vp[cb][s] = __builtin_bit_cast(bf16x8, w); }
#pragma unroll
        for (int cb = 0; cb < 2; ++cb)
#pragma unroll
            for (int c2 = 0; c2 <= cb; ++c2)
#pragma unroll
                for (int s = 0; s < 2; ++s) ot[cb] = __builtin_amdgcn_mfma_f32_32x32x16_bf16(AF[((cb * 2 + c2) * 2 + s) * 64], Vp[c2][s], ot[cb], 0, 0, 0);
        { const int row0 = gdn_item_row(item, 0);
#pragma unroll
          for (int cb = 0; cb < 2; ++cb)
#pragma unroll
              for (int r = 0; r < 16; ++r) OB[(size_t)(row0 + cb * 32 + crow_dev(r, hi)) * WIDTH_B + h * 128 + vb * 32 + r32] = (bf16)f2bf(ot[cb][r]); }
#pragma unroll
        for (int kb = 0; kb < 4; ++kb) {
#pragma unroll
            for (int r = 0; r < 16; ++r) S[kb][r] *= egl;
#pragma unroll
            for (int cb = 0; cb < 2; ++cb)
#pragma unroll
                for (int s = 0; s < 2; ++s) S[kb] = __builtin_amdgcn_mfma_f32_32x32x16_bf16(KF[((kb * 2 + cb) * 2 + s) * 64], Vp[cb][s], S[kb], 0, 0, 0);
        }
        GCH_BAR();
    }
#pragma unroll
    for (int kb = 0; kb < 4; ++kb)
#pragma unroll
        for (int r = 0; r < 16; ++r) dout[(size_t)(kb * 32 + crow_dev(r, hi)) * HEAD_DIM_B + vb * 32 + r32] = S[kb][r];
}
__device__ __forceinline__ void p_gdn_chain(Frame& F, int l) {
    const KArgs ap = kargs(); const auto& a = *ap; WS_OPAQUE(a);
    const unsigned char* GD = wsb + a.off[R_GDN]; bf16* OB = (bf16*)(wsb + a.off[R_OB]);
    if (F.vcu % 32 == 0 && F.vcu / 32 < BATCH * N_HEADS_B) { const int sh = F.vcu / 32, sq = sh / N_HEADS_B, h = sh % N_HEADS_B;
        gdn_chain_wg(F, GD, OB, GOUT(a) + O_DP + (((size_t)l * BATCH + sq) * N_HEADS_B + h) * HEAD_DIM_B * HEAD_DIM_B, sh * GDN_NCH, h, (gu32*)wsb + CW_GDNFLAG + 64 * sh, (unsigned)(l + 1)); }
    else { const int q = F.vcu - F.vcu / 32 - 1;
        if (q < 18) { p_gdn_chunk<1>(F, l, q);
            if (q < 16) { const int tid = otid(), lane = tid & 63, wave = __builtin_amdgcn_readfirstlane(tid >> 6);
#pragma unroll
                for (int tt = 0; tt < 2; ++tt) { const int t = wave + 8 * tt, s = 4 * q + (t >> 2), vb = t & 3, bs = s >> 2, h = s & 3; const size_t so = (((size_t)l * DEC_BATCH + bs) * N_HEADS_B + h) * HEAD_DIM_B * HEAD_DIM_B;
                    gdn_chain(GD, OB, GIN(a, I_SDELTA) + so, GOUT(a) + O_DS + so, GDN_NPI + s, 1, h, vb, lane); } } } }
}
__device__ __forceinline__ void p_mixpost_b(Frame& F, int l) {
    const KArgs ap = kargs(); const auto& a = *ap; WS_OPAQUE(a);
    const int tid = otid(), lane = tid & 63, wave = __builtin_amdgcn_readfirstlane(tid >> 6);
    const bf16* OB = (const bf16*)(wsb + a.off[R_OB]); bf16* OBN = (bf16*)(wsb + a.off[R_OBN]); const bf16* Z = (const bf16*)(wsb + a.off[R_Z]);
    const int gw = F.vcu * NWAVES + wave, NGW = F.G * NWAVES, e0 = 8 * (lane & 15);
    float gn[8];
#pragma unroll
    for (int j = 0; j < 8; ++j) gn[j] = GIN(a, I_GDNN)[l * HEAD_DIM_B + e0 + j];
    v4u n0 = *(const GAS v4u*)(OB + (size_t)gw * WIDTH_B + 8 * lane), n1 = *(const GAS v4u*)(Z + (size_t)gw * ZN + ZC_GB + 8 * lane);
    for (int m = gw; m < RP; m += NGW) {
        float o[8], gt[8];
        unpack8(n0, o); unpack8(n1, gt);
        { const int mn = m + NGW < RP ? m + NGW : gw; n0 = *(const GAS v4u*)(OB + (size_t)mn * WIDTH_B + 8 * lane); n1 = *(const GAS v4u*)(Z + (size_t)mn * ZN + ZC_GB + 8 * lane); }
        float ss = 0.f;
#pragma unroll
        for (int j = 0; j < 8; ++j) ss += o[j] * o[j];
        ss = sum16(ss);
        const float r = __builtin_amdgcn_rsqf(ss * (1.f / 128.f) + EPSF);
#pragma unroll
        for (int j = 0; j < 8; ++j) o[j] = o[j] * r * gn[j] * gt[j] * sigm(gt[j]);
        *(GAS v4u*)(OBN + (size_t)m * WIDTH_B + 8 * lane) = pack8(o);
    }
}
constexpr int S5_M1 = 0, S5_M2 = 131072, S5_M3 = 196608, S5_L16 = 262144, S5_TSTRIDE = 262656;
constexpr int S5_NCHK = RP / 16;
constexpr int S5_NBLK = S5_NCHK / 32;
constexpr int S5_PCH = PEND / 16;
static_assert(S5_NCHK % 32 == 0 && LPP % 16 == 0 && PADF % 16 == 0 && S5_STATE == 64 && S5_GROUPS == 32, "s5 shapes");

__device__ __forceinline__ void s5_tables(Frame& F) {
    const KArgs ap = kargs(); const auto& a = *ap; WS_OPAQUE(a);
    const int tid = otid();
    LAS float* pw = (LAS float*)(F.lds + RING_OFF);
    LAS float* bb = pw + 17 * 128;
    LAS float* Kt = bb + 64 * 32;
    for (int it = F.vcu; it < DEPTH * S5_GROUPS; it += F.G) {
        const int l = it / S5_GROUPS, g = it % S5_GROUPS; const size_t gp = ((size_t)l * S5_GROUPS + g) * S5_STATE;
        unsigned char* tb = wsb + a.off[R_S5T] + (size_t)it * S5_TSTRIDE;
        const float dt = __expf(GIN(a, I_LDT)[l * S5_GROUPS + g]);
        for (int e = tid; e < 17 * 64; e += NTHR) { const int k = e >> 6, p = e & 63; const float ar = GIN(a, I_AR)[gp + p] * dt * (float)k, ai = GIN(a, I_AI)[gp + p] * dt * (float)k;
            float sn, cs; sincosf(ai, &sn, &cs); const float er = expf(ar); pw[e * 2] = er * cs; pw[e * 2 + 1] = er * sn; }
        __syncthreads();
        for (int e = tid; e < 64 * 16; e += NTHR) { const int p = e >> 4; const float ar = GIN(a, I_AR)[gp + p], ai = GIN(a, I_AI)[gp + p];
            const float nr = pw[(64 + p) * 2] - 1.f, ni = pw[(64 + p) * 2 + 1], den = ar * ar + ai * ai, fr = (nr * ar + ni * ai) / den, fi = (ni * ar - nr * ai) / den;
            const float br = GIN(a, I_BR)[gp * 16 + e], bi = GIN(a, I_BI)[gp * 16 + e]; bb[e * 2] = fr * br - fi * bi; bb[e * 2 + 1] = fr * bi + fi * br; }
        if (tid < 128) { const int p = tid & 63; ((float*)(tb + S5_L16))[tid] = pw[(16 * 64 + p) * 2 + (tid >> 6)]; }
        __syncthreads();
        const float* cre = GIN(a, I_CR) + ((size_t)l * S5_GROUPS + g) * 16 * 64; const float* cim = GIN(a, I_CI) + ((size_t)l * S5_GROUPS + g) * 16 * 64;
        { const int j = tid & 15, i = (tid >> 4) & 15;
          f32x4 c4r[16], c4i[16];
#pragma unroll
          for (int q = 0; q < 16; ++q) { c4r[q] = *(const GAS f32x4*)(cre + i * 64 + 4 * q); c4i[q] = *(const GAS f32x4*)(cim + i * 64 + 4 * q); }
#pragma clang loop unroll(disable)
          for (int d = tid >> 8; d < 16; d += 2) { float acc = 0.f;
#pragma unroll
              for (int p = 0; p < 64; ++p) { const float cr = c4r[p >> 2][p & 3], ci = c4i[p >> 2][p & 3], pr = pw[(d * 64 + p) * 2], pi = pw[(d * 64 + p) * 2 + 1];
                  const float tr = cr * pr - ci * pi, ti = cr * pi + ci * pr; acc += tr * bb[(p * 16 + j) * 2] - ti * bb[(p * 16 + j) * 2 + 1]; }
              Kt[(d * 16 + i) * 16 + j] = acc; } }
        __syncthreads();
        bf16* M1 = (bf16*)(tb + S5_M1); bf16* M2 = (bf16*)(tb + S5_M2); bf16* M3 = (bf16*)(tb + S5_M3);
        for (int e = tid; e < 65536; e += NTHR) { const int n = e >> 8, k = e & 255, tau = n >> 4, i = n & 15, sg = k >> 4, j = k & 15;
            float v = 0.f; if (sg <= tau) { v = Kt[((tau - sg) * 16 + i) * 16 + j]; if (sg == tau && i == j) v += GIN(a, I_SD)[(l * S5_GROUPS + g) * 16 + i]; }
            M1[e] = (bf16)f2bf(v); }
        for (int e = tid; e < 32768; e += NTHR) { const int n = e >> 8, k = e & 255, ri = n >> 6, p = n & 63, sg = k >> 4, j = k & 15;
            const float pr = pw[((15 - sg) * 64 + p) * 2], pi = pw[((15 - sg) * 64 + p) * 2 + 1], br = bb[(p * 16 + j) * 2], bi = bb[(p * 16 + j) * 2 + 1];
            M2[e] = (bf16)f2bf(ri == 0 ? pr * br - pi * bi : pr * bi + pi * br); }
        for (int e = tid; e < 32768; e += NTHR) { const int n = e >> 7, k = e & 127, tau = n >> 4, i = n & 15, ri = k >> 6, p = k & 63;
            const float cr = cre[i * 64 + p], ci = cim[i * 64 + p], pr = pw[((tau + 1) * 64 + p) * 2], pi = pw[((tau + 1) * 64 + p) * 2 + 1];
            M3[e] = (bf16)f2bf(ri == 0 ? cr * pr - ci * pi : -(cr * pi + ci * pr)); }
        __syncthreads();
    }
}
__device__ __forceinline__ void p_s5_e(Frame& F, int l) {
    const KArgs ap = kargs(); const auto& a = *ap; WS_OPAQUE(a);
    const int tid = otid(), lane = tid & 63, wave = __builtin_amdgcn_readfirstlane(tid >> 6), r32 = lane & 31, hi = lane >> 5;
    const bf16* Z = (const bf16*)(wsb + a.off[R_Z]); float* E = (float*)(wsb + a.off[R_S5E]);
    for (int u = F.vcu * NWAVES + wave; u < S5_NBLK * S5_GROUPS; u += F.G * NWAVES) {
        const int blk = u / S5_GROUPS, g = u % S5_GROUPS;
        const unsigned char* tb = wsb + a.off[R_S5T] + (size_t)(l * S5_GROUPS + g) * S5_TSTRIDE;
        const GAS bf16x8* M2 = (const GAS bf16x8*)(tb + S5_M2);
        const bf16* zr = Z + (size_t)((blk * 32 + r32) * 16) * ZN + ZC_UC + g * 16 + 8 * hi;
        f32x16 acc[4];
#pragma unroll
        for (int nb = 0; nb < 4; ++nb)
#pragma unroll
            for (int r = 0; r < 16; ++r) acc[nb][r] = 0.f;
#pragma unroll 4
        for (int sg = 0; sg < 16; ++sg) { const bf16x8 af = *(const GAS bf16x8*)(zr + (size_t)sg * ZN);
#pragma unroll
            for (int nb = 0; nb < 4; ++nb) acc[nb] = __builtin_amdgcn_mfma_f32_32x32x16_bf16(af, M2[((nb * 32 + r32) * 256 + sg * 16 + 8 * hi) >> 3], acc[nb], 0, 0, 0); }
#pragma unroll
        for (int nb = 0; nb < 4; ++nb)
#pragma unroll
            for (int r = 0; r < 16; ++r) E[((size_t)(blk * 32 + crow_dev(r, hi)) * S5_GROUPS + g) * 128 + nb * 32 + r32] = acc[nb][r];
    }
}
__device__ __forceinline__ void s5_scan_task(const float* E, bf16* XP, const float* l16, int g, int c0, int nch, float xr, float xi, float* ore, float* oim, int lane) {
    const float lr = l16[lane], li = l16[64 + lane];
    int c = 0;
    for (; c + 8 <= nch; c += 8) { float er[8], ei[8];
#pragma unroll
        for (int q = 0; q < 8; ++q) { const float* e = E + ((size_t)(c0 + c + q) * S5_GROUPS + g) * 128; er[q] = e[lane]; ei[q] = e[64 + lane]; }
#pragma unroll
        for (int q = 0; q < 8; ++q) { bf16* xp = XP + ((size_t)(c0 + c + q) * S5_GROUPS + g) * 128; xp[lane] = (bf16)f2bf(xr); xp[64 + lane] = (bf16)f2bf(xi);
            const float nr = lr * xr - li * xi + er[q], ni = lr * xi + li * xr + ei[q]; xr = nr; xi = ni; } }
    for (; c < nch; ++c) { const float* e = E + ((size_t)(c0 + c) * S5_GROUPS + g) * 128; bf16* xp = XP + ((size_t)(c0 + c) * S5_GROUPS + g) * 128; xp[lane] = (bf16)f2bf(xr); xp[64 + lane] = (bf16)f2bf(xi);
        const float nr = lr * xr - li * xi + e[lane], ni = lr * xi + li * xr + e[64 + lane]; xr = nr; xi = ni; }
    ore[lane] = xr; oim[lane] = xi;
}
constexpr int S5_NTASK = (BATCH + DEC_BATCH) * S5_GROUPS;
__device__ __forceinline__ void s5_scan_run(Frame& F, int l, int t, int lane) {
    const KArgs ap = kargs(); const auto& a = *ap; WS_OPAQUE(a);
    const int sq = t / S5_GROUPS, g = t % S5_GROUPS;
    const float* E = (const float*)(wsb + a.off[R_S5E]); bf16* XP = (bf16*)(wsb + a.off[R_S5X]);
    const float* l16 = (const float*)(wsb + a.off[R_S5T] + (size_t)(l * S5_GROUPS + g) * S5_TSTRIDE + S5_L16);
    if (sq < BATCH) { const size_t oo = (((size_t)l * BATCH + sq) * S5_GROUPS + g) * S5_STATE;
        s5_scan_task(E, XP, l16, g, sq * (LPP / 16), S5_PCH, 0.f, 0.f, GOUT(a) + O_SRP + oo, GOUT(a) + O_SIP + oo, lane); }
    else { const int bs = sq - BATCH; const size_t oo = (((size_t)l * DEC_BATCH + bs) * S5_GROUPS + g) * S5_STATE;
        s5_scan_task(E, XP, l16, g, SROW0 / 16 + bs * (DEC_SEQ / 16), DEC_SEQ / 16, GIN(a, I_SRE)[oo + lane], GIN(a, I_SIM)[oo + lane], GOUT(a) + O_SRS + oo, GOUT(a) + O_SIS + oo, lane); }
}
__device__ __forceinline__ float gelu_tanh(float x) { const float z = 0.7978845608028654f * (x + 0.044715f * x * x * x); const float t = 1.f - 2.f * __builtin_amdgcn_rcpf(__expf(2.f * z) + 1.f); return 0.5f * x * (1.f + t); }
__device__ __forceinline__ void p_s5_out(Frame& F, int l) {
    const KArgs ap = kargs(); const auto& a = *ap; WS_OPAQUE(a);
    const int tid = otid(), lane = tid & 63, wave = __builtin_amdgcn_readfirstlane(tid >> 6), r32 = lane & 31, hi = lane >> 5;
    const bf16* Z = (const bf16*)(wsb + a.off[R_Z]); const bf16* XP = (const bf16*)(wsb + a.off[R_S5X]); bf16* YC = (bf16*)(wsb + a.off[R_YC]);
    constexpr int NB_TOT = S5_NBLK * S5_GROUPS * 8;
    const int gwv = F.vcu * NWAVES + wave, NGW = F.G * NWAVES;
    const int b0 = (int)((long long)gwv * NB_TOT / NGW), b1 = (int)((long long)(gwv + 1) * NB_TOT / NGW);
    for (int bb = b0; bb < b1; ++bb) {
        const int u = bb >> 3, nb = bb & 7, blk = u / S5_GROUPS, g = u % S5_GROUPS;
        const unsigned char* tb = wsb + a.off[R_S5T] + (size_t)(l * S5_GROUPS + g) * S5_TSTRIDE;
        const GAS bf16x8* M1 = (const GAS bf16x8*)(tb + S5_M1); const GAS bf16x8* M3 = (const GAS bf16x8*)(tb + S5_M3);
        const bf16* zr = Z + (size_t)((blk * 32 + r32) * 16) * ZN + ZC_UC + g * 16 + 8 * hi;
        const bf16* xr = XP + ((size_t)(blk * 32 + r32) * S5_GROUPS + g) * 128 + 8 * hi;
        f32x16 acc;
#pragma unroll
        for (int r = 0; r < 16; ++r) acc[r] = 0.f;
#pragma unroll
        for (int sg = 0; sg < 16; ++sg) acc = __builtin_amdgcn_mfma_f32_32x32x16_bf16(*(const GAS bf16x8*)(zr + (size_t)sg * ZN), M1[((nb * 32 + r32) * 256 + sg * 16 + 8 * hi) >> 3], acc, 0, 0, 0);
#pragma unroll
        for (int s = 0; s < 8; ++s) acc = __builtin_amdgcn_mfma_f32_32x32x16_bf16(*(const GAS bf16x8*)(xr + 16 * s), M3[((nb * 32 + r32) * 128 + s * 16 + 8 * hi) >> 3], acc, 0, 0, 0);
#pragma unroll
        for (int r = 0; r < 16; ++r) { const int row = (blk * 32 + crow_dev(r, hi)) * 16 + 2 * nb + (r32 >> 4);
            YC[(size_t)row * WIDTH_C + g * 16 + (r32 & 15)] = (bf16)f2bf(gelu_tanh(acc[r])); }
    }
}
__device__ __forceinline__ int rdlane_i(int v, int i) { return __builtin_amdgcn_readlane(v, i); }
constexpr float NEG_BIG = -3.0e38f;
__device__ __forceinline__ unsigned fkey(float v) { const unsigned u = __builtin_bit_cast(unsigned, v); return (u & 0x80000000u) ? ~u : (u | 0x80000000u); }
__device__ __forceinline__ int mbcnt64(unsigned long long m) { return __builtin_amdgcn_mbcnt_hi((unsigned)(m >> 32), __builtin_amdgcn_mbcnt_lo((unsigned)m, 0)); }
__device__ __forceinline__ void pro_wqs(Frame& F) {
    const KArgs ap = kargs(); const auto& a = *ap; WS_OPAQUE(a);
    const int tid = otid(), lane = tid & 63, wave = __builtin_amdgcn_readfirstlane(tid >> 6);
    bf16* WQ = (bf16*)(wsb + a.off[R_WQS]);
    LAS f32x4* skl = (LAS f32x4*)(F.lds + RING_OFF);
    typedef float f32x2w __attribute__((ext_vector_type(2)));
    for (int t = F.vcu; t < DEPTH * 64; t += F.G) {
        const int l = t >> 6, hc = (t >> 2) & 15, kh = (t >> 1) & 1, nh = t & 1, k = (kh * 8 + wave) * 64 + lane;
        __syncthreads();
        { const GAS f32x4* src = (const GAS f32x4*)(GIN(a, I_PSK) + (((size_t)l * 16 + hc) * 128 + nh * 64) * 128);
#pragma unroll
          for (int q = 0; q < 4; ++q) skl[tid + NTHR * q] = src[tid + NTHR * q]; }
        const float* wr = GIN(a, I_PWQ) + ((size_t)l * D_MODEL + k) * PQ + hc * 128;
        f32x4 w[32];
#pragma unroll
        for (int d = 0; d < 32; ++d) w[d] = *(const GAS f32x4*)(wr + 4 * d);
        const float g2k = GIN(a, I_N2)[(size_t)l * D_MODEL + k];
        bf16* o = WQ + ((size_t)l * PQ + hc * 128 + nh * 64) * D_MODEL + k;
        __syncthreads();
#pragma clang loop vectorize(disable) unroll(disable)
        for (int n = 0; n < 64; ++n) { LAS f32x4* sr = skl + n * 32; f32x2w a0 = {0.f, 0.f}, a1 = {0.f, 0.f};
#pragma unroll
            for (int d = 0; d < 32; ++d) { const f32x4 s = sr[d]; a0 += (f32x2w){w[d].x, w[d].y} * (f32x2w){s.x, s.y}; a1 += (f32x2w){w[d].z, w[d].w} * (f32x2w){s.z, s.w}; }
            o[(size_t)n * D_MODEL] = (bf16)f2bf(((a0.x + a0.y) + (a1.x + a1.y)) * g2k); }
    }
    __syncthreads();
}
__device__ __forceinline__ void pro_wrest(Frame& F) {
    const KArgs ap = kargs(); const auto& a = *ap; WS_OPAQUE(a);
    const int tid = otid(), lane = tid & 63, wave = __builtin_amdgcn_readfirstlane(tid >> 6);
    LAS float* scr = (LAS float*)(F.lds + RING_OFF + wave * 16384);
    const int gw = F.vcu * NWAVES + wave, NGW = F.G * NWAVES;
    bf16* WG = (bf16*)(wsb + a.off[R_WGLU]); bf16* WB = (bf16*)(wsb + a.off[R_WBR]); bf16* WO = (bf16*)(wsb + a.off[R_WOUT]);
    constexpr int IG = (512 / 64) * (1024 / 32), IB = IG, IO = (1024 / 64) * (1024 / 32), IL = IG + 3 * IB + IO;
    TrItem A, B;
#define WR_LOAD(T, it_) do { const int l_ = (it_) / IL; int r_ = (it_) % IL; \
        if (r_ < IG) tr_load(T, GIN(a, I_WGLU) + (size_t)l_ * 512 * 1024, 1024, 32 * (r_ % 32), 64 * (r_ / 32), CmGlu(), lane); \
        else if (r_ < IG + 3 * IB) { const int w_ = (r_ - IG) / IB, q_ = (r_ - IG) % IB; tr_load(T, GIN(a, I_WBA + w_) + (size_t)l_ * 512 * 1024, 1024, 32 * (q_ % 32), 64 * (q_ / 32), CmId(), lane); } \
        else { r_ -= IG + 3 * IB; tr_load(T, GIN(a, I_WOUT) + (size_t)l_ * 1024 * 1024, 1024, 32 * (r_ % 32), 64 * (r_ / 32), CmId(), lane); } } while (0)
    if (gw < DEPTH * IL) WR_LOAD(A, gw);
    for (int it = gw; it < DEPTH * IL; it += NGW) { const int l = it / IL; int r = it % IL;
        if (it + NGW < DEPTH * IL) WR_LOAD(B, it + NGW);
        if (r < IG) tr_store(A, 512, WG + (size_t)l * 1024 * 512, 32 * (r % 32), 64 * (r / 32), scr, lane);
        else if (r < IG + 3 * IB) { const int w = (r - IG) / IB, q = (r - IG) % IB; tr_store(A, 512, WB + ((size_t)l * 3 + w) * 1024 * 512, 32 * (q % 32), 64 * (q / 32), scr, lane); }
        else { r -= IG + 3 * IB; tr_store(A, 1024, WO + (size_t)l * 1024 * 1024, 32 * (r % 32), 64 * (r / 32), scr, lane); }
        A = B; }
#undef WR_LOAD
}
typedef float f32x2v __attribute__((ext_vector_type(2)));
__device__ __forceinline__ unsigned pk_i8(const f32x4 x, float inv) {
    const int a = (int)rintf(x.x * inv), b = (int)rintf(x.y * inv), c = (int)rintf(x.z * inv), d = (int)rintf(x.w * inv);
    return (unsigned)(a & 0xff) | ((unsigned)(b & 0xff) << 8) | ((unsigned)(c & 0xff) << 16) | ((unsigned)(d & 0xff) << 24); }
constexpr size_t PEER_ROWS = (size_t)DEPTH * N_EXPERTS; constexpr int PU_ROWB = 512;
typedef unsigned v3u __attribute__((ext_vector_type(3)));
typedef unsigned v3u_a4 __attribute__((ext_vector_type(3), aligned(4)));
__device__ __forceinline__ float absmax16(const f32x4 x0, const f32x4 x1, const f32x4 x2, const f32x4 x3) {
    float mx = fmaxf(fmaxf(fmaxf(fabsf(x0.x), fabsf(x0.y)), fmaxf(fabsf(x0.z), fabsf(x0.w))), fmaxf(fmaxf(fabsf(x1.x), fabsf(x1.y)), fmaxf(fabsf(x1.z), fabsf(x1.w))));
    return fmaxf(mx, fmaxf(fmaxf(fmaxf(fabsf(x2.x), fabsf(x2.y)), fmaxf(fabsf(x2.z), fabsf(x2.w))), fmaxf(fmaxf(fabsf(x3.x), fabsf(x3.y)), fmaxf(fabsf(x3.z), fabsf(x3.w)))));
}
__device__ __forceinline__ unsigned pk_fp8(const f32x4 x, float inv) { int t = __builtin_amdgcn_cvt_pk_fp8_f32(x.x * inv, x.y * inv, 0, false); t = __builtin_amdgcn_cvt_pk_fp8_f32(x.z * inv, x.w * inv, t, true); return (unsigned)t; }
constexpr int PW_RB = 8, PW_IR = NWAVES * PW_RB, PW_ITEMS_L = 2 * (N_EXPERTS / PW_IR), PW_ITEMS = DEPTH * PW_ITEMS_L, CW_PWQ = CW_QUEUE + 64 * 24;
__device__ __forceinline__ void peerw_item(Frame& F, int it) {
    const KArgs ap = kargs(); const auto& a = *ap; WS_OPAQUE(a);
    const int tid = otid(), lane = tid & 63, wave = __builtin_amdgcn_readfirstlane(tid >> 6);
    float* SCL = (float*)(wsb + a.off[R_MISC]);
    constexpr int RB = PW_RB;
    const int l = it / PW_ITEMS_L, r_ = it % PW_ITEMS_L, w = r_ / (N_EXPERTS / PW_IR), blk = r_ % (N_EXPERTS / PW_IR);
    const size_t row0 = (size_t)l * N_EXPERTS + blk * PW_IR + wave * RB, rw0 = row0 + (w ? PEER_ROWS : 0);
    f32x4 x[RB][4];
#pragma unroll
    for (int r = 0; r < RB; ++r) { const GAS f32x4* src = (const GAS f32x4*)(GIN(a, I_PU + w) + (row0 + r) * D_MODEL) + 4 * lane;
#pragma unroll
        for (int j = 0; j < 4; ++j) x[r][j] = src[j]; }
#pragma unroll
    for (int r = 0; r < RB; ++r) { const float mx = wave_max(absmax16(x[r][0], x[r][1], x[r][2], x[r][3])); v4u o;
        if (w == 0) { float s2_ = 0.f;
#pragma unroll
            for (int j = 0; j < 4; ++j) s2_ += (x[r][j].x * x[r][j].x + x[r][j].y * x[r][j].y) + (x[r][j].z * x[r][j].z + x[r][j].w * x[r][j].w);
            const float clip = fminf(mx, 2.6f * __builtin_sqrtf(wave_sum(s2_) * (1.f / D_MODEL)));
            const float inv = clip > 0.f ? 7.f / clip : 0.f;
            v2u o2;
#pragma unroll
            for (int d = 0; d < 2; ++d) { const f32x4 xa = x[r][2 * d], xb = x[r][2 * d + 1];
#define PW_Q4(v_) ((unsigned)((int)fminf(fmaxf(rintf((v_) * inv), -7.f), 7.f) + 8))
                const unsigned w_ = PW_Q4(xa.x) | (PW_Q4(xa.y) << 4) | (PW_Q4(xa.z) << 8) | (PW_Q4(xa.w) << 12) | (PW_Q4(xb.x) << 16) | (PW_Q4(xb.y) << 20) | (PW_Q4(xb.z) << 24) | (PW_Q4(xb.w) << 28);
#undef PW_Q4
                if (d == 0) o2.x = w_; else o2.y = w_; }
            if (lane == 0) SCL[rw0 + r] = clip * (1.f / 7.f);
            *((GAS v2u*)(wsb + a.off[R_PU] + (row0 + r) * PU_ROWB) + lane) = o2; }
        else { const float inv = mx > 0.f ? 416.f / mx : 0.f; o.x = pk_fp8(x[r][0], inv); o.y = pk_fp8(x[r][1], inv); o.z = pk_fp8(x[r][2], inv); o.w = pk_fp8(x[r][3], inv);
            if (lane == 0) SCL[rw0 + r] = mx * (1.f / 416.f);
            *((GAS v4u*)(wsb + a.off[R_PV] + (row0 + r) * D_MODEL) + lane) = o; } }
}
__device__ __forceinline__ void peerw_drain(Frame& F, int limit) {
    const KArgs ap = kargs(); const auto& a = *ap; WS_OPAQUE(a);
    const bool lead = F.wv == 0 && lane_id() == 0;
    for (;;) {
        if (lead) { const unsigned kept = F.MISC[23]; F.MISC[23] = 0u; F.MISC[24] = kept ? 1u : 0u;
            F.MISC[21] = kept ? kept - 1u : (F.MISC[22] ? (unsigned)PW_ITEMS : __hip_atomic_fetch_add((gu32*)wsb + CW_PWQ, 1u, RLX_AGENT)); }
        __syncthreads();
        const int it = (int)F.MISC[21]; const bool kept = F.MISC[24] != 0u;
        __syncthreads();
        if (it >= PW_ITEMS) { if (lead) F.MISC[22] = 1u; break; }
        peerw_item(F, it);
        if (!kept && it >= limit) break;
    }
}
__device__ __forceinline__ void xcd_barrier_steal(const XcdBarrier& b, Frame& F) {
    const KArgs ap = kargs(); const auto& a = *ap; WS_OPAQUE(a);
    asm volatile("s_waitcnt vmcnt(0)" ::: "memory");
    __syncthreads();
    const bool lead = b.wv == 0 && lane_id() == 0;
    unsigned gen = 0u;
    if (lead) {
        unsigned* bar = b.bar;
        __builtin_amdgcn_s_waitcnt(0);
        unsigned nloc = b.st[0], nx = b.st[1];
        if (nloc == 0u) { xcd_barrier_complete(bar, b.x, nloc, nx); b.st[0] = nloc; b.st[1] = nx; }
        const unsigned old = xb_add(&bar[XB_XSUB(b.x)], 1u);
        gen = old / nloc;
        if (old + 1u == (gen + 1u) * nloc) {
            __builtin_amdgcn_fence(__ATOMIC_RELEASE, "agent");
            asm volatile("s_waitcnt vmcnt(0)" ::: "memory");
            const unsigned og = xb_add(&bar[XB_TOP], 1u);
            const unsigned tg = og / nx;
            if (og + 1u == (tg + 1u) * nx) xb_add(&bar[XB_TOPGEN], 1u);
            else XB_SPIN(xb_ld(&bar[XB_TOPGEN]) == tg, bar);
            __builtin_amdgcn_fence(__ATOMIC_ACQUIRE, "agent");
            xb_add(&bar[XB_XGEN(b.x)], 1u);
            asm volatile("s_waitcnt vmcnt(0)" ::: "memory");
            F.MISC[20] = 1u;
        } else F.MISC[20] = 0u;
    }
    unsigned sp = 0u;
    for (;;) {
        if (lead && F.MISC[20] == 0u) {
            unsigned* bar = b.bar;
            bool rel = xb_ld(&bar[XB_XGEN(b.x)]) != gen;
            if (!rel && F.MISC[22] && !F.MISC[23]) {
                XB_SPIN(xb_ld(&bar[XB_XGEN(b.x)]) == gen, bar); rel = true; }
            if (!rel && (++sp & 1023u) == 0u && xb_ld(&bar[XB_TMO])) rel = true;
            if (rel) { __builtin_amdgcn_fence(__ATOMIC_ACQUIRE, "agent"); asm volatile("s_waitcnt vmcnt(0)" ::: "memory"); F.MISC[20] = 1u; }
            else { const unsigned kept = F.MISC[23]; F.MISC[23] = 0u;
                const unsigned it = kept ? kept - 1u : __hip_atomic_fetch_add((gu32*)wsb + CW_PWQ, 1u, RLX_AGENT); F.MISC[21] = it; if (it >= (unsigned)PW_ITEMS) F.MISC[22] = 1u; }
        }
        __syncthreads();
        const unsigned done = F.MISC[20], it = F.MISC[21];
        __syncthreads();
        if (done) break;
        if (it < (unsigned)PW_ITEMS) {
            const bool ahead = lead && !F.MISC[22]; unsigned nxi = 0u;
            if (ahead) nxi = __hip_atomic_fetch_add((gu32*)wsb + CW_PWQ, 1u, RLX_AGENT);
            peerw_item(F, (int)it);
            if (ahead) { if (nxi < (unsigned)PW_ITEMS) F.MISC[23] = nxi + 1u; else F.MISC[22] = 1u; }
        }
    }
}
__device__ __forceinline__ void pro_peerw(Frame& F) { for (int it = F.vcu; it < PW_ITEMS; it += F.G) peerw_item(F, it); }
__device__ __forceinline__ void fp8x16_to_f32(const v4u q, float (&f)[16]) {
#pragma unroll
    for (int d = 0; d < 4; ++d) { const int w = (int)(d == 0 ? q.x : d == 1 ? q.y : d == 2 ? q.z : q.w);
        const f32x2v lo = __builtin_amdgcn_cvt_pk_f32_fp8(w, false), hi = __builtin_amdgcn_cvt_pk_f32_fp8(w, true); f[4 * d] = lo.x; f[4 * d + 1] = lo.y; f[4 * d + 2] = hi.x; f[4 * d + 3] = hi.y; }
}
#define PK_BIS(NDPP) do { if (!kdone) { const unsigned t_ = kp | (1u << kbit); int c_ = 0; _Pragma("unroll") for (int c4 = 0; c4 < 8; ++c4) { const v4u k4 = keys[c4 * 64 + lane]; \
            c_ += (k4.x >= t_ ? 1 : 0) + (k4.y >= t_ ? 1 : 0); c_ += (k4.z >= t_ ? 1 : 0) + (k4.w >= t_ ? 1 : 0); } \
        c_ += dpp_i<0xB1>(c_); c_ += dpp_i<0x4E>(c_); if (NDPP == 3) c_ += dpp_i<0x141>(c_); const bool up_ = c_ >= 16; kp = up_ ? t_ : kp; kcp = up_ ? c_ : kcp; --kbit; \
        kdone = __ballot(kcp != 16) == 0ull; } } while (0)
__device__ __forceinline__ void p_peer(Frame& F, int l, bool dry) {
    const KArgs ap = kargs(); const auto& a = *ap; WS_OPAQUE(a);
    const int tid = otid(), lane = tid & 63, wave = __builtin_amdgcn_readfirstlane(tid >> 6);
    const float* SC = (const float*)(wsb + a.off[R_SC]); float* X = (float*)(wsb + a.off[R_X]);
    const unsigned char* PU = wsb + a.off[R_PU] + (size_t)l * N_EXPERTS * PU_ROWB; const unsigned char* PV = wsb + a.off[R_PV] + (size_t)l * N_EXPERTS * D_MODEL;
    const float* SCU = (const float*)(wsb + a.off[R_MISC]) + (size_t)l * N_EXPERTS; const float* SCV = SCU + PEER_ROWS;
    LAS float* stop = (LAS float*)(F.lds + RING_OFF + wave * 4096);
    LAS int* itop = (LAS int*)(stop + 256);
    LAS int* elb = itop + 256;
    LAS float* cfb = (LAS float*)(elb + 256);
    gu32* rq = (gu32*)wsb + CW_QUEUE + 64 * (8 + l + (dry ? DEPTH : 0));
    LAS v4u* keys = (LAS v4u*)(F.lds + RING_OFF + 32768 + wave * 8192);
    unsigned kp = 0u; int kbit = 31, kcp = 1 << 20; bool kdone = false; float rsn = 0.f, hscn = 0.f; v4u hqn = {0u, 0u, 0u, 0u};
#define PK_BEGIN(m_) do {   \
        float hx_[16]; { const GAS f32x4* xr0 = (const GAS f32x4*)(X + (size_t)(m_) * D_MODEL + 16 * lane); const GAS f32x4* g4 = (const GAS f32x4*)(GIN(a, I_N2) + (size_t)l * D_MODEL + 16 * lane); float s2 = 0.f; \
          _Pragma("unroll") for (int j = 0; j < 4; ++j) { const f32x4 xv = xr0[j], gv = g4[j]; s2 += (xv.x * xv.x + xv.y * xv.y) + (xv.z * xv.z + xv.w * xv.w); hx_[4 * j] = xv.x * gv.x; hx_[4 * j + 1] = xv.y * gv.y; hx_[4 * j + 2] = xv.z * gv.z; hx_[4 * j + 3] = xv.w * gv.w; } \
          rsn = __builtin_amdgcn_rsqf(wave_sum(s2) * (1.f / D_MODEL) + EPSF); } \
        float hmx = 0.f; _Pragma("unroll") for (int j = 0; j < 16; ++j) { hx_[j] *= rsn; hmx = fmaxf(hmx, fabsf(hx_[j])); } \
        hmx = wave_max(hmx); const float hinv = hmx > 0.f ? 127.f / hmx : 0.f; hscn = hmx * (1.f / 127.f); \
        hqn.x = pk_i8((f32x4){hx_[0], hx_[2], hx_[4], hx_[6]}, hinv); hqn.y = pk_i8((f32x4){hx_[1], hx_[3], hx_[5], hx_[7]}, hinv); hqn.z = pk_i8((f32x4){hx_[8], hx_[10], hx_[12], hx_[14]}, hinv); hqn.w = pk_i8((f32x4){hx_[9], hx_[11], hx_[13], hx_[15]}, hinv);     \
        { const GAS f32x4* p4 = (const GAS f32x4*)(SC + (size_t)(m_) * PQ + (lane >> 2) * 128 + (lane & 3) * 32); \
          _Pragma("unroll") for (int j = 0; j < 8; ++j) { const f32x4 v = p4[j]; keys[j * 64 + lane] = (v4u){fkey(v.x), fkey(v.y), fkey(v.z), fkey(v.w)}; } } \
        kp = 0u; kbit = 31; kcp = 1 << 20; kdone = false; } while (0)
#define PK_MID() do {   \
        { int cl = 0; _Pragma("unroll") for (int c4 = 0; c4 < 8; ++c4) { const v4u k4 = keys[c4 * 64 + lane]; cl += (k4.x >= kp ? 1 : 0) + (k4.y >= kp ? 1 : 0) + (k4.z >= kp ? 1 : 0) + (k4.w >= kp ? 1 : 0); } \
          const int q_ = lane & 3, c0 = dpp_i<0x00>(cl), c1 = dpp_i<0x55>(cl), c2 = dpp_i<0xAA>(cl); int pos = (q_ > 0 ? c0 : 0) + (q_ > 1 ? c1 : 0) + (q_ > 2 ? c2 : 0); const int sb = (lane >> 2) * 16; \
          _Pragma("unroll") for (int c4 = 0; c4 < 8; ++c4) { const v4u k4 = keys[c4 * 64 + lane]; _Pragma("unroll") for (int e = 0; e < 4; ++e) { const unsigned kj = k4[e]; const bool sel = kj >= kp; \
              if (sel && pos < 16) { const unsigned u_ = (kj & 0x80000000u) ? (kj ^ 0x80000000u) : ~kj; stop[sb + pos] = __builtin_bit_cast(float, u_); itop[sb + pos] = q_ * 32 + 4 * c4 + e; } \
              pos += sel ? 1 : 0; } } } \
        LDS_WAIT(); \
        { const int h_ = lane >> 3, sub = lane & 7; const float s1a = stop[(2 * h_) * 16 + 2 * sub], s1b = stop[(2 * h_) * 16 + 2 * sub + 1]; \
          _Pragma("unroll") for (int c4 = 0; c4 < 4; ++c4) { const f32x4 s2_ = *(LAS f32x4*)(stop + (2 * h_ + 1) * 16 + 4 * c4); \
              keys[c4 * 64 + lane] = (v4u){fkey(s1a + s2_.x), fkey(s1a + s2_.y), fkey(s1a + s2_.z), fkey(s1a + s2_.w)}; keys[(4 + c4) * 64 + lane] = (v4u){fkey(s1b + s2_.x), fkey(s1b + s2_.y), fkey(s1b + s2_.z), fkey(s1b + s2_.w)}; } } \
        kp = 0u; kbit = 31; kcp = 1 << 20; kdone = false; } while (0)
#define PK_END(nb_) do {   \
        LAS int* el_ = elb + 128 * (nb_); LAS float* cf_ = cfb + 128 * (nb_); const int h_ = lane >> 3, sub = lane & 7; \
        int cl = 0; _Pragma("unroll") for (int c4 = 0; c4 < 8; ++c4) { const v4u k4 = keys[c4 * 64 + lane]; cl += (k4.x >= kp ? 1 : 0) + (k4.y >= kp ? 1 : 0) + (k4.z >= kp ? 1 : 0) + (k4.w >= kp ? 1 : 0); } \
        int x_ = cl; { int t_ = dpp_i<0x111>(x_); x_ += sub >= 1 ? t_ : 0; t_ = dpp_i<0x112>(x_); x_ += sub >= 2 ? t_ : 0; t_ = dpp_i<0x114>(x_); x_ += sub >= 4 ? t_ : 0; } \
        int pos = x_ - cl; \
        const float s1a = stop[(2 * h_) * 16 + 2 * sub], s1b = stop[(2 * h_) * 16 + 2 * sub + 1]; float s2_[16]; float cmax = NEG_BIG; \
        _Pragma("unroll") for (int j = 0; j < 16; ++j) { s2_[j] = stop[(2 * h_ + 1) * 16 + j]; cmax = fmaxf(cmax, s2_[j]); } \
        cmax += fmaxf(s1a, s1b); cmax = fmaxf(cmax, dpp_f<0xB1>(cmax)); cmax = fmaxf(cmax, dpp_f<0x4E>(cmax)); cmax = fmaxf(cmax, dpp_f<0x141>(cmax)); \
        const int i1a = itop[(2 * h_) * 16 + 2 * sub] * N_KEYS, i1b = itop[(2 * h_) * 16 + 2 * sub + 1] * N_KEYS; float esum = 0.f; \
        _Pragma("unroll") for (int c4 = 0; c4 < 8; ++c4) { const v4u k4 = keys[c4 * 64 + lane]; _Pragma("unroll") for (int e = 0; e < 4; ++e) { const int j = 4 * c4 + e; const bool sel = k4[e] >= kp; \
            if (sel && pos < 16) { const float ex = __expf(rsn * ((j < 16 ? s1a : s1b) + s2_[j & 15] - cmax)); esum += ex; \
                el_[h_ * 16 + pos] = (j < 16 ? i1a : i1b) + itop[(2 * h_ + 1) * 16 + (j & 15)]; cf_[h_ * 16 + pos] = ex; } \
            pos += sel ? 1 : 0; } } \
        esum = sum8(esum); const float inv_ = __builtin_amdgcn_rcpf(esum); \
        LDS_WAIT(); cf_[2 * lane] *= inv_; cf_[2 * lane + 1] *= inv_; LDS_WAIT(); } while (0)
    int cur = __builtin_amdgcn_readfirstlane(lane == 0 ? (int)__hip_atomic_fetch_add(rq, 1u, RLX_AGENT) : 0);
    if (cur >= NT) return;
    int nxt = __builtin_amdgcn_readfirstlane(lane == 0 ? (int)__hip_atomic_fetch_add(rq, 1u, RLX_AGENT) : 0);
    int buf = 0;
    PK_BEGIN(nat2prow(cur));
#pragma clang loop unroll(disable)
    for (int s = 0; s < 32; ++s) PK_BIS(2);
    PK_MID();
#pragma clang loop unroll(disable)
    for (int s = 0; s < 32; ++s) PK_BIS(3);
    PK_END(0);
    const bool lb0 = (lane & 1) != 0, lb1 = (lane & 2) != 0;
    for (;;) {
        const int m = nat2prow(cur); const bool has_next = nxt < NT;
        const v4u hq = hqn; const float hsc = hscn;
        LAS int* elist = elb + 128 * buf; LAS float* cf = cfb + 128 * buf;
        float out[16];
#pragma unroll
        for (int j = 0; j < 16; ++j) out[j] = 0.f;
        const int hs8 = -8 * __builtin_amdgcn_sdot4((int)hq.w, 0x01010101, __builtin_amdgcn_sdot4((int)hq.z, 0x01010101, __builtin_amdgcn_sdot4((int)hq.y, 0x01010101, __builtin_amdgcn_sdot4((int)hq.x, 0x01010101, 0, false), false), false), false);
        v2u uA[4], uB[4]; v4u vA[4], vB[4]; float suA, svA, cA, suB, svB, cB;
#define PEER_LOAD(U, V, SU, SV, CW, q0) do { { const int em_ = elist[(q0) + (lane & 3)]; CW = cf[(q0) + (lane & 3)]; SU = SCU[em_]; SV = SCV[em_]; } _Pragma("unroll") for (int i = 0; i < 4; ++i) { const int e_ = elist[(q0) + i]; \
            U[i] = *((const GAS v2u*)(PU + (size_t)e_ * PU_ROWB) + lane); V[i] = *((const GAS v4u*)(PV + (size_t)e_ * D_MODEL) + lane); } } while (0)
#define PEER_COMP(U, V, SU, SV, CW) do { float d_[4]; _Pragma("unroll") for (int i = 0; i < 4; ++i) { \
            int di_ = __builtin_amdgcn_sdot4((int)(U[i].x & 0x0f0f0f0fu), (int)hq.x, hs8, false); di_ = __builtin_amdgcn_sdot4((int)((U[i].x >> 4) & 0x0f0f0f0fu), (int)hq.y, di_, false); \
            di_ = __builtin_amdgcn_sdot4((int)(U[i].y & 0x0f0f0f0fu), (int)hq.z, di_, false); di_ = __builtin_amdgcn_sdot4((int)((U[i].y >> 4) & 0x0f0f0f0fu), (int)hq.w, di_, false); d_[i] = (float)di_; } \
              \
            const float r0_ = (lb0 ? d_[1] : d_[0]) + dpp_f<0xB1>(lb0 ? d_[0] : d_[1]), r1_ = (lb0 ? d_[3] : d_[2]) + dpp_f<0xB1>(lb0 ? d_[2] : d_[3]); \
            float dsel_ = (lb1 ? r1_ : r0_) + dpp_f<0x4E>(lb1 ? r0_ : r1_); \
            dsel_ += dpp_f<0x124>(dsel_); dsel_ += dpp_f<0x128>(dsel_);                                        \
            dsel_ += swap16(dsel_); dsel_ += swap32(dsel_);                                                       \
            const float ccv_ = CW * gelu_tanh(dsel_ * hsc * SU) * SV; \
            _Pragma("unroll") for (int i = 0; i < 4; ++i) { const float cc = rdlane(ccv_, 60 + i); float t[16]; fp8x16_to_f32(V[i], t); _Pragma("unroll") for (int j = 0; j < 16; ++j) out[j] += cc * t[j]; } } while (0)
        PEER_LOAD(uA, vA, suA, svA, cA, 0);
        if (has_next) PK_BEGIN(nat2prow(nxt)); else kdone = true;
#pragma clang loop unroll(disable)
        for (int q = 0; q < 64; q += 8) {
            PEER_LOAD(uB, vB, suB, svB, cB, q + 4);
            PK_BIS(2); PK_BIS(2);
            PEER_COMP(uA, vA, suA, svA, cA);
            PEER_LOAD(uA, vA, suA, svA, cA, q + 8);
            PK_BIS(2); PK_BIS(2);
            PEER_COMP(uB, vB, suB, svB, cB);
        }
        if (has_next) PK_MID();
#pragma clang loop unroll(disable)
        for (int q = 64; q < 128; q += 8) {
            PEER_LOAD(uB, vB, suB, svB, cB, q + 4);
            PK_BIS(3); PK_BIS(3);
            PEER_COMP(uA, vA, suA, svA, cA);
            if (q + 8 < 128) PEER_LOAD(uA, vA, suA, svA, cA, q + 8);
            PK_BIS(3); PK_BIS(3);
            PEER_COMP(uB, vB, suB, svB, cB);
        }
        if (has_next) PK_END(buf ^ 1);
#undef PEER_LOAD
#undef PEER_COMP
        if (!dry) { GAS f32x4* xr = (GAS f32x4*)(X + (size_t)m * D_MODEL + 16 * lane);
          f32x4 xv[4]; float s2 = 0.f;
#pragma unroll
          for (int j = 0; j < 4; ++j) { xv[j] = xr[j] + (f32x4){out[4 * j], out[4 * j + 1], out[4 * j + 2], out[4 * j + 3]}; s2 += (xv[j].x * xv[j].x + xv[j].y * xv[j].y) + (xv[j].z * xv[j].z + xv[j].w * xv[j].w); }
          const float rn = __builtin_amdgcn_rsqf(wave_sum(s2) * (1.f / D_MODEL) + EPSF);
          if (l + 1 < DEPTH) {
#pragma unroll
              for (int j = 0; j < 4; ++j) xr[j] = xv[j];
              const GAS f32x4* gr = (const GAS f32x4*)(GIN(a, I_N1) + (size_t)(l + 1) * D_MODEL + 16 * lane); float o16[16];
#pragma unroll
              for (int j = 0; j < 4; ++j) { const f32x4 gg = gr[j]; o16[4 * j] = xv[j].x * rn * gg.x; o16[4 * j + 1] = xv[j].y * rn * gg.y; o16[4 * j + 2] = xv[j].z * rn * gg.z; o16[4 * j + 3] = xv[j].w * rn * gg.w; }
              v4u w0, w1; w0.x = pk2(o16[0], o16[1]); w0.y = pk2(o16[2], o16[3]); w0.z = pk2(o16[4], o16[5]); w0.w = pk2(o16[6], o16[7]); w1.x = pk2(o16[8], o16[9]); w1.y = pk2(o16[10], o16[11]); w1.z = pk2(o16[12], o16[13]); w1.w = pk2(o16[14], o16[15]);
              GAS v4u* xo = (GAS v4u*)((bf16*)(wsb + a.off[R_XN]) + (size_t)m * D_MODEL + 16 * lane); xo[0] = w0; xo[1] = w1;
          } else {
              float* dst = nullptr;
              if (m >= SROW0) dst = GOUT(a) + O_YS + (size_t)(m - SROW0) * D_MODEL; else { const int b_ = m / LPP, p_ = m % LPP; if (p_ >= PADF + N_META) dst = GOUT(a) + O_YP + ((size_t)b_ * SEQ + (p_ - PADF - N_META)) * D_MODEL; }
              if (dst) { const GAS f32x4* gr = (const GAS f32x4*)(GIN(a, I_FN) + 16 * lane); GAS f32x4* o = (GAS f32x4*)(dst + 16 * lane);
#pragma unroll
                  for (int j = 0; j < 4; ++j) { const f32x4 gg = gr[j]; o[j] = (f32x4){xv[j].x * rn * gg.x, xv[j].y * rn * gg.y, xv[j].z * rn * gg.z, xv[j].w * rn * gg.w}; } }
          } }
        if (!has_next) break;
        cur = nxt; buf ^= 1;
        nxt = __builtin_amdgcn_readfirstlane(lane == 0 ? (int)__hip_atomic_fetch_add(rq, 1u, RLX_AGENT) : 0);
    }
#undef PK_BEGIN
#undef PK_MID
#undef PK_END
}
#undef PK_BIS
__device__ __forceinline__ void p_final(Frame& F) {
    const KArgs ap = kargs(); const auto& a = *ap; WS_OPAQUE(a);
    const int tid = otid(), lane = tid & 63, wave = __builtin_amdgcn_readfirstlane(tid >> 6);
    const float* X = (const float*)(wsb + a.off[R_X]); const float* g = GIN(a, I_FN);
    for (int m = F.vcu * NWAVES + wave; m < RP; m += F.G * NWAVES) {
        float* dst;
        if (m >= SROW0) dst = GOUT(a) + O_YS + (size_t)(m - SROW0) * D_MODEL;
        else { const int b = m / LPP, p = m % LPP; if (p < PADF + N_META || p >= PEND) continue; dst = GOUT(a) + O_YP + ((size_t)b * SEQ + (p - PADF - N_META)) * D_MODEL; }
        const GAS f32x4* xr = (const GAS f32x4*)(X + (size_t)m * D_MODEL) + lane;
        f32x4 v[4]; float s2 = 0.f;
#pragma unroll
        for (int j = 0; j < 4; ++j) { v[j] = xr[64 * j]; s2 += (v[j].x * v[j].x + v[j].y * v[j].y) + (v[j].z * v[j].z + v[j].w * v[j].w); }
        const float r = __builtin_amdgcn_rsqf(wave_sum(s2) * (1.f / D_MODEL) + EPSF);
        const GAS f32x4* gr = (const GAS f32x4*)g + lane; GAS f32x4* o = (GAS f32x4*)dst + lane;
#pragma unroll
        for (int j = 0; j < 4; ++j) { const f32x4 gg = gr[64 * j]; o[64 * j] = (f32x4){v[j].x * r * gg.x, v[j].y * r * gg.y, v[j].z * r * gg.z, v[j].w * r * gg.w}; }
    }
}

__device__ __forceinline__ void p_prologue(Frame& F, int pmsel = -1) {
    if (pmsel & PM_NORM0) p_norm0(F);
    const KArgs ap = kargs(); const auto& a = *ap; WS_OPAQUE(a);
    const int tid = otid(), lane = tid & 63, wave = __builtin_amdgcn_readfirstlane(tid >> 6);
    LAS float* scr = (LAS float*)(F.lds + RING_OFF + wave * 16384);
    const int gw = F.vcu * NWAVES + wave, NGW = F.G * NWAVES;
    if (a.pro_mask & pmsel & PM_X) {
        float* X = (float*)(wsb + a.off[R_X]);
        for (int m = gw; m < RP; m += NGW) {
            const float* src = nullptr;
            if (m >= SROW0) src = GIN(a, I_XS) + (size_t)(m - SROW0) * D_MODEL;
            else { const int b = m / LPP, p = m % LPP; if (p >= PADF && p < PEND) { const int pos = p - PADF; src = pos < N_META ? GIN(a, I_META) + (size_t)pos * D_MODEL : GIN(a, I_XP) + ((size_t)b * SEQ + pos - N_META) * D_MODEL; } }
            GAS f32x4* o = (GAS f32x4*)(X + (size_t)m * D_MODEL) + lane;
#pragma unroll
            for (int j = 0; j < 4; ++j) o[64 * j] = src ? ((const GAS f32x4*)src)[lane + 64 * j] : (f32x4){0.f, 0.f, 0.f, 0.f};
        }
    }
    if (a.pro_mask & pmsel & PM_WIN) {
        bf16* WT = (bf16*)(wsb + a.off[R_WIN]);
        constexpr int IPL = (D_MODEL / 64) * (ZN / 32);
        TrItem A, B;
#define WIN_LOAD(T, it_) do { const int l_ = (it_) / IPL, r_ = (it_) % IPL; tr_load(T, GIN(a, I_WIN) + (size_t)l_ * D_MODEL * D_IN, D_IN, 32 * (r_ % (ZN / 32)), 64 * (r_ / (ZN / 32)), CmWin(), lane); } while (0)
        if (gw < DEPTH * IPL) WIN_LOAD(A, gw);
        for (int it = gw; it < DEPTH * IPL; it += NGW) { const int l = it / IPL, r = it % IPL, kb = r / (ZN / 32), nb = r % (ZN / 32);
            if (it + NGW < DEPTH * IPL) WIN_LOAD(B, it + NGW);
            tr_store(A, D_MODEL, WT + (size_t)l * ZN * D_MODEL, 32 * nb, 64 * kb, scr, lane); A = B; }
#undef WIN_LOAD
    }
    __syncthreads();
    if (a.pro_mask & pmsel & PM_TABLES) s5_tables(F);
    __syncthreads();
    if (a.pro_mask & pmsel & PM_WREST) pro_wrest(F);
    if (a.pro_mask & pmsel & PM_WQS) pro_wqs(F);
    if (a.pro_mask & pmsel & PM_PEERW) pro_peerw(F);
}

__global__ void __launch_bounds__(NTHR, 2) mk_fwd(Args args) {
    extern __shared__ __attribute__((aligned(16))) unsigned char lds[];
    Frame F;
    F.lds = (LAS unsigned char*)lds; F.MISC = (volatile LAS unsigned*)(F.lds + MISC_OFF);
    F.wv = __builtin_amdgcn_readfirstlane((int)threadIdx.x >> 6);
    F.G = gridDim.x; { const int bx = blockIdx.x; F.vcu = (F.G % 8 == 0) ? (bx % 8) * (F.G / 8) + bx / 8 : bx; }
    F.ctl = (gu32*)args.ws;
    for (int u = F.wv * 64 + lane_id(); u < (LDS_BYTES - LDSCTL_OFF) / 4; u += NTHR) ((LAS unsigned*)(F.lds + LDSCTL_OFF))[u] = 0u;
    __syncthreads();
    const int lo = args.ph_lo, hi = args.ph_hi;
    unsigned* barw = (unsigned*)(F.ctl + CW_BAR) + (size_t)args.bar_region * XCD_BAR_WORDS;
    XcdBarrier bar; bar.bar = barw; bar.x = 0; bar.st = nullptr; bar.wv = F.wv;
    if (hi - lo > 1) bar = xcd_barrier_post(barw, F.MISC + 8, F.wv);
#define IN(k) (lo <= (k) && (k) < hi)
#ifndef MK_REP
#define MK_REP -1
#endif
#ifdef MK_NOSTEAL
#define STEALBAR(b, F) xcd_barrier(b)
#else
#define STEALBAR(b, F) xcd_barrier_steal(b, F)
#endif
#ifdef MK_TBAR
    unsigned long long tbar_ = 0ull;
#define SEAM(k) do { if ((k) + 1 < hi) { const unsigned long long t0_ = __builtin_amdgcn_s_memrealtime(); xcd_barrier(bar); const unsigned long long t1_ = __builtin_amdgcn_s_memrealtime(); if ((MK_TBAR_SEL) < 0 || ((k) - 1) % NPL == (MK_TBAR_SEL)) tbar_ += t1_ - t0_; } } while (0)
#else
#define SEAM(k) do { if ((k) + 1 < hi) { STEALBAR(bar, F); if ((MK_REP) == 300) xcd_barrier(bar); } } while (0)
#endif
#ifndef MK_REP
#define MK_REP -1
#endif
#ifndef MK_PMASK
#define MK_PMASK -1
#endif
    if (IN(PH_PRO)) { for (int rep_ = 0; rep_ < ((MK_REP) == 200 ? 2 : 1); ++rep_) { p_prologue(F, rep_ == 0 ? -1 : (MK_PMASK)); __syncthreads(); } SEAM(PH_PRO); }
#ifndef MK_REP
#define MK_REP -1
#endif
#define REPEAT(ph) for (int rep_ = 0; rep_ < ((MK_REP) == (ph) ? 2 : 1); ++rep_)
    for (int l = 0; l < DEPTH; ++l) {
        const int pb = 1 + l * NPL;
        if (IN(pb + PL_GEMM_IN)) {
            const KArgs ap = kargs(); const auto& a = *ap; WS_OPAQUE(a);
            pg8::Gemm g{(const pg8::bf16_t*)(wsb + a.off[R_XN]), (const pg8::bf16_t*)(wsb + a.off[R_WIN]) + (size_t)l * ZN * D_MODEL, RP, ZN, D_MODEL};
            pg8::StaticOrder S; S.init(RP, ZN, F.G, (int)blockIdx.x);
            pg8::EpiBf16<0> E{(pg8::bf16_t*)(wsb + a.off[R_Z]), ZN, nullptr, 0, 0, 1.f};
            REPEAT(PL_GEMM_IN) pg8::gemm_phase<pg8::EpiBf16<0>, pg8::StaticOrder, true, true>(F.lds + RING_OFF, g, S, E, F.wv);
            SEAM(pb + PL_GEMM_IN);
        }
        if (IN(pb + PL_ZPOST)) { REPEAT(103) p_s5_e(F, l); REPEAT(PL_ZPOST) p_zpost(F, l);     SEAM(pb + PL_ZPOST); }
        if (IN(pb + PL_LOCAL)) { REPEAT(104) p_gdn_chunk<0>(F, l, 0); SEAM(pb + PL_LOCAL); }
        if (IN(pb + PL_MIX)) {
            REPEAT(100) p_gdn_chain(F, l);
            REPEAT(102) { const int tid = otid(), lane = tid & 63, wave = __builtin_amdgcn_readfirstlane(tid >> 6);
              const int q = F.vcu - F.vcu / 32 - 1;
              if (F.vcu % 32 != 0 && q >= 18) for (int t = (q - 18) * NWAVES + wave; t < S5_NTASK; t += (F.G - F.G / 32 - 18) * NWAVES) s5_scan_run(F, l, t, lane); }
            REPEAT(101) p_attention(F, l + DEPTH * rep_, lds);
            SEAM(pb + PL_MIX); }
        if (IN(pb + PL_MIXPOST)) { REPEAT(PL_MIXPOST) { p_mixpost_a(F, l); p_mixpost_b(F, l); p_s5_out(F, l); } SEAM(pb + PL_MIXPOST); }
        if (IN(pb + PL_GEMM_GLU)) REPEAT(PL_GEMM_GLU) {
            const KArgs ap = kargs(); const auto& a = *ap; WS_OPAQUE(a);
            { pg8::Gemm g{(const pg8::bf16_t*)(wsb + a.off[R_YC]), (const pg8::bf16_t*)(wsb + a.off[R_WGLU]) + (size_t)l * 1024 * 512, RP, 1024, 512};
              pg8::StaticOrder S; S.init(RP, 1024, F.G, (int)blockIdx.x); pg8::EpiGlu E{(pg8::bf16_t*)(wsb + a.off[R_OC]), WIDTH_C};
              pg8::gemm_phase<pg8::EpiGlu, pg8::StaticOrder, true, true>(F.lds + RING_OFF, g, S, E, F.wv); }
            { pg8::Gemm g{(const pg8::bf16_t*)(wsb + a.off[R_OA]), (const pg8::bf16_t*)(wsb + a.off[R_WBR]) + ((size_t)l * 3 + 0) * 1024 * 512, RP, 1024, 512};
              pg8::StaticOrder S; S.init(RP, 1024, F.G, (int)((blockIdx.x + 16) % F.G)); pg8::EpiMerge<0> E{(pg8::bf16_t*)(wsb + a.off[R_MRG]), nullptr, nullptr, (const pg8::bf16_t*)(wsb + a.off[R_Z]) + ZC_GATE, ZN};
              pg8::gemm_phase<pg8::EpiMerge<0>, pg8::StaticOrder, true, true>(F.lds + RING_OFF, g, S, E, F.wv); }
            { pg8::Gemm g{(const pg8::bf16_t*)(wsb + a.off[R_OBN]), (const pg8::bf16_t*)(wsb + a.off[R_WBR]) + ((size_t)l * 3 + 1) * 1024 * 512, RP, 1024, 512};
              pg8::StaticOrder S; S.init(RP, 1024, F.G, (int)((blockIdx.x + 32) % F.G)); pg8::EpiMerge<0> E{(pg8::bf16_t*)(wsb + a.off[R_MRG2]), nullptr, nullptr, (const pg8::bf16_t*)(wsb + a.off[R_Z]) + ZC_GATE + 1024, ZN};
              pg8::gemm_phase<pg8::EpiMerge<0>, pg8::StaticOrder, true, true>(F.lds + RING_OFF, g, S, E, F.wv); }
            if (rep_ == ((MK_REP) == PL_GEMM_GLU ? 1 : 0)) SEAM(pb + PL_GEMM_GLU); }
        if (IN(pb + PL_GEMM_BRC)) {
            const KArgs ap = kargs(); const auto& a = *ap; WS_OPAQUE(a);
            pg8::Gemm g{(const pg8::bf16_t*)(wsb + a.off[R_OC]), (const pg8::bf16_t*)(wsb + a.off[R_WBR]) + ((size_t)l * 3 + 2) * 1024 * 512, RP, 1024, 512};
            pg8::StaticOrder S; S.init(RP, 1024, F.G, (int)blockIdx.x); pg8::EpiMerge<2> E{(pg8::bf16_t*)(wsb + a.off[R_MRG]), (const pg8::bf16_t*)(wsb + a.off[R_MRG2]), (pg8::bf16_t*)(wsb + a.off[R_MRGB]), (const pg8::bf16_t*)(wsb + a.off[R_Z]) + ZC_GATE + 2048, ZN};
            REPEAT(PL_GEMM_BRC) pg8::gemm_phase<pg8::EpiMerge<2>, pg8::StaticOrder, true, true>(F.lds + RING_OFF, g, S, E, F.wv);
            SEAM(pb + PL_GEMM_BRC); }
        if (IN(pb + PL_GEMM_OUT)) {
            const KArgs ap = kargs(); const auto& a = *ap; WS_OPAQUE(a);
            pg8::Gemm g{(const pg8::bf16_t*)(wsb + a.off[R_MRGB]), (const pg8::bf16_t*)(wsb + a.off[R_WOUT]) + (size_t)l * 1024 * 1024, RP, 1024, 1024};
            pg8::StaticOrder S; S.init(RP, 1024, F.G, (int)blockIdx.x);
            REPEAT(PL_GEMM_OUT) { pg8::EpiResid E{(float*)(wsb + a.off[R_X]), D_MODEL, (MK_REP) == PL_GEMM_OUT && rep_ == 0, (pg8::bf16_t*)(wsb + a.off[R_XN])};
            pg8::gemm_phase<pg8::EpiResid, pg8::StaticOrder, true, true>(F.lds + RING_OFF, g, S, E, F.wv); }
            SEAM(pb + PL_GEMM_OUT); }
        if (IN(pb + PL_GEMM_PEER)) {
            peerw_drain(F, (l + 1) * PW_ITEMS_L);
            const KArgs ap = kargs(); const auto& a = *ap; WS_OPAQUE(a);
            pg8::Gemm g{(const pg8::bf16_t*)(wsb + a.off[R_XN]), (const pg8::bf16_t*)(wsb + a.off[R_WQS]) + (size_t)l * PQ * D_MODEL, RP, PQ, D_MODEL};
            pg8::StaticOrder S; S.init(RP, PQ, F.G, (int)blockIdx.x); pg8::EpiF32 E{(float*)(wsb + a.off[R_SC]), PQ};
            REPEAT(PL_GEMM_PEER) pg8::gemm_phase<pg8::EpiF32, pg8::StaticOrder, true, true>(F.lds + RING_OFF, g, S, E, F.wv);
            SEAM(pb + PL_GEMM_PEER); }
        if (IN(pb + PL_PEER)) { REPEAT(PL_PEER) p_peer(F, l, (MK_REP) == PL_PEER && rep_ == 0); SEAM(pb + PL_PEER); }
    }
#ifdef MK_TBAR
    if (blockIdx.x == MK_TBAR_WG && F.wv == 0 && lane_id() == 0) args.out[O_YS] = 1000.f * (MK_TBAR_Q) * floorf((float)tbar_ * 1e-5f / (MK_TBAR_Q) + 0.5f);
#endif
#undef IN
#undef SEAM
}
}
#ifndef MK_ONE_LAUNCH
#define MK_ONE_LAUNCH 1
#endif
static int mk_grid = 0;
static bool mk_setup() {
    if (mk_grid) return mk_grid > 0;
    int dev = 0, cus = 0;
    if (hipGetDevice(&dev) != hipSuccess || hipDeviceGetAttribute(&cus, hipDeviceAttributeMultiprocessorCount, dev) != hipSuccess) { mk_grid = -1; return false; }
    if (hipFuncSetAttribute((const void*)mk::mk_fwd, hipFuncAttributeMaxDynamicSharedMemorySize, mk::LDS_BYTES) != hipSuccess) { fprintf(stderr, "kernel_launch: hipFuncSetAttribute failed\n"); mk_grid = -1; return false; }
    int per_cu = 0;
    if (hipOccupancyMaxActiveBlocksPerMultiprocessor(&per_cu, (const void*)mk::mk_fwd, mk::NTHR, mk::LDS_BYTES) != hipSuccess || per_cu < 1) { fprintf(stderr, "kernel_launch: occupancy query says %d workgroups per CU\n", per_cu); }
    (void)hipGetLastError();
    mk_grid = cus;
    return true;
}
static void mk_launch(mk::Args a, int lo, int hi, int region, hipStream_t stream) {
    a.ph_lo = lo; a.ph_hi = hi; a.bar_region = region;
    hipLaunchKernelGGL(mk::mk_fwd, dim3(mk_grid), dim3(mk::NTHR), mk::LDS_BYTES, stream, a);
    hipError_t e = hipPeekAtLastError(); if (e != hipSuccess) fprintf(stderr, "kernel_launch: launch failed: %s\n", hipGetErrorName(e));
}
extern "C" void kernel_launch(void* const* d_in, const int* in_sizes, int n_in, void* d_out, int out_size, void* d_ws, size_t ws_size, hipStream_t stream) {
    if (n_in != N_INPUTS || (size_t)out_size != (size_t)O_END) { fprintf(stderr, "kernel_launch: unexpected n_in %d / out_size %d\n", n_in, out_size); return; }
    if (!mk_setup()) return;
    const size_t MiB = 1u << 20;
    unsigned char* ws = (unsigned char*)d_ws;
    mk::Args a{};
    for (int i = 0; i < N_INPUTS; ++i) a.in[i] = (const float*)d_in[i];
    a.out = (float*)d_out; a.ws = ws;
    { using namespace mk; const struct { int r; size_t mib; } map[] = { {R_WIN, 1}, {R_WGLU, 59}, {R_WBR, 63}, {R_WOUT, 75}, {R_WQS, 83}, {R_S5T, 99}, {R_PU, 132}, {R_PV, 196}, {R_MISC, 260}, {R_OBN, 262}, {R_MRG2, 280}, {R_X, 388}, {R_XN, 456},
        {R_Z, 490}, {R_SC, 490}, {R_QN, 737}, {R_KN, 754}, {R_QKVB, 771}, {R_BG, 822}, {R_O, 823}, {R_MRGB, 823}, {R_OA, 857}, {R_OB, 874}, {R_GDN, 891}, {R_MRG, 891},
        {R_S5E, 986}, {R_YC, 986}, {R_S5X, 1003}, {R_OC, 1012} };
      for (auto& e : map) a.off[e.r] = e.mib * MiB; }
    if (1029 * MiB > ws_size) { fprintf(stderr, "kernel_launch: workspace too small (%zu)\n", ws_size); return; }
    if (hipMemsetAsync(ws, 0, mk::CTL_BYTES, stream) != hipSuccess) { fprintf(stderr, "kernel_launch: memset failed\n"); return; }
    a.pro_mask =   mk::PM_WIN | mk::PM_TABLES | mk::PM_WREST | mk::PM_WQS;
#if MK_ONE_LAUNCH
    mk_launch(a, 0, mk::PH_END, 0, stream);
#else
    int region = 0;
    mk_launch(a, mk::PH_PRO, mk::PH_PRO + 1, region++, stream);
    for (int l = 0; l < DEPTH; ++l) { const int pb = 1 + l * mk::NPL;
        for (int ph = mk::PL_NORM1; ph <= mk::PL_PEER; ++ph) { if (ph == mk::PL_GEMM_BRA || ph == mk::PL_GEMM_BRB) continue; mk_launch(a, pb + ph, pb + ph + 1, region++, stream); } }
    mk_launch(a, mk::PH_FINAL, mk::PH_END, region++, stream);
#endif
}
```

```cpp
#include <hip/hip_runtime.h>
#include <cstdio>
#include <cstdint>
#include <utility>
#define MK_ONE_LAUNCH 1
#ifndef D_MODEL
#define D_MODEL 1024
#define BATCH 2
#define SEQ 8192
#define DEPTH 4
#define DEC_BATCH 16
#define DEC_SEQ 32
#define PAST_LEN 1024
#define N_HEADS_A 4
#define HEAD_DIM_A 64
#define N_HEADS_B 4
#define HEAD_DIM_B 128
#define S5_GROUPS 32
#define S5_STATE 64
#define PEER_HEADS 8
#define PEER_QDIM 256
#define N_KEYS 128
#endif
#define CHUNK 64
#define N_META 16
#define EPSF 1e-6f
#define NUM_BUCKETS 32
#define CONV_W 4
#define S5_GROUP 16
#define PEER_TOPK 16
#define N_EXPERTS (N_KEYS * N_KEYS)
#define WIDTH_A (N_HEADS_A * 2 * HEAD_DIM_A)
#define WIDTH_B (N_HEADS_B * HEAD_DIM_B)
#define WIDTH_C (S5_GROUPS * S5_GROUP)
#define OFF_QA 0
#define OFF_KA (OFF_QA + WIDTH_A)
#define OFF_VA (OFF_KA + WIDTH_A)
#define OFF_QKVB (OFF_VA + WIDTH_A)
#define OFF_GB (OFF_QKVB + 3 * WIDTH_B)
#define OFF_BETA (OFF_GB + WIDTH_B)
#define OFF_ALPHA (OFF_BETA + N_HEADS_B)
#define OFF_UC (OFF_ALPHA + N_HEADS_B)
#define OFF_GATE (OFF_UC + WIDTH_C)
#define D_IN (OFF_GATE + 3 * D_MODEL)
#define LP (N_META + SEQ)
#define NP (BATCH * LP)
#define NS (DEC_BATCH * DEC_SEQ)
#define NT (NP + NS)
#define PQ (PEER_HEADS * PEER_QDIM)

enum { I_XP, I_XS, I_CK, I_CV, I_SCONV, I_SDELTA, I_SRE, I_SIM, I_META, I_REL, I_N1, I_N2, I_FN, I_WIN, I_QN, I_KN, I_LQK, I_SUBLN, I_CONVW, I_ALOG, I_DTB, I_GDNN,
       I_AR, I_AI, I_BR, I_BI, I_CR, I_CI, I_SD, I_LDT, I_WGLU, I_WBA, I_WBB, I_WBC, I_WOUT, I_PWQ, I_PSK, I_PU, I_PV, N_INPUTS };
#define O_YP 0
#define O_YS (O_YP + (size_t)BATCH * SEQ * D_MODEL)
#define O_KP (O_YS + (size_t)NS * D_MODEL)
#define O_VP (O_KP + (size_t)DEPTH * NP * WIDTH_A)
#define O_KS (O_VP + (size_t)DEPTH * NP * WIDTH_A)
#define O_VS (O_KS + (size_t)DEPTH * NS * WIDTH_A)
#define O_CP (O_VS + (size_t)DEPTH * NS * WIDTH_A)
#define O_CS (O_CP + (size_t)DEPTH * BATCH * (CONV_W - 1) * 3 * WIDTH_B)
#define O_DP (O_CS + (size_t)DEPTH * DEC_BATCH * (CONV_W - 1) * 3 * WIDTH_B)
#define O_DS (O_DP + (size_t)DEPTH * BATCH * N_HEADS_B * HEAD_DIM_B * HEAD_DIM_B)
#define O_SRP (O_DS + (size_t)DEPTH * DEC_BATCH * N_HEADS_B * HEAD_DIM_B * HEAD_DIM_B)
#define O_SIP (O_SRP + (size_t)DEPTH * BATCH * S5_GROUPS * S5_STATE)
#define O_SRS (O_SIP + (size_t)DEPTH * BATCH * S5_GROUPS * S5_STATE)
#define O_SIS (O_SRS + (size_t)DEPTH * DEC_BATCH * S5_GROUPS * S5_STATE)
#define O_END (O_SIS + (size_t)DEPTH * DEC_BATCH * S5_GROUPS * S5_STATE)

namespace pg8 {
#define PG8_LAS __attribute__((address_space(3)))
typedef unsigned short bf16_t;
typedef short bf16x8 __attribute__((ext_vector_type(8)));
typedef float f32x4 __attribute__((ext_vector_type(4)));
typedef unsigned u32x4 __attribute__((ext_vector_type(4)));
constexpr int BM = 256, BK = 64, HALF = 128, HTB = HALF * BK * 2  , STAGE_BYTES = 8 * HTB, NXCD = 8, WGM = 8;

__host__ __device__ __forceinline__ int lds_byte(int r, int c) { const int st = (r >> 4) * 2 + (c >> 5), rr = r & 15, cc = c & 31, ob = rr * 64 + cc * 2; return st * 1024 + (ob ^ (((ob >> 9) & 1) << 5)); }
__host__ __device__ __forceinline__ void stage_rc(int b, int& R, int& C) { const int st = b / 1024, sb = b % 1024, swz = sb ^ (((sb >> 9) & 1) << 5); R = (st >> 1) * 16 + swz / 64; C = (st & 1) * 32 + (swz % 64) / 2; }
__host__ __device__ __forceinline__ int perm32(int rho) { const int n = rho >> 4, i = rho & 15; return 8 * (i >> 2) + 4 * n + (i & 3); }

struct Unit { int pm, pn; };
struct Gemm { const bf16_t* A; const bf16_t* Bt; int M, N, K; };

struct StaticOrder {
    int nM, nN, nwg, G, c;
    __host__ __device__ void init(int M, int N, int G_, int c_) { nM = M / BM; nN = N / BM; nwg = nM * nN; G = G_; c = c_; }
    __host__ __device__ bool next(int i, Unit& u) const {
        const long L = (long)i * G + c; if (L >= nwg) return false;
        int wgid = (int)L; { const int q = nwg / NXCD, r = nwg % NXCD, xcd = wgid % NXCD, off = wgid / NXCD; wgid = (xcd < r ? xcd * (q + 1) : r * (q + 1) + (xcd - r) * q) + off; }
        const int nig = WGM * nN, gid = wgid / nig, fm = gid * WGM, gsz = (nM - fm) < WGM ? (nM - fm) : WGM;
        u.pm = fm + ((wgid % nig) % gsz); u.pn = (wgid % nig) / gsz; return true;
    }
    __device__ __forceinline__ void a_ready(const Unit&) const {}
    __device__ __forceinline__ void done(const Unit&) const {}
};

__device__ __forceinline__ unsigned cvt_pk_bf16(float lo, float hi) { unsigned r; asm volatile("v_cvt_pk_bf16_f32 %0, %1, %2" : "=v"(r) : "v"(lo), "v"(hi)); return r; }
typedef float f32x2 __attribute__((ext_vector_type(2)));
__device__ __forceinline__ f32x2 gelu_pk(f32x2 v) {
    const f32x2 av = __builtin_elementwise_abs(v), d = av * 0.2316418882f + 1.0f;
    f32x2 t; t.x = __builtin_amdgcn_rcpf(d.x); t.y = __builtin_amdgcn_rcpf(d.y);
    f32x2 q = t * 0.5307027145f + (-0.7265760135f); q = q * t + 0.7107068705f; q = q * t + (-0.142248368f); q = q * t + 0.127414796f; q = q * t;
    const f32x2 s = (v * v) * (-0.72134752044f);
    f32x2 e; e.x = __builtin_amdgcn_exp2f(s.x); e.y = __builtin_amdgcn_exp2f(s.y);
    const f32x2 m = v * (q * e), r = v - m;
    f32x2 o; o.x = v.x < 0.f ? m.x : r.x; o.y = v.y < 0.f ? m.y : r.y; return o;
}

template <int ACT  > struct EpiBf16 {
    static constexpr bool PERM = true, AFTER_DRAIN = false; static_assert(ACT == 0 || ACT == 1, "EpiBf16: ACT is 0 (none) or 1 (gelu_pk)");
    bf16_t* O; int ldc; const float* bias; int split_cols; size_t split_stride; float scale0;
    __device__ __forceinline__ void operator()(const f32x4 (&acc)[2][2][4][2], const Unit& u, int wr, int wc, int fr, int fq) const {
        const int row0 = u.pm * BM + wr * 64 + fr; int colt = u.pn * BM; bf16_t* base = O;
        float sc = 1.f; if (split_cols) { const int t = colt / split_cols; base += (size_t)t * split_stride; colt -= t * split_cols; if (t == 0) sc = scale0; }
        const int col0 = colt + wc * 32 + 8 * fq, bcol0 = u.pn * BM + wc * 32 + 8 * fq;
        f32x4 bv[2][2];
#pragma unroll
        for (int bj = 0; bj < 2; ++bj)
#pragma unroll
            for (int n = 0; n < 2; ++n) bv[bj][n] = bias ? *(const f32x4*)(bias + bcol0 + bj * HALF + 4 * n) : (f32x4){0.f, 0.f, 0.f, 0.f};
#pragma unroll
        for (int ai = 0; ai < 2; ++ai)
#pragma unroll
            for (int m = 0; m < 4; ++m) { bf16_t* rowp = base + (size_t)(row0 + ai * HALF + m * 16) * ldc + col0;
#pragma unroll
                for (int bj = 0; bj < 2; ++bj) { f32x4 v0 = acc[ai][bj][m][0] + bv[bj][0], v1 = acc[ai][bj][m][1] + bv[bj][1];
                    if (ACT == 1) { f32x2 a = gelu_pk((f32x2){v0[0], v0[1]}), b = gelu_pk((f32x2){v0[2], v0[3]}), c = gelu_pk((f32x2){v1[0], v1[1]}), d = gelu_pk((f32x2){v1[2], v1[3]});
                        v0 = (f32x4){a.x, a.y, b.x, b.y}; v1 = (f32x4){c.x, c.y, d.x, d.y}; }
                    v0 = v0 * sc; v1 = v1 * sc; u32x4 w; w.x = cvt_pk_bf16(v0[0], v0[1]); w.y = cvt_pk_bf16(v0[2], v0[3]); w.z = cvt_pk_bf16(v1[0], v1[1]); w.w = cvt_pk_bf16(v1[2], v1[3]);
                    *(u32x4*)(rowp + bj * HALF) = w; } }
    }
};

__device__ __forceinline__ float epi_sigm(float x) { return __builtin_amdgcn_rcpf(1.f + __expf(-x)); }
struct EpiGlu {
    static constexpr bool PERM = false, AFTER_DRAIN = false;
    bf16_t* O; int ldo;
    __device__ __forceinline__ void operator()(const f32x4 (&acc)[2][2][4][2], const Unit& u, int wr, int wc, int fr, int fq) const {
        const int row0 = u.pm * BM + wr * 64 + fr;
#pragma unroll
        for (int ai = 0; ai < 2; ++ai)
#pragma unroll
            for (int m = 0; m < 4; ++m) { bf16_t* rowp = O + (size_t)(row0 + ai * HALF + m * 16) * ldo + 4 * fq;
#pragma unroll
                for (int bj = 0; bj < 2; ++bj) { const int G = u.pn * 8 + bj * 4 + wc; const f32x4 av = acc[ai][bj][m][0], gv = acc[ai][bj][m][1];
                    typedef unsigned u32x2 __attribute__((ext_vector_type(2))); u32x2 w;
                    w.x = cvt_pk_bf16(av[0] * epi_sigm(gv[0]), av[1] * epi_sigm(gv[1])); w.y = cvt_pk_bf16(av[2] * epi_sigm(gv[2]), av[3] * epi_sigm(gv[3]));
                    *(u32x2*)(rowp + 16 * G) = w; } }
    }
};
template <int MODE> struct EpiMerge {
    static constexpr bool PERM = true, AFTER_DRAIN = false;
    bf16_t* M; const bf16_t* M2; bf16_t* Mb; const bf16_t* Zg; int ldz;
    __device__ __forceinline__ void operator()(const f32x4 (&acc)[2][2][4][2], const Unit& u, int wr, int wc, int fr, int fq) const {
        const int row0 = u.pm * BM + wr * 64 + fr, col0 = u.pn * BM + wc * 32 + 8 * fq;
#define EPI_LO(w) __builtin_bit_cast(float, (w) << 16)
#define EPI_HI(w) __builtin_bit_cast(float, (w) & 0xffff0000u)
        constexpr int MG = MODE == 2 ? 2 : 4;
#pragma unroll
        for (int aim = 0; aim < 8; aim += MG) { const int ai = aim >> 2, m0 = aim & 3;
            u32x4 gz[MG][2], pa[MG][2], pb[MG][2];
#pragma unroll
            for (int m = 0; m < MG; ++m)
#pragma unroll
                for (int bj = 0; bj < 2; ++bj) { const size_t row = (size_t)(row0 + ai * HALF + (m0 + m) * 16); const int col = col0 + bj * HALF;
                    gz[m][bj] = *(const u32x4*)(Zg + row * ldz + col);
                    if (MODE == 2) { pa[m][bj] = *(const u32x4*)(M + row * 1024 + col); pb[m][bj] = *(const u32x4*)(M2 + row * 1024 + col); } }
#pragma unroll
            for (int m = 0; m < MG; ++m)
#pragma unroll
                for (int bj = 0; bj < 2; ++bj) { const size_t row = (size_t)(row0 + ai * HALF + (m0 + m) * 16); const int col = col0 + bj * HALF; const u32x4 g = gz[m][bj];
                    f32x4 v0 = acc[ai][bj][m0 + m][0], v1 = acc[ai][bj][m0 + m][1];
                    v0[0] *= epi_sigm(EPI_LO(g.x)); v0[1] *= epi_sigm(EPI_HI(g.x)); v0[2] *= epi_sigm(EPI_LO(g.y)); v0[3] *= epi_sigm(EPI_HI(g.y));
                    v1[0] *= epi_sigm(EPI_LO(g.z)); v1[1] *= epi_sigm(EPI_HI(g.z)); v1[2] *= epi_sigm(EPI_LO(g.w)); v1[3] *= epi_sigm(EPI_HI(g.w));
                    if (MODE == 2) { const u32x4 a_ = pa[m][bj], b_ = pb[m][bj];
                        v0[0] += EPI_LO(a_.x) + EPI_LO(b_.x); v0[1] += EPI_HI(a_.x) + EPI_HI(b_.x); v0[2] += EPI_LO(a_.y) + EPI_LO(b_.y); v0[3] += EPI_HI(a_.y) + EPI_HI(b_.y);
                        v1[0] += EPI_LO(a_.z) + EPI_LO(b_.z); v1[1] += EPI_HI(a_.z) + EPI_HI(b_.z); v1[2] += EPI_LO(a_.w) + EPI_LO(b_.w); v1[3] += EPI_HI(a_.w) + EPI_HI(b_.w); }
                    u32x4 w; w.x = cvt_pk_bf16(v0[0], v0[1]); w.y = cvt_pk_bf16(v0[2], v0[3]); w.z = cvt_pk_bf16(v1[0], v1[1]); w.w = cvt_pk_bf16(v1[2], v1[3]);
                    *(u32x4*)((MODE == 2 ? Mb : M) + row * 1024 + col) = w; }
        }
#undef EPI_LO
#undef EPI_HI
    }
};
struct EpiResid {
    static constexpr bool PERM = false, AFTER_DRAIN = false;
    float* X; int ldx; bool dry; bf16_t* Xb;
    __device__ __forceinline__ void operator()(const f32x4 (&acc)[2][2][4][2], const Unit& u, int wr, int wc, int fr, int fq) const {
        const int row0 = u.pm * BM + wr * 64 + fr, col0 = u.pn * BM + wc * 32 + 4 * fq;
        typedef unsigned u32x2 __attribute__((ext_vector_type(2)));
#pragma unroll
        for (int aim = 0; aim < 8; aim += 2) { const int ai = aim >> 2, m0 = aim & 3;
            f32x4 xo[2][2][2]; bool ok[2];
#pragma unroll
            for (int m = 0; m < 2; ++m) { const int row = row0 + ai * HALF + (m0 + m) * 16; ok[m] = true; if (row < 16896) { const int p = row % 8448; ok[m] = p >= 48 && p < 8256; } ok[m] = ok[m] && !dry;
                const float* rowp = X + (size_t)row * ldx + col0;
#pragma unroll
                for (int bj = 0; bj < 2; ++bj)
#pragma unroll
                    for (int n = 0; n < 2; ++n) xo[m][bj][n] = *(const f32x4*)(rowp + bj * HALF + n * 16); }
#pragma unroll
            for (int m = 0; m < 2; ++m) { const int row = row0 + ai * HALF + (m0 + m) * 16;
                if (ok[m]) { float* rowp = X + (size_t)row * ldx + col0;
#pragma unroll
                    for (int bj = 0; bj < 2; ++bj)
#pragma unroll
                        for (int n = 0; n < 2; ++n) { const f32x4 v = xo[m][bj][n] + acc[ai][bj][m0 + m][n]; *(f32x4*)(rowp + bj * HALF + n * 16) = v;
                            u32x2 w; w.x = cvt_pk_bf16(v[0], v[1]); w.y = cvt_pk_bf16(v[2], v[3]); *(u32x2*)(Xb + (size_t)row * ldx + col0 + bj * HALF + n * 16) = w; } } }
        }
    }
};
struct EpiF32 {
    static constexpr bool PERM = false, AFTER_DRAIN = false;
    float* C; int ldc;
    __device__ __forceinline__ void operator()(const f32x4 (&acc)[2][2][4][2], const Unit& u, int wr, int wc, int fr, int fq) const {
        const int row0 = u.pm * BM + wr * 64 + fr, col0 = u.pn * BM + wc * 32 + 4 * fq;
#pragma unroll
        for (int ai = 0; ai < 2; ++ai)
#pragma unroll
            for (int m = 0; m < 4; ++m) { float* rowp = C + (size_t)(row0 + ai * HALF + m * 16) * ldc + col0;
#pragma unroll
                for (int bj = 0; bj < 2; ++bj)
#pragma unroll
                    for (int n = 0; n < 2; ++n) *(f32x4*)(rowp + bj * HALF + n * 16) = acc[ai][bj][m][n]; }
    }
};

template <class Epi, class Sched, bool ALIGN_EPI = false, bool SP2 = false>
__device__ __forceinline__ void gemm_phase(PG8_LAS unsigned char* lds, const Gemm g, const Sched& S, const Epi& E, int wv) {
    unsigned om_ = ~0u; asm volatile("" : "+s"(om_), "+s"(wv)); int tid_ = wv * 64 + (int)__builtin_amdgcn_mbcnt_hi(om_, __builtin_amdgcn_mbcnt_lo(om_, 0u));
    const int tid = tid_, wid = __builtin_amdgcn_readfirstlane(tid >> 6), lane = tid & 63, wr = wid >> 2, wc = wid & 3, fr = lane & 15, fq = lane >> 4;
    const int K = g.K, nt = K / BK;
    unsigned voffA[2], voffB[2];
#pragma unroll
    for (int i = 0; i < 2; ++i) { int R, C; stage_rc(tid * 16 + i * 8192, R, C); const int Rb = Epi::PERM ? ((R & ~31) + perm32(R & 31)) : R;
        voffA[i] = (unsigned)(R * K + C) * 2u; voffB[i] = (unsigned)(Rb * K + C) * 2u; }
    const size_t kstep = (size_t)(BK * 2);
    const size_t hstep = (size_t)HALF * K * 2;
    const size_t tstep = 2 * hstep;
    const unsigned ldsw = (unsigned)wid * 1024u;
    const int aoff = lds_byte(wr * 64 + fr, fq * 8), boff = lds_byte(wc * 32 + fr, fq * 8);
#define PG8_SA(b, h) (((b) * 2 + (h)) * HTB)
#define PG8_SB(b, h) ((4 + (b) * 2 + (h)) * HTB)
#define PG8_STAGE(bufoff, gbase, voff) do { _Pragma("unroll") for (int _i = 0; _i < 2; ++_i) \
        __builtin_amdgcn_global_load_lds((const unsigned*)((const char*)(gbase) + (voff)[_i]), (PG8_LAS unsigned*)(lds + (bufoff) + ldsw + _i * 8192), 16, 0, 0); } while (0)
#define PG8_LDA(dst, b, h) do { _Pragma("unroll") for (int m = 0; m < 4; ++m) _Pragma("unroll") for (int k = 0; k < 2; ++k) dst[m][k] = *(const PG8_LAS bf16x8*)(lds + PG8_SA(b, h) + aoff + m * 2048 + k * 1024); } while (0)
#define PG8_LDB(dst, b, h) do { _Pragma("unroll") for (int n = 0; n < 2; ++n) _Pragma("unroll") for (int k = 0; k < 2; ++k) dst[n][k] = *(const PG8_LAS bf16x8*)(lds + PG8_SB(b, h) + boff + n * 2048 + k * 1024); } while (0)
#define PG8_MMA(ai, bj, At, Bt) do { __builtin_amdgcn_s_setprio(1); _Pragma("unroll") for (int m = 0; m < 4; ++m) _Pragma("unroll") for (int n = 0; n < 2; ++n) _Pragma("unroll") for (int k = 0; k < 2; ++k) \
        acc[ai][bj][m][n] = __builtin_amdgcn_mfma_f32_16x16x32_bf16(Bt[n][k], At[m][k], acc[ai][bj][m][n], 0, 0, 0); __builtin_amdgcn_s_setprio(0); } while (0)
#define PG8_WAIT_V(n) asm volatile("s_waitcnt vmcnt(" #n ")" ::: "memory")
#define PG8_WAIT_L(n) asm volatile("s_waitcnt lgkmcnt(" #n ")" ::: "memory")
#define PG8_BAR __builtin_amdgcn_s_barrier()
#define PG8_SCHED __builtin_amdgcn_sched_barrier(0)
    Unit cur, nxt; int ui = 0;
    if (!S.next(0, cur)) return;
    f32x4 acc[2][2][4][2];
#pragma unroll
    for (int a = 0; a < 2; ++a)
#pragma unroll
        for (int b = 0; b < 2; ++b)
#pragma unroll
            for (int m = 0; m < 4; ++m)
#pragma unroll
                for (int n = 0; n < 2; ++n) acc[a][b][m][n] = (f32x4){0.f, 0.f, 0.f, 0.f};
    bf16x8 At[4][2], B0[2][2], B1[2][2];
    const char* cA = (const char*)g.A + (size_t)cur.pm * tstep; const char* cB = (const char*)g.Bt + (size_t)cur.pn * tstep;
    S.a_ready(cur);
    if constexpr (SP2) {
        PG8_STAGE(PG8_SB(0, 0), cB, voffB); PG8_STAGE(PG8_SB(0, 1), cB + hstep, voffB); PG8_STAGE(PG8_SA(0, 0), cA, voffA); PG8_STAGE(PG8_SA(0, 1), cA + hstep, voffA);
        if (wr == 1) PG8_BAR;
        PG8_WAIT_V(2); PG8_BAR;
        PG8_STAGE(PG8_SB(1, 0), cB + kstep, voffB); PG8_STAGE(PG8_SA(1, 0), cA + kstep, voffA); PG8_STAGE(PG8_SB(1, 1), cB + hstep + kstep, voffB);
        PG8_WAIT_V(6); PG8_BAR;
    } else {
        PG8_STAGE(PG8_SB(0, 0), cB, voffB); PG8_STAGE(PG8_SA(0, 0), cA, voffA); PG8_STAGE(PG8_SB(0, 1), cB + hstep, voffB); PG8_STAGE(PG8_SA(0, 1), cA + hstep, voffA);
        if (wr == 1) PG8_BAR;
        PG8_WAIT_V(4); PG8_BAR;
        PG8_STAGE(PG8_SB(1, 0), cB + kstep, voffB); PG8_STAGE(PG8_SA(1, 0), cA + kstep, voffA); PG8_STAGE(PG8_SB(1, 1), cB + hstep + kstep, voffB);
        PG8_WAIT_V(6); PG8_BAR;
    }
    for (;;) {
        const bool has_next = S.next(ui + 1, nxt);
        const char* nA = has_next ? (const char*)g.A + (size_t)nxt.pm * tstep : cA; const char* nB = has_next ? (const char*)g.Bt + (size_t)nxt.pn * tstep : cB;
        for (int t = 0; t < nt; t += 2) {
            const bool last = (t == nt - 2);
            const char* a1 = cA + (size_t)(t + 1) * kstep;
            const char* a2 = last ? nA : cA + (size_t)(t + 2) * kstep; const char* b2 = last ? nB : cB + (size_t)(t + 2) * kstep;
            const char* a3 = a2 + kstep; const char* b3 = b2 + kstep;
            if (last && has_next) S.a_ready(nxt);
            if constexpr (SP2) {
            PG8_LDB(B0, 0, 0); PG8_LDB(B1, 0, 1); PG8_SCHED; PG8_LDA(At, 0, 0); PG8_STAGE(PG8_SA(1, 1), a1 + hstep, voffA);
            PG8_WAIT_V(8); PG8_WAIT_L(0); PG8_BAR; PG8_MMA(0, 0, At, B0); PG8_MMA(0, 1, At, B1); PG8_BAR; PG8_SCHED;
            PG8_LDA(At, 0, 1); PG8_STAGE(PG8_SB(0, 0), b2, voffB); PG8_STAGE(PG8_SB(0, 1), b2 + hstep, voffB); PG8_STAGE(PG8_SA(0, 0), a2, voffA);
            PG8_WAIT_V(8); PG8_WAIT_L(0); PG8_BAR; PG8_MMA(1, 0, At, B0); PG8_MMA(1, 1, At, B1); PG8_BAR; PG8_SCHED;
            PG8_LDB(B0, 1, 0); PG8_LDB(B1, 1, 1); PG8_SCHED; PG8_LDA(At, 1, 0); PG8_STAGE(PG8_SA(0, 1), a2 + hstep, voffA);
            PG8_WAIT_V(8); PG8_WAIT_L(0); PG8_BAR; PG8_MMA(0, 0, At, B0); PG8_MMA(0, 1, At, B1); PG8_BAR; PG8_SCHED;
            PG8_LDA(At, 1, 1); PG8_STAGE(PG8_SB(1, 0), b3, voffB); PG8_STAGE(PG8_SB(1, 1), b3 + hstep, voffB); PG8_STAGE(PG8_SA(1, 0), a3, voffA);
            PG8_WAIT_V(8); PG8_WAIT_L(0); PG8_BAR; PG8_MMA(1, 0, At, B0); PG8_MMA(1, 1, At, B1); PG8_BAR; PG8_SCHED;
            } else {
            PG8_LDB(B0, 0, 0); PG8_SCHED; PG8_LDA(At, 0, 0); PG8_STAGE(PG8_SA(1, 1), a1 + hstep, voffA);
            PG8_WAIT_L(8); PG8_BAR; PG8_WAIT_L(0); PG8_MMA(0, 0, At, B0); PG8_BAR; PG8_SCHED;
            PG8_LDB(B1, 0, 1); PG8_STAGE(PG8_SB(0, 0), b2, voffB);
            PG8_BAR; PG8_WAIT_L(0); PG8_MMA(0, 1, At, B1); PG8_BAR;
            PG8_LDA(At, 0, 1); PG8_STAGE(PG8_SA(0, 0), a2, voffA);
            PG8_BAR; PG8_WAIT_L(0); PG8_MMA(1, 0, At, B0); PG8_BAR; PG8_SCHED;
            PG8_STAGE(PG8_SB(0, 1), b2 + hstep, voffB);
            PG8_WAIT_V(6); PG8_BAR; PG8_MMA(1, 1, At, B1); PG8_BAR;
            PG8_LDB(B0, 1, 0); PG8_SCHED; PG8_LDA(At, 1, 0); PG8_STAGE(PG8_SA(0, 1), a2 + hstep, voffA);
            PG8_WAIT_L(8); PG8_BAR; PG8_WAIT_L(0); PG8_MMA(0, 0, At, B0); PG8_BAR; PG8_SCHED;
            PG8_LDB(B1, 1, 1); PG8_STAGE(PG8_SB(1, 0), b3, voffB);
            PG8_BAR; PG8_WAIT_L(0); PG8_MMA(0, 1, At, B1); PG8_BAR;
            PG8_LDA(At, 1, 1); PG8_STAGE(PG8_SA(1, 0), a3, voffA);
            PG8_BAR; PG8_WAIT_L(0); PG8_MMA(1, 0, At, B0); PG8_BAR; PG8_SCHED;
            PG8_STAGE(PG8_SB(1, 1), b3 + hstep, voffB);
            PG8_WAIT_V(6); PG8_BAR; PG8_MMA(1, 1, At, B1); PG8_BAR;
            }
        }
        if constexpr (ALIGN_EPI) { if (wr == 0) PG8_BAR; }
        if constexpr (!Epi::AFTER_DRAIN) { E(acc, cur, wr, wc, fr, fq); S.done(cur); }
        if (!has_next) break;
#pragma unroll
        for (int a = 0; a < 2; ++a)
#pragma unroll
            for (int b = 0; b < 2; ++b)
#pragma unroll
                for (int m = 0; m < 4; ++m)
#pragma unroll
                    for (int n = 0; n < 2; ++n) acc[a][b][m][n] = (f32x4){0.f, 0.f, 0.f, 0.f};
        cur = nxt; cA = nA; cB = nB; ++ui;
        if constexpr (ALIGN_EPI) { if (wr == 1) PG8_BAR; }
    }
    PG8_WAIT_V(0);
    if constexpr (!ALIGN_EPI) { if (wr == 0) PG8_BAR; }
    PG8_BAR;
    if constexpr (Epi::AFTER_DRAIN) { E.fused(acc, cur, wr, wc, fr, fq, lds, wid, lane); S.done(cur); }
#undef PG8_SA
#undef PG8_SB
#undef PG8_STAGE
#undef PG8_LDA
#undef PG8_LDB
#undef PG8_MMA
#undef PG8_WAIT_V
#undef PG8_WAIT_L
#undef PG8_BAR
#undef PG8_SCHED
}
}
#include <hip/hip_bf16.h>
#include <cmath>
namespace attn_body {
using bf16=__hip_bfloat16;
using bf16x8=__attribute__((ext_vector_type(8)))short;
using s16x4=__attribute__((ext_vector_type(4)))short;
using f32x16=__attribute__((ext_vector_type(16)))float;
using u32x4=__attribute__((ext_vector_type(4)))unsigned;
constexpr int ASEQ=8448,D=64;
constexpr int QP=512,KP=512,VP=7424,OP=1024;
constexpr int NW=8,QBLK=32,QB=QBLK*NW,KVBLK=64,NQB=ASEQ/QB;
constexpr int ATTN_UNIT_ROWS=QB;
__device__ __forceinline__ int crow(int r,int hi){return (r&3)+8*(r>>2)+4*hi;}
#define SBAR() __builtin_amdgcn_sched_barrier(0)
constexpr int BT_OFF=383, BT_N=640;
__device__ __forceinline__ void bmask(f32x16&p0,f32x16&p1,int t,int q0,int wid,int r32,int hi,const __attribute__((address_space(3))) float*tab){
  const float NEG=-INFINITY; const int qw=q0+32*wid;
  if(t>(qw>>6)){
    #pragma unroll
    for(int r=0;r<16;++r){p0[r]=NEG;p1[r]=NEG;} return; }
  if(t>0 && 64*t+63+91<=qw) return;
  const int q=qw+r32, kb=64*t+4*hi;
  #pragma unroll
  for(int r=0;r<16;++r){ const int kv=kb+(r&3)+8*(r>>2); int i0=kv-q+BT_OFF, i1=i0+32; i0=i0<0?0:i0; i1=i1<0?0:i1;
    p0[r]+=tab[i0]; p1[r]+=tab[i1]; if(kv<48)p0[r]=NEG; if(kv+32<48)p1[r]=NEG; }
}

constexpr int NSLOT=3, SLOTB=8192;
constexpr int LDS_K=0, LDS_V=NSLOT*SLOTB, LDS_WS=2*NSLOT*SLOTB, LDS_OST=LDS_WS+NW*64*4, LDS_BT=LDS_OST+NW*4096, LDS_BYTES=LDS_BT+BT_N*4;
constexpr float C2=0.125f*1.4426950408889634f;
__device__ __forceinline__ void glds16(const void*gsrc,unsigned lds_dst){unsigned keep;
  asm volatile("s_mov_b32 %0, m0\n\ts_mov_b32 m0, %2\n\ts_nop 0\n\tglobal_load_lds_dwordx4 %1, off\n\ts_mov_b32 m0, %0":"=&s"(keep):"v"(gsrc),"s"(lds_dst):"memory");}
__device__ __forceinline__ float max3f(float a,float b,float c){float r;asm("v_max3_f32 %0, %1, %2, %3":"=v"(r):"v"(a),"v"(b),"v"(c));return r;}
__device__ __forceinline__ float max2f(float a,float b){float r;asm("v_max_f32_e32 %0, %1, %2":"=v"(r):"v"(a),"v"(b));return r;}
__device__ __forceinline__ float fadd_s(float a,float b){float r;asm("v_add_f32_e32 %0, %1, %2":"=v"(r):"v"(a),"v"(b));return r;}
__device__ __forceinline__ float fsub_s(float a,float b){float r;asm("v_sub_f32_e32 %0, %1, %2":"=v"(r):"v"(a),"v"(b));return r;}
typedef float f32x2_t __attribute__((ext_vector_type(2))); typedef __bf16 bf16x2_t __attribute__((ext_vector_type(2)));
__device__ __forceinline__ unsigned cvtpk_s(float lo,float hi){f32x2_t v={lo,hi};bf16x2_t b=__builtin_convertvector(v,bf16x2_t);return __builtin_bit_cast(unsigned,b);}
#define WAIT_BAR(N) asm volatile("s_waitcnt vmcnt(" #N ") lgkmcnt(0)\n\ts_barrier":::"memory")

__device__ __forceinline__ void qkt(f32x16&p0,f32x16&p1,const char*Kslot,const bf16x8*qr,const f32x16&negm,int r32,int hi){
  const char*kb=Kslot+hi*1024+r32*16;
  #pragma unroll
  for(int d0=0;d0<4;++d0){
    const bf16x8 b0=*reinterpret_cast<const bf16x8*>(kb+d0*2048);
    const bf16x8 b1=*reinterpret_cast<const bf16x8*>(kb+d0*2048+512);
    if(d0==0){p0=__builtin_amdgcn_mfma_f32_32x32x16_bf16(b0,qr[0],negm,0,0,0);p1=__builtin_amdgcn_mfma_f32_32x32x16_bf16(b1,qr[0],negm,0,0,0);}
    else{p0=__builtin_amdgcn_mfma_f32_32x32x16_bf16(b0,qr[d0],p0,0,0,0);p1=__builtin_amdgcn_mfma_f32_32x32x16_bf16(b1,qr[d0],p1,0,0,0);}}
}
typedef __attribute__((address_space(3))) const char* lds_cptr;
typedef __attribute__((address_space(3))) const float* lds_cfptr;
typedef short v4i16_t __attribute__((ext_vector_type(4)));
__device__ __forceinline__ void kload8(bf16x8*kf,lds_cptr kp){
  kf[0]=*(const __attribute__((address_space(3))) bf16x8*)(kp);      kf[1]=*(const __attribute__((address_space(3))) bf16x8*)(kp+512);
  kf[2]=*(const __attribute__((address_space(3))) bf16x8*)(kp+2048); kf[3]=*(const __attribute__((address_space(3))) bf16x8*)(kp+2560);
  kf[4]=*(const __attribute__((address_space(3))) bf16x8*)(kp+4096); kf[5]=*(const __attribute__((address_space(3))) bf16x8*)(kp+4608);
  kf[6]=*(const __attribute__((address_space(3))) bf16x8*)(kp+6144); kf[7]=*(const __attribute__((address_space(3))) bf16x8*)(kp+6656);
}
__device__ __forceinline__ void kload2(bf16x8*kf,lds_cptr kp,int j){ kf[2*j]=*(const __attribute__((address_space(3))) bf16x8*)(kp+j*2048); kf[2*j+1]=*(const __attribute__((address_space(3))) bf16x8*)(kp+j*2048+512); }
__device__ __forceinline__ s16x4 vtr(lds_cptr p){ return __builtin_bit_cast(s16x4,__builtin_amdgcn_ds_read_tr16_b64_v4i16((__attribute__((address_space(3))) v4i16_t*)p)); }
__device__ __forceinline__ float rowmax(const f32x16&p0,const f32x16&p1){
  float a=max3f(p0[0],p0[1],p1[0]),b=max3f(p0[2],p0[3],p1[1]);a=max3f(a,p1[2],p1[3]);
  #pragma unroll
  for(int r=4;r<16;r+=4){a=max3f(a,p0[r],p0[r+1]);b=max3f(b,p0[r+2],p0[r+3]);a=max3f(a,p1[r],p1[r+1]);b=max3f(b,p1[r+2],p1[r+3]);}
  const float m=max2f(a,b);
  auto rr=__builtin_amdgcn_permlane32_swap(__float_as_uint(m),__float_as_uint(m),false,false);
  return max2f(__uint_as_float(rr[0]),__uint_as_float(rr[1]));
}
__device__ __forceinline__ void pv(f32x16*o,int vb,bf16x8 pa0,bf16x8 pa1,bf16x8 pa2,bf16x8 pa3){
  #pragma unroll
  for(int d0=0;d0<2;++d0){s16x4 lo[4],hi[4];
    #pragma unroll
    for(int ks=0;ks<4;++ks){
      asm volatile("ds_read_b64_tr_b16 %0,%1 offset:%c2":"=&v"(lo[ks]):"v"(vb),"i"(d0*4096+ks*1024):"memory");
      asm volatile("ds_read_b64_tr_b16 %0,%1 offset:%c2":"=&v"(hi[ks]):"v"(vb),"i"(d0*4096+ks*1024+512):"memory");}
    asm volatile("s_waitcnt lgkmcnt(0)":::"memory");SBAR();
    #define PK(k) (bf16x8){lo[k][0],lo[k][1],lo[k][2],lo[k][3],hi[k][0],hi[k][1],hi[k][2],hi[k][3]}
    o[d0]=__builtin_amdgcn_mfma_f32_32x32x16_bf16(pa0,PK(0),o[d0],0,0,0);
    o[d0]=__builtin_amdgcn_mfma_f32_32x32x16_bf16(pa1,PK(1),o[d0],0,0,0);
    o[d0]=__builtin_amdgcn_mfma_f32_32x32x16_bf16(pa2,PK(2),o[d0],0,0,0);
    o[d0]=__builtin_amdgcn_mfma_f32_32x32x16_bf16(pa3,PK(3),o[d0],0,0,0);
    #undef PK
  }
}

#ifndef ATTN_STORE16
#define ATTN_STORE16(p,v) (*(u32x4*)(p)=(v))
#endif
template<int THRL> __device__ __forceinline__ void attn_unit(int b,int qoff,int voff,int ooff,int qb,const bf16*Q,const bf16*__restrict__ K,const bf16*__restrict__ V,bf16*O,char*shm,int wv){
  unsigned om_ = ~0u; asm volatile("" : "+s"(om_), "+s"(wv)); int tid_ = wv * 64 + (int)__builtin_amdgcn_mbcnt_hi(om_, __builtin_amdgcn_mbcnt_lo(om_, 0u)); const int tid=tid_,lane=tid&63,r32=lane&31,hi=lane>>5; const int wid=__builtin_amdgcn_readfirstlane(tid>>6);
  const long rowbase=(long)b*ASEQ; const int q0=qb*QB;
  const bf16*Qw=Q+(rowbase+q0+wid*QBLK)*QP+qoff;
  const bf16*Kh=K+rowbase*KP+qoff,*Vh=V+rowbase*VP+voff;
  const unsigned lds0=(unsigned)(uintptr_t)shm;
  float*wsf=(float*)(shm+LDS_WS)+wid*64;
  const bf16*ksrc=Kh+(long)lane*KP+wid*8;
  const bf16*vsrc=Vh+(long)(16*(wid&3)+(lane>>2))*VP+(wid>>2)*32+(lane&3)*8;
  const unsigned kdst=lds0+LDS_K+wid*1024, vdst=lds0+LDS_V+wid*1024;
  #define DMA_K(t,slot) glds16(ksrc+(long)(t)*KVBLK*KP,(unsigned)__builtin_amdgcn_readfirstlane(kdst+(slot)))
  #define DMA_V(t,slot) glds16(vsrc+(long)(t)*KVBLK*VP,(unsigned)__builtin_amdgcn_readfirstlane(vdst+(slot)))
  const int vb0=(int)(lds0+LDS_V)+((lane>>4)&1)*32+(lane&3)*8+(4*hi+((lane&15)>>2))*64;
  const char*Kbase=shm+LDS_K; bf16x8 kf[8];
  const lds_cptr shm3=(lds_cptr)shm; const lds_cfptr btab=(lds_cfptr)(shm3+LDS_BT); const lds_cptr kp0=shm3+LDS_K+hi*1024+r32*16; const lds_cptr vp0=shm3+LDS_V+((lane>>4)&1)*32+(lane&3)*8+(4*hi+((lane&15)>>2))*64;
  const int NTL=(q0+QB)/KVBLK;
  DMA_K(0,0);DMA_V(0,0);DMA_K(1,SLOTB);
  bf16x8 qr[4];
  #pragma unroll
  for(int d0=0;d0<4;++d0)qr[d0]=*reinterpret_cast<const bf16x8*>(&Qw[(long)r32*QP+d0*16+hi*8]);
  float mhat=0.f,l_reg=0.f;f32x16 o[2];o[0]=f32x16{};o[1]=f32x16{};const f32x16 zt=f32x16{};
  const int qrel=wid*QBLK+r32;
  #define CMASK(P0,P1,t) bmask(P0,P1,(t),q0,wid,r32,hi,btab)
  bool resc=false;
  #define START(P0,P1) do{ const float rm=rowmax(P0,P1); resc=false; \
    { const float dl=rm; mhat=fadd_s(mhat,dl); \
      _Pragma("unroll") for(int r=0;r<16;++r){P0[r]=fsub_s(P0[r],dl);P1[r]=fsub_s(P1[r],dl);} \
      } \
    _Pragma("unroll") for(int r=0;r<16;++r)P0[r]=__builtin_amdgcn_exp2f(P0[r]); }while(0)
  #define RESC() do{ if(resc){ asm volatile("s_waitcnt lgkmcnt(0)":::"memory"); \
      _Pragma("unroll") for(int d_=0;d_<2;++d_) _Pragma("unroll") for(int r=0;r<16;++r)o[d_][r]*=wsf[crow(r,hi)]; } }while(0)
  f32x16 pA0,pA1,pB0,pB1;
  int sl_prev=0,sl_cur=0,sl_next=SLOTB;
  #define ROT() do{sl_prev=sl_cur;sl_cur=sl_next;sl_next=(sl_next==(NSLOT-1)*SLOTB)?0:sl_next+SLOTB;}while(0)
  DMA_K(2,2*SLOTB);
  WAIT_BAR(3);
  qkt(pA0,pA1,Kbase,qr,zt,r32,hi);asm volatile("s_nop 15\n\ts_nop 7":"+v"(pA0),"+v"(pA1));CMASK(pA0,pA1,0);
  START(pA0,pA1);
  _Pragma("unroll") for(int r=0;r<16;++r)pA1[r]=__builtin_amdgcn_exp2f(pA1[r]);
  WAIT_BAR(0);
  DMA_K(3,0);DMA_V(1,SLOTB);
  ROT();
  kload8(kf,kp0+sl_cur);
  WAIT_BAR(2);
  s16x4 vlo[8],vhi[8]; u32x4 pw0,pw1,pw2,pw3;
  #define PKW(P,B) cvtpk_s(P[B],P[B+1])
  #define PAF(k) __builtin_bit_cast(bf16x8,pw##k)
  #define VFR(i) (bf16x8){vlo[i][0],vlo[i][1],vlo[i][2],vlo[i][3],vhi[i][0],vhi[i][1],vhi[i][2],vhi[i][3]}
  #define PIN(x) asm volatile("":"+v"(x))
  #define MX3(a,b,c) __builtin_fmaxf(__builtin_fmaxf((a),(b)),(c))
  #define GAPA(MF,A0,A1,A2,A3,W0,W1,PW) do{ MF; sacc+=A0; sacc+=A1; sacc+=A2; sacc+=A3; PIN(sacc); W0; W1; PIN(PW); SBAR(); }while(0)
  #define EX(v) __builtin_amdgcn_exp2f(v)
  #define GAPB(MF,X,B) do{ MF; X[B]=EX(X[B]); X[B+1]=EX(X[B+1]); X[B+2]=EX(X[B+2]); X[B+3]=EX(X[B+3]); PIN(X); SBAR(); }while(0)
  #define VRD(i) do{ vlo[i]=vtr(vp_+(((i)>>2)*4096+((i)&3)*1024)); vhi[i]=vtr(vp_+(((i)>>2)*4096+((i)&3)*1024+512)); }while(0)
  #define KRD(G,j) do{ if(G){ kload2(kf,kp0+sl_next,j); SBAR(); } }while(0)
  #define STEP(C0,C1,P0,P1,t,GK,GV,GL) do{ SBAR(); \
    const lds_cptr vp_=vp0+sl_prev; \
    VRD(0); SBAR(); float sacc=(P0[0]+P0[1]); \
    GAPA(C0=__builtin_amdgcn_mfma_f32_32x32x16_bf16(kf[0],qr[0],zt,0,0,0), P0[2],P0[3],P0[4],P0[5],     pw0[0]=PKW(P0,0), pw0[1]=PKW(P0,2), pw0); \
    VRD(4); SBAR(); GAPA(C1=__builtin_amdgcn_mfma_f32_32x32x16_bf16(kf[1],qr[0],zt,0,0,0), P0[6],P0[7],P0[8],P0[9],     pw0[2]=PKW(P0,4), pw0[3]=PKW(P0,6), pw0); \
    VRD(1); SBAR(); GAPA(C0=__builtin_amdgcn_mfma_f32_32x32x16_bf16(kf[2],qr[1],C0,0,0,0),   P0[10],P0[11],P0[12],P0[13], pw1[0]=PKW(P0,8), pw1[1]=PKW(P0,10), pw1); \
    VRD(5); SBAR(); GAPA(C1=__builtin_amdgcn_mfma_f32_32x32x16_bf16(kf[3],qr[1],C1,0,0,0),   P0[14],P0[15],P1[0],P1[1],   pw1[2]=PKW(P0,12),pw1[3]=PKW(P0,14), pw1); \
    VRD(2); SBAR(); GAPA(C0=__builtin_amdgcn_mfma_f32_32x32x16_bf16(kf[4],qr[2],C0,0,0,0),   P1[2],P1[3],P1[4],P1[5],     pw2[0]=PKW(P1,0), pw2[1]=PKW(P1,2), pw2); \
    VRD(6); SBAR(); GAPA(C1=__builtin_amdgcn_mfma_f32_32x32x16_bf16(kf[5],qr[2],C1,0,0,0),   P1[6],P1[7],P1[8],P1[9],     pw2[2]=PKW(P1,4), pw2[3]=PKW(P1,6), pw2); \
    VRD(3); SBAR(); GAPA(C0=__builtin_amdgcn_mfma_f32_32x32x16_bf16(kf[6],qr[3],C0,0,0,0),   P1[10],P1[11],P1[12],P1[13], pw3[0]=PKW(P1,8), pw3[1]=PKW(P1,10), pw3); \
    VRD(7); SBAR(); GAPA(C1=__builtin_amdgcn_mfma_f32_32x32x16_bf16(kf[7],qr[3],C1,0,0,0),   P1[14],P1[15],0.f,0.f,       pw3[2]=PKW(P1,12),pw3[3]=PKW(P1,14), pw3); \
    l_reg+=sacc; \
    if(GK){DMA_K((t)+3,sl_cur);} if(GV){DMA_V((t)+1,sl_next);} \
    _Pragma("unroll") for(int r=0;r<16;++r){C0[r]-=mhat;C1[r]-=mhat;} \
    CMASK(C0,C1,t); \
    { float a=MX3(C0[0],C0[1],C1[0]),b=MX3(C0[2],C0[3],C1[1]); a=MX3(a,C1[2],C1[3]); \
      _Pragma("unroll") for(int r=4;r<16;r+=4){a=MX3(a,C0[r],C0[r+1]);b=MX3(b,C0[r+2],C0[r+3]);a=MX3(a,C1[r],C1[r+1]);b=MX3(b,C1[r+2],C1[r+3]);} \
      float rm=__builtin_fmaxf(a,b); { auto rr=__builtin_amdgcn_permlane32_swap(__float_as_uint(rm),__float_as_uint(rm),false,false); rm=__builtin_fmaxf(__uint_as_float(rr[0]),__uint_as_float(rr[1])); } \
      resc=false; \
      if(__builtin_expect(__any(rm>(float)THRL),0)){ const float dl=__builtin_fmaxf(rm,0.f); mhat+=dl; \
        _Pragma("unroll") for(int r=0;r<16;++r){C0[r]-=dl;C1[r]-=dl;} \
        const float f=__builtin_amdgcn_exp2f(-dl); l_reg*=f; if(hi==0)wsf[r32]=f; resc=true; } } \
    SBAR(); \
    GAPB(o[0]=__builtin_amdgcn_mfma_f32_32x32x16_bf16(PAF(0),VFR(0),o[0],0,0,0), C0,0); \
    GAPB(o[1]=__builtin_amdgcn_mfma_f32_32x32x16_bf16(PAF(0),VFR(4),o[1],0,0,0), C0,4); \
    KRD(GL,0); GAPB(o[0]=__builtin_amdgcn_mfma_f32_32x32x16_bf16(PAF(1),VFR(1),o[0],0,0,0), C0,8); \
    KRD(GL,1); GAPB(o[1]=__builtin_amdgcn_mfma_f32_32x32x16_bf16(PAF(1),VFR(5),o[1],0,0,0), C0,12); \
    KRD(GL,2); GAPB(o[0]=__builtin_amdgcn_mfma_f32_32x32x16_bf16(PAF(2),VFR(2),o[0],0,0,0), C1,0); \
    KRD(GL,3); GAPB(o[1]=__builtin_amdgcn_mfma_f32_32x32x16_bf16(PAF(2),VFR(6),o[1],0,0,0), C1,4); \
    GAPB(o[0]=__builtin_amdgcn_mfma_f32_32x32x16_bf16(PAF(3),VFR(3),o[0],0,0,0), C1,8); \
    GAPB(o[1]=__builtin_amdgcn_mfma_f32_32x32x16_bf16(PAF(3),VFR(7),o[1],0,0,0), C1,12); \
    }while(0)
  int t=1;
  #undef CMASK
  #define CMASK(P0,P1,t) do{}while(0)
  for(;t+7<NTL;t+=2){
    STEP(pB0,pB1,pA0,pA1,t,true,true,true);     WAIT_BAR(2); RESC(); ROT();
    STEP(pA0,pA1,pB0,pB1,t+1,true,true,true);   WAIT_BAR(2); RESC(); ROT();
  }
  #undef CMASK
  #define CMASK(P0,P1,t) bmask(P0,P1,(t),q0,wid,r32,hi,btab)
  #define ENDW(tt) do{ if((tt)+3<NTL){WAIT_BAR(2);} else if((tt)+2<NTL){WAIT_BAR(1);} else {WAIT_BAR(0);} }while(0)
  for(;t+1<NTL;t+=2){
    STEP(pB0,pB1,pA0,pA1,t,(t+3<NTL),(t+1<NTL),(t+1<NTL));       ENDW(t);   RESC(); ROT();
    STEP(pA0,pA1,pB0,pB1,t+1,(t+4<NTL),(t+2<NTL),(t+2<NTL));     ENDW(t+1); RESC(); ROT();
  }
  STEP(pB0,pB1,pA0,pA1,NTL-1,false,false,false); RESC();
  { float sacc=pB0[0]+pB0[1]; _Pragma("unroll") for(int r=2;r<16;++r)sacc+=pB0[r]; _Pragma("unroll") for(int r=0;r<16;++r)sacc+=pB1[r]; l_reg+=sacc;
    pw0=(u32x4){PKW(pB0,0),PKW(pB0,2),PKW(pB0,4),PKW(pB0,6)};pw1=(u32x4){PKW(pB0,8),PKW(pB0,10),PKW(pB0,12),PKW(pB0,14)};pw2=(u32x4){PKW(pB1,0),PKW(pB1,2),PKW(pB1,4),PKW(pB1,6)};pw3=(u32x4){PKW(pB1,8),PKW(pB1,10),PKW(pB1,12),PKW(pB1,14)};
    SBAR(); pv(o,vb0+sl_cur,PAF(0),PAF(1),PAF(2),PAF(3)); }
  #undef PKW
  #undef PAF
  #undef VFR
  #undef PIN
  #undef MX3
  #undef GAPA
  #undef GAPB
  #undef EX
  #undef VRD
  #undef KRD
  #undef STEP
  #undef ENDW
  {auto rr=__builtin_amdgcn_permlane32_swap(__float_as_uint(l_reg),__float_as_uint(l_reg),false,false);l_reg=__uint_as_float(rr[0])+__uint_as_float(rr[1]);}
  if(hi==0)wsf[32+r32]=l_reg;asm volatile("s_waitcnt lgkmcnt(0)":::"memory");
  float rli[16];
  #pragma unroll
  for(int r=0;r<16;++r)rli[r]=__builtin_amdgcn_rcpf(wsf[32+crow(r,hi)]);
  bf16*Ow=O+(rowbase+q0+wid*QBLK)*OP+ooff;
  { bf16*stg=(bf16*)(shm+LDS_OST)+wid*2048;
    #pragma unroll
    for(int r=0;r<16;++r){const int orow=crow(r,hi);
      #pragma unroll
      for(int d0=0;d0<2;++d0)stg[orow*64+d0*32+r32]=__float2bfloat16(o[d0][r]*rli[r]);}
    asm volatile("s_waitcnt lgkmcnt(0)":::"memory");
    #pragma unroll
    for(int i=0;i<4;++i){const int row=i*8+(lane>>3),ch=lane&7; const u32x4 v=*(const u32x4*)(stg+row*64+ch*8); ATTN_STORE16(Ow+(long)row*OP+ch*8,v);} }
  asm volatile("s_waitcnt lgkmcnt(0)\n\ts_barrier":::"memory");
  #undef DMA_K
  #undef DMA_V
  #undef CMASK
  #undef START
  #undef RESC
  #undef ROT
}
constexpr int ATTN_LDS_BYTES=LDS_BYTES;
#undef SBAR
#undef WAIT_BAR
#undef WAIT_BAR
}
namespace mk {
#define GAS __attribute__((address_space(1)))
#define LAS __attribute__((address_space(3)))
typedef unsigned short bf16;
typedef unsigned v4u __attribute__((ext_vector_type(4)));
typedef unsigned v2u __attribute__((ext_vector_type(2)));
typedef float f32x4 __attribute__((ext_vector_type(4)));
typedef float f32x16 __attribute__((ext_vector_type(16)));
typedef short bf16x8 __attribute__((ext_vector_type(8)));
typedef GAS unsigned gu32;
#define RLX_AGENT __ATOMIC_RELAXED, __HIP_MEMORY_SCOPE_AGENT
#define LDS_WAIT() asm volatile("s_waitcnt lgkmcnt(0)" ::: "memory")
#define VM_WAIT() asm volatile("s_waitcnt vmcnt(0)" ::: "memory")
typedef float f32x2_cv __attribute__((ext_vector_type(2))); typedef __bf16 bf16x2_cv __attribute__((ext_vector_type(2)));
__device__ __forceinline__ unsigned pk2(float lo, float hi) { const f32x2_cv v = {lo, hi}; return __builtin_bit_cast(unsigned, __builtin_convertvector(v, bf16x2_cv)); }
__device__ __forceinline__ unsigned f2bf(float f) { return pk2(f, 0.f) & 0xffffu; }
__device__ __forceinline__ float bf2f(unsigned short b) { return __builtin_bit_cast(float, ((unsigned)b) << 16); }
__device__ __forceinline__ float bflo(unsigned w) { return __builtin_bit_cast(float, w << 16); }
__device__ __forceinline__ float bfhi(unsigned w) { return __builtin_bit_cast(float, w & 0xffff0000u); }

constexpr int NWAVES = 8, NTHR = NWAVES * 64;
constexpr int PADF = 48;
constexpr int LPP = 8448;
constexpr int PEND = PADF + LP;
constexpr int SROW0 = BATCH * LPP;
constexpr int RP = SROW0 + NS;
constexpr int ZN = 7424;
constexpr int ZC_QA = 0, ZC_KA = 512, ZC_VA = 1024, ZC_QKVB = 1536, ZC_GB = 3072, ZC_UC = 3584, ZC_GATE = 4096, ZC_BA = 7168;
static_assert(RP % 256 == 0 && ZN % 256 == 0 && D_MODEL == 1024 && WIDTH_A == 512 && WIDTH_B == 512 && WIDTH_C == 512, "shapes");
__host__ __device__ __forceinline__ int nat2prow(int row) { return row < NP ? (row / LP) * LPP + PADF + row % LP : SROW0 + (row - NP); }
__host__ __device__ __forceinline__ int zcol(int col) { return col < 3584 ? col : (col < 3592 ? ZC_BA + (col - 3584) : col - 8); }
__device__ __forceinline__ bool prow_valid(int prow) { if (prow >= SROW0) return true; const int p = prow % LPP; return p >= PADF && p < PEND; }
__device__ __forceinline__ int prow2nat(int prow) { if (prow >= SROW0) return NP + (prow - SROW0); return (prow / LPP) * LP + (prow % LPP) - PADF; }

constexpr int RING_OFF = 0, RING_BYTES = 147456;
constexpr int LDSCTL_OFF = RING_BYTES, MISC_OFF = LDSCTL_OFF + 320;
constexpr int LDS_BYTES = RING_BYTES + 1024;
static_assert(MISC_OFF + 128 <= LDS_BYTES, "LDS map");

constexpr size_t CTL_BYTES = 1u << 20;
constexpr int CW_TMO = 0, CW_CODE = 1;
constexpr int CW_BAR = 4096;
constexpr int CW_QUEUE = 16384;
constexpr int CW_GDNFLAG = 32768;

__device__ __forceinline__ int lane_id() { return (int)__builtin_amdgcn_mbcnt_hi(~0u, __builtin_amdgcn_mbcnt_lo(~0u, 0u)); }
#define XB_TMO      128
#define XB_XCNT(j)  (256  + 64 * (j))
#define XB_XSUB(j)  (1280 + 64 * (j))
#define XB_XGEN(j)  (2304 + 64 * (j))
#define XB_TOP      3328
#define XB_TOPGEN   3392
#define XCD_BAR_WORDS 3456
#define XB_SPIN_CAP (1u << 18)

__device__ __forceinline__ unsigned xb_ld(unsigned* p)              { return __hip_atomic_load(p, __ATOMIC_RELAXED, __HIP_MEMORY_SCOPE_AGENT); }
__device__ __forceinline__ unsigned xb_add(unsigned* p, unsigned v) { return __hip_atomic_fetch_add(p, v, __ATOMIC_RELAXED, __HIP_MEMORY_SCOPE_AGENT); }
__device__ __forceinline__ unsigned xb_xcc_id() { return (unsigned)__builtin_amdgcn_s_getreg((3 << 11) | 20) & 0xFu; }
#define XB_SPIN(cond, bar) do { unsigned _sp = 0; while (cond) { __builtin_amdgcn_s_sleep(1); \
    if ((++_sp & 255u) == 0u) { if (xb_ld(&(bar)[XB_TMO])) break; if (_sp > XB_SPIN_CAP) { atomicAdd(&(bar)[XB_TMO], 1u); break; } } } } while (0)

struct XcdBarrier {
    unsigned* bar; unsigned x; int wv;
    volatile LAS unsigned* st;
};

__device__ __forceinline__ XcdBarrier xcd_barrier_post(unsigned* bar, volatile LAS unsigned* st, int wv) {
    XcdBarrier b; b.bar = bar; b.x = xb_xcc_id(); b.st = st; b.wv = wv;
    if (wv == 0 && lane_id() == 0) (void)xb_add(&bar[XB_XCNT(b.x)], 1u);
    return b;
}
__device__ __forceinline__ void xcd_barrier_complete(unsigned* bar, unsigned x, unsigned& nloc, unsigned& nx) {
    const unsigned G = gridDim.x * gridDim.y * gridDim.z;
    unsigned sum, cnt, mine, sp = 0u;
    for (;;) {
        sum = 0u; cnt = 0u; mine = 0u;
#pragma unroll
        for (unsigned j = 0; j < 16; ++j) { const unsigned c = xb_ld(&bar[XB_XCNT(j)]); sum += c; cnt += (c > 0u) ? 1u : 0u; mine = (j == x) ? c : mine; }
        if (sum == G) break;
        __builtin_amdgcn_s_sleep(1);
        if ((++sp & 255u) == 0u) { if (xb_ld(&bar[XB_TMO])) break; if (sp > XB_SPIN_CAP) { atomicAdd(&bar[XB_TMO], 1u); break; } }
    }
    nloc = mine > 0u ? mine : 1u; nx = cnt > 0u ? cnt : 1u;
}

__device__ __forceinline__ void xcd_barrier(const XcdBarrier& b) {
    asm volatile("s_waitcnt vmcnt(0)" ::: "memory");
    __syncthreads();
    if (b.wv == 0 && lane_id() == 0) {
        unsigned* bar = b.bar;
        __builtin_amdgcn_s_waitcnt(0);
        unsigned nloc = b.st[0], nx = b.st[1];
        if (nloc == 0u) { xcd_barrier_complete(bar, b.x, nloc, nx); b.st[0] = nloc; b.st[1] = nx; }
        const unsigned old = xb_add(&bar[XB_XSUB(b.x)], 1u);
        const unsigned gen = old / nloc;
        if (old + 1u == (gen + 1u) * nloc) {
            __builtin_amdgcn_fence(__ATOMIC_RELEASE, "agent");
            asm volatile("s_waitcnt vmcnt(0)" ::: "memory");
            const unsigned og = xb_add(&bar[XB_TOP], 1u);
            const unsigned tg = og / nx;
            if (og + 1u == (tg + 1u) * nx) xb_add(&bar[XB_TOPGEN], 1u);
            else XB_SPIN(xb_ld(&bar[XB_TOPGEN]) == tg, bar);
            __builtin_amdgcn_fence(__ATOMIC_ACQUIRE, "agent");
            xb_add(&bar[XB_XGEN(b.x)], 1u);
            asm volatile("s_waitcnt vmcnt(0)" ::: "memory");
        } else {
            XB_SPIN(xb_ld(&bar[XB_XGEN(b.x)]) == gen, bar);
            __builtin_amdgcn_fence(__ATOMIC_ACQUIRE, "agent");
            asm volatile("s_waitcnt vmcnt(0)" ::: "memory");
        }
    }
    __syncthreads();
}


template <int CTRL> __device__ __forceinline__ float dpp_f(float v) { return __builtin_bit_cast(float, __builtin_amdgcn_update_dpp(0, __builtin_bit_cast(int, v), CTRL, 0xf, 0xf, true)); }
template <int CTRL> __device__ __forceinline__ int dpp_i(int v) { return __builtin_amdgcn_update_dpp(0, v, CTRL, 0xf, 0xf, true); }
template <int CTRL, int ROWMASK> __device__ __forceinline__ float dpp_fm(float v) { return __builtin_bit_cast(float, __builtin_amdgcn_update_dpp(0, __builtin_bit_cast(int, v), CTRL, ROWMASK, 0xf, false)); }
__device__ __forceinline__ float rdlane(float v, int i) { return __builtin_bit_cast(float, __builtin_amdgcn_readlane(__builtin_bit_cast(int, v), i)); }
__device__ __forceinline__ float sum8(float v) { v += dpp_f<0xB1>(v); v += dpp_f<0x4E>(v); v += dpp_f<0x141>(v); return v; }
__device__ __forceinline__ float sum16(float v) { v = sum8(v); v += dpp_f<0x140>(v); return v; }
__device__ __forceinline__ float wave_sum(float v) { v = sum16(v); return rdlane(v, 0) + rdlane(v, 16) + rdlane(v, 32) + rdlane(v, 48); }
__device__ __forceinline__ float wave_max(float v) {
    v = fmaxf(v, dpp_f<0xB1>(v)); v = fmaxf(v, dpp_f<0x4E>(v)); v = fmaxf(v, dpp_f<0x141>(v)); v = fmaxf(v, dpp_f<0x140>(v));
    return fmaxf(fmaxf(rdlane(v, 0), rdlane(v, 16)), fmaxf(rdlane(v, 32), rdlane(v, 48)));
}
__device__ __forceinline__ float scan64(float v) {
    v += dpp_f<0x111>(v); v += dpp_f<0x112>(v); v += dpp_f<0x114>(v); v += dpp_f<0x118>(v);
    v += dpp_fm<0x142, 0xA>(v); v += dpp_fm<0x143, 0xC>(v);
    return v;
}
__device__ __forceinline__ float swap32(float v) {
    const auto r = __builtin_amdgcn_permlane32_swap(__builtin_bit_cast(unsigned, v), __builtin_bit_cast(unsigned, v), false, false);
    return __builtin_bit_cast(float, (lane_id() & 32) ? r[0] : r[1]);
}
__device__ __forceinline__ float swap16(float v) {
    const auto r = __builtin_amdgcn_permlane16_swap(__builtin_bit_cast(unsigned, v), __builtin_bit_cast(unsigned, v), false, false);
    return __builtin_bit_cast(float, (lane_id() & 16) ? r[0] : r[1]);
}
}
namespace mk {
enum Region { R_X, R_XN, R_WIN, R_Z, R_QN, R_KN, R_QKVB, R_BG, R_O, R_OA, R_OB, R_YC, R_OC, R_MRG, R_WGLU, R_WBR, R_WOUT, R_WQS, R_PU, R_PV, R_SC, R_GDN, R_S5T, R_MISC, R_S5E, R_S5X, R_MRGB, R_OBN, R_MRG2, R_NREG };
constexpr int NPL = 16;
enum Phase { PH_PRO = 0, PL_NORM1 = 0, PL_GEMM_IN = 1, PL_ZPOST = 2, PL_LOCAL = 3, PL_MIX = 4, PL_MIXPOST = 5, PL_GEMM_GLU = 6, PL_GEMM_BRA = 7, PL_GEMM_BRB = 8, PL_GEMM_BRC = 9,
             PL_GEMM_OUT = 10, PL_NORM2 = 11, PL_GEMM_PEER = 12, PL_PEER = 13, PH_FINAL = 1 + DEPTH * NPL, PH_END = PH_FINAL + 1 };
enum ProMask { PM_NORM0 = 64, PM_X = 1, PM_WIN = 2, PM_WREST = 4, PM_PEERW = 8, PM_WQS = 16, PM_TABLES = 32 };
struct Args {
    const float* in[40];
    float* out;
    unsigned char* ws;
    unsigned long long off[32];
    int ph_lo, ph_hi, pro_mask, bar_region;
};
static_assert(sizeof(Args) == 40 * 8 + 8 + 8 + 32 * 8 + 16, "Args has no padding");

typedef const __attribute__((address_space(4))) Args* KArgs;
__device__ __forceinline__ KArgs kargs() { KArgs p = (KArgs)__builtin_amdgcn_kernarg_segment_ptr(); asm volatile("" : "+s"(p)); return p; }
__device__ __forceinline__ void assume_global(const void* p) {
#if defined(__HIP_DEVICE_COMPILE__)
    __builtin_assume(!__builtin_amdgcn_is_shared(p) && !__builtin_amdgcn_is_private(p));
#endif
}
#define GIN(a, i) ((const float*)(const GAS float*)(a).in[i])
#define GOUT(a) ((float*)(GAS float*)(a).out)
#define WS_OPAQUE(a) GAS unsigned char* wsg_ = (GAS unsigned char*)(a).ws; asm volatile("" : "+s"(wsg_)); unsigned char* wsb = (unsigned char*)wsg_
#define otid() otid_(F.wv)
__device__ __forceinline__ int otid_(int wv) { unsigned m = ~0u; asm volatile("" : "+s"(m), "+s"(wv));
    return wv * 64 + (int)__builtin_amdgcn_mbcnt_hi(m, __builtin_amdgcn_mbcnt_lo(m, 0u)); }
struct Frame {
    LAS unsigned char* lds; volatile LAS unsigned* MISC; gu32* ctl;
    int vcu, G, wv;
};

struct TrItem { f32x4 v[8]; };
template <class CM> __device__ __forceinline__ void tr_load(TrItem& t, const float* W, int ld, int n0, int k0, const CM& cm, int lane) {
    const int sc = cm(n0 + 4 * (lane & 7)), kr = lane >> 3;
    const GAS float* Wg = (const GAS float*)W;
#pragma unroll
    for (int i = 0; i < 8; ++i) t.v[i] = sc >= 0 ? *(const GAS f32x4*)(Wg + (size_t)(k0 + 8 * i + kr) * ld + sc) : (f32x4){0.f, 0.f, 0.f, 0.f};
}
__device__ __forceinline__ void tr_store(const TrItem& t, int K, bf16* WT, int n0, int k0, LAS float* scr, int lane) {
    { const int q = lane & 7, kr = lane >> 3;
#pragma unroll
      for (int i = 0; i < 8; ++i) { LAS float* d = scr + (8 * i + kr) * 33 + 4 * q; d[0] = t.v[i].x; d[1] = t.v[i].y; d[2] = t.v[i].z; d[3] = t.v[i].w; } }
    LDS_WAIT(); asm volatile("" ::: "memory");
    const int c = lane & 7;
#pragma unroll
    for (int j = 0; j < 4; ++j) { const int n = (lane >> 3) + 8 * j; const LAS float* s = scr + (8 * c) * 33 + n;
        v4u o; o.x = pk2(s[0 * 33], s[1 * 33]); o.y = pk2(s[2 * 33], s[3 * 33]); o.z = pk2(s[4 * 33], s[5 * 33]); o.w = pk2(s[6 * 33], s[7 * 33]);
        *(GAS v4u*)(WT + (size_t)(n0 + n) * K + k0 + 8 * c) = o; }
    LDS_WAIT(); asm volatile("" ::: "memory");
}
struct CmWin { __device__ __forceinline__ int operator()(int n) const { return n < 3584 ? n : (n < 7168 ? n + 8 : (n < 7176 ? 3584 + (n - 7168) : -1)); } };
struct CmId { __device__ __forceinline__ int operator()(int n) const { return n; } };
struct CmGlu { __device__ __forceinline__ int operator()(int n) const { const int G = n >> 5, i = n & 31; return i < 16 ? 16 * G + i : 512 + 16 * G + (i - 16); } };

__device__ __forceinline__ void rms_row_to_bf16(const float* xrow, const float* g, bf16* orow, int lane) {
    const GAS f32x4* xr = (const GAS f32x4*)xrow + lane;
    f32x4 v[4]; float s2 = 0.f;
#pragma unroll
    for (int j = 0; j < 4; ++j) { v[j] = xr[64 * j]; s2 += (v[j].x * v[j].x + v[j].y * v[j].y) + (v[j].z * v[j].z + v[j].w * v[j].w); }
    const float r = __builtin_amdgcn_rsqf(wave_sum(s2) * (1.f / D_MODEL) + EPSF);
    const GAS f32x4* gr = (const GAS f32x4*)g + lane;
    GAS unsigned long long* o8 = (GAS unsigned long long*)orow + lane;
#pragma unroll
    for (int j = 0; j < 4; ++j) { const f32x4 gg = gr[64 * j];
        o8[64 * j] = (unsigned long long)pk2(v[j].x * r * gg.x, v[j].y * r * gg.y) | ((unsigned long long)pk2(v[j].z * r * gg.z, v[j].w * r * gg.w) << 32); }
}

__device__ __forceinline__ void p_norm(Frame& F, int l, int gi) {
    const KArgs ap = kargs(); const auto& a = *ap; WS_OPAQUE(a);
    const int tid = otid(), lane = tid & 63, wave = __builtin_amdgcn_readfirstlane(tid >> 6);
    const float* X = (const float*)(wsb + a.off[R_X]); bf16* XN = (bf16*)(wsb + a.off[R_XN]); const float* g = GIN(a, gi) + (size_t)l * D_MODEL;
    const int gw = F.vcu * NWAVES + wave, NGW = F.G * NWAVES;
    for (int m = gw; m < RP; m += NGW) rms_row_to_bf16(X + (size_t)m * D_MODEL, g, XN + (size_t)m * D_MODEL, lane);
}
__device__ __forceinline__ void p_norm0(Frame& F) {
    const KArgs ap = kargs(); const auto& a = *ap; WS_OPAQUE(a);
    const int tid = otid(), lane = tid & 63, wave = __builtin_amdgcn_readfirstlane(tid >> 6);
    float* X = (float*)(wsb + a.off[R_X]); bf16* XN = (bf16*)(wsb + a.off[R_XN]);
    const int gw = F.vcu * NWAVES + wave, NGW = F.G * NWAVES;
    f32x4 gg[4];
#pragma unroll
    for (int j = 0; j < 4; ++j) gg[j] = ((const GAS f32x4*)GIN(a, I_N1))[lane + 64 * j];
#define N0_SRC(m_, s_) do { s_ = nullptr; if ((m_) < RP) { if ((m_) >= SROW0) s_ = GIN(a, I_XS) + (size_t)((m_) - SROW0) * D_MODEL; \
        else { const int b_ = (m_) / LPP, p_ = (m_) % LPP; if (p_ >= PADF && p_ < PEND) { const int pos_ = p_ - PADF; s_ = pos_ < N_META ? GIN(a, I_META) + (size_t)pos_ * D_MODEL : GIN(a, I_XP) + ((size_t)b_ * SEQ + pos_ - N_META) * D_MODEL; } } } } while (0)
#define N0_OUT(m_, v_) do { if ((m_) < RP) { float s2_ = 0.f; _Pragma("unroll") for (int j = 0; j < 4; ++j) s2_ += (v_[j].x * v_[j].x + v_[j].y * v_[j].y) + (v_[j].z * v_[j].z + v_[j].w * v_[j].w); \
        const float r_ = __builtin_amdgcn_rsqf(wave_sum(s2_) * (1.f / D_MODEL) + EPSF); \
        GAS f32x4* o_ = (GAS f32x4*)(X + (size_t)(m_) * D_MODEL) + lane; GAS unsigned long long* o8_ = (GAS unsigned long long*)(XN + (size_t)(m_) * D_MODEL) + lane; \
        _Pragma("unroll") for (int j = 0; j < 4; ++j) { o_[64 * j] = v_[j]; \
            o8_[64 * j] = (unsigned long long)pk2(v_[j].x * r_ * gg[j].x, v_[j].y * r_ * gg[j].y) | ((unsigned long long)pk2(v_[j].z * r_ * gg[j].z, v_[j].w * r_ * gg[j].w) << 32); } } } while (0)
    for (int m = gw; m < RP; m += 2 * NGW) {
        const int m2 = m + NGW; const float* sa; const float* sb; N0_SRC(m, sa); N0_SRC(m2, sb);
        f32x4 va[4], vb[4];
#pragma unroll
        for (int j = 0; j < 4; ++j) va[j] = sa ? ((const GAS f32x4*)sa)[lane + 64 * j] : (f32x4){0.f, 0.f, 0.f, 0.f};
#pragma unroll
        for (int j = 0; j < 4; ++j) vb[j] = sb ? ((const GAS f32x4*)sb)[lane + 64 * j] : (f32x4){0.f, 0.f, 0.f, 0.f};
        N0_OUT(m, va); N0_OUT(m2, vb);
    }
#undef N0_SRC
#undef N0_OUT
}
__device__ __forceinline__ void unpack8(const v4u w, float (&f)[8]) { f[0] = bflo(w.x); f[1] = bfhi(w.x); f[2] = bflo(w.y); f[3] = bfhi(w.y); f[4] = bflo(w.z); f[5] = bfhi(w.z); f[6] = bflo(w.w); f[7] = bfhi(w.w); }
__device__ __forceinline__ v4u pack8(const float (&f)[8]) { v4u w; w.x = pk2(f[0], f[1]); w.y = pk2(f[2], f[3]); w.z = pk2(f[4], f[5]); w.w = pk2(f[6], f[7]); return w; }
__device__ __forceinline__ float sigm(float x) { return __builtin_amdgcn_rcpf(1.f + __expf(-x)); }
constexpr float ATT_C2 = 0.125f * 1.4426950408889634f;
__device__ __forceinline__ void p_zpost(Frame& F, int l) {
    const KArgs ap = kargs(); const auto& a = *ap; WS_OPAQUE(a);
    const bf16* Z = (const bf16*)(wsb + a.off[R_Z]);
    bf16* QN = (bf16*)(wsb + a.off[R_QN]); bf16* KN = (bf16*)(wsb + a.off[R_KN]); bf16* QKVB = (bf16*)(wsb + a.off[R_QKVB]); float* BG = (float*)(wsb + a.off[R_BG]);
    const int tid = otid(), lane = tid & 63, wave = __builtin_amdgcn_readfirstlane(tid >> 6);
    const int gw = F.vcu * NWAVES + wave, NGW = F.G * NWAVES;
    float gq[8], gk[8], cw[3][4][8];
#pragma unroll
    for (int j = 0; j < 8; ++j) { gq[j] = GIN(a, I_QN)[l * HEAD_DIM_A + 8 * (lane & 7) + j] * ATT_C2; gk[j] = GIN(a, I_KN)[l * HEAD_DIM_A + 8 * (lane & 7) + j]; }
#pragma unroll
    for (int w = 0; w < 3; ++w)
#pragma unroll
        for (int i = 0; i < 4; ++i)
#pragma unroll
            for (int j = 0; j < 8; ++j) cw[w][i][j] = GIN(a, I_CONVW)[((size_t)l * CONV_W + i) * 3 * WIDTH_B + w * WIDTH_B + 8 * lane + j];
    float alog = 0.f, dtb = 0.f; if (lane < 4) { alog = GIN(a, I_ALOG)[l * N_HEADS_B + lane]; dtb = GIN(a, I_DTB)[l * N_HEADS_B + lane]; }
    for (int m = gw; m < RP; m += NGW) {
        const bool valid = prow_valid(m); const int nat = valid ? prow2nat(m) : 0;
        const bf16* zr = Z + (size_t)m * ZN;
        float f[8], o[8];
        const v4u Lq = *(const GAS v4u*)(zr + ZC_QA + 8 * lane), Lk = *(const GAS v4u*)(zr + ZC_KA + 8 * lane), Lv = *(const GAS v4u*)(zr + ZC_VA + 8 * lane);
        v4u Lc[3][4];
#pragma unroll
        for (int w = 0; w < 3; ++w)
#pragma unroll
            for (int i = 0; i < 4; ++i) { const int mm = m + i - 3 < 0 ? 0 : m + i - 3; Lc[w][i] = *(const GAS v4u*)(Z + (size_t)mm * ZN + ZC_QKVB + w * WIDTH_B + 8 * lane); }
        const unsigned short Lbe = zr[ZC_BA + (lane & 3)], Lal = zr[ZC_BA + 4 + (lane & 3)];
        unpack8(Lq, f);
        { float ss = 0.f;
#pragma unroll
          for (int j = 0; j < 8; ++j) ss += f[j] * f[j];
          ss = sum8(ss);
          const float r = __builtin_amdgcn_rsqf(ss * (1.f / HEAD_DIM_A) + EPSF);
#pragma unroll
          for (int j = 0; j < 8; ++j) o[j] = f[j] * r * gq[j];
          *(GAS v4u*)(QN + (size_t)m * WIDTH_A + 8 * lane) = pack8(o); }
        unpack8(Lk, f);
        { float ss = 0.f;
#pragma unroll
          for (int j = 0; j < 8; ++j) ss += f[j] * f[j];
          ss = sum8(ss);
          const float r = __builtin_amdgcn_rsqf(ss * (1.f / HEAD_DIM_A) + EPSF);
#pragma unroll
          for (int j = 0; j < 8; ++j) o[j] = f[j] * r * gk[j];
          *(GAS v4u*)(KN + (size_t)m * WIDTH_A + 8 * lane) = pack8(o);
          if (valid) { float* ko = nat < NP ? GOUT(a) + O_KP + ((size_t)l * NP + nat) * WIDTH_A : GOUT(a) + O_KS + ((size_t)l * NS + (nat - NP)) * WIDTH_A;
              *(GAS f32x4*)(ko + 8 * lane) = (f32x4){o[0], o[1], o[2], o[3]}; *(GAS f32x4*)(ko + 8 * lane + 4) = (f32x4){o[4], o[5], o[6], o[7]}; } }
        if (valid) { unpack8(Lv, f);
            float* vo = nat < NP ? GOUT(a) + O_VP + ((size_t)l * NP + nat) * WIDTH_A : GOUT(a) + O_VS + ((size_t)l * NS + (nat - NP)) * WIDTH_A;
            *(GAS f32x4*)(vo + 8 * lane) = (f32x4){f[0], f[1], f[2], f[3]}; *(GAS f32x4*)(vo + 8 * lane + 4) = (f32x4){f[4], f[5], f[6], f[7]}; }
        const int ts = m >= SROW0 ? (m - SROW0) % DEC_SEQ : 1000; const int bs = m >= SROW0 ? (m - SROW0) / DEC_SEQ : 0;
        int cj = -1;
        if (m >= SROW0) { if (ts >= DEC_SEQ - 3) cj = ts - (DEC_SEQ - 3); } else { const int p = m % LPP; if (p >= PEND - 3 && p < PEND) cj = p - (PEND - 3); }
#pragma unroll
        for (int w = 0; w < 3; ++w) {
            float acc[8];
#pragma unroll
            for (int j = 0; j < 8; ++j) acc[j] = 0.f;
#pragma unroll
            for (int i = 0; i < 4; ++i) {
                const int dt = i - 3;
                if (ts + dt < 0) {
                    const float* sc = GIN(a, I_SCONV) + (((size_t)l * DEC_BATCH + bs) * (CONV_W - 1) + (CONV_W - 1 + ts + dt)) * 3 * WIDTH_B + w * WIDTH_B + 8 * lane;
                    const f32x4 s0 = *(const GAS f32x4*)sc, s1 = *(const GAS f32x4*)(sc + 4);
                    f[0] = s0.x; f[1] = s0.y; f[2] = s0.z; f[3] = s0.w; f[4] = s1.x; f[5] = s1.y; f[6] = s1.z; f[7] = s1.w;
                } else unpack8(Lc[w][i], f);
#pragma unroll
                for (int j = 0; j < 8; ++j) acc[j] += f[j] * cw[w][i][j];
                if (i == 3 && cj >= 0) {
                    float* co = m >= SROW0 ? GOUT(a) + O_CS + (((size_t)l * DEC_BATCH + bs) * (CONV_W - 1) + cj) * 3 * WIDTH_B : GOUT(a) + O_CP + (((size_t)l * BATCH + m / LPP) * (CONV_W - 1) + cj) * 3 * WIDTH_B;
                    *(GAS f32x4*)(co + w * WIDTH_B + 8 * lane) = (f32x4){f[0], f[1], f[2], f[3]}; *(GAS f32x4*)(co + w * WIDTH_B + 8 * lane + 4) = (f32x4){f[4], f[5], f[6], f[7]}; }
            }
            float ss = 0.f;
#pragma unroll
            for (int j = 0; j < 8; ++j) { acc[j] = acc[j] * sigm(acc[j]); ss += acc[j] * acc[j]; }
            float sc = 1.f;
            if (w < 2) { ss = sum16(ss);
                sc = __builtin_amdgcn_rsqf(ss + EPSF); if (w == 0) sc *= 0.08838834764831845f; }
#pragma unroll
            for (int j = 0; j < 8; ++j) o[j] = acc[j] * sc;
            *(GAS v4u*)(QKVB + (size_t)m * 3 * WIDTH_B + w * WIDTH_B + 8 * lane) = pack8(o);
        }
        if (lane < 4) { const float be = bf2f(Lbe), al = bf2f(Lal) + dtb;
            const float sp = al > 20.f ? al : __logf(1.f + __expf(al));
            BG[(size_t)m * 8 + lane] = valid ? sigm(be) : 0.f; BG[(size_t)m * 8 + 4 + lane] = valid ? -__expf(alog) * sp : 0.f; }
    }
}
constexpr float LOG2E = 1.4426950408889634f;
__device__ __forceinline__ int t5_bucket_dev(int rel) {
    const int n = rel < 0 ? -rel : rel; int b;
    if (n < 8) b = n; else if (n < 12) b = 8; else if (n < 16) b = 9; else if (n < 23) b = 10; else if (n < 32) b = 11;
    else if (n < 46) b = 12; else if (n < 64) b = 13; else if (n < 91) b = 14; else b = 15;
    return b + (rel > 0 ? 16 : 0);
}
__device__ __forceinline__ void build_bias_table(LAS float* tab, const float* rel_bias, int h, int tid) {
    const float far = rel_bias[15 * N_HEADS_A + h];
    for (int i = tid; i < attn_body::BT_N; i += NTHR) tab[i] = (rel_bias[t5_bucket_dev(i - attn_body::BT_OFF) * N_HEADS_A + h] - far) * LOG2E;
}
__device__ __forceinline__ float lam_init_dev(int l) { return 0.8f - 0.6f * __expf(-0.3f * (float)l); }
__device__ __forceinline__ float lam_dev(const float* lqk_all, int l, int lane) {
    const float* q = lqk_all + (size_t)l * 4 * HEAD_DIM_A;
    const float s0 = wave_sum(q[lane] * q[HEAD_DIM_A + lane]), s1 = wave_sum(q[2 * HEAD_DIM_A + lane] * q[3 * HEAD_DIM_A + lane]);
    return __expf(s0) - __expf(s1) + lam_init_dev(l);
}
__device__ __forceinline__ int krow_dev(int s, int h, int j) { return 16 * s + 8 * (j >> 2) + 4 * h + (j & 3); }
__device__ __forceinline__ int crow_dev(int r, int h) { return (r & 3) + 8 * (r >> 2) + 4 * h; }
__device__ __forceinline__ bf16x8 pack_f8(const f32x4 a, const f32x4 b) { v4u w; w.x = pk2(a.x, a.y); w.y = pk2(a.z, a.w); w.z = pk2(b.x, b.y); w.w = pk2(b.z, b.w); return __builtin_bit_cast(bf16x8, w); }

__device__ __forceinline__ void sample_scores(f32x16& X, int kb, int c, const float* ck, const bf16* KN, int row0, int h, int hi, int r32, int qpos, const bf16x8 (&qf)[4], const LAS float* tab) {
    bf16x8 kf[4];
    if (kb < PAST_LEN / 32) { const float* kr = ck + (size_t)(kb * 32 + r32) * WIDTH_A + h * 128 + c * 64 + 8 * hi;
#pragma unroll
        for (int s = 0; s < 4; ++s) kf[s] = pack_f8(*(const GAS f32x4*)(kr + 16 * s), *(const GAS f32x4*)(kr + 16 * s + 4)); }
    else { const bf16* kr = KN + (size_t)(row0 + (kb * 32 - PAST_LEN) + r32) * WIDTH_A + h * 128 + c * 64 + 8 * hi;
#pragma unroll
        for (int s = 0; s < 4; ++s) kf[s] = *(const GAS bf16x8*)(kr + 16 * s); }
#pragma unroll
    for (int i = 0; i < 16; ++i) X[i] = 0.f;
#pragma unroll
    for (int s = 0; s < 4; ++s) X = __builtin_amdgcn_mfma_f32_32x32x16_bf16(kf[s], qf[s], X, 0, 0, 0);
#pragma unroll
    for (int i = 0; i < 16; ++i) { int idx = kb * 32 + crow_dev(i, hi) - qpos + attn_body::BT_OFF; idx = idx < 0 ? 0 : idx; X[i] += tab[idx]; }
}

__device__ __forceinline__ void attn_sample_unit(Frame& F, int l, int bs, int h) {
    const KArgs ap = kargs(); const auto& a = *ap; WS_OPAQUE(a);
    const int tid = otid(), lane = tid & 63, wid = __builtin_amdgcn_readfirstlane(tid >> 6), r32 = lane & 31, hi = lane >> 5;
    const bf16* QN = (const bf16*)(wsb + a.off[R_QN]); const bf16* KN = (const bf16*)(wsb + a.off[R_KN]); const bf16* Z = (const bf16*)(wsb + a.off[R_Z]); bf16* O = (bf16*)(wsb + a.off[R_O]);
    const float* ck = GIN(a, I_CK) + ((size_t)l * DEC_BATCH + bs) * PAST_LEN * WIDTH_A; const float* cv = GIN(a, I_CV) + ((size_t)l * DEC_BATCH + bs) * PAST_LEN * WIDTH_A;
    const int row0 = SROW0 + bs * DEC_SEQ;
    LAS float* tab = (LAS float*)(F.lds + RING_OFF + attn_body::LDS_BT);
    LAS float* st = (LAS float*)(F.lds + RING_OFF + 90112);
    LAS float* slot = (LAS float*)(F.lds + RING_OFF);
    const float lam = lam_dev(GIN(a, I_LQK), l, lane);
    build_bias_table(tab, GIN(a, I_REL), h, tid);
    bf16x8 qf[2][4];
#pragma unroll
    for (int c = 0; c < 2; ++c)
#pragma unroll
        for (int s = 0; s < 4; ++s) qf[c][s] = *(const GAS bf16x8*)(QN + (size_t)(row0 + r32) * WIDTH_A + h * 128 + c * 64 + 16 * s + 8 * hi);
    __syncthreads();
    float m[2] = {-1e30f, -1e30f}, lsum[2] = {0.f, 0.f};
    const int qpos = PAST_LEN + r32;
    for (int kb = wid; kb < (PAST_LEN + DEC_SEQ) / 32; kb += NWAVES) {
#pragma unroll
        for (int c = 0; c < 2; ++c) { f32x16 X; sample_scores(X, kb, c, ck, KN, row0, h, hi, r32, qpos, qf[c], tab);
            float mx = X[0];
#pragma unroll
            for (int i = 1; i < 16; ++i) mx = fmaxf(mx, X[i]);
            mx = fmaxf(mx, swap32(mx)); const float mn = fmaxf(m[c], mx);
            float sum = 0.f;
#pragma unroll
            for (int i = 0; i < 16; ++i) sum += exp2f(X[i] - mn);
            lsum[c] = lsum[c] * exp2f(m[c] - mn) + sum; m[c] = mn; }
    }
#pragma unroll
    for (int c = 0; c < 2; ++c) { lsum[c] += swap32(lsum[c]); if (hi == 0) { st[((wid * 2 + c) * 2 + 0) * 32 + r32] = m[c]; st[((wid * 2 + c) * 2 + 1) * 32 + r32] = lsum[c]; } }
    __syncthreads();
    float gm[2], ginv[2];
#pragma unroll
    for (int c = 0; c < 2; ++c) { float mm = -1e30f;
#pragma unroll
        for (int w = 0; w < NWAVES; ++w) mm = fmaxf(mm, st[((w * 2 + c) * 2 + 0) * 32 + r32]);
        float ll = 0.f;
#pragma unroll
        for (int w = 0; w < NWAVES; ++w) ll += st[((w * 2 + c) * 2 + 1) * 32 + r32] * exp2f(st[((w * 2 + c) * 2 + 0) * 32 + r32] - mm);
        gm[c] = mm; ginv[c] = (c == 0 ? 1.f : lam) / ll; }
    f32x16 acc[4];
#pragma unroll
    for (int eb = 0; eb < 4; ++eb)
#pragma unroll
        for (int i = 0; i < 16; ++i) acc[eb][i] = 0.f;
    for (int kb = wid; kb < (PAST_LEN + DEC_SEQ) / 32; kb += NWAVES) {
        f32x16 X0, X1; sample_scores(X0, kb, 0, ck, KN, row0, h, hi, r32, qpos, qf[0], tab); sample_scores(X1, kb, 1, ck, KN, row0, h, hi, r32, qpos, qf[1], tab);
        float wv[16];
#pragma unroll
        for (int i = 0; i < 16; ++i) wv[i] = exp2f(X0[i] - gm[0]) * ginv[0] - exp2f(X1[i] - gm[1]) * ginv[1];
        bf16x8 xs[2];
#pragma unroll
        for (int s = 0; s < 2; ++s) { v4u w; w.x = pk2(wv[8 * s], wv[8 * s + 1]); w.y = pk2(wv[8 * s + 2], wv[8 * s + 3]); w.z = pk2(wv[8 * s + 4], wv[8 * s + 5]); w.w = pk2(wv[8 * s + 6], wv[8 * s + 7]); xs[s] = __builtin_bit_cast(bf16x8, w); }
#pragma unroll
        for (int eb = 0; eb < 4; ++eb)
#pragma unroll
            for (int s = 0; s < 2; ++s) {
                float vv[8];
                if (kb < PAST_LEN / 32) { const GAS float* vb = (const GAS float*)(cv + (size_t)(kb * 32 + 4 * hi) * WIDTH_A + h * 128 + eb * 32 + r32); asm volatile("" : "+v"(vb));
#pragma unroll
                    for (int j = 0; j < 8; ++j) vv[j] = vb[(size_t)(16 * s + 8 * (j >> 2) + (j & 3)) * WIDTH_A]; }
                else { const GAS bf16* vb = (const GAS bf16*)(Z + (size_t)(row0 + kb * 32 - PAST_LEN + 4 * hi) * ZN + ZC_VA + h * 128 + eb * 32 + r32); asm volatile("" : "+v"(vb));
#pragma unroll
                    for (int j = 0; j < 8; ++j) vv[j] = bf2f(vb[(size_t)(16 * s + 8 * (j >> 2) + (j & 3)) * ZN]); }
                v4u w; w.x = pk2(vv[0], vv[1]); w.y = pk2(vv[2], vv[3]); w.z = pk2(vv[4], vv[5]); w.w = pk2(vv[6], vv[7]);
                acc[eb] = __builtin_amdgcn_mfma_f32_32x32x16_bf16(xs[s], __builtin_bit_cast(bf16x8, w), acc[eb], 0, 0, 0);
            }
    }
    __syncthreads();
#pragma unroll
    for (int eb = 0; eb < 4; ++eb)
#pragma unroll
        for (int i = 0; i < 16; ++i) slot[(wid * 32 + crow_dev(i, hi)) * 128 + eb * 32 + r32] = acc[eb][i];
    __syncthreads();
    { const int q = tid >> 4, e0 = (tid & 15) * 8; float o[8];
#pragma unroll
      for (int j = 0; j < 8; ++j) o[j] = 0.f;
#pragma unroll
      for (int w = 0; w < NWAVES; ++w)
#pragma unroll
          for (int j = 0; j < 8; ++j) o[j] += slot[(w * 32 + q) * 128 + e0 + j];
      v4u pw; pw.x = pk2(o[0], o[1]); pw.y = pk2(o[2], o[3]); pw.z = pk2(o[4], o[5]); pw.w = pk2(o[6], o[7]);
      bf16* orow = O + (size_t)(row0 + q) * attn_body::OP + h * 256;
      unsigned zq = 0u; asm volatile("" : "+v"(zq));
      *(GAS v4u*)(orow + e0) = pw; *(GAS v4u*)(orow + 128 + e0) = (v4u){zq, zq, zq, zq}; }
    __syncthreads();
}

constexpr int ATT_NQB = LPP / 256;
constexpr int ATT_NPU = BATCH * 16 * ATT_NQB;
constexpr int ATT_NSU = DEC_BATCH * N_HEADS_A;
__device__ __forceinline__ void p_attention(Frame& F, int lq, unsigned char* ldsg) {
    const int l = lq % DEPTH;
    for (;;) {
        const KArgs ap = kargs(); const auto& a = *ap; WS_OPAQUE(a);
        const int tid = otid();
        gu32* head = (gu32*)wsb + CW_QUEUE + 64 * lq;
        const attn_body::bf16* QN = (const attn_body::bf16*)(wsb + a.off[R_QN]); const attn_body::bf16* KN = (const attn_body::bf16*)(wsb + a.off[R_KN]);
        const attn_body::bf16* Z = (const attn_body::bf16*)(wsb + a.off[R_Z]); attn_body::bf16* O = (attn_body::bf16*)(wsb + a.off[R_O]);
        if (tid == 0) F.MISC[16] = __hip_atomic_fetch_add(head, 1u, RLX_AGENT);
        __syncthreads();
        const int u = (int)F.MISC[16];
        __syncthreads();
        if (u >= ATT_NPU + ATT_NSU) break;
        if (u < ATT_NPU) {
            const int qb = (ATT_NQB - 1) - u / 32, bvh = u % 32, b = bvh >> 4, vh = bvh & 15, h = vh >> 2, c = (vh >> 1) & 1, half = vh & 1;
            build_bias_table((LAS float*)(F.lds + RING_OFF + attn_body::LDS_BT), GIN(a, I_REL), h, tid);
            __syncthreads();
            attn_body::attn_unit<8>(b, h * 128 + c * 64, ZC_VA + h * 128 + half * 64, h * 256 + c * 128 + half * 64, qb, QN, KN, Z, O, (char*)ldsg + RING_OFF, F.wv);
        } else { const int su = u - ATT_NPU; attn_sample_unit(F, l, su >> 2, su & 3); }
    }
}
__device__ __forceinline__ void p_mixpost_a(Frame& F, int l) {
    const KArgs ap = kargs(); const auto& a = *ap; WS_OPAQUE(a);
    const int tid = otid(), lane = tid & 63, wave = __builtin_amdgcn_readfirstlane(tid >> 6);
    const bf16* O = (const bf16*)(wsb + a.off[R_O]); bf16* OA = (bf16*)(wsb + a.off[R_OA]);
    const int gw = F.vcu * NWAVES + wave, NGW = F.G * NWAVES;
    const float lam = lam_dev(GIN(a, I_LQK), l, lane), post = 1.f - lam_init_dev(l);
    const int h = lane >> 4, e0 = 8 * (lane & 15);
    float sg[8];
#pragma unroll
    for (int j = 0; j < 8; ++j) sg[j] = GIN(a, I_SUBLN)[l * 2 * HEAD_DIM_A + e0 + j] * post;
    v4u n0 = *(const GAS v4u*)(O + (size_t)gw * 1024 + h * 256 + e0), n1 = *(const GAS v4u*)(O + (size_t)gw * 1024 + h * 256 + 128 + e0);
    for (int m = gw; m < RP; m += NGW) {
        float o0[8], o1[8], d[8];
        unpack8(n0, o0); unpack8(n1, o1);
        { const int mn = m + NGW < RP ? m + NGW : gw; n0 = *(const GAS v4u*)(O + (size_t)mn * 1024 + h * 256 + e0); n1 = *(const GAS v4u*)(O + (size_t)mn * 1024 + h * 256 + 128 + e0); }
        float ss = 0.f;
#pragma unroll
        for (int j = 0; j < 8; ++j) { d[j] = o0[j] - lam * o1[j]; ss += d[j] * d[j]; }
        ss = sum16(ss);
        const float r = __builtin_amdgcn_rsqf(ss * (1.f / 128.f) + EPSF);
#pragma unroll
        for (int j = 0; j < 8; ++j) d[j] = d[j] * r * sg[j];
        *(GAS v4u*)(OA + (size_t)m * WIDTH_A + h * 128 + e0) = pack8(d);
    }
}
constexpr int GDN_NCH = PEND / 64;
constexpr int GDN_NPI = BATCH * N_HEADS_B * GDN_NCH;
constexpr int GDN_NSI = DEC_BATCH * N_HEADS_B;
constexpr int GDN_NI = GDN_NPI + GDN_NSI;
constexpr int GI_W = 0, GI_QG = 16384, GI_KG = 32768, GI_AT = 49152, GI_U = 57344, GI_SC = 73728, GI_STRIDE = 73984, GI_EG = 2048  ;
static_assert(GDN_NI % 4 == 0 && PEND % 64 == 0, "gdn items");
__device__ __forceinline__ int frag_off(int row, int kk, int nkb) {
    const int fid = ((row >> 5) * nkb + (kk >> 5)) * 2 + ((kk & 31) >> 4), ln = (row & 31) + 32 * (((kk & 15) >> 2) & 1), j = ((kk & 15) >> 3) * 4 + (kk & 3);
    return (fid * 64 + ln) * 8 + j;
}
__device__ __forceinline__ int gdn_item_row(int item, int j) {
    if (item < GDN_NPI) { const int sh = item / GDN_NCH, n = item % GDN_NCH; return (sh / N_HEADS_B) * LPP + 64 * n + j; }
    const int s = item - GDN_NPI; return j < 32 ? -1 : SROW0 + (s >> 2) * DEC_SEQ + (j - 32);
}
__device__ __forceinline__ int gdn_item_head(int item) { return item < GDN_NPI ? (item / GDN_NCH) % N_HEADS_B : (item - GDN_NPI) & 3; }

__device__ __forceinline__ void gdn_flush(const LAS unsigned char* stg, unsigned char* dst, int nbytes, int gt) {
    for (int o = gt * 16; o < nbytes; o += 2048) *(GAS v4u*)(dst + o) = *(const LAS v4u*)(stg + o);
}
typedef float f32x2s __attribute__((ext_vector_type(2)));
#define GDN_RL8(a, arow, jb) asm volatile("v_readlane_b32 %0, %8, %9\n\tv_readlane_b32 %1, %8, %10\n\tv_readlane_b32 %2, %8, %11\n\tv_readlane_b32 %3, %8, %12\n\tv_readlane_b32 %4, %8, %13\n\tv_readlane_b32 %5, %8, %14\n\tv_readlane_b32 %6, %8, %15\n\tv_readlane_b32 %7, %8, %16" \
    : "=s"(a[0]), "=s"(a[1]), "=s"(a[2]), "=s"(a[3]), "=s"(a[4]), "=s"(a[5]), "=s"(a[6]), "=s"(a[7]) : "v"(arow), "i"(jb), "i"((jb) + 1), "i"((jb) + 2), "i"((jb) + 3), "i"((jb) + 4), "i"((jb) + 5), "i"((jb) + 6), "i"((jb) + 7))
template <int I, int JB> __device__ __forceinline__ void gdn_subst_blk(f32x2s (&x)[64], float arow) {
    if constexpr (JB < I) { float ar[8]; GDN_RL8(ar, arow, JB);
#pragma unroll
        for (int t = 0; t < 8; ++t) if (JB + t < I) x[I] -= ar[t] * x[JB + t];
        gdn_subst_blk<I, JB + 8>(x, arow); }
}
template <int... Is> __device__ __forceinline__ void gdn_subst_all(f32x2s (&x)[64], const LAS float* A, int lane, std::integer_sequence<int, Is...>) {
    (gdn_subst_blk<Is + 1, 0>(x, A[(Is + 1) * 64 + lane]), ...);
}
template <int MODE> __device__ __forceinline__ void p_gdn_chunk(Frame& F, int l, int q) {
    const KArgs ap = kargs(); const auto& a = *ap; WS_OPAQUE(a);
    const int tid = otid(), wave = __builtin_amdgcn_readfirstlane(tid >> 6), grp = wave >> 1, gw = wave & 1;
    const bf16* QKVB = (const bf16*)(wsb + a.off[R_QKVB]); const float* BG = (const float*)(wsb + a.off[R_BG]); unsigned char* GD = wsb + a.off[R_GDN];
    LAS float* A_lds = (LAS float*)(F.lds + RING_OFF + grp * 34816);
    LAS float* Gs = A_lds + 4096; LAS float* Bs = Gs + 64; LAS float* Es = Bs + 64;
    LAS unsigned char* stg = (LAS unsigned char*)(A_lds + 4096 + 256);
    LAS bf16* stgh = (LAS bf16*)stg;
    static_assert(4 * 34816 <= RING_BYTES && GDN_NI % 4 == 0, "gdn chunk LDS / items");
    for (int pr = MODE == 0 ? F.vcu : q; MODE == 0 ? pr < (GDN_NPI - BATCH * N_HEADS_B) / 4 : pr == q; pr += (MODE == 0 ? F.G : 1 << 20)) {
        int lane_ = otid() & 63;
        const int lane = lane_, r32 = lane & 31, hi = lane >> 5, gt = gw * 64 + lane;
        int item;
        if (MODE == 0) { const int j = 4 * pr + grp; item = (j >> 7) * GDN_NCH + (j & 127); }
        else item = q < 16 ? GDN_NPI + 4 * q + grp : (4 * (q - 16) + grp) * GDN_NCH + (GDN_NCH - 1);
        const int h = gdn_item_head(item);
        unsigned char* ib = GD + (size_t)item * GI_STRIDE;
        const int rowt = gdn_item_row(item, lane);
        const float beta = rowt >= 0 ? BG[(size_t)rowt * 8 + h] : 0.f; float G = rowt >= 0 ? BG[(size_t)rowt * 8 + 4 + h] : 0.f;
        G = scan64(G);
        const float Glast = rdlane(G, 63), eG = __expf(G);
        if (gw == 0) { Gs[lane] = G; Bs[lane] = beta; Es[lane] = eG; }
        __syncthreads();
#pragma unroll
        for (int bq = 0; bq < 2; ++bq) {
          const int i0 = 32 * gw, j0 = 32 * bq; const int j = j0 + r32;
          if (gw == 0 && bq == 1) {
#pragma unroll
              for (int r = 0; r < 16; ++r) { const int i = crow_dev(r, hi); A_lds[i * 64 + j] = 0.f; stgh[frag_off(i, j, 2)] = (bf16)0; }
              LDS_WAIT(); if (lane == 0) *(LAS float*)(stg + GI_EG) = __expf(Glast);
          } else {
          const int ra = gdn_item_row(item, i0 + r32), rb = gdn_item_row(item, j0 + r32);
          f32x16 akk, aqk;
#pragma unroll
          for (int r = 0; r < 16; ++r) { akk[r] = 0.f; aqk[r] = 0.f; }
          const bf16x8 zf = {0, 0, 0, 0, 0, 0, 0, 0};
          bf16x8 qa[8], ka[8], kb[8];
          { const bf16* pa = QKVB + (size_t)(ra < 0 ? 0 : ra) * 1536 + h * 128 + 8 * hi; const bf16* pb = QKVB + (size_t)(rb < 0 ? 0 : rb) * 1536 + 512 + h * 128 + 8 * hi;
#pragma unroll
            for (int s = 0; s < 8; ++s) { qa[s] = *(const GAS bf16x8*)(pa + 16 * s); ka[s] = *(const GAS bf16x8*)(pa + 512 + 16 * s); kb[s] = *(const GAS bf16x8*)(pb + 16 * s); } }
#pragma unroll
          for (int s = 0; s < 8; ++s) { if (ra < 0) { qa[s] = zf; ka[s] = zf; } if (rb < 0) kb[s] = zf;
              akk = __builtin_amdgcn_mfma_f32_32x32x16_bf16(ka[s], kb[s], akk, 0, 0, 0); aqk = __builtin_amdgcn_mfma_f32_32x32x16_bf16(qa[s], kb[s], aqk, 0, 0, 0); }
          const float Gj = Gs[j];
#pragma unroll
          for (int r = 0; r < 16; ++r) { const int i = i0 + crow_dev(r, hi); const float dec = i >= j ? __expf(Gs[i] - Gj) : 0.f;
              A_lds[i * 64 + j] = i > j ? Bs[i] * akk[r] * dec : 0.f;
              stgh[frag_off(i, j, 2)] = (bf16)f2bf(aqk[r] * dec); }
          }
        }
        __syncthreads();
        gdn_flush(stg, ib + GI_AT, 8192, gt);
        { f32x2s x[64]; const int cbase = gw == 0 ? 1024 + h * 128 : 512 + h * 128;
#pragma unroll
          for (int i = 0; i < 64; ++i) { const int ri = __builtin_amdgcn_readfirstlane(gdn_item_row(item, i));
              const bf16* rowp = QKVB + (size_t)(ri < 0 ? 0 : ri) * 1536 + cbase;
              x[i] = ri >= 0 ? (f32x2s){bf2f(rowp[lane]), bf2f(rowp[lane + 64])} : (f32x2s){0.f, 0.f}; }
          const float rsc = gw == 0 ? beta : beta * eG;
#pragma unroll
          for (int i = 0; i < 64; ++i) x[i] *= rdlane(rsc, i);
          gdn_subst_all(x, A_lds, lane, std::make_integer_sequence<int, 63>{});
          __syncthreads();
          if (gw == 0) { GAS bf16* ub = (GAS bf16*)(ib + GI_U) + lane; asm volatile("" : "+v"(ub));
#pragma unroll
              for (int i = 0; i < 64; ++i) { ub[i * 128] = (bf16)f2bf(x[i].x); ub[i * 128 + 64] = (bf16)f2bf(x[i].y); } }
          else { LAS bf16* wb0 = stgh + frag_off(0, lane, 4); LAS bf16* wb1 = stgh + frag_off(0, lane + 64, 4);
#pragma unroll
              for (int i = 0; i < 64; ++i) { wb0[(i >> 5) * 4096 + (i & 31) * 8] = (bf16)f2bf(x[i].x); wb1[(i >> 5) * 4096 + (i & 31) * 8] = (bf16)f2bf(x[i].y); } }
        }
        __syncthreads();
        gdn_flush(stg, ib + GI_W, 16384, gt);
        __syncthreads();
        const float kgs = __expf(Glast - G);
#pragma unroll
        for (int hf = 0; hf < 2; ++hf) { float qv[32];
#pragma unroll
          for (int it = 0; it < 32; ++it) { const int c = it + 32 * hf, rc = __builtin_amdgcn_readfirstlane(gdn_item_row(item, c)); const bf16* rowp = QKVB + (size_t)(rc < 0 ? 0 : rc) * 1536 + h * 128; qv[it] = rc >= 0 ? bf2f(rowp[gt]) : 0.f; }
#pragma unroll
          for (int it = 0; it < 32; ++it) { const int c = it + 32 * hf; stgh[frag_off(c, gt, 4)] = (bf16)f2bf(qv[it] * rdlane(eG, c)); } }
        __syncthreads();
        gdn_flush(stg, ib + GI_QG, 16384, gt);
        __syncthreads();
#pragma unroll
        for (int hf = 0; hf < 2; ++hf) { float kv[32];
#pragma unroll
          for (int it = 0; it < 32; ++it) { const int c = it + 32 * hf, rc = __builtin_amdgcn_readfirstlane(gdn_item_row(item, c)); const bf16* rowp = QKVB + (size_t)(rc < 0 ? 0 : rc) * 1536 + 512 + h * 128; kv[it] = rc >= 0 ? bf2f(rowp[gt]) : 0.f; }
#pragma unroll
          for (int it = 0; it < 32; ++it) { const int c = it + 32 * hf; stgh[frag_off(gt, c, 2)] = (bf16)f2bf(kv[it] * rdlane(kgs, c)); } }
        __syncthreads();
        gdn_flush(stg, ib + GI_KG, 16384, gt);
        VM_WAIT(); __syncthreads();
        if (MODE == 1 && q >= 16) {
            if (wave == 0 && (otid() & 63) == 0) { __builtin_amdgcn_fence(__ATOMIC_RELEASE, "agent"); asm volatile("s_waitcnt vmcnt(0)" ::: "memory");
                gu32* fl = (gu32*)wsb + CW_GDNFLAG;
#pragma unroll
                for (int c = 0; c < 4; ++c) __hip_atomic_store(fl + 64 * (4 * (q - 16) + c), (unsigned)(l + 1), RLX_AGENT); } }
    }
}

__device__ __forceinline__ void gdn_chain(const unsigned char* GD, bf16* OB, const float* sdelta, float* dout, int item0, int nch, int h, int vb, int lane) {
    const int r32 = lane & 31, hi = lane >> 5;
    f32x16 S[4];
#pragma unroll
    for (int kb = 0; kb < 4; ++kb)
#pragma unroll
        for (int r = 0; r < 16; ++r) S[kb][r] = sdelta ? sdelta[(size_t)(kb * 32 + crow_dev(r, hi)) * HEAD_DIM_B + vb * 32 + r32] : 0.f;
    for (int n = 0; n < nch; ++n) {
        const int item = item0 + n; const unsigned char* ib = GD + (size_t)item * GI_STRIDE;
        const float eGl = *(const float*)(ib + GI_AT + GI_EG);
        const GAS bf16x8* WF = (const GAS bf16x8*)(ib + GI_W) + lane; const GAS bf16x8* QF = (const GAS bf16x8*)(ib + GI_QG) + lane;
        const GAS bf16x8* KF = (const GAS bf16x8*)(ib + GI_KG) + lane; const GAS bf16x8* AF = (const GAS bf16x8*)(ib + GI_AT) + lane; const bf16* U = (const bf16*)(ib + GI_U);
        bf16x8 Sp[4][2];
#pragma unroll
        for (int kb = 0; kb < 4; ++kb)
#pragma unroll
            for (int s = 0; s < 2; ++s) { v4u w; w.x = pk2(S[kb][8 * s], S[kb][8 * s + 1]); w.y = pk2(S[kb][8 * s + 2], S[kb][8 * s + 3]); w.z = pk2(S[kb][8 * s + 4], S[kb][8 * s + 5]); w.w = pk2(S[kb][8 * s + 6], S[kb][8 * s + 7]); Sp[kb][s] = __builtin_bit_cast(bf16x8, w); }
        f32x16 vn[2], ot[2];
#pragma unroll
        for (int cb = 0; cb < 2; ++cb) {
            f32x16 ws;
#pragma unroll
            for (int r = 0; r < 16; ++r) { ws[r] = 0.f; ot[cb][r] = 0.f; }
#pragma unroll
            for (int kb = 0; kb < 4; ++kb)
#pragma unroll
                for (int s = 0; s < 2; ++s) { ws = __builtin_amdgcn_mfma_f32_32x32x16_bf16(WF[((cb * 4 + kb) * 2 + s) * 64], Sp[kb][s], ws, 0, 0, 0);
                    ot[cb] = __builtin_amdgcn_mfma_f32_32x32x16_bf16(QF[((cb * 4 + kb) * 2 + s) * 64], Sp[kb][s], ot[cb], 0, 0, 0); }
#pragma unroll
            for (int r = 0; r < 16; ++r) vn[cb][r] = bf2f(U[(cb * 32 + crow_dev(r, hi)) * 128 + vb * 32 + r32]) - ws[r];
        }
        bf16x8 Vp[2][2];
#pragma unroll
        for (int cb = 0; cb < 2; ++cb)
#pragma unroll
            for (int s = 0; s < 2; ++s) { v4u w; w.x = pk2(vn[cb][8 * s], vn[cb][8 * s + 1]); w.y = pk2(vn[cb][8 * s + 2], vn[cb][8 * s + 3]); w.z = pk2(vn[cb][8 * s + 4], vn[cb][8 * s + 5]); w.w = pk2(vn[cb][8 * s + 6], vn[cb][8 * s + 7]); Vp[cb][s] = __builtin_bit_cast(bf16x8, w); }
#pragma unroll
        for (int cb = 0; cb < 2; ++cb)
#pragma unroll
            for (int c2 = 0; c2 <= cb; ++c2)
#pragma unroll
                for (int s = 0; s < 2; ++s) ot[cb] = __builtin_amdgcn_mfma_f32_32x32x16_bf16(AF[((cb * 2 + c2) * 2 + s) * 64], Vp[c2][s], ot[cb], 0, 0, 0);
#pragma unroll
        for (int cb = 0; cb < 2; ++cb)
#pragma unroll
            for (int r = 0; r < 16; ++r) { const int row = gdn_item_row(item, cb * 32 + crow_dev(r, hi)); if (row >= 0) OB[(size_t)row * WIDTH_B + h * 128 + vb * 32 + r32] = (bf16)f2bf(ot[cb][r]); }
#pragma unroll
        for (int kb = 0; kb < 4; ++kb) {
#pragma unroll
            for (int r = 0; r < 16; ++r) S[kb][r] *= eGl;
#pragma unroll
            for (int cb = 0; cb < 2; ++cb)
#pragma unroll
                for (int s = 0; s < 2; ++s) S[kb] = __builtin_amdgcn_mfma_f32_32x32x16_bf16(KF[((kb * 2 + cb) * 2 + s) * 64], Vp[cb][s], S[kb], 0, 0, 0);
        }
    }
#pragma unroll
    for (int kb = 0; kb < 4; ++kb)
#pragma unroll
        for (int r = 0; r < 16; ++r) dout[(size_t)(kb * 32 + crow_dev(r, hi)) * HEAD_DIM_B + vb * 32 + r32] = S[kb][r];
}
constexpr int GCH_BUF = 73728, GCH_PCS = 18;
#define GCH_BAR() do { asm volatile("s_waitcnt lgkmcnt(0)" ::: "memory"); __builtin_amdgcn_s_barrier(); asm volatile("" ::: "memory"); } while (0)
__device__ __forceinline__ void gdn_chain_wg(Frame& F, const unsigned char* GD, bf16* OB, float* dout, int item0, int h, gu32* flag, unsigned epoch) {
    const int tid = otid(), lane = tid & 63, wave = __builtin_amdgcn_readfirstlane(tid >> 6), r32 = lane & 31, hi = lane >> 5, vb = wave & 3;
    LAS unsigned char* lb = F.lds + RING_OFF;
    if (wave >= 4) {
        const int p0 = (wave - 4) * GCH_PCS;
        v4u R0[GCH_PCS], R1[GCH_PCS];
#define GCH_LOAD(R, c) do { if ((c) == GDN_NCH - 1) { unsigned sp_ = 0; while (__hip_atomic_load(flag, RLX_AGENT) != epoch) { __builtin_amdgcn_s_sleep(2); if (++sp_ > (1u << 22)) break; } \
            __builtin_amdgcn_fence(__ATOMIC_ACQUIRE, "agent"); asm volatile("s_waitcnt vmcnt(0)" ::: "memory"); }     \
            const unsigned char* s_ = GD + (size_t)(item0 + (c)) * GI_STRIDE + (size_t)p0 * 1024 + lane * 16; _Pragma("unroll") for (int j = 0; j < GCH_PCS; ++j) \
            asm volatile("global_load_dwordx4 %0, %1, off" : "=&v"(R[j]) : "v"(s_ + j * 1024) : "memory"); } while (0)
#define GCH_PUT(R, c) do { if ((c) + 1 < GDN_NCH) asm volatile("s_waitcnt vmcnt(18)" ::: "memory"); else asm volatile("s_waitcnt vmcnt(0)" ::: "memory"); \
            LAS v4u* d_ = (LAS v4u*)(lb + ((c) & 1) * GCH_BUF + p0 * 1024) + lane; _Pragma("unroll") for (int j = 0; j < GCH_PCS; ++j) d_[j * 64] = R[j]; } while (0)
        GCH_LOAD(R0, 0); GCH_LOAD(R1, 1);
        GCH_PUT(R0, 0); GCH_LOAD(R0, 2);
        GCH_BAR();
        for (int n = 0; n < GDN_NCH; n += 2) {
            if (n + 1 < GDN_NCH) GCH_PUT(R1, n + 1);
            if (n + 3 < GDN_NCH) GCH_LOAD(R1, n + 3);
            GCH_BAR();
            if (n + 1 < GDN_NCH) {
                if (n + 2 < GDN_NCH) GCH_PUT(R0, n + 2);
                if (n + 4 < GDN_NCH) GCH_LOAD(R0, n + 4);
                GCH_BAR(); }
        }
        asm volatile("s_waitcnt vmcnt(0)" ::: "memory");
#undef GCH_LOAD
#undef GCH_PUT
        return;
    }
    f32x16 S[4];
#pragma unroll
    for (int kb = 0; kb < 4; ++kb)
#pragma unroll
        for (int r = 0; r < 16; ++r) S[kb][r] = 0.f;
    GCH_BAR();
    for (int n = 0; n < GDN_NCH; ++n) {
        const int item = item0 + n; const LAS unsigned char* bufc = lb + (n & 1) * GCH_BUF;
        const float egl = *(const LAS float*)(bufc + GI_AT + GI_EG);
        const LAS bf16x8* WF = (const LAS bf16x8*)(bufc + GI_W) + lane; const LAS bf16x8* QF = (const LAS bf16x8*)(bufc + GI_QG) + lane;
        const LAS bf16x8* KF = (const LAS bf16x8*)(bufc + GI_KG) + lane; const LAS bf16x8* AF = (const LAS bf16x8*)(bufc + GI_AT) + lane; const LAS bf16* U = (const LAS bf16*)(bufc + GI_U);
        bf16x8 Sp[4][2];
#pragma unroll
        for (int kb = 0; kb < 4; ++kb)
#pragma unroll
            for (int s = 0; s < 2; ++s) { v4u w; w.x = pk2(S[kb][8 * s], S[kb][8 * s + 1]); w.y = pk2(S[kb][8 * s + 2], S[kb][8 * s + 3]); w.z = pk2(S[kb][8 * s + 4], S[kb][8 * s + 5]); w.w = pk2(S[kb][8 * s + 6], S[kb][8 * s + 7]); Sp[kb][s] = __builtin_bit_cast(bf16x8, w); }
        f32x16 vn[2], ot[2];
#pragma unroll
        for (int cb = 0; cb < 2; ++cb) {
            f32x16 ws;
#pragma unroll
            for (int r = 0; r < 16; ++r) { ws[r] = 0.f; ot[cb][r] = 0.f; }
#pragma unroll
            for (int kb = 0; kb < 4; ++kb)
#pragma unroll
                for (int s = 0; s < 2; ++s) { ws = __builtin_amdgcn_mfma_f32_32x32x16_bf16(WF[((cb * 4 + kb) * 2 + s) * 64], Sp[kb][s], ws, 0, 0, 0);
                    ot[cb] = __builtin_amdgcn_mfma_f32_32x32x16_bf16(QF[((cb * 4 + kb) * 2 + s) * 64], Sp[kb][s], ot[cb], 0, 0, 0); }
#pragma unroll
            for (int r = 0; r < 16; ++r) vn[cb][r] = bf2f(U[(cb * 32 + crow_dev(r, hi)) * 128 + vb * 32 + r32]) - ws[r];
        }
        bf16x8 Vp[2][2];
#pragma unroll
        for (int cb = 0; cb < 2; ++cb)
#pragma unroll
            for (int s = 0; s < 2; ++s) { v4u w; w.x = pk2(vn[cb][8 * s], vn[cb][8 * s + 1]); w.y = pk2(vn[cb][8 * s + 2], vn[cb][8 * s + 3]); w.z = pk2(vn[cb][8 * s + 4], vn[cb][8 * s + 5]); w.w = pk2(vn[cb][8 * s + 6], vn[cb][8 * s + 7]); Vp[cb][s] = __builtin_bit_cast(bf16x8, w); }
#pragma unroll
        for (int cb = 0; cb < 2; ++cb)
#pragma unroll
            for (int c2 = 0; c2 <= cb; ++c2)
#pragma unroll
                for (int s = 0; s < 2; ++s) ot[cb] = __builtin_amdgcn_mfma_f32_32x32x16_bf16(AF[((cb * 2 + c2) * 2 + s) * 64], Vp[c2][s], ot[cb], 0, 0, 0);
        { const int row0 = gdn_item_row(item, 0);
#pragma unroll
          for (int cb = 0; cb < 2; ++cb)
#pragma unroll
              for (int r = 0; r < 16; ++r) OB[(size_t)(row0 + cb * 32 + crow_dev(r, hi)) * WIDTH_B + h * 128 + vb * 32 + r32] = (bf16)f2bf(ot[cb][r]); }
#pragma unroll
        for (int kb = 0; kb < 4; ++kb) {
#pragma unroll
            for (int r = 0; r < 16; ++r) S[kb][r] *= egl;
#pragma unroll
            for (int cb = 0; cb < 2; ++cb)
#pragma unroll
                for (int s = 0; s < 2; ++s) S[kb] = __builtin_amdgcn_mfma_f32_32x32x16_bf16(KF[((kb * 2 + cb) * 2 + s) * 64], Vp[cb][s], S[kb], 0, 0, 0);
        }
        GCH_BAR();
    }
#pragma unroll
    for (int kb = 0; kb < 4; ++kb)
#pragma unroll
        for (int r = 0; r < 16; ++r) dout[(size_t)(kb * 32 + crow_dev(r, hi)) * HEAD_DIM_B + vb * 32 + r32] = S[kb][r];
}
__device__ __forceinline__ void p_gdn_chain(Frame& F, int l) {
    const KArgs ap = kargs(); const auto& a = *ap; WS_OPAQUE(a);
    const unsigned char* GD = wsb + a.off[R_GDN]; bf16* OB = (bf16*)(wsb + a.off[R_OB]);
    if (F.vcu % 32 == 0 && F.vcu / 32 < BATCH * N_HEADS_B) { const int sh = F.vcu / 32, sq = sh / N_HEADS_B, h = sh % N_HEADS_B;
        gdn_chain_wg(F, GD, OB, GOUT(a) + O_DP + (((size_t)l * BATCH + sq) * N_HEADS_B + h) * HEAD_DIM_B * HEAD_DIM_B, sh * GDN_NCH, h, (gu32*)wsb + CW_GDNFLAG + 64 * sh, (unsigned)(l + 1)); }
    else { const int q = F.vcu - F.vcu / 32 - 1;
        if (q < 18) { p_gdn_chunk<1>(F, l, q);
            if (q < 16) { const int tid = otid(), lane = tid & 63, wave = __builtin_amdgcn_readfirstlane(tid >> 6);
#pragma unroll
                for (int tt = 0; tt < 2; ++tt) { const int t = wave + 8 * tt, s = 4 * q + (t >> 2), vb = t & 3, bs = s >> 2, h = s & 3; const size_t so = (((size_t)l * DEC_BATCH + bs) * N_HEADS_B + h) * HEAD_DIM_B * HEAD_DIM_B;
                    gdn_chain(GD, OB, GIN(a, I_SDELTA) + so, GOUT(a) + O_DS + so, GDN_NPI + s, 1, h, vb, lane); } } } }
}
__device__ __forceinline__ void p_mixpost_b(Frame& F, int l) {
    const KArgs ap = kargs(); const auto& a = *ap; WS_OPAQUE(a);
    const int tid = otid(), lane = tid & 63, wave = __builtin_amdgcn_readfirstlane(tid >> 6);
    const bf16* OB = (const bf16*)(wsb + a.off[R_OB]); bf16* OBN = (bf16*)(wsb + a.off[R_OBN]); const bf16* Z = (const bf16*)(wsb + a.off[R_Z]);
    const int gw = F.vcu * NWAVES + wave, NGW = F.G * NWAVES, e0 = 8 * (lane & 15);
    float gn[8];
#pragma unroll
    for (int j = 0; j < 8; ++j) gn[j] = GIN(a, I_GDNN)[l * HEAD_DIM_B + e0 + j];
    v4u n0 = *(const GAS v4u*)(OB + (size_t)gw * WIDTH_B + 8 * lane), n1 = *(const GAS v4u*)(Z + (size_t)gw * ZN + ZC_GB + 8 * lane);
    for (int m = gw; m < RP; m += NGW) {
        float o[8], gt[8];
        unpack8(n0, o); unpack8(n1, gt);
        { const int mn = m + NGW < RP ? m + NGW : gw; n0 = *(const GAS v4u*)(OB + (size_t)mn * WIDTH_B + 8 * lane); n1 = *(const GAS v4u*)(Z + (size_t)mn * ZN + ZC_GB + 8 * lane); }
        float ss = 0.f;
#pragma unroll
        for (int j = 0; j < 8; ++j) ss += o[j] * o[j];
        ss = sum16(ss);
        const float r = __builtin_amdgcn_rsqf(ss * (1.f / 128.f) + EPSF);
#pragma unroll
        for (int j = 0; j < 8; ++j) o[j] = o[j] * r * gn[j] * gt[j] * sigm(gt[j]);
        *(GAS v4u*)(OBN + (size_t)m * WIDTH_B + 8 * lane) = pack8(o);
    }
}
constexpr int S5_M1 = 0, S5_M2 = 131072, S5_M3 = 196608, S5_L16 = 262144, S5_TSTRIDE = 262656;
constexpr int S5_NCHK = RP / 16;
constexpr int S5_NBLK = S5_NCHK / 32;
constexpr int S5_PCH = PEND / 16;
static_assert(S5_NCHK % 32 == 0 && LPP % 16 == 0 && PADF % 16 == 0 && S5_STATE == 64 && S5_GROUPS == 32, "s5 shapes");

__device__ __forceinline__ void s5_tables(Frame& F) {
    const KArgs ap = kargs(); const auto& a = *ap; WS_OPAQUE(a);
    const int tid = otid();
    LAS float* pw = (LAS float*)(F.lds + RING_OFF);
    LAS float* bb = pw + 17 * 128;
    LAS float* Kt = bb + 64 * 32;
    for (int it = F.vcu; it < DEPTH * S5_GROUPS; it += F.G) {
        const int l = it / S5_GROUPS, g = it % S5_GROUPS; const size_t gp = ((size_t)l * S5_GROUPS + g) * S5_STATE;
        unsigned char* tb = wsb + a.off[R_S5T] + (size_t)it * S5_TSTRIDE;
        const float dt = __expf(GIN(a, I_LDT)[l * S5_GROUPS + g]);
        for (int e = tid; e < 17 * 64; e += NTHR) { const int k = e >> 6, p = e & 63; const float ar = GIN(a, I_AR)[gp + p] * dt * (float)k, ai = GIN(a, I_AI)[gp + p] * dt * (float)k;
            float sn, cs; sincosf(ai, &sn, &cs); const float er = expf(ar); pw[e * 2] = er * cs; pw[e * 2 + 1] = er * sn; }
        __syncthreads();
        for (int e = tid; e < 64 * 16; e += NTHR) { const int p = e >> 4; const float ar = GIN(a, I_AR)[gp + p], ai = GIN(a, I_AI)[gp + p];
            const float nr = pw[(64 + p) * 2] - 1.f, ni = pw[(64 + p) * 2 + 1], den = ar * ar + ai * ai, fr = (nr * ar + ni * ai) / den, fi = (ni * ar - nr * ai) / den;
            const float br = GIN(a, I_BR)[gp * 16 + e], bi = GIN(a, I_BI)[gp * 16 + e]; bb[e * 2] = fr * br - fi * bi; bb[e * 2 + 1] = fr * bi + fi * br; }
        if (tid < 128) { const int p = tid & 63; ((float*)(tb + S5_L16))[tid] = pw[(16 * 64 + p) * 2 + (tid >> 6)]; }
        __syncthreads();
        const float* cre = GIN(a, I_CR) + ((size_t)l * S5_GROUPS + g) * 16 * 64; const float* cim = GIN(a, I_CI) + ((size_t)l * S5_GROUPS + g) * 16 * 64;
        { const int j = tid & 15, i = (tid >> 4) & 15;
          f32x4 c4r[16], c4i[16];
#pragma unroll
          for (int q = 0; q < 16; ++q) { c4r[q] = *(const GAS f32x4*)(cre + i * 64 + 4 * q); c4i[q] = *(const GAS f32x4*)(cim + i * 64 + 4 * q); }
#pragma clang loop unroll(disable)
          for (int d = tid >> 8; d < 16; d += 2) { float acc = 0.f;
#pragma unroll
              for (int p = 0; p < 64; ++p) { const float cr = c4r[p >> 2][p & 3], ci = c4i[p >> 2][p & 3], pr = pw[(d * 64 + p) * 2], pi = pw[(d * 64 + p) * 2 + 1];
                  const float tr = cr * pr - ci * pi, ti = cr * pi + ci * pr; acc += tr * bb[(p * 16 + j) * 2] - ti * bb[(p * 16 + j) * 2 + 1]; }
              Kt[(d * 16 + i) * 16 + j] = acc; } }
        __syncthreads();
        bf16* M1 = (bf16*)(tb + S5_M1); bf16* M2 = (bf16*)(tb + S5_M2); bf16* M3 = (bf16*)(tb + S5_M3);
        for (int e = tid; e < 65536; e += NTHR) { const int n = e >> 8, k = e & 255, tau = n >> 4, i = n & 15, sg = k >> 4, j = k & 15;
            float v = 0.f; if (sg <= tau) { v = Kt[((tau - sg) * 16 + i) * 16 + j]; if (sg == tau && i == j) v += GIN(a, I_SD)[(l * S5_GROUPS + g) * 16 + i]; }
            M1[e] = (bf16)f2bf(v); }
        for (int e = tid; e < 32768; e += NTHR) { const int n = e >> 8, k = e & 255, ri = n >> 6, p = n & 63, sg = k >> 4, j = k & 15;
            const float pr = pw[((15 - sg) * 64 + p) * 2], pi = pw[((15 - sg) * 64 + p) * 2 + 1], br = bb[(p * 16 + j) * 2], bi = bb[(p * 16 + j) * 2 + 1];
            M2[e] = (bf16)f2bf(ri == 0 ? pr * br - pi * bi : pr * bi + pi * br); }
        for (int e = tid; e < 32768; e += NTHR) { const int n = e >> 7, k = e & 127, tau = n >> 4, i = n & 15, ri = k >> 6, p = k & 63;
            const float cr = cre[i * 64 + p], ci = cim[i * 64 + p], pr = pw[((tau + 1) * 64 + p) * 2], pi = pw[((tau + 1) * 64 + p) * 2 + 1];
            M3[e] = (bf16)f2bf(ri == 0 ? cr * pr - ci * pi : -(cr * pi + ci * pr)); }
        __syncthreads();
    }
}
__device__ __forceinline__ void p_s5_e(Frame& F, int l) {
    const KArgs ap = kargs(); const auto& a = *ap; WS_OPAQUE(a);
    const int tid = otid(), lane = tid & 63, wave = __builtin_amdgcn_readfirstlane(tid >> 6), r32 = lane & 31, hi = lane >> 5;
    const bf16* Z = (const bf16*)(wsb + a.off[R_Z]); float* E = (float*)(wsb + a.off[R_S5E]);
    for (int u = F.vcu * NWAVES + wave; u < S5_NBLK * S5_GROUPS; u += F.G * NWAVES) {
        const int blk = u / S5_GROUPS, g = u % S5_GROUPS;
        const unsigned char* tb = wsb + a.off[R_S5T] + (size_t)(l * S5_GROUPS + g) * S5_TSTRIDE;
        const GAS bf16x8* M2 = (const GAS bf16x8*)(tb + S5_M2);
        const bf16* zr = Z + (size_t)((blk * 32 + r32) * 16) * ZN + ZC_UC + g * 16 + 8 * hi;
        f32x16 acc[4];
#pragma unroll
        for (int nb = 0; nb < 4; ++nb)
#pragma unroll
            for (int r = 0; r < 16; ++r) acc[nb][r] = 0.f;
#pragma unroll 4
        for (int sg = 0; sg < 16; ++sg) { const bf16x8 af = *(const GAS bf16x8*)(zr + (size_t)sg * ZN);
#pragma unroll
            for (int nb = 0; nb < 4; ++nb) acc[nb] = __builtin_amdgcn_mfma_f32_32x32x16_bf16(af, M2[((nb * 32 + r32) * 256 + sg * 16 + 8 * hi) >> 3], acc[nb], 0, 0, 0); }
#pragma unroll
        for (int nb = 0; nb < 4; ++nb)
#pragma unroll
            for (int r = 0; r < 16; ++r) E[((size_t)(blk * 32 + crow_dev(r, hi)) * S5_GROUPS + g) * 128 + nb * 32 + r32] = acc[nb][r];
    }
}
__device__ __forceinline__ void s5_scan_task(const float* E, bf16* XP, const float* l16, int g, int c0, int nch, float xr, float xi, float* ore, float* oim, int lane) {
    const float lr = l16[lane], li = l16[64 + lane];
    int c = 0;
    for (; c + 8 <= nch; c += 8) { float er[8], ei[8];
#pragma unroll
        for (int q = 0; q < 8; ++q) { const float* e = E + ((size_t)(c0 + c + q) * S5_GROUPS + g) * 128; er[q] = e[lane]; ei[q] = e[64 + lane]; }
#pragma unroll
        for (int q = 0; q < 8; ++q) { bf16* xp = XP + ((size_t)(c0 + c + q) * S5_GROUPS + g) * 128; xp[lane] = (bf16)f2bf(xr); xp[64 + lane] = (bf16)f2bf(xi);
            const float nr = lr * xr - li * xi + er[q], ni = lr * xi + li * xr + ei[q]; xr = nr; xi = ni; } }
    for (; c < nch; ++c) { const float* e = E + ((size_t)(c0 + c) * S5_GROUPS + g) * 128; bf16* xp = XP + ((size_t)(c0 + c) * S5_GROUPS + g) * 128; xp[lane] = (bf16)f2bf(xr); xp[64 + lane] = (bf16)f2bf(xi);
        const float nr = lr * xr - li * xi + e[lane], ni = lr * xi + li * xr + e[64 + lane]; xr = nr; xi = ni; }
    ore[lane] = xr; oim[lane] = xi;
}
constexpr int S5_NTASK = (BATCH + DEC_BATCH) * S5_GROUPS;
__device__ __forceinline__ void s5_scan_run(Frame& F, int l, int t, int lane) {
    const KArgs ap = kargs(); const auto& a = *ap; WS_OPAQUE(a);
    const int sq = t / S5_GROUPS, g = t % S5_GROUPS;
    const float* E = (const float*)(wsb + a.off[R_S5E]); bf16* XP = (bf16*)(wsb + a.off[R_S5X]);
    const float* l16 = (const float*)(wsb + a.off[R_S5T] + (size_t)(l * S5_GROUPS + g) * S5_TSTRIDE + S5_L16);
    if (sq < BATCH) { const size_t oo = (((size_t)l * BATCH + sq) * S5_GROUPS + g) * S5_STATE;
        s5_scan_task(E, XP, l16, g, sq * (LPP / 16), S5_PCH, 0.f, 0.f, GOUT(a) + O_SRP + oo, GOUT(a) + O_SIP + oo, lane); }
    else { const int bs = sq - BATCH; const size_t oo = (((size_t)l * DEC_BATCH + bs) * S5_GROUPS + g) * S5_STATE;
        s5_scan_task(E, XP, l16, g, SROW0 / 16 + bs * (DEC_SEQ / 16), DEC_SEQ / 16, GIN(a, I_SRE)[oo + lane], GIN(a, I_SIM)[oo + lane], GOUT(a) + O_SRS + oo, GOUT(a) + O_SIS + oo, lane); }
}
__device__ __forceinline__ float gelu_tanh(float x) { const float z = 0.7978845608028654f * (x + 0.044715f * x * x * x); const float t = 1.f - 2.f * __builtin_amdgcn_rcpf(__expf(2.f * z) + 1.f); return 0.5f * x * (1.f + t); }
__device__ __forceinline__ void p_s5_out(Frame& F, int l) {
    const KArgs ap = kargs(); const auto& a = *ap; WS_OPAQUE(a);
    const int tid = otid(), lane = tid & 63, wave = __builtin_amdgcn_readfirstlane(tid >> 6), r32 = lane & 31, hi = lane >> 5;
    const bf16* Z = (const bf16*)(wsb + a.off[R_Z]); const bf16* XP = (const bf16*)(wsb + a.off[R_S5X]); bf16* YC = (bf16*)(wsb + a.off[R_YC]);
    constexpr int NB_TOT = S5_NBLK * S5_GROUPS * 8;
    const int gwv = F.vcu * NWAVES + wave, NGW = F.G * NWAVES;
    const int b0 = (int)((long long)gwv * NB_TOT / NGW), b1 = (int)((long long)(gwv + 1) * NB_TOT / NGW);
    for (int bb = b0; bb < b1; ++bb) {
        const int u = bb >> 3, nb = bb & 7, blk = u / S5_GROUPS, g = u % S5_GROUPS;
        const unsigned char* tb = wsb + a.off[R_S5T] + (size_t)(l * S5_GROUPS + g) * S5_TSTRIDE;
        const GAS bf16x8* M1 = (const GAS bf16x8*)(tb + S5_M1); const GAS bf16x8* M3 = (const GAS bf16x8*)(tb + S5_M3);
        const bf16* zr = Z + (size_t)((blk * 32 + r32) * 16) * ZN + ZC_UC + g * 16 + 8 * hi;
        const bf16* xr = XP + ((size_t)(blk * 32 + r32) * S5_GROUPS + g) * 128 + 8 * hi;
        f32x16 acc;
#pragma unroll
        for (int r = 0; r < 16; ++r) acc[r] = 0.f;
#pragma unroll
        for (int sg = 0; sg < 16; ++sg) acc = __builtin_amdgcn_mfma_f32_32x32x16_bf16(*(const GAS bf16x8*)(zr + (size_t)sg * ZN), M1[((nb * 32 + r32) * 256 + sg * 16 + 8 * hi) >> 3], acc, 0, 0, 0);
#pragma unroll
        for (int s = 0; s < 8; ++s) acc = __builtin_amdgcn_mfma_f32_32x32x16_bf16(*(const GAS bf16x8*)(xr + 16 * s), M3[((nb * 32 + r32) * 128 + s * 16 + 8 * hi) >> 3], acc, 0, 0, 0);
#pragma unroll
        for (int r = 0; r < 16; ++r) { const int row = (blk * 32 + crow_dev(r, hi)) * 16 + 2 * nb + (r32 >> 4);
            YC[(size_t)row * WIDTH_C + g * 16 + (r32 & 15)] = (bf16)f2bf(gelu_tanh(acc[r])); }
    }
}
__device__ __forceinline__ int rdlane_i(int v, int i) { return __builtin_amdgcn_readlane(v, i); }
constexpr float NEG_BIG = -3.0e38f;
__device__ __forceinline__ unsigned fkey(float v) { const unsigned u = __builtin_bit_cast(unsigned, v); return (u & 0x80000000u) ? ~u : (u | 0x80000000u); }
__device__ __forceinline__ int mbcnt64(unsigned long long m) { return __builtin_amdgcn_mbcnt_hi((unsigned)(m >> 32), __builtin_amdgcn_mbcnt_lo((unsigned)m, 0)); }
__device__ __forceinline__ void pro_wqs(Frame& F) {
    const KArgs ap = kargs(); const auto& a = *ap; WS_OPAQUE(a);
    const int tid = otid(), lane = tid & 63, wave = __builtin_amdgcn_readfirstlane(tid >> 6);
    bf16* WQ = (bf16*)(wsb + a.off[R_WQS]);
    LAS f32x4* skl = (LAS f32x4*)(F.lds + RING_OFF);
    typedef float f32x2w __attribute__((ext_vector_type(2)));
    for (int t = F.vcu; t < DEPTH * 64; t += F.G) {
        const int l = t >> 6, hc = (t >> 2) & 15, kh = (t >> 1) & 1, nh = t & 1, k = (kh * 8 + wave) * 64 + lane;
        __syncthreads();
        { const GAS f32x4* src = (const GAS f32x4*)(GIN(a, I_PSK) + (((size_t)l * 16 + hc) * 128 + nh * 64) * 128);
#pragma unroll
          for (int q = 0; q < 4; ++q) skl[tid + NTHR * q] = src[tid + NTHR * q]; }
        const float* wr = GIN(a, I_PWQ) + ((size_t)l * D_MODEL + k) * PQ + hc * 128;
        f32x4 w[32];
#pragma unroll
        for (int d = 0; d < 32; ++d) w[d] = *(const GAS f32x4*)(wr + 4 * d);
        const float g2k = GIN(a, I_N2)[(size_t)l * D_MODEL + k];
        bf16* o = WQ + ((size_t)l * PQ + hc * 128 + nh * 64) * D_MODEL + k;
        __syncthreads();
#pragma clang loop vectorize(disable) unroll(disable)
        for (int n = 0; n < 64; ++n) { LAS f32x4* sr = skl + n * 32; f32x2w a0 = {0.f, 0.f}, a1 = {0.f, 0.f};
#pragma unroll
            for (int d = 0; d < 32; ++d) { const f32x4 s = sr[d]; a0 += (f32x2w){w[d].x, w[d].y} * (f32x2w){s.x, s.y}; a1 += (f32x2w){w[d].z, w[d].w} * (f32x2w){s.z, s.w}; }
            o[(size_t)n * D_MODEL] = (bf16)f2bf(((a0.x + a0.y) + (a1.x + a1.y)) * g2k); }
    }
    __syncthreads();
}
__device__ __forceinline__ void pro_wrest(Frame& F) {
    const KArgs ap = kargs(); const auto& a = *ap; WS_OPAQUE(a);
    const int tid = otid(), lane = tid & 63, wave = __builtin_amdgcn_readfirstlane(tid >> 6);
    LAS float* scr = (LAS float*)(F.lds + RING_OFF + wave * 16384);
    const int gw = F.vcu * NWAVES + wave, NGW = F.G * NWAVES;
    bf16* WG = (bf16*)(wsb + a.off[R_WGLU]); bf16* WB = (bf16*)(wsb + a.off[R_WBR]); bf16* WO = (bf16*)(wsb + a.off[R_WOUT]);
    constexpr int IG = (512 / 64) * (1024 / 32), IB = IG, IO = (1024 / 64) * (1024 / 32), IL = IG + 3 * IB + IO;
    TrItem A, B;
#define WR_LOAD(T, it_) do { const int l_ = (it_) / IL; int r_ = (it_) % IL; \
        if (r_ < IG) tr_load(T, GIN(a, I_WGLU) + (size_t)l_ * 512 * 1024, 1024, 32 * (r_ % 32), 64 * (r_ / 32), CmGlu(), lane); \
        else if (r_ < IG + 3 * IB) { const int w_ = (r_ - IG) / IB, q_ = (r_ - IG) % IB; tr_load(T, GIN(a, I_WBA + w_) + (size_t)l_ * 512 * 1024, 1024, 32 * (q_ % 32), 64 * (q_ / 32), CmId(), lane); } \
        else { r_ -= IG + 3 * IB; tr_load(T, GIN(a, I_WOUT) + (size_t)l_ * 1024 * 1024, 1024, 32 * (r_ % 32), 64 * (r_ / 32), CmId(), lane); } } while (0)
    if (gw < DEPTH * IL) WR_LOAD(A, gw);
    for (int it = gw; it < DEPTH * IL; it += NGW) { const int l = it / IL; int r = it % IL;
        if (it + NGW < DEPTH * IL) WR_LOAD(B, it + NGW);
        if (r < IG) tr_store(A, 512, WG + (size_t)l * 1024 * 512, 32 * (r % 32), 64 * (r / 32), scr, lane);
        else if (r < IG + 3 * IB) { const int w = (r - IG) / IB, q = (r - IG) % IB; tr_store(A, 512, WB + ((size_t)l * 3 + w) * 1024 * 512, 32 * (q % 32), 64 * (q / 32), scr, lane); }
        else { r -= IG + 3 * IB; tr_store(A, 1024, WO + (size_t)l * 1024 * 1024, 32 * (r % 32), 64 * (r / 32), scr, lane); }
        A = B; }
#undef WR_LOAD
}
typedef float f32x2v __attribute__((ext_vector_type(2)));
__device__ __forceinline__ unsigned pk_i8(const f32x4 x, float inv) {
    const int a = (int)rintf(x.x * inv), b = (int)rintf(x.y * inv), c = (int)rintf(x.z * inv), d = (int)rintf(x.w * inv);
    return (unsigned)(a & 0xff) | ((unsigned)(b & 0xff) << 8) | ((unsigned)(c & 0xff) << 16) | ((unsigned)(d & 0xff) << 24); }
constexpr size_t PEER_ROWS = (size_t)DEPTH * N_EXPERTS; constexpr int PU_ROWB = 512;
typedef unsigned v3u __attribute__((ext_vector_type(3)));
typedef unsigned v3u_a4 __attribute__((ext_vector_type(3), aligned(4)));
__device__ __forceinline__ float absmax16(const f32x4 x0, const f32x4 x1, const f32x4 x2, const f32x4 x3) {
    float mx = fmaxf(fmaxf(fmaxf(fabsf(x0.x), fabsf(x0.y)), fmaxf(fabsf(x0.z), fabsf(x0.w))), fmaxf(fmaxf(fabsf(x1.x), fabsf(x1.y)), fmaxf(fabsf(x1.z), fabsf(x1.w))));
    return fmaxf(mx, fmaxf(fmaxf(fmaxf(fabsf(x2.x), fabsf(x2.y)), fmaxf(fabsf(x2.z), fabsf(x2.w))), fmaxf(fmaxf(fabsf(x3.x), fabsf(x3.y)), fmaxf(fabsf(x3.z), fabsf(x3.w)))));
}
__device__ __forceinline__ unsigned pk_fp8(const f32x4 x, float inv) { int t = __builtin_amdgcn_cvt_pk_fp8_f32(x.x * inv, x.y * inv, 0, false); t = __builtin_amdgcn_cvt_pk_fp8_f32(x.z * inv, x.w * inv, t, true); return (unsigned)t; }
constexpr int PW_RB = 8, PW_IR = NWAVES * PW_RB, PW_ITEMS_L = 2 * (N_EXPERTS / PW_IR), PW_ITEMS = DEPTH * PW_ITEMS_L, CW_PWQ = CW_QUEUE + 64 * 24;
__device__ __forceinline__ void peerw_item(Frame& F, int it) {
    const KArgs ap = kargs(); const auto& a = *ap; WS_OPAQUE(a);
    const int tid = otid(), lane = tid & 63, wave = __builtin_amdgcn_readfirstlane(tid >> 6);
    float* SCL = (float*)(wsb + a.off[R_MISC]);
    constexpr int RB = PW_RB;
    const int l = it / PW_ITEMS_L, r_ = it % PW_ITEMS_L, w = r_ / (N_EXPERTS / PW_IR), blk = r_ % (N_EXPERTS / PW_IR);
    const size_t row0 = (size_t)l * N_EXPERTS + blk * PW_IR + wave * RB, rw0 = row0 + (w ? PEER_ROWS : 0);
    f32x4 x[RB][4];
#pragma unroll
    for (int r = 0; r < RB; ++r) { const GAS f32x4* src = (const GAS f32x4*)(GIN(a, I_PU + w) + (row0 + r) * D_MODEL) + 4 * lane;
#pragma unroll
        for (int j = 0; j < 4; ++j) x[r][j] = src[j]; }
#pragma unroll
    for (int r = 0; r < RB; ++r) { const float mx = wave_max(absmax16(x[r][0], x[r][1], x[r][2], x[r][3])); v4u o;
        if (w == 0) { float s2_ = 0.f;
#pragma unroll
            for (int j = 0; j < 4; ++j) s2_ += (x[r][j].x * x[r][j].x + x[r][j].y * x[r][j].y) + (x[r][j].z * x[r][j].z + x[r][j].w * x[r][j].w);
            const float clip = fminf(mx, 2.6f * __builtin_sqrtf(wave_sum(s2_) * (1.f / D_MODEL)));
            const float inv = clip > 0.f ? 7.f / clip : 0.f;
            v2u o2;
#pragma unroll
            for (int d = 0; d < 2; ++d) { const f32x4 xa = x[r][2 * d], xb = x[r][2 * d + 1];
#define PW_Q4(v_) ((unsigned)((int)fminf(fmaxf(rintf((v_) * inv), -7.f), 7.f) + 8))
                const unsigned w_ = PW_Q4(xa.x) | (PW_Q4(xa.y) << 4) | (PW_Q4(xa.z) << 8) | (PW_Q4(xa.w) << 12) | (PW_Q4(xb.x) << 16) | (PW_Q4(xb.y) << 20) | (PW_Q4(xb.z) << 24) | (PW_Q4(xb.w) << 28);
#undef PW_Q4
                if (d == 0) o2.x = w_; else o2.y = w_; }
            if (lane == 0) SCL[rw0 + r] = clip * (1.f / 7.f);
            *((GAS v2u*)(wsb + a.off[R_PU] + (row0 + r) * PU_ROWB) + lane) = o2; }
        else { const float inv = mx > 0.f ? 416.f / mx : 0.f; o.x = pk_fp8(x[r][0], inv); o.y = pk_fp8(x[r][1], inv); o.z = pk_fp8(x[r][2], inv); o.w = pk_fp8(x[r][3], inv);
            if (lane == 0) SCL[rw0 + r] = mx * (1.f / 416.f);
            *((GAS v4u*)(wsb + a.off[R_PV] + (row0 + r) * D_MODEL) + lane) = o; } }
}
__device__ __forceinline__ void peerw_drain(Frame& F, int limit) {
    const KArgs ap = kargs(); const auto& a = *ap; WS_OPAQUE(a);
    const bool lead = F.wv == 0 && lane_id() == 0;
    for (;;) {
        if (lead) { const unsigned kept = F.MISC[23]; F.MISC[23] = 0u; F.MISC[24] = kept ? 1u : 0u;
            F.MISC[21] = kept ? kept - 1u : (F.MISC[22] ? (unsigned)PW_ITEMS : __hip_atomic_fetch_add((gu32*)wsb + CW_PWQ, 1u, RLX_AGENT)); }
        __syncthreads();
        const int it = (int)F.MISC[21]; const bool kept = F.MISC[24] != 0u;
        __syncthreads();
        if (it >= PW_ITEMS) { if (lead) F.MISC[22] = 1u; break; }
        peerw_item(F, it);
        if (!kept && it >= limit) break;
    }
}
__device__ __forceinline__ void xcd_barrier_steal(const XcdBarrier& b, Frame& F) {
    const KArgs ap = kargs(); const auto& a = *ap; WS_OPAQUE(a);
    asm volatile("s_waitcnt vmcnt(0)" ::: "memory");
    __syncthreads();
    const bool lead = b.wv == 0 && lane_id() == 0;
    unsigned gen = 0u;
    if (lead) {
        unsigned* bar = b.bar;
        __builtin_amdgcn_s_waitcnt(0);
        unsigned nloc = b.st[0], nx = b.st[1];
        if (nloc == 0u) { xcd_barrier_complete(bar, b.x, nloc, nx); b.st[0] = nloc; b.st[1] = nx; }
        const unsigned old = xb_add(&bar[XB_XSUB(b.x)], 1u);
        gen = old / nloc;
        if (old + 1u == (gen + 1u) * nloc) {
            __builtin_amdgcn_fence(__ATOMIC_RELEASE, "agent");
            asm volatile("s_waitcnt vmcnt(0)" ::: "memory");
            const unsigned og = xb_add(&bar[XB_TOP], 1u);
            const unsigned tg = og / nx;
            if (og + 1u == (tg + 1u) * nx) xb_add(&bar[XB_TOPGEN], 1u);
            else XB_SPIN(xb_ld(&bar[XB_TOPGEN]) == tg, bar);
            __builtin_amdgcn_fence(__ATOMIC_ACQUIRE, "agent");
            xb_add(&bar[XB_XGEN(b.x)], 1u);
            asm volatile("s_waitcnt vmcnt(0)" ::: "memory");
            F.MISC[20] = 1u;
        } else F.MISC[20] = 0u;
    }
    unsigned sp = 0u;
    for (;;) {
        if (lead && F.MISC[20] == 0u) {
            unsigned* bar = b.bar;
            bool rel = xb_ld(&bar[XB_XGEN(b.x)]) != gen;
            if (!rel && F.MISC[22] && !F.MISC[23]) {
                XB_SPIN(xb_ld(&bar[XB_XGEN(b.x)]) == gen, bar); rel = true; }
            if (!rel && (++sp & 1023u) == 0u && xb_ld(&bar[XB_TMO])) rel = true;
            if (rel) { __builtin_amdgcn_fence(__ATOMIC_ACQUIRE, "agent"); asm volatile("s_waitcnt vmcnt(0)" ::: "memory"); F.MISC[20] = 1u; }
            else { const unsigned kept = F.MISC[23]; F.MISC[23] = 0u;
                const unsigned it = kept ? kept - 1u : __hip_atomic_fetch_add((gu32*)wsb + CW_PWQ, 1u, RLX_AGENT); F.MISC[21] = it; if (it >= (unsigned)PW_ITEMS) F.MISC[22] = 1u; }
        }
        __syncthreads();
        const unsigned done = F.MISC[20], it = F.MISC[21];
        __syncthreads();
        if (done) break;
        if (it < (unsigned)PW_ITEMS) {
            const bool ahead = lead && !F.MISC[22]; unsigned nxi = 0u;
            if (ahead) nxi = __hip_atomic_fetch_add((gu32*)wsb + CW_PWQ, 1u, RLX_AGENT);
            peerw_item(F, (int)it);
            if (ahead) { if (nxi < (unsigned)PW_ITEMS) F.MISC[23] = nxi + 1u; else F.MISC[22] = 1u; }
        }
    }
}
__device__ __forceinline__ void pro_peerw(Frame& F) { for (int it = F.vcu; it < PW_ITEMS; it += F.G) peerw_item(F, it); }
__device__ __forceinline__ void fp8x16_to_f32(const v4u q, float (&f)[16]) {
#pragma unroll
    for (int d = 0; d < 4; ++d) { const int w = (int)(d == 0 ? q.x : d == 1 ? q.y : d == 2 ? q.z : q.w);
        const f32x2v lo = __builtin_amdgcn_cvt_pk_f32_fp8(w, false), hi = __builtin_amdgcn_cvt_pk_f32_fp8(w, true); f[4 * d] = lo.x; f[4 * d + 1] = lo.y; f[4 * d + 2] = hi.x; f[4 * d + 3] = hi.y; }
}
#define PK_BIS(NDPP) do { if (!kdone) { const unsigned t_ = kp | (1u << kbit); int c_ = 0; _Pragma("unroll") for (int c4 = 0; c4 < 8; ++c4) { const v4u k4 = keys[c4 * 64 + lane]; \
            c_ += (k4.x >= t_ ? 1 : 0) + (k4.y >= t_ ? 1 : 0); c_ += (k4.z >= t_ ? 1 : 0) + (k4.w >= t_ ? 1 : 0); } \
        c_ += dpp_i<0xB1>(c_); c_ += dpp_i<0x4E>(c_); if (NDPP == 3) c_ += dpp_i<0x141>(c_); const bool up_ = c_ >= 16; kp = up_ ? t_ : kp; kcp = up_ ? c_ : kcp; --kbit; \
        kdone = (__ballot(kcp != 16) == 0ull) || kbit < 0; } } while (0)
__device__ __forceinline__ void p_peer(Frame& F, int l, bool dry) {
    const KArgs ap = kargs(); const auto& a = *ap; WS_OPAQUE(a);
    const int tid = otid(), lane = tid & 63, wave = __builtin_amdgcn_readfirstlane(tid >> 6);
    const float* SC = (const float*)(wsb + a.off[R_SC]); float* X = (float*)(wsb + a.off[R_X]);
    const unsigned char* PU = wsb + a.off[R_PU] + (size_t)l * N_EXPERTS * PU_ROWB; const unsigned char* PV = wsb + a.off[R_PV] + (size_t)l * N_EXPERTS * D_MODEL;
    const float* SCU = (const float*)(wsb + a.off[R_MISC]) + (size_t)l * N_EXPERTS; const float* SCV = SCU + PEER_ROWS;
    LAS float* stop = (LAS float*)(F.lds + RING_OFF + wave * 4096);
    LAS int* itop = (LAS int*)(stop + 256);
    LAS int* elb = itop + 256;
    LAS float* cfb = (LAS float*)(elb + 256);
    gu32* rq = (gu32*)wsb + CW_QUEUE + 64 * (8 + l + (dry ? DEPTH : 0));
    LAS v4u* keys = (LAS v4u*)(F.lds + RING_OFF + 32768 + wave * 8192);
    unsigned kp = 0u, kL1 = 0u; int kbit = 31, kcp = 1 << 20; bool kdone = false; float rsn = 0.f, hscn = 0.f; v4u hqn = {0u, 0u, 0u, 0u};
#define PK_WINDOW(NDPP, LVAR) do {   \
        unsigned mx_ = kk_[0]; _Pragma("unroll") for (int j = 1; j < 32; ++j) mx_ = mx_ > kk_[j] ? mx_ : kk_[j]; \
        { unsigned o_ = (unsigned)dpp_i<0xB1>((int)mx_); mx_ = mx_ > o_ ? mx_ : o_; o_ = (unsigned)dpp_i<0x4E>((int)mx_); mx_ = mx_ > o_ ? mx_ : o_; if (NDPP == 3) { o_ = (unsigned)dpp_i<0x141>((int)mx_); mx_ = mx_ > o_ ? mx_ : o_; } } \
        unsigned L_ = mx_ > (3u << 23) ? mx_ - (3u << 23) : 0u; int c_ = 0; _Pragma("unroll") for (int j = 0; j < 32; ++j) c_ += kk_[j] >= L_ ? 1 : 0; \
        c_ += dpp_i<0xB1>(c_); c_ += dpp_i<0x4E>(c_); if (NDPP == 3) c_ += dpp_i<0x141>(c_); \
        const bool ok_ = __ballot(c_ < 16 || L_ == 0u) == 0ull; L_ = ok_ ? L_ - 1u : 0u; kbit = ok_ ? 24 : 31; LVAR = L_;     \
        _Pragma("unroll") for (int j = 0; j < 8; ++j) { v4u w_; w_.x = (kk_[4 * j] > L_ ? kk_[4 * j] : L_) - L_; w_.y = (kk_[4 * j + 1] > L_ ? kk_[4 * j + 1] : L_) - L_; w_.z = (kk_[4 * j + 2] > L_ ? kk_[4 * j + 2] : L_) - L_; w_.w = (kk_[4 * j + 3] > L_ ? kk_[4 * j + 3] : L_) - L_; keys[j * 64 + lane] = w_; } \
        kp = 0u; kcp = 1 << 20; kdone = false; } while (0)
#define PK_BEGIN(m_) do {   \
        float hx_[16]; { const GAS f32x4* xr0 = (const GAS f32x4*)(X + (size_t)(m_) * D_MODEL + 16 * lane); const GAS f32x4* g4 = (const GAS f32x4*)(GIN(a, I_N2) + (size_t)l * D_MODEL + 16 * lane); float s2 = 0.f; \
          _Pragma("unroll") for (int j = 0; j < 4; ++j) { const f32x4 xv = xr0[j], gv = g4[j]; s2 += (xv.x * xv.x + xv.y * xv.y) + (xv.z * xv.z + xv.w * xv.w); hx_[4 * j] = xv.x * gv.x; hx_[4 * j + 1] = xv.y * gv.y; hx_[4 * j + 2] = xv.z * gv.z; hx_[4 * j + 3] = xv.w * gv.w; } \
          rsn = __builtin_amdgcn_rsqf(wave_sum(s2) * (1.f / D_MODEL) + EPSF); } \
        float hmx = 0.f; _Pragma("unroll") for (int j = 0; j < 16; ++j) { hx_[j] *= rsn; hmx = fmaxf(hmx, fabsf(hx_[j])); } \
        hmx = wave_max(hmx); const float hinv = hmx > 0.f ? 127.f / hmx : 0.f; hscn = hmx * (1.f / 127.f); \
        hqn.x = pk_i8((f32x4){hx_[0], hx_[2], hx_[4], hx_[6]}, hinv); hqn.y = pk_i8((f32x4){hx_[1], hx_[3], hx_[5], hx_[7]}, hinv); hqn.z = pk_i8((f32x4){hx_[8], hx_[10], hx_[12], hx_[14]}, hinv); hqn.w = pk_i8((f32x4){hx_[9], hx_[11], hx_[13], hx_[15]}, hinv);     \
        { const GAS f32x4* p4 = (const GAS f32x4*)(SC + (size_t)(m_) * PQ + (lane >> 2) * 128 + (lane & 3) * 32); \
          unsigned kk_[32]; _Pragma("unroll") for (int j = 0; j < 8; ++j) { const f32x4 v = p4[j]; kk_[4 * j] = fkey(v.x); kk_[4 * j + 1] = fkey(v.y); kk_[4 * j + 2] = fkey(v.z); kk_[4 * j + 3] = fkey(v.w); } \
          PK_WINDOW(2, kL1); } } while (0)
#define PK_MID() do {   \
        { int cl = 0; _Pragma("unroll") for (int c4 = 0; c4 < 8; ++c4) { const v4u k4 = keys[c4 * 64 + lane]; cl += (k4.x >= kp ? 1 : 0) + (k4.y >= kp ? 1 : 0) + (k4.z >= kp ? 1 : 0) + (k4.w >= kp ? 1 : 0); } \
          const int q_ = lane & 3, c0 = dpp_i<0x00>(cl), c1 = dpp_i<0x55>(cl), c2 = dpp_i<0xAA>(cl); int pos = (q_ > 0 ? c0 : 0) + (q_ > 1 ? c1 : 0) + (q_ > 2 ? c2 : 0); const int sb = (lane >> 2) * 16; \
          _Pragma("unroll") for (int c4 = 0; c4 < 8; ++c4) { const v4u k4 = keys[c4 * 64 + lane]; _Pragma("unroll") for (int e = 0; e < 4; ++e) { const unsigned kj = k4[e]; const bool sel = kj >= kp; \
              if (sel && pos < 16) { const unsigned kf_ = kj + kL1; const unsigned u_ = (kf_ & 0x80000000u) ? (kf_ ^ 0x80000000u) : ~kf_; stop[sb + pos] = __builtin_bit_cast(float, u_); itop[sb + pos] = q_ * 32 + 4 * c4 + e; } \
              pos += sel ? 1 : 0; } } } \
        LDS_WAIT(); \
        { const int h_ = lane >> 3, sub = lane & 7; const float s1a = stop[(2 * h_) * 16 + 2 * sub], s1b = stop[(2 * h_) * 16 + 2 * sub + 1]; \
          unsigned kk_[32]; _Pragma("unroll") for (int c4 = 0; c4 < 4; ++c4) { const f32x4 s2_ = *(LAS f32x4*)(stop + (2 * h_ + 1) * 16 + 4 * c4); \
              kk_[4 * c4] = fkey(s1a + s2_.x); kk_[4 * c4 + 1] = fkey(s1a + s2_.y); kk_[4 * c4 + 2] = fkey(s1a + s2_.z); kk_[4 * c4 + 3] = fkey(s1a + s2_.w); \
              kk_[16 + 4 * c4] = fkey(s1b + s2_.x); kk_[17 + 4 * c4] = fkey(s1b + s2_.y); kk_[18 + 4 * c4] = fkey(s1b + s2_.z); kk_[19 + 4 * c4] = fkey(s1b + s2_.w); } \
          unsigned kL2_; PK_WINDOW(3, kL2_); (void)kL2_; } } while (0)
#define PK_END(nb_) do {   \
        LAS int* el_ = elb + 128 * (nb_); LAS float* cf_ = cfb + 128 * (nb_); const int h_ = lane >> 3, sub = lane & 7; \
        int cl = 0; _Pragma("unroll") for (int c4 = 0; c4 < 8; ++c4) { const v4u k4 = keys[c4 * 64 + lane]; cl += (k4.x >= kp ? 1 : 0) + (k4.y >= kp ? 1 : 0) + (k4.z >= kp ? 1 : 0) + (k4.w >= kp ? 1 : 0); } \
        int x_ = cl; { int t_ = dpp_i<0x111>(x_); x_ += sub >= 1 ? t_ : 0; t_ = dpp_i<0x112>(x_); x_ += sub >= 2 ? t_ : 0; t_ = dpp_i<0x114>(x_); x_ += sub >= 4 ? t_ : 0; } \
        int pos = x_ - cl; \
        const float s1a = stop[(2 * h_) * 16 + 2 * sub], s1b = stop[(2 * h_) * 16 + 2 * sub + 1]; float s2_[16]; float cmax = NEG_BIG; \
        _Pragma("unroll") for (int j = 0; j < 16; ++j) { s2_[j] = stop[(2 * h_ + 1) * 16 + j]; cmax = fmaxf(cmax, s2_[j]); } \
        cmax += fmaxf(s1a, s1b); cmax = fmaxf(cmax, dpp_f<0xB1>(cmax)); cmax = fmaxf(cmax, dpp_f<0x4E>(cmax)); cmax = fmaxf(cmax, dpp_f<0x141>(cmax)); \
        const int i1a = itop[(2 * h_) * 16 + 2 * sub] * N_KEYS, i1b = itop[(2 * h_) * 16 + 2 * sub + 1] * N_KEYS; float esum = 0.f; \
        _Pragma("unroll") for (int c4 = 0; c4 < 8; ++c4) { const v4u k4 = keys[c4 * 64 + lane]; _Pragma("unroll") for (int e = 0; e < 4; ++e) { const int j = 4 * c4 + e; const bool sel = k4[e] >= kp; \
            if (sel && pos < 16) { const float ex = __expf(rsn * ((j < 16 ? s1a : s1b) + s2_[j & 15] - cmax)); esum += ex; \
                el_[h_ * 16 + pos] = (j < 16 ? i1a : i1b) + itop[(2 * h_ + 1) * 16 + (j & 15)]; cf_[h_ * 16 + pos] = ex; } \
            pos += sel ? 1 : 0; } } \
        esum = sum8(esum); const float inv_ = __builtin_amdgcn_rcpf(esum); \
        LDS_WAIT(); cf_[2 * lane] *= inv_; cf_[2 * lane + 1] *= inv_; LDS_WAIT(); } while (0)
    int cur = __builtin_amdgcn_readfirstlane(lane == 0 ? (int)__hip_atomic_fetch_add(rq, 1u, RLX_AGENT) : 0);
    if (cur >= NT) return;
    int nxt = __builtin_amdgcn_readfirstlane(lane == 0 ? (int)__hip_atomic_fetch_add(rq, 1u, RLX_AGENT) : 0);
    int buf = 0;
    PK_BEGIN(nat2prow(cur));
#pragma clang loop unroll(disable)
    for (int s = 0; s < 32; ++s) PK_BIS(2);
    PK_MID();
#pragma clang loop unroll(disable)
    for (int s = 0; s < 32; ++s) PK_BIS(3);
    PK_END(0);
    const bool lb0 = (lane & 1) != 0, lb1 = (lane & 2) != 0;
    for (;;) {
        const int m = nat2prow(cur); const bool has_next = nxt < NT;
        const v4u hq = hqn; const float hsc = hscn;
        LAS int* elist = elb + 128 * buf; LAS float* cf = cfb + 128 * buf;
        float out[16];
#pragma unroll
        for (int j = 0; j < 16; ++j) out[j] = 0.f;
        const int hs8 = -8 * __builtin_amdgcn_sdot4((int)hq.w, 0x01010101, __builtin_amdgcn_sdot4((int)hq.z, 0x01010101, __builtin_amdgcn_sdot4((int)hq.y, 0x01010101, __builtin_amdgcn_sdot4((int)hq.x, 0x01010101, 0, false), false), false), false);
        v2u uA[4], uB[4]; v4u vA[4], vB[4]; float suA, svA, cA, suB, svB, cB;
#define PEER_LOAD(U, V, SU, SV, CW, q0) do { { const int em_ = elist[(q0) + (lane & 3)]; CW = cf[(q0) + (lane & 3)]; SU = SCU[em_]; SV = SCV[em_]; } _Pragma("unroll") for (int i = 0; i < 4; ++i) { const int e_ = elist[(q0) + i]; \
            U[i] = *((const GAS v2u*)(PU + (size_t)e_ * PU_ROWB) + lane); V[i] = *((const GAS v4u*)(PV + (size_t)e_ * D_MODEL) + lane); } } while (0)
#define PEER_COMP(U, V, SU, SV, CW) do { float d_[4]; _Pragma("unroll") for (int i = 0; i < 4; ++i) { \
            int di_ = __builtin_amdgcn_sdot4((int)(U[i].x & 0x0f0f0f0fu), (int)hq.x, hs8, false); di_ = __builtin_amdgcn_sdot4((int)((U[i].x >> 4) & 0x0f0f0f0fu), (int)hq.y, di_, false); \
            di_ = __builtin_amdgcn_sdot4((int)(U[i].y & 0x0f0f0f0fu), (int)hq.z, di_, false); di_ = __builtin_amdgcn_sdot4((int)((U[i].y >> 4) & 0x0f0f0f0fu), (int)hq.w, di_, false); d_[i] = (float)di_; } \
              \
            const float r0_ = (lb0 ? d_[1] : d_[0]) + dpp_f<0xB1>(lb0 ? d_[0] : d_[1]), r1_ = (lb0 ? d_[3] : d_[2]) + dpp_f<0xB1>(lb0 ? d_[2] : d_[3]); \
            float dsel_ = (lb1 ? r1_ : r0_) + dpp_f<0x4E>(lb1 ? r0_ : r1_); \
            dsel_ += dpp_f<0x124>(dsel_); dsel_ += dpp_f<0x128>(dsel_);                                        \
            dsel_ += swap16(dsel_); dsel_ += swap32(dsel_);                                                       \
            const float ccv_ = CW * gelu_tanh(dsel_ * hsc * SU) * SV; \
            _Pragma("unroll") for (int i = 0; i < 4; ++i) { const float cc = rdlane(ccv_, 60 + i); float t[16]; fp8x16_to_f32(V[i], t); _Pragma("unroll") for (int j = 0; j < 16; ++j) out[j] += cc * t[j]; } } while (0)
        PEER_LOAD(uA, vA, suA, svA, cA, 0);
        PK_BEGIN(has_next ? nat2prow(nxt) : m);
#pragma clang loop unroll(disable)
        for (int q = 0; q < 64; q += 8) {
            PEER_LOAD(uB, vB, suB, svB, cB, q + 4);
            PK_BIS(2); PK_BIS(2);
            PEER_COMP(uA, vA, suA, svA, cA);
            PEER_LOAD(uA, vA, suA, svA, cA, q + 8);
            PK_BIS(2); PK_BIS(2);
            PEER_COMP(uB, vB, suB, svB, cB);
        }
        PK_MID();
#pragma clang loop unroll(disable)
        for (int q = 64; q < 128; q += 8) {
            PEER_LOAD(uB, vB, suB, svB, cB, q + 4);
            PK_BIS(3); PK_BIS(3);
            PEER_COMP(uA, vA, suA, svA, cA);
            if (q + 8 < 128) PEER_LOAD(uA, vA, suA, svA, cA, q + 8);
            PK_BIS(3); PK_BIS(3);
            PEER_COMP(uB, vB, suB, svB, cB);
        }
        PK_END(buf ^ 1);
#undef PEER_LOAD
#undef PEER_COMP
        if (!dry) { GAS f32x4* xr = (GAS f32x4*)(X + (size_t)m * D_MODEL + 16 * lane);
          f32x4 xv[4]; float s2 = 0.f;
#pragma unroll
          for (int j = 0; j < 4; ++j) { xv[j] = xr[j] + (f32x4){out[4 * j], out[4 * j + 1], out[4 * j + 2], out[4 * j + 3]}; s2 += (xv[j].x * xv[j].x + xv[j].y * xv[j].y) + (xv[j].z * xv[j].z + xv[j].w * xv[j].w); }
          const float rn = __builtin_amdgcn_rsqf(wave_sum(s2) * (1.f / D_MODEL) + EPSF);
          if (l + 1 < DEPTH) {
#pragma unroll
              for (int j = 0; j < 4; ++j) xr[j] = xv[j];
              const GAS f32x4* gr = (const GAS f32x4*)(GIN(a, I_N1) + (size_t)(l + 1) * D_MODEL + 16 * lane); float o16[16];
#pragma unroll
              for (int j = 0; j < 4; ++j) { const f32x4 gg = gr[j]; o16[4 * j] = xv[j].x * rn * gg.x; o16[4 * j + 1] = xv[j].y * rn * gg.y; o16[4 * j + 2] = xv[j].z * rn * gg.z; o16[4 * j + 3] = xv[j].w * rn * gg.w; }
              v4u w0, w1; w0.x = pk2(o16[0], o16[1]); w0.y = pk2(o16[2], o16[3]); w0.z = pk2(o16[4], o16[5]); w0.w = pk2(o16[6], o16[7]); w1.x = pk2(o16[8], o16[9]); w1.y = pk2(o16[10], o16[11]); w1.z = pk2(o16[12], o16[13]); w1.w = pk2(o16[14], o16[15]);
              GAS v4u* xo = (GAS v4u*)((bf16*)(wsb + a.off[R_XN]) + (size_t)m * D_MODEL + 16 * lane); xo[0] = w0; xo[1] = w1;
          } else {
              float* dst = nullptr;
              if (m >= SROW0) dst = GOUT(a) + O_YS + (size_t)(m - SROW0) * D_MODEL; else { const int b_ = m / LPP, p_ = m % LPP; if (p_ >= PADF + N_META) dst = GOUT(a) + O_YP + ((size_t)b_ * SEQ + (p_ - PADF - N_META)) * D_MODEL; }
              if (dst) { const GAS f32x4* gr = (const GAS f32x4*)(GIN(a, I_FN) + 16 * lane); GAS f32x4* o = (GAS f32x4*)(dst + 16 * lane);
#pragma unroll
                  for (int j = 0; j < 4; ++j) { const f32x4 gg = gr[j]; o[j] = (f32x4){xv[j].x * rn * gg.x, xv[j].y * rn * gg.y, xv[j].z * rn * gg.z, xv[j].w * rn * gg.w}; } }
          } }
        if (!has_next) break;
        cur = nxt; buf ^= 1;
        nxt = __builtin_amdgcn_readfirstlane(lane == 0 ? (int)__hip_atomic_fetch_add(rq, 1u, RLX_AGENT) : 0);
    }
#undef PK_BEGIN
#undef PK_WINDOW
#undef PK_MID
#undef PK_END
}
#undef PK_BIS
__device__ __forceinline__ void p_final(Frame& F) {
    const KArgs ap = kargs(); const auto& a = *ap; WS_OPAQUE(a);
    const int tid = otid(), lane = tid & 63, wave = __builtin_amdgcn_readfirstlane(tid >> 6);
    const float* X = (const float*)(wsb + a.off[R_X]); const float* g = GIN(a, I_FN);
    for (int m = F.vcu * NWAVES + wave; m < RP; m += F.G * NWAVES) {
        float* dst;
        if (m >= SROW0) dst = GOUT(a) + O_YS + (size_t)(m - SROW0) * D_MODEL;
        else { const int b = m / LPP, p = m % LPP; if (p < PADF + N_META || p >= PEND) continue; dst = GOUT(a) + O_YP + ((size_t)b * SEQ + (p - PADF - N_META)) * D_MODEL; }
        const GAS f32x4* xr = (const GAS f32x4*)(X + (size_t)m * D_MODEL) + lane;
        f32x4 v[4]; float s2 = 0.f;
#pragma unroll
        for (int j = 0; j < 4; ++j) { v[j] = xr[64 * j]; s2 += (v[j].x * v[j].x + v[j].y * v[j].y) + (v[j].z * v[j].z + v[j].w * v[j].w); }
        const float r = __builtin_amdgcn_rsqf(wave_sum(s2) * (1.f / D_MODEL) + EPSF);
        const GAS f32x4* gr = (const GAS f32x4*)g + lane; GAS f32x4* o = (GAS f32x4*)dst + lane;
#pragma unroll
        for (int j = 0; j < 4; ++j) { const f32x4 gg = gr[64 * j]; o[64 * j] = (f32x4){v[j].x * r * gg.x, v[j].y * r * gg.y, v[j].z * r * gg.z, v[j].w * r * gg.w}; }
    }
}

__device__ __forceinline__ void p_prologue(Frame& F, int pmsel = -1) {
    if (pmsel & PM_NORM0) p_norm0(F);
    const KArgs ap = kargs(); const auto& a = *ap; WS_OPAQUE(a);
    const int tid = otid(), lane = tid & 63, wave = __builtin_amdgcn_readfirstlane(tid >> 6);
    LAS float* scr = (LAS float*)(F.lds + RING_OFF + wave * 16384);
    const int gw = F.vcu * NWAVES + wave, NGW = F.G * NWAVES;
    if (a.pro_mask & pmsel & PM_X) {
        float* X = (float*)(wsb + a.off[R_X]);
        for (int m = gw; m < RP; m += NGW) {
            const float* src = nullptr;
            if (m >= SROW0) src = GIN(a, I_XS) + (size_t)(m - SROW0) * D_MODEL;
            else { const int b = m / LPP, p = m % LPP; if (p >= PADF && p < PEND) { const int pos = p - PADF; src = pos < N_META ? GIN(a, I_META) + (size_t)pos * D_MODEL : GIN(a, I_XP) + ((size_t)b * SEQ + pos - N_META) * D_MODEL; } }
            GAS f32x4* o = (GAS f32x4*)(X + (size_t)m * D_MODEL) + lane;
#pragma unroll
            for (int j = 0; j < 4; ++j) o[64 * j] = src ? ((const GAS f32x4*)src)[lane + 64 * j] : (f32x4){0.f, 0.f, 0.f, 0.f};
        }
    }
    if (a.pro_mask & pmsel & PM_WIN) {
        bf16* WT = (bf16*)(wsb + a.off[R_WIN]);
        constexpr int IPL = (D_MODEL / 64) * (ZN / 32);
        TrItem A, B;
#define WIN_LOAD(T, it_) do { const int l_ = (it_) / IPL, r_ = (it_) % IPL; tr_load(T, GIN(a, I_WIN) + (size_t)l_ * D_MODEL * D_IN, D_IN, 32 * (r_ % (ZN / 32)), 64 * (r_ / (ZN / 32)), CmWin(), lane); } while (0)
        if (gw < DEPTH * IPL) WIN_LOAD(A, gw);
        for (int it = gw; it < DEPTH * IPL; it += NGW) { const int l = it / IPL, r = it % IPL, kb = r / (ZN / 32), nb = r % (ZN / 32);
            if (it + NGW < DEPTH * IPL) WIN_LOAD(B, it + NGW);
            tr_store(A, D_MODEL, WT + (size_t)l * ZN * D_MODEL, 32 * nb, 64 * kb, scr, lane); A = B; }
#undef WIN_LOAD
    }
    __syncthreads();
    if (a.pro_mask & pmsel & PM_TABLES) s5_tables(F);
    __syncthreads();
    if (a.pro_mask & pmsel & PM_WREST) pro_wrest(F);
    if (a.pro_mask & pmsel & PM_WQS) pro_wqs(F);
    if (a.pro_mask & pmsel & PM_PEERW) pro_peerw(F);
}

__global__ void __launch_bounds__(NTHR, 2) mk_fwd(Args args) {
    extern __shared__ __attribute__((aligned(16))) unsigned char lds[];
    Frame F;
    F.lds = (LAS unsigned char*)lds; F.MISC = (volatile LAS unsigned*)(F.lds + MISC_OFF);
    F.wv = __builtin_amdgcn_readfirstlane((int)threadIdx.x >> 6);
    F.G = gridDim.x; { const int bx = blockIdx.x; F.vcu = (F.G % 8 == 0) ? (bx % 8) * (F.G / 8) + bx / 8 : bx; }
    F.ctl = (gu32*)args.ws;
    for (int u = F.wv * 64 + lane_id(); u < (LDS_BYTES - LDSCTL_OFF) / 4; u += NTHR) ((LAS unsigned*)(F.lds + LDSCTL_OFF))[u] = 0u;
    __syncthreads();
    const int lo = args.ph_lo, hi = args.ph_hi;
    unsigned* barw = (unsigned*)(F.ctl + CW_BAR) + (size_t)args.bar_region * XCD_BAR_WORDS;
    XcdBarrier bar; bar.bar = barw; bar.x = 0; bar.st = nullptr; bar.wv = F.wv;
    if (hi - lo > 1) bar = xcd_barrier_post(barw, F.MISC + 8, F.wv);
#define IN(k) (lo <= (k) && (k) < hi)
#ifndef MK_REP
#define MK_REP -1
#endif
#ifdef MK_NOSTEAL
#define STEALBAR(b, F) xcd_barrier(b)
#else
#define STEALBAR(b, F) xcd_barrier_steal(b, F)
#endif
#ifdef MK_TBAR
    unsigned long long tbar_ = 0ull;
#define SEAM(k) do { if ((k) + 1 < hi) { const unsigned long long t0_ = __builtin_amdgcn_s_memrealtime(); xcd_barrier(bar); const unsigned long long t1_ = __builtin_amdgcn_s_memrealtime(); if ((MK_TBAR_SEL) < 0 || ((k) - 1) % NPL == (MK_TBAR_SEL)) tbar_ += t1_ - t0_; } } while (0)
#else
#define SEAM(k) do { if ((k) + 1 < hi) { STEALBAR(bar, F); if ((MK_REP) == 300) xcd_barrier(bar); } } while (0)
#endif
#ifndef MK_REP
#define MK_REP -1
#endif
#ifndef MK_PMASK
#define MK_PMASK -1
#endif
    if (IN(PH_PRO)) { for (int rep_ = 0; rep_ < ((MK_REP) == 200 ? 2 : 1); ++rep_) { p_prologue(F, rep_ == 0 ? -1 : (MK_PMASK)); __syncthreads(); } SEAM(PH_PRO); }
#ifndef MK_REP
#define MK_REP -1
#endif
#define REPEAT(ph) for (int rep_ = 0; rep_ < ((MK_REP) == (ph) ? 2 : 1); ++rep_)
    for (int l = 0; l < DEPTH; ++l) {
        const int pb = 1 + l * NPL;
        if (IN(pb + PL_GEMM_IN)) {
            const KArgs ap = kargs(); const auto& a = *ap; WS_OPAQUE(a);
            pg8::Gemm g{(const pg8::bf16_t*)(wsb + a.off[R_XN]), (const pg8::bf16_t*)(wsb + a.off[R_WIN]) + (size_t)l * ZN * D_MODEL, RP, ZN, D_MODEL};
            pg8::StaticOrder S; S.init(RP, ZN, F.G, (int)blockIdx.x);
            pg8::EpiBf16<0> E{(pg8::bf16_t*)(wsb + a.off[R_Z]), ZN, nullptr, 0, 0, 1.f};
            REPEAT(PL_GEMM_IN) pg8::gemm_phase<pg8::EpiBf16<0>, pg8::StaticOrder, true, true>(F.lds + RING_OFF, g, S, E, F.wv);
            SEAM(pb + PL_GEMM_IN);
        }
        if (IN(pb + PL_ZPOST)) { REPEAT(103) p_s5_e(F, l); REPEAT(PL_ZPOST) p_zpost(F, l);     SEAM(pb + PL_ZPOST); }
        if (IN(pb + PL_LOCAL)) { REPEAT(104) p_gdn_chunk<0>(F, l, 0); SEAM(pb + PL_LOCAL); }
        if (IN(pb + PL_MIX)) {
            REPEAT(100) p_gdn_chain(F, l);
            REPEAT(102) { const int tid = otid(), lane = tid & 63, wave = __builtin_amdgcn_readfirstlane(tid >> 6);
              const int q = F.vcu - F.vcu / 32 - 1;
              if (F.vcu % 32 != 0 && q >= 18) for (int t = (q - 18) * NWAVES + wave; t < S5_NTASK; t += (F.G - F.G / 32 - 18) * NWAVES) s5_scan_run(F, l, t, lane); }
            REPEAT(101) p_attention(F, l + DEPTH * rep_, lds);
            SEAM(pb + PL_MIX); }
        if (IN(pb + PL_MIXPOST)) { REPEAT(PL_MIXPOST) { p_mixpost_a(F, l); p_mixpost_b(F, l); p_s5_out(F, l); } SEAM(pb + PL_MIXPOST); }
        if (IN(pb + PL_GEMM_GLU)) REPEAT(PL_GEMM_GLU) {
            const KArgs ap = kargs(); const auto& a = *ap; WS_OPAQUE(a);
            { pg8::Gemm g{(const pg8::bf16_t*)(wsb + a.off[R_YC]), (const pg8::bf16_t*)(wsb + a.off[R_WGLU]) + (size_t)l * 1024 * 512, RP, 1024, 512};
              pg8::StaticOrder S; S.init(RP, 1024, F.G, (int)blockIdx.x); pg8::EpiGlu E{(pg8::bf16_t*)(wsb + a.off[R_OC]), WIDTH_C};
              pg8::gemm_phase<pg8::EpiGlu, pg8::StaticOrder, true, true>(F.lds + RING_OFF, g, S, E, F.wv); }
            { pg8::Gemm g{(const pg8::bf16_t*)(wsb + a.off[R_OA]), (const pg8::bf16_t*)(wsb + a.off[R_WBR]) + ((size_t)l * 3 + 0) * 1024 * 512, RP, 1024, 512};
              pg8::StaticOrder S; S.init(RP, 1024, F.G, (int)((blockIdx.x + 16) % F.G)); pg8::EpiMerge<0> E{(pg8::bf16_t*)(wsb + a.off[R_MRG]), nullptr, nullptr, (const pg8::bf16_t*)(wsb + a.off[R_Z]) + ZC_GATE, ZN};
              pg8::gemm_phase<pg8::EpiMerge<0>, pg8::StaticOrder, true, true>(F.lds + RING_OFF, g, S, E, F.wv); }
            { pg8::Gemm g{(const pg8::bf16_t*)(wsb + a.off[R_OBN]), (const pg8::bf16_t*)(wsb + a.off[R_WBR]) + ((size_t)l * 3 + 1) * 1024 * 512, RP, 1024, 512};
              pg8::StaticOrder S; S.init(RP, 1024, F.G, (int)((blockIdx.x + 32) % F.G)); pg8::EpiMerge<0> E{(pg8::bf16_t*)(wsb + a.off[R_MRG2]), nullptr, nullptr, (const pg8::bf16_t*)(wsb + a.off[R_Z]) + ZC_GATE + 1024, ZN};
              pg8::gemm_phase<pg8::EpiMerge<0>, pg8::StaticOrder, true, true>(F.lds + RING_OFF, g, S, E, F.wv); }
            if (rep_ == ((MK_REP) == PL_GEMM_GLU ? 1 : 0)) SEAM(pb + PL_GEMM_GLU); }
        if (IN(pb + PL_GEMM_BRC)) {
            const KArgs ap = kargs(); const auto& a = *ap; WS_OPAQUE(a);
            pg8::Gemm g{(const pg8::bf16_t*)(wsb + a.off[R_OC]), (const pg8::bf16_t*)(wsb + a.off[R_WBR]) + ((size_t)l * 3 + 2) * 1024 * 512, RP, 1024, 512};
            pg8::StaticOrder S; S.init(RP, 1024, F.G, (int)blockIdx.x); pg8::EpiMerge<2> E{(pg8::bf16_t*)(wsb + a.off[R_MRG]), (const pg8::bf16_t*)(wsb + a.off[R_MRG2]), (pg8::bf16_t*)(wsb + a.off[R_MRGB]), (const pg8::bf16_t*)(wsb + a.off[R_Z]) + ZC_GATE + 2048, ZN};
            REPEAT(PL_GEMM_BRC) pg8::gemm_phase<pg8::EpiMerge<2>, pg8::StaticOrder, true, true>(F.lds + RING_OFF, g, S, E, F.wv);
            SEAM(pb + PL_GEMM_BRC); }
        if (IN(pb + PL_GEMM_OUT)) {
            const KArgs ap = kargs(); const auto& a = *ap; WS_OPAQUE(a);
            pg8::Gemm g{(const pg8::bf16_t*)(wsb + a.off[R_MRGB]), (const pg8::bf16_t*)(wsb + a.off[R_WOUT]) + (size_t)l * 1024 * 1024, RP, 1024, 1024};
            pg8::StaticOrder S; S.init(RP, 1024, F.G, (int)blockIdx.x);
            REPEAT(PL_GEMM_OUT) { pg8::EpiResid E{(float*)(wsb + a.off[R_X]), D_MODEL, (MK_REP) == PL_GEMM_OUT && rep_ == 0, (pg8::bf16_t*)(wsb + a.off[R_XN])};
            pg8::gemm_phase<pg8::EpiResid, pg8::StaticOrder, true, true>(F.lds + RING_OFF, g, S, E, F.wv); }
            SEAM(pb + PL_GEMM_OUT); }
        if (IN(pb + PL_GEMM_PEER)) {
            peerw_drain(F, (l + 1) * PW_ITEMS_L);
            const KArgs ap = kargs(); const auto& a = *ap; WS_OPAQUE(a);
            pg8::Gemm g{(const pg8::bf16_t*)(wsb + a.off[R_XN]), (const pg8::bf16_t*)(wsb + a.off[R_WQS]) + (size_t)l * PQ * D_MODEL, RP, PQ, D_MODEL};
            pg8::StaticOrder S; S.init(RP, PQ, F.G, (int)blockIdx.x); pg8::EpiF32 E{(float*)(wsb + a.off[R_SC]), PQ};
            REPEAT(PL_GEMM_PEER) pg8::gemm_phase<pg8::EpiF32, pg8::StaticOrder, true, true>(F.lds + RING_OFF, g, S, E, F.wv);
            SEAM(pb + PL_GEMM_PEER); }
        if (IN(pb + PL_PEER)) { REPEAT(PL_PEER) p_peer(F, l, (MK_REP) == PL_PEER && rep_ == 0); SEAM(pb + PL_PEER); }
    }
#ifdef MK_TBAR
    if (blockIdx.x == MK_TBAR_WG && F.wv == 0 && lane_id() == 0) args.out[O_YS] = 1000.f * (MK_TBAR_Q) * floorf((float)tbar_ * 1e-5f / (MK_TBAR_Q) + 0.5f);
#endif
#undef IN
#undef SEAM
}
}
#ifndef MK_ONE_LAUNCH
#define MK_ONE_LAUNCH 1
#endif
static int mk_grid = 0;
static bool mk_setup() {
    if (mk_grid) return mk_grid > 0;
    int dev = 0, cus = 0;
    if (hipGetDevice(&dev) != hipSuccess || hipDeviceGetAttribute(&cus, hipDeviceAttributeMultiprocessorCount, dev) != hipSuccess) { mk_grid = -1; return false; }
    if (hipFuncSetAttribute((const void*)mk::mk_fwd, hipFuncAttributeMaxDynamicSharedMemorySize, mk::LDS_BYTES) != hipSuccess) { fprintf(stderr, "kernel_launch: hipFuncSetAttribute failed\n"); mk_grid = -1; return false; }
    int per_cu = 0;
    if (hipOccupancyMaxActiveBlocksPerMultiprocessor(&per_cu, (const void*)mk::mk_fwd, mk::NTHR, mk::LDS_BYTES) != hipSuccess || per_cu < 1) { fprintf(stderr, "kernel_launch: occupancy query says %d workgroups per CU\n", per_cu); }
    (void)hipGetLastError();
    mk_grid = cus;
    return true;
}
static void mk_launch(mk::Args a, int lo, int hi, int region, hipStream_t stream) {
    a.ph_lo = lo; a.ph_hi = hi; a.bar_region = region;
    hipLaunchKernelGGL(mk::mk_fwd, dim3(mk_grid), dim3(mk::NTHR), mk::LDS_BYTES, stream, a);
    hipError_t e = hipPeekAtLastError(); if (e != hipSuccess) fprintf(stderr, "kernel_launch: launch failed: %s\n", hipGetErrorName(e));
}
extern "C" void kernel_launch(void* const* d_in, const int* in_sizes, int n_in, void* d_out, int out_size, void* d_ws, size_t ws_size, hipStream_t stream) {
    if (n_in != N_INPUTS || (size_t)out_size != (size_t)O_END) { fprintf(stderr, "kernel_launch: unexpected n_in %d / out_size %d\n", n_in, out_size); return; }
    if (!mk_setup()) return;
    const size_t MiB = 1u << 20;
    unsigned char* ws = (unsigned char*)d_ws;
    mk::Args a{};
    for (int i = 0; i < N_INPUTS; ++i) a.in[i] = (const float*)d_in[i];
    a.out = (float*)d_out; a.ws = ws;
    { using namespace mk; const struct { int r; size_t mib; } map[] = { {R_WIN, 1}, {R_WGLU, 59}, {R_WBR, 63}, {R_WOUT, 75}, {R_WQS, 83}, {R_S5T, 99}, {R_PU, 132}, {R_PV, 196}, {R_MISC, 260}, {R_OBN, 262}, {R_MRG2, 280}, {R_X, 388}, {R_XN, 456},
        {R_Z, 490}, {R_SC, 490}, {R_QN, 737}, {R_KN, 754}, {R_QKVB, 771}, {R_BG, 822}, {R_O, 823}, {R_MRGB, 823}, {R_OA, 857}, {R_OB, 874}, {R_GDN, 891}, {R_MRG, 891},
        {R_S5E, 986}, {R_YC, 986}, {R_S5X, 1003}, {R_OC, 1012} };
      for (auto& e : map) a.off[e.r] = e.mib * MiB; }
    if (1029 * MiB > ws_size) { fprintf(stderr, "kernel_launch: workspace too small (%zu)\n", ws_size); return; }
    if (hipMemsetAsync(ws, 0, mk::CTL_BYTES, stream) != hipSuccess) { fprintf(stderr, "kernel_launch: memset failed\n"); return; }
    a.pro_mask =   mk::PM_WIN | mk::PM_TABLES | mk::PM_WREST | mk::PM_WQS;
#if MK_ONE_LAUNCH
    mk_launch(a, 0, mk::PH_END, 0, stream);
#else
    int region = 0;
    mk_launch(a, mk::PH_PRO, mk::PH_PRO + 1, region++, stream);
    for (int l = 0; l < DEPTH; ++l) { const int pb = 1 + l * mk::NPL;
        for (int ph = mk::PL_NORM1; ph <= mk::PL_PEER; ++ph) { if (ph == mk::PL_GEMM_BRA || ph == mk::PL_GEMM_BRB) continue; mk_launch(a, pb + ph, pb + ph + 1, region++, stream); } }
    mk_launch(a, mk::PH_FINAL, mk::PH_END, region++, stream);
#endif
}
```

```cpp
#include <hip/hip_runtime.h>
#include <cstdio>
#include <cstdint>
#include <utility>
#define MK_ONE_LAUNCH 1
#ifndef D_MODEL
#define D_MODEL 1024
#define BATCH 2
#define SEQ 8192
#define DEPTH 4
#define DEC_BATCH 16
#define DEC_SEQ 32
#define PAST_LEN 1024
#define N_HEADS_A 4
#define HEAD_DIM_A 64
#define N_HEADS_B 4
#define HEAD_DIM_B 128
#define S5_GROUPS 32
#define S5_STATE 64
#define PEER_HEADS 8
#define PEER_QDIM 256
#define N_KEYS 128
#endif
#define CHUNK 64
#define N_META 16
#define EPSF 1e-6f
#define NUM_BUCKETS 32
#define CONV_W 4
#define S5_GROUP 16
#define PEER_TOPK 16
#define N_EXPERTS (N_KEYS * N_KEYS)
#define WIDTH_A (N_HEADS_A * 2 * HEAD_DIM_A)
#define WIDTH_B (N_HEADS_B * HEAD_DIM_B)
#define WIDTH_C (S5_GROUPS * S5_GROUP)
#define OFF_QA 0
#define OFF_KA (OFF_QA + WIDTH_A)
#define OFF_VA (OFF_KA + WIDTH_A)
#define OFF_QKVB (OFF_VA + WIDTH_A)
#define OFF_GB (OFF_QKVB + 3 * WIDTH_B)
#define OFF_BETA (OFF_GB + WIDTH_B)
#define OFF_ALPHA (OFF_BETA + N_HEADS_B)
#define OFF_UC (OFF_ALPHA + N_HEADS_B)
#define OFF_GATE (OFF_UC + WIDTH_C)
#define D_IN (OFF_GATE + 3 * D_MODEL)
#define LP (N_META + SEQ)
#define NP (BATCH * LP)
#define NS (DEC_BATCH * DEC_SEQ)
#define NT (NP + NS)
#define PQ (PEER_HEADS * PEER_QDIM)

enum { I_XP, I_XS, I_CK, I_CV, I_SCONV, I_SDELTA, I_SRE, I_SIM, I_META, I_REL, I_N1, I_N2, I_FN, I_WIN, I_QN, I_KN, I_LQK, I_SUBLN, I_CONVW, I_ALOG, I_DTB, I_GDNN,
       I_AR, I_AI, I_BR, I_BI, I_CR, I_CI, I_SD, I_LDT, I_WGLU, I_WBA, I_WBB, I_WBC, I_WOUT, I_PWQ, I_PSK, I_PU, I_PV, N_INPUTS };
#define O_YP 0
#define O_YS (O_YP + (size_t)BATCH * SEQ * D_MODEL)
#define O_KP (O_YS + (size_t)NS * D_MODEL)
#define O_VP (O_KP + (size_t)DEPTH * NP * WIDTH_A)
#define O_KS (O_VP + (size_t)DEPTH * NP * WIDTH_A)
#define O_VS (O_KS + (size_t)DEPTH * NS * WIDTH_A)
#define O_CP (O_VS + (size_t)DEPTH * NS * WIDTH_A)
#define O_CS (O_CP + (size_t)DEPTH * BATCH * (CONV_W - 1) * 3 * WIDTH_B)
#define O_DP (O_CS + (size_t)DEPTH * DEC_BATCH * (CONV_W - 1) * 3 * WIDTH_B)
#define O_DS (O_DP + (size_t)DEPTH * BATCH * N_HEADS_B * HEAD_DIM_B * HEAD_DIM_B)
#define O_SRP (O_DS + (size_t)DEPTH * DEC_BATCH * N_HEADS_B * HEAD_DIM_B * HEAD_DIM_B)
#define O_SIP (O_SRP + (size_t)DEPTH * BATCH * S5_GROUPS * S5_STATE)
#define O_SRS (O_SIP + (size_t)DEPTH * BATCH * S5_GROUPS * S5_STATE)
#define O_SIS (O_SRS + (size_t)DEPTH * DEC_BATCH * S5_GROUPS * S5_STATE)
#define O_END (O_SIS + (size_t)DEPTH * DEC_BATCH * S5_GROUPS * S5_STATE)

namespace pg8 {
#define PG8_LAS __attribute__((address_space(3)))
typedef unsigned short bf16_t;
typedef short bf16x8 __attribute__((ext_vector_type(8)));
typedef float f32x4 __attribute__((ext_vector_type(4)));
typedef unsigned u32x4 __attribute__((ext_vector_type(4)));
constexpr int BM = 256, BK = 64, HALF = 128, HTB = HALF * BK * 2  , STAGE_BYTES = 8 * HTB, NXCD = 8, WGM = 8;

__host__ __device__ __forceinline__ int lds_byte(int r, int c) { const int st = (r >> 4) * 2 + (c >> 5), rr = r & 15, cc = c & 31, ob = rr * 64 + cc * 2; return st * 1024 + (ob ^ (((ob >> 9) & 1) << 5)); }
__host__ __device__ __forceinline__ void stage_rc(int b, int& R, int& C) { const int st = b / 1024, sb = b % 1024, swz = sb ^ (((sb >> 9) & 1) << 5); R = (st >> 1) * 16 + swz / 64; C = (st & 1) * 32 + (swz % 64) / 2; }
__host__ __device__ __forceinline__ int perm32(int rho) { const int n = rho >> 4, i = rho & 15; return 8 * (i >> 2) + 4 * n + (i & 3); }

struct Unit { int pm, pn; };
struct Gemm { const bf16_t* A; const bf16_t* Bt; int M, N, K; };

struct StaticOrder {
    int nM, nN, nwg, G, c;
    __host__ __device__ void init(int M, int N, int G_, int c_) { nM = M / BM; nN = N / BM; nwg = nM * nN; G = G_; c = c_; }
    __host__ __device__ bool next(int i, Unit& u) const {
        const long L = (long)i * G + c; if (L >= nwg) return false;
        int wgid = (int)L; { const int q = nwg / NXCD, r = nwg % NXCD, xcd = wgid % NXCD, off = wgid / NXCD; wgid = (xcd < r ? xcd * (q + 1) : r * (q + 1) + (xcd - r) * q) + off; }
        const int nig = WGM * nN, gid = wgid / nig, fm = gid * WGM, gsz = (nM - fm) < WGM ? (nM - fm) : WGM;
        u.pm = fm + ((wgid % nig) % gsz); u.pn = (wgid % nig) / gsz; return true;
    }
    __device__ __forceinline__ void a_ready(const Unit&) const {}
    __device__ __forceinline__ void done(const Unit&) const {}
};

__device__ __forceinline__ unsigned cvt_pk_bf16(float lo, float hi) { unsigned r; asm volatile("v_cvt_pk_bf16_f32 %0, %1, %2" : "=v"(r) : "v"(lo), "v"(hi)); return r; }
typedef float f32x2 __attribute__((ext_vector_type(2)));
__device__ __forceinline__ f32x2 gelu_pk(f32x2 v) {
    const f32x2 av = __builtin_elementwise_abs(v), d = av * 0.2316418882f + 1.0f;
    f32x2 t; t.x = __builtin_amdgcn_rcpf(d.x); t.y = __builtin_amdgcn_rcpf(d.y);
    f32x2 q = t * 0.5307027145f + (-0.7265760135f); q = q * t + 0.7107068705f; q = q * t + (-0.142248368f); q = q * t + 0.127414796f; q = q * t;
    const f32x2 s = (v * v) * (-0.72134752044f);
    f32x2 e; e.x = __builtin_amdgcn_exp2f(s.x); e.y = __builtin_amdgcn_exp2f(s.y);
    const f32x2 m = v * (q * e), r = v - m;
    f32x2 o; o.x = v.x < 0.f ? m.x : r.x; o.y = v.y < 0.f ? m.y : r.y; return o;
}

template <int ACT  > struct EpiBf16 {
    static constexpr bool PERM = true, AFTER_DRAIN = false; static_assert(ACT == 0 || ACT == 1, "EpiBf16: ACT is 0 (none) or 1 (gelu_pk)");
    bf16_t* O; int ldc; const float* bias; int split_cols; size_t split_stride; float scale0;
    __device__ __forceinline__ void operator()(const f32x4 (&acc)[2][2][4][2], const Unit& u, int wr, int wc, int fr, int fq) const {
        const int row0 = u.pm * BM + wr * 64 + fr; int colt = u.pn * BM; bf16_t* base = O;
        float sc = 1.f; if (split_cols) { const int t = colt / split_cols; base += (size_t)t * split_stride; colt -= t * split_cols; if (t == 0) sc = scale0; }
        const int col0 = colt + wc * 32 + 8 * fq, bcol0 = u.pn * BM + wc * 32 + 8 * fq;
        f32x4 bv[2][2];
#pragma unroll
        for (int bj = 0; bj < 2; ++bj)
#pragma unroll
            for (int n = 0; n < 2; ++n) bv[bj][n] = bias ? *(const f32x4*)(bias + bcol0 + bj * HALF + 4 * n) : (f32x4){0.f, 0.f, 0.f, 0.f};
#pragma unroll
        for (int ai = 0; ai < 2; ++ai)
#pragma unroll
            for (int m = 0; m < 4; ++m) { bf16_t* rowp = base + (size_t)(row0 + ai * HALF + m * 16) * ldc + col0;
#pragma unroll
                for (int bj = 0; bj < 2; ++bj) { f32x4 v0 = acc[ai][bj][m][0] + bv[bj][0], v1 = acc[ai][bj][m][1] + bv[bj][1];
                    if (ACT == 1) { f32x2 a = gelu_pk((f32x2){v0[0], v0[1]}), b = gelu_pk((f32x2){v0[2], v0[3]}), c = gelu_pk((f32x2){v1[0], v1[1]}), d = gelu_pk((f32x2){v1[2], v1[3]});
                        v0 = (f32x4){a.x, a.y, b.x, b.y}; v1 = (f32x4){c.x, c.y, d.x, d.y}; }
                    v0 = v0 * sc; v1 = v1 * sc; u32x4 w; w.x = cvt_pk_bf16(v0[0], v0[1]); w.y = cvt_pk_bf16(v0[2], v0[3]); w.z = cvt_pk_bf16(v1[0], v1[1]); w.w = cvt_pk_bf16(v1[2], v1[3]);
                    *(u32x4*)(rowp + bj * HALF) = w; } }
    }
};

__device__ __forceinline__ float epi_sigm(float x) { return __builtin_amdgcn_rcpf(1.f + __expf(-x)); }
struct EpiGlu {
    static constexpr bool PERM = false, AFTER_DRAIN = false;
    bf16_t* O; int ldo;
    __device__ __forceinline__ void operator()(const f32x4 (&acc)[2][2][4][2], const Unit& u, int wr, int wc, int fr, int fq) const {
        const int row0 = u.pm * BM + wr * 64 + fr;
#pragma unroll
        for (int ai = 0; ai < 2; ++ai)
#pragma unroll
            for (int m = 0; m < 4; ++m) { bf16_t* rowp = O + (size_t)(row0 + ai * HALF + m * 16) * ldo + 4 * fq;
#pragma unroll
                for (int bj = 0; bj < 2; ++bj) { const int G = u.pn * 8 + bj * 4 + wc; const f32x4 av = acc[ai][bj][m][0], gv = acc[ai][bj][m][1];
                    typedef unsigned u32x2 __attribute__((ext_vector_type(2))); u32x2 w;
                    w.x = cvt_pk_bf16(av[0] * epi_sigm(gv[0]), av[1] * epi_sigm(gv[1])); w.y = cvt_pk_bf16(av[2] * epi_sigm(gv[2]), av[3] * epi_sigm(gv[3]));
                    *(u32x2*)(rowp + 16 * G) = w; } }
    }
};
template <int MODE> struct EpiMerge {
    static constexpr bool PERM = true, AFTER_DRAIN = false;
    bf16_t* M; const bf16_t* M2; bf16_t* Mb; const bf16_t* Zg; int ldz;
    __device__ __forceinline__ void operator()(const f32x4 (&acc)[2][2][4][2], const Unit& u, int wr, int wc, int fr, int fq) const {
        const int row0 = u.pm * BM + wr * 64 + fr, col0 = u.pn * BM + wc * 32 + 8 * fq;
#define EPI_LO(w) __builtin_bit_cast(float, (w) << 16)
#define EPI_HI(w) __builtin_bit_cast(float, (w) & 0xffff0000u)
        constexpr int MG = MODE == 2 ? 2 : 4;
#pragma unroll
        for (int aim = 0; aim < 8; aim += MG) { const int ai = aim >> 2, m0 = aim & 3;
            u32x4 gz[MG][2], pa[MG][2], pb[MG][2];
#pragma unroll
            for (int m = 0; m < MG; ++m)
#pragma unroll
                for (int bj = 0; bj < 2; ++bj) { const size_t row = (size_t)(row0 + ai * HALF + (m0 + m) * 16); const int col = col0 + bj * HALF;
                    gz[m][bj] = *(const u32x4*)(Zg + row * ldz + col);
                    if (MODE == 2) { pa[m][bj] = *(const u32x4*)(M + row * 1024 + col); pb[m][bj] = *(const u32x4*)(M2 + row * 1024 + col); } }
#pragma unroll
            for (int m = 0; m < MG; ++m)
#pragma unroll
                for (int bj = 0; bj < 2; ++bj) { const size_t row = (size_t)(row0 + ai * HALF + (m0 + m) * 16); const int col = col0 + bj * HALF; const u32x4 g = gz[m][bj];
                    f32x4 v0 = acc[ai][bj][m0 + m][0], v1 = acc[ai][bj][m0 + m][1];
                    v0[0] *= epi_sigm(EPI_LO(g.x)); v0[1] *= epi_sigm(EPI_HI(g.x)); v0[2] *= epi_sigm(EPI_LO(g.y)); v0[3] *= epi_sigm(EPI_HI(g.y));
                    v1[0] *= epi_sigm(EPI_LO(g.z)); v1[1] *= epi_sigm(EPI_HI(g.z)); v1[2] *= epi_sigm(EPI_LO(g.w)); v1[3] *= epi_sigm(EPI_HI(g.w));
                    if (MODE == 2) { const u32x4 a_ = pa[m][bj], b_ = pb[m][bj];
                        v0[0] += EPI_LO(a_.x) + EPI_LO(b_.x); v0[1] += EPI_HI(a_.x) + EPI_HI(b_.x); v0[2] += EPI_LO(a_.y) + EPI_LO(b_.y); v0[3] += EPI_HI(a_.y) + EPI_HI(b_.y);
                        v1[0] += EPI_LO(a_.z) + EPI_LO(b_.z); v1[1] += EPI_HI(a_.z) + EPI_HI(b_.z); v1[2] += EPI_LO(a_.w) + EPI_LO(b_.w); v1[3] += EPI_HI(a_.w) + EPI_HI(b_.w); }
                    u32x4 w; w.x = cvt_pk_bf16(v0[0], v0[1]); w.y = cvt_pk_bf16(v0[2], v0[3]); w.z = cvt_pk_bf16(v1[0], v1[1]); w.w = cvt_pk_bf16(v1[2], v1[3]);
                    *(u32x4*)((MODE == 2 ? Mb : M) + row * 1024 + col) = w; }
        }
#undef EPI_LO
#undef EPI_HI
    }
};
struct EpiResid {
    static constexpr bool PERM = false, AFTER_DRAIN = false;
    float* X; int ldx; bool dry; bf16_t* Xb;
    __device__ __forceinline__ void operator()(const f32x4 (&acc)[2][2][4][2], const Unit& u, int wr, int wc, int fr, int fq) const {
        const int row0 = u.pm * BM + wr * 64 + fr, col0 = u.pn * BM + wc * 32 + 4 * fq;
        typedef unsigned u32x2 __attribute__((ext_vector_type(2)));
#pragma unroll
        for (int aim = 0; aim < 8; aim += 2) { const int ai = aim >> 2, m0 = aim & 3;
            f32x4 xo[2][2][2]; bool ok[2];
#pragma unroll
            for (int m = 0; m < 2; ++m) { const int row = row0 + ai * HALF + (m0 + m) * 16; ok[m] = true; if (row < 16896) { const int p = row % 8448; ok[m] = p >= 48 && p < 8256; } ok[m] = ok[m] && !dry;
                const float* rowp = X + (size_t)row * ldx + col0;
#pragma unroll
                for (int bj = 0; bj < 2; ++bj)
#pragma unroll
                    for (int n = 0; n < 2; ++n) xo[m][bj][n] = *(const f32x4*)(rowp + bj * HALF + n * 16); }
#pragma unroll
            for (int m = 0; m < 2; ++m) { const int row = row0 + ai * HALF + (m0 + m) * 16;
                if (ok[m]) { float* rowp = X + (size_t)row * ldx + col0;
#pragma unroll
                    for (int bj = 0; bj < 2; ++bj)
#pragma unroll
                        for (int n = 0; n < 2; ++n) { const f32x4 v = xo[m][bj][n] + acc[ai][bj][m0 + m][n]; *(f32x4*)(rowp + bj * HALF + n * 16) = v;
                            u32x2 w; w.x = cvt_pk_bf16(v[0], v[1]); w.y = cvt_pk_bf16(v[2], v[3]); *(u32x2*)(Xb + (size_t)row * ldx + col0 + bj * HALF + n * 16) = w; } } }
        }
    }
};
struct EpiF32 {
    static constexpr bool PERM = false, AFTER_DRAIN = false;
    float* C; int ldc;
    __device__ __forceinline__ void operator()(const f32x4 (&acc)[2][2][4][2], const Unit& u, int wr, int wc, int fr, int fq) const {
        const int row0 = u.pm * BM + wr * 64 + fr, col0 = u.pn * BM + wc * 32 + 4 * fq;
#pragma unroll
        for (int ai = 0; ai < 2; ++ai)
#pragma unroll
            for (int m = 0; m < 4; ++m) { float* rowp = C + (size_t)(row0 + ai * HALF + m * 16) * ldc + col0;
#pragma unroll
                for (int bj = 0; bj < 2; ++bj)
#pragma unroll
                    for (int n = 0; n < 2; ++n) *(f32x4*)(rowp + bj * HALF + n * 16) = acc[ai][bj][m][n]; }
    }
};

template <class Epi, class Sched, bool ALIGN_EPI = false, bool SP2 = false>
__device__ __forceinline__ void gemm_phase(PG8_LAS unsigned char* lds, const Gemm g, const Sched& S, const Epi& E, int wv) {
    unsigned om_ = ~0u; asm volatile("" : "+s"(om_), "+s"(wv)); int tid_ = wv * 64 + (int)__builtin_amdgcn_mbcnt_hi(om_, __builtin_amdgcn_mbcnt_lo(om_, 0u));
    const int tid = tid_, wid = __builtin_amdgcn_readfirstlane(tid >> 6), lane = tid & 63, wr = wid >> 2, wc = wid & 3, fr = lane & 15, fq = lane >> 4;
    const int K = g.K, nt = K / BK;
    unsigned voffA[2], voffB[2];
#pragma unroll
    for (int i = 0; i < 2; ++i) { int R, C; stage_rc(tid * 16 + i * 8192, R, C); const int Rb = Epi::PERM ? ((R & ~31) + perm32(R & 31)) : R;
        voffA[i] = (unsigned)(R * K + C) * 2u; voffB[i] = (unsigned)(Rb * K + C) * 2u; }
    const size_t kstep = (size_t)(BK * 2);
    const size_t hstep = (size_t)HALF * K * 2;
    const size_t tstep = 2 * hstep;
    const unsigned ldsw = (unsigned)wid * 1024u;
    const int aoff = lds_byte(wr * 64 + fr, fq * 8), boff = lds_byte(wc * 32 + fr, fq * 8);
#define PG8_SA(b, h) (((b) * 2 + (h)) * HTB)
#define PG8_SB(b, h) ((4 + (b) * 2 + (h)) * HTB)
#define PG8_STAGE(bufoff, gbase, voff) do { _Pragma("unroll") for (int _i = 0; _i < 2; ++_i) \
        __builtin_amdgcn_global_load_lds((const unsigned*)((const char*)(gbase) + (voff)[_i]), (PG8_LAS unsigned*)(lds + (bufoff) + ldsw + _i * 8192), 16, 0, 0); } while (0)
#define PG8_LDA(dst, b, h) do { _Pragma("unroll") for (int m = 0; m < 4; ++m) _Pragma("unroll") for (int k = 0; k < 2; ++k) dst[m][k] = *(const PG8_LAS bf16x8*)(lds + PG8_SA(b, h) + aoff + m * 2048 + k * 1024); } while (0)
#define PG8_LDB(dst, b, h) do { _Pragma("unroll") for (int n = 0; n < 2; ++n) _Pragma("unroll") for (int k = 0; k < 2; ++k) dst[n][k] = *(const PG8_LAS bf16x8*)(lds + PG8_SB(b, h) + boff + n * 2048 + k * 1024); } while (0)
#define PG8_MMA(ai, bj, At, Bt) do { __builtin_amdgcn_s_setprio(1); _Pragma("unroll") for (int m = 0; m < 4; ++m) _Pragma("unroll") for (int n = 0; n < 2; ++n) _Pragma("unroll") for (int k = 0; k < 2; ++k) \
        acc[ai][bj][m][n] = __builtin_amdgcn_mfma_f32_16x16x32_bf16(Bt[n][k], At[m][k], acc[ai][bj][m][n], 0, 0, 0); __builtin_amdgcn_s_setprio(0); } while (0)
#define PG8_WAIT_V(n) asm volatile("s_waitcnt vmcnt(" #n ")" ::: "memory")
#define PG8_WAIT_L(n) asm volatile("s_waitcnt lgkmcnt(" #n ")" ::: "memory")
#define PG8_BAR __builtin_amdgcn_s_barrier()
#define PG8_SCHED __builtin_amdgcn_sched_barrier(0)
    Unit cur, nxt; int ui = 0;
    if (!S.next(0, cur)) return;
    f32x4 acc[2][2][4][2];
#pragma unroll
    for (int a = 0; a < 2; ++a)
#pragma unroll
        for (int b = 0; b < 2; ++b)
#pragma unroll
            for (int m = 0; m < 4; ++m)
#pragma unroll
                for (int n = 0; n < 2; ++n) acc[a][b][m][n] = (f32x4){0.f, 0.f, 0.f, 0.f};
    bf16x8 At[4][2], B0[2][2], B1[2][2];
    const char* cA = (const char*)g.A + (size_t)cur.pm * tstep; const char* cB = (const char*)g.Bt + (size_t)cur.pn * tstep;
    S.a_ready(cur);
    if constexpr (SP2) {
        PG8_STAGE(PG8_SB(0, 0), cB, voffB); PG8_STAGE(PG8_SB(0, 1), cB + hstep, voffB); PG8_STAGE(PG8_SA(0, 0), cA, voffA); PG8_STAGE(PG8_SA(0, 1), cA + hstep, voffA);
        if (wr == 1) PG8_BAR;
        PG8_WAIT_V(2); PG8_BAR;
        PG8_STAGE(PG8_SB(1, 0), cB + kstep, voffB); PG8_STAGE(PG8_SA(1, 0), cA + kstep, voffA); PG8_STAGE(PG8_SB(1, 1), cB + hstep + kstep, voffB);
        PG8_WAIT_V(6); PG8_BAR;
    } else {
        PG8_STAGE(PG8_SB(0, 0), cB, voffB); PG8_STAGE(PG8_SA(0, 0), cA, voffA); PG8_STAGE(PG8_SB(0, 1), cB + hstep, voffB); PG8_STAGE(PG8_SA(0, 1), cA + hstep, voffA);
        if (wr == 1) PG8_BAR;
        PG8_WAIT_V(4); PG8_BAR;
        PG8_STAGE(PG8_SB(1, 0), cB + kstep, voffB); PG8_STAGE(PG8_SA(1, 0), cA + kstep, voffA); PG8_STAGE(PG8_SB(1, 1), cB + hstep + kstep, voffB);
        PG8_WAIT_V(6); PG8_BAR;
    }
    for (;;) {
        const bool has_next = S.next(ui + 1, nxt);
        const char* nA = has_next ? (const char*)g.A + (size_t)nxt.pm * tstep : cA; const char* nB = has_next ? (const char*)g.Bt + (size_t)nxt.pn * tstep : cB;
        for (int t = 0; t < nt; t += 2) {
            const bool last = (t == nt - 2);
            const char* a1 = cA + (size_t)(t + 1) * kstep;
            const char* a2 = last ? nA : cA + (size_t)(t + 2) * kstep; const char* b2 = last ? nB : cB + (size_t)(t + 2) * kstep;
            const char* a3 = a2 + kstep; const char* b3 = b2 + kstep;
            if (last && has_next) S.a_ready(nxt);
            if constexpr (SP2) {
            PG8_LDB(B0, 0, 0); PG8_LDB(B1, 0, 1); PG8_SCHED; PG8_LDA(At, 0, 0); PG8_STAGE(PG8_SA(1, 1), a1 + hstep, voffA);
            PG8_WAIT_V(8); PG8_WAIT_L(0); PG8_BAR; PG8_MMA(0, 0, At, B0); PG8_MMA(0, 1, At, B1); PG8_BAR; PG8_SCHED;
            PG8_LDA(At, 0, 1); PG8_STAGE(PG8_SB(0, 0), b2, voffB); PG8_STAGE(PG8_SB(0, 1), b2 + hstep, voffB); PG8_STAGE(PG8_SA(0, 0), a2, voffA);
            PG8_WAIT_V(8); PG8_WAIT_L(0); PG8_BAR; PG8_MMA(1, 0, At, B0); PG8_MMA(1, 1, At, B1); PG8_BAR; PG8_SCHED;
            PG8_LDB(B0, 1, 0); PG8_LDB(B1, 1, 1); PG8_SCHED; PG8_LDA(At, 1, 0); PG8_STAGE(PG8_SA(0, 1), a2 + hstep, voffA);
            PG8_WAIT_V(8); PG8_WAIT_L(0); PG8_BAR; PG8_MMA(0, 0, At, B0); PG8_MMA(0, 1, At, B1); PG8_BAR; PG8_SCHED;
            PG8_LDA(At, 1, 1); PG8_STAGE(PG8_SB(1, 0), b3, voffB); PG8_STAGE(PG8_SB(1, 1), b3 + hstep, voffB); PG8_STAGE(PG8_SA(1, 0), a3, voffA);
            PG8_WAIT_V(8); PG8_WAIT_L(0); PG8_BAR; PG8_MMA(1, 0, At, B0); PG8_MMA(1, 1, At, B1); PG8_BAR; PG8_SCHED;
            } else {
            PG8_LDB(B0, 0, 0); PG8_SCHED; PG8_LDA(At, 0, 0); PG8_STAGE(PG8_SA(1, 1), a1 + hstep, voffA);
            PG8_WAIT_L(8); PG8_BAR; PG8_WAIT_L(0); PG8_MMA(0, 0, At, B0); PG8_BAR; PG8_SCHED;
            PG8_LDB(B1, 0, 1); PG8_STAGE(PG8_SB(0, 0), b2, voffB);
            PG8_BAR; PG8_WAIT_L(0); PG8_MMA(0, 1, At, B1); PG8_BAR;
            PG8_LDA(At, 0, 1); PG8_STAGE(PG8_SA(0, 0), a2, voffA);
            PG8_BAR; PG8_WAIT_L(0); PG8_MMA(1, 0, At, B0); PG8_BAR; PG8_SCHED;
            PG8_STAGE(PG8_SB(0, 1), b2 + hstep, voffB);
            PG8_WAIT_V(6); PG8_BAR; PG8_MMA(1, 1, At, B1); PG8_BAR;
            PG8_LDB(B0, 1, 0); PG8_SCHED; PG8_LDA(At, 1, 0); PG8_STAGE(PG8_SA(0, 1), a2 + hstep, voffA);
            PG8_WAIT_L(8); PG8_BAR; PG8_WAIT_L(0); PG8_MMA(0, 0, At, B0); PG8_BAR; PG8_SCHED;
            PG8_LDB(B1, 1, 1); PG8_STAGE(PG8_SB(1, 0), b3, voffB);
            PG8_BAR; PG8_WAIT_L(0); PG8_MMA(0, 1, At, B1); PG8_BAR;
            PG8_LDA(At, 1, 1); PG8_STAGE(PG8_SA(1, 0), a3, voffA);
            PG8_BAR; PG8_WAIT_L(0); PG8_MMA(1, 0, At, B0); PG8_BAR; PG8_SCHED;
            PG8_STAGE(PG8_SB(1, 1), b3 + hstep, voffB);
            PG8_WAIT_V(6); PG8_BAR; PG8_MMA(1, 1, At, B1); PG8_BAR;
            }
        }
        if constexpr (ALIGN_EPI) { if (wr == 0) PG8_BAR; }
        if constexpr (!Epi::AFTER_DRAIN) { E(acc, cur, wr, wc, fr, fq); S.done(cur); }
        if (!has_next) break;
#pragma unroll
        for (int a = 0; a < 2; ++a)
#pragma unroll
            for (int b = 0; b < 2; ++b)
#pragma unroll
                for (int m = 0; m < 4; ++m)
#pragma unroll
                    for (int n = 0; n < 2; ++n) acc[a][b][m][n] = (f32x4){0.f, 0.f, 0.f, 0.f};
        cur = nxt; cA = nA; cB = nB; ++ui;
        if constexpr (ALIGN_EPI) { if (wr == 1) PG8_BAR; }
    }
    PG8_WAIT_V(0);
    if constexpr (!ALIGN_EPI) { if (wr == 0) PG8_BAR; }
    PG8_BAR;
    if constexpr (Epi::AFTER_DRAIN) { E.fused(acc, cur, wr, wc, fr, fq, lds, wid, lane); S.done(cur); }
#undef PG8_SA
#undef PG8_SB
#undef PG8_STAGE
#undef PG8_LDA
#undef PG8_LDB
#undef PG8_MMA
#undef PG8_WAIT_V
#undef PG8_WAIT_L
#undef PG8_BAR
#undef PG8_SCHED
}
}
#include <hip/hip_bf16.h>
#include <cmath>
namespace attn_body {
using bf16=__hip_bfloat16;
using bf16x8=__attribute__((ext_vector_type(8)))short;
using s16x4=__attribute__((ext_vector_type(4)))short;
using f32x16=__attribute__((ext_vector_type(16)))float;
using u32x4=__attribute__((ext_vector_type(4)))unsigned;
constexpr int ASEQ=8448,D=64;
constexpr int QP=512,KP=512,VP=7424,OP=1024;
constexpr int NW=8,QBLK=32,QB=QBLK*NW,KVBLK=64,NQB=ASEQ/QB;
constexpr int ATTN_UNIT_ROWS=QB;
__device__ __forceinline__ int crow(int r,int hi){return (r&3)+8*(r>>2)+4*hi;}
#define SBAR() __builtin_amdgcn_sched_barrier(0)
constexpr int BT_OFF=383, BT_N=640;
__device__ __forceinline__ void bmask(f32x16&p0,f32x16&p1,int t,int q0,int wid,int r32,int hi,const __attribute__((address_space(3))) float*tab){
  const float NEG=-INFINITY; const int qw=q0+32*wid;
  if(t>(qw>>6)){
    #pragma unroll
    for(int r=0;r<16;++r){p0[r]=NEG;p1[r]=NEG;} return; }
  if(t>0 && 64*t+63+91<=qw) return;
  const int q=qw+r32, kb=64*t+4*hi;
  #pragma unroll
  for(int r=0;r<16;++r){ const int kv=kb+(r&3)+8*(r>>2); int i0=kv-q+BT_OFF, i1=i0+32; i0=i0<0?0:i0; i1=i1<0?0:i1;
    p0[r]+=tab[i0]; p1[r]+=tab[i1]; if(kv<48)p0[r]=NEG; if(kv+32<48)p1[r]=NEG; }
}

constexpr int NSLOT=3, SLOTB=8192;
constexpr int LDS_K=0, LDS_V=NSLOT*SLOTB, LDS_WS=2*NSLOT*SLOTB, LDS_OST=LDS_WS+NW*64*4, LDS_BT=LDS_OST+NW*4096, LDS_BYTES=LDS_BT+BT_N*4;
constexpr float C2=0.125f*1.4426950408889634f;
__device__ __forceinline__ void glds16(const void*gsrc,unsigned lds_dst){unsigned keep;
  asm volatile("s_mov_b32 %0, m0\n\ts_mov_b32 m0, %2\n\ts_nop 0\n\tglobal_load_lds_dwordx4 %1, off\n\ts_mov_b32 m0, %0":"=&s"(keep):"v"(gsrc),"s"(lds_dst):"memory");}
__device__ __forceinline__ float max3f(float a,float b,float c){float r;asm("v_max3_f32 %0, %1, %2, %3":"=v"(r):"v"(a),"v"(b),"v"(c));return r;}
__device__ __forceinline__ float max2f(float a,float b){float r;asm("v_max_f32_e32 %0, %1, %2":"=v"(r):"v"(a),"v"(b));return r;}
__device__ __forceinline__ float fadd_s(float a,float b){float r;asm("v_add_f32_e32 %0, %1, %2":"=v"(r):"v"(a),"v"(b));return r;}
__device__ __forceinline__ float fsub_s(float a,float b){float r;asm("v_sub_f32_e32 %0, %1, %2":"=v"(r):"v"(a),"v"(b));return r;}
typedef float f32x2_t __attribute__((ext_vector_type(2))); typedef __bf16 bf16x2_t __attribute__((ext_vector_type(2)));
__device__ __forceinline__ unsigned cvtpk_s(float lo,float hi){f32x2_t v={lo,hi};bf16x2_t b=__builtin_convertvector(v,bf16x2_t);return __builtin_bit_cast(unsigned,b);}
#define WAIT_BAR(N) asm volatile("s_waitcnt vmcnt(" #N ") lgkmcnt(0)\n\ts_barrier":::"memory")

__device__ __forceinline__ void qkt(f32x16&p0,f32x16&p1,const char*Kslot,const bf16x8*qr,const f32x16&negm,int r32,int hi){
  const char*kb=Kslot+hi*1024+r32*16;
  #pragma unroll
  for(int d0=0;d0<4;++d0){
    const bf16x8 b0=*reinterpret_cast<const bf16x8*>(kb+d0*2048);
    const bf16x8 b1=*reinterpret_cast<const bf16x8*>(kb+d0*2048+512);
    if(d0==0){p0=__builtin_amdgcn_mfma_f32_32x32x16_bf16(b0,qr[0],negm,0,0,0);p1=__builtin_amdgcn_mfma_f32_32x32x16_bf16(b1,qr[0],negm,0,0,0);}
    else{p0=__builtin_amdgcn_mfma_f32_32x32x16_bf16(b0,qr[d0],p0,0,0,0);p1=__builtin_amdgcn_mfma_f32_32x32x16_bf16(b1,qr[d0],p1,0,0,0);}}
}
typedef __attribute__((address_space(3))) const char* lds_cptr;
typedef __attribute__((address_space(3))) const float* lds_cfptr;
typedef short v4i16_t __attribute__((ext_vector_type(4)));
__device__ __forceinline__ void kload8(bf16x8*kf,lds_cptr kp){
  kf[0]=*(const __attribute__((address_space(3))) bf16x8*)(kp);      kf[1]=*(const __attribute__((address_space(3))) bf16x8*)(kp+512);
  kf[2]=*(const __attribute__((address_space(3))) bf16x8*)(kp+2048); kf[3]=*(const __attribute__((address_space(3))) bf16x8*)(kp+2560);
  kf[4]=*(const __attribute__((address_space(3))) bf16x8*)(kp+4096); kf[5]=*(const __attribute__((address_space(3))) bf16x8*)(kp+4608);
  kf[6]=*(const __attribute__((address_space(3))) bf16x8*)(kp+6144); kf[7]=*(const __attribute__((address_space(3))) bf16x8*)(kp+6656);
}
__device__ __forceinline__ void kload2(bf16x8*kf,lds_cptr kp,int j){ kf[2*j]=*(const __attribute__((address_space(3))) bf16x8*)(kp+j*2048); kf[2*j+1]=*(const __attribute__((address_space(3))) bf16x8*)(kp+j*2048+512); }
__device__ __forceinline__ s16x4 vtr(lds_cptr p){ return __builtin_bit_cast(s16x4,__builtin_amdgcn_ds_read_tr16_b64_v4i16((__attribute__((address_space(3))) v4i16_t*)p)); }
__device__ __forceinline__ float rowmax(const f32x16&p0,const f32x16&p1){
  float a=max3f(p0[0],p0[1],p1[0]),b=max3f(p0[2],p0[3],p1[1]);a=max3f(a,p1[2],p1[3]);
  #pragma unroll
  for(int r=4;r<16;r+=4){a=max3f(a,p0[r],p0[r+1]);b=max3f(b,p0[r+2],p0[r+3]);a=max3f(a,p1[r],p1[r+1]);b=max3f(b,p1[r+2],p1[r+3]);}
  const float m=max2f(a,b);
  auto rr=__builtin_amdgcn_permlane32_swap(__float_as_uint(m),__float_as_uint(m),false,false);
  return max2f(__uint_as_float(rr[0]),__uint_as_float(rr[1]));
}
__device__ __forceinline__ void pv(f32x16*o,int vb,bf16x8 pa0,bf16x8 pa1,bf16x8 pa2,bf16x8 pa3){
  #pragma unroll
  for(int d0=0;d0<2;++d0){s16x4 lo[4],hi[4];
    #pragma unroll
    for(int ks=0;ks<4;++ks){
      asm volatile("ds_read_b64_tr_b16 %0,%1 offset:%c2":"=&v"(lo[ks]):"v"(vb),"i"(d0*4096+ks*1024):"memory");
      asm volatile("ds_read_b64_tr_b16 %0,%1 offset:%c2":"=&v"(hi[ks]):"v"(vb),"i"(d0*4096+ks*1024+512):"memory");}
    asm volatile("s_waitcnt lgkmcnt(0)":::"memory");SBAR();
    #define PK(k) (bf16x8){lo[k][0],lo[k][1],lo[k][2],lo[k][3],hi[k][0],hi[k][1],hi[k][2],hi[k][3]}
    o[d0]=__builtin_amdgcn_mfma_f32_32x32x16_bf16(pa0,PK(0),o[d0],0,0,0);
    o[d0]=__builtin_amdgcn_mfma_f32_32x32x16_bf16(pa1,PK(1),o[d0],0,0,0);
    o[d0]=__builtin_amdgcn_mfma_f32_32x32x16_bf16(pa2,PK(2),o[d0],0,0,0);
    o[d0]=__builtin_amdgcn_mfma_f32_32x32x16_bf16(pa3,PK(3),o[d0],0,0,0);
    #undef PK
  }
}

#ifndef ATTN_STORE16
#define ATTN_STORE16(p,v) (*(u32x4*)(p)=(v))
#endif
template<int THRL> __device__ __forceinline__ void attn_unit(int b,int qoff,int voff,int ooff,int qb,const bf16*Q,const bf16*__restrict__ K,const bf16*__restrict__ V,bf16*O,char*shm,int wv){
  unsigned om_ = ~0u; asm volatile("" : "+s"(om_), "+s"(wv)); int tid_ = wv * 64 + (int)__builtin_amdgcn_mbcnt_hi(om_, __builtin_amdgcn_mbcnt_lo(om_, 0u)); const int tid=tid_,lane=tid&63,r32=lane&31,hi=lane>>5; const int wid=__builtin_amdgcn_readfirstlane(tid>>6);
  const long rowbase=(long)b*ASEQ; const int q0=qb*QB;
  const bf16*Qw=Q+(rowbase+q0+wid*QBLK)*QP+qoff;
  const bf16*Kh=K+rowbase*KP+qoff,*Vh=V+rowbase*VP+voff;
  const unsigned lds0=(unsigned)(uintptr_t)shm;
  float*wsf=(float*)(shm+LDS_WS)+wid*64;
  const bf16*ksrc=Kh+(long)lane*KP+wid*8;
  const bf16*vsrc=Vh+(long)(16*(wid&3)+(lane>>2))*VP+(wid>>2)*32+(lane&3)*8;
  const unsigned kdst=lds0+LDS_K+wid*1024, vdst=lds0+LDS_V+wid*1024;
  #define DMA_K(t,slot) glds16(ksrc+(long)(t)*KVBLK*KP,(unsigned)__builtin_amdgcn_readfirstlane(kdst+(slot)))
  #define DMA_V(t,slot) glds16(vsrc+(long)(t)*KVBLK*VP,(unsigned)__builtin_amdgcn_readfirstlane(vdst+(slot)))
  const int vb0=(int)(lds0+LDS_V)+((lane>>4)&1)*32+(lane&3)*8+(4*hi+((lane&15)>>2))*64;
  const char*Kbase=shm+LDS_K; bf16x8 kf[8];
  const lds_cptr shm3=(lds_cptr)shm; const lds_cfptr btab=(lds_cfptr)(shm3+LDS_BT); const lds_cptr kp0=shm3+LDS_K+hi*1024+r32*16; const lds_cptr vp0=shm3+LDS_V+((lane>>4)&1)*32+(lane&3)*8+(4*hi+((lane&15)>>2))*64;
  const int NTL=(q0+QB)/KVBLK;
  DMA_K(0,0);DMA_V(0,0);DMA_K(1,SLOTB);
  bf16x8 qr[4];
  #pragma unroll
  for(int d0=0;d0<4;++d0)qr[d0]=*reinterpret_cast<const bf16x8*>(&Qw[(long)r32*QP+d0*16+hi*8]);
  float mhat=0.f,l_reg=0.f;f32x16 o[2];o[0]=f32x16{};o[1]=f32x16{};const f32x16 zt=f32x16{};
  const int qrel=wid*QBLK+r32;
  #define CMASK(P0,P1,t) bmask(P0,P1,(t),q0,wid,r32,hi,btab)
  bool resc=false;
  #define START(P0,P1) do{ const float rm=rowmax(P0,P1); resc=false; \
    { const float dl=rm; mhat=fadd_s(mhat,dl); \
      _Pragma("unroll") for(int r=0;r<16;++r){P0[r]=fsub_s(P0[r],dl);P1[r]=fsub_s(P1[r],dl);} \
      } \
    _Pragma("unroll") for(int r=0;r<16;++r)P0[r]=__builtin_amdgcn_exp2f(P0[r]); }while(0)
  #define RESC() do{ if(resc){ asm volatile("s_waitcnt lgkmcnt(0)":::"memory"); \
      _Pragma("unroll") for(int d_=0;d_<2;++d_) _Pragma("unroll") for(int r=0;r<16;++r)o[d_][r]*=wsf[crow(r,hi)]; } }while(0)
  f32x16 pA0,pA1,pB0,pB1;
  int sl_prev=0,sl_cur=0,sl_next=SLOTB;
  #define ROT() do{sl_prev=sl_cur;sl_cur=sl_next;sl_next=(sl_next==(NSLOT-1)*SLOTB)?0:sl_next+SLOTB;}while(0)
  DMA_K(2,2*SLOTB);
  WAIT_BAR(3);
  qkt(pA0,pA1,Kbase,qr,zt,r32,hi);asm volatile("s_nop 15\n\ts_nop 7":"+v"(pA0),"+v"(pA1));CMASK(pA0,pA1,0);
  START(pA0,pA1);
  _Pragma("unroll") for(int r=0;r<16;++r)pA1[r]=__builtin_amdgcn_exp2f(pA1[r]);
  WAIT_BAR(0);
  DMA_K(3,0);DMA_V(1,SLOTB);
  ROT();
  kload8(kf,kp0+sl_cur);
  WAIT_BAR(2);
  s16x4 vlo[8],vhi[8]; u32x4 pw0,pw1,pw2,pw3;
  #define PKW(P,B) cvtpk_s(P[B],P[B+1])
  #define PAF(k) __builtin_bit_cast(bf16x8,pw##k)
  #define VFR(i) (bf16x8){vlo[i][0],vlo[i][1],vlo[i][2],vlo[i][3],vhi[i][0],vhi[i][1],vhi[i][2],vhi[i][3]}
  #define PIN(x) asm volatile("":"+v"(x))
  #define MX3(a,b,c) __builtin_fmaxf(__builtin_fmaxf((a),(b)),(c))
  #define GAPA(MF,A0,A1,A2,A3,W0,W1,PW) do{ MF; sacc+=A0; sacc+=A1; sacc+=A2; sacc+=A3; PIN(sacc); W0; W1; PIN(PW); SBAR(); }while(0)
  #define EX(v) __builtin_amdgcn_exp2f(v)
  #define GAPB(MF,X,B) do{ MF; X[B]=EX(X[B]); X[B+1]=EX(X[B+1]); X[B+2]=EX(X[B+2]); X[B+3]=EX(X[B+3]); PIN(X); SBAR(); }while(0)
  #define VRD(i) do{ vlo[i]=vtr(vp_+(((i)>>2)*4096+((i)&3)*1024)); vhi[i]=vtr(vp_+(((i)>>2)*4096+((i)&3)*1024+512)); }while(0)
  #define KRD(G,j) do{ if(G){ kload2(kf,kp0+sl_next,j); SBAR(); } }while(0)
  #define STEP(C0,C1,P0,P1,t,GK,GV,GL) do{ SBAR(); \
    const lds_cptr vp_=vp0+sl_prev; \
    VRD(0); SBAR(); float sacc=(P0[0]+P0[1]); \
    GAPA(C0=__builtin_amdgcn_mfma_f32_32x32x16_bf16(kf[0],qr[0],zt,0,0,0), P0[2],P0[3],P0[4],P0[5],     pw0[0]=PKW(P0,0), pw0[1]=PKW(P0,2), pw0); \
    VRD(4); SBAR(); GAPA(C1=__builtin_amdgcn_mfma_f32_32x32x16_bf16(kf[1],qr[0],zt,0,0,0), P0[6],P0[7],P0[8],P0[9],     pw0[2]=PKW(P0,4), pw0[3]=PKW(P0,6), pw0); \
    VRD(1); SBAR(); GAPA(C0=__builtin_amdgcn_mfma_f32_32x32x16_bf16(kf[2],qr[1],C0,0,0,0),   P0[10],P0[11],P0[12],P0[13], pw1[0]=PKW(P0,8), pw1[1]=PKW(P0,10), pw1); \
    VRD(5); SBAR(); GAPA(C1=__builtin_amdgcn_mfma_f32_32x32x16_bf16(kf[3],qr[1],C1,0,0,0),   P0[14],P0[15],P1[0],P1[1],   pw1[2]=PKW(P0,12),pw1[3]=PKW(P0,14), pw1); \
    VRD(2); SBAR(); GAPA(C0=__builtin_amdgcn_mfma_f32_32x32x16_bf16(kf[4],qr[2],C0,0,0,0),   P1[2],P1[3],P1[4],P1[5],     pw2[0]=PKW(P1,0), pw2[1]=PKW(P1,2), pw2); \
    VRD(6); SBAR(); GAPA(C1=__builtin_amdgcn_mfma_f32_32x32x16_bf16(kf[5],qr[2],C1,0,0,0),   P1[6],P1[7],P1[8],P1[9],     pw2[2]=PKW(P1,4), pw2[3]=PKW(P1,6), pw2); \
    VRD(3); SBAR(); GAPA(C0=__builtin_amdgcn_mfma_f32_32x32x16_bf16(kf[6],qr[3],C0,0,0,0),   P1[10],P1[11],P1[12],P1[13], pw3[0]=PKW(P1,8), pw3[1]=PKW(P1,10), pw3); \
    VRD(7); SBAR(); GAPA(C1=__builtin_amdgcn_mfma_f32_32x32x16_bf16(kf[7],qr[3],C1,0,0,0),   P1[14],P1[15],0.f,0.f,       pw3[2]=PKW(P1,12),pw3[3]=PKW(P1,14), pw3); \
    l_reg+=sacc; \
    if(GK){DMA_K((t)+3,sl_cur);} if(GV){DMA_V((t)+1,sl_next);} \
    _Pragma("unroll") for(int r=0;r<16;++r){C0[r]-=mhat;C1[r]-=mhat;} \
    CMASK(C0,C1,t); \
    { float a=MX3(C0[0],C0[1],C1[0]),b=MX3(C0[2],C0[3],C1[1]); a=MX3(a,C1[2],C1[3]); \
      _Pragma("unroll") for(int r=4;r<16;r+=4){a=MX3(a,C0[r],C0[r+1]);b=MX3(b,C0[r+2],C0[r+3]);a=MX3(a,C1[r],C1[r+1]);b=MX3(b,C1[r+2],C1[r+3]);} \
      float rm=__builtin_fmaxf(a,b); { auto rr=__builtin_amdgcn_permlane32_swap(__float_as_uint(rm),__float_as_uint(rm),false,false); rm=__builtin_fmaxf(__uint_as_float(rr[0]),__uint_as_float(rr[1])); } \
      resc=false; \
      if(__builtin_expect(__any(rm>(float)THRL),0)){ const float dl=__builtin_fmaxf(rm,0.f); mhat+=dl; \
        _Pragma("unroll") for(int r=0;r<16;++r){C0[r]-=dl;C1[r]-=dl;} \
        const float f=__builtin_amdgcn_exp2f(-dl); l_reg*=f; if(hi==0)wsf[r32]=f; resc=true; } } \
    SBAR(); \
    GAPB(o[0]=__builtin_amdgcn_mfma_f32_32x32x16_bf16(PAF(0),VFR(0),o[0],0,0,0), C0,0); \
    GAPB(o[1]=__builtin_amdgcn_mfma_f32_32x32x16_bf16(PAF(0),VFR(4),o[1],0,0,0), C0,4); \
    KRD(GL,0); GAPB(o[0]=__builtin_amdgcn_mfma_f32_32x32x16_bf16(PAF(1),VFR(1),o[0],0,0,0), C0,8); \
    KRD(GL,1); GAPB(o[1]=__builtin_amdgcn_mfma_f32_32x32x16_bf16(PAF(1),VFR(5),o[1],0,0,0), C0,12); \
    KRD(GL,2); GAPB(o[0]=__builtin_amdgcn_mfma_f32_32x32x16_bf16(PAF(2),VFR(2),o[0],0,0,0), C1,0); \
    KRD(GL,3); GAPB(o[1]=__builtin_amdgcn_mfma_f32_32x32x16_bf16(PAF(2),VFR(6),o[1],0,0,0), C1,4); \
    GAPB(o[0]=__builtin_amdgcn_mfma_f32_32x32x16_bf16(PAF(3),VFR(3),o[0],0,0,0), C1,8); \
    GAPB(o[1]=__builtin_amdgcn_mfma_f32_32x32x16_bf16(PAF(3),VFR(7),o[1],0,0,0), C1,12); \
    }while(0)
  int t=1;
  #undef CMASK
  #define CMASK(P0,P1,t) do{}while(0)
  for(;t+7<NTL;t+=2){
    STEP(pB0,pB1,pA0,pA1,t,true,true,true);     WAIT_BAR(2); RESC(); ROT();
    STEP(pA0,pA1,pB0,pB1,t+1,true,true,true);   WAIT_BAR(2); RESC(); ROT();
  }
  #undef CMASK
  #define CMASK(P0,P1,t) bmask(P0,P1,(t),q0,wid,r32,hi,btab)
  #define ENDW(tt) do{ if((tt)+3<NTL){WAIT_BAR(2);} else if((tt)+2<NTL){WAIT_BAR(1);} else {WAIT_BAR(0);} }while(0)
  for(;t+1<NTL;t+=2){
    STEP(pB0,pB1,pA0,pA1,t,(t+3<NTL),(t+1<NTL),(t+1<NTL));       ENDW(t);   RESC(); ROT();
    STEP(pA0,pA1,pB0,pB1,t+1,(t+4<NTL),(t+2<NTL),(t+2<NTL));     ENDW(t+1); RESC(); ROT();
  }
  STEP(pB0,pB1,pA0,pA1,NTL-1,false,false,false); RESC();
  { float sacc=pB0[0]+pB0[1]; _Pragma("unroll") for(int r=2;r<16;++r)sacc+=pB0[r]; _Pragma("unroll") for(int r=0;r<16;++r)sacc+=pB1[r]; l_reg+=sacc;
    pw0=(u32x4){PKW(pB0,0),PKW(pB0,2),PKW(pB0,4),PKW(pB0,6)};pw1=(u32x4){PKW(pB0,8),PKW(pB0,10),PKW(pB0,12),PKW(pB0,14)};pw2=(u32x4){PKW(pB1,0),PKW(pB1,2),PKW(pB1,4),PKW(pB1,6)};pw3=(u32x4){PKW(pB1,8),PKW(pB1,10),PKW(pB1,12),PKW(pB1,14)};
    SBAR(); pv(o,vb0+sl_cur,PAF(0),PAF(1),PAF(2),PAF(3)); }
  #undef PKW
  #undef PAF
  #undef VFR
  #undef PIN
  #undef MX3
  #undef GAPA
  #undef GAPB
  #undef EX
  #undef VRD
  #undef KRD
  #undef STEP
  #undef ENDW
  {auto rr=__builtin_amdgcn_permlane32_swap(__float_as_uint(l_reg),__float_as_uint(l_reg),false,false);l_reg=__uint_as_float(rr[0])+__uint_as_float(rr[1]);}
  if(hi==0)wsf[32+r32]=l_reg;asm volatile("s_waitcnt lgkmcnt(0)":::"memory");
  float rli[16];
  #pragma unroll
  for(int r=0;r<16;++r)rli[r]=__builtin_amdgcn_rcpf(wsf[32+crow(r,hi)]);
  bf16*Ow=O+(rowbase+q0+wid*QBLK)*OP+ooff;
  { bf16*stg=(bf16*)(shm+LDS_OST)+wid*2048;
    #pragma unroll
    for(int r=0;r<16;++r){const int orow=crow(r,hi);
      #pragma unroll
      for(int d0=0;d0<2;++d0)stg[orow*64+d0*32+r32]=__float2bfloat16(o[d0][r]*rli[r]);}
    asm volatile("s_waitcnt lgkmcnt(0)":::"memory");
    #pragma unroll
    for(int i=0;i<4;++i){const int row=i*8+(lane>>3),ch=lane&7; const u32x4 v=*(const u32x4*)(stg+row*64+ch*8); ATTN_STORE16(Ow+(long)row*OP+ch*8,v);} }
  asm volatile("s_waitcnt lgkmcnt(0)\n\ts_barrier":::"memory");
  #undef DMA_K
  #undef DMA_V
  #undef CMASK
  #undef START
  #undef RESC
  #undef ROT
}
constexpr int ATTN_LDS_BYTES=LDS_BYTES;
#undef SBAR
#undef WAIT_BAR
#undef WAIT_BAR
}
namespace mk {
#define GAS __attribute__((address_space(1)))
#define LAS __attribute__((address_space(3)))
typedef unsigned short bf16;
typedef unsigned v4u __attribute__((ext_vector_type(4)));
typedef unsigned v2u __attribute__((ext_vector_type(2)));
typedef float f32x4 __attribute__((ext_vector_type(4)));
typedef float f32x16 __attribute__((ext_vector_type(16)));
typedef short bf16x8 __attribute__((ext_vector_type(8)));
typedef GAS unsigned gu32;
#define RLX_AGENT __ATOMIC_RELAXED, __HIP_MEMORY_SCOPE_AGENT
#define LDS_WAIT() asm volatile("s_waitcnt lgkmcnt(0)" ::: "memory")
#define VM_WAIT() asm volatile("s_waitcnt vmcnt(0)" ::: "memory")
typedef float f32x2_cv __attribute__((ext_vector_type(2))); typedef __bf16 bf16x2_cv __attribute__((ext_vector_type(2)));
__device__ __forceinline__ unsigned pk2(float lo, float hi) { const f32x2_cv v = {lo, hi}; return __builtin_bit_cast(unsigned, __builtin_convertvector(v, bf16x2_cv)); }
__device__ __forceinline__ unsigned f2bf(float f) { return pk2(f, 0.f) & 0xffffu; }
__device__ __forceinline__ float bf2f(unsigned short b) { return __builtin_bit_cast(float, ((unsigned)b) << 16); }
__device__ __forceinline__ float bflo(unsigned w) { return __builtin_bit_cast(float, w << 16); }
__device__ __forceinline__ float bfhi(unsigned w) { return __builtin_bit_cast(float, w & 0xffff0000u); }

constexpr int NWAVES = 8, NTHR = NWAVES * 64;
constexpr int PADF = 48;
constexpr int LPP = 8448;
constexpr int PEND = PADF + LP;
constexpr int SROW0 = BATCH * LPP;
constexpr int RP = SROW0 + NS;
constexpr int ZN = 7424;
constexpr int ZC_QA = 0, ZC_KA = 512, ZC_VA = 1024, ZC_QKVB = 1536, ZC_GB = 3072, ZC_UC = 3584, ZC_GATE = 4096, ZC_BA = 7168;
static_assert(RP % 256 == 0 && ZN % 256 == 0 && D_MODEL == 1024 && WIDTH_A == 512 && WIDTH_B == 512 && WIDTH_C == 512, "shapes");
__host__ __device__ __forceinline__ int nat2prow(int row) { return row < NP ? (row / LP) * LPP + PADF + row % LP : SROW0 + (row - NP); }
__host__ __device__ __forceinline__ int zcol(int col) { return col < 3584 ? col : (col < 3592 ? ZC_BA + (col - 3584) : col - 8); }
__device__ __forceinline__ bool prow_valid(int prow) { if (prow >= SROW0) return true; const int p = prow % LPP; return p >= PADF && p < PEND; }
__device__ __forceinline__ int prow2nat(int prow) { if (prow >= SROW0) return NP + (prow - SROW0); return (prow / LPP) * LP + (prow % LPP) - PADF; }

constexpr int RING_OFF = 0, RING_BYTES = 147456;
constexpr int LDSCTL_OFF = RING_BYTES, MISC_OFF = LDSCTL_OFF + 320;
constexpr int LDS_BYTES = RING_BYTES + 1024;
static_assert(MISC_OFF + 128 <= LDS_BYTES, "LDS map");

constexpr size_t CTL_BYTES = 1u << 20;
constexpr int CW_TMO = 0, CW_CODE = 1;
constexpr int CW_BAR = 4096;
constexpr int CW_QUEUE = 16384;
constexpr int CW_GDNFLAG = 32768;

__device__ __forceinline__ int lane_id() { return (int)__builtin_amdgcn_mbcnt_hi(~0u, __builtin_amdgcn_mbcnt_lo(~0u, 0u)); }
#define XB_TMO      128
#define XB_XCNT(j)  (256  + 64 * (j))
#define XB_XSUB(j)  (1280 + 64 * (j))
#define XB_XGEN(j)  (2304 + 64 * (j))
#define XB_TOP      3328
#define XB_TOPGEN   3392
#define XCD_BAR_WORDS 3456
#define XB_SPIN_CAP (1u << 18)

__device__ __forceinline__ unsigned xb_ld(unsigned* p)              { return __hip_atomic_load(p, __ATOMIC_RELAXED, __HIP_MEMORY_SCOPE_AGENT); }
__device__ __forceinline__ unsigned xb_add(unsigned* p, unsigned v) { return __hip_atomic_fetch_add(p, v, __ATOMIC_RELAXED, __HIP_MEMORY_SCOPE_AGENT); }
__device__ __forceinline__ unsigned xb_xcc_id() { return (unsigned)__builtin_amdgcn_s_getreg((3 << 11) | 20) & 0xFu; }
#define XB_SPIN(cond, bar) do { unsigned _sp = 0; while (cond) { __builtin_amdgcn_s_sleep(1); \
    if ((++_sp & 255u) == 0u) { if (xb_ld(&(bar)[XB_TMO])) break; if (_sp > XB_SPIN_CAP) { atomicAdd(&(bar)[XB_TMO], 1u); break; } } } } while (0)

struct XcdBarrier {
    unsigned* bar; unsigned x; int wv;
    volatile LAS unsigned* st;
};

__device__ __forceinline__ XcdBarrier xcd_barrier_post(unsigned* bar, volatile LAS unsigned* st, int wv) {
    XcdBarrier b; b.bar = bar; b.x = xb_xcc_id(); b.st = st; b.wv = wv;
    if (wv == 0 && lane_id() == 0) (void)xb_add(&bar[XB_XCNT(b.x)], 1u);
    return b;
}
__device__ __forceinline__ void xcd_barrier_complete(unsigned* bar, unsigned x, unsigned& nloc, unsigned& nx) {
    const unsigned G = gridDim.x * gridDim.y * gridDim.z;
    unsigned sum, cnt, mine, sp = 0u;
    for (;;) {
        sum = 0u; cnt = 0u; mine = 0u;
#pragma unroll
        for (unsigned j = 0; j < 16; ++j) { const unsigned c = xb_ld(&bar[XB_XCNT(j)]); sum += c; cnt += (c > 0u) ? 1u : 0u; mine = (j == x) ? c : mine; }
        if (sum == G) break;
        __builtin_amdgcn_s_sleep(1);
        if ((++sp & 255u) == 0u) { if (xb_ld(&bar[XB_TMO])) break; if (sp > XB_SPIN_CAP) { atomicAdd(&bar[XB_TMO], 1u); break; } }
    }
    nloc = mine > 0u ? mine : 1u; nx = cnt > 0u ? cnt : 1u;
}

__device__ __forceinline__ void xcd_barrier(const XcdBarrier& b) {
    asm volatile("s_waitcnt vmcnt(0)" ::: "memory");
    __syncthreads();
    if (b.wv == 0 && lane_id() == 0) {
        unsigned* bar = b.bar;
        __builtin_amdgcn_s_waitcnt(0);
        unsigned nloc = b.st[0], nx = b.st[1];
        if (nloc == 0u) { xcd_barrier_complete(bar, b.x, nloc, nx); b.st[0] = nloc; b.st[1] = nx; }
        const unsigned old = xb_add(&bar[XB_XSUB(b.x)], 1u);
        const unsigned gen = old / nloc;
        if (old + 1u == (gen + 1u) * nloc) {
            __builtin_amdgcn_fence(__ATOMIC_RELEASE, "agent");
            asm volatile("s_waitcnt vmcnt(0)" ::: "memory");
            const unsigned og = xb_add(&bar[XB_TOP], 1u);
            const unsigned tg = og / nx;
            if (og + 1u == (tg + 1u) * nx) xb_add(&bar[XB_TOPGEN], 1u);
            else XB_SPIN(xb_ld(&bar[XB_TOPGEN]) == tg, bar);
            __builtin_amdgcn_fence(__ATOMIC_ACQUIRE, "agent");
            xb_add(&bar[XB_XGEN(b.x)], 1u);
            asm volatile("s_waitcnt vmcnt(0)" ::: "memory");
        } else {
            XB_SPIN(xb_ld(&bar[XB_XGEN(b.x)]) == gen, bar);
            __builtin_amdgcn_fence(__ATOMIC_ACQUIRE, "agent");
            asm volatile("s_waitcnt vmcnt(0)" ::: "memory");
        }
    }
    __syncthreads();
}


template <int CTRL> __device__ __forceinline__ float dpp_f(float v) { return __builtin_bit_cast(float, __builtin_amdgcn_update_dpp(0, __builtin_bit_cast(int, v), CTRL, 0xf, 0xf, true)); }
template <int CTRL> __device__ __forceinline__ int dpp_i(int v) { return __builtin_amdgcn_update_dpp(0, v, CTRL, 0xf, 0xf, true); }
template <int CTRL, int ROWMASK> __device__ __forceinline__ float dpp_fm(float v) { return __builtin_bit_cast(float, __builtin_amdgcn_update_dpp(0, __builtin_bit_cast(int, v), CTRL, ROWMASK, 0xf, false)); }
__device__ __forceinline__ float rdlane(float v, int i) { return __builtin_bit_cast(float, __builtin_amdgcn_readlane(__builtin_bit_cast(int, v), i)); }
__device__ __forceinline__ float sum8(float v) { v += dpp_f<0xB1>(v); v += dpp_f<0x4E>(v); v += dpp_f<0x141>(v); return v; }
__device__ __forceinline__ float sum16(float v) { v = sum8(v); v += dpp_f<0x140>(v); return v; }
__device__ __forceinline__ float wave_sum(float v) { v = sum16(v); return rdlane(v, 0) + rdlane(v, 16) + rdlane(v, 32) + rdlane(v, 48); }
__device__ __forceinline__ float wave_max(float v) {
    v = fmaxf(v, dpp_f<0xB1>(v)); v = fmaxf(v, dpp_f<0x4E>(v)); v = fmaxf(v, dpp_f<0x141>(v)); v = fmaxf(v, dpp_f<0x140>(v));
    return fmaxf(fmaxf(rdlane(v, 0), rdlane(v, 16)), fmaxf(rdlane(v, 32), rdlane(v, 48)));
}
__device__ __forceinline__ float scan64(float v) {
    v += dpp_f<0x111>(v); v += dpp_f<0x112>(v); v += dpp_f<0x114>(v); v += dpp_f<0x118>(v);
    v += dpp_fm<0x142, 0xA>(v); v += dpp_fm<0x143, 0xC>(v);
    return v;
}
__device__ __forceinline__ float swap32(float v) {
    const auto r = __builtin_amdgcn_permlane32_swap(__builtin_bit_cast(unsigned, v), __builtin_bit_cast(unsigned, v), false, false);
    return __builtin_bit_cast(float, (lane_id() & 32) ? r[0] : r[1]);
}
__device__ __forceinline__ float swap16(float v) {
    const auto r = __builtin_amdgcn_permlane16_swap(__builtin_bit_cast(unsigned, v), __builtin_bit_cast(unsigned, v), false, false);
    return __builtin_bit_cast(float, (lane_id() & 16) ? r[0] : r[1]);
}
}
namespace mk {
enum Region { R_X, R_XN, R_WIN, R_Z, R_QN, R_KN, R_QKVB, R_BG, R_O, R_OA, R_OB, R_YC, R_OC, R_MRG, R_WGLU, R_WBR, R_WOUT, R_WQS, R_PU, R_PV, R_SC, R_GDN, R_S5T, R_MISC, R_S5E, R_S5X, R_MRGB, R_OBN, R_MRG2, R_NREG };
constexpr int NPL = 16;
enum Phase { PH_PRO = 0, PL_NORM1 = 0, PL_GEMM_IN = 1, PL_ZPOST = 2, PL_LOCAL = 3, PL_MIX = 4, PL_MIXPOST = 5, PL_GEMM_GLU = 6, PL_GEMM_BRA = 7, PL_GEMM_BRB = 8, PL_GEMM_BRC = 9,
             PL_GEMM_OUT = 10, PL_NORM2 = 11, PL_GEMM_PEER = 12, PL_PEER = 13, PH_FINAL = 1 + DEPTH * NPL, PH_END = PH_FINAL + 1 };
enum ProMask { PM_NORM0 = 64, PM_X = 1, PM_WIN = 2, PM_WREST = 4, PM_PEERW = 8, PM_WQS = 16, PM_TABLES = 32 };
struct Args {
    const float* in[40];
    float* out;
    unsigned char* ws;
    unsigned long long off[32];
    int ph_lo, ph_hi, pro_mask, bar_region;
};
static_assert(sizeof(Args) == 40 * 8 + 8 + 8 + 32 * 8 + 16, "Args has no padding");

typedef const __attribute__((address_space(4))) Args* KArgs;
__device__ __forceinline__ KArgs kargs() { KArgs p = (KArgs)__builtin_amdgcn_kernarg_segment_ptr(); asm volatile("" : "+s"(p)); return p; }
__device__ __forceinline__ void assume_global(const void* p) {
#if defined(__HIP_DEVICE_COMPILE__)
    __builtin_assume(!__builtin_amdgcn_is_shared(p) && !__builtin_amdgcn_is_private(p));
#endif
}
#define GIN(a, i) ((const float*)(const GAS float*)(a).in[i])
#define GOUT(a) ((float*)(GAS float*)(a).out)
#define WS_OPAQUE(a) GAS unsigned char* wsg_ = (GAS unsigned char*)(a).ws; asm volatile("" : "+s"(wsg_)); unsigned char* wsb = (unsigned char*)wsg_
#define otid() otid_(F.wv)
__device__ __forceinline__ int otid_(int wv) { unsigned m = ~0u; asm volatile("" : "+s"(m), "+s"(wv));
    return wv * 64 + (int)__builtin_amdgcn_mbcnt_hi(m, __builtin_amdgcn_mbcnt_lo(m, 0u)); }
struct Frame {
    LAS unsigned char* lds; volatile LAS unsigned* MISC; gu32* ctl;
    int vcu, G, wv;
};

struct TrItem { f32x4 v[8]; };
template <class CM> __device__ __forceinline__ void tr_load(TrItem& t, const float* W, int ld, int n0, int k0, const CM& cm, int lane) {
    const int sc = cm(n0 + 4 * (lane & 7)), kr = lane >> 3;
    const GAS float* Wg = (const GAS float*)W;
#pragma unroll
    for (int i = 0; i < 8; ++i) t.v[i] = sc >= 0 ? *(const GAS f32x4*)(Wg + (size_t)(k0 + 8 * i + kr) * ld + sc) : (f32x4){0.f, 0.f, 0.f, 0.f};
}
__device__ __forceinline__ void tr_store(const TrItem& t, int K, bf16* WT, int n0, int k0, LAS float* scr, int lane) {
    { const int q = lane & 7, kr = lane >> 3;
#pragma unroll
      for (int i = 0; i < 8; ++i) { LAS float* d = scr + (8 * i + kr) * 33 + 4 * q; d[0] = t.v[i].x; d[1] = t.v[i].y; d[2] = t.v[i].z; d[3] = t.v[i].w; } }
    LDS_WAIT(); asm volatile("" ::: "memory");
    const int c = lane & 7;
#pragma unroll
    for (int j = 0; j < 4; ++j) { const int n = (lane >> 3) + 8 * j; const LAS float* s = scr + (8 * c) * 33 + n;
        v4u o; o.x = pk2(s[0 * 33], s[1 * 33]); o.y = pk2(s[2 * 33], s[3 * 33]); o.z = pk2(s[4 * 33], s[5 * 33]); o.w = pk2(s[6 * 33], s[7 * 33]);
        *(GAS v4u*)(WT + (size_t)(n0 + n) * K + k0 + 8 * c) = o; }
    LDS_WAIT(); asm volatile("" ::: "memory");
}
struct CmWin { __device__ __forceinline__ int operator()(int n) const { return n < 3584 ? n : (n < 7168 ? n + 8 : (n < 7176 ? 3584 + (n - 7168) : -1)); } };
struct CmId { __device__ __forceinline__ int operator()(int n) const { return n; } };
struct CmGlu { __device__ __forceinline__ int operator()(int n) const { const int G = n >> 5, i = n & 31; return i < 16 ? 16 * G + i : 512 + 16 * G + (i - 16); } };

__device__ __forceinline__ void rms_row_to_bf16(const float* xrow, const float* g, bf16* orow, int lane) {
    const GAS f32x4* xr = (const GAS f32x4*)xrow + lane;
    f32x4 v[4]; float s2 = 0.f;
#pragma unroll
    for (int j = 0; j < 4; ++j) { v[j] = xr[64 * j]; s2 += (v[j].x * v[j].x + v[j].y * v[j].y) + (v[j].z * v[j].z + v[j].w * v[j].w); }
    const float r = __builtin_amdgcn_rsqf(wave_sum(s2) * (1.f / D_MODEL) + EPSF);
    const GAS f32x4* gr = (const GAS f32x4*)g + lane;
    GAS unsigned long long* o8 = (GAS unsigned long long*)orow + lane;
#pragma unroll
    for (int j = 0; j < 4; ++j) { const f32x4 gg = gr[64 * j];
        o8[64 * j] = (unsigned long long)pk2(v[j].x * r * gg.x, v[j].y * r * gg.y) | ((unsigned long long)pk2(v[j].z * r * gg.z, v[j].w * r * gg.w) << 32); }
}

__device__ __forceinline__ void p_norm(Frame& F, int l, int gi) {
    const KArgs ap = kargs(); const auto& a = *ap; WS_OPAQUE(a);
    const int tid = otid(), lane = tid & 63, wave = __builtin_amdgcn_readfirstlane(tid >> 6);
    const float* X = (const float*)(wsb + a.off[R_X]); bf16* XN = (bf16*)(wsb + a.off[R_XN]); const float* g = GIN(a, gi) + (size_t)l * D_MODEL;
    const int gw = F.vcu * NWAVES + wave, NGW = F.G * NWAVES;
    for (int m = gw; m < RP; m += NGW) rms_row_to_bf16(X + (size_t)m * D_MODEL, g, XN + (size_t)m * D_MODEL, lane);
}
__device__ __forceinline__ void p_norm0(Frame& F) {
    const KArgs ap = kargs(); const auto& a = *ap; WS_OPAQUE(a);
    const int tid = otid(), lane = tid & 63, wave = __builtin_amdgcn_readfirstlane(tid >> 6);
    float* X = (float*)(wsb + a.off[R_X]); bf16* XN = (bf16*)(wsb + a.off[R_XN]);
    const int gw = F.vcu * NWAVES + wave, NGW = F.G * NWAVES;
    f32x4 gg[4];
#pragma unroll
    for (int j = 0; j < 4; ++j) gg[j] = ((const GAS f32x4*)GIN(a, I_N1))[lane + 64 * j];
#define N0_SRC(m_, s_) do { s_ = nullptr; if ((m_) < RP) { if ((m_) >= SROW0) s_ = GIN(a, I_XS) + (size_t)((m_) - SROW0) * D_MODEL; \
        else { const int b_ = (m_) / LPP, p_ = (m_) % LPP; if (p_ >= PADF && p_ < PEND) { const int pos_ = p_ - PADF; s_ = pos_ < N_META ? GIN(a, I_META) + (size_t)pos_ * D_MODEL : GIN(a, I_XP) + ((size_t)b_ * SEQ + pos_ - N_META) * D_MODEL; } } } } while (0)
#define N0_OUT(m_, v_) do { if ((m_) < RP) { float s2_ = 0.f; _Pragma("unroll") for (int j = 0; j < 4; ++j) s2_ += (v_[j].x * v_[j].x + v_[j].y * v_[j].y) + (v_[j].z * v_[j].z + v_[j].w * v_[j].w); \
        const float r_ = __builtin_amdgcn_rsqf(wave_sum(s2_) * (1.f / D_MODEL) + EPSF); \
        GAS f32x4* o_ = (GAS f32x4*)(X + (size_t)(m_) * D_MODEL) + lane; GAS unsigned long long* o8_ = (GAS unsigned long long*)(XN + (size_t)(m_) * D_MODEL) + lane; \
        _Pragma("unroll") for (int j = 0; j < 4; ++j) { o_[64 * j] = v_[j]; \
            o8_[64 * j] = (unsigned long long)pk2(v_[j].x * r_ * gg[j].x, v_[j].y * r_ * gg[j].y) | ((unsigned long long)pk2(v_[j].z * r_ * gg[j].z, v_[j].w * r_ * gg[j].w) << 32); } } } while (0)
    for (int m = gw; m < RP; m += 2 * NGW) {
        const int m2 = m + NGW; const float* sa; const float* sb; N0_SRC(m, sa); N0_SRC(m2, sb);
        f32x4 va[4], vb[4];
#pragma unroll
        for (int j = 0; j < 4; ++j) va[j] = sa ? ((const GAS f32x4*)sa)[lane + 64 * j] : (f32x4){0.f, 0.f, 0.f, 0.f};
#pragma unroll
        for (int j = 0; j < 4; ++j) vb[j] = sb ? ((const GAS f32x4*)sb)[lane + 64 * j] : (f32x4){0.f, 0.f, 0.f, 0.f};
        N0_OUT(m, va); N0_OUT(m2, vb);
    }
#undef N0_SRC
#undef N0_OUT
}
__device__ __forceinline__ void unpack8(const v4u w, float (&f)[8]) { f[0] = bflo(w.x); f[1] = bfhi(w.x); f[2] = bflo(w.y); f[3] = bfhi(w.y); f[4] = bflo(w.z); f[5] = bfhi(w.z); f[6] = bflo(w.w); f[7] = bfhi(w.w); }
__device__ __forceinline__ v4u pack8(const float (&f)[8]) { v4u w; w.x = pk2(f[0], f[1]); w.y = pk2(f[2], f[3]); w.z = pk2(f[4], f[5]); w.w = pk2(f[6], f[7]); return w; }
__device__ __forceinline__ float sigm(float x) { return __builtin_amdgcn_rcpf(1.f + __expf(-x)); }
constexpr float ATT_C2 = 0.125f * 1.4426950408889634f;
__device__ __forceinline__ void p_zpost(Frame& F, int l) {
    const KArgs ap = kargs(); const auto& a = *ap; WS_OPAQUE(a);
    const bf16* Z = (const bf16*)(wsb + a.off[R_Z]);
    bf16* QN = (bf16*)(wsb + a.off[R_QN]); bf16* KN = (bf16*)(wsb + a.off[R_KN]); bf16* QKVB = (bf16*)(wsb + a.off[R_QKVB]); float* BG = (float*)(wsb + a.off[R_BG]);
    const int tid = otid(), lane = tid & 63, wave = __builtin_amdgcn_readfirstlane(tid >> 6);
    const int gw = F.vcu * NWAVES + wave, NGW = F.G * NWAVES;
    float gq[8], gk[8], cw[3][4][8];
#pragma unroll
    for (int j = 0; j < 8; ++j) { gq[j] = GIN(a, I_QN)[l * HEAD_DIM_A + 8 * (lane & 7) + j] * ATT_C2; gk[j] = GIN(a, I_KN)[l * HEAD_DIM_A + 8 * (lane & 7) + j]; }
#pragma unroll
    for (int w = 0; w < 3; ++w)
#pragma unroll
        for (int i = 0; i < 4; ++i)
#pragma unroll
            for (int j = 0; j < 8; ++j) cw[w][i][j] = GIN(a, I_CONVW)[((size_t)l * CONV_W + i) * 3 * WIDTH_B + w * WIDTH_B + 8 * lane + j];
    float alog = 0.f, dtb = 0.f; if (lane < 4) { alog = GIN(a, I_ALOG)[l * N_HEADS_B + lane]; dtb = GIN(a, I_DTB)[l * N_HEADS_B + lane]; }
    for (int m = gw; m < RP; m += NGW) {
        const bool valid = prow_valid(m); const int nat = valid ? prow2nat(m) : 0;
        const bf16* zr = Z + (size_t)m * ZN;
        float f[8], o[8];
        const v4u Lq = *(const GAS v4u*)(zr + ZC_QA + 8 * lane), Lk = *(const GAS v4u*)(zr + ZC_KA + 8 * lane), Lv = *(const GAS v4u*)(zr + ZC_VA + 8 * lane);
        v4u Lc[3][4];
#pragma unroll
        for (int w = 0; w < 3; ++w)
#pragma unroll
            for (int i = 0; i < 4; ++i) { const int mm = m + i - 3 < 0 ? 0 : m + i - 3; Lc[w][i] = *(const GAS v4u*)(Z + (size_t)mm * ZN + ZC_QKVB + w * WIDTH_B + 8 * lane); }
        const unsigned short Lbe = zr[ZC_BA + (lane & 3)], Lal = zr[ZC_BA + 4 + (lane & 3)];
        unpack8(Lq, f);
        { float ss = 0.f;
#pragma unroll
          for (int j = 0; j < 8; ++j) ss += f[j] * f[j];
          ss = sum8(ss);
          const float r = __builtin_amdgcn_rsqf(ss * (1.f / HEAD_DIM_A) + EPSF);
#pragma unroll
          for (int j = 0; j < 8; ++j) o[j] = f[j] * r * gq[j];
          *(GAS v4u*)(QN + (size_t)m * WIDTH_A + 8 * lane) = pack8(o); }
        unpack8(Lk, f);
        { float ss = 0.f;
#pragma unroll
          for (int j = 0; j < 8; ++j) ss += f[j] * f[j];
          ss = sum8(ss);
          const float r = __builtin_amdgcn_rsqf(ss * (1.f / HEAD_DIM_A) + EPSF);
#pragma unroll
          for (int j = 0; j < 8; ++j) o[j] = f[j] * r * gk[j];
          *(GAS v4u*)(KN + (size_t)m * WIDTH_A + 8 * lane) = pack8(o);
          if (valid) { float* ko = nat < NP ? GOUT(a) + O_KP + ((size_t)l * NP + nat) * WIDTH_A : GOUT(a) + O_KS + ((size_t)l * NS + (nat - NP)) * WIDTH_A;
              *(GAS f32x4*)(ko + 8 * lane) = (f32x4){o[0], o[1], o[2], o[3]}; *(GAS f32x4*)(ko + 8 * lane + 4) = (f32x4){o[4], o[5], o[6], o[7]}; } }
        if (valid) { unpack8(Lv, f);
            float* vo = nat < NP ? GOUT(a) + O_VP + ((size_t)l * NP + nat) * WIDTH_A : GOUT(a) + O_VS + ((size_t)l * NS + (nat - NP)) * WIDTH_A;
            *(GAS f32x4*)(vo + 8 * lane) = (f32x4){f[0], f[1], f[2], f[3]}; *(GAS f32x4*)(vo + 8 * lane + 4) = (f32x4){f[4], f[5], f[6], f[7]}; }
        const int ts = m >= SROW0 ? (m - SROW0) % DEC_SEQ : 1000; const int bs = m >= SROW0 ? (m - SROW0) / DEC_SEQ : 0;
        int cj = -1;
        if (m >= SROW0) { if (ts >= DEC_SEQ - 3) cj = ts - (DEC_SEQ - 3); } else { const int p = m % LPP; if (p >= PEND - 3 && p < PEND) cj = p - (PEND - 3); }
#pragma unroll
        for (int w = 0; w < 3; ++w) {
            float acc[8];
#pragma unroll
            for (int j = 0; j < 8; ++j) acc[j] = 0.f;
#pragma unroll
            for (int i = 0; i < 4; ++i) {
                const int dt = i - 3;
                if (ts + dt < 0) {
                    const float* sc = GIN(a, I_SCONV) + (((size_t)l * DEC_BATCH + bs) * (CONV_W - 1) + (CONV_W - 1 + ts + dt)) * 3 * WIDTH_B + w * WIDTH_B + 8 * lane;
                    const f32x4 s0 = *(const GAS f32x4*)sc, s1 = *(const GAS f32x4*)(sc + 4);
                    f[0] = s0.x; f[1] = s0.y; f[2] = s0.z; f[3] = s0.w; f[4] = s1.x; f[5] = s1.y; f[6] = s1.z; f[7] = s1.w;
                } else unpack8(Lc[w][i], f);
#pragma unroll
                for (int j = 0; j < 8; ++j) acc[j] += f[j] * cw[w][i][j];
                if (i == 3 && cj >= 0) {
                    float* co = m >= SROW0 ? GOUT(a) + O_CS + (((size_t)l * DEC_BATCH + bs) * (CONV_W - 1) + cj) * 3 * WIDTH_B : GOUT(a) + O_CP + (((size_t)l * BATCH + m / LPP) * (CONV_W - 1) + cj) * 3 * WIDTH_B;
                    *(GAS f32x4*)(co + w * WIDTH_B + 8 * lane) = (f32x4){f[0], f[1], f[2], f[3]}; *(GAS f32x4*)(co + w * WIDTH_B + 8 * lane + 4) = (f32x4){f[4], f[5], f[6], f[7]}; }
            }
            float ss = 0.f;
#pragma unroll
            for (int j = 0; j < 8; ++j) { acc[j] = acc[j] * sigm(acc[j]); ss += acc[j] * acc[j]; }
            float sc = 1.f;
            if (w < 2) { ss = sum16(ss);
                sc = __builtin_amdgcn_rsqf(ss + EPSF); if (w == 0) sc *= 0.08838834764831845f; }
#pragma unroll
            for (int j = 0; j < 8; ++j) o[j] = acc[j] * sc;
            *(GAS v4u*)(QKVB + (size_t)m * 3 * WIDTH_B + w * WIDTH_B + 8 * lane) = pack8(o);
        }
        if (lane < 4) { const float be = bf2f(Lbe), al = bf2f(Lal) + dtb;
            const float sp = al > 20.f ? al : __logf(1.f + __expf(al));
            BG[(size_t)m * 8 + lane] = valid ? sigm(be) : 0.f; BG[(size_t)m * 8 + 4 + lane] = valid ? -__expf(alog) * sp : 0.f; }
    }
}
constexpr float LOG2E = 1.4426950408889634f;
__device__ __forceinline__ int t5_bucket_dev(int rel) {
    const int n = rel < 0 ? -rel : rel; int b;
    if (n < 8) b = n; else if (n < 12) b = 8; else if (n < 16) b = 9; else if (n < 23) b = 10; else if (n < 32) b = 11;
    else if (n < 46) b = 12; else if (n < 64) b = 13; else if (n < 91) b = 14; else b = 15;
    return b + (rel > 0 ? 16 : 0);
}
__device__ __forceinline__ void build_bias_table(LAS float* tab, const float* rel_bias, int h, int tid) {
    const float far = rel_bias[15 * N_HEADS_A + h];
    for (int i = tid; i < attn_body::BT_N; i += NTHR) tab[i] = (rel_bias[t5_bucket_dev(i - attn_body::BT_OFF) * N_HEADS_A + h] - far) * LOG2E;
}
__device__ __forceinline__ float lam_init_dev(int l) { return 0.8f - 0.6f * __expf(-0.3f * (float)l); }
__device__ __forceinline__ float lam_dev(const float* lqk_all, int l, int lane) {
    const float* q = lqk_all + (size_t)l * 4 * HEAD_DIM_A;
    const float s0 = wave_sum(q[lane] * q[HEAD_DIM_A + lane]), s1 = wave_sum(q[2 * HEAD_DIM_A + lane] * q[3 * HEAD_DIM_A + lane]);
    return __expf(s0) - __expf(s1) + lam_init_dev(l);
}
__device__ __forceinline__ int krow_dev(int s, int h, int j) { return 16 * s + 8 * (j >> 2) + 4 * h + (j & 3); }
__device__ __forceinline__ int crow_dev(int r, int h) { return (r & 3) + 8 * (r >> 2) + 4 * h; }
__device__ __forceinline__ bf16x8 pack_f8(const f32x4 a, const f32x4 b) { v4u w; w.x = pk2(a.x, a.y); w.y = pk2(a.z, a.w); w.z = pk2(b.x, b.y); w.w = pk2(b.z, b.w); return __builtin_bit_cast(bf16x8, w); }

__device__ __forceinline__ void sample_scores(f32x16& X, int kb, int c, const float* ck, const bf16* KN, int row0, int h, int hi, int r32, int qpos, const bf16x8 (&qf)[4], const LAS float* tab) {
    bf16x8 kf[4];
    if (kb < PAST_LEN / 32) { const float* kr = ck + (size_t)(kb * 32 + r32) * WIDTH_A + h * 128 + c * 64 + 8 * hi;
#pragma unroll
        for (int s = 0; s < 4; ++s) kf[s] = pack_f8(*(const GAS f32x4*)(kr + 16 * s), *(const GAS f32x4*)(kr + 16 * s + 4)); }
    else { const bf16* kr = KN + (size_t)(row0 + (kb * 32 - PAST_LEN) + r32) * WIDTH_A + h * 128 + c * 64 + 8 * hi;
#pragma unroll
        for (int s = 0; s < 4; ++s) kf[s] = *(const GAS bf16x8*)(kr + 16 * s); }
#pragma unroll
    for (int i = 0; i < 16; ++i) X[i] = 0.f;
#pragma unroll
    for (int s = 0; s < 4; ++s) X = __builtin_amdgcn_mfma_f32_32x32x16_bf16(kf[s], qf[s], X, 0, 0, 0);
#pragma unroll
    for (int i = 0; i < 16; ++i) { int idx = kb * 32 + crow_dev(i, hi) - qpos + attn_body::BT_OFF; idx = idx < 0 ? 0 : idx; X[i] += tab[idx]; }
}

__device__ __forceinline__ void attn_sample_unit(Frame& F, int l, int bs, int h) {
    const KArgs ap = kargs(); const auto& a = *ap; WS_OPAQUE(a);
    const int tid = otid(), lane = tid & 63, wid = __builtin_amdgcn_readfirstlane(tid >> 6), r32 = lane & 31, hi = lane >> 5;
    const bf16* QN = (const bf16*)(wsb + a.off[R_QN]); const bf16* KN = (const bf16*)(wsb + a.off[R_KN]); const bf16* Z = (const bf16*)(wsb + a.off[R_Z]); bf16* O = (bf16*)(wsb + a.off[R_O]);
    const float* ck = GIN(a, I_CK) + ((size_t)l * DEC_BATCH + bs) * PAST_LEN * WIDTH_A; const float* cv = GIN(a, I_CV) + ((size_t)l * DEC_BATCH + bs) * PAST_LEN * WIDTH_A;
    const int row0 = SROW0 + bs * DEC_SEQ;
    LAS float* tab = (LAS float*)(F.lds + RING_OFF + attn_body::LDS_BT);
    LAS float* st = (LAS float*)(F.lds + RING_OFF + 90112);
    LAS float* slot = (LAS float*)(F.lds + RING_OFF);
    const float lam = lam_dev(GIN(a, I_LQK), l, lane);
    build_bias_table(tab, GIN(a, I_REL), h, tid);
    bf16x8 qf[2][4];
#pragma unroll
    for (int c = 0; c < 2; ++c)
#pragma unroll
        for (int s = 0; s < 4; ++s) qf[c][s] = *(const GAS bf16x8*)(QN + (size_t)(row0 + r32) * WIDTH_A + h * 128 + c * 64 + 16 * s + 8 * hi);
    __syncthreads();
    float m[2] = {-1e30f, -1e30f}, lsum[2] = {0.f, 0.f};
    const int qpos = PAST_LEN + r32;
    for (int kb = wid; kb < (PAST_LEN + DEC_SEQ) / 32; kb += NWAVES) {
#pragma unroll
        for (int c = 0; c < 2; ++c) { f32x16 X; sample_scores(X, kb, c, ck, KN, row0, h, hi, r32, qpos, qf[c], tab);
            float mx = X[0];
#pragma unroll
            for (int i = 1; i < 16; ++i) mx = fmaxf(mx, X[i]);
            mx = fmaxf(mx, swap32(mx)); const float mn = fmaxf(m[c], mx);
            float sum = 0.f;
#pragma unroll
            for (int i = 0; i < 16; ++i) sum += exp2f(X[i] - mn);
            lsum[c] = lsum[c] * exp2f(m[c] - mn) + sum; m[c] = mn; }
    }
#pragma unroll
    for (int c = 0; c < 2; ++c) { lsum[c] += swap32(lsum[c]); if (hi == 0) { st[((wid * 2 + c) * 2 + 0) * 32 + r32] = m[c]; st[((wid * 2 + c) * 2 + 1) * 32 + r32] = lsum[c]; } }
    __syncthreads();
    float gm[2], ginv[2];
#pragma unroll
    for (int c = 0; c < 2; ++c) { float mm = -1e30f;
#pragma unroll
        for (int w = 0; w < NWAVES; ++w) mm = fmaxf(mm, st[((w * 2 + c) * 2 + 0) * 32 + r32]);
        float ll = 0.f;
#pragma unroll
        for (int w = 0; w < NWAVES; ++w) ll += st[((w * 2 + c) * 2 + 1) * 32 + r32] * exp2f(st[((w * 2 + c) * 2 + 0) * 32 + r32] - mm);
        gm[c] = mm; ginv[c] = (c == 0 ? 1.f : lam) / ll; }
    f32x16 acc[4];
#pragma unroll
    for (int eb = 0; eb < 4; ++eb)
#pragma unroll
        for (int i = 0; i < 16; ++i) acc[eb][i] = 0.f;
    for (int kb = wid; kb < (PAST_LEN + DEC_SEQ) / 32; kb += NWAVES) {
        f32x16 X0, X1; sample_scores(X0, kb, 0, ck, KN, row0, h, hi, r32, qpos, qf[0], tab); sample_scores(X1, kb, 1, ck, KN, row0, h, hi, r32, qpos, qf[1], tab);
        float wv[16];
#pragma unroll
        for (int i = 0; i < 16; ++i) wv[i] = exp2f(X0[i] - gm[0]) * ginv[0] - exp2f(X1[i] - gm[1]) * ginv[1];
        bf16x8 xs[2];
#pragma unroll
        for (int s = 0; s < 2; ++s) { v4u w; w.x = pk2(wv[8 * s], wv[8 * s + 1]); w.y = pk2(wv[8 * s + 2], wv[8 * s + 3]); w.z = pk2(wv[8 * s + 4], wv[8 * s + 5]); w.w = pk2(wv[8 * s + 6], wv[8 * s + 7]); xs[s] = __builtin_bit_cast(bf16x8, w); }
#pragma unroll
        for (int eb = 0; eb < 4; ++eb)
#pragma unroll
            for (int s = 0; s < 2; ++s) {
                float vv[8];
                if (kb < PAST_LEN / 32) { const GAS float* vb = (const GAS float*)(cv + (size_t)(kb * 32 + 4 * hi) * WIDTH_A + h * 128 + eb * 32 + r32); asm volatile("" : "+v"(vb));
#pragma unroll
                    for (int j = 0; j < 8; ++j) vv[j] = vb[(size_t)(16 * s + 8 * (j >> 2) + (j & 3)) * WIDTH_A]; }
                else { const GAS bf16* vb = (const GAS bf16*)(Z + (size_t)(row0 + kb * 32 - PAST_LEN + 4 * hi) * ZN + ZC_VA + h * 128 + eb * 32 + r32); asm volatile("" : "+v"(vb));
#pragma unroll
                    for (int j = 0; j < 8; ++j) vv[j] = bf2f(vb[(size_t)(16 * s + 8 * (j >> 2) + (j & 3)) * ZN]); }
                v4u w; w.x = pk2(vv[0], vv[1]); w.y = pk2(vv[2], vv[3]); w.z = pk2(vv[4], vv[5]); w.w = pk2(vv[6], vv[7]);
                acc[eb] = __builtin_amdgcn_mfma_f32_32x32x16_bf16(xs[s], __builtin_bit_cast(bf16x8, w), acc[eb], 0, 0, 0);
            }
    }
    __syncthreads();
#pragma unroll
    for (int eb = 0; eb < 4; ++eb)
#pragma unroll
        for (int i = 0; i < 16; ++i) slot[(wid * 32 + crow_dev(i, hi)) * 128 + eb * 32 + r32] = acc[eb][i];
    __syncthreads();
    { const int q = tid >> 4, e0 = (tid & 15) * 8; float o[8];
#pragma unroll
      for (int j = 0; j < 8; ++j) o[j] = 0.f;
#pragma unroll
      for (int w = 0; w < NWAVES; ++w)
#pragma unroll
          for (int j = 0; j < 8; ++j) o[j] += slot[(w * 32 + q) * 128 + e0 + j];
      v4u pw; pw.x = pk2(o[0], o[1]); pw.y = pk2(o[2], o[3]); pw.z = pk2(o[4], o[5]); pw.w = pk2(o[6], o[7]);
      bf16* orow = O + (size_t)(row0 + q) * attn_body::OP + h * 256;
      unsigned zq = 0u; asm volatile("" : "+v"(zq));
      *(GAS v4u*)(orow + e0) = pw; *(GAS v4u*)(orow + 128 + e0) = (v4u){zq, zq, zq, zq}; }
    __syncthreads();
}

constexpr int ATT_NQB = LPP / 256;
constexpr int ATT_NPU = BATCH * 16 * ATT_NQB;
constexpr int ATT_NSU = DEC_BATCH * N_HEADS_A;
__device__ __forceinline__ void p_attention(Frame& F, int lq, unsigned char* ldsg) {
    const int l = lq % DEPTH;
    for (;;) {
        const KArgs ap = kargs(); const auto& a = *ap; WS_OPAQUE(a);
        const int tid = otid();
        gu32* head = (gu32*)wsb + CW_QUEUE + 64 * lq;
        const attn_body::bf16* QN = (const attn_body::bf16*)(wsb + a.off[R_QN]); const attn_body::bf16* KN = (const attn_body::bf16*)(wsb + a.off[R_KN]);
        const attn_body::bf16* Z = (const attn_body::bf16*)(wsb + a.off[R_Z]); attn_body::bf16* O = (attn_body::bf16*)(wsb + a.off[R_O]);
        if (tid == 0) F.MISC[16] = __hip_atomic_fetch_add(head, 1u, RLX_AGENT);
        __syncthreads();
        const int u = (int)F.MISC[16];
        __syncthreads();
        if (u >= ATT_NPU + ATT_NSU) break;
        if (u < ATT_NPU) {
            const int qb = (ATT_NQB - 1) - u / 32, bvh = u % 32, b = bvh >> 4, vh = bvh & 15, h = vh >> 2, c = (vh >> 1) & 1, half = vh & 1;
            build_bias_table((LAS float*)(F.lds + RING_OFF + attn_body::LDS_BT), GIN(a, I_REL), h, tid);
            __syncthreads();
            attn_body::attn_unit<8>(b, h * 128 + c * 64, ZC_VA + h * 128 + half * 64, h * 256 + c * 128 + half * 64, qb, QN, KN, Z, O, (char*)ldsg + RING_OFF, F.wv);
        } else { const int su = u - ATT_NPU; attn_sample_unit(F, l, su >> 2, su & 3); }
    }
}
__device__ __forceinline__ void p_mixpost_a(Frame& F, int l) {
    const KArgs ap = kargs(); const auto& a = *ap; WS_OPAQUE(a);
    const int tid = otid(), lane = tid & 63, wave = __builtin_amdgcn_readfirstlane(tid >> 6);
    const bf16* O = (const bf16*)(wsb + a.off[R_O]); bf16* OA = (bf16*)(wsb + a.off[R_OA]);
    const int gw = F.vcu * NWAVES + wave, NGW = F.G * NWAVES;
    const float lam = lam_dev(GIN(a, I_LQK), l, lane), post = 1.f - lam_init_dev(l);
    const int h = lane >> 4, e0 = 8 * (lane & 15);
    float sg[8];
#pragma unroll
    for (int j = 0; j < 8; ++j) sg[j] = GIN(a, I_SUBLN)[l * 2 * HEAD_DIM_A + e0 + j] * post;
    v4u n0 = *(const GAS v4u*)(O + (size_t)gw * 1024 + h * 256 + e0), n1 = *(const GAS v4u*)(O + (size_t)gw * 1024 + h * 256 + 128 + e0);
    for (int m = gw; m < RP; m += NGW) {
        float o0[8], o1[8], d[8];
        unpack8(n0, o0); unpack8(n1, o1);
        { const int mn = m + NGW < RP ? m + NGW : gw; n0 = *(const GAS v4u*)(O + (size_t)mn * 1024 + h * 256 + e0); n1 = *(const GAS v4u*)(O + (size_t)mn * 1024 + h * 256 + 128 + e0); }
        float ss = 0.f;
#pragma unroll
        for (int j = 0; j < 8; ++j) { d[j] = o0[j] - lam * o1[j]; ss += d[j] * d[j]; }
        ss = sum16(ss);
        const float r = __builtin_amdgcn_rsqf(ss * (1.f / 128.f) + EPSF);
#pragma unroll
        for (int j = 0; j < 8; ++j) d[j] = d[j] * r * sg[j];
        *(GAS v4u*)(OA + (size_t)m * WIDTH_A + h * 128 + e0) = pack8(d);
    }
}
constexpr int GDN_NCH = PEND / 64;
constexpr int GDN_NPI = BATCH * N_HEADS_B * GDN_NCH;
constexpr int GDN_NSI = DEC_BATCH * N_HEADS_B;
constexpr int GDN_NI = GDN_NPI + GDN_NSI;
constexpr int GI_W = 0, GI_QG = 16384, GI_KG = 32768, GI_AT = 49152, GI_U = 57344, GI_SC = 73728, GI_STRIDE = 73984, GI_EG = 2048  ;
static_assert(GDN_NI % 4 == 0 && PEND % 64 == 0, "gdn items");
__device__ __forceinline__ int frag_off(int row, int kk, int nkb) {
    const int fid = ((row >> 5) * nkb + (kk >> 5)) * 2 + ((kk & 31) >> 4), ln = (row & 31) + 32 * (((kk & 15) >> 2) & 1), j = ((kk & 15) >> 3) * 4 + (kk & 3);
    return (fid * 64 + ln) * 8 + j;
}
__device__ __forceinline__ int gdn_item_row(int item, int j) {
    if (item < GDN_NPI) { const int sh = item / GDN_NCH, n = item % GDN_NCH; return (sh / N_HEADS_B) * LPP + 64 * n + j; }
    const int s = item - GDN_NPI; return j < 32 ? -1 : SROW0 + (s >> 2) * DEC_SEQ + (j - 32);
}
__device__ __forceinline__ int gdn_item_head(int item) { return item < GDN_NPI ? (item / GDN_NCH) % N_HEADS_B : (item - GDN_NPI) & 3; }

__device__ __forceinline__ void gdn_flush(const LAS unsigned char* stg, unsigned char* dst, int nbytes, int gt) {
    for (int o = gt * 16; o < nbytes; o += 2048) *(GAS v4u*)(dst + o) = *(const LAS v4u*)(stg + o);
}
typedef float f32x2s __attribute__((ext_vector_type(2)));
#define GDN_RL8(a, arow, jb) asm volatile("v_readlane_b32 %0, %8, %9\n\tv_readlane_b32 %1, %8, %10\n\tv_readlane_b32 %2, %8, %11\n\tv_readlane_b32 %3, %8, %12\n\tv_readlane_b32 %4, %8, %13\n\tv_readlane_b32 %5, %8, %14\n\tv_readlane_b32 %6, %8, %15\n\tv_readlane_b32 %7, %8, %16" \
    : "=s"(a[0]), "=s"(a[1]), "=s"(a[2]), "=s"(a[3]), "=s"(a[4]), "=s"(a[5]), "=s"(a[6]), "=s"(a[7]) : "v"(arow), "i"(jb), "i"((jb) + 1), "i"((jb) + 2), "i"((jb) + 3), "i"((jb) + 4), "i"((jb) + 5), "i"((jb) + 6), "i"((jb) + 7))
template <int I, int JB> __device__ __forceinline__ void gdn_subst_blk(f32x2s (&x)[64], float arow) {
    if constexpr (JB < I) { float ar[8]; GDN_RL8(ar, arow, JB);
#pragma unroll
        for (int t = 0; t < 8; ++t) if (JB + t < I) x[I] -= ar[t] * x[JB + t];
        gdn_subst_blk<I, JB + 8>(x, arow); }
}
template <int... Is> __device__ __forceinline__ void gdn_subst_all(f32x2s (&x)[64], const LAS float* A, int lane, std::integer_sequence<int, Is...>) {
    (gdn_subst_blk<Is + 1, 0>(x, A[(Is + 1) * 64 + lane]), ...);
}
template <int MODE> __device__ __forceinline__ void p_gdn_chunk(Frame& F, int l, int q) {
    const KArgs ap = kargs(); const auto& a = *ap; WS_OPAQUE(a);
    const int tid = otid(), wave = __builtin_amdgcn_readfirstlane(tid >> 6), grp = wave >> 1, gw = wave & 1;
    const bf16* QKVB = (const bf16*)(wsb + a.off[R_QKVB]); const float* BG = (const float*)(wsb + a.off[R_BG]); unsigned char* GD = wsb + a.off[R_GDN];
    LAS float* A_lds = (LAS float*)(F.lds + RING_OFF + grp * 34816);
    LAS float* Gs = A_lds + 4096; LAS float* Bs = Gs + 64; LAS float* Es = Bs + 64;
    LAS unsigned char* stg = (LAS unsigned char*)(A_lds + 4096 + 256);
    LAS bf16* stgh = (LAS bf16*)stg;
    static_assert(4 * 34816 <= RING_BYTES && GDN_NI % 4 == 0, "gdn chunk LDS / items");
    for (int pr = MODE == 0 ? F.vcu : q; MODE == 0 ? pr < (GDN_NPI - BATCH * N_HEADS_B) / 4 : pr == q; pr += (MODE == 0 ? F.G : 1 << 20)) {
        int lane_ = otid() & 63;
        const int lane = lane_, r32 = lane & 31, hi = lane >> 5, gt = gw * 64 + lane;
        int item;
        if (MODE == 0) { const int j = 4 * pr + grp; item = (j >> 7) * GDN_NCH + (j & 127); }
        else item = q < 16 ? GDN_NPI + 4 * q + grp : (4 * (q - 16) + grp) * GDN_NCH + (GDN_NCH - 1);
        const int h = gdn_item_head(item);
        unsigned char* ib = GD + (size_t)item * GI_STRIDE;
        const int rowt = gdn_item_row(item, lane);
        const float beta = rowt >= 0 ? BG[(size_t)rowt * 8 + h] : 0.f; float G = rowt >= 0 ? BG[(size_t)rowt * 8 + 4 + h] : 0.f;
        G = scan64(G);
        const float Glast = rdlane(G, 63), eG = __expf(G);
        if (gw == 0) { Gs[lane] = G; Bs[lane] = beta; Es[lane] = eG; }
        __syncthreads();
#pragma unroll
        for (int bq = 0; bq < 2; ++bq) {
          const int i0 = 32 * gw, j0 = 32 * bq; const int j = j0 + r32;
          if (gw == 0 && bq == 1) {
#pragma unroll
              for (int r = 0; r < 16; ++r) { const int i = crow_dev(r, hi); A_lds[i * 64 + j] = 0.f; stgh[frag_off(i, j, 2)] = (bf16)0; }
              LDS_WAIT(); if (lane == 0) *(LAS float*)(stg + GI_EG) = __expf(Glast);
          } else {
          const int ra = gdn_item_row(item, i0 + r32), rb = gdn_item_row(item, j0 + r32);
          f32x16 akk, aqk;
#pragma unroll
          for (int r = 0; r < 16; ++r) { akk[r] = 0.f; aqk[r] = 0.f; }
          const bf16x8 zf = {0, 0, 0, 0, 0, 0, 0, 0};
          bf16x8 qa[8], ka[8], kb[8];
          { const bf16* pa = QKVB + (size_t)(ra < 0 ? 0 : ra) * 1536 + h * 128 + 8 * hi; const bf16* pb = QKVB + (size_t)(rb < 0 ? 0 : rb) * 1536 + 512 + h * 128 + 8 * hi;
#pragma unroll
            for (int s = 0; s < 8; ++s) { qa[s] = *(const GAS bf16x8*)(pa + 16 * s); ka[s] = *(const GAS bf16x8*)(pa + 512 + 16 * s); kb[s] = *(const GAS bf16x8*)(pb + 16 * s); } }
#pragma unroll
          for (int s = 0; s < 8; ++s) { if (ra < 0) { qa[s] = zf; ka[s] = zf; } if (rb < 0) kb[s] = zf;
              akk = __builtin_amdgcn_mfma_f32_32x32x16_bf16(ka[s], kb[s], akk, 0, 0, 0); aqk = __builtin_amdgcn_mfma_f32_32x32x16_bf16(qa[s], kb[s], aqk, 0, 0, 0); }
          const float Gj = Gs[j];
#pragma unroll
          for (int r = 0; r < 16; ++r) { const int i = i0 + crow_dev(r, hi); const float dec = i >= j ? __expf(Gs[i] - Gj) : 0.f;
              A_lds[i * 64 + j] = i > j ? Bs[i] * akk[r] * dec : 0.f;
              stgh[frag_off(i, j, 2)] = (bf16)f2bf(aqk[r] * dec); }
          }
        }
        __syncthreads();
        gdn_flush(stg, ib + GI_AT, 8192, gt);
        { f32x2s x[64]; const int cbase = gw == 0 ? 1024 + h * 128 : 512 + h * 128;
#pragma unroll
          for (int i = 0; i < 64; ++i) { const int ri = __builtin_amdgcn_readfirstlane(gdn_item_row(item, i));
              const bf16* rowp = QKVB + (size_t)(ri < 0 ? 0 : ri) * 1536 + cbase;
              x[i] = ri >= 0 ? (f32x2s){bf2f(rowp[lane]), bf2f(rowp[lane + 64])} : (f32x2s){0.f, 0.f}; }
          const float rsc = gw == 0 ? beta : beta * eG;
#pragma unroll
          for (int i = 0; i < 64; ++i) x[i] *= rdlane(rsc, i);
          gdn_subst_all(x, A_lds, lane, std::make_integer_sequence<int, 63>{});
          __syncthreads();
          if (gw == 0) { GAS bf16* ub = (GAS bf16*)(ib + GI_U) + lane; asm volatile("" : "+v"(ub));
#pragma unroll
              for (int i = 0; i < 64; ++i) { ub[i * 128] = (bf16)f2bf(x[i].x); ub[i * 128 + 64] = (bf16)f2bf(x[i].y); } }
          else { LAS bf16* wb0 = stgh + frag_off(0, lane, 4); LAS bf16* wb1 = stgh + frag_off(0, lane + 64, 4);
#pragma unroll
              for (int i = 0; i < 64; ++i) { wb0[(i >> 5) * 4096 + (i & 31) * 8] = (bf16)f2bf(x[i].x); wb1[(i >> 5) * 4096 + (i & 31) * 8] = (bf16)f2bf(x[i].y); } }
        }
        __syncthreads();
        gdn_flush(stg, ib + GI_W, 16384, gt);
        __syncthreads();
        const float kgs = __expf(Glast - G);
#pragma unroll
        for (int hf = 0; hf < 2; ++hf) { float qv[32];
#pragma unroll
          for (int it = 0; it < 32; ++it) { const int c = it + 32 * hf, rc = __builtin_amdgcn_readfirstlane(gdn_item_row(item, c)); const bf16* rowp = QKVB + (size_t)(rc < 0 ? 0 : rc) * 1536 + h * 128; qv[it] = rc >= 0 ? bf2f(rowp[gt]) : 0.f; }
#pragma unroll
          for (int it = 0; it < 32; ++it) { const int c = it + 32 * hf; stgh[frag_off(c, gt, 4)] = (bf16)f2bf(qv[it] * rdlane(eG, c)); } }
        __syncthreads();
        gdn_flush(stg, ib + GI_QG, 16384, gt);
        __syncthreads();
#pragma unroll
        for (int hf = 0; hf < 2; ++hf) { float kv[32];
#pragma unroll
          for (int it = 0; it < 32; ++it) { const int c = it + 32 * hf, rc = __builtin_amdgcn_readfirstlane(gdn_item_row(item, c)); const bf16* rowp = QKVB + (size_t)(rc < 0 ? 0 : rc) * 1536 + 512 + h * 128; kv[it] = rc >= 0 ? bf2f(rowp[gt]) : 0.f; }
#pragma unroll
          for (int it = 0; it < 32; ++it) { const int c = it + 32 * hf; stgh[frag_off(gt, c, 2)] = (bf16)f2bf(kv[it] * rdlane(kgs, c)); } }
        __syncthreads();
        gdn_flush(stg, ib + GI_KG, 16384, gt);
        VM_WAIT(); __syncthreads();
        if (MODE == 1 && q >= 16) {
            if (wave == 0 && (otid() & 63) == 0) { __builtin_amdgcn_fence(__ATOMIC_RELEASE, "agent"); asm volatile("s_waitcnt vmcnt(0)" ::: "memory");
                gu32* fl = (gu32*)wsb + CW_GDNFLAG;
#pragma unroll
                for (int c = 0; c < 4; ++c) __hip_atomic_store(fl + 64 * (4 * (q - 16) + c), (unsigned)(l + 1), RLX_AGENT); } }
    }
}

__device__ __forceinline__ void gdn_chain(const unsigned char* GD, bf16* OB, const float* sdelta, float* dout, int item0, int nch, int h, int vb, int lane) {
    const int r32 = lane & 31, hi = lane >> 5;
    f32x16 S[4];
#pragma unroll
    for (int kb = 0; kb < 4; ++kb)
#pragma unroll
        for (int r = 0; r < 16; ++r) S[kb][r] = sdelta ? sdelta[(size_t)(kb * 32 + crow_dev(r, hi)) * HEAD_DIM_B + vb * 32 + r32] : 0.f;
    for (int n = 0; n < nch; ++n) {
        const int item = item0 + n; const unsigned char* ib = GD + (size_t)item * GI_STRIDE;
        const float eGl = *(const float*)(ib + GI_AT + GI_EG);
        const GAS bf16x8* WF = (const GAS bf16x8*)(ib + GI_W) + lane; const GAS bf16x8* QF = (const GAS bf16x8*)(ib + GI_QG) + lane;
        const GAS bf16x8* KF = (const GAS bf16x8*)(ib + GI_KG) + lane; const GAS bf16x8* AF = (const GAS bf16x8*)(ib + GI_AT) + lane; const bf16* U = (const bf16*)(ib + GI_U);
        bf16x8 Sp[4][2];
#pragma unroll
        for (int kb = 0; kb < 4; ++kb)
#pragma unroll
            for (int s = 0; s < 2; ++s) { v4u w; w.x = pk2(S[kb][8 * s], S[kb][8 * s + 1]); w.y = pk2(S[kb][8 * s + 2], S[kb][8 * s + 3]); w.z = pk2(S[kb][8 * s + 4], S[kb][8 * s + 5]); w.w = pk2(S[kb][8 * s + 6], S[kb][8 * s + 7]); Sp[kb][s] = __builtin_bit_cast(bf16x8, w); }
        f32x16 vn[2], ot[2];
#pragma unroll
        for (int cb = 0; cb < 2; ++cb) {
            f32x16 ws;
#pragma unroll
            for (int r = 0; r < 16; ++r) { ws[r] = 0.f; ot[cb][r] = 0.f; }
#pragma unroll
            for (int kb = 0; kb < 4; ++kb)
#pragma unroll
                for (int s = 0; s < 2; ++s) { ws = __builtin_amdgcn_mfma_f32_32x32x16_bf16(WF[((cb * 4 + kb) * 2 + s) * 64], Sp[kb][s], ws, 0, 0, 0);
                    ot[cb] = __builtin_amdgcn_mfma_f32_32x32x16_bf16(QF[((cb * 4 + kb) * 2 + s) * 64], Sp[kb][s], ot[cb], 0, 0, 0); }
#pragma unroll
            for (int r = 0; r < 16; ++r) vn[cb][r] = bf2f(U[(cb * 32 + crow_dev(r, hi)) * 128 + vb * 32 + r32]) - ws[r];
        }
        bf16x8 Vp[2][2];
#pragma unroll
        for (int cb = 0; cb < 2; ++cb)
#pragma unroll
            for (int s = 0; s < 2; ++s) { v4u w; w.x = pk2(vn[cb][8 * s], vn[cb][8 * s + 1]); w.y = pk2(vn[cb][8 * s + 2], vn[cb][8 * s + 3]); w.z = pk2(vn[cb][8 * s + 4], vn[cb][8 * s + 5]); w.w = pk2(vn[cb][8 * s + 6], vn[cb][8 * s + 7]); Vp[cb][s] = __builtin_bit_cast(bf16x8, w); }
#pragma unroll
        for (int cb = 0; cb < 2; ++cb)
#pragma unroll
            for (int c2 = 0; c2 <= cb; ++c2)
#pragma unroll
                for (int s = 0; s < 2; ++s) ot[cb] = __builtin_amdgcn_mfma_f32_32x32x16_bf16(AF[((cb * 2 + c2) * 2 + s) * 64], Vp[c2][s], ot[cb], 0, 0, 0);
#pragma unroll
        for (int cb = 0; cb < 2; ++cb)
#pragma unroll
            for (int r = 0; r < 16; ++r) { const int row = gdn_item_row(item, cb * 32 + crow_dev(r, hi)); if (row >= 0) OB[(size_t)row * WIDTH_B + h * 128 + vb * 32 + r32] = (bf16)f2bf(ot[cb][r]); }
#pragma unroll
        for (int kb = 0; kb < 4; ++kb) {
#pragma unroll
            for (int r = 0; r < 16; ++r) S[kb][r] *= eGl;
#pragma unroll
            for (int cb = 0; cb < 2; ++cb)
#pragma unroll
                for (int s = 0; s < 2; ++s) S[kb] = __builtin_amdgcn_mfma_f32_32x32x16_bf16(KF[((kb * 2 + cb) * 2 + s) * 64], Vp[cb][s], S[kb], 0, 0, 0);
        }
    }
#pragma unroll
    for (int kb = 0; kb < 4; ++kb)
#pragma unroll
        for (int r = 0; r < 16; ++r) dout[(size_t)(kb * 32 + crow_dev(r, hi)) * HEAD_DIM_B + vb * 32 + r32] = S[kb][r];
}
constexpr int GCH_BUF = 73728, GCH_PCS = 18;
#define GCH_BAR() do { asm volatile("s_waitcnt lgkmcnt(0)" ::: "memory"); __builtin_amdgcn_s_barrier(); asm volatile("" ::: "memory"); } while (0)
__device__ __forceinline__ void gdn_chain_wg(Frame& F, const unsigned char* GD, bf16* OB, float* dout, int item0, int h, gu32* flag, unsigned epoch) {
    const int tid = otid(), lane = tid & 63, wave = __builtin_amdgcn_readfirstlane(tid >> 6), r32 = lane & 31, hi = lane >> 5, vb = wave & 3;
    LAS unsigned char* lb = F.lds + RING_OFF;
    if (wave >= 4) {
        const int p0 = (wave - 4) * GCH_PCS;
        v4u R0[GCH_PCS], R1[GCH_PCS];
#define GCH_LOAD(R, c) do { if ((c) == GDN_NCH - 1) { unsigned sp_ = 0; while (__hip_atomic_load(flag, RLX_AGENT) != epoch) { __builtin_amdgcn_s_sleep(2); if (++sp_ > (1u << 22)) break; } \
            __builtin_amdgcn_fence(__ATOMIC_ACQUIRE, "agent"); asm volatile("s_waitcnt vmcnt(0)" ::: "memory"); }     \
            const unsigned char* s_ = GD + (size_t)(item0 + (c)) * GI_STRIDE + (size_t)p0 * 1024 + lane * 16; _Pragma("unroll") for (int j = 0; j < GCH_PCS; ++j) \
            asm volatile("global_load_dwordx4 %0, %1, off" : "=&v"(R[j]) : "v"(s_ + j * 1024) : "memory"); } while (0)
#define GCH_PUT(R, c) do { if ((c) + 1 < GDN_NCH) asm volatile("s_waitcnt vmcnt(18)" ::: "memory"); else asm volatile("s_waitcnt vmcnt(0)" ::: "memory"); \
            LAS v4u* d_ = (LAS v4u*)(lb + ((c) & 1) * GCH_BUF + p0 * 1024) + lane; _Pragma("unroll") for (int j = 0; j < GCH_PCS; ++j) d_[j * 64] = R[j]; } while (0)
        GCH_LOAD(R0, 0); GCH_LOAD(R1, 1);
        GCH_PUT(R0, 0); GCH_LOAD(R0, 2);
        GCH_BAR();
        for (int n = 0; n < GDN_NCH; n += 2) {
            if (n + 1 < GDN_NCH) GCH_PUT(R1, n + 1);
            if (n + 3 < GDN_NCH) GCH_LOAD(R1, n + 3);
            GCH_BAR();
            if (n + 1 < GDN_NCH) {
                if (n + 2 < GDN_NCH) GCH_PUT(R0, n + 2);
                if (n + 4 < GDN_NCH) GCH_LOAD(R0, n + 4);
                GCH_BAR(); }
        }
        asm volatile("s_waitcnt vmcnt(0)" ::: "memory");
#undef GCH_LOAD
#undef GCH_PUT
        return;
    }
    f32x16 S[4];
#pragma unroll
    for (int kb = 0; kb < 4; ++kb)
#pragma unroll
        for (int r = 0; r < 16; ++r) S[kb][r] = 0.f;
    GCH_BAR();
    for (int n = 0; n < GDN_NCH; ++n) {
        const int item = item0 + n; const LAS unsigned char* bufc = lb + (n & 1) * GCH_BUF;
        const float egl = *(const LAS float*)(bufc + GI_AT + GI_EG);
        const LAS bf16x8* WF = (const LAS bf16x8*)(bufc + GI_W) + lane; const LAS bf16x8* QF = (const LAS bf16x8*)(bufc + GI_QG) + lane;
        const LAS bf16x8* KF = (const LAS bf16x8*)(bufc + GI_KG) + lane; const LAS bf16x8* AF = (const LAS bf16x8*)(bufc + GI_AT) + lane; const LAS bf16* U = (const LAS bf16*)(bufc + GI_U);
        bf16x8 Sp[4][2];
#pragma unroll
        for (int kb = 0; kb < 4; ++kb)
#pragma unroll
            for (int s = 0; s < 2; ++s) { v4u w; w.x = pk2(S[kb][8 * s], S[kb][8 * s + 1]); w.y = pk2(S[kb][8 * s + 2], S[kb][8 * s + 3]); w.z = pk2(S[kb][8 * s + 4], S[kb][8 * s + 5]); w.w = pk2(S[kb][8 * s + 6], S[kb][8 * s + 7]); Sp[kb][s] = __builtin_bit_cast(bf16x8, w); }
        f32x16 vn[2], ot[2];
#pragma unroll
        for (int cb = 0; cb < 2; ++cb) {
            f32x16 ws;
#pragma unroll
            for (int r = 0; r < 16; ++r) { ws[r] = 0.f; ot[cb][r] = 0.f; }
#pragma unroll
            for (int kb = 0; kb < 4; ++kb)
#pragma unroll
                for (int s = 0; s < 2; ++s) { ws = __builtin_amdgcn_mfma_f32_32x32x16_bf16(WF[((cb * 4 + kb) * 2 + s) * 64], Sp[kb][s], ws, 0, 0, 0);
                    ot[cb] = __builtin_amdgcn_mfma_f32_32x32x16_bf16(QF[((cb * 4 + kb) * 2 + s) * 64], Sp[kb][s], ot[cb], 0, 0, 0); }
#pragma unroll
            for (int r = 0; r < 16; ++r) vn[cb][r] = bf2f(U[(cb * 32 + crow_dev(r, hi)) * 128 + vb * 32 + r32]) - ws[r];
        }
        bf16x8 Vp[2][2];
#pragma unroll
        for (int cb = 0; cb < 2; ++cb)
#pragma unroll
            for (int s = 0; s < 2; ++s) { v4u w; w.x = pk2(vn[cb][8 * s], vn[cb][8 * s + 1]); w.y = pk2(vn[cb][8 * s + 2], vn[cb][8 * s + 3]); w.z = pk2(vn[cb][8 * s + 4], vn[cb][8 * s + 5]); w.w = pk2(vn[cb][8 * s + 6], vn[cb][8 * s + 7]); Vp[cb][s] = __builtin_bit_cast(bf16x8, w); }
#pragma unroll
        for (int cb = 0; cb < 2; ++cb)
#pragma unroll
            for (int c2 = 0; c2 <= cb; ++c2)
#pragma unroll
                for (int s = 0; s < 2; ++s) ot[cb] = __builtin_amdgcn_mfma_f32_32x32x16_bf16(AF[((cb * 2 + c2) * 2 + s) * 64], Vp[c2][s], ot[cb], 0, 0, 0);
        { const int row0 = gdn_item_row(item, 0);
#pragma unroll
          for (int cb = 0; cb < 2; ++cb)
#pragma unroll
              for (int r = 0; r < 16; ++r) OB[(size_t)(row0 + cb * 32 + crow_dev(r, hi)) * WIDTH_B + h * 128 + vb * 32 + r32] = (bf16)f2bf(ot[cb][r]); }
#pragma unroll
        for (int kb = 0; kb < 4; ++kb) {
#pragma unroll
            for (int r = 0; r < 16; ++r) S[kb][r] *= egl;
#pragma unroll
            for (int cb = 0; cb < 2; ++cb)
#pragma unroll
                for (int s = 0; s < 2; ++s) S[kb] = __builtin_amdgcn_mfma_f32_32x32x16_bf16(KF[((kb * 2 + cb) * 2 + s) * 64], Vp[cb][s], S[kb], 0, 0, 0);
        }
        GCH_BAR();
    }
#pragma unroll
    for (int kb = 0; kb < 4; ++kb)
#pragma unroll
        for (int r = 0; r < 16; ++r) dout[(size_t)(kb * 32 + crow_dev(r, hi)) * HEAD_DIM_B + vb * 32 + r32] = S[kb][r];
}
__device__ __forceinline__ void p_gdn_chain(Frame& F, int l) {
    const KArgs ap = kargs(); const auto& a = *ap; WS_OPAQUE(a);
    const unsigned char* GD = wsb + a.off[R_GDN]; bf16* OB = (bf16*)(wsb + a.off[R_OB]);
    if (F.vcu % 32 == 0 && F.vcu / 32 < BATCH * N_HEADS_B) { const int sh = F.vcu / 32, sq = sh / N_HEADS_B, h = sh % N_HEADS_B;
        gdn_chain_wg(F, GD, OB, GOUT(a) + O_DP + (((size_t)l * BATCH + sq) * N_HEADS_B + h) * HEAD_DIM_B * HEAD_DIM_B, sh * GDN_NCH, h, (gu32*)wsb + CW_GDNFLAG + 64 * sh, (unsigned)(l + 1)); }
    else { const int q = F.vcu - F.vcu / 32 - 1;
        if (q < 18) { p_gdn_chunk<1>(F, l, q);
            if (q < 16) { const int tid = otid(), lane = tid & 63, wave = __builtin_amdgcn_readfirstlane(tid >> 6);
#pragma unroll
                for (int tt = 0; tt < 2; ++tt) { const int t = wave + 8 * tt, s = 4 * q + (t >> 2), vb = t & 3, bs = s >> 2, h = s & 3; const size_t so = (((size_t)l * DEC_BATCH + bs) * N_HEADS_B + h) * HEAD_DIM_B * HEAD_DIM_B;
                    gdn_chain(GD, OB, GIN(a, I_SDELTA) + so, GOUT(a) + O_DS + so, GDN_NPI + s, 1, h, vb, lane); } } } }
}
__device__ __forceinline__ void p_mixpost_b(Frame& F, int l) {
    const KArgs ap = kargs(); const auto& a = *ap; WS_OPAQUE(a);
    const int tid = otid(), lane = tid & 63, wave = __builtin_amdgcn_readfirstlane(tid >> 6);
    const bf16* OB = (const bf16*)(wsb + a.off[R_OB]); bf16* OBN = (bf16*)(wsb + a.off[R_OBN]); const bf16* Z = (const bf16*)(wsb + a.off[R_Z]);
    const int gw = F.vcu * NWAVES + wave, NGW = F.G * NWAVES, e0 = 8 * (lane & 15);
    float gn[8];
#pragma unroll
    for (int j = 0; j < 8; ++j) gn[j] = GIN(a, I_GDNN)[l * HEAD_DIM_B + e0 + j];
    v4u n0 = *(const GAS v4u*)(OB + (size_t)gw * WIDTH_B + 8 * lane), n1 = *(const GAS v4u*)(Z + (size_t)gw * ZN + ZC_GB + 8 * lane);
    for (int m = gw; m < RP; m += NGW) {
        float o[8], gt[8];
        unpack8(n0, o); unpack8(n1, gt);
        { const int mn = m + NGW < RP ? m + NGW : gw; n0 = *(const GAS v4u*)(OB + (size_t)mn * WIDTH_B + 8 * lane); n1 = *(const GAS v4u*)(Z + (size_t)mn * ZN + ZC_GB + 8 * lane); }
        float ss = 0.f;
#pragma unroll
        for (int j = 0; j < 8; ++j) ss += o[j] * o[j];
        ss = sum16(ss);
        const float r = __builtin_amdgcn_rsqf(ss * (1.f / 128.f) + EPSF);
#pragma unroll
        for (int j = 0; j < 8; ++j) o[j] = o[j] * r * gn[j] * gt[j] * sigm(gt[j]);
        *(GAS v4u*)(OBN + (size_t)m * WIDTH_B + 8 * lane) = pack8(o);
    }
}
constexpr int S5_M1 = 0, S5_M2 = 131072, S5_M3 = 196608, S5_L16 = 262144, S5_TSTRIDE = 262656;
constexpr int S5_NCHK = RP / 16;
constexpr int S5_NBLK = S5_NCHK / 32;
constexpr int S5_PCH = PEND / 16;
static_assert(S5_NCHK % 32 == 0 && LPP % 16 == 0 && PADF % 16 == 0 && S5_STATE == 64 && S5_GROUPS == 32, "s5 shapes");

__device__ __forceinline__ void s5_tables(Frame& F) {
    const KArgs ap = kargs(); const auto& a = *ap; WS_OPAQUE(a);
    const int tid = otid();
    LAS float* pw = (LAS float*)(F.lds + RING_OFF);
    LAS float* bb = pw + 17 * 128;
    LAS float* Kt = bb + 64 * 32;
    for (int it = F.vcu; it < DEPTH * S5_GROUPS; it += F.G) {
        const int l = it / S5_GROUPS, g = it % S5_GROUPS; const size_t gp = ((size_t)l * S5_GROUPS + g) * S5_STATE;
        unsigned char* tb = wsb + a.off[R_S5T] + (size_t)it * S5_TSTRIDE;
        const float dt = __expf(GIN(a, I_LDT)[l * S5_GROUPS + g]);
        for (int e = tid; e < 17 * 64; e += NTHR) { const int k = e >> 6, p = e & 63; const float ar = GIN(a, I_AR)[gp + p] * dt * (float)k, ai = GIN(a, I_AI)[gp + p] * dt * (float)k;
            float sn, cs; sincosf(ai, &sn, &cs); const float er = expf(ar); pw[e * 2] = er * cs; pw[e * 2 + 1] = er * sn; }
        __syncthreads();
        for (int e = tid; e < 64 * 16; e += NTHR) { const int p = e >> 4; const float ar = GIN(a, I_AR)[gp + p], ai = GIN(a, I_AI)[gp + p];
            const float nr = pw[(64 + p) * 2] - 1.f, ni = pw[(64 + p) * 2 + 1], den = ar * ar + ai * ai, fr = (nr * ar + ni * ai) / den, fi = (ni * ar - nr * ai) / den;
            const float br = GIN(a, I_BR)[gp * 16 + e], bi = GIN(a, I_BI)[gp * 16 + e]; bb[e * 2] = fr * br - fi * bi; bb[e * 2 + 1] = fr * bi + fi * br; }
        if (tid < 128) { const int p = tid & 63; ((float*)(tb + S5_L16))[tid] = pw[(16 * 64 + p) * 2 + (tid >> 6)]; }
        __syncthreads();
        const float* cre = GIN(a, I_CR) + ((size_t)l * S5_GROUPS + g) * 16 * 64; const float* cim = GIN(a, I_CI) + ((size_t)l * S5_GROUPS + g) * 16 * 64;
        { const int j = tid & 15, i = (tid >> 4) & 15;
          f32x4 c4r[16], c4i[16];
#pragma unroll
          for (int q = 0; q < 16; ++q) { c4r[q] = *(const GAS f32x4*)(cre + i * 64 + 4 * q); c4i[q] = *(const GAS f32x4*)(cim + i * 64 + 4 * q); }
#pragma clang loop unroll(disable)
          for (int d = tid >> 8; d < 16; d += 2) { float acc = 0.f;
#pragma unroll
              for (int p = 0; p < 64; ++p) { const float cr = c4r[p >> 2][p & 3], ci = c4i[p >> 2][p & 3], pr = pw[(d * 64 + p) * 2], pi = pw[(d * 64 + p) * 2 + 1];
                  const float tr = cr * pr - ci * pi, ti = cr * pi + ci * pr; acc += tr * bb[(p * 16 + j) * 2] - ti * bb[(p * 16 + j) * 2 + 1]; }
              Kt[(d * 16 + i) * 16 + j] = acc; } }
        __syncthreads();
        bf16* M1 = (bf16*)(tb + S5_M1); bf16* M2 = (bf16*)(tb + S5_M2); bf16* M3 = (bf16*)(tb + S5_M3);
        for (int e = tid; e < 65536; e += NTHR) { const int n = e >> 8, k = e & 255, tau = n >> 4, i = n & 15, sg = k >> 4, j = k & 15;
            float v = 0.f; if (sg <= tau) { v = Kt[((tau - sg) * 16 + i) * 16 + j]; if (sg == tau && i == j) v += GIN(a, I_SD)[(l * S5_GROUPS + g) * 16 + i]; }
            M1[e] = (bf16)f2bf(v); }
        for (int e = tid; e < 32768; e += NTHR) { const int n = e >> 8, k = e & 255, ri = n >> 6, p = n & 63, sg = k >> 4, j = k & 15;
            const float pr = pw[((15 - sg) * 64 + p) * 2], pi = pw[((15 - sg) * 64 + p) * 2 + 1], br = bb[(p * 16 + j) * 2], bi = bb[(p * 16 + j) * 2 + 1];
            M2[e] = (bf16)f2bf(ri == 0 ? pr * br - pi * bi : pr * bi + pi * br); }
        for (int e = tid; e < 32768; e += NTHR) { const int n = e >> 7, k = e & 127, tau = n >> 4, i = n & 15, ri = k >> 6, p = k & 63;
            const float cr = cre[i * 64 + p], ci = cim[i * 64 + p], pr = pw[((tau + 1) * 64 + p) * 2], pi = pw[((tau + 1) * 64 + p) * 2 + 1];
            M3[e] = (bf16)f2bf(ri == 0 ? cr * pr - ci * pi : -(cr * pi + ci * pr)); }
        __syncthreads();
    }
}
__device__ __forceinline__ void p_s5_e(Frame& F, int l) {
    const KArgs ap = kargs(); const auto& a = *ap; WS_OPAQUE(a);
    const int tid = otid(), lane = tid & 63, wave = __builtin_amdgcn_readfirstlane(tid >> 6), r32 = lane & 31, hi = lane >> 5;
    const bf16* Z = (const bf16*)(wsb + a.off[R_Z]); float* E = (float*)(wsb + a.off[R_S5E]);
    for (int u = F.vcu * NWAVES + wave; u < S5_NBLK * S5_GROUPS; u += F.G * NWAVES) {
        const int blk = u / S5_GROUPS, g = u % S5_GROUPS;
        const unsigned char* tb = wsb + a.off[R_S5T] + (size_t)(l * S5_GROUPS + g) * S5_TSTRIDE;
        const GAS bf16x8* M2 = (const GAS bf16x8*)(tb + S5_M2);
        const bf16* zr = Z + (size_t)((blk * 32 + r32) * 16) * ZN + ZC_UC + g * 16 + 8 * hi;
        f32x16 acc[4];
#pragma unroll
        for (int nb = 0; nb < 4; ++nb)
#pragma unroll
            for (int r = 0; r < 16; ++r) acc[nb][r] = 0.f;
#pragma unroll 4
        for (int sg = 0; sg < 16; ++sg) { const bf16x8 af = *(const GAS bf16x8*)(zr + (size_t)sg * ZN);
#pragma unroll
            for (int nb = 0; nb < 4; ++nb) acc[nb] = __builtin_amdgcn_mfma_f32_32x32x16_bf16(af, M2[((nb * 32 + r32) * 256 + sg * 16 + 8 * hi) >> 3], acc[nb], 0, 0, 0); }
#pragma unroll
        for (int nb = 0; nb < 4; ++nb)
#pragma unroll
            for (int r = 0; r < 16; ++r) E[((size_t)(blk * 32 + crow_dev(r, hi)) * S5_GROUPS + g) * 128 + nb * 32 + r32] = acc[nb][r];
    }
}
__device__ __forceinline__ void s5_scan_task(const float* E, bf16* XP, const float* l16, int g, int c0, int nch, float xr, float xi, float* ore, float* oim, int lane) {
    const float lr = l16[lane], li = l16[64 + lane];
    int c = 0;
    for (; c + 8 <= nch; c += 8) { float er[8], ei[8];
#pragma unroll
        for (int q = 0; q < 8; ++q) { const float* e = E + ((size_t)(c0 + c + q) * S5_GROUPS + g) * 128; er[q] = e[lane]; ei[q] = e[64 + lane]; }
#pragma unroll
        for (int q = 0; q < 8; ++q) { bf16* xp = XP + ((size_t)(c0 + c + q) * S5_GROUPS + g) * 128; xp[lane] = (bf16)f2bf(xr); xp[64 + lane] = (bf16)f2bf(xi);
            const float nr = lr * xr - li * xi + er[q], ni = lr * xi + li * xr + ei[q]; xr = nr; xi = ni; } }
    for (; c < nch; ++c) { const float* e = E + ((size_t)(c0 + c) * S5_GROUPS + g) * 128; bf16* xp = XP + ((size_t)(c0 + c) * S5_GROUPS + g) * 128; xp[lane] = (bf16)f2bf(xr); xp[64 + lane] = (bf16)f2bf(xi);
        const float nr = lr * xr - li * xi + e[lane], ni = lr * xi + li * xr + e[64 + lane]; xr = nr; xi = ni; }
    ore[lane] = xr; oim[lane] = xi;
}
constexpr int S5_NTASK = (BATCH + DEC_BATCH) * S5_GROUPS;
__device__ __forceinline__ void s5_scan_run(Frame& F, int l, int t, int lane) {
    const KArgs ap = kargs(); const auto& a = *ap; WS_OPAQUE(a);
    const int sq = t / S5_GROUPS, g = t % S5_GROUPS;
    const float* E = (const float*)(wsb + a.off[R_S5E]); bf16* XP = (bf16*)(wsb + a.off[R_S5X]);
    const float* l16 = (const float*)(wsb + a.off[R_S5T] + (size_t)(l * S5_GROUPS + g) * S5_TSTRIDE + S5_L16);
    if (sq < BATCH) { const size_t oo = (((size_t)l * BATCH + sq) * S5_GROUPS + g) * S5_STATE;
        s5_scan_task(E, XP, l16, g, sq * (LPP / 16), S5_PCH, 0.f, 0.f, GOUT(a) + O_SRP + oo, GOUT(a) + O_SIP + oo, lane); }
    else { const int bs = sq - BATCH; const size_t oo = (((size_t)l * DEC_BATCH + bs) * S5_GROUPS + g) * S5_STATE;
        s5_scan_task(E, XP, l16, g, SROW0 / 16 + bs * (DEC_SEQ / 16), DEC_SEQ / 16, GIN(a, I_SRE)[oo + lane], GIN(a, I_SIM)[oo + lane], GOUT(a) + O_SRS + oo, GOUT(a) + O_SIS + oo, lane); }
}
__device__ __forceinline__ float gelu_tanh(float x) { const float z = 0.7978845608028654f * (x + 0.044715f * x * x * x); const float t = 1.f - 2.f * __builtin_amdgcn_rcpf(__expf(2.f * z) + 1.f); return 0.5f * x * (1.f + t); }
__device__ __forceinline__ void p_s5_out(Frame& F, int l) {
    const KArgs ap = kargs(); const auto& a = *ap; WS_OPAQUE(a);
    const int tid = otid(), lane = tid & 63, wave = __builtin_amdgcn_readfirstlane(tid >> 6), r32 = lane & 31, hi = lane >> 5;
    const bf16* Z = (const bf16*)(wsb + a.off[R_Z]); const bf16* XP = (const bf16*)(wsb + a.off[R_S5X]); bf16* YC = (bf16*)(wsb + a.off[R_YC]);
    constexpr int NB_TOT = S5_NBLK * S5_GROUPS * 8;
    const int gwv = F.vcu * NWAVES + wave, NGW = F.G * NWAVES;
    const int b0 = (int)((long long)gwv * NB_TOT / NGW), b1 = (int)((long long)(gwv + 1) * NB_TOT / NGW);
    for (int bb = b0; bb < b1; ++bb) {
        const int u = bb >> 3, nb = bb & 7, blk = u / S5_GROUPS, g = u % S5_GROUPS;
        const unsigned char* tb = wsb + a.off[R_S5T] + (size_t)(l * S5_GROUPS + g) * S5_TSTRIDE;
        const GAS bf16x8* M1 = (const GAS bf16x8*)(tb + S5_M1); const GAS bf16x8* M3 = (const GAS bf16x8*)(tb + S5_M3);
        const bf16* zr = Z + (size_t)((blk * 32 + r32) * 16) * ZN + ZC_UC + g * 16 + 8 * hi;
        const bf16* xr = XP + ((size_t)(blk * 32 + r32) * S5_GROUPS + g) * 128 + 8 * hi;
        f32x16 acc;
#pragma unroll
        for (int r = 0; r < 16; ++r) acc[r] = 0.f;
#pragma unroll
        for (int sg = 0; sg < 16; ++sg) acc = __builtin_amdgcn_mfma_f32_32x32x16_bf16(*(const GAS bf16x8*)(zr + (size_t)sg * ZN), M1[((nb * 32 + r32) * 256 + sg * 16 + 8 * hi) >> 3], acc, 0, 0, 0);
#pragma unroll
        for (int s = 0; s < 8; ++s) acc = __builtin_amdgcn_mfma_f32_32x32x16_bf16(*(const GAS bf16x8*)(xr + 16 * s), M3[((nb * 32 + r32) * 128 + s * 16 + 8 * hi) >> 3], acc, 0, 0, 0);
#pragma unroll
        for (int r = 0; r < 16; ++r) { const int row = (blk * 32 + crow_dev(r, hi)) * 16 + 2 * nb + (r32 >> 4);
            YC[(size_t)row * WIDTH_C + g * 16 + (r32 & 15)] = (bf16)f2bf(gelu_tanh(acc[r])); }
    }
}
__device__ __forceinline__ int rdlane_i(int v, int i) { return __builtin_amdgcn_readlane(v, i); }
constexpr float NEG_BIG = -3.0e38f;
__device__ __forceinline__ unsigned fkey(float v) { const unsigned u = __builtin_bit_cast(unsigned, v); return (u & 0x80000000u) ? ~u : (u | 0x80000000u); }
__device__ __forceinline__ int mbcnt64(unsigned long long m) { return __builtin_amdgcn_mbcnt_hi((unsigned)(m >> 32), __builtin_amdgcn_mbcnt_lo((unsigned)m, 0)); }
__device__ __forceinline__ void pro_wqs(Frame& F) {
    const KArgs ap = kargs(); const auto& a = *ap; WS_OPAQUE(a);
    const int tid = otid(), lane = tid & 63, wave = __builtin_amdgcn_readfirstlane(tid >> 6);
    bf16* WQ = (bf16*)(wsb + a.off[R_WQS]);
    LAS f32x4* skl = (LAS f32x4*)(F.lds + RING_OFF);
    typedef float f32x2w __attribute__((ext_vector_type(2)));
    for (int t = F.vcu; t < DEPTH * 64; t += F.G) {
        const int l = t >> 6, hc = (t >> 2) & 15, kh = (t >> 1) & 1, nh = t & 1, k = (kh * 8 + wave) * 64 + lane;
        __syncthreads();
        { const GAS f32x4* src = (const GAS f32x4*)(GIN(a, I_PSK) + (((size_t)l * 16 + hc) * 128 + nh * 64) * 128);
#pragma unroll
          for (int q = 0; q < 4; ++q) skl[tid + NTHR * q] = src[tid + NTHR * q]; }
        const float* wr = GIN(a, I_PWQ) + ((size_t)l * D_MODEL + k) * PQ + hc * 128;
        f32x4 w[32];
#pragma unroll
        for (int d = 0; d < 32; ++d) w[d] = *(const GAS f32x4*)(wr + 4 * d);
        const float g2k = GIN(a, I_N2)[(size_t)l * D_MODEL + k];
        bf16* o = WQ + ((size_t)l * PQ + hc * 128 + nh * 64) * D_MODEL + k;
        __syncthreads();
#pragma clang loop vectorize(disable) unroll(disable)
        for (int n = 0; n < 64; ++n) { LAS f32x4* sr = skl + n * 32; f32x2w a0 = {0.f, 0.f}, a1 = {0.f, 0.f};
#pragma unroll
            for (int d = 0; d < 32; ++d) { const f32x4 s = sr[d]; a0 += (f32x2w){w[d].x, w[d].y} * (f32x2w){s.x, s.y}; a1 += (f32x2w){w[d].z, w[d].w} * (f32x2w){s.z, s.w}; }
            o[(size_t)n * D_MODEL] = (bf16)f2bf(((a0.x + a0.y) + (a1.x + a1.y)) * g2k); }
    }
    __syncthreads();
}
__device__ __forceinline__ void pro_wrest(Frame& F) {
    const KArgs ap = kargs(); const auto& a = *ap; WS_OPAQUE(a);
    const int tid = otid(), lane = tid & 63, wave = __builtin_amdgcn_readfirstlane(tid >> 6);
    LAS float* scr = (LAS float*)(F.lds + RING_OFF + wave * 16384);
    const int gw = F.vcu * NWAVES + wave, NGW = F.G * NWAVES;
    bf16* WG = (bf16*)(wsb + a.off[R_WGLU]); bf16* WB = (bf16*)(wsb + a.off[R_WBR]); bf16* WO = (bf16*)(wsb + a.off[R_WOUT]);
    constexpr int IG = (512 / 64) * (1024 / 32), IB = IG, IO = (1024 / 64) * (1024 / 32), IL = IG + 3 * IB + IO;
    TrItem A, B;
#define WR_LOAD(T, it_) do { const int l_ = (it_) / IL; int r_ = (it_) % IL; \
        if (r_ < IG) tr_load(T, GIN(a, I_WGLU) + (size_t)l_ * 512 * 1024, 1024, 32 * (r_ % 32), 64 * (r_ / 32), CmGlu(), lane); \
        else if (r_ < IG + 3 * IB) { const int w_ = (r_ - IG) / IB, q_ = (r_ - IG) % IB; tr_load(T, GIN(a, I_WBA + w_) + (size_t)l_ * 512 * 1024, 1024, 32 * (q_ % 32), 64 * (q_ / 32), CmId(), lane); } \
        else { r_ -= IG + 3 * IB; tr_load(T, GIN(a, I_WOUT) + (size_t)l_ * 1024 * 1024, 1024, 32 * (r_ % 32), 64 * (r_ / 32), CmId(), lane); } } while (0)
    if (gw < DEPTH * IL) WR_LOAD(A, gw);
    for (int it = gw; it < DEPTH * IL; it += NGW) { const int l = it / IL; int r = it % IL;
        if (it + NGW < DEPTH * IL) WR_LOAD(B, it + NGW);
        if (r < IG) tr_store(A, 512, WG + (size_t)l * 1024 * 512, 32 * (r % 32), 64 * (r / 32), scr, lane);
        else if (r < IG + 3 * IB) { const int w = (r - IG) / IB, q = (r - IG) % IB; tr_store(A, 512, WB + ((size_t)l * 3 + w) * 1024 * 512, 32 * (q % 32), 64 * (q / 32), scr, lane); }
        else { r -= IG + 3 * IB; tr_store(A, 1024, WO + (size_t)l * 1024 * 1024, 32 * (r % 32), 64 * (r / 32), scr, lane); }
        A = B; }
#undef WR_LOAD
}
typedef float f32x2v __attribute__((ext_vector_type(2)));
__device__ __forceinline__ unsigned pk_i8(const f32x4 x, float inv) {
    const int a = (int)rintf(x.x * inv), b = (int)rintf(x.y * inv), c = (int)rintf(x.z * inv), d = (int)rintf(x.w * inv);
    return (unsigned)(a & 0xff) | ((unsigned)(b & 0xff) << 8) | ((unsigned)(c & 0xff) << 16) | ((unsigned)(d & 0xff) << 24); }
constexpr size_t PEER_ROWS = (size_t)DEPTH * N_EXPERTS; constexpr int PU_ROWB = 512;
constexpr int PV_ROWB = 768;
typedef unsigned v3u __attribute__((ext_vector_type(3)));
typedef unsigned v3u_a4 __attribute__((ext_vector_type(3), aligned(4)));
typedef unsigned v6u __attribute__((ext_vector_type(6)));
typedef float f32x32 __attribute__((ext_vector_type(32)));
__device__ __forceinline__ unsigned e2m3_code(float y) { const float a = fabsf(y); float c = a < 2.f ? a * 8.f : (a < 4.f ? 8.f + (a - 2.f) * 4.f + 8.f : 24.f + (a - 4.f) * 2.f);
    const unsigned m = (unsigned)fminf(rintf(c), 31.f); return m | (y < 0.f ? 32u : 0u); }
typedef unsigned v3u __attribute__((ext_vector_type(3)));
typedef unsigned v3u_a4 __attribute__((ext_vector_type(3), aligned(4)));
__device__ __forceinline__ float absmax16(const f32x4 x0, const f32x4 x1, const f32x4 x2, const f32x4 x3) {
    float mx = fmaxf(fmaxf(fmaxf(fabsf(x0.x), fabsf(x0.y)), fmaxf(fabsf(x0.z), fabsf(x0.w))), fmaxf(fmaxf(fabsf(x1.x), fabsf(x1.y)), fmaxf(fabsf(x1.z), fabsf(x1.w))));
    return fmaxf(mx, fmaxf(fmaxf(fmaxf(fabsf(x2.x), fabsf(x2.y)), fmaxf(fabsf(x2.z), fabsf(x2.w))), fmaxf(fmaxf(fabsf(x3.x), fabsf(x3.y)), fmaxf(fabsf(x3.z), fabsf(x3.w)))));
}
__device__ __forceinline__ unsigned pk_fp8(const f32x4 x, float inv) { int t = __builtin_amdgcn_cvt_pk_fp8_f32(x.x * inv, x.y * inv, 0, false); t = __builtin_amdgcn_cvt_pk_fp8_f32(x.z * inv, x.w * inv, t, true); return (unsigned)t; }
constexpr int PW_RB = 8, PW_IR = NWAVES * PW_RB, PW_ITEMS_L = 2 * (N_EXPERTS / PW_IR), PW_ITEMS = DEPTH * PW_ITEMS_L, CW_PWQ = CW_QUEUE + 64 * 24;
__device__ __forceinline__ void peerw_item(Frame& F, int it) {
    const KArgs ap = kargs(); const auto& a = *ap; WS_OPAQUE(a);
    const int tid = otid(), lane = tid & 63, wave = __builtin_amdgcn_readfirstlane(tid >> 6);
    float* SCL = (float*)(wsb + a.off[R_MISC]);
    constexpr int RB = PW_RB;
    const int l = it / PW_ITEMS_L, r_ = it % PW_ITEMS_L, w = r_ / (N_EXPERTS / PW_IR), blk = r_ % (N_EXPERTS / PW_IR);
    const size_t row0 = (size_t)l * N_EXPERTS + blk * PW_IR + wave * RB, rw0 = row0 + (w ? PEER_ROWS : 0);
    f32x4 x[RB][4];
#pragma unroll
    for (int r = 0; r < RB; ++r) { const GAS f32x4* src = (const GAS f32x4*)(GIN(a, I_PU + w) + (row0 + r) * D_MODEL) + 4 * lane;
#pragma unroll
        for (int j = 0; j < 4; ++j) x[r][j] = src[j]; }
#pragma unroll
    for (int r = 0; r < RB; ++r) { const float mx = wave_max(absmax16(x[r][0], x[r][1], x[r][2], x[r][3])); v4u o;
        if (w == 0) { float s2_ = 0.f;
#pragma unroll
            for (int j = 0; j < 4; ++j) s2_ += (x[r][j].x * x[r][j].x + x[r][j].y * x[r][j].y) + (x[r][j].z * x[r][j].z + x[r][j].w * x[r][j].w);
            const float clip = fminf(mx, 2.6f * __builtin_sqrtf(wave_sum(s2_) * (1.f / D_MODEL)));
            const float inv = clip > 0.f ? 7.f / clip : 0.f;
            v2u o2;
#pragma unroll
            for (int d = 0; d < 2; ++d) { const f32x4 xa = x[r][2 * d], xb = x[r][2 * d + 1];
#define PW_Q4(v_) ((unsigned)((int)fminf(fmaxf(rintf((v_) * inv), -7.f), 7.f) + 8))
                const unsigned w_ = PW_Q4(xa.x) | (PW_Q4(xa.y) << 4) | (PW_Q4(xa.z) << 8) | (PW_Q4(xa.w) << 12) | (PW_Q4(xb.x) << 16) | (PW_Q4(xb.y) << 20) | (PW_Q4(xb.z) << 24) | (PW_Q4(xb.w) << 28);
#undef PW_Q4
                if (d == 0) o2.x = w_; else o2.y = w_; }
            if (lane == 0) SCL[rw0 + r] = clip * (1.f / 7.f);
            *((GAS v2u*)(wsb + a.off[R_PU] + (row0 + r) * PU_ROWB) + lane) = o2; }
        else { const float inv = mx > 0.f ? 7.5f / mx : 0.f;
            unsigned q_[16];
#pragma unroll
            for (int j = 0; j < 4; ++j) { q_[4 * j] = e2m3_code(x[r][j].x * inv); q_[4 * j + 1] = e2m3_code(x[r][j].y * inv); q_[4 * j + 2] = e2m3_code(x[r][j].z * inv); q_[4 * j + 3] = e2m3_code(x[r][j].w * inv); }
            v3u o3; o3.x = q_[0] | (q_[1] << 6) | (q_[2] << 12) | (q_[3] << 18) | (q_[4] << 24) | ((q_[5] & 3u) << 30);
            o3.y = (q_[5] >> 2) | (q_[6] << 4) | (q_[7] << 10) | (q_[8] << 16) | (q_[9] << 22) | ((q_[10] & 15u) << 28);
            o3.z = (q_[10] >> 4) | (q_[11] << 2) | (q_[12] << 8) | (q_[13] << 14) | (q_[14] << 20) | (q_[15] << 26);
            if (lane == 0) SCL[rw0 + r] = mx * (1.f / 7.5f);
            *(GAS v3u_a4*)(wsb + a.off[R_PV] + (row0 + r) * PV_ROWB + 12 * lane) = o3; } }
}
__device__ __forceinline__ void peerw_drain(Frame& F, int limit) {
    const KArgs ap = kargs(); const auto& a = *ap; WS_OPAQUE(a);
    const bool lead = F.wv == 0 && lane_id() == 0;
    for (;;) {
        if (lead) { const unsigned kept = F.MISC[23]; F.MISC[23] = 0u; F.MISC[24] = kept ? 1u : 0u;
            F.MISC[21] = kept ? kept - 1u : (F.MISC[22] ? (unsigned)PW_ITEMS : __hip_atomic_fetch_add((gu32*)wsb + CW_PWQ, 1u, RLX_AGENT)); }
        __syncthreads();
        const int it = (int)F.MISC[21]; const bool kept = F.MISC[24] != 0u;
        __syncthreads();
        if (it >= PW_ITEMS) { if (lead) F.MISC[22] = 1u; break; }
        peerw_item(F, it);
        if (!kept && it >= limit) break;
    }
}
__device__ __forceinline__ void xcd_barrier_steal(const XcdBarrier& b, Frame& F) {
    const KArgs ap = kargs(); const auto& a = *ap; WS_OPAQUE(a);
    asm volatile("s_waitcnt vmcnt(0)" ::: "memory");
    __syncthreads();
    const bool lead = b.wv == 0 && lane_id() == 0;
    unsigned gen = 0u;
    if (lead) {
        unsigned* bar = b.bar;
        __builtin_amdgcn_s_waitcnt(0);
        unsigned nloc = b.st[0], nx = b.st[1];
        if (nloc == 0u) { xcd_barrier_complete(bar, b.x, nloc, nx); b.st[0] = nloc; b.st[1] = nx; }
        const unsigned old = xb_add(&bar[XB_XSUB(b.x)], 1u);
        gen = old / nloc;
        if (old + 1u == (gen + 1u) * nloc) {
            __builtin_amdgcn_fence(__ATOMIC_RELEASE, "agent");
            asm volatile("s_waitcnt vmcnt(0)" ::: "memory");
            const unsigned og = xb_add(&bar[XB_TOP], 1u);
            const unsigned tg = og / nx;
            if (og + 1u == (tg + 1u) * nx) xb_add(&bar[XB_TOPGEN], 1u);
            else XB_SPIN(xb_ld(&bar[XB_TOPGEN]) == tg, bar);
            __builtin_amdgcn_fence(__ATOMIC_ACQUIRE, "agent");
            xb_add(&bar[XB_XGEN(b.x)], 1u);
            asm volatile("s_waitcnt vmcnt(0)" ::: "memory");
            F.MISC[20] = 1u;
        } else F.MISC[20] = 0u;
    }
    unsigned sp = 0u;
    for (;;) {
        if (lead && F.MISC[20] == 0u) {
            unsigned* bar = b.bar;
            bool rel = xb_ld(&bar[XB_XGEN(b.x)]) != gen;
            if (!rel && F.MISC[22] && !F.MISC[23]) {
                XB_SPIN(xb_ld(&bar[XB_XGEN(b.x)]) == gen, bar); rel = true; }
            if (!rel && (++sp & 1023u) == 0u && xb_ld(&bar[XB_TMO])) rel = true;
            if (rel) { __builtin_amdgcn_fence(__ATOMIC_ACQUIRE, "agent"); asm volatile("s_waitcnt vmcnt(0)" ::: "memory"); F.MISC[20] = 1u; }
            else { const unsigned kept = F.MISC[23]; F.MISC[23] = 0u;
                const unsigned it = kept ? kept - 1u : __hip_atomic_fetch_add((gu32*)wsb + CW_PWQ, 1u, RLX_AGENT); F.MISC[21] = it; if (it >= (unsigned)PW_ITEMS) F.MISC[22] = 1u; }
        }
        __syncthreads();
        const unsigned done = F.MISC[20], it = F.MISC[21];
        __syncthreads();
        if (done) break;
        if (it < (unsigned)PW_ITEMS) {
            const bool ahead = lead && !F.MISC[22]; unsigned nxi = 0u;
            if (ahead) nxi = __hip_atomic_fetch_add((gu32*)wsb + CW_PWQ, 1u, RLX_AGENT);
            peerw_item(F, (int)it);
            if (ahead) { if (nxi < (unsigned)PW_ITEMS) F.MISC[23] = nxi + 1u; else F.MISC[22] = 1u; }
        }
    }
}
__device__ __forceinline__ void pro_peerw(Frame& F) { for (int it = F.vcu; it < PW_ITEMS; it += F.G) peerw_item(F, it); }
__device__ __forceinline__ void fp8x16_to_f32(const v4u q, float (&f)[16]) {
#pragma unroll
    for (int d = 0; d < 4; ++d) { const int w = (int)(d == 0 ? q.x : d == 1 ? q.y : d == 2 ? q.z : q.w);
        const f32x2v lo = __builtin_amdgcn_cvt_pk_f32_fp8(w, false), hi = __builtin_amdgcn_cvt_pk_f32_fp8(w, true); f[4 * d] = lo.x; f[4 * d + 1] = lo.y; f[4 * d + 2] = hi.x; f[4 * d + 3] = hi.y; }
}
#define PK_BIS(NDPP) do { if (!kdone) { const unsigned t_ = kp | (1u << kbit); int c_ = 0; _Pragma("unroll") for (int c4 = 0; c4 < 8; ++c4) { const v4u k4 = keys[c4 * 64 + lane]; \
            c_ += (k4.x >= t_ ? 1 : 0) + (k4.y >= t_ ? 1 : 0); c_ += (k4.z >= t_ ? 1 : 0) + (k4.w >= t_ ? 1 : 0); } \
        c_ += dpp_i<0xB1>(c_); c_ += dpp_i<0x4E>(c_); if (NDPP == 3) c_ += dpp_i<0x141>(c_); const bool up_ = c_ >= 16; kp = up_ ? t_ : kp; kcp = up_ ? c_ : kcp; --kbit; \
        kdone = (__ballot(kcp != 16) == 0ull) || kbit < 0; } } while (0)
__device__ __forceinline__ void p_peer(Frame& F, int l, bool dry) {
    const KArgs ap = kargs(); const auto& a = *ap; WS_OPAQUE(a);
    const int tid = otid(), lane = tid & 63, wave = __builtin_amdgcn_readfirstlane(tid >> 6);
    const float* SC = (const float*)(wsb + a.off[R_SC]); float* X = (float*)(wsb + a.off[R_X]);
    const unsigned char* PU = wsb + a.off[R_PU] + (size_t)l * N_EXPERTS * PU_ROWB; const unsigned char* PV = wsb + a.off[R_PV] + (size_t)l * N_EXPERTS * PV_ROWB;
    const float* SCU = (const float*)(wsb + a.off[R_MISC]) + (size_t)l * N_EXPERTS; const float* SCV = SCU + PEER_ROWS;
    LAS float* stop = (LAS float*)(F.lds + RING_OFF + wave * 4096);
    LAS int* itop = (LAS int*)(stop + 256);
    LAS int* elb = itop + 256;
    LAS float* cfb = (LAS float*)(elb + 256);
    gu32* rq = (gu32*)wsb + CW_QUEUE + 64 * (8 + l + (dry ? DEPTH : 0));
    LAS v4u* keys = (LAS v4u*)(F.lds + RING_OFF + 32768 + wave * 8192);
    unsigned kp = 0u, kL1 = 0u; int kbit = 31, kcp = 1 << 20; bool kdone = false; float rsn = 0.f, hscn = 0.f; v4u hqn = {0u, 0u, 0u, 0u};
#define PK_WINDOW(NDPP, LVAR) do {   \
        unsigned mx_ = kk_[0]; _Pragma("unroll") for (int j = 1; j < 32; ++j) mx_ = mx_ > kk_[j] ? mx_ : kk_[j]; \
        { unsigned o_ = (unsigned)dpp_i<0xB1>((int)mx_); mx_ = mx_ > o_ ? mx_ : o_; o_ = (unsigned)dpp_i<0x4E>((int)mx_); mx_ = mx_ > o_ ? mx_ : o_; if (NDPP == 3) { o_ = (unsigned)dpp_i<0x141>((int)mx_); mx_ = mx_ > o_ ? mx_ : o_; } } \
        unsigned L_ = mx_ > (3u << 23) ? mx_ - (3u << 23) : 0u; int c_ = 0; _Pragma("unroll") for (int j = 0; j < 32; ++j) c_ += kk_[j] >= L_ ? 1 : 0; \
        c_ += dpp_i<0xB1>(c_); c_ += dpp_i<0x4E>(c_); if (NDPP == 3) c_ += dpp_i<0x141>(c_); \
        const bool ok_ = __ballot(c_ < 16 || L_ == 0u) == 0ull; L_ = ok_ ? L_ - 1u : 0u; kbit = ok_ ? 24 : 31; LVAR = L_;     \
        _Pragma("unroll") for (int j = 0; j < 8; ++j) { v4u w_; w_.x = (kk_[4 * j] > L_ ? kk_[4 * j] : L_) - L_; w_.y = (kk_[4 * j + 1] > L_ ? kk_[4 * j + 1] : L_) - L_; w_.z = (kk_[4 * j + 2] > L_ ? kk_[4 * j + 2] : L_) - L_; w_.w = (kk_[4 * j + 3] > L_ ? kk_[4 * j + 3] : L_) - L_; keys[j * 64 + lane] = w_; } \
        kp = 0u; kcp = 1 << 20; kdone = false; } while (0)
#define PK_BEGIN(m_) do {   \
        float hx_[16]; { const GAS f32x4* xr0 = (const GAS f32x4*)(X + (size_t)(m_) * D_MODEL + 16 * lane); const GAS f32x4* g4 = (const GAS f32x4*)(GIN(a, I_N2) + (size_t)l * D_MODEL + 16 * lane); float s2 = 0.f; \
          _Pragma("unroll") for (int j = 0; j < 4; ++j) { const f32x4 xv = xr0[j], gv = g4[j]; s2 += (xv.x * xv.x + xv.y * xv.y) + (xv.z * xv.z + xv.w * xv.w); hx_[4 * j] = xv.x * gv.x; hx_[4 * j + 1] = xv.y * gv.y; hx_[4 * j + 2] = xv.z * gv.z; hx_[4 * j + 3] = xv.w * gv.w; } \
          rsn = __builtin_amdgcn_rsqf(wave_sum(s2) * (1.f / D_MODEL) + EPSF); } \
        float hmx = 0.f; _Pragma("unroll") for (int j = 0; j < 16; ++j) { hx_[j] *= rsn; hmx = fmaxf(hmx, fabsf(hx_[j])); } \
        hmx = wave_max(hmx); const float hinv = hmx > 0.f ? 127.f / hmx : 0.f; hscn = hmx * (1.f / 127.f); \
        hqn.x = pk_i8((f32x4){hx_[0], hx_[2], hx_[4], hx_[6]}, hinv); hqn.y = pk_i8((f32x4){hx_[1], hx_[3], hx_[5], hx_[7]}, hinv); hqn.z = pk_i8((f32x4){hx_[8], hx_[10], hx_[12], hx_[14]}, hinv); hqn.w = pk_i8((f32x4){hx_[9], hx_[11], hx_[13], hx_[15]}, hinv);     \
        { const GAS f32x4* p4 = (const GAS f32x4*)(SC + (size_t)(m_) * PQ + (lane >> 2) * 128 + (lane & 3) * 32); \
          unsigned kk_[32]; _Pragma("unroll") for (int j = 0; j < 8; ++j) { const f32x4 v = p4[j]; kk_[4 * j] = fkey(v.x); kk_[4 * j + 1] = fkey(v.y); kk_[4 * j + 2] = fkey(v.z); kk_[4 * j + 3] = fkey(v.w); } \
          PK_WINDOW(2, kL1); } } while (0)
#define PK_MID() do {   \
        { int cl = 0; _Pragma("unroll") for (int c4 = 0; c4 < 8; ++c4) { const v4u k4 = keys[c4 * 64 + lane]; cl += (k4.x >= kp ? 1 : 0) + (k4.y >= kp ? 1 : 0) + (k4.z >= kp ? 1 : 0) + (k4.w >= kp ? 1 : 0); } \
          const int q_ = lane & 3, c0 = dpp_i<0x00>(cl), c1 = dpp_i<0x55>(cl), c2 = dpp_i<0xAA>(cl); int pos = (q_ > 0 ? c0 : 0) + (q_ > 1 ? c1 : 0) + (q_ > 2 ? c2 : 0); const int sb = (lane >> 2) * 16; \
          _Pragma("unroll") for (int c4 = 0; c4 < 8; ++c4) { const v4u k4 = keys[c4 * 64 + lane]; _Pragma("unroll") for (int e = 0; e < 4; ++e) { const unsigned kj = k4[e]; const bool sel = kj >= kp; \
              if (sel && pos < 16) { const unsigned kf_ = kj + kL1; const unsigned u_ = (kf_ & 0x80000000u) ? (kf_ ^ 0x80000000u) : ~kf_; stop[sb + pos] = __builtin_bit_cast(float, u_); itop[sb + pos] = q_ * 32 + 4 * c4 + e; } \
              pos += sel ? 1 : 0; } } } \
        LDS_WAIT(); \
        { const int h_ = lane >> 3, sub = lane & 7; const float s1a = stop[(2 * h_) * 16 + 2 * sub], s1b = stop[(2 * h_) * 16 + 2 * sub + 1]; \
          unsigned kk_[32]; _Pragma("unroll") for (int c4 = 0; c4 < 4; ++c4) { const f32x4 s2_ = *(LAS f32x4*)(stop + (2 * h_ + 1) * 16 + 4 * c4); \
              kk_[4 * c4] = fkey(s1a + s2_.x); kk_[4 * c4 + 1] = fkey(s1a + s2_.y); kk_[4 * c4 + 2] = fkey(s1a + s2_.z); kk_[4 * c4 + 3] = fkey(s1a + s2_.w); \
              kk_[16 + 4 * c4] = fkey(s1b + s2_.x); kk_[17 + 4 * c4] = fkey(s1b + s2_.y); kk_[18 + 4 * c4] = fkey(s1b + s2_.z); kk_[19 + 4 * c4] = fkey(s1b + s2_.w); } \
          unsigned kL2_; PK_WINDOW(3, kL2_); (void)kL2_; } } while (0)
#define PK_END(nb_) do {   \
        LAS int* el_ = elb + 128 * (nb_); LAS float* cf_ = cfb + 128 * (nb_); const int h_ = lane >> 3, sub = lane & 7; \
        int cl = 0; _Pragma("unroll") for (int c4 = 0; c4 < 8; ++c4) { const v4u k4 = keys[c4 * 64 + lane]; cl += (k4.x >= kp ? 1 : 0) + (k4.y >= kp ? 1 : 0) + (k4.z >= kp ? 1 : 0) + (k4.w >= kp ? 1 : 0); } \
        int x_ = cl; { int t_ = dpp_i<0x111>(x_); x_ += sub >= 1 ? t_ : 0; t_ = dpp_i<0x112>(x_); x_ += sub >= 2 ? t_ : 0; t_ = dpp_i<0x114>(x_); x_ += sub >= 4 ? t_ : 0; } \
        int pos = x_ - cl; \
        const float s1a = stop[(2 * h_) * 16 + 2 * sub], s1b = stop[(2 * h_) * 16 + 2 * sub + 1]; float s2_[16]; float cmax = NEG_BIG; \
        _Pragma("unroll") for (int j = 0; j < 16; ++j) { s2_[j] = stop[(2 * h_ + 1) * 16 + j]; cmax = fmaxf(cmax, s2_[j]); } \
        cmax += fmaxf(s1a, s1b); cmax = fmaxf(cmax, dpp_f<0xB1>(cmax)); cmax = fmaxf(cmax, dpp_f<0x4E>(cmax)); cmax = fmaxf(cmax, dpp_f<0x141>(cmax)); \
        const int i1a = itop[(2 * h_) * 16 + 2 * sub] * N_KEYS, i1b = itop[(2 * h_) * 16 + 2 * sub + 1] * N_KEYS; float esum = 0.f; \
        _Pragma("unroll") for (int c4 = 0; c4 < 8; ++c4) { const v4u k4 = keys[c4 * 64 + lane]; _Pragma("unroll") for (int e = 0; e < 4; ++e) { const int j = 4 * c4 + e; const bool sel = k4[e] >= kp; \
            if (sel && pos < 16) { const float ex = __expf(rsn * ((j < 16 ? s1a : s1b) + s2_[j & 15] - cmax)); esum += ex; \
                el_[h_ * 16 + pos] = (j < 16 ? i1a : i1b) + itop[(2 * h_ + 1) * 16 + (j & 15)]; cf_[h_ * 16 + pos] = ex; } \
            pos += sel ? 1 : 0; } } \
        esum = sum8(esum); const float inv_ = __builtin_amdgcn_rcpf(esum); \
        LDS_WAIT(); cf_[2 * lane] *= inv_; cf_[2 * lane + 1] *= inv_; LDS_WAIT(); } while (0)
    int cur = __builtin_amdgcn_readfirstlane(lane == 0 ? (int)__hip_atomic_fetch_add(rq, 1u, RLX_AGENT) : 0);
    if (cur >= NT) return;
    int nxt = __builtin_amdgcn_readfirstlane(lane == 0 ? (int)__hip_atomic_fetch_add(rq, 1u, RLX_AGENT) : 0);
    int buf = 0;
    PK_BEGIN(nat2prow(cur));
#pragma clang loop unroll(disable)
    for (int s = 0; s < 32; ++s) PK_BIS(2);
    PK_MID();
#pragma clang loop unroll(disable)
    for (int s = 0; s < 32; ++s) PK_BIS(3);
    PK_END(0);
    const bool lb0 = (lane & 1) != 0, lb1 = (lane & 2) != 0;
    for (;;) {
        const int m = nat2prow(cur); const bool has_next = nxt < NT;
        const v4u hq = hqn; const float hsc = hscn;
        LAS int* elist = elb + 128 * buf; LAS float* cf = cfb + 128 * buf;
        float out[16];
#pragma unroll
        for (int j = 0; j < 16; ++j) out[j] = 0.f;
        const int hs8 = -8 * __builtin_amdgcn_sdot4((int)hq.w, 0x01010101, __builtin_amdgcn_sdot4((int)hq.z, 0x01010101, __builtin_amdgcn_sdot4((int)hq.y, 0x01010101, __builtin_amdgcn_sdot4((int)hq.x, 0x01010101, 0, false), false), false), false);
        v2u uA[4], uB[4]; v3u vA[4], vB[4]; float suA, svA, cA, suB, svB, cB;
#define PEER_LOAD(U, V, SU, SV, CW, q0) do { { const int em_ = elist[(q0) + (lane & 3)]; CW = cf[(q0) + (lane & 3)]; SU = SCU[em_]; SV = SCV[em_]; } _Pragma("unroll") for (int i = 0; i < 4; ++i) { const int e_ = elist[(q0) + i]; \
            U[i] = *((const GAS v2u*)(PU + (size_t)e_ * PU_ROWB) + lane); V[i] = *(const GAS v3u_a4*)(PV + (size_t)e_ * PV_ROWB + 12 * lane); } } while (0)
#define PEER_COMP(U, V, SU, SV, CW) do { float d_[4]; _Pragma("unroll") for (int i = 0; i < 4; ++i) { \
            int di_ = __builtin_amdgcn_sdot4((int)(U[i].x & 0x0f0f0f0fu), (int)hq.x, hs8, false); di_ = __builtin_amdgcn_sdot4((int)((U[i].x >> 4) & 0x0f0f0f0fu), (int)hq.y, di_, false); \
            di_ = __builtin_amdgcn_sdot4((int)(U[i].y & 0x0f0f0f0fu), (int)hq.z, di_, false); di_ = __builtin_amdgcn_sdot4((int)((U[i].y >> 4) & 0x0f0f0f0fu), (int)hq.w, di_, false); d_[i] = (float)di_; } \
              \
            const float r0_ = (lb0 ? d_[1] : d_[0]) + dpp_f<0xB1>(lb0 ? d_[0] : d_[1]), r1_ = (lb0 ? d_[3] : d_[2]) + dpp_f<0xB1>(lb0 ? d_[2] : d_[3]); \
            float dsel_ = (lb1 ? r1_ : r0_) + dpp_f<0x4E>(lb1 ? r0_ : r1_); \
            dsel_ += dpp_f<0x124>(dsel_); dsel_ += dpp_f<0x128>(dsel_);                                        \
            dsel_ += swap16(dsel_); dsel_ += swap32(dsel_);                                                       \
            const float ccv_ = CW * gelu_tanh(dsel_ * hsc * SU) * SV; \
            _Pragma("unroll") for (int i = 0; i < 4; i += 2) { const float cc0 = rdlane(ccv_, 60 + i), cc1 = rdlane(ccv_, 61 + i);     \
                const f32x32 t = __builtin_amdgcn_cvt_scalef32_pk32_f32_fp6((v6u){V[i].x, V[i].y, V[i].z, V[i + 1].x, V[i + 1].y, V[i + 1].z}, 1.0f); \
                _Pragma("unroll") for (int j = 0; j < 16; ++j) out[j] += cc0 * t[j]; _Pragma("unroll") for (int j = 0; j < 16; ++j) out[j] += cc1 * t[16 + j]; } } while (0)
        PEER_LOAD(uA, vA, suA, svA, cA, 0);
        PK_BEGIN(has_next ? nat2prow(nxt) : m);
#pragma clang loop unroll(disable)
        for (int q = 0; q < 64; q += 8) {
            PEER_LOAD(uB, vB, suB, svB, cB, q + 4);
            PK_BIS(2); PK_BIS(2);
            PEER_COMP(uA, vA, suA, svA, cA);
            PEER_LOAD(uA, vA, suA, svA, cA, q + 8);
            PK_BIS(2); PK_BIS(2);
            PEER_COMP(uB, vB, suB, svB, cB);
        }
        PK_MID();
#pragma clang loop unroll(disable)
        for (int q = 64; q < 128; q += 8) {
            PEER_LOAD(uB, vB, suB, svB, cB, q + 4);
            PK_BIS(3); PK_BIS(3);
            PEER_COMP(uA, vA, suA, svA, cA);
            if (q + 8 < 128) PEER_LOAD(uA, vA, suA, svA, cA, q + 8);
            PK_BIS(3); PK_BIS(3);
            PEER_COMP(uB, vB, suB, svB, cB);
        }
        PK_END(buf ^ 1);
#undef PEER_LOAD
#undef PEER_COMP
        if (!dry) { GAS f32x4* xr = (GAS f32x4*)(X + (size_t)m * D_MODEL + 16 * lane);
          f32x4 xv[4]; float s2 = 0.f;
#pragma unroll
          for (int j = 0; j < 4; ++j) { xv[j] = xr[j] + (f32x4){out[4 * j], out[4 * j + 1], out[4 * j + 2], out[4 * j + 3]}; s2 += (xv[j].x * xv[j].x + xv[j].y * xv[j].y) + (xv[j].z * xv[j].z + xv[j].w * xv[j].w); }
          const float rn = __builtin_amdgcn_rsqf(wave_sum(s2) * (1.f / D_MODEL) + EPSF);
          if (l + 1 < DEPTH) {
#pragma unroll
              for (int j = 0; j < 4; ++j) xr[j] = xv[j];
              const GAS f32x4* gr = (const GAS f32x4*)(GIN(a, I_N1) + (size_t)(l + 1) * D_MODEL + 16 * lane); float o16[16];
#pragma unroll
              for (int j = 0; j < 4; ++j) { const f32x4 gg = gr[j]; o16[4 * j] = xv[j].x * rn * gg.x; o16[4 * j + 1] = xv[j].y * rn * gg.y; o16[4 * j + 2] = xv[j].z * rn * gg.z; o16[4 * j + 3] = xv[j].w * rn * gg.w; }
              v4u w0, w1; w0.x = pk2(o16[0], o16[1]); w0.y = pk2(o16[2], o16[3]); w0.z = pk2(o16[4], o16[5]); w0.w = pk2(o16[6], o16[7]); w1.x = pk2(o16[8], o16[9]); w1.y = pk2(o16[10], o16[11]); w1.z = pk2(o16[12], o16[13]); w1.w = pk2(o16[14], o16[15]);
              GAS v4u* xo = (GAS v4u*)((bf16*)(wsb + a.off[R_XN]) + (size_t)m * D_MODEL + 16 * lane); xo[0] = w0; xo[1] = w1;
          } else {
              float* dst = nullptr;
              if (m >= SROW0) dst = GOUT(a) + O_YS + (size_t)(m - SROW0) * D_MODEL; else { const int b_ = m / LPP, p_ = m % LPP; if (p_ >= PADF + N_META) dst = GOUT(a) + O_YP + ((size_t)b_ * SEQ + (p_ - PADF - N_META)) * D_MODEL; }
              if (dst) { const GAS f32x4* gr = (const GAS f32x4*)(GIN(a, I_FN) + 16 * lane); GAS f32x4* o = (GAS f32x4*)(dst + 16 * lane);
#pragma unroll
                  for (int j = 0; j < 4; ++j) { const f32x4 gg = gr[j]; o[j] = (f32x4){xv[j].x * rn * gg.x, xv[j].y * rn * gg.y, xv[j].z * rn * gg.z, xv[j].w * rn * gg.w}; } }
          } }
        if (!has_next) break;
        cur = nxt; buf ^= 1;
        nxt = __builtin_amdgcn_readfirstlane(lane == 0 ? (int)__hip_atomic_fetch_add(rq, 1u, RLX_AGENT) : 0);
    }
#undef PK_BEGIN
#undef PK_WINDOW
#undef PK_MID
#undef PK_END
}
#undef PK_BIS
__device__ __forceinline__ void p_final(Frame& F) {
    const KArgs ap = kargs(); const auto& a = *ap; WS_OPAQUE(a);
    const int tid = otid(), lane = tid & 63, wave = __builtin_amdgcn_readfirstlane(tid >> 6);
    const float* X = (const float*)(wsb + a.off[R_X]); const float* g = GIN(a, I_FN);
    for (int m = F.vcu * NWAVES + wave; m < RP; m += F.G * NWAVES) {
        float* dst;
        if (m >= SROW0) dst = GOUT(a) + O_YS + (size_t)(m - SROW0) * D_MODEL;
        else { const int b = m / LPP, p = m % LPP; if (p < PADF + N_META || p >= PEND) continue; dst = GOUT(a) + O_YP + ((size_t)b * SEQ + (p - PADF - N_META)) * D_MODEL; }
        const GAS f32x4* xr = (const GAS f32x4*)(X + (size_t)m * D_MODEL) + lane;
        f32x4 v[4]; float s2 = 0.f;
#pragma unroll
        for (int j = 0; j < 4; ++j) { v[j] = xr[64 * j]; s2 += (v[j].x * v[j].x + v[j].y * v[j].y) + (v[j].z * v[j].z + v[j].w * v[j].w); }
        const float r = __builtin_amdgcn_rsqf(wave_sum(s2) * (1.f / D_MODEL) + EPSF);
        const GAS f32x4* gr = (const GAS f32x4*)g + lane; GAS f32x4* o = (GAS f32x4*)dst + lane;
#pragma unroll
        for (int j = 0; j < 4; ++j) { const f32x4 gg = gr[64 * j]; o[64 * j] = (f32x4){v[j].x * r * gg.x, v[j].y * r * gg.y, v[j].z * r * gg.z, v[j].w * r * gg.w}; }
    }
}

__device__ __forceinline__ void p_prologue(Frame& F, int pmsel = -1) {
    if (pmsel & PM_NORM0) p_norm0(F);
    const KArgs ap = kargs(); const auto& a = *ap; WS_OPAQUE(a);
    const int tid = otid(), lane = tid & 63, wave = __builtin_amdgcn_readfirstlane(tid >> 6);
    LAS float* scr = (LAS float*)(F.lds + RING_OFF + wave * 16384);
    const int gw = F.vcu * NWAVES + wave, NGW = F.G * NWAVES;
    if (a.pro_mask & pmsel & PM_X) {
        float* X = (float*)(wsb + a.off[R_X]);
        for (int m = gw; m < RP; m += NGW) {
            const float* src = nullptr;
            if (m >= SROW0) src = GIN(a, I_XS) + (size_t)(m - SROW0) * D_MODEL;
            else { const int b = m / LPP, p = m % LPP; if (p >= PADF && p < PEND) { const int pos = p - PADF; src = pos < N_META ? GIN(a, I_META) + (size_t)pos * D_MODEL : GIN(a, I_XP) + ((size_t)b * SEQ + pos - N_META) * D_MODEL; } }
            GAS f32x4* o = (GAS f32x4*)(X + (size_t)m * D_MODEL) + lane;
#pragma unroll
            for (int j = 0; j < 4; ++j) o[64 * j] = src ? ((const GAS f32x4*)src)[lane + 64 * j] : (f32x4){0.f, 0.f, 0.f, 0.f};
        }
    }
    if (a.pro_mask & pmsel & PM_WIN) {
        bf16* WT = (bf16*)(wsb + a.off[R_WIN]);
        constexpr int IPL = (D_MODEL / 64) * (ZN / 32);
        TrItem A, B;
#define WIN_LOAD(T, it_) do { const int l_ = (it_) / IPL, r_ = (it_) % IPL; tr_load(T, GIN(a, I_WIN) + (size_t)l_ * D_MODEL * D_IN, D_IN, 32 * (r_ % (ZN / 32)), 64 * (r_ / (ZN / 32)), CmWin(), lane); } while (0)
        if (gw < DEPTH * IPL) WIN_LOAD(A, gw);
        for (int it = gw; it < DEPTH * IPL; it += NGW) { const int l = it / IPL, r = it % IPL, kb = r / (ZN / 32), nb = r % (ZN / 32);
            if (it + NGW < DEPTH * IPL) WIN_LOAD(B, it + NGW);
            tr_store(A, D_MODEL, WT + (size_t)l * ZN * D_MODEL, 32 * nb, 64 * kb, scr, lane); A = B; }
#undef WIN_LOAD
    }
    __syncthreads();
    if (a.pro_mask & pmsel & PM_TABLES) s5_tables(F);
    __syncthreads();
    if (a.pro_mask & pmsel & PM_WREST) pro_wrest(F);
    if (a.pro_mask & pmsel & PM_WQS) pro_wqs(F);
    if (a.pro_mask & pmsel & PM_PEERW) pro_peerw(F);
}

__global__ void __launch_bounds__(NTHR, 2) mk_fwd(Args args) {
    extern __shared__ __attribute__((aligned(16))) unsigned char lds[];
    Frame F;
    F.lds = (LAS unsigned char*)lds; F.MISC = (volatile LAS unsigned*)(F.lds + MISC_OFF);
    F.wv = __builtin_amdgcn_readfirstlane((int)threadIdx.x >> 6);
    F.G = gridDim.x; { const int bx = blockIdx.x; F.vcu = (F.G % 8 == 0) ? (bx % 8) * (F.G / 8) + bx / 8 : bx; }
    F.ctl = (gu32*)args.ws;
    for (int u = F.wv * 64 + lane_id(); u < (LDS_BYTES - LDSCTL_OFF) / 4; u += NTHR) ((LAS unsigned*)(F.lds + LDSCTL_OFF))[u] = 0u;
    __syncthreads();
    const int lo = args.ph_lo, hi = args.ph_hi;
    unsigned* barw = (unsigned*)(F.ctl + CW_BAR) + (size_t)args.bar_region * XCD_BAR_WORDS;
    XcdBarrier bar; bar.bar = barw; bar.x = 0; bar.st = nullptr; bar.wv = F.wv;
    if (hi - lo > 1) bar = xcd_barrier_post(barw, F.MISC + 8, F.wv);
#define IN(k) (lo <= (k) && (k) < hi)
#ifndef MK_REP
#define MK_REP -1
#endif
#ifdef MK_NOSTEAL
#define STEALBAR(b, F) xcd_barrier(b)
#else
#define STEALBAR(b, F) xcd_barrier_steal(b, F)
#endif
#ifdef MK_TBAR
    unsigned long long tbar_ = 0ull;
#define SEAM(k) do { if ((k) + 1 < hi) { const unsigned long long t0_ = __builtin_amdgcn_s_memrealtime(); xcd_barrier(bar); const unsigned long long t1_ = __builtin_amdgcn_s_memrealtime(); if ((MK_TBAR_SEL) < 0 || ((k) - 1) % NPL == (MK_TBAR_SEL)) tbar_ += t1_ - t0_; } } while (0)
#else
#define SEAM(k) do { if ((k) + 1 < hi) { STEALBAR(bar, F); if ((MK_REP) == 300) xcd_barrier(bar); } } while (0)
#endif
#ifndef MK_REP
#define MK_REP -1
#endif
#ifndef MK_PMASK
#define MK_PMASK -1
#endif
    if (IN(PH_PRO)) { for (int rep_ = 0; rep_ < ((MK_REP) == 200 ? 2 : 1); ++rep_) { p_prologue(F, rep_ == 0 ? -1 : (MK_PMASK)); __syncthreads(); } SEAM(PH_PRO); }
#ifndef MK_REP
#define MK_REP -1
#endif
#define REPEAT(ph) for (int rep_ = 0; rep_ < ((MK_REP) == (ph) ? 2 : 1); ++rep_)
    for (int l = 0; l < DEPTH; ++l) {
        const int pb = 1 + l * NPL;
        if (IN(pb + PL_GEMM_IN)) {
            const KArgs ap = kargs(); const auto& a = *ap; WS_OPAQUE(a);
            pg8::Gemm g{(const pg8::bf16_t*)(wsb + a.off[R_XN]), (const pg8::bf16_t*)(wsb + a.off[R_WIN]) + (size_t)l * ZN * D_MODEL, RP, ZN, D_MODEL};
            pg8::StaticOrder S; S.init(RP, ZN, F.G, (int)blockIdx.x);
            pg8::EpiBf16<0> E{(pg8::bf16_t*)(wsb + a.off[R_Z]), ZN, nullptr, 0, 0, 1.f};
            REPEAT(PL_GEMM_IN) pg8::gemm_phase<pg8::EpiBf16<0>, pg8::StaticOrder, true, true>(F.lds + RING_OFF, g, S, E, F.wv);
            SEAM(pb + PL_GEMM_IN);
        }
        if (IN(pb + PL_ZPOST)) { REPEAT(103) p_s5_e(F, l); REPEAT(PL_ZPOST) p_zpost(F, l);     SEAM(pb + PL_ZPOST); }
        if (IN(pb + PL_LOCAL)) { REPEAT(104) p_gdn_chunk<0>(F, l, 0); SEAM(pb + PL_LOCAL); }
        if (IN(pb + PL_MIX)) {
            REPEAT(100) p_gdn_chain(F, l);
            REPEAT(102) { const int tid = otid(), lane = tid & 63, wave = __builtin_amdgcn_readfirstlane(tid >> 6);
              const int q = F.vcu - F.vcu / 32 - 1;
              if (F.vcu % 32 != 0 && q >= 18) for (int t = (q - 18) * NWAVES + wave; t < S5_NTASK; t += (F.G - F.G / 32 - 18) * NWAVES) s5_scan_run(F, l, t, lane); }
            REPEAT(101) p_attention(F, l + DEPTH * rep_, lds);
            SEAM(pb + PL_MIX); }
        if (IN(pb + PL_MIXPOST)) { REPEAT(PL_MIXPOST) { p_mixpost_a(F, l); p_mixpost_b(F, l); p_s5_out(F, l); } SEAM(pb + PL_MIXPOST); }
        if (IN(pb + PL_GEMM_GLU)) REPEAT(PL_GEMM_GLU) {
            const KArgs ap = kargs(); const auto& a = *ap; WS_OPAQUE(a);
            { pg8::Gemm g{(const pg8::bf16_t*)(wsb + a.off[R_YC]), (const pg8::bf16_t*)(wsb + a.off[R_WGLU]) + (size_t)l * 1024 * 512, RP, 1024, 512};
              pg8::StaticOrder S; S.init(RP, 1024, F.G, (int)blockIdx.x); pg8::EpiGlu E{(pg8::bf16_t*)(wsb + a.off[R_OC]), WIDTH_C};
              pg8::gemm_phase<pg8::EpiGlu, pg8::StaticOrder, true, true>(F.lds + RING_OFF, g, S, E, F.wv); }
            { pg8::Gemm g{(const pg8::bf16_t*)(wsb + a.off[R_OA]), (const pg8::bf16_t*)(wsb + a.off[R_WBR]) + ((size_t)l * 3 + 0) * 1024 * 512, RP, 1024, 512};
              pg8::StaticOrder S; S.init(RP, 1024, F.G, (int)((blockIdx.x + 16) % F.G)); pg8::EpiMerge<0> E{(pg8::bf16_t*)(wsb + a.off[R_MRG]), nullptr, nullptr, (const pg8::bf16_t*)(wsb + a.off[R_Z]) + ZC_GATE, ZN};
              pg8::gemm_phase<pg8::EpiMerge<0>, pg8::StaticOrder, true, true>(F.lds + RING_OFF, g, S, E, F.wv); }
            { pg8::Gemm g{(const pg8::bf16_t*)(wsb + a.off[R_OBN]), (const pg8::bf16_t*)(wsb + a.off[R_WBR]) + ((size_t)l * 3 + 1) * 1024 * 512, RP, 1024, 512};
              pg8::StaticOrder S; S.init(RP, 1024, F.G, (int)((blockIdx.x + 32) % F.G)); pg8::EpiMerge<0> E{(pg8::bf16_t*)(wsb + a.off[R_MRG2]), nullptr, nullptr, (const pg8::bf16_t*)(wsb + a.off[R_Z]) + ZC_GATE + 1024, ZN};
              pg8::gemm_phase<pg8::EpiMerge<0>, pg8::StaticOrder, true, true>(F.lds + RING_OFF, g, S, E, F.wv); }
            if (rep_ == ((MK_REP) == PL_GEMM_GLU ? 1 : 0)) SEAM(pb + PL_GEMM_GLU); }
        if (IN(pb + PL_GEMM_BRC)) {
            const KArgs ap = kargs(); const auto& a = *ap; WS_OPAQUE(a);
            pg8::Gemm g{(const pg8::bf16_t*)(wsb + a.off[R_OC]), (const pg8::bf16_t*)(wsb + a.off[R_WBR]) + ((size_t)l * 3 + 2) * 1024 * 512, RP, 1024, 512};
            pg8::StaticOrder S; S.init(RP, 1024, F.G, (int)blockIdx.x); pg8::EpiMerge<2> E{(pg8::bf16_t*)(wsb + a.off[R_MRG]), (const pg8::bf16_t*)(wsb + a.off[R_MRG2]), (pg8::bf16_t*)(wsb + a.off[R_MRGB]), (const pg8::bf16_t*)(wsb + a.off[R_Z]) + ZC_GATE + 2048, ZN};
            REPEAT(PL_GEMM_BRC) pg8::gemm_phase<pg8::EpiMerge<2>, pg8::StaticOrder, true, true>(F.lds + RING_OFF, g, S, E, F.wv);
            SEAM(pb + PL_GEMM_BRC); }
        if (IN(pb + PL_GEMM_OUT)) {
            const KArgs ap = kargs(); const auto& a = *ap; WS_OPAQUE(a);
            pg8::Gemm g{(const pg8::bf16_t*)(wsb + a.off[R_MRGB]), (const pg8::bf16_t*)(wsb + a.off[R_WOUT]) + (size_t)l * 1024 * 1024, RP, 1024, 1024};
            pg8::StaticOrder S; S.init(RP, 1024, F.G, (int)blockIdx.x);
            REPEAT(PL_GEMM_OUT) { pg8::EpiResid E{(float*)(wsb + a.off[R_X]), D_MODEL, (MK_REP) == PL_GEMM_OUT && rep_ == 0, (pg8::bf16_t*)(wsb + a.off[R_XN])};
            pg8::gemm_phase<pg8::EpiResid, pg8::StaticOrder, true, true>(F.lds + RING_OFF, g, S, E, F.wv); }
            SEAM(pb + PL_GEMM_OUT); }
        if (IN(pb + PL_GEMM_PEER)) {
            peerw_drain(F, (l + 1) * PW_ITEMS_L);
            const KArgs ap = kargs(); const auto& a = *ap; WS_OPAQUE(a);
            pg8::Gemm g{(const pg8::bf16_t*)(wsb + a.off[R_XN]), (const pg8::bf16_t*)(wsb + a.off[R_WQS]) + (size_t)l * PQ * D_MODEL, RP, PQ, D_MODEL};
            pg8::StaticOrder S; S.init(RP, PQ, F.G, (int)blockIdx.x); pg8::EpiF32 E{(float*)(wsb + a.off[R_SC]), PQ};
            REPEAT(PL_GEMM_PEER) pg8::gemm_phase<pg8::EpiF32, pg8::StaticOrder, true, true>(F.lds + RING_OFF, g, S, E, F.wv);
            SEAM(pb + PL_GEMM_PEER); }
        if (IN(pb + PL_PEER)) { REPEAT(PL_PEER) p_peer(F, l, (MK_REP) == PL_PEER && rep_ == 0); SEAM(pb + PL_PEER); }
    }
#ifdef MK_TBAR
    if (blockIdx.x == MK_TBAR_WG && F.wv == 0 && lane_id() == 0) args.out[O_YS] = 1000.f * (MK_TBAR_Q) * floorf((float)tbar_ * 1e-5f / (MK_TBAR_Q) + 0.5f);
#endif
#undef IN
#undef SEAM
}
}
#ifndef MK_ONE_LAUNCH
#define MK_ONE_LAUNCH 1
#endif
static int mk_grid = 0;
static bool mk_setup() {
    if (mk_grid) return mk_grid > 0;
    int dev = 0, cus = 0;
    if (hipGetDevice(&dev) != hipSuccess || hipDeviceGetAttribute(&cus, hipDeviceAttributeMultiprocessorCount, dev) != hipSuccess) { mk_grid = -1; return false; }
    if (hipFuncSetAttribute((const void*)mk::mk_fwd, hipFuncAttributeMaxDynamicSharedMemorySize, mk::LDS_BYTES) != hipSuccess) { fprintf(stderr, "kernel_launch: hipFuncSetAttribute failed\n"); mk_grid = -1; return false; }
    int per_cu = 0;
    if (hipOccupancyMaxActiveBlocksPerMultiprocessor(&per_cu, (const void*)mk::mk_fwd, mk::NTHR, mk::LDS_BYTES) != hipSuccess || per_cu < 1) { fprintf(stderr, "kernel_launch: occupancy query says %d workgroups per CU\n", per_cu); }
    (void)hipGetLastError();
    mk_grid = cus;
    return true;
}
static void mk_launch(mk::Args a, int lo, int hi, int region, hipStream_t stream) {
    a.ph_lo = lo; a.ph_hi = hi; a.bar_region = region;
    hipLaunchKernelGGL(mk::mk_fwd, dim3(mk_grid), dim3(mk::NTHR), mk::LDS_BYTES, stream, a);
    hipError_t e = hipPeekAtLastError(); if (e != hipSuccess) fprintf(stderr, "kernel_launch: launch failed: %s\n", hipGetErrorName(e));
}
extern "C" void kernel_launch(void* const* d_in, const int* in_sizes, int n_in, void* d_out, int out_size, void* d_ws, size_t ws_size, hipStream_t stream) {
    if (n_in != N_INPUTS || (size_t)out_size != (size_t)O_END) { fprintf(stderr, "kernel_launch: unexpected n_in %d / out_size %d\n", n_in, out_size); return; }
    if (!mk_setup()) return;
    const size_t MiB = 1u << 20;
    unsigned char* ws = (unsigned char*)d_ws;
    mk::Args a{};
    for (int i = 0; i < N_INPUTS; ++i) a.in[i] = (const float*)d_in[i];
    a.out = (float*)d_out; a.ws = ws;
    { using namespace mk; const struct { int r; size_t mib; } map[] = { {R_WIN, 1}, {R_WGLU, 59}, {R_WBR, 63}, {R_WOUT, 75}, {R_WQS, 83}, {R_S5T, 99}, {R_PU, 132}, {R_PV, 196}, {R_MISC, 260}, {R_OBN, 262}, {R_MRG2, 280}, {R_X, 388}, {R_XN, 456},
        {R_Z, 490}, {R_SC, 490}, {R_QN, 737}, {R_KN, 754}, {R_QKVB, 771}, {R_BG, 822}, {R_O, 823}, {R_MRGB, 823}, {R_OA, 857}, {R_OB, 874}, {R_GDN, 891}, {R_MRG, 891},
        {R_S5E, 986}, {R_YC, 986}, {R_S5X, 1003}, {R_OC, 1012} };
      for (auto& e : map) a.off[e.r] = e.mib * MiB; }
    if (1029 * MiB > ws_size) { fprintf(stderr, "kernel_launch: workspace too small (%zu)\n", ws_size); return; }
    if (hipMemsetAsync(ws, 0, mk::CTL_BYTES, stream) != hipSuccess) { fprintf(stderr, "kernel_launch: memset failed\n"); return; }
    a.pro_mask =   mk::PM_WIN | mk::PM_TABLES | mk::PM_WREST | mk::PM_WQS;
#if MK_ONE_LAUNCH
    mk_launch(a, 0, mk::PH_END, 0, stream);
#else
    int region = 0;
    mk_launch(a, mk::PH_PRO, mk::PH_PRO + 1, region++, stream);
    for (int l = 0; l < DEPTH; ++l) { const int pb = 1 + l * mk::NPL;
        for (int ph = mk::PL_NORM1; ph <= mk::PL_PEER; ++ph) { if (ph == mk::PL_GEMM_BRA || ph == mk::PL_GEMM_BRB) continue; mk_launch(a, pb + ph, pb + ph + 1, region++, stream); } }
    mk_launch(a, mk::PH_FINAL, mk::PH_END, region++, stream);
#endif
}
```

```cpp
#include <hip/hip_runtime.h>
#include <cstdio>
#include <cstdint>
#include <utility>
#define MK_ONE_LAUNCH 1
#ifndef D_MODEL
#define D_MODEL 1024
#define BATCH 2
#define SEQ 8192
#define DEPTH 4
#define DEC_BATCH 16
#define DEC_SEQ 32
#define PAST_LEN 1024
#define N_HEADS_A 4
#define HEAD_DIM_A 64
#define N_HEADS_B 4
#define HEAD_DIM_B 128
#define S5_GROUPS 32
#define S5_STATE 64
#define PEER_HEADS 8
#define PEER_QDIM 256
#define N_KEYS 128
#endif
#define CHUNK 64
#define N_META 16
#define EPSF 1e-6f
#define NUM_BUCKETS 32
#define CONV_W 4
#define S5_GROUP 16
#define PEER_TOPK 16
#define N_EXPERTS (N_KEYS * N_KEYS)
#define WIDTH_A (N_HEADS_A * 2 * HEAD_DIM_A)
#define WIDTH_B (N_HEADS_B * HEAD_DIM_B)
#define WIDTH_C (S5_GROUPS * S5_GROUP)
#define OFF_QA 0
#define OFF_KA (OFF_QA + WIDTH_A)
#define OFF_VA (OFF_KA + WIDTH_A)
#define OFF_QKVB (OFF_VA + WIDTH_A)
#define OFF_GB (OFF_QKVB + 3 * WIDTH_B)
#define OFF_BETA (OFF_GB + WIDTH_B)
#define OFF_ALPHA (OFF_BETA + N_HEADS_B)
#define OFF_UC (OFF_ALPHA + N_HEADS_B)
#define OFF_GATE (OFF_UC + WIDTH_C)
#define D_IN (OFF_GATE + 3 * D_MODEL)
#define LP (N_META + SEQ)
#define NP (BATCH * LP)
#define NS (DEC_BATCH * DEC_SEQ)
#define NT (NP + NS)
#define PQ (PEER_HEADS * PEER_QDIM)

enum { I_XP, I_XS, I_CK, I_CV, I_SCONV, I_SDELTA, I_SRE, I_SIM, I_META, I_REL, I_N1, I_N2, I_FN, I_WIN, I_QN, I_KN, I_LQK, I_SUBLN, I_CONVW, I_ALOG, I_DTB, I_GDNN,
       I_AR, I_AI, I_BR, I_BI, I_CR, I_CI, I_SD, I_LDT, I_WGLU, I_WBA, I_WBB, I_WBC, I_WOUT, I_PWQ, I_PSK, I_PU, I_PV, N_INPUTS };
#define O_YP 0
#define O_YS (O_YP + (size_t)BATCH * SEQ * D_MODEL)
#define O_KP (O_YS + (size_t)NS * D_MODEL)
#define O_VP (O_KP + (size_t)DEPTH * NP * WIDTH_A)
#define O_KS (O_VP + (size_t)DEPTH * NP * WIDTH_A)
#define O_VS (O_KS + (size_t)DEPTH * NS * WIDTH_A)
#define O_CP (O_VS + (size_t)DEPTH * NS * WIDTH_A)
#define O_CS (O_CP + (size_t)DEPTH * BATCH * (CONV_W - 1) * 3 * WIDTH_B)
#define O_DP (O_CS + (size_t)DEPTH * DEC_BATCH * (CONV_W - 1) * 3 * WIDTH_B)
#define O_DS (O_DP + (size_t)DEPTH * BATCH * N_HEADS_B * HEAD_DIM_B * HEAD_DIM_B)
#define O_SRP (O_DS + (size_t)DEPTH * DEC_BATCH * N_HEADS_B * HEAD_DIM_B * HEAD_DIM_B)
#define O_SIP (O_SRP + (size_t)DEPTH * BATCH * S5_GROUPS * S5_STATE)
#define O_SRS (O_SIP + (size_t)DEPTH * BATCH * S5_GROUPS * S5_STATE)
#define O_SIS (O_SRS + (size_t)DEPTH * DEC_BATCH * S5_GROUPS * S5_STATE)
#define O_END (O_SIS + (size_t)DEPTH * DEC_BATCH * S5_GROUPS * S5_STATE)

namespace pg8 {
#define PG8_LAS __attribute__((address_space(3)))
typedef unsigned short bf16_t;
typedef short bf16x8 __attribute__((ext_vector_type(8)));
typedef float f32x4 __attribute__((ext_vector_type(4)));
typedef unsigned u32x4 __attribute__((ext_vector_type(4)));
constexpr int BM = 256, BK = 64, HALF = 128, HTB = HALF * BK * 2  , STAGE_BYTES = 8 * HTB, NXCD = 8, WGM = 8;

__host__ __device__ __forceinline__ int lds_byte(int r, int c) { const int st = (r >> 4) * 2 + (c >> 5), rr = r & 15, cc = c & 31, ob = rr * 64 + cc * 2; return st * 1024 + (ob ^ (((ob >> 9) & 1) << 5)); }
__host__ __device__ __forceinline__ void stage_rc(int b, int& R, int& C) { const int st = b / 1024, sb = b % 1024, swz = sb ^ (((sb >> 9) & 1) << 5); R = (st >> 1) * 16 + swz / 64; C = (st & 1) * 32 + (swz % 64) / 2; }
__host__ __device__ __forceinline__ int perm32(int rho) { const int n = rho >> 4, i = rho & 15; return 8 * (i >> 2) + 4 * n + (i & 3); }

struct Unit { int pm, pn; };
struct Gemm { const bf16_t* A; const bf16_t* Bt; int M, N, K; };

struct StaticOrder {
    int nM, nN, nwg, G, c;
    __host__ __device__ void init(int M, int N, int G_, int c_) { nM = M / BM; nN = N / BM; nwg = nM * nN; G = G_; c = c_; }
    __host__ __device__ bool next(int i, Unit& u) const {
        const long L = (long)i * G + c; if (L >= nwg) return false;
        int wgid = (int)L; { const int q = nwg / NXCD, r = nwg % NXCD, xcd = wgid % NXCD, off = wgid / NXCD; wgid = (xcd < r ? xcd * (q + 1) : r * (q + 1) + (xcd - r) * q) + off; }
        const int nig = WGM * nN, gid = wgid / nig, fm = gid * WGM, gsz = (nM - fm) < WGM ? (nM - fm) : WGM;
        u.pm = fm + ((wgid % nig) % gsz); u.pn = (wgid % nig) / gsz; return true;
    }
    __device__ __forceinline__ void a_ready(const Unit&) const {}
    __device__ __forceinline__ void done(const Unit&) const {}
};

__device__ __forceinline__ unsigned cvt_pk_bf16(float lo, float hi) { unsigned r; asm volatile("v_cvt_pk_bf16_f32 %0, %1, %2" : "=v"(r) : "v"(lo), "v"(hi)); return r; }
typedef float f32x2 __attribute__((ext_vector_type(2)));
__device__ __forceinline__ f32x2 gelu_pk(f32x2 v) {
    const f32x2 av = __builtin_elementwise_abs(v), d = av * 0.2316418882f + 1.0f;
    f32x2 t; t.x = __builtin_amdgcn_rcpf(d.x); t.y = __builtin_amdgcn_rcpf(d.y);
    f32x2 q = t * 0.5307027145f + (-0.7265760135f); q = q * t + 0.7107068705f; q = q * t + (-0.142248368f); q = q * t + 0.127414796f; q = q * t;
    const f32x2 s = (v * v) * (-0.72134752044f);
    f32x2 e; e.x = __builtin_amdgcn_exp2f(s.x); e.y = __builtin_amdgcn_exp2f(s.y);
    const f32x2 m = v * (q * e), r = v - m;
    f32x2 o; o.x = v.x < 0.f ? m.x : r.x; o.y = v.y < 0.f ? m.y : r.y; return o;
}

template <int ACT  > struct EpiBf16 {
    static constexpr bool PERM = true, AFTER_DRAIN = false; static_assert(ACT == 0 || ACT == 1, "EpiBf16: ACT is 0 (none) or 1 (gelu_pk)");
    bf16_t* O; int ldc; const float* bias; int split_cols; size_t split_stride; float scale0;
    __device__ __forceinline__ void operator()(const f32x4 (&acc)[2][2][4][2], const Unit& u, int wr, int wc, int fr, int fq) const {
        const int row0 = u.pm * BM + wr * 64 + fr; int colt = u.pn * BM; bf16_t* base = O;
        float sc = 1.f; if (split_cols) { const int t = colt / split_cols; base += (size_t)t * split_stride; colt -= t * split_cols; if (t == 0) sc = scale0; }
        const int col0 = colt + wc * 32 + 8 * fq, bcol0 = u.pn * BM + wc * 32 + 8 * fq;
        f32x4 bv[2][2];
#pragma unroll
        for (int bj = 0; bj < 2; ++bj)
#pragma unroll
            for (int n = 0; n < 2; ++n) bv[bj][n] = bias ? *(const f32x4*)(bias + bcol0 + bj * HALF + 4 * n) : (f32x4){0.f, 0.f, 0.f, 0.f};
#pragma unroll
        for (int ai = 0; ai < 2; ++ai)
#pragma unroll
            for (int m = 0; m < 4; ++m) { bf16_t* rowp = base + (size_t)(row0 + ai * HALF + m * 16) * ldc + col0;
#pragma unroll
                for (int bj = 0; bj < 2; ++bj) { f32x4 v0 = acc[ai][bj][m][0] + bv[bj][0], v1 = acc[ai][bj][m][1] + bv[bj][1];
                    if (ACT == 1) { f32x2 a = gelu_pk((f32x2){v0[0], v0[1]}), b = gelu_pk((f32x2){v0[2], v0[3]}), c = gelu_pk((f32x2){v1[0], v1[1]}), d = gelu_pk((f32x2){v1[2], v1[3]});
                        v0 = (f32x4){a.x, a.y, b.x, b.y}; v1 = (f32x4){c.x, c.y, d.x, d.y}; }
                    v0 = v0 * sc; v1 = v1 * sc; u32x4 w; w.x = cvt_pk_bf16(v0[0], v0[1]); w.y = cvt_pk_bf16(v0[2], v0[3]); w.z = cvt_pk_bf16(v1[0], v1[1]); w.w = cvt_pk_bf16(v1[2], v1[3]);
                    *(u32x4*)(rowp + bj * HALF) = w; } }
    }
};

__device__ __forceinline__ float epi_sigm(float x) { return __builtin_amdgcn_rcpf(1.f + __expf(-x)); }
struct EpiGlu {
    static constexpr bool PERM = false, AFTER_DRAIN = false;
    bf16_t* O; int ldo;
    __device__ __forceinline__ void operator()(const f32x4 (&acc)[2][2][4][2], const Unit& u, int wr, int wc, int fr, int fq) const {
        const int row0 = u.pm * BM + wr * 64 + fr;
#pragma unroll
        for (int ai = 0; ai < 2; ++ai)
#pragma unroll
            for (int m = 0; m < 4; ++m) { bf16_t* rowp = O + (size_t)(row0 + ai * HALF + m * 16) * ldo + 4 * fq;
#pragma unroll
                for (int bj = 0; bj < 2; ++bj) { const int G = u.pn * 8 + bj * 4 + wc; const f32x4 av = acc[ai][bj][m][0], gv = acc[ai][bj][m][1];
                    typedef unsigned u32x2 __attribute__((ext_vector_type(2))); u32x2 w;
                    w.x = cvt_pk_bf16(av[0] * epi_sigm(gv[0]), av[1] * epi_sigm(gv[1])); w.y = cvt_pk_bf16(av[2] * epi_sigm(gv[2]), av[3] * epi_sigm(gv[3]));
                    *(u32x2*)(rowp + 16 * G) = w; } }
    }
};
template <int MODE> struct EpiMerge {
    static constexpr bool PERM = true, AFTER_DRAIN = false;
    bf16_t* M; const bf16_t* M2; bf16_t* Mb; const bf16_t* Zg; int ldz;
    __device__ __forceinline__ void operator()(const f32x4 (&acc)[2][2][4][2], const Unit& u, int wr, int wc, int fr, int fq) const {
        const int row0 = u.pm * BM + wr * 64 + fr, col0 = u.pn * BM + wc * 32 + 8 * fq;
#define EPI_LO(w) __builtin_bit_cast(float, (w) << 16)
#define EPI_HI(w) __builtin_bit_cast(float, (w) & 0xffff0000u)
        constexpr int MG = MODE == 2 ? 2 : 4;
#pragma unroll
        for (int aim = 0; aim < 8; aim += MG) { const int ai = aim >> 2, m0 = aim & 3;
            u32x4 gz[MG][2], pa[MG][2], pb[MG][2];
#pragma unroll
            for (int m = 0; m < MG; ++m)
#pragma unroll
                for (int bj = 0; bj < 2; ++bj) { const size_t row = (size_t)(row0 + ai * HALF + (m0 + m) * 16); const int col = col0 + bj * HALF;
                    gz[m][bj] = *(const u32x4*)(Zg + row * ldz + col);
                    if (MODE == 2) { pa[m][bj] = *(const u32x4*)(M + row * 1024 + col); pb[m][bj] = *(const u32x4*)(M2 + row * 1024 + col); } }
#pragma unroll
            for (int m = 0; m < MG; ++m)
#pragma unroll
                for (int bj = 0; bj < 2; ++bj) { const size_t row = (size_t)(row0 + ai * HALF + (m0 + m) * 16); const int col = col0 + bj * HALF; const u32x4 g = gz[m][bj];
                    f32x4 v0 = acc[ai][bj][m0 + m][0], v1 = acc[ai][bj][m0 + m][1];
                    v0[0] *= epi_sigm(EPI_LO(g.x)); v0[1] *= epi_sigm(EPI_HI(g.x)); v0[2] *= epi_sigm(EPI_LO(g.y)); v0[3] *= epi_sigm(EPI_HI(g.y));
                    v1[0] *= epi_sigm(EPI_LO(g.z)); v1[1] *= epi_sigm(EPI_HI(g.z)); v1[2] *= epi_sigm(EPI_LO(g.w)); v1[3] *= epi_sigm(EPI_HI(g.w));
                    if (MODE == 2) { const u32x4 a_ = pa[m][bj], b_ = pb[m][bj];
                        v0[0] += EPI_LO(a_.x) + EPI_LO(b_.x); v0[1] += EPI_HI(a_.x) + EPI_HI(b_.x); v0[2] += EPI_LO(a_.y) + EPI_LO(b_.y); v0[3] += EPI_HI(a_.y) + EPI_HI(b_.y);
                        v1[0] += EPI_LO(a_.z) + EPI_LO(b_.z); v1[1] += EPI_HI(a_.z) + EPI_HI(b_.z); v1[2] += EPI_LO(a_.w) + EPI_LO(b_.w); v1[3] += EPI_HI(a_.w) + EPI_HI(b_.w); }
                    u32x4 w; w.x = cvt_pk_bf16(v0[0], v0[1]); w.y = cvt_pk_bf16(v0[2], v0[3]); w.z = cvt_pk_bf16(v1[0], v1[1]); w.w = cvt_pk_bf16(v1[2], v1[3]);
                    *(u32x4*)((MODE == 2 ? Mb : M) + row * 1024 + col) = w; }
        }
#undef EPI_LO
#undef EPI_HI
    }
};
struct EpiResid {
    static constexpr bool PERM = false, AFTER_DRAIN = false;
    float* X; int ldx; bool dry; bf16_t* Xb;
    __device__ __forceinline__ void operator()(const f32x4 (&acc)[2][2][4][2], const Unit& u, int wr, int wc, int fr, int fq) const {
        const int row0 = u.pm * BM + wr * 64 + fr, col0 = u.pn * BM + wc * 32 + 4 * fq;
        typedef unsigned u32x2 __attribute__((ext_vector_type(2)));
#pragma unroll
        for (int aim = 0; aim < 8; aim += 2) { const int ai = aim >> 2, m0 = aim & 3;
            f32x4 xo[2][2][2]; bool ok[2];
#pragma unroll
            for (int m = 0; m < 2; ++m) { const int row = row0 + ai * HALF + (m0 + m) * 16; ok[m] = true; if (row < 16896) { const int p = row % 8448; ok[m] = p >= 48 && p < 8256; } ok[m] = ok[m] && !dry;
                const float* rowp = X + (size_t)row * ldx + col0;
#pragma unroll
                for (int bj = 0; bj < 2; ++bj)
#pragma unroll
                    for (int n = 0; n < 2; ++n) xo[m][bj][n] = *(const f32x4*)(rowp + bj * HALF + n * 16); }
#pragma unroll
            for (int m = 0; m < 2; ++m) { const int row = row0 + ai * HALF + (m0 + m) * 16;
                if (ok[m]) { float* rowp = X + (size_t)row * ldx + col0;
#pragma unroll
                    for (int bj = 0; bj < 2; ++bj)
#pragma unroll
                        for (int n = 0; n < 2; ++n) { const f32x4 v = xo[m][bj][n] + acc[ai][bj][m0 + m][n]; *(f32x4*)(rowp + bj * HALF + n * 16) = v;
                            u32x2 w; w.x = cvt_pk_bf16(v[0], v[1]); w.y = cvt_pk_bf16(v[2], v[3]); *(u32x2*)(Xb + (size_t)row * ldx + col0 + bj * HALF + n * 16) = w; } } }
        }
    }
};
struct EpiF32 {
    static constexpr bool PERM = false, AFTER_DRAIN = false;
    float* C; int ldc;
    __device__ __forceinline__ void operator()(const f32x4 (&acc)[2][2][4][2], const Unit& u, int wr, int wc, int fr, int fq) const {
        const int row0 = u.pm * BM + wr * 64 + fr, col0 = u.pn * BM + wc * 32 + 4 * fq;
#pragma unroll
        for (int ai = 0; ai < 2; ++ai)
#pragma unroll
            for (int m = 0; m < 4; ++m) { float* rowp = C + (size_t)(row0 + ai * HALF + m * 16) * ldc + col0;
#pragma unroll
                for (int bj = 0; bj < 2; ++bj)
#pragma unroll
                    for (int n = 0; n < 2; ++n) *(f32x4*)(rowp + bj * HALF + n * 16) = acc[ai][bj][m][n]; }
    }
};

template <class Epi, class Sched, bool ALIGN_EPI = false, bool SP2 = false>
__device__ __forceinline__ void gemm_phase(PG8_LAS unsigned char* lds, const Gemm g, const Sched& S, const Epi& E, int wv) {
    unsigned om_ = ~0u; asm volatile("" : "+s"(om_), "+s"(wv)); int tid_ = wv * 64 + (int)__builtin_amdgcn_mbcnt_hi(om_, __builtin_amdgcn_mbcnt_lo(om_, 0u));
    const int tid = tid_, wid = __builtin_amdgcn_readfirstlane(tid >> 6), lane = tid & 63, wr = wid >> 2, wc = wid & 3, fr = lane & 15, fq = lane >> 4;
    const int K = g.K, nt = K / BK;
    unsigned voffA[2], voffB[2];
#pragma unroll
    for (int i = 0; i < 2; ++i) { int R, C; stage_rc(tid * 16 + i * 8192, R, C); const int Rb = Epi::PERM ? ((R & ~31) + perm32(R & 31)) : R;
        voffA[i] = (unsigned)(R * K + C) * 2u; voffB[i] = (unsigned)(Rb * K + C) * 2u; }
    const size_t kstep = (size_t)(BK * 2);
    const size_t hstep = (size_t)HALF * K * 2;
    const size_t tstep = 2 * hstep;
    const unsigned ldsw = (unsigned)wid * 1024u;
    const int aoff = lds_byte(wr * 64 + fr, fq * 8), boff = lds_byte(wc * 32 + fr, fq * 8);
#define PG8_SA(b, h) (((b) * 2 + (h)) * HTB)
#define PG8_SB(b, h) ((4 + (b) * 2 + (h)) * HTB)
#define PG8_STAGE(bufoff, gbase, voff) do { _Pragma("unroll") for (int _i = 0; _i < 2; ++_i) \
        __builtin_amdgcn_global_load_lds((const unsigned*)((const char*)(gbase) + (voff)[_i]), (PG8_LAS unsigned*)(lds + (bufoff) + ldsw + _i * 8192), 16, 0, 0); } while (0)
#define PG8_LDA(dst, b, h) do { _Pragma("unroll") for (int m = 0; m < 4; ++m) _Pragma("unroll") for (int k = 0; k < 2; ++k) dst[m][k] = *(const PG8_LAS bf16x8*)(lds + PG8_SA(b, h) + aoff + m * 2048 + k * 1024); } while (0)
#define PG8_LDB(dst, b, h) do { _Pragma("unroll") for (int n = 0; n < 2; ++n) _Pragma("unroll") for (int k = 0; k < 2; ++k) dst[n][k] = *(const PG8_LAS bf16x8*)(lds + PG8_SB(b, h) + boff + n * 2048 + k * 1024); } while (0)
#define PG8_MMA(ai, bj, At, Bt) do { __builtin_amdgcn_s_setprio(1); _Pragma("unroll") for (int m = 0; m < 4; ++m) _Pragma("unroll") for (int n = 0; n < 2; ++n) _Pragma("unroll") for (int k = 0; k < 2; ++k) \
        acc[ai][bj][m][n] = __builtin_amdgcn_mfma_f32_16x16x32_bf16(Bt[n][k], At[m][k], acc[ai][bj][m][n], 0, 0, 0); __builtin_amdgcn_s_setprio(0); } while (0)
#define PG8_WAIT_V(n) asm volatile("s_waitcnt vmcnt(" #n ")" ::: "memory")
#define PG8_WAIT_L(n) asm volatile("s_waitcnt lgkmcnt(" #n ")" ::: "memory")
#define PG8_BAR __builtin_amdgcn_s_barrier()
#define PG8_SCHED __builtin_amdgcn_sched_barrier(0)
    Unit cur, nxt; int ui = 0;
    if (!S.next(0, cur)) return;
    f32x4 acc[2][2][4][2];
#pragma unroll
    for (int a = 0; a < 2; ++a)
#pragma unroll
        for (int b = 0; b < 2; ++b)
#pragma unroll
            for (int m = 0; m < 4; ++m)
#pragma unroll
                for (int n = 0; n < 2; ++n) acc[a][b][m][n] = (f32x4){0.f, 0.f, 0.f, 0.f};
    bf16x8 At[4][2], B0[2][2], B1[2][2];
    const char* cA = (const char*)g.A + (size_t)cur.pm * tstep; const char* cB = (const char*)g.Bt + (size_t)cur.pn * tstep;
    S.a_ready(cur);
    if constexpr (SP2) {
        PG8_STAGE(PG8_SB(0, 0), cB, voffB); PG8_STAGE(PG8_SB(0, 1), cB + hstep, voffB); PG8_STAGE(PG8_SA(0, 0), cA, voffA); PG8_STAGE(PG8_SA(0, 1), cA + hstep, voffA);
        if (wr == 1) PG8_BAR;
        PG8_WAIT_V(2); PG8_BAR;
        PG8_STAGE(PG8_SB(1, 0), cB + kstep, voffB); PG8_STAGE(PG8_SA(1, 0), cA + kstep, voffA); PG8_STAGE(PG8_SB(1, 1), cB + hstep + kstep, voffB);
        PG8_WAIT_V(6); PG8_BAR;
    } else {
        PG8_STAGE(PG8_SB(0, 0), cB, voffB); PG8_STAGE(PG8_SA(0, 0), cA, voffA); PG8_STAGE(PG8_SB(0, 1), cB + hstep, voffB); PG8_STAGE(PG8_SA(0, 1), cA + hstep, voffA);
        if (wr == 1) PG8_BAR;
        PG8_WAIT_V(4); PG8_BAR;
        PG8_STAGE(PG8_SB(1, 0), cB + kstep, voffB); PG8_STAGE(PG8_SA(1, 0), cA + kstep, voffA); PG8_STAGE(PG8_SB(1, 1), cB + hstep + kstep, voffB);
        PG8_WAIT_V(6); PG8_BAR;
    }
    for (;;) {
        const bool has_next = S.next(ui + 1, nxt);
        const char* nA = has_next ? (const char*)g.A + (size_t)nxt.pm * tstep : cA; const char* nB = has_next ? (const char*)g.Bt + (size_t)nxt.pn * tstep : cB;
        for (int t = 0; t < nt; t += 2) {
            const bool last = (t == nt - 2);
            const char* a1 = cA + (size_t)(t + 1) * kstep;
            const char* a2 = last ? nA : cA + (size_t)(t + 2) * kstep; const char* b2 = last ? nB : cB + (size_t)(t + 2) * kstep;
            const char* a3 = a2 + kstep; const char* b3 = b2 + kstep;
            if (last && has_next) S.a_ready(nxt);
            if constexpr (SP2) {
            PG8_LDB(B0, 0, 0); PG8_LDB(B1, 0, 1); PG8_SCHED; PG8_LDA(At, 0, 0); PG8_STAGE(PG8_SA(1, 1), a1 + hstep, voffA);
            PG8_WAIT_V(8); PG8_WAIT_L(0); PG8_BAR; PG8_MMA(0, 0, At, B0); PG8_MMA(0, 1, At, B1); PG8_BAR; PG8_SCHED;
            PG8_LDA(At, 0, 1); PG8_STAGE(PG8_SB(0, 0), b2, voffB); PG8_STAGE(PG8_SB(0, 1), b2 + hstep, voffB); PG8_STAGE(PG8_SA(0, 0), a2, voffA);
            PG8_WAIT_V(8); PG8_WAIT_L(0); PG8_BAR; PG8_MMA(1, 0, At, B0); PG8_MMA(1, 1, At, B1); PG8_BAR; PG8_SCHED;
            PG8_LDB(B0, 1, 0); PG8_LDB(B1, 1, 1); PG8_SCHED; PG8_LDA(At, 1, 0); PG8_STAGE(PG8_SA(0, 1), a2 + hstep, voffA);
            PG8_WAIT_V(8); PG8_WAIT_L(0); PG8_BAR; PG8_MMA(0, 0, At, B0); PG8_MMA(0, 1, At, B1); PG8_BAR; PG8_SCHED;
            PG8_LDA(At, 1, 1); PG8_STAGE(PG8_SB(1, 0), b3, voffB); PG8_STAGE(PG8_SB(1, 1), b3 + hstep, voffB); PG8_STAGE(PG8_SA(1, 0), a3, voffA);
            PG8_WAIT_V(8); PG8_WAIT_L(0); PG8_BAR; PG8_MMA(1, 0, At, B0); PG8_MMA(1, 1, At, B1); PG8_BAR; PG8_SCHED;
            } else {
            PG8_LDB(B0, 0, 0); PG8_SCHED; PG8_LDA(At, 0, 0); PG8_STAGE(PG8_SA(1, 1), a1 + hstep, voffA);
            PG8_WAIT_L(8); PG8_BAR; PG8_WAIT_L(0); PG8_MMA(0, 0, At, B0); PG8_BAR; PG8_SCHED;
            PG8_LDB(B1, 0, 1); PG8_STAGE(PG8_SB(0, 0), b2, voffB);
            PG8_BAR; PG8_WAIT_L(0); PG8_MMA(0, 1, At, B1); PG8_BAR;
            PG8_LDA(At, 0, 1); PG8_STAGE(PG8_SA(0, 0), a2, voffA);
            PG8_BAR; PG8_WAIT_L(0); PG8_MMA(1, 0, At, B0); PG8_BAR; PG8_SCHED;
            PG8_STAGE(PG8_SB(0, 1), b2 + hstep, voffB);
            PG8_WAIT_V(6); PG8_BAR; PG8_MMA(1, 1, At, B1); PG8_BAR;
            PG8_LDB(B0, 1, 0); PG8_SCHED; PG8_LDA(At, 1, 0); PG8_STAGE(PG8_SA(0, 1), a2 + hstep, voffA);
            PG8_WAIT_L(8); PG8_BAR; PG8_WAIT_L(0); PG8_MMA(0, 0, At, B0); PG8_BAR; PG8_SCHED;
            PG8_LDB(B1, 1, 1); PG8_STAGE(PG8_SB(1, 0), b3, voffB);
            PG8_BAR; PG8_WAIT_L(0); PG8_MMA(0, 1, At, B1); PG8_BAR;
            PG8_LDA(At, 1, 1); PG8_STAGE(PG8_SA(1, 0), a3, voffA);
            PG8_BAR; PG8_WAIT_L(0); PG8_MMA(1, 0, At, B0); PG8_BAR; PG8_SCHED;
            PG8_STAGE(PG8_SB(1, 1), b3 + hstep, voffB);
            PG8_WAIT_V(6); PG8_BAR; PG8_MMA(1, 1, At, B1); PG8_BAR;
            }
        }
        if constexpr (ALIGN_EPI) { if (wr == 0) PG8_BAR; }
        if constexpr (!Epi::AFTER_DRAIN) { E(acc, cur, wr, wc, fr, fq); S.done(cur); }
        if (!has_next) break;
#pragma unroll
        for (int a = 0; a < 2; ++a)
#pragma unroll
            for (int b = 0; b < 2; ++b)
#pragma unroll
                for (int m = 0; m < 4; ++m)
#pragma unroll
                    for (int n = 0; n < 2; ++n) acc[a][b][m][n] = (f32x4){0.f, 0.f, 0.f, 0.f};
        cur = nxt; cA = nA; cB = nB; ++ui;
        if constexpr (ALIGN_EPI) { if (wr == 1) PG8_BAR; }
    }
    PG8_WAIT_V(0);
    if constexpr (!ALIGN_EPI) { if (wr == 0) PG8_BAR; }
    PG8_BAR;
    if constexpr (Epi::AFTER_DRAIN) { E.fused(acc, cur, wr, wc, fr, fq, lds, wid, lane); S.done(cur); }
#undef PG8_SA
#undef PG8_SB
#undef PG8_STAGE
#undef PG8_LDA
#undef PG8_LDB
#undef PG8_MMA
#undef PG8_WAIT_V
#undef PG8_WAIT_L
#undef PG8_BAR
#undef PG8_SCHED
}
}
#include <hip/hip_bf16.h>
#include <cmath>
namespace attn_body {
using bf16=__hip_bfloat16;
using bf16x8=__attribute__((ext_vector_type(8)))short;
using s16x4=__attribute__((ext_vector_type(4)))short;
using f32x16=__attribute__((ext_vector_type(16)))float;
using u32x4=__attribute__((ext_vector_type(4)))unsigned;
constexpr int ASEQ=8448,D=64;
constexpr int QP=512,KP=512,VP=7424,OP=1024;
constexpr int NW=8,QBLK=32,QB=QBLK*NW,KVBLK=64,NQB=ASEQ/QB;
constexpr int ATTN_UNIT_ROWS=QB;
__device__ __forceinline__ int crow(int r,int hi){return (r&3)+8*(r>>2)+4*hi;}
#define SBAR() __builtin_amdgcn_sched_barrier(0)
constexpr int BT_OFF=383, BT_N=640;
__device__ __forceinline__ void bmask(f32x16&p0,f32x16&p1,int t,int q0,int wid,int r32,int hi,const __attribute__((address_space(3))) float*tab){
  const float NEG=-INFINITY; const int qw=q0+32*wid;
  if(t>(qw>>6)){
    #pragma unroll
    for(int r=0;r<16;++r){p0[r]=NEG;p1[r]=NEG;} return; }
  if(t>0 && 64*t+63+91<=qw) return;
  const int q=qw+r32, kb=64*t+4*hi;
  #pragma unroll
  for(int r=0;r<16;++r){ const int kv=kb+(r&3)+8*(r>>2); int i0=kv-q+BT_OFF, i1=i0+32; i0=i0<0?0:i0; i1=i1<0?0:i1;
    p0[r]+=tab[i0]; p1[r]+=tab[i1]; if(kv<48)p0[r]=NEG; if(kv+32<48)p1[r]=NEG; }
}

constexpr int NSLOT=3, SLOTB=8192;
constexpr int LDS_K=0, LDS_V=NSLOT*SLOTB, LDS_WS=2*NSLOT*SLOTB, LDS_OST=LDS_WS+NW*64*4, LDS_BT=LDS_OST+NW*4096, LDS_BYTES=LDS_BT+BT_N*4;
constexpr float C2=0.125f*1.4426950408889634f;
__device__ __forceinline__ void glds16(const void*gsrc,unsigned lds_dst){unsigned keep;
  asm volatile("s_mov_b32 %0, m0\n\ts_mov_b32 m0, %2\n\ts_nop 0\n\tglobal_load_lds_dwordx4 %1, off\n\ts_mov_b32 m0, %0":"=&s"(keep):"v"(gsrc),"s"(lds_dst):"memory");}
__device__ __forceinline__ float max3f(float a,float b,float c){float r;asm("v_max3_f32 %0, %1, %2, %3":"=v"(r):"v"(a),"v"(b),"v"(c));return r;}
__device__ __forceinline__ float max2f(float a,float b){float r;asm("v_max_f32_e32 %0, %1, %2":"=v"(r):"v"(a),"v"(b));return r;}
__device__ __forceinline__ float fadd_s(float a,float b){float r;asm("v_add_f32_e32 %0, %1, %2":"=v"(r):"v"(a),"v"(b));return r;}
__device__ __forceinline__ float fsub_s(float a,float b){float r;asm("v_sub_f32_e32 %0, %1, %2":"=v"(r):"v"(a),"v"(b));return r;}
typedef float f32x2_t __attribute__((ext_vector_type(2))); typedef __bf16 bf16x2_t __attribute__((ext_vector_type(2)));
__device__ __forceinline__ unsigned cvtpk_s(float lo,float hi){f32x2_t v={lo,hi};bf16x2_t b=__builtin_convertvector(v,bf16x2_t);return __builtin_bit_cast(unsigned,b);}
#define WAIT_BAR(N) asm volatile("s_waitcnt vmcnt(" #N ") lgkmcnt(0)\n\ts_barrier":::"memory")

__device__ __forceinline__ void qkt(f32x16&p0,f32x16&p1,const char*Kslot,const bf16x8*qr,const f32x16&negm,int r32,int hi){
  const char*kb=Kslot+hi*1024+r32*16;
  #pragma unroll
  for(int d0=0;d0<4;++d0){
    const bf16x8 b0=*reinterpret_cast<const bf16x8*>(kb+d0*2048);
    const bf16x8 b1=*reinterpret_cast<const bf16x8*>(kb+d0*2048+512);
    if(d0==0){p0=__builtin_amdgcn_mfma_f32_32x32x16_bf16(b0,qr[0],negm,0,0,0);p1=__builtin_amdgcn_mfma_f32_32x32x16_bf16(b1,qr[0],negm,0,0,0);}
    else{p0=__builtin_amdgcn_mfma_f32_32x32x16_bf16(b0,qr[d0],p0,0,0,0);p1=__builtin_amdgcn_mfma_f32_32x32x16_bf16(b1,qr[d0],p1,0,0,0);}}
}
typedef __attribute__((address_space(3))) const char* lds_cptr;
typedef __attribute__((address_space(3))) const float* lds_cfptr;
typedef short v4i16_t __attribute__((ext_vector_type(4)));
__device__ __forceinline__ void kload8(bf16x8*kf,lds_cptr kp){
  kf[0]=*(const __attribute__((address_space(3))) bf16x8*)(kp);      kf[1]=*(const __attribute__((address_space(3))) bf16x8*)(kp+512);
  kf[2]=*(const __attribute__((address_space(3))) bf16x8*)(kp+2048); kf[3]=*(const __attribute__((address_space(3))) bf16x8*)(kp+2560);
  kf[4]=*(const __attribute__((address_space(3))) bf16x8*)(kp+4096); kf[5]=*(const __attribute__((address_space(3))) bf16x8*)(kp+4608);
  kf[6]=*(const __attribute__((address_space(3))) bf16x8*)(kp+6144); kf[7]=*(const __attribute__((address_space(3))) bf16x8*)(kp+6656);
}
__device__ __forceinline__ void kload2(bf16x8*kf,lds_cptr kp,int j){ kf[2*j]=*(const __attribute__((address_space(3))) bf16x8*)(kp+j*2048); kf[2*j+1]=*(const __attribute__((address_space(3))) bf16x8*)(kp+j*2048+512); }
__device__ __forceinline__ s16x4 vtr(lds_cptr p){ return __builtin_bit_cast(s16x4,__builtin_amdgcn_ds_read_tr16_b64_v4i16((__attribute__((address_space(3))) v4i16_t*)p)); }
__device__ __forceinline__ float rowmax(const f32x16&p0,const f32x16&p1){
  float a=max3f(p0[0],p0[1],p1[0]),b=max3f(p0[2],p0[3],p1[1]);a=max3f(a,p1[2],p1[3]);
  #pragma unroll
  for(int r=4;r<16;r+=4){a=max3f(a,p0[r],p0[r+1]);b=max3f(b,p0[r+2],p0[r+3]);a=max3f(a,p1[r],p1[r+1]);b=max3f(b,p1[r+2],p1[r+3]);}
  const float m=max2f(a,b);
  auto rr=__builtin_amdgcn_permlane32_swap(__float_as_uint(m),__float_as_uint(m),false,false);
  return max2f(__uint_as_float(rr[0]),__uint_as_float(rr[1]));
}
__device__ __forceinline__ void pv(f32x16*o,int vb,bf16x8 pa0,bf16x8 pa1,bf16x8 pa2,bf16x8 pa3){
  #pragma unroll
  for(int d0=0;d0<2;++d0){s16x4 lo[4],hi[4];
    #pragma unroll
    for(int ks=0;ks<4;++ks){
      asm volatile("ds_read_b64_tr_b16 %0,%1 offset:%c2":"=&v"(lo[ks]):"v"(vb),"i"(d0*4096+ks*1024):"memory");
      asm volatile("ds_read_b64_tr_b16 %0,%1 offset:%c2":"=&v"(hi[ks]):"v"(vb),"i"(d0*4096+ks*1024+512):"memory");}
    asm volatile("s_waitcnt lgkmcnt(0)":::"memory");SBAR();
    #define PK(k) (bf16x8){lo[k][0],lo[k][1],lo[k][2],lo[k][3],hi[k][0],hi[k][1],hi[k][2],hi[k][3]}
    o[d0]=__builtin_amdgcn_mfma_f32_32x32x16_bf16(pa0,PK(0),o[d0],0,0,0);
    o[d0]=__builtin_amdgcn_mfma_f32_32x32x16_bf16(pa1,PK(1),o[d0],0,0,0);
    o[d0]=__builtin_amdgcn_mfma_f32_32x32x16_bf16(pa2,PK(2),o[d0],0,0,0);
    o[d0]=__builtin_amdgcn_mfma_f32_32x32x16_bf16(pa3,PK(3),o[d0],0,0,0);
    #undef PK
  }
}

#ifndef ATTN_STORE16
#define ATTN_STORE16(p,v) (*(u32x4*)(p)=(v))
#endif
template<int THRL> __device__ __forceinline__ void attn_unit(int b,int qoff,int voff,int ooff,int qb,const bf16*Q,const bf16*__restrict__ K,const bf16*__restrict__ V,bf16*O,char*shm,int wv){
  unsigned om_ = ~0u; asm volatile("" : "+s"(om_), "+s"(wv)); int tid_ = wv * 64 + (int)__builtin_amdgcn_mbcnt_hi(om_, __builtin_amdgcn_mbcnt_lo(om_, 0u)); const int tid=tid_,lane=tid&63,r32=lane&31,hi=lane>>5; const int wid=__builtin_amdgcn_readfirstlane(tid>>6);
  const long rowbase=(long)b*ASEQ; const int q0=qb*QB;
  const bf16*Qw=Q+(rowbase+q0+wid*QBLK)*QP+qoff;
  const bf16*Kh=K+rowbase*KP+qoff,*Vh=V+rowbase*VP+voff;
  const unsigned lds0=(unsigned)(uintptr_t)shm;
  float*wsf=(float*)(shm+LDS_WS)+wid*64;
  const bf16*ksrc=Kh+(long)lane*KP+wid*8;
  const bf16*vsrc=Vh+(long)(16*(wid&3)+(lane>>2))*VP+(wid>>2)*32+(lane&3)*8;
  const unsigned kdst=lds0+LDS_K+wid*1024, vdst=lds0+LDS_V+wid*1024;
  #define DMA_K(t,slot) glds16(ksrc+(long)(t)*KVBLK*KP,(unsigned)__builtin_amdgcn_readfirstlane(kdst+(slot)))
  #define DMA_V(t,slot) glds16(vsrc+(long)(t)*KVBLK*VP,(unsigned)__builtin_amdgcn_readfirstlane(vdst+(slot)))
  const int vb0=(int)(lds0+LDS_V)+((lane>>4)&1)*32+(lane&3)*8+(4*hi+((lane&15)>>2))*64;
  const char*Kbase=shm+LDS_K; bf16x8 kf[8];
  const lds_cptr shm3=(lds_cptr)shm; const lds_cfptr btab=(lds_cfptr)(shm3+LDS_BT); const lds_cptr kp0=shm3+LDS_K+hi*1024+r32*16; const lds_cptr vp0=shm3+LDS_V+((lane>>4)&1)*32+(lane&3)*8+(4*hi+((lane&15)>>2))*64;
  const int NTL=(q0+QB)/KVBLK;
  DMA_K(0,0);DMA_V(0,0);DMA_K(1,SLOTB);
  bf16x8 qr[4];
  #pragma unroll
  for(int d0=0;d0<4;++d0)qr[d0]=*reinterpret_cast<const bf16x8*>(&Qw[(long)r32*QP+d0*16+hi*8]);
  float mhat=0.f,l_reg=0.f;f32x16 o[2];o[0]=f32x16{};o[1]=f32x16{};const f32x16 zt=f32x16{};
  const int qrel=wid*QBLK+r32;
  #define CMASK(P0,P1,t) bmask(P0,P1,(t),q0,wid,r32,hi,btab)
  bool resc=false;
  #define START(P0,P1) do{ const float rm=rowmax(P0,P1); resc=false; \
    { const float dl=rm; mhat=fadd_s(mhat,dl); \
      _Pragma("unroll") for(int r=0;r<16;++r){P0[r]=fsub_s(P0[r],dl);P1[r]=fsub_s(P1[r],dl);} \
      } \
    _Pragma("unroll") for(int r=0;r<16;++r)P0[r]=__builtin_amdgcn_exp2f(P0[r]); }while(0)
  #define RESC() do{ if(resc){ asm volatile("s_waitcnt lgkmcnt(0)":::"memory"); \
      _Pragma("unroll") for(int d_=0;d_<2;++d_) _Pragma("unroll") for(int r=0;r<16;++r)o[d_][r]*=wsf[crow(r,hi)]; } }while(0)
  f32x16 pA0,pA1,pB0,pB1;
  int sl_prev=0,sl_cur=0,sl_next=SLOTB;
  #define ROT() do{sl_prev=sl_cur;sl_cur=sl_next;sl_next=(sl_next==(NSLOT-1)*SLOTB)?0:sl_next+SLOTB;}while(0)
  DMA_K(2,2*SLOTB);
  WAIT_BAR(3);
  qkt(pA0,pA1,Kbase,qr,zt,r32,hi);asm volatile("s_nop 15\n\ts_nop 7":"+v"(pA0),"+v"(pA1));CMASK(pA0,pA1,0);
  START(pA0,pA1);
  _Pragma("unroll") for(int r=0;r<16;++r)pA1[r]=__builtin_amdgcn_exp2f(pA1[r]);
  WAIT_BAR(0);
  DMA_K(3,0);DMA_V(1,SLOTB);
  ROT();
  kload8(kf,kp0+sl_cur);
  WAIT_BAR(2);
  s16x4 vlo[8],vhi[8]; u32x4 pw0,pw1,pw2,pw3;
  #define PKW(P,B) cvtpk_s(P[B],P[B+1])
  #define PAF(k) __builtin_bit_cast(bf16x8,pw##k)
  #define VFR(i) (bf16x8){vlo[i][0],vlo[i][1],vlo[i][2],vlo[i][3],vhi[i][0],vhi[i][1],vhi[i][2],vhi[i][3]}
  #define PIN(x) asm volatile("":"+v"(x))
  #define MX3(a,b,c) __builtin_fmaxf(__builtin_fmaxf((a),(b)),(c))
  #define GAPA(MF,A0,A1,A2,A3,W0,W1,PW) do{ MF; sacc+=A0; sacc+=A1; sacc+=A2; sacc+=A3; PIN(sacc); W0; W1; PIN(PW); SBAR(); }while(0)
  #define EX(v) __builtin_amdgcn_exp2f(v)
  #define GAPB(MF,X,B) do{ MF; X[B]=EX(X[B]); X[B+1]=EX(X[B+1]); X[B+2]=EX(X[B+2]); X[B+3]=EX(X[B+3]); PIN(X); SBAR(); }while(0)
  #define VRD(i) do{ vlo[i]=vtr(vp_+(((i)>>2)*4096+((i)&3)*1024)); vhi[i]=vtr(vp_+(((i)>>2)*4096+((i)&3)*1024+512)); }while(0)
  #define KRD(G,j) do{ if(G){ kload2(kf,kp0+sl_next,j); SBAR(); } }while(0)
  #define STEP(C0,C1,P0,P1,t,GK,GV,GL) do{ SBAR(); \
    const lds_cptr vp_=vp0+sl_prev; \
    VRD(0); SBAR(); float sacc=(P0[0]+P0[1]); \
    GAPA(C0=__builtin_amdgcn_mfma_f32_32x32x16_bf16(kf[0],qr[0],zt,0,0,0), P0[2],P0[3],P0[4],P0[5],     pw0[0]=PKW(P0,0), pw0[1]=PKW(P0,2), pw0); \
    VRD(4); SBAR(); GAPA(C1=__builtin_amdgcn_mfma_f32_32x32x16_bf16(kf[1],qr[0],zt,0,0,0), P0[6],P0[7],P0[8],P0[9],     pw0[2]=PKW(P0,4), pw0[3]=PKW(P0,6), pw0); \
    VRD(1); SBAR(); GAPA(C0=__builtin_amdgcn_mfma_f32_32x32x16_bf16(kf[2],qr[1],C0,0,0,0),   P0[10],P0[11],P0[12],P0[13], pw1[0]=PKW(P0,8), pw1[1]=PKW(P0,10), pw1); \
    VRD(5); SBAR(); GAPA(C1=__builtin_amdgcn_mfma_f32_32x32x16_bf16(kf[3],qr[1],C1,0,0,0),   P0[14],P0[15],P1[0],P1[1],   pw1[2]=PKW(P0,12),pw1[3]=PKW(P0,14), pw1); \
    VRD(2); SBAR(); GAPA(C0=__builtin_amdgcn_mfma_f32_32x32x16_bf16(kf[4],qr[2],C0,0,0,0),   P1[2],P1[3],P1[4],P1[5],     pw2[0]=PKW(P1,0), pw2[1]=PKW(P1,2), pw2); \
    VRD(6); SBAR(); GAPA(C1=__builtin_amdgcn_mfma_f32_32x32x16_bf16(kf[5],qr[2],C1,0,0,0),   P1[6],P1[7],P1[8],P1[9],     pw2[2]=PKW(P1,4), pw2[3]=PKW(P1,6), pw2); \
    VRD(3); SBAR(); GAPA(C0=__builtin_amdgcn_mfma_f32_32x32x16_bf16(kf[6],qr[3],C0,0,0,0),   P1[10],P1[11],P1[12],P1[13], pw3[0]=PKW(P1,8), pw3[1]=PKW(P1,10), pw3); \
    VRD(7); SBAR(); GAPA(C1=__builtin_amdgcn_mfma_f32_32x32x16_bf16(kf[7],qr[3],C1,0,0,0),   P1[14],P1[15],0.f,0.f,       pw3[2]=PKW(P1,12),pw3[3]=PKW(P1,14), pw3); \
    l_reg+=sacc; \
    if(GK){DMA_K((t)+3,sl_cur);} if(GV){DMA_V((t)+1,sl_next);} \
    _Pragma("unroll") for(int r=0;r<16;++r){C0[r]-=mhat;C1[r]-=mhat;} \
    CMASK(C0,C1,t); \
    { float a=MX3(C0[0],C0[1],C1[0]),b=MX3(C0[2],C0[3],C1[1]); a=MX3(a,C1[2],C1[3]); \
      _Pragma("unroll") for(int r=4;r<16;r+=4){a=MX3(a,C0[r],C0[r+1]);b=MX3(b,C0[r+2],C0[r+3]);a=MX3(a,C1[r],C1[r+1]);b=MX3(b,C1[r+2],C1[r+3]);} \
      float rm=__builtin_fmaxf(a,b); { auto rr=__builtin_amdgcn_permlane32_swap(__float_as_uint(rm),__float_as_uint(rm),false,false); rm=__builtin_fmaxf(__uint_as_float(rr[0]),__uint_as_float(rr[1])); } \
      resc=false; \
      if(__builtin_expect(__any(rm>(float)THRL),0)){ const float dl=__builtin_fmaxf(rm,0.f); mhat+=dl; \
        _Pragma("unroll") for(int r=0;r<16;++r){C0[r]-=dl;C1[r]-=dl;} \
        const float f=__builtin_amdgcn_exp2f(-dl); l_reg*=f; if(hi==0)wsf[r32]=f; resc=true; } } \
    SBAR(); \
    GAPB(o[0]=__builtin_amdgcn_mfma_f32_32x32x16_bf16(PAF(0),VFR(0),o[0],0,0,0), C0,0); \
    GAPB(o[1]=__builtin_amdgcn_mfma_f32_32x32x16_bf16(PAF(0),VFR(4),o[1],0,0,0), C0,4); \
    KRD(GL,0); GAPB(o[0]=__builtin_amdgcn_mfma_f32_32x32x16_bf16(PAF(1),VFR(1),o[0],0,0,0), C0,8); \
    KRD(GL,1); GAPB(o[1]=__builtin_amdgcn_mfma_f32_32x32x16_bf16(PAF(1),VFR(5),o[1],0,0,0), C0,12); \
    KRD(GL,2); GAPB(o[0]=__builtin_amdgcn_mfma_f32_32x32x16_bf16(PAF(2),VFR(2),o[0],0,0,0), C1,0); \
    KRD(GL,3); GAPB(o[1]=__builtin_amdgcn_mfma_f32_32x32x16_bf16(PAF(2),VFR(6),o[1],0,0,0), C1,4); \
    GAPB(o[0]=__builtin_amdgcn_mfma_f32_32x32x16_bf16(PAF(3),VFR(3),o[0],0,0,0), C1,8); \
    GAPB(o[1]=__builtin_amdgcn_mfma_f32_32x32x16_bf16(PAF(3),VFR(7),o[1],0,0,0), C1,12); \
    }while(0)
  int t=1;
  #undef CMASK
  #define CMASK(P0,P1,t) do{}while(0)
  for(;t+7<NTL;t+=2){
    STEP(pB0,pB1,pA0,pA1,t,true,true,true);     WAIT_BAR(2); RESC(); ROT();
    STEP(pA0,pA1,pB0,pB1,t+1,true,true,true);   WAIT_BAR(2); RESC(); ROT();
  }
  #undef CMASK
  #define CMASK(P0,P1,t) bmask(P0,P1,(t),q0,wid,r32,hi,btab)
  #define ENDW(tt) do{ if((tt)+3<NTL){WAIT_BAR(2);} else if((tt)+2<NTL){WAIT_BAR(1);} else {WAIT_BAR(0);} }while(0)
  for(;t+1<NTL;t+=2){
    STEP(pB0,pB1,pA0,pA1,t,(t+3<NTL),(t+1<NTL),(t+1<NTL));       ENDW(t);   RESC(); ROT();
    STEP(pA0,pA1,pB0,pB1,t+1,(t+4<NTL),(t+2<NTL),(t+2<NTL));     ENDW(t+1); RESC(); ROT();
  }
  STEP(pB0,pB1,pA0,pA1,NTL-1,false,false,false); RESC();
  { float sacc=pB0[0]+pB0[1]; _Pragma("unroll") for(int r=2;r<16;++r)sacc+=pB0[r]; _Pragma("unroll") for(int r=0;r<16;++r)sacc+=pB1[r]; l_reg+=sacc;
    pw0=(u32x4){PKW(pB0,0),PKW(pB0,2),PKW(pB0,4),PKW(pB0,6)};pw1=(u32x4){PKW(pB0,8),PKW(pB0,10),PKW(pB0,12),PKW(pB0,14)};pw2=(u32x4){PKW(pB1,0),PKW(pB1,2),PKW(pB1,4),PKW(pB1,6)};pw3=(u32x4){PKW(pB1,8),PKW(pB1,10),PKW(pB1,12),PKW(pB1,14)};
    SBAR(); pv(o,vb0+sl_cur,PAF(0),PAF(1),PAF(2),PAF(3)); }
  #undef PKW
  #undef PAF
  #undef VFR
  #undef PIN
  #undef MX3
  #undef GAPA
  #undef GAPB
  #undef EX
  #undef VRD
  #undef KRD
  #undef STEP
  #undef ENDW
  {auto rr=__builtin_amdgcn_permlane32_swap(__float_as_uint(l_reg),__float_as_uint(l_reg),false,false);l_reg=__uint_as_float(rr[0])+__uint_as_float(rr[1]);}
  if(hi==0)wsf[32+r32]=l_reg;asm volatile("s_waitcnt lgkmcnt(0)":::"memory");
  float rli[16];
  #pragma unroll
  for(int r=0;r<16;++r)rli[r]=__builtin_amdgcn_rcpf(wsf[32+crow(r,hi)]);
  bf16*Ow=O+(rowbase+q0+wid*QBLK)*OP+ooff;
  { bf16*stg=(bf16*)(shm+LDS_OST)+wid*2048;
    #pragma unroll
    for(int r=0;r<16;++r){const int orow=crow(r,hi);
      #pragma unroll
      for(int d0=0;d0<2;++d0)stg[orow*64+d0*32+r32]=__float2bfloat16(o[d0][r]*rli[r]);}
    asm volatile("s_waitcnt lgkmcnt(0)":::"memory");
    #pragma unroll
    for(int i=0;i<4;++i){const int row=i*8+(lane>>3),ch=lane&7; const u32x4 v=*(const u32x4*)(stg+row*64+ch*8); ATTN_STORE16(Ow+(long)row*OP+ch*8,v);} }
  asm volatile("s_waitcnt lgkmcnt(0)\n\ts_barrier":::"memory");
  #undef DMA_K
  #undef DMA_V
  #undef CMASK
  #undef START
  #undef RESC
  #undef ROT
}
constexpr int ATTN_LDS_BYTES=LDS_BYTES;
#undef SBAR
#undef WAIT_BAR
#undef WAIT_BAR
}
namespace mk {
#define GAS __attribute__((address_space(1)))
#define LAS __attribute__((address_space(3)))
typedef unsigned short bf16;
typedef unsigned v4u __attribute__((ext_vector_type(4)));
typedef unsigned v2u __attribute__((ext_vector_type(2)));
typedef float f32x4 __attribute__((ext_vector_type(4)));
typedef float f32x16 __attribute__((ext_vector_type(16)));
typedef short bf16x8 __attribute__((ext_vector_type(8)));
typedef GAS unsigned gu32;
#define RLX_AGENT __ATOMIC_RELAXED, __HIP_MEMORY_SCOPE_AGENT
#define LDS_WAIT() asm volatile("s_waitcnt lgkmcnt(0)" ::: "memory")
#define VM_WAIT() asm volatile("s_waitcnt vmcnt(0)" ::: "memory")
typedef float f32x2_cv __attribute__((ext_vector_type(2))); typedef __bf16 bf16x2_cv __attribute__((ext_vector_type(2)));
__device__ __forceinline__ unsigned pk2(float lo, float hi) { const f32x2_cv v = {lo, hi}; return __builtin_bit_cast(unsigned, __builtin_convertvector(v, bf16x2_cv)); }
__device__ __forceinline__ unsigned f2bf(float f) { return pk2(f, 0.f) & 0xffffu; }
__device__ __forceinline__ float bf2f(unsigned short b) { return __builtin_bit_cast(float, ((unsigned)b) << 16); }
__device__ __forceinline__ float bflo(unsigned w) { return __builtin_bit_cast(float, w << 16); }
__device__ __forceinline__ float bfhi(unsigned w) { return __builtin_bit_cast(float, w & 0xffff0000u); }

constexpr int NWAVES = 8, NTHR = NWAVES * 64;
constexpr int PADF = 48;
constexpr int LPP = 8448;
constexpr int PEND = PADF + LP;
constexpr int SROW0 = BATCH * LPP;
constexpr int RP = SROW0 + NS;
constexpr int ZN = 7424;
constexpr int ZC_QA = 0, ZC_KA = 512, ZC_VA = 1024, ZC_QKVB = 1536, ZC_GB = 3072, ZC_UC = 3584, ZC_GATE = 4096, ZC_BA = 7168;
static_assert(RP % 256 == 0 && ZN % 256 == 0 && D_MODEL == 1024 && WIDTH_A == 512 && WIDTH_B == 512 && WIDTH_C == 512, "shapes");
__host__ __device__ __forceinline__ int nat2prow(int row) { return row < NP ? (row / LP) * LPP + PADF + row % LP : SROW0 + (row - NP); }
__host__ __device__ __forceinline__ int zcol(int col) { return col < 3584 ? col : (col < 3592 ? ZC_BA + (col - 3584) : col - 8); }
__device__ __forceinline__ bool prow_valid(int prow) { if (prow >= SROW0) return true; const int p = prow % LPP; return p >= PADF && p < PEND; }
__device__ __forceinline__ int prow2nat(int prow) { if (prow >= SROW0) return NP + (prow - SROW0); return (prow / LPP) * LP + (prow % LPP) - PADF; }

constexpr int RING_OFF = 0, RING_BYTES = 147456;
constexpr int LDSCTL_OFF = RING_BYTES, MISC_OFF = LDSCTL_OFF + 320;
constexpr int LDS_BYTES = RING_BYTES + 1024;
static_assert(MISC_OFF + 128 <= LDS_BYTES, "LDS map");

constexpr size_t CTL_BYTES = 1u << 20;
constexpr int CW_TMO = 0, CW_CODE = 1;
constexpr int CW_BAR = 4096;
constexpr int CW_QUEUE = 16384;
constexpr int CW_GDNFLAG = 32768;

__device__ __forceinline__ int lane_id() { return (int)__builtin_amdgcn_mbcnt_hi(~0u, __builtin_amdgcn_mbcnt_lo(~0u, 0u)); }
#define XB_TMO      128
#define XB_XCNT(j)  (256  + 64 * (j))
#define XB_XSUB(j)  (1280 + 64 * (j))
#define XB_XGEN(j)  (2304 + 64 * (j))
#define XB_TOP      3328
#define XB_TOPGEN   3392
#define XCD_BAR_WORDS 3456
#define XB_SPIN_CAP (1u << 18)

__device__ __forceinline__ unsigned xb_ld(unsigned* p)              { return __hip_atomic_load(p, __ATOMIC_RELAXED, __HIP_MEMORY_SCOPE_AGENT); }
__device__ __forceinline__ unsigned xb_add(unsigned* p, unsigned v) { return __hip_atomic_fetch_add(p, v, __ATOMIC_RELAXED, __HIP_MEMORY_SCOPE_AGENT); }
__device__ __forceinline__ unsigned xb_xcc_id() { return (unsigned)__builtin_amdgcn_s_getreg((3 << 11) | 20) & 0xFu; }
#define XB_SPIN(cond, bar) do { unsigned _sp = 0; while (cond) { __builtin_amdgcn_s_sleep(1); \
    if ((++_sp & 255u) == 0u) { if (xb_ld(&(bar)[XB_TMO])) break; if (_sp > XB_SPIN_CAP) { atomicAdd(&(bar)[XB_TMO], 1u); break; } } } } while (0)

struct XcdBarrier {
    unsigned* bar; unsigned x; int wv;
    volatile LAS unsigned* st;
};

__device__ __forceinline__ XcdBarrier xcd_barrier_post(unsigned* bar, volatile LAS unsigned* st, int wv) {
    XcdBarrier b; b.bar = bar; b.x = xb_xcc_id(); b.st = st; b.wv = wv;
    if (wv == 0 && lane_id() == 0) (void)xb_add(&bar[XB_XCNT(b.x)], 1u);
    return b;
}
__device__ __forceinline__ void xcd_barrier_complete(unsigned* bar, unsigned x, unsigned& nloc, unsigned& nx) {
    const unsigned G = gridDim.x * gridDim.y * gridDim.z;
    unsigned sum, cnt, mine, sp = 0u;
    for (;;) {
        sum = 0u; cnt = 0u; mine = 0u;
#pragma unroll
        for (unsigned j = 0; j < 16; ++j) { const unsigned c = xb_ld(&bar[XB_XCNT(j)]); sum += c; cnt += (c > 0u) ? 1u : 0u; mine = (j == x) ? c : mine; }
        if (sum == G) break;
        __builtin_amdgcn_s_sleep(1);
        if ((++sp & 255u) == 0u) { if (xb_ld(&bar[XB_TMO])) break; if (sp > XB_SPIN_CAP) { atomicAdd(&bar[XB_TMO], 1u); break; } }
    }
    nloc = mine > 0u ? mine : 1u; nx = cnt > 0u ? cnt : 1u;
}

__device__ __forceinline__ void xcd_barrier(const XcdBarrier& b) {
    asm volatile("s_waitcnt vmcnt(0)" ::: "memory");
    __syncthreads();
    if (b.wv == 0 && lane_id() == 0) {
        unsigned* bar = b.bar;
        __builtin_amdgcn_s_waitcnt(0);
        unsigned nloc = b.st[0], nx = b.st[1];
        if (nloc == 0u) { xcd_barrier_complete(bar, b.x, nloc, nx); b.st[0] = nloc; b.st[1] = nx; }
        const unsigned old = xb_add(&bar[XB_XSUB(b.x)], 1u);
        const unsigned gen = old / nloc;
        if (old + 1u == (gen + 1u) * nloc) {
            __builtin_amdgcn_fence(__ATOMIC_RELEASE, "agent");
            asm volatile("s_waitcnt vmcnt(0)" ::: "memory");
            const unsigned og = xb_add(&bar[XB_TOP], 1u);
            const unsigned tg = og / nx;
            if (og + 1u == (tg + 1u) * nx) xb_add(&bar[XB_TOPGEN], 1u);
            else XB_SPIN(xb_ld(&bar[XB_TOPGEN]) == tg, bar);
            __builtin_amdgcn_fence(__ATOMIC_ACQUIRE, "agent");
            xb_add(&bar[XB_XGEN(b.x)], 1u);
            asm volatile("s_waitcnt vmcnt(0)" ::: "memory");
        } else {
            XB_SPIN(xb_ld(&bar[XB_XGEN(b.x)]) == gen, bar);
            __builtin_amdgcn_fence(__ATOMIC_ACQUIRE, "agent");
            asm volatile("s_waitcnt vmcnt(0)" ::: "memory");
        }
    }
    __syncthreads();
}


template <int CTRL> __device__ __forceinline__ float dpp_f(float v) { return __builtin_bit_cast(float, __builtin_amdgcn_update_dpp(0, __builtin_bit_cast(int, v), CTRL, 0xf, 0xf, true)); }
template <int CTRL> __device__ __forceinline__ int dpp_i(int v) { return __builtin_amdgcn_update_dpp(0, v, CTRL, 0xf, 0xf, true); }
template <int CTRL, int ROWMASK> __device__ __forceinline__ float dpp_fm(float v) { return __builtin_bit_cast(float, __builtin_amdgcn_update_dpp(0, __builtin_bit_cast(int, v), CTRL, ROWMASK, 0xf, false)); }
__device__ __forceinline__ float rdlane(float v, int i) { return __builtin_bit_cast(float, __builtin_amdgcn_readlane(__builtin_bit_cast(int, v), i)); }
__device__ __forceinline__ float sum8(float v) { v += dpp_f<0xB1>(v); v += dpp_f<0x4E>(v); v += dpp_f<0x141>(v); return v; }
__device__ __forceinline__ float sum16(float v) { v = sum8(v); v += dpp_f<0x140>(v); return v; }
__device__ __forceinline__ float wave_sum(float v) { v = sum16(v); return rdlane(v, 0) + rdlane(v, 16) + rdlane(v, 32) + rdlane(v, 48); }
__device__ __forceinline__ float wave_max(float v) {
    v = fmaxf(v, dpp_f<0xB1>(v)); v = fmaxf(v, dpp_f<0x4E>(v)); v = fmaxf(v, dpp_f<0x141>(v)); v = fmaxf(v, dpp_f<0x140>(v));
    return fmaxf(fmaxf(rdlane(v, 0), rdlane(v, 16)), fmaxf(rdlane(v, 32), rdlane(v, 48)));
}
__device__ __forceinline__ float scan64(float v) {
    v += dpp_f<0x111>(v); v += dpp_f<0x112>(v); v += dpp_f<0x114>(v); v += dpp_f<0x118>(v);
    v += dpp_fm<0x142, 0xA>(v); v += dpp_fm<0x143, 0xC>(v);
    return v;
}
__device__ __forceinline__ float swap32(float v) {
    const auto r = __builtin_amdgcn_permlane32_swap(__builtin_bit_cast(unsigned, v), __builtin_bit_cast(unsigned, v), false, false);
    return __builtin_bit_cast(float, (lane_id() & 32) ? r[0] : r[1]);
}
__device__ __forceinline__ float swap16(float v) {
    const auto r = __builtin_amdgcn_permlane16_swap(__builtin_bit_cast(unsigned, v), __builtin_bit_cast(unsigned, v), false, false);
    return __builtin_bit_cast(float, (lane_id() & 16) ? r[0] : r[1]);
}
}
namespace mk {
enum Region { R_X, R_XN, R_WIN, R_Z, R_QN, R_KN, R_QKVB, R_BG, R_O, R_OA, R_OB, R_YC, R_OC, R_MRG, R_WGLU, R_WBR, R_WOUT, R_WQS, R_PU, R_PV, R_SC, R_GDN, R_S5T, R_MISC, R_S5E, R_S5X, R_MRGB, R_OBN, R_MRG2, R_NREG };
constexpr int NPL = 16;
enum Phase { PH_PRO = 0, PL_NORM1 = 0, PL_GEMM_IN = 1, PL_ZPOST = 2, PL_LOCAL = 3, PL_MIX = 4, PL_MIXPOST = 5, PL_GEMM_GLU = 6, PL_GEMM_BRA = 7, PL_GEMM_BRB = 8, PL_GEMM_BRC = 9,
             PL_GEMM_OUT = 10, PL_NORM2 = 11, PL_GEMM_PEER = 12, PL_PEER = 13, PH_FINAL = 1 + DEPTH * NPL, PH_END = PH_FINAL + 1 };
enum ProMask { PM_NORM0 = 64, PM_X = 1, PM_WIN = 2, PM_WREST = 4, PM_PEERW = 8, PM_WQS = 16, PM_TABLES = 32 };
struct Args {
    const float* in[40];
    float* out;
    unsigned char* ws;
    unsigned long long off[32];
    int ph_lo, ph_hi, pro_mask, bar_region;
};
static_assert(sizeof(Args) == 40 * 8 + 8 + 8 + 32 * 8 + 16, "Args has no padding");

typedef const __attribute__((address_space(4))) Args* KArgs;
__device__ __forceinline__ KArgs kargs() { KArgs p = (KArgs)__builtin_amdgcn_kernarg_segment_ptr(); asm volatile("" : "+s"(p)); return p; }
__device__ __forceinline__ void assume_global(const void* p) {
#if defined(__HIP_DEVICE_COMPILE__)
    __builtin_assume(!__builtin_amdgcn_is_shared(p) && !__builtin_amdgcn_is_private(p));
#endif
}
#define GIN(a, i) ((const float*)(const GAS float*)(a).in[i])
#define GOUT(a) ((float*)(GAS float*)(a).out)
#define WS_OPAQUE(a) GAS unsigned char* wsg_ = (GAS unsigned char*)(a).ws; asm volatile("" : "+s"(wsg_)); unsigned char* wsb = (unsigned char*)wsg_
#define otid() otid_(F.wv)
__device__ __forceinline__ int otid_(int wv) { unsigned m = ~0u; asm volatile("" : "+s"(m), "+s"(wv));
    return wv * 64 + (int)__builtin_amdgcn_mbcnt_hi(m, __builtin_amdgcn_mbcnt_lo(m, 0u)); }
struct Frame {
    LAS unsigned char* lds; volatile LAS unsigned* MISC; gu32* ctl;
    int vcu, G, wv;
};

struct TrItem { f32x4 v[8]; };
template <class CM> __device__ __forceinline__ void tr_load(TrItem& t, const float* W, int ld, int n0, int k0, const CM& cm, int lane) {
    const int sc = cm(n0 + 4 * (lane & 7)), kr = lane >> 3;
    const GAS float* Wg = (const GAS float*)W;
#pragma unroll
    for (int i = 0; i < 8; ++i) t.v[i] = sc >= 0 ? *(const GAS f32x4*)(Wg + (size_t)(k0 + 8 * i + kr) * ld + sc) : (f32x4){0.f, 0.f, 0.f, 0.f};
}
__device__ __forceinline__ void tr_store(const TrItem& t, int K, bf16* WT, int n0, int k0, LAS float* scr, int lane) {
    { const int q = lane & 7, kr = lane >> 3;
#pragma unroll
      for (int i = 0; i < 8; ++i) { LAS float* d = scr + (8 * i + kr) * 33 + 4 * q; d[0] = t.v[i].x; d[1] = t.v[i].y; d[2] = t.v[i].z; d[3] = t.v[i].w; } }
    LDS_WAIT(); asm volatile("" ::: "memory");
    const int c = lane & 7;
#pragma unroll
    for (int j = 0; j < 4; ++j) { const int n = (lane >> 3) + 8 * j; const LAS float* s = scr + (8 * c) * 33 + n;
        v4u o; o.x = pk2(s[0 * 33], s[1 * 33]); o.y = pk2(s[2 * 33], s[3 * 33]); o.z = pk2(s[4 * 33], s[5 * 33]); o.w = pk2(s[6 * 33], s[7 * 33]);
        *(GAS v4u*)(WT + (size_t)(n0 + n) * K + k0 + 8 * c) = o; }
    LDS_WAIT(); asm volatile("" ::: "memory");
}
struct CmWin { __device__ __forceinline__ int operator()(int n) const { return n < 3584 ? n : (n < 7168 ? n + 8 : (n < 7176 ? 3584 + (n - 7168) : -1)); } };
struct CmId { __device__ __forceinline__ int operator()(int n) const { return n; } };
struct CmGlu { __device__ __forceinline__ int operator()(int n) const { const int G = n >> 5, i = n & 31; return i < 16 ? 16 * G + i : 512 + 16 * G + (i - 16); } };

__device__ __forceinline__ void rms_row_to_bf16(const float* xrow, const float* g, bf16* orow, int lane) {
    const GAS f32x4* xr = (const GAS f32x4*)xrow + lane;
    f32x4 v[4]; float s2 = 0.f;
#pragma unroll
    for (int j = 0; j < 4; ++j) { v[j] = xr[64 * j]; s2 += (v[j].x * v[j].x + v[j].y * v[j].y) + (v[j].z * v[j].z + v[j].w * v[j].w); }
    const float r = __builtin_amdgcn_rsqf(wave_sum(s2) * (1.f / D_MODEL) + EPSF);
    const GAS f32x4* gr = (const GAS f32x4*)g + lane;
    GAS unsigned long long* o8 = (GAS unsigned long long*)orow + lane;
#pragma unroll
    for (int j = 0; j < 4; ++j) { const f32x4 gg = gr[64 * j];
        o8[64 * j] = (unsigned long long)pk2(v[j].x * r * gg.x, v[j].y * r * gg.y) | ((unsigned long long)pk2(v[j].z * r * gg.z, v[j].w * r * gg.w) << 32); }
}

__device__ __forceinline__ void p_norm(Frame& F, int l, int gi) {
    const KArgs ap = kargs(); const auto& a = *ap; WS_OPAQUE(a);
    const int tid = otid(), lane = tid & 63, wave = __builtin_amdgcn_readfirstlane(tid >> 6);
    const float* X = (const float*)(wsb + a.off[R_X]); bf16* XN = (bf16*)(wsb + a.off[R_XN]); const float* g = GIN(a, gi) + (size_t)l * D_MODEL;
    const int gw = F.vcu * NWAVES + wave, NGW = F.G * NWAVES;
    for (int m = gw; m < RP; m += NGW) rms_row_to_bf16(X + (size_t)m * D_MODEL, g, XN + (size_t)m * D_MODEL, lane);
}
__device__ __forceinline__ void p_norm0(Frame& F) {
    const KArgs ap = kargs(); const auto& a = *ap; WS_OPAQUE(a);
    const int tid = otid(), lane = tid & 63, wave = __builtin_amdgcn_readfirstlane(tid >> 6);
    float* X = (float*)(wsb + a.off[R_X]); bf16* XN = (bf16*)(wsb + a.off[R_XN]);
    const int gw = F.vcu * NWAVES + wave, NGW = F.G * NWAVES;
    f32x4 gg[4];
#pragma unroll
    for (int j = 0; j < 4; ++j) gg[j] = ((const GAS f32x4*)GIN(a, I_N1))[lane + 64 * j];
#define N0_SRC(m_, s_) do { s_ = nullptr; if ((m_) < RP) { if ((m_) >= SROW0) s_ = GIN(a, I_XS) + (size_t)((m_) - SROW0) * D_MODEL; \
        else { const int b_ = (m_) / LPP, p_ = (m_) % LPP; if (p_ >= PADF && p_ < PEND) { const int pos_ = p_ - PADF; s_ = pos_ < N_META ? GIN(a, I_META) + (size_t)pos_ * D_MODEL : GIN(a, I_XP) + ((size_t)b_ * SEQ + pos_ - N_META) * D_MODEL; } } } } while (0)
#define N0_OUT(m_, v_) do { if ((m_) < RP) { float s2_ = 0.f; _Pragma("unroll") for (int j = 0; j < 4; ++j) s2_ += (v_[j].x * v_[j].x + v_[j].y * v_[j].y) + (v_[j].z * v_[j].z + v_[j].w * v_[j].w); \
        const float r_ = __builtin_amdgcn_rsqf(wave_sum(s2_) * (1.f / D_MODEL) + EPSF); \
        GAS f32x4* o_ = (GAS f32x4*)(X + (size_t)(m_) * D_MODEL) + lane; GAS unsigned long long* o8_ = (GAS unsigned long long*)(XN + (size_t)(m_) * D_MODEL) + lane; \
        _Pragma("unroll") for (int j = 0; j < 4; ++j) { o_[64 * j] = v_[j]; \
            o8_[64 * j] = (unsigned long long)pk2(v_[j].x * r_ * gg[j].x, v_[j].y * r_ * gg[j].y) | ((unsigned long long)pk2(v_[j].z * r_ * gg[j].z, v_[j].w * r_ * gg[j].w) << 32); } } } while (0)
    for (int m = gw; m < RP; m += 2 * NGW) {
        const int m2 = m + NGW; const float* sa; const float* sb; N0_SRC(m, sa); N0_SRC(m2, sb);
        f32x4 va[4], vb[4];
#pragma unroll
        for (int j = 0; j < 4; ++j) va[j] = sa ? ((const GAS f32x4*)sa)[lane + 64 * j] : (f32x4){0.f, 0.f, 0.f, 0.f};
#pragma unroll
        for (int j = 0; j < 4; ++j) vb[j] = sb ? ((const GAS f32x4*)sb)[lane + 64 * j] : (f32x4){0.f, 0.f, 0.f, 0.f};
        N0_OUT(m, va); N0_OUT(m2, vb);
    }
#undef N0_SRC
#undef N0_OUT
}
__device__ __forceinline__ void unpack8(const v4u w, float (&f)[8]) { f[0] = bflo(w.x); f[1] = bfhi(w.x); f[2] = bflo(w.y); f[3] = bfhi(w.y); f[4] = bflo(w.z); f[5] = bfhi(w.z); f[6] = bflo(w.w); f[7] = bfhi(w.w); }
__device__ __forceinline__ v4u pack8(const float (&f)[8]) { v4u w; w.x = pk2(f[0], f[1]); w.y = pk2(f[2], f[3]); w.z = pk2(f[4], f[5]); w.w = pk2(f[6], f[7]); return w; }
__device__ __forceinline__ float sigm(float x) { return __builtin_amdgcn_rcpf(1.f + __expf(-x)); }
constexpr float ATT_C2 = 0.125f * 1.4426950408889634f;
__device__ __forceinline__ void p_zpost(Frame& F, int l) {
    const KArgs ap = kargs(); const auto& a = *ap; WS_OPAQUE(a);
    const bf16* Z = (const bf16*)(wsb + a.off[R_Z]);
    bf16* QN = (bf16*)(wsb + a.off[R_QN]); bf16* KN = (bf16*)(wsb + a.off[R_KN]); bf16* QKVB = (bf16*)(wsb + a.off[R_QKVB]); float* BG = (float*)(wsb + a.off[R_BG]);
    const int tid = otid(), lane = tid & 63, wave = __builtin_amdgcn_readfirstlane(tid >> 6);
    const int gw = F.vcu * NWAVES + wave, NGW = F.G * NWAVES;
    float gq[8], gk[8], cw[3][4][8];
#pragma unroll
    for (int j = 0; j < 8; ++j) { gq[j] = GIN(a, I_QN)[l * HEAD_DIM_A + 8 * (lane & 7) + j] * ATT_C2; gk[j] = GIN(a, I_KN)[l * HEAD_DIM_A + 8 * (lane & 7) + j]; }
#pragma unroll
    for (int w = 0; w < 3; ++w)
#pragma unroll
        for (int i = 0; i < 4; ++i)
#pragma unroll
            for (int j = 0; j < 8; ++j) cw[w][i][j] = GIN(a, I_CONVW)[((size_t)l * CONV_W + i) * 3 * WIDTH_B + w * WIDTH_B + 8 * lane + j];
    float alog = 0.f, dtb = 0.f; if (lane < 4) { alog = GIN(a, I_ALOG)[l * N_HEADS_B + lane]; dtb = GIN(a, I_DTB)[l * N_HEADS_B + lane]; }
    for (int m = gw; m < RP; m += NGW) {
        const bool valid = prow_valid(m); const int nat = valid ? prow2nat(m) : 0;
        const bf16* zr = Z + (size_t)m * ZN;
        float f[8], o[8];
        const v4u Lq = *(const GAS v4u*)(zr + ZC_QA + 8 * lane), Lk = *(const GAS v4u*)(zr + ZC_KA + 8 * lane), Lv = *(const GAS v4u*)(zr + ZC_VA + 8 * lane);
        v4u Lc[3][4];
#pragma unroll
        for (int w = 0; w < 3; ++w)
#pragma unroll
            for (int i = 0; i < 4; ++i) { const int mm = m + i - 3 < 0 ? 0 : m + i - 3; Lc[w][i] = *(const GAS v4u*)(Z + (size_t)mm * ZN + ZC_QKVB + w * WIDTH_B + 8 * lane); }
        const unsigned short Lbe = zr[ZC_BA + (lane & 3)], Lal = zr[ZC_BA + 4 + (lane & 3)];
        unpack8(Lq, f);
        { float ss = 0.f;
#pragma unroll
          for (int j = 0; j < 8; ++j) ss += f[j] * f[j];
          ss = sum8(ss);
          const float r = __builtin_amdgcn_rsqf(ss * (1.f / HEAD_DIM_A) + EPSF);
#pragma unroll
          for (int j = 0; j < 8; ++j) o[j] = f[j] * r * gq[j];
          *(GAS v4u*)(QN + (size_t)m * WIDTH_A + 8 * lane) = pack8(o); }
        unpack8(Lk, f);
        { float ss = 0.f;
#pragma unroll
          for (int j = 0; j < 8; ++j) ss += f[j] * f[j];
          ss = sum8(ss);
          const float r = __builtin_amdgcn_rsqf(ss * (1.f / HEAD_DIM_A) + EPSF);
#pragma unroll
          for (int j = 0; j < 8; ++j) o[j] = f[j] * r * gk[j];
          *(GAS v4u*)(KN + (size_t)m * WIDTH_A + 8 * lane) = pack8(o);
          if (valid) { float* ko = nat < NP ? GOUT(a) + O_KP + ((size_t)l * NP + nat) * WIDTH_A : GOUT(a) + O_KS + ((size_t)l * NS + (nat - NP)) * WIDTH_A;
              *(GAS f32x4*)(ko + 8 * lane) = (f32x4){o[0], o[1], o[2], o[3]}; *(GAS f32x4*)(ko + 8 * lane + 4) = (f32x4){o[4], o[5], o[6], o[7]}; } }
        if (valid) { unpack8(Lv, f);
            float* vo = nat < NP ? GOUT(a) + O_VP + ((size_t)l * NP + nat) * WIDTH_A : GOUT(a) + O_VS + ((size_t)l * NS + (nat - NP)) * WIDTH_A;
            *(GAS f32x4*)(vo + 8 * lane) = (f32x4){f[0], f[1], f[2], f[3]}; *(GAS f32x4*)(vo + 8 * lane + 4) = (f32x4){f[4], f[5], f[6], f[7]}; }
        const int ts = m >= SROW0 ? (m - SROW0) % DEC_SEQ : 1000; const int bs = m >= SROW0 ? (m - SROW0) / DEC_SEQ : 0;
        int cj = -1;
        if (m >= SROW0) { if (ts >= DEC_SEQ - 3) cj = ts - (DEC_SEQ - 3); } else { const int p = m % LPP; if (p >= PEND - 3 && p < PEND) cj = p - (PEND - 3); }
#pragma unroll
        for (int w = 0; w < 3; ++w) {
            float acc[8];
#pragma unroll
            for (int j = 0; j < 8; ++j) acc[j] = 0.f;
#pragma unroll
            for (int i = 0; i < 4; ++i) {
                const int dt = i - 3;
                if (ts + dt < 0) {
                    const float* sc = GIN(a, I_SCONV) + (((size_t)l * DEC_BATCH + bs) * (CONV_W - 1) + (CONV_W - 1 + ts + dt)) * 3 * WIDTH_B + w * WIDTH_B + 8 * lane;
                    const f32x4 s0 = *(const GAS f32x4*)sc, s1 = *(const GAS f32x4*)(sc + 4);
                    f[0] = s0.x; f[1] = s0.y; f[2] = s0.z; f[3] = s0.w; f[4] = s1.x; f[5] = s1.y; f[6] = s1.z; f[7] = s1.w;
                } else unpack8(Lc[w][i], f);
#pragma unroll
                for (int j = 0; j < 8; ++j) acc[j] += f[j] * cw[w][i][j];
                if (i == 3 && cj >= 0) {
                    float* co = m >= SROW0 ? GOUT(a) + O_CS + (((size_t)l * DEC_BATCH + bs) * (CONV_W - 1) + cj) * 3 * WIDTH_B : GOUT(a) + O_CP + (((size_t)l * BATCH + m / LPP) * (CONV_W - 1) + cj) * 3 * WIDTH_B;
                    *(GAS f32x4*)(co + w * WIDTH_B + 8 * lane) = (f32x4){f[0], f[1], f[2], f[3]}; *(GAS f32x4*)(co + w * WIDTH_B + 8 * lane + 4) = (f32x4){f[4], f[5], f[6], f[7]}; }
            }
            float ss = 0.f;
#pragma unroll
            for (int j = 0; j < 8; ++j) { acc[j] = acc[j] * sigm(acc[j]); ss += acc[j] * acc[j]; }
            float sc = 1.f;
            if (w < 2) { ss = sum16(ss);
                sc = __builtin_amdgcn_rsqf(ss + EPSF); if (w == 0) sc *= 0.08838834764831845f; }
#pragma unroll
            for (int j = 0; j < 8; ++j) o[j] = acc[j] * sc;
            *(GAS v4u*)(QKVB + (size_t)m * 3 * WIDTH_B + w * WIDTH_B + 8 * lane) = pack8(o);
        }
        if (lane < 4) { const float be = bf2f(Lbe), al = bf2f(Lal) + dtb;
            const float sp = al > 20.f ? al : __logf(1.f + __expf(al));
            BG[(size_t)m * 8 + lane] = valid ? sigm(be) : 0.f; BG[(size_t)m * 8 + 4 + lane] = valid ? -__expf(alog) * sp : 0.f; }
    }
}
constexpr float LOG2E = 1.4426950408889634f;
__device__ __forceinline__ int t5_bucket_dev(int rel) {
    const int n = rel < 0 ? -rel : rel; int b;
    if (n < 8) b = n; else if (n < 12) b = 8; else if (n < 16) b = 9; else if (n < 23) b = 10; else if (n < 32) b = 11;
    else if (n < 46) b = 12; else if (n < 64) b = 13; else if (n < 91) b = 14; else b = 15;
    return b + (rel > 0 ? 16 : 0);
}
__device__ __forceinline__ void build_bias_table(LAS float* tab, const float* rel_bias, int h, int tid) {
    const float far = rel_bias[15 * N_HEADS_A + h];
    for (int i = tid; i < attn_body::BT_N; i += NTHR) tab[i] = (rel_bias[t5_bucket_dev(i - attn_body::BT_OFF) * N_HEADS_A + h] - far) * LOG2E;
}
__device__ __forceinline__ float lam_init_dev(int l) { return 0.8f - 0.6f * __expf(-0.3f * (float)l); }
__device__ __forceinline__ float lam_dev(const float* lqk_all, int l, int lane) {
    const float* q = lqk_all + (size_t)l * 4 * HEAD_DIM_A;
    const float s0 = wave_sum(q[lane] * q[HEAD_DIM_A + lane]), s1 = wave_sum(q[2 * HEAD_DIM_A + lane] * q[3 * HEAD_DIM_A + lane]);
    return __expf(s0) - __expf(s1) + lam_init_dev(l);
}
__device__ __forceinline__ int krow_dev(int s, int h, int j) { return 16 * s + 8 * (j >> 2) + 4 * h + (j & 3); }
__device__ __forceinline__ int crow_dev(int r, int h) { return (r & 3) + 8 * (r >> 2) + 4 * h; }
__device__ __forceinline__ bf16x8 pack_f8(const f32x4 a, const f32x4 b) { v4u w; w.x = pk2(a.x, a.y); w.y = pk2(a.z, a.w); w.z = pk2(b.x, b.y); w.w = pk2(b.z, b.w); return __builtin_bit_cast(bf16x8, w); }

__device__ __forceinline__ void sample_scores(f32x16& X, int kb, int c, const float* ck, const bf16* KN, int row0, int h, int hi, int r32, int qpos, const bf16x8 (&qf)[4], const LAS float* tab) {
    bf16x8 kf[4];
    if (kb < PAST_LEN / 32) { const float* kr = ck + (size_t)(kb * 32 + r32) * WIDTH_A + h * 128 + c * 64 + 8 * hi;
#pragma unroll
        for (int s = 0; s < 4; ++s) kf[s] = pack_f8(*(const GAS f32x4*)(kr + 16 * s), *(const GAS f32x4*)(kr + 16 * s + 4)); }
    else { const bf16* kr = KN + (size_t)(row0 + (kb * 32 - PAST_LEN) + r32) * WIDTH_A + h * 128 + c * 64 + 8 * hi;
#pragma unroll
        for (int s = 0; s < 4; ++s) kf[s] = *(const GAS bf16x8*)(kr + 16 * s); }
#pragma unroll
    for (int i = 0; i < 16; ++i) X[i] = 0.f;
#pragma unroll
    for (int s = 0; s < 4; ++s) X = __builtin_amdgcn_mfma_f32_32x32x16_bf16(kf[s], qf[s], X, 0, 0, 0);
#pragma unroll
    for (int i = 0; i < 16; ++i) { int idx = kb * 32 + crow_dev(i, hi) - qpos + attn_body::BT_OFF; idx = idx < 0 ? 0 : idx; X[i] += tab[idx]; }
}

__device__ __forceinline__ void attn_sample_unit(Frame& F, int l, int bs, int h) {
    const KArgs ap = kargs(); const auto& a = *ap; WS_OPAQUE(a);
    const int tid = otid(), lane = tid & 63, wid = __builtin_amdgcn_readfirstlane(tid >> 6), r32 = lane & 31, hi = lane >> 5;
    const bf16* QN = (const bf16*)(wsb + a.off[R_QN]); const bf16* KN = (const bf16*)(wsb + a.off[R_KN]); const bf16* Z = (const bf16*)(wsb + a.off[R_Z]); bf16* O = (bf16*)(wsb + a.off[R_O]);
    const float* ck = GIN(a, I_CK) + ((size_t)l * DEC_BATCH + bs) * PAST_LEN * WIDTH_A; const float* cv = GIN(a, I_CV) + ((size_t)l * DEC_BATCH + bs) * PAST_LEN * WIDTH_A;
    const int row0 = SROW0 + bs * DEC_SEQ;
    LAS float* tab = (LAS float*)(F.lds + RING_OFF + attn_body::LDS_BT);
    LAS float* st = (LAS float*)(F.lds + RING_OFF + 90112);
    LAS float* slot = (LAS float*)(F.lds + RING_OFF);
    const float lam = lam_dev(GIN(a, I_LQK), l, lane);
    build_bias_table(tab, GIN(a, I_REL), h, tid);
    bf16x8 qf[2][4];
#pragma unroll
    for (int c = 0; c < 2; ++c)
#pragma unroll
        for (int s = 0; s < 4; ++s) qf[c][s] = *(const GAS bf16x8*)(QN + (size_t)(row0 + r32) * WIDTH_A + h * 128 + c * 64 + 16 * s + 8 * hi);
    __syncthreads();
    float m[2] = {-1e30f, -1e30f}, lsum[2] = {0.f, 0.f};
    const int qpos = PAST_LEN + r32;
    for (int kb = wid; kb < (PAST_LEN + DEC_SEQ) / 32; kb += NWAVES) {
#pragma unroll
        for (int c = 0; c < 2; ++c) { f32x16 X; sample_scores(X, kb, c, ck, KN, row0, h, hi, r32, qpos, qf[c], tab);
            float mx = X[0];
#pragma unroll
            for (int i = 1; i < 16; ++i) mx = fmaxf(mx, X[i]);
            mx = fmaxf(mx, swap32(mx)); const float mn = fmaxf(m[c], mx);
            float sum = 0.f;
#pragma unroll
            for (int i = 0; i < 16; ++i) sum += exp2f(X[i] - mn);
            lsum[c] = lsum[c] * exp2f(m[c] - mn) + sum; m[c] = mn; }
    }
#pragma unroll
    for (int c = 0; c < 2; ++c) { lsum[c] += swap32(lsum[c]); if (hi == 0) { st[((wid * 2 + c) * 2 + 0) * 32 + r32] = m[c]; st[((wid * 2 + c) * 2 + 1) * 32 + r32] = lsum[c]; } }
    __syncthreads();
    float gm[2], ginv[2];
#pragma unroll
    for (int c = 0; c < 2; ++c) { float mm = -1e30f;
#pragma unroll
        for (int w = 0; w < NWAVES; ++w) mm = fmaxf(mm, st[((w * 2 + c) * 2 + 0) * 32 + r32]);
        float ll = 0.f;
#pragma unroll
        for (int w = 0; w < NWAVES; ++w) ll += st[((w * 2 + c) * 2 + 1) * 32 + r32] * exp2f(st[((w * 2 + c) * 2 + 0) * 32 + r32] - mm);
        gm[c] = mm; ginv[c] = (c == 0 ? 1.f : lam) / ll; }
    f32x16 acc[4];
#pragma unroll
    for (int eb = 0; eb < 4; ++eb)
#pragma unroll
        for (int i = 0; i < 16; ++i) acc[eb][i] = 0.f;
    for (int kb = wid; kb < (PAST_LEN + DEC_SEQ) / 32; kb += NWAVES) {
        f32x16 X0, X1; sample_scores(X0, kb, 0, ck, KN, row0, h, hi, r32, qpos, qf[0], tab); sample_scores(X1, kb, 1, ck, KN, row0, h, hi, r32, qpos, qf[1], tab);
        float wv[16];
#pragma unroll
        for (int i = 0; i < 16; ++i) wv[i] = exp2f(X0[i] - gm[0]) * ginv[0] - exp2f(X1[i] - gm[1]) * ginv[1];
        bf16x8 xs[2];
#pragma unroll
        for (int s = 0; s < 2; ++s) { v4u w; w.x = pk2(wv[8 * s], wv[8 * s + 1]); w.y = pk2(wv[8 * s + 2], wv[8 * s + 3]); w.z = pk2(wv[8 * s + 4], wv[8 * s + 5]); w.w = pk2(wv[8 * s + 6], wv[8 * s + 7]); xs[s] = __builtin_bit_cast(bf16x8, w); }
#pragma unroll
        for (int eb = 0; eb < 4; ++eb)
#pragma unroll
            for (int s = 0; s < 2; ++s) {
                float vv[8];
                if (kb < PAST_LEN / 32) { const GAS float* vb = (const GAS float*)(cv + (size_t)(kb * 32 + 4 * hi) * WIDTH_A + h * 128 + eb * 32 + r32); asm volatile("" : "+v"(vb));
#pragma unroll
                    for (int j = 0; j < 8; ++j) vv[j] = vb[(size_t)(16 * s + 8 * (j >> 2) + (j & 3)) * WIDTH_A]; }
                else { const GAS bf16* vb = (const GAS bf16*)(Z + (size_t)(row0 + kb * 32 - PAST_LEN + 4 * hi) * ZN + ZC_VA + h * 128 + eb * 32 + r32); asm volatile("" : "+v"(vb));
#pragma unroll
                    for (int j = 0; j < 8; ++j) vv[j] = bf2f(vb[(size_t)(16 * s + 8 * (j >> 2) + (j & 3)) * ZN]); }
                v4u w; w.x = pk2(vv[0], vv[1]); w.y = pk2(vv[2], vv[3]); w.z = pk2(vv[4], vv[5]); w.w = pk2(vv[6], vv[7]);
                acc[eb] = __builtin_amdgcn_mfma_f32_32x32x16_bf16(xs[s], __builtin_bit_cast(bf16x8, w), acc[eb], 0, 0, 0);
            }
    }
    __syncthreads();
#pragma unroll
    for (int eb = 0; eb < 4; ++eb)
#pragma unroll
        for (int i = 0; i < 16; ++i) slot[(wid * 32 + crow_dev(i, hi)) * 128 + eb * 32 + r32] = acc[eb][i];
    __syncthreads();
    { const int q = tid >> 4, e0 = (tid & 15) * 8; float o[8];
#pragma unroll
      for (int j = 0; j < 8; ++j) o[j] = 0.f;
#pragma unroll
      for (int w = 0; w < NWAVES; ++w)
#pragma unroll
          for (int j = 0; j < 8; ++j) o[j] += slot[(w * 32 + q) * 128 + e0 + j];
      v4u pw; pw.x = pk2(o[0], o[1]); pw.y = pk2(o[2], o[3]); pw.z = pk2(o[4], o[5]); pw.w = pk2(o[6], o[7]);
      bf16* orow = O + (size_t)(row0 + q) * attn_body::OP + h * 256;
      unsigned zq = 0u; asm volatile("" : "+v"(zq));
      *(GAS v4u*)(orow + e0) = pw; *(GAS v4u*)(orow + 128 + e0) = (v4u){zq, zq, zq, zq}; }
    __syncthreads();
}

constexpr int ATT_NQB = LPP / 256;
constexpr int ATT_NPU = BATCH * 16 * ATT_NQB;
constexpr int ATT_NSU = DEC_BATCH * N_HEADS_A;
__device__ __forceinline__ void p_attention(Frame& F, int lq, unsigned char* ldsg) {
    const int l = lq % DEPTH;
    for (;;) {
        const KArgs ap = kargs(); const auto& a = *ap; WS_OPAQUE(a);
        const int tid = otid();
        gu32* head = (gu32*)wsb + CW_QUEUE + 64 * lq;
        const attn_body::bf16* QN = (const attn_body::bf16*)(wsb + a.off[R_QN]); const attn_body::bf16* KN = (const attn_body::bf16*)(wsb + a.off[R_KN]);
        const attn_body::bf16* Z = (const attn_body::bf16*)(wsb + a.off[R_Z]); attn_body::bf16* O = (attn_body::bf16*)(wsb + a.off[R_O]);
        if (tid == 0) F.MISC[16] = __hip_atomic_fetch_add(head, 1u, RLX_AGENT);
        __syncthreads();
        const int u = (int)F.MISC[16];
        __syncthreads();
        if (u >= ATT_NPU + ATT_NSU) break;
        if (u < ATT_NPU) {
            const int qb = (ATT_NQB - 1) - u / 32, bvh = u % 32, b = bvh >> 4, vh = bvh & 15, h = vh >> 2, c = (vh >> 1) & 1, half = vh & 1;
            build_bias_table((LAS float*)(F.lds + RING_OFF + attn_body::LDS_BT), GIN(a, I_REL), h, tid);
            __syncthreads();
            attn_body::attn_unit<8>(b, h * 128 + c * 64, ZC_VA + h * 128 + half * 64, h * 256 + c * 128 + half * 64, qb, QN, KN, Z, O, (char*)ldsg + RING_OFF, F.wv);
        } else { const int su = u - ATT_NPU; attn_sample_unit(F, l, su >> 2, su & 3); }
    }
}
__device__ __forceinline__ void p_mixpost_a(Frame& F, int l) {
    const KArgs ap = kargs(); const auto& a = *ap; WS_OPAQUE(a);
    const int tid = otid(), lane = tid & 63, wave = __builtin_amdgcn_readfirstlane(tid >> 6);
    const bf16* O = (const bf16*)(wsb + a.off[R_O]); bf16* OA = (bf16*)(wsb + a.off[R_OA]);
    const int gw = F.vcu * NWAVES + wave, NGW = F.G * NWAVES;
    const float lam = lam_dev(GIN(a, I_LQK), l, lane), post = 1.f - lam_init_dev(l);
    const int h = lane >> 4, e0 = 8 * (lane & 15);
    float sg[8];
#pragma unroll
    for (int j = 0; j < 8; ++j) sg[j] = GIN(a, I_SUBLN)[l * 2 * HEAD_DIM_A + e0 + j] * post;
    v4u n0 = *(const GAS v4u*)(O + (size_t)gw * 1024 + h * 256 + e0), n1 = *(const GAS v4u*)(O + (size_t)gw * 1024 + h * 256 + 128 + e0);
    for (int m = gw; m < RP; m += NGW) {
        float o0[8], o1[8], d[8];
        unpack8(n0, o0); unpack8(n1, o1);
        { const int mn = m + NGW < RP ? m + NGW : gw; n0 = *(const GAS v4u*)(O + (size_t)mn * 1024 + h * 256 + e0); n1 = *(const GAS v4u*)(O + (size_t)mn * 1024 + h * 256 + 128 + e0); }
        float ss = 0.f;
#pragma unroll
        for (int j = 0; j < 8; ++j) { d[j] = o0[j] - lam * o1[j]; ss += d[j] * d[j]; }
        ss = sum16(ss);
        const float r = __builtin_amdgcn_rsqf(ss * (1.f / 128.f) + EPSF);
#pragma unroll
        for (int j = 0; j < 8; ++j) d[j] = d[j] * r * sg[j];
        *(GAS v4u*)(OA + (size_t)m * WIDTH_A + h * 128 + e0) = pack8(d);
    }
}
constexpr int GDN_NCH = PEND / 64;
constexpr int GDN_NPI = BATCH * N_HEADS_B * GDN_NCH;
constexpr int GDN_NSI = DEC_BATCH * N_HEADS_B;
constexpr int GDN_NI = GDN_NPI + GDN_NSI;
constexpr int GI_W = 0, GI_QG = 16384, GI_KG = 32768, GI_AT = 49152, GI_U = 57344, GI_SC = 73728, GI_STRIDE = 73984, GI_EG = 2048  ;
static_assert(GDN_NI % 4 == 0 && PEND % 64 == 0, "gdn items");
__device__ __forceinline__ int frag_off(int row, int kk, int nkb) {
    const int fid = ((row >> 5) * nkb + (kk >> 5)) * 2 + ((kk & 31) >> 4), ln = (row & 31) + 32 * (((kk & 15) >> 2) & 1), j = ((kk & 15) >> 3) * 4 + (kk & 3);
    return (fid * 64 + ln) * 8 + j;
}
__device__ __forceinline__ int gdn_item_row(int item, int j) {
    if (item < GDN_NPI) { const int sh = item / GDN_NCH, n = item % GDN_NCH; return (sh / N_HEADS_B) * LPP + 64 * n + j; }
    const int s = item - GDN_NPI; return j < 32 ? -1 : SROW0 + (s >> 2) * DEC_SEQ + (j - 32);
}
__device__ __forceinline__ int gdn_item_head(int item) { return item < GDN_NPI ? (item / GDN_NCH) % N_HEADS_B : (item - GDN_NPI) & 3; }

__device__ __forceinline__ void gdn_flush(const LAS unsigned char* stg, unsigned char* dst, int nbytes, int gt) {
    for (int o = gt * 16; o < nbytes; o += 2048) *(GAS v4u*)(dst + o) = *(const LAS v4u*)(stg + o);
}
typedef float f32x2s __attribute__((ext_vector_type(2)));
#define GDN_RL8(a, arow, jb) asm volatile("v_readlane_b32 %0, %8, %9\n\tv_readlane_b32 %1, %8, %10\n\tv_readlane_b32 %2, %8, %11\n\tv_readlane_b32 %3, %8, %12\n\tv_readlane_b32 %4, %8, %13\n\tv_readlane_b32 %5, %8, %14\n\tv_readlane_b32 %6, %8, %15\n\tv_readlane_b32 %7, %8, %16" \
    : "=s"(a[0]), "=s"(a[1]), "=s"(a[2]), "=s"(a[3]), "=s"(a[4]), "=s"(a[5]), "=s"(a[6]), "=s"(a[7]) : "v"(arow), "i"(jb), "i"((jb) + 1), "i"((jb) + 2), "i"((jb) + 3), "i"((jb) + 4), "i"((jb) + 5), "i"((jb) + 6), "i"((jb) + 7))
template <int I, int JB> __device__ __forceinline__ void gdn_subst_blk(f32x2s (&x)[64], float arow) {
    if constexpr (JB < I) { float ar[8]; GDN_RL8(ar, arow, JB);
#pragma unroll
        for (int t = 0; t < 8; ++t) if (JB + t < I) x[I] -= ar[t] * x[JB + t];
        gdn_subst_blk<I, JB + 8>(x, arow); }
}
template <int... Is> __device__ __forceinline__ void gdn_subst_all(f32x2s (&x)[64], const LAS float* A, int lane, std::integer_sequence<int, Is...>) {
    (gdn_subst_blk<Is + 1, 0>(x, A[(Is + 1) * 64 + lane]), ...);
}
template <int MODE> __device__ __forceinline__ void p_gdn_chunk(Frame& F, int l, int q) {
    const KArgs ap = kargs(); const auto& a = *ap; WS_OPAQUE(a);
    const int tid = otid(), wave = __builtin_amdgcn_readfirstlane(tid >> 6), grp = wave >> 1, gw = wave & 1;
    const bf16* QKVB = (const bf16*)(wsb + a.off[R_QKVB]); const float* BG = (const float*)(wsb + a.off[R_BG]); unsigned char* GD = wsb + a.off[R_GDN];
    LAS float* A_lds = (LAS float*)(F.lds + RING_OFF + grp * 34816);
    LAS float* Gs = A_lds + 4096; LAS float* Bs = Gs + 64; LAS float* Es = Bs + 64;
    LAS unsigned char* stg = (LAS unsigned char*)(A_lds + 4096 + 256);
    LAS bf16* stgh = (LAS bf16*)stg;
    static_assert(4 * 34816 <= RING_BYTES && GDN_NI % 4 == 0, "gdn chunk LDS / items");
    for (int pr = MODE == 0 ? F.vcu : q; MODE == 0 ? pr < (GDN_NPI - BATCH * N_HEADS_B) / 4 : pr == q; pr += (MODE == 0 ? F.G : 1 << 20)) {
        int lane_ = otid() & 63;
        const int lane = lane_, r32 = lane & 31, hi = lane >> 5, gt = gw * 64 + lane;
        int item;
        if (MODE == 0) { const int j = 4 * pr + grp; item = (j >> 7) * GDN_NCH + (j & 127); }
        else item = q < 16 ? GDN_NPI + 4 * q + grp : (4 * (q - 16) + grp) * GDN_NCH + (GDN_NCH - 1);
        const int h = gdn_item_head(item);
        unsigned char* ib = GD + (size_t)item * GI_STRIDE;
        const int rowt = gdn_item_row(item, lane);
        const float beta = rowt >= 0 ? BG[(size_t)rowt * 8 + h] : 0.f; float G = rowt >= 0 ? BG[(size_t)rowt * 8 + 4 + h] : 0.f;
        G = scan64(G);
        const float Glast = rdlane(G, 63), eG = __expf(G);
        if (gw == 0) { Gs[lane] = G; Bs[lane] = beta; Es[lane] = eG; }
        __syncthreads();
#pragma unroll
        for (int bq = 0; bq < 2; ++bq) {
          const int i0 = 32 * gw, j0 = 32 * bq; const int j = j0 + r32;
          if (gw == 0 && bq == 1) {
#pragma unroll
              for (int r = 0; r < 16; ++r) { const int i = crow_dev(r, hi); A_lds[i * 64 + j] = 0.f; stgh[frag_off(i, j, 2)] = (bf16)0; }
              LDS_WAIT(); if (lane == 0) *(LAS float*)(stg + GI_EG) = __expf(Glast);
          } else {
          const int ra = gdn_item_row(item, i0 + r32), rb = gdn_item_row(item, j0 + r32);
          f32x16 akk, aqk;
#pragma unroll
          for (int r = 0; r < 16; ++r) { akk[r] = 0.f; aqk[r] = 0.f; }
          const bf16x8 zf = {0, 0, 0, 0, 0, 0, 0, 0};
          bf16x8 qa[8], ka[8], kb[8];
          { const bf16* pa = QKVB + (size_t)(ra < 0 ? 0 : ra) * 1536 + h * 128 + 8 * hi; const bf16* pb = QKVB + (size_t)(rb < 0 ? 0 : rb) * 1536 + 512 + h * 128 + 8 * hi;
#pragma unroll
            for (int s = 0; s < 8; ++s) { qa[s] = *(const GAS bf16x8*)(pa + 16 * s); ka[s] = *(const GAS bf16x8*)(pa + 512 + 16 * s); kb[s] = *(const GAS bf16x8*)(pb + 16 * s); } }
#pragma unroll
          for (int s = 0; s < 8; ++s) { if (ra < 0) { qa[s] = zf; ka[s] = zf; } if (rb < 0) kb[s] = zf;
              akk = __builtin_amdgcn_mfma_f32_32x32x16_bf16(ka[s], kb[s], akk, 0, 0, 0); aqk = __builtin_amdgcn_mfma_f32_32x32x16_bf16(qa[s], kb[s], aqk, 0, 0, 0); }
          const float Gj = Gs[j];
#pragma unroll
          for (int r = 0; r < 16; ++r) { const int i = i0 + crow_dev(r, hi); const float dec = i >= j ? __expf(Gs[i] - Gj) : 0.f;
              A_lds[i * 64 + j] = i > j ? Bs[i] * akk[r] * dec : 0.f;
              stgh[frag_off(i, j, 2)] = (bf16)f2bf(aqk[r] * dec); }
          }
        }
        __syncthreads();
        gdn_flush(stg, ib + GI_AT, 8192, gt);
        { f32x2s x[64]; const int cbase = gw == 0 ? 1024 + h * 128 : 512 + h * 128;
#pragma unroll
          for (int i = 0; i < 64; ++i) { const int ri = __builtin_amdgcn_readfirstlane(gdn_item_row(item, i));
              const bf16* rowp = QKVB + (size_t)(ri < 0 ? 0 : ri) * 1536 + cbase;
              x[i] = ri >= 0 ? (f32x2s){bf2f(rowp[lane]), bf2f(rowp[lane + 64])} : (f32x2s){0.f, 0.f}; }
          const float rsc = gw == 0 ? beta : beta * eG;
#pragma unroll
          for (int i = 0; i < 64; ++i) x[i] *= rdlane(rsc, i);
          gdn_subst_all(x, A_lds, lane, std::make_integer_sequence<int, 63>{});
          __syncthreads();
          if (gw == 0) { GAS bf16* ub = (GAS bf16*)(ib + GI_U) + lane; asm volatile("" : "+v"(ub));
#pragma unroll
              for (int i = 0; i < 64; ++i) { ub[i * 128] = (bf16)f2bf(x[i].x); ub[i * 128 + 64] = (bf16)f2bf(x[i].y); } }
          else { LAS bf16* wb0 = stgh + frag_off(0, lane, 4); LAS bf16* wb1 = stgh + frag_off(0, lane + 64, 4);
#pragma unroll
              for (int i = 0; i < 64; ++i) { wb0[(i >> 5) * 4096 + (i & 31) * 8] = (bf16)f2bf(x[i].x); wb1[(i >> 5) * 4096 + (i & 31) * 8] = (bf16)f2bf(x[i].y); } }
        }
        __syncthreads();
        gdn_flush(stg, ib + GI_W, 16384, gt);
        __syncthreads();
        const float kgs = __expf(Glast - G);
#pragma unroll
        for (int hf = 0; hf < 2; ++hf) { float qv[32];
#pragma unroll
          for (int it = 0; it < 32; ++it) { const int c = it + 32 * hf, rc = __builtin_amdgcn_readfirstlane(gdn_item_row(item, c)); const bf16* rowp = QKVB + (size_t)(rc < 0 ? 0 : rc) * 1536 + h * 128; qv[it] = rc >= 0 ? bf2f(rowp[gt]) : 0.f; }
#pragma unroll
          for (int it = 0; it < 32; ++it) { const int c = it + 32 * hf; stgh[frag_off(c, gt, 4)] = (bf16)f2bf(qv[it] * rdlane(eG, c)); } }
        __syncthreads();
        gdn_flush(stg, ib + GI_QG, 16384, gt);
        __syncthreads();
#pragma unroll
        for (int hf = 0; hf < 2; ++hf) { float kv[32];
#pragma unroll
          for (int it = 0; it < 32; ++it) { const int c = it + 32 * hf, rc = __builtin_amdgcn_readfirstlane(gdn_item_row(item, c)); const bf16* rowp = QKVB + (size_t)(rc < 0 ? 0 : rc) * 1536 + 512 + h * 128; kv[it] = rc >= 0 ? bf2f(rowp[gt]) : 0.f; }
#pragma unroll
          for (int it = 0; it < 32; ++it) { const int c = it + 32 * hf; stgh[frag_off(gt, c, 2)] = (bf16)f2bf(kv[it] * rdlane(kgs, c)); } }
        __syncthreads();
        gdn_flush(stg, ib + GI_KG, 16384, gt);
        VM_WAIT(); __syncthreads();
        if (MODE == 1 && q >= 16) {
            if (wave == 0 && (otid() & 63) == 0) { __builtin_amdgcn_fence(__ATOMIC_RELEASE, "agent"); asm volatile("s_waitcnt vmcnt(0)" ::: "memory");
                gu32* fl = (gu32*)wsb + CW_GDNFLAG;
#pragma unroll
                for (int c = 0; c < 4; ++c) __hip_atomic_store(fl + 64 * (4 * (q - 16) + c), (unsigned)(l + 1), RLX_AGENT); } }
    }
}

__device__ __forceinline__ void gdn_chain(const unsigned char* GD, bf16* OB, const float* sdelta, float* dout, int item0, int nch, int h, int vb, int lane) {
    const int r32 = lane & 31, hi = lane >> 5;
    f32x16 S[4];
#pragma unroll
    for (int kb = 0; kb < 4; ++kb)
#pragma unroll
        for (int r = 0; r < 16; ++r) S[kb][r] = sdelta ? sdelta[(size_t)(kb * 32 + crow_dev(r, hi)) * HEAD_DIM_B + vb * 32 + r32] : 0.f;
    for (int n = 0; n < nch; ++n) {
        const int item = item0 + n; const unsigned char* ib = GD + (size_t)item * GI_STRIDE;
        const float eGl = *(const float*)(ib + GI_AT + GI_EG);
        const GAS bf16x8* WF = (const GAS bf16x8*)(ib + GI_W) + lane; const GAS bf16x8* QF = (const GAS bf16x8*)(ib + GI_QG) + lane;
        const GAS bf16x8* KF = (const GAS bf16x8*)(ib + GI_KG) + lane; const GAS bf16x8* AF = (const GAS bf16x8*)(ib + GI_AT) + lane; const bf16* U = (const bf16*)(ib + GI_U);
        bf16x8 Sp[4][2];
#pragma unroll
        for (int kb = 0; kb < 4; ++kb)
#pragma unroll
            for (int s = 0; s < 2; ++s) { v4u w; w.x = pk2(S[kb][8 * s], S[kb][8 * s + 1]); w.y = pk2(S[kb][8 * s + 2], S[kb][8 * s + 3]); w.z = pk2(S[kb][8 * s + 4], S[kb][8 * s + 5]); w.w = pk2(S[kb][8 * s + 6], S[kb][8 * s + 7]); Sp[kb][s] = __builtin_bit_cast(bf16x8, w); }
        f32x16 vn[2], ot[2];
#pragma unroll
        for (int cb = 0; cb < 2; ++cb) {
            f32x16 ws;
#pragma unroll
            for (int r = 0; r < 16; ++r) { ws[r] = 0.f; ot[cb][r] = 0.f; }
#pragma unroll
            for (int kb = 0; kb < 4; ++kb)
#pragma unroll
                for (int s = 0; s < 2; ++s) { ws = __builtin_amdgcn_mfma_f32_32x32x16_bf16(WF[((cb * 4 + kb) * 2 + s) * 64], Sp[kb][s], ws, 0, 0, 0);
                    ot[cb] = __builtin_amdgcn_mfma_f32_32x32x16_bf16(QF[((cb * 4 + kb) * 2 + s) * 64], Sp[kb][s], ot[cb], 0, 0, 0); }
#pragma unroll
            for (int r = 0; r < 16; ++r) vn[cb][r] = bf2f(U[(cb * 32 + crow_dev(r, hi)) * 128 + vb * 32 + r32]) - ws[r];
        }
        bf16x8 Vp[2][2];
#pragma unroll
        for (int cb = 0; cb < 2; ++cb)
#pragma unroll
            for (int s = 0; s < 2; ++s) { v4u w; w.x = pk2(vn[cb][8 * s], vn[cb][8 * s + 1]); w.y = pk2(vn[cb][8 * s + 2], vn[cb][8 * s + 3]); w.z = pk2(vn[cb][8 * s + 4], vn[cb][8 * s + 5]); w.w = pk2(vn[cb][8 * s + 6], vn[cb][8 * s + 7]); Vp[cb][s] = __builtin_bit_cast(bf16x8, w); }
#pragma unroll
        for (int cb = 0; cb < 2; ++cb)
#pragma unroll
            for (int c2 = 0; c2 <= cb; ++c2)
#pragma unroll
                for (int s = 0; s < 2; ++s) ot[cb] = __builtin_amdgcn_mfma_f32_32x32x16_bf16(AF[((cb * 2 + c2) * 2 + s) * 64], Vp[c2][s], ot[cb], 0, 0, 0);
#pragma unroll
        for (int cb = 0; cb < 2; ++cb)
#pragma unroll
            for (int r = 0; r < 16; ++r) { const int row = gdn_item_row(item, cb * 32 + crow_dev(r, hi)); if (row >= 0) OB[(size_t)row * WIDTH_B + h * 128 + vb * 32 + r32] = (bf16)f2bf(ot[cb][r]); }
#pragma unroll
        for (int kb = 0; kb < 4; ++kb) {
#pragma unroll
            for (int r = 0; r < 16; ++r) S[kb][r] *= eGl;
#pragma unroll
            for (int cb = 0; cb < 2; ++cb)
#pragma unroll
                for (int s = 0; s < 2; ++s) S[kb] = __builtin_amdgcn_mfma_f32_32x32x16_bf16(KF[((kb * 2 + cb) * 2 + s) * 64], Vp[cb][s], S[kb], 0, 0, 0);
        }
    }
#pragma unroll
    for (int kb = 0; kb < 4; ++kb)
#pragma unroll
        for (int r = 0; r < 16; ++r) dout[(size_t)(kb * 32 + crow_dev(r, hi)) * HEAD_DIM_B + vb * 32 + r32] = S[kb][r];
}
constexpr int GCH_BUF = 73728, GCH_PCS = 18;
#define GCH_BAR() do { asm volatile("s_waitcnt lgkmcnt(0)" ::: "memory"); __builtin_amdgcn_s_barrier(); asm volatile("" ::: "memory"); } while (0)
__device__ __forceinline__ void gdn_chain_wg(Frame& F, const unsigned char* GD, bf16* OB, float* dout, int item0, int h, gu32* flag, unsigned epoch) {
    const int tid = otid(), lane = tid & 63, wave = __builtin_amdgcn_readfirstlane(tid >> 6), r32 = lane & 31, hi = lane >> 5, vb = wave & 3;
    LAS unsigned char* lb = F.lds + RING_OFF;
    if (wave >= 4) {
        const int p0 = (wave - 4) * GCH_PCS;
        v4u R0[GCH_PCS], R1[GCH_PCS];
#define GCH_LOAD(R, c) do { if ((c) == GDN_NCH - 1) { unsigned sp_ = 0; while (__hip_atomic_load(flag, RLX_AGENT) != epoch) { __builtin_amdgcn_s_sleep(2); if (++sp_ > (1u << 22)) break; } \
            __builtin_amdgcn_fence(__ATOMIC_ACQUIRE, "agent"); asm volatile("s_waitcnt vmcnt(0)" ::: "memory"); }     \
            const unsigned char* s_ = GD + (size_t)(item0 + (c)) * GI_STRIDE + (size_t)p0 * 1024 + lane * 16; _Pragma("unroll") for (int j = 0; j < GCH_PCS; ++j) \
            asm volatile("global_load_dwordx4 %0, %1, off" : "=&v"(R[j]) : "v"(s_ + j * 1024) : "memory"); } while (0)
#define GCH_PUT(R, c) do { if ((c) + 1 < GDN_NCH) asm volatile("s_waitcnt vmcnt(18)" ::: "memory"); else asm volatile("s_waitcnt vmcnt(0)" ::: "memory"); \
            LAS v4u* d_ = (LAS v4u*)(lb + ((c) & 1) * GCH_BUF + p0 * 1024) + lane; _Pragma("unroll") for (int j = 0; j < GCH_PCS; ++j) d_[j * 64] = R[j]; } while (0)
        GCH_LOAD(R0, 0); GCH_LOAD(R1, 1);
        GCH_PUT(R0, 0); GCH_LOAD(R0, 2);
        GCH_BAR();
        for (int n = 0; n < GDN_NCH; n += 2) {
            if (n + 1 < GDN_NCH) GCH_PUT(R1, n + 1);
            if (n + 3 < GDN_NCH) GCH_LOAD(R1, n + 3);
            GCH_BAR();
            if (n + 1 < GDN_NCH) {
                if (n + 2 < GDN_NCH) GCH_PUT(R0, n + 2);
                if (n + 4 < GDN_NCH) GCH_LOAD(R0, n + 4);
                GCH_BAR(); }
        }
        asm volatile("s_waitcnt vmcnt(0)" ::: "memory");
#undef GCH_LOAD
#undef GCH_PUT
        return;
    }
    f32x16 S[4];
#pragma unroll
    for (int kb = 0; kb < 4; ++kb)
#pragma unroll
        for (int r = 0; r < 16; ++r) S[kb][r] = 0.f;
    GCH_BAR();
    for (int n = 0; n < GDN_NCH; ++n) {
        const int item = item0 + n; const LAS unsigned char* bufc = lb + (n & 1) * GCH_BUF;
        const float egl = *(const LAS float*)(bufc + GI_AT + GI_EG);
        const LAS bf16x8* WF = (const LAS bf16x8*)(bufc + GI_W) + lane; const LAS bf16x8* QF = (const LAS bf16x8*)(bufc + GI_QG) + lane;
        const LAS bf16x8* KF = (const LAS bf16x8*)(bufc + GI_KG) + lane; const LAS bf16x8* AF = (const LAS bf16x8*)(bufc + GI_AT) + lane; const LAS bf16* U = (const LAS bf16*)(bufc + GI_U);
        bf16x8 Sp[4][2];
#pragma unroll
        for (int kb = 0; kb < 4; ++kb)
#pragma unroll
            for (int s = 0; s < 2; ++s) { v4u w; w.x = pk2(S[kb][8 * s], S[kb][8 * s + 1]); w.y = pk2(S[kb][8 * s + 2], S[kb][8 * s + 3]); w.z = pk2(S[kb][8 * s + 4], S[kb][8 * s + 5]); w.w = pk2(S[kb][8 * s + 6], S[kb][8 * s + 7]); Sp[kb][s] = __builtin_bit_cast(bf16x8, w); }
        f32x16 vn[2], ot[2];
#pragma unroll
        for (int cb = 0; cb < 2; ++cb) {
            f32x16 ws;
#pragma unroll
            for (int r = 0; r < 16; ++r) { ws[r] = 0.f; ot[cb][r] = 0.f; }
#pragma unroll
            for (int kb = 0; kb < 4; ++kb)
#pragma unroll
                for (int s = 0; s < 2; ++s) { ws = __builtin_amdgcn_mfma_f32_32x32x16_bf16(WF[((cb * 4 + kb) * 2 + s) * 64], Sp[kb][s], ws, 0, 0, 0);
                    ot[cb] = __builtin_amdgcn_mfma_f32_32x32x16_bf16(QF[((cb * 4 + kb) * 2 + s) * 64], Sp[kb][s], ot[cb], 0, 0, 0); }
#pragma unroll
            for (int r = 0; r < 16; ++r) vn[cb][r] = bf2f(U[(cb * 32 + crow_dev(r, hi)) * 128 + vb * 32 + r32]) - ws[r];
        }
        bf16x8 Vp[2][2];
#pragma unroll
        for (int cb = 0; cb < 2; ++cb)
#pragma unroll
            for (int s = 0; s < 2; ++s) { v4u w; w.x = pk2(vn[cb][8 * s], vn[cb][8 * s + 1]); w.y = pk2(vn[cb][8 * s + 2], vn[cb][8 * s + 3]); w.z = pk2(vn[cb][8 * s + 4], vn[cb][8 * s + 5]); w.w = pk2(vn[cb][8 * s + 6], vn[cb][8 * s + 7]); Vp[cb][s] = __builtin_bit_cast(bf16x8, w); }
#pragma unroll
        for (int cb = 0; cb < 2; ++cb)
#pragma unroll
            for (int c2 = 0; c2 <= cb; ++c2)
#pragma unroll
                for (int s = 0; s < 2; ++s) ot[cb] = __builtin_amdgcn_mfma_f32_32x32x16_bf16(AF[((cb * 2 + c2) * 2 + s) * 64], Vp[c2][s], ot[cb], 0, 0, 0);
        { const int row0 = gdn_item_row(item, 0);
#pragma unroll
          for (int cb = 0; cb < 2; ++cb)
#pragma unroll
              for (int r = 0; r < 16; ++r) OB[(size_t)(row0 + cb * 32 + crow_dev(r, hi)) * WIDTH_B + h * 128 + vb * 32 + r32] = (bf16)f2bf(ot[cb][r]); }
#pragma unroll
        for (int kb = 0; kb < 4; ++kb) {
#pragma unroll
            for (int r = 0; r < 16; ++r) S[kb][r] *= egl;
#pragma unroll
            for (int cb = 0; cb < 2; ++cb)
#pragma unroll
                for (int s = 0; s < 2; ++s) S[kb] = __builtin_amdgcn_mfma_f32_32x32x16_bf16(KF[((kb * 2 + cb) * 2 + s) * 64], Vp[cb][s], S[kb], 0, 0, 0);
        }
        GCH_BAR();
    }
#pragma unroll
    for (int kb = 0; kb < 4; ++kb)
#pragma unroll
        for (int r = 0; r < 16; ++r) dout[(size_t)(kb * 32 + crow_dev(r, hi)) * HEAD_DIM_B + vb * 32 + r32] = S[kb][r];
}
__device__ __forceinline__ void p_gdn_chain(Frame& F, int l) {
    const KArgs ap = kargs(); const auto& a = *ap; WS_OPAQUE(a);
    const unsigned char* GD = wsb + a.off[R_GDN]; bf16* OB = (bf16*)(wsb + a.off[R_OB]);
    if (F.vcu % 32 == 0 && F.vcu / 32 < BATCH * N_HEADS_B) { const int sh = F.vcu / 32, sq = sh / N_HEADS_B, h = sh % N_HEADS_B;
        gdn_chain_wg(F, GD, OB, GOUT(a) + O_DP + (((size_t)l * BATCH + sq) * N_HEADS_B + h) * HEAD_DIM_B * HEAD_DIM_B, sh * GDN_NCH, h, (gu32*)wsb + CW_GDNFLAG + 64 * sh, (unsigned)(l + 1)); }
    else { const int q = F.vcu - F.vcu / 32 - 1;
        if (q < 18) { p_gdn_chunk<1>(F, l, q);
            if (q < 16) { const int tid = otid(), lane = tid & 63, wave = __builtin_amdgcn_readfirstlane(tid >> 6);
#pragma unroll
                for (int tt = 0; tt < 2; ++tt) { const int t = wave + 8 * tt, s = 4 * q + (t >> 2), vb = t & 3, bs = s >> 2, h = s & 3; const size_t so = (((size_t)l * DEC_BATCH + bs) * N_HEADS_B + h) * HEAD_DIM_B * HEAD_DIM_B;
                    gdn_chain(GD, OB, GIN(a, I_SDELTA) + so, GOUT(a) + O_DS + so, GDN_NPI + s, 1, h, vb, lane); } } } }
}
__device__ __forceinline__ void p_mixpost_b(Frame& F, int l) {
    const KArgs ap = kargs(); const auto& a = *ap; WS_OPAQUE(a);
    const int tid = otid(), lane = tid & 63, wave = __builtin_amdgcn_readfirstlane(tid >> 6);
    const bf16* OB = (const bf16*)(wsb + a.off[R_OB]); bf16* OBN = (bf16*)(wsb + a.off[R_OBN]); const bf16* Z = (const bf16*)(wsb + a.off[R_Z]);
    const int gw = F.vcu * NWAVES + wave, NGW = F.G * NWAVES, e0 = 8 * (lane & 15);
    float gn[8];
#pragma unroll
    for (int j = 0; j < 8; ++j) gn[j] = GIN(a, I_GDNN)[l * HEAD_DIM_B + e0 + j];
    v4u n0 = *(const GAS v4u*)(OB + (size_t)gw * WIDTH_B + 8 * lane), n1 = *(const GAS v4u*)(Z + (size_t)gw * ZN + ZC_GB + 8 * lane);
    for (int m = gw; m < RP; m += NGW) {
        float o[8], gt[8];
        unpack8(n0, o); unpack8(n1, gt);
        { const int mn = m + NGW < RP ? m + NGW : gw; n0 = *(const GAS v4u*)(OB + (size_t)mn * WIDTH_B + 8 * lane); n1 = *(const GAS v4u*)(Z + (size_t)mn * ZN + ZC_GB + 8 * lane); }
        float ss = 0.f;
#pragma unroll
        for (int j = 0; j < 8; ++j) ss += o[j] * o[j];
        ss = sum16(ss);
        const float r = __builtin_amdgcn_rsqf(ss * (1.f / 128.f) + EPSF);
#pragma unroll
        for (int j = 0; j < 8; ++j) o[j] = o[j] * r * gn[j] * gt[j] * sigm(gt[j]);
        *(GAS v4u*)(OBN + (size_t)m * WIDTH_B + 8 * lane) = pack8(o);
    }
}
constexpr int S5_M1 = 0, S5_M2 = 131072, S5_M3 = 196608, S5_L16 = 262144, S5_TSTRIDE = 262656;
constexpr int S5_NCHK = RP / 16;
constexpr int S5_NBLK = S5_NCHK / 32;
constexpr int S5_PCH = PEND / 16;
static_assert(S5_NCHK % 32 == 0 && LPP % 16 == 0 && PADF % 16 == 0 && S5_STATE == 64 && S5_GROUPS == 32, "s5 shapes");

__device__ __forceinline__ void s5_tables(Frame& F) {
    const KArgs ap = kargs(); const auto& a = *ap; WS_OPAQUE(a);
    const int tid = otid();
    LAS float* pw = (LAS float*)(F.lds + RING_OFF);
    LAS float* bb = pw + 17 * 128;
    LAS float* Kt = bb + 64 * 32;
    for (int it = F.vcu; it < DEPTH * S5_GROUPS; it += F.G) {
        const int l = it / S5_GROUPS, g = it % S5_GROUPS; const size_t gp = ((size_t)l * S5_GROUPS + g) * S5_STATE;
        unsigned char* tb = wsb + a.off[R_S5T] + (size_t)it * S5_TSTRIDE;
        const float dt = __expf(GIN(a, I_LDT)[l * S5_GROUPS + g]);
        for (int e = tid; e < 17 * 64; e += NTHR) { const int k = e >> 6, p = e & 63; const float ar = GIN(a, I_AR)[gp + p] * dt * (float)k, ai = GIN(a, I_AI)[gp + p] * dt * (float)k;
            float sn, cs; sincosf(ai, &sn, &cs); const float er = expf(ar); pw[e * 2] = er * cs; pw[e * 2 + 1] = er * sn; }
        __syncthreads();
        for (int e = tid; e < 64 * 16; e += NTHR) { const int p = e >> 4; const float ar = GIN(a, I_AR)[gp + p], ai = GIN(a, I_AI)[gp + p];
            const float nr = pw[(64 + p) * 2] - 1.f, ni = pw[(64 + p) * 2 + 1], den = ar * ar + ai * ai, fr = (nr * ar + ni * ai) / den, fi = (ni * ar - nr * ai) / den;
            const float br = GIN(a, I_BR)[gp * 16 + e], bi = GIN(a, I_BI)[gp * 16 + e]; bb[e * 2] = fr * br - fi * bi; bb[e * 2 + 1] = fr * bi + fi * br; }
        if (tid < 128) { const int p = tid & 63; ((float*)(tb + S5_L16))[tid] = pw[(16 * 64 + p) * 2 + (tid >> 6)]; }
        __syncthreads();
        const float* cre = GIN(a, I_CR) + ((size_t)l * S5_GROUPS + g) * 16 * 64; const float* cim = GIN(a, I_CI) + ((size_t)l * S5_GROUPS + g) * 16 * 64;
        { const int j = tid & 15, i = (tid >> 4) & 15;
          f32x4 c4r[16], c4i[16];
#pragma unroll
          for (int q = 0; q < 16; ++q) { c4r[q] = *(const GAS f32x4*)(cre + i * 64 + 4 * q); c4i[q] = *(const GAS f32x4*)(cim + i * 64 + 4 * q); }
#pragma clang loop unroll(disable)
          for (int d = tid >> 8; d < 16; d += 2) { float acc = 0.f;
#pragma unroll
              for (int p = 0; p < 64; ++p) { const float cr = c4r[p >> 2][p & 3], ci = c4i[p >> 2][p & 3], pr = pw[(d * 64 + p) * 2], pi = pw[(d * 64 + p) * 2 + 1];
                  const float tr = cr * pr - ci * pi, ti = cr * pi + ci * pr; acc += tr * bb[(p * 16 + j) * 2] - ti * bb[(p * 16 + j) * 2 + 1]; }
              Kt[(d * 16 + i) * 16 + j] = acc; } }
        __syncthreads();
        bf16* M1 = (bf16*)(tb + S5_M1); bf16* M2 = (bf16*)(tb + S5_M2); bf16* M3 = (bf16*)(tb + S5_M3);
        for (int e = tid; e < 65536; e += NTHR) { const int n = e >> 8, k = e & 255, tau = n >> 4, i = n & 15, sg = k >> 4, j = k & 15;
            float v = 0.f; if (sg <= tau) { v = Kt[((tau - sg) * 16 + i) * 16 + j]; if (sg == tau && i == j) v += GIN(a, I_SD)[(l * S5_GROUPS + g) * 16 + i]; }
            M1[e] = (bf16)f2bf(v); }
        for (int e = tid; e < 32768; e += NTHR) { const int n = e >> 8, k = e & 255, ri = n >> 6, p = n & 63, sg = k >> 4, j = k & 15;
            const float pr = pw[((15 - sg) * 64 + p) * 2], pi = pw[((15 - sg) * 64 + p) * 2 + 1], br = bb[(p * 16 + j) * 2], bi = bb[(p * 16 + j) * 2 + 1];
            M2[e] = (bf16)f2bf(ri == 0 ? pr * br - pi * bi : pr * bi + pi * br); }
        for (int e = tid; e < 32768; e += NTHR) { const int n = e >> 7, k = e & 127, tau = n >> 4, i = n & 15, ri = k >> 6, p = k & 63;
            const float cr = cre[i * 64 + p], ci = cim[i * 64 + p], pr = pw[((tau + 1) * 64 + p) * 2], pi = pw[((tau + 1) * 64 + p) * 2 + 1];
            M3[e] = (bf16)f2bf(ri == 0 ? cr * pr - ci * pi : -(cr * pi + ci * pr)); }
        __syncthreads();
    }
}
__device__ __forceinline__ void p_s5_e(Frame& F, int l) {
    const KArgs ap = kargs(); const auto& a = *ap; WS_OPAQUE(a);
    const int tid = otid(), lane = tid & 63, wave = __builtin_amdgcn_readfirstlane(tid >> 6), r32 = lane & 31, hi = lane >> 5;
    const bf16* Z = (const bf16*)(wsb + a.off[R_Z]); float* E = (float*)(wsb + a.off[R_S5E]);
    for (int u = F.vcu * NWAVES + wave; u < S5_NBLK * S5_GROUPS; u += F.G * NWAVES) {
        const int blk = u / S5_GROUPS, g = u % S5_GROUPS;
        const unsigned char* tb = wsb + a.off[R_S5T] + (size_t)(l * S5_GROUPS + g) * S5_TSTRIDE;
        const GAS bf16x8* M2 = (const GAS bf16x8*)(tb + S5_M2);
        const bf16* zr = Z + (size_t)((blk * 32 + r32) * 16) * ZN + ZC_UC + g * 16 + 8 * hi;
        f32x16 acc[4];
#pragma unroll
        for (int nb = 0; nb < 4; ++nb)
#pragma unroll
            for (int r = 0; r < 16; ++r) acc[nb][r] = 0.f;
#pragma unroll 4
        for (int sg = 0; sg < 16; ++sg) { const bf16x8 af = *(const GAS bf16x8*)(zr + (size_t)sg * ZN);
#pragma unroll
            for (int nb = 0; nb < 4; ++nb) acc[nb] = __builtin_amdgcn_mfma_f32_32x32x16_bf16(af, M2[((nb * 32 + r32) * 256 + sg * 16 + 8 * hi) >> 3], acc[nb], 0, 0, 0); }
#pragma unroll
        for (int nb = 0; nb < 4; ++nb)
#pragma unroll
            for (int r = 0; r < 16; ++r) E[((size_t)(blk * 32 + crow_dev(r, hi)) * S5_GROUPS + g) * 128 + nb * 32 + r32] = acc[nb][r];
    }
}
__device__ __forceinline__ void s5_scan_task(const float* E, bf16* XP, const float* l16, int g, int c0, int nch, float xr, float xi, float* ore, float* oim, int lane) {
    const float lr = l16[lane], li = l16[64 + lane];
    int c = 0;
    for (; c + 8 <= nch; c += 8) { float er[8], ei[8];
#pragma unroll
        for (int q = 0; q < 8; ++q) { const float* e = E + ((size_t)(c0 + c + q) * S5_GROUPS + g) * 128; er[q] = e[lane]; ei[q] = e[64 + lane]; }
#pragma unroll
        for (int q = 0; q < 8; ++q) { bf16* xp = XP + ((size_t)(c0 + c + q) * S5_GROUPS + g) * 128; xp[lane] = (bf16)f2bf(xr); xp[64 + lane] = (bf16)f2bf(xi);
            const float nr = lr * xr - li * xi + er[q], ni = lr * xi + li * xr + ei[q]; xr = nr; xi = ni; } }
    for (; c < nch; ++c) { const float* e = E + ((size_t)(c0 + c) * S5_GROUPS + g) * 128; bf16* xp = XP + ((size_t)(c0 + c) * S5_GROUPS + g) * 128; xp[lane] = (bf16)f2bf(xr); xp[64 + lane] = (bf16)f2bf(xi);
        const float nr = lr * xr - li * xi + e[lane], ni = lr * xi + li * xr + e[64 + lane]; xr = nr; xi = ni; }
    ore[lane] = xr; oim[lane] = xi;
}
constexpr int S5_NTASK = (BATCH + DEC_BATCH) * S5_GROUPS;
__device__ __forceinline__ void s5_scan_run(Frame& F, int l, int t, int lane) {
    const KArgs ap = kargs(); const auto& a = *ap; WS_OPAQUE(a);
    const int sq = t / S5_GROUPS, g = t % S5_GROUPS;
    const float* E = (const float*)(wsb + a.off[R_S5E]); bf16* XP = (bf16*)(wsb + a.off[R_S5X]);
    const float* l16 = (const float*)(wsb + a.off[R_S5T] + (size_t)(l * S5_GROUPS + g) * S5_TSTRIDE + S5_L16);
    if (sq < BATCH) { const size_t oo = (((size_t)l * BATCH + sq) * S5_GROUPS + g) * S5_STATE;
        s5_scan_task(E, XP, l16, g, sq * (LPP / 16), S5_PCH, 0.f, 0.f, GOUT(a) + O_SRP + oo, GOUT(a) + O_SIP + oo, lane); }
    else { const int bs = sq - BATCH; const size_t oo = (((size_t)l * DEC_BATCH + bs) * S5_GROUPS + g) * S5_STATE;
        s5_scan_task(E, XP, l16, g, SROW0 / 16 + bs * (DEC_SEQ / 16), DEC_SEQ / 16, GIN(a, I_SRE)[oo + lane], GIN(a, I_SIM)[oo + lane], GOUT(a) + O_SRS + oo, GOUT(a) + O_SIS + oo, lane); }
}
__device__ __forceinline__ float gelu_tanh(float x) { const float z = 0.7978845608028654f * (x + 0.044715f * x * x * x); const float t = 1.f - 2.f * __builtin_amdgcn_rcpf(__expf(2.f * z) + 1.f); return 0.5f * x * (1.f + t); }
__device__ __forceinline__ void p_s5_out(Frame& F, int l) {
    const KArgs ap = kargs(); const auto& a = *ap; WS_OPAQUE(a);
    const int tid = otid(), lane = tid & 63, wave = __builtin_amdgcn_readfirstlane(tid >> 6), r32 = lane & 31, hi = lane >> 5;
    const bf16* Z = (const bf16*)(wsb + a.off[R_Z]); const bf16* XP = (const bf16*)(wsb + a.off[R_S5X]); bf16* YC = (bf16*)(wsb + a.off[R_YC]);
    constexpr int NB_TOT = S5_NBLK * S5_GROUPS * 8;
    const int gwv = F.vcu * NWAVES + wave, NGW = F.G * NWAVES;
    const int b0 = (int)((long long)gwv * NB_TOT / NGW), b1 = (int)((long long)(gwv + 1) * NB_TOT / NGW);
    for (int bb = b0; bb < b1; ++bb) {
        const int u = bb >> 3, nb = bb & 7, blk = u / S5_GROUPS, g = u % S5_GROUPS;
        const unsigned char* tb = wsb + a.off[R_S5T] + (size_t)(l * S5_GROUPS + g) * S5_TSTRIDE;
        const GAS bf16x8* M1 = (const GAS bf16x8*)(tb + S5_M1); const GAS bf16x8* M3 = (const GAS bf16x8*)(tb + S5_M3);
        const bf16* zr = Z + (size_t)((blk * 32 + r32) * 16) * ZN + ZC_UC + g * 16 + 8 * hi;
        const bf16* xr = XP + ((size_t)(blk * 32 + r32) * S5_GROUPS + g) * 128 + 8 * hi;
        f32x16 acc;
#pragma unroll
        for (int r = 0; r < 16; ++r) acc[r] = 0.f;
#pragma unroll
        for (int sg = 0; sg < 16; ++sg) acc = __builtin_amdgcn_mfma_f32_32x32x16_bf16(*(const GAS bf16x8*)(zr + (size_t)sg * ZN), M1[((nb * 32 + r32) * 256 + sg * 16 + 8 * hi) >> 3], acc, 0, 0, 0);
#pragma unroll
        for (int s = 0; s < 8; ++s) acc = __builtin_amdgcn_mfma_f32_32x32x16_bf16(*(const GAS bf16x8*)(xr + 16 * s), M3[((nb * 32 + r32) * 128 + s * 16 + 8 * hi) >> 3], acc, 0, 0, 0);
#pragma unroll
        for (int r = 0; r < 16; ++r) { const int row = (blk * 32 + crow_dev(r, hi)) * 16 + 2 * nb + (r32 >> 4);
            YC[(size_t)row * WIDTH_C + g * 16 + (r32 & 15)] = (bf16)f2bf(gelu_tanh(acc[r])); }
    }
}
__device__ __forceinline__ int rdlane_i(int v, int i) { return __builtin_amdgcn_readlane(v, i); }
constexpr float NEG_BIG = -3.0e38f;
__device__ __forceinline__ unsigned fkey(float v) { const unsigned u = __builtin_bit_cast(unsigned, v); return (u & 0x80000000u) ? ~u : (u | 0x80000000u); }
__device__ __forceinline__ int mbcnt64(unsigned long long m) { return __builtin_amdgcn_mbcnt_hi((unsigned)(m >> 32), __builtin_amdgcn_mbcnt_lo((unsigned)m, 0)); }
__device__ __forceinline__ void pro_wqs(Frame& F) {
    const KArgs ap = kargs(); const auto& a = *ap; WS_OPAQUE(a);
    const int tid = otid(), lane = tid & 63, wave = __builtin_amdgcn_readfirstlane(tid >> 6);
    bf16* WQ = (bf16*)(wsb + a.off[R_WQS]);
    LAS f32x4* skl = (LAS f32x4*)(F.lds + RING_OFF);
    typedef float f32x2w __attribute__((ext_vector_type(2)));
    for (int t = F.vcu; t < DEPTH * 64; t += F.G) {
        const int l = t >> 6, hc = (t >> 2) & 15, kh = (t >> 1) & 1, nh = t & 1, k = (kh * 8 + wave) * 64 + lane;
        __syncthreads();
        { const GAS f32x4* src = (const GAS f32x4*)(GIN(a, I_PSK) + (((size_t)l * 16 + hc) * 128 + nh * 64) * 128);
#pragma unroll
          for (int q = 0; q < 4; ++q) skl[tid + NTHR * q] = src[tid + NTHR * q]; }
        const float* wr = GIN(a, I_PWQ) + ((size_t)l * D_MODEL + k) * PQ + hc * 128;
        f32x4 w[32];
#pragma unroll
        for (int d = 0; d < 32; ++d) w[d] = *(const GAS f32x4*)(wr + 4 * d);
        const float g2k = GIN(a, I_N2)[(size_t)l * D_MODEL + k];
        bf16* o = WQ + ((size_t)l * PQ + hc * 128 + nh * 64) * D_MODEL + k;
        __syncthreads();
#pragma clang loop vectorize(disable) unroll(disable)
        for (int n = 0; n < 64; ++n) { LAS f32x4* sr = skl + n * 32; f32x2w a0 = {0.f, 0.f}, a1 = {0.f, 0.f};
#pragma unroll
            for (int d = 0; d < 32; ++d) { const f32x4 s = sr[d]; a0 += (f32x2w){w[d].x, w[d].y} * (f32x2w){s.x, s.y}; a1 += (f32x2w){w[d].z, w[d].w} * (f32x2w){s.z, s.w}; }
            o[(size_t)n * D_MODEL] = (bf16)f2bf(((a0.x + a0.y) + (a1.x + a1.y)) * g2k); }
    }
    __syncthreads();
}
__device__ __forceinline__ void pro_wrest(Frame& F) {
    const KArgs ap = kargs(); const auto& a = *ap; WS_OPAQUE(a);
    const int tid = otid(), lane = tid & 63, wave = __builtin_amdgcn_readfirstlane(tid >> 6);
    LAS float* scr = (LAS float*)(F.lds + RING_OFF + wave * 16384);
    const int gw = F.vcu * NWAVES + wave, NGW = F.G * NWAVES;
    bf16* WG = (bf16*)(wsb + a.off[R_WGLU]); bf16* WB = (bf16*)(wsb + a.off[R_WBR]); bf16* WO = (bf16*)(wsb + a.off[R_WOUT]);
    constexpr int IG = (512 / 64) * (1024 / 32), IB = IG, IO = (1024 / 64) * (1024 / 32), IL = IG + 3 * IB + IO;
    TrItem A, B;
#define WR_LOAD(T, it_) do { const int l_ = (it_) / IL; int r_ = (it_) % IL; \
        if (r_ < IG) tr_load(T, GIN(a, I_WGLU) + (size_t)l_ * 512 * 1024, 1024, 32 * (r_ % 32), 64 * (r_ / 32), CmGlu(), lane); \
        else if (r_ < IG + 3 * IB) { const int w_ = (r_ - IG) / IB, q_ = (r_ - IG) % IB; tr_load(T, GIN(a, I_WBA + w_) + (size_t)l_ * 512 * 1024, 1024, 32 * (q_ % 32), 64 * (q_ / 32), CmId(), lane); } \
        else { r_ -= IG + 3 * IB; tr_load(T, GIN(a, I_WOUT) + (size_t)l_ * 1024 * 1024, 1024, 32 * (r_ % 32), 64 * (r_ / 32), CmId(), lane); } } while (0)
    if (gw < DEPTH * IL) WR_LOAD(A, gw);
    for (int it = gw; it < DEPTH * IL; it += NGW) { const int l = it / IL; int r = it % IL;
        if (it + NGW < DEPTH * IL) WR_LOAD(B, it + NGW);
        if (r < IG) tr_store(A, 512, WG + (size_t)l * 1024 * 512, 32 * (r % 32), 64 * (r / 32), scr, lane);
        else if (r < IG + 3 * IB) { const int w = (r - IG) / IB, q = (r - IG) % IB; tr_store(A, 512, WB + ((size_t)l * 3 + w) * 1024 * 512, 32 * (q % 32), 64 * (q / 32), scr, lane); }
        else { r -= IG + 3 * IB; tr_store(A, 1024, WO + (size_t)l * 1024 * 1024, 32 * (r % 32), 64 * (r / 32), scr, lane); }
        A = B; }
#undef WR_LOAD
}
typedef float f32x2v __attribute__((ext_vector_type(2)));
__device__ __forceinline__ unsigned pk_i8(const f32x4 x, float inv) {
    const int a = (int)rintf(x.x * inv), b = (int)rintf(x.y * inv), c = (int)rintf(x.z * inv), d = (int)rintf(x.w * inv);
    return (unsigned)(a & 0xff) | ((unsigned)(b & 0xff) << 8) | ((unsigned)(c & 0xff) << 16) | ((unsigned)(d & 0xff) << 24); }
constexpr size_t PEER_ROWS = (size_t)DEPTH * N_EXPERTS; constexpr int PU_ROWB = 512;
constexpr int PV_ROWB = 768;
constexpr int PE_RECB = PU_ROWB + PV_ROWB;
typedef unsigned v3u __attribute__((ext_vector_type(3)));
typedef unsigned v3u_a4 __attribute__((ext_vector_type(3), aligned(4)));
typedef unsigned v6u __attribute__((ext_vector_type(6)));
typedef float f32x32 __attribute__((ext_vector_type(32)));
__device__ __forceinline__ unsigned e2m3_code(float y) { const float a = fabsf(y); float c = a < 2.f ? a * 8.f : (a < 4.f ? 8.f + (a - 2.f) * 4.f + 8.f : 24.f + (a - 4.f) * 2.f);
    const unsigned m = (unsigned)fminf(rintf(c), 31.f); return m | (y < 0.f ? 32u : 0u); }
typedef unsigned v3u __attribute__((ext_vector_type(3)));
typedef unsigned v3u_a4 __attribute__((ext_vector_type(3), aligned(4)));
__device__ __forceinline__ float absmax16(const f32x4 x0, const f32x4 x1, const f32x4 x2, const f32x4 x3) {
    float mx = fmaxf(fmaxf(fmaxf(fabsf(x0.x), fabsf(x0.y)), fmaxf(fabsf(x0.z), fabsf(x0.w))), fmaxf(fmaxf(fabsf(x1.x), fabsf(x1.y)), fmaxf(fabsf(x1.z), fabsf(x1.w))));
    return fmaxf(mx, fmaxf(fmaxf(fmaxf(fabsf(x2.x), fabsf(x2.y)), fmaxf(fabsf(x2.z), fabsf(x2.w))), fmaxf(fmaxf(fabsf(x3.x), fabsf(x3.y)), fmaxf(fabsf(x3.z), fabsf(x3.w)))));
}
__device__ __forceinline__ unsigned pk_fp8(const f32x4 x, float inv) { int t = __builtin_amdgcn_cvt_pk_fp8_f32(x.x * inv, x.y * inv, 0, false); t = __builtin_amdgcn_cvt_pk_fp8_f32(x.z * inv, x.w * inv, t, true); return (unsigned)t; }
constexpr int PW_RB = 8, PW_IR = NWAVES * PW_RB, PW_ITEMS_L = 2 * (N_EXPERTS / PW_IR), PW_ITEMS = DEPTH * PW_ITEMS_L, CW_PWQ = CW_QUEUE + 64 * 24;
__device__ __forceinline__ void peerw_item(Frame& F, int it) {
    const KArgs ap = kargs(); const auto& a = *ap; WS_OPAQUE(a);
    const int tid = otid(), lane = tid & 63, wave = __builtin_amdgcn_readfirstlane(tid >> 6);
    float* SCL = (float*)(wsb + a.off[R_MISC]);
    constexpr int RB = PW_RB;
    const int l = it / PW_ITEMS_L, r_ = it % PW_ITEMS_L, w = r_ / (N_EXPERTS / PW_IR), blk = r_ % (N_EXPERTS / PW_IR);
    const size_t row0 = (size_t)l * N_EXPERTS + blk * PW_IR + wave * RB, rw0 = row0 + (w ? PEER_ROWS : 0);
    f32x4 x[RB][4];
#pragma unroll
    for (int r = 0; r < RB; ++r) { const GAS f32x4* src = (const GAS f32x4*)(GIN(a, I_PU + w) + (row0 + r) * D_MODEL) + 4 * lane;
#pragma unroll
        for (int j = 0; j < 4; ++j) x[r][j] = src[j]; }
#pragma unroll
    for (int r = 0; r < RB; ++r) { const float mx = wave_max(absmax16(x[r][0], x[r][1], x[r][2], x[r][3])); v4u o;
        if (w == 0) { float s2_ = 0.f;
#pragma unroll
            for (int j = 0; j < 4; ++j) s2_ += (x[r][j].x * x[r][j].x + x[r][j].y * x[r][j].y) + (x[r][j].z * x[r][j].z + x[r][j].w * x[r][j].w);
            const float clip = fminf(mx, 2.6f * __builtin_sqrtf(wave_sum(s2_) * (1.f / D_MODEL)));
            const float inv = clip > 0.f ? 7.f / clip : 0.f;
            v2u o2;
#pragma unroll
            for (int d = 0; d < 2; ++d) { const f32x4 xa = x[r][2 * d], xb = x[r][2 * d + 1];
#define PW_Q4(v_) ((unsigned)((int)fminf(fmaxf(rintf((v_) * inv), -7.f), 7.f) + 8))
                const unsigned w_ = PW_Q4(xa.x) | (PW_Q4(xa.y) << 4) | (PW_Q4(xa.z) << 8) | (PW_Q4(xa.w) << 12) | (PW_Q4(xb.x) << 16) | (PW_Q4(xb.y) << 20) | (PW_Q4(xb.z) << 24) | (PW_Q4(xb.w) << 28);
#undef PW_Q4
                if (d == 0) o2.x = w_; else o2.y = w_; }
            if (lane == 0) SCL[rw0 + r] = clip * (1.f / 7.f);
            *((GAS v2u*)(wsb + a.off[R_PU] + (row0 + r) * PE_RECB) + lane) = o2; }
        else { const float inv = mx > 0.f ? 7.5f / mx : 0.f;
            unsigned q_[16];
#pragma unroll
            for (int j = 0; j < 4; ++j) { q_[4 * j] = e2m3_code(x[r][j].x * inv); q_[4 * j + 1] = e2m3_code(x[r][j].y * inv); q_[4 * j + 2] = e2m3_code(x[r][j].z * inv); q_[4 * j + 3] = e2m3_code(x[r][j].w * inv); }
            v3u o3; o3.x = q_[0] | (q_[1] << 6) | (q_[2] << 12) | (q_[3] << 18) | (q_[4] << 24) | ((q_[5] & 3u) << 30);
            o3.y = (q_[5] >> 2) | (q_[6] << 4) | (q_[7] << 10) | (q_[8] << 16) | (q_[9] << 22) | ((q_[10] & 15u) << 28);
            o3.z = (q_[10] >> 4) | (q_[11] << 2) | (q_[12] << 8) | (q_[13] << 14) | (q_[14] << 20) | (q_[15] << 26);
            if (lane == 0) SCL[rw0 + r] = mx * (1.f / 7.5f);
            *(GAS v3u_a4*)(wsb + a.off[R_PU] + (row0 + r) * PE_RECB + PU_ROWB + 12 * lane) = o3; } }
}
__device__ __forceinline__ void peerw_drain(Frame& F, int limit) {
    const KArgs ap = kargs(); const auto& a = *ap; WS_OPAQUE(a);
    const bool lead = F.wv == 0 && lane_id() == 0;
    for (;;) {
        if (lead) { const unsigned kept = F.MISC[23]; F.MISC[23] = 0u; F.MISC[24] = kept ? 1u : 0u;
            F.MISC[21] = kept ? kept - 1u : (F.MISC[22] ? (unsigned)PW_ITEMS : __hip_atomic_fetch_add((gu32*)wsb + CW_PWQ, 1u, RLX_AGENT)); }
        __syncthreads();
        const int it = (int)F.MISC[21]; const bool kept = F.MISC[24] != 0u;
        __syncthreads();
        if (it >= PW_ITEMS) { if (lead) F.MISC[22] = 1u; break; }
        peerw_item(F, it);
        if (!kept && it >= limit) break;
    }
}
__device__ __forceinline__ void xcd_barrier_steal(const XcdBarrier& b, Frame& F) {
    const KArgs ap = kargs(); const auto& a = *ap; WS_OPAQUE(a);
    asm volatile("s_waitcnt vmcnt(0)" ::: "memory");
    __syncthreads();
    const bool lead = b.wv == 0 && lane_id() == 0;
    unsigned gen = 0u;
    if (lead) {
        unsigned* bar = b.bar;
        __builtin_amdgcn_s_waitcnt(0);
        unsigned nloc = b.st[0], nx = b.st[1];
        if (nloc == 0u) { xcd_barrier_complete(bar, b.x, nloc, nx); b.st[0] = nloc; b.st[1] = nx; }
        const unsigned old = xb_add(&bar[XB_XSUB(b.x)], 1u);
        gen = old / nloc;
        if (old + 1u == (gen + 1u) * nloc) {
            __builtin_amdgcn_fence(__ATOMIC_RELEASE, "agent");
            asm volatile("s_waitcnt vmcnt(0)" ::: "memory");
            const unsigned og = xb_add(&bar[XB_TOP], 1u);
            const unsigned tg = og / nx;
            if (og + 1u == (tg + 1u) * nx) xb_add(&bar[XB_TOPGEN], 1u);
            else XB_SPIN(xb_ld(&bar[XB_TOPGEN]) == tg, bar);
            __builtin_amdgcn_fence(__ATOMIC_ACQUIRE, "agent");
            xb_add(&bar[XB_XGEN(b.x)], 1u);
            asm volatile("s_waitcnt vmcnt(0)" ::: "memory");
            F.MISC[20] = 1u;
        } else F.MISC[20] = 0u;
    }
    unsigned sp = 0u;
    for (;;) {
        if (lead && F.MISC[20] == 0u) {
            unsigned* bar = b.bar;
            bool rel = xb_ld(&bar[XB_XGEN(b.x)]) != gen;
            if (!rel && F.MISC[22] && !F.MISC[23]) {
                XB_SPIN(xb_ld(&bar[XB_XGEN(b.x)]) == gen, bar); rel = true; }
            if (!rel && (++sp & 1023u) == 0u && xb_ld(&bar[XB_TMO])) rel = true;
            if (rel) { __builtin_amdgcn_fence(__ATOMIC_ACQUIRE, "agent"); asm volatile("s_waitcnt vmcnt(0)" ::: "memory"); F.MISC[20] = 1u; }
            else { const unsigned kept = F.MISC[23]; F.MISC[23] = 0u;
                const unsigned it = kept ? kept - 1u : __hip_atomic_fetch_add((gu32*)wsb + CW_PWQ, 1u, RLX_AGENT); F.MISC[21] = it; if (it >= (unsigned)PW_ITEMS) F.MISC[22] = 1u; }
        }
        __syncthreads();
        const unsigned done = F.MISC[20], it = F.MISC[21];
        __syncthreads();
        if (done) break;
        if (it < (unsigned)PW_ITEMS) {
            const bool ahead = lead && !F.MISC[22]; unsigned nxi = 0u;
            if (ahead) nxi = __hip_atomic_fetch_add((gu32*)wsb + CW_PWQ, 1u, RLX_AGENT);
            peerw_item(F, (int)it);
            if (ahead) { if (nxi < (unsigned)PW_ITEMS) F.MISC[23] = nxi + 1u; else F.MISC[22] = 1u; }
        }
    }
}
__device__ __forceinline__ void pro_peerw(Frame& F) { for (int it = F.vcu; it < PW_ITEMS; it += F.G) peerw_item(F, it); }
__device__ __forceinline__ void fp8x16_to_f32(const v4u q, float (&f)[16]) {
#pragma unroll
    for (int d = 0; d < 4; ++d) { const int w = (int)(d == 0 ? q.x : d == 1 ? q.y : d == 2 ? q.z : q.w);
        const f32x2v lo = __builtin_amdgcn_cvt_pk_f32_fp8(w, false), hi = __builtin_amdgcn_cvt_pk_f32_fp8(w, true); f[4 * d] = lo.x; f[4 * d + 1] = lo.y; f[4 * d + 2] = hi.x; f[4 * d + 3] = hi.y; }
}
#define PK_BIS(NDPP) do { if (!kdone) { const unsigned t_ = kp | (1u << kbit); int c_ = 0; _Pragma("unroll") for (int c4 = 0; c4 < 8; ++c4) { const v4u k4 = keys[c4 * 64 + lane]; \
            c_ += (k4.x >= t_ ? 1 : 0) + (k4.y >= t_ ? 1 : 0); c_ += (k4.z >= t_ ? 1 : 0) + (k4.w >= t_ ? 1 : 0); } \
        c_ += dpp_i<0xB1>(c_); c_ += dpp_i<0x4E>(c_); if (NDPP == 3) c_ += dpp_i<0x141>(c_); const bool up_ = c_ >= 16; kp = up_ ? t_ : kp; kcp = up_ ? c_ : kcp; --kbit; \
        kdone = (__ballot(kcp != 16) == 0ull) || kbit < 0; } } while (0)
__device__ __forceinline__ void p_peer(Frame& F, int l, bool dry) {
    const KArgs ap = kargs(); const auto& a = *ap; WS_OPAQUE(a);
    const int tid = otid(), lane = tid & 63, wave = __builtin_amdgcn_readfirstlane(tid >> 6);
    const float* SC = (const float*)(wsb + a.off[R_SC]); float* X = (float*)(wsb + a.off[R_X]);
    const unsigned char* PU = wsb + a.off[R_PU] + (size_t)l * N_EXPERTS * PE_RECB; const unsigned char* PV = PU + PU_ROWB;
    const float* SCU = (const float*)(wsb + a.off[R_MISC]) + (size_t)l * N_EXPERTS; const float* SCV = SCU + PEER_ROWS;
    LAS float* stop = (LAS float*)(F.lds + RING_OFF + wave * 4096);
    LAS int* itop = (LAS int*)(stop + 256);
    LAS int* elb = itop + 256;
    LAS float* cfb = (LAS float*)(elb + 256);
    gu32* rq = (gu32*)wsb + CW_QUEUE + 64 * (8 + l + (dry ? DEPTH : 0));
    LAS v4u* keys = (LAS v4u*)(F.lds + RING_OFF + 32768 + wave * 8192);
    unsigned kp = 0u, kL1 = 0u; int kbit = 31, kcp = 1 << 20; bool kdone = false; float rsn = 0.f, hscn = 0.f; v4u hqn = {0u, 0u, 0u, 0u};
#define PK_WINDOW(NDPP, LVAR) do {   \
        unsigned mx_ = kk_[0]; _Pragma("unroll") for (int j = 1; j < 32; ++j) mx_ = mx_ > kk_[j] ? mx_ : kk_[j]; \
        { unsigned o_ = (unsigned)dpp_i<0xB1>((int)mx_); mx_ = mx_ > o_ ? mx_ : o_; o_ = (unsigned)dpp_i<0x4E>((int)mx_); mx_ = mx_ > o_ ? mx_ : o_; if (NDPP == 3) { o_ = (unsigned)dpp_i<0x141>((int)mx_); mx_ = mx_ > o_ ? mx_ : o_; } } \
        unsigned L_ = mx_ > (3u << 23) ? mx_ - (3u << 23) : 0u; int c_ = 0; _Pragma("unroll") for (int j = 0; j < 32; ++j) c_ += kk_[j] >= L_ ? 1 : 0; \
        c_ += dpp_i<0xB1>(c_); c_ += dpp_i<0x4E>(c_); if (NDPP == 3) c_ += dpp_i<0x141>(c_); \
        const bool ok_ = __ballot(c_ < 16 || L_ == 0u) == 0ull; L_ = ok_ ? L_ - 1u : 0u; kbit = ok_ ? 24 : 31; LVAR = L_;     \
        _Pragma("unroll") for (int j = 0; j < 8; ++j) { v4u w_; w_.x = (kk_[4 * j] > L_ ? kk_[4 * j] : L_) - L_; w_.y = (kk_[4 * j + 1] > L_ ? kk_[4 * j + 1] : L_) - L_; w_.z = (kk_[4 * j + 2] > L_ ? kk_[4 * j + 2] : L_) - L_; w_.w = (kk_[4 * j + 3] > L_ ? kk_[4 * j + 3] : L_) - L_; keys[j * 64 + lane] = w_; } \
        kp = 0u; kcp = 1 << 20; kdone = false; } while (0)
#define PK_BEGIN(m_) do {   \
        float hx_[16]; { const GAS f32x4* xr0 = (const GAS f32x4*)(X + (size_t)(m_) * D_MODEL + 16 * lane); const GAS f32x4* g4 = (const GAS f32x4*)(GIN(a, I_N2) + (size_t)l * D_MODEL + 16 * lane); float s2 = 0.f; \
          _Pragma("unroll") for (int j = 0; j < 4; ++j) { const f32x4 xv = xr0[j], gv = g4[j]; s2 += (xv.x * xv.x + xv.y * xv.y) + (xv.z * xv.z + xv.w * xv.w); hx_[4 * j] = xv.x * gv.x; hx_[4 * j + 1] = xv.y * gv.y; hx_[4 * j + 2] = xv.z * gv.z; hx_[4 * j + 3] = xv.w * gv.w; } \
          rsn = __builtin_amdgcn_rsqf(wave_sum(s2) * (1.f / D_MODEL) + EPSF); } \
        float hmx = 0.f; _Pragma("unroll") for (int j = 0; j < 16; ++j) { hx_[j] *= rsn; hmx = fmaxf(hmx, fabsf(hx_[j])); } \
        hmx = wave_max(hmx); const float hinv = hmx > 0.f ? 127.f / hmx : 0.f; hscn = hmx * (1.f / 127.f); \
        hqn.x = pk_i8((f32x4){hx_[0], hx_[2], hx_[4], hx_[6]}, hinv); hqn.y = pk_i8((f32x4){hx_[1], hx_[3], hx_[5], hx_[7]}, hinv); hqn.z = pk_i8((f32x4){hx_[8], hx_[10], hx_[12], hx_[14]}, hinv); hqn.w = pk_i8((f32x4){hx_[9], hx_[11], hx_[13], hx_[15]}, hinv);     \
        { const GAS f32x4* p4 = (const GAS f32x4*)(SC + (size_t)(m_) * PQ + (lane >> 2) * 128 + (lane & 3) * 32); \
          unsigned kk_[32]; _Pragma("unroll") for (int j = 0; j < 8; ++j) { const f32x4 v = p4[j]; kk_[4 * j] = fkey(v.x); kk_[4 * j + 1] = fkey(v.y); kk_[4 * j + 2] = fkey(v.z); kk_[4 * j + 3] = fkey(v.w); } \
          PK_WINDOW(2, kL1); } } while (0)
#define PK_MID() do {   \
        { int cl = 0; _Pragma("unroll") for (int c4 = 0; c4 < 8; ++c4) { const v4u k4 = keys[c4 * 64 + lane]; cl += (k4.x >= kp ? 1 : 0) + (k4.y >= kp ? 1 : 0) + (k4.z >= kp ? 1 : 0) + (k4.w >= kp ? 1 : 0); } \
          const int q_ = lane & 3, c0 = dpp_i<0x00>(cl), c1 = dpp_i<0x55>(cl), c2 = dpp_i<0xAA>(cl); int pos = (q_ > 0 ? c0 : 0) + (q_ > 1 ? c1 : 0) + (q_ > 2 ? c2 : 0); const int sb = (lane >> 2) * 16; \
          _Pragma("unroll") for (int c4 = 0; c4 < 8; ++c4) { const v4u k4 = keys[c4 * 64 + lane]; _Pragma("unroll") for (int e = 0; e < 4; ++e) { const unsigned kj = k4[e]; const bool sel = kj >= kp; \
              if (sel && pos < 16) { const unsigned kf_ = kj + kL1; const unsigned u_ = (kf_ & 0x80000000u) ? (kf_ ^ 0x80000000u) : ~kf_; stop[sb + pos] = __builtin_bit_cast(float, u_); itop[sb + pos] = q_ * 32 + 4 * c4 + e; } \
              pos += sel ? 1 : 0; } } } \
        LDS_WAIT(); \
        { const int h_ = lane >> 3, sub = lane & 7; const float s1a = stop[(2 * h_) * 16 + 2 * sub], s1b = stop[(2 * h_) * 16 + 2 * sub + 1]; \
          unsigned kk_[32]; _Pragma("unroll") for (int c4 = 0; c4 < 4; ++c4) { const f32x4 s2_ = *(LAS f32x4*)(stop + (2 * h_ + 1) * 16 + 4 * c4); \
              kk_[4 * c4] = fkey(s1a + s2_.x); kk_[4 * c4 + 1] = fkey(s1a + s2_.y); kk_[4 * c4 + 2] = fkey(s1a + s2_.z); kk_[4 * c4 + 3] = fkey(s1a + s2_.w); \
              kk_[16 + 4 * c4] = fkey(s1b + s2_.x); kk_[17 + 4 * c4] = fkey(s1b + s2_.y); kk_[18 + 4 * c4] = fkey(s1b + s2_.z); kk_[19 + 4 * c4] = fkey(s1b + s2_.w); } \
          unsigned kL2_; PK_WINDOW(3, kL2_); (void)kL2_; } } while (0)
#define PK_END(nb_) do {   \
        LAS int* el_ = elb + 128 * (nb_); LAS float* cf_ = cfb + 128 * (nb_); const int h_ = lane >> 3, sub = lane & 7; \
        int cl = 0; _Pragma("unroll") for (int c4 = 0; c4 < 8; ++c4) { const v4u k4 = keys[c4 * 64 + lane]; cl += (k4.x >= kp ? 1 : 0) + (k4.y >= kp ? 1 : 0) + (k4.z >= kp ? 1 : 0) + (k4.w >= kp ? 1 : 0); } \
        int x_ = cl; { int t_ = dpp_i<0x111>(x_); x_ += sub >= 1 ? t_ : 0; t_ = dpp_i<0x112>(x_); x_ += sub >= 2 ? t_ : 0; t_ = dpp_i<0x114>(x_); x_ += sub >= 4 ? t_ : 0; } \
        int pos = x_ - cl; \
        const float s1a = stop[(2 * h_) * 16 + 2 * sub], s1b = stop[(2 * h_) * 16 + 2 * sub + 1]; float s2_[16]; float cmax = NEG_BIG; \
        _Pragma("unroll") for (int j = 0; j < 16; ++j) { s2_[j] = stop[(2 * h_ + 1) * 16 + j]; cmax = fmaxf(cmax, s2_[j]); } \
        cmax += fmaxf(s1a, s1b); cmax = fmaxf(cmax, dpp_f<0xB1>(cmax)); cmax = fmaxf(cmax, dpp_f<0x4E>(cmax)); cmax = fmaxf(cmax, dpp_f<0x141>(cmax)); \
        const int i1a = itop[(2 * h_) * 16 + 2 * sub] * N_KEYS, i1b = itop[(2 * h_) * 16 + 2 * sub + 1] * N_KEYS; float esum = 0.f; \
        _Pragma("unroll") for (int c4 = 0; c4 < 8; ++c4) { const v4u k4 = keys[c4 * 64 + lane]; _Pragma("unroll") for (int e = 0; e < 4; ++e) { const int j = 4 * c4 + e; const bool sel = k4[e] >= kp; \
            if (sel && pos < 16) { const float ex = __expf(rsn * ((j < 16 ? s1a : s1b) + s2_[j & 15] - cmax)); esum += ex; \
                el_[h_ * 16 + pos] = (j < 16 ? i1a : i1b) + itop[(2 * h_ + 1) * 16 + (j & 15)]; cf_[h_ * 16 + pos] = ex; } \
            pos += sel ? 1 : 0; } } \
        esum = sum8(esum); const float inv_ = __builtin_amdgcn_rcpf(esum); \
        LDS_WAIT(); cf_[2 * lane] *= inv_; cf_[2 * lane + 1] *= inv_; LDS_WAIT(); } while (0)
    int cur = __builtin_amdgcn_readfirstlane(lane == 0 ? (int)__hip_atomic_fetch_add(rq, 1u, RLX_AGENT) : 0);
    if (cur >= NT) return;
    int nxt = __builtin_amdgcn_readfirstlane(lane == 0 ? (int)__hip_atomic_fetch_add(rq, 1u, RLX_AGENT) : 0);
    int buf = 0;
    PK_BEGIN(nat2prow(cur));
#pragma clang loop unroll(disable)
    for (int s = 0; s < 32; ++s) PK_BIS(2);
    PK_MID();
#pragma clang loop unroll(disable)
    for (int s = 0; s < 32; ++s) PK_BIS(3);
    PK_END(0);
    const bool lb0 = (lane & 1) != 0, lb1 = (lane & 2) != 0;
    for (;;) {
        const int m = nat2prow(cur); const bool has_next = nxt < NT;
        const v4u hq = hqn; const float hsc = hscn;
        LAS int* elist = elb + 128 * buf; LAS float* cf = cfb + 128 * buf;
        float out[16];
#pragma unroll
        for (int j = 0; j < 16; ++j) out[j] = 0.f;
        const int hs8 = -8 * __builtin_amdgcn_sdot4((int)hq.w, 0x01010101, __builtin_amdgcn_sdot4((int)hq.z, 0x01010101, __builtin_amdgcn_sdot4((int)hq.y, 0x01010101, __builtin_amdgcn_sdot4((int)hq.x, 0x01010101, 0, false), false), false), false);
        v2u uA[4], uB[4]; v3u vA[4], vB[4]; float suA, svA, cA, suB, svB, cB;
#define PEER_LOAD(U, V, SU, SV, CW, q0) do { { const int em_ = elist[(q0) + (lane & 3)]; CW = cf[(q0) + (lane & 3)]; SU = SCU[em_]; SV = SCV[em_]; } _Pragma("unroll") for (int i = 0; i < 4; ++i) { const int e_ = elist[(q0) + i]; \
            U[i] = *((const GAS v2u*)(PU + (size_t)e_ * PE_RECB) + lane); V[i] = *(const GAS v3u_a4*)(PV + (size_t)e_ * PE_RECB + 12 * lane); } } while (0)
#define PEER_COMP(U, V, SU, SV, CW) do { float d_[4]; _Pragma("unroll") for (int i = 0; i < 4; ++i) { \
            int di_ = __builtin_amdgcn_sdot4((int)(U[i].x & 0x0f0f0f0fu), (int)hq.x, hs8, false); di_ = __builtin_amdgcn_sdot4((int)((U[i].x >> 4) & 0x0f0f0f0fu), (int)hq.y, di_, false); \
            di_ = __builtin_amdgcn_sdot4((int)(U[i].y & 0x0f0f0f0fu), (int)hq.z, di_, false); di_ = __builtin_amdgcn_sdot4((int)((U[i].y >> 4) & 0x0f0f0f0fu), (int)hq.w, di_, false); d_[i] = (float)di_; } \
              \
            const float r0_ = (lb0 ? d_[1] : d_[0]) + dpp_f<0xB1>(lb0 ? d_[0] : d_[1]), r1_ = (lb0 ? d_[3] : d_[2]) + dpp_f<0xB1>(lb0 ? d_[2] : d_[3]); \
            float dsel_ = (lb1 ? r1_ : r0_) + dpp_f<0x4E>(lb1 ? r0_ : r1_); \
            dsel_ += dpp_f<0x124>(dsel_); dsel_ += dpp_f<0x128>(dsel_);                                        \
            dsel_ += swap16(dsel_); dsel_ += swap32(dsel_);                                                       \
            const float ccv_ = CW * gelu_tanh(dsel_ * hsc * SU) * SV; \
            _Pragma("unroll") for (int i = 0; i < 4; i += 2) { const float cc0 = rdlane(ccv_, 60 + i), cc1 = rdlane(ccv_, 61 + i);     \
                const f32x32 t = __builtin_amdgcn_cvt_scalef32_pk32_f32_fp6((v6u){V[i].x, V[i].y, V[i].z, V[i + 1].x, V[i + 1].y, V[i + 1].z}, 1.0f); \
                _Pragma("unroll") for (int j = 0; j < 16; ++j) out[j] += cc0 * t[j]; _Pragma("unroll") for (int j = 0; j < 16; ++j) out[j] += cc1 * t[16 + j]; } } while (0)
        PEER_LOAD(uA, vA, suA, svA, cA, 0);
        PK_BEGIN(has_next ? nat2prow(nxt) : m);
#pragma clang loop unroll(disable)
        for (int q = 0; q < 64; q += 8) {
            PEER_LOAD(uB, vB, suB, svB, cB, q + 4);
            PK_BIS(2); PK_BIS(2);
            PEER_COMP(uA, vA, suA, svA, cA);
            PEER_LOAD(uA, vA, suA, svA, cA, q + 8);
            PK_BIS(2); PK_BIS(2);
            PEER_COMP(uB, vB, suB, svB, cB);
        }
        PK_MID();
#pragma clang loop unroll(disable)
        for (int q = 64; q < 128; q += 8) {
            PEER_LOAD(uB, vB, suB, svB, cB, q + 4);
            PK_BIS(3); PK_BIS(3);
            PEER_COMP(uA, vA, suA, svA, cA);
            if (q + 8 < 128) PEER_LOAD(uA, vA, suA, svA, cA, q + 8);
            PK_BIS(3); PK_BIS(3);
            PEER_COMP(uB, vB, suB, svB, cB);
        }
        PK_END(buf ^ 1);
#undef PEER_LOAD
#undef PEER_COMP
        if (!dry) { GAS f32x4* xr = (GAS f32x4*)(X + (size_t)m * D_MODEL + 16 * lane);
          f32x4 xv[4]; float s2 = 0.f;
#pragma unroll
          for (int j = 0; j < 4; ++j) { xv[j] = xr[j] + (f32x4){out[4 * j], out[4 * j + 1], out[4 * j + 2], out[4 * j + 3]}; s2 += (xv[j].x * xv[j].x + xv[j].y * xv[j].y) + (xv[j].z * xv[j].z + xv[j].w * xv[j].w); }
          const float rn = __builtin_amdgcn_rsqf(wave_sum(s2) * (1.f / D_MODEL) + EPSF);
          if (l + 1 < DEPTH) {
#pragma unroll
              for (int j = 0; j < 4; ++j) xr[j] = xv[j];
              const GAS f32x4* gr = (const GAS f32x4*)(GIN(a, I_N1) + (size_t)(l + 1) * D_MODEL + 16 * lane); float o16[16];
#pragma unroll
              for (int j = 0; j < 4; ++j) { const f32x4 gg = gr[j]; o16[4 * j] = xv[j].x * rn * gg.x; o16[4 * j + 1] = xv[j].y * rn * gg.y; o16[4 * j + 2] = xv[j].z * rn * gg.z; o16[4 * j + 3] = xv[j].w * rn * gg.w; }
              v4u w0, w1; w0.x = pk2(o16[0], o16[1]); w0.y = pk2(o16[2], o16[3]); w0.z = pk2(o16[4], o16[5]); w0.w = pk2(o16[6], o16[7]); w1.x = pk2(o16[8], o16[9]); w1.y = pk2(o16[10], o16[11]); w1.z = pk2(o16[12], o16[13]); w1.w = pk2(o16[14], o16[15]);
              GAS v4u* xo = (GAS v4u*)((bf16*)(wsb + a.off[R_XN]) + (size_t)m * D_MODEL + 16 * lane); xo[0] = w0; xo[1] = w1;
          } else {
              float* dst = nullptr;
              if (m >= SROW0) dst = GOUT(a) + O_YS + (size_t)(m - SROW0) * D_MODEL; else { const int b_ = m / LPP, p_ = m % LPP; if (p_ >= PADF + N_META) dst = GOUT(a) + O_YP + ((size_t)b_ * SEQ + (p_ - PADF - N_META)) * D_MODEL; }
              if (dst) { const GAS f32x4* gr = (const GAS f32x4*)(GIN(a, I_FN) + 16 * lane); GAS f32x4* o = (GAS f32x4*)(dst + 16 * lane);
#pragma unroll
                  for (int j = 0; j < 4; ++j) { const f32x4 gg = gr[j]; o[j] = (f32x4){xv[j].x * rn * gg.x, xv[j].y * rn * gg.y, xv[j].z * rn * gg.z, xv[j].w * rn * gg.w}; } }
          } }
        if (!has_next) break;
        cur = nxt; buf ^= 1;
        nxt = __builtin_amdgcn_readfirstlane(lane == 0 ? (int)__hip_atomic_fetch_add(rq, 1u, RLX_AGENT) : 0);
    }
#undef PK_BEGIN
#undef PK_WINDOW
#undef PK_MID
#undef PK_END
}
#undef PK_BIS
__device__ __forceinline__ void p_final(Frame& F) {
    const KArgs ap = kargs(); const auto& a = *ap; WS_OPAQUE(a);
    const int tid = otid(), lane = tid & 63, wave = __builtin_amdgcn_readfirstlane(tid >> 6);
    const float* X = (const float*)(wsb + a.off[R_X]); const float* g = GIN(a, I_FN);
    for (int m = F.vcu * NWAVES + wave; m < RP; m += F.G * NWAVES) {
        float* dst;
        if (m >= SROW0) dst = GOUT(a) + O_YS + (size_t)(m - SROW0) * D_MODEL;
        else { const int b = m / LPP, p = m % LPP; if (p < PADF + N_META || p >= PEND) continue; dst = GOUT(a) + O_YP + ((size_t)b * SEQ + (p - PADF - N_META)) * D_MODEL; }
        const GAS f32x4* xr = (const GAS f32x4*)(X + (size_t)m * D_MODEL) + lane;
        f32x4 v[4]; float s2 = 0.f;
#pragma unroll
        for (int j = 0; j < 4; ++j) { v[j] = xr[64 * j]; s2 += (v[j].x * v[j].x + v[j].y * v[j].y) + (v[j].z * v[j].z + v[j].w * v[j].w); }
        const float r = __builtin_amdgcn_rsqf(wave_sum(s2) * (1.f / D_MODEL) + EPSF);
        const GAS f32x4* gr = (const GAS f32x4*)g + lane; GAS f32x4* o = (GAS f32x4*)dst + lane;
#pragma unroll
        for (int j = 0; j < 4; ++j) { const f32x4 gg = gr[64 * j]; o[64 * j] = (f32x4){v[j].x * r * gg.x, v[j].y * r * gg.y, v[j].z * r * gg.z, v[j].w * r * gg.w}; }
    }
}

__device__ __forceinline__ void p_prologue(Frame& F, int pmsel = -1) {
    if (pmsel & PM_NORM0) p_norm0(F);
    const KArgs ap = kargs(); const auto& a = *ap; WS_OPAQUE(a);
    const int tid = otid(), lane = tid & 63, wave = __builtin_amdgcn_readfirstlane(tid >> 6);
    LAS float* scr = (LAS float*)(F.lds + RING_OFF + wave * 16384);
    const int gw = F.vcu * NWAVES + wave, NGW = F.G * NWAVES;
    if (a.pro_mask & pmsel & PM_X) {
        float* X = (float*)(wsb + a.off[R_X]);
        for (int m = gw; m < RP; m += NGW) {
            const float* src = nullptr;
            if (m >= SROW0) src = GIN(a, I_XS) + (size_t)(m - SROW0) * D_MODEL;
            else { const int b = m / LPP, p = m % LPP; if (p >= PADF && p < PEND) { const int pos = p - PADF; src = pos < N_META ? GIN(a, I_META) + (size_t)pos * D_MODEL : GIN(a, I_XP) + ((size_t)b * SEQ + pos - N_META) * D_MODEL; } }
            GAS f32x4* o = (GAS f32x4*)(X + (size_t)m * D_MODEL) + lane;
#pragma unroll
            for (int j = 0; j < 4; ++j) o[64 * j] = src ? ((const GAS f32x4*)src)[lane + 64 * j] : (f32x4){0.f, 0.f, 0.f, 0.f};
        }
    }
    if (a.pro_mask & pmsel & PM_WIN) {
        bf16* WT = (bf16*)(wsb + a.off[R_WIN]);
        constexpr int IPL = (D_MODEL / 64) * (ZN / 32);
        TrItem A, B;
#define WIN_LOAD(T, it_) do { const int l_ = (it_) / IPL, r_ = (it_) % IPL; tr_load(T, GIN(a, I_WIN) + (size_t)l_ * D_MODEL * D_IN, D_IN, 32 * (r_ % (ZN / 32)), 64 * (r_ / (ZN / 32)), CmWin(), lane); } while (0)
        if (gw < DEPTH * IPL) WIN_LOAD(A, gw);
        for (int it = gw; it < DEPTH * IPL; it += NGW) { const int l = it / IPL, r = it % IPL, kb = r / (ZN / 32), nb = r % (ZN / 32);
            if (it + NGW < DEPTH * IPL) WIN_LOAD(B, it + NGW);
            tr_store(A, D_MODEL, WT + (size_t)l * ZN * D_MODEL, 32 * nb, 64 * kb, scr, lane); A = B; }
#undef WIN_LOAD
    }
    __syncthreads();
    if (a.pro_mask & pmsel & PM_TABLES) s5_tables(F);
    __syncthreads();
    if (a.pro_mask & pmsel & PM_WREST) pro_wrest(F);
    if (a.pro_mask & pmsel & PM_WQS) pro_wqs(F);
    if (a.pro_mask & pmsel & PM_PEERW) pro_peerw(F);
}

__global__ void __launch_bounds__(NTHR, 2) mk_fwd(Args args) {
    extern __shared__ __attribute__((aligned(16))) unsigned char lds[];
    Frame F;
    F.lds = (LAS unsigned char*)lds; F.MISC = (volatile LAS unsigned*)(F.lds + MISC_OFF);
    F.wv = __builtin_amdgcn_readfirstlane((int)threadIdx.x >> 6);
    F.G = gridDim.x; { const int bx = blockIdx.x; F.vcu = (F.G % 8 == 0) ? (bx % 8) * (F.G / 8) + bx / 8 : bx; }
    F.ctl = (gu32*)args.ws;
    for (int u = F.wv * 64 + lane_id(); u < (LDS_BYTES - LDSCTL_OFF) / 4; u += NTHR) ((LAS unsigned*)(F.lds + LDSCTL_OFF))[u] = 0u;
    __syncthreads();
    const int lo = args.ph_lo, hi = args.ph_hi;
    unsigned* barw = (unsigned*)(F.ctl + CW_BAR) + (size_t)args.bar_region * XCD_BAR_WORDS;
    XcdBarrier bar; bar.bar = barw; bar.x = 0; bar.st = nullptr; bar.wv = F.wv;
    if (hi - lo > 1) bar = xcd_barrier_post(barw, F.MISC + 8, F.wv);
#define IN(k) (lo <= (k) && (k) < hi)
#ifndef MK_REP
#define MK_REP -1
#endif
#ifdef MK_NOSTEAL
#define STEALBAR(b, F) xcd_barrier(b)
#else
#define STEALBAR(b, F) xcd_barrier_steal(b, F)
#endif
#ifdef MK_TBAR
    unsigned long long tbar_ = 0ull;
#define SEAM(k) do { if ((k) + 1 < hi) { const unsigned long long t0_ = __builtin_amdgcn_s_memrealtime(); xcd_barrier(bar); const unsigned long long t1_ = __builtin_amdgcn_s_memrealtime(); if ((MK_TBAR_SEL) < 0 || ((k) - 1) % NPL == (MK_TBAR_SEL)) tbar_ += t1_ - t0_; } } while (0)
#else
#define SEAM(k) do { if ((k) + 1 < hi) { STEALBAR(bar, F); if ((MK_REP) == 300) xcd_barrier(bar); } } while (0)
#endif
#ifndef MK_REP
#define MK_REP -1
#endif
#ifndef MK_PMASK
#define MK_PMASK -1
#endif
    if (IN(PH_PRO)) { for (int rep_ = 0; rep_ < ((MK_REP) == 200 ? 2 : 1); ++rep_) { p_prologue(F, rep_ == 0 ? -1 : (MK_PMASK)); __syncthreads(); } SEAM(PH_PRO); }
#ifndef MK_REP
#define MK_REP -1
#endif
#define REPEAT(ph) for (int rep_ = 0; rep_ < ((MK_REP) == (ph) ? 2 : 1); ++rep_)
    for (int l = 0; l < DEPTH; ++l) {
        const int pb = 1 + l * NPL;
        if (IN(pb + PL_GEMM_IN)) {
            const KArgs ap = kargs(); const auto& a = *ap; WS_OPAQUE(a);
            pg8::Gemm g{(const pg8::bf16_t*)(wsb + a.off[R_XN]), (const pg8::bf16_t*)(wsb + a.off[R_WIN]) + (size_t)l * ZN * D_MODEL, RP, ZN, D_MODEL};
            pg8::StaticOrder S; S.init(RP, ZN, F.G, (int)blockIdx.x);
            pg8::EpiBf16<0> E{(pg8::bf16_t*)(wsb + a.off[R_Z]), ZN, nullptr, 0, 0, 1.f};
            REPEAT(PL_GEMM_IN) pg8::gemm_phase<pg8::EpiBf16<0>, pg8::StaticOrder, true, true>(F.lds + RING_OFF, g, S, E, F.wv);
            SEAM(pb + PL_GEMM_IN);
        }
        if (IN(pb + PL_ZPOST)) { REPEAT(103) p_s5_e(F, l); REPEAT(PL_ZPOST) p_zpost(F, l);     SEAM(pb + PL_ZPOST); }
        if (IN(pb + PL_LOCAL)) { REPEAT(104) p_gdn_chunk<0>(F, l, 0); SEAM(pb + PL_LOCAL); }
        if (IN(pb + PL_MIX)) {
            REPEAT(100) p_gdn_chain(F, l);
            REPEAT(102) { const int tid = otid(), lane = tid & 63, wave = __builtin_amdgcn_readfirstlane(tid >> 6);
              const int q = F.vcu - F.vcu / 32 - 1;
              if (F.vcu % 32 != 0 && q >= 18) for (int t = (q - 18) * NWAVES + wave; t < S5_NTASK; t += (F.G - F.G / 32 - 18) * NWAVES) s5_scan_run(F, l, t, lane); }
            REPEAT(101) p_attention(F, l + DEPTH * rep_, lds);
            SEAM(pb + PL_MIX); }
        if (IN(pb + PL_MIXPOST)) { REPEAT(PL_MIXPOST) { p_mixpost_a(F, l); p_mixpost_b(F, l); p_s5_out(F, l); } SEAM(pb + PL_MIXPOST); }
        if (IN(pb + PL_GEMM_GLU)) REPEAT(PL_GEMM_GLU) {
            const KArgs ap = kargs(); const auto& a = *ap; WS_OPAQUE(a);
            { pg8::Gemm g{(const pg8::bf16_t*)(wsb + a.off[R_YC]), (const pg8::bf16_t*)(wsb + a.off[R_WGLU]) + (size_t)l * 1024 * 512, RP, 1024, 512};
              pg8::StaticOrder S; S.init(RP, 1024, F.G, (int)blockIdx.x); pg8::EpiGlu E{(pg8::bf16_t*)(wsb + a.off[R_OC]), WIDTH_C};
              pg8::gemm_phase<pg8::EpiGlu, pg8::StaticOrder, true, true>(F.lds + RING_OFF, g, S, E, F.wv); }
            { pg8::Gemm g{(const pg8::bf16_t*)(wsb + a.off[R_OA]), (const pg8::bf16_t*)(wsb + a.off[R_WBR]) + ((size_t)l * 3 + 0) * 1024 * 512, RP, 1024, 512};
              pg8::StaticOrder S; S.init(RP, 1024, F.G, (int)((blockIdx.x + 16) % F.G)); pg8::EpiMerge<0> E{(pg8::bf16_t*)(wsb + a.off[R_MRG]), nullptr, nullptr, (const pg8::bf16_t*)(wsb + a.off[R_Z]) + ZC_GATE, ZN};
              pg8::gemm_phase<pg8::EpiMerge<0>, pg8::StaticOrder, true, true>(F.lds + RING_OFF, g, S, E, F.wv); }
            { pg8::Gemm g{(const pg8::bf16_t*)(wsb + a.off[R_OBN]), (const pg8::bf16_t*)(wsb + a.off[R_WBR]) + ((size_t)l * 3 + 1) * 1024 * 512, RP, 1024, 512};
              pg8::StaticOrder S; S.init(RP, 1024, F.G, (int)((blockIdx.x + 32) % F.G)); pg8::EpiMerge<0> E{(pg8::bf16_t*)(wsb + a.off[R_MRG2]), nullptr, nullptr, (const pg8::bf16_t*)(wsb + a.off[R_Z]) + ZC_GATE + 1024, ZN};
              pg8::gemm_phase<pg8::EpiMerge<0>, pg8::StaticOrder, true, true>(F.lds + RING_OFF, g, S, E, F.wv); }
            if (rep_ == ((MK_REP) == PL_GEMM_GLU ? 1 : 0)) SEAM(pb + PL_GEMM_GLU); }
        if (IN(pb + PL_GEMM_BRC)) {
            const KArgs ap = kargs(); const auto& a = *ap; WS_OPAQUE(a);
            pg8::Gemm g{(const pg8::bf16_t*)(wsb + a.off[R_OC]), (const pg8::bf16_t*)(wsb + a.off[R_WBR]) + ((size_t)l * 3 + 2) * 1024 * 512, RP, 1024, 512};
            pg8::StaticOrder S; S.init(RP, 1024, F.G, (int)blockIdx.x); pg8::EpiMerge<2> E{(pg8::bf16_t*)(wsb + a.off[R_MRG]), (const pg8::bf16_t*)(wsb + a.off[R_MRG2]), (pg8::bf16_t*)(wsb + a.off[R_MRGB]), (const pg8::bf16_t*)(wsb + a.off[R_Z]) + ZC_GATE + 2048, ZN};
            REPEAT(PL_GEMM_BRC) pg8::gemm_phase<pg8::EpiMerge<2>, pg8::StaticOrder, true, true>(F.lds + RING_OFF, g, S, E, F.wv);
            SEAM(pb + PL_GEMM_BRC); }
        if (IN(pb + PL_GEMM_OUT)) {
            const KArgs ap = kargs(); const auto& a = *ap; WS_OPAQUE(a);
            pg8::Gemm g{(const pg8::bf16_t*)(wsb + a.off[R_MRGB]), (const pg8::bf16_t*)(wsb + a.off[R_WOUT]) + (size_t)l * 1024 * 1024, RP, 1024, 1024};
            pg8::StaticOrder S; S.init(RP, 1024, F.G, (int)blockIdx.x);
            REPEAT(PL_GEMM_OUT) { pg8::EpiResid E{(float*)(wsb + a.off[R_X]), D_MODEL, (MK_REP) == PL_GEMM_OUT && rep_ == 0, (pg8::bf16_t*)(wsb + a.off[R_XN])};
            pg8::gemm_phase<pg8::EpiResid, pg8::StaticOrder, true, true>(F.lds + RING_OFF, g, S, E, F.wv); }
            SEAM(pb + PL_GEMM_OUT); }
        if (IN(pb + PL_GEMM_PEER)) {
            peerw_drain(F, (l + 1) * PW_ITEMS_L);
            const KArgs ap = kargs(); const auto& a = *ap; WS_OPAQUE(a);
            pg8::Gemm g{(const pg8::bf16_t*)(wsb + a.off[R_XN]), (const pg8::bf16_t*)(wsb + a.off[R_WQS]) + (size_t)l * PQ * D_MODEL, RP, PQ, D_MODEL};
            pg8::StaticOrder S; S.init(RP, PQ, F.G, (int)blockIdx.x); pg8::EpiF32 E{(float*)(wsb + a.off[R_SC]), PQ};
            REPEAT(PL_GEMM_PEER) pg8::gemm_phase<pg8::EpiF32, pg8::StaticOrder, true, true>(F.lds + RING_OFF, g, S, E, F.wv);
            SEAM(pb + PL_GEMM_PEER); }
        if (IN(pb + PL_PEER)) { REPEAT(PL_PEER) p_peer(F, l, (MK_REP) == PL_PEER && rep_ == 0); SEAM(pb + PL_PEER); }
    }
#ifdef MK_TBAR
    if (blockIdx.x == MK_TBAR_WG && F.wv == 0 && lane_id() == 0) args.out[O_YS] = 1000.f * (MK_TBAR_Q) * floorf((float)tbar_ * 1e-5f / (MK_TBAR_Q) + 0.5f);
#endif
#undef IN
#undef SEAM
}
}
#ifndef MK_ONE_LAUNCH
#define MK_ONE_LAUNCH 1
#endif
static int mk_grid = 0;
static bool mk_setup() {
    if (mk_grid) return mk_grid > 0;
    int dev = 0, cus = 0;
    if (hipGetDevice(&dev) != hipSuccess || hipDeviceGetAttribute(&cus, hipDeviceAttributeMultiprocessorCount, dev) != hipSuccess) { mk_grid = -1; return false; }
    if (hipFuncSetAttribute((const void*)mk::mk_fwd, hipFuncAttributeMaxDynamicSharedMemorySize, mk::LDS_BYTES) != hipSuccess) { fprintf(stderr, "kernel_launch: hipFuncSetAttribute failed\n"); mk_grid = -1; return false; }
    int per_cu = 0;
    if (hipOccupancyMaxActiveBlocksPerMultiprocessor(&per_cu, (const void*)mk::mk_fwd, mk::NTHR, mk::LDS_BYTES) != hipSuccess || per_cu < 1) { fprintf(stderr, "kernel_launch: occupancy query says %d workgroups per CU\n", per_cu); }
    (void)hipGetLastError();
    mk_grid = cus;
    return true;
}
static void mk_launch(mk::Args a, int lo, int hi, int region, hipStream_t stream) {
    a.ph_lo = lo; a.ph_hi = hi; a.bar_region = region;
    hipLaunchKernelGGL(mk::mk_fwd, dim3(mk_grid), dim3(mk::NTHR), mk::LDS_BYTES, stream, a);
    hipError_t e = hipPeekAtLastError(); if (e != hipSuccess) fprintf(stderr, "kernel_launch: launch failed: %s\n", hipGetErrorName(e));
}
extern "C" void kernel_launch(void* const* d_in, const int* in_sizes, int n_in, void* d_out, int out_size, void* d_ws, size_t ws_size, hipStream_t stream) {
    if (n_in != N_INPUTS || (size_t)out_size != (size_t)O_END) { fprintf(stderr, "kernel_launch: unexpected n_in %d / out_size %d\n", n_in, out_size); return; }
    if (!mk_setup()) return;
    const size_t MiB = 1u << 20;
    unsigned char* ws = (unsigned char*)d_ws;
    mk::Args a{};
    for (int i = 0; i < N_INPUTS; ++i) a.in[i] = (const float*)d_in[i];
    a.out = (float*)d_out; a.ws = ws;
    { using namespace mk; const struct { int r; size_t mib; } map[] = { {R_WIN, 1}, {R_WGLU, 59}, {R_WBR, 63}, {R_WOUT, 75}, {R_WQS, 83}, {R_S5T, 99}, {R_PU, 132}, {R_PV, 196}, {R_MISC, 260}, {R_OBN, 262}, {R_MRG2, 280}, {R_X, 388}, {R_XN, 456},
        {R_Z, 490}, {R_SC, 490}, {R_QN, 737}, {R_KN, 754}, {R_QKVB, 771}, {R_BG, 822}, {R_O, 823}, {R_MRGB, 823}, {R_OA, 857}, {R_OB, 874}, {R_GDN, 891}, {R_MRG, 891},
        {R_S5E, 986}, {R_YC, 986}, {R_S5X, 1003}, {R_OC, 1012} };
      for (auto& e : map) a.off[e.r] = e.mib * MiB; }
    if (1029 * MiB > ws_size) { fprintf(stderr, "kernel_launch: workspace too small (%zu)\n", ws_size); return; }
    if (hipMemsetAsync(ws, 0, mk::CTL_BYTES, stream) != hipSuccess) { fprintf(stderr, "kernel_launch: memset failed\n"); return; }
    a.pro_mask =   mk::PM_WIN | mk::PM_TABLES | mk::PM_WREST | mk::PM_WQS;
#if MK_ONE_LAUNCH
    mk_launch(a, 0, mk::PH_END, 0, stream);
#else
    int region = 0;
    mk_launch(a, mk::PH_PRO, mk::PH_PRO + 1, region++, stream);
    for (int l = 0; l < DEPTH; ++l) { const int pb = 1 + l * mk::NPL;
        for (int ph = mk::PL_NORM1; ph <= mk::PL_PEER; ++ph) { if (ph == mk::PL_GEMM_BRA || ph == mk::PL_GEMM_BRB) continue; mk_launch(a, pb + ph, pb + ph + 1, region++, stream); } }
    mk_launch(a, mk::PH_FINAL, mk::PH_END, region++, stream);
#endif
}
```
